# Optimizing an MI355X kernel written in HIP

```python
import jax, jax.numpy as jnp
from jax import lax
import numpy as np

D_MODEL = 2048
BATCH = 1
SEQ = 16384
DEPTH = 1

HEAD_DIM = 128
N_ATT_HEADS = 8
N_KV_GROUPS = 2
HEADS_PER_GROUP = N_ATT_HEADS // N_KV_GROUPS
ATT_WIDTH = N_ATT_HEADS * HEAD_DIM
KV_WIDTH = N_KV_GROUPS * HEAD_DIM
N_CONV_GROUPS = 8
CONV_WIDTH = N_CONV_GROUPS * HEAD_DIM
MIX_WIDTH = ATT_WIDTH + CONV_WIDTH
N_MIX_GROUPS = N_ATT_HEADS + N_CONV_GROUPS
N_BRANCH = 3
CMP_BLOCK = 32
CMP_STRIDE = 16
CMP_HIDDEN = 512
SLC_BLOCK = 64
N_SELECT = 16
WINDOW = 512
Q_BLOCK = 128
CONV_K = 3
PEER_HEADS = 8
N_KEYS = 128
N_EXPERTS = N_KEYS * N_KEYS
PEER_QDIM = 256
PEER_HALF = PEER_QDIM // 2
PEER_TOPK = 16
TOKEN_CHUNK = 128
ALPHA = (2.0 * DEPTH) ** 0.25
BETA = (8.0 * DEPTH) ** -0.25
LN_EPS = 1e-5
RMS_EPS = 1e-6
NEG_INF = -1e30
FORCE_BONUS = 1e4
SPLIT_SIZES = (ATT_WIDTH, KV_WIDTH, KV_WIDTH, KV_WIDTH, KV_WIDTH, KV_WIDTH, KV_WIDTH,
               N_ATT_HEADS * N_BRANCH, CONV_WIDTH, CONV_WIDTH, CONV_WIDTH)
IN_WIDTH = sum(SPLIT_SIZES)

kernel_name = 'hybrid_nsa_shortconv_peer_deepnorm'


def _layernorm(x, g, b):
    xf = x.astype(jnp.float32)
    mu = xf.mean(-1, keepdims=True)
    var = jnp.square(xf - mu).mean(-1, keepdims=True)
    return ((xf - mu) * lax.rsqrt(var + LN_EPS) * g + b).astype(x.dtype)


def _head_rmsnorm(y, g):
    B, S, _ = y.shape
    yf = y.astype(jnp.float32).reshape(B, S, N_MIX_GROUPS, HEAD_DIM)
    yf = yf * lax.rsqrt(jnp.mean(jnp.square(yf), -1, keepdims=True) + RMS_EPS)
    return (yf.reshape(B, S, MIX_WIDTH) * g).astype(y.dtype)


def _alibi_slopes():
    return 2.0 ** (-8.0 * jnp.arange(1, N_ATT_HEADS + 1, dtype=jnp.float32) / N_ATT_HEADS)


def _compress(kv, pos, w1, b1, w2):
    B, S, G, D = kv.shape
    n_cmp = (S - CMP_BLOCK) // CMP_STRIDE + 1
    idx = jnp.arange(n_cmp)[:, None] * CMP_STRIDE + jnp.arange(CMP_BLOCK)[None, :]
    blocks = kv[:, idx] + pos[None, None, :, None, :]
    blocks = blocks.transpose(0, 1, 3, 2, 4).reshape(B, n_cmp, G, CMP_BLOCK * D)
    return jax.nn.gelu(blocks @ w1 + b1) @ w2


def _nsa(q, k_cmp, v_cmp, k_slc, v_slc, k_win, v_win, gates):
    B, S = q.shape[:2]
    G, R, D = N_KV_GROUPS, HEADS_PER_GROUP, HEAD_DIM
    f32 = jnp.float32
    n_cmp = k_cmp.shape[1]
    n_slc = S // SLC_BLOCK
    n_sel = min(N_SELECT, n_slc)
    n_qb = S // Q_BLOCK
    scale = D ** -0.5
    slopes = _alibi_slopes().reshape(G, R)
    sl5 = slopes[None, :, :, None, None]
    sl6 = slopes[None, :, :, None, None, None]
    q = q.astype(f32)
    k_cmp, v_cmp = k_cmp.astype(f32), v_cmp.astype(f32)
    cmp_pos = jnp.arange(n_cmp, dtype=f32) * CMP_STRIDE + (CMP_BLOCK - 1) / 2.0
    cmp_end = jnp.arange(n_cmp) * CMP_STRIDE + CMP_BLOCK - 1
    ci = jnp.arange(n_cmp, dtype=f32)[:, None] * CMP_STRIDE
    sj = jnp.arange(n_slc, dtype=f32)[None, :] * SLC_BLOCK
    overlap = ((ci < sj + SLC_BLOCK) & (ci + CMP_BLOCK > sj)).astype(f32)
    k_blocks = k_slc.astype(f32).reshape(B, n_slc, SLC_BLOCK, G, D).transpose(0, 3, 1, 2, 4)
    v_blocks = v_slc.astype(f32).reshape(B, n_slc, SLC_BLOCK, G, D).transpose(0, 3, 1, 2, 4)
    k_wpad = jnp.pad(k_win.astype(f32), ((0, 0), (WINDOW, 0), (0, 0), (0, 0)))
    v_wpad = jnp.pad(v_win.astype(f32), ((0, 0), (WINDOW, 0), (0, 0), (0, 0)))
    b_ix = jnp.arange(B)[:, None, None, None]
    g_ix = jnp.arange(G)[None, :, None, None]
    jb = jnp.arange(n_slc)

    def block(nb):
        s0 = nb * Q_BLOCK
        t = s0 + jnp.arange(Q_BLOCK)
        tf = t.astype(f32)
        qb = lax.dynamic_slice_in_dim(q, s0, Q_BLOCK, axis=1).reshape(B, Q_BLOCK, G, R, D) * scale
        gb = lax.dynamic_slice_in_dim(gates, s0, Q_BLOCK, axis=1).reshape(B, Q_BLOCK, G, R, N_BRANCH)
        s = jnp.einsum('bqgrd,bngd->bgrqn', qb, k_cmp) - sl5 * (tf[:, None] - cmp_pos[None, :])
        valid = cmp_end[None, :] <= t[:, None]
        p_cmp = jax.nn.softmax(jnp.where(valid, s, NEG_INF), axis=-1) * valid
        o_cmp = jnp.einsum('bgrqn,bngd->bqgrd', p_cmp, v_cmp)
        imp = jnp.einsum('bgrqn,nj->bgqj', p_cmp, overlap)
        cur = t // SLC_BLOCK
        valid_s = jb[None, :] * SLC_BLOCK <= t[:, None]
        forced = (jb[None, :] == 0) | (jb[None, :] == cur[:, None]) | (jb[None, :] == cur[:, None] - 1)
        score = jnp.where(valid_s, imp + FORCE_BONUS * forced, -1.0)
        _, sel = lax.top_k(score, n_sel)
        kb = k_blocks[b_ix, g_ix, sel]
        vb = v_blocks[b_ix, g_ix, sel]
        pos = sel[..., None] * SLC_BLOCK + jnp.arange(SLC_BLOCK)
        dist = (t[:, None, None] - pos)[:, :, None]
        s = jnp.einsum('bqgrd,bgqkpd->bgrqkp', qb, kb) - sl6 * dist.astype(f32)
        s = jnp.where(dist >= 0, s, NEG_INF)
        p = jax.nn.softmax(s.reshape(B, G, R, Q_BLOCK, n_sel * SLC_BLOCK), axis=-1)
        p = p.reshape(B, G, R, Q_BLOCK, n_sel, SLC_BLOCK)
        o_slc = jnp.einsum('bgrqkp,bgqkpd->bqgrd', p, vb)
        kw = lax.dynamic_slice_in_dim(k_wpad, s0, WINDOW + Q_BLOCK, axis=1)
        vw = lax.dynamic_slice_in_dim(v_wpad, s0, WINDOW + Q_BLOCK, axis=1)
        posw = s0 - WINDOW + jnp.arange(WINDOW + Q_BLOCK)
        dw = t[:, None] - posw[None, :]
        mw = (dw >= 0) & (dw < WINDOW) & (posw[None, :] >= 0)
        s = jnp.einsum('bqgrd,bkgd->bgrqk', qb, kw) - sl5 * dw.astype(f32)
        p = jax.nn.softmax(jnp.where(mw, s, NEG_INF), axis=-1)
        o_win = jnp.einsum('bgrqk,bkgd->bqgrd', p, vw)
        o = gb[..., 0:1] * o_cmp + gb[..., 1:2] * o_slc + gb[..., 2:3] * o_win
        return o.reshape(B, Q_BLOCK, ATT_WIDTH)

    out = lax.map(block, jnp.arange(n_qb))
    return out.transpose(1, 0, 2, 3).reshape(B, S, ATT_WIDTH)


def _short_conv(u, gate_b, gate_c, conv_w):
    y = lax.conv_general_dilated(gate_c * u, conv_w[:, None, :].astype(u.dtype), window_strides=(1,),
                                 padding=[(CONV_K - 1, 0)], dimension_numbers=('NWC', 'WIO', 'NWC'),
                                 feature_group_count=CONV_WIDTH)
    return gate_b * y


def _peer(h, w_query, sub_keys, expert_u, expert_v):
    B, S, D = h.shape
    q = (h @ w_query).reshape(B, S, PEER_HEADS, 2, PEER_HALF).astype(jnp.float32)
    s = jnp.einsum('bshcd,hckd->bshck', q, sub_keys.astype(jnp.float32))
    top_s, top_i = lax.top_k(s, PEER_TOPK)
    cand = top_s[..., 0, :, None] + top_s[..., 1, None, :]
    cand = cand.reshape(B, S, PEER_HEADS, PEER_TOPK * PEER_TOPK)
    best_s, best_i = lax.top_k(cand, PEER_TOPK)
    i1 = jnp.take_along_axis(top_i[..., 0, :], best_i // PEER_TOPK, axis=-1)
    i2 = jnp.take_along_axis(top_i[..., 1, :], best_i % PEER_TOPK, axis=-1)
    eid = i1 * N_KEYS + i2
    g = jax.nn.softmax(best_s, axis=-1).astype(h.dtype)
    n_ch = (B * S) // TOKEN_CHUNK
    hc = h.reshape(n_ch, TOKEN_CHUNK, D)
    ec = eid.reshape(n_ch, TOKEN_CHUNK, PEER_HEADS, PEER_TOPK)
    gc = g.reshape(n_ch, TOKEN_CHUNK, PEER_HEADS, PEER_TOPK)

    def chunk(args):
        hx, e, gw = args
        a = jax.nn.gelu(jnp.einsum('td,thkd->thk', hx, expert_u[e]))
        return jnp.einsum('thk,thkd->td', gw * a, expert_v[e])

    return lax.map(chunk, (hc, ec, gc)).reshape(B, S, D)


def setup_inputs(seed: int = 0) -> dict:
    key = jax.random.key(seed)
    ks = jax.random.split(key, 24)
    L, D = DEPTH, D_MODEL
    nrm = lambda k, shape, sc: jax.random.normal(k, shape, jnp.float32) * sc
    col_scale = np.concatenate([
        np.ones(ATT_WIDTH), np.ones(KV_WIDTH), np.full(KV_WIDTH, BETA), np.ones(KV_WIDTH),
        np.full(KV_WIDTH, BETA), np.ones(KV_WIDTH), np.full(KV_WIDTH, BETA),
        np.ones(N_ATT_HEADS * N_BRANCH), np.full(CONV_WIDTH, BETA), np.ones(CONV_WIDTH),
        np.ones(CONV_WIDTH)]).astype(np.float32)
    return {
        'x': nrm(ks[0], (BATCH, SEQ, D), 1.0),
        'w_in': nrm(ks[1], (L, D, IN_WIDTH), D ** -0.5) * jnp.asarray(col_scale),
        'cmp_k_pos': nrm(ks[2], (L, CMP_BLOCK, HEAD_DIM), 0.1),
        'cmp_k_w1': nrm(ks[3], (L, CMP_BLOCK * HEAD_DIM, CMP_HIDDEN), (CMP_BLOCK * HEAD_DIM) ** -0.5),
        'cmp_k_b1': nrm(ks[4], (L, CMP_HIDDEN), 0.01),
        'cmp_k_w2': nrm(ks[5], (L, CMP_HIDDEN, HEAD_DIM), CMP_HIDDEN ** -0.5),
        'cmp_v_pos': nrm(ks[6], (L, CMP_BLOCK, HEAD_DIM), 0.1),
        'cmp_v_w1': nrm(ks[7], (L, CMP_BLOCK * HEAD_DIM, CMP_HIDDEN), (CMP_BLOCK * HEAD_DIM) ** -0.5),
        'cmp_v_b1': nrm(ks[8], (L, CMP_HIDDEN), 0.01),
        'cmp_v_w2': nrm(ks[9], (L, CMP_HIDDEN, HEAD_DIM), CMP_HIDDEN ** -0.5),
        'conv_w': nrm(ks[10], (L, CONV_K, CONV_WIDTH), 0.5),
        'head_norm_g': 1.0 + nrm(ks[11], (L, MIX_WIDTH), 0.02),
        'w_out': nrm(ks[12], (L, MIX_WIDTH, D), BETA * MIX_WIDTH ** -0.5),
        'ln1_g': 1.0 + nrm(ks[13], (L, D), 0.02),
        'ln1_b': nrm(ks[14], (L, D), 0.01),
        'w_query': nrm(ks[15], (L, D, PEER_HEADS * PEER_QDIM), D ** -0.5),
        'sub_keys': nrm(ks[16], (L, PEER_HEADS, 2, N_KEYS, PEER_HALF), PEER_HALF ** -0.5),
        'expert_u': nrm(ks[17], (L, N_EXPERTS, D), D ** -0.5),
        'expert_v': nrm(ks[18], (L, N_EXPERTS, D), BETA),
        'ln2_g': 1.0 + nrm(ks[19], (L, D), 0.02),
        'ln2_b': nrm(ks[20], (L, D), 0.01),
    }


def reference(x, w_in, cmp_k_pos, cmp_k_w1, cmp_k_b1, cmp_k_w2, cmp_v_pos, cmp_v_w1, cmp_v_b1,
              cmp_v_w2, conv_w, head_norm_g, w_out, ln1_g, ln1_b, w_query, sub_keys, expert_u,
              expert_v, ln2_g, ln2_b):
    B, S, _ = x.shape
    offs = np.cumsum(SPLIT_SIZES)[:-1].tolist()
    for l in range(DEPTH):
        proj = x @ w_in[l]
        q, k_c, v_c, k_s, v_s, k_w, v_w, gate_logits, u, gate_b, gate_c = jnp.split(proj, offs, axis=-1)
        grp = lambda t: t.reshape(B, S, N_KV_GROUPS, HEAD_DIM)
        kc = _compress(grp(k_c), cmp_k_pos[l], cmp_k_w1[l], cmp_k_b1[l], cmp_k_w2[l])
        vc = _compress(grp(v_c), cmp_v_pos[l], cmp_v_w1[l], cmp_v_b1[l], cmp_v_w2[l])
        gates = jax.nn.sigmoid(gate_logits).reshape(B, S, N_ATT_HEADS, N_BRANCH)
        o_att = _nsa(q.reshape(B, S, N_ATT_HEADS, HEAD_DIM), kc, vc, grp(k_s), grp(v_s),
                     grp(k_w), grp(v_w), gates).astype(x.dtype)
        o_conv = _short_conv(u, gate_b, gate_c, conv_w[l])
        mix = _head_rmsnorm(jnp.concatenate([o_att, o_conv], axis=-1), head_norm_g[l])
        h = _layernorm(ALPHA * x + mix @ w_out[l], ln1_g[l], ln1_b[l])
        x = _layernorm(ALPHA * h + _peer(h, w_query[l], sub_keys[l], expert_u[l], expert_v[l]),
                       ln2_g[l], ln2_b[l])
    return x
```

```cpp
#include <hip/hip_runtime.h>
#include <stdint.h>

#define DI __device__ __forceinline__
typedef unsigned short bf16_t;
using bf16x8 = __attribute__((ext_vector_type(8))) short;
using f32x4 = __attribute__((ext_vector_type(4))) float;
using u32x4 = __attribute__((ext_vector_type(4))) unsigned;

constexpr int S = 16384, DM = 2048, HD = 128;
constexpr int INW = 5656, INWP = 5760;
constexpr int OFF_Q = 0, OFF_KC = 1024, OFF_VC = 1280, OFF_KS = 1536, OFF_VS = 1792, OFF_KW = 2048, OFF_VW = 2304,
              OFF_G = 2560, OFF_U = 2584, OFF_B = 3608, OFF_C = 4632;
constexpr int NCMP = 1023;
constexpr float ALPHA = 1.189207115002721f;
constexpr float QSCALE = 0.08838834764831845f;

DI bf16_t f2bf(float x) { unsigned u = __float_as_uint(x); u += 0x7fffu + ((u >> 16) & 1u); return (bf16_t)(u >> 16); }
DI float bf2f(bf16_t b) { return __uint_as_float(((unsigned)b) << 16); }
DI float gelu_tanh(float x) { float u = 0.7978845608028654f * (x + 0.044715f * x * x * x); return 0.5f * x * (1.f + tanhf(u)); }
DI float wave_sum(float v) { for (int o = 32; o > 0; o >>= 1) v += __shfl_xor(v, o); return v; }
DI float wave_max(float v) { for (int o = 32; o > 0; o >>= 1) v = fmaxf(v, __shfl_xor(v, o)); return v; }

__global__ void k_cvt(const float* __restrict__ in, bf16_t* __restrict__ out, size_t n) {
  size_t i = (size_t)blockIdx.x * blockDim.x + threadIdx.x;
  size_t stride = (size_t)gridDim.x * blockDim.x;
  for (; i < n; i += stride) out[i] = f2bf(in[i]);
}
__global__ void k_cvtT(const float* __restrict__ W, bf16_t* __restrict__ WT, int K, int N, int NP) {
  __shared__ float t[32][33];
  int n0 = blockIdx.x * 32, k0 = blockIdx.y * 32;
  int tx = threadIdx.x & 31, ty = threadIdx.x >> 5;
  for (int i = ty; i < 32; i += 8) { int k = k0 + i, n = n0 + tx; t[i][tx] = (n < N && k < K) ? W[(size_t)k * N + n] : 0.f; }
  __syncthreads();
  for (int i = ty; i < 32; i += 8) { int n = n0 + i, k = k0 + tx; if (n < NP && k < K) WT[(size_t)n * K + k] = f2bf(t[tx][i]); }
}

constexpr int LDS_LD = 72;
struct EpiProj { bf16_t* proj; float* gates; };
struct EpiF32 { float* C; int ldc; int N; };
struct EpiRes { float* C; const float* X; };

template <class Epi>
__global__ void __launch_bounds__(256) k_gemm(const bf16_t* __restrict__ A, int lda, const bf16_t* __restrict__ BT, int ldb, int K,
                                               int tilesM, Epi epi) {
  __shared__ __attribute__((aligned(16))) bf16_t As[128 * LDS_LD];
  __shared__ __attribute__((aligned(16))) bf16_t Bs[128 * LDS_LD];
  const int tid = threadIdx.x, lane = tid & 63, wid = tid >> 6;
  const int wm = wid >> 1, wn = wid & 1;
  const int tm = blockIdx.x % tilesM, tn = blockIdx.x / tilesM;
  const int m0 = tm * 128, n0 = tn * 128;
  f32x4 acc[4][4];
#pragma unroll
  for (int i = 0; i < 4; ++i)
#pragma unroll
    for (int j = 0; j < 4; ++j) acc[i][j] = f32x4{0.f, 0.f, 0.f, 0.f};
  u32x4 ra[4], rb[4];
#define GLOAD(k0_)                                                                  \
  _Pragma("unroll") for (int i = 0; i < 4; ++i) {                                   \
    int c = tid + i * 256; int row = c >> 3, kc = c & 7;                            \
    ra[i] = *(const u32x4*)(A + (size_t)(m0 + row) * lda + (k0_) + kc * 8);         \
    rb[i] = *(const u32x4*)(BT + (size_t)(n0 + row) * ldb + (k0_) + kc * 8);        \
  }
  GLOAD(0)
  for (int k0 = 0; k0 < K; k0 += 64) {
    __syncthreads();
#pragma unroll
    for (int i = 0; i < 4; ++i) {
      int c = tid + i * 256; int row = c >> 3, kc = c & 7;
      *(u32x4*)(As + row * LDS_LD + kc * 8) = ra[i];
      *(u32x4*)(Bs + row * LDS_LD + kc * 8) = rb[i];
    }
    __syncthreads();
    if (k0 + 64 < K) { GLOAD(k0 + 64) }
#pragma unroll
    for (int ks = 0; ks < 2; ++ks) {
      bf16x8 a[4], b[4];
#pragma unroll
      for (int i = 0; i < 4; ++i) {
        a[i] = *(const bf16x8*)(As + (wm * 64 + i * 16 + (lane & 15)) * LDS_LD + ks * 32 + (lane >> 4) * 8);
        b[i] = *(const bf16x8*)(Bs + (wn * 64 + i * 16 + (lane & 15)) * LDS_LD + ks * 32 + (lane >> 4) * 8);
      }
#pragma unroll
      for (int i = 0; i < 4; ++i)
#pragma unroll
        for (int j = 0; j < 4; ++j) acc[i][j] = __builtin_amdgcn_mfma_f32_16x16x32_bf16(a[i], b[j], acc[i][j], 0, 0, 0);
    }
  }
#pragma unroll
  for (int i = 0; i < 4; ++i)
#pragma unroll
    for (int j = 0; j < 4; ++j)
#pragma unroll
      for (int r = 0; r < 4; ++r) {
        int row = m0 + wm * 64 + i * 16 + (lane >> 4) * 4 + r;
        int col = n0 + wn * 64 + j * 16 + (lane & 15);
        epi(row, col, acc[i][j][r]);
      }
}
struct EpiProjF {
  bf16_t* proj; float* gates;
  DI void operator()(int row, int col, float v) const {
    if (col < INW) proj[(size_t)row * INWP + col] = f2bf(v);
    if (col >= OFF_G && col < OFF_G + 24) gates[row * 24 + (col - OFF_G)] = 1.f / (1.f + __expf(-v));
  }
};
struct EpiF32F {
  float* C; int ldc; int N;
  DI void operator()(int row, int col, float v) const { if (col < N) C[(size_t)row * ldc + col] = v; }
};
struct EpiResF {
  float* C; const float* X;
  DI void operator()(int row, int col, float v) const { C[(size_t)row * DM + col] = ALPHA * X[(size_t)row * DM + col] + v; }
};

__global__ void k_build_cmp(const bf16_t* __restrict__ proj, int off, const float* __restrict__ pos, bf16_t* __restrict__ Ac) {
  int row = blockIdx.x;
  int n = row >> 1, g = row & 1;
  for (int k = threadIdx.x; k < 4096; k += blockDim.x) {
    float v = 0.f;
    if (row < 2046) { int l = k >> 7, d = k & 127; v = bf2f(proj[(size_t)(16 * n + l) * INWP + off + g * 128 + d]) + pos[l * 128 + d]; }
    Ac[(size_t)row * 4096 + k] = f2bf(v);
  }
}
__global__ void k_cmp2(const float* __restrict__ hid, const float* __restrict__ b1, const float* __restrict__ w2, float* __restrict__ out) {
  __shared__ float a[512];
  int row = blockIdx.x;
  for (int j = threadIdx.x; j < 512; j += blockDim.x) a[j] = gelu_tanh(hid[(size_t)row * 512 + j] + b1[j]);
  __syncthreads();
  int d = threadIdx.x;
  float s = 0.f;
  for (int j = 0; j < 512; ++j) s += a[j] * w2[j * 128 + d];
  out[(size_t)row * 128 + d] = s;
}

__global__ void __launch_bounds__(256) k_nsa(const bf16_t* __restrict__ proj, const float* __restrict__ gates,
                                             const float* __restrict__ kc, const float* __restrict__ vc, float* __restrict__ oatt) {
  __shared__ float qs[4][128];
  __shared__ float sc[4][1024];
  __shared__ float imp[256];
  __shared__ float score[256];
  __shared__ int sel[16];
  const int t = blockIdx.x >> 1, g = blockIdx.x & 1;
  const int tid = threadIdx.x, lane = tid & 63, r = tid >> 6;
  const int hd = g * 4 + r;
  const float slope = exp2f(-(float)(hd + 1));
  const bf16_t* prow = proj + (size_t)t * INWP;
  for (int d = lane; d < 128; d += 64) qs[r][d] = bf2f(prow[OFF_Q + hd * 128 + d]) * QSCALE;
  __syncthreads();
  float ocmp0 = 0.f, ocmp1 = 0.f;
  int nv = (t >= 31) ? ((t - 31) / 16 + 1) : 0; if (nv > NCMP) nv = NCMP;
  {
    float mx = -3e38f;
    for (int n = lane; n < nv; n += 64) {
      const float* kr = kc + ((size_t)n * 2 + g) * 128;
      float s = 0.f;
      for (int d = 0; d < 128; ++d) s += qs[r][d] * kr[d];
      s -= slope * ((float)t - ((float)n * 16.f + 15.5f));
      sc[r][n] = s; mx = fmaxf(mx, s);
    }
    mx = wave_max(mx);
    float sum = 0.f;
    for (int n = lane; n < nv; n += 64) { float e = __expf(sc[r][n] - mx); sc[r][n] = e; sum += e; }
    sum = wave_sum(sum);
    float inv = nv > 0 ? 1.f / sum : 0.f;
    for (int n = lane; n < 1024; n += 64) sc[r][n] = (n < nv) ? sc[r][n] * inv : 0.f;
    __syncthreads();
    for (int n = 0; n < nv; ++n) {
      float p = sc[r][n];
      const float* vr = vc + ((size_t)n * 2 + g) * 128;
      ocmp0 += p * vr[lane * 2]; ocmp1 += p * vr[lane * 2 + 1];
    }
  }
  {
    int j = tid;
    float s = 0.f;
    for (int rr = 0; rr < 4; ++rr)
      for (int n = 4 * j - 1; n <= 4 * j + 3; ++n)
        if (n >= 0 && n < NCMP) s += sc[rr][n];
    imp[j] = s;
    int cur = t >> 6;
    bool valid = j <= cur;
    bool forced = (j == 0) || (j == cur) || (j == cur - 1);
    score[j] = valid ? (s + (forced ? 1e4f : 0.f)) : -1.f;
  }
  __syncthreads();
  {
    int j = tid; float my = score[j]; int rank = 0;
    for (int i = 0; i < 256; ++i) { float o = score[i]; rank += (o > my || (o == my && i < j)) ? 1 : 0; }
    if (rank < 16) sel[rank] = j;
  }
  __syncthreads();
  float oslc0 = 0.f, oslc1 = 0.f;
  {
    float mx = -3e38f;
    for (int i = 0; i < 16; ++i) {
      int pos = sel[i] * 64 + lane;
      float s = -3e38f;
      if (pos <= t) {
        const bf16_t* kr = proj + (size_t)pos * INWP + OFF_KS + g * 128;
        float a = 0.f;
        for (int d = 0; d < 128; ++d) a += qs[r][d] * bf2f(kr[d]);
        s = a - slope * (float)(t - pos);
      }
      sc[r][i * 64 + lane] = s; mx = fmaxf(mx, s);
    }
    mx = wave_max(mx);
    float sum = 0.f;
    for (int i = 0; i < 16; ++i) { float s = sc[r][i * 64 + lane]; float e = (s > -1e38f) ? __expf(s - mx) : 0.f; sc[r][i * 64 + lane] = e; sum += e; }
    sum = wave_sum(sum);
    float inv = 1.f / sum;
    __syncthreads();
    for (int i = 0; i < 16; ++i) {
      int b0 = sel[i] * 64;
      for (int kk = 0; kk < 64; ++kk) {
        int pos = b0 + kk; if (pos > t) break;
        float p = sc[r][i * 64 + kk];
        const bf16_t* vr = proj + (size_t)pos * INWP + OFF_VS + g * 128;
        oslc0 += p * bf2f(vr[lane * 2]); oslc1 += p * bf2f(vr[lane * 2 + 1]);
      }
    }
    oslc0 *= inv; oslc1 *= inv;
  }
  __syncthreads();
  float owin0 = 0.f, owin1 = 0.f;
  {
    int p0 = t - 511; if (p0 < 0) p0 = 0;
    int nk = t - p0 + 1;
    float mx = -3e38f;
    for (int i = lane; i < nk; i += 64) {
      int pos = p0 + i;
      const bf16_t* kr = proj + (size_t)pos * INWP + OFF_KW + g * 128;
      float a = 0.f;
      for (int d = 0; d < 128; ++d) a += qs[r][d] * bf2f(kr[d]);
      float s = a - slope * (float)(t - pos);
      sc[r][i] = s; mx = fmaxf(mx, s);
    }
    mx = wave_max(mx);
    float sum = 0.f;
    for (int i = lane; i < nk; i += 64) { float e = __expf(sc[r][i] - mx); sc[r][i] = e; sum += e; }
    sum = wave_sum(sum);
    float inv = 1.f / sum;
    __syncthreads();
    for (int i = 0; i < nk; ++i) {
      float p = sc[r][i];
      const bf16_t* vr = proj + (size_t)(p0 + i) * INWP + OFF_VW + g * 128;
      owin0 += p * bf2f(vr[lane * 2]); owin1 += p * bf2f(vr[lane * 2 + 1]);
    }
    owin0 *= inv; owin1 *= inv;
  }
  const float* gt = gates + (size_t)t * 24 + hd * 3;
  float g0 = gt[0], g1 = gt[1], g2 = gt[2];
  float* o = oatt + (size_t)t * 1024 + hd * 128 + lane * 2;
  o[0] = g0 * ocmp0 + g1 * oslc0 + g2 * owin0;
  o[1] = g0 * ocmp1 + g1 * oslc1 + g2 * owin1;
}

__global__ void __launch_bounds__(256) k_mix(const bf16_t* __restrict__ proj, const float* __restrict__ oatt, const float* __restrict__ convw,
                                             const float* __restrict__ hng, bf16_t* __restrict__ mix) {
  const int t = blockIdx.x, tid = threadIdx.x;
  float v[8];
  const int c0 = tid * 8;
  if (c0 < 1024) {
    for (int i = 0; i < 8; ++i) v[i] = oatt[(size_t)t * 1024 + c0 + i];
  } else {
    int c = c0 - 1024;
    for (int i = 0; i < 8; ++i) {
      float acc = 0.f;
      for (int j = 0; j < 3; ++j) {
        int tt = t - 2 + j;
        if (tt >= 0) {
          const bf16_t* pr = proj + (size_t)tt * INWP;
          acc += convw[j * 1024 + c + i] * bf2f(pr[OFF_C + c + i]) * bf2f(pr[OFF_U + c + i]);
        }
      }
      v[i] = acc * bf2f(proj[(size_t)t * INWP + OFF_B + c + i]);
    }
  }
  float ss = 0.f;
  for (int i = 0; i < 8; ++i) ss += v[i] * v[i];
  for (int o = 8; o > 0; o >>= 1) ss += __shfl_xor(ss, o);
  float rs = rsqrtf(ss * (1.f / 128.f) + 1e-6f);
  for (int i = 0; i < 8; ++i) mix[(size_t)t * DM + c0 + i] = f2bf(v[i] * rs * hng[c0 + i]);
}

__global__ void __launch_bounds__(256) k_ln(const float* __restrict__ y, const float* __restrict__ gam, const float* __restrict__ bet,
                                            float* __restrict__ hf, bf16_t* __restrict__ hb) {
  __shared__ float red[8];
  const int t = blockIdx.x, tid = threadIdx.x;
  float v[8]; float s = 0.f;
  for (int i = 0; i < 8; ++i) { v[i] = y[(size_t)t * DM + tid + i * 256]; s += v[i]; }
  s = wave_sum(s); if ((tid & 63) == 0) red[tid >> 6] = s; __syncthreads();
  float mu = (red[0] + red[1] + red[2] + red[3]) * (1.f / DM);
  float q = 0.f; for (int i = 0; i < 8; ++i) { float d = v[i] - mu; q += d * d; }
  q = wave_sum(q); if ((tid & 63) == 0) red[4 + (tid >> 6)] = q; __syncthreads();
  float var = (red[4] + red[5] + red[6] + red[7]) * (1.f / DM);
  float rs = rsqrtf(var + 1e-5f);
  for (int i = 0; i < 8; ++i) {
    int c = tid + i * 256; float o = (v[i] - mu) * rs * gam[c] + bet[c];
    if (hf) hf[(size_t)t * DM + c] = o;
    if (hb) hb[(size_t)t * DM + c] = f2bf(o);
  }
}

__global__ void __launch_bounds__(256) k_peer_route(const float* __restrict__ qp, const float* __restrict__ subk, int* __restrict__ eid,
                                                    float* __restrict__ gw) {
  __shared__ float q[2048];
  __shared__ float s[16][128];
  __shared__ float ts[16][16];
  __shared__ int ti[16][16];
  __shared__ float cand[8][256];
  __shared__ float bs[8][16];
  __shared__ int bi[8][16];
  const int t = blockIdx.x, tid = threadIdx.x;
  for (int i = tid; i < 2048; i += 256) q[i] = qp[(size_t)t * 2048 + i];
  __syncthreads();
  for (int idx = tid; idx < 2048; idx += 256) {
    int hc = idx >> 7, key = idx & 127;
    const float* kr = subk + ((size_t)hc * 128 + key) * 128;
    const float* qq = q + hc * 128;
    float a = 0.f;
    for (int d = 0; d < 128; ++d) a += qq[d] * kr[d];
    s[hc][key] = a;
  }
  __syncthreads();
  for (int idx = tid; idx < 2048; idx += 256) {
    int hc = idx >> 7, key = idx & 127;
    float my = s[hc][key]; int rank = 0;
    for (int i = 0; i < 128; ++i) { float o = s[hc][i]; rank += (o > my || (o == my && i < key)) ? 1 : 0; }
    if (rank < 16) { ts[hc][rank] = my; ti[hc][rank] = key; }
  }
  __syncthreads();
  for (int idx = tid; idx < 2048; idx += 256) {
    int h = idx >> 8, c = idx & 255;
    cand[h][c] = ts[h * 2][c >> 4] + ts[h * 2 + 1][c & 15];
  }
  __syncthreads();
  for (int idx = tid; idx < 2048; idx += 256) {
    int h = idx >> 8, c = idx & 255;
    float my = cand[h][c]; int rank = 0;
    for (int i = 0; i < 256; ++i) { float o = cand[h][i]; rank += (o > my || (o == my && i < c)) ? 1 : 0; }
    if (rank < 16) { bs[h][rank] = my; bi[h][rank] = c; }
  }
  __syncthreads();
  if (tid < 128) {
    int h = tid >> 4, k = tid & 15;
    float mx = bs[h][0];
    float sum = 0.f;
    for (int i = 0; i < 16; ++i) sum += __expf(bs[h][i] - mx);
    float gv = __expf(bs[h][k] - mx) / sum;
    int c = bi[h][k];
    int i1 = ti[h * 2][c >> 4], i2 = ti[h * 2 + 1][c & 15];
    eid[(size_t)t * 128 + tid] = i1 * 128 + i2;
    gw[(size_t)t * 128 + tid] = gv;
  }
}

__global__ void __launch_bounds__(256) k_peer_exp(const float* __restrict__ hf, const int* __restrict__ eid, const float* __restrict__ gw,
                                                  const float* __restrict__ eu, const float* __restrict__ ev, const float* __restrict__ gam,
                                                  const float* __restrict__ bet, float* __restrict__ out) {
  __shared__ float hs[2048];
  __shared__ float coef[128];
  __shared__ float red[8];
  const int t = blockIdx.x, tid = threadIdx.x, lane = tid & 63, w = tid >> 6;
  for (int i = tid; i < 2048; i += 256) hs[i] = hf[(size_t)t * 2048 + i];
  __syncthreads();
  for (int e = w; e < 128; e += 4) {
    const float* ur = eu + (size_t)eid[(size_t)t * 128 + e] * 2048;
    float a = 0.f;
    for (int i = lane; i < 2048; i += 64) a += hs[i] * ur[i];
    a = wave_sum(a);
    if (lane == 0) coef[e] = gw[(size_t)t * 128 + e] * gelu_tanh(a);
  }
  __syncthreads();
  float acc[8];
  for (int i = 0; i < 8; ++i) acc[i] = 0.f;
  for (int e = 0; e < 128; ++e) {
    const float* vr = ev + (size_t)eid[(size_t)t * 128 + e] * 2048;
    float c = coef[e];
    for (int i = 0; i < 8; ++i) acc[i] += c * vr[tid + i * 256];
  }
  float v[8]; float s = 0.f;
  for (int i = 0; i < 8; ++i) { v[i] = ALPHA * hs[tid + i * 256] + acc[i]; s += v[i]; }
  s = wave_sum(s); if (lane == 0) red[w] = s; __syncthreads();
  float mu = (red[0] + red[1] + red[2] + red[3]) * (1.f / DM);
  float q = 0.f; for (int i = 0; i < 8; ++i) { float d = v[i] - mu; q += d * d; }
  q = wave_sum(q); if (lane == 0) red[4 + w] = q; __syncthreads();
  float var = (red[4] + red[5] + red[6] + red[7]) * (1.f / DM);
  float rs = rsqrtf(var + 1e-5f);
  for (int i = 0; i < 8; ++i) { int c = tid + i * 256; out[(size_t)t * DM + c] = (v[i] - mu) * rs * gam[c] + bet[c]; }
}

extern "C" void kernel_launch(void* const* d_in, const int* in_sizes, int n_in, void* d_out, int out_size, void* d_ws, size_t ws_size,
                              hipStream_t stream) {
  const float* x = (const float*)d_in[0];
  const float* w_in = (const float*)d_in[1];
  const float* ck_pos = (const float*)d_in[2];
  const float* ck_w1 = (const float*)d_in[3];
  const float* ck_b1 = (const float*)d_in[4];
  const float* ck_w2 = (const float*)d_in[5];
  const float* cv_pos = (const float*)d_in[6];
  const float* cv_w1 = (const float*)d_in[7];
  const float* cv_b1 = (const float*)d_in[8];
  const float* cv_w2 = (const float*)d_in[9];
  const float* conv_w = (const float*)d_in[10];
  const float* hng = (const float*)d_in[11];
  const float* w_out = (const float*)d_in[12];
  const float* ln1g = (const float*)d_in[13];
  const float* ln1b = (const float*)d_in[14];
  const float* w_query = (const float*)d_in[15];
  const float* subk = (const float*)d_in[16];
  const float* eu = (const float*)d_in[17];
  const float* ev = (const float*)d_in[18];
  const float* ln2g = (const float*)d_in[19];
  const float* ln2b = (const float*)d_in[20];
  float* out = (float*)d_out;

  char* ws = (char*)d_ws;
  size_t off = 0;
  auto alloc = [&](size_t bytes) { char* p = ws + off; off += (bytes + 255) & ~(size_t)255; return p; };
  bf16_t* xb = (bf16_t*)alloc((size_t)S * DM * 2);
  bf16_t* winT = (bf16_t*)alloc((size_t)INWP * DM * 2);
  bf16_t* proj = (bf16_t*)alloc((size_t)S * INWP * 2);
  float* gates = (float*)alloc((size_t)S * 24 * 4);
  bf16_t* w1kT = (bf16_t*)alloc((size_t)512 * 4096 * 2);
  bf16_t* w1vT = (bf16_t*)alloc((size_t)512 * 4096 * 2);
  bf16_t* acmp = (bf16_t*)alloc((size_t)2048 * 4096 * 2);
  float* hid = (float*)alloc((size_t)2048 * 512 * 4);
  float* kc = (float*)alloc((size_t)2048 * 128 * 4);
  float* vc = (float*)alloc((size_t)2048 * 128 * 4);
  float* oatt = (float*)alloc((size_t)S * 1024 * 4);
  bf16_t* mix = (bf16_t*)alloc((size_t)S * DM * 2);
  bf16_t* woutT = (bf16_t*)alloc((size_t)DM * DM * 2);
  bf16_t* wqT = (bf16_t*)alloc((size_t)DM * DM * 2);
  int* eid = (int*)alloc((size_t)S * 128 * 4);
  float* gw = (float*)alloc((size_t)S * 128 * 4);
  float* y = (float*)proj;
  bf16_t* hb = xb;
  float* hf = y;

  k_cvt<<<2048, 256, 0, stream>>>(x, xb, (size_t)S * DM);
  k_cvtT<<<dim3(INWP / 32, DM / 32), 256, 0, stream>>>(w_in, winT, DM, INW, INWP);
  k_cvtT<<<dim3(512 / 32, 4096 / 32), 256, 0, stream>>>(ck_w1, w1kT, 4096, 512, 512);
  k_cvtT<<<dim3(512 / 32, 4096 / 32), 256, 0, stream>>>(cv_w1, w1vT, 4096, 512, 512);
  k_cvtT<<<dim3(DM / 32, DM / 32), 256, 0, stream>>>(w_out, woutT, DM, DM, DM);
  k_cvtT<<<dim3(DM / 32, DM / 32), 256, 0, stream>>>(w_query, wqT, DM, DM, DM);
  k_gemm<EpiProjF><<<(S / 128) * (INWP / 128), 256, 0, stream>>>(xb, DM, winT, DM, DM, S / 128, EpiProjF{proj, gates});
  k_build_cmp<<<2048, 256, 0, stream>>>(proj, OFF_KC, ck_pos, acmp);
  k_gemm<EpiF32F><<<(2048 / 128) * (512 / 128), 256, 0, stream>>>(acmp, 4096, w1kT, 4096, 4096, 2048 / 128, EpiF32F{hid, 512, 512});
  k_cmp2<<<2046, 128, 0, stream>>>(hid, ck_b1, ck_w2, kc);
  k_build_cmp<<<2048, 256, 0, stream>>>(proj, OFF_VC, cv_pos, acmp);
  k_gemm<EpiF32F><<<(2048 / 128) * (512 / 128), 256, 0, stream>>>(acmp, 4096, w1vT, 4096, 4096, 2048 / 128, EpiF32F{hid, 512, 512});
  k_cmp2<<<2046, 128, 0, stream>>>(hid, cv_b1, cv_w2, vc);
  k_nsa<<<S * 2, 256, 0, stream>>>(proj, gates, kc, vc, oatt);
  k_mix<<<S, 256, 0, stream>>>(proj, oatt, conv_w, hng, mix);
  k_gemm<EpiResF><<<(S / 128) * (DM / 128), 256, 0, stream>>>(mix, DM, woutT, DM, DM, S / 128, EpiResF{y, x});
  k_ln<<<S, 256, 0, stream>>>(y, ln1g, ln1b, hf, hb);
  float* qpf = (float*)oatt;
  k_gemm<EpiF32F><<<(S / 128) * (DM / 128), 256, 0, stream>>>(hb, DM, wqT, DM, DM, S / 128, EpiF32F{qpf, DM, DM});
  k_peer_route<<<S, 256, 0, stream>>>(qpf, subk, eid, gw);
  k_peer_exp<<<S, 256, 0, stream>>>(hf, eid, gw, eu, ev, ln2g, ln2b, out);
}
```

```cpp
#include <hip/hip_runtime.h>
#include <hip/hip_cooperative_groups.h>
#include <stdint.h>
#include <stdio.h>
namespace cg = cooperative_groups;

#define DI __device__ __forceinline__
typedef unsigned short bf16_t;
using bf16x8 = __attribute__((ext_vector_type(8))) short;
using f32x4 = __attribute__((ext_vector_type(4))) float;
using u32x4 = __attribute__((ext_vector_type(4))) unsigned;

constexpr int S = 16384, DM = 2048, HD = 128;
constexpr int INW = 5656, INWP = 5760;
constexpr int OFF_Q = 0, OFF_KC = 1024, OFF_VC = 1280, OFF_KS = 1536, OFF_VS = 1792, OFF_KW = 2048, OFF_VW = 2304,
              OFF_G = 2560, OFF_U = 2584, OFF_B = 3608, OFF_C = 4632;
constexpr int NCMP = 1023;
constexpr float ALPHA = 1.189207115002721f;
constexpr float QSCALE = 0.08838834764831845f;

DI bf16_t f2bf(float x) { unsigned u = __float_as_uint(x); u += 0x7fffu + ((u >> 16) & 1u); return (bf16_t)(u >> 16); }
DI float bf2f(bf16_t b) { return __uint_as_float(((unsigned)b) << 16); }
DI float gelu_tanh(float x) { float u = 0.7978845608028654f * (x + 0.044715f * x * x * x); return 0.5f * x * (1.f + tanhf(u)); }
DI float wave_sum(float v) { for (int o = 32; o > 0; o >>= 1) v += __shfl_xor(v, o); return v; }
DI float wave_max(float v) { for (int o = 32; o > 0; o >>= 1) v = fmaxf(v, __shfl_xor(v, o)); return v; }

__device__ void d_cvt(const float* __restrict__ in, bf16_t* __restrict__ out, size_t n4) {
  size_t i = (size_t)blockIdx.x * blockDim.x + threadIdx.x;
  size_t stride = (size_t)gridDim.x * blockDim.x;
  for (; i < n4; i += stride) { float4 v = ((const float4*)in)[i]; ushort4 o; o.x = f2bf(v.x); o.y = f2bf(v.y); o.z = f2bf(v.z); o.w = f2bf(v.w); ((ushort4*)out)[i] = o; }
}
__device__ void d_cvtT(int vb, char* smem, const float* __restrict__ W, bf16_t* __restrict__ WT, int K, int N, int NP) {
  float (*t)[33] = (float (*)[33])smem;
  int nbx = NP / 32;
  int n0 = (vb % nbx) * 32, k0 = (vb / nbx) * 32;
  int tx = threadIdx.x & 31, ty = threadIdx.x >> 5;
  for (int i = ty; i < 32; i += 8) { int k = k0 + i, n = n0 + tx; t[i][tx] = (n < N && k < K) ? W[(size_t)k * N + n] : 0.f; }
  __syncthreads();
  for (int i = ty; i < 32; i += 8) { int n = n0 + i, k = k0 + tx; if (n < NP && k < K) WT[(size_t)n * K + k] = f2bf(t[tx][i]); }
  __syncthreads();
}

constexpr int LDS_LD = 72;
struct EpiProj { bf16_t* proj; float* gates; };
struct EpiF32 { float* C; int ldc; int N; };
struct EpiRes { float* C; const float* X; };

template <class Epi>
__device__ void d_gemm(int vb, char* smem, const bf16_t* __restrict__ A, int lda, const bf16_t* __restrict__ BT, int ldb, int K,
                       int tilesM, Epi epi) {
  bf16_t* As = (bf16_t*)smem;
  bf16_t* Bs = As + 128 * LDS_LD;
  const int tid = threadIdx.x, lane = tid & 63, wid = tid >> 6;
  const int wm = wid >> 1, wn = wid & 1;
  const int tm = vb % tilesM, tn = vb / tilesM;
  const int m0 = tm * 128, n0 = tn * 128;
  f32x4 acc[4][4];
#pragma unroll
  for (int i = 0; i < 4; ++i)
#pragma unroll
    for (int j = 0; j < 4; ++j) acc[i][j] = f32x4{0.f, 0.f, 0.f, 0.f};
  u32x4 ra[4], rb[4];
#define GLOAD(k0_)                                                                  \
  _Pragma("unroll") for (int i = 0; i < 4; ++i) {                                   \
    int c = tid + i * 256; int row = c >> 3, kc = c & 7;                            \
    ra[i] = *(const u32x4*)(A + (size_t)(m0 + row) * lda + (k0_) + kc * 8);         \
    rb[i] = *(const u32x4*)(BT + (size_t)(n0 + row) * ldb + (k0_) + kc * 8);        \
  }
  GLOAD(0)
  for (int k0 = 0; k0 < K; k0 += 64) {
    __syncthreads();
#pragma unroll
    for (int i = 0; i < 4; ++i) {
      int c = tid + i * 256; int row = c >> 3, kc = c & 7;
      *(u32x4*)(As + row * LDS_LD + kc * 8) = ra[i];
      *(u32x4*)(Bs + row * LDS_LD + kc * 8) = rb[i];
    }
    __syncthreads();
    if (k0 + 64 < K) { GLOAD(k0 + 64) }
#pragma unroll
    for (int ks = 0; ks < 2; ++ks) {
      bf16x8 a[4], b[4];
#pragma unroll
      for (int i = 0; i < 4; ++i) {
        a[i] = *(const bf16x8*)(As + (wm * 64 + i * 16 + (lane & 15)) * LDS_LD + ks * 32 + (lane >> 4) * 8);
        b[i] = *(const bf16x8*)(Bs + (wn * 64 + i * 16 + (lane & 15)) * LDS_LD + ks * 32 + (lane >> 4) * 8);
      }
#pragma unroll
      for (int i = 0; i < 4; ++i)
#pragma unroll
        for (int j = 0; j < 4; ++j) acc[i][j] = __builtin_amdgcn_mfma_f32_16x16x32_bf16(a[i], b[j], acc[i][j], 0, 0, 0);
    }
  }
#pragma unroll
  for (int i = 0; i < 4; ++i)
#pragma unroll
    for (int j = 0; j < 4; ++j)
#pragma unroll
      for (int r = 0; r < 4; ++r) {
        int row = m0 + wm * 64 + i * 16 + (lane >> 4) * 4 + r;
        int col = n0 + wn * 64 + j * 16 + (lane & 15);
        epi(row, col, acc[i][j][r]);
      }
  __syncthreads();
}
struct EpiProjF {
  bf16_t* proj; float* gates;
  DI void operator()(int row, int col, float v) const {
    if (col < INW) proj[(size_t)row * INWP + col] = f2bf(v);
    if (col >= OFF_G && col < OFF_G + 24) gates[row * 24 + (col - OFF_G)] = 1.f / (1.f + __expf(-v));
  }
};
struct EpiF32F {
  float* C; int ldc; int N;
  DI void operator()(int row, int col, float v) const { if (col < N) C[(size_t)row * ldc + col] = v; }
};
struct EpiResF {
  float* C; const float* X;
  DI void operator()(int row, int col, float v) const { C[(size_t)row * DM + col] = ALPHA * X[(size_t)row * DM + col] + v; }
};

__device__ void d_build_cmp(int row, const bf16_t* __restrict__ proj, int off, const float* __restrict__ pos, bf16_t* __restrict__ Ac) {
  int n = row >> 1, g = row & 1;
  for (int k = threadIdx.x; k < 4096; k += blockDim.x) {
    float v = 0.f;
    if (row < 2046) { int l = k >> 7, d = k & 127; v = bf2f(proj[(size_t)(16 * n + l) * INWP + off + g * 128 + d]) + pos[l * 128 + d]; }
    Ac[(size_t)row * 4096 + k] = f2bf(v);
  }
}
__device__ void d_cmp2(int row, char* smem, const float* __restrict__ hid, const float* __restrict__ b1, const float* __restrict__ w2, float* __restrict__ out) {
  float* a = (float*)smem;
  for (int j = threadIdx.x; j < 512; j += blockDim.x) a[j] = gelu_tanh(hid[(size_t)row * 512 + j] + b1[j]);
  __syncthreads();
  int d = threadIdx.x & 127, half = threadIdx.x >> 7;
  float s = 0.f;
  for (int j = half * 256; j < half * 256 + 256; ++j) s += a[j] * w2[j * 128 + d];
  float* red = a + 512;
  if (half) red[d] = s;
  __syncthreads();
  if (!half) out[(size_t)row * 128 + d] = s + red[d];
  __syncthreads();
}

__device__ void d_nsa(int vb, char* smem, const bf16_t* __restrict__ proj, const float* __restrict__ gates,
                      const float* __restrict__ kc, const float* __restrict__ vc, float* __restrict__ oatt) {
  float (*qs)[128] = (float (*)[128])smem;
  float (*sc)[1024] = (float (*)[1024])(smem + 2048);
  float* imp = (float*)(smem + 2048 + 16384);
  float* score = imp + 256;
  int* sel = (int*)(score + 256);
  const int t = vb >> 1, g = vb & 1;
  const int tid = threadIdx.x, lane = tid & 63, r = tid >> 6;
  const int hd = g * 4 + r;
  const float slope = exp2f(-(float)(hd + 1));
  const bf16_t* prow = proj + (size_t)t * INWP;
  for (int d = lane; d < 128; d += 64) qs[r][d] = bf2f(prow[OFF_Q + hd * 128 + d]) * QSCALE;
  __syncthreads();
  float ocmp0 = 0.f, ocmp1 = 0.f;
  int nv = (t >= 31) ? ((t - 31) / 16 + 1) : 0; if (nv > NCMP) nv = NCMP;
  {
    float mx = -3e38f;
    for (int n = lane; n < nv; n += 64) {
      const float* kr = kc + ((size_t)n * 2 + g) * 128;
      float s = 0.f;
      for (int d = 0; d < 128; ++d) s += qs[r][d] * kr[d];
      s -= slope * ((float)t - ((float)n * 16.f + 15.5f));
      sc[r][n] = s; mx = fmaxf(mx, s);
    }
    mx = wave_max(mx);
    float sum = 0.f;
    for (int n = lane; n < nv; n += 64) { float e = __expf(sc[r][n] - mx); sc[r][n] = e; sum += e; }
    sum = wave_sum(sum);
    float inv = nv > 0 ? 1.f / sum : 0.f;
    for (int n = lane; n < 1024; n += 64) sc[r][n] = (n < nv) ? sc[r][n] * inv : 0.f;
    __syncthreads();
    for (int n = 0; n < nv; ++n) {
      float p = sc[r][n];
      const float* vr = vc + ((size_t)n * 2 + g) * 128;
      ocmp0 += p * vr[lane * 2]; ocmp1 += p * vr[lane * 2 + 1];
    }
  }
  {
    int j = tid;
    float s = 0.f;
    for (int rr = 0; rr < 4; ++rr)
      for (int n = 4 * j - 1; n <= 4 * j + 3; ++n)
        if (n >= 0 && n < NCMP) s += sc[rr][n];
    imp[j] = s;
    int cur = t >> 6;
    bool valid = j <= cur;
    bool forced = (j == 0) || (j == cur) || (j == cur - 1);
    score[j] = valid ? (s + (forced ? 1e4f : 0.f)) : -1.f;
  }
  __syncthreads();
  {
    int j = tid; float my = score[j]; int rank = 0;
    for (int i = 0; i < 256; ++i) { float o = score[i]; rank += (o > my || (o == my && i < j)) ? 1 : 0; }
    if (rank < 16) sel[rank] = j;
  }
  __syncthreads();
  float oslc0 = 0.f, oslc1 = 0.f;
  {
    float mx = -3e38f;
    for (int i = 0; i < 16; ++i) {
      int pos = sel[i] * 64 + lane;
      float s = -3e38f;
      if (pos <= t) {
        const bf16_t* kr = proj + (size_t)pos * INWP + OFF_KS + g * 128;
        float a = 0.f;
        for (int d = 0; d < 128; ++d) a += qs[r][d] * bf2f(kr[d]);
        s = a - slope * (float)(t - pos);
      }
      sc[r][i * 64 + lane] = s; mx = fmaxf(mx, s);
    }
    mx = wave_max(mx);
    float sum = 0.f;
    for (int i = 0; i < 16; ++i) { float s = sc[r][i * 64 + lane]; float e = (s > -1e38f) ? __expf(s - mx) : 0.f; sc[r][i * 64 + lane] = e; sum += e; }
    sum = wave_sum(sum);
    float inv = 1.f / sum;
    __syncthreads();
    for (int i = 0; i < 16; ++i) {
      int b0 = sel[i] * 64;
      for (int kk = 0; kk < 64; ++kk) {
        int pos = b0 + kk; if (pos > t) break;
        float p = sc[r][i * 64 + kk];
        const bf16_t* vr = proj + (size_t)pos * INWP + OFF_VS + g * 128;
        oslc0 += p * bf2f(vr[lane * 2]); oslc1 += p * bf2f(vr[lane * 2 + 1]);
      }
    }
    oslc0 *= inv; oslc1 *= inv;
  }
  __syncthreads();
  float owin0 = 0.f, owin1 = 0.f;
  {
    int p0 = t - 511; if (p0 < 0) p0 = 0;
    int nk = t - p0 + 1;
    float mx = -3e38f;
    for (int i = lane; i < nk; i += 64) {
      int pos = p0 + i;
      const bf16_t* kr = proj + (size_t)pos * INWP + OFF_KW + g * 128;
      float a = 0.f;
      for (int d = 0; d < 128; ++d) a += qs[r][d] * bf2f(kr[d]);
      float s = a - slope * (float)(t - pos);
      sc[r][i] = s; mx = fmaxf(mx, s);
    }
    mx = wave_max(mx);
    float sum = 0.f;
    for (int i = lane; i < nk; i += 64) { float e = __expf(sc[r][i] - mx); sc[r][i] = e; sum += e; }
    sum = wave_sum(sum);
    float inv = 1.f / sum;
    __syncthreads();
    for (int i = 0; i < nk; ++i) {
      float p = sc[r][i];
      const bf16_t* vr = proj + (size_t)(p0 + i) * INWP + OFF_VW + g * 128;
      owin0 += p * bf2f(vr[lane * 2]); owin1 += p * bf2f(vr[lane * 2 + 1]);
    }
    owin0 *= inv; owin1 *= inv;
  }
  const float* gt = gates + (size_t)t * 24 + hd * 3;
  float g0 = gt[0], g1 = gt[1], g2 = gt[2];
  float* o = oatt + (size_t)t * 1024 + hd * 128 + lane * 2;
  o[0] = g0 * ocmp0 + g1 * oslc0 + g2 * owin0;
  o[1] = g0 * ocmp1 + g1 * oslc1 + g2 * owin1;
  __syncthreads();
}

__device__ void d_mix(int t, const bf16_t* __restrict__ proj, const float* __restrict__ oatt, const float* __restrict__ convw,
                      const float* __restrict__ hng, bf16_t* __restrict__ mix) {
  const int tid = threadIdx.x;
  float v[8];
  const int c0 = tid * 8;
  if (c0 < 1024) {
    for (int i = 0; i < 8; ++i) v[i] = oatt[(size_t)t * 1024 + c0 + i];
  } else {
    int c = c0 - 1024;
    for (int i = 0; i < 8; ++i) {
      float acc = 0.f;
      for (int j = 0; j < 3; ++j) {
        int tt = t - 2 + j;
        if (tt >= 0) {
          const bf16_t* pr = proj + (size_t)tt * INWP;
          acc += convw[j * 1024 + c + i] * bf2f(pr[OFF_C + c + i]) * bf2f(pr[OFF_U + c + i]);
        }
      }
      v[i] = acc * bf2f(proj[(size_t)t * INWP + OFF_B + c + i]);
    }
  }
  float ss = 0.f;
  for (int i = 0; i < 8; ++i) ss += v[i] * v[i];
  for (int o = 8; o > 0; o >>= 1) ss += __shfl_xor(ss, o);
  float rs = rsqrtf(ss * (1.f / 128.f) + 1e-6f);
  for (int i = 0; i < 8; ++i) mix[(size_t)t * DM + c0 + i] = f2bf(v[i] * rs * hng[c0 + i]);
}

__device__ void d_ln(int t, char* smem, const float* __restrict__ y, const float* __restrict__ gam, const float* __restrict__ bet,
                     float* __restrict__ hf, bf16_t* __restrict__ hb) {
  float* red = (float*)smem;
  const int tid = threadIdx.x;
  float v[8]; float s = 0.f;
  for (int i = 0; i < 8; ++i) { v[i] = y[(size_t)t * DM + tid + i * 256]; s += v[i]; }
  s = wave_sum(s); if ((tid & 63) == 0) red[tid >> 6] = s; __syncthreads();
  float mu = (red[0] + red[1] + red[2] + red[3]) * (1.f / DM);
  float q = 0.f; for (int i = 0; i < 8; ++i) { float d = v[i] - mu; q += d * d; }
  q = wave_sum(q); if ((tid & 63) == 0) red[4 + (tid >> 6)] = q; __syncthreads();
  float var = (red[4] + red[5] + red[6] + red[7]) * (1.f / DM);
  float rs = rsqrtf(var + 1e-5f);
  for (int i = 0; i < 8; ++i) {
    int c = tid + i * 256; float o = (v[i] - mu) * rs * gam[c] + bet[c];
    if (hf) hf[(size_t)t * DM + c] = o;
    if (hb) hb[(size_t)t * DM + c] = f2bf(o);
  }
  __syncthreads();
}

__device__ void d_peer_route(int t, char* smem, const float* __restrict__ qp, const float* __restrict__ subk, int* __restrict__ eid,
                             float* __restrict__ gw) {
  float* q = (float*)smem;
  float (*s)[128] = (float (*)[128])(smem + 8192);
  float (*ts)[16] = (float (*)[16])(smem + 16384);
  int (*ti)[16] = (int (*)[16])(smem + 17408);
  float (*cand)[256] = (float (*)[256])(smem + 18432);
  float (*bs)[16] = (float (*)[16])(smem + 26624);
  int (*bi)[16] = (int (*)[16])(smem + 27136);
  const int tid = threadIdx.x;
  for (int i = tid; i < 2048; i += 256) q[i] = qp[(size_t)t * 2048 + i];
  __syncthreads();
  for (int idx = tid; idx < 2048; idx += 256) {
    int hc = idx >> 7, key = idx & 127;
    const float* kr = subk + ((size_t)hc * 128 + key) * 128;
    const float* qq = q + hc * 128;
    float a = 0.f;
    for (int d = 0; d < 128; ++d) a += qq[d] * kr[d];
    s[hc][key] = a;
  }
  __syncthreads();
  for (int idx = tid; idx < 2048; idx += 256) {
    int hc = idx >> 7, key = idx & 127;
    float my = s[hc][key]; int rank = 0;
    for (int i = 0; i < 128; ++i) { float o = s[hc][i]; rank += (o > my || (o == my && i < key)) ? 1 : 0; }
    if (rank < 16) { ts[hc][rank] = my; ti[hc][rank] = key; }
  }
  __syncthreads();
  for (int idx = tid; idx < 2048; idx += 256) {
    int h = idx >> 8, c = idx & 255;
    cand[h][c] = ts[h * 2][c >> 4] + ts[h * 2 + 1][c & 15];
  }
  __syncthreads();
  for (int idx = tid; idx < 2048; idx += 256) {
    int h = idx >> 8, c = idx & 255;
    float my = cand[h][c]; int rank = 0;
    for (int i = 0; i < 256; ++i) { float o = cand[h][i]; rank += (o > my || (o == my && i < c)) ? 1 : 0; }
    if (rank < 16) { bs[h][rank] = my; bi[h][rank] = c; }
  }
  __syncthreads();
  if (tid < 128) {
    int h = tid >> 4, k = tid & 15;
    float mx = bs[h][0];
    float sum = 0.f;
    for (int i = 0; i < 16; ++i) sum += __expf(bs[h][i] - mx);
    float gv = __expf(bs[h][k] - mx) / sum;
    int c = bi[h][k];
    int i1 = ti[h * 2][c >> 4], i2 = ti[h * 2 + 1][c & 15];
    eid[(size_t)t * 128 + tid] = i1 * 128 + i2;
    gw[(size_t)t * 128 + tid] = gv;
  }
  __syncthreads();
}

__device__ void d_peer_exp(int t, char* smem, const float* __restrict__ hf, const int* __restrict__ eid, const float* __restrict__ gw,
                           const float* __restrict__ eu, const float* __restrict__ ev, const float* __restrict__ gam,
                           const float* __restrict__ bet, float* __restrict__ out) {
  float* hs = (float*)smem;
  float* coef = hs + 2048;
  float* red = coef + 128;
  const int tid = threadIdx.x, lane = tid & 63, w = tid >> 6;
  for (int i = tid; i < 2048; i += 256) hs[i] = hf[(size_t)t * 2048 + i];
  __syncthreads();
  for (int e = w; e < 128; e += 4) {
    const float* ur = eu + (size_t)eid[(size_t)t * 128 + e] * 2048;
    float a = 0.f;
    for (int i = lane; i < 2048; i += 64) a += hs[i] * ur[i];
    a = wave_sum(a);
    if (lane == 0) coef[e] = gw[(size_t)t * 128 + e] * gelu_tanh(a);
  }
  __syncthreads();
  float acc[8];
  for (int i = 0; i < 8; ++i) acc[i] = 0.f;
  for (int e = 0; e < 128; ++e) {
    const float* vr = ev + (size_t)eid[(size_t)t * 128 + e] * 2048;
    float c = coef[e];
    for (int i = 0; i < 8; ++i) acc[i] += c * vr[tid + i * 256];
  }
  float v[8]; float s = 0.f;
  for (int i = 0; i < 8; ++i) { v[i] = ALPHA * hs[tid + i * 256] + acc[i]; s += v[i]; }
  s = wave_sum(s); if (lane == 0) red[w] = s; __syncthreads();
  float mu = (red[0] + red[1] + red[2] + red[3]) * (1.f / DM);
  float q = 0.f; for (int i = 0; i < 8; ++i) { float d = v[i] - mu; q += d * d; }
  q = wave_sum(q); if (lane == 0) red[4 + w] = q; __syncthreads();
  float var = (red[4] + red[5] + red[6] + red[7]) * (1.f / DM);
  float rs = rsqrtf(var + 1e-5f);
  for (int i = 0; i < 8; ++i) { int c = tid + i * 256; out[(size_t)t * DM + c] = (v[i] - mu) * rs * gam[c] + bet[c]; }
  __syncthreads();
}

struct Params {
  const float *x, *w_in, *ck_pos, *ck_w1, *ck_b1, *ck_w2, *cv_pos, *cv_w1, *cv_b1, *cv_w2, *conv_w, *hng, *w_out, *ln1g, *ln1b, *w_query, *subk,
      *eu, *ev, *ln2g, *ln2b;
  float* out;
  bf16_t *xb, *winT, *proj, *w1kT, *w1vT, *acmpK, *acmpV, *mix, *woutT, *wqT, *hb;
  float *gates, *hidK, *hidV, *kc, *vc, *oatt, *y, *qpf, *gw;
  int* eid;
};

#define FOR_VB(n) for (int vb = blockIdx.x; vb < (n); vb += gridDim.x)

__global__ void __launch_bounds__(256) mega(Params p) {
  cg::grid_group grid = cg::this_grid();
  __shared__ __attribute__((aligned(16))) char smem[36864];
  d_cvt(p.x, p.xb, (size_t)S * DM / 4);
  FOR_VB((INWP / 32) * (DM / 32)) d_cvtT(vb, smem, p.w_in, p.winT, DM, INW, INWP);
  FOR_VB((512 / 32) * (4096 / 32)) d_cvtT(vb, smem, p.ck_w1, p.w1kT, 4096, 512, 512);
  FOR_VB((512 / 32) * (4096 / 32)) d_cvtT(vb, smem, p.cv_w1, p.w1vT, 4096, 512, 512);
  FOR_VB((DM / 32) * (DM / 32)) d_cvtT(vb, smem, p.w_out, p.woutT, DM, DM, DM);
  FOR_VB((DM / 32) * (DM / 32)) d_cvtT(vb, smem, p.w_query, p.wqT, DM, DM, DM);
  grid.sync();
  FOR_VB((S / 128) * (INWP / 128)) d_gemm(vb, smem, p.xb, DM, p.winT, DM, DM, S / 128, EpiProjF{p.proj, p.gates});
  grid.sync();
  FOR_VB(4096) { if (vb < 2048) d_build_cmp(vb, p.proj, OFF_KC, p.ck_pos, p.acmpK); else d_build_cmp(vb - 2048, p.proj, OFF_VC, p.cv_pos, p.acmpV); }
  grid.sync();
  FOR_VB(128) {
    if (vb < 64) d_gemm(vb, smem, p.acmpK, 4096, p.w1kT, 4096, 4096, 16, EpiF32F{p.hidK, 512, 512});
    else d_gemm(vb - 64, smem, p.acmpV, 4096, p.w1vT, 4096, 4096, 16, EpiF32F{p.hidV, 512, 512});
  }
  grid.sync();
  FOR_VB(4092) { if (vb < 2046) d_cmp2(vb, smem, p.hidK, p.ck_b1, p.ck_w2, p.kc); else d_cmp2(vb - 2046, smem, p.hidV, p.cv_b1, p.cv_w2, p.vc); }
  grid.sync();
  FOR_VB(S * 2) d_nsa(vb, smem, p.proj, p.gates, p.kc, p.vc, p.oatt);
  grid.sync();
  FOR_VB(S) d_mix(vb, p.proj, p.oatt, p.conv_w, p.hng, p.mix);
  grid.sync();
  FOR_VB((S / 128) * (DM / 128)) d_gemm(vb, smem, p.mix, DM, p.woutT, DM, DM, S / 128, EpiResF{p.y, p.x});
  grid.sync();
  FOR_VB(S) d_ln(vb, smem, p.y, p.ln1g, p.ln1b, p.y, p.hb);
  grid.sync();
  FOR_VB((S / 128) * (DM / 128)) d_gemm(vb, smem, p.hb, DM, p.wqT, DM, DM, S / 128, EpiF32F{p.qpf, DM, DM});
  grid.sync();
  FOR_VB(S) d_peer_route(vb, smem, p.qpf, p.subk, p.eid, p.gw);
  grid.sync();
  FOR_VB(S) d_peer_exp(vb, smem, p.y, p.eid, p.gw, p.eu, p.ev, p.ln2g, p.ln2b, p.out);
}

extern "C" void kernel_launch(void* const* d_in, const int* in_sizes, int n_in, void* d_out, int out_size, void* d_ws, size_t ws_size,
                              hipStream_t stream) {
  Params p{};
  p.x = (const float*)d_in[0]; p.w_in = (const float*)d_in[1]; p.ck_pos = (const float*)d_in[2]; p.ck_w1 = (const float*)d_in[3];
  p.ck_b1 = (const float*)d_in[4]; p.ck_w2 = (const float*)d_in[5]; p.cv_pos = (const float*)d_in[6]; p.cv_w1 = (const float*)d_in[7];
  p.cv_b1 = (const float*)d_in[8]; p.cv_w2 = (const float*)d_in[9]; p.conv_w = (const float*)d_in[10]; p.hng = (const float*)d_in[11];
  p.w_out = (const float*)d_in[12]; p.ln1g = (const float*)d_in[13]; p.ln1b = (const float*)d_in[14]; p.w_query = (const float*)d_in[15];
  p.subk = (const float*)d_in[16]; p.eu = (const float*)d_in[17]; p.ev = (const float*)d_in[18]; p.ln2g = (const float*)d_in[19];
  p.ln2b = (const float*)d_in[20];
  p.out = (float*)d_out;
  char* ws = (char*)d_ws;
  size_t off = 0;
  auto alloc = [&](size_t bytes) { char* q = ws + off; off += (bytes + 255) & ~(size_t)255; return q; };
  p.xb = (bf16_t*)alloc((size_t)S * DM * 2);
  p.winT = (bf16_t*)alloc((size_t)INWP * DM * 2);
  p.proj = (bf16_t*)alloc((size_t)S * INWP * 2);
  p.gates = (float*)alloc((size_t)S * 24 * 4);
  p.w1kT = (bf16_t*)alloc((size_t)512 * 4096 * 2);
  p.w1vT = (bf16_t*)alloc((size_t)512 * 4096 * 2);
  p.acmpK = (bf16_t*)alloc((size_t)2048 * 4096 * 2);
  p.acmpV = (bf16_t*)alloc((size_t)2048 * 4096 * 2);
  p.hidK = (float*)alloc((size_t)2048 * 512 * 4);
  p.hidV = (float*)alloc((size_t)2048 * 512 * 4);
  p.kc = (float*)alloc((size_t)2048 * 128 * 4);
  p.vc = (float*)alloc((size_t)2048 * 128 * 4);
  p.oatt = (float*)alloc((size_t)S * 1024 * 4);
  p.mix = (bf16_t*)alloc((size_t)S * DM * 2);
  p.woutT = (bf16_t*)alloc((size_t)DM * DM * 2);
  p.wqT = (bf16_t*)alloc((size_t)DM * DM * 2);
  p.eid = (int*)alloc((size_t)S * 128 * 4);
  p.gw = (float*)alloc((size_t)S * 128 * 4);
  p.y = (float*)p.proj;
  p.hb = p.xb;
  p.qpf = p.oatt;
  static int grid_blocks = 0;
  if (!grid_blocks) {
    int dev = 0, cus = 0, per_cu = 0;
    hipGetDevice(&dev);
    hipDeviceGetAttribute(&cus, hipDeviceAttributeMultiprocessorCount, dev);
    hipOccupancyMaxActiveBlocksPerMultiprocessor(&per_cu, mega, 256, 0);
    if (per_cu > 2) per_cu = 2;
    if (per_cu < 1) per_cu = 1;
    grid_blocks = cus * per_cu;
  }
  void* args[] = {&p};
  hipError_t e = hipLaunchCooperativeKernel((void*)mega, dim3(grid_blocks), dim3(256), args, 0, stream);
  if (e != hipSuccess) fprintf(stderr, "cooperative launch failed: %s (grid %d)\n", hipGetErrorString(e), grid_blocks);
}
```

```cpp
#include <hip/hip_runtime.h>
#include <hip/hip_cooperative_groups.h>
#include <stdint.h>
#include <stdio.h>
namespace cg = cooperative_groups;

#define DI __device__ __forceinline__
typedef unsigned short bf16_t;
using bf16x8 = __attribute__((ext_vector_type(8))) short;
using f32x4 = __attribute__((ext_vector_type(4))) float;
using u32x4 = __attribute__((ext_vector_type(4))) unsigned;

constexpr int S = 16384, DM = 2048, HD = 128;
constexpr int INW = 5656, INWP = 5760;
constexpr int OFF_Q = 0, OFF_KC = 1024, OFF_VC = 1280, OFF_KS = 1536, OFF_VS = 1792, OFF_KW = 2048, OFF_VW = 2304,
              OFF_G = 2560, OFF_U = 2584, OFF_B = 3608, OFF_C = 4632;
constexpr int NCMP = 1023;
constexpr float ALPHA = 1.189207115002721f;
constexpr float QSCALE = 0.08838834764831845f;

DI bf16_t f2bf(float x) { unsigned u = __float_as_uint(x); u += 0x7fffu + ((u >> 16) & 1u); return (bf16_t)(u >> 16); }
DI float bf2f(bf16_t b) { return __uint_as_float(((unsigned)b) << 16); }
DI float gelu_tanh(float x) { float u = 0.7978845608028654f * (x + 0.044715f * x * x * x); return 0.5f * x * (1.f + tanhf(u)); }
DI float wave_sum(float v) { for (int o = 32; o > 0; o >>= 1) v += __shfl_xor(v, o); return v; }
DI float wave_max(float v) { for (int o = 32; o > 0; o >>= 1) v = fmaxf(v, __shfl_xor(v, o)); return v; }

__device__ void d_cvt(const float* __restrict__ in, bf16_t* __restrict__ out, size_t n4) {
  size_t i = (size_t)blockIdx.x * blockDim.x + threadIdx.x;
  size_t stride = (size_t)gridDim.x * blockDim.x;
  for (; i < n4; i += stride) { float4 v = ((const float4*)in)[i]; ushort4 o; o.x = f2bf(v.x); o.y = f2bf(v.y); o.z = f2bf(v.z); o.w = f2bf(v.w); ((ushort4*)out)[i] = o; }
}
__device__ void d_cvtT(int vb, char* smem, const float* __restrict__ W, bf16_t* __restrict__ WT, int K, int N, int NP) {
  float (*t)[33] = (float (*)[33])smem;
  int nbx = NP / 32;
  int n0 = (vb % nbx) * 32, k0 = (vb / nbx) * 32;
  int tx = (threadIdx.x & 255) & 31, ty = (threadIdx.x & 255) >> 5;
  for (int i = ty; i < 32; i += 8) { int k = k0 + i, n = n0 + tx; t[i][tx] = (n < N && k < K) ? W[(size_t)k * N + n] : 0.f; }
  __syncthreads();
  for (int i = ty; i < 32; i += 8) { int n = n0 + i, k = k0 + tx; if (n < NP && k < K) WT[(size_t)n * K + k] = f2bf(t[tx][i]); }
  __syncthreads();
}

constexpr int LDS_LD = 72;
struct EpiProj { bf16_t* proj; float* gates; };
struct EpiF32 { float* C; int ldc; int N; };
struct EpiRes { float* C; const float* X; };

template <class Epi>
__device__ void d_gemm(int vb, char* smem, const bf16_t* __restrict__ A, int lda, const bf16_t* __restrict__ BT, int ldb, int K,
                       int tilesM, Epi epi) {
  bf16_t* As = (bf16_t*)smem;
  bf16_t* Bs = As + 256 * LDS_LD;
  const int tid = threadIdx.x, lane = tid & 63, wid = tid >> 6;
  const int wm = wid >> 1, wn = wid & 1;
  const int tm = vb % tilesM, tn = vb / tilesM;
  const int m0 = tm * 256, n0 = tn * 128;
  f32x4 acc[4][4];
#pragma unroll
  for (int i = 0; i < 4; ++i)
#pragma unroll
    for (int j = 0; j < 4; ++j) acc[i][j] = f32x4{0.f, 0.f, 0.f, 0.f};
  u32x4 ra[4], rb[2];
#define GLOAD(k0_)                                                                  \
  _Pragma("unroll") for (int i = 0; i < 4; ++i) {                                   \
    int c = tid + i * 512; int row = c >> 3, kc = c & 7;                            \
    ra[i] = *(const u32x4*)(A + (size_t)(m0 + row) * lda + (k0_) + kc * 8);         \
  }                                                                                 \
  _Pragma("unroll") for (int i = 0; i < 2; ++i) {                                   \
    int c = tid + i * 512; int row = c >> 3, kc = c & 7;                            \
    rb[i] = *(const u32x4*)(BT + (size_t)(n0 + row) * ldb + (k0_) + kc * 8);        \
  }
  GLOAD(0)
  for (int k0 = 0; k0 < K; k0 += 64) {
    __syncthreads();
#pragma unroll
    for (int i = 0; i < 4; ++i) { int c = tid + i * 512; int row = c >> 3, kc = c & 7; *(u32x4*)(As + row * LDS_LD + kc * 8) = ra[i]; }
#pragma unroll
    for (int i = 0; i < 2; ++i) { int c = tid + i * 512; int row = c >> 3, kc = c & 7; *(u32x4*)(Bs + row * LDS_LD + kc * 8) = rb[i]; }
    __syncthreads();
    if (k0 + 64 < K) { GLOAD(k0 + 64) }
#pragma unroll
    for (int ks = 0; ks < 2; ++ks) {
      bf16x8 a[4], b[4];
#pragma unroll
      for (int i = 0; i < 4; ++i) {
        a[i] = *(const bf16x8*)(As + (wm * 64 + i * 16 + (lane & 15)) * LDS_LD + ks * 32 + (lane >> 4) * 8);
        b[i] = *(const bf16x8*)(Bs + (wn * 64 + i * 16 + (lane & 15)) * LDS_LD + ks * 32 + (lane >> 4) * 8);
      }
#pragma unroll
      for (int i = 0; i < 4; ++i)
#pragma unroll
        for (int j = 0; j < 4; ++j) acc[i][j] = __builtin_amdgcn_mfma_f32_16x16x32_bf16(a[i], b[j], acc[i][j], 0, 0, 0);
    }
  }
#pragma unroll
  for (int i = 0; i < 4; ++i)
#pragma unroll
    for (int j = 0; j < 4; ++j)
#pragma unroll
      for (int r = 0; r < 4; ++r) {
        int row = m0 + wm * 64 + i * 16 + (lane >> 4) * 4 + r;
        int col = n0 + wn * 64 + j * 16 + (lane & 15);
        epi(row, col, acc[i][j][r]);
      }
  __syncthreads();
}
struct EpiProjF {
  bf16_t* proj; float* gates;
  DI void operator()(int row, int col, float v) const {
    if (col < INW) proj[(size_t)row * INWP + col] = f2bf(v);
    if (col >= OFF_G && col < OFF_G + 24) gates[row * 24 + (col - OFF_G)] = 1.f / (1.f + __expf(-v));
  }
};
struct EpiF32F {
  float* C; int ldc; int N;
  DI void operator()(int row, int col, float v) const { if (col < N) C[(size_t)row * ldc + col] = v; }
};
struct EpiResF {
  float* C; const float* X;
  DI void operator()(int row, int col, float v) const { C[(size_t)row * DM + col] = ALPHA * X[(size_t)row * DM + col] + v; }
};

__device__ void d_build_cmp(int row, const bf16_t* __restrict__ proj, int off, const float* __restrict__ pos, bf16_t* __restrict__ Ac) {
  int n = row >> 1, g = row & 1;
  for (int k = (threadIdx.x & 255); k < 4096; k += 256) {
    float v = 0.f;
    if (row < 2046) { int l = k >> 7, d = k & 127; v = bf2f(proj[(size_t)(16 * n + l) * INWP + off + g * 128 + d]) + pos[l * 128 + d]; }
    Ac[(size_t)row * 4096 + k] = f2bf(v);
  }
}
__device__ void d_cmp2(int row, char* smem, const float* __restrict__ hid, const float* __restrict__ b1, const float* __restrict__ w2, float* __restrict__ out) {
  float* a = (float*)smem;
  for (int j = (threadIdx.x & 255); j < 512; j += 256) a[j] = gelu_tanh(hid[(size_t)row * 512 + j] + b1[j]);
  __syncthreads();
  int d = (threadIdx.x & 255) & 127, half = (threadIdx.x & 255) >> 7;
  float s = 0.f;
  for (int j = half * 256; j < half * 256 + 256; ++j) s += a[j] * w2[j * 128 + d];
  float* red = a + 512;
  if (half) red[d] = s;
  __syncthreads();
  if (!half) out[(size_t)row * 128 + d] = s + red[d];
  __syncthreads();
}

using f32x16 = __attribute__((ext_vector_type(16))) float;
using bf16x8v = __attribute__((ext_vector_type(8))) __bf16;
using bf16x2v = __attribute__((ext_vector_type(2))) __bf16;
#define MFMA32(a, b, c) __builtin_amdgcn_mfma_f32_32x32x16_bf16((a), (b), (c), 0, 0, 0)
constexpr float LOG2E = 1.4426950408889634f;
constexpr float NEGB = -1e30f;
DI int pi_perm(int i) { return (i & ~12) | ((i & 8) >> 1) | ((i & 4) << 1); }
DI unsigned pack2(float a, float b) { bf16x2v v = {(__bf16)a, (__bf16)b}; return __builtin_bit_cast(unsigned, v); }
DI bf16x8 pack8(float a0, float a1, float a2, float a3, float a4, float a5, float a6, float a7) {
  bf16x8v v = {(__bf16)a0, (__bf16)a1, (__bf16)a2, (__bf16)a3, (__bf16)a4, (__bf16)a5, (__bf16)a6, (__bf16)a7};
  return __builtin_bit_cast(bf16x8, v);
}
__device__ void d_relayoutK_bf(size_t c, int NT, const bf16_t* __restrict__ src, int ld, int col0, bf16_t* __restrict__ dst) {
  int lane = c & 63, s = (c >> 6) & 7; size_t tt = c >> 9; int T = tt % NT, g = tt / NT;
  int i = lane & 31, h = lane >> 5;
  int tok = 32 * T + pi_perm(i);
  *(u32x4*)(dst + c * 8) = *(const u32x4*)(src + (size_t)tok * ld + col0 + g * 128 + 16 * s + 8 * h);
}
__device__ void d_relayoutV_bf(size_t c, int NT, const bf16_t* __restrict__ src, int ld, int col0, bf16_t* __restrict__ dst) {
  int lane = c & 63, s2 = (c >> 6) & 1, dt = (c >> 7) & 3; size_t tt = c >> 9; int T = tt % NT, g = tt / NT;
  int dd = lane & 31, h = lane >> 5;
  bf16_t v[8];
#pragma unroll
  for (int j = 0; j < 8; ++j) v[j] = src[(size_t)(32 * T + 16 * s2 + 8 * h + j) * ld + col0 + g * 128 + 32 * dt + dd];
  u32x4 o; o.x = v[0] | ((unsigned)v[1] << 16); o.y = v[2] | ((unsigned)v[3] << 16); o.z = v[4] | ((unsigned)v[5] << 16); o.w = v[6] | ((unsigned)v[7] << 16);
  *(u32x4*)(dst + c * 8) = o;
}
__device__ void d_relayoutK_f32(size_t c, const float* __restrict__ src, bf16_t* __restrict__ dst) {
  int lane = c & 63, s = (c >> 6) & 7; size_t tt = c >> 9; int T = tt % 32, g = tt / 32;
  int i = lane & 31, h = lane >> 5;
  int n = 32 * T + pi_perm(i);
  bf16_t v[8];
#pragma unroll
  for (int j = 0; j < 8; ++j) v[j] = (n < NCMP) ? f2bf(src[((size_t)n * 2 + g) * 128 + 16 * s + 8 * h + j]) : (bf16_t)0;
  u32x4 o; o.x = v[0] | ((unsigned)v[1] << 16); o.y = v[2] | ((unsigned)v[3] << 16); o.z = v[4] | ((unsigned)v[5] << 16); o.w = v[6] | ((unsigned)v[7] << 16);
  *(u32x4*)(dst + c * 8) = o;
}
__device__ void d_relayoutV_f32(size_t c, const float* __restrict__ src, bf16_t* __restrict__ dst) {
  int lane = c & 63, s2 = (c >> 6) & 1, dt = (c >> 7) & 3; size_t tt = c >> 9; int T = tt % 32, g = tt / 32;
  int dd = lane & 31, h = lane >> 5;
  bf16_t v[8];
#pragma unroll
  for (int j = 0; j < 8; ++j) { int n = 32 * T + 16 * s2 + 8 * h + j; v[j] = (n < NCMP) ? f2bf(src[((size_t)n * 2 + g) * 128 + 32 * dt + dd]) : (bf16_t)0; }
  u32x4 o; o.x = v[0] | ((unsigned)v[1] << 16); o.y = v[2] | ((unsigned)v[3] << 16); o.z = v[4] | ((unsigned)v[5] << 16); o.w = v[6] | ((unsigned)v[7] << 16);
  *(u32x4*)(dst + c * 8) = o;
}

struct AttnPtrs {
  const bf16_t* proj; const float* gates;
  const bf16_t *kcf, *vcf, *ksf, *vsf, *kwf, *vwf;
  float* oatt;
};

DI f32x16 qk_tile(const bf16_t* __restrict__ kt, const bf16_t* qL, int lane) {
  f32x16 acc;
#pragma unroll
  for (int i = 0; i < 16; ++i) acc[i] = 0.f;
  const bf16_t* qp = qL + (lane & 31) * 136 + 8 * (lane >> 5);
#pragma unroll
  for (int s = 0; s < 8; ++s) {
    bf16x8 kf = *(const bf16x8*)(kt + s * 512 + lane * 8);
    bf16x8 qf = *(const bf16x8*)(qp + 16 * s);
    acc = MFMA32(kf, qf, acc);
  }
  return acc;
}
DI void pv_tile(const bf16_t* __restrict__ vt, const float (&p)[16], f32x16 (&O)[4], int lane) {
  bf16x8 pf0 = pack8(p[0], p[1], p[2], p[3], p[4], p[5], p[6], p[7]);
  bf16x8 pf1 = pack8(p[8], p[9], p[10], p[11], p[12], p[13], p[14], p[15]);
#pragma unroll
  for (int dt = 0; dt < 4; ++dt) {
    bf16x8 v0 = *(const bf16x8*)(vt + (dt * 2 + 0) * 512 + lane * 8);
    bf16x8 v1 = *(const bf16x8*)(vt + (dt * 2 + 1) * 512 + lane * 8);
    O[dt] = MFMA32(v0, pf0, O[dt]);
    O[dt] = MFMA32(v1, pf1, O[dt]);
  }
}
DI void osm_step(const float (&sv)[16], unsigned vmask, float& m, float& l, f32x16 (&O)[4], float (&p)[16]) {
  float tmax = NEGB;
#pragma unroll
  for (int r = 0; r < 16; ++r) tmax = fmaxf(tmax, sv[r]);
  tmax = fmaxf(tmax, __shfl_xor(tmax, 32));
  float mn = fmaxf(m, tmax);
  float alpha = exp2f(m - mn);
  float ps = 0.f;
#pragma unroll
  for (int r = 0; r < 16; ++r) { float e = ((vmask >> r) & 1u) ? exp2f(sv[r] - mn) : 0.f; p[r] = e; ps += e; }
  l = l * alpha + ps;
  m = mn;
  if (__ballot(alpha < 1.f)) {
#pragma unroll
    for (int dt = 0; dt < 4; ++dt)
#pragma unroll
      for (int r = 0; r < 16; ++r) O[dt][r] *= alpha;
  }
}
DI void ot_store(char* otL, int lane, const f32x16 (&O)[4], float sc) {
#pragma unroll
  for (int dt = 0; dt < 4; ++dt) {
    u32x4 a, b;
#pragma unroll
    for (int i = 0; i < 4; ++i) { a[i] = pack2(sc * O[dt][2 * i], sc * O[dt][2 * i + 1]); b[i] = pack2(sc * O[dt][8 + 2 * i], sc * O[dt][8 + 2 * i + 1]); }
    *(u32x4*)(otL + lane * 128 + dt * 32) = a;
    *(u32x4*)(otL + lane * 128 + dt * 32 + 16) = b;
  }
}
DI void ot_accum(const char* otL, int lane, f32x16 (&O)[4], float sc) {
#pragma unroll
  for (int dt = 0; dt < 4; ++dt) {
    u32x4 a = *(const u32x4*)(otL + lane * 128 + dt * 32);
    u32x4 b = *(const u32x4*)(otL + lane * 128 + dt * 32 + 16);
#pragma unroll
    for (int i = 0; i < 4; ++i) {
      const unsigned wa = a[i], wb = b[i];
      O[dt][2 * i] = fmaf(sc, O[dt][2 * i], __uint_as_float(wa << 16));
      O[dt][2 * i + 1] = fmaf(sc, O[dt][2 * i + 1], __uint_as_float(wa & 0xFFFF0000u));
      O[dt][8 + 2 * i] = fmaf(sc, O[dt][8 + 2 * i], __uint_as_float(wb << 16));
      O[dt][8 + 2 * i + 1] = fmaf(sc, O[dt][8 + 2 * i + 1], __uint_as_float(wb & 0xFFFF0000u));
    }
  }
}
DI void zero_o(f32x16 (&O)[4]) {
#pragma unroll
  for (int dt = 0; dt < 4; ++dt)
#pragma unroll
    for (int i = 0; i < 16; ++i) O[dt][i] = 0.f;
}

constexpr int ATT_WSM = 17408;
__device__ __noinline__ void d_select(const float* impL, unsigned* mskL, unsigned* uniL, int cur) {
  const int lane = threadIdx.x & 63;
  const int stok = lane >> 3, sub = lane & 7;
  unsigned key[32];
#pragma unroll
  for (int i4 = 0; i4 < 8; ++i4) {
    f32x4 v = *(const f32x4*)(impL + stok * 256 + sub * 32 + i4 * 4);
#pragma unroll
    for (int e = 0; e < 4; ++e) {
      const int j = sub * 32 + i4 * 4 + e;
      const bool valid = j <= cur;
      const bool forced = (j == 0) || (j == cur) || (j == cur - 1);
      unsigned kb = forced ? 0xFFFFFF00u : (__float_as_uint(v[e]) & 0xFFFFFF00u);
      key[i4 * 4 + e] = valid ? (kb | (unsigned)(255 - j)) : 0u;
    }
  }
#pragma unroll
  for (int k = 2; k <= 32; k <<= 1) {
#pragma unroll
    for (int jj = k >> 1; jj > 0; jj >>= 1) {
#pragma unroll
      for (int i = 0; i < 32; ++i) {
        const int l2 = i ^ jj;
        if (l2 > i) {
          const bool desc = ((i & k) == 0);
          unsigned a = key[i], b = key[l2];
          unsigned mx = a > b ? a : b, mn = a > b ? b : a;
          key[i] = desc ? mx : mn; key[l2] = desc ? mn : mx;
        }
      }
    }
  }
#pragma unroll
  for (int xm = 1; xm < 8; xm <<= 1) {
    unsigned L[16];
#pragma unroll
    for (int i = 0; i < 16; ++i) { unsigned o = (unsigned)__shfl_xor((int)key[15 - i], xm); L[i] = key[i] > o ? key[i] : o; }
#pragma unroll
    for (int jj = 8; jj > 0; jj >>= 1) {
#pragma unroll
      for (int i = 0; i < 16; ++i) {
        const int l2 = i ^ jj;
        if (l2 > i) { unsigned a = L[i], b = L[l2]; L[i] = a > b ? a : b; L[l2] = a > b ? b : a; }
      }
    }
#pragma unroll
    for (int i = 0; i < 16; ++i) key[i] = L[i];
  }
#pragma unroll
  for (int i = 0; i < 16; ++i) {
    if ((i & 7) == sub) {
      const int j = 255 - (int)(key[i] & 255u);
      if (j <= cur) { atomicOr(&mskL[stok * 8 + (j >> 5)], 1u << (j & 31)); atomicOr(&uniL[j >> 5], 1u << (j & 31)); }
    }
  }
}

__device__ void d_attn_wave(int item, char* wsm, const AttnPtrs& P) {
  const int lane = threadIdx.x & 63;
  const int g = item & 1, tok0 = (item >> 1) * 8;
  const int c = lane & 31, h = lane >> 5, tokl = c >> 2, r = c & 3;
  const int t = tok0 + tokl, hd = g * 4 + r;
  const float slope2 = exp2f(-(float)(hd + 1)) * LOG2E;
  const float c1 = QSCALE * LOG2E;
  float* impL = (float*)wsm;
  char* otL = wsm;
  bf16_t* qL = (bf16_t*)(wsm + 8192);
  unsigned* mskL = (unsigned*)(wsm + 8192 + 8704);
  unsigned* uniL = mskL + 64;
  {
#pragma unroll
    for (int i = 0; i < 8; ++i) {
      const int id = i * 64 + lane, row = id >> 4, ch = id & 15;
      u32x4 v = *(const u32x4*)(P.proj + (size_t)(tok0 + (row >> 2)) * INWP + OFF_Q + (g * 4 + (row & 3)) * 128 + ch * 8);
      *(u32x4*)(qL + row * 136 + ch * 8) = v;
    }
    u32x4 z = {0u, 0u, 0u, 0u};
#pragma unroll
    for (int i = 0; i < 8; ++i) *(u32x4*)(wsm + (i * 64 + lane) * 16) = z;
    if (lane < 18) *(u32x4*)(wsm + 8192 + 8704 + lane * 16) = z;
  }
  const float* gt = P.gates + (size_t)t * 24 + hd * 3;
  const float g0 = gt[0], g1 = gt[1], g2 = gt[2];
  f32x16 Ob[4];
  zero_o(Ob);
  {
    const int nmax = (t >= 31) ? ((t - 31) >> 4) : -1;
    const int nmaxw = (tok0 + 7 >= 31) ? ((tok0 + 7 - 31) >> 4) : -1;
    const int ntc = (nmaxw + 32) >> 5;
    const bf16_t* kcf = P.kcf + (size_t)g * 32 * 4096;
    const bf16_t* vcf = P.vcf + (size_t)g * 32 * 4096;
    float mC = NEGB, lC = 0.f;
    const float sl16 = slope2 * 16.f;
    for (int T = ntc - 1; T >= 0; --T) {
      f32x16 acc = qk_tile(kcf + (size_t)T * 4096, qL, lane);
      const float base = slope2 * (float)(512 * T + 128 * h) + slope2 * (15.5f - (float)t);
      const int nb = 32 * T + 8 * h;
      float tmax = NEGB; float sv[16];
#pragma unroll
      for (int rg = 0; rg < 16; ++rg) {
        const int kk = (rg & 7) + 16 * (rg >> 3);
        float v = fmaf(acc[rg], c1, fmaf(sl16, (float)kk, base));
        v = (nb + kk <= nmax) ? v : NEGB;
        sv[rg] = v; tmax = fmaxf(tmax, v);
      }
      tmax = fmaxf(tmax, __shfl_xor(tmax, 32));
      float mn = fmaxf(mC, tmax);
      float ps = 0.f;
#pragma unroll
      for (int rg = 0; rg < 16; ++rg) { const int kk = (rg & 7) + 16 * (rg >> 3); ps += (nb + kk <= nmax) ? exp2f(sv[rg] - mn) : 0.f; }
      lC = lC * exp2f(mC - mn) + ps; mC = mn;
    }
    lC += __shfl_xor(lC, 32);
    const float invC = (lC > 0.f) ? 1.f / lC : 0.f;
    float carry = 0.f;
    for (int T = 0; T < ntc; ++T) {
      f32x16 acc = qk_tile(kcf + (size_t)T * 4096, qL, lane);
      const float base = slope2 * (float)(512 * T + 128 * h) + slope2 * (15.5f - (float)t);
      const int nb = 32 * T + 8 * h;
      float p[16];
#pragma unroll
      for (int rg = 0; rg < 16; ++rg) {
        const int kk = (rg & 7) + 16 * (rg >> 3);
        float v = fmaf(acc[rg], c1, fmaf(sl16, (float)kk, base));
        p[rg] = (nb + kk <= nmax) ? exp2f(v - mC) * invC : 0.f;
      }
      float Ga = (p[0] + p[1]) + (p[2] + p[3]), Gb = (p[4] + p[5]) + (p[6] + p[7]);
      float Gc = (p[8] + p[9]) + (p[10] + p[11]), Gd = (p[12] + p[13]) + (p[14] + p[15]);
      float xb = __shfl_xor(p[7], 32), xd = __shfl_xor(p[15], 32);
      float ia = Ga + (h ? xb : carry);
      float ib = Gb + p[3];
      float ic = Gc + (h ? xd : xb);
      float id = Gd + p[11];
      carry = xd;
      ia += __shfl_xor(ia, 1); ia += __shfl_xor(ia, 2);
      ib += __shfl_xor(ib, 1); ib += __shfl_xor(ib, 2);
      ic += __shfl_xor(ic, 1); ic += __shfl_xor(ic, 2);
      id += __shfl_xor(id, 1); id += __shfl_xor(id, 2);
      {
        float val = (r == 0) ? ia : (r == 1) ? ib : (r == 2) ? ic : id;
        int j = 8 * T + 2 * h + ((r == 0) ? 0 : (r == 1) ? 1 : (r == 2) ? 4 : 5);
        impL[tokl * 256 + j] = val;
      }
      pv_tile(vcf + (size_t)T * 4096, p, Ob, lane);
    }
  }
  const int cur = tok0 >> 6;
  d_select(impL, mskL, uniL, cur);
  ot_store(otL, lane, Ob, g0);
  zero_o(Ob);
  {
    const bf16_t* ksf = P.ksf + (size_t)g * 512 * 4096;
    const bf16_t* vsf = P.vsf + (size_t)g * 512 * 4096;
    float m = NEGB, l = 0.f;
    for (int w = 7; w >= 0; --w) {
      unsigned uw = __builtin_amdgcn_readfirstlane(uniL[w]);
      while (uw) {
        const int bit = 31 - __builtin_clz(uw);
        uw &= ~(1u << bit);
        const int b = 32 * w + bit;
        const bool mine = (mskL[tokl * 8 + w] >> bit) & 1u;
        for (int half = 1; half >= 0; --half) {
          const int T = 2 * b + half;
          const int pos0 = 32 * T;
          if (pos0 > tok0 + 7) continue;
          f32x16 acc = qk_tile(ksf + (size_t)T * 4096, qL, lane);
          const float base = slope2 * (float)(pos0 + 8 * h - t);
          const int pb = pos0 + 8 * h;
          float sv[16]; unsigned vm = 0;
#pragma unroll
          for (int rg = 0; rg < 16; ++rg) {
            const int kk = (rg & 7) + 16 * (rg >> 3);
            const bool ok = mine && (pb + kk <= t);
            float v = fmaf(acc[rg], c1, fmaf(slope2, (float)kk, base));
            sv[rg] = ok ? v : NEGB; vm |= ok ? (1u << rg) : 0u;
          }
          float p[16];
          osm_step(sv, vm, m, l, Ob, p);
          pv_tile(vsf + (size_t)T * 4096, p, Ob, lane);
        }
      }
    }
    l += __shfl_xor(l, 32);
    const float inv = (l > 0.f) ? g1 / l : 0.f;
    ot_accum(otL, lane, Ob, inv);
    ot_store(otL, lane, Ob, 1.f);
    zero_o(Ob);
  }
  {
    const bf16_t* kwf = P.kwf + (size_t)g * 512 * 4096;
    const bf16_t* vwf = P.vwf + (size_t)g * 512 * 4096;
    float m = NEGB, l = 0.f;
    const int plo = tok0 - 511 > 0 ? tok0 - 511 : 0;
    const int Tlo = plo >> 5, Thi = (tok0 + 7) >> 5;
    for (int T = Thi; T >= Tlo; --T) {
      const int pos0 = 32 * T;
      f32x16 acc = qk_tile(kwf + (size_t)T * 4096, qL, lane);
      const float base = slope2 * (float)(pos0 + 8 * h - t);
      const int pb = pos0 + 8 * h;
      float sv[16]; unsigned vm = 0;
#pragma unroll
      for (int rg = 0; rg < 16; ++rg) {
        const int kk = (rg & 7) + 16 * (rg >> 3);
        const int dw = t - (pb + kk);
        const bool ok = (dw >= 0) && (dw < 512);
        float v = fmaf(acc[rg], c1, fmaf(slope2, (float)kk, base));
        sv[rg] = ok ? v : NEGB; vm |= ok ? (1u << rg) : 0u;
      }
      float p[16];
      osm_step(sv, vm, m, l, Ob, p);
      pv_tile(vwf + (size_t)T * 4096, p, Ob, lane);
    }
    l += __shfl_xor(l, 32);
    const float inv = (l > 0.f) ? g2 / l : 0.f;
    ot_accum(otL, lane, Ob, inv);
  }
  {
    float* orow = P.oatt + (size_t)t * 1024 + hd * 128;
#pragma unroll
    for (int dt = 0; dt < 4; ++dt)
#pragma unroll
      for (int a = 0; a < 4; ++a) {
        f32x4 v = {Ob[dt][4 * a], Ob[dt][4 * a + 1], Ob[dt][4 * a + 2], Ob[dt][4 * a + 3]};
        *(f32x4*)(orow + 32 * dt + 8 * a + 4 * h) = v;
      }
  }
}

__device__ void d_mix(int t, const bf16_t* __restrict__ proj, const float* __restrict__ oatt, const float* __restrict__ convw,
                      const float* __restrict__ hng, bf16_t* __restrict__ mix) {
  const int tid = (threadIdx.x & 255);
  float v[8];
  const int c0 = tid * 8;
  if (c0 < 1024) {
    for (int i = 0; i < 8; ++i) v[i] = oatt[(size_t)t * 1024 + c0 + i];
  } else {
    int c = c0 - 1024;
    for (int i = 0; i < 8; ++i) {
      float acc = 0.f;
      for (int j = 0; j < 3; ++j) {
        int tt = t - 2 + j;
        if (tt >= 0) {
          const bf16_t* pr = proj + (size_t)tt * INWP;
          acc += convw[j * 1024 + c + i] * bf2f(pr[OFF_C + c + i]) * bf2f(pr[OFF_U + c + i]);
        }
      }
      v[i] = acc * bf2f(proj[(size_t)t * INWP + OFF_B + c + i]);
    }
  }
  float ss = 0.f;
  for (int i = 0; i < 8; ++i) ss += v[i] * v[i];
  for (int o = 8; o > 0; o >>= 1) ss += __shfl_xor(ss, o);
  float rs = rsqrtf(ss * (1.f / 128.f) + 1e-6f);
  for (int i = 0; i < 8; ++i) mix[(size_t)t * DM + c0 + i] = f2bf(v[i] * rs * hng[c0 + i]);
}

__device__ void d_ln(int t, char* smem, const float* __restrict__ y, const float* __restrict__ gam, const float* __restrict__ bet,
                     float* __restrict__ hf, bf16_t* __restrict__ hb) {
  float* red = (float*)smem;
  const int tid = (threadIdx.x & 255);
  float v[8]; float s = 0.f;
  for (int i = 0; i < 8; ++i) { v[i] = y[(size_t)t * DM + tid + i * 256]; s += v[i]; }
  s = wave_sum(s); if ((tid & 63) == 0) red[tid >> 6] = s; __syncthreads();
  float mu = (red[0] + red[1] + red[2] + red[3]) * (1.f / DM);
  float q = 0.f; for (int i = 0; i < 8; ++i) { float d = v[i] - mu; q += d * d; }
  q = wave_sum(q); if ((tid & 63) == 0) red[4 + (tid >> 6)] = q; __syncthreads();
  float var = (red[4] + red[5] + red[6] + red[7]) * (1.f / DM);
  float rs = rsqrtf(var + 1e-5f);
  for (int i = 0; i < 8; ++i) {
    int c = tid + i * 256; float o = (v[i] - mu) * rs * gam[c] + bet[c];
    if (hf) hf[(size_t)t * DM + c] = o;
    if (hb) hb[(size_t)t * DM + c] = f2bf(o);
  }
  __syncthreads();
}

__device__ void d_peer_route(int t, char* smem, const float* __restrict__ qp, const float* __restrict__ subk, int* __restrict__ eid,
                             float* __restrict__ gw) {
  float* q = (float*)smem;
  float (*s)[128] = (float (*)[128])(smem + 8192);
  float (*ts)[16] = (float (*)[16])(smem + 16384);
  int (*ti)[16] = (int (*)[16])(smem + 17408);
  float (*cand)[256] = (float (*)[256])(smem + 18432);
  float (*bs)[16] = (float (*)[16])(smem + 26624);
  int (*bi)[16] = (int (*)[16])(smem + 27136);
  const int tid = (threadIdx.x & 255);
  for (int i = tid; i < 2048; i += 256) q[i] = qp[(size_t)t * 2048 + i];
  __syncthreads();
  for (int idx = tid; idx < 2048; idx += 256) {
    int hc = idx >> 7, key = idx & 127;
    const float* kr = subk + ((size_t)hc * 128 + key) * 128;
    const float* qq = q + hc * 128;
    float a = 0.f;
    for (int d = 0; d < 128; ++d) a += qq[d] * kr[d];
    s[hc][key] = a;
  }
  __syncthreads();
  for (int idx = tid; idx < 2048; idx += 256) {
    int hc = idx >> 7, key = idx & 127;
    float my = s[hc][key]; int rank = 0;
    for (int i = 0; i < 128; ++i) { float o = s[hc][i]; rank += (o > my || (o == my && i < key)) ? 1 : 0; }
    if (rank < 16) { ts[hc][rank] = my; ti[hc][rank] = key; }
  }
  __syncthreads();
  for (int idx = tid; idx < 2048; idx += 256) {
    int h = idx >> 8, c = idx & 255;
    cand[h][c] = ts[h * 2][c >> 4] + ts[h * 2 + 1][c & 15];
  }
  __syncthreads();
  for (int idx = tid; idx < 2048; idx += 256) {
    int h = idx >> 8, c = idx & 255;
    float my = cand[h][c]; int rank = 0;
    for (int i = 0; i < 256; ++i) { float o = cand[h][i]; rank += (o > my || (o == my && i < c)) ? 1 : 0; }
    if (rank < 16) { bs[h][rank] = my; bi[h][rank] = c; }
  }
  __syncthreads();
  if (tid < 128) {
    int h = tid >> 4, k = tid & 15;
    float mx = bs[h][0];
    float sum = 0.f;
    for (int i = 0; i < 16; ++i) sum += __expf(bs[h][i] - mx);
    float gv = __expf(bs[h][k] - mx) / sum;
    int c = bi[h][k];
    int i1 = ti[h * 2][c >> 4], i2 = ti[h * 2 + 1][c & 15];
    eid[(size_t)t * 128 + tid] = i1 * 128 + i2;
    gw[(size_t)t * 128 + tid] = gv;
  }
  __syncthreads();
}

DI float dot8(u32x4 a, const unsigned (&hh)[4], float acc) {
#pragma unroll
  for (int i = 0; i < 4; ++i) { const unsigned ai = a[i], hi = hh[i]; acc = __builtin_amdgcn_fdot2_f32_bf16(__builtin_bit_cast(bf16x2v, ai), __builtin_bit_cast(bf16x2v, hi), acc, false); }
  return acc;
}
__device__ void d_expert_wave(int t, const float* __restrict__ hf, const int* __restrict__ eid, const float* __restrict__ gw,
                              const bf16_t* __restrict__ eub, const bf16_t* __restrict__ evb, const float* __restrict__ gam,
                              const float* __restrict__ bet, float* __restrict__ out) {
  const int lane = threadIdx.x & 63;
  float hv[32]; unsigned hp[4][4];
#pragma unroll
  for (int q = 0; q < 4; ++q) {
    f32x4 a = *(const f32x4*)(hf + (size_t)t * DM + 512 * q + 8 * lane);
    f32x4 b = *(const f32x4*)(hf + (size_t)t * DM + 512 * q + 8 * lane + 4);
#pragma unroll
    for (int j = 0; j < 4; ++j) { hv[q * 8 + j] = a[j]; hv[q * 8 + 4 + j] = b[j]; }
#pragma unroll
    for (int j = 0; j < 4; ++j) hp[q][j] = (unsigned)f2bf(hv[q * 8 + 2 * j]) | ((unsigned)f2bf(hv[q * 8 + 2 * j + 1]) << 16);
  }
  const int e0 = eid[(size_t)t * 128 + lane], e1 = eid[(size_t)t * 128 + 64 + lane];
  const float w0 = gw[(size_t)t * 128 + lane], w1 = gw[(size_t)t * 128 + 64 + lane];
  float c0 = 0.f, c1 = 0.f;
#pragma unroll 1
  for (int eb = 0; eb < 128; eb += 4) {
    u32x4 rr[4][4];
#pragma unroll
    for (int k = 0; k < 4; ++k) {
      const int e = eb + k;
      const int id = __shfl((e < 64) ? e0 : e1, e & 63);
      const bf16_t* row = eub + (size_t)id * DM + 8 * lane;
#pragma unroll
      for (int q = 0; q < 4; ++q) rr[k][q] = *(const u32x4*)(row + 512 * q);
    }
#pragma unroll
    for (int k = 0; k < 4; ++k) {
      float a = 0.f;
#pragma unroll
      for (int q = 0; q < 4; ++q) a = dot8(rr[k][q], hp[q], a);
      a = wave_sum(a);
      const float gl = gelu_tanh(a);
      const int e = eb + k;
      if (e < 64) { if (lane == e) c0 = w0 * gl; } else { if (lane == e - 64) c1 = w1 * gl; }
    }
  }
  float acc[32];
#pragma unroll
  for (int i = 0; i < 32; ++i) acc[i] = 0.f;
#pragma unroll 1
  for (int eb = 0; eb < 128; eb += 4) {
    u32x4 rr[4][4]; float cc[4];
#pragma unroll
    for (int k = 0; k < 4; ++k) {
      const int e = eb + k;
      const int id = __shfl((e < 64) ? e0 : e1, e & 63);
      cc[k] = __shfl((e < 64) ? c0 : c1, e & 63);
      const bf16_t* row = evb + (size_t)id * DM + 8 * lane;
#pragma unroll
      for (int q = 0; q < 4; ++q) rr[k][q] = *(const u32x4*)(row + 512 * q);
    }
#pragma unroll
    for (int k = 0; k < 4; ++k)
#pragma unroll
      for (int q = 0; q < 4; ++q)
#pragma unroll
        for (int j = 0; j < 4; ++j) {
          const unsigned w = rr[k][q][j];
          acc[q * 8 + 2 * j] = fmaf(cc[k], __uint_as_float(w << 16), acc[q * 8 + 2 * j]);
          acc[q * 8 + 2 * j + 1] = fmaf(cc[k], __uint_as_float(w & 0xFFFF0000u), acc[q * 8 + 2 * j + 1]);
        }
  }
  float s = 0.f;
#pragma unroll
  for (int i = 0; i < 32; ++i) { acc[i] = fmaf(ALPHA, hv[i], acc[i]); s += acc[i]; }
  s = wave_sum(s);
  const float mu = s * (1.f / DM);
  float qv = 0.f;
#pragma unroll
  for (int i = 0; i < 32; ++i) { const float d = acc[i] - mu; qv += d * d; }
  qv = wave_sum(qv);
  const float rs = rsqrtf(qv * (1.f / DM) + 1e-5f);
#pragma unroll
  for (int q = 0; q < 4; ++q) {
    const int cbase = 512 * q + 8 * lane;
    f32x4 ga = *(const f32x4*)(gam + cbase), gb = *(const f32x4*)(gam + cbase + 4);
    f32x4 ba = *(const f32x4*)(bet + cbase), bb = *(const f32x4*)(bet + cbase + 4);
    f32x4 oa, ob;
#pragma unroll
    for (int j = 0; j < 4; ++j) { oa[j] = (acc[q * 8 + j] - mu) * rs * ga[j] + ba[j]; ob[j] = (acc[q * 8 + 4 + j] - mu) * rs * gb[j] + bb[j]; }
    *(f32x4*)(out + (size_t)t * DM + cbase) = oa;
    *(f32x4*)(out + (size_t)t * DM + cbase + 4) = ob;
  }
}

struct Params {
  const float *x, *w_in, *ck_pos, *ck_w1, *ck_b1, *ck_w2, *cv_pos, *cv_w1, *cv_b1, *cv_w2, *conv_w, *hng, *w_out, *ln1g, *ln1b, *w_query, *subk,
      *eu, *ev, *ln2g, *ln2b;
  float* out;
  bf16_t *xb, *winT, *proj, *w1kT, *w1vT, *acmpK, *acmpV, *mix, *woutT, *wqT, *hb;
  float *gates, *hidK, *hidV, *kc, *vc, *oatt, *y, *qpf, *gw;
  bf16_t *kcf, *vcf, *ksf, *vsf, *kwf, *vwf, *eub, *evb;
  int* eid;
};

#define FOR_VB(n) for (int vb = blockIdx.x; vb < (n); vb += gridDim.x)
#define FOR_VB2(n) for (int vb = blockIdx.x * 2 + (int)(threadIdx.x >> 8); vb < (n); vb += gridDim.x * 2)
constexpr int SMEM_BYTES = 8 * 17408;
constexpr int HALF = 36864;

__global__ void __launch_bounds__(512) mega(Params p) {
  cg::grid_group grid = cg::this_grid();
  __shared__ __attribute__((aligned(16))) char smem[SMEM_BYTES];
  char* smh = smem + (threadIdx.x >> 8) * HALF;
  const int wv = threadIdx.x >> 6;
  constexpr int NWV = 8;
  d_cvt(p.x, p.xb, (size_t)S * DM / 4);
  FOR_VB2((INWP / 32) * (DM / 32)) d_cvtT(vb, smh, p.w_in, p.winT, DM, INW, INWP);
  FOR_VB2((512 / 32) * (4096 / 32)) d_cvtT(vb, smh, p.ck_w1, p.w1kT, 4096, 512, 512);
  FOR_VB2((512 / 32) * (4096 / 32)) d_cvtT(vb, smh, p.cv_w1, p.w1vT, 4096, 512, 512);
  FOR_VB2((DM / 32) * (DM / 32)) d_cvtT(vb, smh, p.w_out, p.woutT, DM, DM, DM);
  FOR_VB2((DM / 32) * (DM / 32)) d_cvtT(vb, smh, p.w_query, p.wqT, DM, DM, DM);
  grid.sync();
  FOR_VB((S / 256) * (INWP / 128)) d_gemm(vb, smem, p.xb, DM, p.winT, DM, DM, S / 256, EpiProjF{p.proj, p.gates});
  grid.sync();
  FOR_VB2(4096) { if (vb < 2048) d_build_cmp(vb, p.proj, OFF_KC, p.ck_pos, p.acmpK); else d_build_cmp(vb - 2048, p.proj, OFF_VC, p.cv_pos, p.acmpV); }
  grid.sync();
  FOR_VB(64) {
    if (vb < 32) d_gemm(vb, smem, p.acmpK, 4096, p.w1kT, 4096, 4096, 8, EpiF32F{p.hidK, 512, 512});
    else d_gemm(vb - 32, smem, p.acmpV, 4096, p.w1vT, 4096, 4096, 8, EpiF32F{p.hidV, 512, 512});
  }
  grid.sync();
  FOR_VB2(4092) { if (vb < 2046) d_cmp2(vb, smh, p.hidK, p.ck_b1, p.ck_w2, p.kc); else d_cmp2(vb - 2046, smh, p.hidV, p.cv_b1, p.cv_w2, p.vc); }
  grid.sync();
  {
    const size_t gt = (size_t)blockIdx.x * 512 + threadIdx.x, gs = (size_t)gridDim.x * 512;
    for (size_t c = gt; c < (size_t)2 * 32 * 512; c += gs) { d_relayoutK_f32(c, p.kc, p.kcf); d_relayoutV_f32(c, p.vc, p.vcf); }
    for (size_t c = gt; c < (size_t)2 * 512 * 512; c += gs) {
      d_relayoutK_bf(c, 512, p.proj, INWP, OFF_KS, p.ksf); d_relayoutV_bf(c, 512, p.proj, INWP, OFF_VS, p.vsf);
      d_relayoutK_bf(c, 512, p.proj, INWP, OFF_KW, p.kwf); d_relayoutV_bf(c, 512, p.proj, INWP, OFF_VW, p.vwf);
    }
  }
  grid.sync();
  {
    AttnPtrs ap{p.proj, p.gates, p.kcf, p.vcf, p.ksf, p.vsf, p.kwf, p.vwf, p.oatt};
    for (int item = blockIdx.x * NWV + wv; item < 4096; item += gridDim.x * NWV) d_attn_wave(item, smem + wv * ATT_WSM, ap);
  }
  grid.sync();
  FOR_VB2(S) d_mix(vb, p.proj, p.oatt, p.conv_w, p.hng, p.mix);
  grid.sync();
  FOR_VB((S / 256) * (DM / 128)) d_gemm(vb, smem, p.mix, DM, p.woutT, DM, DM, S / 256, EpiResF{p.y, p.x});
  grid.sync();
  FOR_VB2(S) d_ln(vb, smh, p.y, p.ln1g, p.ln1b, p.y, p.hb);
  d_cvt(p.eu, p.eub, (size_t)16384 * DM / 4);
  d_cvt(p.ev, p.evb, (size_t)16384 * DM / 4);
  grid.sync();
  FOR_VB((S / 256) * (DM / 128)) d_gemm(vb, smem, p.hb, DM, p.wqT, DM, DM, S / 256, EpiF32F{p.qpf, DM, DM});
  grid.sync();
  FOR_VB2(S) d_peer_route(vb, smh, p.qpf, p.subk, p.eid, p.gw);
  grid.sync();
  for (int t = blockIdx.x * NWV + wv; t < S; t += gridDim.x * NWV) d_expert_wave(t, p.y, p.eid, p.gw, p.eub, p.evb, p.ln2g, p.ln2b, p.out);
}

extern "C" void kernel_launch(void* const* d_in, const int* in_sizes, int n_in, void* d_out, int out_size, void* d_ws, size_t ws_size,
                              hipStream_t stream) {
  Params p{};
  p.x = (const float*)d_in[0]; p.w_in = (const float*)d_in[1]; p.ck_pos = (const float*)d_in[2]; p.ck_w1 = (const float*)d_in[3];
  p.ck_b1 = (const float*)d_in[4]; p.ck_w2 = (const float*)d_in[5]; p.cv_pos = (const float*)d_in[6]; p.cv_w1 = (const float*)d_in[7];
  p.cv_b1 = (const float*)d_in[8]; p.cv_w2 = (const float*)d_in[9]; p.conv_w = (const float*)d_in[10]; p.hng = (const float*)d_in[11];
  p.w_out = (const float*)d_in[12]; p.ln1g = (const float*)d_in[13]; p.ln1b = (const float*)d_in[14]; p.w_query = (const float*)d_in[15];
  p.subk = (const float*)d_in[16]; p.eu = (const float*)d_in[17]; p.ev = (const float*)d_in[18]; p.ln2g = (const float*)d_in[19];
  p.ln2b = (const float*)d_in[20];
  p.out = (float*)d_out;
  char* ws = (char*)d_ws;
  size_t off = 0;
  auto alloc = [&](size_t bytes) { char* q = ws + off; off += (bytes + 255) & ~(size_t)255; return q; };
  p.xb = (bf16_t*)alloc((size_t)S * DM * 2);
  p.proj = (bf16_t*)alloc((size_t)S * INWP * 2);
  p.winT = (bf16_t*)alloc((size_t)INWP * DM * 2);
  p.gates = (float*)alloc((size_t)S * 24 * 4);
  p.w1kT = (bf16_t*)alloc((size_t)512 * 4096 * 2);
  p.w1vT = (bf16_t*)alloc((size_t)512 * 4096 * 2);
  p.acmpK = (bf16_t*)alloc((size_t)2048 * 4096 * 2);
  p.acmpV = (bf16_t*)alloc((size_t)2048 * 4096 * 2);
  p.hidK = (float*)alloc((size_t)2048 * 512 * 4);
  p.hidV = (float*)alloc((size_t)2048 * 512 * 4);
  p.kc = (float*)alloc((size_t)2048 * 128 * 4);
  p.vc = (float*)alloc((size_t)2048 * 128 * 4);
  p.kcf = (bf16_t*)alloc((size_t)2 * 32 * 4096 * 2);
  p.vcf = (bf16_t*)alloc((size_t)2 * 32 * 4096 * 2);
  p.ksf = (bf16_t*)alloc((size_t)2 * 512 * 4096 * 2);
  p.vsf = (bf16_t*)alloc((size_t)2 * 512 * 4096 * 2);
  p.kwf = (bf16_t*)alloc((size_t)2 * 512 * 4096 * 2);
  p.vwf = (bf16_t*)alloc((size_t)2 * 512 * 4096 * 2);
  size_t endA = off;
  p.oatt = (float*)alloc((size_t)S * 1024 * 4);
  p.mix = (bf16_t*)alloc((size_t)S * DM * 2);
  p.woutT = (bf16_t*)alloc((size_t)DM * DM * 2);
  p.wqT = (bf16_t*)alloc((size_t)DM * DM * 2);
  p.eid = (int*)alloc((size_t)S * 128 * 4);
  p.gw = (float*)alloc((size_t)S * 128 * 4);
  p.y = (float*)p.proj;
  p.hb = p.xb;
  p.qpf = p.oatt;
  p.eub = (bf16_t*)((char*)p.proj + (size_t)S * DM * 4);
  p.evb = p.eub + (size_t)16384 * DM;
  if ((char*)(p.evb + (size_t)16384 * DM) > ws + endA || off > ws_size) fprintf(stderr, "workspace layout overflow\n");
  static int grid_blocks = 0;
  if (!grid_blocks) {
    int dev = 0, cus = 0, per_cu = 0;
    hipGetDevice(&dev);
    hipDeviceGetAttribute(&cus, hipDeviceAttributeMultiprocessorCount, dev);
    hipOccupancyMaxActiveBlocksPerMultiprocessor(&per_cu, mega, 512, 0);
    if (per_cu > 1) per_cu = 1;
    if (per_cu < 1) per_cu = 1;
    grid_blocks = cus * per_cu;
  }
  void* args[] = {&p};
  hipError_t e = hipLaunchCooperativeKernel((void*)mega, dim3(grid_blocks), dim3(512), args, 0, stream);
  if (e != hipSuccess) fprintf(stderr, "cooperative launch failed: %s (grid %d)\n", hipGetErrorString(e), grid_blocks);
}
```

```cpp
#include <hip/hip_runtime.h>
#include <hip/hip_cooperative_groups.h>
#include <stdint.h>
#include <stdio.h>
namespace cg = cooperative_groups;

#define DI __device__ __forceinline__
typedef unsigned short bf16_t;
using bf16x8 = __attribute__((ext_vector_type(8))) short;
using f32x4 = __attribute__((ext_vector_type(4))) float;
using u32x4 = __attribute__((ext_vector_type(4))) unsigned;

constexpr int S = 16384, DM = 2048, HD = 128;
constexpr int INW = 5656, INWP = 5760;
constexpr int OFF_Q = 0, OFF_KC = 1024, OFF_VC = 1280, OFF_KS = 1536, OFF_VS = 1792, OFF_KW = 2048, OFF_VW = 2304,
              OFF_G = 2560, OFF_U = 2584, OFF_B = 3608, OFF_C = 4632;
constexpr int NCMP = 1023;
constexpr float ALPHA = 1.189207115002721f;
constexpr float QSCALE = 0.08838834764831845f;

DI bf16_t f2bf(float x) { unsigned u = __float_as_uint(x); u += 0x7fffu + ((u >> 16) & 1u); return (bf16_t)(u >> 16); }
DI float bf2f(bf16_t b) { return __uint_as_float(((unsigned)b) << 16); }
DI float gelu_tanh(float x) { float u = 0.7978845608028654f * (x + 0.044715f * x * x * x); return 0.5f * x * (1.f + tanhf(u)); }
DI float wave_sum(float v) { for (int o = 32; o > 0; o >>= 1) v += __shfl_xor(v, o); return v; }
DI float wave_max(float v) { for (int o = 32; o > 0; o >>= 1) v = fmaxf(v, __shfl_xor(v, o)); return v; }

__device__ void d_cvt(const float* __restrict__ in, bf16_t* __restrict__ out, size_t n4) {
  size_t i = (size_t)blockIdx.x * blockDim.x + threadIdx.x;
  size_t stride = (size_t)gridDim.x * blockDim.x;
  for (; i < n4; i += stride) { float4 v = ((const float4*)in)[i]; ushort4 o; o.x = f2bf(v.x); o.y = f2bf(v.y); o.z = f2bf(v.z); o.w = f2bf(v.w); ((ushort4*)out)[i] = o; }
}
__device__ void d_cvtT(int vb, char* smem, const float* __restrict__ W, bf16_t* __restrict__ WT, int K, int N, int NP) {
  float (*t)[33] = (float (*)[33])smem;
  int nbx = NP / 32;
  int n0 = (vb % nbx) * 32, k0 = (vb / nbx) * 32;
  int tx = (threadIdx.x & 255) & 31, ty = (threadIdx.x & 255) >> 5;
  for (int i = ty; i < 32; i += 8) { int k = k0 + i, n = n0 + tx; t[i][tx] = (n < N && k < K) ? W[(size_t)k * N + n] : 0.f; }
  __syncthreads();
  for (int i = ty; i < 32; i += 8) { int n = n0 + i, k = k0 + tx; if (n < NP && k < K) WT[(size_t)n * K + k] = f2bf(t[tx][i]); }
  __syncthreads();
}

constexpr int LDS_LD = 72;
struct EpiProj { bf16_t* proj; float* gates; };
struct EpiF32 { float* C; int ldc; int N; };
struct EpiRes { float* C; const float* X; };


#define ELEMWISE_TILE                                                                              \
  DI void tile(f32x4 (&acc)[4][4], char*, int m0, int n0, int, int wm, int wn, int, int lane) const { \
    _Pragma("unroll") for (int i = 0; i < 4; ++i)                                                  \
    _Pragma("unroll") for (int j = 0; j < 4; ++j)                                                  \
    _Pragma("unroll") for (int r = 0; r < 4; ++r) {                                                \
      int row = m0 + wm * 64 + i * 16 + (lane >> 4) * 4 + r;                                       \
      int col = n0 + wn * 64 + j * 16 + (lane & 15);                                               \
      (*this)(row, col, acc[i][j][r]);                                                             \
    }                                                                                              \
  }
template <class Epi>
__device__ void d_gemm(int vb, char* smem, const bf16_t* __restrict__ A, int lda, const bf16_t* __restrict__ BT, int ldb, int K,
                       int tilesM, Epi epi) {
  bf16_t* As = (bf16_t*)smem;
  bf16_t* Bs = As + 256 * LDS_LD;
  const int tid = threadIdx.x, lane = tid & 63, wid = tid >> 6;
  const int wm = wid >> 1, wn = wid & 1;
  const int tm = vb % tilesM, tn = vb / tilesM;
  const int m0 = tm * 256, n0 = tn * 128;
  f32x4 acc[4][4];
#pragma unroll
  for (int i = 0; i < 4; ++i)
#pragma unroll
    for (int j = 0; j < 4; ++j) acc[i][j] = f32x4{0.f, 0.f, 0.f, 0.f};
  u32x4 ra[4], rb[2];
#define GLOAD(k0_)                                                                  \
  _Pragma("unroll") for (int i = 0; i < 4; ++i) {                                   \
    int c = tid + i * 512; int row = c >> 3, kc = c & 7;                            \
    ra[i] = *(const u32x4*)(A + (size_t)(m0 + row) * lda + (k0_) + kc * 8);         \
  }                                                                                 \
  _Pragma("unroll") for (int i = 0; i < 2; ++i) {                                   \
    int c = tid + i * 512; int row = c >> 3, kc = c & 7;                            \
    rb[i] = *(const u32x4*)(BT + (size_t)(n0 + row) * ldb + (k0_) + kc * 8);        \
  }
  GLOAD(0)
  for (int k0 = 0; k0 < K; k0 += 64) {
    __syncthreads();
#pragma unroll
    for (int i = 0; i < 4; ++i) { int c = tid + i * 512; int row = c >> 3, kc = c & 7; *(u32x4*)(As + row * LDS_LD + kc * 8) = ra[i]; }
#pragma unroll
    for (int i = 0; i < 2; ++i) { int c = tid + i * 512; int row = c >> 3, kc = c & 7; *(u32x4*)(Bs + row * LDS_LD + kc * 8) = rb[i]; }
    __syncthreads();
    if (k0 + 64 < K) { GLOAD(k0 + 64) }
#pragma unroll
    for (int ks = 0; ks < 2; ++ks) {
      bf16x8 a[4], b[4];
#pragma unroll
      for (int i = 0; i < 4; ++i) {
        a[i] = *(const bf16x8*)(As + (wm * 64 + i * 16 + (lane & 15)) * LDS_LD + ks * 32 + (lane >> 4) * 8);
        b[i] = *(const bf16x8*)(Bs + (wn * 64 + i * 16 + (lane & 15)) * LDS_LD + ks * 32 + (lane >> 4) * 8);
      }
#pragma unroll
      for (int i = 0; i < 4; ++i)
#pragma unroll
        for (int j = 0; j < 4; ++j) acc[i][j] = __builtin_amdgcn_mfma_f32_16x16x32_bf16(a[i], b[j], acc[i][j], 0, 0, 0);
    }
  }
  epi.tile(acc, smem, m0, n0, tn, wm, wn, wid, lane);
  __syncthreads();
}
struct EpiProjF {
  bf16_t* proj; float* gates;
  DI void operator()(int row, int col, float v) const {
    if (col < INW) proj[(size_t)row * INWP + col] = f2bf(v);
    if (col >= OFF_G && col < OFF_G + 24) gates[row * 24 + (col - OFF_G)] = 1.f / (1.f + __expf(-v));
  }
  ELEMWISE_TILE
};
struct EpiF32F {
  float* C; int ldc; int N;
  DI void operator()(int row, int col, float v) const { if (col < N) C[(size_t)row * ldc + col] = v; }
  ELEMWISE_TILE
};
struct EpiResF {
  float* C; const float* X;
  DI void operator()(int row, int col, float v) const { C[(size_t)row * DM + col] = ALPHA * X[(size_t)row * DM + col] + v; }
  ELEMWISE_TILE
};

__device__ void d_build_cmp(int row, const bf16_t* __restrict__ proj, int off, const float* __restrict__ pos, bf16_t* __restrict__ Ac) {
  int n = row >> 1, g = row & 1;
  for (int k = (threadIdx.x & 255); k < 4096; k += 256) {
    float v = 0.f;
    if (row < 2046) { int l = k >> 7, d = k & 127; v = bf2f(proj[(size_t)(16 * n + l) * INWP + off + g * 128 + d]) + pos[l * 128 + d]; }
    Ac[(size_t)row * 4096 + k] = f2bf(v);
  }
}
__device__ void d_cmp2(int row, char* smem, const float* __restrict__ hid, const float* __restrict__ b1, const float* __restrict__ w2, float* __restrict__ out) {
  float* a = (float*)smem;
  for (int j = (threadIdx.x & 255); j < 512; j += 256) a[j] = gelu_tanh(hid[(size_t)row * 512 + j] + b1[j]);
  __syncthreads();
  int d = (threadIdx.x & 255) & 127, half = (threadIdx.x & 255) >> 7;
  float s = 0.f;
  for (int j = half * 256; j < half * 256 + 256; ++j) s += a[j] * w2[j * 128 + d];
  float* red = a + 512;
  if (half) red[d] = s;
  __syncthreads();
  if (!half) out[(size_t)row * 128 + d] = s + red[d];
  __syncthreads();
}

using f32x16 = __attribute__((ext_vector_type(16))) float;
using bf16x8v = __attribute__((ext_vector_type(8))) __bf16;
using bf16x2v = __attribute__((ext_vector_type(2))) __bf16;
#define MFMA32(a, b, c) __builtin_amdgcn_mfma_f32_32x32x16_bf16((a), (b), (c), 0, 0, 0)
constexpr float LOG2E = 1.4426950408889634f;
constexpr float NEGB = -1e30f;
DI int pi_perm(int i) { return (i & ~12) | ((i & 8) >> 1) | ((i & 4) << 1); }
DI unsigned pack2(float a, float b) { bf16x2v v = {(__bf16)a, (__bf16)b}; return __builtin_bit_cast(unsigned, v); }
DI bf16x8 pack8(float a0, float a1, float a2, float a3, float a4, float a5, float a6, float a7) {
  bf16x8v v = {(__bf16)a0, (__bf16)a1, (__bf16)a2, (__bf16)a3, (__bf16)a4, (__bf16)a5, (__bf16)a6, (__bf16)a7};
  return __builtin_bit_cast(bf16x8, v);
}
__device__ void d_relayoutK_bf(size_t c, int NT, const bf16_t* __restrict__ src, int ld, int col0, bf16_t* __restrict__ dst) {
  int lane = c & 63, s = (c >> 6) & 7; size_t tt = c >> 9; int T = tt % NT, g = tt / NT;
  int i = lane & 31, h = lane >> 5;
  int tok = 32 * T + pi_perm(i);
  *(u32x4*)(dst + c * 8) = *(const u32x4*)(src + (size_t)tok * ld + col0 + g * 128 + 16 * s + 8 * h);
}
__device__ void d_relayoutV_bf(size_t c, int NT, const bf16_t* __restrict__ src, int ld, int col0, bf16_t* __restrict__ dst) {
  int lane = c & 63, s2 = (c >> 6) & 1, dt = (c >> 7) & 3; size_t tt = c >> 9; int T = tt % NT, g = tt / NT;
  int dd = lane & 31, h = lane >> 5;
  bf16_t v[8];
#pragma unroll
  for (int j = 0; j < 8; ++j) v[j] = src[(size_t)(32 * T + 16 * s2 + 8 * h + j) * ld + col0 + g * 128 + 32 * dt + dd];
  u32x4 o; o.x = v[0] | ((unsigned)v[1] << 16); o.y = v[2] | ((unsigned)v[3] << 16); o.z = v[4] | ((unsigned)v[5] << 16); o.w = v[6] | ((unsigned)v[7] << 16);
  *(u32x4*)(dst + c * 8) = o;
}
__device__ void d_relayoutK_f32(size_t c, const float* __restrict__ src, bf16_t* __restrict__ dst) {
  int lane = c & 63, s = (c >> 6) & 7; size_t tt = c >> 9; int T = tt % 32, g = tt / 32;
  int i = lane & 31, h = lane >> 5;
  int n = 32 * T + pi_perm(i);
  bf16_t v[8];
#pragma unroll
  for (int j = 0; j < 8; ++j) v[j] = (n < NCMP) ? f2bf(src[((size_t)n * 2 + g) * 128 + 16 * s + 8 * h + j]) : (bf16_t)0;
  u32x4 o; o.x = v[0] | ((unsigned)v[1] << 16); o.y = v[2] | ((unsigned)v[3] << 16); o.z = v[4] | ((unsigned)v[5] << 16); o.w = v[6] | ((unsigned)v[7] << 16);
  *(u32x4*)(dst + c * 8) = o;
}
__device__ void d_relayoutV_f32(size_t c, const float* __restrict__ src, bf16_t* __restrict__ dst) {
  int lane = c & 63, s2 = (c >> 6) & 1, dt = (c >> 7) & 3; size_t tt = c >> 9; int T = tt % 32, g = tt / 32;
  int dd = lane & 31, h = lane >> 5;
  bf16_t v[8];
#pragma unroll
  for (int j = 0; j < 8; ++j) { int n = 32 * T + 16 * s2 + 8 * h + j; v[j] = (n < NCMP) ? f2bf(src[((size_t)n * 2 + g) * 128 + 32 * dt + dd]) : (bf16_t)0; }
  u32x4 o; o.x = v[0] | ((unsigned)v[1] << 16); o.y = v[2] | ((unsigned)v[3] << 16); o.z = v[4] | ((unsigned)v[5] << 16); o.w = v[6] | ((unsigned)v[7] << 16);
  *(u32x4*)(dst + c * 8) = o;
}

struct AttnPtrs {
  const bf16_t* proj; const float* gates;
  const bf16_t *kcf, *vcf, *ksf, *vsf, *kwf, *vwf;
  float* oatt;
};

DI f32x16 qk_tile(const bf16_t* __restrict__ kt, const bf16_t* qL, int lane) {
  f32x16 acc;
#pragma unroll
  for (int i = 0; i < 16; ++i) acc[i] = 0.f;
  const bf16_t* qp = qL + (lane & 31) * 136 + 8 * (lane >> 5);
#pragma unroll
  for (int s = 0; s < 8; ++s) {
    bf16x8 kf = *(const bf16x8*)(kt + s * 512 + lane * 8);
    bf16x8 qf = *(const bf16x8*)(qp + 16 * s);
    acc = MFMA32(kf, qf, acc);
  }
  return acc;
}
DI void pv_tile(const bf16_t* __restrict__ vt, const float (&p)[16], f32x16 (&O)[4], int lane) {
  bf16x8 pf0 = pack8(p[0], p[1], p[2], p[3], p[4], p[5], p[6], p[7]);
  bf16x8 pf1 = pack8(p[8], p[9], p[10], p[11], p[12], p[13], p[14], p[15]);
#pragma unroll
  for (int dt = 0; dt < 4; ++dt) {
    bf16x8 v0 = *(const bf16x8*)(vt + (dt * 2 + 0) * 512 + lane * 8);
    bf16x8 v1 = *(const bf16x8*)(vt + (dt * 2 + 1) * 512 + lane * 8);
    O[dt] = MFMA32(v0, pf0, O[dt]);
    O[dt] = MFMA32(v1, pf1, O[dt]);
  }
}
DI void osm_step(const float (&sv)[16], unsigned vmask, float& m, float& l, f32x16 (&O)[4], float (&p)[16]) {
  float tmax = NEGB;
#pragma unroll
  for (int r = 0; r < 16; ++r) tmax = fmaxf(tmax, sv[r]);
  tmax = fmaxf(tmax, __shfl_xor(tmax, 32));
  float mn = fmaxf(m, tmax);
  float alpha = exp2f(m - mn);
  float ps = 0.f;
#pragma unroll
  for (int r = 0; r < 16; ++r) { float e = ((vmask >> r) & 1u) ? exp2f(sv[r] - mn) : 0.f; p[r] = e; ps += e; }
  l = l * alpha + ps;
  m = mn;
  if (__ballot(alpha < 1.f)) {
#pragma unroll
    for (int dt = 0; dt < 4; ++dt)
#pragma unroll
      for (int r = 0; r < 16; ++r) O[dt][r] *= alpha;
  }
}
DI void ot_store(char* otL, int lane, const f32x16 (&O)[4], float sc) {
#pragma unroll
  for (int dt = 0; dt < 4; ++dt) {
    u32x4 a, b;
#pragma unroll
    for (int i = 0; i < 4; ++i) { a[i] = pack2(sc * O[dt][2 * i], sc * O[dt][2 * i + 1]); b[i] = pack2(sc * O[dt][8 + 2 * i], sc * O[dt][8 + 2 * i + 1]); }
    *(u32x4*)(otL + lane * 128 + dt * 32) = a;
    *(u32x4*)(otL + lane * 128 + dt * 32 + 16) = b;
  }
}
DI void ot_accum(const char* otL, int lane, f32x16 (&O)[4], float sc) {
#pragma unroll
  for (int dt = 0; dt < 4; ++dt) {
    u32x4 a = *(const u32x4*)(otL + lane * 128 + dt * 32);
    u32x4 b = *(const u32x4*)(otL + lane * 128 + dt * 32 + 16);
#pragma unroll
    for (int i = 0; i < 4; ++i) {
      const unsigned wa = a[i], wb = b[i];
      O[dt][2 * i] = fmaf(sc, O[dt][2 * i], __uint_as_float(wa << 16));
      O[dt][2 * i + 1] = fmaf(sc, O[dt][2 * i + 1], __uint_as_float(wa & 0xFFFF0000u));
      O[dt][8 + 2 * i] = fmaf(sc, O[dt][8 + 2 * i], __uint_as_float(wb << 16));
      O[dt][8 + 2 * i + 1] = fmaf(sc, O[dt][8 + 2 * i + 1], __uint_as_float(wb & 0xFFFF0000u));
    }
  }
}
DI void zero_o(f32x16 (&O)[4]) {
#pragma unroll
  for (int dt = 0; dt < 4; ++dt)
#pragma unroll
    for (int i = 0; i < 16; ++i) O[dt][i] = 0.f;
}

constexpr int ATT_WSM = 17408;
__device__ __noinline__ void d_select(const float* impL, unsigned* mskL, unsigned* uniL, int cur) {
  const int lane = threadIdx.x & 63;
  const int stok = lane >> 3, sub = lane & 7;
  unsigned key[32];
#pragma unroll
  for (int i4 = 0; i4 < 8; ++i4) {
    f32x4 v = *(const f32x4*)(impL + stok * 256 + sub * 32 + i4 * 4);
#pragma unroll
    for (int e = 0; e < 4; ++e) {
      const int j = sub * 32 + i4 * 4 + e;
      const bool valid = j <= cur;
      const bool forced = (j == 0) || (j == cur) || (j == cur - 1);
      unsigned kb = forced ? 0xFFFFFF00u : (__float_as_uint(v[e]) & 0xFFFFFF00u);
      key[i4 * 4 + e] = valid ? (kb | (unsigned)(255 - j)) : 0u;
    }
  }
#pragma unroll
  for (int k = 2; k <= 32; k <<= 1) {
#pragma unroll
    for (int jj = k >> 1; jj > 0; jj >>= 1) {
#pragma unroll
      for (int i = 0; i < 32; ++i) {
        const int l2 = i ^ jj;
        if (l2 > i) {
          const bool desc = ((i & k) == 0);
          unsigned a = key[i], b = key[l2];
          unsigned mx = a > b ? a : b, mn = a > b ? b : a;
          key[i] = desc ? mx : mn; key[l2] = desc ? mn : mx;
        }
      }
    }
  }
#pragma unroll
  for (int xm = 1; xm < 8; xm <<= 1) {
    unsigned L[16];
#pragma unroll
    for (int i = 0; i < 16; ++i) { unsigned o = (unsigned)__shfl_xor((int)key[15 - i], xm); L[i] = key[i] > o ? key[i] : o; }
#pragma unroll
    for (int jj = 8; jj > 0; jj >>= 1) {
#pragma unroll
      for (int i = 0; i < 16; ++i) {
        const int l2 = i ^ jj;
        if (l2 > i) { unsigned a = L[i], b = L[l2]; L[i] = a > b ? a : b; L[l2] = a > b ? b : a; }
      }
    }
#pragma unroll
    for (int i = 0; i < 16; ++i) key[i] = L[i];
  }
#pragma unroll
  for (int i = 0; i < 16; ++i) {
    if ((i & 7) == sub) {
      const int j = 255 - (int)(key[i] & 255u);
      if (j <= cur) { atomicOr(&mskL[stok * 8 + (j >> 5)], 1u << (j & 31)); atomicOr(&uniL[j >> 5], 1u << (j & 31)); }
    }
  }
}

__device__ void d_attn_wave(int item, char* wsm, const AttnPtrs& P) {
  const int lane = threadIdx.x & 63;
  const int g = item & 1, tok0 = (item >> 1) * 8;
  const int c = lane & 31, h = lane >> 5, tokl = c >> 2, r = c & 3;
  const int t = tok0 + tokl, hd = g * 4 + r;
  const float slope2 = exp2f(-(float)(hd + 1)) * LOG2E;
  const float c1 = QSCALE * LOG2E;
  float* impL = (float*)wsm;
  char* otL = wsm;
  bf16_t* qL = (bf16_t*)(wsm + 8192);
  unsigned* mskL = (unsigned*)(wsm + 8192 + 8704);
  unsigned* uniL = mskL + 64;
  {
#pragma unroll
    for (int i = 0; i < 8; ++i) {
      const int id = i * 64 + lane, row = id >> 4, ch = id & 15;
      u32x4 v = *(const u32x4*)(P.proj + (size_t)(tok0 + (row >> 2)) * INWP + OFF_Q + (g * 4 + (row & 3)) * 128 + ch * 8);
      *(u32x4*)(qL + row * 136 + ch * 8) = v;
    }
    u32x4 z = {0u, 0u, 0u, 0u};
#pragma unroll
    for (int i = 0; i < 8; ++i) *(u32x4*)(wsm + (i * 64 + lane) * 16) = z;
    if (lane < 18) *(u32x4*)(wsm + 8192 + 8704 + lane * 16) = z;
  }
  const float* gt = P.gates + (size_t)t * 24 + hd * 3;
  const float g0 = gt[0], g1 = gt[1], g2 = gt[2];
  f32x16 Ob[4];
  zero_o(Ob);
  {
    const int nmax = (t >= 31) ? ((t - 31) >> 4) : -1;
    const int nmaxw = (tok0 + 7 >= 31) ? ((tok0 + 7 - 31) >> 4) : -1;
    const int ntc = (nmaxw + 32) >> 5;
    const bf16_t* kcf = P.kcf + (size_t)g * 32 * 4096;
    const bf16_t* vcf = P.vcf + (size_t)g * 32 * 4096;
    float mC = NEGB, lC = 0.f;
    const float sl16 = slope2 * 16.f;
    for (int T = ntc - 1; T >= 0; --T) {
      f32x16 acc = qk_tile(kcf + (size_t)T * 4096, qL, lane);
      const float base = slope2 * (float)(512 * T + 128 * h) + slope2 * (15.5f - (float)t);
      const int nb = 32 * T + 8 * h;
      float tmax = NEGB; float sv[16];
#pragma unroll
      for (int rg = 0; rg < 16; ++rg) {
        const int kk = (rg & 7) + 16 * (rg >> 3);
        float v = fmaf(acc[rg], c1, fmaf(sl16, (float)kk, base));
        v = (nb + kk <= nmax) ? v : NEGB;
        sv[rg] = v; tmax = fmaxf(tmax, v);
      }
      tmax = fmaxf(tmax, __shfl_xor(tmax, 32));
      float mn = fmaxf(mC, tmax);
      float ps = 0.f;
#pragma unroll
      for (int rg = 0; rg < 16; ++rg) { const int kk = (rg & 7) + 16 * (rg >> 3); ps += (nb + kk <= nmax) ? exp2f(sv[rg] - mn) : 0.f; }
      lC = lC * exp2f(mC - mn) + ps; mC = mn;
    }
    lC += __shfl_xor(lC, 32);
    const float invC = (lC > 0.f) ? 1.f / lC : 0.f;
    float carry = 0.f;
    for (int T = 0; T < ntc; ++T) {
      f32x16 acc = qk_tile(kcf + (size_t)T * 4096, qL, lane);
      const float base = slope2 * (float)(512 * T + 128 * h) + slope2 * (15.5f - (float)t);
      const int nb = 32 * T + 8 * h;
      float p[16];
#pragma unroll
      for (int rg = 0; rg < 16; ++rg) {
        const int kk = (rg & 7) + 16 * (rg >> 3);
        float v = fmaf(acc[rg], c1, fmaf(sl16, (float)kk, base));
        p[rg] = (nb + kk <= nmax) ? exp2f(v - mC) * invC : 0.f;
      }
      float Ga = (p[0] + p[1]) + (p[2] + p[3]), Gb = (p[4] + p[5]) + (p[6] + p[7]);
      float Gc = (p[8] + p[9]) + (p[10] + p[11]), Gd = (p[12] + p[13]) + (p[14] + p[15]);
      float xb = __shfl_xor(p[7], 32), xd = __shfl_xor(p[15], 32);
      float ia = Ga + (h ? xb : carry);
      float ib = Gb + p[3];
      float ic = Gc + (h ? xd : xb);
      float id = Gd + p[11];
      carry = xd;
      ia += __shfl_xor(ia, 1); ia += __shfl_xor(ia, 2);
      ib += __shfl_xor(ib, 1); ib += __shfl_xor(ib, 2);
      ic += __shfl_xor(ic, 1); ic += __shfl_xor(ic, 2);
      id += __shfl_xor(id, 1); id += __shfl_xor(id, 2);
      {
        float val = (r == 0) ? ia : (r == 1) ? ib : (r == 2) ? ic : id;
        int j = 8 * T + 2 * h + ((r == 0) ? 0 : (r == 1) ? 1 : (r == 2) ? 4 : 5);
        impL[tokl * 256 + j] = val;
      }
      pv_tile(vcf + (size_t)T * 4096, p, Ob, lane);
    }
  }
  const int cur = tok0 >> 6;
  d_select(impL, mskL, uniL, cur);
  ot_store(otL, lane, Ob, g0);
  zero_o(Ob);
  {
    const bf16_t* ksf = P.ksf + (size_t)g * 512 * 4096;
    const bf16_t* vsf = P.vsf + (size_t)g * 512 * 4096;
    float m = NEGB, l = 0.f;
    for (int w = 7; w >= 0; --w) {
      unsigned uw = __builtin_amdgcn_readfirstlane(uniL[w]);
      while (uw) {
        const int bit = 31 - __builtin_clz(uw);
        uw &= ~(1u << bit);
        const int b = 32 * w + bit;
        const bool mine = (mskL[tokl * 8 + w] >> bit) & 1u;
        for (int half = 1; half >= 0; --half) {
          const int T = 2 * b + half;
          const int pos0 = 32 * T;
          if (pos0 > tok0 + 7) continue;
          f32x16 acc = qk_tile(ksf + (size_t)T * 4096, qL, lane);
          const float base = slope2 * (float)(pos0 + 8 * h - t);
          const int pb = pos0 + 8 * h;
          float sv[16]; unsigned vm = 0;
#pragma unroll
          for (int rg = 0; rg < 16; ++rg) {
            const int kk = (rg & 7) + 16 * (rg >> 3);
            const bool ok = mine && (pb + kk <= t);
            float v = fmaf(acc[rg], c1, fmaf(slope2, (float)kk, base));
            sv[rg] = ok ? v : NEGB; vm |= ok ? (1u << rg) : 0u;
          }
          float p[16];
          osm_step(sv, vm, m, l, Ob, p);
          pv_tile(vsf + (size_t)T * 4096, p, Ob, lane);
        }
      }
    }
    l += __shfl_xor(l, 32);
    const float inv = (l > 0.f) ? g1 / l : 0.f;
    ot_accum(otL, lane, Ob, inv);
    ot_store(otL, lane, Ob, 1.f);
    zero_o(Ob);
  }
  {
    const bf16_t* kwf = P.kwf + (size_t)g * 512 * 4096;
    const bf16_t* vwf = P.vwf + (size_t)g * 512 * 4096;
    float m = NEGB, l = 0.f;
    const int plo = tok0 - 511 > 0 ? tok0 - 511 : 0;
    const int Tlo = plo >> 5, Thi = (tok0 + 7) >> 5;
    for (int T = Thi; T >= Tlo; --T) {
      const int pos0 = 32 * T;
      f32x16 acc = qk_tile(kwf + (size_t)T * 4096, qL, lane);
      const float base = slope2 * (float)(pos0 + 8 * h - t);
      const int pb = pos0 + 8 * h;
      float sv[16]; unsigned vm = 0;
#pragma unroll
      for (int rg = 0; rg < 16; ++rg) {
        const int kk = (rg & 7) + 16 * (rg >> 3);
        const int dw = t - (pb + kk);
        const bool ok = (dw >= 0) && (dw < 512);
        float v = fmaf(acc[rg], c1, fmaf(slope2, (float)kk, base));
        sv[rg] = ok ? v : NEGB; vm |= ok ? (1u << rg) : 0u;
      }
      float p[16];
      osm_step(sv, vm, m, l, Ob, p);
      pv_tile(vwf + (size_t)T * 4096, p, Ob, lane);
    }
    l += __shfl_xor(l, 32);
    const float inv = (l > 0.f) ? g2 / l : 0.f;
    ot_accum(otL, lane, Ob, inv);
  }
  {
    float* orow = P.oatt + (size_t)t * 1024 + hd * 128;
#pragma unroll
    for (int dt = 0; dt < 4; ++dt)
#pragma unroll
      for (int a = 0; a < 4; ++a) {
        f32x4 v = {Ob[dt][4 * a], Ob[dt][4 * a + 1], Ob[dt][4 * a + 2], Ob[dt][4 * a + 3]};
        *(f32x4*)(orow + 32 * dt + 8 * a + 4 * h) = v;
      }
  }
}

__device__ void d_mix(int t, const bf16_t* __restrict__ proj, const float* __restrict__ oatt, const float* __restrict__ convw,
                      const float* __restrict__ hng, bf16_t* __restrict__ mix) {
  const int tid = (threadIdx.x & 255);
  float v[8];
  const int c0 = tid * 8;
  if (c0 < 1024) {
    for (int i = 0; i < 8; ++i) v[i] = oatt[(size_t)t * 1024 + c0 + i];
  } else {
    int c = c0 - 1024;
    for (int i = 0; i < 8; ++i) {
      float acc = 0.f;
      for (int j = 0; j < 3; ++j) {
        int tt = t - 2 + j;
        if (tt >= 0) {
          const bf16_t* pr = proj + (size_t)tt * INWP;
          acc += convw[j * 1024 + c + i] * bf2f(pr[OFF_C + c + i]) * bf2f(pr[OFF_U + c + i]);
        }
      }
      v[i] = acc * bf2f(proj[(size_t)t * INWP + OFF_B + c + i]);
    }
  }
  float ss = 0.f;
  for (int i = 0; i < 8; ++i) ss += v[i] * v[i];
  for (int o = 8; o > 0; o >>= 1) ss += __shfl_xor(ss, o);
  float rs = rsqrtf(ss * (1.f / 128.f) + 1e-6f);
  for (int i = 0; i < 8; ++i) mix[(size_t)t * DM + c0 + i] = f2bf(v[i] * rs * hng[c0 + i]);
}

__device__ void d_ln(int t, char* smem, const float* __restrict__ y, const float* __restrict__ gam, const float* __restrict__ bet,
                     float* __restrict__ hf, bf16_t* __restrict__ hb) {
  float* red = (float*)smem;
  const int tid = (threadIdx.x & 255);
  float v[8]; float s = 0.f;
  for (int i = 0; i < 8; ++i) { v[i] = y[(size_t)t * DM + tid + i * 256]; s += v[i]; }
  s = wave_sum(s); if ((tid & 63) == 0) red[tid >> 6] = s; __syncthreads();
  float mu = (red[0] + red[1] + red[2] + red[3]) * (1.f / DM);
  float q = 0.f; for (int i = 0; i < 8; ++i) { float d = v[i] - mu; q += d * d; }
  q = wave_sum(q); if ((tid & 63) == 0) red[4 + (tid >> 6)] = q; __syncthreads();
  float var = (red[4] + red[5] + red[6] + red[7]) * (1.f / DM);
  float rs = rsqrtf(var + 1e-5f);
  for (int i = 0; i < 8; ++i) {
    int c = tid + i * 256; float o = (v[i] - mu) * rs * gam[c] + bet[c];
    if (hf) hf[(size_t)t * DM + c] = o;
    if (hb) hb[(size_t)t * DM + c] = f2bf(o);
  }
  __syncthreads();
}


DI unsigned f2sort(float f) { unsigned u = __float_as_uint(f); return u ^ ((unsigned)((int)u >> 31) | 0x80000000u); }
DI float sort2f(unsigned k) { unsigned u = (k & 0x80000000u) ? (k ^ 0x80000000u) : ~k; return __uint_as_float(u); }
template <int N>
DI void bitonic_sort_desc(unsigned (&key)[N]) {
#pragma unroll
  for (int k = 2; k <= N; k <<= 1) {
#pragma unroll
    for (int jj = k >> 1; jj > 0; jj >>= 1) {
#pragma unroll
      for (int i = 0; i < N; ++i) {
        const int l2 = i ^ jj;
        if (l2 > i) {
          const bool desc = ((i & k) == 0);
          unsigned a = key[i], b = key[l2];
          unsigned mx = a > b ? a : b, mn = a > b ? b : a;
          key[i] = desc ? mx : mn; key[l2] = desc ? mn : mx;
        }
      }
    }
  }
}
DI void merge_top16(unsigned (&a)[16], const unsigned (&b)[16]) {
#pragma unroll
  for (int i = 0; i < 16; ++i) { unsigned o = b[15 - i]; a[i] = a[i] > o ? a[i] : o; }
#pragma unroll
  for (int jj = 8; jj > 0; jj >>= 1) {
#pragma unroll
    for (int i = 0; i < 16; ++i) {
      const int l2 = i ^ jj;
      if (l2 > i) { unsigned x = a[i], y = a[l2]; a[i] = x > y ? x : y; a[l2] = x > y ? y : x; }
    }
  }
}
__device__ void d_cvt_subk(size_t c, const float* __restrict__ subk, bf16_t* __restrict__ skf) {
  int lane = c & 63, s = (c >> 6) & 7, kt = (c >> 9) & 3, hc = c >> 11;
  int i = lane & 31, h = lane >> 5;
  const float* src = subk + ((size_t)hc * 128 + 32 * kt + i) * 128 + 16 * s + 8 * h;
  bf16_t v[8];
#pragma unroll
  for (int j = 0; j < 8; ++j) v[j] = f2bf(src[j]);
  u32x4 o; o.x = v[0] | ((unsigned)v[1] << 16); o.y = v[2] | ((unsigned)v[3] << 16); o.z = v[4] | ((unsigned)v[5] << 16); o.w = v[6] | ((unsigned)v[7] << 16);
  *(u32x4*)(skf + c * 8) = o;
}
struct EpiRouteF {
  const bf16_t* skf; unsigned* tops;
  DI void tile(f32x4 (&acc)[4][4], char* smem, int m0, int n0, int tn, int wm, int wn, int wid, int lane) const {
    bf16_t* Qs = (bf16_t*)smem;
    __syncthreads();
#pragma unroll
    for (int i = 0; i < 4; ++i)
#pragma unroll
      for (int j = 0; j < 4; ++j)
#pragma unroll
        for (int r = 0; r < 4; ++r) {
          int row = wm * 64 + i * 16 + (lane >> 4) * 4 + r;
          int col = wn * 64 + j * 16 + (lane & 15);
          Qs[row * 136 + col] = f2bf(acc[i][j][r]);
        }
    __syncthreads();
    const int c = lane & 31, h = lane >> 5;
    const bf16_t* sk = skf + (size_t)tn * 4 * 4096;
    const bf16_t* qp = Qs + (wid * 32 + c) * 136 + 8 * h;
    unsigned k0[16], k1[16], k2[16], k3[16];
#define ROUTE_KT(KT, KA)                                                                        \
    {                                                                                           \
      f32x16 sc;                                                                                \
      _Pragma("unroll") for (int i = 0; i < 16; ++i) sc[i] = 0.f;                               \
      _Pragma("unroll") for (int s = 0; s < 8; ++s) {                                           \
        bf16x8 af = *(const bf16x8*)(sk + (KT) * 4096 + s * 512 + lane * 8);                    \
        bf16x8 bq = *(const bf16x8*)(qp + 16 * s);                                              \
        sc = __builtin_amdgcn_mfma_f32_32x32x16_bf16(af, bq, sc, 0, 0, 0);                      \
      }                                                                                         \
      _Pragma("unroll") for (int rg = 0; rg < 16; ++rg) {                                       \
        const int kidx = 32 * (KT) + (rg & 3) + 8 * (rg >> 2) + 4 * h;                          \
        KA[rg] = (f2sort(sc[rg]) & 0xFFFFFF80u) | (unsigned)(127 - kidx);                       \
      }                                                                                         \
      bitonic_sort_desc<16>(KA);                                                                \
    }
    ROUTE_KT(0, k0) ROUTE_KT(1, k1)
    merge_top16(k0, k1);
    ROUTE_KT(2, k2) ROUTE_KT(3, k3)
    merge_top16(k2, k3);
    merge_top16(k0, k2);
#undef ROUTE_KT
#pragma unroll
    for (int i = 0; i < 16; ++i) k1[i] = (unsigned)__shfl_xor((int)k0[i], 32);
    merge_top16(k0, k1);
    if (h == 0) {
      unsigned* dst = tops + ((size_t)(m0 + wid * 32 + c) * 16 + tn) * 16;
#pragma unroll
      for (int q4 = 0; q4 < 4; ++q4) { u32x4 o = {k0[4 * q4], k0[4 * q4 + 1], k0[4 * q4 + 2], k0[4 * q4 + 3]}; *(u32x4*)(dst + 4 * q4) = o; }
    }
  }
};

typedef float v2f __attribute__((ext_vector_type(2)));
__device__ void d_cvt_fp8_row(int row, const float* __restrict__ src, unsigned char* __restrict__ dst, float* __restrict__ scale) {
  const int lane = threadIdx.x & 63;
  float v[32]; float amax = 0.f;
#pragma unroll
  for (int q = 0; q < 2; ++q)
#pragma unroll
    for (int i = 0; i < 4; ++i) {
      f32x4 x = *(const f32x4*)(src + (size_t)row * DM + 1024 * q + 16 * lane + 4 * i);
#pragma unroll
      for (int j = 0; j < 4; ++j) { v[q * 16 + i * 4 + j] = x[j]; amax = fmaxf(amax, fabsf(x[j])); }
    }
  amax = wave_max(amax);
  const float sc = amax > 0.f ? amax * (1.f / 448.f) : 1.f;
  const float inv = 1.f / sc;
#pragma unroll
  for (int q = 0; q < 2; ++q) {
    u32x4 o;
#pragma unroll
    for (int i = 0; i < 4; ++i) {
      int w = __builtin_amdgcn_cvt_pk_fp8_f32(v[q * 16 + i * 4] * inv, v[q * 16 + i * 4 + 1] * inv, 0, false);
      w = __builtin_amdgcn_cvt_pk_fp8_f32(v[q * 16 + i * 4 + 2] * inv, v[q * 16 + i * 4 + 3] * inv, w, true);
      o[i] = (unsigned)w;
    }
    *(u32x4*)(dst + (size_t)row * DM + 1024 * q + 16 * lane) = o;
  }
  if (lane == 0) scale[row] = sc;
}
__device__ void d_expert_wave(int t, const float* __restrict__ hf, const unsigned* __restrict__ tops,
                              const unsigned char* __restrict__ eu8, const unsigned char* __restrict__ ev8, const float* __restrict__ su,
                              const float* __restrict__ sv, const float* __restrict__ gam,
                              const float* __restrict__ bet, float* __restrict__ out) {
  const int lane = threadIdx.x & 63;
  float hv[32];
#pragma unroll
  for (int q = 0; q < 2; ++q)
#pragma unroll
    for (int i = 0; i < 4; ++i) {
      f32x4 x = *(const f32x4*)(hf + (size_t)t * DM + 1024 * q + 16 * lane + 4 * i);
#pragma unroll
      for (int j = 0; j < 4; ++j) hv[q * 16 + i * 4 + j] = x[j];
    }
  int e0 = 0, e1 = 0; float w0 = 0.f, w1 = 0.f;
  {
    const int ci = (lane < 16) ? 0 : (lane < 24) ? 1 : (lane < 29) ? 2 : (lane < 33) ? 3 : (lane < 36) ? 4 : (lane < 38) ? 5 : (lane < 40) ? 6
                   : (lane < 42) ? 7 : (lane - 34);
    const int cpre = (ci == 0) ? 0 : (ci == 1) ? 16 : (ci == 2) ? 24 : (ci == 3) ? 29 : (ci == 4) ? 33 : (ci == 5) ? 36 : (ci == 6) ? 38
                     : (ci == 7) ? 40 : (34 + ci);
    const int cj = lane - cpre;
    const bool cvalid = lane < 50;
    const unsigned* tp = tops + (size_t)t * 256;
#pragma unroll 1
    for (int hh = 0; hh < 8; ++hh) {
      unsigned key = 0u;
      if (cvalid) {
        const float sa = sort2f(tp[(2 * hh) * 16 + ci]), sb = sort2f(tp[(2 * hh + 1) * 16 + cj]);
        key = (f2sort(sa + sb) & 0xFFFFFF00u) | (unsigned)(255 - (ci * 16 + cj));
      }
#pragma unroll
      for (int k = 2; k <= 64; k <<= 1) {
#pragma unroll
        for (int jj = k >> 1; jj > 0; jj >>= 1) {
          const unsigned o = (unsigned)__shfl_xor((int)key, jj);
          const bool lower = (lane & jj) == 0;
          const bool desc = (lane & k) == 0 || k == 64;
          const unsigned mx = key > o ? key : o, mn = key > o ? o : key;
          key = (lower == desc) ? mx : mn;
        }
      }
      const int flat = 255 - (int)(key & 255u);
      const int bi = (flat >> 4) & 15, bj = flat & 15;
      const unsigned ka = tp[(2 * hh) * 16 + bi], kb = tp[(2 * hh + 1) * 16 + bj];
      const float sc = sort2f(ka) + sort2f(kb);
      const int ex = (127 - (int)(ka & 127u)) * 128 + (127 - (int)(kb & 127u));
      float mx = sc;
      mx = fmaxf(mx, __shfl_xor(mx, 1)); mx = fmaxf(mx, __shfl_xor(mx, 2)); mx = fmaxf(mx, __shfl_xor(mx, 4)); mx = fmaxf(mx, __shfl_xor(mx, 8));
      const float ev_ = __expf(sc - mx);
      float sm = ev_;
      sm += __shfl_xor(sm, 1); sm += __shfl_xor(sm, 2); sm += __shfl_xor(sm, 4); sm += __shfl_xor(sm, 8);
      const float gv = ev_ / sm;
      const int exs = __shfl(ex, lane & 15); const float gvs = __shfl(gv, lane & 15);
      if ((lane >> 4) == (hh & 3)) { if (hh < 4) { e0 = exs; w0 = gvs; } else { e1 = exs; w1 = gvs; } }
    }
  }
  const float su0 = su[e0], su1 = su[e1], sv0 = sv[e0], sv1 = sv[e1];
  float c0 = 0.f, c1 = 0.f;
#pragma unroll 1
  for (int eb = 0; eb < 128; eb += 8) {
    u32x4 rr[8][2];
#pragma unroll
    for (int k = 0; k < 8; ++k) {
      const int e = eb + k;
      const int id = __shfl((e < 64) ? e0 : e1, e & 63);
      const unsigned char* row = eu8 + (size_t)id * DM + 16 * lane;
      rr[k][0] = *(const u32x4*)(row);
      rr[k][1] = *(const u32x4*)(row + 1024);
    }
#pragma unroll
    for (int k = 0; k < 8; ++k) {
      float a = 0.f;
#pragma unroll
      for (int q = 0; q < 2; ++q)
#pragma unroll
        for (int i = 0; i < 4; ++i) {
          const int w = (int)rr[k][q][i];
          v2f lo = __builtin_amdgcn_cvt_pk_f32_fp8(w, false), hi = __builtin_amdgcn_cvt_pk_f32_fp8(w, true);
          a = fmaf(lo.x, hv[q * 16 + i * 4], a); a = fmaf(lo.y, hv[q * 16 + i * 4 + 1], a);
          a = fmaf(hi.x, hv[q * 16 + i * 4 + 2], a); a = fmaf(hi.y, hv[q * 16 + i * 4 + 3], a);
        }
      a = wave_sum(a);
      const int e = eb + k;
      if (e < 64) { if (lane == e) c0 = w0 * sv0 * gelu_tanh(a * su0); } else { if (lane == e - 64) c1 = w1 * sv1 * gelu_tanh(a * su1); }
      __builtin_amdgcn_sched_barrier(0);
    }
  }
  float acc[32];
#pragma unroll
  for (int i = 0; i < 32; ++i) acc[i] = 0.f;
#pragma unroll 1
  for (int eb = 0; eb < 128; eb += 8) {
    u32x4 rr[8][2]; float cc[8];
#pragma unroll
    for (int k = 0; k < 8; ++k) {
      const int e = eb + k;
      const int id = __shfl((e < 64) ? e0 : e1, e & 63);
      cc[k] = __shfl((e < 64) ? c0 : c1, e & 63);
      const unsigned char* row = ev8 + (size_t)id * DM + 16 * lane;
      rr[k][0] = *(const u32x4*)(row);
      rr[k][1] = *(const u32x4*)(row + 1024);
    }
#pragma unroll
    for (int k = 0; k < 8; ++k) {
#pragma unroll
      for (int q = 0; q < 2; ++q)
#pragma unroll
        for (int i = 0; i < 4; ++i) {
          const int w = (int)rr[k][q][i];
          v2f lo = __builtin_amdgcn_cvt_pk_f32_fp8(w, false), hi = __builtin_amdgcn_cvt_pk_f32_fp8(w, true);
          acc[q * 16 + i * 4] = fmaf(cc[k], lo.x, acc[q * 16 + i * 4]);
          acc[q * 16 + i * 4 + 1] = fmaf(cc[k], lo.y, acc[q * 16 + i * 4 + 1]);
          acc[q * 16 + i * 4 + 2] = fmaf(cc[k], hi.x, acc[q * 16 + i * 4 + 2]);
          acc[q * 16 + i * 4 + 3] = fmaf(cc[k], hi.y, acc[q * 16 + i * 4 + 3]);
        }
      __builtin_amdgcn_sched_barrier(0);
    }
  }
  int le = lane;
  asm volatile("" : "+v"(le) :: "memory");
  float s = 0.f;
#pragma unroll
  for (int q = 0; q < 2; ++q)
#pragma unroll
    for (int i = 0; i < 4; ++i) {
      f32x4 x = *(const f32x4*)(hf + (size_t)t * DM + 1024 * q + 16 * le + 4 * i);
#pragma unroll
      for (int j = 0; j < 4; ++j) { acc[q * 16 + i * 4 + j] = fmaf(ALPHA, x[j], acc[q * 16 + i * 4 + j]); s += acc[q * 16 + i * 4 + j]; }
    }
  s = wave_sum(s);
  const float mu = s * (1.f / DM);
  float qv = 0.f;
#pragma unroll
  for (int i = 0; i < 32; ++i) { const float d = acc[i] - mu; qv += d * d; }
  qv = wave_sum(qv);
  const float rs = rsqrtf(qv * (1.f / DM) + 1e-5f);
#pragma unroll
  for (int q = 0; q < 2; ++q)
#pragma unroll
    for (int i = 0; i < 4; ++i) {
      const int cbase = 1024 * q + 16 * le + 4 * i;
      f32x4 ga = *(const f32x4*)(gam + cbase), ba = *(const f32x4*)(bet + cbase), o;
#pragma unroll
      for (int j = 0; j < 4; ++j) o[j] = (acc[q * 16 + i * 4 + j] - mu) * rs * ga[j] + ba[j];
      *(f32x4*)(out + (size_t)t * DM + cbase) = o;
    }
}

constexpr size_t al256(size_t x) { return (x + 255) & ~(size_t)255; }
constexpr size_t WS_XB = 0;
constexpr size_t WS_PROJ = WS_XB + al256((size_t)S * DM * 2);
constexpr size_t WS_WINT = WS_PROJ + al256((size_t)S * INWP * 2);
constexpr size_t WS_GATES = WS_WINT + al256((size_t)INWP * DM * 2);
constexpr size_t WS_W1KT = WS_GATES + al256((size_t)S * 24 * 4);
constexpr size_t WS_W1VT = WS_W1KT + al256((size_t)512 * 4096 * 2);
constexpr size_t WS_ACMPK = WS_W1VT + al256((size_t)512 * 4096 * 2);
constexpr size_t WS_ACMPV = WS_ACMPK + al256((size_t)2048 * 4096 * 2);
constexpr size_t WS_HIDK = WS_ACMPV + al256((size_t)2048 * 4096 * 2);
constexpr size_t WS_HIDV = WS_HIDK + al256((size_t)2048 * 512 * 4);
constexpr size_t WS_KC = WS_HIDV + al256((size_t)2048 * 512 * 4);
constexpr size_t WS_VC = WS_KC + al256((size_t)2048 * 128 * 4);
constexpr size_t WS_KCF = WS_VC + al256((size_t)2048 * 128 * 4);
constexpr size_t WS_VCF = WS_KCF + al256((size_t)2 * 32 * 4096 * 2);
constexpr size_t WS_KSF = WS_VCF + al256((size_t)2 * 32 * 4096 * 2);
constexpr size_t WS_VSF = WS_KSF + al256((size_t)2 * 512 * 4096 * 2);
constexpr size_t WS_KWF = WS_VSF + al256((size_t)2 * 512 * 4096 * 2);
constexpr size_t WS_VWF = WS_KWF + al256((size_t)2 * 512 * 4096 * 2);
constexpr size_t WS_ENDA = WS_VWF + al256((size_t)2 * 512 * 4096 * 2);
constexpr size_t WS_OATT = WS_ENDA;
constexpr size_t WS_MIX = WS_OATT + al256((size_t)S * 1024 * 4);
constexpr size_t WS_WOUTT = WS_MIX + al256((size_t)S * DM * 2);
constexpr size_t WS_WQT = WS_WOUTT + al256((size_t)DM * DM * 2);
constexpr size_t WS_TOPS = WS_WQT + al256((size_t)DM * DM * 2);
constexpr size_t WS_SKF = WS_TOPS + al256((size_t)S * 256 * 4);
constexpr size_t WS_END = WS_SKF + al256((size_t)16 * 128 * 128 * 2);
constexpr size_t WS_Y = WS_PROJ;
constexpr size_t WS_HB = WS_XB;
constexpr size_t WS_EU8 = WS_Y + (size_t)S * DM * 4;
constexpr size_t WS_EV8 = WS_EU8 + (size_t)16384 * DM;
constexpr size_t WS_SU = WS_EV8 + (size_t)16384 * DM;
constexpr size_t WS_SV = WS_SU + 16384 * 4;
static_assert(WS_SV + 16384 * 4 <= WS_ENDA, "expert overlay overflows group A");
static_assert(WS_END <= (size_t)512 * 1024 * 1024, "workspace over 512 MiB");

struct Params {
  const float *x, *w_in, *ck_pos, *ck_w1, *ck_b1, *ck_w2, *cv_pos, *cv_w1, *cv_b1, *cv_w2, *conv_w, *hng, *w_out, *ln1g, *ln1b, *w_query, *subk,
      *eu, *ev, *ln2g, *ln2b;
  float* out;
  char* ws;
};
#define WSP(T, OFF) ((T*)(p.ws + (OFF)))

#define FOR_VB(n) for (int vb = blockIdx.x; vb < (n); vb += gridDim.x)
#define FOR_VB2(n) for (int vb = blockIdx.x * 2 + (int)(threadIdx.x >> 8); vb < (n); vb += gridDim.x * 2)
constexpr int SMEM_BYTES = 8 * 17408;
constexpr int HALF = 36864;

__global__ void __launch_bounds__(512) mega(Params p) {
  cg::grid_group grid = cg::this_grid();
  __shared__ __attribute__((aligned(16))) char smem[SMEM_BYTES];
  char* smh = smem + (threadIdx.x >> 8) * HALF;
  const int wv = threadIdx.x >> 6;
  constexpr int NWV = 8;
  d_cvt(p.x, WSP(bf16_t, WS_XB), (size_t)S * DM / 4);
  FOR_VB2((INWP / 32) * (DM / 32)) d_cvtT(vb, smh, p.w_in, WSP(bf16_t, WS_WINT), DM, INW, INWP);
  FOR_VB2((512 / 32) * (4096 / 32)) d_cvtT(vb, smh, p.ck_w1, WSP(bf16_t, WS_W1KT), 4096, 512, 512);
  FOR_VB2((512 / 32) * (4096 / 32)) d_cvtT(vb, smh, p.cv_w1, WSP(bf16_t, WS_W1VT), 4096, 512, 512);
  FOR_VB2((DM / 32) * (DM / 32)) d_cvtT(vb, smh, p.w_out, WSP(bf16_t, WS_WOUTT), DM, DM, DM);
  FOR_VB2((DM / 32) * (DM / 32)) d_cvtT(vb, smh, p.w_query, WSP(bf16_t, WS_WQT), DM, DM, DM);
  for (size_t c = (size_t)blockIdx.x * 512 + threadIdx.x; c < (size_t)16 * 4 * 8 * 64; c += (size_t)gridDim.x * 512) d_cvt_subk(c, p.subk, WSP(bf16_t, WS_SKF));
  grid.sync();
  FOR_VB((S / 256) * (INWP / 128)) d_gemm(vb, smem, WSP(bf16_t, WS_XB), DM, WSP(bf16_t, WS_WINT), DM, DM, S / 256, EpiProjF{WSP(bf16_t, WS_PROJ), WSP(float, WS_GATES)});
  grid.sync();
  FOR_VB2(4096) { if (vb < 2048) d_build_cmp(vb, WSP(bf16_t, WS_PROJ), OFF_KC, p.ck_pos, WSP(bf16_t, WS_ACMPK)); else d_build_cmp(vb - 2048, WSP(bf16_t, WS_PROJ), OFF_VC, p.cv_pos, WSP(bf16_t, WS_ACMPV)); }
  grid.sync();
  FOR_VB(64) {
    if (vb < 32) d_gemm(vb, smem, WSP(bf16_t, WS_ACMPK), 4096, WSP(bf16_t, WS_W1KT), 4096, 4096, 8, EpiF32F{WSP(float, WS_HIDK), 512, 512});
    else d_gemm(vb - 32, smem, WSP(bf16_t, WS_ACMPV), 4096, WSP(bf16_t, WS_W1VT), 4096, 4096, 8, EpiF32F{WSP(float, WS_HIDV), 512, 512});
  }
  grid.sync();
  FOR_VB2(4092) { if (vb < 2046) d_cmp2(vb, smh, WSP(float, WS_HIDK), p.ck_b1, p.ck_w2, WSP(float, WS_KC)); else d_cmp2(vb - 2046, smh, WSP(float, WS_HIDV), p.cv_b1, p.cv_w2, WSP(float, WS_VC)); }
  grid.sync();
  {
    const size_t gt = (size_t)blockIdx.x * 512 + threadIdx.x, gs = (size_t)gridDim.x * 512;
    for (size_t c = gt; c < (size_t)2 * 32 * 512; c += gs) { d_relayoutK_f32(c, WSP(float, WS_KC), WSP(bf16_t, WS_KCF)); d_relayoutV_f32(c, WSP(float, WS_VC), WSP(bf16_t, WS_VCF)); }
    for (size_t c = gt; c < (size_t)2 * 512 * 512; c += gs) {
      d_relayoutK_bf(c, 512, WSP(bf16_t, WS_PROJ), INWP, OFF_KS, WSP(bf16_t, WS_KSF)); d_relayoutV_bf(c, 512, WSP(bf16_t, WS_PROJ), INWP, OFF_VS, WSP(bf16_t, WS_VSF));
      d_relayoutK_bf(c, 512, WSP(bf16_t, WS_PROJ), INWP, OFF_KW, WSP(bf16_t, WS_KWF)); d_relayoutV_bf(c, 512, WSP(bf16_t, WS_PROJ), INWP, OFF_VW, WSP(bf16_t, WS_VWF));
    }
  }
  grid.sync();
  {
    AttnPtrs ap{WSP(bf16_t, WS_PROJ), WSP(float, WS_GATES), WSP(bf16_t, WS_KCF), WSP(bf16_t, WS_VCF), WSP(bf16_t, WS_KSF), WSP(bf16_t, WS_VSF), WSP(bf16_t, WS_KWF), WSP(bf16_t, WS_VWF), WSP(float, WS_OATT)};
    for (int item = blockIdx.x * NWV + wv; item < 4096; item += gridDim.x * NWV) d_attn_wave(item, smem + wv * ATT_WSM, ap);
  }
  grid.sync();
  FOR_VB2(S) d_mix(vb, WSP(bf16_t, WS_PROJ), WSP(float, WS_OATT), p.conv_w, p.hng, WSP(bf16_t, WS_MIX));
  grid.sync();
  FOR_VB((S / 256) * (DM / 128)) d_gemm(vb, smem, WSP(bf16_t, WS_MIX), DM, WSP(bf16_t, WS_WOUTT), DM, DM, S / 256, EpiResF{WSP(float, WS_Y), p.x});
  grid.sync();
  FOR_VB2(S) d_ln(vb, smh, WSP(float, WS_Y), p.ln1g, p.ln1b, WSP(float, WS_Y), WSP(bf16_t, WS_HB));
  for (int r = blockIdx.x * NWV + wv; r < 32768; r += gridDim.x * NWV) {
    if (r < 16384) d_cvt_fp8_row(r, p.eu, WSP(unsigned char, WS_EU8), WSP(float, WS_SU)); else d_cvt_fp8_row(r - 16384, p.ev, WSP(unsigned char, WS_EV8), WSP(float, WS_SV));
  }
  grid.sync();
  FOR_VB((S / 256) * (DM / 128)) d_gemm(vb, smem, WSP(bf16_t, WS_HB), DM, WSP(bf16_t, WS_WQT), DM, DM, S / 256, EpiRouteF{WSP(bf16_t, WS_SKF), WSP(unsigned, WS_TOPS)});
  grid.sync();
  for (int t = blockIdx.x * NWV + wv; t < S; t += gridDim.x * NWV) d_expert_wave(t, WSP(float, WS_Y), WSP(unsigned, WS_TOPS), WSP(unsigned char, WS_EU8), WSP(unsigned char, WS_EV8), WSP(float, WS_SU), WSP(float, WS_SV), p.ln2g, p.ln2b, p.out);
}

extern "C" void kernel_launch(void* const* d_in, const int* in_sizes, int n_in, void* d_out, int out_size, void* d_ws, size_t ws_size,
                              hipStream_t stream) {
  Params p{};
  p.x = (const float*)d_in[0]; p.w_in = (const float*)d_in[1]; p.ck_pos = (const float*)d_in[2]; p.ck_w1 = (const float*)d_in[3];
  p.ck_b1 = (const float*)d_in[4]; p.ck_w2 = (const float*)d_in[5]; p.cv_pos = (const float*)d_in[6]; p.cv_w1 = (const float*)d_in[7];
  p.cv_b1 = (const float*)d_in[8]; p.cv_w2 = (const float*)d_in[9]; p.conv_w = (const float*)d_in[10]; p.hng = (const float*)d_in[11];
  p.w_out = (const float*)d_in[12]; p.ln1g = (const float*)d_in[13]; p.ln1b = (const float*)d_in[14]; p.w_query = (const float*)d_in[15];
  p.subk = (const float*)d_in[16]; p.eu = (const float*)d_in[17]; p.ev = (const float*)d_in[18]; p.ln2g = (const float*)d_in[19];
  p.ln2b = (const float*)d_in[20];
  p.out = (float*)d_out;
  p.ws = (char*)d_ws;
  if (ws_size < WS_END) fprintf(stderr, "workspace too small\n");
  static int grid_blocks = 0;
  if (!grid_blocks) {
    int dev = 0, cus = 0, per_cu = 0;
    hipGetDevice(&dev);
    hipDeviceGetAttribute(&cus, hipDeviceAttributeMultiprocessorCount, dev);
    hipOccupancyMaxActiveBlocksPerMultiprocessor(&per_cu, mega, 512, 0);
    if (per_cu > 1) per_cu = 1;
    if (per_cu < 1) per_cu = 1;
    grid_blocks = cus * per_cu;
  }
  void* args[] = {&p};
  hipError_t e = hipLaunchCooperativeKernel((void*)mega, dim3(grid_blocks), dim3(512), args, 0, stream);
  if (e != hipSuccess) fprintf(stderr, "cooperative launch failed: %s (grid %d)\n", hipGetErrorString(e), grid_blocks);
}
```

```cpp
#include <hip/hip_runtime.h>
#include <stdint.h>
#include <stdio.h>


#define DI __device__ __forceinline__
static __device__ __forceinline__ int tidx_() { int t = (int)__builtin_amdgcn_workitem_id_x(); asm volatile("" : "+v"(t)); return t; }
#define TIDX (tidx_())
typedef unsigned short bf16_t;
using bf16x8 = __attribute__((ext_vector_type(8))) short;
using f32x4 = __attribute__((ext_vector_type(4))) float;
using u32x4 = __attribute__((ext_vector_type(4))) unsigned;
using u32x2 = __attribute__((ext_vector_type(2))) unsigned;

constexpr int S = 16384, DM = 2048, HD = 128;
constexpr int INW = 5656, INWP = 5760, INWG = 5888;
constexpr int OFF_Q = 0, OFF_KC = 1024, OFF_VC = 1280, OFF_KS = 1536, OFF_VS = 1792, OFF_KW = 2048, OFF_VW = 2304,
              OFF_G = 2560, OFF_U = 2584, OFF_B = 3608, OFF_C = 4632;
constexpr int NCMP = 1023;
constexpr float ALPHA = 1.189207115002721f;
constexpr float QSCALE = 0.08838834764831845f;

DI bf16_t f2bf(float x) { unsigned u = __float_as_uint(x); u += 0x7fffu + ((u >> 16) & 1u); return (bf16_t)(u >> 16); }
DI float bf2f(bf16_t b) { return __uint_as_float(((unsigned)b) << 16); }
DI float gelu_tanh(float x) { float u = 0.7978845608028654f * (x + 0.044715f * x * x * x); return 0.5f * x * (1.f + tanhf(u)); }
DI float wave_sum(float v) { for (int o = 32; o > 0; o >>= 1) v += __shfl_xor(v, o); return v; }
DI float wave_max(float v) { for (int o = 32; o > 0; o >>= 1) v = fmaxf(v, __shfl_xor(v, o)); return v; }

namespace pg8 {
#define PG8_LAS __attribute__((address_space(3)))
typedef unsigned short bf16_t;
typedef short bf16x8 __attribute__((ext_vector_type(8)));
typedef float f32x4 __attribute__((ext_vector_type(4)));
typedef unsigned u32x4 __attribute__((ext_vector_type(4)));
constexpr int BM = 256, BK = 64, HALF = 128, HTB = HALF * BK * 2  , STAGE_BYTES = 8 * HTB, NXCD = 8, WGM = 8;

__host__ __device__ __forceinline__ int lds_byte(int r, int c) { const int st = (r >> 4) * 2 + (c >> 5), rr = r & 15, cc = c & 31, ob = rr * 64 + cc * 2; return st * 1024 + (ob ^ (((ob >> 9) & 1) << 5)); }
__host__ __device__ __forceinline__ void stage_rc(int b, int& R, int& C) { const int st = b / 1024, sb = b % 1024, swz = sb ^ (((sb >> 9) & 1) << 5); R = (st >> 1) * 16 + swz / 64; C = (st & 1) * 32 + (swz % 64) / 2; }
__host__ __device__ __forceinline__ int perm32(int rho) { const int n = rho >> 4, i = rho & 15; return 8 * (i >> 2) + 4 * n + (i & 3); }

struct Unit { int pm, pn; };
struct Gemm { const bf16_t* A; const bf16_t* Bt; int M, N, K; };

struct StaticOrder {
    int nM, nN, nwg, G, c;
    __host__ __device__ void init(int M, int N, int G_, int c_) { nM = M / BM; nN = N / BM; nwg = nM * nN; G = G_; c = c_; }
    __host__ __device__ bool next(int i, Unit& u) const {
        const long L = (long)i * G + c; if (L >= nwg) return false;
        int wgid = (int)L; { const int q = nwg / NXCD, r = nwg % NXCD, xcd = wgid % NXCD, off = wgid / NXCD; wgid = (xcd < r ? xcd * (q + 1) : r * (q + 1) + (xcd - r) * q) + off; }
        const int nig = WGM * nN, gid = wgid / nig, fm = gid * WGM, gsz = (nM - fm) < WGM ? (nM - fm) : WGM;
        u.pm = fm + ((wgid % nig) % gsz); u.pn = (wgid % nig) / gsz; return true;
    }
    __device__ __forceinline__ void a_ready(const Unit&) const {}
    __device__ __forceinline__ void done(const Unit&) const {}
};
struct OneUnit : StaticOrder {
    int k;
    __device__ bool next(int i, Unit& u) const { if (i > 0) return false; return StaticOrder::next(k, u); }
};
__device__ __forceinline__ unsigned cvt_pk_bf16(float lo, float hi) { unsigned r; asm volatile("v_cvt_pk_bf16_f32 %0, %1, %2" : "=v"(r) : "v"(lo), "v"(hi)); return r; }
template <class Epi, class Sched, bool STAMP = false>
__device__ __forceinline__ void gemm_phase(PG8_LAS unsigned char* lds, const Gemm g, const Sched& S, const Epi& E, unsigned long long* stamps) {
    const int tid = TIDX, wid = __builtin_amdgcn_readfirstlane(tid >> 6), lane = tid & 63, wr = wid >> 2, wc = wid & 3, fr = lane & 15, fq = lane >> 4;
    const int K = g.K, nt = K / BK;
    int ts_lo = 0, ts_hi = 0, nts = 0; const unsigned long long rt_entry = STAMP ? (unsigned long long)wall_clock64() : 0ull;
#define PG8_STAMP() do { if (STAMP && wid == 0 && nts < 64) { const unsigned long long _c = (unsigned long long)clock64(); \
        ts_lo = (lane == nts) ? (int)(unsigned)_c : ts_lo; ts_hi = (lane == nts) ? (int)(unsigned)(_c >> 32) : ts_hi; ++nts; } } while (0)
    PG8_STAMP();
    unsigned voffA[2], voffB[2];
#pragma unroll
    for (int i = 0; i < 2; ++i) { int R, C; stage_rc(tid * 16 + i * 8192, R, C); const int Rb = Epi::PERM ? ((R & ~31) + perm32(R & 31)) : R;
        voffA[i] = (unsigned)(R * K + C) * 2u; voffB[i] = (unsigned)(Rb * K + C) * 2u; }
    const size_t kstep = (size_t)(BK * 2);
    const size_t hstep = (size_t)HALF * K * 2;
    const size_t tstep = 2 * hstep;
    const unsigned ldsw = (unsigned)wid * 1024u;
    const int aoff = lds_byte(wr * 64 + fr, fq * 8), boff = lds_byte(wc * 32 + fr, fq * 8);
#define PG8_SA(b, h) (((b) * 2 + (h)) * HTB)
#define PG8_SB(b, h) ((4 + (b) * 2 + (h)) * HTB)
#define PG8_STAGE(bufoff, gbase, voff) do { _Pragma("unroll") for (int _i = 0; _i < 2; ++_i) \
        __builtin_amdgcn_global_load_lds((const unsigned*)((const char*)(gbase) + (voff)[_i]), (PG8_LAS unsigned*)(lds + (bufoff) + ldsw + _i * 8192), 16, 0, 0); } while (0)
#define PG8_LDA(dst, b, h) do { _Pragma("unroll") for (int m = 0; m < 4; ++m) _Pragma("unroll") for (int k = 0; k < 2; ++k) dst[m][k] = *(const PG8_LAS bf16x8*)(lds + PG8_SA(b, h) + aoff + m * 2048 + k * 1024); } while (0)
#define PG8_LDB(dst, b, h) do { _Pragma("unroll") for (int n = 0; n < 2; ++n) _Pragma("unroll") for (int k = 0; k < 2; ++k) dst[n][k] = *(const PG8_LAS bf16x8*)(lds + PG8_SB(b, h) + boff + n * 2048 + k * 1024); } while (0)
#define PG8_MMA(ai, bj, At, Bt) do { __builtin_amdgcn_s_setprio(1); _Pragma("unroll") for (int m = 0; m < 4; ++m) _Pragma("unroll") for (int n = 0; n < 2; ++n) _Pragma("unroll") for (int k = 0; k < 2; ++k) \
        acc[ai][bj][m][n] = __builtin_amdgcn_mfma_f32_16x16x32_bf16(Bt[n][k], At[m][k], acc[ai][bj][m][n], 0, 0, 0); __builtin_amdgcn_s_setprio(0); } while (0)
#define PG8_WAIT_V(n) asm volatile("s_waitcnt vmcnt(" #n ")" ::: "memory")
#define PG8_WAIT_L(n) asm volatile("s_waitcnt lgkmcnt(" #n ")" ::: "memory")
#define PG8_BAR __builtin_amdgcn_s_barrier()
#define PG8_SCHED __builtin_amdgcn_sched_barrier(0)
    Unit cur, nxt; int ui = 0;
    if (!S.next(0, cur)) return;
    f32x4 acc[2][2][4][2];
#pragma unroll
    for (int a = 0; a < 2; ++a)
#pragma unroll
        for (int b = 0; b < 2; ++b)
#pragma unroll
            for (int m = 0; m < 4; ++m)
#pragma unroll
                for (int n = 0; n < 2; ++n) acc[a][b][m][n] = (f32x4){0.f, 0.f, 0.f, 0.f};
    bf16x8 At[4][2], B0[2][2], B1[2][2];
    const char* cA = (const char*)g.A + (size_t)cur.pm * tstep; const char* cB = (const char*)g.Bt + (size_t)cur.pn * tstep;
    S.a_ready(cur);
    PG8_STAGE(PG8_SB(0, 0), cB, voffB); PG8_STAGE(PG8_SA(0, 0), cA, voffA); PG8_STAGE(PG8_SB(0, 1), cB + hstep, voffB); PG8_STAGE(PG8_SA(0, 1), cA + hstep, voffA);
    if (wr == 1) PG8_BAR;
    PG8_WAIT_V(4); PG8_BAR;
    PG8_STAGE(PG8_SB(1, 0), cB + kstep, voffB); PG8_STAGE(PG8_SA(1, 0), cA + kstep, voffA); PG8_STAGE(PG8_SB(1, 1), cB + hstep + kstep, voffB);
    PG8_WAIT_V(6); PG8_BAR;
    PG8_STAMP();
    for (;;) {
        const bool has_next = S.next(ui + 1, nxt);
        const char* nA = has_next ? (const char*)g.A + (size_t)nxt.pm * tstep : cA; const char* nB = has_next ? (const char*)g.Bt + (size_t)nxt.pn * tstep : cB;
        for (int t = 0; t < nt; t += 2) {
            const bool last = (t == nt - 2);
            const char* a1 = cA + (size_t)(t + 1) * kstep;
            const char* a2 = last ? nA : cA + (size_t)(t + 2) * kstep; const char* b2 = last ? nB : cB + (size_t)(t + 2) * kstep;
            const char* a3 = a2 + kstep; const char* b3 = b2 + kstep;
            if (last && has_next) S.a_ready(nxt);
            PG8_LDB(B0, 0, 0); PG8_SCHED; PG8_LDA(At, 0, 0); PG8_STAGE(PG8_SA(1, 1), a1 + hstep, voffA);
            PG8_WAIT_L(8); PG8_BAR; PG8_WAIT_L(0); PG8_MMA(0, 0, At, B0); PG8_BAR; PG8_SCHED;
            PG8_LDB(B1, 0, 1); PG8_STAGE(PG8_SB(0, 0), b2, voffB);
            PG8_BAR; PG8_WAIT_L(0); PG8_MMA(0, 1, At, B1); PG8_BAR;
            PG8_LDA(At, 0, 1); PG8_STAGE(PG8_SA(0, 0), a2, voffA);
            PG8_BAR; PG8_WAIT_L(0); PG8_MMA(1, 0, At, B0); PG8_BAR; PG8_SCHED;
            PG8_STAGE(PG8_SB(0, 1), b2 + hstep, voffB);
            PG8_WAIT_V(6); PG8_BAR; PG8_MMA(1, 1, At, B1); PG8_BAR;
            PG8_LDB(B0, 1, 0); PG8_SCHED; PG8_LDA(At, 1, 0); PG8_STAGE(PG8_SA(0, 1), a2 + hstep, voffA);
            PG8_WAIT_L(8); PG8_BAR; PG8_WAIT_L(0); PG8_MMA(0, 0, At, B0); PG8_BAR; PG8_SCHED;
            PG8_LDB(B1, 1, 1); PG8_STAGE(PG8_SB(1, 0), b3, voffB);
            PG8_BAR; PG8_WAIT_L(0); PG8_MMA(0, 1, At, B1); PG8_BAR;
            PG8_LDA(At, 1, 1); PG8_STAGE(PG8_SA(1, 0), a3, voffA);
            PG8_BAR; PG8_WAIT_L(0); PG8_MMA(1, 0, At, B0); PG8_BAR; PG8_SCHED;
            PG8_STAGE(PG8_SB(1, 1), b3 + hstep, voffB);
            PG8_WAIT_V(6); PG8_BAR; PG8_MMA(1, 1, At, B1); PG8_BAR;
        }
        PG8_STAMP();
        if constexpr (!Epi::AFTER_DRAIN) { E(acc, cur, wr, wc, fr, fq); S.done(cur); }
        PG8_STAMP();
        if (!has_next) break;
#pragma unroll
        for (int a = 0; a < 2; ++a)
#pragma unroll
            for (int b = 0; b < 2; ++b)
#pragma unroll
                for (int m = 0; m < 4; ++m)
#pragma unroll
                    for (int n = 0; n < 2; ++n) acc[a][b][m][n] = (f32x4){0.f, 0.f, 0.f, 0.f};
        cur = nxt; cA = nA; cB = nB; ++ui;
    }
    PG8_WAIT_V(0);
    if (wr == 0) PG8_BAR;
    PG8_BAR;
    if constexpr (Epi::AFTER_DRAIN) { E.fused(acc, cur, wr, wc, fr, fq, lds, wid, lane); S.done(cur); }
    PG8_STAMP();
    if (STAMP && wid == 0) { stamps[lane] = lane < nts ? (((unsigned long long)(unsigned)ts_hi << 32) | (unsigned)ts_lo) : 0ull;
        if (lane == 62) stamps[62] = rt_entry; if (lane == 63) stamps[63] = (unsigned long long)wall_clock64(); }
#undef PG8_STAMP
#undef PG8_SA
#undef PG8_SB
#undef PG8_STAGE
#undef PG8_LDA
#undef PG8_LDB
#undef PG8_MMA
#undef PG8_WAIT_V
#undef PG8_WAIT_L
#undef PG8_BAR
#undef PG8_SCHED
}
}

#define XB_TMO      128
#define XB_XCNT(j)  (256  + 64 * (j))
#define XB_XSUB(j)  (1280 + 64 * (j))
#define XB_XGEN(j)  (2304 + 64 * (j))
#define XB_TOP      3328
#define XB_TOPGEN   3392
#define XCD_BAR_WORDS 3456
#define XB_SPIN_CAP (1u << 18)
#define LAS __attribute__((address_space(3)))

__device__ __forceinline__ unsigned xb_ld(unsigned* p)              { return __hip_atomic_load(p, __ATOMIC_RELAXED, __HIP_MEMORY_SCOPE_AGENT); }
__device__ __forceinline__ unsigned xb_add(unsigned* p, unsigned v) { return __hip_atomic_fetch_add(p, v, __ATOMIC_RELAXED, __HIP_MEMORY_SCOPE_AGENT); }
__device__ __forceinline__ unsigned xb_xcc_id() { return (unsigned)__builtin_amdgcn_s_getreg((3 << 11) | 20) & 0xFu; }
#define XB_SPIN(cond, bar) do { unsigned _sp = 0; while (cond) { __builtin_amdgcn_s_sleep(1); \
    if ((++_sp & 255u) == 0u) { if (xb_ld(&(bar)[XB_TMO])) break; if (_sp > XB_SPIN_CAP) { atomicAdd(&(bar)[XB_TMO], 1u); break; } } } } while (0)

struct XcdBarrier {
    unsigned* bar; unsigned x;
    volatile LAS unsigned* st;
};

__device__ __forceinline__ XcdBarrier xcd_barrier_post(unsigned* bar, volatile LAS unsigned* st) {
    XcdBarrier b; b.bar = bar; b.x = xb_xcc_id(); b.st = st;
    if (TIDX == 0) (void)xb_add(&bar[XB_XCNT(b.x)], 1u);
    return b;
}
__device__ __forceinline__ void xcd_barrier_complete(unsigned* bar, unsigned x, unsigned& nloc, unsigned& nx) {
    const unsigned G = gridDim.x * gridDim.y * gridDim.z;
    unsigned sum, cnt, mine, sp = 0u;
    for (;;) {
        sum = 0u; cnt = 0u; mine = 0u;
#pragma unroll
        for (unsigned j = 0; j < 16; ++j) { const unsigned c = xb_ld(&bar[XB_XCNT(j)]); sum += c; cnt += (c > 0u) ? 1u : 0u; mine = (j == x) ? c : mine; }
        if (sum == G) break;
        __builtin_amdgcn_s_sleep(1);
        if ((++sp & 255u) == 0u) { if (xb_ld(&bar[XB_TMO])) break; if (sp > XB_SPIN_CAP) { atomicAdd(&bar[XB_TMO], 1u); break; } }
    }
    nloc = mine > 0u ? mine : 1u; nx = cnt > 0u ? cnt : 1u;
}

__device__ __forceinline__ void xcd_barrier(const XcdBarrier& b) {
    asm volatile("s_waitcnt vmcnt(0)" ::: "memory");
    __syncthreads();
    if (TIDX == 0) {
        unsigned* bar = b.bar;
        __builtin_amdgcn_s_waitcnt(0);
        unsigned nloc = b.st[0], nx = b.st[1];
        if (nloc == 0u) { xcd_barrier_complete(bar, b.x, nloc, nx); b.st[0] = nloc; b.st[1] = nx; }
        const unsigned old = xb_add(&bar[XB_XSUB(b.x)], 1u);
        const unsigned gen = old / nloc;
        if (old + 1u == (gen + 1u) * nloc) {
            __builtin_amdgcn_fence(__ATOMIC_RELEASE, "agent");
            asm volatile("s_waitcnt vmcnt(0)" ::: "memory");
            const unsigned og = xb_add(&bar[XB_TOP], 1u);
            const unsigned tg = og / nx;
            if (og + 1u == (tg + 1u) * nx) xb_add(&bar[XB_TOPGEN], 1u);
            else XB_SPIN(xb_ld(&bar[XB_TOPGEN]) == tg, bar);
            __builtin_amdgcn_fence(__ATOMIC_ACQUIRE, "agent");
            xb_add(&bar[XB_XGEN(b.x)], 1u);
            asm volatile("s_waitcnt vmcnt(0)" ::: "memory");
        } else {
            XB_SPIN(xb_ld(&bar[XB_XGEN(b.x)]) == gen, bar);
            __builtin_amdgcn_fence(__ATOMIC_ACQUIRE, "agent");
            asm volatile("s_waitcnt vmcnt(0)" ::: "memory");
        }
    }
    __syncthreads();
}

__device__ void d_cvt(const float* __restrict__ in, bf16_t* __restrict__ out, size_t n4) {
  size_t i = (size_t)blockIdx.x * blockDim.x + TIDX;
  size_t stride = (size_t)gridDim.x * blockDim.x;
  for (; i < n4; i += stride) { float4 v = ((const float4*)in)[i]; ushort4 o; o.x = f2bf(v.x); o.y = f2bf(v.y); o.z = f2bf(v.z); o.w = f2bf(v.w); ((ushort4*)out)[i] = o; }
}
__device__ void d_cvtT(int vb, char* smem, const float* __restrict__ W, bf16_t* __restrict__ WT, int K, int N, int NP) {
  float (*t)[33] = (float (*)[33])smem;
  int nbx = NP / 32;
  int n0 = (vb % nbx) * 32, k0 = (vb / nbx) * 32;
  int tx = (TIDX & 255) & 31, ty = (TIDX & 255) >> 5;
  for (int i = ty; i < 32; i += 8) { int k = k0 + i, n = n0 + tx; t[i][tx] = (n < N && k < K) ? W[(size_t)k * N + n] : 0.f; }
  __syncthreads();
  for (int i = ty; i < 32; i += 8) { int n = n0 + i, k = k0 + tx; if (n < NP && k < K) WT[(size_t)n * K + k] = f2bf(t[tx][i]); }
  __syncthreads();
}

constexpr int LDS_LD = 72;
struct EpiProj { bf16_t* proj; float* gates; };
struct EpiF32 { float* C; int ldc; int N; };
struct EpiRes { float* C; const float* X; };


#define ELEMWISE_TILE                                                                              \
  DI void tile(f32x4 (&acc)[4][4], char*, int m0, int n0, int, int wm, int wn, int, int lane) const { \
    _Pragma("unroll") for (int i = 0; i < 4; ++i)                                                  \
    _Pragma("unroll") for (int j = 0; j < 4; ++j)                                                  \
    _Pragma("unroll") for (int r = 0; r < 4; ++r) {                                                \
      int row = m0 + wm * 64 + i * 16 + (lane >> 4) * 4 + r;                                       \
      int col = n0 + wn * 64 + j * 16 + (lane & 15);                                               \
      (*this)(row, col, acc[i][j][r]);                                                             \
    }                                                                                              \
  }
template <class Epi>
__device__ void d_gemm(int vb, char* smem, const bf16_t* __restrict__ A, int lda, const bf16_t* __restrict__ BT, int ldb, int K,
                       int tilesM, Epi epi) {
  bf16_t* As = (bf16_t*)smem;
  bf16_t* Bs = As + 256 * LDS_LD;
  const int tid = TIDX, lane = tid & 63, wid = tid >> 6;
  const int wm = wid >> 1, wn = wid & 1;
  const int tm = vb % tilesM, tn = vb / tilesM;
  const int m0 = tm * 256, n0 = tn * 128;
  f32x4 acc[4][4];
#pragma unroll
  for (int i = 0; i < 4; ++i)
#pragma unroll
    for (int j = 0; j < 4; ++j) acc[i][j] = f32x4{0.f, 0.f, 0.f, 0.f};
  u32x4 ra[4], rb[2];
#define GLOAD(k0_)                                                                  \
  _Pragma("unroll") for (int i = 0; i < 4; ++i) {                                   \
    int c = tid + i * 512; int row = c >> 3, kc = c & 7;                            \
    ra[i] = *(const u32x4*)(A + (size_t)(m0 + row) * lda + (k0_) + kc * 8);         \
  }                                                                                 \
  _Pragma("unroll") for (int i = 0; i < 2; ++i) {                                   \
    int c = tid + i * 512; int row = c >> 3, kc = c & 7;                            \
    rb[i] = *(const u32x4*)(BT + (size_t)(n0 + row) * ldb + (k0_) + kc * 8);        \
  }
  GLOAD(0)
  for (int k0 = 0; k0 < K; k0 += 64) {
    __syncthreads();
#pragma unroll
    for (int i = 0; i < 4; ++i) { int c = tid + i * 512; int row = c >> 3, kc = c & 7; *(u32x4*)(As + row * LDS_LD + kc * 8) = ra[i]; }
#pragma unroll
    for (int i = 0; i < 2; ++i) { int c = tid + i * 512; int row = c >> 3, kc = c & 7; *(u32x4*)(Bs + row * LDS_LD + kc * 8) = rb[i]; }
    __syncthreads();
    if (k0 + 64 < K) { GLOAD(k0 + 64) }
#pragma unroll
    for (int ks = 0; ks < 2; ++ks) {
      bf16x8 a[4], b[4];
#pragma unroll
      for (int i = 0; i < 4; ++i) {
        a[i] = *(const bf16x8*)(As + (wm * 64 + i * 16 + (lane & 15)) * LDS_LD + ks * 32 + (lane >> 4) * 8);
        b[i] = *(const bf16x8*)(Bs + (wn * 64 + i * 16 + (lane & 15)) * LDS_LD + ks * 32 + (lane >> 4) * 8);
      }
#pragma unroll
      for (int i = 0; i < 4; ++i)
#pragma unroll
        for (int j = 0; j < 4; ++j) acc[i][j] = __builtin_amdgcn_mfma_f32_16x16x32_bf16(a[i], b[j], acc[i][j], 0, 0, 0);
    }
  }
  epi.tile(acc, smem, m0, n0, tn, wm, wn, wid, lane);
  __syncthreads();
}
struct EpiProjF {
  bf16_t* proj; float* gates;
  DI void operator()(int row, int col, float v) const {
    if (col < INW) proj[(size_t)row * INWP + col] = f2bf(v);
    if (col >= OFF_G && col < OFF_G + 24) gates[row * 24 + (col - OFF_G)] = 1.f / (1.f + __expf(-v));
  }
  ELEMWISE_TILE
};
struct EpiF32F {
  float* C; int ldc; int N;
  DI void operator()(int row, int col, float v) const { if (col < N) C[(size_t)row * ldc + col] = v; }
  ELEMWISE_TILE
};
struct EpiResF {
  float* C; const float* X;
  DI void operator()(int row, int col, float v) const { C[(size_t)row * DM + col] = ALPHA * X[(size_t)row * DM + col] + v; }
  ELEMWISE_TILE
};

__device__ void d_build_cmp(int row, const bf16_t* __restrict__ proj, int off, const float* __restrict__ pos, bf16_t* __restrict__ Ac) {
  int n = row >> 1, g = row & 1;
  for (int k = (TIDX & 255); k < 4096; k += 256) {
    float v = 0.f;
    if (row < 2046) { int l = k >> 7, d = k & 127; v = bf2f(proj[(size_t)(16 * n + l) * INWP + off + g * 128 + d]) + pos[l * 128 + d]; }
    Ac[(size_t)row * 4096 + k] = f2bf(v);
  }
}
__device__ void d_cmp2(int row, char* smem, const float* __restrict__ hid, const float* __restrict__ b1, const float* __restrict__ w2, float* __restrict__ out) {
  float* a = (float*)smem;
  for (int j = (TIDX & 255); j < 512; j += 256) a[j] = gelu_tanh(hid[(size_t)row * 512 + j] + b1[j]);
  __syncthreads();
  int d = (TIDX & 255) & 127, half = (TIDX & 255) >> 7;
  float s = 0.f;
  for (int j = half * 256; j < half * 256 + 256; ++j) s += a[j] * w2[j * 128 + d];
  float* red = a + 512;
  if (half) red[d] = s;
  __syncthreads();
  if (!half) out[(size_t)row * 128 + d] = s + red[d];
  __syncthreads();
}

using f32x16 = __attribute__((ext_vector_type(16))) float;
using bf16x8v = __attribute__((ext_vector_type(8))) __bf16;
using bf16x2v = __attribute__((ext_vector_type(2))) __bf16;
#define MFMA32(a, b, c) __builtin_amdgcn_mfma_f32_32x32x16_bf16((a), (b), (c), 0, 0, 0)
constexpr float LOG2E = 1.4426950408889634f;
constexpr float NEGB = -1e30f;
DI int pi_perm(int i) { return (i & ~12) | ((i & 8) >> 1) | ((i & 4) << 1); }
DI unsigned pack2(float a, float b) { bf16x2v v = {(__bf16)a, (__bf16)b}; return __builtin_bit_cast(unsigned, v); }
DI bf16x8 pack8(float a0, float a1, float a2, float a3, float a4, float a5, float a6, float a7) {
  bf16x8v v = {(__bf16)a0, (__bf16)a1, (__bf16)a2, (__bf16)a3, (__bf16)a4, (__bf16)a5, (__bf16)a6, (__bf16)a7};
  return __builtin_bit_cast(bf16x8, v);
}
__device__ void d_relayoutK_bf(size_t c, int NT, const bf16_t* __restrict__ src, int ld, int col0, bf16_t* __restrict__ dst) {
  int lane = c & 63, s = (c >> 6) & 7; size_t tt = c >> 9; int T = tt % NT, g = tt / NT;
  int i = lane & 31, h = lane >> 5;
  int tok = 32 * T + pi_perm(i);
  *(u32x4*)(dst + c * 8) = *(const u32x4*)(src + (size_t)tok * ld + col0 + g * 128 + 16 * s + 8 * h);
}
__device__ void d_relayoutV_bf(size_t c, int NT, const bf16_t* __restrict__ src, int ld, int col0, bf16_t* __restrict__ dst) {
  int lane = c & 63, s2 = (c >> 6) & 1, dt = (c >> 7) & 3; size_t tt = c >> 9; int T = tt % NT, g = tt / NT;
  int dd = lane & 31, h = lane >> 5;
  bf16_t v[8];
#pragma unroll
  for (int j = 0; j < 8; ++j) v[j] = src[(size_t)(32 * T + 16 * s2 + 8 * h + j) * ld + col0 + g * 128 + 32 * dt + dd];
  u32x4 o; o.x = v[0] | ((unsigned)v[1] << 16); o.y = v[2] | ((unsigned)v[3] << 16); o.z = v[4] | ((unsigned)v[5] << 16); o.w = v[6] | ((unsigned)v[7] << 16);
  *(u32x4*)(dst + c * 8) = o;
}
__device__ void d_relayoutK_f32(size_t c, const float* __restrict__ src, bf16_t* __restrict__ dst) {
  int lane = c & 63, s = (c >> 6) & 7; size_t tt = c >> 9; int T = tt % 32, g = tt / 32;
  int i = lane & 31, h = lane >> 5;
  int n = 32 * T + pi_perm(i);
  bf16_t v[8];
#pragma unroll
  for (int j = 0; j < 8; ++j) v[j] = (n < NCMP) ? f2bf(src[((size_t)n * 2 + g) * 128 + 16 * s + 8 * h + j]) : (bf16_t)0;
  u32x4 o; o.x = v[0] | ((unsigned)v[1] << 16); o.y = v[2] | ((unsigned)v[3] << 16); o.z = v[4] | ((unsigned)v[5] << 16); o.w = v[6] | ((unsigned)v[7] << 16);
  *(u32x4*)(dst + c * 8) = o;
}
__device__ void d_relayoutV_f32(size_t c, const float* __restrict__ src, bf16_t* __restrict__ dst) {
  int lane = c & 63, s2 = (c >> 6) & 1, dt = (c >> 7) & 3; size_t tt = c >> 9; int T = tt % 32, g = tt / 32;
  int dd = lane & 31, h = lane >> 5;
  bf16_t v[8];
#pragma unroll
  for (int j = 0; j < 8; ++j) { int n = 32 * T + 16 * s2 + 8 * h + j; v[j] = (n < NCMP) ? f2bf(src[((size_t)n * 2 + g) * 128 + 32 * dt + dd]) : (bf16_t)0; }
  u32x4 o; o.x = v[0] | ((unsigned)v[1] << 16); o.y = v[2] | ((unsigned)v[3] << 16); o.z = v[4] | ((unsigned)v[5] << 16); o.w = v[6] | ((unsigned)v[7] << 16);
  *(u32x4*)(dst + c * 8) = o;
}

struct AttnPtrs {
  const bf16_t* proj; const float* gates;
  const bf16_t *kcf, *vcf, *ksf, *vsf, *kwf, *vwf;
  bf16_t* mix; const float* hng;
};

DI f32x16 qk_tile(const bf16_t* __restrict__ kt, const bf16_t* qL, int lane) {
  f32x16 acc;
#pragma unroll
  for (int i = 0; i < 16; ++i) acc[i] = 0.f;
  const bf16_t* qp = qL + (lane & 31) * 136 + 8 * (lane >> 5);
#pragma unroll
  for (int s = 0; s < 8; ++s) {
    bf16x8 kf = *(const bf16x8*)(kt + s * 512 + lane * 8);
    bf16x8 qf = *(const bf16x8*)(qp + 16 * s);
    acc = MFMA32(kf, qf, acc);
  }
  return acc;
}
DI void pv_tile(const bf16_t* __restrict__ vt, const float (&p)[16], f32x16 (&O)[4], int lane) {
  bf16x8 pf0 = pack8(p[0], p[1], p[2], p[3], p[4], p[5], p[6], p[7]);
  bf16x8 pf1 = pack8(p[8], p[9], p[10], p[11], p[12], p[13], p[14], p[15]);
#pragma unroll
  for (int dt = 0; dt < 4; ++dt) {
    bf16x8 v0 = *(const bf16x8*)(vt + (dt * 2 + 0) * 512 + lane * 8);
    bf16x8 v1 = *(const bf16x8*)(vt + (dt * 2 + 1) * 512 + lane * 8);
    O[dt] = MFMA32(v0, pf0, O[dt]);
    O[dt] = MFMA32(v1, pf1, O[dt]);
  }
}
DI void osm_step(const float (&sv)[16], unsigned vmask, float& m, float& l, f32x16 (&O)[4], float (&p)[16]) {
  float tmax = NEGB;
#pragma unroll
  for (int r = 0; r < 16; ++r) tmax = fmaxf(tmax, sv[r]);
  tmax = fmaxf(tmax, __shfl_xor(tmax, 32));
  float mn = fmaxf(m, tmax);
  float alpha = exp2f(m - mn);
  float ps = 0.f;
#pragma unroll
  for (int r = 0; r < 16; ++r) { float e = ((vmask >> r) & 1u) ? exp2f(sv[r] - mn) : 0.f; p[r] = e; ps += e; }
  l = l * alpha + ps;
  m = mn;
  if (__ballot(alpha < 1.f)) {
#pragma unroll
    for (int dt = 0; dt < 4; ++dt)
#pragma unroll
      for (int r = 0; r < 16; ++r) O[dt][r] *= alpha;
  }
}
DI void ot_store(char* otL, int lane, const f32x16 (&O)[4], float sc) {
#pragma unroll
  for (int dt = 0; dt < 4; ++dt) {
    u32x4 a, b;
#pragma unroll
    for (int i = 0; i < 4; ++i) { a[i] = pack2(sc * O[dt][2 * i], sc * O[dt][2 * i + 1]); b[i] = pack2(sc * O[dt][8 + 2 * i], sc * O[dt][8 + 2 * i + 1]); }
    *(u32x4*)(otL + lane * 128 + dt * 32) = a;
    *(u32x4*)(otL + lane * 128 + dt * 32 + 16) = b;
  }
}
DI void ot_accum(const char* otL, int lane, f32x16 (&O)[4], float sc) {
#pragma unroll
  for (int dt = 0; dt < 4; ++dt) {
    u32x4 a = *(const u32x4*)(otL + lane * 128 + dt * 32);
    u32x4 b = *(const u32x4*)(otL + lane * 128 + dt * 32 + 16);
#pragma unroll
    for (int i = 0; i < 4; ++i) {
      const unsigned wa = a[i], wb = b[i];
      O[dt][2 * i] = fmaf(sc, O[dt][2 * i], __uint_as_float(wa << 16));
      O[dt][2 * i + 1] = fmaf(sc, O[dt][2 * i + 1], __uint_as_float(wa & 0xFFFF0000u));
      O[dt][8 + 2 * i] = fmaf(sc, O[dt][8 + 2 * i], __uint_as_float(wb << 16));
      O[dt][8 + 2 * i + 1] = fmaf(sc, O[dt][8 + 2 * i + 1], __uint_as_float(wb & 0xFFFF0000u));
    }
  }
}
DI void zero_o(f32x16 (&O)[4]) {
#pragma unroll
  for (int dt = 0; dt < 4; ++dt)
#pragma unroll
    for (int i = 0; i < 16; ++i) O[dt][i] = 0.f;
}

constexpr int ATT_WSM = 17408;
__device__ __forceinline__ void d_select(const float* impL, unsigned* mskL, unsigned* uniL, int cur) {
  const int lane = TIDX & 63;
  const int stok = lane >> 3, sub = lane & 7;
  unsigned key[32];
#pragma unroll
  for (int i4 = 0; i4 < 8; ++i4) {
    f32x4 v = *(const f32x4*)(impL + stok * 256 + sub * 32 + i4 * 4);
#pragma unroll
    for (int e = 0; e < 4; ++e) {
      const int j = sub * 32 + i4 * 4 + e;
      const bool valid = j <= cur;
      const bool forced = (j == 0) || (j == cur) || (j == cur - 1);
      unsigned kb = forced ? 0xFFFFFF00u : (__float_as_uint(v[e]) & 0xFFFFFF00u);
      key[i4 * 4 + e] = valid ? (kb | (unsigned)(255 - j)) : 0u;
    }
  }
#pragma unroll
  for (int k = 2; k <= 32; k <<= 1) {
#pragma unroll
    for (int jj = k >> 1; jj > 0; jj >>= 1) {
#pragma unroll
      for (int i = 0; i < 32; ++i) {
        const int l2 = i ^ jj;
        if (l2 > i) {
          const bool desc = ((i & k) == 0);
          unsigned a = key[i], b = key[l2];
          unsigned mx = a > b ? a : b, mn = a > b ? b : a;
          key[i] = desc ? mx : mn; key[l2] = desc ? mn : mx;
        }
      }
    }
  }
#pragma unroll
  for (int xm = 1; xm < 8; xm <<= 1) {
    unsigned L[16];
#pragma unroll
    for (int i = 0; i < 16; ++i) { unsigned o = (unsigned)__shfl_xor((int)key[15 - i], xm); L[i] = key[i] > o ? key[i] : o; }
#pragma unroll
    for (int jj = 8; jj > 0; jj >>= 1) {
#pragma unroll
      for (int i = 0; i < 16; ++i) {
        const int l2 = i ^ jj;
        if (l2 > i) { unsigned a = L[i], b = L[l2]; L[i] = a > b ? a : b; L[l2] = a > b ? b : a; }
      }
    }
#pragma unroll
    for (int i = 0; i < 16; ++i) key[i] = L[i];
  }
#pragma unroll
  for (int i = 0; i < 16; ++i) {
    if ((i & 7) == sub) {
      const int j = 255 - (int)(key[i] & 255u);
      if (j <= cur) { atomicOr(&mskL[stok * 8 + (j >> 5)], 1u << (j & 31)); atomicOr(&uniL[j >> 5], 1u << (j & 31)); }
    }
  }
}

__device__ void d_attn_wave(int item, char* wsm, const AttnPtrs& P) {
  const int lane = TIDX & 63;
  const int g = item & 1, tok0 = (item >> 1) * 8;
  const int c = lane & 31, h = lane >> 5, tokl = c >> 2, r = c & 3;
  const int t = tok0 + tokl, hd = g * 4 + r;
  const float slope2 = exp2f(-(float)(hd + 1)) * LOG2E;
  const float c1 = QSCALE * LOG2E;
  float* impL = (float*)wsm;
  char* otL = wsm;
  bf16_t* qL = (bf16_t*)(wsm + 8192);
  unsigned* mskL = (unsigned*)(wsm + 8192 + 8704);
  unsigned* uniL = mskL + 64;
  {
#pragma unroll
    for (int i = 0; i < 8; ++i) {
      const int id = i * 64 + lane, row = id >> 4, ch = id & 15;
      u32x4 v = *(const u32x4*)(P.proj + (size_t)(tok0 + (row >> 2)) * INWP + OFF_Q + (g * 4 + (row & 3)) * 128 + ch * 8);
      *(u32x4*)(qL + row * 136 + ch * 8) = v;
    }
    u32x4 z = {0u, 0u, 0u, 0u};
#pragma unroll
    for (int i = 0; i < 8; ++i) *(u32x4*)(wsm + (i * 64 + lane) * 16) = z;
    if (lane < 18) *(u32x4*)(wsm + 8192 + 8704 + lane * 16) = z;
  }
  const float* gt = P.gates + (size_t)t * 24 + hd * 3;
  const float g0 = gt[0], g1 = gt[1], g2 = gt[2];
  f32x16 Ob[4];
  zero_o(Ob);
  {
    const int nmax = (t >= 31) ? ((t - 31) >> 4) : -1;
    const int nmaxw = (tok0 + 7 >= 31) ? ((tok0 + 7 - 31) >> 4) : -1;
    const int ntc = (nmaxw + 32) >> 5;
    const bf16_t* kcf = P.kcf + (size_t)g * 32 * 4096;
    const bf16_t* vcf = P.vcf + (size_t)g * 32 * 4096;
    float mC = NEGB, lC = 0.f;
    const float sl16 = slope2 * 16.f;
    for (int T = ntc - 1; T >= 0; --T) {
      f32x16 acc = qk_tile(kcf + (size_t)T * 4096, qL, lane);
      const float base = slope2 * (float)(512 * T + 128 * h) + slope2 * (15.5f - (float)t);
      const int nb = 32 * T + 8 * h;
      float tmax = NEGB; float sv[16];
#pragma unroll
      for (int rg = 0; rg < 16; ++rg) {
        const int kk = (rg & 7) + 16 * (rg >> 3);
        float v = fmaf(acc[rg], c1, fmaf(sl16, (float)kk, base));
        v = (nb + kk <= nmax) ? v : NEGB;
        sv[rg] = v; tmax = fmaxf(tmax, v);
      }
      tmax = fmaxf(tmax, __shfl_xor(tmax, 32));
      float mn = fmaxf(mC, tmax);
      float ps = 0.f;
#pragma unroll
      for (int rg = 0; rg < 16; ++rg) { const int kk = (rg & 7) + 16 * (rg >> 3); ps += (nb + kk <= nmax) ? exp2f(sv[rg] - mn) : 0.f; }
      lC = lC * exp2f(mC - mn) + ps; mC = mn;
    }
    lC += __shfl_xor(lC, 32);
    const float invC = (lC > 0.f) ? 1.f / lC : 0.f;
    float carry = 0.f;
    for (int T = 0; T < ntc; ++T) {
      f32x16 acc = qk_tile(kcf + (size_t)T * 4096, qL, lane);
      const float base = slope2 * (float)(512 * T + 128 * h) + slope2 * (15.5f - (float)t);
      const int nb = 32 * T + 8 * h;
      float p[16];
#pragma unroll
      for (int rg = 0; rg < 16; ++rg) {
        const int kk = (rg & 7) + 16 * (rg >> 3);
        float v = fmaf(acc[rg], c1, fmaf(sl16, (float)kk, base));
        p[rg] = (nb + kk <= nmax) ? exp2f(v - mC) * invC : 0.f;
      }
      float Ga = (p[0] + p[1]) + (p[2] + p[3]), Gb = (p[4] + p[5]) + (p[6] + p[7]);
      float Gc = (p[8] + p[9]) + (p[10] + p[11]), Gd = (p[12] + p[13]) + (p[14] + p[15]);
      float xb = __shfl_xor(p[7], 32), xd = __shfl_xor(p[15], 32);
      float ia = Ga + (h ? xb : carry);
      float ib = Gb + p[3];
      float ic = Gc + (h ? xd : xb);
      float id = Gd + p[11];
      carry = xd;
      ia += __shfl_xor(ia, 1); ia += __shfl_xor(ia, 2);
      ib += __shfl_xor(ib, 1); ib += __shfl_xor(ib, 2);
      ic += __shfl_xor(ic, 1); ic += __shfl_xor(ic, 2);
      id += __shfl_xor(id, 1); id += __shfl_xor(id, 2);
      {
        float val = (r == 0) ? ia : (r == 1) ? ib : (r == 2) ? ic : id;
        int j = 8 * T + 2 * h + ((r == 0) ? 0 : (r == 1) ? 1 : (r == 2) ? 4 : 5);
        impL[tokl * 256 + j] = val;
      }
      pv_tile(vcf + (size_t)T * 4096, p, Ob, lane);
    }
  }
  const int cur = tok0 >> 6;
  d_select(impL, mskL, uniL, cur);
  ot_store(otL, lane, Ob, g0);
  zero_o(Ob);
  {
    const bf16_t* ksf = P.ksf + (size_t)g * 512 * 4096;
    const bf16_t* vsf = P.vsf + (size_t)g * 512 * 4096;
    float m = NEGB, l = 0.f;
    for (int w = 7; w >= 0; --w) {
      unsigned uw = __builtin_amdgcn_readfirstlane(uniL[w]);
      while (uw) {
        const int bit = 31 - __builtin_clz(uw);
        uw &= ~(1u << bit);
        const int b = 32 * w + bit;
        const bool mine = (mskL[tokl * 8 + w] >> bit) & 1u;
        for (int half = 1; half >= 0; --half) {
          const int T = 2 * b + half;
          const int pos0 = 32 * T;
          if (pos0 > tok0 + 7) continue;
          f32x16 acc = qk_tile(ksf + (size_t)T * 4096, qL, lane);
          const float base = slope2 * (float)(pos0 + 8 * h - t);
          const int pb = pos0 + 8 * h;
          float sv[16]; unsigned vm = 0;
#pragma unroll
          for (int rg = 0; rg < 16; ++rg) {
            const int kk = (rg & 7) + 16 * (rg >> 3);
            const bool ok = mine && (pb + kk <= t);
            float v = fmaf(acc[rg], c1, fmaf(slope2, (float)kk, base));
            sv[rg] = ok ? v : NEGB; vm |= ok ? (1u << rg) : 0u;
          }
          float p[16];
          osm_step(sv, vm, m, l, Ob, p);
          pv_tile(vsf + (size_t)T * 4096, p, Ob, lane);
        }
      }
    }
    l += __shfl_xor(l, 32);
    const float inv = (l > 0.f) ? g1 / l : 0.f;
    ot_accum(otL, lane, Ob, inv);
    ot_store(otL, lane, Ob, 1.f);
    zero_o(Ob);
  }
  {
    const bf16_t* kwf = P.kwf + (size_t)g * 512 * 4096;
    const bf16_t* vwf = P.vwf + (size_t)g * 512 * 4096;
    float m = NEGB, l = 0.f;
    const int plo = tok0 - 511 > 0 ? tok0 - 511 : 0;
    const int Tlo = plo >> 5, Thi = (tok0 + 7) >> 5;
    for (int T = Thi; T >= Tlo; --T) {
      const int pos0 = 32 * T;
      f32x16 acc = qk_tile(kwf + (size_t)T * 4096, qL, lane);
      const float base = slope2 * (float)(pos0 + 8 * h - t);
      const int pb = pos0 + 8 * h;
      float sv[16]; unsigned vm = 0;
#pragma unroll
      for (int rg = 0; rg < 16; ++rg) {
        const int kk = (rg & 7) + 16 * (rg >> 3);
        const int dw = t - (pb + kk);
        const bool ok = (dw >= 0) && (dw < 512);
        float v = fmaf(acc[rg], c1, fmaf(slope2, (float)kk, base));
        sv[rg] = ok ? v : NEGB; vm |= ok ? (1u << rg) : 0u;
      }
      float p[16];
      osm_step(sv, vm, m, l, Ob, p);
      pv_tile(vwf + (size_t)T * 4096, p, Ob, lane);
    }
    l += __shfl_xor(l, 32);
    const float inv = (l > 0.f) ? g2 / l : 0.f;
    ot_accum(otL, lane, Ob, inv);
  }
  {
    float ss = 0.f;
#pragma unroll
    for (int dt = 0; dt < 4; ++dt)
#pragma unroll
      for (int i = 0; i < 16; ++i) ss = fmaf(Ob[dt][i], Ob[dt][i], ss);
    ss += __shfl_xor(ss, 32);
    const float rs = rsqrtf(ss * (1.f / 128.f) + 1e-6f);
    bf16_t* orow = P.mix + (size_t)t * DM + hd * 128 + 4 * h;
    const float* grow = P.hng + hd * 128 + 4 * h;
#pragma unroll
    for (int dt = 0; dt < 4; ++dt)
#pragma unroll
      for (int a = 0; a < 4; ++a) {
        const f32x4 gv = *(const f32x4*)(grow + 32 * dt + 8 * a);
        u32x2 w = {pack2(Ob[dt][4 * a] * rs * gv[0], Ob[dt][4 * a + 1] * rs * gv[1]), pack2(Ob[dt][4 * a + 2] * rs * gv[2], Ob[dt][4 * a + 3] * rs * gv[3])};
        *(u32x2*)(orow + 32 * dt + 8 * a) = w;
      }
  }
}

__device__ void d_convmix(int t, int tl, const bf16_t* __restrict__ proj, const float* __restrict__ convw, const float* __restrict__ hng,
                          bf16_t* __restrict__ mix) {
  const int c = tl * 8;
  float acc[8];
#pragma unroll
  for (int i = 0; i < 8; ++i) acc[i] = 0.f;
#pragma unroll
  for (int j = 0; j < 3; ++j) {
    const int tt = t - 2 + j;
    if (tt >= 0) {
      const u32x4 cu = *(const u32x4*)(proj + (size_t)tt * INWP + OFF_C + c);
      const u32x4 uu = *(const u32x4*)(proj + (size_t)tt * INWP + OFF_U + c);
      const f32x4 w0 = *(const f32x4*)(convw + j * 1024 + c), w1 = *(const f32x4*)(convw + j * 1024 + c + 4);
#pragma unroll
      for (int i = 0; i < 4; ++i) {
        const unsigned a = cu[i], b = uu[i];
        const float wl = (i < 2) ? w0[2 * i] : w1[2 * i - 4], wh = (i < 2) ? w0[2 * i + 1] : w1[2 * i - 3];
        acc[2 * i] = fmaf(wl * __uint_as_float(a << 16), __uint_as_float(b << 16), acc[2 * i]);
        acc[2 * i + 1] = fmaf(wh * __uint_as_float(a & 0xFFFF0000u), __uint_as_float(b & 0xFFFF0000u), acc[2 * i + 1]);
      }
    }
  }
  const u32x4 bb = *(const u32x4*)(proj + (size_t)t * INWP + OFF_B + c);
  float ss = 0.f;
#pragma unroll
  for (int i = 0; i < 4; ++i) {
    const unsigned b = bb[i];
    acc[2 * i] *= __uint_as_float(b << 16); acc[2 * i + 1] *= __uint_as_float(b & 0xFFFF0000u);
    ss = fmaf(acc[2 * i], acc[2 * i], ss); ss = fmaf(acc[2 * i + 1], acc[2 * i + 1], ss);
  }
  ss += __shfl_xor(ss, 8); ss += __shfl_xor(ss, 4); ss += __shfl_xor(ss, 2); ss += __shfl_xor(ss, 1);
  const float rs = rsqrtf(ss * (1.f / 128.f) + 1e-6f);
  const f32x4 g0 = *(const f32x4*)(hng + 1024 + c), g1 = *(const f32x4*)(hng + 1024 + c + 4);
  u32x4 o = {pack2(acc[0] * rs * g0[0], acc[1] * rs * g0[1]), pack2(acc[2] * rs * g0[2], acc[3] * rs * g0[3]),
             pack2(acc[4] * rs * g1[0], acc[5] * rs * g1[1]), pack2(acc[6] * rs * g1[2], acc[7] * rs * g1[3])};
  *(u32x4*)(mix + (size_t)t * DM + 1024 + c) = o;
}

__device__ void d_ln(int t, char* smem, const float* __restrict__ y, const float* __restrict__ gam, const float* __restrict__ bet,
                     float* __restrict__ hf, bf16_t* __restrict__ hb) {
  float* red = (float*)smem;
  const int tid = (TIDX & 255);
  float v[8]; float s = 0.f;
  for (int i = 0; i < 8; ++i) { v[i] = y[(size_t)t * DM + tid + i * 256]; s += v[i]; }
  s = wave_sum(s); if ((tid & 63) == 0) red[tid >> 6] = s; __syncthreads();
  float mu = (red[0] + red[1] + red[2] + red[3]) * (1.f / DM);
  float q = 0.f; for (int i = 0; i < 8; ++i) { float d = v[i] - mu; q += d * d; }
  q = wave_sum(q); if ((tid & 63) == 0) red[4 + (tid >> 6)] = q; __syncthreads();
  float var = (red[4] + red[5] + red[6] + red[7]) * (1.f / DM);
  float rs = rsqrtf(var + 1e-5f);
  for (int i = 0; i < 8; ++i) {
    int c = tid + i * 256; float o = (v[i] - mu) * rs * gam[c] + bet[c];
    if (hf) hf[(size_t)t * DM + c] = o;
    if (hb) hb[(size_t)t * DM + c] = f2bf(o);
  }
  __syncthreads();
}


__device__ void d_cvt_w1f(size_t c, const float* __restrict__ w1, bf16_t* __restrict__ w1f) {
  const int lane = c & 63, ks = (c >> 6) & 255, ct = c >> 14;
  const int col = lane & 31, h = lane >> 5;
  bf16_t v[8];
#pragma unroll
  for (int j = 0; j < 8; ++j) v[j] = f2bf(w1[(size_t)(16 * ks + 8 * h + j) * 512 + 32 * ct + col]);
  u32x4 o; o.x = v[0] | ((unsigned)v[1] << 16); o.y = v[2] | ((unsigned)v[3] << 16); o.z = v[4] | ((unsigned)v[5] << 16); o.w = v[6] | ((unsigned)v[7] << 16);
  *(u32x4*)(w1f + c * 8) = o;
}
__device__ void d_cvt_w2f(size_t c, const float* __restrict__ w2, bf16_t* __restrict__ w2f) {
  const int lane = c & 63, s = (c >> 6) & 31, ct = c >> 11;
  const int col = lane & 31, h = lane >> 5;
  bf16_t v[8];
#pragma unroll
  for (int j = 0; j < 8; ++j) v[j] = f2bf(w2[(size_t)(16 * s + 8 * h + j) * 128 + 32 * ct + col]);
  u32x4 o; o.x = v[0] | ((unsigned)v[1] << 16); o.y = v[2] | ((unsigned)v[3] << 16); o.z = v[4] | ((unsigned)v[5] << 16); o.w = v[6] | ((unsigned)v[7] << 16);
  *(u32x4*)(w2f + c * 8) = o;
}
__device__ __forceinline__ void d_compress_unit(int rt, char* smem, const bf16_t* __restrict__ proj, int col0, const float* __restrict__ pos,
                                const bf16_t* __restrict__ w1f, const float* __restrict__ b1, const bf16_t* __restrict__ w2f,
                                bf16_t* __restrict__ outf, bool isV) {
  bf16_t* Xs = (bf16_t*)smem;
  bf16_t* Hs = (bf16_t*)(smem + 2 * 8704);
  const int tid = TIDX, lane = tid & 63, w = tid >> 6, c = lane & 31, h = lane >> 5;
  const int R0 = rt * 32;
  const int srow = tid >> 4, sch = tid & 15;
  const int grow = R0 + srow, sn = grow >> 1, sg = grow & 1;
  const bool svalid = grow < 2046;
  const bf16_t* sp = proj + (size_t)(16 * sn) * INWP + col0 + sg * 128 + sch * 8;
  f32x16 acc0, acc1;
#pragma unroll
  for (int i = 0; i < 16; ++i) { acc0[i] = 0.f; acc1[i] = 0.f; }
  u32x4 rx = {0u, 0u, 0u, 0u}; f32x4 rp0, rp1;
#define STAGE_WRITE(buf)                                                                                   \
  {                                                                                                        \
    u32x4 o_;                                                                                              \
    _Pragma("unroll") for (int i = 0; i < 4; ++i) {                                                        \
      const unsigned wv_ = rx[i];                                                                          \
      const float lo = __uint_as_float(wv_ << 16) + ((i < 2) ? rp0[2 * i] : rp1[2 * i - 4]);               \
      const float hi = __uint_as_float(wv_ & 0xFFFF0000u) + ((i < 2) ? rp0[2 * i + 1] : rp1[2 * i - 3]);   \
      o_[i] = pack2(lo, hi);                                                                               \
    }                                                                                                      \
    *(u32x4*)(Xs + (buf) * 4352 + srow * 136 + sch * 8) = o_;                                              \
  }
  if (svalid) rx = *(const u32x4*)(sp);
  rp0 = *(const f32x4*)(pos + sch * 8); rp1 = *(const f32x4*)(pos + sch * 8 + 4);
  STAGE_WRITE(0)
  __syncthreads();
  const bf16_t* wb0 = w1f + ((size_t)(2 * w) * 256 * 64 + lane) * 8;
  const bf16_t* wb1 = w1f + ((size_t)(2 * w + 1) * 256 * 64 + lane) * 8;
#pragma unroll 1
  for (int l = 0; l < 32; ++l) {
    if (l + 1 < 32) {
      if (svalid) rx = *(const u32x4*)(sp + (size_t)(l + 1) * INWP);
      rp0 = *(const f32x4*)(pos + (l + 1) * 128 + sch * 8); rp1 = *(const f32x4*)(pos + (l + 1) * 128 + sch * 8 + 4);
    }
    const bf16_t* xa = Xs + (l & 1) * 4352 + c * 136 + 8 * h;
#pragma unroll
    for (int s8 = 0; s8 < 8; ++s8) {
      const bf16x8 a = *(const bf16x8*)(xa + 16 * s8);
      const bf16x8 b0 = *(const bf16x8*)(wb0 + (size_t)(8 * l + s8) * 512);
      const bf16x8 b1v = *(const bf16x8*)(wb1 + (size_t)(8 * l + s8) * 512);
      acc0 = MFMA32(a, b0, acc0);
      acc1 = MFMA32(a, b1v, acc1);
    }
    if (l + 1 < 32) STAGE_WRITE((l + 1) & 1)
    __syncthreads();
  }
  {
    const float bb0 = b1[64 * w + c], bb1 = b1[64 * w + 32 + c];
#pragma unroll
    for (int rg = 0; rg < 16; ++rg) {
      const int row = (rg & 3) + 8 * (rg >> 2) + 4 * h;
      Hs[row * 520 + 64 * w + c] = f2bf(gelu_tanh(acc0[rg] + bb0));
      Hs[row * 520 + 64 * w + 32 + c] = f2bf(gelu_tanh(acc1[rg] + bb1));
    }
  }
  __syncthreads();
  if (w < 4) {
    f32x16 o2;
#pragma unroll
    for (int i = 0; i < 16; ++i) o2[i] = 0.f;
    const bf16_t* ha = Hs + c * 520 + 8 * h;
    const bf16_t* wb = w2f + ((size_t)w * 32 * 64 + lane) * 8;
#pragma unroll 8
    for (int s2 = 0; s2 < 32; ++s2) {
      const bf16x8 a = *(const bf16x8*)(ha + 16 * s2);
      const bf16x8 b = *(const bf16x8*)(wb + (size_t)s2 * 512);
      o2 = MFMA32(a, b, o2);
    }
    const int d = 32 * w + c;
#pragma unroll
    for (int rg = 0; rg < 16; ++rg) {
      const int row = R0 + (rg & 3) + 8 * (rg >> 2) + 4 * h;
      const int n = row >> 1, g = row & 1;
      const bf16_t val = (row < 2046) ? f2bf(o2[rg]) : (bf16_t)0;
      const int T = n >> 5, nn = n & 31;
      size_t idx;
      if (!isV) idx = ((((size_t)(g * 32 + T) * 8 + (d >> 4)) * 64 + (pi_perm(nn) + 32 * ((d >> 3) & 1))) * 8 + (d & 7));
      else idx = (((((size_t)(g * 32 + T) * 4 + (d >> 5)) * 2 + (nn >> 4)) * 64 + ((d & 31) + 32 * ((nn >> 3) & 1))) * 8 + (nn & 7));
      outf[idx] = val;
    }
  }
  __syncthreads();
}


DI unsigned f2sort(float f) { unsigned u = __float_as_uint(f); return u ^ ((unsigned)((int)u >> 31) | 0x80000000u); }
DI float sort2f(unsigned k) { unsigned u = (k & 0x80000000u) ? (k ^ 0x80000000u) : ~k; return __uint_as_float(u); }
template <int N>
DI void bitonic_sort_desc(unsigned (&key)[N]) {
#pragma unroll
  for (int k = 2; k <= N; k <<= 1) {
#pragma unroll
    for (int jj = k >> 1; jj > 0; jj >>= 1) {
#pragma unroll
      for (int i = 0; i < N; ++i) {
        const int l2 = i ^ jj;
        if (l2 > i) {
          const bool desc = ((i & k) == 0);
          unsigned a = key[i], b = key[l2];
          unsigned mx = a > b ? a : b, mn = a > b ? b : a;
          key[i] = desc ? mx : mn; key[l2] = desc ? mn : mx;
        }
      }
    }
  }
}
DI void merge_top16(unsigned (&a)[16], const unsigned (&b)[16]) {
#pragma unroll
  for (int i = 0; i < 16; ++i) { unsigned o = b[15 - i]; a[i] = a[i] > o ? a[i] : o; }
#pragma unroll
  for (int jj = 8; jj > 0; jj >>= 1) {
#pragma unroll
    for (int i = 0; i < 16; ++i) {
      const int l2 = i ^ jj;
      if (l2 > i) { unsigned x = a[i], y = a[l2]; a[i] = x > y ? x : y; a[l2] = x > y ? y : x; }
    }
  }
}
__device__ void d_cvt_subk(size_t c, const float* __restrict__ subk, bf16_t* __restrict__ skf) {
  int lane = c & 63, s = (c >> 6) & 7, kt = (c >> 9) & 3, hc = c >> 11;
  int i = lane & 31, h = lane >> 5;
  const float* src = subk + ((size_t)hc * 128 + 32 * kt + i) * 128 + 16 * s + 8 * h;
  bf16_t v[8];
#pragma unroll
  for (int j = 0; j < 8; ++j) v[j] = f2bf(src[j]);
  u32x4 o; o.x = v[0] | ((unsigned)v[1] << 16); o.y = v[2] | ((unsigned)v[3] << 16); o.z = v[4] | ((unsigned)v[5] << 16); o.w = v[6] | ((unsigned)v[7] << 16);
  *(u32x4*)(skf + c * 8) = o;
}

struct EpiProjG {
  static constexpr bool PERM = true, AFTER_DRAIN = false;
  bf16_t* proj; float* gates;
  DI void operator()(const f32x4 (&acc)[2][2][4][2], const pg8::Unit& u, int wr, int wc, int fr, int fq) const {
#pragma unroll
    for (int ai = 0; ai < 2; ++ai)
#pragma unroll
      for (int m = 0; m < 4; ++m) {
        const int row = u.pm * 256 + ai * 128 + wr * 64 + m * 16 + fr;
#pragma unroll
        for (int bj = 0; bj < 2; ++bj) {
          const int c0 = u.pn * 256 + bj * 128 + wc * 32 + 8 * fq;
          const f32x4 v0 = acc[ai][bj][m][0], v1 = acc[ai][bj][m][1];
          if (c0 < INW) {
            u32x4 w = {pack2(v0[0], v0[1]), pack2(v0[2], v0[3]), pack2(v1[0], v1[1]), pack2(v1[2], v1[3])};
            *(u32x4*)(proj + (size_t)row * INWP + c0) = w;
          }
          if (c0 >= OFF_G && c0 < OFF_G + 24) {
            f32x4 g0, g1;
#pragma unroll
            for (int j = 0; j < 4; ++j) { g0[j] = 1.f / (1.f + __expf(-v0[j])); g1[j] = 1.f / (1.f + __expf(-v1[j])); }
            *(f32x4*)(gates + (size_t)row * 24 + (c0 - OFF_G)) = g0;
            *(f32x4*)(gates + (size_t)row * 24 + (c0 - OFF_G) + 4) = g1;
          }
        }
      }
  }
};
struct EpiResG {
  static constexpr bool PERM = false, AFTER_DRAIN = false;
  float* Y; const float* X;
  DI void operator()(const f32x4 (&acc)[2][2][4][2], const pg8::Unit& u, int wr, int wc, int fr, int fq) const {
#pragma unroll
    for (int ai = 0; ai < 2; ++ai)
#pragma unroll
      for (int m = 0; m < 4; ++m) {
        const size_t ro = (size_t)(u.pm * 256 + ai * 128 + wr * 64 + m * 16 + fr) * DM + u.pn * 256 + wc * 32 + 4 * fq;
#pragma unroll
        for (int bj = 0; bj < 2; ++bj)
#pragma unroll
          for (int n = 0; n < 2; ++n) {
            const f32x4 xv = *(const f32x4*)(X + ro + bj * 128 + n * 16);
            *(f32x4*)(Y + ro + bj * 128 + n * 16) = ALPHA * xv + acc[ai][bj][m][n];
          }
      }
  }
};
struct EpiF32G {
  static constexpr bool PERM = false, AFTER_DRAIN = false;
  float* C; int ldc;
  DI void operator()(const f32x4 (&acc)[2][2][4][2], const pg8::Unit& u, int wr, int wc, int fr, int fq) const {
#pragma unroll
    for (int ai = 0; ai < 2; ++ai)
#pragma unroll
      for (int m = 0; m < 4; ++m) {
        const size_t ro = (size_t)(u.pm * 256 + ai * 128 + wr * 64 + m * 16 + fr) * ldc + u.pn * 256 + wc * 32 + 4 * fq;
#pragma unroll
        for (int bj = 0; bj < 2; ++bj)
#pragma unroll
          for (int n = 0; n < 2; ++n) *(f32x4*)(C + ro + bj * 128 + n * 16) = acc[ai][bj][m][n];
      }
  }
};
struct EpiRouteG {
  static constexpr bool PERM = false, AFTER_DRAIN = true;
  const bf16_t* skf; unsigned* tops;
  DI void operator()(const f32x4 (&)[2][2][4][2], const pg8::Unit&, int, int, int, int) const {}
  DI void fused(const f32x4 (&acc)[2][2][4][2], const pg8::Unit& u, int wr, int wc, int fr, int fq, PG8_LAS unsigned char* ldsp, int, int) const {
    const int lane = fr | (fq << 4), wid = wr * 4 + wc;
    bf16_t* Qs = (bf16_t*)ldsp;
#pragma unroll
    for (int ai = 0; ai < 2; ++ai)
#pragma unroll
      for (int m = 0; m < 4; ++m) {
        const int row = ai * 128 + wr * 64 + m * 16 + fr;
#pragma unroll
        for (int bj = 0; bj < 2; ++bj)
#pragma unroll
          for (int n = 0; n < 2; ++n) {
            const f32x4 v = acc[ai][bj][m][n];
            u32x2 w = {pack2(v[0], v[1]), pack2(v[2], v[3])};
            *(u32x2*)(Qs + row * 264 + bj * 128 + wc * 32 + n * 16 + 4 * fq) = w;
          }
      }
    __syncthreads();
    const int c = lane & 31, h = lane >> 5;
#pragma unroll 1
    for (int half = 0; half < 2; ++half) {
      const int hc = u.pn * 2 + half;
      const bf16_t* sk = skf + (size_t)hc * 4 * 4096;
      const bf16_t* qp = Qs + (wid * 32 + c) * 264 + half * 128 + 8 * h;
      unsigned k0[16], k1[16];
#define ROUTE_KT(KT, KA)                                                                        \
      {                                                                                         \
        f32x16 sc;                                                                              \
        _Pragma("unroll") for (int i = 0; i < 16; ++i) sc[i] = 0.f;                             \
        _Pragma("unroll") for (int s = 0; s < 8; ++s) {                                         \
          bf16x8 af = *(const bf16x8*)(sk + (KT) * 4096 + s * 512 + lane * 8);                  \
          bf16x8 bq = *(const bf16x8*)(qp + 16 * s);                                            \
          sc = __builtin_amdgcn_mfma_f32_32x32x16_bf16(af, bq, sc, 0, 0, 0);                    \
        }                                                                                       \
        _Pragma("unroll") for (int rg = 0; rg < 16; ++rg) {                                     \
          const int kidx = 32 * (KT) + (rg & 3) + 8 * (rg >> 2) + 4 * h;                        \
          KA[rg] = (f2sort(sc[rg]) & 0xFFFFFF80u) | (unsigned)(127 - kidx);                     \
        }                                                                                       \
        bitonic_sort_desc<16>(KA);                                                              \
      }
      ROUTE_KT(0, k0)
      __builtin_amdgcn_sched_barrier(0);
      ROUTE_KT(1, k1)
      merge_top16(k0, k1);
      __builtin_amdgcn_sched_barrier(0);
      ROUTE_KT(2, k1)
      merge_top16(k0, k1);
      __builtin_amdgcn_sched_barrier(0);
      ROUTE_KT(3, k1)
      merge_top16(k0, k1);
      __builtin_amdgcn_sched_barrier(0);
#undef ROUTE_KT
#pragma unroll
      for (int i = 0; i < 16; ++i) k1[i] = (unsigned)__shfl_xor((int)k0[i], 32);
      merge_top16(k0, k1);
      if (h == 0) {
        unsigned* dst = tops + ((size_t)(u.pm * 256 + wid * 32 + c) * 16 + hc) * 16;
#pragma unroll
        for (int q4 = 0; q4 < 4; ++q4) { u32x4 o = {k0[4 * q4], k0[4 * q4 + 1], k0[4 * q4 + 2], k0[4 * q4 + 3]}; *(u32x4*)(dst + 4 * q4) = o; }
      }
    }
    __syncthreads();
  }
};

typedef float v2f __attribute__((ext_vector_type(2)));
__device__ void d_cvt_fp8_row(int row, const float* __restrict__ src, unsigned char* __restrict__ dst, float* __restrict__ scale) {
  const int lane = TIDX & 63;
  float v[32]; float amax = 0.f;
#pragma unroll
  for (int q = 0; q < 2; ++q)
#pragma unroll
    for (int i = 0; i < 4; ++i) {
      f32x4 x = *(const f32x4*)(src + (size_t)row * DM + 1024 * q + 16 * lane + 4 * i);
#pragma unroll
      for (int j = 0; j < 4; ++j) { v[q * 16 + i * 4 + j] = x[j]; amax = fmaxf(amax, fabsf(x[j])); }
    }
  amax = wave_max(amax);
  const float sc = amax > 0.f ? amax * (1.f / 448.f) : 1.f;
  const float inv = 1.f / sc;
#pragma unroll
  for (int q = 0; q < 2; ++q) {
    u32x4 o;
#pragma unroll
    for (int i = 0; i < 4; ++i) {
      int w = __builtin_amdgcn_cvt_pk_fp8_f32(v[q * 16 + i * 4] * inv, v[q * 16 + i * 4 + 1] * inv, 0, false);
      w = __builtin_amdgcn_cvt_pk_fp8_f32(v[q * 16 + i * 4 + 2] * inv, v[q * 16 + i * 4 + 3] * inv, w, true);
      o[i] = (unsigned)w;
    }
    *(u32x4*)(dst + (size_t)row * DM + 1024 * q + 16 * lane) = o;
  }
  if (lane == 0) scale[row] = sc;
}
__device__ void d_expert_wave(int t, const float* __restrict__ hf, const unsigned* __restrict__ tops,
                              const unsigned char* __restrict__ eu8, const unsigned char* __restrict__ ev8, const float* __restrict__ su,
                              const float* __restrict__ sv, const float* __restrict__ gam,
                              const float* __restrict__ bet, float* __restrict__ out) {
  const int lane = TIDX & 63;
  float hv[32];
#pragma unroll
  for (int q = 0; q < 2; ++q)
#pragma unroll
    for (int i = 0; i < 4; ++i) {
      f32x4 x = *(const f32x4*)(hf + (size_t)t * DM + 1024 * q + 16 * lane + 4 * i);
#pragma unroll
      for (int j = 0; j < 4; ++j) hv[q * 16 + i * 4 + j] = x[j];
    }
  int e0 = 0, e1 = 0; float w0 = 0.f, w1 = 0.f;
  {
    const int ci = (lane < 16) ? 0 : (lane < 24) ? 1 : (lane < 29) ? 2 : (lane < 33) ? 3 : (lane < 36) ? 4 : (lane < 38) ? 5 : (lane < 40) ? 6
                   : (lane < 42) ? 7 : (lane - 34);
    const int cpre = (ci == 0) ? 0 : (ci == 1) ? 16 : (ci == 2) ? 24 : (ci == 3) ? 29 : (ci == 4) ? 33 : (ci == 5) ? 36 : (ci == 6) ? 38
                     : (ci == 7) ? 40 : (34 + ci);
    const int cj = lane - cpre;
    const bool cvalid = lane < 50;
    const unsigned* tp = tops + (size_t)t * 256;
#pragma unroll 1
    for (int hh = 0; hh < 8; ++hh) {
      unsigned key = 0u;
      if (cvalid) {
        const float sa = sort2f(tp[(2 * hh) * 16 + ci]), sb = sort2f(tp[(2 * hh + 1) * 16 + cj]);
        key = (f2sort(sa + sb) & 0xFFFFFF00u) | (unsigned)(255 - (ci * 16 + cj));
      }
#pragma unroll
      for (int k = 2; k <= 64; k <<= 1) {
#pragma unroll
        for (int jj = k >> 1; jj > 0; jj >>= 1) {
          const unsigned o = (unsigned)__shfl_xor((int)key, jj);
          const bool lower = (lane & jj) == 0;
          const bool desc = (lane & k) == 0 || k == 64;
          const unsigned mx = key > o ? key : o, mn = key > o ? o : key;
          key = (lower == desc) ? mx : mn;
        }
      }
      const int flat = 255 - (int)(key & 255u);
      const int bi = (flat >> 4) & 15, bj = flat & 15;
      const unsigned ka = tp[(2 * hh) * 16 + bi], kb = tp[(2 * hh + 1) * 16 + bj];
      const float sc = sort2f(ka) + sort2f(kb);
      const int ex = (127 - (int)(ka & 127u)) * 128 + (127 - (int)(kb & 127u));
      float mx = sc;
      mx = fmaxf(mx, __shfl_xor(mx, 1)); mx = fmaxf(mx, __shfl_xor(mx, 2)); mx = fmaxf(mx, __shfl_xor(mx, 4)); mx = fmaxf(mx, __shfl_xor(mx, 8));
      const float ev_ = __expf(sc - mx);
      float sm = ev_;
      sm += __shfl_xor(sm, 1); sm += __shfl_xor(sm, 2); sm += __shfl_xor(sm, 4); sm += __shfl_xor(sm, 8);
      const float gv = ev_ / sm;
      const int exs = __shfl(ex, lane & 15); const float gvs = __shfl(gv, lane & 15);
      if ((lane >> 4) == (hh & 3)) { if (hh < 4) { e0 = exs; w0 = gvs; } else { e1 = exs; w1 = gvs; } }
    }
  }
  const float su0 = su[e0], su1 = su[e1], sv0 = sv[e0], sv1 = sv[e1];
  float c0 = 0.f, c1 = 0.f;
#pragma unroll 1
  for (int eb = 0; eb < 128; eb += 8) {
    u32x4 rr[8][2];
#pragma unroll
    for (int k = 0; k < 8; ++k) {
      const int e = eb + k;
      const int id = __shfl((e < 64) ? e0 : e1, e & 63);
      const unsigned char* row = eu8 + (size_t)id * DM + 16 * lane;
      rr[k][0] = *(const u32x4*)(row);
      rr[k][1] = *(const u32x4*)(row + 1024);
    }
#pragma unroll
    for (int k = 0; k < 8; ++k) {
      float a = 0.f;
#pragma unroll
      for (int q = 0; q < 2; ++q)
#pragma unroll
        for (int i = 0; i < 4; ++i) {
          const int w = (int)rr[k][q][i];
          v2f lo = __builtin_amdgcn_cvt_pk_f32_fp8(w, false), hi = __builtin_amdgcn_cvt_pk_f32_fp8(w, true);
          a = fmaf(lo.x, hv[q * 16 + i * 4], a); a = fmaf(lo.y, hv[q * 16 + i * 4 + 1], a);
          a = fmaf(hi.x, hv[q * 16 + i * 4 + 2], a); a = fmaf(hi.y, hv[q * 16 + i * 4 + 3], a);
        }
      a = wave_sum(a);
      const int e = eb + k;
      if (e < 64) { if (lane == e) c0 = w0 * sv0 * gelu_tanh(a * su0); } else { if (lane == e - 64) c1 = w1 * sv1 * gelu_tanh(a * su1); }
      __builtin_amdgcn_sched_barrier(0);
    }
  }
  float acc[32];
#pragma unroll
  for (int i = 0; i < 32; ++i) acc[i] = 0.f;
#pragma unroll 1
  for (int eb = 0; eb < 128; eb += 8) {
    u32x4 rr[8][2]; float cc[8];
#pragma unroll
    for (int k = 0; k < 8; ++k) {
      const int e = eb + k;
      const int id = __shfl((e < 64) ? e0 : e1, e & 63);
      cc[k] = __shfl((e < 64) ? c0 : c1, e & 63);
      const unsigned char* row = ev8 + (size_t)id * DM + 16 * lane;
      rr[k][0] = *(const u32x4*)(row);
      rr[k][1] = *(const u32x4*)(row + 1024);
    }
#pragma unroll
    for (int k = 0; k < 8; ++k) {
#pragma unroll
      for (int q = 0; q < 2; ++q)
#pragma unroll
        for (int i = 0; i < 4; ++i) {
          const int w = (int)rr[k][q][i];
          v2f lo = __builtin_amdgcn_cvt_pk_f32_fp8(w, false), hi = __builtin_amdgcn_cvt_pk_f32_fp8(w, true);
          acc[q * 16 + i * 4] = fmaf(cc[k], lo.x, acc[q * 16 + i * 4]);
          acc[q * 16 + i * 4 + 1] = fmaf(cc[k], lo.y, acc[q * 16 + i * 4 + 1]);
          acc[q * 16 + i * 4 + 2] = fmaf(cc[k], hi.x, acc[q * 16 + i * 4 + 2]);
          acc[q * 16 + i * 4 + 3] = fmaf(cc[k], hi.y, acc[q * 16 + i * 4 + 3]);
        }
      __builtin_amdgcn_sched_barrier(0);
    }
  }
  int le = lane;
  asm volatile("" : "+v"(le) :: "memory");
  float s = 0.f;
#pragma unroll
  for (int q = 0; q < 2; ++q)
#pragma unroll
    for (int i = 0; i < 4; ++i) {
      f32x4 x = *(const f32x4*)(hf + (size_t)t * DM + 1024 * q + 16 * le + 4 * i);
#pragma unroll
      for (int j = 0; j < 4; ++j) { acc[q * 16 + i * 4 + j] = fmaf(ALPHA, x[j], acc[q * 16 + i * 4 + j]); s += acc[q * 16 + i * 4 + j]; }
    }
  s = wave_sum(s);
  const float mu = s * (1.f / DM);
  float qv = 0.f;
#pragma unroll
  for (int i = 0; i < 32; ++i) { const float d = acc[i] - mu; qv += d * d; }
  qv = wave_sum(qv);
  const float rs = rsqrtf(qv * (1.f / DM) + 1e-5f);
#pragma unroll
  for (int q = 0; q < 2; ++q)
#pragma unroll
    for (int i = 0; i < 4; ++i) {
      const int cbase = 1024 * q + 16 * le + 4 * i;
      f32x4 ga = *(const f32x4*)(gam + cbase), ba = *(const f32x4*)(bet + cbase), o;
#pragma unroll
      for (int j = 0; j < 4; ++j) o[j] = (acc[q * 16 + i * 4 + j] - mu) * rs * ga[j] + ba[j];
      *(f32x4*)(out + (size_t)t * DM + cbase) = o;
    }
}

constexpr size_t al256(size_t x) { return (x + 255) & ~(size_t)255; }
constexpr size_t WS_XB = 0;
constexpr size_t WS_PROJ = WS_XB + al256((size_t)S * DM * 2);
constexpr size_t WS_WINT = WS_PROJ + al256((size_t)S * INWP * 2);
constexpr size_t WS_GATES = WS_WINT + al256((size_t)INWG * DM * 2);
constexpr size_t WS_W1KF = WS_GATES + al256((size_t)S * 24 * 4);
constexpr size_t WS_W1VF = WS_W1KF + al256((size_t)512 * 4096 * 2);
constexpr size_t WS_W2KF = WS_W1VF + al256((size_t)512 * 4096 * 2);
constexpr size_t WS_W2VF = WS_W2KF + al256((size_t)512 * 128 * 2);
constexpr size_t WS_VC = WS_W2VF + al256((size_t)512 * 128 * 2) - al256((size_t)2048 * 128 * 4);
constexpr size_t WS_KCF = WS_VC + al256((size_t)2048 * 128 * 4);
constexpr size_t WS_VCF = WS_KCF + al256((size_t)2 * 32 * 4096 * 2);
constexpr size_t WS_KSF = WS_VCF + al256((size_t)2 * 32 * 4096 * 2);
constexpr size_t WS_VSF = WS_KSF + al256((size_t)2 * 512 * 4096 * 2);
constexpr size_t WS_KWF = WS_VSF + al256((size_t)2 * 512 * 4096 * 2);
constexpr size_t WS_VWF = WS_KWF + al256((size_t)2 * 512 * 4096 * 2);
constexpr size_t WS_ENDA = WS_VWF + al256((size_t)2 * 512 * 4096 * 2);
constexpr size_t WS_OATT = WS_ENDA;
constexpr size_t WS_MIX = WS_OATT + al256((size_t)S * 1024 * 4);
constexpr size_t WS_WOUTT = WS_MIX + al256((size_t)S * DM * 2);
constexpr size_t WS_WQT = WS_WOUTT + al256((size_t)DM * DM * 2);
constexpr size_t WS_TOPS = WS_WQT + al256((size_t)DM * DM * 2);
constexpr size_t WS_SKF = WS_TOPS + al256((size_t)S * 256 * 4);
constexpr size_t WS_CTRL = WS_SKF + al256((size_t)16 * 128 * 128 * 2);
constexpr size_t CTRL_BYTES = 32768;
constexpr size_t WS_END = WS_CTRL + CTRL_BYTES;
constexpr size_t WS_Y = WS_PROJ;
constexpr size_t WS_HB = WS_XB;
constexpr size_t WS_EU8 = WS_Y + (size_t)S * DM * 4;
constexpr size_t WS_EV8 = WS_EU8 + (size_t)16384 * DM;
constexpr size_t WS_SU = WS_EV8 + (size_t)16384 * DM;
constexpr size_t WS_SV = WS_SU + 16384 * 4;
static_assert(WS_SV + 16384 * 4 <= WS_ENDA, "expert overlay overflows group A");
static_assert(WS_END <= (size_t)512 * 1024 * 1024, "workspace over 512 MiB");

struct Params {
  const float *x, *w_in, *ck_pos, *ck_w1, *ck_b1, *ck_w2, *cv_pos, *cv_w1, *cv_b1, *cv_w2, *conv_w, *hng, *w_out, *ln1g, *ln1b, *w_query, *subk,
      *eu, *ev, *ln2g, *ln2b;
  float* out;
  char* ws;
};
#define WSP(T, OFF) ((T*)(p.ws + (OFF)))

#define FOR_VB(n) for (int vb = blockIdx.x; vb < (n); vb += gridDim.x)
#define FOR_VB2(n) for (int vb = blockIdx.x * 2 + (TIDX >> 8); vb < (n); vb += gridDim.x * 2)
constexpr int SMEM_BYTES = 8 * 17408;
constexpr int HALF = 36864;

__global__ void __launch_bounds__(512) mega(Params p) {
  __shared__ __attribute__((aligned(16))) char smem[SMEM_BYTES + 16];
  if (TIDX == 0) *(u32x4*)(smem + SMEM_BYTES) = u32x4{0u, 0u, 0u, 0u};
  __syncthreads();
  const XcdBarrier xbar = xcd_barrier_post(WSP(unsigned, WS_CTRL + 1024), (volatile LAS unsigned*)(smem + SMEM_BYTES));
#define smh (smem + (TIDX >> 8) * HALF)
#define wv ((TIDX >> 6))
  constexpr int NWV = 8;
  d_cvt(p.x, WSP(bf16_t, WS_XB), (size_t)S * DM / 4);
  FOR_VB2((INWG / 32) * (DM / 32)) d_cvtT(vb, smh, p.w_in, WSP(bf16_t, WS_WINT), DM, INW, INWG);
  for (size_t c = (size_t)blockIdx.x * 512 + TIDX; c < (size_t)16 * 256 * 64; c += (size_t)gridDim.x * 512) {
    d_cvt_w1f(c, p.ck_w1, WSP(bf16_t, WS_W1KF)); d_cvt_w1f(c, p.cv_w1, WSP(bf16_t, WS_W1VF));
    if (c < (size_t)4 * 32 * 64) { d_cvt_w2f(c, p.ck_w2, WSP(bf16_t, WS_W2KF)); d_cvt_w2f(c, p.cv_w2, WSP(bf16_t, WS_W2VF)); }
  }
  FOR_VB2((DM / 32) * (DM / 32)) d_cvtT(vb, smh, p.w_out, WSP(bf16_t, WS_WOUTT), DM, DM, DM);
  FOR_VB2((DM / 32) * (DM / 32)) d_cvtT(vb, smh, p.w_query, WSP(bf16_t, WS_WQT), DM, DM, DM);
  for (size_t c = (size_t)blockIdx.x * 512 + TIDX; c < (size_t)16 * 4 * 8 * 64; c += (size_t)gridDim.x * 512) d_cvt_subk(c, p.subk, WSP(bf16_t, WS_SKF));
  xcd_barrier(xbar);
  {
    pg8::StaticOrder so; so.init(S, INWG, gridDim.x, blockIdx.x);
    pg8::gemm_phase<EpiProjG, pg8::StaticOrder>((PG8_LAS unsigned char*)smem, pg8::Gemm{WSP(bf16_t, WS_XB), WSP(bf16_t, WS_WINT), S, INWG, DM}, so,
                                                EpiProjG{WSP(bf16_t, WS_PROJ), WSP(float, WS_GATES)}, nullptr);
  }
  xcd_barrier(xbar);
  {
    if (blockIdx.x < 128) {
      const int u = blockIdx.x; const bool isV = u >= 64;
      d_compress_unit(u & 63, smem, WSP(bf16_t, WS_PROJ), isV ? OFF_VC : OFF_KC, isV ? p.cv_pos : p.ck_pos, isV ? WSP(bf16_t, WS_W1VF) : WSP(bf16_t, WS_W1KF),
                      isV ? p.cv_b1 : p.ck_b1, isV ? WSP(bf16_t, WS_W2VF) : WSP(bf16_t, WS_W2KF), isV ? WSP(bf16_t, WS_VCF) : WSP(bf16_t, WS_KCF), isV);
    }
    int* slot = (int*)smem;
    unsigned* ctr = WSP(unsigned, WS_CTRL);
    for (;;) {
      if (TIDX == 0) *slot = (int)atomicAdd(ctr, 1u);
      __syncthreads();
      const int it = *slot;
      __syncthreads();
      if (it >= 2048) break;
      const int tt = TIDX;
      {
        const int T = it >> 2, which = it & 3;
        for (int r = tt; r < 1024; r += 512) {
          const size_t cidx = ((size_t)((r >> 9) * 512 + T)) * 512 + (r & 511);
          if (which == 0) d_relayoutK_bf(cidx, 512, WSP(bf16_t, WS_PROJ), INWP, OFF_KS, WSP(bf16_t, WS_KSF));
          else if (which == 1) d_relayoutV_bf(cidx, 512, WSP(bf16_t, WS_PROJ), INWP, OFF_VS, WSP(bf16_t, WS_VSF));
          else if (which == 2) d_relayoutK_bf(cidx, 512, WSP(bf16_t, WS_PROJ), INWP, OFF_KW, WSP(bf16_t, WS_KWF));
          else d_relayoutV_bf(cidx, 512, WSP(bf16_t, WS_PROJ), INWP, OFF_VW, WSP(bf16_t, WS_VWF));
        }
      }
      for (int q = 0; q < 2; ++q) d_convmix(it * 8 + q * 4 + (tt >> 7), tt & 127, WSP(bf16_t, WS_PROJ), p.conv_w, p.hng, WSP(bf16_t, WS_MIX));
    }
  }
  xcd_barrier(xbar);
  {
    AttnPtrs ap{WSP(bf16_t, WS_PROJ), WSP(float, WS_GATES), WSP(bf16_t, WS_KCF), WSP(bf16_t, WS_VCF), WSP(bf16_t, WS_KSF), WSP(bf16_t, WS_VSF), WSP(bf16_t, WS_KWF), WSP(bf16_t, WS_VWF), WSP(bf16_t, WS_MIX), p.hng};
    for (int item = blockIdx.x * NWV + wv; item < 4096; item += gridDim.x * NWV) d_attn_wave(item, smem + wv * ATT_WSM, ap);
  }
  xcd_barrier(xbar);
  {
    pg8::StaticOrder so; so.init(S, DM, gridDim.x, blockIdx.x);
    pg8::gemm_phase<EpiResG, pg8::StaticOrder>((PG8_LAS unsigned char*)smem, pg8::Gemm{WSP(bf16_t, WS_MIX), WSP(bf16_t, WS_WOUTT), S, DM, DM}, so,
                                               EpiResG{WSP(float, WS_Y), p.x}, nullptr);
  }
  xcd_barrier(xbar);
  FOR_VB2(S) d_ln(vb, smh, WSP(float, WS_Y), p.ln1g, p.ln1b, WSP(float, WS_Y), WSP(bf16_t, WS_HB));
  for (int r = blockIdx.x * NWV + wv; r < 32768; r += gridDim.x * NWV) {
    if (r < 16384) d_cvt_fp8_row(r, p.eu, WSP(unsigned char, WS_EU8), WSP(float, WS_SU)); else d_cvt_fp8_row(r - 16384, p.ev, WSP(unsigned char, WS_EV8), WSP(float, WS_SV));
  }
  xcd_barrier(xbar);
  for (int k = 0; k * (int)gridDim.x < (S / 256) * (DM / 256); ++k) {
    pg8::OneUnit so; so.init(S, DM, gridDim.x, blockIdx.x); so.k = k;
    pg8::gemm_phase<EpiRouteG, pg8::OneUnit>((PG8_LAS unsigned char*)smem, pg8::Gemm{WSP(bf16_t, WS_HB), WSP(bf16_t, WS_WQT), S, DM, DM}, so,
                                             EpiRouteG{WSP(bf16_t, WS_SKF), WSP(unsigned, WS_TOPS)}, nullptr);
    __syncthreads();
  }
  xcd_barrier(xbar);
  for (int t = blockIdx.x * NWV + wv; t < S; t += gridDim.x * NWV) d_expert_wave(t, WSP(float, WS_Y), WSP(unsigned, WS_TOPS), WSP(unsigned char, WS_EU8), WSP(unsigned char, WS_EV8), WSP(float, WS_SU), WSP(float, WS_SV), p.ln2g, p.ln2b, p.out);
}

extern "C" void kernel_launch(void* const* d_in, const int* in_sizes, int n_in, void* d_out, int out_size, void* d_ws, size_t ws_size,
                              hipStream_t stream) {
  Params p{};
  p.x = (const float*)d_in[0]; p.w_in = (const float*)d_in[1]; p.ck_pos = (const float*)d_in[2]; p.ck_w1 = (const float*)d_in[3];
  p.ck_b1 = (const float*)d_in[4]; p.ck_w2 = (const float*)d_in[5]; p.cv_pos = (const float*)d_in[6]; p.cv_w1 = (const float*)d_in[7];
  p.cv_b1 = (const float*)d_in[8]; p.cv_w2 = (const float*)d_in[9]; p.conv_w = (const float*)d_in[10]; p.hng = (const float*)d_in[11];
  p.w_out = (const float*)d_in[12]; p.ln1g = (const float*)d_in[13]; p.ln1b = (const float*)d_in[14]; p.w_query = (const float*)d_in[15];
  p.subk = (const float*)d_in[16]; p.eu = (const float*)d_in[17]; p.ev = (const float*)d_in[18]; p.ln2g = (const float*)d_in[19];
  p.ln2b = (const float*)d_in[20];
  p.out = (float*)d_out;
  p.ws = (char*)d_ws;
  if (ws_size < WS_END) fprintf(stderr, "workspace too small\n");
  static int grid_blocks = 0;
  if (!grid_blocks) {
    int dev = 0, cus = 0, per_cu = 0;
    hipGetDevice(&dev);
    hipDeviceGetAttribute(&cus, hipDeviceAttributeMultiprocessorCount, dev);
    hipOccupancyMaxActiveBlocksPerMultiprocessor(&per_cu, mega, 512, 0);
    if (per_cu > 1) per_cu = 1;
    if (per_cu < 1) per_cu = 1;
    grid_blocks = cus * per_cu;
  }
  hipMemsetAsync((char*)d_ws + WS_CTRL, 0, CTRL_BYTES, stream);
  void* args[] = {&p};
  hipError_t e = hipLaunchCooperativeKernel((void*)mega, dim3(grid_blocks), dim3(512), args, 0, stream);
  if (e != hipSuccess) fprintf(stderr, "cooperative launch failed: %s (grid %d)\n", hipGetErrorString(e), grid_blocks);
}
```

```cpp
#include <hip/hip_runtime.h>
#include <stdint.h>
#include <stdio.h>


#define DI __device__ __forceinline__
static __device__ __forceinline__ int tidx_() { int t = (int)__builtin_amdgcn_workitem_id_x(); asm volatile("" : "+v"(t)); return t; }
#define TIDX (tidx_())
typedef unsigned short bf16_t;
using bf16x8 = __attribute__((ext_vector_type(8))) short;
using f32x4 = __attribute__((ext_vector_type(4))) float;
using u32x4 = __attribute__((ext_vector_type(4))) unsigned;
using u32x2 = __attribute__((ext_vector_type(2))) unsigned;

constexpr int S = 16384, DM = 2048, HD = 128;
constexpr int INW = 5656, INWP = 5760, INWG = 5888;
constexpr int OFF_Q = 0, OFF_KC = 1024, OFF_VC = 1280, OFF_KS = 1536, OFF_VS = 1792, OFF_KW = 2048, OFF_VW = 2304,
              OFF_G = 2560, OFF_U = 2584, OFF_B = 3608, OFF_C = 4632;
constexpr int NCMP = 1023;
constexpr float ALPHA = 1.189207115002721f;
constexpr float QSCALE = 0.08838834764831845f;

DI bf16_t f2bf(float x) { unsigned u = __float_as_uint(x); u += 0x7fffu + ((u >> 16) & 1u); return (bf16_t)(u >> 16); }
DI float bf2f(bf16_t b) { return __uint_as_float(((unsigned)b) << 16); }
DI float gelu_tanh(float x) { float u = 0.7978845608028654f * (x + 0.044715f * x * x * x); return 0.5f * x * (1.f + tanhf(u)); }
DI float wave_sum(float v) { for (int o = 32; o > 0; o >>= 1) v += __shfl_xor(v, o); return v; }
using bf16x2v = __attribute__((ext_vector_type(2))) __bf16;
DI unsigned pack2(float a, float b) { bf16x2v v = {(__bf16)a, (__bf16)b}; return __builtin_bit_cast(unsigned, v); }
DI float wave_max(float v) { for (int o = 32; o > 0; o >>= 1) v = fmaxf(v, __shfl_xor(v, o)); return v; }

namespace pg8 {
#define PG8_LAS __attribute__((address_space(3)))
typedef unsigned short bf16_t;
typedef short bf16x8 __attribute__((ext_vector_type(8)));
typedef float f32x4 __attribute__((ext_vector_type(4)));
typedef unsigned u32x4 __attribute__((ext_vector_type(4)));
constexpr int BM = 256, BK = 64, HALF = 128, HTB = HALF * BK * 2  , STAGE_BYTES = 8 * HTB, NXCD = 8, WGM = 8;

__host__ __device__ __forceinline__ int lds_byte(int r, int c) { const int st = (r >> 4) * 2 + (c >> 5), rr = r & 15, cc = c & 31, ob = rr * 64 + cc * 2; return st * 1024 + (ob ^ (((ob >> 9) & 1) << 5)); }
__host__ __device__ __forceinline__ void stage_rc(int b, int& R, int& C) { const int st = b / 1024, sb = b % 1024, swz = sb ^ (((sb >> 9) & 1) << 5); R = (st >> 1) * 16 + swz / 64; C = (st & 1) * 32 + (swz % 64) / 2; }
__host__ __device__ __forceinline__ int perm32(int rho) { const int n = rho >> 4, i = rho & 15; return 8 * (i >> 2) + 4 * n + (i & 3); }

struct Unit { int pm, pn; };
struct Gemm { const bf16_t* A; const bf16_t* Bt; int M, N, K; };

struct StaticOrder {
    int nM, nN, nwg, G, c;
    __host__ __device__ void init(int M, int N, int G_, int c_) { nM = M / BM; nN = N / BM; nwg = nM * nN; G = G_; c = c_; }
    __host__ __device__ bool next(int i, Unit& u) const {
        const long L = (long)i * G + c; if (L >= nwg) return false;
        int wgid = (int)L; { const int q = nwg / NXCD, r = nwg % NXCD, xcd = wgid % NXCD, off = wgid / NXCD; wgid = (xcd < r ? xcd * (q + 1) : r * (q + 1) + (xcd - r) * q) + off; }
        const int nig = WGM * nN, gid = wgid / nig, fm = gid * WGM, gsz = (nM - fm) < WGM ? (nM - fm) : WGM;
        u.pm = fm + ((wgid % nig) % gsz); u.pn = (wgid % nig) / gsz; return true;
    }
    __device__ __forceinline__ void a_ready(const Unit&) const {}
    __device__ __forceinline__ void done(const Unit&) const {}
};
struct OneUnit : StaticOrder {
    int k;
    __device__ bool next(int i, Unit& u) const { if (i > 0) return false; return StaticOrder::next(k, u); }
};
__device__ __forceinline__ unsigned cvt_pk_bf16(float lo, float hi) { unsigned r; asm volatile("v_cvt_pk_bf16_f32 %0, %1, %2" : "=v"(r) : "v"(lo), "v"(hi)); return r; }
template <class Epi, class Sched, bool STAMP = false>
__device__ __forceinline__ void gemm_phase(PG8_LAS unsigned char* lds, const Gemm g, const Sched& S, const Epi& E, unsigned long long* stamps) {
    const int tid = TIDX, wid = __builtin_amdgcn_readfirstlane(tid >> 6), lane = tid & 63, wr = wid >> 2, wc = wid & 3, fr = lane & 15, fq = lane >> 4;
    const int K = g.K, nt = K / BK;
    int ts_lo = 0, ts_hi = 0, nts = 0; const unsigned long long rt_entry = STAMP ? (unsigned long long)wall_clock64() : 0ull;
#define PG8_STAMP() do { if (STAMP && wid == 0 && nts < 64) { const unsigned long long _c = (unsigned long long)clock64(); \
        ts_lo = (lane == nts) ? (int)(unsigned)_c : ts_lo; ts_hi = (lane == nts) ? (int)(unsigned)(_c >> 32) : ts_hi; ++nts; } } while (0)
    PG8_STAMP();
    unsigned voffA[2], voffB[2];
#pragma unroll
    for (int i = 0; i < 2; ++i) { int R, C; stage_rc(tid * 16 + i * 8192, R, C); const int Rb = Epi::PERM ? ((R & ~31) + perm32(R & 31)) : R;
        voffA[i] = (unsigned)(R * K + C) * 2u; voffB[i] = (unsigned)(Rb * K + C) * 2u; }
    const size_t kstep = (size_t)(BK * 2);
    const size_t hstep = (size_t)HALF * K * 2;
    const size_t tstep = 2 * hstep;
    const unsigned ldsw = (unsigned)wid * 1024u;
    const int aoff = lds_byte(wr * 64 + fr, fq * 8), boff = lds_byte(wc * 32 + fr, fq * 8);
#define PG8_SA(b, h) (((b) * 2 + (h)) * HTB)
#define PG8_SB(b, h) ((4 + (b) * 2 + (h)) * HTB)
#define PG8_STAGE(bufoff, gbase, voff) do { _Pragma("unroll") for (int _i = 0; _i < 2; ++_i) \
        __builtin_amdgcn_global_load_lds((const unsigned*)((const char*)(gbase) + (voff)[_i]), (PG8_LAS unsigned*)(lds + (bufoff) + ldsw + _i * 8192), 16, 0, 0); } while (0)
#define PG8_LDA(dst, b, h) do { _Pragma("unroll") for (int m = 0; m < 4; ++m) _Pragma("unroll") for (int k = 0; k < 2; ++k) dst[m][k] = *(const PG8_LAS bf16x8*)(lds + PG8_SA(b, h) + aoff + m * 2048 + k * 1024); } while (0)
#define PG8_LDB(dst, b, h) do { _Pragma("unroll") for (int n = 0; n < 2; ++n) _Pragma("unroll") for (int k = 0; k < 2; ++k) dst[n][k] = *(const PG8_LAS bf16x8*)(lds + PG8_SB(b, h) + boff + n * 2048 + k * 1024); } while (0)
#define PG8_MMA(ai, bj, At, Bt) do { __builtin_amdgcn_s_setprio(1); _Pragma("unroll") for (int m = 0; m < 4; ++m) _Pragma("unroll") for (int n = 0; n < 2; ++n) _Pragma("unroll") for (int k = 0; k < 2; ++k) \
        acc[ai][bj][m][n] = __builtin_amdgcn_mfma_f32_16x16x32_bf16(Bt[n][k], At[m][k], acc[ai][bj][m][n], 0, 0, 0); __builtin_amdgcn_s_setprio(0); } while (0)
#define PG8_WAIT_V(n) asm volatile("s_waitcnt vmcnt(" #n ")" ::: "memory")
#define PG8_WAIT_L(n) asm volatile("s_waitcnt lgkmcnt(" #n ")" ::: "memory")
#define PG8_BAR __builtin_amdgcn_s_barrier()
#define PG8_SCHED __builtin_amdgcn_sched_barrier(0)
    Unit cur, nxt; int ui = 0;
    if (!S.next(0, cur)) return;
    f32x4 acc[2][2][4][2];
#pragma unroll
    for (int a = 0; a < 2; ++a)
#pragma unroll
        for (int b = 0; b < 2; ++b)
#pragma unroll
            for (int m = 0; m < 4; ++m)
#pragma unroll
                for (int n = 0; n < 2; ++n) acc[a][b][m][n] = (f32x4){0.f, 0.f, 0.f, 0.f};
    bf16x8 At[4][2], B0[2][2], B1[2][2];
    const char* cA = (const char*)g.A + (size_t)cur.pm * tstep; const char* cB = (const char*)g.Bt + (size_t)cur.pn * tstep;
    S.a_ready(cur);
    PG8_STAGE(PG8_SB(0, 0), cB, voffB); PG8_STAGE(PG8_SA(0, 0), cA, voffA); PG8_STAGE(PG8_SB(0, 1), cB + hstep, voffB); PG8_STAGE(PG8_SA(0, 1), cA + hstep, voffA);
    if (wr == 1) PG8_BAR;
    PG8_WAIT_V(4); PG8_BAR;
    PG8_STAGE(PG8_SB(1, 0), cB + kstep, voffB); PG8_STAGE(PG8_SA(1, 0), cA + kstep, voffA); PG8_STAGE(PG8_SB(1, 1), cB + hstep + kstep, voffB);
    PG8_WAIT_V(6); PG8_BAR;
    PG8_STAMP();
    for (;;) {
        const bool has_next = S.next(ui + 1, nxt);
        const char* nA = has_next ? (const char*)g.A + (size_t)nxt.pm * tstep : cA; const char* nB = has_next ? (const char*)g.Bt + (size_t)nxt.pn * tstep : cB;
        for (int t = 0; t < nt; t += 2) {
            const bool last = (t == nt - 2);
            const char* a1 = cA + (size_t)(t + 1) * kstep;
            const char* a2 = last ? nA : cA + (size_t)(t + 2) * kstep; const char* b2 = last ? nB : cB + (size_t)(t + 2) * kstep;
            const char* a3 = a2 + kstep; const char* b3 = b2 + kstep;
            if (last && has_next) S.a_ready(nxt);
            PG8_LDB(B0, 0, 0); PG8_SCHED; PG8_LDA(At, 0, 0); PG8_STAGE(PG8_SA(1, 1), a1 + hstep, voffA);
            PG8_WAIT_L(8); PG8_BAR; PG8_WAIT_L(0); PG8_MMA(0, 0, At, B0); PG8_BAR; PG8_SCHED;
            PG8_LDB(B1, 0, 1); PG8_STAGE(PG8_SB(0, 0), b2, voffB);
            PG8_BAR; PG8_WAIT_L(0); PG8_MMA(0, 1, At, B1); PG8_BAR;
            PG8_LDA(At, 0, 1); PG8_STAGE(PG8_SA(0, 0), a2, voffA);
            PG8_BAR; PG8_WAIT_L(0); PG8_MMA(1, 0, At, B0); PG8_BAR; PG8_SCHED;
            PG8_STAGE(PG8_SB(0, 1), b2 + hstep, voffB);
            PG8_WAIT_V(6); PG8_BAR; PG8_MMA(1, 1, At, B1); PG8_BAR;
            PG8_LDB(B0, 1, 0); PG8_SCHED; PG8_LDA(At, 1, 0); PG8_STAGE(PG8_SA(0, 1), a2 + hstep, voffA);
            PG8_WAIT_L(8); PG8_BAR; PG8_WAIT_L(0); PG8_MMA(0, 0, At, B0); PG8_BAR; PG8_SCHED;
            PG8_LDB(B1, 1, 1); PG8_STAGE(PG8_SB(1, 0), b3, voffB);
            PG8_BAR; PG8_WAIT_L(0); PG8_MMA(0, 1, At, B1); PG8_BAR;
            PG8_LDA(At, 1, 1); PG8_STAGE(PG8_SA(1, 0), a3, voffA);
            PG8_BAR; PG8_WAIT_L(0); PG8_MMA(1, 0, At, B0); PG8_BAR; PG8_SCHED;
            PG8_STAGE(PG8_SB(1, 1), b3 + hstep, voffB);
            PG8_WAIT_V(6); PG8_BAR; PG8_MMA(1, 1, At, B1); PG8_BAR;
        }
        PG8_STAMP();
        if constexpr (!Epi::AFTER_DRAIN) { E(acc, cur, wr, wc, fr, fq); S.done(cur); }
        PG8_STAMP();
        if (!has_next) break;
#pragma unroll
        for (int a = 0; a < 2; ++a)
#pragma unroll
            for (int b = 0; b < 2; ++b)
#pragma unroll
                for (int m = 0; m < 4; ++m)
#pragma unroll
                    for (int n = 0; n < 2; ++n) acc[a][b][m][n] = (f32x4){0.f, 0.f, 0.f, 0.f};
        cur = nxt; cA = nA; cB = nB; ++ui;
    }
    PG8_WAIT_V(0);
    if (wr == 0) PG8_BAR;
    PG8_BAR;
    if constexpr (Epi::AFTER_DRAIN) { E.fused(acc, cur, wr, wc, fr, fq, lds, wid, lane); S.done(cur); }
    PG8_STAMP();
    if (STAMP && wid == 0) { stamps[lane] = lane < nts ? (((unsigned long long)(unsigned)ts_hi << 32) | (unsigned)ts_lo) : 0ull;
        if (lane == 62) stamps[62] = rt_entry; if (lane == 63) stamps[63] = (unsigned long long)wall_clock64(); }
#undef PG8_STAMP
#undef PG8_SA
#undef PG8_SB
#undef PG8_STAGE
#undef PG8_LDA
#undef PG8_LDB
#undef PG8_MMA
#undef PG8_WAIT_V
#undef PG8_WAIT_L
#undef PG8_BAR
#undef PG8_SCHED
}
}

#define XB_TMO      128
#define XB_XCNT(j)  (256  + 64 * (j))
#define XB_XSUB(j)  (1280 + 64 * (j))
#define XB_XGEN(j)  (2304 + 64 * (j))
#define XB_TOP      3328
#define XB_TOPGEN   3392
#define XCD_BAR_WORDS 3456
#define XB_SPIN_CAP (1u << 18)
#define LAS __attribute__((address_space(3)))

__device__ __forceinline__ unsigned xb_ld(unsigned* p)              { return __hip_atomic_load(p, __ATOMIC_RELAXED, __HIP_MEMORY_SCOPE_AGENT); }
__device__ __forceinline__ unsigned xb_add(unsigned* p, unsigned v) { return __hip_atomic_fetch_add(p, v, __ATOMIC_RELAXED, __HIP_MEMORY_SCOPE_AGENT); }
__device__ __forceinline__ unsigned xb_xcc_id() { return (unsigned)__builtin_amdgcn_s_getreg((3 << 11) | 20) & 0xFu; }
#define XB_SPIN(cond, bar) do { unsigned _sp = 0; while (cond) { __builtin_amdgcn_s_sleep(1); \
    if ((++_sp & 255u) == 0u) { if (xb_ld(&(bar)[XB_TMO])) break; if (_sp > XB_SPIN_CAP) { atomicAdd(&(bar)[XB_TMO], 1u); break; } } } } while (0)

struct XcdBarrier {
    unsigned* bar; unsigned x;
    volatile LAS unsigned* st;
};

__device__ __forceinline__ XcdBarrier xcd_barrier_post(unsigned* bar, volatile LAS unsigned* st) {
    XcdBarrier b; b.bar = bar; b.x = xb_xcc_id(); b.st = st;
    if (TIDX == 0) (void)xb_add(&bar[XB_XCNT(b.x)], 1u);
    return b;
}
__device__ __forceinline__ void xcd_barrier_complete(unsigned* bar, unsigned x, unsigned& nloc, unsigned& nx) {
    const unsigned G = gridDim.x * gridDim.y * gridDim.z;
    unsigned sum, cnt, mine, sp = 0u;
    for (;;) {
        sum = 0u; cnt = 0u; mine = 0u;
#pragma unroll
        for (unsigned j = 0; j < 16; ++j) { const unsigned c = xb_ld(&bar[XB_XCNT(j)]); sum += c; cnt += (c > 0u) ? 1u : 0u; mine = (j == x) ? c : mine; }
        if (sum == G) break;
        __builtin_amdgcn_s_sleep(1);
        if ((++sp & 255u) == 0u) { if (xb_ld(&bar[XB_TMO])) break; if (sp > XB_SPIN_CAP) { atomicAdd(&bar[XB_TMO], 1u); break; } }
    }
    nloc = mine > 0u ? mine : 1u; nx = cnt > 0u ? cnt : 1u;
}

__device__ __forceinline__ void xcd_barrier(const XcdBarrier& b) {
    asm volatile("s_waitcnt vmcnt(0)" ::: "memory");
    __syncthreads();
    if (TIDX == 0) {
        unsigned* bar = b.bar;
        __builtin_amdgcn_s_waitcnt(0);
        unsigned nloc = b.st[0], nx = b.st[1];
        if (nloc == 0u) { xcd_barrier_complete(bar, b.x, nloc, nx); b.st[0] = nloc; b.st[1] = nx; }
        const unsigned old = xb_add(&bar[XB_XSUB(b.x)], 1u);
        const unsigned gen = old / nloc;
        if (old + 1u == (gen + 1u) * nloc) {
            __builtin_amdgcn_fence(__ATOMIC_RELEASE, "agent");
            asm volatile("s_waitcnt vmcnt(0)" ::: "memory");
            const unsigned og = xb_add(&bar[XB_TOP], 1u);
            const unsigned tg = og / nx;
            if (og + 1u == (tg + 1u) * nx) xb_add(&bar[XB_TOPGEN], 1u);
            else XB_SPIN(xb_ld(&bar[XB_TOPGEN]) == tg, bar);
            __builtin_amdgcn_fence(__ATOMIC_ACQUIRE, "agent");
            xb_add(&bar[XB_XGEN(b.x)], 1u);
            asm volatile("s_waitcnt vmcnt(0)" ::: "memory");
        } else {
            XB_SPIN(xb_ld(&bar[XB_XGEN(b.x)]) == gen, bar);
            __builtin_amdgcn_fence(__ATOMIC_ACQUIRE, "agent");
            asm volatile("s_waitcnt vmcnt(0)" ::: "memory");
        }
    }
    __syncthreads();
}

__device__ void d_cvt(const float* __restrict__ in, bf16_t* __restrict__ out, size_t n4) {
  size_t i = (size_t)blockIdx.x * blockDim.x + TIDX;
  size_t stride = (size_t)gridDim.x * blockDim.x;
  for (; i < n4; i += stride) { float4 v = ((const float4*)in)[i]; ushort4 o; o.x = f2bf(v.x); o.y = f2bf(v.y); o.z = f2bf(v.z); o.w = f2bf(v.w); ((ushort4*)out)[i] = o; }
}
__device__ void d_cvtT(int vb, char* smem, const float* __restrict__ W, bf16_t* __restrict__ WT, int K, int N, int NP) {
  float (*t)[33] = (float (*)[33])smem;
  int nbx = NP / 32;
  int n0 = (vb % nbx) * 32, k0 = (vb / nbx) * 32;
  int tx = (TIDX & 255) & 31, ty = (TIDX & 255) >> 5;
  for (int i = ty; i < 32; i += 8) { int k = k0 + i, n = n0 + tx; t[i][tx] = (n < N && k < K) ? W[(size_t)k * N + n] : 0.f; }
  __syncthreads();
  for (int i = ty; i < 32; i += 8) { int n = n0 + i, k = k0 + tx; if (n < NP && k < K) WT[(size_t)n * K + k] = f2bf(t[tx][i]); }
  __syncthreads();
}

constexpr int LDS_LD = 72;
struct EpiProj { bf16_t* proj; float* gates; };
struct EpiF32 { float* C; int ldc; int N; };
struct EpiRes { float* C; const float* X; };


#define ELEMWISE_TILE                                                                              \
  DI void tile(f32x4 (&acc)[4][4], char*, int m0, int n0, int, int wm, int wn, int, int lane) const { \
    _Pragma("unroll") for (int i = 0; i < 4; ++i)                                                  \
    _Pragma("unroll") for (int j = 0; j < 4; ++j)                                                  \
    _Pragma("unroll") for (int r = 0; r < 4; ++r) {                                                \
      int row = m0 + wm * 64 + i * 16 + (lane >> 4) * 4 + r;                                       \
      int col = n0 + wn * 64 + j * 16 + (lane & 15);                                               \
      (*this)(row, col, acc[i][j][r]);                                                             \
    }                                                                                              \
  }
template <class Epi>
__device__ void d_gemm(int vb, char* smem, const bf16_t* __restrict__ A, int lda, const bf16_t* __restrict__ BT, int ldb, int K,
                       int tilesM, Epi epi) {
  bf16_t* As = (bf16_t*)smem;
  bf16_t* Bs = As + 256 * LDS_LD;
  const int tid = TIDX, lane = tid & 63, wid = tid >> 6;
  const int wm = wid >> 1, wn = wid & 1;
  const int tm = vb % tilesM, tn = vb / tilesM;
  const int m0 = tm * 256, n0 = tn * 128;
  f32x4 acc[4][4];
#pragma unroll
  for (int i = 0; i < 4; ++i)
#pragma unroll
    for (int j = 0; j < 4; ++j) acc[i][j] = f32x4{0.f, 0.f, 0.f, 0.f};
  u32x4 ra[4], rb[2];
#define GLOAD(k0_)                                                                  \
  _Pragma("unroll") for (int i = 0; i < 4; ++i) {                                   \
    int c = tid + i * 512; int row = c >> 3, kc = c & 7;                            \
    ra[i] = *(const u32x4*)(A + (size_t)(m0 + row) * lda + (k0_) + kc * 8);         \
  }                                                                                 \
  _Pragma("unroll") for (int i = 0; i < 2; ++i) {                                   \
    int c = tid + i * 512; int row = c >> 3, kc = c & 7;                            \
    rb[i] = *(const u32x4*)(BT + (size_t)(n0 + row) * ldb + (k0_) + kc * 8);        \
  }
  GLOAD(0)
  for (int k0 = 0; k0 < K; k0 += 64) {
    __syncthreads();
#pragma unroll
    for (int i = 0; i < 4; ++i) { int c = tid + i * 512; int row = c >> 3, kc = c & 7; *(u32x4*)(As + row * LDS_LD + kc * 8) = ra[i]; }
#pragma unroll
    for (int i = 0; i < 2; ++i) { int c = tid + i * 512; int row = c >> 3, kc = c & 7; *(u32x4*)(Bs + row * LDS_LD + kc * 8) = rb[i]; }
    __syncthreads();
    if (k0 + 64 < K) { GLOAD(k0 + 64) }
#pragma unroll
    for (int ks = 0; ks < 2; ++ks) {
      bf16x8 a[4], b[4];
#pragma unroll
      for (int i = 0; i < 4; ++i) {
        a[i] = *(const bf16x8*)(As + (wm * 64 + i * 16 + (lane & 15)) * LDS_LD + ks * 32 + (lane >> 4) * 8);
        b[i] = *(const bf16x8*)(Bs + (wn * 64 + i * 16 + (lane & 15)) * LDS_LD + ks * 32 + (lane >> 4) * 8);
      }
#pragma unroll
      for (int i = 0; i < 4; ++i)
#pragma unroll
        for (int j = 0; j < 4; ++j) acc[i][j] = __builtin_amdgcn_mfma_f32_16x16x32_bf16(a[i], b[j], acc[i][j], 0, 0, 0);
    }
  }
  epi.tile(acc, smem, m0, n0, tn, wm, wn, wid, lane);
  __syncthreads();
}
struct EpiProjF {
  bf16_t* proj; float* gates;
  DI void operator()(int row, int col, float v) const {
    if (col < INW) proj[(size_t)row * INWP + col] = f2bf(v);
    if (col >= OFF_G && col < OFF_G + 24) gates[row * 24 + (col - OFF_G)] = 1.f / (1.f + __expf(-v));
  }
  ELEMWISE_TILE
};
struct EpiF32F {
  float* C; int ldc; int N;
  DI void operator()(int row, int col, float v) const { if (col < N) C[(size_t)row * ldc + col] = v; }
  ELEMWISE_TILE
};
struct EpiResF {
  float* C; const float* X;
  DI void operator()(int row, int col, float v) const { C[(size_t)row * DM + col] = ALPHA * X[(size_t)row * DM + col] + v; }
  ELEMWISE_TILE
};

__device__ void d_build_cmp(int row, const bf16_t* __restrict__ proj, int off, const float* __restrict__ pos, bf16_t* __restrict__ Ac) {
  int n = row >> 1, g = row & 1;
  for (int k = (TIDX & 255); k < 4096; k += 256) {
    float v = 0.f;
    if (row < 2046) { int l = k >> 7, d = k & 127; v = bf2f(proj[(size_t)(16 * n + l) * INWP + off + g * 128 + d]) + pos[l * 128 + d]; }
    Ac[(size_t)row * 4096 + k] = f2bf(v);
  }
}
__device__ void d_cmp2(int row, char* smem, const float* __restrict__ hid, const float* __restrict__ b1, const float* __restrict__ w2, float* __restrict__ out) {
  float* a = (float*)smem;
  for (int j = (TIDX & 255); j < 512; j += 256) a[j] = gelu_tanh(hid[(size_t)row * 512 + j] + b1[j]);
  __syncthreads();
  int d = (TIDX & 255) & 127, half = (TIDX & 255) >> 7;
  float s = 0.f;
  for (int j = half * 256; j < half * 256 + 256; ++j) s += a[j] * w2[j * 128 + d];
  float* red = a + 512;
  if (half) red[d] = s;
  __syncthreads();
  if (!half) out[(size_t)row * 128 + d] = s + red[d];
  __syncthreads();
}

using f32x16 = __attribute__((ext_vector_type(16))) float;
using bf16x8v = __attribute__((ext_vector_type(8))) __bf16;
#define MFMA32(a, b, c) __builtin_amdgcn_mfma_f32_32x32x16_bf16((a), (b), (c), 0, 0, 0)
constexpr float LOG2E = 1.4426950408889634f;
constexpr float NEGB = -1e30f;
DI int pi_perm(int i) { return (i & ~12) | ((i & 8) >> 1) | ((i & 4) << 1); }
DI bf16x8 pack8(float a0, float a1, float a2, float a3, float a4, float a5, float a6, float a7) {
  bf16x8v v = {(__bf16)a0, (__bf16)a1, (__bf16)a2, (__bf16)a3, (__bf16)a4, (__bf16)a5, (__bf16)a6, (__bf16)a7};
  return __builtin_bit_cast(bf16x8, v);
}
__device__ void d_relayoutK_bf(size_t c, int NT, const bf16_t* __restrict__ src, int ld, int col0, bf16_t* __restrict__ dst) {
  int lane = c & 63, s = (c >> 6) & 7; size_t tt = c >> 9; int T = tt % NT, g = tt / NT;
  int i = lane & 31, h = lane >> 5;
  int tok = 32 * T + pi_perm(i);
  *(u32x4*)(dst + c * 8) = *(const u32x4*)(src + (size_t)tok * ld + col0 + g * 128 + 16 * s + 8 * h);
}
__device__ void d_relayoutV_bf(size_t c, int NT, const bf16_t* __restrict__ src, int ld, int col0, bf16_t* __restrict__ dst) {
  int lane = c & 63, s2 = (c >> 6) & 1, dt = (c >> 7) & 3; size_t tt = c >> 9; int T = tt % NT, g = tt / NT;
  int dd = lane & 31, h = lane >> 5;
  bf16_t v[8];
#pragma unroll
  for (int j = 0; j < 8; ++j) v[j] = src[(size_t)(32 * T + 16 * s2 + 8 * h + j) * ld + col0 + g * 128 + 32 * dt + dd];
  u32x4 o; o.x = v[0] | ((unsigned)v[1] << 16); o.y = v[2] | ((unsigned)v[3] << 16); o.z = v[4] | ((unsigned)v[5] << 16); o.w = v[6] | ((unsigned)v[7] << 16);
  *(u32x4*)(dst + c * 8) = o;
}
__device__ void d_relayoutK_f32(size_t c, const float* __restrict__ src, bf16_t* __restrict__ dst) {
  int lane = c & 63, s = (c >> 6) & 7; size_t tt = c >> 9; int T = tt % 32, g = tt / 32;
  int i = lane & 31, h = lane >> 5;
  int n = 32 * T + pi_perm(i);
  bf16_t v[8];
#pragma unroll
  for (int j = 0; j < 8; ++j) v[j] = (n < NCMP) ? f2bf(src[((size_t)n * 2 + g) * 128 + 16 * s + 8 * h + j]) : (bf16_t)0;
  u32x4 o; o.x = v[0] | ((unsigned)v[1] << 16); o.y = v[2] | ((unsigned)v[3] << 16); o.z = v[4] | ((unsigned)v[5] << 16); o.w = v[6] | ((unsigned)v[7] << 16);
  *(u32x4*)(dst + c * 8) = o;
}
__device__ void d_relayoutV_f32(size_t c, const float* __restrict__ src, bf16_t* __restrict__ dst) {
  int lane = c & 63, s2 = (c >> 6) & 1, dt = (c >> 7) & 3; size_t tt = c >> 9; int T = tt % 32, g = tt / 32;
  int dd = lane & 31, h = lane >> 5;
  bf16_t v[8];
#pragma unroll
  for (int j = 0; j < 8; ++j) { int n = 32 * T + 16 * s2 + 8 * h + j; v[j] = (n < NCMP) ? f2bf(src[((size_t)n * 2 + g) * 128 + 32 * dt + dd]) : (bf16_t)0; }
  u32x4 o; o.x = v[0] | ((unsigned)v[1] << 16); o.y = v[2] | ((unsigned)v[3] << 16); o.z = v[4] | ((unsigned)v[5] << 16); o.w = v[6] | ((unsigned)v[7] << 16);
  *(u32x4*)(dst + c * 8) = o;
}


__device__ __forceinline__ void d_relayout_tile(int T, char* smem, const bf16_t* __restrict__ proj, int col0, bf16_t* __restrict__ dst, bool isV) {
  bf16_t* Ls = (bf16_t*)smem;
  const int tid = TIDX;
#pragma unroll
  for (int q = 0; q < 2; ++q) {
    const int cidx = tid + q * 512;
    const int g = cidx >> 9, tok = (cidx >> 4) & 31, ch = cidx & 15;
    const u32x4 v = *(const u32x4*)(proj + (size_t)(32 * T + tok) * INWP + col0 + g * 128 + ch * 8);
    *(u32x4*)(Ls + (g * 32 + tok) * 136 + ch * 8) = v;
  }
  __syncthreads();
#pragma unroll
  for (int q = 0; q < 2; ++q) {
    const int oc = tid + q * 512;
    const int g = oc >> 9, r9 = oc & 511, lane = r9 & 63;
    u32x4 o;
    if (!isV) {
      const int s8 = r9 >> 6, i = lane & 31, h = lane >> 5;
      o = *(const u32x4*)(Ls + (g * 32 + pi_perm(i)) * 136 + 16 * s8 + 8 * h);
    } else {
      const int s2 = (r9 >> 6) & 1, dt = r9 >> 7, dd = lane & 31, h = lane >> 5;
      const bf16_t* col = Ls + (g * 32 + 16 * s2 + 8 * h) * 136 + 32 * dt + dd;
      unsigned short e[8];
#pragma unroll
      for (int j = 0; j < 8; ++j) e[j] = col[j * 136];
      o.x = e[0] | ((unsigned)e[1] << 16); o.y = e[2] | ((unsigned)e[3] << 16); o.z = e[4] | ((unsigned)e[5] << 16); o.w = e[6] | ((unsigned)e[7] << 16);
    }
    *(u32x4*)(dst + (((size_t)(g * 512 + T)) * 512 + r9) * 8) = o;
  }
  __syncthreads();
}

struct AttnPtrs {
  const bf16_t* proj; const float* gates;
  const bf16_t *kcf, *vcf, *ksf, *vsf, *kwf, *vwf;
  bf16_t* mix; const float* hng;
};

DI float ex2(float x) { return __builtin_amdgcn_exp2f(x); }
DI void halves(float x, float& lo, float& hi) {
  const unsigned u = __float_as_uint(x);
  auto r = __builtin_amdgcn_permlane32_swap(u, u, false, false);
  lo = __uint_as_float(r[0]); hi = __uint_as_float(r[1]);
}
DI float hmax(float x) { float a, b; halves(x, a, b); return fmaxf(a, b); }
DI float hsum(float x) { float a, b; halves(x, a, b); return a + b; }
DI float dpp_quad(float v, int ctrl_is_xor1) {
  const int iv = __float_as_int(v);
  const int r = ctrl_is_xor1 ? __builtin_amdgcn_update_dpp(iv, iv, 0xB1, 0xF, 0xF, false) : __builtin_amdgcn_update_dpp(iv, iv, 0x4E, 0xF, 0xF, false);
  return __int_as_float(r);
}
DI float quad_sum(float v) { v += dpp_quad(v, 1); v += dpp_quad(v, 0); return v; }
DI void load_k(bf16x8 (&kf)[8], const bf16_t* __restrict__ kt, int lane) {
#pragma unroll
  for (int s = 0; s < 8; ++s) kf[s] = *(const bf16x8*)(kt + s * 512 + lane * 8);
}
DI f32x16 qk_frags(const bf16x8 (&kf)[8], const bf16_t* qL, int lane) {
  f32x16 acc;
#pragma unroll
  for (int i = 0; i < 16; ++i) acc[i] = 0.f;
  const bf16_t* qp = qL + (lane & 31) * 136 + 8 * (lane >> 5);
#pragma unroll
  for (int s = 0; s < 8; ++s) {
    bf16x8 qf = *(const bf16x8*)(qp + 16 * s);
    acc = MFMA32(kf[s], qf, acc);
  }
  return acc;
}
DI void pv_frags(const bf16x8 (&vf)[8], const float (&p)[16], f32x16 (&O)[4]) {
  bf16x8 pf0 = pack8(p[0], p[1], p[2], p[3], p[4], p[5], p[6], p[7]);
  bf16x8 pf1 = pack8(p[8], p[9], p[10], p[11], p[12], p[13], p[14], p[15]);
#pragma unroll
  for (int dt = 0; dt < 4; ++dt) {
    O[dt] = MFMA32(vf[dt * 2], pf0, O[dt]);
    O[dt] = MFMA32(vf[dt * 2 + 1], pf1, O[dt]);
  }
}
DI void osm_step(const float (&sv)[16], float& m, float& l, f32x16 (&O)[4], float (&p)[16]) {
  float tmax = fmaxf(fmaxf(fmaxf(sv[0], sv[1]), fmaxf(sv[2], sv[3])), fmaxf(fmaxf(sv[4], sv[5]), fmaxf(sv[6], sv[7])));
  tmax = fmaxf(tmax, fmaxf(fmaxf(fmaxf(sv[8], sv[9]), fmaxf(sv[10], sv[11])), fmaxf(fmaxf(sv[12], sv[13]), fmaxf(sv[14], sv[15]))));
  tmax = hmax(tmax);
  if (__ballot(tmax - m > 8.f)) {
    const float mn = fmaxf(m, tmax);
    const float alpha = ex2(m - mn);
    l *= alpha; m = mn;
#pragma unroll
    for (int dt = 0; dt < 4; ++dt)
#pragma unroll
      for (int r = 0; r < 16; ++r) O[dt][r] *= alpha;
  }
  float ps0 = 0.f, ps1 = 0.f;
#pragma unroll
  for (int r = 0; r < 16; r += 2) { const float e0 = ex2(sv[r] - m), e1 = ex2(sv[r + 1] - m); p[r] = e0; p[r + 1] = e1; ps0 += e0; ps1 += e1; }
  l += ps0 + ps1;
}
DI void ot_store(char* otL, int lane, const f32x16 (&O)[4], float sc) {
#pragma unroll
  for (int dt = 0; dt < 4; ++dt) {
    u32x4 a, b;
#pragma unroll
    for (int i = 0; i < 4; ++i) { a[i] = pack2(sc * O[dt][2 * i], sc * O[dt][2 * i + 1]); b[i] = pack2(sc * O[dt][8 + 2 * i], sc * O[dt][8 + 2 * i + 1]); }
    *(u32x4*)(otL + lane * 128 + dt * 32) = a;
    *(u32x4*)(otL + lane * 128 + dt * 32 + 16) = b;
  }
}
DI void ot_accum(const char* otL, int lane, f32x16 (&O)[4], float sc) {
#pragma unroll
  for (int dt = 0; dt < 4; ++dt) {
    u32x4 a = *(const u32x4*)(otL + lane * 128 + dt * 32);
    u32x4 b = *(const u32x4*)(otL + lane * 128 + dt * 32 + 16);
#pragma unroll
    for (int i = 0; i < 4; ++i) {
      const unsigned wa = a[i], wb = b[i];
      O[dt][2 * i] = fmaf(sc, O[dt][2 * i], __uint_as_float(wa << 16));
      O[dt][2 * i + 1] = fmaf(sc, O[dt][2 * i + 1], __uint_as_float(wa & 0xFFFF0000u));
      O[dt][8 + 2 * i] = fmaf(sc, O[dt][8 + 2 * i], __uint_as_float(wb << 16));
      O[dt][8 + 2 * i + 1] = fmaf(sc, O[dt][8 + 2 * i + 1], __uint_as_float(wb & 0xFFFF0000u));
    }
  }
}
DI void zero_o(f32x16 (&O)[4]) {
#pragma unroll
  for (int dt = 0; dt < 4; ++dt)
#pragma unroll
    for (int i = 0; i < 16; ++i) O[dt][i] = 0.f;
}

constexpr int ATT_PW = 8704;
constexpr int ATT_R = 4, ATT_D = 3;
constexpr int ATT_RING = 8 * ATT_PW;
constexpr int ATT_LIST = ATT_RING + ATT_R * 16384;
constexpr int ATT_BUNI = ATT_LIST + 2048;
constexpr int ATT_SMEM = ATT_BUNI + 64;
#define LAS3 __attribute__((address_space(3)))
__device__ __forceinline__ void d_select(const float* impL, unsigned* mskL, unsigned* uniL, int cur) {
  const int lane = TIDX & 63;
  const int stok = lane >> 3, sub = lane & 7;
  unsigned key[32];
#pragma unroll
  for (int i4 = 0; i4 < 8; ++i4) {
    f32x4 v = *(const f32x4*)(impL + stok * 256 + sub * 32 + i4 * 4);
#pragma unroll
    for (int e = 0; e < 4; ++e) {
      const int j = sub * 32 + i4 * 4 + e;
      const bool valid = j <= cur;
      const bool forced = (j == 0) || (j == cur) || (j == cur - 1);
      unsigned kb = forced ? 0xFFFFFF00u : (__float_as_uint(v[e]) & 0xFFFFFF00u);
      key[i4 * 4 + e] = valid ? (kb | (unsigned)(255 - j)) : 0u;
    }
  }
#pragma unroll
  for (int k = 2; k <= 32; k <<= 1) {
#pragma unroll
    for (int jj = k >> 1; jj > 0; jj >>= 1) {
#pragma unroll
      for (int i = 0; i < 32; ++i) {
        const int l2 = i ^ jj;
        if (l2 > i) {
          const bool desc = ((i & k) == 0);
          unsigned a = key[i], b = key[l2];
          unsigned mx = a > b ? a : b, mn = a > b ? b : a;
          key[i] = desc ? mx : mn; key[l2] = desc ? mn : mx;
        }
      }
    }
  }
#pragma unroll
  for (int xm = 1; xm < 8; xm <<= 1) {
    unsigned L[16];
#pragma unroll
    for (int i = 0; i < 16; ++i) { unsigned o = (unsigned)__shfl_xor((int)key[15 - i], xm); L[i] = key[i] > o ? key[i] : o; }
#pragma unroll
    for (int jj = 8; jj > 0; jj >>= 1) {
#pragma unroll
      for (int i = 0; i < 16; ++i) {
        const int l2 = i ^ jj;
        if (l2 > i) { unsigned a = L[i], b = L[l2]; L[i] = a > b ? a : b; L[l2] = a > b ? b : a; }
      }
    }
#pragma unroll
    for (int i = 0; i < 16; ++i) key[i] = L[i];
  }
#pragma unroll
  for (int i = 0; i < 16; ++i) {
    if ((i & 7) == sub) {
      const int j = 255 - (int)(key[i] & 255u);
      if (j <= cur) { atomicOr(&mskL[stok * 8 + (j >> 5)], 1u << (j & 31)); atomicOr(&uniL[j >> 5], 1u << (j & 31)); }
    }
  }
}


DI void att_issue(LAS3 unsigned char* ring, int slot, int w, int lane, const bf16_t* kb, const bf16_t* vb, int tile) {
  const char* ks = (const char*)kb + (size_t)tile * 8192 + w * 1024 + lane * 16;
  const char* vs = (const char*)vb + (size_t)tile * 8192 + w * 1024 + lane * 16;
  __builtin_amdgcn_global_load_lds((const unsigned*)ks, (LAS3 unsigned*)(ring + slot * 16384 + w * 1024), 16, 0, 0);
  __builtin_amdgcn_global_load_lds((const unsigned*)vs, (LAS3 unsigned*)(ring + slot * 16384 + 8192 + w * 1024), 16, 0, 0);
}
DI void att_wait(int newer_tiles) {
  if (newer_tiles >= 2) asm volatile("s_waitcnt vmcnt(4)" ::: "memory");
  else if (newer_tiles == 1) asm volatile("s_waitcnt vmcnt(2)" ::: "memory");
  else asm volatile("s_waitcnt vmcnt(0)" ::: "memory");
}
DI f32x16 qk_lds(LAS3 const unsigned char* kt, const bf16x8 (&qf)[8], int lane) {
  f32x16 acc;
#pragma unroll
  for (int i = 0; i < 16; ++i) acc[i] = 0.f;
#pragma unroll
  for (int s8 = 0; s8 < 8; ++s8) {
    const bf16x8 kf = *(LAS3 const bf16x8*)(kt + s8 * 1024 + lane * 16);
    acc = MFMA32(kf, qf[s8], acc);
  }
  return acc;
}
DI void pv_lds(LAS3 const unsigned char* vt, const float (&p)[16], f32x16 (&O)[4], int lane) {
  const bf16x8 pf0 = pack8(p[0], p[1], p[2], p[3], p[4], p[5], p[6], p[7]);
  const bf16x8 pf1 = pack8(p[8], p[9], p[10], p[11], p[12], p[13], p[14], p[15]);
#pragma unroll
  for (int dt = 0; dt < 4; ++dt) {
    const bf16x8 v0 = *(LAS3 const bf16x8*)(vt + (dt * 2) * 1024 + lane * 16);
    const bf16x8 v1 = *(LAS3 const bf16x8*)(vt + (dt * 2 + 1) * 1024 + lane * 16);
    O[dt] = MFMA32(v0, pf0, O[dt]);
    O[dt] = MFMA32(v1, pf1, O[dt]);
  }
}

__device__ __forceinline__ void d_attn_block(int B, int g, char* smem, const AttnPtrs& P) {
  const int tid = TIDX, lane = tid & 63, w = tid >> 6;
  const int c = lane & 31, h = lane >> 5, tokl = c >> 2, r = c & 3;
  const int tok0 = 64 * B + 8 * w;
  const int t = tok0 + tokl, hd = g * 4 + r;
  const float slope2 = exp2f(-(float)(hd + 1)) * LOG2E;
  const float c1 = QSCALE * LOG2E;
  const float ninf = -__builtin_inff();
  char* wsm = smem + w * ATT_PW;
  float* impL = (float*)wsm;
  char* otL = wsm;
  unsigned* mskL = (unsigned*)(wsm + 8192);
  unsigned* uniL = mskL + 64;
  LAS3 unsigned char* ring = (LAS3 unsigned char*)(smem + ATT_RING);
  unsigned short* tl = (unsigned short*)(smem + ATT_LIST);
  unsigned* buni = (unsigned*)(smem + ATT_BUNI);
  const bf16_t* kcf = P.kcf + (size_t)g * 32 * 4096;
  const bf16_t* vcf = P.vcf + (size_t)g * 32 * 4096;
  const bf16_t* ksf = P.ksf + (size_t)g * 512 * 4096;
  const bf16_t* vsf = P.vsf + (size_t)g * 512 * 4096;
  const bf16_t* kwf = P.kwf + (size_t)g * 512 * 4096;
  const bf16_t* vwf = P.vwf + (size_t)g * 512 * 4096;
  bf16x8 qf[8];
  {
    const bf16_t* qrow = P.proj + (size_t)t * INWP + OFF_Q + hd * 128 + 8 * h;
#pragma unroll
    for (int s8 = 0; s8 < 8; ++s8) qf[s8] = *(const bf16x8*)(qrow + 16 * s8);
  }
  const float* gt = P.gates + (size_t)t * 24 + hd * 3;
  const float g0 = gt[0], g1 = gt[1], g2 = gt[2];
  {
    unsigned z0 = 0u;
    asm volatile("" : "+v"(z0));
    u32x4 z = {z0, z0, z0, z0};
#pragma unroll
    for (int i = 0; i < 8; ++i) *(u32x4*)(wsm + (i * 64 + lane) * 16) = z;
    if (lane < 18) *(u32x4*)(wsm + 8192 + lane * 16) = z;
    if (tid < 8) buni[tid] = z0;
  }
  f32x16 Ob[4];
  zero_o(Ob);
  const int nmax = (t >= 31) ? ((t - 31) >> 4) : -1;
  const int nmaxw = (tok0 + 7 >= 31) ? ((tok0 + 7 - 31) >> 4) : -1;
  const int nminw = (tok0 >= 31) ? ((tok0 - 31) >> 4) : -1;
  const int ntcw = (nmaxw + 32) >> 5;
  const int ntcB = (((64 * B + 63 - 31) >> 4) + 32) >> 5;
  const float sl16 = slope2 * 16.f;
  float mC = NEGB, lC = 0.f, invC = 0.f, carry = 0.f;
  {
    const int n = 2 * ntcB;
    asm volatile("s_waitcnt vmcnt(0)" ::: "memory");
#define A_TILE(i_) (((i_) < ntcB) ? (ntcB - 1 - (i_)) : ((i_) - ntcB))
#pragma unroll 1
    for (int j = 0; j < ATT_D && j < n; ++j) att_issue(ring, j, w, lane, kcf, vcf, A_TILE(j));
#pragma unroll 1
    for (int i = 0; i < n; ++i) {
      const int newer = (n - 1 - i < ATT_D - 1) ? (n - 1 - i) : (ATT_D - 1);
      att_wait(newer);
      __builtin_amdgcn_s_barrier();
      asm volatile("" ::: "memory");
      if (i + ATT_D < n) att_issue(ring, (i + ATT_D) % ATT_R, w, lane, kcf, vcf, A_TILE(i + ATT_D));
      const int T = A_TILE(i);
      if (T >= ntcw) continue;
      LAS3 const unsigned char* slot = ring + (i % ATT_R) * 16384;
      const f32x16 acc = qk_lds(slot, qf, lane);
      const float base = slope2 * (float)(512 * T + 128 * h) + slope2 * (15.5f - (float)t);
      const int nb = 32 * T + 8 * h;
      const bool full = (32 * T + 31 <= nminw);
      float sv[16];
#pragma unroll
      for (int rg = 0; rg < 16; ++rg) { const int kk = (rg & 7) + 16 * (rg >> 3); sv[rg] = fmaf(acc[rg], c1, fmaf(sl16, (float)kk, base)); }
      if (!full) {
#pragma unroll
        for (int rg = 0; rg < 16; ++rg) { const int kk = (rg & 7) + 16 * (rg >> 3); sv[rg] = (nb + kk <= nmax) ? sv[rg] : ninf; }
      }
      if (i < ntcB) {
        float tmax = fmaxf(fmaxf(fmaxf(sv[0], sv[1]), fmaxf(sv[2], sv[3])), fmaxf(fmaxf(sv[4], sv[5]), fmaxf(sv[6], sv[7])));
        tmax = fmaxf(tmax, fmaxf(fmaxf(fmaxf(sv[8], sv[9]), fmaxf(sv[10], sv[11])), fmaxf(fmaxf(sv[12], sv[13]), fmaxf(sv[14], sv[15]))));
        tmax = hmax(tmax);
        const float mn = fmaxf(mC, tmax);
        float ps = 0.f;
#pragma unroll
        for (int rg = 0; rg < 16; ++rg) ps += ex2(sv[rg] - mn);
        lC = lC * ex2(mC - mn) + ps; mC = mn;
      } else {
        if (T == 0) { lC = hsum(lC); invC = (lC > 0.f) ? 1.f / lC : 0.f; }
        float p[16];
#pragma unroll
        for (int rg = 0; rg < 16; ++rg) p[rg] = ex2(sv[rg] - mC) * invC;
        float Ga = (p[0] + p[1]) + (p[2] + p[3]), Gb = (p[4] + p[5]) + (p[6] + p[7]);
        float Gc = (p[8] + p[9]) + (p[10] + p[11]), Gd = (p[12] + p[13]) + (p[14] + p[15]);
        float xb, xd; { float a_, b_; halves(p[7], a_, b_); xb = h ? a_ : b_; halves(p[15], a_, b_); xd = h ? a_ : b_; }
        float ia = Ga + (h ? xb : carry);
        float ib = Gb + p[3];
        float ic = Gc + (h ? xd : xb);
        float id = Gd + p[11];
        carry = xd;
        ia = quad_sum(ia); ib = quad_sum(ib); ic = quad_sum(ic); id = quad_sum(id);
        {
          float val = (r == 0) ? ia : (r == 1) ? ib : (r == 2) ? ic : id;
          int j = 8 * T + 2 * h + ((r == 0) ? 0 : (r == 1) ? 1 : (r == 2) ? 4 : 5);
          impL[tokl * 256 + j] = val;
        }
        pv_lds(slot + 8192, p, Ob, lane);
      }
    }
#undef A_TILE
  }
  const int cur = B;
  d_select(impL, mskL, uniL, cur);
  ot_store(otL, lane, Ob, g0);
  zero_o(Ob);
  if (lane < 8) { const unsigned u = uniL[lane]; if (u) atomicOr(&buni[lane], u); }
  __syncthreads();
  int nslc = 0, ntl = 0;
  {
    for (int iw = 7; iw >= 0; --iw) {
      unsigned iuw = __builtin_amdgcn_readfirstlane(buni[iw]);
      while (iuw) {
        const int bit = 31 - __builtin_clz(iuw);
        iuw &= ~(1u << bit);
        const int bb = 32 * iw + bit;
        if (bb < B) { if (lane == 0) tl[ntl] = (unsigned short)(2 * bb + 1); ++ntl; }
        else { if (lane == 0) tl[ntl] = (unsigned short)(2 * bb + 1); ++ntl; }
        if (lane == 0) tl[ntl] = (unsigned short)(2 * bb);
        ++ntl;
      }
    }
    nslc = ntl;
    const int ThiB = 2 * B + 1, TloB = ((64 * B - 511 > 0) ? (64 * B - 511) : 0) >> 5;
    for (int T = ThiB; T >= TloB; --T) { if (lane == 0) tl[ntl] = (unsigned short)T; ++ntl; }
  }
  float m = NEGB, l = 0.f;
  {
    const int n = ntl;
    const int Tlow = ((tok0 - 511 > 0) ? (tok0 - 511) : 0) >> 5, Thiw = (tok0 + 7) >> 5;
#define B_ISSUE(j_, slot_) { const int e_ = __builtin_amdgcn_readfirstlane((int)tl[j_]); if ((j_) < nslc) att_issue(ring, slot_, w, lane, ksf, vsf, e_); else att_issue(ring, slot_, w, lane, kwf, vwf, e_); }
#pragma unroll 1
    for (int j = 0; j < ATT_D && j < n; ++j) B_ISSUE(j, j)
#pragma unroll 1
    for (int i = 0; i < n; ++i) {
      const int newer = (n - 1 - i < ATT_D - 1) ? (n - 1 - i) : (ATT_D - 1);
      att_wait(newer);
      __builtin_amdgcn_s_barrier();
      asm volatile("" ::: "memory");
      if (i + ATT_D < n) B_ISSUE(i + ATT_D, (i + ATT_D) % ATT_R)
      if (i == nslc) {
        l = hsum(l);
        const float inv = (l > 0.f) ? g1 / l : 0.f;
        ot_accum(otL, lane, Ob, inv);
        ot_store(otL, lane, Ob, 1.f);
        zero_o(Ob);
        m = NEGB; l = 0.f;
      }
      const int T = __builtin_amdgcn_readfirstlane((int)tl[i]);
      const int pos0 = 32 * T, pb = pos0 + 8 * h;
      bool full; bool mine = true;
      if (i < nslc) {
        const int bb = T >> 1;
        const unsigned uw = __builtin_amdgcn_readfirstlane(uniL[bb >> 5]);
        if (!((uw >> (bb & 31)) & 1u) || pos0 > tok0 + 7) continue;
        mine = (mskL[tokl * 8 + (bb >> 5)] >> (bb & 31)) & 1u;
        full = (pos0 + 31 <= tok0) && (__ballot(!mine) == 0ull);
      } else {
        if (T < Tlow || T > Thiw) continue;
        full = (pos0 + 31 <= tok0) && (pos0 >= tok0 + 7 - 511);
      }
      LAS3 const unsigned char* slot = ring + (i % ATT_R) * 16384;
      const f32x16 acc = qk_lds(slot, qf, lane);
      const float base = slope2 * (float)(pos0 + 8 * h - t);
      float sv[16], p[16];
#pragma unroll
      for (int rg = 0; rg < 16; ++rg) { const int kk = (rg & 7) + 16 * (rg >> 3); sv[rg] = fmaf(acc[rg], c1, fmaf(slope2, (float)kk, base)); }
      if (!full) {
        if (i < nslc) {
#pragma unroll
          for (int rg = 0; rg < 16; ++rg) { const int kk = (rg & 7) + 16 * (rg >> 3); sv[rg] = (mine && (pb + kk <= t)) ? sv[rg] : ninf; }
        } else {
#pragma unroll
          for (int rg = 0; rg < 16; ++rg) { const int kk = (rg & 7) + 16 * (rg >> 3); const int dw = t - (pb + kk); sv[rg] = ((dw >= 0) && (dw < 512)) ? sv[rg] : ninf; }
        }
      }
      osm_step(sv, m, l, Ob, p);
      pv_lds(slot + 8192, p, Ob, lane);
    }
#undef B_ISSUE
    l = hsum(l);
    const float inv = (l > 0.f) ? g2 / l : 0.f;
    ot_accum(otL, lane, Ob, inv);
  }
  {
    float ss = 0.f;
#pragma unroll
    for (int dt = 0; dt < 4; ++dt)
#pragma unroll
      for (int i = 0; i < 16; ++i) ss = fmaf(Ob[dt][i], Ob[dt][i], ss);
    ss = hsum(ss);
    const float rs = rsqrtf(ss * (1.f / 128.f) + 1e-6f);
    bf16_t* orow = P.mix + (size_t)t * DM + hd * 128 + 4 * h;
    const float* grow = P.hng + hd * 128 + 4 * h;
#pragma unroll
    for (int dt = 0; dt < 4; ++dt)
#pragma unroll
      for (int a = 0; a < 4; ++a) {
        const f32x4 gv = *(const f32x4*)(grow + 32 * dt + 8 * a);
        u32x2 wv2 = {pack2(Ob[dt][4 * a] * rs * gv[0], Ob[dt][4 * a + 1] * rs * gv[1]), pack2(Ob[dt][4 * a + 2] * rs * gv[2], Ob[dt][4 * a + 3] * rs * gv[3])};
        *(u32x2*)(orow + 32 * dt + 8 * a) = wv2;
      }
  }
  asm volatile("s_waitcnt vmcnt(0)" ::: "memory");
  __syncthreads();
}

__device__ void d_convmix(int t, int tl, const bf16_t* __restrict__ proj, const float* __restrict__ convw, const float* __restrict__ hng,
                          bf16_t* __restrict__ mix) {
  const int c = tl * 8;
  float acc[8];
#pragma unroll
  for (int i = 0; i < 8; ++i) acc[i] = 0.f;
#pragma unroll
  for (int j = 0; j < 3; ++j) {
    const int tt = t - 2 + j;
    if (tt >= 0) {
      const u32x4 cu = *(const u32x4*)(proj + (size_t)tt * INWP + OFF_C + c);
      const u32x4 uu = *(const u32x4*)(proj + (size_t)tt * INWP + OFF_U + c);
      const f32x4 w0 = *(const f32x4*)(convw + j * 1024 + c), w1 = *(const f32x4*)(convw + j * 1024 + c + 4);
#pragma unroll
      for (int i = 0; i < 4; ++i) {
        const unsigned a = cu[i], b = uu[i];
        const float wl = (i < 2) ? w0[2 * i] : w1[2 * i - 4], wh = (i < 2) ? w0[2 * i + 1] : w1[2 * i - 3];
        acc[2 * i] = fmaf(wl * __uint_as_float(a << 16), __uint_as_float(b << 16), acc[2 * i]);
        acc[2 * i + 1] = fmaf(wh * __uint_as_float(a & 0xFFFF0000u), __uint_as_float(b & 0xFFFF0000u), acc[2 * i + 1]);
      }
    }
  }
  const u32x4 bb = *(const u32x4*)(proj + (size_t)t * INWP + OFF_B + c);
  float ss = 0.f;
#pragma unroll
  for (int i = 0; i < 4; ++i) {
    const unsigned b = bb[i];
    acc[2 * i] *= __uint_as_float(b << 16); acc[2 * i + 1] *= __uint_as_float(b & 0xFFFF0000u);
    ss = fmaf(acc[2 * i], acc[2 * i], ss); ss = fmaf(acc[2 * i + 1], acc[2 * i + 1], ss);
  }
  ss += __shfl_xor(ss, 8); ss += __shfl_xor(ss, 4); ss += __shfl_xor(ss, 2); ss += __shfl_xor(ss, 1);
  const float rs = rsqrtf(ss * (1.f / 128.f) + 1e-6f);
  const f32x4 g0 = *(const f32x4*)(hng + 1024 + c), g1 = *(const f32x4*)(hng + 1024 + c + 4);
  u32x4 o = {pack2(acc[0] * rs * g0[0], acc[1] * rs * g0[1]), pack2(acc[2] * rs * g0[2], acc[3] * rs * g0[3]),
             pack2(acc[4] * rs * g1[0], acc[5] * rs * g1[1]), pack2(acc[6] * rs * g1[2], acc[7] * rs * g1[3])};
  *(u32x4*)(mix + (size_t)t * DM + 1024 + c) = o;
}

__device__ void d_ln(int t, char* smem, const float* __restrict__ y, const float* __restrict__ gam, const float* __restrict__ bet,
                     float* __restrict__ stats, bf16_t* __restrict__ hb) {
  float* red = (float*)smem;
  const int tid = (TIDX & 255);
  const f32x4 a = *(const f32x4*)(y + (size_t)t * DM + tid * 8), b = *(const f32x4*)(y + (size_t)t * DM + tid * 8 + 4);
  float s = (a[0] + a[1]) + (a[2] + a[3]) + (b[0] + b[1]) + (b[2] + b[3]);
  s = wave_sum(s); if ((tid & 63) == 0) red[tid >> 6] = s; __syncthreads();
  const float mu = (red[0] + red[1] + red[2] + red[3]) * (1.f / DM);
  float q = 0.f;
#pragma unroll
  for (int i = 0; i < 4; ++i) { const float d0 = a[i] - mu, d1 = b[i] - mu; q = fmaf(d0, d0, q); q = fmaf(d1, d1, q); }
  q = wave_sum(q); if ((tid & 63) == 0) red[4 + (tid >> 6)] = q; __syncthreads();
  const float var = (red[4] + red[5] + red[6] + red[7]) * (1.f / DM);
  const float rs = rsqrtf(var + 1e-5f);
  const f32x4 g0 = *(const f32x4*)(gam + tid * 8), g1 = *(const f32x4*)(gam + tid * 8 + 4);
  const f32x4 b0 = *(const f32x4*)(bet + tid * 8), b1 = *(const f32x4*)(bet + tid * 8 + 4);
  u32x4 o = {pack2((a[0] - mu) * rs * g0[0] + b0[0], (a[1] - mu) * rs * g0[1] + b0[1]), pack2((a[2] - mu) * rs * g0[2] + b0[2], (a[3] - mu) * rs * g0[3] + b0[3]),
             pack2((b[0] - mu) * rs * g1[0] + b1[0], (b[1] - mu) * rs * g1[1] + b1[1]), pack2((b[2] - mu) * rs * g1[2] + b1[2], (b[3] - mu) * rs * g1[3] + b1[3])};
  *(u32x4*)(hb + (size_t)t * DM + tid * 8) = o;
  if (tid == 0) { stats[2 * t] = mu; stats[2 * t + 1] = rs; }
  __syncthreads();
}

__device__ void d_cvt_w1f(size_t c, const float* __restrict__ w1, bf16_t* __restrict__ w1f) {
  const int lane = c & 63, ks = (c >> 6) & 255, ct = c >> 14;
  const int col = lane & 31, h = lane >> 5;
  bf16_t v[8];
#pragma unroll
  for (int j = 0; j < 8; ++j) v[j] = f2bf(w1[(size_t)(16 * ks + 8 * h + j) * 512 + 32 * ct + col]);
  u32x4 o; o.x = v[0] | ((unsigned)v[1] << 16); o.y = v[2] | ((unsigned)v[3] << 16); o.z = v[4] | ((unsigned)v[5] << 16); o.w = v[6] | ((unsigned)v[7] << 16);
  *(u32x4*)(w1f + c * 8) = o;
}
__device__ void d_cvt_w2f(size_t c, const float* __restrict__ w2, bf16_t* __restrict__ w2f) {
  const int lane = c & 63, s = (c >> 6) & 31, ct = c >> 11;
  const int col = lane & 31, h = lane >> 5;
  bf16_t v[8];
#pragma unroll
  for (int j = 0; j < 8; ++j) v[j] = f2bf(w2[(size_t)(16 * s + 8 * h + j) * 128 + 32 * ct + col]);
  u32x4 o; o.x = v[0] | ((unsigned)v[1] << 16); o.y = v[2] | ((unsigned)v[3] << 16); o.z = v[4] | ((unsigned)v[5] << 16); o.w = v[6] | ((unsigned)v[7] << 16);
  *(u32x4*)(w2f + c * 8) = o;
}
__device__ __forceinline__ void d_compress_unit(int rt, char* smem, const bf16_t* __restrict__ proj, int col0, const float* __restrict__ pos,
                                const bf16_t* __restrict__ w1f, const float* __restrict__ b1, const bf16_t* __restrict__ w2f,
                                bf16_t* __restrict__ outf, bool isV) {
  bf16_t* Xs = (bf16_t*)smem;
  bf16_t* Hs = (bf16_t*)(smem + 2 * 8704);
  const int tid = TIDX, lane = tid & 63, w = tid >> 6, c = lane & 31, h = lane >> 5;
  const int R0 = rt * 32;
  const int srow = tid >> 4, sch = tid & 15;
  const int grow = R0 + srow, sn = grow >> 1, sg = grow & 1;
  const bool svalid = grow < 2046;
  const bf16_t* sp = proj + (size_t)(16 * sn) * INWP + col0 + sg * 128 + sch * 8;
  f32x16 acc0, acc1;
#pragma unroll
  for (int i = 0; i < 16; ++i) { acc0[i] = 0.f; acc1[i] = 0.f; }
  u32x4 rx = {0u, 0u, 0u, 0u}; f32x4 rp0, rp1;
#define STAGE_WRITE(buf)                                                                                   \
  {                                                                                                        \
    u32x4 o_;                                                                                              \
    _Pragma("unroll") for (int i = 0; i < 4; ++i) {                                                        \
      const unsigned wv_ = rx[i];                                                                          \
      const float lo = __uint_as_float(wv_ << 16) + ((i < 2) ? rp0[2 * i] : rp1[2 * i - 4]);               \
      const float hi = __uint_as_float(wv_ & 0xFFFF0000u) + ((i < 2) ? rp0[2 * i + 1] : rp1[2 * i - 3]);   \
      o_[i] = pack2(lo, hi);                                                                               \
    }                                                                                                      \
    *(u32x4*)(Xs + (buf) * 4352 + srow * 136 + sch * 8) = o_;                                              \
  }
  if (svalid) rx = *(const u32x4*)(sp);
  rp0 = *(const f32x4*)(pos + sch * 8); rp1 = *(const f32x4*)(pos + sch * 8 + 4);
  STAGE_WRITE(0)
  __syncthreads();
  const bf16_t* wb0 = w1f + ((size_t)(2 * w) * 256 * 64 + lane) * 8;
  const bf16_t* wb1 = w1f + ((size_t)(2 * w + 1) * 256 * 64 + lane) * 8;
#pragma unroll 1
  for (int l = 0; l < 32; ++l) {
    if (l + 1 < 32) {
      if (svalid) rx = *(const u32x4*)(sp + (size_t)(l + 1) * INWP);
      rp0 = *(const f32x4*)(pos + (l + 1) * 128 + sch * 8); rp1 = *(const f32x4*)(pos + (l + 1) * 128 + sch * 8 + 4);
    }
    const bf16_t* xa = Xs + (l & 1) * 4352 + c * 136 + 8 * h;
#pragma unroll
    for (int s8 = 0; s8 < 8; ++s8) {
      const bf16x8 a = *(const bf16x8*)(xa + 16 * s8);
      const bf16x8 b0 = *(const bf16x8*)(wb0 + (size_t)(8 * l + s8) * 512);
      const bf16x8 b1v = *(const bf16x8*)(wb1 + (size_t)(8 * l + s8) * 512);
      acc0 = MFMA32(a, b0, acc0);
      acc1 = MFMA32(a, b1v, acc1);
    }
    if (l + 1 < 32) STAGE_WRITE((l + 1) & 1)
    __syncthreads();
  }
  {
    const float bb0 = b1[64 * w + c], bb1 = b1[64 * w + 32 + c];
#pragma unroll
    for (int rg = 0; rg < 16; ++rg) {
      const int row = (rg & 3) + 8 * (rg >> 2) + 4 * h;
      Hs[row * 520 + 64 * w + c] = f2bf(gelu_tanh(acc0[rg] + bb0));
      Hs[row * 520 + 64 * w + 32 + c] = f2bf(gelu_tanh(acc1[rg] + bb1));
    }
  }
  __syncthreads();
  if (w < 4) {
    f32x16 o2;
#pragma unroll
    for (int i = 0; i < 16; ++i) o2[i] = 0.f;
    const bf16_t* ha = Hs + c * 520 + 8 * h;
    const bf16_t* wb = w2f + ((size_t)w * 32 * 64 + lane) * 8;
#pragma unroll 8
    for (int s2 = 0; s2 < 32; ++s2) {
      const bf16x8 a = *(const bf16x8*)(ha + 16 * s2);
      const bf16x8 b = *(const bf16x8*)(wb + (size_t)s2 * 512);
      o2 = MFMA32(a, b, o2);
    }
    const int d = 32 * w + c;
#pragma unroll
    for (int rg = 0; rg < 16; ++rg) {
      const int row = R0 + (rg & 3) + 8 * (rg >> 2) + 4 * h;
      const int n = row >> 1, g = row & 1;
      const bf16_t val = (row < 2046) ? f2bf(o2[rg]) : (bf16_t)0;
      const int T = n >> 5, nn = n & 31;
      size_t idx;
      if (!isV) idx = ((((size_t)(g * 32 + T) * 8 + (d >> 4)) * 64 + (pi_perm(nn) + 32 * ((d >> 3) & 1))) * 8 + (d & 7));
      else idx = (((((size_t)(g * 32 + T) * 4 + (d >> 5)) * 2 + (nn >> 4)) * 64 + ((d & 31) + 32 * ((nn >> 3) & 1))) * 8 + (nn & 7));
      outf[idx] = val;
    }
  }
  __syncthreads();
}


DI unsigned f2sort(float f) { unsigned u = __float_as_uint(f); return u ^ ((unsigned)((int)u >> 31) | 0x80000000u); }
DI float sort2f(unsigned k) { unsigned u = (k & 0x80000000u) ? (k ^ 0x80000000u) : ~k; return __uint_as_float(u); }
template <int N>
DI void bitonic_sort_desc(unsigned (&key)[N]) {
#pragma unroll
  for (int k = 2; k <= N; k <<= 1) {
#pragma unroll
    for (int jj = k >> 1; jj > 0; jj >>= 1) {
#pragma unroll
      for (int i = 0; i < N; ++i) {
        const int l2 = i ^ jj;
        if (l2 > i) {
          const bool desc = ((i & k) == 0);
          unsigned a = key[i], b = key[l2];
          unsigned mx = a > b ? a : b, mn = a > b ? b : a;
          key[i] = desc ? mx : mn; key[l2] = desc ? mn : mx;
        }
      }
    }
  }
}
DI void merge_top16(unsigned (&a)[16], const unsigned (&b)[16]) {
#pragma unroll
  for (int i = 0; i < 16; ++i) { unsigned o = b[15 - i]; a[i] = a[i] > o ? a[i] : o; }
#pragma unroll
  for (int jj = 8; jj > 0; jj >>= 1) {
#pragma unroll
    for (int i = 0; i < 16; ++i) {
      const int l2 = i ^ jj;
      if (l2 > i) { unsigned x = a[i], y = a[l2]; a[i] = x > y ? x : y; a[l2] = x > y ? y : x; }
    }
  }
}
__device__ void d_cvt_subk(size_t c, const float* __restrict__ subk, bf16_t* __restrict__ skf) {
  int lane = c & 63, s = (c >> 6) & 7, kt = (c >> 9) & 3, hc = c >> 11;
  int i = lane & 31, h = lane >> 5;
  const float* src = subk + ((size_t)hc * 128 + 32 * kt + i) * 128 + 16 * s + 8 * h;
  bf16_t v[8];
#pragma unroll
  for (int j = 0; j < 8; ++j) v[j] = f2bf(src[j]);
  u32x4 o; o.x = v[0] | ((unsigned)v[1] << 16); o.y = v[2] | ((unsigned)v[3] << 16); o.z = v[4] | ((unsigned)v[5] << 16); o.w = v[6] | ((unsigned)v[7] << 16);
  *(u32x4*)(skf + c * 8) = o;
}

struct EpiProjG {
  static constexpr bool PERM = true, AFTER_DRAIN = false;
  bf16_t* proj; float* gates;
  DI void operator()(const f32x4 (&acc)[2][2][4][2], const pg8::Unit& u, int wr, int wc, int fr, int fq) const {
#pragma unroll
    for (int ai = 0; ai < 2; ++ai)
#pragma unroll
      for (int m = 0; m < 4; ++m) {
        const int row = u.pm * 256 + ai * 128 + wr * 64 + m * 16 + fr;
#pragma unroll
        for (int bj = 0; bj < 2; ++bj) {
          const int c0 = u.pn * 256 + bj * 128 + wc * 32 + 8 * fq;
          const f32x4 v0 = acc[ai][bj][m][0], v1 = acc[ai][bj][m][1];
          if (c0 < INW) {
            u32x4 w = {pack2(v0[0], v0[1]), pack2(v0[2], v0[3]), pack2(v1[0], v1[1]), pack2(v1[2], v1[3])};
            *(u32x4*)(proj + (size_t)row * INWP + c0) = w;
          }
          if (c0 >= OFF_G && c0 < OFF_G + 24) {
            f32x4 g0, g1;
#pragma unroll
            for (int j = 0; j < 4; ++j) { g0[j] = 1.f / (1.f + __expf(-v0[j])); g1[j] = 1.f / (1.f + __expf(-v1[j])); }
            *(f32x4*)(gates + (size_t)row * 24 + (c0 - OFF_G)) = g0;
            *(f32x4*)(gates + (size_t)row * 24 + (c0 - OFF_G) + 4) = g1;
          }
        }
      }
  }
};
struct EpiResG {
  static constexpr bool PERM = false, AFTER_DRAIN = false;
  float* Y; const float* X;
  DI void operator()(const f32x4 (&acc)[2][2][4][2], const pg8::Unit& u, int wr, int wc, int fr, int fq) const {
#pragma unroll
    for (int ai = 0; ai < 2; ++ai)
#pragma unroll
      for (int m = 0; m < 4; ++m) {
        const size_t ro = (size_t)(u.pm * 256 + ai * 128 + wr * 64 + m * 16 + fr) * DM + u.pn * 256 + wc * 32 + 4 * fq;
#pragma unroll
        for (int bj = 0; bj < 2; ++bj)
#pragma unroll
          for (int n = 0; n < 2; ++n) {
            const f32x4 xv = *(const f32x4*)(X + ro + bj * 128 + n * 16);
            *(f32x4*)(Y + ro + bj * 128 + n * 16) = ALPHA * xv + acc[ai][bj][m][n];
          }
      }
  }
};
struct EpiF32G {
  static constexpr bool PERM = false, AFTER_DRAIN = false;
  float* C; int ldc;
  DI void operator()(const f32x4 (&acc)[2][2][4][2], const pg8::Unit& u, int wr, int wc, int fr, int fq) const {
#pragma unroll
    for (int ai = 0; ai < 2; ++ai)
#pragma unroll
      for (int m = 0; m < 4; ++m) {
        const size_t ro = (size_t)(u.pm * 256 + ai * 128 + wr * 64 + m * 16 + fr) * ldc + u.pn * 256 + wc * 32 + 4 * fq;
#pragma unroll
        for (int bj = 0; bj < 2; ++bj)
#pragma unroll
          for (int n = 0; n < 2; ++n) *(f32x4*)(C + ro + bj * 128 + n * 16) = acc[ai][bj][m][n];
      }
  }
};
struct EpiRouteG {
  static constexpr bool PERM = false, AFTER_DRAIN = true;
  const bf16_t* skf; unsigned* tops;
  DI void operator()(const f32x4 (&)[2][2][4][2], const pg8::Unit&, int, int, int, int) const {}
  DI void fused(const f32x4 (&acc)[2][2][4][2], const pg8::Unit& u, int wr, int wc, int fr, int fq, PG8_LAS unsigned char* ldsp, int, int) const {
    const int lane = fr | (fq << 4), wid = wr * 4 + wc;
    bf16_t* Qs = (bf16_t*)ldsp;
#pragma unroll
    for (int ai = 0; ai < 2; ++ai)
#pragma unroll
      for (int m = 0; m < 4; ++m) {
        const int row = ai * 128 + wr * 64 + m * 16 + fr;
#pragma unroll
        for (int bj = 0; bj < 2; ++bj)
#pragma unroll
          for (int n = 0; n < 2; ++n) {
            const f32x4 v = acc[ai][bj][m][n];
            u32x2 w = {pack2(v[0], v[1]), pack2(v[2], v[3])};
            *(u32x2*)(Qs + row * 264 + bj * 128 + wc * 32 + n * 16 + 4 * fq) = w;
          }
      }
    __syncthreads();
    const int c = lane & 31, h = lane >> 5;
#pragma unroll 1
    for (int half = 0; half < 2; ++half) {
      const int hc = u.pn * 2 + half;
      const bf16_t* sk = skf + (size_t)hc * 4 * 4096;
      const bf16_t* qp = Qs + (wid * 32 + c) * 264 + half * 128 + 8 * h;
      unsigned k0[16], k1[16];
#define ROUTE_KT(KT, KA)                                                                        \
      {                                                                                         \
        f32x16 sc;                                                                              \
        _Pragma("unroll") for (int i = 0; i < 16; ++i) sc[i] = 0.f;                             \
        _Pragma("unroll") for (int s = 0; s < 8; ++s) {                                         \
          bf16x8 af = *(const bf16x8*)(sk + (KT) * 4096 + s * 512 + lane * 8);                  \
          bf16x8 bq = *(const bf16x8*)(qp + 16 * s);                                            \
          sc = __builtin_amdgcn_mfma_f32_32x32x16_bf16(af, bq, sc, 0, 0, 0);                    \
        }                                                                                       \
        _Pragma("unroll") for (int rg = 0; rg < 16; ++rg) {                                     \
          const int kidx = 32 * (KT) + (rg & 3) + 8 * (rg >> 2) + 4 * h;                        \
          KA[rg] = (f2sort(sc[rg]) & 0xFFFFFF80u) | (unsigned)(127 - kidx);                     \
        }                                                                                       \
        bitonic_sort_desc<16>(KA);                                                              \
      }
      ROUTE_KT(0, k0)
      __builtin_amdgcn_sched_barrier(0);
      ROUTE_KT(1, k1)
      merge_top16(k0, k1);
      __builtin_amdgcn_sched_barrier(0);
      ROUTE_KT(2, k1)
      merge_top16(k0, k1);
      __builtin_amdgcn_sched_barrier(0);
      ROUTE_KT(3, k1)
      merge_top16(k0, k1);
      __builtin_amdgcn_sched_barrier(0);
#undef ROUTE_KT
#pragma unroll
      for (int i = 0; i < 16; ++i) k1[i] = (unsigned)__shfl_xor((int)k0[i], 32);
      merge_top16(k0, k1);
      if (h == 0) {
        unsigned* dst = tops + ((size_t)(u.pm * 256 + wid * 32 + c) * 16 + hc) * 16;
#pragma unroll
        for (int q4 = 0; q4 < 4; ++q4) { u32x4 o = {k0[4 * q4], k0[4 * q4 + 1], k0[4 * q4 + 2], k0[4 * q4 + 3]}; *(u32x4*)(dst + 4 * q4) = o; }
      }
    }
    __syncthreads();
  }
};

typedef float v2f __attribute__((ext_vector_type(2)));
__device__ void d_cvt_fp8_row(int row, const float* __restrict__ src, unsigned char* __restrict__ dst, float* __restrict__ scale) {
  const int lane = TIDX & 63;
  float v[32]; float amax = 0.f;
#pragma unroll
  for (int q = 0; q < 2; ++q)
#pragma unroll
    for (int i = 0; i < 4; ++i) {
      f32x4 x = *(const f32x4*)(src + (size_t)row * DM + 1024 * q + 16 * lane + 4 * i);
#pragma unroll
      for (int j = 0; j < 4; ++j) { v[q * 16 + i * 4 + j] = x[j]; amax = fmaxf(amax, fabsf(x[j])); }
    }
  amax = wave_max(amax);
  const float sc = amax > 0.f ? amax * (1.f / 448.f) : 1.f;
  const float inv = 1.f / sc;
#pragma unroll
  for (int q = 0; q < 2; ++q) {
    u32x4 o;
#pragma unroll
    for (int i = 0; i < 4; ++i) {
      int w = __builtin_amdgcn_cvt_pk_fp8_f32(v[q * 16 + i * 4] * inv, v[q * 16 + i * 4 + 1] * inv, 0, false);
      w = __builtin_amdgcn_cvt_pk_fp8_f32(v[q * 16 + i * 4 + 2] * inv, v[q * 16 + i * 4 + 3] * inv, w, true);
      o[i] = (unsigned)w;
    }
    *(u32x4*)(dst + (size_t)row * DM + 1024 * q + 16 * lane) = o;
  }
  if (lane == 0) scale[row] = sc;
}
__device__ void d_expert_wave(int t, const float* __restrict__ yf, const float* __restrict__ stats, const float* __restrict__ g1v, const float* __restrict__ b1v,
                              const unsigned* __restrict__ tops, const unsigned char* __restrict__ eu8, const unsigned char* __restrict__ ev8, const float* __restrict__ su,
                              const float* __restrict__ sv, const float* __restrict__ gam,
                              const float* __restrict__ bet, float* __restrict__ out) {
  const int lane = TIDX & 63;
  const float mu1 = stats[2 * t], rs1 = stats[2 * t + 1];
  float hv[32];
#pragma unroll
  for (int q = 0; q < 2; ++q)
#pragma unroll
    for (int i = 0; i < 4; ++i) {
      const int cb = 1024 * q + 16 * lane + 4 * i;
      const f32x4 x = *(const f32x4*)(yf + (size_t)t * DM + cb), gg = *(const f32x4*)(g1v + cb), bb = *(const f32x4*)(b1v + cb);
#pragma unroll
      for (int j = 0; j < 4; ++j) hv[q * 16 + i * 4 + j] = (x[j] - mu1) * rs1 * gg[j] + bb[j];
    }
  int e0 = 0, e1 = 0; float w0 = 0.f, w1 = 0.f;
  {
    const int ci = (lane < 16) ? 0 : (lane < 24) ? 1 : (lane < 29) ? 2 : (lane < 33) ? 3 : (lane < 36) ? 4 : (lane < 38) ? 5 : (lane < 40) ? 6
                   : (lane < 42) ? 7 : (lane - 34);
    const int cpre = (ci == 0) ? 0 : (ci == 1) ? 16 : (ci == 2) ? 24 : (ci == 3) ? 29 : (ci == 4) ? 33 : (ci == 5) ? 36 : (ci == 6) ? 38
                     : (ci == 7) ? 40 : (34 + ci);
    const int cj = lane - cpre;
    const bool cvalid = lane < 50;
    const unsigned* tp = tops + (size_t)t * 256;
#pragma unroll 1
    for (int hh = 0; hh < 8; ++hh) {
      unsigned key = 0u;
      if (cvalid) {
        const float sa = sort2f(tp[(2 * hh) * 16 + ci]), sb = sort2f(tp[(2 * hh + 1) * 16 + cj]);
        key = (f2sort(sa + sb) & 0xFFFFFF00u) | (unsigned)(255 - (ci * 16 + cj));
      }
#pragma unroll
      for (int k = 2; k <= 64; k <<= 1) {
#pragma unroll
        for (int jj = k >> 1; jj > 0; jj >>= 1) {
          const unsigned o = (unsigned)__shfl_xor((int)key, jj);
          const bool lower = (lane & jj) == 0;
          const bool desc = (lane & k) == 0 || k == 64;
          const unsigned mx = key > o ? key : o, mn = key > o ? o : key;
          key = (lower == desc) ? mx : mn;
        }
      }
      const int flat = 255 - (int)(key & 255u);
      const int bi = (flat >> 4) & 15, bj = flat & 15;
      const unsigned ka = tp[(2 * hh) * 16 + bi], kb = tp[(2 * hh + 1) * 16 + bj];
      const float sc = sort2f(ka) + sort2f(kb);
      const int ex = (127 - (int)(ka & 127u)) * 128 + (127 - (int)(kb & 127u));
      float mx = sc;
      mx = fmaxf(mx, __shfl_xor(mx, 1)); mx = fmaxf(mx, __shfl_xor(mx, 2)); mx = fmaxf(mx, __shfl_xor(mx, 4)); mx = fmaxf(mx, __shfl_xor(mx, 8));
      const float ev_ = __expf(sc - mx);
      float sm = ev_;
      sm += __shfl_xor(sm, 1); sm += __shfl_xor(sm, 2); sm += __shfl_xor(sm, 4); sm += __shfl_xor(sm, 8);
      const float gv = ev_ / sm;
      const int exs = __shfl(ex, lane & 15); const float gvs = __shfl(gv, lane & 15);
      if ((lane >> 4) == (hh & 3)) { if (hh < 4) { e0 = exs; w0 = gvs; } else { e1 = exs; w1 = gvs; } }
    }
  }
  const float su0 = su[e0], su1 = su[e1], sv0 = sv[e0], sv1 = sv[e1];
  float c0 = 0.f, c1 = 0.f;
#pragma unroll 1
  for (int eb = 0; eb < 128; eb += 8) {
    u32x4 rr[8][2];
#pragma unroll
    for (int k = 0; k < 8; ++k) {
      const int e = eb + k;
      const int id = __shfl((e < 64) ? e0 : e1, e & 63);
      const unsigned char* row = eu8 + (size_t)id * DM + 16 * lane;
      rr[k][0] = *(const u32x4*)(row);
      rr[k][1] = *(const u32x4*)(row + 1024);
    }
#pragma unroll
    for (int k = 0; k < 8; ++k) {
      float a = 0.f;
#pragma unroll
      for (int q = 0; q < 2; ++q)
#pragma unroll
        for (int i = 0; i < 4; ++i) {
          const int w = (int)rr[k][q][i];
          v2f lo = __builtin_amdgcn_cvt_pk_f32_fp8(w, false), hi = __builtin_amdgcn_cvt_pk_f32_fp8(w, true);
          a = fmaf(lo.x, hv[q * 16 + i * 4], a); a = fmaf(lo.y, hv[q * 16 + i * 4 + 1], a);
          a = fmaf(hi.x, hv[q * 16 + i * 4 + 2], a); a = fmaf(hi.y, hv[q * 16 + i * 4 + 3], a);
        }
      a = wave_sum(a);
      const int e = eb + k;
      if (e < 64) { if (lane == e) c0 = w0 * sv0 * gelu_tanh(a * su0); } else { if (lane == e - 64) c1 = w1 * sv1 * gelu_tanh(a * su1); }
      __builtin_amdgcn_sched_barrier(0);
    }
  }
  float acc[32];
#pragma unroll
  for (int i = 0; i < 32; ++i) acc[i] = 0.f;
#pragma unroll 1
  for (int eb = 0; eb < 128; eb += 8) {
    u32x4 rr[8][2]; float cc[8];
#pragma unroll
    for (int k = 0; k < 8; ++k) {
      const int e = eb + k;
      const int id = __shfl((e < 64) ? e0 : e1, e & 63);
      cc[k] = __shfl((e < 64) ? c0 : c1, e & 63);
      const unsigned char* row = ev8 + (size_t)id * DM + 16 * lane;
      rr[k][0] = *(const u32x4*)(row);
      rr[k][1] = *(const u32x4*)(row + 1024);
    }
#pragma unroll
    for (int k = 0; k < 8; ++k) {
#pragma unroll
      for (int q = 0; q < 2; ++q)
#pragma unroll
        for (int i = 0; i < 4; ++i) {
          const int w = (int)rr[k][q][i];
          v2f lo = __builtin_amdgcn_cvt_pk_f32_fp8(w, false), hi = __builtin_amdgcn_cvt_pk_f32_fp8(w, true);
          acc[q * 16 + i * 4] = fmaf(cc[k], lo.x, acc[q * 16 + i * 4]);
          acc[q * 16 + i * 4 + 1] = fmaf(cc[k], lo.y, acc[q * 16 + i * 4 + 1]);
          acc[q * 16 + i * 4 + 2] = fmaf(cc[k], hi.x, acc[q * 16 + i * 4 + 2]);
          acc[q * 16 + i * 4 + 3] = fmaf(cc[k], hi.y, acc[q * 16 + i * 4 + 3]);
        }
      __builtin_amdgcn_sched_barrier(0);
    }
  }
  int le = lane;
  asm volatile("" : "+v"(le) :: "memory");
  float s = 0.f;
#pragma unroll
  for (int q = 0; q < 2; ++q)
#pragma unroll
    for (int i = 0; i < 4; ++i) {
      const int cb = 1024 * q + 16 * le + 4 * i;
      const f32x4 x = *(const f32x4*)(yf + (size_t)t * DM + cb), gg = *(const f32x4*)(g1v + cb), bb = *(const f32x4*)(b1v + cb);
#pragma unroll
      for (int j = 0; j < 4; ++j) { const float hj = (x[j] - mu1) * rs1 * gg[j] + bb[j]; acc[q * 16 + i * 4 + j] = fmaf(ALPHA, hj, acc[q * 16 + i * 4 + j]); s += acc[q * 16 + i * 4 + j]; }
    }
  s = wave_sum(s);
  const float mu = s * (1.f / DM);
  float qv = 0.f;
#pragma unroll
  for (int i = 0; i < 32; ++i) { const float d = acc[i] - mu; qv += d * d; }
  qv = wave_sum(qv);
  const float rs = rsqrtf(qv * (1.f / DM) + 1e-5f);
#pragma unroll
  for (int q = 0; q < 2; ++q)
#pragma unroll
    for (int i = 0; i < 4; ++i) {
      const int cbase = 1024 * q + 16 * le + 4 * i;
      f32x4 ga = *(const f32x4*)(gam + cbase), ba = *(const f32x4*)(bet + cbase), o;
#pragma unroll
      for (int j = 0; j < 4; ++j) o[j] = (acc[q * 16 + i * 4 + j] - mu) * rs * ga[j] + ba[j];
      *(f32x4*)(out + (size_t)t * DM + cbase) = o;
    }
}

constexpr size_t al256(size_t x) { return (x + 255) & ~(size_t)255; }
constexpr size_t WS_XB = 0;
constexpr size_t WS_PROJ = WS_XB + al256((size_t)S * DM * 2);
constexpr size_t WS_WINT = WS_PROJ + al256((size_t)S * INWP * 2);
constexpr size_t WS_GATES = WS_WINT + al256((size_t)INWG * DM * 2);
constexpr size_t WS_W1KF = WS_GATES + al256((size_t)S * 24 * 4);
constexpr size_t WS_W1VF = WS_W1KF + al256((size_t)512 * 4096 * 2);
constexpr size_t WS_W2KF = WS_W1VF + al256((size_t)512 * 4096 * 2);
constexpr size_t WS_W2VF = WS_W2KF + al256((size_t)512 * 128 * 2);
constexpr size_t WS_VC = WS_W2VF + al256((size_t)512 * 128 * 2) - al256((size_t)2048 * 128 * 4);
constexpr size_t WS_KCF = WS_VC + al256((size_t)2048 * 128 * 4);
constexpr size_t WS_VCF = WS_KCF + al256((size_t)2 * 32 * 4096 * 2);
constexpr size_t WS_KSF = WS_VCF + al256((size_t)2 * 32 * 4096 * 2);
constexpr size_t WS_VSF = WS_KSF + al256((size_t)2 * 512 * 4096 * 2);
constexpr size_t WS_KWF = WS_VSF + al256((size_t)2 * 512 * 4096 * 2);
constexpr size_t WS_VWF = WS_KWF + al256((size_t)2 * 512 * 4096 * 2);
constexpr size_t WS_ENDA = WS_VWF + al256((size_t)2 * 512 * 4096 * 2);
constexpr size_t WS_OATT = WS_ENDA;
constexpr size_t WS_MIX = WS_OATT + al256((size_t)S * 1024 * 4);
constexpr size_t WS_WOUTT = WS_MIX + al256((size_t)S * DM * 2);
constexpr size_t WS_WQT = WS_WOUTT + al256((size_t)DM * DM * 2);
constexpr size_t WS_TOPS = WS_WQT + al256((size_t)DM * DM * 2);
constexpr size_t WS_SKF = WS_TOPS + al256((size_t)S * 256 * 4);
constexpr size_t WS_STATS = WS_SKF + al256((size_t)16 * 128 * 128 * 2);
constexpr size_t WS_CTRL = WS_STATS + al256((size_t)S * 2 * 4);
constexpr size_t CTRL_BYTES = 32768;
constexpr size_t WS_END = WS_CTRL + CTRL_BYTES;
constexpr size_t WS_Y = WS_PROJ;
constexpr size_t WS_HB = WS_XB;
constexpr size_t WS_EU8 = WS_Y + (size_t)S * DM * 4;
constexpr size_t WS_EV8 = WS_EU8 + (size_t)16384 * DM;
constexpr size_t WS_SU = WS_EV8 + (size_t)16384 * DM;
constexpr size_t WS_SV = WS_SU + 16384 * 4;
static_assert(WS_SV + 16384 * 4 <= WS_ENDA, "expert overlay overflows group A");
static_assert(WS_END <= (size_t)512 * 1024 * 1024, "workspace over 512 MiB");

struct Params {
  const float *x, *w_in, *ck_pos, *ck_w1, *ck_b1, *ck_w2, *cv_pos, *cv_w1, *cv_b1, *cv_w2, *conv_w, *hng, *w_out, *ln1g, *ln1b, *w_query, *subk,
      *eu, *ev, *ln2g, *ln2b;
  float* out;
  char* ws;
};
#define WSP(T, OFF) ((T*)(p.ws + (OFF)))

#define FOR_VB(n) for (int vb = blockIdx.x; vb < (n); vb += gridDim.x)
#define FOR_VB2(n) for (int vb = blockIdx.x * 2 + (TIDX >> 8); vb < (n); vb += gridDim.x * 2)
constexpr int SMEM_BYTES = 143360;
constexpr int HALF = 36864;

__global__ void __launch_bounds__(512) mega(Params p) {
  __shared__ __attribute__((aligned(16))) char smem[SMEM_BYTES + 16];
  if (TIDX == 0) *(u32x4*)(smem + SMEM_BYTES) = u32x4{0u, 0u, 0u, 0u};
  __syncthreads();
  const XcdBarrier xbar = xcd_barrier_post(WSP(unsigned, WS_CTRL + 1024), (volatile LAS unsigned*)(smem + SMEM_BYTES));
#define smh (smem + (TIDX >> 8) * HALF)
#define wv ((TIDX >> 6))
  constexpr int NWV = 8;
  d_cvt(p.x, WSP(bf16_t, WS_XB), (size_t)S * DM / 4);
  FOR_VB2((INWG / 32) * (DM / 32)) d_cvtT(vb, smh, p.w_in, WSP(bf16_t, WS_WINT), DM, INW, INWG);
  for (size_t c = (size_t)blockIdx.x * 512 + TIDX; c < (size_t)16 * 256 * 64; c += (size_t)gridDim.x * 512) {
    d_cvt_w1f(c, p.ck_w1, WSP(bf16_t, WS_W1KF)); d_cvt_w1f(c, p.cv_w1, WSP(bf16_t, WS_W1VF));
    if (c < (size_t)4 * 32 * 64) { d_cvt_w2f(c, p.ck_w2, WSP(bf16_t, WS_W2KF)); d_cvt_w2f(c, p.cv_w2, WSP(bf16_t, WS_W2VF)); }
  }
  FOR_VB2((DM / 32) * (DM / 32)) d_cvtT(vb, smh, p.w_out, WSP(bf16_t, WS_WOUTT), DM, DM, DM);
  FOR_VB2((DM / 32) * (DM / 32)) d_cvtT(vb, smh, p.w_query, WSP(bf16_t, WS_WQT), DM, DM, DM);
  for (size_t c = (size_t)blockIdx.x * 512 + TIDX; c < (size_t)16 * 4 * 8 * 64; c += (size_t)gridDim.x * 512) d_cvt_subk(c, p.subk, WSP(bf16_t, WS_SKF));
  xcd_barrier(xbar);
  {
    pg8::StaticOrder so; so.init(S, INWG, gridDim.x, blockIdx.x);
    pg8::gemm_phase<EpiProjG, pg8::StaticOrder>((PG8_LAS unsigned char*)smem, pg8::Gemm{WSP(bf16_t, WS_XB), WSP(bf16_t, WS_WINT), S, INWG, DM}, so,
                                                EpiProjG{WSP(bf16_t, WS_PROJ), WSP(float, WS_GATES)}, nullptr);
  }
  xcd_barrier(xbar);
  {
    if (blockIdx.x < 128) {
      const int u = blockIdx.x; const bool isV = u >= 64;
      d_compress_unit(u & 63, smem, WSP(bf16_t, WS_PROJ), isV ? OFF_VC : OFF_KC, isV ? p.cv_pos : p.ck_pos, isV ? WSP(bf16_t, WS_W1VF) : WSP(bf16_t, WS_W1KF),
                      isV ? p.cv_b1 : p.ck_b1, isV ? WSP(bf16_t, WS_W2VF) : WSP(bf16_t, WS_W2KF), isV ? WSP(bf16_t, WS_VCF) : WSP(bf16_t, WS_KCF), isV);
    }
    int* slot = (int*)smem;
    unsigned* ctr = WSP(unsigned, WS_CTRL);
    for (;;) {
      if (TIDX == 0) *slot = (int)atomicAdd(ctr, 1u);
      __syncthreads();
      const int it = *slot;
      __syncthreads();
      if (it >= 2048) break;
      const int tt = TIDX;
      {
        const int T = it >> 2, which = it & 3;
        d_relayout_tile(T, smem + 64, WSP(bf16_t, WS_PROJ), (which == 0) ? OFF_KS : (which == 1) ? OFF_VS : (which == 2) ? OFF_KW : OFF_VW,
                        (which == 0) ? WSP(bf16_t, WS_KSF) : (which == 1) ? WSP(bf16_t, WS_VSF) : (which == 2) ? WSP(bf16_t, WS_KWF) : WSP(bf16_t, WS_VWF), (which & 1) != 0);
      }
      for (int q = 0; q < 2; ++q) d_convmix(it * 8 + q * 4 + (tt >> 7), tt & 127, WSP(bf16_t, WS_PROJ), p.conv_w, p.hng, WSP(bf16_t, WS_MIX));
    }
  }
  xcd_barrier(xbar);
  {
    AttnPtrs ap{WSP(bf16_t, WS_PROJ), WSP(float, WS_GATES), WSP(bf16_t, WS_KCF), WSP(bf16_t, WS_VCF), WSP(bf16_t, WS_KSF), WSP(bf16_t, WS_VSF), WSP(bf16_t, WS_KWF), WSP(bf16_t, WS_VWF), WSP(bf16_t, WS_MIX), p.hng};
    for (int it = blockIdx.x; it < 512; it += gridDim.x) {
      const int Bq = (it < 256) ? it : (511 - it), gq = (it < 256) ? 0 : 1;
      d_attn_block(Bq, gq, smem, ap);
    }
  }
  xcd_barrier(xbar);
  {
    pg8::StaticOrder so; so.init(S, DM, gridDim.x, blockIdx.x);
    pg8::gemm_phase<EpiResG, pg8::StaticOrder>((PG8_LAS unsigned char*)smem, pg8::Gemm{WSP(bf16_t, WS_MIX), WSP(bf16_t, WS_WOUTT), S, DM, DM}, so,
                                               EpiResG{WSP(float, WS_Y), p.x}, nullptr);
  }
  xcd_barrier(xbar);
  FOR_VB2(S) d_ln(vb, smh, WSP(float, WS_Y), p.ln1g, p.ln1b, WSP(float, WS_STATS), WSP(bf16_t, WS_HB));
  for (int r = blockIdx.x * NWV + wv; r < 32768; r += gridDim.x * NWV) {
    if (r < 16384) d_cvt_fp8_row(r, p.eu, WSP(unsigned char, WS_EU8), WSP(float, WS_SU)); else d_cvt_fp8_row(r - 16384, p.ev, WSP(unsigned char, WS_EV8), WSP(float, WS_SV));
  }
  xcd_barrier(xbar);
  for (int k = 0; k * (int)gridDim.x < (S / 256) * (DM / 256); ++k) {
    pg8::OneUnit so; so.init(S, DM, gridDim.x, blockIdx.x); so.k = k;
    pg8::gemm_phase<EpiRouteG, pg8::OneUnit>((PG8_LAS unsigned char*)smem, pg8::Gemm{WSP(bf16_t, WS_HB), WSP(bf16_t, WS_WQT), S, DM, DM}, so,
                                             EpiRouteG{WSP(bf16_t, WS_SKF), WSP(unsigned, WS_TOPS)}, nullptr);
    __syncthreads();
  }
  xcd_barrier(xbar);
  for (int t = blockIdx.x * NWV + wv; t < S; t += gridDim.x * NWV) d_expert_wave(t, WSP(float, WS_Y), WSP(float, WS_STATS), p.ln1g, p.ln1b, WSP(unsigned, WS_TOPS), WSP(unsigned char, WS_EU8), WSP(unsigned char, WS_EV8), WSP(float, WS_SU), WSP(float, WS_SV), p.ln2g, p.ln2b, p.out);
}

extern "C" void kernel_launch(void* const* d_in, const int* in_sizes, int n_in, void* d_out, int out_size, void* d_ws, size_t ws_size,
                              hipStream_t stream) {
  Params p{};
  p.x = (const float*)d_in[0]; p.w_in = (const float*)d_in[1]; p.ck_pos = (const float*)d_in[2]; p.ck_w1 = (const float*)d_in[3];
  p.ck_b1 = (const float*)d_in[4]; p.ck_w2 = (const float*)d_in[5]; p.cv_pos = (const float*)d_in[6]; p.cv_w1 = (const float*)d_in[7];
  p.cv_b1 = (const float*)d_in[8]; p.cv_w2 = (const float*)d_in[9]; p.conv_w = (const float*)d_in[10]; p.hng = (const float*)d_in[11];
  p.w_out = (const float*)d_in[12]; p.ln1g = (const float*)d_in[13]; p.ln1b = (const float*)d_in[14]; p.w_query = (const float*)d_in[15];
  p.subk = (const float*)d_in[16]; p.eu = (const float*)d_in[17]; p.ev = (const float*)d_in[18]; p.ln2g = (const float*)d_in[19];
  p.ln2b = (const float*)d_in[20];
  p.out = (float*)d_out;
  p.ws = (char*)d_ws;
  if (ws_size < WS_END) fprintf(stderr, "workspace too small\n");
  static int grid_blocks = 0;
  if (!grid_blocks) {
    int dev = 0, cus = 0, per_cu = 0;
    hipGetDevice(&dev);
    hipDeviceGetAttribute(&cus, hipDeviceAttributeMultiprocessorCount, dev);
    hipOccupancyMaxActiveBlocksPerMultiprocessor(&per_cu, mega, 512, 0);
    if (per_cu > 1) per_cu = 1;
    if (per_cu < 1) per_cu = 1;
    grid_blocks = cus * per_cu;
  }
  hipMemsetAsync((char*)d_ws + WS_CTRL, 0, CTRL_BYTES, stream);
  void* args[] = {&p};
  hipError_t e = hipLaunchCooperativeKernel((void*)mega, dim3(grid_blocks), dim3(512), args, 0, stream);
  if (e != hipSuccess) fprintf(stderr, "cooperative launch failed: %s (grid %d)\n", hipGetErrorString(e), grid_blocks);
}
```

```cpp
#include <hip/hip_runtime.h>
#include <stdint.h>
#include <stdio.h>


#define DI __device__ __forceinline__
static __device__ __forceinline__ int tidx_() { int t = (int)__builtin_amdgcn_workitem_id_x(); asm volatile("" : "+v"(t)); return t; }
#define TIDX (tidx_())
typedef unsigned short bf16_t;
using bf16x8 = __attribute__((ext_vector_type(8))) short;
using f32x4 = __attribute__((ext_vector_type(4))) float;
using u32x4 = __attribute__((ext_vector_type(4))) unsigned;
using u32x2 = __attribute__((ext_vector_type(2))) unsigned;

constexpr int S = 16384, DM = 2048, HD = 128;
constexpr int INW = 5656, INWP = 5760, INWG = 5888;
constexpr int OFF_Q = 0, OFF_KC = 1024, OFF_VC = 1280, OFF_KS = 1536, OFF_VS = 1792, OFF_KW = 2048, OFF_VW = 2304,
              OFF_G = 2560, OFF_U = 2584, OFF_B = 3608, OFF_C = 4632;
constexpr int NCMP = 1023;
constexpr float ALPHA = 1.189207115002721f;
constexpr float QSCALE = 0.08838834764831845f;

DI bf16_t f2bf(float x) { unsigned u = __float_as_uint(x); u += 0x7fffu + ((u >> 16) & 1u); return (bf16_t)(u >> 16); }
DI float bf2f(bf16_t b) { return __uint_as_float(((unsigned)b) << 16); }
DI float gelu_tanh(float x) { float u = 0.7978845608028654f * (x + 0.044715f * x * x * x); return 0.5f * x * (1.f + tanhf(u)); }
DI float wave_sum(float v) { for (int o = 32; o > 0; o >>= 1) v += __shfl_xor(v, o); return v; }
using bf16x2v = __attribute__((ext_vector_type(2))) __bf16;
DI unsigned pack2(float a, float b) { bf16x2v v = {(__bf16)a, (__bf16)b}; return __builtin_bit_cast(unsigned, v); }
DI float wave_max(float v) { for (int o = 32; o > 0; o >>= 1) v = fmaxf(v, __shfl_xor(v, o)); return v; }

namespace pg8 {
#define PG8_LAS __attribute__((address_space(3)))
typedef unsigned short bf16_t;
typedef short bf16x8 __attribute__((ext_vector_type(8)));
typedef float f32x4 __attribute__((ext_vector_type(4)));
typedef unsigned u32x4 __attribute__((ext_vector_type(4)));
constexpr int BM = 256, BK = 64, HALF = 128, HTB = HALF * BK * 2  , STAGE_BYTES = 8 * HTB, NXCD = 8, WGM = 8;

__host__ __device__ __forceinline__ int lds_byte(int r, int c) { const int st = (r >> 4) * 2 + (c >> 5), rr = r & 15, cc = c & 31, ob = rr * 64 + cc * 2; return st * 1024 + (ob ^ (((ob >> 9) & 1) << 5)); }
__host__ __device__ __forceinline__ void stage_rc(int b, int& R, int& C) { const int st = b / 1024, sb = b % 1024, swz = sb ^ (((sb >> 9) & 1) << 5); R = (st >> 1) * 16 + swz / 64; C = (st & 1) * 32 + (swz % 64) / 2; }
__host__ __device__ __forceinline__ int perm32(int rho) { const int n = rho >> 4, i = rho & 15; return 8 * (i >> 2) + 4 * n + (i & 3); }

struct Unit { int pm, pn; };
struct Gemm { const bf16_t* A; const bf16_t* Bt; int M, N, K; };

struct StaticOrder {
    int nM, nN, nwg, G, c;
    __host__ __device__ void init(int M, int N, int G_, int c_) { nM = M / BM; nN = N / BM; nwg = nM * nN; G = G_; c = c_; }
    __host__ __device__ bool next(int i, Unit& u) const {
        const long L = (long)i * G + c; if (L >= nwg) return false;
        int wgid = (int)L; { const int q = nwg / NXCD, r = nwg % NXCD, xcd = wgid % NXCD, off = wgid / NXCD; wgid = (xcd < r ? xcd * (q + 1) : r * (q + 1) + (xcd - r) * q) + off; }
        const int nig = WGM * nN, gid = wgid / nig, fm = gid * WGM, gsz = (nM - fm) < WGM ? (nM - fm) : WGM;
        u.pm = fm + ((wgid % nig) % gsz); u.pn = (wgid % nig) / gsz; return true;
    }
    __device__ __forceinline__ void a_ready(const Unit&) const {}
    __device__ __forceinline__ void done(const Unit&) const {}
};
struct OneUnit : StaticOrder {
    int k;
    __device__ bool next(int i, Unit& u) const { if (i > 0) return false; return StaticOrder::next(k, u); }
};
__device__ __forceinline__ unsigned cvt_pk_bf16(float lo, float hi) { unsigned r; asm volatile("v_cvt_pk_bf16_f32 %0, %1, %2" : "=v"(r) : "v"(lo), "v"(hi)); return r; }
template <class Epi, class Sched, bool STAMP = false>
__device__ __forceinline__ void gemm_phase(PG8_LAS unsigned char* lds, const Gemm g, const Sched& S, const Epi& E, unsigned long long* stamps) {
    const int tid = TIDX, wid = __builtin_amdgcn_readfirstlane(tid >> 6), lane = tid & 63, wr = wid >> 2, wc = wid & 3, fr = lane & 15, fq = lane >> 4;
    const int K = g.K, nt = K / BK;
    int ts_lo = 0, ts_hi = 0, nts = 0; const unsigned long long rt_entry = STAMP ? (unsigned long long)wall_clock64() : 0ull;
#define PG8_STAMP() do { if (STAMP && wid == 0 && nts < 64) { const unsigned long long _c = (unsigned long long)clock64(); \
        ts_lo = (lane == nts) ? (int)(unsigned)_c : ts_lo; ts_hi = (lane == nts) ? (int)(unsigned)(_c >> 32) : ts_hi; ++nts; } } while (0)
    PG8_STAMP();
    unsigned voffA[2], voffB[2];
#pragma unroll
    for (int i = 0; i < 2; ++i) { int R, C; stage_rc(tid * 16 + i * 8192, R, C); const int Rb = Epi::PERM ? ((R & ~31) + perm32(R & 31)) : R;
        voffA[i] = (unsigned)(R * K + C) * 2u; voffB[i] = (unsigned)(Rb * K + C) * 2u; }
    const size_t kstep = (size_t)(BK * 2);
    const size_t hstep = (size_t)HALF * K * 2;
    const size_t tstep = 2 * hstep;
    const unsigned ldsw = (unsigned)wid * 1024u;
    const int aoff = lds_byte(wr * 64 + fr, fq * 8), boff = lds_byte(wc * 32 + fr, fq * 8);
#define PG8_SA(b, h) (((b) * 2 + (h)) * HTB)
#define PG8_SB(b, h) ((4 + (b) * 2 + (h)) * HTB)
#define PG8_STAGE(bufoff, gbase, voff) do { _Pragma("unroll") for (int _i = 0; _i < 2; ++_i) \
        __builtin_amdgcn_global_load_lds((const unsigned*)((const char*)(gbase) + (voff)[_i]), (PG8_LAS unsigned*)(lds + (bufoff) + ldsw + _i * 8192), 16, 0, 0); } while (0)
#define PG8_LDA(dst, b, h) do { _Pragma("unroll") for (int m = 0; m < 4; ++m) _Pragma("unroll") for (int k = 0; k < 2; ++k) dst[m][k] = *(const PG8_LAS bf16x8*)(lds + PG8_SA(b, h) + aoff + m * 2048 + k * 1024); } while (0)
#define PG8_LDB(dst, b, h) do { _Pragma("unroll") for (int n = 0; n < 2; ++n) _Pragma("unroll") for (int k = 0; k < 2; ++k) dst[n][k] = *(const PG8_LAS bf16x8*)(lds + PG8_SB(b, h) + boff + n * 2048 + k * 1024); } while (0)
#define PG8_MMA(ai, bj, At, Bt) do { __builtin_amdgcn_s_setprio(1); _Pragma("unroll") for (int m = 0; m < 4; ++m) _Pragma("unroll") for (int n = 0; n < 2; ++n) _Pragma("unroll") for (int k = 0; k < 2; ++k) \
        acc[ai][bj][m][n] = __builtin_amdgcn_mfma_f32_16x16x32_bf16(Bt[n][k], At[m][k], acc[ai][bj][m][n], 0, 0, 0); __builtin_amdgcn_s_setprio(0); } while (0)
#define PG8_WAIT_V(n) asm volatile("s_waitcnt vmcnt(" #n ")" ::: "memory")
#define PG8_WAIT_L(n) asm volatile("s_waitcnt lgkmcnt(" #n ")" ::: "memory")
#define PG8_BAR __builtin_amdgcn_s_barrier()
#define PG8_SCHED __builtin_amdgcn_sched_barrier(0)
    Unit cur, nxt; int ui = 0;
    if (!S.next(0, cur)) return;
    f32x4 acc[2][2][4][2];
#pragma unroll
    for (int a = 0; a < 2; ++a)
#pragma unroll
        for (int b = 0; b < 2; ++b)
#pragma unroll
            for (int m = 0; m < 4; ++m)
#pragma unroll
                for (int n = 0; n < 2; ++n) acc[a][b][m][n] = (f32x4){0.f, 0.f, 0.f, 0.f};
    bf16x8 At[4][2], B0[2][2], B1[2][2];
    const char* cA = (const char*)g.A + (size_t)cur.pm * tstep; const char* cB = (const char*)g.Bt + (size_t)cur.pn * tstep;
    S.a_ready(cur);
    PG8_STAGE(PG8_SB(0, 0), cB, voffB); PG8_STAGE(PG8_SA(0, 0), cA, voffA); PG8_STAGE(PG8_SB(0, 1), cB + hstep, voffB); PG8_STAGE(PG8_SA(0, 1), cA + hstep, voffA);
    if (wr == 1) PG8_BAR;
    PG8_WAIT_V(4); PG8_BAR;
    PG8_STAGE(PG8_SB(1, 0), cB + kstep, voffB); PG8_STAGE(PG8_SA(1, 0), cA + kstep, voffA); PG8_STAGE(PG8_SB(1, 1), cB + hstep + kstep, voffB);
    PG8_WAIT_V(6); PG8_BAR;
    PG8_STAMP();
    for (;;) {
        const bool has_next = S.next(ui + 1, nxt);
        const char* nA = has_next ? (const char*)g.A + (size_t)nxt.pm * tstep : cA; const char* nB = has_next ? (const char*)g.Bt + (size_t)nxt.pn * tstep : cB;
        for (int t = 0; t < nt; t += 2) {
            const bool last = (t == nt - 2);
            const char* a1 = cA + (size_t)(t + 1) * kstep;
            const char* a2 = last ? nA : cA + (size_t)(t + 2) * kstep; const char* b2 = last ? nB : cB + (size_t)(t + 2) * kstep;
            const char* a3 = a2 + kstep; const char* b3 = b2 + kstep;
            if (last && has_next) S.a_ready(nxt);
            PG8_LDB(B0, 0, 0); PG8_SCHED; PG8_LDA(At, 0, 0); PG8_STAGE(PG8_SA(1, 1), a1 + hstep, voffA);
            PG8_WAIT_L(8); PG8_BAR; PG8_WAIT_L(0); PG8_MMA(0, 0, At, B0); PG8_BAR; PG8_SCHED;
            PG8_LDB(B1, 0, 1); PG8_STAGE(PG8_SB(0, 0), b2, voffB);
            PG8_BAR; PG8_WAIT_L(0); PG8_MMA(0, 1, At, B1); PG8_BAR;
            PG8_LDA(At, 0, 1); PG8_STAGE(PG8_SA(0, 0), a2, voffA);
            PG8_BAR; PG8_WAIT_L(0); PG8_MMA(1, 0, At, B0); PG8_BAR; PG8_SCHED;
            PG8_STAGE(PG8_SB(0, 1), b2 + hstep, voffB);
            PG8_WAIT_V(6); PG8_BAR; PG8_MMA(1, 1, At, B1); PG8_BAR;
            PG8_LDB(B0, 1, 0); PG8_SCHED; PG8_LDA(At, 1, 0); PG8_STAGE(PG8_SA(0, 1), a2 + hstep, voffA);
            PG8_WAIT_L(8); PG8_BAR; PG8_WAIT_L(0); PG8_MMA(0, 0, At, B0); PG8_BAR; PG8_SCHED;
            PG8_LDB(B1, 1, 1); PG8_STAGE(PG8_SB(1, 0), b3, voffB);
            PG8_BAR; PG8_WAIT_L(0); PG8_MMA(0, 1, At, B1); PG8_BAR;
            PG8_LDA(At, 1, 1); PG8_STAGE(PG8_SA(1, 0), a3, voffA);
            PG8_BAR; PG8_WAIT_L(0); PG8_MMA(1, 0, At, B0); PG8_BAR; PG8_SCHED;
            PG8_STAGE(PG8_SB(1, 1), b3 + hstep, voffB);
            PG8_WAIT_V(6); PG8_BAR; PG8_MMA(1, 1, At, B1); PG8_BAR;
        }
        PG8_STAMP();
        if constexpr (!Epi::AFTER_DRAIN) { E(acc, cur, wr, wc, fr, fq); S.done(cur); }
        PG8_STAMP();
        if (!has_next) break;
#pragma unroll
        for (int a = 0; a < 2; ++a)
#pragma unroll
            for (int b = 0; b < 2; ++b)
#pragma unroll
                for (int m = 0; m < 4; ++m)
#pragma unroll
                    for (int n = 0; n < 2; ++n) acc[a][b][m][n] = (f32x4){0.f, 0.f, 0.f, 0.f};
        cur = nxt; cA = nA; cB = nB; ++ui;
    }
    PG8_WAIT_V(0);
    if (wr == 0) PG8_BAR;
    PG8_BAR;
    if constexpr (Epi::AFTER_DRAIN) { E.fused(acc, cur, wr, wc, fr, fq, lds, wid, lane); S.done(cur); }
    PG8_STAMP();
    if (STAMP && wid == 0) { stamps[lane] = lane < nts ? (((unsigned long long)(unsigned)ts_hi << 32) | (unsigned)ts_lo) : 0ull;
        if (lane == 62) stamps[62] = rt_entry; if (lane == 63) stamps[63] = (unsigned long long)wall_clock64(); }
#undef PG8_STAMP
#undef PG8_SA
#undef PG8_SB
#undef PG8_STAGE
#undef PG8_LDA
#undef PG8_LDB
#undef PG8_MMA
#undef PG8_WAIT_V
#undef PG8_WAIT_L
#undef PG8_BAR
#undef PG8_SCHED
}
}

#define XB_TMO      128
#define XB_XCNT(j)  (256  + 64 * (j))
#define XB_XSUB(j)  (1280 + 64 * (j))
#define XB_XGEN(j)  (2304 + 64 * (j))
#define XB_TOP      3328
#define XB_TOPGEN   3392
#define XCD_BAR_WORDS 3456
#define XB_SPIN_CAP (1u << 18)
#define LAS __attribute__((address_space(3)))

__device__ __forceinline__ unsigned xb_ld(unsigned* p)              { return __hip_atomic_load(p, __ATOMIC_RELAXED, __HIP_MEMORY_SCOPE_AGENT); }
__device__ __forceinline__ unsigned xb_add(unsigned* p, unsigned v) { return __hip_atomic_fetch_add(p, v, __ATOMIC_RELAXED, __HIP_MEMORY_SCOPE_AGENT); }
__device__ __forceinline__ unsigned xb_xcc_id() { return (unsigned)__builtin_amdgcn_s_getreg((3 << 11) | 20) & 0xFu; }
#define XB_SPIN(cond, bar) do { unsigned _sp = 0; while (cond) { __builtin_amdgcn_s_sleep(1); \
    if ((++_sp & 255u) == 0u) { if (xb_ld(&(bar)[XB_TMO])) break; if (_sp > XB_SPIN_CAP) { atomicAdd(&(bar)[XB_TMO], 1u); break; } } } } while (0)

struct XcdBarrier {
    unsigned* bar; unsigned x;
    volatile LAS unsigned* st;
};

__device__ __forceinline__ XcdBarrier xcd_barrier_post(unsigned* bar, volatile LAS unsigned* st) {
    XcdBarrier b; b.bar = bar; b.x = xb_xcc_id(); b.st = st;
    if (TIDX == 0) (void)xb_add(&bar[XB_XCNT(b.x)], 1u);
    return b;
}
__device__ __forceinline__ void xcd_barrier_complete(unsigned* bar, unsigned x, unsigned& nloc, unsigned& nx) {
    const unsigned G = gridDim.x * gridDim.y * gridDim.z;
    unsigned sum, cnt, mine, sp = 0u;
    for (;;) {
        sum = 0u; cnt = 0u; mine = 0u;
#pragma unroll
        for (unsigned j = 0; j < 16; ++j) { const unsigned c = xb_ld(&bar[XB_XCNT(j)]); sum += c; cnt += (c > 0u) ? 1u : 0u; mine = (j == x) ? c : mine; }
        if (sum == G) break;
        __builtin_amdgcn_s_sleep(1);
        if ((++sp & 255u) == 0u) { if (xb_ld(&bar[XB_TMO])) break; if (sp > XB_SPIN_CAP) { atomicAdd(&bar[XB_TMO], 1u); break; } }
    }
    nloc = mine > 0u ? mine : 1u; nx = cnt > 0u ? cnt : 1u;
}

__device__ __forceinline__ void xcd_barrier(const XcdBarrier& b) {
    asm volatile("s_waitcnt vmcnt(0)" ::: "memory");
    __syncthreads();
    if (TIDX == 0) {
        unsigned* bar = b.bar;
        __builtin_amdgcn_s_waitcnt(0);
        unsigned nloc = b.st[0], nx = b.st[1];
        if (nloc == 0u) { xcd_barrier_complete(bar, b.x, nloc, nx); b.st[0] = nloc; b.st[1] = nx; }
        const unsigned old = xb_add(&bar[XB_XSUB(b.x)], 1u);
        const unsigned gen = old / nloc;
        if (old + 1u == (gen + 1u) * nloc) {
            __builtin_amdgcn_fence(__ATOMIC_RELEASE, "agent");
            asm volatile("s_waitcnt vmcnt(0)" ::: "memory");
            const unsigned og = xb_add(&bar[XB_TOP], 1u);
            const unsigned tg = og / nx;
            if (og + 1u == (tg + 1u) * nx) xb_add(&bar[XB_TOPGEN], 1u);
            else XB_SPIN(xb_ld(&bar[XB_TOPGEN]) == tg, bar);
            __builtin_amdgcn_fence(__ATOMIC_ACQUIRE, "agent");
            xb_add(&bar[XB_XGEN(b.x)], 1u);
            asm volatile("s_waitcnt vmcnt(0)" ::: "memory");
        } else {
            XB_SPIN(xb_ld(&bar[XB_XGEN(b.x)]) == gen, bar);
            __builtin_amdgcn_fence(__ATOMIC_ACQUIRE, "agent");
            asm volatile("s_waitcnt vmcnt(0)" ::: "memory");
        }
    }
    __syncthreads();
}

__device__ void d_cvt(const float* __restrict__ in, bf16_t* __restrict__ out, size_t n4) {
  size_t i = (size_t)blockIdx.x * blockDim.x + TIDX;
  size_t stride = (size_t)gridDim.x * blockDim.x;
  for (; i < n4; i += stride) { float4 v = ((const float4*)in)[i]; ushort4 o; o.x = f2bf(v.x); o.y = f2bf(v.y); o.z = f2bf(v.z); o.w = f2bf(v.w); ((ushort4*)out)[i] = o; }
}
__device__ void d_cvtT(int vb, char* smem, const float* __restrict__ W, bf16_t* __restrict__ WT, int K, int N, int NP) {
  float (*t)[33] = (float (*)[33])smem;
  int nbx = NP / 32;
  int n0 = (vb % nbx) * 32, k0 = (vb / nbx) * 32;
  int tx = (TIDX & 255) & 31, ty = (TIDX & 255) >> 5;
  for (int i = ty; i < 32; i += 8) { int k = k0 + i, n = n0 + tx; t[i][tx] = (n < N && k < K) ? W[(size_t)k * N + n] : 0.f; }
  __syncthreads();
  for (int i = ty; i < 32; i += 8) { int n = n0 + i, k = k0 + tx; if (n < NP && k < K) WT[(size_t)n * K + k] = f2bf(t[tx][i]); }
  __syncthreads();
}

constexpr int LDS_LD = 72;
struct EpiProj { bf16_t* proj; float* gates; };
struct EpiF32 { float* C; int ldc; int N; };
struct EpiRes { float* C; const float* X; };


#define ELEMWISE_TILE                                                                              \
  DI void tile(f32x4 (&acc)[4][4], char*, int m0, int n0, int, int wm, int wn, int, int lane) const { \
    _Pragma("unroll") for (int i = 0; i < 4; ++i)                                                  \
    _Pragma("unroll") for (int j = 0; j < 4; ++j)                                                  \
    _Pragma("unroll") for (int r = 0; r < 4; ++r) {                                                \
      int row = m0 + wm * 64 + i * 16 + (lane >> 4) * 4 + r;                                       \
      int col = n0 + wn * 64 + j * 16 + (lane & 15);                                               \
      (*this)(row, col, acc[i][j][r]);                                                             \
    }                                                                                              \
  }
template <class Epi>
__device__ void d_gemm(int vb, char* smem, const bf16_t* __restrict__ A, int lda, const bf16_t* __restrict__ BT, int ldb, int K,
                       int tilesM, Epi epi) {
  bf16_t* As = (bf16_t*)smem;
  bf16_t* Bs = As + 256 * LDS_LD;
  const int tid = TIDX, lane = tid & 63, wid = tid >> 6;
  const int wm = wid >> 1, wn = wid & 1;
  const int tm = vb % tilesM, tn = vb / tilesM;
  const int m0 = tm * 256, n0 = tn * 128;
  f32x4 acc[4][4];
#pragma unroll
  for (int i = 0; i < 4; ++i)
#pragma unroll
    for (int j = 0; j < 4; ++j) acc[i][j] = f32x4{0.f, 0.f, 0.f, 0.f};
  u32x4 ra[4], rb[2];
#define GLOAD(k0_)                                                                  \
  _Pragma("unroll") for (int i = 0; i < 4; ++i) {                                   \
    int c = tid + i * 512; int row = c >> 3, kc = c & 7;                            \
    ra[i] = *(const u32x4*)(A + (size_t)(m0 + row) * lda + (k0_) + kc * 8);         \
  }                                                                                 \
  _Pragma("unroll") for (int i = 0; i < 2; ++i) {                                   \
    int c = tid + i * 512; int row = c >> 3, kc = c & 7;                            \
    rb[i] = *(const u32x4*)(BT + (size_t)(n0 + row) * ldb + (k0_) + kc * 8);        \
  }
  GLOAD(0)
  for (int k0 = 0; k0 < K; k0 += 64) {
    __syncthreads();
#pragma unroll
    for (int i = 0; i < 4; ++i) { int c = tid + i * 512; int row = c >> 3, kc = c & 7; *(u32x4*)(As + row * LDS_LD + kc * 8) = ra[i]; }
#pragma unroll
    for (int i = 0; i < 2; ++i) { int c = tid + i * 512; int row = c >> 3, kc = c & 7; *(u32x4*)(Bs + row * LDS_LD + kc * 8) = rb[i]; }
    __syncthreads();
    if (k0 + 64 < K) { GLOAD(k0 + 64) }
#pragma unroll
    for (int ks = 0; ks < 2; ++ks) {
      bf16x8 a[4], b[4];
#pragma unroll
      for (int i = 0; i < 4; ++i) {
        a[i] = *(const bf16x8*)(As + (wm * 64 + i * 16 + (lane & 15)) * LDS_LD + ks * 32 + (lane >> 4) * 8);
        b[i] = *(const bf16x8*)(Bs + (wn * 64 + i * 16 + (lane & 15)) * LDS_LD + ks * 32 + (lane >> 4) * 8);
      }
#pragma unroll
      for (int i = 0; i < 4; ++i)
#pragma unroll
        for (int j = 0; j < 4; ++j) acc[i][j] = __builtin_amdgcn_mfma_f32_16x16x32_bf16(a[i], b[j], acc[i][j], 0, 0, 0);
    }
  }
  epi.tile(acc, smem, m0, n0, tn, wm, wn, wid, lane);
  __syncthreads();
}
struct EpiProjF {
  bf16_t* proj; float* gates;
  DI void operator()(int row, int col, float v) const {
    if (col < INW) proj[(size_t)row * INWP + col] = f2bf(v);
    if (col >= OFF_G && col < OFF_G + 24) gates[row * 24 + (col - OFF_G)] = 1.f / (1.f + __expf(-v));
  }
  ELEMWISE_TILE
};
struct EpiF32F {
  float* C; int ldc; int N;
  DI void operator()(int row, int col, float v) const { if (col < N) C[(size_t)row * ldc + col] = v; }
  ELEMWISE_TILE
};
struct EpiResF {
  float* C; const float* X;
  DI void operator()(int row, int col, float v) const { C[(size_t)row * DM + col] = ALPHA * X[(size_t)row * DM + col] + v; }
  ELEMWISE_TILE
};

__device__ void d_build_cmp(int row, const bf16_t* __restrict__ proj, int off, const float* __restrict__ pos, bf16_t* __restrict__ Ac) {
  int n = row >> 1, g = row & 1;
  for (int k = (TIDX & 255); k < 4096; k += 256) {
    float v = 0.f;
    if (row < 2046) { int l = k >> 7, d = k & 127; v = bf2f(proj[(size_t)(16 * n + l) * INWP + off + g * 128 + d]) + pos[l * 128 + d]; }
    Ac[(size_t)row * 4096 + k] = f2bf(v);
  }
}
__device__ void d_cmp2(int row, char* smem, const float* __restrict__ hid, const float* __restrict__ b1, const float* __restrict__ w2, float* __restrict__ out) {
  float* a = (float*)smem;
  for (int j = (TIDX & 255); j < 512; j += 256) a[j] = gelu_tanh(hid[(size_t)row * 512 + j] + b1[j]);
  __syncthreads();
  int d = (TIDX & 255) & 127, half = (TIDX & 255) >> 7;
  float s = 0.f;
  for (int j = half * 256; j < half * 256 + 256; ++j) s += a[j] * w2[j * 128 + d];
  float* red = a + 512;
  if (half) red[d] = s;
  __syncthreads();
  if (!half) out[(size_t)row * 128 + d] = s + red[d];
  __syncthreads();
}

using f32x16 = __attribute__((ext_vector_type(16))) float;
using bf16x8v = __attribute__((ext_vector_type(8))) __bf16;
#define MFMA32(a, b, c) __builtin_amdgcn_mfma_f32_32x32x16_bf16((a), (b), (c), 0, 0, 0)
constexpr float LOG2E = 1.4426950408889634f;
constexpr float NEGB = -1e30f;
DI int pi_perm(int i) { return (i & ~12) | ((i & 8) >> 1) | ((i & 4) << 1); }
DI bf16x8 pack8(float a0, float a1, float a2, float a3, float a4, float a5, float a6, float a7) {
  bf16x8v v = {(__bf16)a0, (__bf16)a1, (__bf16)a2, (__bf16)a3, (__bf16)a4, (__bf16)a5, (__bf16)a6, (__bf16)a7};
  return __builtin_bit_cast(bf16x8, v);
}
__device__ void d_relayoutK_bf(size_t c, int NT, const bf16_t* __restrict__ src, int ld, int col0, bf16_t* __restrict__ dst) {
  int lane = c & 63, s = (c >> 6) & 7; size_t tt = c >> 9; int T = tt % NT, g = tt / NT;
  int i = lane & 31, h = lane >> 5;
  int tok = 32 * T + pi_perm(i);
  *(u32x4*)(dst + c * 8) = *(const u32x4*)(src + (size_t)tok * ld + col0 + g * 128 + 16 * s + 8 * h);
}
__device__ void d_relayoutV_bf(size_t c, int NT, const bf16_t* __restrict__ src, int ld, int col0, bf16_t* __restrict__ dst) {
  int lane = c & 63, s2 = (c >> 6) & 1, dt = (c >> 7) & 3; size_t tt = c >> 9; int T = tt % NT, g = tt / NT;
  int dd = lane & 31, h = lane >> 5;
  bf16_t v[8];
#pragma unroll
  for (int j = 0; j < 8; ++j) v[j] = src[(size_t)(32 * T + 16 * s2 + 8 * h + j) * ld + col0 + g * 128 + 32 * dt + dd];
  u32x4 o; o.x = v[0] | ((unsigned)v[1] << 16); o.y = v[2] | ((unsigned)v[3] << 16); o.z = v[4] | ((unsigned)v[5] << 16); o.w = v[6] | ((unsigned)v[7] << 16);
  *(u32x4*)(dst + c * 8) = o;
}
__device__ void d_relayoutK_f32(size_t c, const float* __restrict__ src, bf16_t* __restrict__ dst) {
  int lane = c & 63, s = (c >> 6) & 7; size_t tt = c >> 9; int T = tt % 32, g = tt / 32;
  int i = lane & 31, h = lane >> 5;
  int n = 32 * T + pi_perm(i);
  bf16_t v[8];
#pragma unroll
  for (int j = 0; j < 8; ++j) v[j] = (n < NCMP) ? f2bf(src[((size_t)n * 2 + g) * 128 + 16 * s + 8 * h + j]) : (bf16_t)0;
  u32x4 o; o.x = v[0] | ((unsigned)v[1] << 16); o.y = v[2] | ((unsigned)v[3] << 16); o.z = v[4] | ((unsigned)v[5] << 16); o.w = v[6] | ((unsigned)v[7] << 16);
  *(u32x4*)(dst + c * 8) = o;
}
__device__ void d_relayoutV_f32(size_t c, const float* __restrict__ src, bf16_t* __restrict__ dst) {
  int lane = c & 63, s2 = (c >> 6) & 1, dt = (c >> 7) & 3; size_t tt = c >> 9; int T = tt % 32, g = tt / 32;
  int dd = lane & 31, h = lane >> 5;
  bf16_t v[8];
#pragma unroll
  for (int j = 0; j < 8; ++j) { int n = 32 * T + 16 * s2 + 8 * h + j; v[j] = (n < NCMP) ? f2bf(src[((size_t)n * 2 + g) * 128 + 32 * dt + dd]) : (bf16_t)0; }
  u32x4 o; o.x = v[0] | ((unsigned)v[1] << 16); o.y = v[2] | ((unsigned)v[3] << 16); o.z = v[4] | ((unsigned)v[5] << 16); o.w = v[6] | ((unsigned)v[7] << 16);
  *(u32x4*)(dst + c * 8) = o;
}


__device__ __forceinline__ void d_relayout_tile(int T, char* smem, const bf16_t* __restrict__ proj, int col0, bf16_t* __restrict__ dst, bool isV) {
  bf16_t* Ls = (bf16_t*)smem;
  const int tid = TIDX;
#pragma unroll
  for (int q = 0; q < 2; ++q) {
    const int cidx = tid + q * 512;
    const int g = cidx >> 9, tok = (cidx >> 4) & 31, ch = cidx & 15;
    const u32x4 v = *(const u32x4*)(proj + (size_t)(32 * T + tok) * INWP + col0 + g * 128 + ch * 8);
    *(u32x4*)(Ls + (g * 32 + tok) * 136 + ch * 8) = v;
  }
  __syncthreads();
#pragma unroll
  for (int q = 0; q < 2; ++q) {
    const int oc = tid + q * 512;
    const int g = oc >> 9, r9 = oc & 511, lane = r9 & 63;
    u32x4 o;
    if (!isV) {
      const int s8 = r9 >> 6, i = lane & 31, h = lane >> 5;
      o = *(const u32x4*)(Ls + (g * 32 + pi_perm(i)) * 136 + 16 * s8 + 8 * h);
    } else {
      const int s2 = (r9 >> 6) & 1, dt = r9 >> 7, dd = lane & 31, h = lane >> 5;
      const bf16_t* col = Ls + (g * 32 + 16 * s2 + 8 * h) * 136 + 32 * dt + dd;
      unsigned short e[8];
#pragma unroll
      for (int j = 0; j < 8; ++j) e[j] = col[j * 136];
      o.x = e[0] | ((unsigned)e[1] << 16); o.y = e[2] | ((unsigned)e[3] << 16); o.z = e[4] | ((unsigned)e[5] << 16); o.w = e[6] | ((unsigned)e[7] << 16);
    }
    *(u32x4*)(dst + (((size_t)(g * 512 + T)) * 512 + r9) * 8) = o;
  }
  __syncthreads();
}

struct AttnPtrs {
  const bf16_t* proj; const float* gates;
  const bf16_t *kcf, *vcf, *ksf, *vsf, *kwf, *vwf;
  bf16_t* mix; const float* hng;
};

DI float ex2(float x) { return __builtin_amdgcn_exp2f(x); }
DI void halves(float x, float& lo, float& hi) {
  const unsigned u = __float_as_uint(x);
  auto r = __builtin_amdgcn_permlane32_swap(u, u, false, false);
  lo = __uint_as_float(r[0]); hi = __uint_as_float(r[1]);
}
DI float hmax(float x) { float a, b; halves(x, a, b); return fmaxf(a, b); }
DI float hsum(float x) { float a, b; halves(x, a, b); return a + b; }
DI float dpp_quad(float v, int ctrl_is_xor1) {
  const int iv = __float_as_int(v);
  const int r = ctrl_is_xor1 ? __builtin_amdgcn_update_dpp(iv, iv, 0xB1, 0xF, 0xF, false) : __builtin_amdgcn_update_dpp(iv, iv, 0x4E, 0xF, 0xF, false);
  return __int_as_float(r);
}
DI float quad_sum(float v) { v += dpp_quad(v, 1); v += dpp_quad(v, 0); return v; }
DI void load_k(bf16x8 (&kf)[8], const bf16_t* __restrict__ kt, int lane) {
#pragma unroll
  for (int s = 0; s < 8; ++s) kf[s] = *(const bf16x8*)(kt + s * 512 + lane * 8);
}
DI f32x16 qk_frags(const bf16x8 (&kf)[8], const bf16_t* qL, int lane) {
  f32x16 acc;
#pragma unroll
  for (int i = 0; i < 16; ++i) acc[i] = 0.f;
  const bf16_t* qp = qL + (lane & 31) * 136 + 8 * (lane >> 5);
#pragma unroll
  for (int s = 0; s < 8; ++s) {
    bf16x8 qf = *(const bf16x8*)(qp + 16 * s);
    acc = MFMA32(kf[s], qf, acc);
  }
  return acc;
}
DI void pv_frags(const bf16x8 (&vf)[8], const float (&p)[16], f32x16 (&O)[4]) {
  bf16x8 pf0 = pack8(p[0], p[1], p[2], p[3], p[4], p[5], p[6], p[7]);
  bf16x8 pf1 = pack8(p[8], p[9], p[10], p[11], p[12], p[13], p[14], p[15]);
#pragma unroll
  for (int dt = 0; dt < 4; ++dt) {
    O[dt] = MFMA32(vf[dt * 2], pf0, O[dt]);
    O[dt] = MFMA32(vf[dt * 2 + 1], pf1, O[dt]);
  }
}
DI void osm_step(const float (&sv)[16], float& m, float& l, f32x16 (&O)[4], float (&p)[16]) {
  float tmax = fmaxf(fmaxf(fmaxf(sv[0], sv[1]), fmaxf(sv[2], sv[3])), fmaxf(fmaxf(sv[4], sv[5]), fmaxf(sv[6], sv[7])));
  tmax = fmaxf(tmax, fmaxf(fmaxf(fmaxf(sv[8], sv[9]), fmaxf(sv[10], sv[11])), fmaxf(fmaxf(sv[12], sv[13]), fmaxf(sv[14], sv[15]))));
  tmax = hmax(tmax);
  if (__ballot(tmax - m > 8.f)) {
    const float mn = fmaxf(m, tmax);
    const float alpha = ex2(m - mn);
    l *= alpha; m = mn;
#pragma unroll
    for (int dt = 0; dt < 4; ++dt)
#pragma unroll
      for (int r = 0; r < 16; ++r) O[dt][r] *= alpha;
  }
  float ps0 = 0.f, ps1 = 0.f;
#pragma unroll
  for (int r = 0; r < 16; r += 2) { const float e0 = ex2(sv[r] - m), e1 = ex2(sv[r + 1] - m); p[r] = e0; p[r + 1] = e1; ps0 += e0; ps1 += e1; }
  l += ps0 + ps1;
}
DI void ot_store(char* otL, int lane, const f32x16 (&O)[4], float sc) {
#pragma unroll
  for (int dt = 0; dt < 4; ++dt) {
    u32x4 a, b;
#pragma unroll
    for (int i = 0; i < 4; ++i) { a[i] = pack2(sc * O[dt][2 * i], sc * O[dt][2 * i + 1]); b[i] = pack2(sc * O[dt][8 + 2 * i], sc * O[dt][8 + 2 * i + 1]); }
    *(u32x4*)(otL + lane * 128 + dt * 32) = a;
    *(u32x4*)(otL + lane * 128 + dt * 32 + 16) = b;
  }
}
DI void ot_accum(const char* otL, int lane, f32x16 (&O)[4], float sc) {
#pragma unroll
  for (int dt = 0; dt < 4; ++dt) {
    u32x4 a = *(const u32x4*)(otL + lane * 128 + dt * 32);
    u32x4 b = *(const u32x4*)(otL + lane * 128 + dt * 32 + 16);
#pragma unroll
    for (int i = 0; i < 4; ++i) {
      const unsigned wa = a[i], wb = b[i];
      O[dt][2 * i] = fmaf(sc, O[dt][2 * i], __uint_as_float(wa << 16));
      O[dt][2 * i + 1] = fmaf(sc, O[dt][2 * i + 1], __uint_as_float(wa & 0xFFFF0000u));
      O[dt][8 + 2 * i] = fmaf(sc, O[dt][8 + 2 * i], __uint_as_float(wb << 16));
      O[dt][8 + 2 * i + 1] = fmaf(sc, O[dt][8 + 2 * i + 1], __uint_as_float(wb & 0xFFFF0000u));
    }
  }
}
DI void zero_o(f32x16 (&O)[4]) {
#pragma unroll
  for (int dt = 0; dt < 4; ++dt)
#pragma unroll
    for (int i = 0; i < 16; ++i) O[dt][i] = 0.f;
}

constexpr int ATT_PW = 8704;
constexpr int ATT_R = 4, ATT_D = 3;
constexpr int ATT_RING = 8 * ATT_PW;
constexpr int ATT_LIST = ATT_RING + ATT_R * 16384;
constexpr int ATT_BUNI = ATT_LIST + 2048;
constexpr int ATT_SMEM = ATT_BUNI + 64;
#define LAS3 __attribute__((address_space(3)))
__device__ __forceinline__ void d_select(const float* impL, unsigned* mskL, unsigned* uniL, int cur) {
  const int lane = TIDX & 63;
  const int stok = lane >> 3, sub = lane & 7;
  unsigned key[32];
#pragma unroll
  for (int i4 = 0; i4 < 8; ++i4) {
    f32x4 v = *(const f32x4*)(impL + stok * 256 + sub * 32 + i4 * 4);
#pragma unroll
    for (int e = 0; e < 4; ++e) {
      const int j = sub * 32 + i4 * 4 + e;
      const bool valid = j <= cur;
      const bool forced = (j == 0) || (j == cur) || (j == cur - 1);
      unsigned kb = forced ? 0xFFFFFF00u : (__float_as_uint(v[e]) & 0xFFFFFF00u);
      key[i4 * 4 + e] = valid ? (kb | (unsigned)(255 - j)) : 0u;
    }
  }
#pragma unroll
  for (int k = 2; k <= 32; k <<= 1) {
#pragma unroll
    for (int jj = k >> 1; jj > 0; jj >>= 1) {
#pragma unroll
      for (int i = 0; i < 32; ++i) {
        const int l2 = i ^ jj;
        if (l2 > i) {
          const bool desc = ((i & k) == 0);
          unsigned a = key[i], b = key[l2];
          unsigned mx = a > b ? a : b, mn = a > b ? b : a;
          key[i] = desc ? mx : mn; key[l2] = desc ? mn : mx;
        }
      }
    }
  }
#pragma unroll
  for (int xm = 1; xm < 8; xm <<= 1) {
    unsigned L[16];
#pragma unroll
    for (int i = 0; i < 16; ++i) { unsigned o = (unsigned)__shfl_xor((int)key[15 - i], xm); L[i] = key[i] > o ? key[i] : o; }
#pragma unroll
    for (int jj = 8; jj > 0; jj >>= 1) {
#pragma unroll
      for (int i = 0; i < 16; ++i) {
        const int l2 = i ^ jj;
        if (l2 > i) { unsigned a = L[i], b = L[l2]; L[i] = a > b ? a : b; L[l2] = a > b ? b : a; }
      }
    }
#pragma unroll
    for (int i = 0; i < 16; ++i) key[i] = L[i];
  }
#pragma unroll
  for (int i = 0; i < 16; ++i) {
    if ((i & 7) == sub) {
      const int j = 255 - (int)(key[i] & 255u);
      if (j <= cur) { atomicOr(&mskL[stok * 8 + (j >> 5)], 1u << (j & 31)); atomicOr(&uniL[j >> 5], 1u << (j & 31)); }
    }
  }
}


DI void att_issue(LAS3 unsigned char* ring, int slot, int w, int lane, const bf16_t* kb, const bf16_t* vb, int tile) {
  const char* ks = (const char*)kb + (size_t)tile * 8192 + w * 1024 + lane * 16;
  const char* vs = (const char*)vb + (size_t)tile * 8192 + w * 1024 + lane * 16;
  __builtin_amdgcn_global_load_lds((const unsigned*)ks, (LAS3 unsigned*)(ring + slot * 16384 + w * 1024), 16, 0, 0);
  __builtin_amdgcn_global_load_lds((const unsigned*)vs, (LAS3 unsigned*)(ring + slot * 16384 + 8192 + w * 1024), 16, 0, 0);
}
DI void att_wait(int newer_tiles) {
  if (newer_tiles >= 2) asm volatile("s_waitcnt vmcnt(4)" ::: "memory");
  else if (newer_tiles == 1) asm volatile("s_waitcnt vmcnt(2)" ::: "memory");
  else asm volatile("s_waitcnt vmcnt(0)" ::: "memory");
}
DI f32x16 qk_lds(LAS3 const unsigned char* kt, const bf16x8 (&qf)[8], int lane) {
  f32x16 acc;
#pragma unroll
  for (int i = 0; i < 16; ++i) acc[i] = 0.f;
#pragma unroll
  for (int s8 = 0; s8 < 8; ++s8) {
    const bf16x8 kf = *(LAS3 const bf16x8*)(kt + s8 * 1024 + lane * 16);
    acc = MFMA32(kf, qf[s8], acc);
  }
  return acc;
}
DI void pv_lds(LAS3 const unsigned char* vt, const float (&p)[16], f32x16 (&O)[4], int lane) {
  const bf16x8 pf0 = pack8(p[0], p[1], p[2], p[3], p[4], p[5], p[6], p[7]);
  const bf16x8 pf1 = pack8(p[8], p[9], p[10], p[11], p[12], p[13], p[14], p[15]);
#pragma unroll
  for (int dt = 0; dt < 4; ++dt) {
    const bf16x8 v0 = *(LAS3 const bf16x8*)(vt + (dt * 2) * 1024 + lane * 16);
    const bf16x8 v1 = *(LAS3 const bf16x8*)(vt + (dt * 2 + 1) * 1024 + lane * 16);
    O[dt] = MFMA32(v0, pf0, O[dt]);
    O[dt] = MFMA32(v1, pf1, O[dt]);
  }
}

__device__ __forceinline__ void d_attn_block(int B, int g, char* smem, const AttnPtrs& P) {
  const int tid = TIDX, lane = tid & 63, w = tid >> 6;
  const int c = lane & 31, h = lane >> 5, tokl = c >> 2, r = c & 3;
  const int tok0 = 64 * B + 8 * w;
  const int t = tok0 + tokl, hd = g * 4 + r;
  const float slope2 = exp2f(-(float)(hd + 1)) * LOG2E;
  const float c1 = QSCALE * LOG2E;
  const float ninf = -__builtin_inff();
  char* wsm = smem + w * ATT_PW;
  float* impL = (float*)wsm;
  char* otL = wsm;
  unsigned* mskL = (unsigned*)(wsm + 8192);
  unsigned* uniL = mskL + 64;
  LAS3 unsigned char* ring = (LAS3 unsigned char*)(smem + ATT_RING);
  unsigned short* tl = (unsigned short*)(smem + ATT_LIST);
  unsigned* buni = (unsigned*)(smem + ATT_BUNI);
  const bf16_t* kcf = P.kcf + (size_t)g * 32 * 4096;
  const bf16_t* vcf = P.vcf + (size_t)g * 32 * 4096;
  const bf16_t* ksf = P.ksf + (size_t)g * 512 * 4096;
  const bf16_t* vsf = P.vsf + (size_t)g * 512 * 4096;
  const bf16_t* kwf = P.kwf + (size_t)g * 512 * 4096;
  const bf16_t* vwf = P.vwf + (size_t)g * 512 * 4096;
  bf16x8 qf[8];
  {
    const bf16_t* qrow = P.proj + (size_t)t * INWP + OFF_Q + hd * 128 + 8 * h;
#pragma unroll
    for (int s8 = 0; s8 < 8; ++s8) qf[s8] = *(const bf16x8*)(qrow + 16 * s8);
  }
  const float* gt = P.gates + (size_t)t * 24 + hd * 3;
  const float g0 = gt[0], g1 = gt[1], g2 = gt[2];
  {
    unsigned z0 = 0u;
    asm volatile("" : "+v"(z0));
    u32x4 z = {z0, z0, z0, z0};
#pragma unroll
    for (int i = 0; i < 8; ++i) *(u32x4*)(wsm + (i * 64 + lane) * 16) = z;
    if (lane < 18) *(u32x4*)(wsm + 8192 + lane * 16) = z;
    if (tid < 8) buni[tid] = z0;
  }
  f32x16 Ob[4];
  zero_o(Ob);
  const int nmax = (t >= 31) ? ((t - 31) >> 4) : -1;
  const int nmaxw = (tok0 + 7 >= 31) ? ((tok0 + 7 - 31) >> 4) : -1;
  const int nminw = (tok0 >= 31) ? ((tok0 - 31) >> 4) : -1;
  const int ntcw = (nmaxw + 32) >> 5;
  const int ntcB = (((64 * B + 63 - 31) >> 4) + 32) >> 5;
  const float sl16 = slope2 * 16.f;
  float mC = NEGB, lC = 0.f, invC = 0.f, carry = 0.f;
  {
    const int n = 2 * ntcB;
    asm volatile("s_waitcnt vmcnt(0)" ::: "memory");
#define A_TILE(i_) (((i_) < ntcB) ? (ntcB - 1 - (i_)) : ((i_) - ntcB))
#pragma unroll 1
    for (int j = 0; j < ATT_D && j < n; ++j) att_issue(ring, j, w, lane, kcf, vcf, A_TILE(j));
#pragma unroll 1
    for (int i = 0; i < n; ++i) {
      const int newer = (n - 1 - i < ATT_D - 1) ? (n - 1 - i) : (ATT_D - 1);
      att_wait(newer);
      __builtin_amdgcn_s_barrier();
      asm volatile("" ::: "memory");
      if (i + ATT_D < n) att_issue(ring, (i + ATT_D) % ATT_R, w, lane, kcf, vcf, A_TILE(i + ATT_D));
      const int T = A_TILE(i);
      if (T >= ntcw) continue;
      LAS3 const unsigned char* slot = ring + (i % ATT_R) * 16384;
      const f32x16 acc = qk_lds(slot, qf, lane);
      const float base = slope2 * (float)(512 * T + 128 * h) + slope2 * (15.5f - (float)t);
      const int nb = 32 * T + 8 * h;
      const bool full = (32 * T + 31 <= nminw);
      float sv[16];
#pragma unroll
      for (int rg = 0; rg < 16; ++rg) { const int kk = (rg & 7) + 16 * (rg >> 3); sv[rg] = fmaf(acc[rg], c1, fmaf(sl16, (float)kk, base)); }
      if (!full) {
#pragma unroll
        for (int rg = 0; rg < 16; ++rg) { const int kk = (rg & 7) + 16 * (rg >> 3); sv[rg] = (nb + kk <= nmax) ? sv[rg] : ninf; }
      }
      if (i < ntcB) {
        float tmax = fmaxf(fmaxf(fmaxf(sv[0], sv[1]), fmaxf(sv[2], sv[3])), fmaxf(fmaxf(sv[4], sv[5]), fmaxf(sv[6], sv[7])));
        tmax = fmaxf(tmax, fmaxf(fmaxf(fmaxf(sv[8], sv[9]), fmaxf(sv[10], sv[11])), fmaxf(fmaxf(sv[12], sv[13]), fmaxf(sv[14], sv[15]))));
        tmax = hmax(tmax);
        const float mn = fmaxf(mC, tmax);
        float ps = 0.f;
#pragma unroll
        for (int rg = 0; rg < 16; ++rg) ps += ex2(sv[rg] - mn);
        lC = lC * ex2(mC - mn) + ps; mC = mn;
      } else {
        if (T == 0) { lC = hsum(lC); invC = (lC > 0.f) ? 1.f / lC : 0.f; }
        float p[16];
#pragma unroll
        for (int rg = 0; rg < 16; ++rg) p[rg] = ex2(sv[rg] - mC) * invC;
        float Ga = (p[0] + p[1]) + (p[2] + p[3]), Gb = (p[4] + p[5]) + (p[6] + p[7]);
        float Gc = (p[8] + p[9]) + (p[10] + p[11]), Gd = (p[12] + p[13]) + (p[14] + p[15]);
        float xb, xd; { float a_, b_; halves(p[7], a_, b_); xb = h ? a_ : b_; halves(p[15], a_, b_); xd = h ? a_ : b_; }
        float ia = Ga + (h ? xb : carry);
        float ib = Gb + p[3];
        float ic = Gc + (h ? xd : xb);
        float id = Gd + p[11];
        carry = xd;
        ia = quad_sum(ia); ib = quad_sum(ib); ic = quad_sum(ic); id = quad_sum(id);
        {
          float val = (r == 0) ? ia : (r == 1) ? ib : (r == 2) ? ic : id;
          int j = 8 * T + 2 * h + ((r == 0) ? 0 : (r == 1) ? 1 : (r == 2) ? 4 : 5);
          impL[tokl * 256 + j] = val;
        }
        pv_lds(slot + 8192, p, Ob, lane);
      }
    }
#undef A_TILE
  }
  const int cur = B;
  d_select(impL, mskL, uniL, cur);
  ot_store(otL, lane, Ob, g0);
  zero_o(Ob);
  if (lane < 8) { const unsigned u = uniL[lane]; if (u) atomicOr(&buni[lane], u); }
  __syncthreads();
  int nslc = 0, ntl = 0;
  {
    for (int iw = 7; iw >= 0; --iw) {
      unsigned iuw = __builtin_amdgcn_readfirstlane(buni[iw]);
      while (iuw) {
        const int bit = 31 - __builtin_clz(iuw);
        iuw &= ~(1u << bit);
        const int bb = 32 * iw + bit;
        if (bb < B) { if (lane == 0) tl[ntl] = (unsigned short)(2 * bb + 1); ++ntl; }
        else { if (lane == 0) tl[ntl] = (unsigned short)(2 * bb + 1); ++ntl; }
        if (lane == 0) tl[ntl] = (unsigned short)(2 * bb);
        ++ntl;
      }
    }
    nslc = ntl;
    const int ThiB = 2 * B + 1, TloB = ((64 * B - 511 > 0) ? (64 * B - 511) : 0) >> 5;
    for (int T = ThiB; T >= TloB; --T) { if (lane == 0) tl[ntl] = (unsigned short)T; ++ntl; }
  }
  float m = NEGB, l = 0.f;
  {
    const int n = ntl;
    const int Tlow = ((tok0 - 511 > 0) ? (tok0 - 511) : 0) >> 5, Thiw = (tok0 + 7) >> 5;
#define B_ISSUE(j_, slot_) { const int e_ = __builtin_amdgcn_readfirstlane((int)tl[j_]); if ((j_) < nslc) att_issue(ring, slot_, w, lane, ksf, vsf, e_); else att_issue(ring, slot_, w, lane, kwf, vwf, e_); }
#pragma unroll 1
    for (int j = 0; j < ATT_D && j < n; ++j) B_ISSUE(j, j)
#pragma unroll 1
    for (int i = 0; i < n; ++i) {
      const int newer = (n - 1 - i < ATT_D - 1) ? (n - 1 - i) : (ATT_D - 1);
      att_wait(newer);
      __builtin_amdgcn_s_barrier();
      asm volatile("" ::: "memory");
      if (i + ATT_D < n) B_ISSUE(i + ATT_D, (i + ATT_D) % ATT_R)
      if (i == nslc) {
        l = hsum(l);
        const float inv = (l > 0.f) ? g1 / l : 0.f;
        ot_accum(otL, lane, Ob, inv);
        ot_store(otL, lane, Ob, 1.f);
        zero_o(Ob);
        m = NEGB; l = 0.f;
      }
      const int T = __builtin_amdgcn_readfirstlane((int)tl[i]);
      const int pos0 = 32 * T, pb = pos0 + 8 * h;
      bool full; bool mine = true;
      if (i < nslc) {
        const int bb = T >> 1;
        const unsigned uw = __builtin_amdgcn_readfirstlane(uniL[bb >> 5]);
        if (!((uw >> (bb & 31)) & 1u) || pos0 > tok0 + 7) continue;
        mine = (mskL[tokl * 8 + (bb >> 5)] >> (bb & 31)) & 1u;
        full = (pos0 + 31 <= tok0) && (__ballot(!mine) == 0ull);
      } else {
        if (T < Tlow || T > Thiw) continue;
        full = (pos0 + 31 <= tok0) && (pos0 >= tok0 + 7 - 511);
      }
      LAS3 const unsigned char* slot = ring + (i % ATT_R) * 16384;
      const f32x16 acc = qk_lds(slot, qf, lane);
      const float base = slope2 * (float)(pos0 + 8 * h - t);
      float sv[16], p[16];
#pragma unroll
      for (int rg = 0; rg < 16; ++rg) { const int kk = (rg & 7) + 16 * (rg >> 3); sv[rg] = fmaf(acc[rg], c1, fmaf(slope2, (float)kk, base)); }
      if (!full) {
        if (i < nslc) {
#pragma unroll
          for (int rg = 0; rg < 16; ++rg) { const int kk = (rg & 7) + 16 * (rg >> 3); sv[rg] = (mine && (pb + kk <= t)) ? sv[rg] : ninf; }
        } else {
#pragma unroll
          for (int rg = 0; rg < 16; ++rg) { const int kk = (rg & 7) + 16 * (rg >> 3); const int dw = t - (pb + kk); sv[rg] = ((dw >= 0) && (dw < 512)) ? sv[rg] : ninf; }
        }
      }
      osm_step(sv, m, l, Ob, p);
      pv_lds(slot + 8192, p, Ob, lane);
    }
#undef B_ISSUE
    l = hsum(l);
    const float inv = (l > 0.f) ? g2 / l : 0.f;
    ot_accum(otL, lane, Ob, inv);
  }
  {
    float ss = 0.f;
#pragma unroll
    for (int dt = 0; dt < 4; ++dt)
#pragma unroll
      for (int i = 0; i < 16; ++i) ss = fmaf(Ob[dt][i], Ob[dt][i], ss);
    ss = hsum(ss);
    const float rs = rsqrtf(ss * (1.f / 128.f) + 1e-6f);
    bf16_t* orow = P.mix + (size_t)t * DM + hd * 128 + 4 * h;
    const float* grow = P.hng + hd * 128 + 4 * h;
#pragma unroll
    for (int dt = 0; dt < 4; ++dt)
#pragma unroll
      for (int a = 0; a < 4; ++a) {
        const f32x4 gv = *(const f32x4*)(grow + 32 * dt + 8 * a);
        u32x2 wv2 = {pack2(Ob[dt][4 * a] * rs * gv[0], Ob[dt][4 * a + 1] * rs * gv[1]), pack2(Ob[dt][4 * a + 2] * rs * gv[2], Ob[dt][4 * a + 3] * rs * gv[3])};
        *(u32x2*)(orow + 32 * dt + 8 * a) = wv2;
      }
  }
  asm volatile("s_waitcnt vmcnt(0)" ::: "memory");
  __syncthreads();
}

__device__ void d_convmix(int t, int tl, const bf16_t* __restrict__ proj, const float* __restrict__ convw, const float* __restrict__ hng,
                          bf16_t* __restrict__ mix) {
  const int c = tl * 8;
  float acc[8];
#pragma unroll
  for (int i = 0; i < 8; ++i) acc[i] = 0.f;
#pragma unroll
  for (int j = 0; j < 3; ++j) {
    const int tt = t - 2 + j;
    if (tt >= 0) {
      const u32x4 cu = *(const u32x4*)(proj + (size_t)tt * INWP + OFF_C + c);
      const u32x4 uu = *(const u32x4*)(proj + (size_t)tt * INWP + OFF_U + c);
      const f32x4 w0 = *(const f32x4*)(convw + j * 1024 + c), w1 = *(const f32x4*)(convw + j * 1024 + c + 4);
#pragma unroll
      for (int i = 0; i < 4; ++i) {
        const unsigned a = cu[i], b = uu[i];
        const float wl = (i < 2) ? w0[2 * i] : w1[2 * i - 4], wh = (i < 2) ? w0[2 * i + 1] : w1[2 * i - 3];
        acc[2 * i] = fmaf(wl * __uint_as_float(a << 16), __uint_as_float(b << 16), acc[2 * i]);
        acc[2 * i + 1] = fmaf(wh * __uint_as_float(a & 0xFFFF0000u), __uint_as_float(b & 0xFFFF0000u), acc[2 * i + 1]);
      }
    }
  }
  const u32x4 bb = *(const u32x4*)(proj + (size_t)t * INWP + OFF_B + c);
  float ss = 0.f;
#pragma unroll
  for (int i = 0; i < 4; ++i) {
    const unsigned b = bb[i];
    acc[2 * i] *= __uint_as_float(b << 16); acc[2 * i + 1] *= __uint_as_float(b & 0xFFFF0000u);
    ss = fmaf(acc[2 * i], acc[2 * i], ss); ss = fmaf(acc[2 * i + 1], acc[2 * i + 1], ss);
  }
  ss += __shfl_xor(ss, 8); ss += __shfl_xor(ss, 4); ss += __shfl_xor(ss, 2); ss += __shfl_xor(ss, 1);
  const float rs = rsqrtf(ss * (1.f / 128.f) + 1e-6f);
  const f32x4 g0 = *(const f32x4*)(hng + 1024 + c), g1 = *(const f32x4*)(hng + 1024 + c + 4);
  u32x4 o = {pack2(acc[0] * rs * g0[0], acc[1] * rs * g0[1]), pack2(acc[2] * rs * g0[2], acc[3] * rs * g0[3]),
             pack2(acc[4] * rs * g1[0], acc[5] * rs * g1[1]), pack2(acc[6] * rs * g1[2], acc[7] * rs * g1[3])};
  *(u32x4*)(mix + (size_t)t * DM + 1024 + c) = o;
}

__device__ void d_ln(int t, char* smem, const float* __restrict__ y, const float* __restrict__ gam, const float* __restrict__ bet,
                     float* __restrict__ stats, bf16_t* __restrict__ hb) {
  float* red = (float*)smem;
  const int tid = (TIDX & 255);
  const f32x4 a = *(const f32x4*)(y + (size_t)t * DM + tid * 8), b = *(const f32x4*)(y + (size_t)t * DM + tid * 8 + 4);
  float s = (a[0] + a[1]) + (a[2] + a[3]) + (b[0] + b[1]) + (b[2] + b[3]);
  s = wave_sum(s); if ((tid & 63) == 0) red[tid >> 6] = s; __syncthreads();
  const float mu = (red[0] + red[1] + red[2] + red[3]) * (1.f / DM);
  float q = 0.f;
#pragma unroll
  for (int i = 0; i < 4; ++i) { const float d0 = a[i] - mu, d1 = b[i] - mu; q = fmaf(d0, d0, q); q = fmaf(d1, d1, q); }
  q = wave_sum(q); if ((tid & 63) == 0) red[4 + (tid >> 6)] = q; __syncthreads();
  const float var = (red[4] + red[5] + red[6] + red[7]) * (1.f / DM);
  const float rs = rsqrtf(var + 1e-5f);
  const f32x4 g0 = *(const f32x4*)(gam + tid * 8), g1 = *(const f32x4*)(gam + tid * 8 + 4);
  const f32x4 b0 = *(const f32x4*)(bet + tid * 8), b1 = *(const f32x4*)(bet + tid * 8 + 4);
  u32x4 o = {pack2((a[0] - mu) * rs * g0[0] + b0[0], (a[1] - mu) * rs * g0[1] + b0[1]), pack2((a[2] - mu) * rs * g0[2] + b0[2], (a[3] - mu) * rs * g0[3] + b0[3]),
             pack2((b[0] - mu) * rs * g1[0] + b1[0], (b[1] - mu) * rs * g1[1] + b1[1]), pack2((b[2] - mu) * rs * g1[2] + b1[2], (b[3] - mu) * rs * g1[3] + b1[3])};
  *(u32x4*)(hb + (size_t)t * DM + tid * 8) = o;
  if (tid == 0) { stats[2 * t] = mu; stats[2 * t + 1] = rs; }
  __syncthreads();
}

__device__ void d_cvt_w1f(size_t c, const float* __restrict__ w1, bf16_t* __restrict__ w1f) {
  const int lane = c & 63, ks = (c >> 6) & 255, ct = c >> 14;
  const int col = lane & 31, h = lane >> 5;
  bf16_t v[8];
#pragma unroll
  for (int j = 0; j < 8; ++j) v[j] = f2bf(w1[(size_t)(16 * ks + 8 * h + j) * 512 + 32 * ct + col]);
  u32x4 o; o.x = v[0] | ((unsigned)v[1] << 16); o.y = v[2] | ((unsigned)v[3] << 16); o.z = v[4] | ((unsigned)v[5] << 16); o.w = v[6] | ((unsigned)v[7] << 16);
  *(u32x4*)(w1f + c * 8) = o;
}
__device__ void d_cvt_w2f(size_t c, const float* __restrict__ w2, bf16_t* __restrict__ w2f) {
  const int lane = c & 63, s = (c >> 6) & 31, ct = c >> 11;
  const int col = lane & 31, h = lane >> 5;
  bf16_t v[8];
#pragma unroll
  for (int j = 0; j < 8; ++j) v[j] = f2bf(w2[(size_t)(16 * s + 8 * h + j) * 128 + 32 * ct + col]);
  u32x4 o; o.x = v[0] | ((unsigned)v[1] << 16); o.y = v[2] | ((unsigned)v[3] << 16); o.z = v[4] | ((unsigned)v[5] << 16); o.w = v[6] | ((unsigned)v[7] << 16);
  *(u32x4*)(w2f + c * 8) = o;
}
__device__ __forceinline__ void d_compress_unit(int rt, char* smem, const bf16_t* __restrict__ proj, int col0, const float* __restrict__ pos,
                                const bf16_t* __restrict__ w1f, const float* __restrict__ b1, const bf16_t* __restrict__ w2f,
                                bf16_t* __restrict__ outf, bool isV) {
  bf16_t* Xs = (bf16_t*)smem;
  bf16_t* Hs = (bf16_t*)(smem + 2 * 8704);
  const int tid = TIDX, lane = tid & 63, w = tid >> 6, c = lane & 31, h = lane >> 5;
  const int R0 = rt * 32;
  const int srow = tid >> 4, sch = tid & 15;
  const int grow = R0 + srow, sn = grow >> 1, sg = grow & 1;
  const bool svalid = grow < 2046;
  const bf16_t* sp = proj + (size_t)(16 * sn) * INWP + col0 + sg * 128 + sch * 8;
  f32x16 acc0, acc1;
#pragma unroll
  for (int i = 0; i < 16; ++i) { acc0[i] = 0.f; acc1[i] = 0.f; }
  u32x4 rx = {0u, 0u, 0u, 0u}; f32x4 rp0, rp1;
#define STAGE_WRITE(buf)                                                                                   \
  {                                                                                                        \
    u32x4 o_;                                                                                              \
    _Pragma("unroll") for (int i = 0; i < 4; ++i) {                                                        \
      const unsigned wv_ = rx[i];                                                                          \
      const float lo = __uint_as_float(wv_ << 16) + ((i < 2) ? rp0[2 * i] : rp1[2 * i - 4]);               \
      const float hi = __uint_as_float(wv_ & 0xFFFF0000u) + ((i < 2) ? rp0[2 * i + 1] : rp1[2 * i - 3]);   \
      o_[i] = pack2(lo, hi);                                                                               \
    }                                                                                                      \
    *(u32x4*)(Xs + (buf) * 4352 + srow * 136 + sch * 8) = o_;                                              \
  }
  if (svalid) rx = *(const u32x4*)(sp);
  rp0 = *(const f32x4*)(pos + sch * 8); rp1 = *(const f32x4*)(pos + sch * 8 + 4);
  STAGE_WRITE(0)
  __syncthreads();
  const bf16_t* wb0 = w1f + ((size_t)(2 * w) * 256 * 64 + lane) * 8;
  const bf16_t* wb1 = w1f + ((size_t)(2 * w + 1) * 256 * 64 + lane) * 8;
#pragma unroll 1
  for (int l = 0; l < 32; ++l) {
    if (l + 1 < 32) {
      if (svalid) rx = *(const u32x4*)(sp + (size_t)(l + 1) * INWP);
      rp0 = *(const f32x4*)(pos + (l + 1) * 128 + sch * 8); rp1 = *(const f32x4*)(pos + (l + 1) * 128 + sch * 8 + 4);
    }
    const bf16_t* xa = Xs + (l & 1) * 4352 + c * 136 + 8 * h;
#pragma unroll
    for (int s8 = 0; s8 < 8; ++s8) {
      const bf16x8 a = *(const bf16x8*)(xa + 16 * s8);
      const bf16x8 b0 = *(const bf16x8*)(wb0 + (size_t)(8 * l + s8) * 512);
      const bf16x8 b1v = *(const bf16x8*)(wb1 + (size_t)(8 * l + s8) * 512);
      acc0 = MFMA32(a, b0, acc0);
      acc1 = MFMA32(a, b1v, acc1);
    }
    if (l + 1 < 32) STAGE_WRITE((l + 1) & 1)
    __syncthreads();
  }
  {
    const float bb0 = b1[64 * w + c], bb1 = b1[64 * w + 32 + c];
#pragma unroll
    for (int rg = 0; rg < 16; ++rg) {
      const int row = (rg & 3) + 8 * (rg >> 2) + 4 * h;
      Hs[row * 520 + 64 * w + c] = f2bf(gelu_tanh(acc0[rg] + bb0));
      Hs[row * 520 + 64 * w + 32 + c] = f2bf(gelu_tanh(acc1[rg] + bb1));
    }
  }
  __syncthreads();
  if (w < 4) {
    f32x16 o2;
#pragma unroll
    for (int i = 0; i < 16; ++i) o2[i] = 0.f;
    const bf16_t* ha = Hs + c * 520 + 8 * h;
    const bf16_t* wb = w2f + ((size_t)w * 32 * 64 + lane) * 8;
#pragma unroll 8
    for (int s2 = 0; s2 < 32; ++s2) {
      const bf16x8 a = *(const bf16x8*)(ha + 16 * s2);
      const bf16x8 b = *(const bf16x8*)(wb + (size_t)s2 * 512);
      o2 = MFMA32(a, b, o2);
    }
    const int d = 32 * w + c;
#pragma unroll
    for (int rg = 0; rg < 16; ++rg) {
      const int row = R0 + (rg & 3) + 8 * (rg >> 2) + 4 * h;
      const int n = row >> 1, g = row & 1;
      const bf16_t val = (row < 2046) ? f2bf(o2[rg]) : (bf16_t)0;
      const int T = n >> 5, nn = n & 31;
      size_t idx;
      if (!isV) idx = ((((size_t)(g * 32 + T) * 8 + (d >> 4)) * 64 + (pi_perm(nn) + 32 * ((d >> 3) & 1))) * 8 + (d & 7));
      else idx = (((((size_t)(g * 32 + T) * 4 + (d >> 5)) * 2 + (nn >> 4)) * 64 + ((d & 31) + 32 * ((nn >> 3) & 1))) * 8 + (nn & 7));
      outf[idx] = val;
    }
  }
  __syncthreads();
}


DI unsigned f2sort(float f) { unsigned u = __float_as_uint(f); return u ^ ((unsigned)((int)u >> 31) | 0x80000000u); }
DI float sort2f(unsigned k) { unsigned u = (k & 0x80000000u) ? (k ^ 0x80000000u) : ~k; return __uint_as_float(u); }
template <int N>
DI void bitonic_sort_desc(unsigned (&key)[N]) {
#pragma unroll
  for (int k = 2; k <= N; k <<= 1) {
#pragma unroll
    for (int jj = k >> 1; jj > 0; jj >>= 1) {
#pragma unroll
      for (int i = 0; i < N; ++i) {
        const int l2 = i ^ jj;
        if (l2 > i) {
          const bool desc = ((i & k) == 0);
          unsigned a = key[i], b = key[l2];
          unsigned mx = a > b ? a : b, mn = a > b ? b : a;
          key[i] = desc ? mx : mn; key[l2] = desc ? mn : mx;
        }
      }
    }
  }
}
DI void merge_top16(unsigned (&a)[16], const unsigned (&b)[16]) {
#pragma unroll
  for (int i = 0; i < 16; ++i) { unsigned o = b[15 - i]; a[i] = a[i] > o ? a[i] : o; }
#pragma unroll
  for (int jj = 8; jj > 0; jj >>= 1) {
#pragma unroll
    for (int i = 0; i < 16; ++i) {
      const int l2 = i ^ jj;
      if (l2 > i) { unsigned x = a[i], y = a[l2]; a[i] = x > y ? x : y; a[l2] = x > y ? y : x; }
    }
  }
}
__device__ void d_cvt_subk(size_t c, const float* __restrict__ subk, bf16_t* __restrict__ skf) {
  int lane = c & 63, s = (c >> 6) & 7, kt = (c >> 9) & 3, hc = c >> 11;
  int i = lane & 31, h = lane >> 5;
  const float* src = subk + ((size_t)hc * 128 + 32 * kt + i) * 128 + 16 * s + 8 * h;
  bf16_t v[8];
#pragma unroll
  for (int j = 0; j < 8; ++j) v[j] = f2bf(src[j]);
  u32x4 o; o.x = v[0] | ((unsigned)v[1] << 16); o.y = v[2] | ((unsigned)v[3] << 16); o.z = v[4] | ((unsigned)v[5] << 16); o.w = v[6] | ((unsigned)v[7] << 16);
  *(u32x4*)(skf + c * 8) = o;
}

struct EpiProjG {
  static constexpr bool PERM = true, AFTER_DRAIN = false;
  bf16_t* proj; float* gates;
  DI void operator()(const f32x4 (&acc)[2][2][4][2], const pg8::Unit& u, int wr, int wc, int fr, int fq) const {
#pragma unroll
    for (int ai = 0; ai < 2; ++ai)
#pragma unroll
      for (int m = 0; m < 4; ++m) {
        const int row = u.pm * 256 + ai * 128 + wr * 64 + m * 16 + fr;
#pragma unroll
        for (int bj = 0; bj < 2; ++bj) {
          const int c0 = u.pn * 256 + bj * 128 + wc * 32 + 8 * fq;
          const f32x4 v0 = acc[ai][bj][m][0], v1 = acc[ai][bj][m][1];
          if (c0 < INW) {
            u32x4 w = {pack2(v0[0], v0[1]), pack2(v0[2], v0[3]), pack2(v1[0], v1[1]), pack2(v1[2], v1[3])};
            *(u32x4*)(proj + (size_t)row * INWP + c0) = w;
          }
          if (c0 >= OFF_G && c0 < OFF_G + 24) {
            f32x4 g0, g1;
#pragma unroll
            for (int j = 0; j < 4; ++j) { g0[j] = 1.f / (1.f + __expf(-v0[j])); g1[j] = 1.f / (1.f + __expf(-v1[j])); }
            *(f32x4*)(gates + (size_t)row * 24 + (c0 - OFF_G)) = g0;
            *(f32x4*)(gates + (size_t)row * 24 + (c0 - OFF_G) + 4) = g1;
          }
        }
      }
  }
};
struct EpiResG {
  static constexpr bool PERM = false, AFTER_DRAIN = false;
  float* Y; const float* X;
  DI void operator()(const f32x4 (&acc)[2][2][4][2], const pg8::Unit& u, int wr, int wc, int fr, int fq) const {
#pragma unroll
    for (int ai = 0; ai < 2; ++ai)
#pragma unroll
      for (int m = 0; m < 4; ++m) {
        const size_t ro = (size_t)(u.pm * 256 + ai * 128 + wr * 64 + m * 16 + fr) * DM + u.pn * 256 + wc * 32 + 4 * fq;
#pragma unroll
        for (int bj = 0; bj < 2; ++bj)
#pragma unroll
          for (int n = 0; n < 2; ++n) {
            const f32x4 xv = *(const f32x4*)(X + ro + bj * 128 + n * 16);
            *(f32x4*)(Y + ro + bj * 128 + n * 16) = ALPHA * xv + acc[ai][bj][m][n];
          }
      }
  }
};
struct EpiF32G {
  static constexpr bool PERM = false, AFTER_DRAIN = false;
  float* C; int ldc;
  DI void operator()(const f32x4 (&acc)[2][2][4][2], const pg8::Unit& u, int wr, int wc, int fr, int fq) const {
#pragma unroll
    for (int ai = 0; ai < 2; ++ai)
#pragma unroll
      for (int m = 0; m < 4; ++m) {
        const size_t ro = (size_t)(u.pm * 256 + ai * 128 + wr * 64 + m * 16 + fr) * ldc + u.pn * 256 + wc * 32 + 4 * fq;
#pragma unroll
        for (int bj = 0; bj < 2; ++bj)
#pragma unroll
          for (int n = 0; n < 2; ++n) *(f32x4*)(C + ro + bj * 128 + n * 16) = acc[ai][bj][m][n];
      }
  }
};
struct EpiRouteG {
  static constexpr bool PERM = false, AFTER_DRAIN = true;
  const bf16_t* skf; unsigned* tops;
  DI void operator()(const f32x4 (&)[2][2][4][2], const pg8::Unit&, int, int, int, int) const {}
  DI void fused(const f32x4 (&acc)[2][2][4][2], const pg8::Unit& u, int wr, int wc, int fr, int fq, PG8_LAS unsigned char* ldsp, int, int) const {
    const int lane = fr | (fq << 4), wid = wr * 4 + wc;
    bf16_t* Qs = (bf16_t*)ldsp;
#pragma unroll
    for (int ai = 0; ai < 2; ++ai)
#pragma unroll
      for (int m = 0; m < 4; ++m) {
        const int row = ai * 128 + wr * 64 + m * 16 + fr;
#pragma unroll
        for (int bj = 0; bj < 2; ++bj)
#pragma unroll
          for (int n = 0; n < 2; ++n) {
            const f32x4 v = acc[ai][bj][m][n];
            u32x2 w = {pack2(v[0], v[1]), pack2(v[2], v[3])};
            *(u32x2*)(Qs + row * 264 + bj * 128 + wc * 32 + n * 16 + 4 * fq) = w;
          }
      }
    __syncthreads();
    const int c = lane & 31, h = lane >> 5;
#pragma unroll 1
    for (int half = 0; half < 2; ++half) {
      const int hc = u.pn * 2 + half;
      const bf16_t* sk = skf + (size_t)hc * 4 * 4096;
      const bf16_t* qp = Qs + (wid * 32 + c) * 264 + half * 128 + 8 * h;
      unsigned k0[16], k1[16];
#define ROUTE_KT(KT, KA)                                                                        \
      {                                                                                         \
        f32x16 sc;                                                                              \
        _Pragma("unroll") for (int i = 0; i < 16; ++i) sc[i] = 0.f;                             \
        _Pragma("unroll") for (int s = 0; s < 8; ++s) {                                         \
          bf16x8 af = *(const bf16x8*)(sk + (KT) * 4096 + s * 512 + lane * 8);                  \
          bf16x8 bq = *(const bf16x8*)(qp + 16 * s);                                            \
          sc = __builtin_amdgcn_mfma_f32_32x32x16_bf16(af, bq, sc, 0, 0, 0);                    \
        }                                                                                       \
        _Pragma("unroll") for (int rg = 0; rg < 16; ++rg) {                                     \
          const int kidx = 32 * (KT) + (rg & 3) + 8 * (rg >> 2) + 4 * h;                        \
          KA[rg] = (f2sort(sc[rg]) & 0xFFFFFF80u) | (unsigned)(127 - kidx);                     \
        }                                                                                       \
        bitonic_sort_desc<16>(KA);                                                              \
      }
      ROUTE_KT(0, k0)
      __builtin_amdgcn_sched_barrier(0);
      ROUTE_KT(1, k1)
      merge_top16(k0, k1);
      __builtin_amdgcn_sched_barrier(0);
      ROUTE_KT(2, k1)
      merge_top16(k0, k1);
      __builtin_amdgcn_sched_barrier(0);
      ROUTE_KT(3, k1)
      merge_top16(k0, k1);
      __builtin_amdgcn_sched_barrier(0);
#undef ROUTE_KT
#pragma unroll
      for (int i = 0; i < 16; ++i) k1[i] = (unsigned)__shfl_xor((int)k0[i], 32);
      merge_top16(k0, k1);
      if (h == 0) {
        unsigned* dst = tops + ((size_t)(u.pm * 256 + wid * 32 + c) * 16 + hc) * 16;
#pragma unroll
        for (int q4 = 0; q4 < 4; ++q4) { u32x4 o = {k0[4 * q4], k0[4 * q4 + 1], k0[4 * q4 + 2], k0[4 * q4 + 3]}; *(u32x4*)(dst + 4 * q4) = o; }
      }
    }
    __syncthreads();
  }
};


template <int CTRL> DI float dpp_f(float v) { const int iv = __float_as_int(v); return __int_as_float(__builtin_amdgcn_update_dpp(iv, iv, CTRL, 0xF, 0xF, false)); }
DI float wsum(float x) {
  x += dpp_f<0xB1>(x);
  x += dpp_f<0x4E>(x);
  x += dpp_f<0x124>(x);
  x += dpp_f<0x128>(x);
  x += __shfl_xor(x, 16);
  return hsum(x);
}
DI float gelu_fast(float x) {
  const float u2 = 1.5957691216057308f * (x + 0.044715f * x * x * x);
  return x * __builtin_amdgcn_rcpf(1.f + ex2(-LOG2E * u2));
}

constexpr int EROW = 1152;
typedef float v2f __attribute__((ext_vector_type(2)));
__device__ void d_cvt_fp4_row(int row, const float* __restrict__ src, unsigned char* __restrict__ dst) {
  const int lane = TIDX & 63;
  float v[32]; float amax = 0.f;
#pragma unroll
  for (int i = 0; i < 8; ++i) {
    f32x4 x = *(const f32x4*)(src + (size_t)row * DM + 32 * lane + 4 * i);
#pragma unroll
    for (int j = 0; j < 4; ++j) { v[i * 4 + j] = x[j]; amax = fmaxf(amax, fabsf(x[j])); }
  }
  const float sc = amax > 0.f ? amax * (1.f / 6.f) : 1.f;
  const float scb = bf2f(f2bf(sc));
  const float inv = 1.f / scb;
  u32x4 o;
#pragma unroll
  for (int k = 0; k < 4; ++k) {
    unsigned w = 0u;
#define FP4C(x_) fminf(fmaxf((x_) * inv, -6.f), 6.f)
    w = __builtin_amdgcn_cvt_scalef32_pk_fp4_f32(w, FP4C(v[8 * k + 0]), FP4C(v[8 * k + 1]), 1.0f, 0);
    w = __builtin_amdgcn_cvt_scalef32_pk_fp4_f32(w, FP4C(v[8 * k + 2]), FP4C(v[8 * k + 3]), 1.0f, 1);
    w = __builtin_amdgcn_cvt_scalef32_pk_fp4_f32(w, FP4C(v[8 * k + 4]), FP4C(v[8 * k + 5]), 1.0f, 2);
    w = __builtin_amdgcn_cvt_scalef32_pk_fp4_f32(w, FP4C(v[8 * k + 6]), FP4C(v[8 * k + 7]), 1.0f, 3);
#undef FP4C
    o[k] = w;
  }
  *(u32x4*)(dst + (size_t)row * EROW + 16 * lane) = o;
  *(bf16_t*)(dst + (size_t)row * EROW + 1024 + 2 * lane) = f2bf(sc);
}
__device__ void d_expert_wave(int t, const float* __restrict__ yf, const float* __restrict__ stats, const float* __restrict__ g1v, const float* __restrict__ b1v,
                              const unsigned* __restrict__ tops, const unsigned char* __restrict__ eu4, const unsigned char* __restrict__ ev4,
                              const float* __restrict__ gam, const float* __restrict__ bet, float* __restrict__ out) {
  const int lane = TIDX & 63;
  const float mu1 = stats[2 * t], rs1 = stats[2 * t + 1];
  float hv[32];
#pragma unroll
  for (int i = 0; i < 8; ++i) {
    const int cb = 32 * lane + 4 * i;
    const f32x4 x = *(const f32x4*)(yf + (size_t)t * DM + cb), gg = *(const f32x4*)(g1v + cb), bb = *(const f32x4*)(b1v + cb);
#pragma unroll
    for (int j = 0; j < 4; ++j) hv[i * 4 + j] = (x[j] - mu1) * rs1 * gg[j] + bb[j];
  }
  int e0 = 0, e1 = 0; float w0 = 0.f, w1 = 0.f;
  {
    const int ci = (lane < 16) ? 0 : (lane < 24) ? 1 : (lane < 29) ? 2 : (lane < 33) ? 3 : (lane < 36) ? 4 : (lane < 38) ? 5 : (lane < 40) ? 6
                   : (lane < 42) ? 7 : (lane - 34);
    const int cpre = (ci == 0) ? 0 : (ci == 1) ? 16 : (ci == 2) ? 24 : (ci == 3) ? 29 : (ci == 4) ? 33 : (ci == 5) ? 36 : (ci == 6) ? 38
                     : (ci == 7) ? 40 : (34 + ci);
    const int cj = lane - cpre;
    const bool cvalid = lane < 50;
    const unsigned* tp = tops + (size_t)t * 256;
#pragma unroll 1
    for (int hh = 0; hh < 8; ++hh) {
      unsigned key = 0u;
      if (cvalid) {
        const float sa = sort2f(tp[(2 * hh) * 16 + ci]), sb = sort2f(tp[(2 * hh + 1) * 16 + cj]);
        key = (f2sort(sa + sb) & 0xFFFFFF00u) | (unsigned)(255 - (ci * 16 + cj));
      }
#pragma unroll
      for (int k = 2; k <= 64; k <<= 1) {
#pragma unroll
        for (int jj = k >> 1; jj > 0; jj >>= 1) {
          const unsigned o = (unsigned)__shfl_xor((int)key, jj);
          const bool lower = (lane & jj) == 0;
          const bool desc = (lane & k) == 0 || k == 64;
          const unsigned mx = key > o ? key : o, mn = key > o ? o : key;
          key = (lower == desc) ? mx : mn;
        }
      }
      const int flat = 255 - (int)(key & 255u);
      const int bi = (flat >> 4) & 15, bj = flat & 15;
      const unsigned ka = tp[(2 * hh) * 16 + bi], kb = tp[(2 * hh + 1) * 16 + bj];
      const float sc = sort2f(ka) + sort2f(kb);
      const int ex = (127 - (int)(ka & 127u)) * 128 + (127 - (int)(kb & 127u));
      float mx = sc;
      mx = fmaxf(mx, __shfl_xor(mx, 1)); mx = fmaxf(mx, __shfl_xor(mx, 2)); mx = fmaxf(mx, __shfl_xor(mx, 4)); mx = fmaxf(mx, __shfl_xor(mx, 8));
      const float ev_ = __expf(sc - mx);
      float sm = ev_;
      sm += __shfl_xor(sm, 1); sm += __shfl_xor(sm, 2); sm += __shfl_xor(sm, 4); sm += __shfl_xor(sm, 8);
      const float gv = ev_ / sm;
      const int exs = __shfl(ex, lane & 15); const float gvs = __shfl(gv, lane & 15);
      if ((lane >> 4) == (hh & 3)) { if (hh < 4) { e0 = exs; w0 = gvs; } else { e1 = exs; w1 = gvs; } }
    }
  }
  v2f hv2[16];
#pragma unroll
  for (int i = 0; i < 16; ++i) hv2[i] = v2f{hv[2 * i], hv[2 * i + 1]};
  float c0 = 0.f, c1 = 0.f;
  u32x4 rA[4], rB[4]; unsigned short sA[4], sB[4];
#define EX_LOAD(R, SS, TAB, EB)                                                            \
  _Pragma("unroll") for (int k = 0; k < 4; ++k) {                                          \
    const int e = (EB) + k;                                                                \
    const int id = __builtin_amdgcn_readlane((e < 64) ? e0 : e1, e & 63);                 \
    const unsigned char* row = (TAB) + (size_t)id * EROW;                                  \
    R[k] = *(const u32x4*)(row + 16 * lane);                                               \
    SS[k] = *(const unsigned short*)(row + 1024 + 2 * lane);                               \
  }
#define PKFMA(a_, b_, c_) __builtin_elementwise_fma((a_), (b_), (c_))
#define EX_COMP_U(R, SS, EB)                                                               \
  {                                                                                        \
    float dd[4];                                                                           \
    _Pragma("unroll") for (int k = 0; k < 4; ++k) {                                        \
      v2f d0 = {0.f, 0.f}, d1 = {0.f, 0.f};                                                \
      _Pragma("unroll") for (int q = 0; q < 4; ++q) {                                      \
        const unsigned wq = R[k][q];                                                       \
        const v2f f0 = __builtin_amdgcn_cvt_scalef32_pk_f32_fp4(wq, 1.0f, 0), f1 = __builtin_amdgcn_cvt_scalef32_pk_f32_fp4(wq, 1.0f, 1); \
        const v2f f2 = __builtin_amdgcn_cvt_scalef32_pk_f32_fp4(wq, 1.0f, 2), f3 = __builtin_amdgcn_cvt_scalef32_pk_f32_fp4(wq, 1.0f, 3); \
        d0 = PKFMA(hv2[4 * q + 0], f0, d0); d1 = PKFMA(hv2[4 * q + 1], f1, d1);            \
        d0 = PKFMA(hv2[4 * q + 2], f2, d0); d1 = PKFMA(hv2[4 * q + 3], f3, d1);            \
      }                                                                                    \
      dd[k] = bf2f(SS[k]) * ((d0.x + d0.y) + (d1.x + d1.y));                               \
      __builtin_amdgcn_sched_barrier(0);                                                   \
    }                                                                                      \
    _Pragma("unroll") for (int k = 0; k < 4; ++k) dd[k] = wsum(dd[k]);                     \
    _Pragma("unroll") for (int k = 0; k < 4; ++k) {                                        \
      const int e = (EB) + k;                                                              \
      const float gl = gelu_fast(dd[k]);                                                   \
      if (e < 64) { if (lane == e) c0 = w0 * gl; } else { if (lane == e - 64) c1 = w1 * gl; } \
    }                                                                                      \
    __builtin_amdgcn_sched_barrier(0);                                                     \
  }
#define EX_COMP_V(R, SS, EB)                                                               \
  _Pragma("unroll") for (int k = 0; k < 4; ++k) {                                          \
    const int e = (EB) + k;                                                                \
    const float cs = __int_as_float(__builtin_amdgcn_readlane(__float_as_int((e < 64) ? c0 : c1), e & 63)) * bf2f(SS[k]);                     \
    const v2f cs2 = {cs, cs};                                                              \
    _Pragma("unroll") for (int q = 0; q < 4; ++q) {                                        \
      const unsigned wq = R[k][q];                                                         \
      const v2f f0 = __builtin_amdgcn_cvt_scalef32_pk_f32_fp4(wq, 1.0f, 0), f1 = __builtin_amdgcn_cvt_scalef32_pk_f32_fp4(wq, 1.0f, 1); \
      const v2f f2 = __builtin_amdgcn_cvt_scalef32_pk_f32_fp4(wq, 1.0f, 2), f3 = __builtin_amdgcn_cvt_scalef32_pk_f32_fp4(wq, 1.0f, 3); \
      acc2[4 * q + 0] = PKFMA(cs2, f0, acc2[4 * q + 0]); acc2[4 * q + 1] = PKFMA(cs2, f1, acc2[4 * q + 1]); \
      acc2[4 * q + 2] = PKFMA(cs2, f2, acc2[4 * q + 2]); acc2[4 * q + 3] = PKFMA(cs2, f3, acc2[4 * q + 3]); \
    }                                                                                      \
    __builtin_amdgcn_sched_barrier(0);                                                     \
  }
  EX_LOAD(rA, sA, eu4, 0)
  __builtin_amdgcn_sched_barrier(0);
#pragma unroll 1
  for (int eb = 0; eb < 128; eb += 8) {
    EX_LOAD(rB, sB, eu4, eb + 4)
    __builtin_amdgcn_sched_barrier(0);
    EX_COMP_U(rA, sA, eb)
    { const bool more = eb + 8 < 128; const unsigned char* tabn = more ? eu4 : ev4; const int ebn = more ? eb + 8 : 0;
      EX_LOAD(rA, sA, tabn, ebn) }
    __builtin_amdgcn_sched_barrier(0);
    EX_COMP_U(rB, sB, eb + 4)
  }
  v2f acc2[16];
#pragma unroll
  for (int i = 0; i < 16; ++i) acc2[i] = v2f{0.f, 0.f};
#pragma unroll 1
  for (int eb = 0; eb < 128; eb += 8) {
    EX_LOAD(rB, sB, ev4, eb + 4)
    __builtin_amdgcn_sched_barrier(0);
    EX_COMP_V(rA, sA, eb)
    { const int ebn = (eb + 8 < 128) ? eb + 8 : 0;
      EX_LOAD(rA, sA, ev4, ebn) }
    __builtin_amdgcn_sched_barrier(0);
    EX_COMP_V(rB, sB, eb + 4)
  }
#undef EX_LOAD
#undef EX_COMP_U
#undef EX_COMP_V
#undef PKFMA
  float acc[32];
#pragma unroll
  for (int i = 0; i < 16; ++i) { acc[2 * i] = acc2[i].x; acc[2 * i + 1] = acc2[i].y; }
  int le = lane;
  asm volatile("" : "+v"(le) :: "memory");
  float s = 0.f;
#pragma unroll
  for (int i = 0; i < 8; ++i) {
    const int cb = 32 * le + 4 * i;
    const f32x4 x = *(const f32x4*)(yf + (size_t)t * DM + cb), gg = *(const f32x4*)(g1v + cb), bb = *(const f32x4*)(b1v + cb);
#pragma unroll
    for (int j = 0; j < 4; ++j) { const float hj = (x[j] - mu1) * rs1 * gg[j] + bb[j]; acc[i * 4 + j] = fmaf(ALPHA, hj, acc[i * 4 + j]); s += acc[i * 4 + j]; }
  }
  s = wsum(s);
  const float mu = s * (1.f / DM);
  float qv = 0.f;
#pragma unroll
  for (int i = 0; i < 32; ++i) { const float d = acc[i] - mu; qv += d * d; }
  qv = wsum(qv);
  const float rs = rsqrtf(qv * (1.f / DM) + 1e-5f);
#pragma unroll
  for (int i = 0; i < 8; ++i) {
    const int cbase = 32 * le + 4 * i;
    f32x4 ga = *(const f32x4*)(gam + cbase), ba = *(const f32x4*)(bet + cbase), o;
#pragma unroll
    for (int j = 0; j < 4; ++j) o[j] = (acc[i * 4 + j] - mu) * rs * ga[j] + ba[j];
    *(f32x4*)(out + (size_t)t * DM + cbase) = o;
  }
}

constexpr size_t al256(size_t x) { return (x + 255) & ~(size_t)255; }
constexpr size_t WS_XB = 0;
constexpr size_t WS_PROJ = WS_XB + al256((size_t)S * DM * 2);
constexpr size_t WS_WINT = WS_PROJ + al256((size_t)S * INWP * 2);
constexpr size_t WS_GATES = WS_WINT + al256((size_t)INWG * DM * 2);
constexpr size_t WS_W1KF = WS_GATES + al256((size_t)S * 24 * 4);
constexpr size_t WS_W1VF = WS_W1KF + al256((size_t)512 * 4096 * 2);
constexpr size_t WS_W2KF = WS_W1VF + al256((size_t)512 * 4096 * 2);
constexpr size_t WS_W2VF = WS_W2KF + al256((size_t)512 * 128 * 2);
constexpr size_t WS_VC = WS_W2VF + al256((size_t)512 * 128 * 2) - al256((size_t)2048 * 128 * 4);
constexpr size_t WS_KCF = WS_VC + al256((size_t)2048 * 128 * 4);
constexpr size_t WS_VCF = WS_KCF + al256((size_t)2 * 32 * 4096 * 2);
constexpr size_t WS_KSF = WS_VCF + al256((size_t)2 * 32 * 4096 * 2);
constexpr size_t WS_VSF = WS_KSF + al256((size_t)2 * 512 * 4096 * 2);
constexpr size_t WS_KWF = WS_VSF + al256((size_t)2 * 512 * 4096 * 2);
constexpr size_t WS_VWF = WS_KWF + al256((size_t)2 * 512 * 4096 * 2);
constexpr size_t WS_ENDA = WS_VWF + al256((size_t)2 * 512 * 4096 * 2);
constexpr size_t WS_OATT = WS_ENDA;
constexpr size_t WS_MIX = WS_OATT + al256((size_t)S * 1024 * 4);
constexpr size_t WS_WOUTT = WS_MIX + al256((size_t)S * DM * 2);
constexpr size_t WS_WQT = WS_WOUTT + al256((size_t)DM * DM * 2);
constexpr size_t WS_TOPS = WS_WQT + al256((size_t)DM * DM * 2);
constexpr size_t WS_SKF = WS_TOPS + al256((size_t)S * 256 * 4);
constexpr size_t WS_STATS = WS_SKF + al256((size_t)16 * 128 * 128 * 2);
constexpr size_t WS_CTRL = WS_STATS + al256((size_t)S * 2 * 4);
constexpr size_t CTRL_BYTES = 32768;
constexpr size_t WS_END = WS_CTRL + CTRL_BYTES;
constexpr size_t WS_Y = WS_PROJ;
constexpr size_t WS_HB = WS_XB;
constexpr size_t WS_EU8 = WS_Y + (size_t)S * DM * 4;
constexpr size_t WS_EV8 = WS_EU8 + (size_t)16384 * 1152;
static_assert(WS_EV8 + (size_t)16384 * 1152 <= WS_ENDA, "expert overlay overflows group A");
static_assert(WS_END <= (size_t)512 * 1024 * 1024, "workspace over 512 MiB");

struct Params {
  const float *x, *w_in, *ck_pos, *ck_w1, *ck_b1, *ck_w2, *cv_pos, *cv_w1, *cv_b1, *cv_w2, *conv_w, *hng, *w_out, *ln1g, *ln1b, *w_query, *subk,
      *eu, *ev, *ln2g, *ln2b;
  float* out;
  char* ws;
};
#define WSP(T, OFF) ((T*)(p.ws + (OFF)))

#define FOR_VB(n) for (int vb = blockIdx.x; vb < (n); vb += gridDim.x)
#define FOR_VB2(n) for (int vb = blockIdx.x * 2 + (TIDX >> 8); vb < (n); vb += gridDim.x * 2)
constexpr int SMEM_BYTES = 143360;
constexpr int HALF = 36864;

__global__ void __launch_bounds__(512) mega(Params p) {
  __shared__ __attribute__((aligned(16))) char smem[SMEM_BYTES + 16];
  if (TIDX == 0) *(u32x4*)(smem + SMEM_BYTES) = u32x4{0u, 0u, 0u, 0u};
  __syncthreads();
  const XcdBarrier xbar = xcd_barrier_post(WSP(unsigned, WS_CTRL + 1024), (volatile LAS unsigned*)(smem + SMEM_BYTES));
#define smh (smem + (TIDX >> 8) * HALF)
#define wv ((TIDX >> 6))
  constexpr int NWV = 8;
  d_cvt(p.x, WSP(bf16_t, WS_XB), (size_t)S * DM / 4);
  FOR_VB2((INWG / 32) * (DM / 32)) d_cvtT(vb, smh, p.w_in, WSP(bf16_t, WS_WINT), DM, INW, INWG);
  for (size_t c = (size_t)blockIdx.x * 512 + TIDX; c < (size_t)16 * 256 * 64; c += (size_t)gridDim.x * 512) {
    d_cvt_w1f(c, p.ck_w1, WSP(bf16_t, WS_W1KF)); d_cvt_w1f(c, p.cv_w1, WSP(bf16_t, WS_W1VF));
    if (c < (size_t)4 * 32 * 64) { d_cvt_w2f(c, p.ck_w2, WSP(bf16_t, WS_W2KF)); d_cvt_w2f(c, p.cv_w2, WSP(bf16_t, WS_W2VF)); }
  }
  FOR_VB2((DM / 32) * (DM / 32)) d_cvtT(vb, smh, p.w_out, WSP(bf16_t, WS_WOUTT), DM, DM, DM);
  FOR_VB2((DM / 32) * (DM / 32)) d_cvtT(vb, smh, p.w_query, WSP(bf16_t, WS_WQT), DM, DM, DM);
  for (size_t c = (size_t)blockIdx.x * 512 + TIDX; c < (size_t)16 * 4 * 8 * 64; c += (size_t)gridDim.x * 512) d_cvt_subk(c, p.subk, WSP(bf16_t, WS_SKF));
  xcd_barrier(xbar);
  {
    pg8::StaticOrder so; so.init(S, INWG, gridDim.x, blockIdx.x);
    pg8::gemm_phase<EpiProjG, pg8::StaticOrder>((PG8_LAS unsigned char*)smem, pg8::Gemm{WSP(bf16_t, WS_XB), WSP(bf16_t, WS_WINT), S, INWG, DM}, so,
                                                EpiProjG{WSP(bf16_t, WS_PROJ), WSP(float, WS_GATES)}, nullptr);
  }
  xcd_barrier(xbar);
  {
    if (blockIdx.x < 128) {
      const int u = blockIdx.x; const bool isV = u >= 64;
      d_compress_unit(u & 63, smem, WSP(bf16_t, WS_PROJ), isV ? OFF_VC : OFF_KC, isV ? p.cv_pos : p.ck_pos, isV ? WSP(bf16_t, WS_W1VF) : WSP(bf16_t, WS_W1KF),
                      isV ? p.cv_b1 : p.ck_b1, isV ? WSP(bf16_t, WS_W2VF) : WSP(bf16_t, WS_W2KF), isV ? WSP(bf16_t, WS_VCF) : WSP(bf16_t, WS_KCF), isV);
    }
    int* slot = (int*)smem;
    unsigned* ctr = WSP(unsigned, WS_CTRL);
    for (;;) {
      if (TIDX == 0) *slot = (int)atomicAdd(ctr, 1u);
      __syncthreads();
      const int it = *slot;
      __syncthreads();
      if (it >= 2048) break;
      const int tt = TIDX;
      {
        const int T = it >> 2, which = it & 3;
        d_relayout_tile(T, smem + 64, WSP(bf16_t, WS_PROJ), (which == 0) ? OFF_KS : (which == 1) ? OFF_VS : (which == 2) ? OFF_KW : OFF_VW,
                        (which == 0) ? WSP(bf16_t, WS_KSF) : (which == 1) ? WSP(bf16_t, WS_VSF) : (which == 2) ? WSP(bf16_t, WS_KWF) : WSP(bf16_t, WS_VWF), (which & 1) != 0);
      }
      for (int q = 0; q < 2; ++q) d_convmix(it * 8 + q * 4 + (tt >> 7), tt & 127, WSP(bf16_t, WS_PROJ), p.conv_w, p.hng, WSP(bf16_t, WS_MIX));
    }
  }
  xcd_barrier(xbar);
  {
    AttnPtrs ap{WSP(bf16_t, WS_PROJ), WSP(float, WS_GATES), WSP(bf16_t, WS_KCF), WSP(bf16_t, WS_VCF), WSP(bf16_t, WS_KSF), WSP(bf16_t, WS_VSF), WSP(bf16_t, WS_KWF), WSP(bf16_t, WS_VWF), WSP(bf16_t, WS_MIX), p.hng};
    for (int it = blockIdx.x; it < 512; it += gridDim.x) {
      const int Bq = (it < 256) ? it : (511 - it), gq = (it < 256) ? 0 : 1;
      d_attn_block(Bq, gq, smem, ap);
    }
  }
  xcd_barrier(xbar);
  {
    pg8::StaticOrder so; so.init(S, DM, gridDim.x, blockIdx.x);
    pg8::gemm_phase<EpiResG, pg8::StaticOrder>((PG8_LAS unsigned char*)smem, pg8::Gemm{WSP(bf16_t, WS_MIX), WSP(bf16_t, WS_WOUTT), S, DM, DM}, so,
                                               EpiResG{WSP(float, WS_Y), p.x}, nullptr);
  }
  xcd_barrier(xbar);
  FOR_VB2(S) d_ln(vb, smh, WSP(float, WS_Y), p.ln1g, p.ln1b, WSP(float, WS_STATS), WSP(bf16_t, WS_HB));
  for (int r = blockIdx.x * NWV + wv; r < 32768; r += gridDim.x * NWV) {
    if (r < 16384) d_cvt_fp4_row(r, p.eu, WSP(unsigned char, WS_EU8)); else d_cvt_fp4_row(r - 16384, p.ev, WSP(unsigned char, WS_EV8));
  }
  xcd_barrier(xbar);
  for (int k = 0; k * (int)gridDim.x < (S / 256) * (DM / 256); ++k) {
    pg8::OneUnit so; so.init(S, DM, gridDim.x, blockIdx.x); so.k = k;
    pg8::gemm_phase<EpiRouteG, pg8::OneUnit>((PG8_LAS unsigned char*)smem, pg8::Gemm{WSP(bf16_t, WS_HB), WSP(bf16_t, WS_WQT), S, DM, DM}, so,
                                             EpiRouteG{WSP(bf16_t, WS_SKF), WSP(unsigned, WS_TOPS)}, nullptr);
    __syncthreads();
  }
  xcd_barrier(xbar);
  for (int t = blockIdx.x * NWV + wv; t < S; t += gridDim.x * NWV) d_expert_wave(t, WSP(float, WS_Y), WSP(float, WS_STATS), p.ln1g, p.ln1b, WSP(unsigned, WS_TOPS), WSP(unsigned char, WS_EU8), WSP(unsigned char, WS_EV8), p.ln2g, p.ln2b, p.out);
}

extern "C" void kernel_launch(void* const* d_in, const int* in_sizes, int n_in, void* d_out, int out_size, void* d_ws, size_t ws_size,
                              hipStream_t stream) {
  Params p{};
  p.x = (const float*)d_in[0]; p.w_in = (const float*)d_in[1]; p.ck_pos = (const float*)d_in[2]; p.ck_w1 = (const float*)d_in[3];
  p.ck_b1 = (const float*)d_in[4]; p.ck_w2 = (const float*)d_in[5]; p.cv_pos = (const float*)d_in[6]; p.cv_w1 = (const float*)d_in[7];
  p.cv_b1 = (const float*)d_in[8]; p.cv_w2 = (const float*)d_in[9]; p.conv_w = (const float*)d_in[10]; p.hng = (const float*)d_in[11];
  p.w_out = (const float*)d_in[12]; p.ln1g = (const float*)d_in[13]; p.ln1b = (const float*)d_in[14]; p.w_query = (const float*)d_in[15];
  p.subk = (const float*)d_in[16]; p.eu = (const float*)d_in[17]; p.ev = (const float*)d_in[18]; p.ln2g = (const float*)d_in[19];
  p.ln2b = (const float*)d_in[20];
  p.out = (float*)d_out;
  p.ws = (char*)d_ws;
  if (ws_size < WS_END) fprintf(stderr, "workspace too small\n");
  static int grid_blocks = 0;
  if (!grid_blocks) {
    int dev = 0, cus = 0, per_cu = 0;
    hipGetDevice(&dev);
    hipDeviceGetAttribute(&cus, hipDeviceAttributeMultiprocessorCount, dev);
    hipOccupancyMaxActiveBlocksPerMultiprocessor(&per_cu, mega, 512, 0);
    if (per_cu > 1) per_cu = 1;
    if (per_cu < 1) per_cu = 1;
    grid_blocks = cus * per_cu;
  }
  hipMemsetAsync((char*)d_ws + WS_CTRL, 0, CTRL_BYTES, stream);
  void* args[] = {&p};
  hipError_t e = hipLaunchCooperativeKernel((void*)mega, dim3(grid_blocks), dim3(512), args, 0, stream);
  if (e != hipSuccess) fprintf(stderr, "cooperative launch failed: %s (grid %d)\n", hipGetErrorString(e), grid_blocks);
}
```

```cpp
#include <hip/hip_runtime.h>
#include <stdint.h>
#include <stdio.h>


#define DI __device__ __forceinline__
static __device__ __forceinline__ int tidx_() { int t = (int)__builtin_amdgcn_workitem_id_x(); asm volatile("" : "+v"(t)); return t; }
#define TIDX (tidx_())
typedef unsigned short bf16_t;
using bf16x8 = __attribute__((ext_vector_type(8))) short;
using f32x4 = __attribute__((ext_vector_type(4))) float;
using u32x4 = __attribute__((ext_vector_type(4))) unsigned;
using u32x2 = __attribute__((ext_vector_type(2))) unsigned;

constexpr int S = 16384, DM = 2048, HD = 128;
constexpr int INW = 5656, INWP = 5760, INWG = 5888;
constexpr int OFF_Q = 0, OFF_KC = 1024, OFF_VC = 1280, OFF_KS = 1536, OFF_VS = 1792, OFF_KW = 2048, OFF_VW = 2304,
              OFF_G = 2560, OFF_U = 2584, OFF_B = 3608, OFF_C = 4632;
constexpr int NCMP = 1023;
constexpr float ALPHA = 1.189207115002721f;
constexpr float QSCALE = 0.08838834764831845f;

DI bf16_t f2bf(float x) { unsigned u = __float_as_uint(x); u += 0x7fffu + ((u >> 16) & 1u); return (bf16_t)(u >> 16); }
DI float bf2f(bf16_t b) { return __uint_as_float(((unsigned)b) << 16); }
DI float gelu_tanh(float x) { float u = 0.7978845608028654f * (x + 0.044715f * x * x * x); return 0.5f * x * (1.f + tanhf(u)); }
DI float wave_sum(float v) { for (int o = 32; o > 0; o >>= 1) v += __shfl_xor(v, o); return v; }
using bf16x2v = __attribute__((ext_vector_type(2))) __bf16;
DI unsigned pack2(float a, float b) { bf16x2v v = {(__bf16)a, (__bf16)b}; return __builtin_bit_cast(unsigned, v); }
DI float wave_max(float v) { for (int o = 32; o > 0; o >>= 1) v = fmaxf(v, __shfl_xor(v, o)); return v; }

namespace pg8 {
#define PG8_LAS __attribute__((address_space(3)))
typedef unsigned short bf16_t;
typedef short bf16x8 __attribute__((ext_vector_type(8)));
typedef float f32x4 __attribute__((ext_vector_type(4)));
typedef unsigned u32x4 __attribute__((ext_vector_type(4)));
constexpr int BM = 256, BK = 64, HALF = 128, HTB = HALF * BK * 2  , STAGE_BYTES = 8 * HTB, NXCD = 8, WGM = 8;

__host__ __device__ __forceinline__ int lds_byte(int r, int c) { const int st = (r >> 4) * 2 + (c >> 5), rr = r & 15, cc = c & 31, ob = rr * 64 + cc * 2; return st * 1024 + (ob ^ (((ob >> 9) & 1) << 5)); }
__host__ __device__ __forceinline__ void stage_rc(int b, int& R, int& C) { const int st = b / 1024, sb = b % 1024, swz = sb ^ (((sb >> 9) & 1) << 5); R = (st >> 1) * 16 + swz / 64; C = (st & 1) * 32 + (swz % 64) / 2; }
__host__ __device__ __forceinline__ int perm32(int rho) { const int n = rho >> 4, i = rho & 15; return 8 * (i >> 2) + 4 * n + (i & 3); }

struct Unit { int pm, pn; };
struct Gemm { const bf16_t* A; const bf16_t* Bt; int M, N, K; };

struct StaticOrder {
    int nM, nN, nwg, G, c;
    __host__ __device__ void init(int M, int N, int G_, int c_) { nM = M / BM; nN = N / BM; nwg = nM * nN; G = G_; c = c_; }
    __host__ __device__ bool next(int i, Unit& u) const {
        const long L = (long)i * G + c; if (L >= nwg) return false;
        int wgid = (int)L; { const int q = nwg / NXCD, r = nwg % NXCD, xcd = wgid % NXCD, off = wgid / NXCD; wgid = (xcd < r ? xcd * (q + 1) : r * (q + 1) + (xcd - r) * q) + off; }
        const int nig = WGM * nN, gid = wgid / nig, fm = gid * WGM, gsz = (nM - fm) < WGM ? (nM - fm) : WGM;
        u.pm = fm + ((wgid % nig) % gsz); u.pn = (wgid % nig) / gsz; return true;
    }
    __device__ __forceinline__ void a_ready(const Unit&) const {}
    __device__ __forceinline__ void done(const Unit&) const {}
};
struct OneUnit : StaticOrder {
    int k;
    __device__ bool next(int i, Unit& u) const { if (i > 0) return false; return StaticOrder::next(k, u); }
};
__device__ __forceinline__ unsigned cvt_pk_bf16(float lo, float hi) { unsigned r; asm volatile("v_cvt_pk_bf16_f32 %0, %1, %2" : "=v"(r) : "v"(lo), "v"(hi)); return r; }
template <class Epi, class Sched, bool STAMP = false>
__device__ __forceinline__ void gemm_phase(PG8_LAS unsigned char* lds, const Gemm g, const Sched& S, const Epi& E, unsigned long long* stamps) {
    const int tid = TIDX, wid = __builtin_amdgcn_readfirstlane(tid >> 6), lane = tid & 63, wr = wid >> 2, wc = wid & 3, fr = lane & 15, fq = lane >> 4;
    const int K = g.K, nt = K / BK;
    int ts_lo = 0, ts_hi = 0, nts = 0; const unsigned long long rt_entry = STAMP ? (unsigned long long)wall_clock64() : 0ull;
#define PG8_STAMP() do { if (STAMP && wid == 0 && nts < 64) { const unsigned long long _c = (unsigned long long)clock64(); \
        ts_lo = (lane == nts) ? (int)(unsigned)_c : ts_lo; ts_hi = (lane == nts) ? (int)(unsigned)(_c >> 32) : ts_hi; ++nts; } } while (0)
    PG8_STAMP();
    unsigned voffA[2], voffB[2];
#pragma unroll
    for (int i = 0; i < 2; ++i) { int R, C; stage_rc(tid * 16 + i * 8192, R, C); const int Rb = Epi::PERM ? ((R & ~31) + perm32(R & 31)) : R;
        voffA[i] = (unsigned)(R * K + C) * 2u; voffB[i] = (unsigned)(Rb * K + C) * 2u; }
    const size_t kstep = (size_t)(BK * 2);
    const size_t hstep = (size_t)HALF * K * 2;
    const size_t tstep = 2 * hstep;
    const unsigned ldsw = (unsigned)wid * 1024u;
    const int aoff = lds_byte(wr * 64 + fr, fq * 8), boff = lds_byte(wc * 32 + fr, fq * 8);
#define PG8_SA(b, h) (((b) * 2 + (h)) * HTB)
#define PG8_SB(b, h) ((4 + (b) * 2 + (h)) * HTB)
#define PG8_STAGE(bufoff, gbase, voff) do { _Pragma("unroll") for (int _i = 0; _i < 2; ++_i) \
        __builtin_amdgcn_global_load_lds((const unsigned*)((const char*)(gbase) + (voff)[_i]), (PG8_LAS unsigned*)(lds + (bufoff) + ldsw + _i * 8192), 16, 0, 0); } while (0)
#define PG8_LDA(dst, b, h) do { _Pragma("unroll") for (int m = 0; m < 4; ++m) _Pragma("unroll") for (int k = 0; k < 2; ++k) dst[m][k] = *(const PG8_LAS bf16x8*)(lds + PG8_SA(b, h) + aoff + m * 2048 + k * 1024); } while (0)
#define PG8_LDB(dst, b, h) do { _Pragma("unroll") for (int n = 0; n < 2; ++n) _Pragma("unroll") for (int k = 0; k < 2; ++k) dst[n][k] = *(const PG8_LAS bf16x8*)(lds + PG8_SB(b, h) + boff + n * 2048 + k * 1024); } while (0)
#define PG8_MMA(ai, bj, At, Bt) do { __builtin_amdgcn_s_setprio(1); _Pragma("unroll") for (int m = 0; m < 4; ++m) _Pragma("unroll") for (int n = 0; n < 2; ++n) _Pragma("unroll") for (int k = 0; k < 2; ++k) \
        acc[ai][bj][m][n] = __builtin_amdgcn_mfma_f32_16x16x32_bf16(Bt[n][k], At[m][k], acc[ai][bj][m][n], 0, 0, 0); __builtin_amdgcn_s_setprio(0); } while (0)
#define PG8_WAIT_V(n) asm volatile("s_waitcnt vmcnt(" #n ")" ::: "memory")
#define PG8_WAIT_L(n) asm volatile("s_waitcnt lgkmcnt(" #n ")" ::: "memory")
#define PG8_BAR __builtin_amdgcn_s_barrier()
#define PG8_SCHED __builtin_amdgcn_sched_barrier(0)
    Unit cur, nxt; int ui = 0;
    if (!S.next(0, cur)) return;
    f32x4 acc[2][2][4][2];
#pragma unroll
    for (int a = 0; a < 2; ++a)
#pragma unroll
        for (int b = 0; b < 2; ++b)
#pragma unroll
            for (int m = 0; m < 4; ++m)
#pragma unroll
                for (int n = 0; n < 2; ++n) acc[a][b][m][n] = (f32x4){0.f, 0.f, 0.f, 0.f};
    bf16x8 At[4][2], B0[2][2], B1[2][2];
    const char* cA = (const char*)g.A + (size_t)cur.pm * tstep; const char* cB = (const char*)g.Bt + (size_t)cur.pn * tstep;
    S.a_ready(cur);
    PG8_STAGE(PG8_SB(0, 0), cB, voffB); PG8_STAGE(PG8_SA(0, 0), cA, voffA); PG8_STAGE(PG8_SB(0, 1), cB + hstep, voffB); PG8_STAGE(PG8_SA(0, 1), cA + hstep, voffA);
    if (wr == 1) PG8_BAR;
    PG8_WAIT_V(4); PG8_BAR;
    PG8_STAGE(PG8_SB(1, 0), cB + kstep, voffB); PG8_STAGE(PG8_SA(1, 0), cA + kstep, voffA); PG8_STAGE(PG8_SB(1, 1), cB + hstep + kstep, voffB);
    PG8_WAIT_V(6); PG8_BAR;
    PG8_STAMP();
    for (;;) {
        const bool has_next = S.next(ui + 1, nxt);
        const char* nA = has_next ? (const char*)g.A + (size_t)nxt.pm * tstep : cA; const char* nB = has_next ? (const char*)g.Bt + (size_t)nxt.pn * tstep : cB;
        for (int t = 0; t < nt; t += 2) {
            const bool last = (t == nt - 2);
            const char* a1 = cA + (size_t)(t + 1) * kstep;
            const char* a2 = last ? nA : cA + (size_t)(t + 2) * kstep; const char* b2 = last ? nB : cB + (size_t)(t + 2) * kstep;
            const char* a3 = a2 + kstep; const char* b3 = b2 + kstep;
            if (last && has_next) S.a_ready(nxt);
            PG8_LDB(B0, 0, 0); PG8_SCHED; PG8_LDA(At, 0, 0); PG8_STAGE(PG8_SA(1, 1), a1 + hstep, voffA);
            PG8_WAIT_L(8); PG8_BAR; PG8_WAIT_L(0); PG8_MMA(0, 0, At, B0); PG8_BAR; PG8_SCHED;
            PG8_LDB(B1, 0, 1); PG8_STAGE(PG8_SB(0, 0), b2, voffB);
            PG8_BAR; PG8_WAIT_L(0); PG8_MMA(0, 1, At, B1); PG8_BAR;
            PG8_LDA(At, 0, 1); PG8_STAGE(PG8_SA(0, 0), a2, voffA);
            PG8_BAR; PG8_WAIT_L(0); PG8_MMA(1, 0, At, B0); PG8_BAR; PG8_SCHED;
            PG8_STAGE(PG8_SB(0, 1), b2 + hstep, voffB);
            PG8_WAIT_V(6); PG8_BAR; PG8_MMA(1, 1, At, B1); PG8_BAR;
            PG8_LDB(B0, 1, 0); PG8_SCHED; PG8_LDA(At, 1, 0); PG8_STAGE(PG8_SA(0, 1), a2 + hstep, voffA);
            PG8_WAIT_L(8); PG8_BAR; PG8_WAIT_L(0); PG8_MMA(0, 0, At, B0); PG8_BAR; PG8_SCHED;
            PG8_LDB(B1, 1, 1); PG8_STAGE(PG8_SB(1, 0), b3, voffB);
            PG8_BAR; PG8_WAIT_L(0); PG8_MMA(0, 1, At, B1); PG8_BAR;
            PG8_LDA(At, 1, 1); PG8_STAGE(PG8_SA(1, 0), a3, voffA);
            PG8_BAR; PG8_WAIT_L(0); PG8_MMA(1, 0, At, B0); PG8_BAR; PG8_SCHED;
            PG8_STAGE(PG8_SB(1, 1), b3 + hstep, voffB);
            PG8_WAIT_V(6); PG8_BAR; PG8_MMA(1, 1, At, B1); PG8_BAR;
        }
        PG8_STAMP();
        if constexpr (!Epi::AFTER_DRAIN) { E(acc, cur, wr, wc, fr, fq); S.done(cur); }
        PG8_STAMP();
        if (!has_next) break;
#pragma unroll
        for (int a = 0; a < 2; ++a)
#pragma unroll
            for (int b = 0; b < 2; ++b)
#pragma unroll
                for (int m = 0; m < 4; ++m)
#pragma unroll
                    for (int n = 0; n < 2; ++n) acc[a][b][m][n] = (f32x4){0.f, 0.f, 0.f, 0.f};
        cur = nxt; cA = nA; cB = nB; ++ui;
    }
    PG8_WAIT_V(0);
    if (wr == 0) PG8_BAR;
    PG8_BAR;
    if constexpr (Epi::AFTER_DRAIN) { E.fused(acc, cur, wr, wc, fr, fq, lds, wid, lane); S.done(cur); }
    PG8_STAMP();
    if (STAMP && wid == 0) { stamps[lane] = lane < nts ? (((unsigned long long)(unsigned)ts_hi << 32) | (unsigned)ts_lo) : 0ull;
        if (lane == 62) stamps[62] = rt_entry; if (lane == 63) stamps[63] = (unsigned long long)wall_clock64(); }
#undef PG8_STAMP
#undef PG8_SA
#undef PG8_SB
#undef PG8_STAGE
#undef PG8_LDA
#undef PG8_LDB
#undef PG8_MMA
#undef PG8_WAIT_V
#undef PG8_WAIT_L
#undef PG8_BAR
#undef PG8_SCHED
}
}

#define XB_TMO      128
#define XB_XCNT(j)  (256  + 64 * (j))
#define XB_XSUB(j)  (1280 + 64 * (j))
#define XB_XGEN(j)  (2304 + 64 * (j))
#define XB_TOP      3328
#define XB_TOPGEN   3392
#define XCD_BAR_WORDS 3456
#define XB_SPIN_CAP (1u << 18)
#define LAS __attribute__((address_space(3)))

__device__ __forceinline__ unsigned xb_ld(unsigned* p)              { return __hip_atomic_load(p, __ATOMIC_RELAXED, __HIP_MEMORY_SCOPE_AGENT); }
__device__ __forceinline__ unsigned xb_add(unsigned* p, unsigned v) { return __hip_atomic_fetch_add(p, v, __ATOMIC_RELAXED, __HIP_MEMORY_SCOPE_AGENT); }
__device__ __forceinline__ unsigned xb_xcc_id() { return (unsigned)__builtin_amdgcn_s_getreg((3 << 11) | 20) & 0xFu; }
#define XB_SPIN(cond, bar) do { unsigned _sp = 0; while (cond) { __builtin_amdgcn_s_sleep(1); \
    if ((++_sp & 255u) == 0u) { if (xb_ld(&(bar)[XB_TMO])) break; if (_sp > XB_SPIN_CAP) { atomicAdd(&(bar)[XB_TMO], 1u); break; } } } } while (0)

struct XcdBarrier {
    unsigned* bar; unsigned x;
    volatile LAS unsigned* st;
};

__device__ __forceinline__ XcdBarrier xcd_barrier_post(unsigned* bar, volatile LAS unsigned* st) {
    XcdBarrier b; b.bar = bar; b.x = xb_xcc_id(); b.st = st;
    if (TIDX == 0) (void)xb_add(&bar[XB_XCNT(b.x)], 1u);
    return b;
}
__device__ __forceinline__ void xcd_barrier_complete(unsigned* bar, unsigned x, unsigned& nloc, unsigned& nx) {
    const unsigned G = gridDim.x * gridDim.y * gridDim.z;
    unsigned sum, cnt, mine, sp = 0u;
    for (;;) {
        sum = 0u; cnt = 0u; mine = 0u;
#pragma unroll
        for (unsigned j = 0; j < 16; ++j) { const unsigned c = xb_ld(&bar[XB_XCNT(j)]); sum += c; cnt += (c > 0u) ? 1u : 0u; mine = (j == x) ? c : mine; }
        if (sum == G) break;
        __builtin_amdgcn_s_sleep(1);
        if ((++sp & 255u) == 0u) { if (xb_ld(&bar[XB_TMO])) break; if (sp > XB_SPIN_CAP) { atomicAdd(&bar[XB_TMO], 1u); break; } }
    }
    nloc = mine > 0u ? mine : 1u; nx = cnt > 0u ? cnt : 1u;
}

__device__ __forceinline__ void xcd_barrier(const XcdBarrier& b) {
    asm volatile("s_waitcnt vmcnt(0)" ::: "memory");
    __syncthreads();
    if (TIDX == 0) {
        unsigned* bar = b.bar;
        __builtin_amdgcn_s_waitcnt(0);
        unsigned nloc = b.st[0], nx = b.st[1];
        if (nloc == 0u) { xcd_barrier_complete(bar, b.x, nloc, nx); b.st[0] = nloc; b.st[1] = nx; }
        const unsigned old = xb_add(&bar[XB_XSUB(b.x)], 1u);
        const unsigned gen = old / nloc;
        if (old + 1u == (gen + 1u) * nloc) {
            __builtin_amdgcn_fence(__ATOMIC_RELEASE, "agent");
            asm volatile("s_waitcnt vmcnt(0)" ::: "memory");
            const unsigned og = xb_add(&bar[XB_TOP], 1u);
            const unsigned tg = og / nx;
            if (og + 1u == (tg + 1u) * nx) xb_add(&bar[XB_TOPGEN], 1u);
            else XB_SPIN(xb_ld(&bar[XB_TOPGEN]) == tg, bar);
            __builtin_amdgcn_fence(__ATOMIC_ACQUIRE, "agent");
            xb_add(&bar[XB_XGEN(b.x)], 1u);
            asm volatile("s_waitcnt vmcnt(0)" ::: "memory");
        } else {
            XB_SPIN(xb_ld(&bar[XB_XGEN(b.x)]) == gen, bar);
            __builtin_amdgcn_fence(__ATOMIC_ACQUIRE, "agent");
            asm volatile("s_waitcnt vmcnt(0)" ::: "memory");
        }
    }
    __syncthreads();
}

__device__ void d_cvt(const float* __restrict__ in, bf16_t* __restrict__ out, size_t n4) {
  size_t i = (size_t)blockIdx.x * blockDim.x + TIDX;
  size_t stride = (size_t)gridDim.x * blockDim.x;
  for (; i < n4; i += stride) { float4 v = ((const float4*)in)[i]; ushort4 o; o.x = f2bf(v.x); o.y = f2bf(v.y); o.z = f2bf(v.z); o.w = f2bf(v.w); ((ushort4*)out)[i] = o; }
}
__device__ void d_cvtT(int vb, char* smem, const float* __restrict__ W, bf16_t* __restrict__ WT, int K, int N, int NP) {
  float (*t)[33] = (float (*)[33])smem;
  int nbx = NP / 32;
  int n0 = (vb % nbx) * 32, k0 = (vb / nbx) * 32;
  int tx = (TIDX & 255) & 31, ty = (TIDX & 255) >> 5;
  for (int i = ty; i < 32; i += 8) { int k = k0 + i, n = n0 + tx; t[i][tx] = (n < N && k < K) ? W[(size_t)k * N + n] : 0.f; }
  __syncthreads();
  for (int i = ty; i < 32; i += 8) { int n = n0 + i, k = k0 + tx; if (n < NP && k < K) WT[(size_t)n * K + k] = f2bf(t[tx][i]); }
  __syncthreads();
}

__device__ void d_cvtT64(int vb, char* smem, const float* __restrict__ W, bf16_t* __restrict__ WT, int K, int N, int NP) {
  float (*tt)[65] = (float (*)[65])smem;
  const int tid = (TIDX & 255);
  const int nbx = NP / 64;
  const int n0 = (vb % nbx) * 64, k0 = (vb / nbx) * 64;
  {
    const int kr = tid >> 4, nc = (tid & 15) * 4;
#pragma unroll
    for (int i = 0; i < 4; ++i) {
      const int k = k0 + kr + 16 * i, n = n0 + nc;
      f32x4 v = {0.f, 0.f, 0.f, 0.f};
      if (n < N) v = *(const f32x4*)(W + (size_t)k * N + n);
      tt[kr + 16 * i][nc] = v[0]; tt[kr + 16 * i][nc + 1] = v[1]; tt[kr + 16 * i][nc + 2] = v[2]; tt[kr + 16 * i][nc + 3] = v[3];
    }
  }
  __syncthreads();
  {
    const int nr = tid >> 3, kc = (tid & 7) * 8;
#pragma unroll
    for (int i = 0; i < 2; ++i) {
      const int nl = nr + 32 * i;
      u32x4 o = {pack2(tt[kc][nl], tt[kc + 1][nl]), pack2(tt[kc + 2][nl], tt[kc + 3][nl]), pack2(tt[kc + 4][nl], tt[kc + 5][nl]), pack2(tt[kc + 6][nl], tt[kc + 7][nl])};
      *(u32x4*)(WT + (size_t)(n0 + nl) * K + k0 + kc) = o;
    }
  }
  __syncthreads();
}

constexpr int LDS_LD = 72;
struct EpiProj { bf16_t* proj; float* gates; };
struct EpiF32 { float* C; int ldc; int N; };
struct EpiRes { float* C; const float* X; };


#define ELEMWISE_TILE                                                                              \
  DI void tile(f32x4 (&acc)[4][4], char*, int m0, int n0, int, int wm, int wn, int, int lane) const { \
    _Pragma("unroll") for (int i = 0; i < 4; ++i)                                                  \
    _Pragma("unroll") for (int j = 0; j < 4; ++j)                                                  \
    _Pragma("unroll") for (int r = 0; r < 4; ++r) {                                                \
      int row = m0 + wm * 64 + i * 16 + (lane >> 4) * 4 + r;                                       \
      int col = n0 + wn * 64 + j * 16 + (lane & 15);                                               \
      (*this)(row, col, acc[i][j][r]);                                                             \
    }                                                                                              \
  }
template <class Epi>
__device__ void d_gemm(int vb, char* smem, const bf16_t* __restrict__ A, int lda, const bf16_t* __restrict__ BT, int ldb, int K,
                       int tilesM, Epi epi) {
  bf16_t* As = (bf16_t*)smem;
  bf16_t* Bs = As + 256 * LDS_LD;
  const int tid = TIDX, lane = tid & 63, wid = tid >> 6;
  const int wm = wid >> 1, wn = wid & 1;
  const int tm = vb % tilesM, tn = vb / tilesM;
  const int m0 = tm * 256, n0 = tn * 128;
  f32x4 acc[4][4];
#pragma unroll
  for (int i = 0; i < 4; ++i)
#pragma unroll
    for (int j = 0; j < 4; ++j) acc[i][j] = f32x4{0.f, 0.f, 0.f, 0.f};
  u32x4 ra[4], rb[2];
#define GLOAD(k0_)                                                                  \
  _Pragma("unroll") for (int i = 0; i < 4; ++i) {                                   \
    int c = tid + i * 512; int row = c >> 3, kc = c & 7;                            \
    ra[i] = *(const u32x4*)(A + (size_t)(m0 + row) * lda + (k0_) + kc * 8);         \
  }                                                                                 \
  _Pragma("unroll") for (int i = 0; i < 2; ++i) {                                   \
    int c = tid + i * 512; int row = c >> 3, kc = c & 7;                            \
    rb[i] = *(const u32x4*)(BT + (size_t)(n0 + row) * ldb + (k0_) + kc * 8);        \
  }
  GLOAD(0)
  for (int k0 = 0; k0 < K; k0 += 64) {
    __syncthreads();
#pragma unroll
    for (int i = 0; i < 4; ++i) { int c = tid + i * 512; int row = c >> 3, kc = c & 7; *(u32x4*)(As + row * LDS_LD + kc * 8) = ra[i]; }
#pragma unroll
    for (int i = 0; i < 2; ++i) { int c = tid + i * 512; int row = c >> 3, kc = c & 7; *(u32x4*)(Bs + row * LDS_LD + kc * 8) = rb[i]; }
    __syncthreads();
    if (k0 + 64 < K) { GLOAD(k0 + 64) }
#pragma unroll
    for (int ks = 0; ks < 2; ++ks) {
      bf16x8 a[4], b[4];
#pragma unroll
      for (int i = 0; i < 4; ++i) {
        a[i] = *(const bf16x8*)(As + (wm * 64 + i * 16 + (lane & 15)) * LDS_LD + ks * 32 + (lane >> 4) * 8);
        b[i] = *(const bf16x8*)(Bs + (wn * 64 + i * 16 + (lane & 15)) * LDS_LD + ks * 32 + (lane >> 4) * 8);
      }
#pragma unroll
      for (int i = 0; i < 4; ++i)
#pragma unroll
        for (int j = 0; j < 4; ++j) acc[i][j] = __builtin_amdgcn_mfma_f32_16x16x32_bf16(a[i], b[j], acc[i][j], 0, 0, 0);
    }
  }
  epi.tile(acc, smem, m0, n0, tn, wm, wn, wid, lane);
  __syncthreads();
}
struct EpiProjF {
  bf16_t* proj; float* gates;
  DI void operator()(int row, int col, float v) const {
    if (col < INW) proj[(size_t)row * INWP + col] = f2bf(v);
    if (col >= OFF_G && col < OFF_G + 24) gates[row * 24 + (col - OFF_G)] = 1.f / (1.f + __expf(-v));
  }
  ELEMWISE_TILE
};
struct EpiF32F {
  float* C; int ldc; int N;
  DI void operator()(int row, int col, float v) const { if (col < N) C[(size_t)row * ldc + col] = v; }
  ELEMWISE_TILE
};
struct EpiResF {
  float* C; const float* X;
  DI void operator()(int row, int col, float v) const { C[(size_t)row * DM + col] = ALPHA * X[(size_t)row * DM + col] + v; }
  ELEMWISE_TILE
};

__device__ void d_build_cmp(int row, const bf16_t* __restrict__ proj, int off, const float* __restrict__ pos, bf16_t* __restrict__ Ac) {
  int n = row >> 1, g = row & 1;
  for (int k = (TIDX & 255); k < 4096; k += 256) {
    float v = 0.f;
    if (row < 2046) { int l = k >> 7, d = k & 127; v = bf2f(proj[(size_t)(16 * n + l) * INWP + off + g * 128 + d]) + pos[l * 128 + d]; }
    Ac[(size_t)row * 4096 + k] = f2bf(v);
  }
}
__device__ void d_cmp2(int row, char* smem, const float* __restrict__ hid, const float* __restrict__ b1, const float* __restrict__ w2, float* __restrict__ out) {
  float* a = (float*)smem;
  for (int j = (TIDX & 255); j < 512; j += 256) a[j] = gelu_tanh(hid[(size_t)row * 512 + j] + b1[j]);
  __syncthreads();
  int d = (TIDX & 255) & 127, half = (TIDX & 255) >> 7;
  float s = 0.f;
  for (int j = half * 256; j < half * 256 + 256; ++j) s += a[j] * w2[j * 128 + d];
  float* red = a + 512;
  if (half) red[d] = s;
  __syncthreads();
  if (!half) out[(size_t)row * 128 + d] = s + red[d];
  __syncthreads();
}

using f32x16 = __attribute__((ext_vector_type(16))) float;
using bf16x8v = __attribute__((ext_vector_type(8))) __bf16;
#define MFMA32(a, b, c) __builtin_amdgcn_mfma_f32_32x32x16_bf16((a), (b), (c), 0, 0, 0)
constexpr float LOG2E = 1.4426950408889634f;
constexpr float NEGB = -1e30f;
DI int pi_perm(int i) { return (i & ~12) | ((i & 8) >> 1) | ((i & 4) << 1); }
DI bf16x8 pack8(float a0, float a1, float a2, float a3, float a4, float a5, float a6, float a7) {
  bf16x8v v = {(__bf16)a0, (__bf16)a1, (__bf16)a2, (__bf16)a3, (__bf16)a4, (__bf16)a5, (__bf16)a6, (__bf16)a7};
  return __builtin_bit_cast(bf16x8, v);
}
__device__ void d_relayoutK_bf(size_t c, int NT, const bf16_t* __restrict__ src, int ld, int col0, bf16_t* __restrict__ dst) {
  int lane = c & 63, s = (c >> 6) & 7; size_t tt = c >> 9; int T = tt % NT, g = tt / NT;
  int i = lane & 31, h = lane >> 5;
  int tok = 32 * T + pi_perm(i);
  *(u32x4*)(dst + c * 8) = *(const u32x4*)(src + (size_t)tok * ld + col0 + g * 128 + 16 * s + 8 * h);
}
__device__ void d_relayoutV_bf(size_t c, int NT, const bf16_t* __restrict__ src, int ld, int col0, bf16_t* __restrict__ dst) {
  int lane = c & 63, s2 = (c >> 6) & 1, dt = (c >> 7) & 3; size_t tt = c >> 9; int T = tt % NT, g = tt / NT;
  int dd = lane & 31, h = lane >> 5;
  bf16_t v[8];
#pragma unroll
  for (int j = 0; j < 8; ++j) v[j] = src[(size_t)(32 * T + 16 * s2 + 8 * h + j) * ld + col0 + g * 128 + 32 * dt + dd];
  u32x4 o; o.x = v[0] | ((unsigned)v[1] << 16); o.y = v[2] | ((unsigned)v[3] << 16); o.z = v[4] | ((unsigned)v[5] << 16); o.w = v[6] | ((unsigned)v[7] << 16);
  *(u32x4*)(dst + c * 8) = o;
}
__device__ void d_relayoutK_f32(size_t c, const float* __restrict__ src, bf16_t* __restrict__ dst) {
  int lane = c & 63, s = (c >> 6) & 7; size_t tt = c >> 9; int T = tt % 32, g = tt / 32;
  int i = lane & 31, h = lane >> 5;
  int n = 32 * T + pi_perm(i);
  bf16_t v[8];
#pragma unroll
  for (int j = 0; j < 8; ++j) v[j] = (n < NCMP) ? f2bf(src[((size_t)n * 2 + g) * 128 + 16 * s + 8 * h + j]) : (bf16_t)0;
  u32x4 o; o.x = v[0] | ((unsigned)v[1] << 16); o.y = v[2] | ((unsigned)v[3] << 16); o.z = v[4] | ((unsigned)v[5] << 16); o.w = v[6] | ((unsigned)v[7] << 16);
  *(u32x4*)(dst + c * 8) = o;
}
__device__ void d_relayoutV_f32(size_t c, const float* __restrict__ src, bf16_t* __restrict__ dst) {
  int lane = c & 63, s2 = (c >> 6) & 1, dt = (c >> 7) & 3; size_t tt = c >> 9; int T = tt % 32, g = tt / 32;
  int dd = lane & 31, h = lane >> 5;
  bf16_t v[8];
#pragma unroll
  for (int j = 0; j < 8; ++j) { int n = 32 * T + 16 * s2 + 8 * h + j; v[j] = (n < NCMP) ? f2bf(src[((size_t)n * 2 + g) * 128 + 32 * dt + dd]) : (bf16_t)0; }
  u32x4 o; o.x = v[0] | ((unsigned)v[1] << 16); o.y = v[2] | ((unsigned)v[3] << 16); o.z = v[4] | ((unsigned)v[5] << 16); o.w = v[6] | ((unsigned)v[7] << 16);
  *(u32x4*)(dst + c * 8) = o;
}


__device__ __forceinline__ void d_relayout_tile(int T, char* smem, const bf16_t* __restrict__ proj, int col0, bf16_t* __restrict__ dst, bool isV) {
  bf16_t* Ls = (bf16_t*)smem;
  const int tid = TIDX;
#pragma unroll
  for (int q = 0; q < 2; ++q) {
    const int cidx = tid + q * 512;
    const int g = cidx >> 9, tok = (cidx >> 4) & 31, ch = cidx & 15;
    const u32x4 v = *(const u32x4*)(proj + (size_t)(32 * T + tok) * INWP + col0 + g * 128 + ch * 8);
    *(u32x4*)(Ls + (g * 32 + tok) * 136 + ch * 8) = v;
  }
  __syncthreads();
#pragma unroll
  for (int q = 0; q < 2; ++q) {
    const int oc = tid + q * 512;
    const int g = oc >> 9, r9 = oc & 511, lane = r9 & 63;
    u32x4 o;
    if (!isV) {
      const int s8 = r9 >> 6, i = lane & 31, h = lane >> 5;
      o = *(const u32x4*)(Ls + (g * 32 + pi_perm(i)) * 136 + 16 * s8 + 8 * h);
    } else {
      const int s2 = (r9 >> 6) & 1, dt = r9 >> 7, dd = lane & 31, h = lane >> 5;
      const bf16_t* col = Ls + (g * 32 + 16 * s2 + 8 * h) * 136 + 32 * dt + dd;
      unsigned short e[8];
#pragma unroll
      for (int j = 0; j < 8; ++j) e[j] = col[j * 136];
      o.x = e[0] | ((unsigned)e[1] << 16); o.y = e[2] | ((unsigned)e[3] << 16); o.z = e[4] | ((unsigned)e[5] << 16); o.w = e[6] | ((unsigned)e[7] << 16);
    }
    *(u32x4*)(dst + (((size_t)(g * 512 + T)) * 512 + r9) * 8) = o;
  }
  __syncthreads();
}

struct AttnPtrs {
  const bf16_t* proj; const float* gates;
  const bf16_t *kcf, *vcf, *ksf, *vsf, *kwf, *vwf;
  bf16_t* mix; const float* hng;
};

DI float ex2(float x) { return __builtin_amdgcn_exp2f(x); }
DI void halves(float x, float& lo, float& hi) {
  const unsigned u = __float_as_uint(x);
  auto r = __builtin_amdgcn_permlane32_swap(u, u, false, false);
  lo = __uint_as_float(r[0]); hi = __uint_as_float(r[1]);
}
DI float hmax(float x) { float a, b; halves(x, a, b); return fmaxf(a, b); }
DI float hsum(float x) { float a, b; halves(x, a, b); return a + b; }
DI float dpp_quad(float v, int ctrl_is_xor1) {
  const int iv = __float_as_int(v);
  const int r = ctrl_is_xor1 ? __builtin_amdgcn_update_dpp(iv, iv, 0xB1, 0xF, 0xF, false) : __builtin_amdgcn_update_dpp(iv, iv, 0x4E, 0xF, 0xF, false);
  return __int_as_float(r);
}
DI float quad_sum(float v) { v += dpp_quad(v, 1); v += dpp_quad(v, 0); return v; }
DI void load_k(bf16x8 (&kf)[8], const bf16_t* __restrict__ kt, int lane) {
#pragma unroll
  for (int s = 0; s < 8; ++s) kf[s] = *(const bf16x8*)(kt + s * 512 + lane * 8);
}
DI f32x16 qk_frags(const bf16x8 (&kf)[8], const bf16_t* qL, int lane) {
  f32x16 acc;
#pragma unroll
  for (int i = 0; i < 16; ++i) acc[i] = 0.f;
  const bf16_t* qp = qL + (lane & 31) * 136 + 8 * (lane >> 5);
#pragma unroll
  for (int s = 0; s < 8; ++s) {
    bf16x8 qf = *(const bf16x8*)(qp + 16 * s);
    acc = MFMA32(kf[s], qf, acc);
  }
  return acc;
}
DI void pv_frags(const bf16x8 (&vf)[8], const float (&p)[16], f32x16 (&O)[4]) {
  bf16x8 pf0 = pack8(p[0], p[1], p[2], p[3], p[4], p[5], p[6], p[7]);
  bf16x8 pf1 = pack8(p[8], p[9], p[10], p[11], p[12], p[13], p[14], p[15]);
#pragma unroll
  for (int dt = 0; dt < 4; ++dt) {
    O[dt] = MFMA32(vf[dt * 2], pf0, O[dt]);
    O[dt] = MFMA32(vf[dt * 2 + 1], pf1, O[dt]);
  }
}
DI void osm_step(const float (&sv)[16], float& m, float& l, f32x16 (&O)[4], float (&p)[16]) {
  float tmax = fmaxf(fmaxf(fmaxf(sv[0], sv[1]), fmaxf(sv[2], sv[3])), fmaxf(fmaxf(sv[4], sv[5]), fmaxf(sv[6], sv[7])));
  tmax = fmaxf(tmax, fmaxf(fmaxf(fmaxf(sv[8], sv[9]), fmaxf(sv[10], sv[11])), fmaxf(fmaxf(sv[12], sv[13]), fmaxf(sv[14], sv[15]))));
  tmax = hmax(tmax);
  if (__ballot(tmax - m > 8.f)) {
    const float mn = fmaxf(m, tmax);
    const float alpha = ex2(m - mn);
    l *= alpha; m = mn;
#pragma unroll
    for (int dt = 0; dt < 4; ++dt)
#pragma unroll
      for (int r = 0; r < 16; ++r) O[dt][r] *= alpha;
  }
  float ps0 = 0.f, ps1 = 0.f;
#pragma unroll
  for (int r = 0; r < 16; r += 2) { const float e0 = ex2(sv[r] - m), e1 = ex2(sv[r + 1] - m); p[r] = e0; p[r + 1] = e1; ps0 += e0; ps1 += e1; }
  l += ps0 + ps1;
}
DI void ot_store(char* otL, int lane, const f32x16 (&O)[4], float sc) {
#pragma unroll
  for (int dt = 0; dt < 4; ++dt) {
    u32x4 a, b;
#pragma unroll
    for (int i = 0; i < 4; ++i) { a[i] = pack2(sc * O[dt][2 * i], sc * O[dt][2 * i + 1]); b[i] = pack2(sc * O[dt][8 + 2 * i], sc * O[dt][8 + 2 * i + 1]); }
    *(u32x4*)(otL + lane * 128 + dt * 32) = a;
    *(u32x4*)(otL + lane * 128 + dt * 32 + 16) = b;
  }
}
DI void ot_accum(const char* otL, int lane, f32x16 (&O)[4], float sc) {
#pragma unroll
  for (int dt = 0; dt < 4; ++dt) {
    u32x4 a = *(const u32x4*)(otL + lane * 128 + dt * 32);
    u32x4 b = *(const u32x4*)(otL + lane * 128 + dt * 32 + 16);
#pragma unroll
    for (int i = 0; i < 4; ++i) {
      const unsigned wa = a[i], wb = b[i];
      O[dt][2 * i] = fmaf(sc, O[dt][2 * i], __uint_as_float(wa << 16));
      O[dt][2 * i + 1] = fmaf(sc, O[dt][2 * i + 1], __uint_as_float(wa & 0xFFFF0000u));
      O[dt][8 + 2 * i] = fmaf(sc, O[dt][8 + 2 * i], __uint_as_float(wb << 16));
      O[dt][8 + 2 * i + 1] = fmaf(sc, O[dt][8 + 2 * i + 1], __uint_as_float(wb & 0xFFFF0000u));
    }
  }
}
DI void zero_o(f32x16 (&O)[4]) {
#pragma unroll
  for (int dt = 0; dt < 4; ++dt)
#pragma unroll
    for (int i = 0; i < 16; ++i) O[dt][i] = 0.f;
}

constexpr int ATT_PW = 8704;
constexpr int ATT_R = 4, ATT_D = 3;
constexpr int ATT_RING = 8 * ATT_PW;
constexpr int ATT_LIST = ATT_RING + ATT_R * 16384;
constexpr int ATT_BUNI = ATT_LIST + 2048;
constexpr int ATT_SMEM = ATT_BUNI + 64;
#define LAS3 __attribute__((address_space(3)))
__device__ __forceinline__ void d_select(const float* impL, unsigned* mskL, unsigned* uniL, int cur) {
  const int lane = TIDX & 63;
  const int stok = lane >> 3, sub = lane & 7;
  unsigned key[32];
#pragma unroll
  for (int i4 = 0; i4 < 8; ++i4) {
    f32x4 v = *(const f32x4*)(impL + stok * 256 + sub * 32 + i4 * 4);
#pragma unroll
    for (int e = 0; e < 4; ++e) {
      const int j = sub * 32 + i4 * 4 + e;
      const bool valid = j <= cur;
      const bool forced = (j == 0) || (j == cur) || (j == cur - 1);
      unsigned kb = forced ? 0xFFFFFF00u : (__float_as_uint(v[e]) & 0xFFFFFF00u);
      key[i4 * 4 + e] = valid ? (kb | (unsigned)(255 - j)) : 0u;
    }
  }
#pragma unroll
  for (int k = 2; k <= 32; k <<= 1) {
#pragma unroll
    for (int jj = k >> 1; jj > 0; jj >>= 1) {
#pragma unroll
      for (int i = 0; i < 32; ++i) {
        const int l2 = i ^ jj;
        if (l2 > i) {
          const bool desc = ((i & k) == 0);
          unsigned a = key[i], b = key[l2];
          unsigned mx = a > b ? a : b, mn = a > b ? b : a;
          key[i] = desc ? mx : mn; key[l2] = desc ? mn : mx;
        }
      }
    }
  }
#pragma unroll
  for (int xm = 1; xm < 8; xm <<= 1) {
    unsigned L[16];
#pragma unroll
    for (int i = 0; i < 16; ++i) { unsigned o = (unsigned)__shfl_xor((int)key[15 - i], xm); L[i] = key[i] > o ? key[i] : o; }
#pragma unroll
    for (int jj = 8; jj > 0; jj >>= 1) {
#pragma unroll
      for (int i = 0; i < 16; ++i) {
        const int l2 = i ^ jj;
        if (l2 > i) { unsigned a = L[i], b = L[l2]; L[i] = a > b ? a : b; L[l2] = a > b ? b : a; }
      }
    }
#pragma unroll
    for (int i = 0; i < 16; ++i) key[i] = L[i];
  }
#pragma unroll
  for (int i = 0; i < 16; ++i) {
    if ((i & 7) == sub) {
      const int j = 255 - (int)(key[i] & 255u);
      if (j <= cur) { atomicOr(&mskL[stok * 8 + (j >> 5)], 1u << (j & 31)); atomicOr(&uniL[j >> 5], 1u << (j & 31)); }
    }
  }
}


DI void att_issue(LAS3 unsigned char* ring, int slot, int w, int lane, const bf16_t* kb, const bf16_t* vb, int tile) {
  const char* ks = (const char*)kb + (size_t)tile * 8192 + w * 1024 + lane * 16;
  const char* vs = (const char*)vb + (size_t)tile * 8192 + w * 1024 + lane * 16;
  __builtin_amdgcn_global_load_lds((const unsigned*)ks, (LAS3 unsigned*)(ring + slot * 16384 + w * 1024), 16, 0, 0);
  __builtin_amdgcn_global_load_lds((const unsigned*)vs, (LAS3 unsigned*)(ring + slot * 16384 + 8192 + w * 1024), 16, 0, 0);
}
DI void att_wait(int newer_tiles) {
  if (newer_tiles >= 2) asm volatile("s_waitcnt vmcnt(4)" ::: "memory");
  else if (newer_tiles == 1) asm volatile("s_waitcnt vmcnt(2)" ::: "memory");
  else asm volatile("s_waitcnt vmcnt(0)" ::: "memory");
}
DI f32x16 qk_lds(LAS3 const unsigned char* kt, const bf16x8 (&qf)[8], int lane) {
  f32x16 acc;
#pragma unroll
  for (int i = 0; i < 16; ++i) acc[i] = 0.f;
#pragma unroll
  for (int s8 = 0; s8 < 8; ++s8) {
    const bf16x8 kf = *(LAS3 const bf16x8*)(kt + s8 * 1024 + lane * 16);
    acc = MFMA32(kf, qf[s8], acc);
  }
  return acc;
}
DI void pv_lds(LAS3 const unsigned char* vt, const float (&p)[16], f32x16 (&O)[4], int lane) {
  const bf16x8 pf0 = pack8(p[0], p[1], p[2], p[3], p[4], p[5], p[6], p[7]);
  const bf16x8 pf1 = pack8(p[8], p[9], p[10], p[11], p[12], p[13], p[14], p[15]);
#pragma unroll
  for (int dt = 0; dt < 4; ++dt) {
    const bf16x8 v0 = *(LAS3 const bf16x8*)(vt + (dt * 2) * 1024 + lane * 16);
    const bf16x8 v1 = *(LAS3 const bf16x8*)(vt + (dt * 2 + 1) * 1024 + lane * 16);
    O[dt] = MFMA32(v0, pf0, O[dt]);
    O[dt] = MFMA32(v1, pf1, O[dt]);
  }
}

__device__ __forceinline__ void d_attn_block(int B, int g, char* smem, const AttnPtrs& P) {
  const int tid = TIDX, lane = tid & 63, w = tid >> 6;
  const int c = lane & 31, h = lane >> 5, tokl = c >> 2, r = c & 3;
  const int tok0 = 64 * B + 8 * w;
  const int t = tok0 + tokl, hd = g * 4 + r;
  const float slope2 = exp2f(-(float)(hd + 1)) * LOG2E;
  const float c1 = QSCALE * LOG2E;
  const float ninf = -__builtin_inff();
  char* wsm = smem + w * ATT_PW;
  float* impL = (float*)wsm;
  char* otL = wsm;
  unsigned* mskL = (unsigned*)(wsm + 8192);
  unsigned* uniL = mskL + 64;
  LAS3 unsigned char* ring = (LAS3 unsigned char*)(smem + ATT_RING);
  unsigned short* tl = (unsigned short*)(smem + ATT_LIST);
  unsigned* buni = (unsigned*)(smem + ATT_BUNI);
  const bf16_t* kcf = P.kcf + (size_t)g * 32 * 4096;
  const bf16_t* vcf = P.vcf + (size_t)g * 32 * 4096;
  const bf16_t* ksf = P.ksf + (size_t)g * 512 * 4096;
  const bf16_t* vsf = P.vsf + (size_t)g * 512 * 4096;
  const bf16_t* kwf = P.kwf + (size_t)g * 512 * 4096;
  const bf16_t* vwf = P.vwf + (size_t)g * 512 * 4096;
  bf16x8 qf[8];
  {
    const bf16_t* qrow = P.proj + (size_t)t * INWP + OFF_Q + hd * 128 + 8 * h;
#pragma unroll
    for (int s8 = 0; s8 < 8; ++s8) qf[s8] = *(const bf16x8*)(qrow + 16 * s8);
  }
  const float* gt = P.gates + (size_t)t * 24 + hd * 3;
  const float g0 = gt[0], g1 = gt[1], g2 = gt[2];
  {
    unsigned z0 = 0u;
    asm volatile("" : "+v"(z0));
    u32x4 z = {z0, z0, z0, z0};
#pragma unroll
    for (int i = 0; i < 8; ++i) *(u32x4*)(wsm + (i * 64 + lane) * 16) = z;
    if (lane < 18) *(u32x4*)(wsm + 8192 + lane * 16) = z;
    if (tid < 8) buni[tid] = z0;
  }
  f32x16 Ob[4];
  zero_o(Ob);
  const int nmax = (t >= 31) ? ((t - 31) >> 4) : -1;
  const int nmaxw = (tok0 + 7 >= 31) ? ((tok0 + 7 - 31) >> 4) : -1;
  const int nminw = (tok0 >= 31) ? ((tok0 - 31) >> 4) : -1;
  const int ntcw = (nmaxw + 32) >> 5;
  const int ntcB = (((64 * B + 63 - 31) >> 4) + 32) >> 5;
  const float sl16 = slope2 * 16.f;
  float mC = NEGB, lC = 0.f, invC = 0.f, carry = 0.f;
  {
    const int n = 2 * ntcB;
    asm volatile("s_waitcnt vmcnt(0)" ::: "memory");
#define A_TILE(i_) (((i_) < ntcB) ? (ntcB - 1 - (i_)) : ((i_) - ntcB))
#pragma unroll 1
    for (int j = 0; j < ATT_D && j < n; ++j) att_issue(ring, j, w, lane, kcf, vcf, A_TILE(j));
#pragma unroll 1
    for (int i = 0; i < n; ++i) {
      const int newer = (n - 1 - i < ATT_D - 1) ? (n - 1 - i) : (ATT_D - 1);
      att_wait(newer);
      __builtin_amdgcn_s_barrier();
      asm volatile("" ::: "memory");
      if (i + ATT_D < n) att_issue(ring, (i + ATT_D) % ATT_R, w, lane, kcf, vcf, A_TILE(i + ATT_D));
      const int T = A_TILE(i);
      if (T >= ntcw) continue;
      LAS3 const unsigned char* slot = ring + (i % ATT_R) * 16384;
      const f32x16 acc = qk_lds(slot, qf, lane);
      const float base = slope2 * (float)(512 * T + 128 * h) + slope2 * (15.5f - (float)t);
      const int nb = 32 * T + 8 * h;
      const bool full = (32 * T + 31 <= nminw);
      float sv[16];
#pragma unroll
      for (int rg = 0; rg < 16; ++rg) { const int kk = (rg & 7) + 16 * (rg >> 3); sv[rg] = fmaf(acc[rg], c1, fmaf(sl16, (float)kk, base)); }
      if (!full) {
#pragma unroll
        for (int rg = 0; rg < 16; ++rg) { const int kk = (rg & 7) + 16 * (rg >> 3); sv[rg] = (nb + kk <= nmax) ? sv[rg] : ninf; }
      }
      if (i < ntcB) {
        float tmax = fmaxf(fmaxf(fmaxf(sv[0], sv[1]), fmaxf(sv[2], sv[3])), fmaxf(fmaxf(sv[4], sv[5]), fmaxf(sv[6], sv[7])));
        tmax = fmaxf(tmax, fmaxf(fmaxf(fmaxf(sv[8], sv[9]), fmaxf(sv[10], sv[11])), fmaxf(fmaxf(sv[12], sv[13]), fmaxf(sv[14], sv[15]))));
        tmax = hmax(tmax);
        const float mn = fmaxf(mC, tmax);
        float ps = 0.f;
#pragma unroll
        for (int rg = 0; rg < 16; ++rg) ps += ex2(sv[rg] - mn);
        lC = lC * ex2(mC - mn) + ps; mC = mn;
      } else {
        if (T == 0) { lC = hsum(lC); invC = (lC > 0.f) ? 1.f / lC : 0.f; }
        float p[16];
#pragma unroll
        for (int rg = 0; rg < 16; ++rg) p[rg] = ex2(sv[rg] - mC) * invC;
        float Ga = (p[0] + p[1]) + (p[2] + p[3]), Gb = (p[4] + p[5]) + (p[6] + p[7]);
        float Gc = (p[8] + p[9]) + (p[10] + p[11]), Gd = (p[12] + p[13]) + (p[14] + p[15]);
        float xb, xd; { float a_, b_; halves(p[7], a_, b_); xb = h ? a_ : b_; halves(p[15], a_, b_); xd = h ? a_ : b_; }
        float ia = Ga + (h ? xb : carry);
        float ib = Gb + p[3];
        float ic = Gc + (h ? xd : xb);
        float id = Gd + p[11];
        carry = xd;
        ia = quad_sum(ia); ib = quad_sum(ib); ic = quad_sum(ic); id = quad_sum(id);
        {
          float val = (r == 0) ? ia : (r == 1) ? ib : (r == 2) ? ic : id;
          int j = 8 * T + 2 * h + ((r == 0) ? 0 : (r == 1) ? 1 : (r == 2) ? 4 : 5);
          impL[tokl * 256 + j] = val;
        }
        pv_lds(slot + 8192, p, Ob, lane);
      }
    }
#undef A_TILE
  }
  const int cur = B;
  d_select(impL, mskL, uniL, cur);
  ot_store(otL, lane, Ob, g0);
  zero_o(Ob);
  if (lane < 8) { const unsigned u = uniL[lane]; if (u) atomicOr(&buni[lane], u); }
  __syncthreads();
  int nslc = 0, ntl = 0;
  {
    for (int iw = 7; iw >= 0; --iw) {
      unsigned iuw = __builtin_amdgcn_readfirstlane(buni[iw]);
      while (iuw) {
        const int bit = 31 - __builtin_clz(iuw);
        iuw &= ~(1u << bit);
        const int bb = 32 * iw + bit;
        if (bb < B) { if (lane == 0) tl[ntl] = (unsigned short)(2 * bb + 1); ++ntl; }
        else { if (lane == 0) tl[ntl] = (unsigned short)(2 * bb + 1); ++ntl; }
        if (lane == 0) tl[ntl] = (unsigned short)(2 * bb);
        ++ntl;
      }
    }
    nslc = ntl;
    const int ThiB = 2 * B + 1, TloB = ((64 * B - 511 > 0) ? (64 * B - 511) : 0) >> 5;
    for (int T = ThiB; T >= TloB; --T) { if (lane == 0) tl[ntl] = (unsigned short)T; ++ntl; }
  }
  float m = NEGB, l = 0.f;
  {
    const int n = ntl;
    const int Tlow = ((tok0 - 511 > 0) ? (tok0 - 511) : 0) >> 5, Thiw = (tok0 + 7) >> 5;
#define B_ISSUE(j_, slot_) { const int e_ = __builtin_amdgcn_readfirstlane((int)tl[j_]); if ((j_) < nslc) att_issue(ring, slot_, w, lane, ksf, vsf, e_); else att_issue(ring, slot_, w, lane, kwf, vwf, e_); }
#pragma unroll 1
    for (int j = 0; j < ATT_D && j < n; ++j) B_ISSUE(j, j)
#pragma unroll 1
    for (int i = 0; i < n; ++i) {
      const int newer = (n - 1 - i < ATT_D - 1) ? (n - 1 - i) : (ATT_D - 1);
      att_wait(newer);
      __builtin_amdgcn_s_barrier();
      asm volatile("" ::: "memory");
      if (i + ATT_D < n) B_ISSUE(i + ATT_D, (i + ATT_D) % ATT_R)
      if (i == nslc) {
        l = hsum(l);
        const float inv = (l > 0.f) ? g1 / l : 0.f;
        ot_accum(otL, lane, Ob, inv);
        ot_store(otL, lane, Ob, 1.f);
        zero_o(Ob);
        m = NEGB; l = 0.f;
      }
      const int T = __builtin_amdgcn_readfirstlane((int)tl[i]);
      const int pos0 = 32 * T, pb = pos0 + 8 * h;
      bool full; bool mine = true;
      if (i < nslc) {
        const int bb = T >> 1;
        const unsigned uw = __builtin_amdgcn_readfirstlane(uniL[bb >> 5]);
        if (!((uw >> (bb & 31)) & 1u) || pos0 > tok0 + 7) continue;
        mine = (mskL[tokl * 8 + (bb >> 5)] >> (bb & 31)) & 1u;
        full = (pos0 + 31 <= tok0) && (__ballot(!mine) == 0ull);
      } else {
        if (T < Tlow || T > Thiw) continue;
        full = (pos0 + 31 <= tok0) && (pos0 >= tok0 + 7 - 511);
      }
      LAS3 const unsigned char* slot = ring + (i % ATT_R) * 16384;
      const f32x16 acc = qk_lds(slot, qf, lane);
      const float base = slope2 * (float)(pos0 + 8 * h - t);
      float sv[16], p[16];
#pragma unroll
      for (int rg = 0; rg < 16; ++rg) { const int kk = (rg & 7) + 16 * (rg >> 3); sv[rg] = fmaf(acc[rg], c1, fmaf(slope2, (float)kk, base)); }
      if (!full) {
        if (i < nslc) {
#pragma unroll
          for (int rg = 0; rg < 16; ++rg) { const int kk = (rg & 7) + 16 * (rg >> 3); sv[rg] = (mine && (pb + kk <= t)) ? sv[rg] : ninf; }
        } else {
#pragma unroll
          for (int rg = 0; rg < 16; ++rg) { const int kk = (rg & 7) + 16 * (rg >> 3); const int dw = t - (pb + kk); sv[rg] = ((dw >= 0) && (dw < 512)) ? sv[rg] : ninf; }
        }
      }
      osm_step(sv, m, l, Ob, p);
      pv_lds(slot + 8192, p, Ob, lane);
    }
#undef B_ISSUE
    l = hsum(l);
    const float inv = (l > 0.f) ? g2 / l : 0.f;
    ot_accum(otL, lane, Ob, inv);
  }
  {
    float ss = 0.f;
#pragma unroll
    for (int dt = 0; dt < 4; ++dt)
#pragma unroll
      for (int i = 0; i < 16; ++i) ss = fmaf(Ob[dt][i], Ob[dt][i], ss);
    ss = hsum(ss);
    const float rs = rsqrtf(ss * (1.f / 128.f) + 1e-6f);
    bf16_t* orow = P.mix + (size_t)t * DM + hd * 128 + 4 * h;
    const float* grow = P.hng + hd * 128 + 4 * h;
#pragma unroll
    for (int dt = 0; dt < 4; ++dt)
#pragma unroll
      for (int a = 0; a < 4; ++a) {
        const f32x4 gv = *(const f32x4*)(grow + 32 * dt + 8 * a);
        u32x2 wv2 = {pack2(Ob[dt][4 * a] * rs * gv[0], Ob[dt][4 * a + 1] * rs * gv[1]), pack2(Ob[dt][4 * a + 2] * rs * gv[2], Ob[dt][4 * a + 3] * rs * gv[3])};
        *(u32x2*)(orow + 32 * dt + 8 * a) = wv2;
      }
  }
  asm volatile("s_waitcnt vmcnt(0)" ::: "memory");
  __syncthreads();
}

__device__ void d_convmix(int t, int tl, const bf16_t* __restrict__ proj, const float* __restrict__ convw, const float* __restrict__ hng,
                          bf16_t* __restrict__ mix) {
  const int c = tl * 8;
  float acc[8];
#pragma unroll
  for (int i = 0; i < 8; ++i) acc[i] = 0.f;
#pragma unroll
  for (int j = 0; j < 3; ++j) {
    const int tt = t - 2 + j;
    if (tt >= 0) {
      const u32x4 cu = *(const u32x4*)(proj + (size_t)tt * INWP + OFF_C + c);
      const u32x4 uu = *(const u32x4*)(proj + (size_t)tt * INWP + OFF_U + c);
      const f32x4 w0 = *(const f32x4*)(convw + j * 1024 + c), w1 = *(const f32x4*)(convw + j * 1024 + c + 4);
#pragma unroll
      for (int i = 0; i < 4; ++i) {
        const unsigned a = cu[i], b = uu[i];
        const float wl = (i < 2) ? w0[2 * i] : w1[2 * i - 4], wh = (i < 2) ? w0[2 * i + 1] : w1[2 * i - 3];
        acc[2 * i] = fmaf(wl * __uint_as_float(a << 16), __uint_as_float(b << 16), acc[2 * i]);
        acc[2 * i + 1] = fmaf(wh * __uint_as_float(a & 0xFFFF0000u), __uint_as_float(b & 0xFFFF0000u), acc[2 * i + 1]);
      }
    }
  }
  const u32x4 bb = *(const u32x4*)(proj + (size_t)t * INWP + OFF_B + c);
  float ss = 0.f;
#pragma unroll
  for (int i = 0; i < 4; ++i) {
    const unsigned b = bb[i];
    acc[2 * i] *= __uint_as_float(b << 16); acc[2 * i + 1] *= __uint_as_float(b & 0xFFFF0000u);
    ss = fmaf(acc[2 * i], acc[2 * i], ss); ss = fmaf(acc[2 * i + 1], acc[2 * i + 1], ss);
  }
  ss += __shfl_xor(ss, 8); ss += __shfl_xor(ss, 4); ss += __shfl_xor(ss, 2); ss += __shfl_xor(ss, 1);
  const float rs = rsqrtf(ss * (1.f / 128.f) + 1e-6f);
  const f32x4 g0 = *(const f32x4*)(hng + 1024 + c), g1 = *(const f32x4*)(hng + 1024 + c + 4);
  u32x4 o = {pack2(acc[0] * rs * g0[0], acc[1] * rs * g0[1]), pack2(acc[2] * rs * g0[2], acc[3] * rs * g0[3]),
             pack2(acc[4] * rs * g1[0], acc[5] * rs * g1[1]), pack2(acc[6] * rs * g1[2], acc[7] * rs * g1[3])};
  *(u32x4*)(mix + (size_t)t * DM + 1024 + c) = o;
}

__device__ void d_ln(int t, char* smem, const float* __restrict__ y, const float* __restrict__ gam, const float* __restrict__ bet,
                     float* __restrict__ stats, bf16_t* __restrict__ hb) {
  float* red = (float*)smem;
  const int tid = (TIDX & 255);
  const f32x4 a = *(const f32x4*)(y + (size_t)t * DM + tid * 8), b = *(const f32x4*)(y + (size_t)t * DM + tid * 8 + 4);
  float s = (a[0] + a[1]) + (a[2] + a[3]) + (b[0] + b[1]) + (b[2] + b[3]);
  s = wave_sum(s); if ((tid & 63) == 0) red[tid >> 6] = s; __syncthreads();
  const float mu = (red[0] + red[1] + red[2] + red[3]) * (1.f / DM);
  float q = 0.f;
#pragma unroll
  for (int i = 0; i < 4; ++i) { const float d0 = a[i] - mu, d1 = b[i] - mu; q = fmaf(d0, d0, q); q = fmaf(d1, d1, q); }
  q = wave_sum(q); if ((tid & 63) == 0) red[4 + (tid >> 6)] = q; __syncthreads();
  const float var = (red[4] + red[5] + red[6] + red[7]) * (1.f / DM);
  const float rs = rsqrtf(var + 1e-5f);
  const f32x4 g0 = *(const f32x4*)(gam + tid * 8), g1 = *(const f32x4*)(gam + tid * 8 + 4);
  const f32x4 b0 = *(const f32x4*)(bet + tid * 8), b1 = *(const f32x4*)(bet + tid * 8 + 4);
  u32x4 o = {pack2((a[0] - mu) * rs * g0[0] + b0[0], (a[1] - mu) * rs * g0[1] + b0[1]), pack2((a[2] - mu) * rs * g0[2] + b0[2], (a[3] - mu) * rs * g0[3] + b0[3]),
             pack2((b[0] - mu) * rs * g1[0] + b1[0], (b[1] - mu) * rs * g1[1] + b1[1]), pack2((b[2] - mu) * rs * g1[2] + b1[2], (b[3] - mu) * rs * g1[3] + b1[3])};
  *(u32x4*)(hb + (size_t)t * DM + tid * 8) = o;
  if (tid == 0) { stats[2 * t] = mu; stats[2 * t + 1] = rs; }
  __syncthreads();
}

__device__ void d_cvt_w1f(size_t c, const float* __restrict__ w1, bf16_t* __restrict__ w1f) {
  const int lane = c & 63, ks = (c >> 6) & 255, ct = c >> 14;
  const int col = lane & 31, h = lane >> 5;
  bf16_t v[8];
#pragma unroll
  for (int j = 0; j < 8; ++j) v[j] = f2bf(w1[(size_t)(16 * ks + 8 * h + j) * 512 + 32 * ct + col]);
  u32x4 o; o.x = v[0] | ((unsigned)v[1] << 16); o.y = v[2] | ((unsigned)v[3] << 16); o.z = v[4] | ((unsigned)v[5] << 16); o.w = v[6] | ((unsigned)v[7] << 16);
  *(u32x4*)(w1f + c * 8) = o;
}
__device__ void d_cvt_w2f(size_t c, const float* __restrict__ w2, bf16_t* __restrict__ w2f) {
  const int lane = c & 63, s = (c >> 6) & 31, ct = c >> 11;
  const int col = lane & 31, h = lane >> 5;
  bf16_t v[8];
#pragma unroll
  for (int j = 0; j < 8; ++j) v[j] = f2bf(w2[(size_t)(16 * s + 8 * h + j) * 128 + 32 * ct + col]);
  u32x4 o; o.x = v[0] | ((unsigned)v[1] << 16); o.y = v[2] | ((unsigned)v[3] << 16); o.z = v[4] | ((unsigned)v[5] << 16); o.w = v[6] | ((unsigned)v[7] << 16);
  *(u32x4*)(w2f + c * 8) = o;
}
__device__ __forceinline__ void d_compress_unit(int rt, char* smem, const bf16_t* __restrict__ proj, int col0, const float* __restrict__ pos,
                                const bf16_t* __restrict__ w1f, const float* __restrict__ b1, const bf16_t* __restrict__ w2f,
                                bf16_t* __restrict__ outf, bool isV) {
  bf16_t* Xs = (bf16_t*)smem;
  bf16_t* Hs = (bf16_t*)(smem + 2 * 8704);
  const int tid = TIDX, lane = tid & 63, w = tid >> 6, c = lane & 31, h = lane >> 5;
  const int R0 = rt * 32;
  const int srow = tid >> 4, sch = tid & 15;
  const int grow = R0 + srow, sn = grow >> 1, sg = grow & 1;
  const bool svalid = grow < 2046;
  const bf16_t* sp = proj + (size_t)(16 * sn) * INWP + col0 + sg * 128 + sch * 8;
  f32x16 acc0, acc1;
#pragma unroll
  for (int i = 0; i < 16; ++i) { acc0[i] = 0.f; acc1[i] = 0.f; }
  u32x4 rx = {0u, 0u, 0u, 0u}; f32x4 rp0, rp1;
#define STAGE_WRITE(buf)                                                                                   \
  {                                                                                                        \
    u32x4 o_;                                                                                              \
    _Pragma("unroll") for (int i = 0; i < 4; ++i) {                                                        \
      const unsigned wv_ = rx[i];                                                                          \
      const float lo = __uint_as_float(wv_ << 16) + ((i < 2) ? rp0[2 * i] : rp1[2 * i - 4]);               \
      const float hi = __uint_as_float(wv_ & 0xFFFF0000u) + ((i < 2) ? rp0[2 * i + 1] : rp1[2 * i - 3]);   \
      o_[i] = pack2(lo, hi);                                                                               \
    }                                                                                                      \
    *(u32x4*)(Xs + (buf) * 4352 + srow * 136 + sch * 8) = o_;                                              \
  }
  if (svalid) rx = *(const u32x4*)(sp);
  rp0 = *(const f32x4*)(pos + sch * 8); rp1 = *(const f32x4*)(pos + sch * 8 + 4);
  STAGE_WRITE(0)
  __syncthreads();
  const bf16_t* wb0 = w1f + ((size_t)(2 * w) * 256 * 64 + lane) * 8;
  const bf16_t* wb1 = w1f + ((size_t)(2 * w + 1) * 256 * 64 + lane) * 8;
#pragma unroll 1
  for (int l = 0; l < 32; ++l) {
    if (l + 1 < 32) {
      if (svalid) rx = *(const u32x4*)(sp + (size_t)(l + 1) * INWP);
      rp0 = *(const f32x4*)(pos + (l + 1) * 128 + sch * 8); rp1 = *(const f32x4*)(pos + (l + 1) * 128 + sch * 8 + 4);
    }
    const bf16_t* xa = Xs + (l & 1) * 4352 + c * 136 + 8 * h;
#pragma unroll
    for (int s8 = 0; s8 < 8; ++s8) {
      const bf16x8 a = *(const bf16x8*)(xa + 16 * s8);
      const bf16x8 b0 = *(const bf16x8*)(wb0 + (size_t)(8 * l + s8) * 512);
      const bf16x8 b1v = *(const bf16x8*)(wb1 + (size_t)(8 * l + s8) * 512);
      acc0 = MFMA32(a, b0, acc0);
      acc1 = MFMA32(a, b1v, acc1);
    }
    if (l + 1 < 32) STAGE_WRITE((l + 1) & 1)
    __syncthreads();
  }
  {
    const float bb0 = b1[64 * w + c], bb1 = b1[64 * w + 32 + c];
#pragma unroll
    for (int rg = 0; rg < 16; ++rg) {
      const int row = (rg & 3) + 8 * (rg >> 2) + 4 * h;
      Hs[row * 520 + 64 * w + c] = f2bf(gelu_tanh(acc0[rg] + bb0));
      Hs[row * 520 + 64 * w + 32 + c] = f2bf(gelu_tanh(acc1[rg] + bb1));
    }
  }
  __syncthreads();
  if (w < 4) {
    f32x16 o2;
#pragma unroll
    for (int i = 0; i < 16; ++i) o2[i] = 0.f;
    const bf16_t* ha = Hs + c * 520 + 8 * h;
    const bf16_t* wb = w2f + ((size_t)w * 32 * 64 + lane) * 8;
#pragma unroll 8
    for (int s2 = 0; s2 < 32; ++s2) {
      const bf16x8 a = *(const bf16x8*)(ha + 16 * s2);
      const bf16x8 b = *(const bf16x8*)(wb + (size_t)s2 * 512);
      o2 = MFMA32(a, b, o2);
    }
    const int d = 32 * w + c;
#pragma unroll
    for (int rg = 0; rg < 16; ++rg) {
      const int row = R0 + (rg & 3) + 8 * (rg >> 2) + 4 * h;
      const int n = row >> 1, g = row & 1;
      const bf16_t val = (row < 2046) ? f2bf(o2[rg]) : (bf16_t)0;
      const int T = n >> 5, nn = n & 31;
      size_t idx;
      if (!isV) idx = ((((size_t)(g * 32 + T) * 8 + (d >> 4)) * 64 + (pi_perm(nn) + 32 * ((d >> 3) & 1))) * 8 + (d & 7));
      else idx = (((((size_t)(g * 32 + T) * 4 + (d >> 5)) * 2 + (nn >> 4)) * 64 + ((d & 31) + 32 * ((nn >> 3) & 1))) * 8 + (nn & 7));
      outf[idx] = val;
    }
  }
  __syncthreads();
}


DI unsigned f2sort(float f) { unsigned u = __float_as_uint(f); return u ^ ((unsigned)((int)u >> 31) | 0x80000000u); }
DI float sort2f(unsigned k) { unsigned u = (k & 0x80000000u) ? (k ^ 0x80000000u) : ~k; return __uint_as_float(u); }
template <int N>
DI void bitonic_sort_desc(unsigned (&key)[N]) {
#pragma unroll
  for (int k = 2; k <= N; k <<= 1) {
#pragma unroll
    for (int jj = k >> 1; jj > 0; jj >>= 1) {
#pragma unroll
      for (int i = 0; i < N; ++i) {
        const int l2 = i ^ jj;
        if (l2 > i) {
          const bool desc = ((i & k) == 0);
          unsigned a = key[i], b = key[l2];
          unsigned mx = a > b ? a : b, mn = a > b ? b : a;
          key[i] = desc ? mx : mn; key[l2] = desc ? mn : mx;
        }
      }
    }
  }
}
DI void merge_top16(unsigned (&a)[16], const unsigned (&b)[16]) {
#pragma unroll
  for (int i = 0; i < 16; ++i) { unsigned o = b[15 - i]; a[i] = a[i] > o ? a[i] : o; }
#pragma unroll
  for (int jj = 8; jj > 0; jj >>= 1) {
#pragma unroll
    for (int i = 0; i < 16; ++i) {
      const int l2 = i ^ jj;
      if (l2 > i) { unsigned x = a[i], y = a[l2]; a[i] = x > y ? x : y; a[l2] = x > y ? y : x; }
    }
  }
}
__device__ void d_cvt_subk(size_t c, const float* __restrict__ subk, bf16_t* __restrict__ skf) {
  int lane = c & 63, s = (c >> 6) & 7, kt = (c >> 9) & 3, hc = c >> 11;
  int i = lane & 31, h = lane >> 5;
  const float* src = subk + ((size_t)hc * 128 + 32 * kt + i) * 128 + 16 * s + 8 * h;
  bf16_t v[8];
#pragma unroll
  for (int j = 0; j < 8; ++j) v[j] = f2bf(src[j]);
  u32x4 o; o.x = v[0] | ((unsigned)v[1] << 16); o.y = v[2] | ((unsigned)v[3] << 16); o.z = v[4] | ((unsigned)v[5] << 16); o.w = v[6] | ((unsigned)v[7] << 16);
  *(u32x4*)(skf + c * 8) = o;
}

struct EpiProjG {
  static constexpr bool PERM = true, AFTER_DRAIN = false;
  bf16_t* proj; float* gates;
  DI void operator()(const f32x4 (&acc)[2][2][4][2], const pg8::Unit& u, int wr, int wc, int fr, int fq) const {
#pragma unroll
    for (int ai = 0; ai < 2; ++ai)
#pragma unroll
      for (int m = 0; m < 4; ++m) {
        const int row = u.pm * 256 + ai * 128 + wr * 64 + m * 16 + fr;
#pragma unroll
        for (int bj = 0; bj < 2; ++bj) {
          const int c0 = u.pn * 256 + bj * 128 + wc * 32 + 8 * fq;
          const f32x4 v0 = acc[ai][bj][m][0], v1 = acc[ai][bj][m][1];
          if (c0 < INW) {
            u32x4 w = {pack2(v0[0], v0[1]), pack2(v0[2], v0[3]), pack2(v1[0], v1[1]), pack2(v1[2], v1[3])};
            *(u32x4*)(proj + (size_t)row * INWP + c0) = w;
          }
          if (c0 >= OFF_G && c0 < OFF_G + 24) {
            f32x4 g0, g1;
#pragma unroll
            for (int j = 0; j < 4; ++j) { g0[j] = 1.f / (1.f + __expf(-v0[j])); g1[j] = 1.f / (1.f + __expf(-v1[j])); }
            *(f32x4*)(gates + (size_t)row * 24 + (c0 - OFF_G)) = g0;
            *(f32x4*)(gates + (size_t)row * 24 + (c0 - OFF_G) + 4) = g1;
          }
        }
      }
  }
};
struct EpiResG {
  static constexpr bool PERM = false, AFTER_DRAIN = false;
  float* Y; const float* X;
  DI void operator()(const f32x4 (&acc)[2][2][4][2], const pg8::Unit& u, int wr, int wc, int fr, int fq) const {
#pragma unroll
    for (int ai = 0; ai < 2; ++ai)
#pragma unroll
      for (int m = 0; m < 4; ++m) {
        const size_t ro = (size_t)(u.pm * 256 + ai * 128 + wr * 64 + m * 16 + fr) * DM + u.pn * 256 + wc * 32 + 4 * fq;
#pragma unroll
        for (int bj = 0; bj < 2; ++bj)
#pragma unroll
          for (int n = 0; n < 2; ++n) {
            const f32x4 xv = *(const f32x4*)(X + ro + bj * 128 + n * 16);
            *(f32x4*)(Y + ro + bj * 128 + n * 16) = ALPHA * xv + acc[ai][bj][m][n];
          }
      }
  }
};
struct EpiF32G {
  static constexpr bool PERM = false, AFTER_DRAIN = false;
  float* C; int ldc;
  DI void operator()(const f32x4 (&acc)[2][2][4][2], const pg8::Unit& u, int wr, int wc, int fr, int fq) const {
#pragma unroll
    for (int ai = 0; ai < 2; ++ai)
#pragma unroll
      for (int m = 0; m < 4; ++m) {
        const size_t ro = (size_t)(u.pm * 256 + ai * 128 + wr * 64 + m * 16 + fr) * ldc + u.pn * 256 + wc * 32 + 4 * fq;
#pragma unroll
        for (int bj = 0; bj < 2; ++bj)
#pragma unroll
          for (int n = 0; n < 2; ++n) *(f32x4*)(C + ro + bj * 128 + n * 16) = acc[ai][bj][m][n];
      }
  }
};
struct EpiRouteG {
  static constexpr bool PERM = false, AFTER_DRAIN = true;
  const bf16_t* skf; unsigned* tops;
  DI void operator()(const f32x4 (&)[2][2][4][2], const pg8::Unit&, int, int, int, int) const {}
  DI void fused(const f32x4 (&acc)[2][2][4][2], const pg8::Unit& u, int wr, int wc, int fr, int fq, PG8_LAS unsigned char* ldsp, int, int) const {
    const int lane = fr | (fq << 4), wid = wr * 4 + wc;
    bf16_t* Qs = (bf16_t*)ldsp;
#pragma unroll
    for (int ai = 0; ai < 2; ++ai)
#pragma unroll
      for (int m = 0; m < 4; ++m) {
        const int row = ai * 128 + wr * 64 + m * 16 + fr;
#pragma unroll
        for (int bj = 0; bj < 2; ++bj)
#pragma unroll
          for (int n = 0; n < 2; ++n) {
            const f32x4 v = acc[ai][bj][m][n];
            u32x2 w = {pack2(v[0], v[1]), pack2(v[2], v[3])};
            *(u32x2*)(Qs + row * 264 + bj * 128 + wc * 32 + n * 16 + 4 * fq) = w;
          }
      }
    __syncthreads();
    const int c = lane & 31, h = lane >> 5;
#pragma unroll 1
    for (int half = 0; half < 2; ++half) {
      const int hc = u.pn * 2 + half;
      const bf16_t* sk = skf + (size_t)hc * 4 * 4096;
      const bf16_t* qp = Qs + (wid * 32 + c) * 264 + half * 128 + 8 * h;
      unsigned k0[16], k1[16];
#define ROUTE_KT(KT, KA)                                                                        \
      {                                                                                         \
        f32x16 sc;                                                                              \
        _Pragma("unroll") for (int i = 0; i < 16; ++i) sc[i] = 0.f;                             \
        _Pragma("unroll") for (int s = 0; s < 8; ++s) {                                         \
          bf16x8 af = *(const bf16x8*)(sk + (KT) * 4096 + s * 512 + lane * 8);                  \
          bf16x8 bq = *(const bf16x8*)(qp + 16 * s);                                            \
          sc = __builtin_amdgcn_mfma_f32_32x32x16_bf16(af, bq, sc, 0, 0, 0);                    \
        }                                                                                       \
        _Pragma("unroll") for (int rg = 0; rg < 16; ++rg) {                                     \
          const int kidx = 32 * (KT) + (rg & 3) + 8 * (rg >> 2) + 4 * h;                        \
          KA[rg] = (f2sort(sc[rg]) & 0xFFFFFF80u) | (unsigned)(127 - kidx);                     \
        }                                                                                       \
        bitonic_sort_desc<16>(KA);                                                              \
      }
      ROUTE_KT(0, k0)
      __builtin_amdgcn_sched_barrier(0);
      ROUTE_KT(1, k1)
      merge_top16(k0, k1);
      __builtin_amdgcn_sched_barrier(0);
      ROUTE_KT(2, k1)
      merge_top16(k0, k1);
      __builtin_amdgcn_sched_barrier(0);
      ROUTE_KT(3, k1)
      merge_top16(k0, k1);
      __builtin_amdgcn_sched_barrier(0);
#undef ROUTE_KT
#pragma unroll
      for (int i = 0; i < 16; ++i) k1[i] = (unsigned)__shfl_xor((int)k0[i], 32);
      merge_top16(k0, k1);
      if (h == 0) {
        unsigned* dst = tops + ((size_t)(u.pm * 256 + wid * 32 + c) * 16 + hc) * 16;
#pragma unroll
        for (int q4 = 0; q4 < 4; ++q4) { u32x4 o = {k0[4 * q4], k0[4 * q4 + 1], k0[4 * q4 + 2], k0[4 * q4 + 3]}; *(u32x4*)(dst + 4 * q4) = o; }
      }
    }
    __syncthreads();
  }
};


template <int CTRL> DI float dpp_f(float v) { const int iv = __float_as_int(v); return __int_as_float(__builtin_amdgcn_update_dpp(iv, iv, CTRL, 0xF, 0xF, false)); }
DI float wsum(float x) {
  x += dpp_f<0xB1>(x);
  x += dpp_f<0x4E>(x);
  x += dpp_f<0x124>(x);
  x += dpp_f<0x128>(x);
  x += __shfl_xor(x, 16);
  return hsum(x);
}
DI float gelu_fast(float x) {
  const float u2 = 1.5957691216057308f * (x + 0.044715f * x * x * x);
  return x * __builtin_amdgcn_rcpf(1.f + ex2(-LOG2E * u2));
}

constexpr int EROW = 1152;
typedef float v2f __attribute__((ext_vector_type(2)));
__device__ void d_cvt_fp4_row(int row, const float* __restrict__ src, unsigned char* __restrict__ dst) {
  const int lane = TIDX & 63;
  float v[32]; float amax = 0.f;
#pragma unroll
  for (int i = 0; i < 8; ++i) {
    f32x4 x = *(const f32x4*)(src + (size_t)row * DM + 256 * i + 4 * lane);
#pragma unroll
    for (int j = 0; j < 4; ++j) { v[i * 4 + j] = x[j]; amax = fmaxf(amax, fabsf(x[j])); }
  }
  const float sc = amax > 0.f ? amax * (1.f / 6.f) : 1.f;
  const float scb = bf2f(f2bf(sc));
  const float inv = 1.f / scb;
  u32x4 o;
#pragma unroll
  for (int k = 0; k < 4; ++k) {
    unsigned w = 0u;
#define FP4C(x_) fminf(fmaxf((x_) * inv, -6.f), 6.f)
    w = __builtin_amdgcn_cvt_scalef32_pk_fp4_f32(w, FP4C(v[8 * k + 0]), FP4C(v[8 * k + 1]), 1.0f, 0);
    w = __builtin_amdgcn_cvt_scalef32_pk_fp4_f32(w, FP4C(v[8 * k + 2]), FP4C(v[8 * k + 3]), 1.0f, 1);
    w = __builtin_amdgcn_cvt_scalef32_pk_fp4_f32(w, FP4C(v[8 * k + 4]), FP4C(v[8 * k + 5]), 1.0f, 2);
    w = __builtin_amdgcn_cvt_scalef32_pk_fp4_f32(w, FP4C(v[8 * k + 6]), FP4C(v[8 * k + 7]), 1.0f, 3);
#undef FP4C
    o[k] = w;
  }
  *(u32x4*)(dst + (size_t)row * EROW + 16 * lane) = o;
  *(bf16_t*)(dst + (size_t)row * EROW + 1024 + 2 * lane) = f2bf(sc);
}
__device__ void d_expert_wave(int t, const float* __restrict__ yf, const float* __restrict__ stats, const float* __restrict__ g1v, const float* __restrict__ b1v,
                              const unsigned* __restrict__ tops, const unsigned char* __restrict__ eu4, const unsigned char* __restrict__ ev4,
                              const float* __restrict__ gam, const float* __restrict__ bet, float* __restrict__ out) {
  const int lane = TIDX & 63;
  const float mu1 = stats[2 * t], rs1 = stats[2 * t + 1];
  float hv[32];
#pragma unroll
  for (int i = 0; i < 8; ++i) {
    const int cb = 256 * i + 4 * lane;
    const f32x4 x = *(const f32x4*)(yf + (size_t)t * DM + cb), gg = *(const f32x4*)(g1v + cb), bb = *(const f32x4*)(b1v + cb);
#pragma unroll
    for (int j = 0; j < 4; ++j) hv[i * 4 + j] = (x[j] - mu1) * rs1 * gg[j] + bb[j];
  }
  int e0 = 0, e1 = 0; float w0 = 0.f, w1 = 0.f;
  {
    const int ci = (lane < 16) ? 0 : (lane < 24) ? 1 : (lane < 29) ? 2 : (lane < 33) ? 3 : (lane < 36) ? 4 : (lane < 38) ? 5 : (lane < 40) ? 6
                   : (lane < 42) ? 7 : (lane - 34);
    const int cpre = (ci == 0) ? 0 : (ci == 1) ? 16 : (ci == 2) ? 24 : (ci == 3) ? 29 : (ci == 4) ? 33 : (ci == 5) ? 36 : (ci == 6) ? 38
                     : (ci == 7) ? 40 : (34 + ci);
    const int cj = lane - cpre;
    const bool cvalid = lane < 50;
    const unsigned* tp = tops + (size_t)t * 256;
#pragma unroll 1
    for (int hh = 0; hh < 8; ++hh) {
      unsigned key = 0u;
      if (cvalid) {
        const float sa = sort2f(tp[(2 * hh) * 16 + ci]), sb = sort2f(tp[(2 * hh + 1) * 16 + cj]);
        key = (f2sort(sa + sb) & 0xFFFFFF00u) | (unsigned)(255 - (ci * 16 + cj));
      }
#pragma unroll
      for (int k = 2; k <= 64; k <<= 1) {
#pragma unroll
        for (int jj = k >> 1; jj > 0; jj >>= 1) {
          const unsigned o = (unsigned)__shfl_xor((int)key, jj);
          const bool lower = (lane & jj) == 0;
          const bool desc = (lane & k) == 0 || k == 64;
          const unsigned mx = key > o ? key : o, mn = key > o ? o : key;
          key = (lower == desc) ? mx : mn;
        }
      }
      const int flat = 255 - (int)(key & 255u);
      const int bi = (flat >> 4) & 15, bj = flat & 15;
      const unsigned ka = tp[(2 * hh) * 16 + bi], kb = tp[(2 * hh + 1) * 16 + bj];
      const float sc = sort2f(ka) + sort2f(kb);
      const int ex = (127 - (int)(ka & 127u)) * 128 + (127 - (int)(kb & 127u));
      float mx = sc;
      mx = fmaxf(mx, __shfl_xor(mx, 1)); mx = fmaxf(mx, __shfl_xor(mx, 2)); mx = fmaxf(mx, __shfl_xor(mx, 4)); mx = fmaxf(mx, __shfl_xor(mx, 8));
      const float ev_ = __expf(sc - mx);
      float sm = ev_;
      sm += __shfl_xor(sm, 1); sm += __shfl_xor(sm, 2); sm += __shfl_xor(sm, 4); sm += __shfl_xor(sm, 8);
      const float gv = ev_ / sm;
      const int exs = __shfl(ex, lane & 15); const float gvs = __shfl(gv, lane & 15);
      if ((lane >> 4) == (hh & 3)) { if (hh < 4) { e0 = exs; w0 = gvs; } else { e1 = exs; w1 = gvs; } }
    }
  }
  bf16x2v hb2[16];
#pragma unroll
  for (int i = 0; i < 16; ++i) hb2[i] = bf16x2v{(__bf16)hv[2 * i], (__bf16)hv[2 * i + 1]};
  float c0 = 0.f, c1 = 0.f;
  u32x4 rA[4], rB[4]; unsigned short sA[4], sB[4];
#define EX_LOAD(R, SS, TAB, EB)                                                            \
  _Pragma("unroll") for (int k = 0; k < 4; ++k) {                                          \
    const int e = (EB) + k;                                                                \
    const int id = __builtin_amdgcn_readlane((e < 64) ? e0 : e1, e & 63);                 \
    const unsigned char* row = (TAB) + (size_t)id * EROW;                                  \
    R[k] = *(const u32x4*)(row + 16 * lane);                                               \
    SS[k] = *(const unsigned short*)(row + 1024 + 2 * lane);                               \
  }
#define PKFMA(a_, b_, c_) __builtin_elementwise_fma((a_), (b_), (c_))
#define EX_COMP_U(R, SS, EB)                                                               \
  {                                                                                        \
    float dd[4];                                                                           \
    _Pragma("unroll") for (int k = 0; k < 4; ++k) {                                        \
      float d0 = 0.f, d1 = 0.f;                                                            \
      _Pragma("unroll") for (int q = 0; q < 4; ++q) {                                      \
        const unsigned wq = R[k][q];                                                       \
        d0 = __builtin_amdgcn_fdot2_f32_bf16(__builtin_amdgcn_cvt_scalef32_pk_bf16_fp4(wq, 1.0f, 0), hb2[4 * q + 0], d0, false); \
        d1 = __builtin_amdgcn_fdot2_f32_bf16(__builtin_amdgcn_cvt_scalef32_pk_bf16_fp4(wq, 1.0f, 1), hb2[4 * q + 1], d1, false); \
        d0 = __builtin_amdgcn_fdot2_f32_bf16(__builtin_amdgcn_cvt_scalef32_pk_bf16_fp4(wq, 1.0f, 2), hb2[4 * q + 2], d0, false); \
        d1 = __builtin_amdgcn_fdot2_f32_bf16(__builtin_amdgcn_cvt_scalef32_pk_bf16_fp4(wq, 1.0f, 3), hb2[4 * q + 3], d1, false); \
      }                                                                                    \
      dd[k] = bf2f(SS[k]) * (d0 + d1);                                                     \
      __builtin_amdgcn_sched_barrier(0);                                                   \
    }                                                                                      \
    _Pragma("unroll") for (int k = 0; k < 4; ++k) dd[k] = wsum(dd[k]);                     \
    _Pragma("unroll") for (int k = 0; k < 4; ++k) {                                        \
      const int e = (EB) + k;                                                              \
      const float gl = gelu_fast(dd[k]);                                                   \
      if (e < 64) { if (lane == e) c0 = w0 * gl; } else { if (lane == e - 64) c1 = w1 * gl; } \
    }                                                                                      \
    __builtin_amdgcn_sched_barrier(0);                                                     \
  }
#define EX_COMP_V(R, SS, EB)                                                               \
  _Pragma("unroll") for (int k = 0; k < 4; ++k) {                                          \
    const int e = (EB) + k;                                                                \
    const float cs = __int_as_float(__builtin_amdgcn_readlane(__float_as_int((e < 64) ? c0 : c1), e & 63)) * bf2f(SS[k]);                     \
    const v2f cs2 = {cs, cs};                                                              \
    _Pragma("unroll") for (int q = 0; q < 4; ++q) {                                        \
      const unsigned wq = R[k][q];                                                         \
      const v2f f0 = __builtin_amdgcn_cvt_scalef32_pk_f32_fp4(wq, 1.0f, 0), f1 = __builtin_amdgcn_cvt_scalef32_pk_f32_fp4(wq, 1.0f, 1); \
      const v2f f2 = __builtin_amdgcn_cvt_scalef32_pk_f32_fp4(wq, 1.0f, 2), f3 = __builtin_amdgcn_cvt_scalef32_pk_f32_fp4(wq, 1.0f, 3); \
      acc2[4 * q + 0] = PKFMA(cs2, f0, acc2[4 * q + 0]); acc2[4 * q + 1] = PKFMA(cs2, f1, acc2[4 * q + 1]); \
      acc2[4 * q + 2] = PKFMA(cs2, f2, acc2[4 * q + 2]); acc2[4 * q + 3] = PKFMA(cs2, f3, acc2[4 * q + 3]); \
    }                                                                                      \
    __builtin_amdgcn_sched_barrier(0);                                                     \
  }
  EX_LOAD(rA, sA, eu4, 0)
  __builtin_amdgcn_sched_barrier(0);
#pragma unroll 1
  for (int eb = 0; eb < 128; eb += 8) {
    EX_LOAD(rB, sB, eu4, eb + 4)
    __builtin_amdgcn_sched_barrier(0);
    EX_COMP_U(rA, sA, eb)
    { const bool more = eb + 8 < 128; const unsigned char* tabn = more ? eu4 : ev4; const int ebn = more ? eb + 8 : 0;
      EX_LOAD(rA, sA, tabn, ebn) }
    __builtin_amdgcn_sched_barrier(0);
    EX_COMP_U(rB, sB, eb + 4)
  }
  v2f acc2[16];
#pragma unroll
  for (int i = 0; i < 16; ++i) acc2[i] = v2f{0.f, 0.f};
#pragma unroll 1
  for (int eb = 0; eb < 128; eb += 8) {
    EX_LOAD(rB, sB, ev4, eb + 4)
    __builtin_amdgcn_sched_barrier(0);
    EX_COMP_V(rA, sA, eb)
    { const int ebn = (eb + 8 < 128) ? eb + 8 : 0;
      EX_LOAD(rA, sA, ev4, ebn) }
    __builtin_amdgcn_sched_barrier(0);
    EX_COMP_V(rB, sB, eb + 4)
  }
#undef EX_LOAD
#undef EX_COMP_U
#undef EX_COMP_V
#undef PKFMA
  float acc[32];
#pragma unroll
  for (int i = 0; i < 16; ++i) { acc[2 * i] = acc2[i].x; acc[2 * i + 1] = acc2[i].y; }
  int le = lane;
  asm volatile("" : "+v"(le) :: "memory");
  float s = 0.f;
#pragma unroll
  for (int i = 0; i < 8; ++i) {
    const int cb = 256 * i + 4 * le;
    const f32x4 x = *(const f32x4*)(yf + (size_t)t * DM + cb), gg = *(const f32x4*)(g1v + cb), bb = *(const f32x4*)(b1v + cb);
#pragma unroll
    for (int j = 0; j < 4; ++j) { const float hj = (x[j] - mu1) * rs1 * gg[j] + bb[j]; acc[i * 4 + j] = fmaf(ALPHA, hj, acc[i * 4 + j]); s += acc[i * 4 + j]; }
  }
  s = wsum(s);
  const float mu = s * (1.f / DM);
  float qv = 0.f;
#pragma unroll
  for (int i = 0; i < 32; ++i) { const float d = acc[i] - mu; qv += d * d; }
  qv = wsum(qv);
  const float rs = rsqrtf(qv * (1.f / DM) + 1e-5f);
#pragma unroll
  for (int i = 0; i < 8; ++i) {
    const int cbase = 256 * i + 4 * le;
    f32x4 ga = *(const f32x4*)(gam + cbase), ba = *(const f32x4*)(bet + cbase), o;
#pragma unroll
    for (int j = 0; j < 4; ++j) o[j] = (acc[i * 4 + j] - mu) * rs * ga[j] + ba[j];
    *(f32x4*)(out + (size_t)t * DM + cbase) = o;
  }
}

constexpr size_t al256(size_t x) { return (x + 255) & ~(size_t)255; }
constexpr size_t WS_XB = 0;
constexpr size_t WS_PROJ = WS_XB + al256((size_t)S * DM * 2);
constexpr size_t WS_WINT = WS_PROJ + al256((size_t)S * INWP * 2);
constexpr size_t WS_GATES = WS_WINT + al256((size_t)INWG * DM * 2);
constexpr size_t WS_W1KF = WS_GATES + al256((size_t)S * 24 * 4);
constexpr size_t WS_W1VF = WS_W1KF + al256((size_t)512 * 4096 * 2);
constexpr size_t WS_W2KF = WS_W1VF + al256((size_t)512 * 4096 * 2);
constexpr size_t WS_W2VF = WS_W2KF + al256((size_t)512 * 128 * 2);
constexpr size_t WS_VC = WS_W2VF + al256((size_t)512 * 128 * 2) - al256((size_t)2048 * 128 * 4);
constexpr size_t WS_KCF = WS_VC + al256((size_t)2048 * 128 * 4);
constexpr size_t WS_VCF = WS_KCF + al256((size_t)2 * 32 * 4096 * 2);
constexpr size_t WS_KSF = WS_VCF + al256((size_t)2 * 32 * 4096 * 2);
constexpr size_t WS_VSF = WS_KSF + al256((size_t)2 * 512 * 4096 * 2);
constexpr size_t WS_KWF = WS_VSF + al256((size_t)2 * 512 * 4096 * 2);
constexpr size_t WS_VWF = WS_KWF + al256((size_t)2 * 512 * 4096 * 2);
constexpr size_t WS_ENDA = WS_VWF + al256((size_t)2 * 512 * 4096 * 2);
constexpr size_t WS_OATT = WS_ENDA;
constexpr size_t WS_MIX = WS_OATT + al256((size_t)S * 1024 * 4);
constexpr size_t WS_WOUTT = WS_MIX + al256((size_t)S * DM * 2);
constexpr size_t WS_WQT = WS_WOUTT + al256((size_t)DM * DM * 2);
constexpr size_t WS_TOPS = WS_WQT + al256((size_t)DM * DM * 2);
constexpr size_t WS_SKF = WS_TOPS + al256((size_t)S * 256 * 4);
constexpr size_t WS_STATS = WS_SKF + al256((size_t)16 * 128 * 128 * 2);
constexpr size_t WS_CTRL = WS_STATS + al256((size_t)S * 2 * 4);
constexpr size_t CTRL_BYTES = 32768;
constexpr size_t WS_END = WS_CTRL + CTRL_BYTES;
constexpr size_t WS_Y = WS_PROJ;
constexpr size_t WS_HB = WS_XB;
constexpr size_t WS_EU8 = WS_Y + (size_t)S * DM * 4;
constexpr size_t WS_EV8 = WS_EU8 + (size_t)16384 * 1152;
static_assert(WS_EV8 + (size_t)16384 * 1152 <= WS_ENDA, "expert overlay overflows group A");
static_assert(WS_END <= (size_t)512 * 1024 * 1024, "workspace over 512 MiB");

struct Params {
  const float *x, *w_in, *ck_pos, *ck_w1, *ck_b1, *ck_w2, *cv_pos, *cv_w1, *cv_b1, *cv_w2, *conv_w, *hng, *w_out, *ln1g, *ln1b, *w_query, *subk,
      *eu, *ev, *ln2g, *ln2b;
  float* out;
  char* ws;
};
#define WSP(T, OFF) ((T*)(p.ws + (OFF)))

#define FOR_VB(n) for (int vb = blockIdx.x; vb < (n); vb += gridDim.x)
#define FOR_VB2(n) for (int vb = blockIdx.x * 2 + (TIDX >> 8); vb < (n); vb += gridDim.x * 2)
constexpr int SMEM_BYTES = 143360;
constexpr int HALF = 36864;

__global__ void __launch_bounds__(512) mega(Params p) {
  __shared__ __attribute__((aligned(16))) char smem[SMEM_BYTES + 16];
  if (TIDX == 0) *(u32x4*)(smem + SMEM_BYTES) = u32x4{0u, 0u, 0u, 0u};
  __syncthreads();
  const XcdBarrier xbar = xcd_barrier_post(WSP(unsigned, WS_CTRL + 1024), (volatile LAS unsigned*)(smem + SMEM_BYTES));
#define smh (smem + (TIDX >> 8) * HALF)
#define wv ((TIDX >> 6))
  constexpr int NWV = 8;
  d_cvt(p.x, WSP(bf16_t, WS_XB), (size_t)S * DM / 4);
  FOR_VB2((INWG / 64) * (DM / 64)) d_cvtT64(vb, smh, p.w_in, WSP(bf16_t, WS_WINT), DM, INW, INWG);
  for (size_t c = (size_t)blockIdx.x * 512 + TIDX; c < (size_t)16 * 256 * 64; c += (size_t)gridDim.x * 512) {
    d_cvt_w1f(c, p.ck_w1, WSP(bf16_t, WS_W1KF)); d_cvt_w1f(c, p.cv_w1, WSP(bf16_t, WS_W1VF));
    if (c < (size_t)4 * 32 * 64) { d_cvt_w2f(c, p.ck_w2, WSP(bf16_t, WS_W2KF)); d_cvt_w2f(c, p.cv_w2, WSP(bf16_t, WS_W2VF)); }
  }
  FOR_VB2((DM / 64) * (DM / 64)) d_cvtT64(vb, smh, p.w_out, WSP(bf16_t, WS_WOUTT), DM, DM, DM);
  FOR_VB2((DM / 64) * (DM / 64)) d_cvtT64(vb, smh, p.w_query, WSP(bf16_t, WS_WQT), DM, DM, DM);
  for (size_t c = (size_t)blockIdx.x * 512 + TIDX; c < (size_t)16 * 4 * 8 * 64; c += (size_t)gridDim.x * 512) d_cvt_subk(c, p.subk, WSP(bf16_t, WS_SKF));
  xcd_barrier(xbar);
  {
    pg8::StaticOrder so; so.init(S, INWG, gridDim.x, blockIdx.x);
    pg8::gemm_phase<EpiProjG, pg8::StaticOrder>((PG8_LAS unsigned char*)smem, pg8::Gemm{WSP(bf16_t, WS_XB), WSP(bf16_t, WS_WINT), S, INWG, DM}, so,
                                                EpiProjG{WSP(bf16_t, WS_PROJ), WSP(float, WS_GATES)}, nullptr);
  }
  xcd_barrier(xbar);
  {
    if (blockIdx.x < 128) {
      const int u = blockIdx.x; const bool isV = u >= 64;
      d_compress_unit(u & 63, smem, WSP(bf16_t, WS_PROJ), isV ? OFF_VC : OFF_KC, isV ? p.cv_pos : p.ck_pos, isV ? WSP(bf16_t, WS_W1VF) : WSP(bf16_t, WS_W1KF),
                      isV ? p.cv_b1 : p.ck_b1, isV ? WSP(bf16_t, WS_W2VF) : WSP(bf16_t, WS_W2KF), isV ? WSP(bf16_t, WS_VCF) : WSP(bf16_t, WS_KCF), isV);
    }
    int* slot = (int*)smem;
    unsigned* ctr = WSP(unsigned, WS_CTRL);
    for (;;) {
      if (TIDX == 0) *slot = (int)atomicAdd(ctr, 1u);
      __syncthreads();
      const int it = *slot;
      __syncthreads();
      if (it >= 2048) break;
      const int tt = TIDX;
      {
        const int T = it >> 2, which = it & 3;
        d_relayout_tile(T, smem + 64, WSP(bf16_t, WS_PROJ), (which == 0) ? OFF_KS : (which == 1) ? OFF_VS : (which == 2) ? OFF_KW : OFF_VW,
                        (which == 0) ? WSP(bf16_t, WS_KSF) : (which == 1) ? WSP(bf16_t, WS_VSF) : (which == 2) ? WSP(bf16_t, WS_KWF) : WSP(bf16_t, WS_VWF), (which & 1) != 0);
      }
      for (int q = 0; q < 2; ++q) d_convmix(it * 8 + q * 4 + (tt >> 7), tt & 127, WSP(bf16_t, WS_PROJ), p.conv_w, p.hng, WSP(bf16_t, WS_MIX));
    }
  }
  xcd_barrier(xbar);
  {
    AttnPtrs ap{WSP(bf16_t, WS_PROJ), WSP(float, WS_GATES), WSP(bf16_t, WS_KCF), WSP(bf16_t, WS_VCF), WSP(bf16_t, WS_KSF), WSP(bf16_t, WS_VSF), WSP(bf16_t, WS_KWF), WSP(bf16_t, WS_VWF), WSP(bf16_t, WS_MIX), p.hng};
    for (int it = blockIdx.x; it < 512; it += gridDim.x) {
      const int Bq = (it < 256) ? it : (511 - it), gq = (it < 256) ? 0 : 1;
      d_attn_block(Bq, gq, smem, ap);
    }
  }
  xcd_barrier(xbar);
  {
    pg8::StaticOrder so; so.init(S, DM, gridDim.x, blockIdx.x);
    pg8::gemm_phase<EpiResG, pg8::StaticOrder>((PG8_LAS unsigned char*)smem, pg8::Gemm{WSP(bf16_t, WS_MIX), WSP(bf16_t, WS_WOUTT), S, DM, DM}, so,
                                               EpiResG{WSP(float, WS_Y), p.x}, nullptr);
  }
  xcd_barrier(xbar);
  FOR_VB2(S) d_ln(vb, smh, WSP(float, WS_Y), p.ln1g, p.ln1b, WSP(float, WS_STATS), WSP(bf16_t, WS_HB));
  for (int r = blockIdx.x * NWV + wv; r < 32768; r += gridDim.x * NWV) {
    if (r < 16384) d_cvt_fp4_row(r, p.eu, WSP(unsigned char, WS_EU8)); else d_cvt_fp4_row(r - 16384, p.ev, WSP(unsigned char, WS_EV8));
  }
  xcd_barrier(xbar);
  for (int k = 0; k * (int)gridDim.x < (S / 256) * (DM / 256); ++k) {
    pg8::OneUnit so; so.init(S, DM, gridDim.x, blockIdx.x); so.k = k;
    pg8::gemm_phase<EpiRouteG, pg8::OneUnit>((PG8_LAS unsigned char*)smem, pg8::Gemm{WSP(bf16_t, WS_HB), WSP(bf16_t, WS_WQT), S, DM, DM}, so,
                                             EpiRouteG{WSP(bf16_t, WS_SKF), WSP(unsigned, WS_TOPS)}, nullptr);
    __syncthreads();
  }
  xcd_barrier(xbar);
  for (int t = blockIdx.x * NWV + wv; t < S; t += gridDim.x * NWV) d_expert_wave(t, WSP(float, WS_Y), WSP(float, WS_STATS), p.ln1g, p.ln1b, WSP(unsigned, WS_TOPS), WSP(unsigned char, WS_EU8), WSP(unsigned char, WS_EV8), p.ln2g, p.ln2b, p.out);
}

extern "C" void kernel_launch(void* const* d_in, const int* in_sizes, int n_in, void* d_out, int out_size, void* d_ws, size_t ws_size,
                              hipStream_t stream) {
  Params p{};
  p.x = (const float*)d_in[0]; p.w_in = (const float*)d_in[1]; p.ck_pos = (const float*)d_in[2]; p.ck_w1 = (const float*)d_in[3];
  p.ck_b1 = (const float*)d_in[4]; p.ck_w2 = (const float*)d_in[5]; p.cv_pos = (const float*)d_in[6]; p.cv_w1 = (const float*)d_in[7];
  p.cv_b1 = (const float*)d_in[8]; p.cv_w2 = (const float*)d_in[9]; p.conv_w = (const float*)d_in[10]; p.hng = (const float*)d_in[11];
  p.w_out = (const float*)d_in[12]; p.ln1g = (const float*)d_in[13]; p.ln1b = (const float*)d_in[14]; p.w_query = (const float*)d_in[15];
  p.subk = (const float*)d_in[16]; p.eu = (const float*)d_in[17]; p.ev = (const float*)d_in[18]; p.ln2g = (const float*)d_in[19];
  p.ln2b = (const float*)d_in[20];
  p.out = (float*)d_out;
  p.ws = (char*)d_ws;
  if (ws_size < WS_END) fprintf(stderr, "workspace too small\n");
  static int grid_blocks = 0;
  if (!grid_blocks) {
    int dev = 0, cus = 0, per_cu = 0;
    hipGetDevice(&dev);
    hipDeviceGetAttribute(&cus, hipDeviceAttributeMultiprocessorCount, dev);
    hipOccupancyMaxActiveBlocksPerMultiprocessor(&per_cu, mega, 512, 0);
    if (per_cu > 1) per_cu = 1;
    if (per_cu < 1) per_cu = 1;
    grid_blocks = cus * per_cu;
  }
  hipMemsetAsync((char*)d_ws + WS_CTRL, 0, CTRL_BYTES, stream);
  void* args[] = {&p};
  hipError_t e = hipLaunchCooperativeKernel((void*)mega, dim3(grid_blocks), dim3(512), args, 0, stream);
  if (e != hipSuccess) fprintf(stderr, "cooperative launch failed: %s (grid %d)\n", hipGetErrorString(e), grid_blocks);
}
```

```cpp
#include <hip/hip_runtime.h>
#include <stdint.h>
#include <stdio.h>


#define DI __device__ __forceinline__
static __device__ __forceinline__ int tidx_() { int t = (int)__builtin_amdgcn_workitem_id_x(); asm volatile("" : "+v"(t)); return t; }
#define TIDX (tidx_())

template <int J> DI int swz_xor(int x) { return __builtin_amdgcn_ds_swizzle(x, (J << 10) | 0x1F); }
template <int CTRL> DI int dpp_i(int x) { return __builtin_amdgcn_update_dpp(x, x, CTRL, 0xF, 0xF, false); }
DI int shx_i(int x, int j) {
  switch (j) {
    case 1: return dpp_i<0xB1>(x);
    case 2: return dpp_i<0x4E>(x);
    case 4: return dpp_i<0x1B>(dpp_i<0x141>(x));
    case 8: return dpp_i<0x128>(x);
    case 16: return swz_xor<16>(x);
    default: {
      auto r = __builtin_amdgcn_permlane32_swap((unsigned)x, (unsigned)x, false, false);
      return (TIDX & 32) ? (int)r[0] : (int)r[1];
    }
  }
}
DI float shx(float x, int j) { return __int_as_float(shx_i(__float_as_int(x), j)); }
typedef unsigned short bf16_t;
using bf16x8 = __attribute__((ext_vector_type(8))) short;
using f32x4 = __attribute__((ext_vector_type(4))) float;
using u32x4 = __attribute__((ext_vector_type(4))) unsigned;
using u32x2 = __attribute__((ext_vector_type(2))) unsigned;

constexpr int S = 16384, DM = 2048, HD = 128;
constexpr int INW = 5656, INWP = 5760, INWG = 5888;
constexpr int OFF_Q = 0, OFF_KC = 1024, OFF_VC = 1280, OFF_KS = 1536, OFF_VS = 1792, OFF_KW = 2048, OFF_VW = 2304,
              OFF_G = 2560, OFF_U = 2584, OFF_B = 3608, OFF_C = 4632;
constexpr int NCMP = 1023;
constexpr float ALPHA = 1.189207115002721f;
constexpr float QSCALE = 0.08838834764831845f;

DI bf16_t f2bf(float x) { unsigned u = __float_as_uint(x); u += 0x7fffu + ((u >> 16) & 1u); return (bf16_t)(u >> 16); }
DI float bf2f(bf16_t b) { return __uint_as_float(((unsigned)b) << 16); }
DI float gelu_tanh(float x) { float u = 0.7978845608028654f * (x + 0.044715f * x * x * x); return 0.5f * x * (1.f + tanhf(u)); }
DI float wave_sum(float v) { for (int o = 32; o > 0; o >>= 1) v += shx(v, o); return v; }
using bf16x2v = __attribute__((ext_vector_type(2))) __bf16;
DI unsigned pack2(float a, float b) { bf16x2v v = {(__bf16)a, (__bf16)b}; return __builtin_bit_cast(unsigned, v); }
DI float wave_max(float v) { for (int o = 32; o > 0; o >>= 1) v = fmaxf(v, shx(v, o)); return v; }

namespace pg8 {
#define PG8_LAS __attribute__((address_space(3)))
typedef unsigned short bf16_t;
typedef short bf16x8 __attribute__((ext_vector_type(8)));
typedef float f32x4 __attribute__((ext_vector_type(4)));
typedef unsigned u32x4 __attribute__((ext_vector_type(4)));
constexpr int BM = 256, BK = 64, HALF = 128, HTB = HALF * BK * 2  , STAGE_BYTES = 8 * HTB, NXCD = 8, WGM = 8;

__host__ __device__ __forceinline__ int lds_byte(int r, int c) { const int st = (r >> 4) * 2 + (c >> 5), rr = r & 15, cc = c & 31, ob = rr * 64 + cc * 2; return st * 1024 + (ob ^ (((ob >> 9) & 1) << 5)); }
__host__ __device__ __forceinline__ void stage_rc(int b, int& R, int& C) { const int st = b / 1024, sb = b % 1024, swz = sb ^ (((sb >> 9) & 1) << 5); R = (st >> 1) * 16 + swz / 64; C = (st & 1) * 32 + (swz % 64) / 2; }
__host__ __device__ __forceinline__ int perm32(int rho) { const int n = rho >> 4, i = rho & 15; return 8 * (i >> 2) + 4 * n + (i & 3); }

struct Unit { int pm, pn; };
struct Gemm { const bf16_t* A; const bf16_t* Bt; int M, N, K; };

struct StaticOrder {
    int nM, nN, nwg, G, c;
    __host__ __device__ void init(int M, int N, int G_, int c_) { nM = M / BM; nN = N / BM; nwg = nM * nN; G = G_; c = c_; }
    __host__ __device__ bool next(int i, Unit& u) const {
        const long L = (long)i * G + c; if (L >= nwg) return false;
        int wgid = (int)L; { const int q = nwg / NXCD, r = nwg % NXCD, xcd = wgid % NXCD, off = wgid / NXCD; wgid = (xcd < r ? xcd * (q + 1) : r * (q + 1) + (xcd - r) * q) + off; }
        const int nig = WGM * nN, gid = wgid / nig, fm = gid * WGM, gsz = (nM - fm) < WGM ? (nM - fm) : WGM;
        u.pm = fm + ((wgid % nig) % gsz); u.pn = (wgid % nig) / gsz; return true;
    }
    __device__ __forceinline__ void a_ready(const Unit&) const {}
    __device__ __forceinline__ void done(const Unit&) const {}
};
struct OneUnit : StaticOrder {
    int k;
    __device__ bool next(int i, Unit& u) const { if (i > 0) return false; return StaticOrder::next(k, u); }
};
__device__ __forceinline__ unsigned cvt_pk_bf16(float lo, float hi) { unsigned r; asm volatile("v_cvt_pk_bf16_f32 %0, %1, %2" : "=v"(r) : "v"(lo), "v"(hi)); return r; }
template <class Epi, class Sched, bool STAMP = false>
__device__ __forceinline__ void gemm_phase(PG8_LAS unsigned char* lds, const Gemm g, const Sched& S, const Epi& E, unsigned long long* stamps) {
    const int tid = TIDX, wid = __builtin_amdgcn_readfirstlane(tid >> 6), lane = tid & 63, wr = wid >> 2, wc = wid & 3, fr = lane & 15, fq = lane >> 4;
    const int K = g.K, nt = K / BK;
    int ts_lo = 0, ts_hi = 0, nts = 0; const unsigned long long rt_entry = STAMP ? (unsigned long long)wall_clock64() : 0ull;
#define PG8_STAMP() do { if (STAMP && wid == 0 && nts < 64) { const unsigned long long _c = (unsigned long long)clock64(); \
        ts_lo = (lane == nts) ? (int)(unsigned)_c : ts_lo; ts_hi = (lane == nts) ? (int)(unsigned)(_c >> 32) : ts_hi; ++nts; } } while (0)
    PG8_STAMP();
    unsigned voffA[2], voffB[2];
#pragma unroll
    for (int i = 0; i < 2; ++i) { int R, C; stage_rc(tid * 16 + i * 8192, R, C); const int Rb = Epi::PERM ? ((R & ~31) + perm32(R & 31)) : R;
        voffA[i] = (unsigned)(R * K + C) * 2u; voffB[i] = (unsigned)(Rb * K + C) * 2u; }
    const size_t kstep = (size_t)(BK * 2);
    const size_t hstep = (size_t)HALF * K * 2;
    const size_t tstep = 2 * hstep;
    const unsigned ldsw = (unsigned)wid * 1024u;
    const int aoff = lds_byte(wr * 64 + fr, fq * 8), boff = lds_byte(wc * 32 + fr, fq * 8);
#define PG8_SA(b, h) (((b) * 2 + (h)) * HTB)
#define PG8_SB(b, h) ((4 + (b) * 2 + (h)) * HTB)
#define PG8_STAGE(bufoff, gbase, voff) do { _Pragma("unroll") for (int _i = 0; _i < 2; ++_i) \
        __builtin_amdgcn_global_load_lds((const unsigned*)((const char*)(gbase) + (voff)[_i]), (PG8_LAS unsigned*)(lds + (bufoff) + ldsw + _i * 8192), 16, 0, 0); } while (0)
#define PG8_LDA(dst, b, h) do { _Pragma("unroll") for (int m = 0; m < 4; ++m) _Pragma("unroll") for (int k = 0; k < 2; ++k) dst[m][k] = *(const PG8_LAS bf16x8*)(lds + PG8_SA(b, h) + aoff + m * 2048 + k * 1024); } while (0)
#define PG8_LDB(dst, b, h) do { _Pragma("unroll") for (int n = 0; n < 2; ++n) _Pragma("unroll") for (int k = 0; k < 2; ++k) dst[n][k] = *(const PG8_LAS bf16x8*)(lds + PG8_SB(b, h) + boff + n * 2048 + k * 1024); } while (0)
#define PG8_MMA(ai, bj, At, Bt) do { __builtin_amdgcn_s_setprio(1); _Pragma("unroll") for (int m = 0; m < 4; ++m) _Pragma("unroll") for (int n = 0; n < 2; ++n) _Pragma("unroll") for (int k = 0; k < 2; ++k) \
        acc[ai][bj][m][n] = __builtin_amdgcn_mfma_f32_16x16x32_bf16(Bt[n][k], At[m][k], acc[ai][bj][m][n], 0, 0, 0); __builtin_amdgcn_s_setprio(0); } while (0)
#define PG8_WAIT_V(n) asm volatile("s_waitcnt vmcnt(" #n ")" ::: "memory")
#define PG8_WAIT_L(n) asm volatile("s_waitcnt lgkmcnt(" #n ")" ::: "memory")
#define PG8_BAR __builtin_amdgcn_s_barrier()
#define PG8_SCHED __builtin_amdgcn_sched_barrier(0)
    Unit cur, nxt; int ui = 0;
    if (!S.next(0, cur)) return;
    f32x4 acc[2][2][4][2];
#pragma unroll
    for (int a = 0; a < 2; ++a)
#pragma unroll
        for (int b = 0; b < 2; ++b)
#pragma unroll
            for (int m = 0; m < 4; ++m)
#pragma unroll
                for (int n = 0; n < 2; ++n) acc[a][b][m][n] = (f32x4){0.f, 0.f, 0.f, 0.f};
    bf16x8 At[4][2], B0[2][2], B1[2][2];
    const char* cA = (const char*)g.A + (size_t)cur.pm * tstep; const char* cB = (const char*)g.Bt + (size_t)cur.pn * tstep;
    S.a_ready(cur);
    PG8_STAGE(PG8_SB(0, 0), cB, voffB); PG8_STAGE(PG8_SA(0, 0), cA, voffA); PG8_STAGE(PG8_SB(0, 1), cB + hstep, voffB); PG8_STAGE(PG8_SA(0, 1), cA + hstep, voffA);
    if (wr == 1) PG8_BAR;
    PG8_WAIT_V(4); PG8_BAR;
    PG8_STAGE(PG8_SB(1, 0), cB + kstep, voffB); PG8_STAGE(PG8_SA(1, 0), cA + kstep, voffA); PG8_STAGE(PG8_SB(1, 1), cB + hstep + kstep, voffB);
    PG8_WAIT_V(6); PG8_BAR;
    PG8_STAMP();
    for (;;) {
        const bool has_next = S.next(ui + 1, nxt);
        const char* nA = has_next ? (const char*)g.A + (size_t)nxt.pm * tstep : cA; const char* nB = has_next ? (const char*)g.Bt + (size_t)nxt.pn * tstep : cB;
        for (int t = 0; t < nt; t += 2) {
            const bool last = (t == nt - 2);
            const char* a1 = cA + (size_t)(t + 1) * kstep;
            const char* a2 = last ? nA : cA + (size_t)(t + 2) * kstep; const char* b2 = last ? nB : cB + (size_t)(t + 2) * kstep;
            const char* a3 = a2 + kstep; const char* b3 = b2 + kstep;
            if (last && has_next) S.a_ready(nxt);
            PG8_LDB(B0, 0, 0); PG8_SCHED; PG8_LDA(At, 0, 0); PG8_STAGE(PG8_SA(1, 1), a1 + hstep, voffA);
            PG8_WAIT_L(8); PG8_BAR; PG8_WAIT_L(0); PG8_MMA(0, 0, At, B0); PG8_BAR; PG8_SCHED;
            PG8_LDB(B1, 0, 1); PG8_STAGE(PG8_SB(0, 0), b2, voffB);
            PG8_BAR; PG8_WAIT_L(0); PG8_MMA(0, 1, At, B1); PG8_BAR;
            PG8_LDA(At, 0, 1); PG8_STAGE(PG8_SA(0, 0), a2, voffA);
            PG8_BAR; PG8_WAIT_L(0); PG8_MMA(1, 0, At, B0); PG8_BAR; PG8_SCHED;
            PG8_STAGE(PG8_SB(0, 1), b2 + hstep, voffB);
            PG8_WAIT_V(6); PG8_BAR; PG8_MMA(1, 1, At, B1); PG8_BAR;
            PG8_LDB(B0, 1, 0); PG8_SCHED; PG8_LDA(At, 1, 0); PG8_STAGE(PG8_SA(0, 1), a2 + hstep, voffA);
            PG8_WAIT_L(8); PG8_BAR; PG8_WAIT_L(0); PG8_MMA(0, 0, At, B0); PG8_BAR; PG8_SCHED;
            PG8_LDB(B1, 1, 1); PG8_STAGE(PG8_SB(1, 0), b3, voffB);
            PG8_BAR; PG8_WAIT_L(0); PG8_MMA(0, 1, At, B1); PG8_BAR;
            PG8_LDA(At, 1, 1); PG8_STAGE(PG8_SA(1, 0), a3, voffA);
            PG8_BAR; PG8_WAIT_L(0); PG8_MMA(1, 0, At, B0); PG8_BAR; PG8_SCHED;
            PG8_STAGE(PG8_SB(1, 1), b3 + hstep, voffB);
            PG8_WAIT_V(6); PG8_BAR; PG8_MMA(1, 1, At, B1); PG8_BAR;
        }
        PG8_STAMP();
        if constexpr (!Epi::AFTER_DRAIN) { E(acc, cur, wr, wc, fr, fq); S.done(cur); }
        PG8_STAMP();
        if (!has_next) break;
#pragma unroll
        for (int a = 0; a < 2; ++a)
#pragma unroll
            for (int b = 0; b < 2; ++b)
#pragma unroll
                for (int m = 0; m < 4; ++m)
#pragma unroll
                    for (int n = 0; n < 2; ++n) acc[a][b][m][n] = (f32x4){0.f, 0.f, 0.f, 0.f};
        cur = nxt; cA = nA; cB = nB; ++ui;
    }
    PG8_WAIT_V(0);
    if (wr == 0) PG8_BAR;
    PG8_BAR;
    if constexpr (Epi::AFTER_DRAIN) { E.fused(acc, cur, wr, wc, fr, fq, lds, wid, lane); S.done(cur); }
    PG8_STAMP();
    if (STAMP && wid == 0) { stamps[lane] = lane < nts ? (((unsigned long long)(unsigned)ts_hi << 32) | (unsigned)ts_lo) : 0ull;
        if (lane == 62) stamps[62] = rt_entry; if (lane == 63) stamps[63] = (unsigned long long)wall_clock64(); }
#undef PG8_STAMP
#undef PG8_SA
#undef PG8_SB
#undef PG8_STAGE
#undef PG8_LDA
#undef PG8_LDB
#undef PG8_MMA
#undef PG8_WAIT_V
#undef PG8_WAIT_L
#undef PG8_BAR
#undef PG8_SCHED
}
}

#define XB_TMO      128
#define XB_XCNT(j)  (256  + 64 * (j))
#define XB_XSUB(j)  (1280 + 64 * (j))
#define XB_XGEN(j)  (2304 + 64 * (j))
#define XB_TOP      3328
#define XB_TOPGEN   3392
#define XCD_BAR_WORDS 3456
#define XB_SPIN_CAP (1u << 18)
#define LAS __attribute__((address_space(3)))

__device__ __forceinline__ unsigned xb_ld(unsigned* p)              { return __hip_atomic_load(p, __ATOMIC_RELAXED, __HIP_MEMORY_SCOPE_AGENT); }
__device__ __forceinline__ unsigned xb_add(unsigned* p, unsigned v) { return __hip_atomic_fetch_add(p, v, __ATOMIC_RELAXED, __HIP_MEMORY_SCOPE_AGENT); }
__device__ __forceinline__ unsigned xb_xcc_id() { return (unsigned)__builtin_amdgcn_s_getreg((3 << 11) | 20) & 0xFu; }
#define XB_SPIN(cond, bar) do { unsigned _sp = 0; while (cond) { __builtin_amdgcn_s_sleep(1); \
    if ((++_sp & 255u) == 0u) { if (xb_ld(&(bar)[XB_TMO])) break; if (_sp > XB_SPIN_CAP) { atomicAdd(&(bar)[XB_TMO], 1u); break; } } } } while (0)

struct XcdBarrier {
    unsigned* bar; unsigned x;
    volatile LAS unsigned* st;
};

__device__ __forceinline__ XcdBarrier xcd_barrier_post(unsigned* bar, volatile LAS unsigned* st) {
    XcdBarrier b; b.bar = bar; b.x = xb_xcc_id(); b.st = st;
    if (TIDX == 0) (void)xb_add(&bar[XB_XCNT(b.x)], 1u);
    return b;
}
__device__ __forceinline__ void xcd_barrier_complete(unsigned* bar, unsigned x, unsigned& nloc, unsigned& nx) {
    const unsigned G = gridDim.x * gridDim.y * gridDim.z;
    unsigned sum, cnt, mine, sp = 0u;
    for (;;) {
        sum = 0u; cnt = 0u; mine = 0u;
#pragma unroll
        for (unsigned j = 0; j < 16; ++j) { const unsigned c = xb_ld(&bar[XB_XCNT(j)]); sum += c; cnt += (c > 0u) ? 1u : 0u; mine = (j == x) ? c : mine; }
        if (sum == G) break;
        __builtin_amdgcn_s_sleep(1);
        if ((++sp & 255u) == 0u) { if (xb_ld(&bar[XB_TMO])) break; if (sp > XB_SPIN_CAP) { atomicAdd(&bar[XB_TMO], 1u); break; } }
    }
    nloc = mine > 0u ? mine : 1u; nx = cnt > 0u ? cnt : 1u;
}

__device__ __forceinline__ void xcd_barrier(const XcdBarrier& b) {
    asm volatile("s_waitcnt vmcnt(0)" ::: "memory");
    __syncthreads();
    if (TIDX == 0) {
        unsigned* bar = b.bar;
        __builtin_amdgcn_s_waitcnt(0);
        unsigned nloc = b.st[0], nx = b.st[1];
        if (nloc == 0u) { xcd_barrier_complete(bar, b.x, nloc, nx); b.st[0] = nloc; b.st[1] = nx; }
        const unsigned old = xb_add(&bar[XB_XSUB(b.x)], 1u);
        const unsigned gen = old / nloc;
        if (old + 1u == (gen + 1u) * nloc) {
            __builtin_amdgcn_fence(__ATOMIC_RELEASE, "agent");
            asm volatile("s_waitcnt vmcnt(0)" ::: "memory");
            const unsigned og = xb_add(&bar[XB_TOP], 1u);
            const unsigned tg = og / nx;
            if (og + 1u == (tg + 1u) * nx) xb_add(&bar[XB_TOPGEN], 1u);
            else XB_SPIN(xb_ld(&bar[XB_TOPGEN]) == tg, bar);
            __builtin_amdgcn_fence(__ATOMIC_ACQUIRE, "agent");
            xb_add(&bar[XB_XGEN(b.x)], 1u);
            asm volatile("s_waitcnt vmcnt(0)" ::: "memory");
        } else {
            XB_SPIN(xb_ld(&bar[XB_XGEN(b.x)]) == gen, bar);
            __builtin_amdgcn_fence(__ATOMIC_ACQUIRE, "agent");
            asm volatile("s_waitcnt vmcnt(0)" ::: "memory");
        }
    }
    __syncthreads();
}

__device__ void d_cvt(const float* __restrict__ in, bf16_t* __restrict__ out, size_t n4) {
  size_t i = (size_t)blockIdx.x * blockDim.x + TIDX;
  size_t stride = (size_t)gridDim.x * blockDim.x;
  for (; i < n4; i += stride) { float4 v = ((const float4*)in)[i]; ushort4 o; o.x = f2bf(v.x); o.y = f2bf(v.y); o.z = f2bf(v.z); o.w = f2bf(v.w); ((ushort4*)out)[i] = o; }
}
__device__ void d_cvtT(int vb, char* smem, const float* __restrict__ W, bf16_t* __restrict__ WT, int K, int N, int NP) {
  float (*t)[33] = (float (*)[33])smem;
  int nbx = NP / 32;
  int n0 = (vb % nbx) * 32, k0 = (vb / nbx) * 32;
  int tx = (TIDX & 255) & 31, ty = (TIDX & 255) >> 5;
  for (int i = ty; i < 32; i += 8) { int k = k0 + i, n = n0 + tx; t[i][tx] = (n < N && k < K) ? W[(size_t)k * N + n] : 0.f; }
  __syncthreads();
  for (int i = ty; i < 32; i += 8) { int n = n0 + i, k = k0 + tx; if (n < NP && k < K) WT[(size_t)n * K + k] = f2bf(t[tx][i]); }
  __syncthreads();
}

__device__ void d_cvtT64(int vb, char* smem, const float* __restrict__ W, bf16_t* __restrict__ WT, int K, int N, int NP) {
  float (*tt)[65] = (float (*)[65])smem;
  const int tid = (TIDX & 255);
  const int nbx = NP / 64;
  const int n0 = (vb % nbx) * 64, k0 = (vb / nbx) * 64;
  {
    const int kr = tid >> 4, nc = (tid & 15) * 4;
#pragma unroll
    for (int i = 0; i < 4; ++i) {
      const int k = k0 + kr + 16 * i, n = n0 + nc;
      f32x4 v = {0.f, 0.f, 0.f, 0.f};
      if (n < N) v = *(const f32x4*)(W + (size_t)k * N + n);
      tt[kr + 16 * i][nc] = v[0]; tt[kr + 16 * i][nc + 1] = v[1]; tt[kr + 16 * i][nc + 2] = v[2]; tt[kr + 16 * i][nc + 3] = v[3];
    }
  }
  __syncthreads();
  {
    const int nr = tid >> 3, kc = (tid & 7) * 8;
#pragma unroll
    for (int i = 0; i < 2; ++i) {
      const int nl = nr + 32 * i;
      u32x4 o = {pack2(tt[kc][nl], tt[kc + 1][nl]), pack2(tt[kc + 2][nl], tt[kc + 3][nl]), pack2(tt[kc + 4][nl], tt[kc + 5][nl]), pack2(tt[kc + 6][nl], tt[kc + 7][nl])};
      *(u32x4*)(WT + (size_t)(n0 + nl) * K + k0 + kc) = o;
    }
  }
  __syncthreads();
}

constexpr int LDS_LD = 72;
struct EpiProj { bf16_t* proj; float* gates; };
struct EpiF32 { float* C; int ldc; int N; };
struct EpiRes { float* C; const float* X; };


#define ELEMWISE_TILE                                                                              \
  DI void tile(f32x4 (&acc)[4][4], char*, int m0, int n0, int, int wm, int wn, int, int lane) const { \
    _Pragma("unroll") for (int i = 0; i < 4; ++i)                                                  \
    _Pragma("unroll") for (int j = 0; j < 4; ++j)                                                  \
    _Pragma("unroll") for (int r = 0; r < 4; ++r) {                                                \
      int row = m0 + wm * 64 + i * 16 + (lane >> 4) * 4 + r;                                       \
      int col = n0 + wn * 64 + j * 16 + (lane & 15);                                               \
      (*this)(row, col, acc[i][j][r]);                                                             \
    }                                                                                              \
  }
template <class Epi>
__device__ void d_gemm(int vb, char* smem, const bf16_t* __restrict__ A, int lda, const bf16_t* __restrict__ BT, int ldb, int K,
                       int tilesM, Epi epi) {
  bf16_t* As = (bf16_t*)smem;
  bf16_t* Bs = As + 256 * LDS_LD;
  const int tid = TIDX, lane = tid & 63, wid = tid >> 6;
  const int wm = wid >> 1, wn = wid & 1;
  const int tm = vb % tilesM, tn = vb / tilesM;
  const int m0 = tm * 256, n0 = tn * 128;
  f32x4 acc[4][4];
#pragma unroll
  for (int i = 0; i < 4; ++i)
#pragma unroll
    for (int j = 0; j < 4; ++j) acc[i][j] = f32x4{0.f, 0.f, 0.f, 0.f};
  u32x4 ra[4], rb[2];
#define GLOAD(k0_)                                                                  \
  _Pragma("unroll") for (int i = 0; i < 4; ++i) {                                   \
    int c = tid + i * 512; int row = c >> 3, kc = c & 7;                            \
    ra[i] = *(const u32x4*)(A + (size_t)(m0 + row) * lda + (k0_) + kc * 8);         \
  }                                                                                 \
  _Pragma("unroll") for (int i = 0; i < 2; ++i) {                                   \
    int c = tid + i * 512; int row = c >> 3, kc = c & 7;                            \
    rb[i] = *(const u32x4*)(BT + (size_t)(n0 + row) * ldb + (k0_) + kc * 8);        \
  }
  GLOAD(0)
  for (int k0 = 0; k0 < K; k0 += 64) {
    __syncthreads();
#pragma unroll
    for (int i = 0; i < 4; ++i) { int c = tid + i * 512; int row = c >> 3, kc = c & 7; *(u32x4*)(As + row * LDS_LD + kc * 8) = ra[i]; }
#pragma unroll
    for (int i = 0; i < 2; ++i) { int c = tid + i * 512; int row = c >> 3, kc = c & 7; *(u32x4*)(Bs + row * LDS_LD + kc * 8) = rb[i]; }
    __syncthreads();
    if (k0 + 64 < K) { GLOAD(k0 + 64) }
#pragma unroll
    for (int ks = 0; ks < 2; ++ks) {
      bf16x8 a[4], b[4];
#pragma unroll
      for (int i = 0; i < 4; ++i) {
        a[i] = *(const bf16x8*)(As + (wm * 64 + i * 16 + (lane & 15)) * LDS_LD + ks * 32 + (lane >> 4) * 8);
        b[i] = *(const bf16x8*)(Bs + (wn * 64 + i * 16 + (lane & 15)) * LDS_LD + ks * 32 + (lane >> 4) * 8);
      }
#pragma unroll
      for (int i = 0; i < 4; ++i)
#pragma unroll
        for (int j = 0; j < 4; ++j) acc[i][j] = __builtin_amdgcn_mfma_f32_16x16x32_bf16(a[i], b[j], acc[i][j], 0, 0, 0);
    }
  }
  epi.tile(acc, smem, m0, n0, tn, wm, wn, wid, lane);
  __syncthreads();
}
struct EpiProjF {
  bf16_t* proj; float* gates;
  DI void operator()(int row, int col, float v) const {
    if (col < INW) proj[(size_t)row * INWP + col] = f2bf(v);
    if (col >= OFF_G && col < OFF_G + 24) gates[row * 24 + (col - OFF_G)] = 1.f / (1.f + __expf(-v));
  }
  ELEMWISE_TILE
};
struct EpiF32F {
  float* C; int ldc; int N;
  DI void operator()(int row, int col, float v) const { if (col < N) C[(size_t)row * ldc + col] = v; }
  ELEMWISE_TILE
};
struct EpiResF {
  float* C; const float* X;
  DI void operator()(int row, int col, float v) const { C[(size_t)row * DM + col] = ALPHA * X[(size_t)row * DM + col] + v; }
  ELEMWISE_TILE
};

__device__ void d_build_cmp(int row, const bf16_t* __restrict__ proj, int off, const float* __restrict__ pos, bf16_t* __restrict__ Ac) {
  int n = row >> 1, g = row & 1;
  for (int k = (TIDX & 255); k < 4096; k += 256) {
    float v = 0.f;
    if (row < 2046) { int l = k >> 7, d = k & 127; v = bf2f(proj[(size_t)(16 * n + l) * INWP + off + g * 128 + d]) + pos[l * 128 + d]; }
    Ac[(size_t)row * 4096 + k] = f2bf(v);
  }
}
__device__ void d_cmp2(int row, char* smem, const float* __restrict__ hid, const float* __restrict__ b1, const float* __restrict__ w2, float* __restrict__ out) {
  float* a = (float*)smem;
  for (int j = (TIDX & 255); j < 512; j += 256) a[j] = gelu_tanh(hid[(size_t)row * 512 + j] + b1[j]);
  __syncthreads();
  int d = (TIDX & 255) & 127, half = (TIDX & 255) >> 7;
  float s = 0.f;
  for (int j = half * 256; j < half * 256 + 256; ++j) s += a[j] * w2[j * 128 + d];
  float* red = a + 512;
  if (half) red[d] = s;
  __syncthreads();
  if (!half) out[(size_t)row * 128 + d] = s + red[d];
  __syncthreads();
}

using f32x16 = __attribute__((ext_vector_type(16))) float;
using bf16x8v = __attribute__((ext_vector_type(8))) __bf16;
#define MFMA32(a, b, c) __builtin_amdgcn_mfma_f32_32x32x16_bf16((a), (b), (c), 0, 0, 0)
constexpr float LOG2E = 1.4426950408889634f;
constexpr float NEGB = -1e30f;
DI int pi_perm(int i) { return (i & ~12) | ((i & 8) >> 1) | ((i & 4) << 1); }
DI bf16x8 pack8(float a0, float a1, float a2, float a3, float a4, float a5, float a6, float a7) {
  bf16x8v v = {(__bf16)a0, (__bf16)a1, (__bf16)a2, (__bf16)a3, (__bf16)a4, (__bf16)a5, (__bf16)a6, (__bf16)a7};
  return __builtin_bit_cast(bf16x8, v);
}
__device__ void d_relayoutK_bf(size_t c, int NT, const bf16_t* __restrict__ src, int ld, int col0, bf16_t* __restrict__ dst) {
  int lane = c & 63, s = (c >> 6) & 7; size_t tt = c >> 9; int T = tt % NT, g = tt / NT;
  int i = lane & 31, h = lane >> 5;
  int tok = 32 * T + pi_perm(i);
  *(u32x4*)(dst + c * 8) = *(const u32x4*)(src + (size_t)tok * ld + col0 + g * 128 + 16 * s + 8 * h);
}
__device__ void d_relayoutV_bf(size_t c, int NT, const bf16_t* __restrict__ src, int ld, int col0, bf16_t* __restrict__ dst) {
  int lane = c & 63, s2 = (c >> 6) & 1, dt = (c >> 7) & 3; size_t tt = c >> 9; int T = tt % NT, g = tt / NT;
  int dd = lane & 31, h = lane >> 5;
  bf16_t v[8];
#pragma unroll
  for (int j = 0; j < 8; ++j) v[j] = src[(size_t)(32 * T + 16 * s2 + 8 * h + j) * ld + col0 + g * 128 + 32 * dt + dd];
  u32x4 o; o.x = v[0] | ((unsigned)v[1] << 16); o.y = v[2] | ((unsigned)v[3] << 16); o.z = v[4] | ((unsigned)v[5] << 16); o.w = v[6] | ((unsigned)v[7] << 16);
  *(u32x4*)(dst + c * 8) = o;
}
__device__ void d_relayoutK_f32(size_t c, const float* __restrict__ src, bf16_t* __restrict__ dst) {
  int lane = c & 63, s = (c >> 6) & 7; size_t tt = c >> 9; int T = tt % 32, g = tt / 32;
  int i = lane & 31, h = lane >> 5;
  int n = 32 * T + pi_perm(i);
  bf16_t v[8];
#pragma unroll
  for (int j = 0; j < 8; ++j) v[j] = (n < NCMP) ? f2bf(src[((size_t)n * 2 + g) * 128 + 16 * s + 8 * h + j]) : (bf16_t)0;
  u32x4 o; o.x = v[0] | ((unsigned)v[1] << 16); o.y = v[2] | ((unsigned)v[3] << 16); o.z = v[4] | ((unsigned)v[5] << 16); o.w = v[6] | ((unsigned)v[7] << 16);
  *(u32x4*)(dst + c * 8) = o;
}
__device__ void d_relayoutV_f32(size_t c, const float* __restrict__ src, bf16_t* __restrict__ dst) {
  int lane = c & 63, s2 = (c >> 6) & 1, dt = (c >> 7) & 3; size_t tt = c >> 9; int T = tt % 32, g = tt / 32;
  int dd = lane & 31, h = lane >> 5;
  bf16_t v[8];
#pragma unroll
  for (int j = 0; j < 8; ++j) { int n = 32 * T + 16 * s2 + 8 * h + j; v[j] = (n < NCMP) ? f2bf(src[((size_t)n * 2 + g) * 128 + 32 * dt + dd]) : (bf16_t)0; }
  u32x4 o; o.x = v[0] | ((unsigned)v[1] << 16); o.y = v[2] | ((unsigned)v[3] << 16); o.z = v[4] | ((unsigned)v[5] << 16); o.w = v[6] | ((unsigned)v[7] << 16);
  *(u32x4*)(dst + c * 8) = o;
}


__device__ __forceinline__ void d_relayout_tile(int T, char* smem, const bf16_t* __restrict__ proj, int col0, bf16_t* __restrict__ dst, bool isV) {
  bf16_t* Ls = (bf16_t*)smem;
  const int tid = TIDX;
#pragma unroll
  for (int q = 0; q < 2; ++q) {
    const int cidx = tid + q * 512;
    const int g = cidx >> 9, tok = (cidx >> 4) & 31, ch = cidx & 15;
    const u32x4 v = *(const u32x4*)(proj + (size_t)(32 * T + tok) * INWP + col0 + g * 128 + ch * 8);
    *(u32x4*)(Ls + (g * 32 + tok) * 136 + ch * 8) = v;
  }
  __syncthreads();
#pragma unroll
  for (int q = 0; q < 2; ++q) {
    const int oc = tid + q * 512;
    const int g = oc >> 9, r9 = oc & 511, lane = r9 & 63;
    u32x4 o;
    if (!isV) {
      const int s8 = r9 >> 6, i = lane & 31, h = lane >> 5;
      o = *(const u32x4*)(Ls + (g * 32 + pi_perm(i)) * 136 + 16 * s8 + 8 * h);
    } else {
      const int s2 = (r9 >> 6) & 1, dt = r9 >> 7, dd = lane & 31, h = lane >> 5;
      const bf16_t* col = Ls + (g * 32 + 16 * s2 + 8 * h) * 136 + 32 * dt + dd;
      unsigned short e[8];
#pragma unroll
      for (int j = 0; j < 8; ++j) e[j] = col[j * 136];
      o.x = e[0] | ((unsigned)e[1] << 16); o.y = e[2] | ((unsigned)e[3] << 16); o.z = e[4] | ((unsigned)e[5] << 16); o.w = e[6] | ((unsigned)e[7] << 16);
    }
    *(u32x4*)(dst + (((size_t)(g * 512 + T)) * 512 + r9) * 8) = o;
  }
  __syncthreads();
}

struct AttnPtrs {
  const bf16_t* proj; const float* gates;
  const bf16_t *kcf, *vcf, *ksf, *vsf, *kwf, *vwf;
  bf16_t* mix; const float* hng;
};

DI float ex2(float x) { return __builtin_amdgcn_exp2f(x); }
DI void halves(float x, float& lo, float& hi) {
  const unsigned u = __float_as_uint(x);
  auto r = __builtin_amdgcn_permlane32_swap(u, u, false, false);
  lo = __uint_as_float(r[0]); hi = __uint_as_float(r[1]);
}
DI float hmax(float x) { float a, b; halves(x, a, b); return fmaxf(a, b); }
DI float hsum(float x) { float a, b; halves(x, a, b); return a + b; }
DI float dpp_quad(float v, int ctrl_is_xor1) {
  const int iv = __float_as_int(v);
  const int r = ctrl_is_xor1 ? __builtin_amdgcn_update_dpp(iv, iv, 0xB1, 0xF, 0xF, false) : __builtin_amdgcn_update_dpp(iv, iv, 0x4E, 0xF, 0xF, false);
  return __int_as_float(r);
}
DI float quad_sum(float v) { v += dpp_quad(v, 1); v += dpp_quad(v, 0); return v; }
DI void load_k(bf16x8 (&kf)[8], const bf16_t* __restrict__ kt, int lane) {
#pragma unroll
  for (int s = 0; s < 8; ++s) kf[s] = *(const bf16x8*)(kt + s * 512 + lane * 8);
}
DI f32x16 qk_frags(const bf16x8 (&kf)[8], const bf16_t* qL, int lane) {
  f32x16 acc;
#pragma unroll
  for (int i = 0; i < 16; ++i) acc[i] = 0.f;
  const bf16_t* qp = qL + (lane & 31) * 136 + 8 * (lane >> 5);
#pragma unroll
  for (int s = 0; s < 8; ++s) {
    bf16x8 qf = *(const bf16x8*)(qp + 16 * s);
    acc = MFMA32(kf[s], qf, acc);
  }
  return acc;
}
DI void pv_frags(const bf16x8 (&vf)[8], const float (&p)[16], f32x16 (&O)[4]) {
  bf16x8 pf0 = pack8(p[0], p[1], p[2], p[3], p[4], p[5], p[6], p[7]);
  bf16x8 pf1 = pack8(p[8], p[9], p[10], p[11], p[12], p[13], p[14], p[15]);
#pragma unroll
  for (int dt = 0; dt < 4; ++dt) {
    O[dt] = MFMA32(vf[dt * 2], pf0, O[dt]);
    O[dt] = MFMA32(vf[dt * 2 + 1], pf1, O[dt]);
  }
}
DI void osm_step(const float (&sv)[16], float& m, float& l, f32x16 (&O)[4], float (&p)[16]) {
  float tmax = fmaxf(fmaxf(fmaxf(sv[0], sv[1]), fmaxf(sv[2], sv[3])), fmaxf(fmaxf(sv[4], sv[5]), fmaxf(sv[6], sv[7])));
  tmax = fmaxf(tmax, fmaxf(fmaxf(fmaxf(sv[8], sv[9]), fmaxf(sv[10], sv[11])), fmaxf(fmaxf(sv[12], sv[13]), fmaxf(sv[14], sv[15]))));
  tmax = hmax(tmax);
  if (__ballot(tmax - m > 8.f)) {
    const float mn = fmaxf(m, tmax);
    const float alpha = ex2(m - mn);
    l *= alpha; m = mn;
#pragma unroll
    for (int dt = 0; dt < 4; ++dt)
#pragma unroll
      for (int r = 0; r < 16; ++r) O[dt][r] *= alpha;
  }
  float ps0 = 0.f, ps1 = 0.f;
#pragma unroll
  for (int r = 0; r < 16; r += 2) { const float e0 = ex2(sv[r] - m), e1 = ex2(sv[r + 1] - m); p[r] = e0; p[r + 1] = e1; ps0 += e0; ps1 += e1; }
  l += ps0 + ps1;
}
DI void ot_store(char* otL, int lane, const f32x16 (&O)[4], float sc) {
#pragma unroll
  for (int dt = 0; dt < 4; ++dt) {
    u32x4 a, b;
#pragma unroll
    for (int i = 0; i < 4; ++i) { a[i] = pack2(sc * O[dt][2 * i], sc * O[dt][2 * i + 1]); b[i] = pack2(sc * O[dt][8 + 2 * i], sc * O[dt][8 + 2 * i + 1]); }
    *(u32x4*)(otL + lane * 128 + dt * 32) = a;
    *(u32x4*)(otL + lane * 128 + dt * 32 + 16) = b;
  }
}
DI void ot_accum(const char* otL, int lane, f32x16 (&O)[4], float sc) {
#pragma unroll
  for (int dt = 0; dt < 4; ++dt) {
    u32x4 a = *(const u32x4*)(otL + lane * 128 + dt * 32);
    u32x4 b = *(const u32x4*)(otL + lane * 128 + dt * 32 + 16);
#pragma unroll
    for (int i = 0; i < 4; ++i) {
      const unsigned wa = a[i], wb = b[i];
      O[dt][2 * i] = fmaf(sc, O[dt][2 * i], __uint_as_float(wa << 16));
      O[dt][2 * i + 1] = fmaf(sc, O[dt][2 * i + 1], __uint_as_float(wa & 0xFFFF0000u));
      O[dt][8 + 2 * i] = fmaf(sc, O[dt][8 + 2 * i], __uint_as_float(wb << 16));
      O[dt][8 + 2 * i + 1] = fmaf(sc, O[dt][8 + 2 * i + 1], __uint_as_float(wb & 0xFFFF0000u));
    }
  }
}
DI void zero_o(f32x16 (&O)[4]) {
#pragma unroll
  for (int dt = 0; dt < 4; ++dt)
#pragma unroll
    for (int i = 0; i < 16; ++i) O[dt][i] = 0.f;
}

constexpr int ATT_PW = 8704;
constexpr int ATT_R = 4, ATT_D = 3;
constexpr int ATT_RING = 8 * ATT_PW;
constexpr int ATT_LIST = ATT_RING + ATT_R * 16384;
constexpr int ATT_BUNI = ATT_LIST + 2048;
constexpr int ATT_SMEM = ATT_BUNI + 64;
#define LAS3 __attribute__((address_space(3)))
__device__ __forceinline__ void d_select(const float* impL, unsigned* mskL, unsigned* uniL, int cur) {
  const int lane = TIDX & 63;
  const int stok = lane >> 3, sub = lane & 7;
  unsigned key[32];
#pragma unroll
  for (int i4 = 0; i4 < 8; ++i4) {
    f32x4 v = *(const f32x4*)(impL + stok * 256 + sub * 32 + i4 * 4);
#pragma unroll
    for (int e = 0; e < 4; ++e) {
      const int j = sub * 32 + i4 * 4 + e;
      const bool valid = j <= cur;
      const bool forced = (j == 0) || (j == cur) || (j == cur - 1);
      unsigned kb = forced ? 0xFFFFFF00u : (__float_as_uint(v[e]) & 0xFFFFFF00u);
      key[i4 * 4 + e] = valid ? (kb | (unsigned)(255 - j)) : 0u;
    }
  }
#pragma unroll
  for (int k = 2; k <= 32; k <<= 1) {
#pragma unroll
    for (int jj = k >> 1; jj > 0; jj >>= 1) {
#pragma unroll
      for (int i = 0; i < 32; ++i) {
        const int l2 = i ^ jj;
        if (l2 > i) {
          const bool desc = ((i & k) == 0);
          unsigned a = key[i], b = key[l2];
          unsigned mx = a > b ? a : b, mn = a > b ? b : a;
          key[i] = desc ? mx : mn; key[l2] = desc ? mn : mx;
        }
      }
    }
  }
#pragma unroll
  for (int xm = 1; xm < 8; xm <<= 1) {
    unsigned L[16];
#pragma unroll
    for (int i = 0; i < 16; ++i) { unsigned o = (unsigned)shx_i((int)key[15 - i], xm); L[i] = key[i] > o ? key[i] : o; }
#pragma unroll
    for (int jj = 8; jj > 0; jj >>= 1) {
#pragma unroll
      for (int i = 0; i < 16; ++i) {
        const int l2 = i ^ jj;
        if (l2 > i) { unsigned a = L[i], b = L[l2]; L[i] = a > b ? a : b; L[l2] = a > b ? b : a; }
      }
    }
#pragma unroll
    for (int i = 0; i < 16; ++i) key[i] = L[i];
  }
#pragma unroll
  for (int i = 0; i < 16; ++i) {
    if ((i & 7) == sub) {
      const int j = 255 - (int)(key[i] & 255u);
      if (j <= cur) { atomicOr(&mskL[stok * 8 + (j >> 5)], 1u << (j & 31)); atomicOr(&uniL[j >> 5], 1u << (j & 31)); }
    }
  }
}


DI void att_issue(LAS3 unsigned char* ring, int slot, int w, int lane, const bf16_t* kb, const bf16_t* vb, int tile) {
  const char* ks = (const char*)kb + (size_t)tile * 8192 + w * 1024 + lane * 16;
  const char* vs = (const char*)vb + (size_t)tile * 8192 + w * 1024 + lane * 16;
  __builtin_amdgcn_global_load_lds((const unsigned*)ks, (LAS3 unsigned*)(ring + slot * 16384 + w * 1024), 16, 0, 0);
  __builtin_amdgcn_global_load_lds((const unsigned*)vs, (LAS3 unsigned*)(ring + slot * 16384 + 8192 + w * 1024), 16, 0, 0);
}
DI void att_wait(int newer_tiles) {
  if (newer_tiles >= 2) asm volatile("s_waitcnt vmcnt(4)" ::: "memory");
  else if (newer_tiles == 1) asm volatile("s_waitcnt vmcnt(2)" ::: "memory");
  else asm volatile("s_waitcnt vmcnt(0)" ::: "memory");
}
DI f32x16 qk_lds(LAS3 const unsigned char* kt, const bf16x8 (&qf)[8], int lane) {
  f32x16 acc;
#pragma unroll
  for (int i = 0; i < 16; ++i) acc[i] = 0.f;
#pragma unroll
  for (int s8 = 0; s8 < 8; ++s8) {
    const bf16x8 kf = *(LAS3 const bf16x8*)(kt + s8 * 1024 + lane * 16);
    acc = MFMA32(kf, qf[s8], acc);
  }
  return acc;
}
DI void pv_lds(LAS3 const unsigned char* vt, const float (&p)[16], f32x16 (&O)[4], int lane) {
  const bf16x8 pf0 = pack8(p[0], p[1], p[2], p[3], p[4], p[5], p[6], p[7]);
  const bf16x8 pf1 = pack8(p[8], p[9], p[10], p[11], p[12], p[13], p[14], p[15]);
#pragma unroll
  for (int dt = 0; dt < 4; ++dt) {
    const bf16x8 v0 = *(LAS3 const bf16x8*)(vt + (dt * 2) * 1024 + lane * 16);
    const bf16x8 v1 = *(LAS3 const bf16x8*)(vt + (dt * 2 + 1) * 1024 + lane * 16);
    O[dt] = MFMA32(v0, pf0, O[dt]);
    O[dt] = MFMA32(v1, pf1, O[dt]);
  }
}

__device__ __forceinline__ void d_attn_block(int B, int g, char* smem, const AttnPtrs& P) {
  const int tid = TIDX, lane = tid & 63, w = tid >> 6;
  const int c = lane & 31, h = lane >> 5, tokl = c >> 2, r = c & 3;
  const int tok0 = 64 * B + 8 * w;
  const int t = tok0 + tokl, hd = g * 4 + r;
  const float slope2 = exp2f(-(float)(hd + 1)) * LOG2E;
  const float c1 = QSCALE * LOG2E;
  const float ninf = -__builtin_inff();
  char* wsm = smem + w * ATT_PW;
  float* impL = (float*)wsm;
  char* otL = wsm;
  unsigned* mskL = (unsigned*)(wsm + 8192);
  unsigned* uniL = mskL + 64;
  LAS3 unsigned char* ring = (LAS3 unsigned char*)(smem + ATT_RING);
  unsigned short* tl = (unsigned short*)(smem + ATT_LIST);
  unsigned* buni = (unsigned*)(smem + ATT_BUNI);
  const bf16_t* kcf = P.kcf + (size_t)g * 32 * 4096;
  const bf16_t* vcf = P.vcf + (size_t)g * 32 * 4096;
  const bf16_t* ksf = P.ksf + (size_t)g * 512 * 4096;
  const bf16_t* vsf = P.vsf + (size_t)g * 512 * 4096;
  const bf16_t* kwf = P.kwf + (size_t)g * 512 * 4096;
  const bf16_t* vwf = P.vwf + (size_t)g * 512 * 4096;
  bf16x8 qf[8];
  {
    const bf16_t* qrow = P.proj + (size_t)t * INWP + OFF_Q + hd * 128 + 8 * h;
#pragma unroll
    for (int s8 = 0; s8 < 8; ++s8) qf[s8] = *(const bf16x8*)(qrow + 16 * s8);
  }
  const float* gt = P.gates + (size_t)t * 24 + hd * 3;
  const float g0 = gt[0], g1 = gt[1], g2 = gt[2];
  {
    unsigned z0 = 0u;
    asm volatile("" : "+v"(z0));
    u32x4 z = {z0, z0, z0, z0};
#pragma unroll
    for (int i = 0; i < 8; ++i) *(u32x4*)(wsm + (i * 64 + lane) * 16) = z;
    if (lane < 18) *(u32x4*)(wsm + 8192 + lane * 16) = z;
    if (tid < 8) buni[tid] = z0;
  }
  f32x16 Ob[4];
  zero_o(Ob);
  const int nmax = (t >= 31) ? ((t - 31) >> 4) : -1;
  const int nmaxw = (tok0 + 7 >= 31) ? ((tok0 + 7 - 31) >> 4) : -1;
  const int nminw = (tok0 >= 31) ? ((tok0 - 31) >> 4) : -1;
  const int ntcw = (nmaxw + 32) >> 5;
  const int ntcB = (((64 * B + 63 - 31) >> 4) + 32) >> 5;
  const float sl16 = slope2 * 16.f;
  float mC = NEGB, lC = 0.f, invC = 0.f, carry = 0.f;
  {
    const int n = 2 * ntcB;
    asm volatile("s_waitcnt vmcnt(0)" ::: "memory");
#define A_TILE(i_) (((i_) < ntcB) ? (ntcB - 1 - (i_)) : ((i_) - ntcB))
#pragma unroll 1
    for (int j = 0; j < ATT_D && j < n; ++j) att_issue(ring, j, w, lane, kcf, vcf, A_TILE(j));
#pragma unroll 1
    for (int i = 0; i < n; ++i) {
      const int newer = (n - 1 - i < ATT_D - 1) ? (n - 1 - i) : (ATT_D - 1);
      att_wait(newer);
      __builtin_amdgcn_s_barrier();
      asm volatile("" ::: "memory");
      if (i + ATT_D < n) att_issue(ring, (i + ATT_D) % ATT_R, w, lane, kcf, vcf, A_TILE(i + ATT_D));
      const int T = A_TILE(i);
      if (T >= ntcw) continue;
      LAS3 const unsigned char* slot = ring + (i % ATT_R) * 16384;
      const f32x16 acc = qk_lds(slot, qf, lane);
      const float base = slope2 * (float)(512 * T + 128 * h) + slope2 * (15.5f - (float)t);
      const int nb = 32 * T + 8 * h;
      const bool full = (32 * T + 31 <= nminw);
      float sv[16];
#pragma unroll
      for (int rg = 0; rg < 16; ++rg) { const int kk = (rg & 7) + 16 * (rg >> 3); sv[rg] = fmaf(acc[rg], c1, fmaf(sl16, (float)kk, base)); }
      if (!full) {
#pragma unroll
        for (int rg = 0; rg < 16; ++rg) { const int kk = (rg & 7) + 16 * (rg >> 3); sv[rg] = (nb + kk <= nmax) ? sv[rg] : ninf; }
      }
      if (i < ntcB) {
        float tmax = fmaxf(fmaxf(fmaxf(sv[0], sv[1]), fmaxf(sv[2], sv[3])), fmaxf(fmaxf(sv[4], sv[5]), fmaxf(sv[6], sv[7])));
        tmax = fmaxf(tmax, fmaxf(fmaxf(fmaxf(sv[8], sv[9]), fmaxf(sv[10], sv[11])), fmaxf(fmaxf(sv[12], sv[13]), fmaxf(sv[14], sv[15]))));
        tmax = hmax(tmax);
        const float mn = fmaxf(mC, tmax);
        float ps = 0.f;
#pragma unroll
        for (int rg = 0; rg < 16; ++rg) ps += ex2(sv[rg] - mn);
        lC = lC * ex2(mC - mn) + ps; mC = mn;
      } else {
        if (T == 0) { lC = hsum(lC); invC = (lC > 0.f) ? 1.f / lC : 0.f; }
        float p[16];
#pragma unroll
        for (int rg = 0; rg < 16; ++rg) p[rg] = ex2(sv[rg] - mC) * invC;
        float Ga = (p[0] + p[1]) + (p[2] + p[3]), Gb = (p[4] + p[5]) + (p[6] + p[7]);
        float Gc = (p[8] + p[9]) + (p[10] + p[11]), Gd = (p[12] + p[13]) + (p[14] + p[15]);
        float xb, xd; { float a_, b_; halves(p[7], a_, b_); xb = h ? a_ : b_; halves(p[15], a_, b_); xd = h ? a_ : b_; }
        float ia = Ga + (h ? xb : carry);
        float ib = Gb + p[3];
        float ic = Gc + (h ? xd : xb);
        float id = Gd + p[11];
        carry = xd;
        ia = quad_sum(ia); ib = quad_sum(ib); ic = quad_sum(ic); id = quad_sum(id);
        {
          float val = (r == 0) ? ia : (r == 1) ? ib : (r == 2) ? ic : id;
          int j = 8 * T + 2 * h + ((r == 0) ? 0 : (r == 1) ? 1 : (r == 2) ? 4 : 5);
          impL[tokl * 256 + j] = val;
        }
        pv_lds(slot + 8192, p, Ob, lane);
      }
    }
#undef A_TILE
  }
  const int cur = B;
  d_select(impL, mskL, uniL, cur);
  ot_store(otL, lane, Ob, g0);
  zero_o(Ob);
  if (lane < 8) { const unsigned u = uniL[lane]; if (u) atomicOr(&buni[lane], u); }
  __syncthreads();
  int nslc = 0, ntl = 0;
  {
    for (int iw = 7; iw >= 0; --iw) {
      unsigned iuw = __builtin_amdgcn_readfirstlane(buni[iw]);
      while (iuw) {
        const int bit = 31 - __builtin_clz(iuw);
        iuw &= ~(1u << bit);
        const int bb = 32 * iw + bit;
        if (bb < B) { if (lane == 0) tl[ntl] = (unsigned short)(2 * bb + 1); ++ntl; }
        else { if (lane == 0) tl[ntl] = (unsigned short)(2 * bb + 1); ++ntl; }
        if (lane == 0) tl[ntl] = (unsigned short)(2 * bb);
        ++ntl;
      }
    }
    nslc = ntl;
    const int ThiB = 2 * B + 1, TloB = ((64 * B - 511 > 0) ? (64 * B - 511) : 0) >> 5;
    for (int T = ThiB; T >= TloB; --T) { if (lane == 0) tl[ntl] = (unsigned short)T; ++ntl; }
  }
  float m = NEGB, l = 0.f;
  {
    const int n = ntl;
    const int Tlow = ((tok0 - 511 > 0) ? (tok0 - 511) : 0) >> 5, Thiw = (tok0 + 7) >> 5;
#define B_ISSUE(j_, slot_) { const int e_ = __builtin_amdgcn_readfirstlane((int)tl[j_]); if ((j_) < nslc) att_issue(ring, slot_, w, lane, ksf, vsf, e_); else att_issue(ring, slot_, w, lane, kwf, vwf, e_); }
#pragma unroll 1
    for (int j = 0; j < ATT_D && j < n; ++j) B_ISSUE(j, j)
#pragma unroll 1
    for (int i = 0; i < n; ++i) {
      const int newer = (n - 1 - i < ATT_D - 1) ? (n - 1 - i) : (ATT_D - 1);
      att_wait(newer);
      __builtin_amdgcn_s_barrier();
      asm volatile("" ::: "memory");
      if (i + ATT_D < n) B_ISSUE(i + ATT_D, (i + ATT_D) % ATT_R)
      if (i == nslc) {
        l = hsum(l);
        const float inv = (l > 0.f) ? g1 / l : 0.f;
        ot_accum(otL, lane, Ob, inv);
        ot_store(otL, lane, Ob, 1.f);
        zero_o(Ob);
        m = NEGB; l = 0.f;
      }
      const int T = __builtin_amdgcn_readfirstlane((int)tl[i]);
      const int pos0 = 32 * T, pb = pos0 + 8 * h;
      bool full; bool mine = true;
      if (i < nslc) {
        const int bb = T >> 1;
        const unsigned uw = __builtin_amdgcn_readfirstlane(uniL[bb >> 5]);
        if (!((uw >> (bb & 31)) & 1u) || pos0 > tok0 + 7) continue;
        mine = (mskL[tokl * 8 + (bb >> 5)] >> (bb & 31)) & 1u;
        full = (pos0 + 31 <= tok0) && (__ballot(!mine) == 0ull);
      } else {
        if (T < Tlow || T > Thiw) continue;
        full = (pos0 + 31 <= tok0) && (pos0 >= tok0 + 7 - 511);
      }
      LAS3 const unsigned char* slot = ring + (i % ATT_R) * 16384;
      const f32x16 acc = qk_lds(slot, qf, lane);
      const float base = slope2 * (float)(pos0 + 8 * h - t);
      float sv[16], p[16];
#pragma unroll
      for (int rg = 0; rg < 16; ++rg) { const int kk = (rg & 7) + 16 * (rg >> 3); sv[rg] = fmaf(acc[rg], c1, fmaf(slope2, (float)kk, base)); }
      if (!full) {
        if (i < nslc) {
#pragma unroll
          for (int rg = 0; rg < 16; ++rg) { const int kk = (rg & 7) + 16 * (rg >> 3); sv[rg] = (mine && (pb + kk <= t)) ? sv[rg] : ninf; }
        } else {
#pragma unroll
          for (int rg = 0; rg < 16; ++rg) { const int kk = (rg & 7) + 16 * (rg >> 3); const int dw = t - (pb + kk); sv[rg] = ((dw >= 0) && (dw < 512)) ? sv[rg] : ninf; }
        }
      }
      osm_step(sv, m, l, Ob, p);
      pv_lds(slot + 8192, p, Ob, lane);
    }
#undef B_ISSUE
    l = hsum(l);
    const float inv = (l > 0.f) ? g2 / l : 0.f;
    ot_accum(otL, lane, Ob, inv);
  }
  {
    float ss = 0.f;
#pragma unroll
    for (int dt = 0; dt < 4; ++dt)
#pragma unroll
      for (int i = 0; i < 16; ++i) ss = fmaf(Ob[dt][i], Ob[dt][i], ss);
    ss = hsum(ss);
    const float rs = rsqrtf(ss * (1.f / 128.f) + 1e-6f);
    bf16_t* orow = P.mix + (size_t)t * DM + hd * 128 + 4 * h;
    const float* grow = P.hng + hd * 128 + 4 * h;
#pragma unroll
    for (int dt = 0; dt < 4; ++dt)
#pragma unroll
      for (int a = 0; a < 4; ++a) {
        const f32x4 gv = *(const f32x4*)(grow + 32 * dt + 8 * a);
        u32x2 wv2 = {pack2(Ob[dt][4 * a] * rs * gv[0], Ob[dt][4 * a + 1] * rs * gv[1]), pack2(Ob[dt][4 * a + 2] * rs * gv[2], Ob[dt][4 * a + 3] * rs * gv[3])};
        *(u32x2*)(orow + 32 * dt + 8 * a) = wv2;
      }
  }
  asm volatile("s_waitcnt vmcnt(0)" ::: "memory");
  __syncthreads();
}

__device__ void d_convmix(int t, int tl, const bf16_t* __restrict__ proj, const float* __restrict__ convw, const float* __restrict__ hng,
                          bf16_t* __restrict__ mix) {
  const int c = tl * 8;
  float acc[8];
#pragma unroll
  for (int i = 0; i < 8; ++i) acc[i] = 0.f;
#pragma unroll
  for (int j = 0; j < 3; ++j) {
    const int tt = t - 2 + j;
    if (tt >= 0) {
      const u32x4 cu = *(const u32x4*)(proj + (size_t)tt * INWP + OFF_C + c);
      const u32x4 uu = *(const u32x4*)(proj + (size_t)tt * INWP + OFF_U + c);
      const f32x4 w0 = *(const f32x4*)(convw + j * 1024 + c), w1 = *(const f32x4*)(convw + j * 1024 + c + 4);
#pragma unroll
      for (int i = 0; i < 4; ++i) {
        const unsigned a = cu[i], b = uu[i];
        const float wl = (i < 2) ? w0[2 * i] : w1[2 * i - 4], wh = (i < 2) ? w0[2 * i + 1] : w1[2 * i - 3];
        acc[2 * i] = fmaf(wl * __uint_as_float(a << 16), __uint_as_float(b << 16), acc[2 * i]);
        acc[2 * i + 1] = fmaf(wh * __uint_as_float(a & 0xFFFF0000u), __uint_as_float(b & 0xFFFF0000u), acc[2 * i + 1]);
      }
    }
  }
  const u32x4 bb = *(const u32x4*)(proj + (size_t)t * INWP + OFF_B + c);
  float ss = 0.f;
#pragma unroll
  for (int i = 0; i < 4; ++i) {
    const unsigned b = bb[i];
    acc[2 * i] *= __uint_as_float(b << 16); acc[2 * i + 1] *= __uint_as_float(b & 0xFFFF0000u);
    ss = fmaf(acc[2 * i], acc[2 * i], ss); ss = fmaf(acc[2 * i + 1], acc[2 * i + 1], ss);
  }
  ss += shx(ss, 8); ss += shx(ss, 4); ss += shx(ss, 2); ss += shx(ss, 1);
  const float rs = rsqrtf(ss * (1.f / 128.f) + 1e-6f);
  const f32x4 g0 = *(const f32x4*)(hng + 1024 + c), g1 = *(const f32x4*)(hng + 1024 + c + 4);
  u32x4 o = {pack2(acc[0] * rs * g0[0], acc[1] * rs * g0[1]), pack2(acc[2] * rs * g0[2], acc[3] * rs * g0[3]),
             pack2(acc[4] * rs * g1[0], acc[5] * rs * g1[1]), pack2(acc[6] * rs * g1[2], acc[7] * rs * g1[3])};
  *(u32x4*)(mix + (size_t)t * DM + 1024 + c) = o;
}

__device__ void d_ln(int t, char* smem, const float* __restrict__ y, const float* __restrict__ gam, const float* __restrict__ bet,
                     float* __restrict__ stats, bf16_t* __restrict__ hb) {
  float* red = (float*)smem;
  const int tid = (TIDX & 255);
  const f32x4 a = *(const f32x4*)(y + (size_t)t * DM + tid * 8), b = *(const f32x4*)(y + (size_t)t * DM + tid * 8 + 4);
  float s = (a[0] + a[1]) + (a[2] + a[3]) + (b[0] + b[1]) + (b[2] + b[3]);
  s = wave_sum(s); if ((tid & 63) == 0) red[tid >> 6] = s; __syncthreads();
  const float mu = (red[0] + red[1] + red[2] + red[3]) * (1.f / DM);
  float q = 0.f;
#pragma unroll
  for (int i = 0; i < 4; ++i) { const float d0 = a[i] - mu, d1 = b[i] - mu; q = fmaf(d0, d0, q); q = fmaf(d1, d1, q); }
  q = wave_sum(q); if ((tid & 63) == 0) red[4 + (tid >> 6)] = q; __syncthreads();
  const float var = (red[4] + red[5] + red[6] + red[7]) * (1.f / DM);
  const float rs = rsqrtf(var + 1e-5f);
  const f32x4 g0 = *(const f32x4*)(gam + tid * 8), g1 = *(const f32x4*)(gam + tid * 8 + 4);
  const f32x4 b0 = *(const f32x4*)(bet + tid * 8), b1 = *(const f32x4*)(bet + tid * 8 + 4);
  u32x4 o = {pack2((a[0] - mu) * rs * g0[0] + b0[0], (a[1] - mu) * rs * g0[1] + b0[1]), pack2((a[2] - mu) * rs * g0[2] + b0[2], (a[3] - mu) * rs * g0[3] + b0[3]),
             pack2((b[0] - mu) * rs * g1[0] + b1[0], (b[1] - mu) * rs * g1[1] + b1[1]), pack2((b[2] - mu) * rs * g1[2] + b1[2], (b[3] - mu) * rs * g1[3] + b1[3])};
  *(u32x4*)(hb + (size_t)t * DM + tid * 8) = o;
  if (tid == 0) { stats[2 * t] = mu; stats[2 * t + 1] = rs; }
  __syncthreads();
}

__device__ void d_cvt_w1f(size_t c, const float* __restrict__ w1, bf16_t* __restrict__ w1f) {
  const int lane = c & 63, ks = (c >> 6) & 255, ct = c >> 14;
  const int col = lane & 31, h = lane >> 5;
  bf16_t v[8];
#pragma unroll
  for (int j = 0; j < 8; ++j) v[j] = f2bf(w1[(size_t)(16 * ks + 8 * h + j) * 512 + 32 * ct + col]);
  u32x4 o; o.x = v[0] | ((unsigned)v[1] << 16); o.y = v[2] | ((unsigned)v[3] << 16); o.z = v[4] | ((unsigned)v[5] << 16); o.w = v[6] | ((unsigned)v[7] << 16);
  *(u32x4*)(w1f + c * 8) = o;
}
__device__ void d_cvt_w2f(size_t c, const float* __restrict__ w2, bf16_t* __restrict__ w2f) {
  const int lane = c & 63, s = (c >> 6) & 31, ct = c >> 11;
  const int col = lane & 31, h = lane >> 5;
  bf16_t v[8];
#pragma unroll
  for (int j = 0; j < 8; ++j) v[j] = f2bf(w2[(size_t)(16 * s + 8 * h + j) * 128 + 32 * ct + col]);
  u32x4 o; o.x = v[0] | ((unsigned)v[1] << 16); o.y = v[2] | ((unsigned)v[3] << 16); o.z = v[4] | ((unsigned)v[5] << 16); o.w = v[6] | ((unsigned)v[7] << 16);
  *(u32x4*)(w2f + c * 8) = o;
}
__device__ __forceinline__ void d_compress_unit(int rt, char* smem, const bf16_t* __restrict__ proj, int col0, const float* __restrict__ pos,
                                const bf16_t* __restrict__ w1f, const float* __restrict__ b1, const bf16_t* __restrict__ w2f,
                                bf16_t* __restrict__ outf, bool isV) {
  bf16_t* Xs = (bf16_t*)smem;
  bf16_t* Hs = (bf16_t*)(smem + 2 * 8704);
  const int tid = TIDX, lane = tid & 63, w = tid >> 6, c = lane & 31, h = lane >> 5;
  const int R0 = rt * 32;
  const int srow = tid >> 4, sch = tid & 15;
  const int grow = R0 + srow, sn = grow >> 1, sg = grow & 1;
  const bool svalid = grow < 2046;
  const bf16_t* sp = proj + (size_t)(16 * sn) * INWP + col0 + sg * 128 + sch * 8;
  f32x16 acc0, acc1;
#pragma unroll
  for (int i = 0; i < 16; ++i) { acc0[i] = 0.f; acc1[i] = 0.f; }
  u32x4 rx = {0u, 0u, 0u, 0u}; f32x4 rp0, rp1;
#define STAGE_WRITE(buf)                                                                                   \
  {                                                                                                        \
    u32x4 o_;                                                                                              \
    _Pragma("unroll") for (int i = 0; i < 4; ++i) {                                                        \
      const unsigned wv_ = rx[i];                                                                          \
      const float lo = __uint_as_float(wv_ << 16) + ((i < 2) ? rp0[2 * i] : rp1[2 * i - 4]);               \
      const float hi = __uint_as_float(wv_ & 0xFFFF0000u) + ((i < 2) ? rp0[2 * i + 1] : rp1[2 * i - 3]);   \
      o_[i] = pack2(lo, hi);                                                                               \
    }                                                                                                      \
    *(u32x4*)(Xs + (buf) * 4352 + srow * 136 + sch * 8) = o_;                                              \
  }
  if (svalid) rx = *(const u32x4*)(sp);
  rp0 = *(const f32x4*)(pos + sch * 8); rp1 = *(const f32x4*)(pos + sch * 8 + 4);
  STAGE_WRITE(0)
  __syncthreads();
  const bf16_t* wb0 = w1f + ((size_t)(2 * w) * 256 * 64 + lane) * 8;
  const bf16_t* wb1 = w1f + ((size_t)(2 * w + 1) * 256 * 64 + lane) * 8;
#pragma unroll 1
  for (int l = 0; l < 32; ++l) {
    if (l + 1 < 32) {
      if (svalid) rx = *(const u32x4*)(sp + (size_t)(l + 1) * INWP);
      rp0 = *(const f32x4*)(pos + (l + 1) * 128 + sch * 8); rp1 = *(const f32x4*)(pos + (l + 1) * 128 + sch * 8 + 4);
    }
    const bf16_t* xa = Xs + (l & 1) * 4352 + c * 136 + 8 * h;
#pragma unroll
    for (int s8 = 0; s8 < 8; ++s8) {
      const bf16x8 a = *(const bf16x8*)(xa + 16 * s8);
      const bf16x8 b0 = *(const bf16x8*)(wb0 + (size_t)(8 * l + s8) * 512);
      const bf16x8 b1v = *(const bf16x8*)(wb1 + (size_t)(8 * l + s8) * 512);
      acc0 = MFMA32(a, b0, acc0);
      acc1 = MFMA32(a, b1v, acc1);
    }
    if (l + 1 < 32) STAGE_WRITE((l + 1) & 1)
    __syncthreads();
  }
  {
    const float bb0 = b1[64 * w + c], bb1 = b1[64 * w + 32 + c];
#pragma unroll
    for (int rg = 0; rg < 16; ++rg) {
      const int row = (rg & 3) + 8 * (rg >> 2) + 4 * h;
      Hs[row * 520 + 64 * w + c] = f2bf(gelu_tanh(acc0[rg] + bb0));
      Hs[row * 520 + 64 * w + 32 + c] = f2bf(gelu_tanh(acc1[rg] + bb1));
    }
  }
  __syncthreads();
  if (w < 4) {
    f32x16 o2;
#pragma unroll
    for (int i = 0; i < 16; ++i) o2[i] = 0.f;
    const bf16_t* ha = Hs + c * 520 + 8 * h;
    const bf16_t* wb = w2f + ((size_t)w * 32 * 64 + lane) * 8;
#pragma unroll 8
    for (int s2 = 0; s2 < 32; ++s2) {
      const bf16x8 a = *(const bf16x8*)(ha + 16 * s2);
      const bf16x8 b = *(const bf16x8*)(wb + (size_t)s2 * 512);
      o2 = MFMA32(a, b, o2);
    }
    const int d = 32 * w + c;
#pragma unroll
    for (int rg = 0; rg < 16; ++rg) {
      const int row = R0 + (rg & 3) + 8 * (rg >> 2) + 4 * h;
      const int n = row >> 1, g = row & 1;
      const bf16_t val = (row < 2046) ? f2bf(o2[rg]) : (bf16_t)0;
      const int T = n >> 5, nn = n & 31;
      size_t idx;
      if (!isV) idx = ((((size_t)(g * 32 + T) * 8 + (d >> 4)) * 64 + (pi_perm(nn) + 32 * ((d >> 3) & 1))) * 8 + (d & 7));
      else idx = (((((size_t)(g * 32 + T) * 4 + (d >> 5)) * 2 + (nn >> 4)) * 64 + ((d & 31) + 32 * ((nn >> 3) & 1))) * 8 + (nn & 7));
      outf[idx] = val;
    }
  }
  __syncthreads();
}


DI unsigned f2sort(float f) { unsigned u = __float_as_uint(f); return u ^ ((unsigned)((int)u >> 31) | 0x80000000u); }
DI float sort2f(unsigned k) { unsigned u = (k & 0x80000000u) ? (k ^ 0x80000000u) : ~k; return __uint_as_float(u); }
template <int N>
DI void bitonic_sort_desc(unsigned (&key)[N]) {
#pragma unroll
  for (int k = 2; k <= N; k <<= 1) {
#pragma unroll
    for (int jj = k >> 1; jj > 0; jj >>= 1) {
#pragma unroll
      for (int i = 0; i < N; ++i) {
        const int l2 = i ^ jj;
        if (l2 > i) {
          const bool desc = ((i & k) == 0);
          unsigned a = key[i], b = key[l2];
          unsigned mx = a > b ? a : b, mn = a > b ? b : a;
          key[i] = desc ? mx : mn; key[l2] = desc ? mn : mx;
        }
      }
    }
  }
}
DI void merge_top16(unsigned (&a)[16], const unsigned (&b)[16]) {
#pragma unroll
  for (int i = 0; i < 16; ++i) { unsigned o = b[15 - i]; a[i] = a[i] > o ? a[i] : o; }
#pragma unroll
  for (int jj = 8; jj > 0; jj >>= 1) {
#pragma unroll
    for (int i = 0; i < 16; ++i) {
      const int l2 = i ^ jj;
      if (l2 > i) { unsigned x = a[i], y = a[l2]; a[i] = x > y ? x : y; a[l2] = x > y ? y : x; }
    }
  }
}
__device__ void d_cvt_subk(size_t c, const float* __restrict__ subk, bf16_t* __restrict__ skf) {
  int lane = c & 63, s = (c >> 6) & 7, kt = (c >> 9) & 3, hc = c >> 11;
  int i = lane & 31, h = lane >> 5;
  const float* src = subk + ((size_t)hc * 128 + 32 * kt + i) * 128 + 16 * s + 8 * h;
  bf16_t v[8];
#pragma unroll
  for (int j = 0; j < 8; ++j) v[j] = f2bf(src[j]);
  u32x4 o; o.x = v[0] | ((unsigned)v[1] << 16); o.y = v[2] | ((unsigned)v[3] << 16); o.z = v[4] | ((unsigned)v[5] << 16); o.w = v[6] | ((unsigned)v[7] << 16);
  *(u32x4*)(skf + c * 8) = o;
}

struct EpiProjG {
  static constexpr bool PERM = true, AFTER_DRAIN = false;
  bf16_t* proj; float* gates;
  DI void operator()(const f32x4 (&acc)[2][2][4][2], const pg8::Unit& u, int wr, int wc, int fr, int fq) const {
#pragma unroll
    for (int ai = 0; ai < 2; ++ai)
#pragma unroll
      for (int m = 0; m < 4; ++m) {
        const int row = u.pm * 256 + ai * 128 + wr * 64 + m * 16 + fr;
#pragma unroll
        for (int bj = 0; bj < 2; ++bj) {
          const int c0 = u.pn * 256 + bj * 128 + wc * 32 + 8 * fq;
          const f32x4 v0 = acc[ai][bj][m][0], v1 = acc[ai][bj][m][1];
          if (c0 < INW) {
            u32x4 w = {pack2(v0[0], v0[1]), pack2(v0[2], v0[3]), pack2(v1[0], v1[1]), pack2(v1[2], v1[3])};
            *(u32x4*)(proj + (size_t)row * INWP + c0) = w;
          }
          if (c0 >= OFF_G && c0 < OFF_G + 24) {
            f32x4 g0, g1;
#pragma unroll
            for (int j = 0; j < 4; ++j) { g0[j] = 1.f / (1.f + __expf(-v0[j])); g1[j] = 1.f / (1.f + __expf(-v1[j])); }
            *(f32x4*)(gates + (size_t)row * 24 + (c0 - OFF_G)) = g0;
            *(f32x4*)(gates + (size_t)row * 24 + (c0 - OFF_G) + 4) = g1;
          }
        }
      }
  }
};
struct EpiResG {
  static constexpr bool PERM = false, AFTER_DRAIN = false;
  float* Y; const float* X;
  DI void operator()(const f32x4 (&acc)[2][2][4][2], const pg8::Unit& u, int wr, int wc, int fr, int fq) const {
#pragma unroll
    for (int ai = 0; ai < 2; ++ai)
#pragma unroll
      for (int m = 0; m < 4; ++m) {
        const size_t ro = (size_t)(u.pm * 256 + ai * 128 + wr * 64 + m * 16 + fr) * DM + u.pn * 256 + wc * 32 + 4 * fq;
#pragma unroll
        for (int bj = 0; bj < 2; ++bj)
#pragma unroll
          for (int n = 0; n < 2; ++n) {
            const f32x4 xv = *(const f32x4*)(X + ro + bj * 128 + n * 16);
            *(f32x4*)(Y + ro + bj * 128 + n * 16) = ALPHA * xv + acc[ai][bj][m][n];
          }
      }
  }
};
struct EpiF32G {
  static constexpr bool PERM = false, AFTER_DRAIN = false;
  float* C; int ldc;
  DI void operator()(const f32x4 (&acc)[2][2][4][2], const pg8::Unit& u, int wr, int wc, int fr, int fq) const {
#pragma unroll
    for (int ai = 0; ai < 2; ++ai)
#pragma unroll
      for (int m = 0; m < 4; ++m) {
        const size_t ro = (size_t)(u.pm * 256 + ai * 128 + wr * 64 + m * 16 + fr) * ldc + u.pn * 256 + wc * 32 + 4 * fq;
#pragma unroll
        for (int bj = 0; bj < 2; ++bj)
#pragma unroll
          for (int n = 0; n < 2; ++n) *(f32x4*)(C + ro + bj * 128 + n * 16) = acc[ai][bj][m][n];
      }
  }
};
struct EpiRouteG {
  static constexpr bool PERM = false, AFTER_DRAIN = true;
  const bf16_t* skf; unsigned* tops;
  DI void operator()(const f32x4 (&)[2][2][4][2], const pg8::Unit&, int, int, int, int) const {}
  DI void fused(const f32x4 (&acc)[2][2][4][2], const pg8::Unit& u, int wr, int wc, int fr, int fq, PG8_LAS unsigned char* ldsp, int, int) const {
    const int lane = fr | (fq << 4), wid = wr * 4 + wc;
    bf16_t* Qs = (bf16_t*)ldsp;
#pragma unroll
    for (int ai = 0; ai < 2; ++ai)
#pragma unroll
      for (int m = 0; m < 4; ++m) {
        const int row = ai * 128 + wr * 64 + m * 16 + fr;
#pragma unroll
        for (int bj = 0; bj < 2; ++bj)
#pragma unroll
          for (int n = 0; n < 2; ++n) {
            const f32x4 v = acc[ai][bj][m][n];
            u32x2 w = {pack2(v[0], v[1]), pack2(v[2], v[3])};
            *(u32x2*)(Qs + row * 264 + bj * 128 + wc * 32 + n * 16 + 4 * fq) = w;
          }
      }
    __syncthreads();
    const int c = lane & 31, h = lane >> 5;
#pragma unroll 1
    for (int half = 0; half < 2; ++half) {
      const int hc = u.pn * 2 + half;
      const bf16_t* sk = skf + (size_t)hc * 4 * 4096;
      const bf16_t* qp = Qs + (wid * 32 + c) * 264 + half * 128 + 8 * h;
      unsigned k0[16], k1[16];
#define ROUTE_KT(KT, KA)                                                                        \
      {                                                                                         \
        f32x16 sc;                                                                              \
        _Pragma("unroll") for (int i = 0; i < 16; ++i) sc[i] = 0.f;                             \
        _Pragma("unroll") for (int s = 0; s < 8; ++s) {                                         \
          bf16x8 af = *(const bf16x8*)(sk + (KT) * 4096 + s * 512 + lane * 8);                  \
          bf16x8 bq = *(const bf16x8*)(qp + 16 * s);                                            \
          sc = __builtin_amdgcn_mfma_f32_32x32x16_bf16(af, bq, sc, 0, 0, 0);                    \
        }                                                                                       \
        _Pragma("unroll") for (int rg = 0; rg < 16; ++rg) {                                     \
          const int kidx = 32 * (KT) + (rg & 3) + 8 * (rg >> 2) + 4 * h;                        \
          KA[rg] = (f2sort(sc[rg]) & 0xFFFFFF80u) | (unsigned)(127 - kidx);                     \
        }                                                                                       \
        bitonic_sort_desc<16>(KA);                                                              \
      }
      ROUTE_KT(0, k0)
      __builtin_amdgcn_sched_barrier(0);
      ROUTE_KT(1, k1)
      merge_top16(k0, k1);
      __builtin_amdgcn_sched_barrier(0);
      ROUTE_KT(2, k1)
      merge_top16(k0, k1);
      __builtin_amdgcn_sched_barrier(0);
      ROUTE_KT(3, k1)
      merge_top16(k0, k1);
      __builtin_amdgcn_sched_barrier(0);
#undef ROUTE_KT
#pragma unroll
      for (int i = 0; i < 16; ++i) k1[i] = (unsigned)shx_i((int)k0[i], 32);
      merge_top16(k0, k1);
      if (h == 0) {
        unsigned* dst = tops + ((size_t)(u.pm * 256 + wid * 32 + c) * 16 + hc) * 16;
#pragma unroll
        for (int q4 = 0; q4 < 4; ++q4) { u32x4 o = {k0[4 * q4], k0[4 * q4 + 1], k0[4 * q4 + 2], k0[4 * q4 + 3]}; *(u32x4*)(dst + 4 * q4) = o; }
      }
    }
    __syncthreads();
  }
};


template <int CTRL> DI float dpp_f(float v) { const int iv = __float_as_int(v); return __int_as_float(__builtin_amdgcn_update_dpp(iv, iv, CTRL, 0xF, 0xF, false)); }
DI float wsum(float x) {
  x += dpp_f<0xB1>(x);
  x += dpp_f<0x4E>(x);
  x += dpp_f<0x124>(x);
  x += dpp_f<0x128>(x);
  x += shx(x, 16);
  return hsum(x);
}
DI float gelu_fast(float x) {
  const float u2 = 1.5957691216057308f * (x + 0.044715f * x * x * x);
  return x * __builtin_amdgcn_rcpf(1.f + ex2(-LOG2E * u2));
}

constexpr int EROW = 1152;
typedef float v2f __attribute__((ext_vector_type(2)));
__device__ void d_cvt_fp4_row(int row, const float* __restrict__ src, unsigned char* __restrict__ dst) {
  const int lane = TIDX & 63;
  float v[32]; float amax = 0.f;
#pragma unroll
  for (int i = 0; i < 8; ++i) {
    f32x4 x = *(const f32x4*)(src + (size_t)row * DM + 256 * i + 4 * lane);
#pragma unroll
    for (int j = 0; j < 4; ++j) { v[i * 4 + j] = x[j]; amax = fmaxf(amax, fabsf(x[j])); }
  }
  const float sc = amax > 0.f ? amax * (1.f / 6.f) : 1.f;
  const float scb = bf2f(f2bf(sc));
  const float inv = 1.f / scb;
  u32x4 o;
#pragma unroll
  for (int k = 0; k < 4; ++k) {
    unsigned w = 0u;
#define FP4C(x_) fminf(fmaxf((x_) * inv, -6.f), 6.f)
    w = __builtin_amdgcn_cvt_scalef32_pk_fp4_f32(w, FP4C(v[8 * k + 0]), FP4C(v[8 * k + 1]), 1.0f, 0);
    w = __builtin_amdgcn_cvt_scalef32_pk_fp4_f32(w, FP4C(v[8 * k + 2]), FP4C(v[8 * k + 3]), 1.0f, 1);
    w = __builtin_amdgcn_cvt_scalef32_pk_fp4_f32(w, FP4C(v[8 * k + 4]), FP4C(v[8 * k + 5]), 1.0f, 2);
    w = __builtin_amdgcn_cvt_scalef32_pk_fp4_f32(w, FP4C(v[8 * k + 6]), FP4C(v[8 * k + 7]), 1.0f, 3);
#undef FP4C
    o[k] = w;
  }
  *(u32x4*)(dst + (size_t)row * EROW + 16 * lane) = o;
  *(bf16_t*)(dst + (size_t)row * EROW + 1024 + 2 * lane) = f2bf(sc);
}
__device__ void d_expert_wave(int t, unsigned* tpl, const float* __restrict__ yf, const float* __restrict__ stats, const float* __restrict__ g1v, const float* __restrict__ b1v,
                              const unsigned* __restrict__ tops, const unsigned char* __restrict__ eu4, const unsigned char* __restrict__ ev4,
                              const float* __restrict__ gam, const float* __restrict__ bet, float* __restrict__ out) {
  const int lane = TIDX & 63;
  const float mu1 = stats[2 * t], rs1 = stats[2 * t + 1];
  float hv[32];
#pragma unroll
  for (int i = 0; i < 8; ++i) {
    const int cb = 256 * i + 4 * lane;
    const f32x4 x = *(const f32x4*)(yf + (size_t)t * DM + cb), gg = *(const f32x4*)(g1v + cb), bb = *(const f32x4*)(b1v + cb);
#pragma unroll
    for (int j = 0; j < 4; ++j) hv[i * 4 + j] = (x[j] - mu1) * rs1 * gg[j] + bb[j];
  }
  int e0 = 0, e1 = 0; float w0 = 0.f, w1 = 0.f;
  {
    const int ci = (lane < 16) ? 0 : (lane < 24) ? 1 : (lane < 29) ? 2 : (lane < 33) ? 3 : (lane < 36) ? 4 : (lane < 38) ? 5 : (lane < 40) ? 6
                   : (lane < 42) ? 7 : (lane - 34);
    const int cpre = (ci == 0) ? 0 : (ci == 1) ? 16 : (ci == 2) ? 24 : (ci == 3) ? 29 : (ci == 4) ? 33 : (ci == 5) ? 36 : (ci == 6) ? 38
                     : (ci == 7) ? 40 : (34 + ci);
    const int cj = lane - cpre;
    const bool cvalid = lane < 50;
    *(u32x4*)(tpl + 4 * lane) = *(const u32x4*)(tops + (size_t)t * 256 + 4 * lane);
    const unsigned* tp = tpl;
#pragma unroll 1
    for (int hh = 0; hh < 8; ++hh) {
      unsigned key = 0u;
      if (cvalid) {
        const float sa = sort2f(tp[(2 * hh) * 16 + ci]), sb = sort2f(tp[(2 * hh + 1) * 16 + cj]);
        key = (f2sort(sa + sb) & 0xFFFFFF00u) | (unsigned)(255 - (ci * 16 + cj));
      }
#pragma unroll
      for (int k = 2; k <= 64; k <<= 1) {
#pragma unroll
        for (int jj = k >> 1; jj > 0; jj >>= 1) {
          const unsigned o = (unsigned)shx_i((int)key, jj);
          const bool lower = (lane & jj) == 0;
          const bool desc = (lane & k) == 0 || k == 64;
          const unsigned mx = key > o ? key : o, mn = key > o ? o : key;
          key = (lower == desc) ? mx : mn;
        }
      }
      const int flat = 255 - (int)(key & 255u);
      const int bi = (flat >> 4) & 15, bj = flat & 15;
      const unsigned ka = tp[(2 * hh) * 16 + bi], kb = tp[(2 * hh + 1) * 16 + bj];
      const float sc = sort2f(ka) + sort2f(kb);
      const int ex = (127 - (int)(ka & 127u)) * 128 + (127 - (int)(kb & 127u));
      float mx = sc;
      mx = fmaxf(mx, shx(mx, 1)); mx = fmaxf(mx, shx(mx, 2)); mx = fmaxf(mx, shx(mx, 4)); mx = fmaxf(mx, shx(mx, 8));
      const float ev_ = __expf(sc - mx);
      float sm = ev_;
      sm += shx(sm, 1); sm += shx(sm, 2); sm += shx(sm, 4); sm += shx(sm, 8);
      const float gv = ev_ / sm;
      const int exs = __shfl(ex, lane & 15); const float gvs = __shfl(gv, lane & 15);
      if ((lane >> 4) == (hh & 3)) { if (hh < 4) { e0 = exs; w0 = gvs; } else { e1 = exs; w1 = gvs; } }
    }
  }
  bf16x2v hb2[16];
#pragma unroll
  for (int i = 0; i < 16; ++i) hb2[i] = bf16x2v{(__bf16)hv[2 * i], (__bf16)hv[2 * i + 1]};
  float c0 = 0.f, c1 = 0.f;
  u32x4 rA[4], rB[4]; unsigned short sA[4], sB[4];
#define EX_LOAD(R, SS, TAB, EB)                                                            \
  _Pragma("unroll") for (int k = 0; k < 4; ++k) {                                          \
    const int e = (EB) + k;                                                                \
    const int id = __builtin_amdgcn_readlane((e < 64) ? e0 : e1, e & 63);                 \
    const unsigned char* row = (TAB) + (size_t)id * EROW;                                  \
    R[k] = *(const u32x4*)(row + 16 * lane);                                               \
    SS[k] = *(const unsigned short*)(row + 1024 + 2 * lane);                               \
  }
#define PKFMA(a_, b_, c_) __builtin_elementwise_fma((a_), (b_), (c_))
#define EX_COMP_U(R, SS, EB)                                                               \
  {                                                                                        \
    float dd[4];                                                                           \
    _Pragma("unroll") for (int k = 0; k < 4; ++k) {                                        \
      float d0 = 0.f, d1 = 0.f;                                                            \
      _Pragma("unroll") for (int q = 0; q < 4; ++q) {                                      \
        const unsigned wq = R[k][q];                                                       \
        d0 = __builtin_amdgcn_fdot2_f32_bf16(__builtin_amdgcn_cvt_scalef32_pk_bf16_fp4(wq, 1.0f, 0), hb2[4 * q + 0], d0, false); \
        d1 = __builtin_amdgcn_fdot2_f32_bf16(__builtin_amdgcn_cvt_scalef32_pk_bf16_fp4(wq, 1.0f, 1), hb2[4 * q + 1], d1, false); \
        d0 = __builtin_amdgcn_fdot2_f32_bf16(__builtin_amdgcn_cvt_scalef32_pk_bf16_fp4(wq, 1.0f, 2), hb2[4 * q + 2], d0, false); \
        d1 = __builtin_amdgcn_fdot2_f32_bf16(__builtin_amdgcn_cvt_scalef32_pk_bf16_fp4(wq, 1.0f, 3), hb2[4 * q + 3], d1, false); \
      }                                                                                    \
      dd[k] = bf2f(SS[k]) * (d0 + d1);                                                     \
      __builtin_amdgcn_sched_barrier(0);                                                   \
    }                                                                                      \
    _Pragma("unroll") for (int k = 0; k < 4; ++k) dd[k] = wsum(dd[k]);                     \
    _Pragma("unroll") for (int k = 0; k < 4; ++k) {                                        \
      const int e = (EB) + k;                                                              \
      const float gl = gelu_fast(dd[k]);                                                   \
      if (e < 64) { if (lane == e) c0 = w0 * gl; } else { if (lane == e - 64) c1 = w1 * gl; } \
    }                                                                                      \
    __builtin_amdgcn_sched_barrier(0);                                                     \
  }
#define EX_COMP_V(R, SS, EB)                                                               \
  _Pragma("unroll") for (int k = 0; k < 4; ++k) {                                          \
    const int e = (EB) + k;                                                                \
    const float cs = __int_as_float(__builtin_amdgcn_readlane(__float_as_int((e < 64) ? c0 : c1), e & 63)) * bf2f(SS[k]);                     \
    const v2f cs2 = {cs, cs};                                                              \
    _Pragma("unroll") for (int q = 0; q < 4; ++q) {                                        \
      const unsigned wq = R[k][q];                                                         \
      const v2f f0 = __builtin_amdgcn_cvt_scalef32_pk_f32_fp4(wq, 1.0f, 0), f1 = __builtin_amdgcn_cvt_scalef32_pk_f32_fp4(wq, 1.0f, 1); \
      const v2f f2 = __builtin_amdgcn_cvt_scalef32_pk_f32_fp4(wq, 1.0f, 2), f3 = __builtin_amdgcn_cvt_scalef32_pk_f32_fp4(wq, 1.0f, 3); \
      acc2[4 * q + 0] = PKFMA(cs2, f0, acc2[4 * q + 0]); acc2[4 * q + 1] = PKFMA(cs2, f1, acc2[4 * q + 1]); \
      acc2[4 * q + 2] = PKFMA(cs2, f2, acc2[4 * q + 2]); acc2[4 * q + 3] = PKFMA(cs2, f3, acc2[4 * q + 3]); \
    }                                                                                      \
    __builtin_amdgcn_sched_barrier(0);                                                     \
  }
  EX_LOAD(rA, sA, eu4, 0)
  __builtin_amdgcn_sched_barrier(0);
#pragma unroll 1
  for (int eb = 0; eb < 128; eb += 8) {
    EX_LOAD(rB, sB, eu4, eb + 4)
    __builtin_amdgcn_sched_barrier(0);
    EX_COMP_U(rA, sA, eb)
    { const bool more = eb + 8 < 128; const unsigned char* tabn = more ? eu4 : ev4; const int ebn = more ? eb + 8 : 0;
      EX_LOAD(rA, sA, tabn, ebn) }
    __builtin_amdgcn_sched_barrier(0);
    EX_COMP_U(rB, sB, eb + 4)
  }
  v2f acc2[16];
#pragma unroll
  for (int i = 0; i < 16; ++i) acc2[i] = v2f{0.f, 0.f};
#pragma unroll 1
  for (int eb = 0; eb < 128; eb += 8) {
    EX_LOAD(rB, sB, ev4, eb + 4)
    __builtin_amdgcn_sched_barrier(0);
    EX_COMP_V(rA, sA, eb)
    { const int ebn = (eb + 8 < 128) ? eb + 8 : 0;
      EX_LOAD(rA, sA, ev4, ebn) }
    __builtin_amdgcn_sched_barrier(0);
    EX_COMP_V(rB, sB, eb + 4)
  }
#undef EX_LOAD
#undef EX_COMP_U
#undef EX_COMP_V
#undef PKFMA
  float acc[32];
#pragma unroll
  for (int i = 0; i < 16; ++i) { acc[2 * i] = acc2[i].x; acc[2 * i + 1] = acc2[i].y; }
  int le = lane;
  asm volatile("" : "+v"(le) :: "memory");
  float s = 0.f;
#pragma unroll
  for (int i = 0; i < 8; ++i) {
    const int cb = 256 * i + 4 * le;
    const f32x4 x = *(const f32x4*)(yf + (size_t)t * DM + cb), gg = *(const f32x4*)(g1v + cb), bb = *(const f32x4*)(b1v + cb);
#pragma unroll
    for (int j = 0; j < 4; ++j) { const float hj = (x[j] - mu1) * rs1 * gg[j] + bb[j]; acc[i * 4 + j] = fmaf(ALPHA, hj, acc[i * 4 + j]); s += acc[i * 4 + j]; }
  }
  s = wsum(s);
  const float mu = s * (1.f / DM);
  float qv = 0.f;
#pragma unroll
  for (int i = 0; i < 32; ++i) { const float d = acc[i] - mu; qv += d * d; }
  qv = wsum(qv);
  const float rs = rsqrtf(qv * (1.f / DM) + 1e-5f);
#pragma unroll
  for (int i = 0; i < 8; ++i) {
    const int cbase = 256 * i + 4 * le;
    f32x4 ga = *(const f32x4*)(gam + cbase), ba = *(const f32x4*)(bet + cbase), o;
#pragma unroll
    for (int j = 0; j < 4; ++j) o[j] = (acc[i * 4 + j] - mu) * rs * ga[j] + ba[j];
    *(f32x4*)(out + (size_t)t * DM + cbase) = o;
  }
}

constexpr size_t al256(size_t x) { return (x + 255) & ~(size_t)255; }
constexpr size_t WS_XB = 0;
constexpr size_t WS_PROJ = WS_XB + al256((size_t)S * DM * 2);
constexpr size_t WS_WINT = WS_PROJ + al256((size_t)S * INWP * 2);
constexpr size_t WS_GATES = WS_WINT + al256((size_t)INWG * DM * 2);
constexpr size_t WS_W1KF = WS_GATES + al256((size_t)S * 24 * 4);
constexpr size_t WS_W1VF = WS_W1KF + al256((size_t)512 * 4096 * 2);
constexpr size_t WS_W2KF = WS_W1VF + al256((size_t)512 * 4096 * 2);
constexpr size_t WS_W2VF = WS_W2KF + al256((size_t)512 * 128 * 2);
constexpr size_t WS_VC = WS_W2VF + al256((size_t)512 * 128 * 2) - al256((size_t)2048 * 128 * 4);
constexpr size_t WS_KCF = WS_VC + al256((size_t)2048 * 128 * 4);
constexpr size_t WS_VCF = WS_KCF + al256((size_t)2 * 32 * 4096 * 2);
constexpr size_t WS_KSF = WS_VCF + al256((size_t)2 * 32 * 4096 * 2);
constexpr size_t WS_VSF = WS_KSF + al256((size_t)2 * 512 * 4096 * 2);
constexpr size_t WS_KWF = WS_VSF + al256((size_t)2 * 512 * 4096 * 2);
constexpr size_t WS_VWF = WS_KWF + al256((size_t)2 * 512 * 4096 * 2);
constexpr size_t WS_ENDA = WS_VWF + al256((size_t)2 * 512 * 4096 * 2);
constexpr size_t WS_OATT = WS_ENDA;
constexpr size_t WS_MIX = WS_OATT + al256((size_t)S * 1024 * 4);
constexpr size_t WS_WOUTT = WS_MIX + al256((size_t)S * DM * 2);
constexpr size_t WS_WQT = WS_WOUTT + al256((size_t)DM * DM * 2);
constexpr size_t WS_TOPS = WS_WQT + al256((size_t)DM * DM * 2);
constexpr size_t WS_SKF = WS_TOPS + al256((size_t)S * 256 * 4);
constexpr size_t WS_STATS = WS_SKF + al256((size_t)16 * 128 * 128 * 2);
constexpr size_t WS_CTRL = WS_STATS + al256((size_t)S * 2 * 4);
constexpr size_t CTRL_BYTES = 32768;
constexpr size_t WS_END = WS_CTRL + CTRL_BYTES;
constexpr size_t WS_Y = WS_PROJ;
constexpr size_t WS_HB = WS_XB;
constexpr size_t WS_EU8 = WS_Y + (size_t)S * DM * 4;
constexpr size_t WS_EV8 = WS_EU8 + (size_t)16384 * 1152;
static_assert(WS_EV8 + (size_t)16384 * 1152 <= WS_ENDA, "expert overlay overflows group A");
static_assert(WS_END <= (size_t)512 * 1024 * 1024, "workspace over 512 MiB");

struct Params {
  const float *x, *w_in, *ck_pos, *ck_w1, *ck_b1, *ck_w2, *cv_pos, *cv_w1, *cv_b1, *cv_w2, *conv_w, *hng, *w_out, *ln1g, *ln1b, *w_query, *subk,
      *eu, *ev, *ln2g, *ln2b;
  float* out;
  char* ws;
};
#define WSP(T, OFF) ((T*)(p.ws + (OFF)))

#define FOR_VB(n) for (int vb = blockIdx.x; vb < (n); vb += gridDim.x)
#define FOR_VB2(n) for (int vb = blockIdx.x * 2 + (TIDX >> 8); vb < (n); vb += gridDim.x * 2)
constexpr int SMEM_BYTES = 143360;
constexpr int HALF = 36864;

__global__ void __launch_bounds__(512) mega(Params p) {
  __shared__ __attribute__((aligned(16))) char smem[SMEM_BYTES + 16];
  if (TIDX == 0) *(u32x4*)(smem + SMEM_BYTES) = u32x4{0u, 0u, 0u, 0u};
  __syncthreads();
  const XcdBarrier xbar = xcd_barrier_post(WSP(unsigned, WS_CTRL + 1024), (volatile LAS unsigned*)(smem + SMEM_BYTES));
#define smh (smem + (TIDX >> 8) * HALF)
#define wv ((TIDX >> 6))
  constexpr int NWV = 8;
  d_cvt(p.x, WSP(bf16_t, WS_XB), (size_t)S * DM / 4);
  FOR_VB2((INWG / 64) * (DM / 64)) d_cvtT64(vb, smh, p.w_in, WSP(bf16_t, WS_WINT), DM, INW, INWG);
  for (size_t c = (size_t)blockIdx.x * 512 + TIDX; c < (size_t)16 * 256 * 64; c += (size_t)gridDim.x * 512) {
    d_cvt_w1f(c, p.ck_w1, WSP(bf16_t, WS_W1KF)); d_cvt_w1f(c, p.cv_w1, WSP(bf16_t, WS_W1VF));
    if (c < (size_t)4 * 32 * 64) { d_cvt_w2f(c, p.ck_w2, WSP(bf16_t, WS_W2KF)); d_cvt_w2f(c, p.cv_w2, WSP(bf16_t, WS_W2VF)); }
  }
  FOR_VB2((DM / 64) * (DM / 64)) d_cvtT64(vb, smh, p.w_out, WSP(bf16_t, WS_WOUTT), DM, DM, DM);
  FOR_VB2((DM / 64) * (DM / 64)) d_cvtT64(vb, smh, p.w_query, WSP(bf16_t, WS_WQT), DM, DM, DM);
  for (size_t c = (size_t)blockIdx.x * 512 + TIDX; c < (size_t)16 * 4 * 8 * 64; c += (size_t)gridDim.x * 512) d_cvt_subk(c, p.subk, WSP(bf16_t, WS_SKF));
  xcd_barrier(xbar);
  {
    pg8::StaticOrder so; so.init(S, INWG, gridDim.x, blockIdx.x);
    pg8::gemm_phase<EpiProjG, pg8::StaticOrder>((PG8_LAS unsigned char*)smem, pg8::Gemm{WSP(bf16_t, WS_XB), WSP(bf16_t, WS_WINT), S, INWG, DM}, so,
                                                EpiProjG{WSP(bf16_t, WS_PROJ), WSP(float, WS_GATES)}, nullptr);
  }
  xcd_barrier(xbar);
  {
    if (blockIdx.x < 128) {
      const int u = blockIdx.x; const bool isV = u >= 64;
      d_compress_unit(u & 63, smem, WSP(bf16_t, WS_PROJ), isV ? OFF_VC : OFF_KC, isV ? p.cv_pos : p.ck_pos, isV ? WSP(bf16_t, WS_W1VF) : WSP(bf16_t, WS_W1KF),
                      isV ? p.cv_b1 : p.ck_b1, isV ? WSP(bf16_t, WS_W2VF) : WSP(bf16_t, WS_W2KF), isV ? WSP(bf16_t, WS_VCF) : WSP(bf16_t, WS_KCF), isV);
    }
    int* slot = (int*)smem;
    unsigned* ctr = WSP(unsigned, WS_CTRL);
    for (;;) {
      if (TIDX == 0) *slot = (int)atomicAdd(ctr, 1u);
      __syncthreads();
      const int it = *slot;
      __syncthreads();
      if (it >= 2048) break;
      const int tt = TIDX;
      {
        const int T = it >> 2, which = it & 3;
        d_relayout_tile(T, smem + 64, WSP(bf16_t, WS_PROJ), (which == 0) ? OFF_KS : (which == 1) ? OFF_VS : (which == 2) ? OFF_KW : OFF_VW,
                        (which == 0) ? WSP(bf16_t, WS_KSF) : (which == 1) ? WSP(bf16_t, WS_VSF) : (which == 2) ? WSP(bf16_t, WS_KWF) : WSP(bf16_t, WS_VWF), (which & 1) != 0);
      }
      for (int q = 0; q < 2; ++q) d_convmix(it * 8 + q * 4 + (tt >> 7), tt & 127, WSP(bf16_t, WS_PROJ), p.conv_w, p.hng, WSP(bf16_t, WS_MIX));
    }
  }
  xcd_barrier(xbar);
  {
    AttnPtrs ap{WSP(bf16_t, WS_PROJ), WSP(float, WS_GATES), WSP(bf16_t, WS_KCF), WSP(bf16_t, WS_VCF), WSP(bf16_t, WS_KSF), WSP(bf16_t, WS_VSF), WSP(bf16_t, WS_KWF), WSP(bf16_t, WS_VWF), WSP(bf16_t, WS_MIX), p.hng};
    for (int it = blockIdx.x; it < 512; it += gridDim.x) {
      const int Bq = (it < 256) ? it : (511 - it), gq = (it < 256) ? 0 : 1;
      d_attn_block(Bq, gq, smem, ap);
    }
  }
  xcd_barrier(xbar);
  {
    pg8::StaticOrder so; so.init(S, DM, gridDim.x, blockIdx.x);
    pg8::gemm_phase<EpiResG, pg8::StaticOrder>((PG8_LAS unsigned char*)smem, pg8::Gemm{WSP(bf16_t, WS_MIX), WSP(bf16_t, WS_WOUTT), S, DM, DM}, so,
                                               EpiResG{WSP(float, WS_Y), p.x}, nullptr);
  }
  xcd_barrier(xbar);
  FOR_VB2(S) d_ln(vb, smh, WSP(float, WS_Y), p.ln1g, p.ln1b, WSP(float, WS_STATS), WSP(bf16_t, WS_HB));
  for (int r = blockIdx.x * NWV + wv; r < 32768; r += gridDim.x * NWV) {
    if (r < 16384) d_cvt_fp4_row(r, p.eu, WSP(unsigned char, WS_EU8)); else d_cvt_fp4_row(r - 16384, p.ev, WSP(unsigned char, WS_EV8));
  }
  xcd_barrier(xbar);
  for (int k = 0; k * (int)gridDim.x < (S / 256) * (DM / 256); ++k) {
    pg8::OneUnit so; so.init(S, DM, gridDim.x, blockIdx.x); so.k = k;
    pg8::gemm_phase<EpiRouteG, pg8::OneUnit>((PG8_LAS unsigned char*)smem, pg8::Gemm{WSP(bf16_t, WS_HB), WSP(bf16_t, WS_WQT), S, DM, DM}, so,
                                             EpiRouteG{WSP(bf16_t, WS_SKF), WSP(unsigned, WS_TOPS)}, nullptr);
    __syncthreads();
  }
  xcd_barrier(xbar);
  for (int t = blockIdx.x * NWV + wv; t < S; t += gridDim.x * NWV) d_expert_wave(t, (unsigned*)(smem + wv * 1024), WSP(float, WS_Y), WSP(float, WS_STATS), p.ln1g, p.ln1b, WSP(unsigned, WS_TOPS), WSP(unsigned char, WS_EU8), WSP(unsigned char, WS_EV8), p.ln2g, p.ln2b, p.out);
}

extern "C" void kernel_launch(void* const* d_in, const int* in_sizes, int n_in, void* d_out, int out_size, void* d_ws, size_t ws_size,
                              hipStream_t stream) {
  Params p{};
  p.x = (const float*)d_in[0]; p.w_in = (const float*)d_in[1]; p.ck_pos = (const float*)d_in[2]; p.ck_w1 = (const float*)d_in[3];
  p.ck_b1 = (const float*)d_in[4]; p.ck_w2 = (const float*)d_in[5]; p.cv_pos = (const float*)d_in[6]; p.cv_w1 = (const float*)d_in[7];
  p.cv_b1 = (const float*)d_in[8]; p.cv_w2 = (const float*)d_in[9]; p.conv_w = (const float*)d_in[10]; p.hng = (const float*)d_in[11];
  p.w_out = (const float*)d_in[12]; p.ln1g = (const float*)d_in[13]; p.ln1b = (const float*)d_in[14]; p.w_query = (const float*)d_in[15];
  p.subk = (const float*)d_in[16]; p.eu = (const float*)d_in[17]; p.ev = (const float*)d_in[18]; p.ln2g = (const float*)d_in[19];
  p.ln2b = (const float*)d_in[20];
  p.out = (float*)d_out;
  p.ws = (char*)d_ws;
  if (ws_size < WS_END) fprintf(stderr, "workspace too small\n");
  static int grid_blocks = 0;
  if (!grid_blocks) {
    int dev = 0, cus = 0, per_cu = 0;
    hipGetDevice(&dev);
    hipDeviceGetAttribute(&cus, hipDeviceAttributeMultiprocessorCount, dev);
    hipOccupancyMaxActiveBlocksPerMultiprocessor(&per_cu, mega, 512, 0);
    if (per_cu > 1) per_cu = 1;
    if (per_cu < 1) per_cu = 1;
    grid_blocks = cus * per_cu;
  }
  hipMemsetAsync((char*)d_ws + WS_CTRL, 0, CTRL_BYTES, stream);
  void* args[] = {&p};
  hipError_t e = hipLaunchCooperativeKernel((void*)mega, dim3(grid_blocks), dim3(512), args, 0, stream);
  if (e != hipSuccess) fprintf(stderr, "cooperative launch failed: %s (grid %d)\n", hipGetErrorString(e), grid_blocks);
}
```

```cpp
#include <hip/hip_runtime.h>
#include <stdint.h>
#include <stdio.h>


#define DI __device__ __forceinline__
static __device__ __forceinline__ int tidx_() { int t = (int)__builtin_amdgcn_workitem_id_x(); asm volatile("" : "+v"(t)); return t; }
#define TIDX (tidx_())

template <int J> DI int swz_xor(int x) { return __builtin_amdgcn_ds_swizzle(x, (J << 10) | 0x1F); }
template <int CTRL> DI int dpp_i(int x) { return __builtin_amdgcn_update_dpp(x, x, CTRL, 0xF, 0xF, false); }
DI int shx_i(int x, int j) {
  switch (j) {
    case 1: return dpp_i<0xB1>(x);
    case 2: return dpp_i<0x4E>(x);
    case 4: return dpp_i<0x1B>(dpp_i<0x141>(x));
    case 8: return dpp_i<0x128>(x);
    case 16: return swz_xor<16>(x);
    default: {
      auto r = __builtin_amdgcn_permlane32_swap((unsigned)x, (unsigned)x, false, false);
      return (TIDX & 32) ? (int)r[0] : (int)r[1];
    }
  }
}
DI float shx(float x, int j) { return __int_as_float(shx_i(__float_as_int(x), j)); }
typedef unsigned short bf16_t;
using bf16x8 = __attribute__((ext_vector_type(8))) short;
using f32x4 = __attribute__((ext_vector_type(4))) float;
using u32x4 = __attribute__((ext_vector_type(4))) unsigned;
using u32x2 = __attribute__((ext_vector_type(2))) unsigned;

constexpr int S = 16384, DM = 2048, HD = 128;
constexpr int INW = 5656, INWP = 5760, INWG = 5888;
constexpr int OFF_Q = 0, OFF_KC = 1024, OFF_VC = 1280, OFF_KS = 1536, OFF_VS = 1792, OFF_KW = 2048, OFF_VW = 2304,
              OFF_G = 2560, OFF_U = 2584, OFF_B = 3608, OFF_C = 4632;
constexpr int NCMP = 1023;
constexpr float ALPHA = 1.189207115002721f;
constexpr float QSCALE = 0.08838834764831845f;

DI bf16_t f2bf(float x) { unsigned u = __float_as_uint(x); u += 0x7fffu + ((u >> 16) & 1u); return (bf16_t)(u >> 16); }
DI float bf2f(bf16_t b) { return __uint_as_float(((unsigned)b) << 16); }
DI float gelu_tanh(float x) { float u = 0.7978845608028654f * (x + 0.044715f * x * x * x); return 0.5f * x * (1.f + tanhf(u)); }
DI float wave_sum(float v) { for (int o = 32; o > 0; o >>= 1) v += shx(v, o); return v; }
using bf16x2v = __attribute__((ext_vector_type(2))) __bf16;
DI unsigned pack2(float a, float b) { bf16x2v v = {(__bf16)a, (__bf16)b}; return __builtin_bit_cast(unsigned, v); }
DI float wave_max(float v) { for (int o = 32; o > 0; o >>= 1) v = fmaxf(v, shx(v, o)); return v; }

namespace pg8 {
#define PG8_LAS __attribute__((address_space(3)))
typedef unsigned short bf16_t;
typedef short bf16x8 __attribute__((ext_vector_type(8)));
typedef float f32x4 __attribute__((ext_vector_type(4)));
typedef unsigned u32x4 __attribute__((ext_vector_type(4)));
constexpr int BM = 256, BK = 64, HALF = 128, HTB = HALF * BK * 2  , STAGE_BYTES = 8 * HTB, NXCD = 8, WGM = 8;

__host__ __device__ __forceinline__ int lds_byte(int r, int c) { const int st = (r >> 4) * 2 + (c >> 5), rr = r & 15, cc = c & 31, ob = rr * 64 + cc * 2; return st * 1024 + (ob ^ (((ob >> 9) & 1) << 5)); }
__host__ __device__ __forceinline__ void stage_rc(int b, int& R, int& C) { const int st = b / 1024, sb = b % 1024, swz = sb ^ (((sb >> 9) & 1) << 5); R = (st >> 1) * 16 + swz / 64; C = (st & 1) * 32 + (swz % 64) / 2; }
__host__ __device__ __forceinline__ int perm32(int rho) { const int n = rho >> 4, i = rho & 15; return 8 * (i >> 2) + 4 * n + (i & 3); }

struct Unit { int pm, pn; };
struct Gemm { const bf16_t* A; const bf16_t* Bt; int M, N, K; };

struct StaticOrder {
    int nM, nN, nwg, G, c;
    __host__ __device__ void init(int M, int N, int G_, int c_) { nM = M / BM; nN = N / BM; nwg = nM * nN; G = G_; c = c_; }
    __host__ __device__ bool next(int i, Unit& u) const {
        const long L = (long)i * G + c; if (L >= nwg) return false;
        int wgid = (int)L; { const int q = nwg / NXCD, r = nwg % NXCD, xcd = wgid % NXCD, off = wgid / NXCD; wgid = (xcd < r ? xcd * (q + 1) : r * (q + 1) + (xcd - r) * q) + off; }
        const int nig = WGM * nN, gid = wgid / nig, fm = gid * WGM, gsz = (nM - fm) < WGM ? (nM - fm) : WGM;
        u.pm = fm + ((wgid % nig) % gsz); u.pn = (wgid % nig) / gsz; return true;
    }
    __device__ __forceinline__ void a_ready(const Unit&) const {}
    __device__ __forceinline__ void done(const Unit&) const {}
};
struct OneUnit : StaticOrder {
    int k;
    __device__ bool next(int i, Unit& u) const { if (i > 0) return false; return StaticOrder::next(k, u); }
};
__device__ __forceinline__ unsigned cvt_pk_bf16(float lo, float hi) { unsigned r; asm volatile("v_cvt_pk_bf16_f32 %0, %1, %2" : "=v"(r) : "v"(lo), "v"(hi)); return r; }
template <class Epi, class Sched, bool STAMP = false>
__device__ __forceinline__ void gemm_phase(PG8_LAS unsigned char* lds, const Gemm g, const Sched& S, const Epi& E, unsigned long long* stamps) {
    const int tid = TIDX, wid = __builtin_amdgcn_readfirstlane(tid >> 6), lane = tid & 63, wr = wid >> 2, wc = wid & 3, fr = lane & 15, fq = lane >> 4;
    const int K = g.K, nt = K / BK;
    int ts_lo = 0, ts_hi = 0, nts = 0; const unsigned long long rt_entry = STAMP ? (unsigned long long)wall_clock64() : 0ull;
#define PG8_STAMP() do { if (STAMP && wid == 0 && nts < 64) { const unsigned long long _c = (unsigned long long)clock64(); \
        ts_lo = (lane == nts) ? (int)(unsigned)_c : ts_lo; ts_hi = (lane == nts) ? (int)(unsigned)(_c >> 32) : ts_hi; ++nts; } } while (0)
    PG8_STAMP();
    unsigned voffA[2], voffB[2];
#pragma unroll
    for (int i = 0; i < 2; ++i) { int R, C; stage_rc(tid * 16 + i * 8192, R, C); const int Rb = Epi::PERM ? ((R & ~31) + perm32(R & 31)) : R;
        voffA[i] = (unsigned)(R * K + C) * 2u; voffB[i] = (unsigned)(Rb * K + C) * 2u; }
    const size_t kstep = (size_t)(BK * 2);
    const size_t hstep = (size_t)HALF * K * 2;
    const size_t tstep = 2 * hstep;
    const unsigned ldsw = (unsigned)wid * 1024u;
    const int aoff = lds_byte(wr * 64 + fr, fq * 8), boff = lds_byte(wc * 32 + fr, fq * 8);
#define PG8_SA(b, h) (((b) * 2 + (h)) * HTB)
#define PG8_SB(b, h) ((4 + (b) * 2 + (h)) * HTB)
#define PG8_STAGE(bufoff, gbase, voff) do { _Pragma("unroll") for (int _i = 0; _i < 2; ++_i) \
        __builtin_amdgcn_global_load_lds((const unsigned*)((const char*)(gbase) + (voff)[_i]), (PG8_LAS unsigned*)(lds + (bufoff) + ldsw + _i * 8192), 16, 0, 0); } while (0)
#define PG8_LDA(dst, b, h) do { _Pragma("unroll") for (int m = 0; m < 4; ++m) _Pragma("unroll") for (int k = 0; k < 2; ++k) dst[m][k] = *(const PG8_LAS bf16x8*)(lds + PG8_SA(b, h) + aoff + m * 2048 + k * 1024); } while (0)
#define PG8_LDB(dst, b, h) do { _Pragma("unroll") for (int n = 0; n < 2; ++n) _Pragma("unroll") for (int k = 0; k < 2; ++k) dst[n][k] = *(const PG8_LAS bf16x8*)(lds + PG8_SB(b, h) + boff + n * 2048 + k * 1024); } while (0)
#define PG8_MMA(ai, bj, At, Bt) do { __builtin_amdgcn_s_setprio(1); _Pragma("unroll") for (int m = 0; m < 4; ++m) _Pragma("unroll") for (int n = 0; n < 2; ++n) _Pragma("unroll") for (int k = 0; k < 2; ++k) \
        acc[ai][bj][m][n] = __builtin_amdgcn_mfma_f32_16x16x32_bf16(Bt[n][k], At[m][k], acc[ai][bj][m][n], 0, 0, 0); __builtin_amdgcn_s_setprio(0); } while (0)
#define PG8_WAIT_V(n) asm volatile("s_waitcnt vmcnt(" #n ")" ::: "memory")
#define PG8_WAIT_L(n) asm volatile("s_waitcnt lgkmcnt(" #n ")" ::: "memory")
#define PG8_BAR __builtin_amdgcn_s_barrier()
#define PG8_SCHED __builtin_amdgcn_sched_barrier(0)
    Unit cur, nxt; int ui = 0;
    if (!S.next(0, cur)) return;
    f32x4 acc[2][2][4][2];
#pragma unroll
    for (int a = 0; a < 2; ++a)
#pragma unroll
        for (int b = 0; b < 2; ++b)
#pragma unroll
            for (int m = 0; m < 4; ++m)
#pragma unroll
                for (int n = 0; n < 2; ++n) acc[a][b][m][n] = (f32x4){0.f, 0.f, 0.f, 0.f};
    bf16x8 At[4][2], B0[2][2], B1[2][2];
    const char* cA = (const char*)g.A + (size_t)cur.pm * tstep; const char* cB = (const char*)g.Bt + (size_t)cur.pn * tstep;
    S.a_ready(cur);
    PG8_STAGE(PG8_SB(0, 0), cB, voffB); PG8_STAGE(PG8_SA(0, 0), cA, voffA); PG8_STAGE(PG8_SB(0, 1), cB + hstep, voffB); PG8_STAGE(PG8_SA(0, 1), cA + hstep, voffA);
    if (wr == 1) PG8_BAR;
    PG8_WAIT_V(4); PG8_BAR;
    PG8_STAGE(PG8_SB(1, 0), cB + kstep, voffB); PG8_STAGE(PG8_SA(1, 0), cA + kstep, voffA); PG8_STAGE(PG8_SB(1, 1), cB + hstep + kstep, voffB);
    PG8_WAIT_V(6); PG8_BAR;
    PG8_STAMP();
    for (;;) {
        const bool has_next = S.next(ui + 1, nxt);
        const char* nA = has_next ? (const char*)g.A + (size_t)nxt.pm * tstep : cA; const char* nB = has_next ? (const char*)g.Bt + (size_t)nxt.pn * tstep : cB;
        for (int t = 0; t < nt; t += 2) {
            const bool last = (t == nt - 2);
            const char* a1 = cA + (size_t)(t + 1) * kstep;
            const char* a2 = last ? nA : cA + (size_t)(t + 2) * kstep; const char* b2 = last ? nB : cB + (size_t)(t + 2) * kstep;
            const char* a3 = a2 + kstep; const char* b3 = b2 + kstep;
            if (last && has_next) S.a_ready(nxt);
            PG8_LDB(B0, 0, 0); PG8_SCHED; PG8_LDA(At, 0, 0); PG8_STAGE(PG8_SA(1, 1), a1 + hstep, voffA);
            PG8_WAIT_L(8); PG8_BAR; PG8_WAIT_L(0); PG8_MMA(0, 0, At, B0); PG8_BAR; PG8_SCHED;
            PG8_LDB(B1, 0, 1); PG8_STAGE(PG8_SB(0, 0), b2, voffB);
            PG8_BAR; PG8_WAIT_L(0); PG8_MMA(0, 1, At, B1); PG8_BAR;
            PG8_LDA(At, 0, 1); PG8_STAGE(PG8_SA(0, 0), a2, voffA);
            PG8_BAR; PG8_WAIT_L(0); PG8_MMA(1, 0, At, B0); PG8_BAR; PG8_SCHED;
            PG8_STAGE(PG8_SB(0, 1), b2 + hstep, voffB);
            PG8_WAIT_V(6); PG8_BAR; PG8_MMA(1, 1, At, B1); PG8_BAR;
            PG8_LDB(B0, 1, 0); PG8_SCHED; PG8_LDA(At, 1, 0); PG8_STAGE(PG8_SA(0, 1), a2 + hstep, voffA);
            PG8_WAIT_L(8); PG8_BAR; PG8_WAIT_L(0); PG8_MMA(0, 0, At, B0); PG8_BAR; PG8_SCHED;
            PG8_LDB(B1, 1, 1); PG8_STAGE(PG8_SB(1, 0), b3, voffB);
            PG8_BAR; PG8_WAIT_L(0); PG8_MMA(0, 1, At, B1); PG8_BAR;
            PG8_LDA(At, 1, 1); PG8_STAGE(PG8_SA(1, 0), a3, voffA);
            PG8_BAR; PG8_WAIT_L(0); PG8_MMA(1, 0, At, B0); PG8_BAR; PG8_SCHED;
            PG8_STAGE(PG8_SB(1, 1), b3 + hstep, voffB);
            PG8_WAIT_V(6); PG8_BAR; PG8_MMA(1, 1, At, B1); PG8_BAR;
        }
        PG8_STAMP();
        if constexpr (!Epi::AFTER_DRAIN) { E(acc, cur, wr, wc, fr, fq); S.done(cur); }
        PG8_STAMP();
        if (!has_next) break;
#pragma unroll
        for (int a = 0; a < 2; ++a)
#pragma unroll
            for (int b = 0; b < 2; ++b)
#pragma unroll
                for (int m = 0; m < 4; ++m)
#pragma unroll
                    for (int n = 0; n < 2; ++n) acc[a][b][m][n] = (f32x4){0.f, 0.f, 0.f, 0.f};
        cur = nxt; cA = nA; cB = nB; ++ui;
    }
    PG8_WAIT_V(0);
    if (wr == 0) PG8_BAR;
    PG8_BAR;
    if constexpr (Epi::AFTER_DRAIN) { E.fused(acc, cur, wr, wc, fr, fq, lds, wid, lane); S.done(cur); }
    PG8_STAMP();
    if (STAMP && wid == 0) { stamps[lane] = lane < nts ? (((unsigned long long)(unsigned)ts_hi << 32) | (unsigned)ts_lo) : 0ull;
        if (lane == 62) stamps[62] = rt_entry; if (lane == 63) stamps[63] = (unsigned long long)wall_clock64(); }
#undef PG8_STAMP
#undef PG8_SA
#undef PG8_SB
#undef PG8_STAGE
#undef PG8_LDA
#undef PG8_LDB
#undef PG8_MMA
#undef PG8_WAIT_V
#undef PG8_WAIT_L
#undef PG8_BAR
#undef PG8_SCHED
}
}

#define XB_TMO      128
#define XB_XCNT(j)  (256  + 64 * (j))
#define XB_XSUB(j)  (1280 + 64 * (j))
#define XB_XGEN(j)  (2304 + 64 * (j))
#define XB_TOP      3328
#define XB_TOPGEN   3392
#define XCD_BAR_WORDS 3456
#define XB_SPIN_CAP (1u << 18)
#define LAS __attribute__((address_space(3)))

__device__ __forceinline__ unsigned xb_ld(unsigned* p)              { return __hip_atomic_load(p, __ATOMIC_RELAXED, __HIP_MEMORY_SCOPE_AGENT); }
__device__ __forceinline__ unsigned xb_add(unsigned* p, unsigned v) { return __hip_atomic_fetch_add(p, v, __ATOMIC_RELAXED, __HIP_MEMORY_SCOPE_AGENT); }
__device__ __forceinline__ unsigned xb_xcc_id() { return (unsigned)__builtin_amdgcn_s_getreg((3 << 11) | 20) & 0xFu; }
#define XB_SPIN(cond, bar) do { unsigned _sp = 0; while (cond) { __builtin_amdgcn_s_sleep(1); \
    if ((++_sp & 255u) == 0u) { if (xb_ld(&(bar)[XB_TMO])) break; if (_sp > XB_SPIN_CAP) { atomicAdd(&(bar)[XB_TMO], 1u); break; } } } } while (0)

struct XcdBarrier {
    unsigned* bar; unsigned x;
    volatile LAS unsigned* st;
};

__device__ __forceinline__ XcdBarrier xcd_barrier_post(unsigned* bar, volatile LAS unsigned* st) {
    XcdBarrier b; b.bar = bar; b.x = xb_xcc_id(); b.st = st;
    if (TIDX == 0) (void)xb_add(&bar[XB_XCNT(b.x)], 1u);
    return b;
}
__device__ __forceinline__ void xcd_barrier_complete(unsigned* bar, unsigned x, unsigned& nloc, unsigned& nx) {
    const unsigned G = gridDim.x * gridDim.y * gridDim.z;
    unsigned sum, cnt, mine, sp = 0u;
    for (;;) {
        sum = 0u; cnt = 0u; mine = 0u;
#pragma unroll
        for (unsigned j = 0; j < 16; ++j) { const unsigned c = xb_ld(&bar[XB_XCNT(j)]); sum += c; cnt += (c > 0u) ? 1u : 0u; mine = (j == x) ? c : mine; }
        if (sum == G) break;
        __builtin_amdgcn_s_sleep(1);
        if ((++sp & 255u) == 0u) { if (xb_ld(&bar[XB_TMO])) break; if (sp > XB_SPIN_CAP) { atomicAdd(&bar[XB_TMO], 1u); break; } }
    }
    nloc = mine > 0u ? mine : 1u; nx = cnt > 0u ? cnt : 1u;
}

__device__ __forceinline__ void xcd_barrier(const XcdBarrier& b) {
    asm volatile("s_waitcnt vmcnt(0)" ::: "memory");
    __syncthreads();
    if (TIDX == 0) {
        unsigned* bar = b.bar;
        __builtin_amdgcn_s_waitcnt(0);
        unsigned nloc = b.st[0], nx = b.st[1];
        if (nloc == 0u) { xcd_barrier_complete(bar, b.x, nloc, nx); b.st[0] = nloc; b.st[1] = nx; }
        const unsigned old = xb_add(&bar[XB_XSUB(b.x)], 1u);
        const unsigned gen = old / nloc;
        if (old + 1u == (gen + 1u) * nloc) {
            __builtin_amdgcn_fence(__ATOMIC_RELEASE, "agent");
            asm volatile("s_waitcnt vmcnt(0)" ::: "memory");
            const unsigned og = xb_add(&bar[XB_TOP], 1u);
            const unsigned tg = og / nx;
            if (og + 1u == (tg + 1u) * nx) xb_add(&bar[XB_TOPGEN], 1u);
            else XB_SPIN(xb_ld(&bar[XB_TOPGEN]) == tg, bar);
            __builtin_amdgcn_fence(__ATOMIC_ACQUIRE, "agent");
            xb_add(&bar[XB_XGEN(b.x)], 1u);
            asm volatile("s_waitcnt vmcnt(0)" ::: "memory");
        } else {
            XB_SPIN(xb_ld(&bar[XB_XGEN(b.x)]) == gen, bar);
            __builtin_amdgcn_fence(__ATOMIC_ACQUIRE, "agent");
            asm volatile("s_waitcnt vmcnt(0)" ::: "memory");
        }
    }
    __syncthreads();
}

__device__ void d_cvt(const float* __restrict__ in, bf16_t* __restrict__ out, size_t n4) {
  const size_t stride = (size_t)gridDim.x * blockDim.x;
  size_t i = (size_t)blockIdx.x * blockDim.x + TIDX;
  for (; i + 3 * stride < n4; i += 4 * stride) {
    f32x4 v[4];
#pragma unroll
    for (int q = 0; q < 4; ++q) v[q] = ((const f32x4*)in)[i + q * stride];
#pragma unroll
    for (int q = 0; q < 4; ++q) { u32x2 o = {pack2(v[q][0], v[q][1]), pack2(v[q][2], v[q][3])}; ((u32x2*)out)[i + q * stride] = o; }
  }
  for (; i < n4; i += stride) { const f32x4 v = ((const f32x4*)in)[i]; u32x2 o = {pack2(v[0], v[1]), pack2(v[2], v[3])}; ((u32x2*)out)[i] = o; }
}
__device__ void d_cvtT(int vb, char* smem, const float* __restrict__ W, bf16_t* __restrict__ WT, int K, int N, int NP) {
  float (*t)[33] = (float (*)[33])smem;
  int nbx = NP / 32;
  int n0 = (vb % nbx) * 32, k0 = (vb / nbx) * 32;
  int tx = (TIDX & 255) & 31, ty = (TIDX & 255) >> 5;
  for (int i = ty; i < 32; i += 8) { int k = k0 + i, n = n0 + tx; t[i][tx] = (n < N && k < K) ? W[(size_t)k * N + n] : 0.f; }
  __syncthreads();
  for (int i = ty; i < 32; i += 8) { int n = n0 + i, k = k0 + tx; if (n < NP && k < K) WT[(size_t)n * K + k] = f2bf(t[tx][i]); }
  __syncthreads();
}

__device__ void d_cvtT64(int vb, char* smem, const float* __restrict__ W, bf16_t* __restrict__ WT, int K, int N, int NP) {
  float (*tt)[65] = (float (*)[65])smem;
  const int tid = (TIDX & 255);
  const int nbx = NP / 64;
  const int n0 = (vb % nbx) * 64, k0 = (vb / nbx) * 64;
  {
    const int kr = tid >> 4, nc = (tid & 15) * 4;
#pragma unroll
    for (int i = 0; i < 4; ++i) {
      const int k = k0 + kr + 16 * i, n = n0 + nc;
      f32x4 v = {0.f, 0.f, 0.f, 0.f};
      if (n < N) v = *(const f32x4*)(W + (size_t)k * N + n);
      tt[kr + 16 * i][nc] = v[0]; tt[kr + 16 * i][nc + 1] = v[1]; tt[kr + 16 * i][nc + 2] = v[2]; tt[kr + 16 * i][nc + 3] = v[3];
    }
  }
  __syncthreads();
  {
    const int nr = tid >> 3, kc = (tid & 7) * 8;
#pragma unroll
    for (int i = 0; i < 2; ++i) {
      const int nl = nr + 32 * i;
      u32x4 o = {pack2(tt[kc][nl], tt[kc + 1][nl]), pack2(tt[kc + 2][nl], tt[kc + 3][nl]), pack2(tt[kc + 4][nl], tt[kc + 5][nl]), pack2(tt[kc + 6][nl], tt[kc + 7][nl])};
      *(u32x4*)(WT + (size_t)(n0 + nl) * K + k0 + kc) = o;
    }
  }
  __syncthreads();
}

constexpr int LDS_LD = 72;
struct EpiProj { bf16_t* proj; float* gates; };
struct EpiF32 { float* C; int ldc; int N; };
struct EpiRes { float* C; const float* X; };


#define ELEMWISE_TILE                                                                              \
  DI void tile(f32x4 (&acc)[4][4], char*, int m0, int n0, int, int wm, int wn, int, int lane) const { \
    _Pragma("unroll") for (int i = 0; i < 4; ++i)                                                  \
    _Pragma("unroll") for (int j = 0; j < 4; ++j)                                                  \
    _Pragma("unroll") for (int r = 0; r < 4; ++r) {                                                \
      int row = m0 + wm * 64 + i * 16 + (lane >> 4) * 4 + r;                                       \
      int col = n0 + wn * 64 + j * 16 + (lane & 15);                                               \
      (*this)(row, col, acc[i][j][r]);                                                             \
    }                                                                                              \
  }
template <class Epi>
__device__ void d_gemm(int vb, char* smem, const bf16_t* __restrict__ A, int lda, const bf16_t* __restrict__ BT, int ldb, int K,
                       int tilesM, Epi epi) {
  bf16_t* As = (bf16_t*)smem;
  bf16_t* Bs = As + 256 * LDS_LD;
  const int tid = TIDX, lane = tid & 63, wid = tid >> 6;
  const int wm = wid >> 1, wn = wid & 1;
  const int tm = vb % tilesM, tn = vb / tilesM;
  const int m0 = tm * 256, n0 = tn * 128;
  f32x4 acc[4][4];
#pragma unroll
  for (int i = 0; i < 4; ++i)
#pragma unroll
    for (int j = 0; j < 4; ++j) acc[i][j] = f32x4{0.f, 0.f, 0.f, 0.f};
  u32x4 ra[4], rb[2];
#define GLOAD(k0_)                                                                  \
  _Pragma("unroll") for (int i = 0; i < 4; ++i) {                                   \
    int c = tid + i * 512; int row = c >> 3, kc = c & 7;                            \
    ra[i] = *(const u32x4*)(A + (size_t)(m0 + row) * lda + (k0_) + kc * 8);         \
  }                                                                                 \
  _Pragma("unroll") for (int i = 0; i < 2; ++i) {                                   \
    int c = tid + i * 512; int row = c >> 3, kc = c & 7;                            \
    rb[i] = *(const u32x4*)(BT + (size_t)(n0 + row) * ldb + (k0_) + kc * 8);        \
  }
  GLOAD(0)
  for (int k0 = 0; k0 < K; k0 += 64) {
    __syncthreads();
#pragma unroll
    for (int i = 0; i < 4; ++i) { int c = tid + i * 512; int row = c >> 3, kc = c & 7; *(u32x4*)(As + row * LDS_LD + kc * 8) = ra[i]; }
#pragma unroll
    for (int i = 0; i < 2; ++i) { int c = tid + i * 512; int row = c >> 3, kc = c & 7; *(u32x4*)(Bs + row * LDS_LD + kc * 8) = rb[i]; }
    __syncthreads();
    if (k0 + 64 < K) { GLOAD(k0 + 64) }
#pragma unroll
    for (int ks = 0; ks < 2; ++ks) {
      bf16x8 a[4], b[4];
#pragma unroll
      for (int i = 0; i < 4; ++i) {
        a[i] = *(const bf16x8*)(As + (wm * 64 + i * 16 + (lane & 15)) * LDS_LD + ks * 32 + (lane >> 4) * 8);
        b[i] = *(const bf16x8*)(Bs + (wn * 64 + i * 16 + (lane & 15)) * LDS_LD + ks * 32 + (lane >> 4) * 8);
      }
#pragma unroll
      for (int i = 0; i < 4; ++i)
#pragma unroll
        for (int j = 0; j < 4; ++j) acc[i][j] = __builtin_amdgcn_mfma_f32_16x16x32_bf16(a[i], b[j], acc[i][j], 0, 0, 0);
    }
  }
  epi.tile(acc, smem, m0, n0, tn, wm, wn, wid, lane);
  __syncthreads();
}
struct EpiProjF {
  bf16_t* proj; float* gates;
  DI void operator()(int row, int col, float v) const {
    if (col < INW) proj[(size_t)row * INWP + col] = f2bf(v);
    if (col >= OFF_G && col < OFF_G + 24) gates[row * 24 + (col - OFF_G)] = 1.f / (1.f + __expf(-v));
  }
  ELEMWISE_TILE
};
struct EpiF32F {
  float* C; int ldc; int N;
  DI void operator()(int row, int col, float v) const { if (col < N) C[(size_t)row * ldc + col] = v; }
  ELEMWISE_TILE
};
struct EpiResF {
  float* C; const float* X;
  DI void operator()(int row, int col, float v) const { C[(size_t)row * DM + col] = ALPHA * X[(size_t)row * DM + col] + v; }
  ELEMWISE_TILE
};

__device__ void d_build_cmp(int row, const bf16_t* __restrict__ proj, int off, const float* __restrict__ pos, bf16_t* __restrict__ Ac) {
  int n = row >> 1, g = row & 1;
  for (int k = (TIDX & 255); k < 4096; k += 256) {
    float v = 0.f;
    if (row < 2046) { int l = k >> 7, d = k & 127; v = bf2f(proj[(size_t)(16 * n + l) * INWP + off + g * 128 + d]) + pos[l * 128 + d]; }
    Ac[(size_t)row * 4096 + k] = f2bf(v);
  }
}
__device__ void d_cmp2(int row, char* smem, const float* __restrict__ hid, const float* __restrict__ b1, const float* __restrict__ w2, float* __restrict__ out) {
  float* a = (float*)smem;
  for (int j = (TIDX & 255); j < 512; j += 256) a[j] = gelu_tanh(hid[(size_t)row * 512 + j] + b1[j]);
  __syncthreads();
  int d = (TIDX & 255) & 127, half = (TIDX & 255) >> 7;
  float s = 0.f;
  for (int j = half * 256; j < half * 256 + 256; ++j) s += a[j] * w2[j * 128 + d];
  float* red = a + 512;
  if (half) red[d] = s;
  __syncthreads();
  if (!half) out[(size_t)row * 128 + d] = s + red[d];
  __syncthreads();
}

using f32x16 = __attribute__((ext_vector_type(16))) float;
using bf16x8v = __attribute__((ext_vector_type(8))) __bf16;
#define MFMA32(a, b, c) __builtin_amdgcn_mfma_f32_32x32x16_bf16((a), (b), (c), 0, 0, 0)
constexpr float LOG2E = 1.4426950408889634f;
constexpr float NEGB = -1e30f;
DI int pi_perm(int i) { return (i & ~12) | ((i & 8) >> 1) | ((i & 4) << 1); }
DI bf16x8 pack8(float a0, float a1, float a2, float a3, float a4, float a5, float a6, float a7) {
  bf16x8v v = {(__bf16)a0, (__bf16)a1, (__bf16)a2, (__bf16)a3, (__bf16)a4, (__bf16)a5, (__bf16)a6, (__bf16)a7};
  return __builtin_bit_cast(bf16x8, v);
}
__device__ void d_relayoutK_bf(size_t c, int NT, const bf16_t* __restrict__ src, int ld, int col0, bf16_t* __restrict__ dst) {
  int lane = c & 63, s = (c >> 6) & 7; size_t tt = c >> 9; int T = tt % NT, g = tt / NT;
  int i = lane & 31, h = lane >> 5;
  int tok = 32 * T + pi_perm(i);
  *(u32x4*)(dst + c * 8) = *(const u32x4*)(src + (size_t)tok * ld + col0 + g * 128 + 16 * s + 8 * h);
}
__device__ void d_relayoutV_bf(size_t c, int NT, const bf16_t* __restrict__ src, int ld, int col0, bf16_t* __restrict__ dst) {
  int lane = c & 63, s2 = (c >> 6) & 1, dt = (c >> 7) & 3; size_t tt = c >> 9; int T = tt % NT, g = tt / NT;
  int dd = lane & 31, h = lane >> 5;
  bf16_t v[8];
#pragma unroll
  for (int j = 0; j < 8; ++j) v[j] = src[(size_t)(32 * T + 16 * s2 + 8 * h + j) * ld + col0 + g * 128 + 32 * dt + dd];
  u32x4 o; o.x = v[0] | ((unsigned)v[1] << 16); o.y = v[2] | ((unsigned)v[3] << 16); o.z = v[4] | ((unsigned)v[5] << 16); o.w = v[6] | ((unsigned)v[7] << 16);
  *(u32x4*)(dst + c * 8) = o;
}
__device__ void d_relayoutK_f32(size_t c, const float* __restrict__ src, bf16_t* __restrict__ dst) {
  int lane = c & 63, s = (c >> 6) & 7; size_t tt = c >> 9; int T = tt % 32, g = tt / 32;
  int i = lane & 31, h = lane >> 5;
  int n = 32 * T + pi_perm(i);
  bf16_t v[8];
#pragma unroll
  for (int j = 0; j < 8; ++j) v[j] = (n < NCMP) ? f2bf(src[((size_t)n * 2 + g) * 128 + 16 * s + 8 * h + j]) : (bf16_t)0;
  u32x4 o; o.x = v[0] | ((unsigned)v[1] << 16); o.y = v[2] | ((unsigned)v[3] << 16); o.z = v[4] | ((unsigned)v[5] << 16); o.w = v[6] | ((unsigned)v[7] << 16);
  *(u32x4*)(dst + c * 8) = o;
}
__device__ void d_relayoutV_f32(size_t c, const float* __restrict__ src, bf16_t* __restrict__ dst) {
  int lane = c & 63, s2 = (c >> 6) & 1, dt = (c >> 7) & 3; size_t tt = c >> 9; int T = tt % 32, g = tt / 32;
  int dd = lane & 31, h = lane >> 5;
  bf16_t v[8];
#pragma unroll
  for (int j = 0; j < 8; ++j) { int n = 32 * T + 16 * s2 + 8 * h + j; v[j] = (n < NCMP) ? f2bf(src[((size_t)n * 2 + g) * 128 + 32 * dt + dd]) : (bf16_t)0; }
  u32x4 o; o.x = v[0] | ((unsigned)v[1] << 16); o.y = v[2] | ((unsigned)v[3] << 16); o.z = v[4] | ((unsigned)v[5] << 16); o.w = v[6] | ((unsigned)v[7] << 16);
  *(u32x4*)(dst + c * 8) = o;
}


__device__ __forceinline__ void d_relayout_tile(int T, char* smem, const bf16_t* __restrict__ proj, int col0, bf16_t* __restrict__ dst, bool isV) {
  bf16_t* Ls = (bf16_t*)smem;
  const int tid = TIDX;
#pragma unroll
  for (int q = 0; q < 2; ++q) {
    const int cidx = tid + q * 512;
    const int g = cidx >> 9, tok = (cidx >> 4) & 31, ch = cidx & 15;
    const u32x4 v = *(const u32x4*)(proj + (size_t)(32 * T + tok) * INWP + col0 + g * 128 + ch * 8);
    *(u32x4*)(Ls + (g * 32 + tok) * 136 + ch * 8) = v;
  }
  __syncthreads();
#pragma unroll
  for (int q = 0; q < 2; ++q) {
    const int oc = tid + q * 512;
    const int g = oc >> 9, r9 = oc & 511, lane = r9 & 63;
    u32x4 o;
    if (!isV) {
      const int s8 = r9 >> 6, i = lane & 31, h = lane >> 5;
      o = *(const u32x4*)(Ls + (g * 32 + pi_perm(i)) * 136 + 16 * s8 + 8 * h);
    } else {
      const int s2 = (r9 >> 6) & 1, dt = r9 >> 7, dd = lane & 31, h = lane >> 5;
      const bf16_t* col = Ls + (g * 32 + 16 * s2 + 8 * h) * 136 + 32 * dt + dd;
      unsigned short e[8];
#pragma unroll
      for (int j = 0; j < 8; ++j) e[j] = col[j * 136];
      o.x = e[0] | ((unsigned)e[1] << 16); o.y = e[2] | ((unsigned)e[3] << 16); o.z = e[4] | ((unsigned)e[5] << 16); o.w = e[6] | ((unsigned)e[7] << 16);
    }
    *(u32x4*)(dst + (((size_t)(g * 512 + T)) * 512 + r9) * 8) = o;
  }
  __syncthreads();
}

struct AttnPtrs {
  const bf16_t* proj; const float* gates;
  const bf16_t *kcf, *vcf, *ksf, *vsf, *kwf, *vwf;
  bf16_t* mix; const float* hng;
};

DI float ex2(float x) { return __builtin_amdgcn_exp2f(x); }
DI void halves(float x, float& lo, float& hi) {
  const unsigned u = __float_as_uint(x);
  auto r = __builtin_amdgcn_permlane32_swap(u, u, false, false);
  lo = __uint_as_float(r[0]); hi = __uint_as_float(r[1]);
}
DI float hmax(float x) { float a, b; halves(x, a, b); return fmaxf(a, b); }
DI float hsum(float x) { float a, b; halves(x, a, b); return a + b; }
DI float dpp_quad(float v, int ctrl_is_xor1) {
  const int iv = __float_as_int(v);
  const int r = ctrl_is_xor1 ? __builtin_amdgcn_update_dpp(iv, iv, 0xB1, 0xF, 0xF, false) : __builtin_amdgcn_update_dpp(iv, iv, 0x4E, 0xF, 0xF, false);
  return __int_as_float(r);
}
DI float quad_sum(float v) { v += dpp_quad(v, 1); v += dpp_quad(v, 0); return v; }
DI void load_k(bf16x8 (&kf)[8], const bf16_t* __restrict__ kt, int lane) {
#pragma unroll
  for (int s = 0; s < 8; ++s) kf[s] = *(const bf16x8*)(kt + s * 512 + lane * 8);
}
DI f32x16 qk_frags(const bf16x8 (&kf)[8], const bf16_t* qL, int lane) {
  f32x16 acc;
#pragma unroll
  for (int i = 0; i < 16; ++i) acc[i] = 0.f;
  const bf16_t* qp = qL + (lane & 31) * 136 + 8 * (lane >> 5);
#pragma unroll
  for (int s = 0; s < 8; ++s) {
    bf16x8 qf = *(const bf16x8*)(qp + 16 * s);
    acc = MFMA32(kf[s], qf, acc);
  }
  return acc;
}
DI void pv_frags(const bf16x8 (&vf)[8], const float (&p)[16], f32x16 (&O)[4]) {
  bf16x8 pf0 = pack8(p[0], p[1], p[2], p[3], p[4], p[5], p[6], p[7]);
  bf16x8 pf1 = pack8(p[8], p[9], p[10], p[11], p[12], p[13], p[14], p[15]);
#pragma unroll
  for (int dt = 0; dt < 4; ++dt) {
    O[dt] = MFMA32(vf[dt * 2], pf0, O[dt]);
    O[dt] = MFMA32(vf[dt * 2 + 1], pf1, O[dt]);
  }
}
DI void osm_step(const float (&sv)[16], float& m, float& l, f32x16 (&O)[4], float (&p)[16]) {
  float tmax = fmaxf(fmaxf(fmaxf(sv[0], sv[1]), fmaxf(sv[2], sv[3])), fmaxf(fmaxf(sv[4], sv[5]), fmaxf(sv[6], sv[7])));
  tmax = fmaxf(tmax, fmaxf(fmaxf(fmaxf(sv[8], sv[9]), fmaxf(sv[10], sv[11])), fmaxf(fmaxf(sv[12], sv[13]), fmaxf(sv[14], sv[15]))));
  tmax = hmax(tmax);
  if (__ballot(tmax - m > 8.f)) {
    const float mn = fmaxf(m, tmax);
    const float alpha = ex2(m - mn);
    l *= alpha; m = mn;
#pragma unroll
    for (int dt = 0; dt < 4; ++dt)
#pragma unroll
      for (int r = 0; r < 16; ++r) O[dt][r] *= alpha;
  }
  float ps0 = 0.f, ps1 = 0.f;
#pragma unroll
  for (int r = 0; r < 16; r += 2) { const float e0 = ex2(sv[r] - m), e1 = ex2(sv[r + 1] - m); p[r] = e0; p[r + 1] = e1; ps0 += e0; ps1 += e1; }
  l += ps0 + ps1;
}
DI void ot_store(char* otL, int lane, const f32x16 (&O)[4], float sc) {
#pragma unroll
  for (int dt = 0; dt < 4; ++dt) {
    u32x4 a, b;
#pragma unroll
    for (int i = 0; i < 4; ++i) { a[i] = pack2(sc * O[dt][2 * i], sc * O[dt][2 * i + 1]); b[i] = pack2(sc * O[dt][8 + 2 * i], sc * O[dt][8 + 2 * i + 1]); }
    *(u32x4*)(otL + lane * 128 + dt * 32) = a;
    *(u32x4*)(otL + lane * 128 + dt * 32 + 16) = b;
  }
}
DI void ot_accum(const char* otL, int lane, f32x16 (&O)[4], float sc) {
#pragma unroll
  for (int dt = 0; dt < 4; ++dt) {
    u32x4 a = *(const u32x4*)(otL + lane * 128 + dt * 32);
    u32x4 b = *(const u32x4*)(otL + lane * 128 + dt * 32 + 16);
#pragma unroll
    for (int i = 0; i < 4; ++i) {
      const unsigned wa = a[i], wb = b[i];
      O[dt][2 * i] = fmaf(sc, O[dt][2 * i], __uint_as_float(wa << 16));
      O[dt][2 * i + 1] = fmaf(sc, O[dt][2 * i + 1], __uint_as_float(wa & 0xFFFF0000u));
      O[dt][8 + 2 * i] = fmaf(sc, O[dt][8 + 2 * i], __uint_as_float(wb << 16));
      O[dt][8 + 2 * i + 1] = fmaf(sc, O[dt][8 + 2 * i + 1], __uint_as_float(wb & 0xFFFF0000u));
    }
  }
}
DI void zero_o(f32x16 (&O)[4]) {
#pragma unroll
  for (int dt = 0; dt < 4; ++dt)
#pragma unroll
    for (int i = 0; i < 16; ++i) O[dt][i] = 0.f;
}

constexpr int ATT_PW = 8704;
constexpr int ATT_R = 4, ATT_D = 3;
constexpr int ATT_RING = 8 * ATT_PW;
constexpr int ATT_LIST = ATT_RING + ATT_R * 16384;
constexpr int ATT_BUNI = ATT_LIST + 2048;
constexpr int ATT_SMEM = ATT_BUNI + 64;
#define LAS3 __attribute__((address_space(3)))
__device__ __forceinline__ void d_select(const float* impL, unsigned* mskL, unsigned* uniL, int cur) {
  const int lane = TIDX & 63;
  const int stok = lane >> 3, sub = lane & 7;
  unsigned key[32];
#pragma unroll
  for (int i4 = 0; i4 < 8; ++i4) {
    f32x4 v = *(const f32x4*)(impL + stok * 256 + sub * 32 + i4 * 4);
#pragma unroll
    for (int e = 0; e < 4; ++e) {
      const int j = sub * 32 + i4 * 4 + e;
      const bool valid = j <= cur;
      const bool forced = (j == 0) || (j == cur) || (j == cur - 1);
      unsigned kb = forced ? 0xFFFFFF00u : (__float_as_uint(v[e]) & 0xFFFFFF00u);
      key[i4 * 4 + e] = valid ? (kb | (unsigned)(255 - j)) : 0u;
    }
  }
#pragma unroll
  for (int k = 2; k <= 32; k <<= 1) {
#pragma unroll
    for (int jj = k >> 1; jj > 0; jj >>= 1) {
#pragma unroll
      for (int i = 0; i < 32; ++i) {
        const int l2 = i ^ jj;
        if (l2 > i) {
          const bool desc = ((i & k) == 0);
          unsigned a = key[i], b = key[l2];
          unsigned mx = a > b ? a : b, mn = a > b ? b : a;
          key[i] = desc ? mx : mn; key[l2] = desc ? mn : mx;
        }
      }
    }
  }
#pragma unroll
  for (int xm = 1; xm < 8; xm <<= 1) {
    unsigned L[16];
#pragma unroll
    for (int i = 0; i < 16; ++i) { unsigned o = (unsigned)shx_i((int)key[15 - i], xm); L[i] = key[i] > o ? key[i] : o; }
#pragma unroll
    for (int jj = 8; jj > 0; jj >>= 1) {
#pragma unroll
      for (int i = 0; i < 16; ++i) {
        const int l2 = i ^ jj;
        if (l2 > i) { unsigned a = L[i], b = L[l2]; L[i] = a > b ? a : b; L[l2] = a > b ? b : a; }
      }
    }
#pragma unroll
    for (int i = 0; i < 16; ++i) key[i] = L[i];
  }
#pragma unroll
  for (int i = 0; i < 16; ++i) {
    if ((i & 7) == sub) {
      const int j = 255 - (int)(key[i] & 255u);
      if (j <= cur) { atomicOr(&mskL[stok * 8 + (j >> 5)], 1u << (j & 31)); atomicOr(&uniL[j >> 5], 1u << (j & 31)); }
    }
  }
}


DI void att_issue(LAS3 unsigned char* ring, int slot, int w, int lane, const bf16_t* kb, const bf16_t* vb, int tile) {
  const char* ks = (const char*)kb + (size_t)tile * 8192 + w * 1024 + lane * 16;
  const char* vs = (const char*)vb + (size_t)tile * 8192 + w * 1024 + lane * 16;
  __builtin_amdgcn_global_load_lds((const unsigned*)ks, (LAS3 unsigned*)(ring + slot * 16384 + w * 1024), 16, 0, 0);
  __builtin_amdgcn_global_load_lds((const unsigned*)vs, (LAS3 unsigned*)(ring + slot * 16384 + 8192 + w * 1024), 16, 0, 0);
}
DI void att_wait(int newer_tiles) {
  if (newer_tiles >= 2) asm volatile("s_waitcnt vmcnt(4)" ::: "memory");
  else if (newer_tiles == 1) asm volatile("s_waitcnt vmcnt(2)" ::: "memory");
  else asm volatile("s_waitcnt vmcnt(0)" ::: "memory");
}
DI f32x16 qk_lds(LAS3 const unsigned char* kt, const bf16x8 (&qf)[8], int lane) {
  f32x16 acc;
#pragma unroll
  for (int i = 0; i < 16; ++i) acc[i] = 0.f;
#pragma unroll
  for (int s8 = 0; s8 < 8; ++s8) {
    const bf16x8 kf = *(LAS3 const bf16x8*)(kt + s8 * 1024 + lane * 16);
    acc = MFMA32(kf, qf[s8], acc);
  }
  return acc;
}
DI void pv_lds(LAS3 const unsigned char* vt, const float (&p)[16], f32x16 (&O)[4], int lane) {
  const bf16x8 pf0 = pack8(p[0], p[1], p[2], p[3], p[4], p[5], p[6], p[7]);
  const bf16x8 pf1 = pack8(p[8], p[9], p[10], p[11], p[12], p[13], p[14], p[15]);
#pragma unroll
  for (int dt = 0; dt < 4; ++dt) {
    const bf16x8 v0 = *(LAS3 const bf16x8*)(vt + (dt * 2) * 1024 + lane * 16);
    const bf16x8 v1 = *(LAS3 const bf16x8*)(vt + (dt * 2 + 1) * 1024 + lane * 16);
    O[dt] = MFMA32(v0, pf0, O[dt]);
    O[dt] = MFMA32(v1, pf1, O[dt]);
  }
}

__device__ __forceinline__ void d_attn_block(int B, int g, char* smem, const AttnPtrs& P) {
  const int tid = TIDX, lane = tid & 63, w = tid >> 6;
  const int c = lane & 31, h = lane >> 5, tokl = c >> 2, r = c & 3;
  const int tok0 = 64 * B + 8 * w;
  const int t = tok0 + tokl, hd = g * 4 + r;
  const float slope2 = exp2f(-(float)(hd + 1)) * LOG2E;
  const float c1 = QSCALE * LOG2E;
  const float ninf = -__builtin_inff();
  char* wsm = smem + w * ATT_PW;
  float* impL = (float*)wsm;
  char* otL = wsm;
  unsigned* mskL = (unsigned*)(wsm + 8192);
  unsigned* uniL = mskL + 64;
  LAS3 unsigned char* ring = (LAS3 unsigned char*)(smem + ATT_RING);
  unsigned short* tl = (unsigned short*)(smem + ATT_LIST);
  unsigned* buni = (unsigned*)(smem + ATT_BUNI);
  const bf16_t* kcf = P.kcf + (size_t)g * 32 * 4096;
  const bf16_t* vcf = P.vcf + (size_t)g * 32 * 4096;
  const bf16_t* ksf = P.ksf + (size_t)g * 512 * 4096;
  const bf16_t* vsf = P.vsf + (size_t)g * 512 * 4096;
  const bf16_t* kwf = P.kwf + (size_t)g * 512 * 4096;
  const bf16_t* vwf = P.vwf + (size_t)g * 512 * 4096;
  bf16x8 qf[8];
  {
    const bf16_t* qrow = P.proj + (size_t)t * INWP + OFF_Q + hd * 128 + 8 * h;
#pragma unroll
    for (int s8 = 0; s8 < 8; ++s8) qf[s8] = *(const bf16x8*)(qrow + 16 * s8);
  }
  const float* gt = P.gates + (size_t)t * 24 + hd * 3;
  const float g0 = gt[0], g1 = gt[1], g2 = gt[2];
  {
    unsigned z0 = 0u;
    asm volatile("" : "+v"(z0));
    u32x4 z = {z0, z0, z0, z0};
#pragma unroll
    for (int i = 0; i < 8; ++i) *(u32x4*)(wsm + (i * 64 + lane) * 16) = z;
    if (lane < 18) *(u32x4*)(wsm + 8192 + lane * 16) = z;
    if (tid < 8) buni[tid] = z0;
  }
  f32x16 Ob[4];
  zero_o(Ob);
  const int nmax = (t >= 31) ? ((t - 31) >> 4) : -1;
  const int nmaxw = (tok0 + 7 >= 31) ? ((tok0 + 7 - 31) >> 4) : -1;
  const int nminw = (tok0 >= 31) ? ((tok0 - 31) >> 4) : -1;
  const int ntcw = (nmaxw + 32) >> 5;
  const int ntcB = (((64 * B + 63 - 31) >> 4) + 32) >> 5;
  const float sl16 = slope2 * 16.f;
  float mC = NEGB, lC = 0.f, invC = 0.f, carry = 0.f;
  {
    const int n = 2 * ntcB;
    asm volatile("s_waitcnt vmcnt(0)" ::: "memory");
#define A_TILE(i_) (((i_) < ntcB) ? (ntcB - 1 - (i_)) : ((i_) - ntcB))
    att_issue(ring, 0, w, lane, kcf, vcf, A_TILE(0));
    if (n > 1) att_issue(ring, 1, w, lane, kcf, vcf, A_TILE(1));
#pragma unroll 1
    for (int i = 0; i < n; ++i) {
      if ((i & 1) == 0) {
        asm volatile("s_waitcnt vmcnt(0)" ::: "memory");
        __builtin_amdgcn_s_barrier();
        asm volatile("" ::: "memory");
        if (i + 2 < n) att_issue(ring, (i + 2) & 3, w, lane, kcf, vcf, A_TILE(i + 2));
        if (i + 3 < n) att_issue(ring, (i + 3) & 3, w, lane, kcf, vcf, A_TILE(i + 3));
      }
      const int T = A_TILE(i);
      if (T >= ntcw) continue;
      LAS3 const unsigned char* slot = ring + (i % ATT_R) * 16384;
      const f32x16 acc = qk_lds(slot, qf, lane);
      const float base = slope2 * (float)(512 * T + 128 * h) + slope2 * (15.5f - (float)t);
      const int nb = 32 * T + 8 * h;
      const bool full = (32 * T + 31 <= nminw);
      float sv[16];
#pragma unroll
      for (int rg = 0; rg < 16; ++rg) { const int kk = (rg & 7) + 16 * (rg >> 3); sv[rg] = fmaf(acc[rg], c1, fmaf(sl16, (float)kk, base)); }
      if (!full) {
#pragma unroll
        for (int rg = 0; rg < 16; ++rg) { const int kk = (rg & 7) + 16 * (rg >> 3); sv[rg] = (nb + kk <= nmax) ? sv[rg] : ninf; }
      }
      if (i < ntcB) {
        float tmax = fmaxf(fmaxf(fmaxf(sv[0], sv[1]), fmaxf(sv[2], sv[3])), fmaxf(fmaxf(sv[4], sv[5]), fmaxf(sv[6], sv[7])));
        tmax = fmaxf(tmax, fmaxf(fmaxf(fmaxf(sv[8], sv[9]), fmaxf(sv[10], sv[11])), fmaxf(fmaxf(sv[12], sv[13]), fmaxf(sv[14], sv[15]))));
        tmax = hmax(tmax);
        const float mn = fmaxf(mC, tmax);
        float ps = 0.f;
#pragma unroll
        for (int rg = 0; rg < 16; ++rg) ps += ex2(sv[rg] - mn);
        lC = lC * ex2(mC - mn) + ps; mC = mn;
      } else {
        if (T == 0) { lC = hsum(lC); invC = (lC > 0.f) ? 1.f / lC : 0.f; }
        float p[16];
#pragma unroll
        for (int rg = 0; rg < 16; ++rg) p[rg] = ex2(sv[rg] - mC) * invC;
        float Ga = (p[0] + p[1]) + (p[2] + p[3]), Gb = (p[4] + p[5]) + (p[6] + p[7]);
        float Gc = (p[8] + p[9]) + (p[10] + p[11]), Gd = (p[12] + p[13]) + (p[14] + p[15]);
        float xb, xd; { float a_, b_; halves(p[7], a_, b_); xb = h ? a_ : b_; halves(p[15], a_, b_); xd = h ? a_ : b_; }
        float ia = Ga + (h ? xb : carry);
        float ib = Gb + p[3];
        float ic = Gc + (h ? xd : xb);
        float id = Gd + p[11];
        carry = xd;
        ia = quad_sum(ia); ib = quad_sum(ib); ic = quad_sum(ic); id = quad_sum(id);
        {
          float val = (r == 0) ? ia : (r == 1) ? ib : (r == 2) ? ic : id;
          int j = 8 * T + 2 * h + ((r == 0) ? 0 : (r == 1) ? 1 : (r == 2) ? 4 : 5);
          impL[tokl * 256 + j] = val;
        }
        pv_lds(slot + 8192, p, Ob, lane);
      }
    }
#undef A_TILE
  }
  const int cur = B;
  d_select(impL, mskL, uniL, cur);
  ot_store(otL, lane, Ob, g0);
  zero_o(Ob);
  if (lane < 8) { const unsigned u = uniL[lane]; if (u) atomicOr(&buni[lane], u); }
  __syncthreads();
  int nslc = 0, ntl = 0;
  {
    for (int iw = 7; iw >= 0; --iw) {
      unsigned iuw = __builtin_amdgcn_readfirstlane(buni[iw]);
      while (iuw) {
        const int bit = 31 - __builtin_clz(iuw);
        iuw &= ~(1u << bit);
        const int bb = 32 * iw + bit;
        if (bb < B) { if (lane == 0) tl[ntl] = (unsigned short)(2 * bb + 1); ++ntl; }
        else { if (lane == 0) tl[ntl] = (unsigned short)(2 * bb + 1); ++ntl; }
        if (lane == 0) tl[ntl] = (unsigned short)(2 * bb);
        ++ntl;
      }
    }
    nslc = ntl;
    const int ThiB = 2 * B + 1, TloB = ((64 * B - 511 > 0) ? (64 * B - 511) : 0) >> 5;
    for (int T = ThiB; T >= TloB; --T) { if (lane == 0) tl[ntl] = (unsigned short)T; ++ntl; }
  }
  float m = NEGB, l = 0.f;
  {
    const int n = ntl;
    const int Tlow = ((tok0 - 511 > 0) ? (tok0 - 511) : 0) >> 5, Thiw = (tok0 + 7) >> 5;
#define B_ISSUE(j_, slot_) { const int e_ = __builtin_amdgcn_readfirstlane((int)tl[j_]); if ((j_) < nslc) att_issue(ring, slot_, w, lane, ksf, vsf, e_); else att_issue(ring, slot_, w, lane, kwf, vwf, e_); }
    B_ISSUE(0, 0)
    if (n > 1) B_ISSUE(1, 1)
#pragma unroll 1
    for (int i = 0; i < n; ++i) {
      if ((i & 1) == 0) {
        asm volatile("s_waitcnt vmcnt(0)" ::: "memory");
        __builtin_amdgcn_s_barrier();
        asm volatile("" ::: "memory");
        if (i + 2 < n) B_ISSUE(i + 2, (i + 2) & 3)
        if (i + 3 < n) B_ISSUE(i + 3, (i + 3) & 3)
      }
      if (i == nslc) {
        l = hsum(l);
        const float inv = (l > 0.f) ? g1 / l : 0.f;
        ot_accum(otL, lane, Ob, inv);
        ot_store(otL, lane, Ob, 1.f);
        zero_o(Ob);
        m = NEGB; l = 0.f;
      }
      const int T = __builtin_amdgcn_readfirstlane((int)tl[i]);
      const int pos0 = 32 * T, pb = pos0 + 8 * h;
      bool full; bool mine = true;
      if (i < nslc) {
        const int bb = T >> 1;
        const unsigned uw = __builtin_amdgcn_readfirstlane(uniL[bb >> 5]);
        if (!((uw >> (bb & 31)) & 1u) || pos0 > tok0 + 7) continue;
        mine = (mskL[tokl * 8 + (bb >> 5)] >> (bb & 31)) & 1u;
        full = (pos0 + 31 <= tok0) && (__ballot(!mine) == 0ull);
      } else {
        if (T < Tlow || T > Thiw) continue;
        full = (pos0 + 31 <= tok0) && (pos0 >= tok0 + 7 - 511);
      }
      LAS3 const unsigned char* slot = ring + (i % ATT_R) * 16384;
      const f32x16 acc = qk_lds(slot, qf, lane);
      const float base = slope2 * (float)(pos0 + 8 * h - t);
      float sv[16], p[16];
#pragma unroll
      for (int rg = 0; rg < 16; ++rg) { const int kk = (rg & 7) + 16 * (rg >> 3); sv[rg] = fmaf(acc[rg], c1, fmaf(slope2, (float)kk, base)); }
      if (!full) {
        if (i < nslc) {
#pragma unroll
          for (int rg = 0; rg < 16; ++rg) { const int kk = (rg & 7) + 16 * (rg >> 3); sv[rg] = (mine && (pb + kk <= t)) ? sv[rg] : ninf; }
        } else {
#pragma unroll
          for (int rg = 0; rg < 16; ++rg) { const int kk = (rg & 7) + 16 * (rg >> 3); const int dw = t - (pb + kk); sv[rg] = ((dw >= 0) && (dw < 512)) ? sv[rg] : ninf; }
        }
      }
      osm_step(sv, m, l, Ob, p);
      pv_lds(slot + 8192, p, Ob, lane);
    }
#undef B_ISSUE
    l = hsum(l);
    const float inv = (l > 0.f) ? g2 / l : 0.f;
    ot_accum(otL, lane, Ob, inv);
  }
  {
    float ss = 0.f;
#pragma unroll
    for (int dt = 0; dt < 4; ++dt)
#pragma unroll
      for (int i = 0; i < 16; ++i) ss = fmaf(Ob[dt][i], Ob[dt][i], ss);
    ss = hsum(ss);
    const float rs = rsqrtf(ss * (1.f / 128.f) + 1e-6f);
    bf16_t* orow = P.mix + (size_t)t * DM + hd * 128 + 4 * h;
    const float* grow = P.hng + hd * 128 + 4 * h;
#pragma unroll
    for (int dt = 0; dt < 4; ++dt)
#pragma unroll
      for (int a = 0; a < 4; ++a) {
        const f32x4 gv = *(const f32x4*)(grow + 32 * dt + 8 * a);
        u32x2 wv2 = {pack2(Ob[dt][4 * a] * rs * gv[0], Ob[dt][4 * a + 1] * rs * gv[1]), pack2(Ob[dt][4 * a + 2] * rs * gv[2], Ob[dt][4 * a + 3] * rs * gv[3])};
        *(u32x2*)(orow + 32 * dt + 8 * a) = wv2;
      }
  }
  asm volatile("s_waitcnt vmcnt(0)" ::: "memory");
  __syncthreads();
}

__device__ void d_convmix(int t, int tl, const bf16_t* __restrict__ proj, const float* __restrict__ convw, const float* __restrict__ hng,
                          bf16_t* __restrict__ mix) {
  const int c = tl * 8;
  float acc[8];
#pragma unroll
  for (int i = 0; i < 8; ++i) acc[i] = 0.f;
#pragma unroll
  for (int j = 0; j < 3; ++j) {
    const int tt = t - 2 + j;
    if (tt >= 0) {
      const u32x4 cu = *(const u32x4*)(proj + (size_t)tt * INWP + OFF_C + c);
      const u32x4 uu = *(const u32x4*)(proj + (size_t)tt * INWP + OFF_U + c);
      const f32x4 w0 = *(const f32x4*)(convw + j * 1024 + c), w1 = *(const f32x4*)(convw + j * 1024 + c + 4);
#pragma unroll
      for (int i = 0; i < 4; ++i) {
        const unsigned a = cu[i], b = uu[i];
        const float wl = (i < 2) ? w0[2 * i] : w1[2 * i - 4], wh = (i < 2) ? w0[2 * i + 1] : w1[2 * i - 3];
        acc[2 * i] = fmaf(wl * __uint_as_float(a << 16), __uint_as_float(b << 16), acc[2 * i]);
        acc[2 * i + 1] = fmaf(wh * __uint_as_float(a & 0xFFFF0000u), __uint_as_float(b & 0xFFFF0000u), acc[2 * i + 1]);
      }
    }
  }
  const u32x4 bb = *(const u32x4*)(proj + (size_t)t * INWP + OFF_B + c);
  float ss = 0.f;
#pragma unroll
  for (int i = 0; i < 4; ++i) {
    const unsigned b = bb[i];
    acc[2 * i] *= __uint_as_float(b << 16); acc[2 * i + 1] *= __uint_as_float(b & 0xFFFF0000u);
    ss = fmaf(acc[2 * i], acc[2 * i], ss); ss = fmaf(acc[2 * i + 1], acc[2 * i + 1], ss);
  }
  ss += shx(ss, 8); ss += shx(ss, 4); ss += shx(ss, 2); ss += shx(ss, 1);
  const float rs = rsqrtf(ss * (1.f / 128.f) + 1e-6f);
  const f32x4 g0 = *(const f32x4*)(hng + 1024 + c), g1 = *(const f32x4*)(hng + 1024 + c + 4);
  u32x4 o = {pack2(acc[0] * rs * g0[0], acc[1] * rs * g0[1]), pack2(acc[2] * rs * g0[2], acc[3] * rs * g0[3]),
             pack2(acc[4] * rs * g1[0], acc[5] * rs * g1[1]), pack2(acc[6] * rs * g1[2], acc[7] * rs * g1[3])};
  *(u32x4*)(mix + (size_t)t * DM + 1024 + c) = o;
}

__device__ void d_ln_wave(int t, const float* __restrict__ y, const float* __restrict__ gam, const float* __restrict__ bet,
                          float* __restrict__ stats, bf16_t* __restrict__ hb) {
  const int lane = TIDX & 63;
  f32x4 v[8];
#pragma unroll
  for (int i = 0; i < 8; ++i) v[i] = *(const f32x4*)(y + (size_t)t * DM + 256 * i + 4 * lane);
  float s = 0.f;
#pragma unroll
  for (int i = 0; i < 8; ++i) s += (v[i][0] + v[i][1]) + (v[i][2] + v[i][3]);
  s = wave_sum(s);
  const float mu = s * (1.f / DM);
  float q = 0.f;
#pragma unroll
  for (int i = 0; i < 8; ++i)
#pragma unroll
    for (int j = 0; j < 4; ++j) { const float d = v[i][j] - mu; q = fmaf(d, d, q); }
  q = wave_sum(q);
  const float rs = rsqrtf(q * (1.f / DM) + 1e-5f);
#pragma unroll
  for (int i = 0; i < 8; ++i) {
    const int cb = 256 * i + 4 * lane;
    const f32x4 g = *(const f32x4*)(gam + cb), b = *(const f32x4*)(bet + cb);
    u32x2 o = {pack2((v[i][0] - mu) * rs * g[0] + b[0], (v[i][1] - mu) * rs * g[1] + b[1]), pack2((v[i][2] - mu) * rs * g[2] + b[2], (v[i][3] - mu) * rs * g[3] + b[3])};
    *(u32x2*)(hb + (size_t)t * DM + cb) = o;
  }
  if (lane == 0) { stats[2 * t] = mu; stats[2 * t + 1] = rs; }
}

__device__ void d_cvt_w1f(size_t c, const float* __restrict__ w1, bf16_t* __restrict__ w1f) {
  const int lane = c & 63, ks = (c >> 6) & 255, ct = c >> 14;
  const int col = lane & 31, h = lane >> 5;
  bf16_t v[8];
#pragma unroll
  for (int j = 0; j < 8; ++j) v[j] = f2bf(w1[(size_t)(16 * ks + 8 * h + j) * 512 + 32 * ct + col]);
  u32x4 o; o.x = v[0] | ((unsigned)v[1] << 16); o.y = v[2] | ((unsigned)v[3] << 16); o.z = v[4] | ((unsigned)v[5] << 16); o.w = v[6] | ((unsigned)v[7] << 16);
  *(u32x4*)(w1f + c * 8) = o;
}
__device__ void d_cvt_w2f(size_t c, const float* __restrict__ w2, bf16_t* __restrict__ w2f) {
  const int lane = c & 63, s = (c >> 6) & 31, ct = c >> 11;
  const int col = lane & 31, h = lane >> 5;
  bf16_t v[8];
#pragma unroll
  for (int j = 0; j < 8; ++j) v[j] = f2bf(w2[(size_t)(16 * s + 8 * h + j) * 128 + 32 * ct + col]);
  u32x4 o; o.x = v[0] | ((unsigned)v[1] << 16); o.y = v[2] | ((unsigned)v[3] << 16); o.z = v[4] | ((unsigned)v[5] << 16); o.w = v[6] | ((unsigned)v[7] << 16);
  *(u32x4*)(w2f + c * 8) = o;
}
__device__ __forceinline__ void d_compress_unit(int rt, char* smem, const bf16_t* __restrict__ proj, int col0, const float* __restrict__ pos,
                                const bf16_t* __restrict__ w1f, const float* __restrict__ b1, const bf16_t* __restrict__ w2f,
                                bf16_t* __restrict__ outf, bool isV) {
  bf16_t* Xs = (bf16_t*)smem;
  bf16_t* Hs = (bf16_t*)(smem + 2 * 8704);
  const int tid = TIDX, lane = tid & 63, w = tid >> 6, c = lane & 31, h = lane >> 5;
  const int R0 = rt * 32;
  const int srow = tid >> 4, sch = tid & 15;
  const int grow = R0 + srow, sn = grow >> 1, sg = grow & 1;
  const bool svalid = grow < 2046;
  const bf16_t* sp = proj + (size_t)(16 * sn) * INWP + col0 + sg * 128 + sch * 8;
  f32x16 acc0, acc1;
#pragma unroll
  for (int i = 0; i < 16; ++i) { acc0[i] = 0.f; acc1[i] = 0.f; }
  u32x4 rx = {0u, 0u, 0u, 0u}; f32x4 rp0, rp1;
#define STAGE_WRITE(buf)                                                                                   \
  {                                                                                                        \
    u32x4 o_;                                                                                              \
    _Pragma("unroll") for (int i = 0; i < 4; ++i) {                                                        \
      const unsigned wv_ = rx[i];                                                                          \
      const float lo = __uint_as_float(wv_ << 16) + ((i < 2) ? rp0[2 * i] : rp1[2 * i - 4]);               \
      const float hi = __uint_as_float(wv_ & 0xFFFF0000u) + ((i < 2) ? rp0[2 * i + 1] : rp1[2 * i - 3]);   \
      o_[i] = pack2(lo, hi);                                                                               \
    }                                                                                                      \
    *(u32x4*)(Xs + (buf) * 4352 + srow * 136 + sch * 8) = o_;                                              \
  }
  if (svalid) rx = *(const u32x4*)(sp);
  rp0 = *(const f32x4*)(pos + sch * 8); rp1 = *(const f32x4*)(pos + sch * 8 + 4);
  STAGE_WRITE(0)
  __syncthreads();
  const bf16_t* wb0 = w1f + ((size_t)(2 * w) * 256 * 64 + lane) * 8;
  const bf16_t* wb1 = w1f + ((size_t)(2 * w + 1) * 256 * 64 + lane) * 8;
#pragma unroll 1
  for (int l = 0; l < 32; ++l) {
    if (l + 1 < 32) {
      if (svalid) rx = *(const u32x4*)(sp + (size_t)(l + 1) * INWP);
      rp0 = *(const f32x4*)(pos + (l + 1) * 128 + sch * 8); rp1 = *(const f32x4*)(pos + (l + 1) * 128 + sch * 8 + 4);
    }
    const bf16_t* xa = Xs + (l & 1) * 4352 + c * 136 + 8 * h;
#pragma unroll
    for (int s8 = 0; s8 < 8; ++s8) {
      const bf16x8 a = *(const bf16x8*)(xa + 16 * s8);
      const bf16x8 b0 = *(const bf16x8*)(wb0 + (size_t)(8 * l + s8) * 512);
      const bf16x8 b1v = *(const bf16x8*)(wb1 + (size_t)(8 * l + s8) * 512);
      acc0 = MFMA32(a, b0, acc0);
      acc1 = MFMA32(a, b1v, acc1);
    }
    if (l + 1 < 32) STAGE_WRITE((l + 1) & 1)
    __syncthreads();
  }
  {
    const float bb0 = b1[64 * w + c], bb1 = b1[64 * w + 32 + c];
#pragma unroll
    for (int rg = 0; rg < 16; ++rg) {
      const int row = (rg & 3) + 8 * (rg >> 2) + 4 * h;
      Hs[row * 520 + 64 * w + c] = f2bf(gelu_tanh(acc0[rg] + bb0));
      Hs[row * 520 + 64 * w + 32 + c] = f2bf(gelu_tanh(acc1[rg] + bb1));
    }
  }
  __syncthreads();
  if (w < 4) {
    f32x16 o2;
#pragma unroll
    for (int i = 0; i < 16; ++i) o2[i] = 0.f;
    const bf16_t* ha = Hs + c * 520 + 8 * h;
    const bf16_t* wb = w2f + ((size_t)w * 32 * 64 + lane) * 8;
#pragma unroll 8
    for (int s2 = 0; s2 < 32; ++s2) {
      const bf16x8 a = *(const bf16x8*)(ha + 16 * s2);
      const bf16x8 b = *(const bf16x8*)(wb + (size_t)s2 * 512);
      o2 = MFMA32(a, b, o2);
    }
    const int d = 32 * w + c;
#pragma unroll
    for (int rg = 0; rg < 16; ++rg) {
      const int row = R0 + (rg & 3) + 8 * (rg >> 2) + 4 * h;
      const int n = row >> 1, g = row & 1;
      const bf16_t val = (row < 2046) ? f2bf(o2[rg]) : (bf16_t)0;
      const int T = n >> 5, nn = n & 31;
      size_t idx;
      if (!isV) idx = ((((size_t)(g * 32 + T) * 8 + (d >> 4)) * 64 + (pi_perm(nn) + 32 * ((d >> 3) & 1))) * 8 + (d & 7));
      else idx = (((((size_t)(g * 32 + T) * 4 + (d >> 5)) * 2 + (nn >> 4)) * 64 + ((d & 31) + 32 * ((nn >> 3) & 1))) * 8 + (nn & 7));
      outf[idx] = val;
    }
  }
  __syncthreads();
}


DI unsigned f2sort(float f) { unsigned u = __float_as_uint(f); return u ^ ((unsigned)((int)u >> 31) | 0x80000000u); }
DI float sort2f(unsigned k) { unsigned u = (k & 0x80000000u) ? (k ^ 0x80000000u) : ~k; return __uint_as_float(u); }
template <int N>
DI void bitonic_sort_desc(unsigned (&key)[N]) {
#pragma unroll
  for (int k = 2; k <= N; k <<= 1) {
#pragma unroll
    for (int jj = k >> 1; jj > 0; jj >>= 1) {
#pragma unroll
      for (int i = 0; i < N; ++i) {
        const int l2 = i ^ jj;
        if (l2 > i) {
          const bool desc = ((i & k) == 0);
          unsigned a = key[i], b = key[l2];
          unsigned mx = a > b ? a : b, mn = a > b ? b : a;
          key[i] = desc ? mx : mn; key[l2] = desc ? mn : mx;
        }
      }
    }
  }
}
DI void merge_top16(unsigned (&a)[16], const unsigned (&b)[16]) {
#pragma unroll
  for (int i = 0; i < 16; ++i) { unsigned o = b[15 - i]; a[i] = a[i] > o ? a[i] : o; }
#pragma unroll
  for (int jj = 8; jj > 0; jj >>= 1) {
#pragma unroll
    for (int i = 0; i < 16; ++i) {
      const int l2 = i ^ jj;
      if (l2 > i) { unsigned x = a[i], y = a[l2]; a[i] = x > y ? x : y; a[l2] = x > y ? y : x; }
    }
  }
}
__device__ void d_cvt_subk(size_t c, const float* __restrict__ subk, bf16_t* __restrict__ skf) {
  int lane = c & 63, s = (c >> 6) & 7, kt = (c >> 9) & 3, hc = c >> 11;
  int i = lane & 31, h = lane >> 5;
  const float* src = subk + ((size_t)hc * 128 + 32 * kt + i) * 128 + 16 * s + 8 * h;
  bf16_t v[8];
#pragma unroll
  for (int j = 0; j < 8; ++j) v[j] = f2bf(src[j]);
  u32x4 o; o.x = v[0] | ((unsigned)v[1] << 16); o.y = v[2] | ((unsigned)v[3] << 16); o.z = v[4] | ((unsigned)v[5] << 16); o.w = v[6] | ((unsigned)v[7] << 16);
  *(u32x4*)(skf + c * 8) = o;
}

struct EpiProjG {
  static constexpr bool PERM = true, AFTER_DRAIN = false;
  bf16_t* proj; float* gates;
  DI void operator()(const f32x4 (&acc)[2][2][4][2], const pg8::Unit& u, int wr, int wc, int fr, int fq) const {
#pragma unroll
    for (int ai = 0; ai < 2; ++ai)
#pragma unroll
      for (int m = 0; m < 4; ++m) {
        const int row = u.pm * 256 + ai * 128 + wr * 64 + m * 16 + fr;
#pragma unroll
        for (int bj = 0; bj < 2; ++bj) {
          const int c0 = u.pn * 256 + bj * 128 + wc * 32 + 8 * fq;
          const f32x4 v0 = acc[ai][bj][m][0], v1 = acc[ai][bj][m][1];
          if (c0 < INW) {
            u32x4 w = {pack2(v0[0], v0[1]), pack2(v0[2], v0[3]), pack2(v1[0], v1[1]), pack2(v1[2], v1[3])};
            *(u32x4*)(proj + (size_t)row * INWP + c0) = w;
          }
          if (c0 >= OFF_G && c0 < OFF_G + 24) {
            f32x4 g0, g1;
#pragma unroll
            for (int j = 0; j < 4; ++j) { g0[j] = 1.f / (1.f + __expf(-v0[j])); g1[j] = 1.f / (1.f + __expf(-v1[j])); }
            *(f32x4*)(gates + (size_t)row * 24 + (c0 - OFF_G)) = g0;
            *(f32x4*)(gates + (size_t)row * 24 + (c0 - OFF_G) + 4) = g1;
          }
        }
      }
  }
};
struct EpiResG {
  static constexpr bool PERM = false, AFTER_DRAIN = false;
  float* Y; const float* X;
  DI void operator()(const f32x4 (&acc)[2][2][4][2], const pg8::Unit& u, int wr, int wc, int fr, int fq) const {
#pragma unroll
    for (int ai = 0; ai < 2; ++ai)
#pragma unroll
      for (int m = 0; m < 4; ++m) {
        const size_t ro = (size_t)(u.pm * 256 + ai * 128 + wr * 64 + m * 16 + fr) * DM + u.pn * 256 + wc * 32 + 4 * fq;
#pragma unroll
        for (int bj = 0; bj < 2; ++bj)
#pragma unroll
          for (int n = 0; n < 2; ++n) {
            const f32x4 xv = *(const f32x4*)(X + ro + bj * 128 + n * 16);
            *(f32x4*)(Y + ro + bj * 128 + n * 16) = ALPHA * xv + acc[ai][bj][m][n];
          }
      }
  }
};
struct EpiF32G {
  static constexpr bool PERM = false, AFTER_DRAIN = false;
  float* C; int ldc;
  DI void operator()(const f32x4 (&acc)[2][2][4][2], const pg8::Unit& u, int wr, int wc, int fr, int fq) const {
#pragma unroll
    for (int ai = 0; ai < 2; ++ai)
#pragma unroll
      for (int m = 0; m < 4; ++m) {
        const size_t ro = (size_t)(u.pm * 256 + ai * 128 + wr * 64 + m * 16 + fr) * ldc + u.pn * 256 + wc * 32 + 4 * fq;
#pragma unroll
        for (int bj = 0; bj < 2; ++bj)
#pragma unroll
          for (int n = 0; n < 2; ++n) *(f32x4*)(C + ro + bj * 128 + n * 16) = acc[ai][bj][m][n];
      }
  }
};
struct EpiRouteG {
  static constexpr bool PERM = false, AFTER_DRAIN = true;
  const bf16_t* skf; unsigned* tops;
  DI void operator()(const f32x4 (&)[2][2][4][2], const pg8::Unit&, int, int, int, int) const {}
  DI void fused(const f32x4 (&acc)[2][2][4][2], const pg8::Unit& u, int wr, int wc, int fr, int fq, PG8_LAS unsigned char* ldsp, int, int) const {
    const int lane = fr | (fq << 4), wid = wr * 4 + wc;
    bf16_t* Qs = (bf16_t*)ldsp;
#pragma unroll
    for (int ai = 0; ai < 2; ++ai)
#pragma unroll
      for (int m = 0; m < 4; ++m) {
        const int row = ai * 128 + wr * 64 + m * 16 + fr;
#pragma unroll
        for (int bj = 0; bj < 2; ++bj)
#pragma unroll
          for (int n = 0; n < 2; ++n) {
            const f32x4 v = acc[ai][bj][m][n];
            u32x2 w = {pack2(v[0], v[1]), pack2(v[2], v[3])};
            *(u32x2*)(Qs + row * 264 + bj * 128 + wc * 32 + n * 16 + 4 * fq) = w;
          }
      }
    __syncthreads();
    const int c = lane & 31, h = lane >> 5;
#pragma unroll 1
    for (int half = 0; half < 2; ++half) {
      const int hc = u.pn * 2 + half;
      const bf16_t* sk = skf + (size_t)hc * 4 * 4096;
      const bf16_t* qp = Qs + (wid * 32 + c) * 264 + half * 128 + 8 * h;
      unsigned k0[16], k1[16];
#define ROUTE_KT(KT, KA)                                                                        \
      {                                                                                         \
        f32x16 sc;                                                                              \
        _Pragma("unroll") for (int i = 0; i < 16; ++i) sc[i] = 0.f;                             \
        _Pragma("unroll") for (int s = 0; s < 8; ++s) {                                         \
          bf16x8 af = *(const bf16x8*)(sk + (KT) * 4096 + s * 512 + lane * 8);                  \
          bf16x8 bq = *(const bf16x8*)(qp + 16 * s);                                            \
          sc = __builtin_amdgcn_mfma_f32_32x32x16_bf16(af, bq, sc, 0, 0, 0);                    \
        }                                                                                       \
        _Pragma("unroll") for (int rg = 0; rg < 16; ++rg) {                                     \
          const int kidx = 32 * (KT) + (rg & 3) + 8 * (rg >> 2) + 4 * h;                        \
          KA[rg] = (f2sort(sc[rg]) & 0xFFFFFF80u) | (unsigned)(127 - kidx);                     \
        }                                                                                       \
        bitonic_sort_desc<16>(KA);                                                              \
      }
      ROUTE_KT(0, k0)
      __builtin_amdgcn_sched_barrier(0);
      ROUTE_KT(1, k1)
      merge_top16(k0, k1);
      __builtin_amdgcn_sched_barrier(0);
      ROUTE_KT(2, k1)
      merge_top16(k0, k1);
      __builtin_amdgcn_sched_barrier(0);
      ROUTE_KT(3, k1)
      merge_top16(k0, k1);
      __builtin_amdgcn_sched_barrier(0);
#undef ROUTE_KT
#pragma unroll
      for (int i = 0; i < 16; ++i) k1[i] = (unsigned)shx_i((int)k0[i], 32);
      merge_top16(k0, k1);
      if (h == 0) {
        unsigned* dst = tops + ((size_t)(u.pm * 256 + wid * 32 + c) * 16 + hc) * 16;
#pragma unroll
        for (int q4 = 0; q4 < 4; ++q4) { u32x4 o = {k0[4 * q4], k0[4 * q4 + 1], k0[4 * q4 + 2], k0[4 * q4 + 3]}; *(u32x4*)(dst + 4 * q4) = o; }
      }
    }
    __syncthreads();
  }
};


template <int CTRL> DI float dpp_f(float v) { const int iv = __float_as_int(v); return __int_as_float(__builtin_amdgcn_update_dpp(iv, iv, CTRL, 0xF, 0xF, false)); }
DI float wsum(float x) {
  x += dpp_f<0xB1>(x);
  x += dpp_f<0x4E>(x);
  x += dpp_f<0x124>(x);
  x += dpp_f<0x128>(x);
  x += shx(x, 16);
  return hsum(x);
}
DI float gelu_fast(float x) {
  const float u2 = 1.5957691216057308f * (x + 0.044715f * x * x * x);
  return x * __builtin_amdgcn_rcpf(1.f + ex2(-LOG2E * u2));
}

constexpr int EROW = 1152;
typedef float v2f __attribute__((ext_vector_type(2)));
__device__ void d_cvt_fp4_row(int row, const float* __restrict__ src, unsigned char* __restrict__ dst) {
  const int lane = TIDX & 63;
  float v[32]; float amax = 0.f;
#pragma unroll
  for (int i = 0; i < 8; ++i) {
    f32x4 x = *(const f32x4*)(src + (size_t)row * DM + 256 * i + 4 * lane);
#pragma unroll
    for (int j = 0; j < 4; ++j) { v[i * 4 + j] = x[j]; amax = fmaxf(amax, fabsf(x[j])); }
  }
  const float sc = amax > 0.f ? amax * (1.f / 6.f) : 1.f;
  const float scb = bf2f(f2bf(sc));
  const float inv = 1.f / scb;
  u32x4 o;
#pragma unroll
  for (int k = 0; k < 4; ++k) {
    unsigned w = 0u;
#define FP4C(x_) fminf(fmaxf((x_) * inv, -6.f), 6.f)
    w = __builtin_amdgcn_cvt_scalef32_pk_fp4_f32(w, FP4C(v[8 * k + 0]), FP4C(v[8 * k + 1]), 1.0f, 0);
    w = __builtin_amdgcn_cvt_scalef32_pk_fp4_f32(w, FP4C(v[8 * k + 2]), FP4C(v[8 * k + 3]), 1.0f, 1);
    w = __builtin_amdgcn_cvt_scalef32_pk_fp4_f32(w, FP4C(v[8 * k + 4]), FP4C(v[8 * k + 5]), 1.0f, 2);
    w = __builtin_amdgcn_cvt_scalef32_pk_fp4_f32(w, FP4C(v[8 * k + 6]), FP4C(v[8 * k + 7]), 1.0f, 3);
#undef FP4C
    o[k] = w;
  }
  *(u32x4*)(dst + (size_t)row * EROW + 16 * lane) = o;
  *(bf16_t*)(dst + (size_t)row * EROW + 1024 + 2 * lane) = f2bf(sc);
}
__device__ void d_expert_wave(int t, unsigned* tpl, const float* __restrict__ yf, const float* __restrict__ stats, const float* __restrict__ g1v, const float* __restrict__ b1v,
                              const unsigned* __restrict__ tops, const unsigned char* __restrict__ eu4, const unsigned char* __restrict__ ev4,
                              const float* __restrict__ gam, const float* __restrict__ bet, float* __restrict__ out) {
  const int lane = TIDX & 63;
  const float mu1 = stats[2 * t], rs1 = stats[2 * t + 1];
  float hv[32];
#pragma unroll
  for (int i = 0; i < 8; ++i) {
    const int cb = 256 * i + 4 * lane;
    const f32x4 x = *(const f32x4*)(yf + (size_t)t * DM + cb), gg = *(const f32x4*)(g1v + cb), bb = *(const f32x4*)(b1v + cb);
#pragma unroll
    for (int j = 0; j < 4; ++j) hv[i * 4 + j] = (x[j] - mu1) * rs1 * gg[j] + bb[j];
  }
  int e0 = 0, e1 = 0; float w0 = 0.f, w1 = 0.f;
  {
    const int ci = (lane < 16) ? 0 : (lane < 24) ? 1 : (lane < 29) ? 2 : (lane < 33) ? 3 : (lane < 36) ? 4 : (lane < 38) ? 5 : (lane < 40) ? 6
                   : (lane < 42) ? 7 : (lane - 34);
    const int cpre = (ci == 0) ? 0 : (ci == 1) ? 16 : (ci == 2) ? 24 : (ci == 3) ? 29 : (ci == 4) ? 33 : (ci == 5) ? 36 : (ci == 6) ? 38
                     : (ci == 7) ? 40 : (34 + ci);
    const int cj = lane - cpre;
    const bool cvalid = lane < 50;
    *(u32x4*)(tpl + 4 * lane) = *(const u32x4*)(tops + (size_t)t * 256 + 4 * lane);
    const unsigned* tp = tpl;
#pragma unroll 1
    for (int hh = 0; hh < 8; ++hh) {
      unsigned key = 0u;
      if (cvalid) {
        const float sa = sort2f(tp[(2 * hh) * 16 + ci]), sb = sort2f(tp[(2 * hh + 1) * 16 + cj]);
        key = (f2sort(sa + sb) & 0xFFFFFF00u) | (unsigned)(255 - (ci * 16 + cj));
      }
#pragma unroll
      for (int k = 2; k <= 64; k <<= 1) {
#pragma unroll
        for (int jj = k >> 1; jj > 0; jj >>= 1) {
          const unsigned o = (unsigned)shx_i((int)key, jj);
          const bool lower = (lane & jj) == 0;
          const bool desc = (lane & k) == 0 || k == 64;
          const unsigned mx = key > o ? key : o, mn = key > o ? o : key;
          key = (lower == desc) ? mx : mn;
        }
      }
      const int flat = 255 - (int)(key & 255u);
      const int bi = (flat >> 4) & 15, bj = flat & 15;
      const unsigned ka = tp[(2 * hh) * 16 + bi], kb = tp[(2 * hh + 1) * 16 + bj];
      const float sc = sort2f(ka) + sort2f(kb);
      const int ex = (127 - (int)(ka & 127u)) * 128 + (127 - (int)(kb & 127u));
      float mx = sc;
      mx = fmaxf(mx, shx(mx, 1)); mx = fmaxf(mx, shx(mx, 2)); mx = fmaxf(mx, shx(mx, 4)); mx = fmaxf(mx, shx(mx, 8));
      const float ev_ = __expf(sc - mx);
      float sm = ev_;
      sm += shx(sm, 1); sm += shx(sm, 2); sm += shx(sm, 4); sm += shx(sm, 8);
      const float gv = ev_ / sm;
      const int exs = __shfl(ex, lane & 15); const float gvs = __shfl(gv, lane & 15);
      if ((lane >> 4) == (hh & 3)) { if (hh < 4) { e0 = exs; w0 = gvs; } else { e1 = exs; w1 = gvs; } }
    }
  }
  bf16x2v hb2[16];
#pragma unroll
  for (int i = 0; i < 16; ++i) hb2[i] = bf16x2v{(__bf16)hv[2 * i], (__bf16)hv[2 * i + 1]};
  float c0 = 0.f, c1 = 0.f;
  u32x4 rA[4], rB[4]; unsigned short sA[4], sB[4];
#define EX_LOAD(R, SS, TAB, EB)                                                            \
  _Pragma("unroll") for (int k = 0; k < 4; ++k) {                                          \
    const int e = (EB) + k;                                                                \
    const int id = __builtin_amdgcn_readlane((e < 64) ? e0 : e1, e & 63);                 \
    const unsigned char* row = (TAB) + (size_t)id * EROW;                                  \
    R[k] = *(const u32x4*)(row + 16 * lane);                                               \
    SS[k] = *(const unsigned short*)(row + 1024 + 2 * lane);                               \
  }
#define PKFMA(a_, b_, c_) __builtin_elementwise_fma((a_), (b_), (c_))
#define EX_COMP_U(R, SS, EB)                                                               \
  {                                                                                        \
    float dd[4];                                                                           \
    _Pragma("unroll") for (int k = 0; k < 4; ++k) {                                        \
      float d0 = 0.f, d1 = 0.f;                                                            \
      _Pragma("unroll") for (int q = 0; q < 4; ++q) {                                      \
        const unsigned wq = R[k][q];                                                       \
        d0 = __builtin_amdgcn_fdot2_f32_bf16(__builtin_amdgcn_cvt_scalef32_pk_bf16_fp4(wq, 1.0f, 0), hb2[4 * q + 0], d0, false); \
        d1 = __builtin_amdgcn_fdot2_f32_bf16(__builtin_amdgcn_cvt_scalef32_pk_bf16_fp4(wq, 1.0f, 1), hb2[4 * q + 1], d1, false); \
        d0 = __builtin_amdgcn_fdot2_f32_bf16(__builtin_amdgcn_cvt_scalef32_pk_bf16_fp4(wq, 1.0f, 2), hb2[4 * q + 2], d0, false); \
        d1 = __builtin_amdgcn_fdot2_f32_bf16(__builtin_amdgcn_cvt_scalef32_pk_bf16_fp4(wq, 1.0f, 3), hb2[4 * q + 3], d1, false); \
      }                                                                                    \
      dd[k] = bf2f(SS[k]) * (d0 + d1);                                                     \
      __builtin_amdgcn_sched_barrier(0);                                                   \
    }                                                                                      \
    _Pragma("unroll") for (int k = 0; k < 4; ++k) dd[k] = wsum(dd[k]);                     \
    _Pragma("unroll") for (int k = 0; k < 4; ++k) {                                        \
      const int e = (EB) + k;                                                              \
      const float gl = gelu_fast(dd[k]);                                                   \
      if (e < 64) { if (lane == e) c0 = w0 * gl; } else { if (lane == e - 64) c1 = w1 * gl; } \
    }                                                                                      \
    __builtin_amdgcn_sched_barrier(0);                                                     \
  }
#define EX_COMP_V(R, SS, EB)                                                               \
  _Pragma("unroll") for (int k = 0; k < 4; ++k) {                                          \
    const int e = (EB) + k;                                                                \
    const float cs = __int_as_float(__builtin_amdgcn_readlane(__float_as_int((e < 64) ? c0 : c1), e & 63)) * bf2f(SS[k]);                     \
    const v2f cs2 = {cs, cs};                                                              \
    _Pragma("unroll") for (int q = 0; q < 4; ++q) {                                        \
      const unsigned wq = R[k][q];                                                         \
      const v2f f0 = __builtin_amdgcn_cvt_scalef32_pk_f32_fp4(wq, 1.0f, 0), f1 = __builtin_amdgcn_cvt_scalef32_pk_f32_fp4(wq, 1.0f, 1); \
      const v2f f2 = __builtin_amdgcn_cvt_scalef32_pk_f32_fp4(wq, 1.0f, 2), f3 = __builtin_amdgcn_cvt_scalef32_pk_f32_fp4(wq, 1.0f, 3); \
      acc2[4 * q + 0] = PKFMA(cs2, f0, acc2[4 * q + 0]); acc2[4 * q + 1] = PKFMA(cs2, f1, acc2[4 * q + 1]); \
      acc2[4 * q + 2] = PKFMA(cs2, f2, acc2[4 * q + 2]); acc2[4 * q + 3] = PKFMA(cs2, f3, acc2[4 * q + 3]); \
    }                                                                                      \
    __builtin_amdgcn_sched_barrier(0);                                                     \
  }
  EX_LOAD(rA, sA, eu4, 0)
  __builtin_amdgcn_sched_barrier(0);
#pragma unroll 1
  for (int eb = 0; eb < 128; eb += 8) {
    EX_LOAD(rB, sB, eu4, eb + 4)
    __builtin_amdgcn_sched_barrier(0);
    EX_COMP_U(rA, sA, eb)
    { const bool more = eb + 8 < 128; const unsigned char* tabn = more ? eu4 : ev4; const int ebn = more ? eb + 8 : 0;
      EX_LOAD(rA, sA, tabn, ebn) }
    __builtin_amdgcn_sched_barrier(0);
    EX_COMP_U(rB, sB, eb + 4)
  }
  v2f acc2[16];
#pragma unroll
  for (int i = 0; i < 16; ++i) acc2[i] = v2f{0.f, 0.f};
#pragma unroll 1
  for (int eb = 0; eb < 128; eb += 8) {
    EX_LOAD(rB, sB, ev4, eb + 4)
    __builtin_amdgcn_sched_barrier(0);
    EX_COMP_V(rA, sA, eb)
    { const int ebn = (eb + 8 < 128) ? eb + 8 : 0;
      EX_LOAD(rA, sA, ev4, ebn) }
    __builtin_amdgcn_sched_barrier(0);
    EX_COMP_V(rB, sB, eb + 4)
  }
#undef EX_LOAD
#undef EX_COMP_U
#undef EX_COMP_V
#undef PKFMA
  float acc[32];
#pragma unroll
  for (int i = 0; i < 16; ++i) { acc[2 * i] = acc2[i].x; acc[2 * i + 1] = acc2[i].y; }
  int le = lane;
  asm volatile("" : "+v"(le) :: "memory");
  float s = 0.f;
#pragma unroll
  for (int i = 0; i < 8; ++i) {
    const int cb = 256 * i + 4 * le;
    const f32x4 x = *(const f32x4*)(yf + (size_t)t * DM + cb), gg = *(const f32x4*)(g1v + cb), bb = *(const f32x4*)(b1v + cb);
#pragma unroll
    for (int j = 0; j < 4; ++j) { const float hj = (x[j] - mu1) * rs1 * gg[j] + bb[j]; acc[i * 4 + j] = fmaf(ALPHA, hj, acc[i * 4 + j]); s += acc[i * 4 + j]; }
  }
  s = wsum(s);
  const float mu = s * (1.f / DM);
  float qv = 0.f;
#pragma unroll
  for (int i = 0; i < 32; ++i) { const float d = acc[i] - mu; qv += d * d; }
  qv = wsum(qv);
  const float rs = rsqrtf(qv * (1.f / DM) + 1e-5f);
#pragma unroll
  for (int i = 0; i < 8; ++i) {
    const int cbase = 256 * i + 4 * le;
    f32x4 ga = *(const f32x4*)(gam + cbase), ba = *(const f32x4*)(bet + cbase), o;
#pragma unroll
    for (int j = 0; j < 4; ++j) o[j] = (acc[i * 4 + j] - mu) * rs * ga[j] + ba[j];
    *(f32x4*)(out + (size_t)t * DM + cbase) = o;
  }
}

constexpr size_t al256(size_t x) { return (x + 255) & ~(size_t)255; }
constexpr size_t WS_XB = 0;
constexpr size_t WS_PROJ = WS_XB + al256((size_t)S * DM * 2);
constexpr size_t WS_WINT = WS_PROJ + al256((size_t)S * INWP * 2);
constexpr size_t WS_GATES = WS_WINT + al256((size_t)INWG * DM * 2);
constexpr size_t WS_W1KF = WS_GATES + al256((size_t)S * 24 * 4);
constexpr size_t WS_W1VF = WS_W1KF + al256((size_t)512 * 4096 * 2);
constexpr size_t WS_W2KF = WS_W1VF + al256((size_t)512 * 4096 * 2);
constexpr size_t WS_W2VF = WS_W2KF + al256((size_t)512 * 128 * 2);
constexpr size_t WS_VC = WS_W2VF + al256((size_t)512 * 128 * 2) - al256((size_t)2048 * 128 * 4);
constexpr size_t WS_KCF = WS_VC + al256((size_t)2048 * 128 * 4);
constexpr size_t WS_VCF = WS_KCF + al256((size_t)2 * 32 * 4096 * 2);
constexpr size_t WS_KSF = WS_VCF + al256((size_t)2 * 32 * 4096 * 2);
constexpr size_t WS_VSF = WS_KSF + al256((size_t)2 * 512 * 4096 * 2);
constexpr size_t WS_KWF = WS_VSF + al256((size_t)2 * 512 * 4096 * 2);
constexpr size_t WS_VWF = WS_KWF + al256((size_t)2 * 512 * 4096 * 2);
constexpr size_t WS_ENDA = WS_VWF + al256((size_t)2 * 512 * 4096 * 2);
constexpr size_t WS_OATT = WS_ENDA;
constexpr size_t WS_MIX = WS_OATT + al256((size_t)S * 1024 * 4);
constexpr size_t WS_WOUTT = WS_MIX + al256((size_t)S * DM * 2);
constexpr size_t WS_WQT = WS_WOUTT + al256((size_t)DM * DM * 2);
constexpr size_t WS_TOPS = WS_WQT + al256((size_t)DM * DM * 2);
constexpr size_t WS_SKF = WS_TOPS + al256((size_t)S * 256 * 4);
constexpr size_t WS_STATS = WS_SKF + al256((size_t)16 * 128 * 128 * 2);
constexpr size_t WS_CTRL = WS_STATS + al256((size_t)S * 2 * 4);
constexpr size_t CTRL_BYTES = 32768;
constexpr size_t WS_END = WS_CTRL + CTRL_BYTES;
constexpr size_t WS_Y = WS_PROJ;
constexpr size_t WS_HB = WS_XB;
constexpr size_t WS_EU8 = WS_Y + (size_t)S * DM * 4;
constexpr size_t WS_EV8 = WS_EU8 + (size_t)16384 * 1152;
static_assert(WS_EV8 + (size_t)16384 * 1152 <= WS_ENDA, "expert overlay overflows group A");
static_assert(WS_END <= (size_t)512 * 1024 * 1024, "workspace over 512 MiB");

struct Params {
  const float *x, *w_in, *ck_pos, *ck_w1, *ck_b1, *ck_w2, *cv_pos, *cv_w1, *cv_b1, *cv_w2, *conv_w, *hng, *w_out, *ln1g, *ln1b, *w_query, *subk,
      *eu, *ev, *ln2g, *ln2b;
  float* out;
  char* ws;
};
#define WSP(T, OFF) ((T*)(p.ws + (OFF)))

#define FOR_VB(n) for (int vb = blockIdx.x; vb < (n); vb += gridDim.x)
#define FOR_VB2(n) for (int vb = blockIdx.x * 2 + (TIDX >> 8); vb < (n); vb += gridDim.x * 2)
constexpr int SMEM_BYTES = 143360;
constexpr int HALF = 36864;

__global__ void __launch_bounds__(512) mega(Params p) {
  __shared__ __attribute__((aligned(16))) char smem[SMEM_BYTES + 16];
  if (TIDX == 0) *(u32x4*)(smem + SMEM_BYTES) = u32x4{0u, 0u, 0u, 0u};
  __syncthreads();
  const XcdBarrier xbar = xcd_barrier_post(WSP(unsigned, WS_CTRL + 1024), (volatile LAS unsigned*)(smem + SMEM_BYTES));
#define smh (smem + (TIDX >> 8) * HALF)
#define wv ((TIDX >> 6))
  constexpr int NWV = 8;
  d_cvt(p.x, WSP(bf16_t, WS_XB), (size_t)S * DM / 4);
  FOR_VB2((INWG / 64) * (DM / 64)) d_cvtT64(vb, smh, p.w_in, WSP(bf16_t, WS_WINT), DM, INW, INWG);
  for (size_t c = (size_t)blockIdx.x * 512 + TIDX; c < (size_t)16 * 256 * 64; c += (size_t)gridDim.x * 512) {
    d_cvt_w1f(c, p.ck_w1, WSP(bf16_t, WS_W1KF)); d_cvt_w1f(c, p.cv_w1, WSP(bf16_t, WS_W1VF));
    if (c < (size_t)4 * 32 * 64) { d_cvt_w2f(c, p.ck_w2, WSP(bf16_t, WS_W2KF)); d_cvt_w2f(c, p.cv_w2, WSP(bf16_t, WS_W2VF)); }
  }
  FOR_VB2((DM / 64) * (DM / 64)) d_cvtT64(vb, smh, p.w_out, WSP(bf16_t, WS_WOUTT), DM, DM, DM);
  FOR_VB2((DM / 64) * (DM / 64)) d_cvtT64(vb, smh, p.w_query, WSP(bf16_t, WS_WQT), DM, DM, DM);
  for (size_t c = (size_t)blockIdx.x * 512 + TIDX; c < (size_t)16 * 4 * 8 * 64; c += (size_t)gridDim.x * 512) d_cvt_subk(c, p.subk, WSP(bf16_t, WS_SKF));
  xcd_barrier(xbar);
  {
    pg8::StaticOrder so; so.init(S, INWG, gridDim.x, blockIdx.x);
    pg8::gemm_phase<EpiProjG, pg8::StaticOrder>((PG8_LAS unsigned char*)smem, pg8::Gemm{WSP(bf16_t, WS_XB), WSP(bf16_t, WS_WINT), S, INWG, DM}, so,
                                                EpiProjG{WSP(bf16_t, WS_PROJ), WSP(float, WS_GATES)}, nullptr);
  }
  xcd_barrier(xbar);
  {
    if (blockIdx.x < 128) {
      const int u = blockIdx.x; const bool isV = u >= 64;
      d_compress_unit(u & 63, smem, WSP(bf16_t, WS_PROJ), isV ? OFF_VC : OFF_KC, isV ? p.cv_pos : p.ck_pos, isV ? WSP(bf16_t, WS_W1VF) : WSP(bf16_t, WS_W1KF),
                      isV ? p.cv_b1 : p.ck_b1, isV ? WSP(bf16_t, WS_W2VF) : WSP(bf16_t, WS_W2KF), isV ? WSP(bf16_t, WS_VCF) : WSP(bf16_t, WS_KCF), isV);
    }
    int* slot = (int*)smem;
    unsigned* ctr = WSP(unsigned, WS_CTRL);
    for (;;) {
      if (TIDX == 0) *slot = (int)atomicAdd(ctr, 1u);
      __syncthreads();
      const int it = *slot;
      __syncthreads();
      if (it >= 2048) break;
      const int tt = TIDX;
      {
        const int T = it >> 2, which = it & 3;
        d_relayout_tile(T, smem + 64, WSP(bf16_t, WS_PROJ), (which == 0) ? OFF_KS : (which == 1) ? OFF_VS : (which == 2) ? OFF_KW : OFF_VW,
                        (which == 0) ? WSP(bf16_t, WS_KSF) : (which == 1) ? WSP(bf16_t, WS_VSF) : (which == 2) ? WSP(bf16_t, WS_KWF) : WSP(bf16_t, WS_VWF), (which & 1) != 0);
      }
      for (int q = 0; q < 2; ++q) d_convmix(it * 8 + q * 4 + (tt >> 7), tt & 127, WSP(bf16_t, WS_PROJ), p.conv_w, p.hng, WSP(bf16_t, WS_MIX));
    }
  }
  xcd_barrier(xbar);
  {
    AttnPtrs ap{WSP(bf16_t, WS_PROJ), WSP(float, WS_GATES), WSP(bf16_t, WS_KCF), WSP(bf16_t, WS_VCF), WSP(bf16_t, WS_KSF), WSP(bf16_t, WS_VSF), WSP(bf16_t, WS_KWF), WSP(bf16_t, WS_VWF), WSP(bf16_t, WS_MIX), p.hng};
    for (int it = blockIdx.x; it < 512; it += gridDim.x) {
      const int Bq = (it < 256) ? it : (511 - it), gq = (it < 256) ? 0 : 1;
      d_attn_block(Bq, gq, smem, ap);
    }
  }
  xcd_barrier(xbar);
  {
    pg8::StaticOrder so; so.init(S, DM, gridDim.x, blockIdx.x);
    pg8::gemm_phase<EpiResG, pg8::StaticOrder>((PG8_LAS unsigned char*)smem, pg8::Gemm{WSP(bf16_t, WS_MIX), WSP(bf16_t, WS_WOUTT), S, DM, DM}, so,
                                               EpiResG{WSP(float, WS_Y), p.x}, nullptr);
  }
  xcd_barrier(xbar);
  for (int r = blockIdx.x * NWV + wv; r < S; r += gridDim.x * NWV) d_ln_wave(r, WSP(float, WS_Y), p.ln1g, p.ln1b, WSP(float, WS_STATS), WSP(bf16_t, WS_HB));
  for (int r = blockIdx.x * NWV + wv; r < 32768; r += gridDim.x * NWV) {
    if (r < 16384) d_cvt_fp4_row(r, p.eu, WSP(unsigned char, WS_EU8)); else d_cvt_fp4_row(r - 16384, p.ev, WSP(unsigned char, WS_EV8));
  }
  xcd_barrier(xbar);
  for (int k = 0; k * (int)gridDim.x < (S / 256) * (DM / 256); ++k) {
    pg8::OneUnit so; so.init(S, DM, gridDim.x, blockIdx.x); so.k = k;
    pg8::gemm_phase<EpiRouteG, pg8::OneUnit>((PG8_LAS unsigned char*)smem, pg8::Gemm{WSP(bf16_t, WS_HB), WSP(bf16_t, WS_WQT), S, DM, DM}, so,
                                             EpiRouteG{WSP(bf16_t, WS_SKF), WSP(unsigned, WS_TOPS)}, nullptr);
    __syncthreads();
  }
  xcd_barrier(xbar);
  for (int t = blockIdx.x * NWV + wv; t < S; t += gridDim.x * NWV) d_expert_wave(t, (unsigned*)(smem + wv * 1024), WSP(float, WS_Y), WSP(float, WS_STATS), p.ln1g, p.ln1b, WSP(unsigned, WS_TOPS), WSP(unsigned char, WS_EU8), WSP(unsigned char, WS_EV8), p.ln2g, p.ln2b, p.out);
}

extern "C" void kernel_launch(void* const* d_in, const int* in_sizes, int n_in, void* d_out, int out_size, void* d_ws, size_t ws_size,
                              hipStream_t stream) {
  Params p{};
  p.x = (const float*)d_in[0]; p.w_in = (const float*)d_in[1]; p.ck_pos = (const float*)d_in[2]; p.ck_w1 = (const float*)d_in[3];
  p.ck_b1 = (const float*)d_in[4]; p.ck_w2 = (const float*)d_in[5]; p.cv_pos = (const float*)d_in[6]; p.cv_w1 = (const float*)d_in[7];
  p.cv_b1 = (const float*)d_in[8]; p.cv_w2 = (const float*)d_in[9]; p.conv_w = (const float*)d_in[10]; p.hng = (const float*)d_in[11];
  p.w_out = (const float*)d_in[12]; p.ln1g = (const float*)d_in[13]; p.ln1b = (const float*)d_in[14]; p.w_query = (const float*)d_in[15];
  p.subk = (const float*)d_in[16]; p.eu = (const float*)d_in[17]; p.ev = (const float*)d_in[18]; p.ln2g = (const float*)d_in[19];
  p.ln2b = (const float*)d_in[20];
  p.out = (float*)d_out;
  p.ws = (char*)d_ws;
  if (ws_size < WS_END) fprintf(stderr, "workspace too small\n");
  static int grid_blocks = 0;
  if (!grid_blocks) {
    int dev = 0, cus = 0, per_cu = 0;
    hipGetDevice(&dev);
    hipDeviceGetAttribute(&cus, hipDeviceAttributeMultiprocessorCount, dev);
    hipOccupancyMaxActiveBlocksPerMultiprocessor(&per_cu, mega, 512, 0);
    if (per_cu > 1) per_cu = 1;
    if (per_cu < 1) per_cu = 1;
    grid_blocks = cus * per_cu;
  }
  hipMemsetAsync((char*)d_ws + WS_CTRL, 0, CTRL_BYTES, stream);
  void* args[] = {&p};
  hipError_t e = hipLaunchCooperativeKernel((void*)mega, dim3(grid_blocks), dim3(512), args, 0, stream);
  if (e != hipSuccess) fprintf(stderr, "cooperative launch failed: %s (grid %d)\n", hipGetErrorString(e), grid_blocks);
}
```

```cpp
#include <hip/hip_runtime.h>
#include <stdint.h>
#include <stdio.h>


#define DI __device__ __forceinline__
static __device__ __forceinline__ int tidx_() { int t = (int)__builtin_amdgcn_workitem_id_x(); asm volatile("" : "+v"(t)); return t; }
#define TIDX (tidx_())

template <int J> DI int swz_xor(int x) { return __builtin_amdgcn_ds_swizzle(x, (J << 10) | 0x1F); }
template <int CTRL> DI int dpp_i(int x) { return __builtin_amdgcn_update_dpp(x, x, CTRL, 0xF, 0xF, false); }
DI int shx_i(int x, int j) {
  switch (j) {
    case 1: return dpp_i<0xB1>(x);
    case 2: return dpp_i<0x4E>(x);
    case 4: return dpp_i<0x1B>(dpp_i<0x141>(x));
    case 8: return dpp_i<0x128>(x);
    case 16: return swz_xor<16>(x);
    default: {
      auto r = __builtin_amdgcn_permlane32_swap((unsigned)x, (unsigned)x, false, false);
      return (TIDX & 32) ? (int)r[0] : (int)r[1];
    }
  }
}
DI float shx(float x, int j) { return __int_as_float(shx_i(__float_as_int(x), j)); }
typedef unsigned short bf16_t;
using bf16x8 = __attribute__((ext_vector_type(8))) short;
using f32x4 = __attribute__((ext_vector_type(4))) float;
using u32x4 = __attribute__((ext_vector_type(4))) unsigned;
using u32x2 = __attribute__((ext_vector_type(2))) unsigned;

constexpr int S = 16384, DM = 2048, HD = 128;
constexpr int INW = 5656, INWP = 5760, INWG = 5888;
constexpr int OFF_Q = 0, OFF_KC = 1024, OFF_VC = 1280, OFF_KS = 1536, OFF_VS = 1792, OFF_KW = 2048, OFF_VW = 2304,
              OFF_G = 2560, OFF_U = 2584, OFF_B = 3608, OFF_C = 4632;
constexpr int NCMP = 1023;
constexpr float ALPHA = 1.189207115002721f;
constexpr float QSCALE = 0.08838834764831845f;

DI bf16_t f2bf(float x) { unsigned u = __float_as_uint(x); u += 0x7fffu + ((u >> 16) & 1u); return (bf16_t)(u >> 16); }
DI float bf2f(bf16_t b) { return __uint_as_float(((unsigned)b) << 16); }
DI float gelu_tanh(float x) { float u = 0.7978845608028654f * (x + 0.044715f * x * x * x); return 0.5f * x * (1.f + tanhf(u)); }
DI float wave_sum(float v) { for (int o = 32; o > 0; o >>= 1) v += shx(v, o); return v; }
using bf16x2v = __attribute__((ext_vector_type(2))) __bf16;
DI unsigned pack2(float a, float b) { bf16x2v v = {(__bf16)a, (__bf16)b}; return __builtin_bit_cast(unsigned, v); }
DI float wave_max(float v) { for (int o = 32; o > 0; o >>= 1) v = fmaxf(v, shx(v, o)); return v; }

namespace pg8 {
#define PG8_LAS __attribute__((address_space(3)))
typedef unsigned short bf16_t;
typedef short bf16x8 __attribute__((ext_vector_type(8)));
typedef float f32x4 __attribute__((ext_vector_type(4)));
typedef unsigned u32x4 __attribute__((ext_vector_type(4)));
constexpr int BM = 256, BK = 64, HALF = 128, HTB = HALF * BK * 2  , STAGE_BYTES = 8 * HTB, NXCD = 8, WGM = 8;

__host__ __device__ __forceinline__ int lds_byte(int r, int c) { const int st = (r >> 4) * 2 + (c >> 5), rr = r & 15, cc = c & 31, ob = rr * 64 + cc * 2; return st * 1024 + (ob ^ (((ob >> 9) & 1) << 5)); }
__host__ __device__ __forceinline__ void stage_rc(int b, int& R, int& C) { const int st = b / 1024, sb = b % 1024, swz = sb ^ (((sb >> 9) & 1) << 5); R = (st >> 1) * 16 + swz / 64; C = (st & 1) * 32 + (swz % 64) / 2; }
__host__ __device__ __forceinline__ int perm32(int rho) { const int n = rho >> 4, i = rho & 15; return 8 * (i >> 2) + 4 * n + (i & 3); }

struct Unit { int pm, pn; };
struct Gemm { const bf16_t* A; const bf16_t* Bt; int M, N, K; };

struct StaticOrder {
    int nM, nN, nwg, G, c;
    __host__ __device__ void init(int M, int N, int G_, int c_) { nM = M / BM; nN = N / BM; nwg = nM * nN; G = G_; c = c_; }
    __host__ __device__ bool next(int i, Unit& u) const {
        const long L = (long)i * G + c; if (L >= nwg) return false;
        int wgid = (int)L; { const int q = nwg / NXCD, r = nwg % NXCD, xcd = wgid % NXCD, off = wgid / NXCD; wgid = (xcd < r ? xcd * (q + 1) : r * (q + 1) + (xcd - r) * q) + off; }
        const int nig = WGM * nN, gid = wgid / nig, fm = gid * WGM, gsz = (nM - fm) < WGM ? (nM - fm) : WGM;
        u.pm = fm + ((wgid % nig) % gsz); u.pn = (wgid % nig) / gsz; return true;
    }
    __device__ __forceinline__ void a_ready(const Unit&) const {}
    __device__ __forceinline__ void done(const Unit&) const {}
};
struct OneUnit : StaticOrder {
    int k;
    __device__ bool next(int i, Unit& u) const { if (i > 0) return false; return StaticOrder::next(k, u); }
};
__device__ __forceinline__ unsigned cvt_pk_bf16(float lo, float hi) { unsigned r; asm volatile("v_cvt_pk_bf16_f32 %0, %1, %2" : "=v"(r) : "v"(lo), "v"(hi)); return r; }
template <class Epi, class Sched, bool STAMP = false>
__device__ __forceinline__ void gemm_phase(PG8_LAS unsigned char* lds, const Gemm g, const Sched& S, const Epi& E, unsigned long long* stamps) {
    const int tid = TIDX, wid = __builtin_amdgcn_readfirstlane(tid >> 6), lane = tid & 63, wr = wid >> 2, wc = wid & 3, fr = lane & 15, fq = lane >> 4;
    const int K = g.K, nt = K / BK;
    int ts_lo = 0, ts_hi = 0, nts = 0; const unsigned long long rt_entry = STAMP ? (unsigned long long)wall_clock64() : 0ull;
#define PG8_STAMP() do { if (STAMP && wid == 0 && nts < 64) { const unsigned long long _c = (unsigned long long)clock64(); \
        ts_lo = (lane == nts) ? (int)(unsigned)_c : ts_lo; ts_hi = (lane == nts) ? (int)(unsigned)(_c >> 32) : ts_hi; ++nts; } } while (0)
    PG8_STAMP();
    unsigned voffA[2], voffB[2];
#pragma unroll
    for (int i = 0; i < 2; ++i) { int R, C; stage_rc(tid * 16 + i * 8192, R, C); const int Rb = Epi::PERM ? ((R & ~31) + perm32(R & 31)) : R;
        voffA[i] = (unsigned)(R * K + C) * 2u; voffB[i] = (unsigned)(Rb * K + C) * 2u; }
    const size_t kstep = (size_t)(BK * 2);
    const size_t hstep = (size_t)HALF * K * 2;
    const size_t tstep = 2 * hstep;
    const unsigned ldsw = (unsigned)wid * 1024u;
    const int aoff = lds_byte(wr * 64 + fr, fq * 8), boff = lds_byte(wc * 32 + fr, fq * 8);
#define PG8_SA(b, h) (((b) * 2 + (h)) * HTB)
#define PG8_SB(b, h) ((4 + (b) * 2 + (h)) * HTB)
#define PG8_STAGE(bufoff, gbase, voff) do { _Pragma("unroll") for (int _i = 0; _i < 2; ++_i) \
        __builtin_amdgcn_global_load_lds((const unsigned*)((const char*)(gbase) + (voff)[_i]), (PG8_LAS unsigned*)(lds + (bufoff) + ldsw + _i * 8192), 16, 0, 0); } while (0)
#define PG8_LDA(dst, b, h) do { _Pragma("unroll") for (int m = 0; m < 4; ++m) _Pragma("unroll") for (int k = 0; k < 2; ++k) dst[m][k] = *(const PG8_LAS bf16x8*)(lds + PG8_SA(b, h) + aoff + m * 2048 + k * 1024); } while (0)
#define PG8_LDB(dst, b, h) do { _Pragma("unroll") for (int n = 0; n < 2; ++n) _Pragma("unroll") for (int k = 0; k < 2; ++k) dst[n][k] = *(const PG8_LAS bf16x8*)(lds + PG8_SB(b, h) + boff + n * 2048 + k * 1024); } while (0)
#define PG8_MMA(ai, bj, At, Bt) do { __builtin_amdgcn_s_setprio(1); _Pragma("unroll") for (int m = 0; m < 4; ++m) _Pragma("unroll") for (int n = 0; n < 2; ++n) _Pragma("unroll") for (int k = 0; k < 2; ++k) \
        acc[ai][bj][m][n] = __builtin_amdgcn_mfma_f32_16x16x32_bf16(Bt[n][k], At[m][k], acc[ai][bj][m][n], 0, 0, 0); __builtin_amdgcn_s_setprio(0); } while (0)
#define PG8_WAIT_V(n) asm volatile("s_waitcnt vmcnt(" #n ")" ::: "memory")
#define PG8_WAIT_L(n) asm volatile("s_waitcnt lgkmcnt(" #n ")" ::: "memory")
#define PG8_BAR __builtin_amdgcn_s_barrier()
#define PG8_SCHED __builtin_amdgcn_sched_barrier(0)
    Unit cur, nxt; int ui = 0;
    if (!S.next(0, cur)) return;
    f32x4 acc[2][2][4][2];
#pragma unroll
    for (int a = 0; a < 2; ++a)
#pragma unroll
        for (int b = 0; b < 2; ++b)
#pragma unroll
            for (int m = 0; m < 4; ++m)
#pragma unroll
                for (int n = 0; n < 2; ++n) acc[a][b][m][n] = (f32x4){0.f, 0.f, 0.f, 0.f};
    bf16x8 At[4][2], B0[2][2], B1[2][2];
    const char* cA = (const char*)g.A + (size_t)cur.pm * tstep; const char* cB = (const char*)g.Bt + (size_t)cur.pn * tstep;
    S.a_ready(cur);
    PG8_STAGE(PG8_SB(0, 0), cB, voffB); PG8_STAGE(PG8_SA(0, 0), cA, voffA); PG8_STAGE(PG8_SB(0, 1), cB + hstep, voffB); PG8_STAGE(PG8_SA(0, 1), cA + hstep, voffA);
    if (wr == 1) PG8_BAR;
    PG8_WAIT_V(4); PG8_BAR;
    PG8_STAGE(PG8_SB(1, 0), cB + kstep, voffB); PG8_STAGE(PG8_SA(1, 0), cA + kstep, voffA); PG8_STAGE(PG8_SB(1, 1), cB + hstep + kstep, voffB);
    PG8_WAIT_V(6); PG8_BAR;
    PG8_STAMP();
    for (;;) {
        const bool has_next = S.next(ui + 1, nxt);
        const char* nA = has_next ? (const char*)g.A + (size_t)nxt.pm * tstep : cA; const char* nB = has_next ? (const char*)g.Bt + (size_t)nxt.pn * tstep : cB;
        for (int t = 0; t < nt; t += 2) {
            const bool last = (t == nt - 2);
            const char* a1 = cA + (size_t)(t + 1) * kstep;
            const char* a2 = last ? nA : cA + (size_t)(t + 2) * kstep; const char* b2 = last ? nB : cB + (size_t)(t + 2) * kstep;
            const char* a3 = a2 + kstep; const char* b3 = b2 + kstep;
            if (last && has_next) S.a_ready(nxt);
            PG8_LDB(B0, 0, 0); PG8_SCHED; PG8_LDA(At, 0, 0); PG8_STAGE(PG8_SA(1, 1), a1 + hstep, voffA);
            PG8_WAIT_L(8); PG8_BAR; PG8_WAIT_L(0); PG8_MMA(0, 0, At, B0); PG8_BAR; PG8_SCHED;
            PG8_LDB(B1, 0, 1); PG8_STAGE(PG8_SB(0, 0), b2, voffB);
            PG8_BAR; PG8_WAIT_L(0); PG8_MMA(0, 1, At, B1); PG8_BAR;
            PG8_LDA(At, 0, 1); PG8_STAGE(PG8_SA(0, 0), a2, voffA);
            PG8_BAR; PG8_WAIT_L(0); PG8_MMA(1, 0, At, B0); PG8_BAR; PG8_SCHED;
            PG8_STAGE(PG8_SB(0, 1), b2 + hstep, voffB);
            PG8_WAIT_V(6); PG8_BAR; PG8_MMA(1, 1, At, B1); PG8_BAR;
            PG8_LDB(B0, 1, 0); PG8_SCHED; PG8_LDA(At, 1, 0); PG8_STAGE(PG8_SA(0, 1), a2 + hstep, voffA);
            PG8_WAIT_L(8); PG8_BAR; PG8_WAIT_L(0); PG8_MMA(0, 0, At, B0); PG8_BAR; PG8_SCHED;
            PG8_LDB(B1, 1, 1); PG8_STAGE(PG8_SB(1, 0), b3, voffB);
            PG8_BAR; PG8_WAIT_L(0); PG8_MMA(0, 1, At, B1); PG8_BAR;
            PG8_LDA(At, 1, 1); PG8_STAGE(PG8_SA(1, 0), a3, voffA);
            PG8_BAR; PG8_WAIT_L(0); PG8_MMA(1, 0, At, B0); PG8_BAR; PG8_SCHED;
            PG8_STAGE(PG8_SB(1, 1), b3 + hstep, voffB);
            PG8_WAIT_V(6); PG8_BAR; PG8_MMA(1, 1, At, B1); PG8_BAR;
        }
        PG8_STAMP();
        if constexpr (!Epi::AFTER_DRAIN) { E(acc, cur, wr, wc, fr, fq); S.done(cur); }
        PG8_STAMP();
        if (!has_next) break;
#pragma unroll
        for (int a = 0; a < 2; ++a)
#pragma unroll
            for (int b = 0; b < 2; ++b)
#pragma unroll
                for (int m = 0; m < 4; ++m)
#pragma unroll
                    for (int n = 0; n < 2; ++n) acc[a][b][m][n] = (f32x4){0.f, 0.f, 0.f, 0.f};
        cur = nxt; cA = nA; cB = nB; ++ui;
    }
    PG8_WAIT_V(0);
    if (wr == 0) PG8_BAR;
    PG8_BAR;
    if constexpr (Epi::AFTER_DRAIN) { E.fused(acc, cur, wr, wc, fr, fq, lds, wid, lane); S.done(cur); }
    PG8_STAMP();
    if (STAMP && wid == 0) { stamps[lane] = lane < nts ? (((unsigned long long)(unsigned)ts_hi << 32) | (unsigned)ts_lo) : 0ull;
        if (lane == 62) stamps[62] = rt_entry; if (lane == 63) stamps[63] = (unsigned long long)wall_clock64(); }
#undef PG8_STAMP
#undef PG8_SA
#undef PG8_SB
#undef PG8_STAGE
#undef PG8_LDA
#undef PG8_LDB
#undef PG8_MMA
#undef PG8_WAIT_V
#undef PG8_WAIT_L
#undef PG8_BAR
#undef PG8_SCHED
}
}

#define XB_TMO      128
#define XB_XCNT(j)  (256  + 64 * (j))
#define XB_XSUB(j)  (1280 + 64 * (j))
#define XB_XGEN(j)  (2304 + 64 * (j))
#define XB_TOP      3328
#define XB_TOPGEN   3392
#define XCD_BAR_WORDS 3456
#define XB_SPIN_CAP (1u << 18)
#define LAS __attribute__((address_space(3)))

__device__ __forceinline__ unsigned xb_ld(unsigned* p)              { return __hip_atomic_load(p, __ATOMIC_RELAXED, __HIP_MEMORY_SCOPE_AGENT); }
__device__ __forceinline__ unsigned xb_add(unsigned* p, unsigned v) { return __hip_atomic_fetch_add(p, v, __ATOMIC_RELAXED, __HIP_MEMORY_SCOPE_AGENT); }
__device__ __forceinline__ unsigned xb_xcc_id() { return (unsigned)__builtin_amdgcn_s_getreg((3 << 11) | 20) & 0xFu; }
#define XB_SPIN(cond, bar) do { unsigned _sp = 0; while (cond) { __builtin_amdgcn_s_sleep(1); \
    if ((++_sp & 255u) == 0u) { if (xb_ld(&(bar)[XB_TMO])) break; if (_sp > XB_SPIN_CAP) { atomicAdd(&(bar)[XB_TMO], 1u); break; } } } } while (0)

struct XcdBarrier {
    unsigned* bar; unsigned x;
    volatile LAS unsigned* st;
};

__device__ __forceinline__ XcdBarrier xcd_barrier_post(unsigned* bar, volatile LAS unsigned* st) {
    XcdBarrier b; b.bar = bar; b.x = xb_xcc_id(); b.st = st;
    if (TIDX == 0) (void)xb_add(&bar[XB_XCNT(b.x)], 1u);
    return b;
}
__device__ __forceinline__ void xcd_barrier_complete(unsigned* bar, unsigned x, unsigned& nloc, unsigned& nx) {
    const unsigned G = gridDim.x * gridDim.y * gridDim.z;
    unsigned sum, cnt, mine, sp = 0u;
    for (;;) {
        sum = 0u; cnt = 0u; mine = 0u;
#pragma unroll
        for (unsigned j = 0; j < 16; ++j) { const unsigned c = xb_ld(&bar[XB_XCNT(j)]); sum += c; cnt += (c > 0u) ? 1u : 0u; mine = (j == x) ? c : mine; }
        if (sum == G) break;
        __builtin_amdgcn_s_sleep(1);
        if ((++sp & 255u) == 0u) { if (xb_ld(&bar[XB_TMO])) break; if (sp > XB_SPIN_CAP) { atomicAdd(&bar[XB_TMO], 1u); break; } }
    }
    nloc = mine > 0u ? mine : 1u; nx = cnt > 0u ? cnt : 1u;
}

__device__ __forceinline__ void xcd_barrier(const XcdBarrier& b) {
    asm volatile("s_waitcnt vmcnt(0)" ::: "memory");
    __syncthreads();
    if (TIDX == 0) {
        unsigned* bar = b.bar;
        __builtin_amdgcn_s_waitcnt(0);
        unsigned nloc = b.st[0], nx = b.st[1];
        if (nloc == 0u) { xcd_barrier_complete(bar, b.x, nloc, nx); b.st[0] = nloc; b.st[1] = nx; }
        const unsigned old = xb_add(&bar[XB_XSUB(b.x)], 1u);
        const unsigned gen = old / nloc;
        if (old + 1u == (gen + 1u) * nloc) {
            __builtin_amdgcn_fence(__ATOMIC_RELEASE, "agent");
            asm volatile("s_waitcnt vmcnt(0)" ::: "memory");
            const unsigned og = xb_add(&bar[XB_TOP], 1u);
            const unsigned tg = og / nx;
            if (og + 1u == (tg + 1u) * nx) xb_add(&bar[XB_TOPGEN], 1u);
            else XB_SPIN(xb_ld(&bar[XB_TOPGEN]) == tg, bar);
            __builtin_amdgcn_fence(__ATOMIC_ACQUIRE, "agent");
            xb_add(&bar[XB_XGEN(b.x)], 1u);
            asm volatile("s_waitcnt vmcnt(0)" ::: "memory");
        } else {
            XB_SPIN(xb_ld(&bar[XB_XGEN(b.x)]) == gen, bar);
            __builtin_amdgcn_fence(__ATOMIC_ACQUIRE, "agent");
            asm volatile("s_waitcnt vmcnt(0)" ::: "memory");
        }
    }
    __syncthreads();
}

__device__ void d_cvt(const float* __restrict__ in, bf16_t* __restrict__ out, size_t n4) {
  const size_t stride = (size_t)gridDim.x * blockDim.x;
  size_t i = (size_t)blockIdx.x * blockDim.x + TIDX;
  for (; i + 3 * stride < n4; i += 4 * stride) {
    f32x4 v[4];
#pragma unroll
    for (int q = 0; q < 4; ++q) v[q] = ((const f32x4*)in)[i + q * stride];
#pragma unroll
    for (int q = 0; q < 4; ++q) { u32x2 o = {pack2(v[q][0], v[q][1]), pack2(v[q][2], v[q][3])}; ((u32x2*)out)[i + q * stride] = o; }
  }
  for (; i < n4; i += stride) { const f32x4 v = ((const f32x4*)in)[i]; u32x2 o = {pack2(v[0], v[1]), pack2(v[2], v[3])}; ((u32x2*)out)[i] = o; }
}
__device__ void d_cvtT64(int vb, char* smem, const float* __restrict__ W, bf16_t* __restrict__ WT, int K, int N, int NP) {
  float (*tt)[65] = (float (*)[65])smem;
  const int tid = (TIDX & 255);
  const int nbx = NP / 64;
  const int n0 = (vb % nbx) * 64, k0 = (vb / nbx) * 64;
  {
    const int kr = tid >> 4, nc = (tid & 15) * 4;
#pragma unroll
    for (int i = 0; i < 4; ++i) {
      const int k = k0 + kr + 16 * i, n = n0 + nc;
      f32x4 v = {0.f, 0.f, 0.f, 0.f};
      if (n < N) v = *(const f32x4*)(W + (size_t)k * N + n);
      tt[kr + 16 * i][nc] = v[0]; tt[kr + 16 * i][nc + 1] = v[1]; tt[kr + 16 * i][nc + 2] = v[2]; tt[kr + 16 * i][nc + 3] = v[3];
    }
  }
  __syncthreads();
  {
    const int nr = tid >> 3, kc = (tid & 7) * 8;
#pragma unroll
    for (int i = 0; i < 2; ++i) {
      const int nl = nr + 32 * i;
      u32x4 o = {pack2(tt[kc][nl], tt[kc + 1][nl]), pack2(tt[kc + 2][nl], tt[kc + 3][nl]), pack2(tt[kc + 4][nl], tt[kc + 5][nl]), pack2(tt[kc + 6][nl], tt[kc + 7][nl])};
      *(u32x4*)(WT + (size_t)(n0 + nl) * K + k0 + kc) = o;
    }
  }
  __syncthreads();
}

using f32x16 = __attribute__((ext_vector_type(16))) float;
using bf16x8v = __attribute__((ext_vector_type(8))) __bf16;
#define MFMA32(a, b, c) __builtin_amdgcn_mfma_f32_32x32x16_bf16((a), (b), (c), 0, 0, 0)
constexpr float LOG2E = 1.4426950408889634f;
constexpr float NEGB = -1e30f;
DI int pi_perm(int i) { return (i & ~12) | ((i & 8) >> 1) | ((i & 4) << 1); }
DI bf16x8 pack8(float a0, float a1, float a2, float a3, float a4, float a5, float a6, float a7) {
  bf16x8v v = {(__bf16)a0, (__bf16)a1, (__bf16)a2, (__bf16)a3, (__bf16)a4, (__bf16)a5, (__bf16)a6, (__bf16)a7};
  return __builtin_bit_cast(bf16x8, v);
}
__device__ __forceinline__ void d_relayout_tile(int T, char* smem, const bf16_t* __restrict__ proj, int col0, bf16_t* __restrict__ dst, bool isV) {
  bf16_t* Ls = (bf16_t*)smem;
  const int tid = TIDX;
#pragma unroll
  for (int q = 0; q < 2; ++q) {
    const int cidx = tid + q * 512;
    const int g = cidx >> 9, tok = (cidx >> 4) & 31, ch = cidx & 15;
    const u32x4 v = *(const u32x4*)(proj + (size_t)(32 * T + tok) * INWP + col0 + g * 128 + ch * 8);
    *(u32x4*)(Ls + (g * 32 + tok) * 136 + ch * 8) = v;
  }
  __syncthreads();
#pragma unroll
  for (int q = 0; q < 2; ++q) {
    const int oc = tid + q * 512;
    const int g = oc >> 9, r9 = oc & 511, lane = r9 & 63;
    u32x4 o;
    if (!isV) {
      const int s8 = r9 >> 6, i = lane & 31, h = lane >> 5;
      o = *(const u32x4*)(Ls + (g * 32 + pi_perm(i)) * 136 + 16 * s8 + 8 * h);
    } else {
      const int s2 = (r9 >> 6) & 1, dt = r9 >> 7, dd = lane & 31, h = lane >> 5;
      const bf16_t* col = Ls + (g * 32 + 16 * s2 + 8 * h) * 136 + 32 * dt + dd;
      unsigned short e[8];
#pragma unroll
      for (int j = 0; j < 8; ++j) e[j] = col[j * 136];
      o.x = e[0] | ((unsigned)e[1] << 16); o.y = e[2] | ((unsigned)e[3] << 16); o.z = e[4] | ((unsigned)e[5] << 16); o.w = e[6] | ((unsigned)e[7] << 16);
    }
    *(u32x4*)(dst + (((size_t)(g * 512 + T)) * 512 + r9) * 8) = o;
  }
  __syncthreads();
}

struct AttnPtrs {
  const bf16_t* proj; const float* gates;
  const bf16_t *kcf, *vcf, *ksf, *vsf, *kwf, *vwf;
  bf16_t* mix; const float* hng;
};

DI float ex2(float x) { return __builtin_amdgcn_exp2f(x); }
DI void halves(float x, float& lo, float& hi) {
  const unsigned u = __float_as_uint(x);
  auto r = __builtin_amdgcn_permlane32_swap(u, u, false, false);
  lo = __uint_as_float(r[0]); hi = __uint_as_float(r[1]);
}
DI float hmax(float x) { float a, b; halves(x, a, b); return fmaxf(a, b); }
DI float hsum(float x) { float a, b; halves(x, a, b); return a + b; }
DI float dpp_quad(float v, int ctrl_is_xor1) {
  const int iv = __float_as_int(v);
  const int r = ctrl_is_xor1 ? __builtin_amdgcn_update_dpp(iv, iv, 0xB1, 0xF, 0xF, false) : __builtin_amdgcn_update_dpp(iv, iv, 0x4E, 0xF, 0xF, false);
  return __int_as_float(r);
}
DI float quad_sum(float v) { v += dpp_quad(v, 1); v += dpp_quad(v, 0); return v; }
DI void osm_step(const float (&sv)[16], float& m, float& l, f32x16 (&O)[4], float (&p)[16]) {
  float tmax = fmaxf(fmaxf(fmaxf(sv[0], sv[1]), fmaxf(sv[2], sv[3])), fmaxf(fmaxf(sv[4], sv[5]), fmaxf(sv[6], sv[7])));
  tmax = fmaxf(tmax, fmaxf(fmaxf(fmaxf(sv[8], sv[9]), fmaxf(sv[10], sv[11])), fmaxf(fmaxf(sv[12], sv[13]), fmaxf(sv[14], sv[15]))));
  tmax = hmax(tmax);
  if (__ballot(tmax - m > 8.f)) {
    const float mn = fmaxf(m, tmax);
    const float alpha = ex2(m - mn);
    l *= alpha; m = mn;
#pragma unroll
    for (int dt = 0; dt < 4; ++dt)
#pragma unroll
      for (int r = 0; r < 16; ++r) O[dt][r] *= alpha;
  }
  float ps0 = 0.f, ps1 = 0.f;
#pragma unroll
  for (int r = 0; r < 16; r += 2) { const float e0 = ex2(sv[r] - m), e1 = ex2(sv[r + 1] - m); p[r] = e0; p[r + 1] = e1; ps0 += e0; ps1 += e1; }
  l += ps0 + ps1;
}
DI void ot_store(char* otL, int lane, const f32x16 (&O)[4], float sc) {
#pragma unroll
  for (int dt = 0; dt < 4; ++dt) {
    u32x4 a, b;
#pragma unroll
    for (int i = 0; i < 4; ++i) { a[i] = pack2(sc * O[dt][2 * i], sc * O[dt][2 * i + 1]); b[i] = pack2(sc * O[dt][8 + 2 * i], sc * O[dt][8 + 2 * i + 1]); }
    *(u32x4*)(otL + lane * 128 + dt * 32) = a;
    *(u32x4*)(otL + lane * 128 + dt * 32 + 16) = b;
  }
}
DI void ot_accum(const char* otL, int lane, f32x16 (&O)[4], float sc) {
#pragma unroll
  for (int dt = 0; dt < 4; ++dt) {
    u32x4 a = *(const u32x4*)(otL + lane * 128 + dt * 32);
    u32x4 b = *(const u32x4*)(otL + lane * 128 + dt * 32 + 16);
#pragma unroll
    for (int i = 0; i < 4; ++i) {
      const unsigned wa = a[i], wb = b[i];
      O[dt][2 * i] = fmaf(sc, O[dt][2 * i], __uint_as_float(wa << 16));
      O[dt][2 * i + 1] = fmaf(sc, O[dt][2 * i + 1], __uint_as_float(wa & 0xFFFF0000u));
      O[dt][8 + 2 * i] = fmaf(sc, O[dt][8 + 2 * i], __uint_as_float(wb << 16));
      O[dt][8 + 2 * i + 1] = fmaf(sc, O[dt][8 + 2 * i + 1], __uint_as_float(wb & 0xFFFF0000u));
    }
  }
}
DI void zero_o(f32x16 (&O)[4]) {
#pragma unroll
  for (int dt = 0; dt < 4; ++dt)
#pragma unroll
    for (int i = 0; i < 16; ++i) O[dt][i] = 0.f;
}

constexpr int ATT_PW = 8704;
constexpr int ATT_R = 4, ATT_D = 3;
constexpr int ATT_RING = 8 * ATT_PW;
constexpr int ATT_LIST = ATT_RING + ATT_R * 16384;
constexpr int ATT_BUNI = ATT_LIST + 2048;
constexpr int ATT_SMEM = ATT_BUNI + 64;
#define LAS3 __attribute__((address_space(3)))
__device__ __forceinline__ void d_select(const float* impL, unsigned* mskL, unsigned* uniL, int cur) {
  const int lane = TIDX & 63;
  const int stok = lane >> 3, sub = lane & 7;
  unsigned key[32];
#pragma unroll
  for (int i4 = 0; i4 < 8; ++i4) {
    f32x4 v = *(const f32x4*)(impL + stok * 256 + sub * 32 + i4 * 4);
#pragma unroll
    for (int e = 0; e < 4; ++e) {
      const int j = sub * 32 + i4 * 4 + e;
      const bool valid = j <= cur;
      const bool forced = (j == 0) || (j == cur) || (j == cur - 1);
      unsigned kb = forced ? 0xFFFFFF00u : (__float_as_uint(v[e]) & 0xFFFFFF00u);
      key[i4 * 4 + e] = valid ? (kb | (unsigned)(255 - j)) : 0u;
    }
  }
#pragma unroll
  for (int k = 2; k <= 32; k <<= 1) {
#pragma unroll
    for (int jj = k >> 1; jj > 0; jj >>= 1) {
#pragma unroll
      for (int i = 0; i < 32; ++i) {
        const int l2 = i ^ jj;
        if (l2 > i) {
          const bool desc = ((i & k) == 0);
          unsigned a = key[i], b = key[l2];
          unsigned mx = a > b ? a : b, mn = a > b ? b : a;
          key[i] = desc ? mx : mn; key[l2] = desc ? mn : mx;
        }
      }
    }
  }
#pragma unroll
  for (int xm = 1; xm < 8; xm <<= 1) {
    unsigned L[16];
#pragma unroll
    for (int i = 0; i < 16; ++i) { unsigned o = (unsigned)shx_i((int)key[15 - i], xm); L[i] = key[i] > o ? key[i] : o; }
#pragma unroll
    for (int jj = 8; jj > 0; jj >>= 1) {
#pragma unroll
      for (int i = 0; i < 16; ++i) {
        const int l2 = i ^ jj;
        if (l2 > i) { unsigned a = L[i], b = L[l2]; L[i] = a > b ? a : b; L[l2] = a > b ? b : a; }
      }
    }
#pragma unroll
    for (int i = 0; i < 16; ++i) key[i] = L[i];
  }
#pragma unroll
  for (int i = 0; i < 16; ++i) {
    if ((i & 7) == sub) {
      const int j = 255 - (int)(key[i] & 255u);
      if (j <= cur) { atomicOr(&mskL[stok * 8 + (j >> 5)], 1u << (j & 31)); atomicOr(&uniL[j >> 5], 1u << (j & 31)); }
    }
  }
}


DI void att_issue(LAS3 unsigned char* ring, int slot, int w, int lane, const bf16_t* kb, const bf16_t* vb, int tile) {
  const char* ks = (const char*)kb + (size_t)tile * 8192 + w * 1024 + lane * 16;
  const char* vs = (const char*)vb + (size_t)tile * 8192 + w * 1024 + lane * 16;
  __builtin_amdgcn_global_load_lds((const unsigned*)ks, (LAS3 unsigned*)(ring + slot * 16384 + w * 1024), 16, 0, 0);
  __builtin_amdgcn_global_load_lds((const unsigned*)vs, (LAS3 unsigned*)(ring + slot * 16384 + 8192 + w * 1024), 16, 0, 0);
}
DI f32x16 qk_lds(LAS3 const unsigned char* kt, const bf16x8 (&qf)[8], int lane) {
  f32x16 acc;
#pragma unroll
  for (int i = 0; i < 16; ++i) acc[i] = 0.f;
#pragma unroll
  for (int s8 = 0; s8 < 8; ++s8) {
    const bf16x8 kf = *(LAS3 const bf16x8*)(kt + s8 * 1024 + lane * 16);
    acc = MFMA32(kf, qf[s8], acc);
  }
  return acc;
}
DI void pv_lds(LAS3 const unsigned char* vt, const float (&p)[16], f32x16 (&O)[4], int lane) {
  const bf16x8 pf0 = pack8(p[0], p[1], p[2], p[3], p[4], p[5], p[6], p[7]);
  const bf16x8 pf1 = pack8(p[8], p[9], p[10], p[11], p[12], p[13], p[14], p[15]);
#pragma unroll
  for (int dt = 0; dt < 4; ++dt) {
    const bf16x8 v0 = *(LAS3 const bf16x8*)(vt + (dt * 2) * 1024 + lane * 16);
    const bf16x8 v1 = *(LAS3 const bf16x8*)(vt + (dt * 2 + 1) * 1024 + lane * 16);
    O[dt] = MFMA32(v0, pf0, O[dt]);
    O[dt] = MFMA32(v1, pf1, O[dt]);
  }
}

__device__ __forceinline__ void d_attn_block(int B, int g, char* smem, const AttnPtrs& P) {
  const int tid = TIDX, lane = tid & 63, w = tid >> 6;
  const int c = lane & 31, h = lane >> 5, tokl = c >> 2, r = c & 3;
  const int tok0 = 64 * B + 8 * w;
  const int t = tok0 + tokl, hd = g * 4 + r;
  const float slope2 = exp2f(-(float)(hd + 1)) * LOG2E;
  const float c1 = QSCALE * LOG2E;
  const float ninf = -__builtin_inff();
  char* wsm = smem + w * ATT_PW;
  float* impL = (float*)wsm;
  char* otL = wsm;
  unsigned* mskL = (unsigned*)(wsm + 8192);
  unsigned* uniL = mskL + 64;
  LAS3 unsigned char* ring = (LAS3 unsigned char*)(smem + ATT_RING);
  unsigned short* tl = (unsigned short*)(smem + ATT_LIST);
  unsigned* buni = (unsigned*)(smem + ATT_BUNI);
  const bf16_t* kcf = P.kcf + (size_t)g * 32 * 4096;
  const bf16_t* vcf = P.vcf + (size_t)g * 32 * 4096;
  const bf16_t* ksf = P.ksf + (size_t)g * 512 * 4096;
  const bf16_t* vsf = P.vsf + (size_t)g * 512 * 4096;
  const bf16_t* kwf = P.kwf + (size_t)g * 512 * 4096;
  const bf16_t* vwf = P.vwf + (size_t)g * 512 * 4096;
  bf16x8 qf[8];
  {
    const bf16_t* qrow = P.proj + (size_t)t * INWP + OFF_Q + hd * 128 + 8 * h;
#pragma unroll
    for (int s8 = 0; s8 < 8; ++s8) qf[s8] = *(const bf16x8*)(qrow + 16 * s8);
  }
  const float* gt = P.gates + (size_t)t * 24 + hd * 3;
  const float g0 = gt[0], g1 = gt[1], g2 = gt[2];
  {
    unsigned z0 = 0u;
    asm volatile("" : "+v"(z0));
    u32x4 z = {z0, z0, z0, z0};
#pragma unroll
    for (int i = 0; i < 8; ++i) *(u32x4*)(wsm + (i * 64 + lane) * 16) = z;
    if (lane < 18) *(u32x4*)(wsm + 8192 + lane * 16) = z;
    if (tid < 8) buni[tid] = z0;
  }
  f32x16 Ob[4];
  zero_o(Ob);
  const int nmax = (t >= 31) ? ((t - 31) >> 4) : -1;
  const int nmaxw = (tok0 + 7 >= 31) ? ((tok0 + 7 - 31) >> 4) : -1;
  const int nminw = (tok0 >= 31) ? ((tok0 - 31) >> 4) : -1;
  const int ntcw = (nmaxw + 32) >> 5;
  const int ntcB = (((64 * B + 63 - 31) >> 4) + 32) >> 5;
  const float sl16 = slope2 * 16.f;
  float mC = NEGB, lC = 0.f, invC = 0.f, carry = 0.f;
  {
    const int n = 2 * ntcB;
    asm volatile("s_waitcnt vmcnt(0)" ::: "memory");
#define A_TILE(i_) (((i_) < ntcB) ? (ntcB - 1 - (i_)) : ((i_) - ntcB))
    att_issue(ring, 0, w, lane, kcf, vcf, A_TILE(0));
    if (n > 1) att_issue(ring, 1, w, lane, kcf, vcf, A_TILE(1));
#pragma unroll 1
    for (int i = 0; i < n; ++i) {
      if ((i & 1) == 0) {
        asm volatile("s_waitcnt vmcnt(0)" ::: "memory");
        __builtin_amdgcn_s_barrier();
        asm volatile("" ::: "memory");
        if (i + 2 < n) att_issue(ring, (i + 2) & 3, w, lane, kcf, vcf, A_TILE(i + 2));
        if (i + 3 < n) att_issue(ring, (i + 3) & 3, w, lane, kcf, vcf, A_TILE(i + 3));
      }
      const int T = A_TILE(i);
      if (T >= ntcw) continue;
      LAS3 const unsigned char* slot = ring + (i % ATT_R) * 16384;
      const f32x16 acc = qk_lds(slot, qf, lane);
      const float base = slope2 * (float)(512 * T + 128 * h) + slope2 * (15.5f - (float)t);
      const int nb = 32 * T + 8 * h;
      const bool full = (32 * T + 31 <= nminw);
      float sv[16];
#pragma unroll
      for (int rg = 0; rg < 16; ++rg) { const int kk = (rg & 7) + 16 * (rg >> 3); sv[rg] = fmaf(acc[rg], c1, fmaf(sl16, (float)kk, base)); }
      if (!full) {
#pragma unroll
        for (int rg = 0; rg < 16; ++rg) { const int kk = (rg & 7) + 16 * (rg >> 3); sv[rg] = (nb + kk <= nmax) ? sv[rg] : ninf; }
      }
      if (i < ntcB) {
        float tmax = fmaxf(fmaxf(fmaxf(sv[0], sv[1]), fmaxf(sv[2], sv[3])), fmaxf(fmaxf(sv[4], sv[5]), fmaxf(sv[6], sv[7])));
        tmax = fmaxf(tmax, fmaxf(fmaxf(fmaxf(sv[8], sv[9]), fmaxf(sv[10], sv[11])), fmaxf(fmaxf(sv[12], sv[13]), fmaxf(sv[14], sv[15]))));
        tmax = hmax(tmax);
        const float mn = fmaxf(mC, tmax);
        float ps = 0.f;
#pragma unroll
        for (int rg = 0; rg < 16; ++rg) ps += ex2(sv[rg] - mn);
        lC = lC * ex2(mC - mn) + ps; mC = mn;
      } else {
        if (T == 0) { lC = hsum(lC); invC = (lC > 0.f) ? 1.f / lC : 0.f; }
        float p[16];
#pragma unroll
        for (int rg = 0; rg < 16; ++rg) p[rg] = ex2(sv[rg] - mC) * invC;
        float Ga = (p[0] + p[1]) + (p[2] + p[3]), Gb = (p[4] + p[5]) + (p[6] + p[7]);
        float Gc = (p[8] + p[9]) + (p[10] + p[11]), Gd = (p[12] + p[13]) + (p[14] + p[15]);
        float xb, xd; { float a_, b_; halves(p[7], a_, b_); xb = h ? a_ : b_; halves(p[15], a_, b_); xd = h ? a_ : b_; }
        float ia = Ga + (h ? xb : carry);
        float ib = Gb + p[3];
        float ic = Gc + (h ? xd : xb);
        float id = Gd + p[11];
        carry = xd;
        ia = quad_sum(ia); ib = quad_sum(ib); ic = quad_sum(ic); id = quad_sum(id);
        {
          float val = (r == 0) ? ia : (r == 1) ? ib : (r == 2) ? ic : id;
          int j = 8 * T + 2 * h + ((r == 0) ? 0 : (r == 1) ? 1 : (r == 2) ? 4 : 5);
          impL[tokl * 256 + j] = val;
        }
        pv_lds(slot + 8192, p, Ob, lane);
      }
    }
#undef A_TILE
  }
  const int cur = B;
  d_select(impL, mskL, uniL, cur);
  ot_store(otL, lane, Ob, g0);
  zero_o(Ob);
  if (lane < 8) { const unsigned u = uniL[lane]; if (u) atomicOr(&buni[lane], u); }
  __syncthreads();
  int nslc = 0, ntl = 0;
  {
    for (int iw = 7; iw >= 0; --iw) {
      unsigned iuw = __builtin_amdgcn_readfirstlane(buni[iw]);
      while (iuw) {
        const int bit = 31 - __builtin_clz(iuw);
        iuw &= ~(1u << bit);
        const int bb = 32 * iw + bit;
        if (bb < B) { if (lane == 0) tl[ntl] = (unsigned short)(2 * bb + 1); ++ntl; }
        else { if (lane == 0) tl[ntl] = (unsigned short)(2 * bb + 1); ++ntl; }
        if (lane == 0) tl[ntl] = (unsigned short)(2 * bb);
        ++ntl;
      }
    }
    nslc = ntl;
    const int ThiB = 2 * B + 1, TloB = ((64 * B - 511 > 0) ? (64 * B - 511) : 0) >> 5;
    for (int T = ThiB; T >= TloB; --T) { if (lane == 0) tl[ntl] = (unsigned short)T; ++ntl; }
  }
  float m = NEGB, l = 0.f;
  {
    const int n = ntl;
    const int Tlow = ((tok0 - 511 > 0) ? (tok0 - 511) : 0) >> 5, Thiw = (tok0 + 7) >> 5;
#define B_ISSUE(j_, slot_) { const int e_ = __builtin_amdgcn_readfirstlane((int)tl[j_]); if ((j_) < nslc) att_issue(ring, slot_, w, lane, ksf, vsf, e_); else att_issue(ring, slot_, w, lane, kwf, vwf, e_); }
    B_ISSUE(0, 0)
    if (n > 1) B_ISSUE(1, 1)
#pragma unroll 1
    for (int i = 0; i < n; ++i) {
      if ((i & 1) == 0) {
        asm volatile("s_waitcnt vmcnt(0)" ::: "memory");
        __builtin_amdgcn_s_barrier();
        asm volatile("" ::: "memory");
        if (i + 2 < n) B_ISSUE(i + 2, (i + 2) & 3)
        if (i + 3 < n) B_ISSUE(i + 3, (i + 3) & 3)
      }
      if (i == nslc) {
        l = hsum(l);
        const float inv = (l > 0.f) ? g1 / l : 0.f;
        ot_accum(otL, lane, Ob, inv);
        ot_store(otL, lane, Ob, 1.f);
        zero_o(Ob);
        m = NEGB; l = 0.f;
      }
      const int T = __builtin_amdgcn_readfirstlane((int)tl[i]);
      const int pos0 = 32 * T, pb = pos0 + 8 * h;
      bool full; bool mine = true;
      if (i < nslc) {
        const int bb = T >> 1;
        const unsigned uw = __builtin_amdgcn_readfirstlane(uniL[bb >> 5]);
        if (!((uw >> (bb & 31)) & 1u) || pos0 > tok0 + 7) continue;
        mine = (mskL[tokl * 8 + (bb >> 5)] >> (bb & 31)) & 1u;
        full = (pos0 + 31 <= tok0) && (__ballot(!mine) == 0ull);
      } else {
        if (T < Tlow || T > Thiw) continue;
        full = (pos0 + 31 <= tok0) && (pos0 >= tok0 + 7 - 511);
      }
      LAS3 const unsigned char* slot = ring + (i % ATT_R) * 16384;
      const f32x16 acc = qk_lds(slot, qf, lane);
      const float base = slope2 * (float)(pos0 + 8 * h - t);
      float sv[16], p[16];
#pragma unroll
      for (int rg = 0; rg < 16; ++rg) { const int kk = (rg & 7) + 16 * (rg >> 3); sv[rg] = fmaf(acc[rg], c1, fmaf(slope2, (float)kk, base)); }
      if (!full) {
        if (i < nslc) {
#pragma unroll
          for (int rg = 0; rg < 16; ++rg) { const int kk = (rg & 7) + 16 * (rg >> 3); sv[rg] = (mine && (pb + kk <= t)) ? sv[rg] : ninf; }
        } else {
#pragma unroll
          for (int rg = 0; rg < 16; ++rg) { const int kk = (rg & 7) + 16 * (rg >> 3); const int dw = t - (pb + kk); sv[rg] = ((dw >= 0) && (dw < 512)) ? sv[rg] : ninf; }
        }
      }
      osm_step(sv, m, l, Ob, p);
      pv_lds(slot + 8192, p, Ob, lane);
    }
#undef B_ISSUE
    l = hsum(l);
    const float inv = (l > 0.f) ? g2 / l : 0.f;
    ot_accum(otL, lane, Ob, inv);
  }
  {
    float ss = 0.f;
#pragma unroll
    for (int dt = 0; dt < 4; ++dt)
#pragma unroll
      for (int i = 0; i < 16; ++i) ss = fmaf(Ob[dt][i], Ob[dt][i], ss);
    ss = hsum(ss);
    const float rs = rsqrtf(ss * (1.f / 128.f) + 1e-6f);
    bf16_t* orow = P.mix + (size_t)t * DM + hd * 128 + 4 * h;
    const float* grow = P.hng + hd * 128 + 4 * h;
#pragma unroll
    for (int dt = 0; dt < 4; ++dt)
#pragma unroll
      for (int a = 0; a < 4; ++a) {
        const f32x4 gv = *(const f32x4*)(grow + 32 * dt + 8 * a);
        u32x2 wv2 = {pack2(Ob[dt][4 * a] * rs * gv[0], Ob[dt][4 * a + 1] * rs * gv[1]), pack2(Ob[dt][4 * a + 2] * rs * gv[2], Ob[dt][4 * a + 3] * rs * gv[3])};
        *(u32x2*)(orow + 32 * dt + 8 * a) = wv2;
      }
  }
  asm volatile("s_waitcnt vmcnt(0)" ::: "memory");
  __syncthreads();
}

__device__ void d_convmix(int t, int tl, const bf16_t* __restrict__ proj, const float* __restrict__ convw, const float* __restrict__ hng,
                          bf16_t* __restrict__ mix) {
  const int c = tl * 8;
  float acc[8];
#pragma unroll
  for (int i = 0; i < 8; ++i) acc[i] = 0.f;
#pragma unroll
  for (int j = 0; j < 3; ++j) {
    const int tt = t - 2 + j;
    if (tt >= 0) {
      const u32x4 cu = *(const u32x4*)(proj + (size_t)tt * INWP + OFF_C + c);
      const u32x4 uu = *(const u32x4*)(proj + (size_t)tt * INWP + OFF_U + c);
      const f32x4 w0 = *(const f32x4*)(convw + j * 1024 + c), w1 = *(const f32x4*)(convw + j * 1024 + c + 4);
#pragma unroll
      for (int i = 0; i < 4; ++i) {
        const unsigned a = cu[i], b = uu[i];
        const float wl = (i < 2) ? w0[2 * i] : w1[2 * i - 4], wh = (i < 2) ? w0[2 * i + 1] : w1[2 * i - 3];
        acc[2 * i] = fmaf(wl * __uint_as_float(a << 16), __uint_as_float(b << 16), acc[2 * i]);
        acc[2 * i + 1] = fmaf(wh * __uint_as_float(a & 0xFFFF0000u), __uint_as_float(b & 0xFFFF0000u), acc[2 * i + 1]);
      }
    }
  }
  const u32x4 bb = *(const u32x4*)(proj + (size_t)t * INWP + OFF_B + c);
  float ss = 0.f;
#pragma unroll
  for (int i = 0; i < 4; ++i) {
    const unsigned b = bb[i];
    acc[2 * i] *= __uint_as_float(b << 16); acc[2 * i + 1] *= __uint_as_float(b & 0xFFFF0000u);
    ss = fmaf(acc[2 * i], acc[2 * i], ss); ss = fmaf(acc[2 * i + 1], acc[2 * i + 1], ss);
  }
  ss += shx(ss, 8); ss += shx(ss, 4); ss += shx(ss, 2); ss += shx(ss, 1);
  const float rs = rsqrtf(ss * (1.f / 128.f) + 1e-6f);
  const f32x4 g0 = *(const f32x4*)(hng + 1024 + c), g1 = *(const f32x4*)(hng + 1024 + c + 4);
  u32x4 o = {pack2(acc[0] * rs * g0[0], acc[1] * rs * g0[1]), pack2(acc[2] * rs * g0[2], acc[3] * rs * g0[3]),
             pack2(acc[4] * rs * g1[0], acc[5] * rs * g1[1]), pack2(acc[6] * rs * g1[2], acc[7] * rs * g1[3])};
  *(u32x4*)(mix + (size_t)t * DM + 1024 + c) = o;
}

__device__ void d_ln_wave(int t, const float* __restrict__ y, const float* __restrict__ gam, const float* __restrict__ bet,
                          float* __restrict__ stats, bf16_t* __restrict__ hb) {
  const int lane = TIDX & 63;
  f32x4 v[8];
#pragma unroll
  for (int i = 0; i < 8; ++i) v[i] = *(const f32x4*)(y + (size_t)t * DM + 256 * i + 4 * lane);
  float s = 0.f;
#pragma unroll
  for (int i = 0; i < 8; ++i) s += (v[i][0] + v[i][1]) + (v[i][2] + v[i][3]);
  s = wave_sum(s);
  const float mu = s * (1.f / DM);
  float q = 0.f;
#pragma unroll
  for (int i = 0; i < 8; ++i)
#pragma unroll
    for (int j = 0; j < 4; ++j) { const float d = v[i][j] - mu; q = fmaf(d, d, q); }
  q = wave_sum(q);
  const float rs = rsqrtf(q * (1.f / DM) + 1e-5f);
#pragma unroll
  for (int i = 0; i < 8; ++i) {
    const int cb = 256 * i + 4 * lane;
    const f32x4 g = *(const f32x4*)(gam + cb), b = *(const f32x4*)(bet + cb);
    u32x2 o = {pack2((v[i][0] - mu) * rs * g[0] + b[0], (v[i][1] - mu) * rs * g[1] + b[1]), pack2((v[i][2] - mu) * rs * g[2] + b[2], (v[i][3] - mu) * rs * g[3] + b[3])};
    *(u32x2*)(hb + (size_t)t * DM + cb) = o;
  }
  if (lane == 0) { stats[2 * t] = mu; stats[2 * t + 1] = rs; }
}

__device__ void d_cvt_w1f(size_t c, const float* __restrict__ w1, bf16_t* __restrict__ w1f) {
  const int lane = c & 63, ks = (c >> 6) & 255, ct = c >> 14;
  const int col = lane & 31, h = lane >> 5;
  bf16_t v[8];
#pragma unroll
  for (int j = 0; j < 8; ++j) v[j] = f2bf(w1[(size_t)(16 * ks + 8 * h + j) * 512 + 32 * ct + col]);
  u32x4 o; o.x = v[0] | ((unsigned)v[1] << 16); o.y = v[2] | ((unsigned)v[3] << 16); o.z = v[4] | ((unsigned)v[5] << 16); o.w = v[6] | ((unsigned)v[7] << 16);
  *(u32x4*)(w1f + c * 8) = o;
}
__device__ void d_cvt_w2f(size_t c, const float* __restrict__ w2, bf16_t* __restrict__ w2f) {
  const int lane = c & 63, s = (c >> 6) & 31, ct = c >> 11;
  const int col = lane & 31, h = lane >> 5;
  bf16_t v[8];
#pragma unroll
  for (int j = 0; j < 8; ++j) v[j] = f2bf(w2[(size_t)(16 * s + 8 * h + j) * 128 + 32 * ct + col]);
  u32x4 o; o.x = v[0] | ((unsigned)v[1] << 16); o.y = v[2] | ((unsigned)v[3] << 16); o.z = v[4] | ((unsigned)v[5] << 16); o.w = v[6] | ((unsigned)v[7] << 16);
  *(u32x4*)(w2f + c * 8) = o;
}
__device__ __forceinline__ void d_compress_unit(int rt, char* smem, const bf16_t* __restrict__ proj, int col0, const float* __restrict__ pos,
                                const bf16_t* __restrict__ w1f, const float* __restrict__ b1, const bf16_t* __restrict__ w2f,
                                bf16_t* __restrict__ outf, bool isV) {
  bf16_t* Xs = (bf16_t*)smem;
  bf16_t* Hs = (bf16_t*)(smem + 2 * 8704);
  const int tid = TIDX, lane = tid & 63, w = tid >> 6, c = lane & 31, h = lane >> 5;
  const int R0 = rt * 32;
  const int srow = tid >> 4, sch = tid & 15;
  const int grow = R0 + srow, sn = grow >> 1, sg = grow & 1;
  const bool svalid = grow < 2046;
  const bf16_t* sp = proj + (size_t)(16 * sn) * INWP + col0 + sg * 128 + sch * 8;
  f32x16 acc0, acc1;
#pragma unroll
  for (int i = 0; i < 16; ++i) { acc0[i] = 0.f; acc1[i] = 0.f; }
  u32x4 rx = {0u, 0u, 0u, 0u}; f32x4 rp0, rp1;
#define STAGE_WRITE(buf)                                                                                   \
  {                                                                                                        \
    u32x4 o_;                                                                                              \
    _Pragma("unroll") for (int i = 0; i < 4; ++i) {                                                        \
      const unsigned wv_ = rx[i];                                                                          \
      const float lo = __uint_as_float(wv_ << 16) + ((i < 2) ? rp0[2 * i] : rp1[2 * i - 4]);               \
      const float hi = __uint_as_float(wv_ & 0xFFFF0000u) + ((i < 2) ? rp0[2 * i + 1] : rp1[2 * i - 3]);   \
      o_[i] = pack2(lo, hi);                                                                               \
    }                                                                                                      \
    *(u32x4*)(Xs + (buf) * 4352 + srow * 136 + sch * 8) = o_;                                              \
  }
  if (svalid) rx = *(const u32x4*)(sp);
  rp0 = *(const f32x4*)(pos + sch * 8); rp1 = *(const f32x4*)(pos + sch * 8 + 4);
  STAGE_WRITE(0)
  __syncthreads();
  const bf16_t* wb0 = w1f + ((size_t)(2 * w) * 256 * 64 + lane) * 8;
  const bf16_t* wb1 = w1f + ((size_t)(2 * w + 1) * 256 * 64 + lane) * 8;
#pragma unroll 1
  for (int l = 0; l < 32; ++l) {
    if (l + 1 < 32) {
      if (svalid) rx = *(const u32x4*)(sp + (size_t)(l + 1) * INWP);
      rp0 = *(const f32x4*)(pos + (l + 1) * 128 + sch * 8); rp1 = *(const f32x4*)(pos + (l + 1) * 128 + sch * 8 + 4);
    }
    const bf16_t* xa = Xs + (l & 1) * 4352 + c * 136 + 8 * h;
#pragma unroll
    for (int s8 = 0; s8 < 8; ++s8) {
      const bf16x8 a = *(const bf16x8*)(xa + 16 * s8);
      const bf16x8 b0 = *(const bf16x8*)(wb0 + (size_t)(8 * l + s8) * 512);
      const bf16x8 b1v = *(const bf16x8*)(wb1 + (size_t)(8 * l + s8) * 512);
      acc0 = MFMA32(a, b0, acc0);
      acc1 = MFMA32(a, b1v, acc1);
    }
    if (l + 1 < 32) STAGE_WRITE((l + 1) & 1)
    __syncthreads();
  }
  {
    const float bb0 = b1[64 * w + c], bb1 = b1[64 * w + 32 + c];
#pragma unroll
    for (int rg = 0; rg < 16; ++rg) {
      const int row = (rg & 3) + 8 * (rg >> 2) + 4 * h;
      Hs[row * 520 + 64 * w + c] = f2bf(gelu_tanh(acc0[rg] + bb0));
      Hs[row * 520 + 64 * w + 32 + c] = f2bf(gelu_tanh(acc1[rg] + bb1));
    }
  }
  __syncthreads();
  if (w < 4) {
    f32x16 o2;
#pragma unroll
    for (int i = 0; i < 16; ++i) o2[i] = 0.f;
    const bf16_t* ha = Hs + c * 520 + 8 * h;
    const bf16_t* wb = w2f + ((size_t)w * 32 * 64 + lane) * 8;
#pragma unroll 8
    for (int s2 = 0; s2 < 32; ++s2) {
      const bf16x8 a = *(const bf16x8*)(ha + 16 * s2);
      const bf16x8 b = *(const bf16x8*)(wb + (size_t)s2 * 512);
      o2 = MFMA32(a, b, o2);
    }
    const int d = 32 * w + c;
#pragma unroll
    for (int rg = 0; rg < 16; ++rg) {
      const int row = R0 + (rg & 3) + 8 * (rg >> 2) + 4 * h;
      const int n = row >> 1, g = row & 1;
      const bf16_t val = (row < 2046) ? f2bf(o2[rg]) : (bf16_t)0;
      const int T = n >> 5, nn = n & 31;
      size_t idx;
      if (!isV) idx = ((((size_t)(g * 32 + T) * 8 + (d >> 4)) * 64 + (pi_perm(nn) + 32 * ((d >> 3) & 1))) * 8 + (d & 7));
      else idx = (((((size_t)(g * 32 + T) * 4 + (d >> 5)) * 2 + (nn >> 4)) * 64 + ((d & 31) + 32 * ((nn >> 3) & 1))) * 8 + (nn & 7));
      outf[idx] = val;
    }
  }
  __syncthreads();
}


DI unsigned f2sort(float f) { unsigned u = __float_as_uint(f); return u ^ ((unsigned)((int)u >> 31) | 0x80000000u); }
DI float sort2f(unsigned k) { unsigned u = (k & 0x80000000u) ? (k ^ 0x80000000u) : ~k; return __uint_as_float(u); }
template <int N>
DI void bitonic_sort_desc(unsigned (&key)[N]) {
#pragma unroll
  for (int k = 2; k <= N; k <<= 1) {
#pragma unroll
    for (int jj = k >> 1; jj > 0; jj >>= 1) {
#pragma unroll
      for (int i = 0; i < N; ++i) {
        const int l2 = i ^ jj;
        if (l2 > i) {
          const bool desc = ((i & k) == 0);
          unsigned a = key[i], b = key[l2];
          unsigned mx = a > b ? a : b, mn = a > b ? b : a;
          key[i] = desc ? mx : mn; key[l2] = desc ? mn : mx;
        }
      }
    }
  }
}
DI void merge_top16(unsigned (&a)[16], const unsigned (&b)[16]) {
#pragma unroll
  for (int i = 0; i < 16; ++i) { unsigned o = b[15 - i]; a[i] = a[i] > o ? a[i] : o; }
#pragma unroll
  for (int jj = 8; jj > 0; jj >>= 1) {
#pragma unroll
    for (int i = 0; i < 16; ++i) {
      const int l2 = i ^ jj;
      if (l2 > i) { unsigned x = a[i], y = a[l2]; a[i] = x > y ? x : y; a[l2] = x > y ? y : x; }
    }
  }
}
__device__ void d_cvt_subk(size_t c, const float* __restrict__ subk, bf16_t* __restrict__ skf) {
  int lane = c & 63, s = (c >> 6) & 7, kt = (c >> 9) & 3, hc = c >> 11;
  int i = lane & 31, h = lane >> 5;
  const float* src = subk + ((size_t)hc * 128 + 32 * kt + i) * 128 + 16 * s + 8 * h;
  bf16_t v[8];
#pragma unroll
  for (int j = 0; j < 8; ++j) v[j] = f2bf(src[j]);
  u32x4 o; o.x = v[0] | ((unsigned)v[1] << 16); o.y = v[2] | ((unsigned)v[3] << 16); o.z = v[4] | ((unsigned)v[5] << 16); o.w = v[6] | ((unsigned)v[7] << 16);
  *(u32x4*)(skf + c * 8) = o;
}

struct EpiProjG {
  static constexpr bool PERM = true, AFTER_DRAIN = false;
  bf16_t* proj; float* gates;
  DI void operator()(const f32x4 (&acc)[2][2][4][2], const pg8::Unit& u, int wr, int wc, int fr, int fq) const {
#pragma unroll
    for (int ai = 0; ai < 2; ++ai)
#pragma unroll
      for (int m = 0; m < 4; ++m) {
        const int row = u.pm * 256 + ai * 128 + wr * 64 + m * 16 + fr;
#pragma unroll
        for (int bj = 0; bj < 2; ++bj) {
          const int c0 = u.pn * 256 + bj * 128 + wc * 32 + 8 * fq;
          const f32x4 v0 = acc[ai][bj][m][0], v1 = acc[ai][bj][m][1];
          if (c0 < INW) {
            u32x4 w = {pack2(v0[0], v0[1]), pack2(v0[2], v0[3]), pack2(v1[0], v1[1]), pack2(v1[2], v1[3])};
            *(u32x4*)(proj + (size_t)row * INWP + c0) = w;
          }
          if (c0 >= OFF_G && c0 < OFF_G + 24) {
            f32x4 g0, g1;
#pragma unroll
            for (int j = 0; j < 4; ++j) { g0[j] = 1.f / (1.f + __expf(-v0[j])); g1[j] = 1.f / (1.f + __expf(-v1[j])); }
            *(f32x4*)(gates + (size_t)row * 24 + (c0 - OFF_G)) = g0;
            *(f32x4*)(gates + (size_t)row * 24 + (c0 - OFF_G) + 4) = g1;
          }
        }
      }
  }
};
struct EpiResG {
  static constexpr bool PERM = false, AFTER_DRAIN = false;
  float* Y; const float* X;
  DI void operator()(const f32x4 (&acc)[2][2][4][2], const pg8::Unit& u, int wr, int wc, int fr, int fq) const {
#pragma unroll
    for (int ai = 0; ai < 2; ++ai)
#pragma unroll
      for (int m = 0; m < 4; ++m) {
        const size_t ro = (size_t)(u.pm * 256 + ai * 128 + wr * 64 + m * 16 + fr) * DM + u.pn * 256 + wc * 32 + 4 * fq;
#pragma unroll
        for (int bj = 0; bj < 2; ++bj)
#pragma unroll
          for (int n = 0; n < 2; ++n) {
            const f32x4 xv = *(const f32x4*)(X + ro + bj * 128 + n * 16);
            *(f32x4*)(Y + ro + bj * 128 + n * 16) = ALPHA * xv + acc[ai][bj][m][n];
          }
      }
  }
};
struct EpiF32G {
  static constexpr bool PERM = false, AFTER_DRAIN = false;
  float* C; int ldc;
  DI void operator()(const f32x4 (&acc)[2][2][4][2], const pg8::Unit& u, int wr, int wc, int fr, int fq) const {
#pragma unroll
    for (int ai = 0; ai < 2; ++ai)
#pragma unroll
      for (int m = 0; m < 4; ++m) {
        const size_t ro = (size_t)(u.pm * 256 + ai * 128 + wr * 64 + m * 16 + fr) * ldc + u.pn * 256 + wc * 32 + 4 * fq;
#pragma unroll
        for (int bj = 0; bj < 2; ++bj)
#pragma unroll
          for (int n = 0; n < 2; ++n) *(f32x4*)(C + ro + bj * 128 + n * 16) = acc[ai][bj][m][n];
      }
  }
};
struct EpiRouteG {
  static constexpr bool PERM = false, AFTER_DRAIN = true;
  const bf16_t* skf; unsigned* tops;
  DI void operator()(const f32x4 (&)[2][2][4][2], const pg8::Unit&, int, int, int, int) const {}
  DI void fused(const f32x4 (&acc)[2][2][4][2], const pg8::Unit& u, int wr, int wc, int fr, int fq, PG8_LAS unsigned char* ldsp, int, int) const {
    const int lane = fr | (fq << 4), wid = wr * 4 + wc;
    bf16_t* Qs = (bf16_t*)ldsp;
#pragma unroll
    for (int ai = 0; ai < 2; ++ai)
#pragma unroll
      for (int m = 0; m < 4; ++m) {
        const int row = ai * 128 + wr * 64 + m * 16 + fr;
#pragma unroll
        for (int bj = 0; bj < 2; ++bj)
#pragma unroll
          for (int n = 0; n < 2; ++n) {
            const f32x4 v = acc[ai][bj][m][n];
            u32x2 w = {pack2(v[0], v[1]), pack2(v[2], v[3])};
            *(u32x2*)(Qs + row * 264 + bj * 128 + wc * 32 + n * 16 + 4 * fq) = w;
          }
      }
    __syncthreads();
    const int c = lane & 31, h = lane >> 5;
#pragma unroll 1
    for (int half = 0; half < 2; ++half) {
      const int hc = u.pn * 2 + half;
      const bf16_t* sk = skf + (size_t)hc * 4 * 4096;
      const bf16_t* qp = Qs + (wid * 32 + c) * 264 + half * 128 + 8 * h;
      unsigned k0[16], k1[16];
#define ROUTE_KT(KT, KA)                                                                        \
      {                                                                                         \
        f32x16 sc;                                                                              \
        _Pragma("unroll") for (int i = 0; i < 16; ++i) sc[i] = 0.f;                             \
        _Pragma("unroll") for (int s = 0; s < 8; ++s) {                                         \
          bf16x8 af = *(const bf16x8*)(sk + (KT) * 4096 + s * 512 + lane * 8);                  \
          bf16x8 bq = *(const bf16x8*)(qp + 16 * s);                                            \
          sc = __builtin_amdgcn_mfma_f32_32x32x16_bf16(af, bq, sc, 0, 0, 0);                    \
        }                                                                                       \
        _Pragma("unroll") for (int rg = 0; rg < 16; ++rg) {                                     \
          const int kidx = 32 * (KT) + (rg & 3) + 8 * (rg >> 2) + 4 * h;                        \
          KA[rg] = (f2sort(sc[rg]) & 0xFFFFFF80u) | (unsigned)(127 - kidx);                     \
        }                                                                                       \
        bitonic_sort_desc<16>(KA);                                                              \
      }
      ROUTE_KT(0, k0)
      __builtin_amdgcn_sched_barrier(0);
      ROUTE_KT(1, k1)
      merge_top16(k0, k1);
      __builtin_amdgcn_sched_barrier(0);
      ROUTE_KT(2, k1)
      merge_top16(k0, k1);
      __builtin_amdgcn_sched_barrier(0);
      ROUTE_KT(3, k1)
      merge_top16(k0, k1);
      __builtin_amdgcn_sched_barrier(0);
#undef ROUTE_KT
#pragma unroll
      for (int i = 0; i < 16; ++i) k1[i] = (unsigned)shx_i((int)k0[i], 32);
      merge_top16(k0, k1);
      if (h == 0) {
        unsigned* dst = tops + ((size_t)(u.pm * 256 + wid * 32 + c) * 16 + hc) * 16;
#pragma unroll
        for (int q4 = 0; q4 < 4; ++q4) { u32x4 o = {k0[4 * q4], k0[4 * q4 + 1], k0[4 * q4 + 2], k0[4 * q4 + 3]}; *(u32x4*)(dst + 4 * q4) = o; }
      }
    }
    __syncthreads();
  }
};


template <int CTRL> DI float dpp_f(float v) { const int iv = __float_as_int(v); return __int_as_float(__builtin_amdgcn_update_dpp(iv, iv, CTRL, 0xF, 0xF, false)); }
DI float wsum(float x) {
  x += dpp_f<0xB1>(x);
  x += dpp_f<0x4E>(x);
  x += dpp_f<0x124>(x);
  x += dpp_f<0x128>(x);
  x += shx(x, 16);
  return hsum(x);
}
DI float gelu_fast(float x) {
  const float u2 = 1.5957691216057308f * (x + 0.044715f * x * x * x);
  return x * __builtin_amdgcn_rcpf(1.f + ex2(-LOG2E * u2));
}

constexpr int EROW = 1152;
typedef float v2f __attribute__((ext_vector_type(2)));
__device__ void d_cvt_fp4_row(int row, const float* __restrict__ src, unsigned char* __restrict__ dst) {
  const int lane = TIDX & 63;
  float v[32]; float amax = 0.f;
#pragma unroll
  for (int i = 0; i < 8; ++i) {
    f32x4 x = *(const f32x4*)(src + (size_t)row * DM + 256 * i + 4 * lane);
#pragma unroll
    for (int j = 0; j < 4; ++j) { v[i * 4 + j] = x[j]; amax = fmaxf(amax, fabsf(x[j])); }
  }
  const float sc = amax > 0.f ? amax * (1.f / 6.f) : 1.f;
  const float scb = bf2f(f2bf(sc));
  const float inv = 1.f / scb;
  u32x4 o;
#pragma unroll
  for (int k = 0; k < 4; ++k) {
    unsigned w = 0u;
#define FP4C(x_) fminf(fmaxf((x_) * inv, -6.f), 6.f)
    w = __builtin_amdgcn_cvt_scalef32_pk_fp4_f32(w, FP4C(v[8 * k + 0]), FP4C(v[8 * k + 1]), 1.0f, 0);
    w = __builtin_amdgcn_cvt_scalef32_pk_fp4_f32(w, FP4C(v[8 * k + 2]), FP4C(v[8 * k + 3]), 1.0f, 1);
    w = __builtin_amdgcn_cvt_scalef32_pk_fp4_f32(w, FP4C(v[8 * k + 4]), FP4C(v[8 * k + 5]), 1.0f, 2);
    w = __builtin_amdgcn_cvt_scalef32_pk_fp4_f32(w, FP4C(v[8 * k + 6]), FP4C(v[8 * k + 7]), 1.0f, 3);
#undef FP4C
    o[k] = w;
  }
  *(u32x4*)(dst + (size_t)row * EROW + 16 * lane) = o;
  *(bf16_t*)(dst + (size_t)row * EROW + 1024 + 2 * lane) = f2bf(sc);
}
__device__ void d_expert_wave(int t, unsigned* tpl, const float* __restrict__ yf, const float* __restrict__ stats, const float* __restrict__ g1v, const float* __restrict__ b1v,
                              const unsigned* __restrict__ tops, const unsigned char* __restrict__ eu4, const unsigned char* __restrict__ ev4,
                              const float* __restrict__ gam, const float* __restrict__ bet, float* __restrict__ out) {
  const int lane = TIDX & 63;
  const float mu1 = stats[2 * t], rs1 = stats[2 * t + 1];
  float hv[32];
#pragma unroll
  for (int i = 0; i < 8; ++i) {
    const int cb = 256 * i + 4 * lane;
    const f32x4 x = *(const f32x4*)(yf + (size_t)t * DM + cb), gg = *(const f32x4*)(g1v + cb), bb = *(const f32x4*)(b1v + cb);
#pragma unroll
    for (int j = 0; j < 4; ++j) hv[i * 4 + j] = (x[j] - mu1) * rs1 * gg[j] + bb[j];
  }
  int e0 = 0, e1 = 0; float w0 = 0.f, w1 = 0.f;
  {
    const int ci = (lane < 16) ? 0 : (lane < 24) ? 1 : (lane < 29) ? 2 : (lane < 33) ? 3 : (lane < 36) ? 4 : (lane < 38) ? 5 : (lane < 40) ? 6
                   : (lane < 42) ? 7 : (lane - 34);
    const int cpre = (ci == 0) ? 0 : (ci == 1) ? 16 : (ci == 2) ? 24 : (ci == 3) ? 29 : (ci == 4) ? 33 : (ci == 5) ? 36 : (ci == 6) ? 38
                     : (ci == 7) ? 40 : (34 + ci);
    const int cj = lane - cpre;
    const bool cvalid = lane < 50;
    *(u32x4*)(tpl + 4 * lane) = *(const u32x4*)(tops + (size_t)t * 256 + 4 * lane);
    const unsigned* tp = tpl;
#pragma unroll 1
    for (int hh = 0; hh < 8; ++hh) {
      unsigned key = 0u;
      if (cvalid) {
        const float sa = sort2f(tp[(2 * hh) * 16 + ci]), sb = sort2f(tp[(2 * hh + 1) * 16 + cj]);
        key = (f2sort(sa + sb) & 0xFFFFFF00u) | (unsigned)(255 - (ci * 16 + cj));
      }
#pragma unroll
      for (int k = 2; k <= 64; k <<= 1) {
#pragma unroll
        for (int jj = k >> 1; jj > 0; jj >>= 1) {
          const unsigned o = (unsigned)shx_i((int)key, jj);
          const bool lower = (lane & jj) == 0;
          const bool desc = (lane & k) == 0 || k == 64;
          const unsigned mx = key > o ? key : o, mn = key > o ? o : key;
          key = (lower == desc) ? mx : mn;
        }
      }
      const int flat = 255 - (int)(key & 255u);
      const int bi = (flat >> 4) & 15, bj = flat & 15;
      const unsigned ka = tp[(2 * hh) * 16 + bi], kb = tp[(2 * hh + 1) * 16 + bj];
      const float sc = sort2f(ka) + sort2f(kb);
      const int ex = (127 - (int)(ka & 127u)) * 128 + (127 - (int)(kb & 127u));
      float mx = sc;
      mx = fmaxf(mx, shx(mx, 1)); mx = fmaxf(mx, shx(mx, 2)); mx = fmaxf(mx, shx(mx, 4)); mx = fmaxf(mx, shx(mx, 8));
      const float ev_ = __expf(sc - mx);
      float sm = ev_;
      sm += shx(sm, 1); sm += shx(sm, 2); sm += shx(sm, 4); sm += shx(sm, 8);
      const float gv = ev_ / sm;
      const int exs = __shfl(ex, lane & 15); const float gvs = __shfl(gv, lane & 15);
      if ((lane >> 4) == (hh & 3)) { if (hh < 4) { e0 = exs; w0 = gvs; } else { e1 = exs; w1 = gvs; } }
    }
  }
  bf16x2v hb2[16];
#pragma unroll
  for (int i = 0; i < 16; ++i) hb2[i] = bf16x2v{(__bf16)hv[2 * i], (__bf16)hv[2 * i + 1]};
  float c0 = 0.f, c1 = 0.f;
  u32x4 rA[4], rB[4]; unsigned short sA[4], sB[4];
#define EX_LOAD(R, SS, TAB, EB)                                                            \
  _Pragma("unroll") for (int k = 0; k < 4; ++k) {                                          \
    const int e = (EB) + k;                                                                \
    const int id = __builtin_amdgcn_readlane((e < 64) ? e0 : e1, e & 63);                 \
    const unsigned char* row = (TAB) + (size_t)id * EROW;                                  \
    R[k] = *(const u32x4*)(row + 16 * lane);                                               \
    SS[k] = *(const unsigned short*)(row + 1024 + 2 * lane);                               \
  }
#define PKFMA(a_, b_, c_) __builtin_elementwise_fma((a_), (b_), (c_))
#define EX_COMP_U(R, SS, EB)                                                               \
  {                                                                                        \
    float dd[4];                                                                           \
    _Pragma("unroll") for (int k = 0; k < 4; ++k) {                                        \
      float d0 = 0.f, d1 = 0.f;                                                            \
      _Pragma("unroll") for (int q = 0; q < 4; ++q) {                                      \
        const unsigned wq = R[k][q];                                                       \
        d0 = __builtin_amdgcn_fdot2_f32_bf16(__builtin_amdgcn_cvt_scalef32_pk_bf16_fp4(wq, 1.0f, 0), hb2[4 * q + 0], d0, false); \
        d1 = __builtin_amdgcn_fdot2_f32_bf16(__builtin_amdgcn_cvt_scalef32_pk_bf16_fp4(wq, 1.0f, 1), hb2[4 * q + 1], d1, false); \
        d0 = __builtin_amdgcn_fdot2_f32_bf16(__builtin_amdgcn_cvt_scalef32_pk_bf16_fp4(wq, 1.0f, 2), hb2[4 * q + 2], d0, false); \
        d1 = __builtin_amdgcn_fdot2_f32_bf16(__builtin_amdgcn_cvt_scalef32_pk_bf16_fp4(wq, 1.0f, 3), hb2[4 * q + 3], d1, false); \
      }                                                                                    \
      dd[k] = bf2f(SS[k]) * (d0 + d1);                                                     \
      __builtin_amdgcn_sched_barrier(0);                                                   \
    }                                                                                      \
      \
    float t01, t23;                                                                        \
    { auto r_ = __builtin_amdgcn_permlane32_swap(__float_as_uint(dd[0]), __float_as_uint(dd[1]), false, false);   \
      t01 = __uint_as_float(r_[0]) + __uint_as_float(r_[1]); }          \
    { auto r_ = __builtin_amdgcn_permlane32_swap(__float_as_uint(dd[2]), __float_as_uint(dd[3]), false, false);   \
      t23 = __uint_as_float(r_[0]) + __uint_as_float(r_[1]); }          \
    const bool b4_ = (lane & 16) != 0;                                                     \
    float tv = (b4_ ? t23 : t01) + shx(b4_ ? t01 : t23, 16);          \
    tv += dpp_f<0x128>(tv); tv += dpp_f<0x124>(tv); tv += dpp_f<0x4E>(tv); tv += dpp_f<0xB1>(tv);                 \
    _Pragma("unroll") for (int k = 0; k < 4; ++k) {                                        \
      const int e = (EB) + k;                                                              \
      const float tot = __int_as_float(__builtin_amdgcn_readlane(__float_as_int(tv), (k == 0) ? 0 : (k == 1) ? 32 : (k == 2) ? 16 : 48)); \
      if (e < 64) { if (lane == e) c0 = tot; } else { if (lane == e - 64) c1 = tot; }        \
    }                                                                                      \
    __builtin_amdgcn_sched_barrier(0);                                                     \
  }
#define EX_COMP_V(R, SS, EB)                                                               \
  _Pragma("unroll") for (int k = 0; k < 4; ++k) {                                          \
    const int e = (EB) + k;                                                                \
    const float cs = __int_as_float(__builtin_amdgcn_readlane(__float_as_int((e < 64) ? c0 : c1), e & 63)) * bf2f(SS[k]);                     \
    const v2f cs2 = {cs, cs};                                                              \
    _Pragma("unroll") for (int q = 0; q < 4; ++q) {                                        \
      const unsigned wq = R[k][q];                                                         \
      const v2f f0 = __builtin_amdgcn_cvt_scalef32_pk_f32_fp4(wq, 1.0f, 0), f1 = __builtin_amdgcn_cvt_scalef32_pk_f32_fp4(wq, 1.0f, 1); \
      const v2f f2 = __builtin_amdgcn_cvt_scalef32_pk_f32_fp4(wq, 1.0f, 2), f3 = __builtin_amdgcn_cvt_scalef32_pk_f32_fp4(wq, 1.0f, 3); \
      acc2[4 * q + 0] = PKFMA(cs2, f0, acc2[4 * q + 0]); acc2[4 * q + 1] = PKFMA(cs2, f1, acc2[4 * q + 1]); \
      acc2[4 * q + 2] = PKFMA(cs2, f2, acc2[4 * q + 2]); acc2[4 * q + 3] = PKFMA(cs2, f3, acc2[4 * q + 3]); \
    }                                                                                      \
    __builtin_amdgcn_sched_barrier(0);                                                     \
  }
  EX_LOAD(rA, sA, eu4, 0)
  __builtin_amdgcn_sched_barrier(0);
#pragma unroll 1
  for (int eb = 0; eb < 128; eb += 8) {
    EX_LOAD(rB, sB, eu4, eb + 4)
    __builtin_amdgcn_sched_barrier(0);
    EX_COMP_U(rA, sA, eb)
    { const bool more = eb + 8 < 128; const unsigned char* tabn = more ? eu4 : ev4; const int ebn = more ? eb + 8 : 0;
      EX_LOAD(rA, sA, tabn, ebn) }
    __builtin_amdgcn_sched_barrier(0);
    EX_COMP_U(rB, sB, eb + 4)
  }
  c0 = w0 * gelu_fast(c0); c1 = w1 * gelu_fast(c1);
  v2f acc2[16];
#pragma unroll
  for (int i = 0; i < 16; ++i) acc2[i] = v2f{0.f, 0.f};
#pragma unroll 1
  for (int eb = 0; eb < 128; eb += 8) {
    EX_LOAD(rB, sB, ev4, eb + 4)
    __builtin_amdgcn_sched_barrier(0);
    EX_COMP_V(rA, sA, eb)
    { const int ebn = (eb + 8 < 128) ? eb + 8 : 0;
      EX_LOAD(rA, sA, ev4, ebn) }
    __builtin_amdgcn_sched_barrier(0);
    EX_COMP_V(rB, sB, eb + 4)
  }
#undef EX_LOAD
#undef EX_COMP_U
#undef EX_COMP_V
#undef PKFMA
  float acc[32];
#pragma unroll
  for (int i = 0; i < 16; ++i) { acc[2 * i] = acc2[i].x; acc[2 * i + 1] = acc2[i].y; }
  int le = lane;
  asm volatile("" : "+v"(le) :: "memory");
  float s = 0.f;
#pragma unroll
  for (int i = 0; i < 8; ++i) {
    const int cb = 256 * i + 4 * le;
    const f32x4 x = *(const f32x4*)(yf + (size_t)t * DM + cb), gg = *(const f32x4*)(g1v + cb), bb = *(const f32x4*)(b1v + cb);
#pragma unroll
    for (int j = 0; j < 4; ++j) { const float hj = (x[j] - mu1) * rs1 * gg[j] + bb[j]; acc[i * 4 + j] = fmaf(ALPHA, hj, acc[i * 4 + j]); s += acc[i * 4 + j]; }
  }
  s = wsum(s);
  const float mu = s * (1.f / DM);
  float qv = 0.f;
#pragma unroll
  for (int i = 0; i < 32; ++i) { const float d = acc[i] - mu; qv += d * d; }
  qv = wsum(qv);
  const float rs = rsqrtf(qv * (1.f / DM) + 1e-5f);
#pragma unroll
  for (int i = 0; i < 8; ++i) {
    const int cbase = 256 * i + 4 * le;
    f32x4 ga = *(const f32x4*)(gam + cbase), ba = *(const f32x4*)(bet + cbase), o;
#pragma unroll
    for (int j = 0; j < 4; ++j) o[j] = (acc[i * 4 + j] - mu) * rs * ga[j] + ba[j];
    *(f32x4*)(out + (size_t)t * DM + cbase) = o;
  }
}

constexpr size_t al256(size_t x) { return (x + 255) & ~(size_t)255; }
constexpr size_t WS_XB = 0;
constexpr size_t WS_PROJ = WS_XB + al256((size_t)S * DM * 2);
constexpr size_t WS_WINT = WS_PROJ + al256((size_t)S * INWP * 2);
constexpr size_t WS_GATES = WS_WINT + al256((size_t)INWG * DM * 2);
constexpr size_t WS_W1KF = WS_GATES + al256((size_t)S * 24 * 4);
constexpr size_t WS_W1VF = WS_W1KF + al256((size_t)512 * 4096 * 2);
constexpr size_t WS_W2KF = WS_W1VF + al256((size_t)512 * 4096 * 2);
constexpr size_t WS_W2VF = WS_W2KF + al256((size_t)512 * 128 * 2);
constexpr size_t WS_VC = WS_W2VF + al256((size_t)512 * 128 * 2) - al256((size_t)2048 * 128 * 4);
constexpr size_t WS_KCF = WS_VC + al256((size_t)2048 * 128 * 4);
constexpr size_t WS_VCF = WS_KCF + al256((size_t)2 * 32 * 4096 * 2);
constexpr size_t WS_KSF = WS_VCF + al256((size_t)2 * 32 * 4096 * 2);
constexpr size_t WS_VSF = WS_KSF + al256((size_t)2 * 512 * 4096 * 2);
constexpr size_t WS_KWF = WS_VSF + al256((size_t)2 * 512 * 4096 * 2);
constexpr size_t WS_VWF = WS_KWF + al256((size_t)2 * 512 * 4096 * 2);
constexpr size_t WS_ENDA = WS_VWF + al256((size_t)2 * 512 * 4096 * 2);
constexpr size_t WS_OATT = WS_ENDA;
constexpr size_t WS_MIX = WS_OATT + al256((size_t)S * 1024 * 4);
constexpr size_t WS_WOUTT = WS_MIX + al256((size_t)S * DM * 2);
constexpr size_t WS_WQT = WS_WOUTT + al256((size_t)DM * DM * 2);
constexpr size_t WS_TOPS = WS_WQT + al256((size_t)DM * DM * 2);
constexpr size_t WS_SKF = WS_TOPS + al256((size_t)S * 256 * 4);
constexpr size_t WS_STATS = WS_SKF + al256((size_t)16 * 128 * 128 * 2);
constexpr size_t WS_CTRL = WS_STATS + al256((size_t)S * 2 * 4);
constexpr size_t CTRL_BYTES = 32768;
constexpr size_t WS_END = WS_CTRL + CTRL_BYTES;
constexpr size_t WS_Y = WS_PROJ;
constexpr size_t WS_HB = WS_XB;
constexpr size_t WS_EU8 = WS_Y + (size_t)S * DM * 4;
constexpr size_t WS_EV8 = WS_EU8 + (size_t)16384 * 1152;
static_assert(WS_EV8 + (size_t)16384 * 1152 <= WS_ENDA, "expert overlay overflows group A");
static_assert(WS_END <= (size_t)512 * 1024 * 1024, "workspace over 512 MiB");

struct Params {
  const float *x, *w_in, *ck_pos, *ck_w1, *ck_b1, *ck_w2, *cv_pos, *cv_w1, *cv_b1, *cv_w2, *conv_w, *hng, *w_out, *ln1g, *ln1b, *w_query, *subk,
      *eu, *ev, *ln2g, *ln2b;
  float* out;
  char* ws;
};
#define WSP(T, OFF) ((T*)(p.ws + (OFF)))

#define FOR_VB(n) for (int vb = blockIdx.x; vb < (n); vb += gridDim.x)
#define FOR_VB2(n) for (int vb = blockIdx.x * 2 + (TIDX >> 8); vb < (n); vb += gridDim.x * 2)
constexpr int SMEM_BYTES = 143360;
constexpr int HALF = 36864;

__global__ void __launch_bounds__(512) mega(Params p) {
  __shared__ __attribute__((aligned(16))) char smem[SMEM_BYTES + 16];
  if (TIDX == 0) *(u32x4*)(smem + SMEM_BYTES) = u32x4{0u, 0u, 0u, 0u};
  __syncthreads();
  const XcdBarrier xbar = xcd_barrier_post(WSP(unsigned, WS_CTRL + 1024), (volatile LAS unsigned*)(smem + SMEM_BYTES));
#define smh (smem + (TIDX >> 8) * HALF)
#define wv ((TIDX >> 6))
  constexpr int NWV = 8;
  d_cvt(p.x, WSP(bf16_t, WS_XB), (size_t)S * DM / 4);
  FOR_VB2((INWG / 64) * (DM / 64)) d_cvtT64(vb, smh, p.w_in, WSP(bf16_t, WS_WINT), DM, INW, INWG);
  for (size_t c = (size_t)blockIdx.x * 512 + TIDX; c < (size_t)16 * 256 * 64; c += (size_t)gridDim.x * 512) {
    d_cvt_w1f(c, p.ck_w1, WSP(bf16_t, WS_W1KF)); d_cvt_w1f(c, p.cv_w1, WSP(bf16_t, WS_W1VF));
    if (c < (size_t)4 * 32 * 64) { d_cvt_w2f(c, p.ck_w2, WSP(bf16_t, WS_W2KF)); d_cvt_w2f(c, p.cv_w2, WSP(bf16_t, WS_W2VF)); }
  }
  FOR_VB2((DM / 64) * (DM / 64)) d_cvtT64(vb, smh, p.w_out, WSP(bf16_t, WS_WOUTT), DM, DM, DM);
  FOR_VB2((DM / 64) * (DM / 64)) d_cvtT64(vb, smh, p.w_query, WSP(bf16_t, WS_WQT), DM, DM, DM);
  for (size_t c = (size_t)blockIdx.x * 512 + TIDX; c < (size_t)16 * 4 * 8 * 64; c += (size_t)gridDim.x * 512) d_cvt_subk(c, p.subk, WSP(bf16_t, WS_SKF));
  xcd_barrier(xbar);
  {
    pg8::StaticOrder so; so.init(S, INWG, gridDim.x, blockIdx.x);
    pg8::gemm_phase<EpiProjG, pg8::StaticOrder>((PG8_LAS unsigned char*)smem, pg8::Gemm{WSP(bf16_t, WS_XB), WSP(bf16_t, WS_WINT), S, INWG, DM}, so,
                                                EpiProjG{WSP(bf16_t, WS_PROJ), WSP(float, WS_GATES)}, nullptr);
  }
  xcd_barrier(xbar);
  {
    if (blockIdx.x < 128) {
      const int u = blockIdx.x; const bool isV = u >= 64;
      d_compress_unit(u & 63, smem, WSP(bf16_t, WS_PROJ), isV ? OFF_VC : OFF_KC, isV ? p.cv_pos : p.ck_pos, isV ? WSP(bf16_t, WS_W1VF) : WSP(bf16_t, WS_W1KF),
                      isV ? p.cv_b1 : p.ck_b1, isV ? WSP(bf16_t, WS_W2VF) : WSP(bf16_t, WS_W2KF), isV ? WSP(bf16_t, WS_VCF) : WSP(bf16_t, WS_KCF), isV);
    }
    int* slot = (int*)smem;
    unsigned* ctr = WSP(unsigned, WS_CTRL);
    for (;;) {
      if (TIDX == 0) *slot = (int)atomicAdd(ctr, 1u);
      __syncthreads();
      const int it = *slot;
      __syncthreads();
      if (it >= 2048) break;
      const int tt = TIDX;
      {
        const int T = it >> 2, which = it & 3;
        d_relayout_tile(T, smem + 64, WSP(bf16_t, WS_PROJ), (which == 0) ? OFF_KS : (which == 1) ? OFF_VS : (which == 2) ? OFF_KW : OFF_VW,
                        (which == 0) ? WSP(bf16_t, WS_KSF) : (which == 1) ? WSP(bf16_t, WS_VSF) : (which == 2) ? WSP(bf16_t, WS_KWF) : WSP(bf16_t, WS_VWF), (which & 1) != 0);
      }
      for (int q = 0; q < 2; ++q) d_convmix(it * 8 + q * 4 + (tt >> 7), tt & 127, WSP(bf16_t, WS_PROJ), p.conv_w, p.hng, WSP(bf16_t, WS_MIX));
    }
  }
  xcd_barrier(xbar);
  {
    AttnPtrs ap{WSP(bf16_t, WS_PROJ), WSP(float, WS_GATES), WSP(bf16_t, WS_KCF), WSP(bf16_t, WS_VCF), WSP(bf16_t, WS_KSF), WSP(bf16_t, WS_VSF), WSP(bf16_t, WS_KWF), WSP(bf16_t, WS_VWF), WSP(bf16_t, WS_MIX), p.hng};
    for (int it = blockIdx.x; it < 512; it += gridDim.x) {
      const int Bq = (it < 256) ? it : (511 - it), gq = (it < 256) ? 0 : 1;
      d_attn_block(Bq, gq, smem, ap);
    }
  }
  xcd_barrier(xbar);
  {
    pg8::StaticOrder so; so.init(S, DM, gridDim.x, blockIdx.x);
    pg8::gemm_phase<EpiResG, pg8::StaticOrder>((PG8_LAS unsigned char*)smem, pg8::Gemm{WSP(bf16_t, WS_MIX), WSP(bf16_t, WS_WOUTT), S, DM, DM}, so,
                                               EpiResG{WSP(float, WS_Y), p.x}, nullptr);
  }
  xcd_barrier(xbar);
  for (int r = blockIdx.x * NWV + wv; r < S; r += gridDim.x * NWV) d_ln_wave(r, WSP(float, WS_Y), p.ln1g, p.ln1b, WSP(float, WS_STATS), WSP(bf16_t, WS_HB));
  for (int r = blockIdx.x * NWV + wv; r < 32768; r += gridDim.x * NWV) {
    if (r < 16384) d_cvt_fp4_row(r, p.eu, WSP(unsigned char, WS_EU8)); else d_cvt_fp4_row(r - 16384, p.ev, WSP(unsigned char, WS_EV8));
  }
  xcd_barrier(xbar);
  for (int k = 0; k * (int)gridDim.x < (S / 256) * (DM / 256); ++k) {
    pg8::OneUnit so; so.init(S, DM, gridDim.x, blockIdx.x); so.k = k;
    pg8::gemm_phase<EpiRouteG, pg8::OneUnit>((PG8_LAS unsigned char*)smem, pg8::Gemm{WSP(bf16_t, WS_HB), WSP(bf16_t, WS_WQT), S, DM, DM}, so,
                                             EpiRouteG{WSP(bf16_t, WS_SKF), WSP(unsigned, WS_TOPS)}, nullptr);
    __syncthreads();
  }
  xcd_barrier(xbar);
  for (int t = blockIdx.x * NWV + wv; t < S; t += gridDim.x * NWV) d_expert_wave(t, (unsigned*)(smem + wv * 1024), WSP(float, WS_Y), WSP(float, WS_STATS), p.ln1g, p.ln1b, WSP(unsigned, WS_TOPS), WSP(unsigned char, WS_EU8), WSP(unsigned char, WS_EV8), p.ln2g, p.ln2b, p.out);
}

extern "C" void kernel_launch(void* const* d_in, const int* in_sizes, int n_in, void* d_out, int out_size, void* d_ws, size_t ws_size,
                              hipStream_t stream) {
  Params p{};
  p.x = (const float*)d_in[0]; p.w_in = (const float*)d_in[1]; p.ck_pos = (const float*)d_in[2]; p.ck_w1 = (const float*)d_in[3];
  p.ck_b1 = (const float*)d_in[4]; p.ck_w2 = (const float*)d_in[5]; p.cv_pos = (const float*)d_in[6]; p.cv_w1 = (const float*)d_in[7];
  p.cv_b1 = (const float*)d_in[8]; p.cv_w2 = (const float*)d_in[9]; p.conv_w = (const float*)d_in[10]; p.hng = (const float*)d_in[11];
  p.w_out = (const float*)d_in[12]; p.ln1g = (const float*)d_in[13]; p.ln1b = (const float*)d_in[14]; p.w_query = (const float*)d_in[15];
  p.subk = (const float*)d_in[16]; p.eu = (const float*)d_in[17]; p.ev = (const float*)d_in[18]; p.ln2g = (const float*)d_in[19];
  p.ln2b = (const float*)d_in[20];
  p.out = (float*)d_out;
  p.ws = (char*)d_ws;
  if (ws_size < WS_END) fprintf(stderr, "workspace too small\n");
  static int grid_blocks = 0;
  if (!grid_blocks) {
    int dev = 0, cus = 0, per_cu = 0;
    hipGetDevice(&dev);
    hipDeviceGetAttribute(&cus, hipDeviceAttributeMultiprocessorCount, dev);
    hipOccupancyMaxActiveBlocksPerMultiprocessor(&per_cu, mega, 512, 0);
    if (per_cu > 1) per_cu = 1;
    if (per_cu < 1) per_cu = 1;
    grid_blocks = cus * per_cu;
  }
  hipMemsetAsync((char*)d_ws + WS_CTRL, 0, CTRL_BYTES, stream);
  void* args[] = {&p};
  hipError_t e = hipLaunchCooperativeKernel((void*)mega, dim3(grid_blocks), dim3(512), args, 0, stream);
  if (e != hipSuccess) fprintf(stderr, "cooperative launch failed: %s (grid %d)\n", hipGetErrorString(e), grid_blocks);
}
```

```cpp
#include <hip/hip_runtime.h>
#include <stdint.h>
#include <stdio.h>


#define DI __device__ __forceinline__
static __device__ __forceinline__ int tidx_() { int t = (int)__builtin_amdgcn_workitem_id_x(); asm volatile("" : "+v"(t)); return t; }
#define TIDX (tidx_())

template <int J> DI int swz_xor(int x) { return __builtin_amdgcn_ds_swizzle(x, (J << 10) | 0x1F); }
template <int CTRL> DI int dpp_i(int x) { return __builtin_amdgcn_update_dpp(x, x, CTRL, 0xF, 0xF, false); }
DI int shx_i(int x, int j) {
  switch (j) {
    case 1: return dpp_i<0xB1>(x);
    case 2: return dpp_i<0x4E>(x);
    case 4: return dpp_i<0x1B>(dpp_i<0x141>(x));
    case 8: return dpp_i<0x128>(x);
    case 16: return swz_xor<16>(x);
    default: {
      auto r = __builtin_amdgcn_permlane32_swap((unsigned)x, (unsigned)x, false, false);
      return (TIDX & 32) ? (int)r[0] : (int)r[1];
    }
  }
}
DI float shx(float x, int j) { return __int_as_float(shx_i(__float_as_int(x), j)); }
typedef unsigned short bf16_t;
using bf16x8 = __attribute__((ext_vector_type(8))) short;
using f32x4 = __attribute__((ext_vector_type(4))) float;
using u32x4 = __attribute__((ext_vector_type(4))) unsigned;
using u32x2 = __attribute__((ext_vector_type(2))) unsigned;

constexpr int S = 16384, DM = 2048, HD = 128;
constexpr int INW = 5656, INWP = 5760, INWG = 5888;
constexpr int OFF_Q = 0, OFF_KC = 1024, OFF_VC = 1280, OFF_KS = 1536, OFF_VS = 1792, OFF_KW = 2048, OFF_VW = 2304,
              OFF_G = 2560, OFF_U = 2584, OFF_B = 3608, OFF_C = 4632;
constexpr int NCMP = 1023;
constexpr float ALPHA = 1.189207115002721f;
constexpr float QSCALE = 0.08838834764831845f;

DI bf16_t f2bf(float x) { unsigned u = __float_as_uint(x); u += 0x7fffu + ((u >> 16) & 1u); return (bf16_t)(u >> 16); }
DI float bf2f(bf16_t b) { return __uint_as_float(((unsigned)b) << 16); }
DI float gelu_tanh(float x) { float u = 0.7978845608028654f * (x + 0.044715f * x * x * x); return 0.5f * x * (1.f + tanhf(u)); }
DI float wave_sum(float v) { for (int o = 32; o > 0; o >>= 1) v += shx(v, o); return v; }
using bf16x2v = __attribute__((ext_vector_type(2))) __bf16;
DI unsigned pack2(float a, float b) { bf16x2v v = {(__bf16)a, (__bf16)b}; return __builtin_bit_cast(unsigned, v); }
DI float wave_max(float v) { for (int o = 32; o > 0; o >>= 1) v = fmaxf(v, shx(v, o)); return v; }

namespace pg8 {
#define PG8_LAS __attribute__((address_space(3)))
typedef unsigned short bf16_t;
typedef short bf16x8 __attribute__((ext_vector_type(8)));
typedef float f32x4 __attribute__((ext_vector_type(4)));
typedef unsigned u32x4 __attribute__((ext_vector_type(4)));
constexpr int BM = 256, BK = 64, HALF = 128, HTB = HALF * BK * 2  , STAGE_BYTES = 8 * HTB, NXCD = 8, WGM = 8;

__host__ __device__ __forceinline__ int lds_byte(int r, int c) { const int st = (r >> 4) * 2 + (c >> 5), rr = r & 15, cc = c & 31, ob = rr * 64 + cc * 2; return st * 1024 + (ob ^ (((ob >> 9) & 1) << 5)); }
__host__ __device__ __forceinline__ void stage_rc(int b, int& R, int& C) { const int st = b / 1024, sb = b % 1024, swz = sb ^ (((sb >> 9) & 1) << 5); R = (st >> 1) * 16 + swz / 64; C = (st & 1) * 32 + (swz % 64) / 2; }
__host__ __device__ __forceinline__ int perm32(int rho) { const int n = rho >> 4, i = rho & 15; return 8 * (i >> 2) + 4 * n + (i & 3); }

struct Unit { int pm, pn; };
struct Gemm { const bf16_t* A; const bf16_t* Bt; int M, N, K; };

struct StaticOrder {
    int nM, nN, nwg, G, c;
    __host__ __device__ void init(int M, int N, int G_, int c_) { nM = M / BM; nN = N / BM; nwg = nM * nN; G = G_; c = c_; }
    __host__ __device__ bool next(int i, Unit& u) const {
        const long L = (long)i * G + c; if (L >= nwg) return false;
        int wgid = (int)L; { const int q = nwg / NXCD, r = nwg % NXCD, xcd = wgid % NXCD, off = wgid / NXCD; wgid = (xcd < r ? xcd * (q + 1) : r * (q + 1) + (xcd - r) * q) + off; }
        const int nig = WGM * nN, gid = wgid / nig, fm = gid * WGM, gsz = (nM - fm) < WGM ? (nM - fm) : WGM;
        u.pm = fm + ((wgid % nig) % gsz); u.pn = (wgid % nig) / gsz; return true;
    }
    __device__ __forceinline__ void a_ready(const Unit&) const {}
    __device__ __forceinline__ void done(const Unit&) const {}
};
struct OneUnit : StaticOrder {
    int k;
    __device__ bool next(int i, Unit& u) const { if (i > 0) return false; return StaticOrder::next(k, u); }
};
__device__ __forceinline__ unsigned cvt_pk_bf16(float lo, float hi) { unsigned r; asm volatile("v_cvt_pk_bf16_f32 %0, %1, %2" : "=v"(r) : "v"(lo), "v"(hi)); return r; }
template <class Epi, class Sched, bool STAMP = false>
__device__ __forceinline__ void gemm_phase(PG8_LAS unsigned char* lds, const Gemm g, const Sched& S, const Epi& E, unsigned long long* stamps) {
    const int tid = TIDX, wid = __builtin_amdgcn_readfirstlane(tid >> 6), lane = tid & 63, wr = wid >> 2, wc = wid & 3, fr = lane & 15, fq = lane >> 4;
    const int K = g.K, nt = K / BK;
    int ts_lo = 0, ts_hi = 0, nts = 0; const unsigned long long rt_entry = STAMP ? (unsigned long long)wall_clock64() : 0ull;
#define PG8_STAMP() do { if (STAMP && wid == 0 && nts < 64) { const unsigned long long _c = (unsigned long long)clock64(); \
        ts_lo = (lane == nts) ? (int)(unsigned)_c : ts_lo; ts_hi = (lane == nts) ? (int)(unsigned)(_c >> 32) : ts_hi; ++nts; } } while (0)
    PG8_STAMP();
    unsigned voffA[2], voffB[2];
#pragma unroll
    for (int i = 0; i < 2; ++i) { int R, C; stage_rc(tid * 16 + i * 8192, R, C); const int Rb = Epi::PERM ? ((R & ~31) + perm32(R & 31)) : R;
        voffA[i] = (unsigned)(R * K + C) * 2u; voffB[i] = (unsigned)(Rb * K + C) * 2u; }
    const size_t kstep = (size_t)(BK * 2);
    const size_t hstep = (size_t)HALF * K * 2;
    const size_t tstep = 2 * hstep;
    const unsigned ldsw = (unsigned)wid * 1024u;
    const int aoff = lds_byte(wr * 64 + fr, fq * 8), boff = lds_byte(wc * 32 + fr, fq * 8);
#define PG8_SA(b, h) (((b) * 2 + (h)) * HTB)
#define PG8_SB(b, h) ((4 + (b) * 2 + (h)) * HTB)
#define PG8_STAGE(bufoff, gbase, voff) do { _Pragma("unroll") for (int _i = 0; _i < 2; ++_i) \
        __builtin_amdgcn_global_load_lds((const unsigned*)((const char*)(gbase) + (voff)[_i]), (PG8_LAS unsigned*)(lds + (bufoff) + ldsw + _i * 8192), 16, 0, 0); } while (0)
#define PG8_LDA(dst, b, h) do { _Pragma("unroll") for (int m = 0; m < 4; ++m) _Pragma("unroll") for (int k = 0; k < 2; ++k) dst[m][k] = *(const PG8_LAS bf16x8*)(lds + PG8_SA(b, h) + aoff + m * 2048 + k * 1024); } while (0)
#define PG8_LDB(dst, b, h) do { _Pragma("unroll") for (int n = 0; n < 2; ++n) _Pragma("unroll") for (int k = 0; k < 2; ++k) dst[n][k] = *(const PG8_LAS bf16x8*)(lds + PG8_SB(b, h) + boff + n * 2048 + k * 1024); } while (0)
#define PG8_MMA(ai, bj, At, Bt) do { __builtin_amdgcn_s_setprio(1); _Pragma("unroll") for (int m = 0; m < 4; ++m) _Pragma("unroll") for (int n = 0; n < 2; ++n) _Pragma("unroll") for (int k = 0; k < 2; ++k) \
        acc[ai][bj][m][n] = __builtin_amdgcn_mfma_f32_16x16x32_bf16(Bt[n][k], At[m][k], acc[ai][bj][m][n], 0, 0, 0); __builtin_amdgcn_s_setprio(0); } while (0)
#define PG8_WAIT_V(n) asm volatile("s_waitcnt vmcnt(" #n ")" ::: "memory")
#define PG8_WAIT_L(n) asm volatile("s_waitcnt lgkmcnt(" #n ")" ::: "memory")
#define PG8_BAR __builtin_amdgcn_s_barrier()
#define PG8_SCHED __builtin_amdgcn_sched_barrier(0)
    Unit cur, nxt; int ui = 0;
    if (!S.next(0, cur)) return;
    f32x4 acc[2][2][4][2];
#pragma unroll
    for (int a = 0; a < 2; ++a)
#pragma unroll
        for (int b = 0; b < 2; ++b)
#pragma unroll
            for (int m = 0; m < 4; ++m)
#pragma unroll
                for (int n = 0; n < 2; ++n) acc[a][b][m][n] = (f32x4){0.f, 0.f, 0.f, 0.f};
    bf16x8 At[4][2], B0[2][2], B1[2][2];
    const char* cA = (const char*)g.A + (size_t)cur.pm * tstep; const char* cB = (const char*)g.Bt + (size_t)cur.pn * tstep;
    S.a_ready(cur);
    PG8_STAGE(PG8_SB(0, 0), cB, voffB); PG8_STAGE(PG8_SA(0, 0), cA, voffA); PG8_STAGE(PG8_SB(0, 1), cB + hstep, voffB); PG8_STAGE(PG8_SA(0, 1), cA + hstep, voffA);
    if (wr == 1) PG8_BAR;
    PG8_WAIT_V(4); PG8_BAR;
    PG8_STAGE(PG8_SB(1, 0), cB + kstep, voffB); PG8_STAGE(PG8_SA(1, 0), cA + kstep, voffA); PG8_STAGE(PG8_SB(1, 1), cB + hstep + kstep, voffB);
    PG8_WAIT_V(6); PG8_BAR;
    PG8_STAMP();
    for (;;) {
        const bool has_next = S.next(ui + 1, nxt);
        const char* nA = has_next ? (const char*)g.A + (size_t)nxt.pm * tstep : cA; const char* nB = has_next ? (const char*)g.Bt + (size_t)nxt.pn * tstep : cB;
        for (int t = 0; t < nt; t += 2) {
            const bool last = (t == nt - 2);
            const char* a1 = cA + (size_t)(t + 1) * kstep;
            const char* a2 = last ? nA : cA + (size_t)(t + 2) * kstep; const char* b2 = last ? nB : cB + (size_t)(t + 2) * kstep;
            const char* a3 = a2 + kstep; const char* b3 = b2 + kstep;
            if (last && has_next) S.a_ready(nxt);
            PG8_LDB(B0, 0, 0); PG8_SCHED; PG8_LDA(At, 0, 0); PG8_STAGE(PG8_SA(1, 1), a1 + hstep, voffA);
            PG8_WAIT_L(8); PG8_BAR; PG8_WAIT_L(0); PG8_MMA(0, 0, At, B0); PG8_BAR; PG8_SCHED;
            PG8_LDB(B1, 0, 1); PG8_STAGE(PG8_SB(0, 0), b2, voffB);
            PG8_BAR; PG8_WAIT_L(0); PG8_MMA(0, 1, At, B1); PG8_BAR;
            PG8_LDA(At, 0, 1); PG8_STAGE(PG8_SA(0, 0), a2, voffA);
            PG8_BAR; PG8_WAIT_L(0); PG8_MMA(1, 0, At, B0); PG8_BAR; PG8_SCHED;
            PG8_STAGE(PG8_SB(0, 1), b2 + hstep, voffB);
            PG8_WAIT_V(6); PG8_BAR; PG8_MMA(1, 1, At, B1); PG8_BAR;
            PG8_LDB(B0, 1, 0); PG8_SCHED; PG8_LDA(At, 1, 0); PG8_STAGE(PG8_SA(0, 1), a2 + hstep, voffA);
            PG8_WAIT_L(8); PG8_BAR; PG8_WAIT_L(0); PG8_MMA(0, 0, At, B0); PG8_BAR; PG8_SCHED;
            PG8_LDB(B1, 1, 1); PG8_STAGE(PG8_SB(1, 0), b3, voffB);
            PG8_BAR; PG8_WAIT_L(0); PG8_MMA(0, 1, At, B1); PG8_BAR;
            PG8_LDA(At, 1, 1); PG8_STAGE(PG8_SA(1, 0), a3, voffA);
            PG8_BAR; PG8_WAIT_L(0); PG8_MMA(1, 0, At, B0); PG8_BAR; PG8_SCHED;
            PG8_STAGE(PG8_SB(1, 1), b3 + hstep, voffB);
            PG8_WAIT_V(6); PG8_BAR; PG8_MMA(1, 1, At, B1); PG8_BAR;
        }
        PG8_STAMP();
        if constexpr (!Epi::AFTER_DRAIN) { E(acc, cur, wr, wc, fr, fq); S.done(cur); }
        PG8_STAMP();
        if (!has_next) break;
#pragma unroll
        for (int a = 0; a < 2; ++a)
#pragma unroll
            for (int b = 0; b < 2; ++b)
#pragma unroll
                for (int m = 0; m < 4; ++m)
#pragma unroll
                    for (int n = 0; n < 2; ++n) acc[a][b][m][n] = (f32x4){0.f, 0.f, 0.f, 0.f};
        cur = nxt; cA = nA; cB = nB; ++ui;
    }
    PG8_WAIT_V(0);
    if (wr == 0) PG8_BAR;
    PG8_BAR;
    if constexpr (Epi::AFTER_DRAIN) { E.fused(acc, cur, wr, wc, fr, fq, lds, wid, lane); S.done(cur); }
    PG8_STAMP();
    if (STAMP && wid == 0) { stamps[lane] = lane < nts ? (((unsigned long long)(unsigned)ts_hi << 32) | (unsigned)ts_lo) : 0ull;
        if (lane == 62) stamps[62] = rt_entry; if (lane == 63) stamps[63] = (unsigned long long)wall_clock64(); }
#undef PG8_STAMP
#undef PG8_SA
#undef PG8_SB
#undef PG8_STAGE
#undef PG8_LDA
#undef PG8_LDB
#undef PG8_MMA
#undef PG8_WAIT_V
#undef PG8_WAIT_L
#undef PG8_BAR
#undef PG8_SCHED
}
}

#define XB_TMO      128
#define XB_XCNT(j)  (256  + 64 * (j))
#define XB_XSUB(j)  (1280 + 64 * (j))
#define XB_XGEN(j)  (2304 + 64 * (j))
#define XB_TOP      3328
#define XB_TOPGEN   3392
#define XCD_BAR_WORDS 3456
#define XB_SPIN_CAP (1u << 18)
#define LAS __attribute__((address_space(3)))

__device__ __forceinline__ unsigned xb_ld(unsigned* p)              { return __hip_atomic_load(p, __ATOMIC_RELAXED, __HIP_MEMORY_SCOPE_AGENT); }
__device__ __forceinline__ unsigned xb_add(unsigned* p, unsigned v) { return __hip_atomic_fetch_add(p, v, __ATOMIC_RELAXED, __HIP_MEMORY_SCOPE_AGENT); }
__device__ __forceinline__ unsigned xb_xcc_id() { return (unsigned)__builtin_amdgcn_s_getreg((3 << 11) | 20) & 0xFu; }
#define XB_SPIN(cond, bar) do { unsigned _sp = 0; while (cond) { __builtin_amdgcn_s_sleep(1); \
    if ((++_sp & 255u) == 0u) { if (xb_ld(&(bar)[XB_TMO])) break; if (_sp > XB_SPIN_CAP) { atomicAdd(&(bar)[XB_TMO], 1u); break; } } } } while (0)

struct XcdBarrier {
    unsigned* bar; unsigned x;
    volatile LAS unsigned* st;
};

__device__ __forceinline__ XcdBarrier xcd_barrier_post(unsigned* bar, volatile LAS unsigned* st) {
    XcdBarrier b; b.bar = bar; b.x = xb_xcc_id(); b.st = st;
    if (TIDX == 0) (void)xb_add(&bar[XB_XCNT(b.x)], 1u);
    return b;
}
__device__ __forceinline__ void xcd_barrier_complete(unsigned* bar, unsigned x, unsigned& nloc, unsigned& nx) {
    const unsigned G = gridDim.x * gridDim.y * gridDim.z;
    unsigned sum, cnt, mine, sp = 0u;
    for (;;) {
        sum = 0u; cnt = 0u; mine = 0u;
#pragma unroll
        for (unsigned j = 0; j < 16; ++j) { const unsigned c = xb_ld(&bar[XB_XCNT(j)]); sum += c; cnt += (c > 0u) ? 1u : 0u; mine = (j == x) ? c : mine; }
        if (sum == G) break;
        __builtin_amdgcn_s_sleep(1);
        if ((++sp & 255u) == 0u) { if (xb_ld(&bar[XB_TMO])) break; if (sp > XB_SPIN_CAP) { atomicAdd(&bar[XB_TMO], 1u); break; } }
    }
    nloc = mine > 0u ? mine : 1u; nx = cnt > 0u ? cnt : 1u;
}

__device__ __forceinline__ void xcd_barrier(const XcdBarrier& b) {
    asm volatile("s_waitcnt vmcnt(0)" ::: "memory");
    __syncthreads();
    if (TIDX == 0) {
        unsigned* bar = b.bar;
        __builtin_amdgcn_s_waitcnt(0);
        unsigned nloc = b.st[0], nx = b.st[1];
        if (nloc == 0u) { xcd_barrier_complete(bar, b.x, nloc, nx); b.st[0] = nloc; b.st[1] = nx; }
        const unsigned old = xb_add(&bar[XB_XSUB(b.x)], 1u);
        const unsigned gen = old / nloc;
        if (old + 1u == (gen + 1u) * nloc) {
            __builtin_amdgcn_fence(__ATOMIC_RELEASE, "agent");
            asm volatile("s_waitcnt vmcnt(0)" ::: "memory");
            const unsigned og = xb_add(&bar[XB_TOP], 1u);
            const unsigned tg = og / nx;
            if (og + 1u == (tg + 1u) * nx) xb_add(&bar[XB_TOPGEN], 1u);
            else XB_SPIN(xb_ld(&bar[XB_TOPGEN]) == tg, bar);
            __builtin_amdgcn_fence(__ATOMIC_ACQUIRE, "agent");
            xb_add(&bar[XB_XGEN(b.x)], 1u);
            asm volatile("s_waitcnt vmcnt(0)" ::: "memory");
        } else {
            XB_SPIN(xb_ld(&bar[XB_XGEN(b.x)]) == gen, bar);
            __builtin_amdgcn_fence(__ATOMIC_ACQUIRE, "agent");
            asm volatile("s_waitcnt vmcnt(0)" ::: "memory");
        }
    }
    __syncthreads();
}

__device__ void d_cvt(const float* __restrict__ in, bf16_t* __restrict__ out, size_t n4) {
  const size_t stride = (size_t)gridDim.x * blockDim.x;
  size_t i = (size_t)blockIdx.x * blockDim.x + TIDX;
  for (; i + 3 * stride < n4; i += 4 * stride) {
    f32x4 v[4];
#pragma unroll
    for (int q = 0; q < 4; ++q) v[q] = ((const f32x4*)in)[i + q * stride];
#pragma unroll
    for (int q = 0; q < 4; ++q) { u32x2 o = {pack2(v[q][0], v[q][1]), pack2(v[q][2], v[q][3])}; ((u32x2*)out)[i + q * stride] = o; }
  }
  for (; i < n4; i += stride) { const f32x4 v = ((const f32x4*)in)[i]; u32x2 o = {pack2(v[0], v[1]), pack2(v[2], v[3])}; ((u32x2*)out)[i] = o; }
}
__device__ void d_cvtT64(int vb, char* smem, const float* __restrict__ W, bf16_t* __restrict__ WT, int K, int N, int NP) {
  float (*tt)[65] = (float (*)[65])smem;
  const int tid = (TIDX & 255);
  const int nbx = NP / 64;
  const int n0 = (vb % nbx) * 64, k0 = (vb / nbx) * 64;
  {
    const int kr = tid >> 4, nc = (tid & 15) * 4;
#pragma unroll
    for (int i = 0; i < 4; ++i) {
      const int k = k0 + kr + 16 * i, n = n0 + nc;
      f32x4 v = {0.f, 0.f, 0.f, 0.f};
      if (n < N) v = *(const f32x4*)(W + (size_t)k * N + n);
      tt[kr + 16 * i][nc] = v[0]; tt[kr + 16 * i][nc + 1] = v[1]; tt[kr + 16 * i][nc + 2] = v[2]; tt[kr + 16 * i][nc + 3] = v[3];
    }
  }
  __syncthreads();
  {
    const int nr = tid >> 3, kc = (tid & 7) * 8;
#pragma unroll
    for (int i = 0; i < 2; ++i) {
      const int nl = nr + 32 * i;
      u32x4 o = {pack2(tt[kc][nl], tt[kc + 1][nl]), pack2(tt[kc + 2][nl], tt[kc + 3][nl]), pack2(tt[kc + 4][nl], tt[kc + 5][nl]), pack2(tt[kc + 6][nl], tt[kc + 7][nl])};
      *(u32x4*)(WT + (size_t)(n0 + nl) * K + k0 + kc) = o;
    }
  }
  __syncthreads();
}

using f32x16 = __attribute__((ext_vector_type(16))) float;
using bf16x8v = __attribute__((ext_vector_type(8))) __bf16;
#define MFMA32(a, b, c) __builtin_amdgcn_mfma_f32_32x32x16_bf16((a), (b), (c), 0, 0, 0)
constexpr float LOG2E = 1.4426950408889634f;
constexpr float NEGB = -1e30f;
DI int pi_perm(int i) { return (i & ~12) | ((i & 8) >> 1) | ((i & 4) << 1); }
DI bf16x8 pack8(float a0, float a1, float a2, float a3, float a4, float a5, float a6, float a7) {
  bf16x8v v = {(__bf16)a0, (__bf16)a1, (__bf16)a2, (__bf16)a3, (__bf16)a4, (__bf16)a5, (__bf16)a6, (__bf16)a7};
  return __builtin_bit_cast(bf16x8, v);
}
__device__ __forceinline__ void d_relayout_tile(int T, char* smem, const bf16_t* __restrict__ proj, int col0, bf16_t* __restrict__ dst, bool isV) {
  bf16_t* Ls = (bf16_t*)smem;
  const int tid = TIDX;
#pragma unroll
  for (int q = 0; q < 2; ++q) {
    const int cidx = tid + q * 512;
    const int g = cidx >> 9, tok = (cidx >> 4) & 31, ch = cidx & 15;
    const u32x4 v = *(const u32x4*)(proj + (size_t)(32 * T + tok) * INWP + col0 + g * 128 + ch * 8);
    *(u32x4*)(Ls + (g * 32 + tok) * 136 + ch * 8) = v;
  }
  __syncthreads();
#pragma unroll
  for (int q = 0; q < 2; ++q) {
    const int oc = tid + q * 512;
    const int g = oc >> 9, r9 = oc & 511, lane = r9 & 63;
    u32x4 o;
    if (!isV) {
      const int s8 = r9 >> 6, i = lane & 31, h = lane >> 5;
      o = *(const u32x4*)(Ls + (g * 32 + pi_perm(i)) * 136 + 16 * s8 + 8 * h);
    } else {
      const int s2 = (r9 >> 6) & 1, dt = r9 >> 7, dd = lane & 31, h = lane >> 5;
      const bf16_t* col = Ls + (g * 32 + 16 * s2 + 8 * h) * 136 + 32 * dt + dd;
      unsigned short e[8];
#pragma unroll
      for (int j = 0; j < 8; ++j) e[j] = col[j * 136];
      o.x = e[0] | ((unsigned)e[1] << 16); o.y = e[2] | ((unsigned)e[3] << 16); o.z = e[4] | ((unsigned)e[5] << 16); o.w = e[6] | ((unsigned)e[7] << 16);
    }
    *(u32x4*)(dst + (((size_t)(g * 512 + T)) * 512 + r9) * 8) = o;
  }
  __syncthreads();
}

struct AttnPtrs {
  const bf16_t* proj; const float* gates;
  const bf16_t *kcf, *vcf, *ksf, *vsf, *kwf, *vwf;
  bf16_t* mix; const float* hng;
};

DI float ex2(float x) { return __builtin_amdgcn_exp2f(x); }
DI void halves(float x, float& lo, float& hi) {
  const unsigned u = __float_as_uint(x);
  auto r = __builtin_amdgcn_permlane32_swap(u, u, false, false);
  lo = __uint_as_float(r[0]); hi = __uint_as_float(r[1]);
}
DI float hmax(float x) { float a, b; halves(x, a, b); return fmaxf(a, b); }
DI float hsum(float x) { float a, b; halves(x, a, b); return a + b; }
DI float dpp_quad(float v, int ctrl_is_xor1) {
  const int iv = __float_as_int(v);
  const int r = ctrl_is_xor1 ? __builtin_amdgcn_update_dpp(iv, iv, 0xB1, 0xF, 0xF, false) : __builtin_amdgcn_update_dpp(iv, iv, 0x4E, 0xF, 0xF, false);
  return __int_as_float(r);
}
DI float quad_sum(float v) { v += dpp_quad(v, 1); v += dpp_quad(v, 0); return v; }
DI void osm_step(const float (&sv)[16], float& m, float& l, f32x16 (&O)[4], float (&p)[16]) {
  float tmax = fmaxf(fmaxf(fmaxf(sv[0], sv[1]), fmaxf(sv[2], sv[3])), fmaxf(fmaxf(sv[4], sv[5]), fmaxf(sv[6], sv[7])));
  tmax = fmaxf(tmax, fmaxf(fmaxf(fmaxf(sv[8], sv[9]), fmaxf(sv[10], sv[11])), fmaxf(fmaxf(sv[12], sv[13]), fmaxf(sv[14], sv[15]))));
  tmax = hmax(tmax);
  if (__ballot(tmax - m > 8.f)) {
    const float mn = fmaxf(m, tmax);
    const float alpha = ex2(m - mn);
    l *= alpha; m = mn;
#pragma unroll
    for (int dt = 0; dt < 4; ++dt)
#pragma unroll
      for (int r = 0; r < 16; ++r) O[dt][r] *= alpha;
  }
  float ps0 = 0.f, ps1 = 0.f;
#pragma unroll
  for (int r = 0; r < 16; r += 2) { const float e0 = ex2(sv[r] - m), e1 = ex2(sv[r + 1] - m); p[r] = e0; p[r + 1] = e1; ps0 += e0; ps1 += e1; }
  l += ps0 + ps1;
}
DI void ot_store(char* otL, int lane, const f32x16 (&O)[4], float sc) {
#pragma unroll
  for (int dt = 0; dt < 4; ++dt) {
    u32x4 a, b;
#pragma unroll
    for (int i = 0; i < 4; ++i) { a[i] = pack2(sc * O[dt][2 * i], sc * O[dt][2 * i + 1]); b[i] = pack2(sc * O[dt][8 + 2 * i], sc * O[dt][8 + 2 * i + 1]); }
    *(u32x4*)(otL + lane * 128 + dt * 32) = a;
    *(u32x4*)(otL + lane * 128 + dt * 32 + 16) = b;
  }
}
DI void ot_accum(const char* otL, int lane, f32x16 (&O)[4], float sc) {
#pragma unroll
  for (int dt = 0; dt < 4; ++dt) {
    u32x4 a = *(const u32x4*)(otL + lane * 128 + dt * 32);
    u32x4 b = *(const u32x4*)(otL + lane * 128 + dt * 32 + 16);
#pragma unroll
    for (int i = 0; i < 4; ++i) {
      const unsigned wa = a[i], wb = b[i];
      O[dt][2 * i] = fmaf(sc, O[dt][2 * i], __uint_as_float(wa << 16));
      O[dt][2 * i + 1] = fmaf(sc, O[dt][2 * i + 1], __uint_as_float(wa & 0xFFFF0000u));
      O[dt][8 + 2 * i] = fmaf(sc, O[dt][8 + 2 * i], __uint_as_float(wb << 16));
      O[dt][8 + 2 * i + 1] = fmaf(sc, O[dt][8 + 2 * i + 1], __uint_as_float(wb & 0xFFFF0000u));
    }
  }
}
DI void zero_o(f32x16 (&O)[4]) {
#pragma unroll
  for (int dt = 0; dt < 4; ++dt)
#pragma unroll
    for (int i = 0; i < 16; ++i) O[dt][i] = 0.f;
}

constexpr int ATT_PW = 8704;
constexpr int ATT_R = 4, ATT_D = 3;
constexpr int ATT_RING = 8 * ATT_PW;
constexpr int ATT_LIST = ATT_RING + ATT_R * 16384;
constexpr int ATT_BUNI = ATT_LIST + 2048;
constexpr int ATT_SMEM = ATT_BUNI + 64;
#define LAS3 __attribute__((address_space(3)))
__device__ __forceinline__ void d_select(const float* impL, unsigned* mskL, unsigned* uniL, int cur) {
  const int lane = TIDX & 63;
  const int stok = lane >> 3, sub = lane & 7;
  unsigned key[32];
#pragma unroll
  for (int i4 = 0; i4 < 8; ++i4) {
    f32x4 v = *(const f32x4*)(impL + stok * 256 + sub * 32 + i4 * 4);
#pragma unroll
    for (int e = 0; e < 4; ++e) {
      const int j = sub * 32 + i4 * 4 + e;
      const bool valid = j <= cur;
      const bool forced = (j == 0) || (j == cur) || (j == cur - 1);
      unsigned kb = forced ? 0xFFFFFF00u : (__float_as_uint(v[e]) & 0xFFFFFF00u);
      key[i4 * 4 + e] = valid ? (kb | (unsigned)(255 - j)) : 0u;
    }
  }
#pragma unroll
  for (int k = 2; k <= 32; k <<= 1) {
#pragma unroll
    for (int jj = k >> 1; jj > 0; jj >>= 1) {
#pragma unroll
      for (int i = 0; i < 32; ++i) {
        const int l2 = i ^ jj;
        if (l2 > i) {
          const bool desc = ((i & k) == 0);
          unsigned a = key[i], b = key[l2];
          unsigned mx = a > b ? a : b, mn = a > b ? b : a;
          key[i] = desc ? mx : mn; key[l2] = desc ? mn : mx;
        }
      }
    }
  }
#pragma unroll
  for (int xm = 1; xm < 8; xm <<= 1) {
    unsigned L[16];
#pragma unroll
    for (int i = 0; i < 16; ++i) { unsigned o = (unsigned)shx_i((int)key[15 - i], xm); L[i] = key[i] > o ? key[i] : o; }
#pragma unroll
    for (int jj = 8; jj > 0; jj >>= 1) {
#pragma unroll
      for (int i = 0; i < 16; ++i) {
        const int l2 = i ^ jj;
        if (l2 > i) { unsigned a = L[i], b = L[l2]; L[i] = a > b ? a : b; L[l2] = a > b ? b : a; }
      }
    }
#pragma unroll
    for (int i = 0; i < 16; ++i) key[i] = L[i];
  }
#pragma unroll
  for (int i = 0; i < 16; ++i) {
    if ((i & 7) == sub) {
      const int j = 255 - (int)(key[i] & 255u);
      if (j <= cur) { atomicOr(&mskL[stok * 8 + (j >> 5)], 1u << (j & 31)); atomicOr(&uniL[j >> 5], 1u << (j & 31)); }
    }
  }
}


DI void att_issue(LAS3 unsigned char* ring, int slot, int w, int lane, const bf16_t* kb, const bf16_t* vb, int tile) {
  const char* ks = (const char*)kb + (size_t)tile * 8192 + w * 1024 + lane * 16;
  const char* vs = (const char*)vb + (size_t)tile * 8192 + w * 1024 + lane * 16;
  __builtin_amdgcn_global_load_lds((const unsigned*)ks, (LAS3 unsigned*)(ring + slot * 16384 + w * 1024), 16, 0, 0);
  __builtin_amdgcn_global_load_lds((const unsigned*)vs, (LAS3 unsigned*)(ring + slot * 16384 + 8192 + w * 1024), 16, 0, 0);
}
DI f32x16 qk_lds(LAS3 const unsigned char* kt, const bf16x8 (&qf)[8], int lane) {
  f32x16 acc;
#pragma unroll
  for (int i = 0; i < 16; ++i) acc[i] = 0.f;
#pragma unroll
  for (int s8 = 0; s8 < 8; ++s8) {
    const bf16x8 kf = *(LAS3 const bf16x8*)(kt + s8 * 1024 + lane * 16);
    acc = MFMA32(kf, qf[s8], acc);
  }
  return acc;
}
DI void pv_lds(LAS3 const unsigned char* vt, const float (&p)[16], f32x16 (&O)[4], int lane) {
  const bf16x8 pf0 = pack8(p[0], p[1], p[2], p[3], p[4], p[5], p[6], p[7]);
  const bf16x8 pf1 = pack8(p[8], p[9], p[10], p[11], p[12], p[13], p[14], p[15]);
#pragma unroll
  for (int dt = 0; dt < 4; ++dt) {
    const bf16x8 v0 = *(LAS3 const bf16x8*)(vt + (dt * 2) * 1024 + lane * 16);
    const bf16x8 v1 = *(LAS3 const bf16x8*)(vt + (dt * 2 + 1) * 1024 + lane * 16);
    O[dt] = MFMA32(v0, pf0, O[dt]);
    O[dt] = MFMA32(v1, pf1, O[dt]);
  }
}

__device__ __forceinline__ void d_attn_block(int B, int g, char* smem, const AttnPtrs& P) {
  const int tid = TIDX, lane = tid & 63, w = tid >> 6;
  const int c = lane & 31, h = lane >> 5, tokl = c >> 2, r = c & 3;
  const int tok0 = 64 * B + 8 * w;
  const int t = tok0 + tokl, hd = g * 4 + r;
  const float slope2 = exp2f(-(float)(hd + 1)) * LOG2E;
  const float c1 = QSCALE * LOG2E;
  const float ninf = -__builtin_inff();
  char* wsm = smem + w * ATT_PW;
  float* impL = (float*)wsm;
  char* otL = wsm;
  unsigned* mskL = (unsigned*)(wsm + 8192);
  unsigned* uniL = mskL + 64;
  LAS3 unsigned char* ring = (LAS3 unsigned char*)(smem + ATT_RING);
  unsigned short* tl = (unsigned short*)(smem + ATT_LIST);
  unsigned* buni = (unsigned*)(smem + ATT_BUNI);
  const bf16_t* kcf = P.kcf + (size_t)g * 32 * 4096;
  const bf16_t* vcf = P.vcf + (size_t)g * 32 * 4096;
  const bf16_t* ksf = P.ksf + (size_t)g * 512 * 4096;
  const bf16_t* vsf = P.vsf + (size_t)g * 512 * 4096;
  const bf16_t* kwf = P.kwf + (size_t)g * 512 * 4096;
  const bf16_t* vwf = P.vwf + (size_t)g * 512 * 4096;
  bf16x8 qf[8];
  {
    const bf16_t* qrow = P.proj + (size_t)t * INWP + OFF_Q + hd * 128 + 8 * h;
#pragma unroll
    for (int s8 = 0; s8 < 8; ++s8) qf[s8] = *(const bf16x8*)(qrow + 16 * s8);
  }
  const float* gt = P.gates + (size_t)t * 24 + hd * 3;
  const float g0 = gt[0], g1 = gt[1], g2 = gt[2];
  {
    unsigned z0 = 0u;
    asm volatile("" : "+v"(z0));
    u32x4 z = {z0, z0, z0, z0};
#pragma unroll
    for (int i = 0; i < 8; ++i) *(u32x4*)(wsm + (i * 64 + lane) * 16) = z;
    if (lane < 18) *(u32x4*)(wsm + 8192 + lane * 16) = z;
    if (tid < 8) buni[tid] = z0;
  }
  f32x16 Ob[4];
  zero_o(Ob);
  const int nmax = (t >= 31) ? ((t - 31) >> 4) : -1;
  const int nmaxw = (tok0 + 7 >= 31) ? ((tok0 + 7 - 31) >> 4) : -1;
  const int nminw = (tok0 >= 31) ? ((tok0 - 31) >> 4) : -1;
  const int ntcw = (nmaxw + 32) >> 5;
  const int ntcB = (((64 * B + 63 - 31) >> 4) + 32) >> 5;
  const float sl16 = slope2 * 16.f;
  float mC = NEGB, lC = 0.f, invC = 0.f, carry = 0.f;
  {
    const int n = 2 * ntcB;
    asm volatile("s_waitcnt vmcnt(0)" ::: "memory");
#define A_TILE(i_) (((i_) < ntcB) ? (ntcB - 1 - (i_)) : ((i_) - ntcB))
    att_issue(ring, 0, w, lane, kcf, vcf, A_TILE(0));
    if (n > 1) att_issue(ring, 1, w, lane, kcf, vcf, A_TILE(1));
#pragma unroll 1
    for (int i = 0; i < n; ++i) {
      if ((i & 1) == 0) {
        asm volatile("s_waitcnt vmcnt(0)" ::: "memory");
        __builtin_amdgcn_s_barrier();
        asm volatile("" ::: "memory");
        if (i + 2 < n) att_issue(ring, (i + 2) & 3, w, lane, kcf, vcf, A_TILE(i + 2));
        if (i + 3 < n) att_issue(ring, (i + 3) & 3, w, lane, kcf, vcf, A_TILE(i + 3));
      }
      const int T = A_TILE(i);
      if (T >= ntcw) continue;
      LAS3 const unsigned char* slot = ring + (i % ATT_R) * 16384;
      const f32x16 acc = qk_lds(slot, qf, lane);
      const float base = slope2 * (float)(512 * T + 128 * h) + slope2 * (15.5f - (float)t);
      const int nb = 32 * T + 8 * h;
      const bool full = (32 * T + 31 <= nminw);
      float sv[16];
#pragma unroll
      for (int rg = 0; rg < 16; ++rg) { const int kk = (rg & 7) + 16 * (rg >> 3); sv[rg] = fmaf(acc[rg], c1, fmaf(sl16, (float)kk, base)); }
      if (!full) {
#pragma unroll
        for (int rg = 0; rg < 16; ++rg) { const int kk = (rg & 7) + 16 * (rg >> 3); sv[rg] = (nb + kk <= nmax) ? sv[rg] : ninf; }
      }
      if (i < ntcB) {
        float tmax = fmaxf(fmaxf(fmaxf(sv[0], sv[1]), fmaxf(sv[2], sv[3])), fmaxf(fmaxf(sv[4], sv[5]), fmaxf(sv[6], sv[7])));
        tmax = fmaxf(tmax, fmaxf(fmaxf(fmaxf(sv[8], sv[9]), fmaxf(sv[10], sv[11])), fmaxf(fmaxf(sv[12], sv[13]), fmaxf(sv[14], sv[15]))));
        tmax = hmax(tmax);
        const float mn = fmaxf(mC, tmax);
        float ps = 0.f;
#pragma unroll
        for (int rg = 0; rg < 16; ++rg) ps += ex2(sv[rg] - mn);
        lC = lC * ex2(mC - mn) + ps; mC = mn;
      } else {
        if (T == 0) { lC = hsum(lC); invC = (lC > 0.f) ? 1.f / lC : 0.f; }
        float p[16];
#pragma unroll
        for (int rg = 0; rg < 16; ++rg) p[rg] = ex2(sv[rg] - mC) * invC;
        float Ga = (p[0] + p[1]) + (p[2] + p[3]), Gb = (p[4] + p[5]) + (p[6] + p[7]);
        float Gc = (p[8] + p[9]) + (p[10] + p[11]), Gd = (p[12] + p[13]) + (p[14] + p[15]);
        float xb, xd; { float a_, b_; halves(p[7], a_, b_); xb = h ? a_ : b_; halves(p[15], a_, b_); xd = h ? a_ : b_; }
        float ia = Ga + (h ? xb : carry);
        float ib = Gb + p[3];
        float ic = Gc + (h ? xd : xb);
        float id = Gd + p[11];
        carry = xd;
        ia = quad_sum(ia); ib = quad_sum(ib); ic = quad_sum(ic); id = quad_sum(id);
        {
          float val = (r == 0) ? ia : (r == 1) ? ib : (r == 2) ? ic : id;
          int j = 8 * T + 2 * h + ((r == 0) ? 0 : (r == 1) ? 1 : (r == 2) ? 4 : 5);
          impL[tokl * 256 + j] = val;
        }
        pv_lds(slot + 8192, p, Ob, lane);
      }
    }
#undef A_TILE
  }
  const int cur = B;
  d_select(impL, mskL, uniL, cur);
  ot_store(otL, lane, Ob, g0);
  zero_o(Ob);
  if (lane < 8) { const unsigned u = uniL[lane]; if (u) atomicOr(&buni[lane], u); }
  __syncthreads();
  int nslc = 0, ntl = 0;
  {
    for (int iw = 7; iw >= 0; --iw) {
      unsigned iuw = __builtin_amdgcn_readfirstlane(buni[iw]);
      while (iuw) {
        const int bit = 31 - __builtin_clz(iuw);
        iuw &= ~(1u << bit);
        const int bb = 32 * iw + bit;
        if (bb < B) { if (lane == 0) tl[ntl] = (unsigned short)(2 * bb + 1); ++ntl; }
        else { if (lane == 0) tl[ntl] = (unsigned short)(2 * bb + 1); ++ntl; }
        if (lane == 0) tl[ntl] = (unsigned short)(2 * bb);
        ++ntl;
      }
    }
    nslc = ntl;
    const int ThiB = 2 * B + 1, TloB = ((64 * B - 511 > 0) ? (64 * B - 511) : 0) >> 5;
    for (int T = ThiB; T >= TloB; --T) { if (lane == 0) tl[ntl] = (unsigned short)T; ++ntl; }
  }
  float m = NEGB, l = 0.f;
  {
    const int n = ntl;
    const int Tlow = ((tok0 - 511 > 0) ? (tok0 - 511) : 0) >> 5, Thiw = (tok0 + 7) >> 5;
#define B_ISSUE(j_, slot_) { const int e_ = __builtin_amdgcn_readfirstlane((int)tl[j_]); if ((j_) < nslc) att_issue(ring, slot_, w, lane, ksf, vsf, e_); else att_issue(ring, slot_, w, lane, kwf, vwf, e_); }
    B_ISSUE(0, 0)
    if (n > 1) B_ISSUE(1, 1)
#pragma unroll 1
    for (int i = 0; i < n; ++i) {
      if ((i & 1) == 0) {
        asm volatile("s_waitcnt vmcnt(0)" ::: "memory");
        __builtin_amdgcn_s_barrier();
        asm volatile("" ::: "memory");
        if (i + 2 < n) B_ISSUE(i + 2, (i + 2) & 3)
        if (i + 3 < n) B_ISSUE(i + 3, (i + 3) & 3)
      }
      if (i == nslc) {
        l = hsum(l);
        const float inv = (l > 0.f) ? g1 / l : 0.f;
        ot_accum(otL, lane, Ob, inv);
        ot_store(otL, lane, Ob, 1.f);
        zero_o(Ob);
        m = NEGB; l = 0.f;
      }
      const int T = __builtin_amdgcn_readfirstlane((int)tl[i]);
      const int pos0 = 32 * T, pb = pos0 + 8 * h;
      bool full; bool mine = true;
      if (i < nslc) {
        const int bb = T >> 1;
        const unsigned uw = __builtin_amdgcn_readfirstlane(uniL[bb >> 5]);
        if (!((uw >> (bb & 31)) & 1u) || pos0 > tok0 + 7) continue;
        mine = (mskL[tokl * 8 + (bb >> 5)] >> (bb & 31)) & 1u;
        full = (pos0 + 31 <= tok0) && (__ballot(!mine) == 0ull);
      } else {
        if (T < Tlow || T > Thiw) continue;
        full = (pos0 + 31 <= tok0) && (pos0 >= tok0 + 7 - 511);
      }
      LAS3 const unsigned char* slot = ring + (i % ATT_R) * 16384;
      const f32x16 acc = qk_lds(slot, qf, lane);
      const float base = slope2 * (float)(pos0 + 8 * h - t);
      float sv[16], p[16];
#pragma unroll
      for (int rg = 0; rg < 16; ++rg) { const int kk = (rg & 7) + 16 * (rg >> 3); sv[rg] = fmaf(acc[rg], c1, fmaf(slope2, (float)kk, base)); }
      if (!full) {
        if (i < nslc) {
#pragma unroll
          for (int rg = 0; rg < 16; ++rg) { const int kk = (rg & 7) + 16 * (rg >> 3); sv[rg] = (mine && (pb + kk <= t)) ? sv[rg] : ninf; }
        } else {
#pragma unroll
          for (int rg = 0; rg < 16; ++rg) { const int kk = (rg & 7) + 16 * (rg >> 3); const int dw = t - (pb + kk); sv[rg] = ((dw >= 0) && (dw < 512)) ? sv[rg] : ninf; }
        }
      }
      osm_step(sv, m, l, Ob, p);
      pv_lds(slot + 8192, p, Ob, lane);
    }
#undef B_ISSUE
    l = hsum(l);
    const float inv = (l > 0.f) ? g2 / l : 0.f;
    ot_accum(otL, lane, Ob, inv);
  }
  {
    float ss = 0.f;
#pragma unroll
    for (int dt = 0; dt < 4; ++dt)
#pragma unroll
      for (int i = 0; i < 16; ++i) ss = fmaf(Ob[dt][i], Ob[dt][i], ss);
    ss = hsum(ss);
    const float rs = rsqrtf(ss * (1.f / 128.f) + 1e-6f);
    bf16_t* orow = P.mix + (size_t)t * DM + hd * 128 + 4 * h;
    const float* grow = P.hng + hd * 128 + 4 * h;
#pragma unroll
    for (int dt = 0; dt < 4; ++dt)
#pragma unroll
      for (int a = 0; a < 4; ++a) {
        const f32x4 gv = *(const f32x4*)(grow + 32 * dt + 8 * a);
        u32x2 wv2 = {pack2(Ob[dt][4 * a] * rs * gv[0], Ob[dt][4 * a + 1] * rs * gv[1]), pack2(Ob[dt][4 * a + 2] * rs * gv[2], Ob[dt][4 * a + 3] * rs * gv[3])};
        *(u32x2*)(orow + 32 * dt + 8 * a) = wv2;
      }
  }
  asm volatile("s_waitcnt vmcnt(0)" ::: "memory");
  __syncthreads();
}

__device__ void d_convmix(int t, int tl, const bf16_t* __restrict__ proj, const float* __restrict__ convw, const float* __restrict__ hng,
                          bf16_t* __restrict__ mix) {
  const int c = tl * 8;
  float acc[8];
#pragma unroll
  for (int i = 0; i < 8; ++i) acc[i] = 0.f;
#pragma unroll
  for (int j = 0; j < 3; ++j) {
    const int tt = t - 2 + j;
    if (tt >= 0) {
      const u32x4 cu = *(const u32x4*)(proj + (size_t)tt * INWP + OFF_C + c);
      const u32x4 uu = *(const u32x4*)(proj + (size_t)tt * INWP + OFF_U + c);
      const f32x4 w0 = *(const f32x4*)(convw + j * 1024 + c), w1 = *(const f32x4*)(convw + j * 1024 + c + 4);
#pragma unroll
      for (int i = 0; i < 4; ++i) {
        const unsigned a = cu[i], b = uu[i];
        const float wl = (i < 2) ? w0[2 * i] : w1[2 * i - 4], wh = (i < 2) ? w0[2 * i + 1] : w1[2 * i - 3];
        acc[2 * i] = fmaf(wl * __uint_as_float(a << 16), __uint_as_float(b << 16), acc[2 * i]);
        acc[2 * i + 1] = fmaf(wh * __uint_as_float(a & 0xFFFF0000u), __uint_as_float(b & 0xFFFF0000u), acc[2 * i + 1]);
      }
    }
  }
  const u32x4 bb = *(const u32x4*)(proj + (size_t)t * INWP + OFF_B + c);
  float ss = 0.f;
#pragma unroll
  for (int i = 0; i < 4; ++i) {
    const unsigned b = bb[i];
    acc[2 * i] *= __uint_as_float(b << 16); acc[2 * i + 1] *= __uint_as_float(b & 0xFFFF0000u);
    ss = fmaf(acc[2 * i], acc[2 * i], ss); ss = fmaf(acc[2 * i + 1], acc[2 * i + 1], ss);
  }
  ss += shx(ss, 8); ss += shx(ss, 4); ss += shx(ss, 2); ss += shx(ss, 1);
  const float rs = rsqrtf(ss * (1.f / 128.f) + 1e-6f);
  const f32x4 g0 = *(const f32x4*)(hng + 1024 + c), g1 = *(const f32x4*)(hng + 1024 + c + 4);
  u32x4 o = {pack2(acc[0] * rs * g0[0], acc[1] * rs * g0[1]), pack2(acc[2] * rs * g0[2], acc[3] * rs * g0[3]),
             pack2(acc[4] * rs * g1[0], acc[5] * rs * g1[1]), pack2(acc[6] * rs * g1[2], acc[7] * rs * g1[3])};
  *(u32x4*)(mix + (size_t)t * DM + 1024 + c) = o;
}

__device__ void d_ln_wave(int t, bf16_t* __restrict__ yh, const float* __restrict__ gam, const float* __restrict__ bet) {
  const int lane = TIDX & 63;
  float v[32];
#pragma unroll
  for (int i = 0; i < 4; ++i) {
    const u32x4 w = *(const u32x4*)(yh + (size_t)t * DM + 512 * i + 8 * lane);
#pragma unroll
    for (int j = 0; j < 4; ++j) { const unsigned ww = w[j]; v[i * 8 + 2 * j] = __uint_as_float(ww << 16); v[i * 8 + 2 * j + 1] = __uint_as_float(ww & 0xFFFF0000u); }
  }
  float s = 0.f;
#pragma unroll
  for (int i = 0; i < 32; ++i) s += v[i];
  s = wave_sum(s);
  const float mu = s * (1.f / DM);
  float q = 0.f;
#pragma unroll
  for (int i = 0; i < 32; ++i) { const float d = v[i] - mu; q = fmaf(d, d, q); }
  q = wave_sum(q);
  const float rs = rsqrtf(q * (1.f / DM) + 1e-5f);
#pragma unroll
  for (int i = 0; i < 4; ++i) {
    const int cb = 512 * i + 8 * lane;
    const f32x4 g0 = *(const f32x4*)(gam + cb), g1 = *(const f32x4*)(gam + cb + 4), b0 = *(const f32x4*)(bet + cb), b1 = *(const f32x4*)(bet + cb + 4);
    u32x4 o = {pack2((v[i * 8 + 0] - mu) * rs * g0[0] + b0[0], (v[i * 8 + 1] - mu) * rs * g0[1] + b0[1]), pack2((v[i * 8 + 2] - mu) * rs * g0[2] + b0[2], (v[i * 8 + 3] - mu) * rs * g0[3] + b0[3]),
               pack2((v[i * 8 + 4] - mu) * rs * g1[0] + b1[0], (v[i * 8 + 5] - mu) * rs * g1[1] + b1[1]), pack2((v[i * 8 + 6] - mu) * rs * g1[2] + b1[2], (v[i * 8 + 7] - mu) * rs * g1[3] + b1[3])};
    *(u32x4*)(yh + (size_t)t * DM + cb) = o;
  }
}

__device__ void d_cvt_w1f(size_t c, const float* __restrict__ w1, bf16_t* __restrict__ w1f) {
  const int lane = c & 63, ks = (c >> 6) & 255, ct = c >> 14;
  const int col = lane & 31, h = lane >> 5;
  bf16_t v[8];
#pragma unroll
  for (int j = 0; j < 8; ++j) v[j] = f2bf(w1[(size_t)(16 * ks + 8 * h + j) * 512 + 32 * ct + col]);
  u32x4 o; o.x = v[0] | ((unsigned)v[1] << 16); o.y = v[2] | ((unsigned)v[3] << 16); o.z = v[4] | ((unsigned)v[5] << 16); o.w = v[6] | ((unsigned)v[7] << 16);
  *(u32x4*)(w1f + c * 8) = o;
}
__device__ void d_cvt_w2f(size_t c, const float* __restrict__ w2, bf16_t* __restrict__ w2f) {
  const int lane = c & 63, s = (c >> 6) & 31, ct = c >> 11;
  const int col = lane & 31, h = lane >> 5;
  bf16_t v[8];
#pragma unroll
  for (int j = 0; j < 8; ++j) v[j] = f2bf(w2[(size_t)(16 * s + 8 * h + j) * 128 + 32 * ct + col]);
  u32x4 o; o.x = v[0] | ((unsigned)v[1] << 16); o.y = v[2] | ((unsigned)v[3] << 16); o.z = v[4] | ((unsigned)v[5] << 16); o.w = v[6] | ((unsigned)v[7] << 16);
  *(u32x4*)(w2f + c * 8) = o;
}
__device__ __forceinline__ void d_compress_unit(int rt, char* smem, const bf16_t* __restrict__ proj, int col0, const float* __restrict__ pos,
                                const bf16_t* __restrict__ w1f, const float* __restrict__ b1, const bf16_t* __restrict__ w2f,
                                bf16_t* __restrict__ outf, bool isV) {
  bf16_t* Xs = (bf16_t*)smem;
  bf16_t* Hs = (bf16_t*)(smem + 2 * 8704);
  const int tid = TIDX, lane = tid & 63, w = tid >> 6, c = lane & 31, h = lane >> 5;
  const int R0 = rt * 32;
  const int srow = tid >> 4, sch = tid & 15;
  const int grow = R0 + srow, sn = grow >> 1, sg = grow & 1;
  const bool svalid = grow < 2046;
  const bf16_t* sp = proj + (size_t)(16 * sn) * INWP + col0 + sg * 128 + sch * 8;
  f32x16 acc0, acc1;
#pragma unroll
  for (int i = 0; i < 16; ++i) { acc0[i] = 0.f; acc1[i] = 0.f; }
  u32x4 rx = {0u, 0u, 0u, 0u}; f32x4 rp0, rp1;
#define STAGE_WRITE(buf)                                                                                   \
  {                                                                                                        \
    u32x4 o_;                                                                                              \
    _Pragma("unroll") for (int i = 0; i < 4; ++i) {                                                        \
      const unsigned wv_ = rx[i];                                                                          \
      const float lo = __uint_as_float(wv_ << 16) + ((i < 2) ? rp0[2 * i] : rp1[2 * i - 4]);               \
      const float hi = __uint_as_float(wv_ & 0xFFFF0000u) + ((i < 2) ? rp0[2 * i + 1] : rp1[2 * i - 3]);   \
      o_[i] = pack2(lo, hi);                                                                               \
    }                                                                                                      \
    *(u32x4*)(Xs + (buf) * 4352 + srow * 136 + sch * 8) = o_;                                              \
  }
  if (svalid) rx = *(const u32x4*)(sp);
  rp0 = *(const f32x4*)(pos + sch * 8); rp1 = *(const f32x4*)(pos + sch * 8 + 4);
  STAGE_WRITE(0)
  __syncthreads();
  const bf16_t* wb0 = w1f + ((size_t)(2 * w) * 256 * 64 + lane) * 8;
  const bf16_t* wb1 = w1f + ((size_t)(2 * w + 1) * 256 * 64 + lane) * 8;
#pragma unroll 1
  for (int l = 0; l < 32; ++l) {
    if (l + 1 < 32) {
      if (svalid) rx = *(const u32x4*)(sp + (size_t)(l + 1) * INWP);
      rp0 = *(const f32x4*)(pos + (l + 1) * 128 + sch * 8); rp1 = *(const f32x4*)(pos + (l + 1) * 128 + sch * 8 + 4);
    }
    const bf16_t* xa = Xs + (l & 1) * 4352 + c * 136 + 8 * h;
#pragma unroll
    for (int s8 = 0; s8 < 8; ++s8) {
      const bf16x8 a = *(const bf16x8*)(xa + 16 * s8);
      const bf16x8 b0 = *(const bf16x8*)(wb0 + (size_t)(8 * l + s8) * 512);
      const bf16x8 b1v = *(const bf16x8*)(wb1 + (size_t)(8 * l + s8) * 512);
      acc0 = MFMA32(a, b0, acc0);
      acc1 = MFMA32(a, b1v, acc1);
    }
    if (l + 1 < 32) STAGE_WRITE((l + 1) & 1)
    __syncthreads();
  }
  {
    const float bb0 = b1[64 * w + c], bb1 = b1[64 * w + 32 + c];
#pragma unroll
    for (int rg = 0; rg < 16; ++rg) {
      const int row = (rg & 3) + 8 * (rg >> 2) + 4 * h;
      Hs[row * 520 + 64 * w + c] = f2bf(gelu_tanh(acc0[rg] + bb0));
      Hs[row * 520 + 64 * w + 32 + c] = f2bf(gelu_tanh(acc1[rg] + bb1));
    }
  }
  __syncthreads();
  if (w < 4) {
    f32x16 o2;
#pragma unroll
    for (int i = 0; i < 16; ++i) o2[i] = 0.f;
    const bf16_t* ha = Hs + c * 520 + 8 * h;
    const bf16_t* wb = w2f + ((size_t)w * 32 * 64 + lane) * 8;
#pragma unroll 8
    for (int s2 = 0; s2 < 32; ++s2) {
      const bf16x8 a = *(const bf16x8*)(ha + 16 * s2);
      const bf16x8 b = *(const bf16x8*)(wb + (size_t)s2 * 512);
      o2 = MFMA32(a, b, o2);
    }
    const int d = 32 * w + c;
#pragma unroll
    for (int rg = 0; rg < 16; ++rg) {
      const int row = R0 + (rg & 3) + 8 * (rg >> 2) + 4 * h;
      const int n = row >> 1, g = row & 1;
      const bf16_t val = (row < 2046) ? f2bf(o2[rg]) : (bf16_t)0;
      const int T = n >> 5, nn = n & 31;
      size_t idx;
      if (!isV) idx = ((((size_t)(g * 32 + T) * 8 + (d >> 4)) * 64 + (pi_perm(nn) + 32 * ((d >> 3) & 1))) * 8 + (d & 7));
      else idx = (((((size_t)(g * 32 + T) * 4 + (d >> 5)) * 2 + (nn >> 4)) * 64 + ((d & 31) + 32 * ((nn >> 3) & 1))) * 8 + (nn & 7));
      outf[idx] = val;
    }
  }
  __syncthreads();
}


DI unsigned f2sort(float f) { unsigned u = __float_as_uint(f); return u ^ ((unsigned)((int)u >> 31) | 0x80000000u); }
DI float sort2f(unsigned k) { unsigned u = (k & 0x80000000u) ? (k ^ 0x80000000u) : ~k; return __uint_as_float(u); }
template <int N>
DI void bitonic_sort_desc(unsigned (&key)[N]) {
#pragma unroll
  for (int k = 2; k <= N; k <<= 1) {
#pragma unroll
    for (int jj = k >> 1; jj > 0; jj >>= 1) {
#pragma unroll
      for (int i = 0; i < N; ++i) {
        const int l2 = i ^ jj;
        if (l2 > i) {
          const bool desc = ((i & k) == 0);
          unsigned a = key[i], b = key[l2];
          unsigned mx = a > b ? a : b, mn = a > b ? b : a;
          key[i] = desc ? mx : mn; key[l2] = desc ? mn : mx;
        }
      }
    }
  }
}
DI void merge_top16(unsigned (&a)[16], const unsigned (&b)[16]) {
#pragma unroll
  for (int i = 0; i < 16; ++i) { unsigned o = b[15 - i]; a[i] = a[i] > o ? a[i] : o; }
#pragma unroll
  for (int jj = 8; jj > 0; jj >>= 1) {
#pragma unroll
    for (int i = 0; i < 16; ++i) {
      const int l2 = i ^ jj;
      if (l2 > i) { unsigned x = a[i], y = a[l2]; a[i] = x > y ? x : y; a[l2] = x > y ? y : x; }
    }
  }
}
__device__ void d_cvt_subk(size_t c, const float* __restrict__ subk, bf16_t* __restrict__ skf) {
  int lane = c & 63, s = (c >> 6) & 7, kt = (c >> 9) & 3, hc = c >> 11;
  int i = lane & 31, h = lane >> 5;
  const float* src = subk + ((size_t)hc * 128 + 32 * kt + i) * 128 + 16 * s + 8 * h;
  bf16_t v[8];
#pragma unroll
  for (int j = 0; j < 8; ++j) v[j] = f2bf(src[j]);
  u32x4 o; o.x = v[0] | ((unsigned)v[1] << 16); o.y = v[2] | ((unsigned)v[3] << 16); o.z = v[4] | ((unsigned)v[5] << 16); o.w = v[6] | ((unsigned)v[7] << 16);
  *(u32x4*)(skf + c * 8) = o;
}

struct EpiProjG {
  static constexpr bool PERM = true, AFTER_DRAIN = false;
  bf16_t* proj; float* gates;
  DI void operator()(const f32x4 (&acc)[2][2][4][2], const pg8::Unit& u, int wr, int wc, int fr, int fq) const {
#pragma unroll
    for (int ai = 0; ai < 2; ++ai)
#pragma unroll
      for (int m = 0; m < 4; ++m) {
        const int row = u.pm * 256 + ai * 128 + wr * 64 + m * 16 + fr;
#pragma unroll
        for (int bj = 0; bj < 2; ++bj) {
          const int c0 = u.pn * 256 + bj * 128 + wc * 32 + 8 * fq;
          const f32x4 v0 = acc[ai][bj][m][0], v1 = acc[ai][bj][m][1];
          if (c0 < INW) {
            u32x4 w = {pack2(v0[0], v0[1]), pack2(v0[2], v0[3]), pack2(v1[0], v1[1]), pack2(v1[2], v1[3])};
            *(u32x4*)(proj + (size_t)row * INWP + c0) = w;
          }
          if (c0 >= OFF_G && c0 < OFF_G + 24) {
            f32x4 g0, g1;
#pragma unroll
            for (int j = 0; j < 4; ++j) { g0[j] = 1.f / (1.f + __expf(-v0[j])); g1[j] = 1.f / (1.f + __expf(-v1[j])); }
            *(f32x4*)(gates + (size_t)row * 24 + (c0 - OFF_G)) = g0;
            *(f32x4*)(gates + (size_t)row * 24 + (c0 - OFF_G) + 4) = g1;
          }
        }
      }
  }
};
struct EpiResG {
  static constexpr bool PERM = false, AFTER_DRAIN = false;
  bf16_t* YB;
  DI void operator()(const f32x4 (&acc)[2][2][4][2], const pg8::Unit& u, int wr, int wc, int fr, int fq) const {
#pragma unroll
    for (int ai = 0; ai < 2; ++ai)
#pragma unroll
      for (int m = 0; m < 4; ++m) {
        const size_t ro = (size_t)(u.pm * 256 + ai * 128 + wr * 64 + m * 16 + fr) * DM + u.pn * 256 + wc * 32 + 4 * fq;
#pragma unroll
        for (int bj = 0; bj < 2; ++bj)
#pragma unroll
          for (int n = 0; n < 2; ++n) {
            const u32x2 xw = *(const u32x2*)(YB + ro + bj * 128 + n * 16);
            const f32x4 xv = {__uint_as_float(xw[0] << 16), __uint_as_float(xw[0] & 0xFFFF0000u), __uint_as_float(xw[1] << 16), __uint_as_float(xw[1] & 0xFFFF0000u)};
            const f32x4 yv = ALPHA * xv + acc[ai][bj][m][n];
            u32x2 o = {pack2(yv[0], yv[1]), pack2(yv[2], yv[3])};
            *(u32x2*)(YB + ro + bj * 128 + n * 16) = o;
          }
      }
  }
};
struct EpiF32G {
  static constexpr bool PERM = false, AFTER_DRAIN = false;
  float* C; int ldc;
  DI void operator()(const f32x4 (&acc)[2][2][4][2], const pg8::Unit& u, int wr, int wc, int fr, int fq) const {
#pragma unroll
    for (int ai = 0; ai < 2; ++ai)
#pragma unroll
      for (int m = 0; m < 4; ++m) {
        const size_t ro = (size_t)(u.pm * 256 + ai * 128 + wr * 64 + m * 16 + fr) * ldc + u.pn * 256 + wc * 32 + 4 * fq;
#pragma unroll
        for (int bj = 0; bj < 2; ++bj)
#pragma unroll
          for (int n = 0; n < 2; ++n) *(f32x4*)(C + ro + bj * 128 + n * 16) = acc[ai][bj][m][n];
      }
  }
};
struct EpiRouteG {
  static constexpr bool PERM = false, AFTER_DRAIN = true;
  const bf16_t* skf; unsigned* tops;
  DI void operator()(const f32x4 (&)[2][2][4][2], const pg8::Unit&, int, int, int, int) const {}
  DI void fused(const f32x4 (&acc)[2][2][4][2], const pg8::Unit& u, int wr, int wc, int fr, int fq, PG8_LAS unsigned char* ldsp, int, int) const {
    const int lane = fr | (fq << 4), wid = wr * 4 + wc;
    bf16_t* Qs = (bf16_t*)ldsp;
#pragma unroll
    for (int ai = 0; ai < 2; ++ai)
#pragma unroll
      for (int m = 0; m < 4; ++m) {
        const int row = ai * 128 + wr * 64 + m * 16 + fr;
#pragma unroll
        for (int bj = 0; bj < 2; ++bj)
#pragma unroll
          for (int n = 0; n < 2; ++n) {
            const f32x4 v = acc[ai][bj][m][n];
            u32x2 w = {pack2(v[0], v[1]), pack2(v[2], v[3])};
            *(u32x2*)(Qs + row * 264 + bj * 128 + wc * 32 + n * 16 + 4 * fq) = w;
          }
      }
    __syncthreads();
    const int c = lane & 31, h = lane >> 5;
#pragma unroll 1
    for (int half = 0; half < 2; ++half) {
      const int hc = u.pn * 2 + half;
      const bf16_t* sk = skf + (size_t)hc * 4 * 4096;
      const bf16_t* qp = Qs + (wid * 32 + c) * 264 + half * 128 + 8 * h;
      unsigned k0[16], k1[16];
#define ROUTE_KT(KT, KA)                                                                        \
      {                                                                                         \
        f32x16 sc;                                                                              \
        _Pragma("unroll") for (int i = 0; i < 16; ++i) sc[i] = 0.f;                             \
        _Pragma("unroll") for (int s = 0; s < 8; ++s) {                                         \
          bf16x8 af = *(const bf16x8*)(sk + (KT) * 4096 + s * 512 + lane * 8);                  \
          bf16x8 bq = *(const bf16x8*)(qp + 16 * s);                                            \
          sc = __builtin_amdgcn_mfma_f32_32x32x16_bf16(af, bq, sc, 0, 0, 0);                    \
        }                                                                                       \
        _Pragma("unroll") for (int rg = 0; rg < 16; ++rg) {                                     \
          const int kidx = 32 * (KT) + (rg & 3) + 8 * (rg >> 2) + 4 * h;                        \
          KA[rg] = (f2sort(sc[rg]) & 0xFFFFFF80u) | (unsigned)(127 - kidx);                     \
        }                                                                                       \
        bitonic_sort_desc<16>(KA);                                                              \
      }
      ROUTE_KT(0, k0)
      __builtin_amdgcn_sched_barrier(0);
      ROUTE_KT(1, k1)
      merge_top16(k0, k1);
      __builtin_amdgcn_sched_barrier(0);
      ROUTE_KT(2, k1)
      merge_top16(k0, k1);
      __builtin_amdgcn_sched_barrier(0);
      ROUTE_KT(3, k1)
      merge_top16(k0, k1);
      __builtin_amdgcn_sched_barrier(0);
#undef ROUTE_KT
#pragma unroll
      for (int i = 0; i < 16; ++i) k1[i] = (unsigned)shx_i((int)k0[i], 32);
      merge_top16(k0, k1);
      if (h == 0) {
        unsigned* dst = tops + ((size_t)(u.pm * 256 + wid * 32 + c) * 16 + hc) * 16;
#pragma unroll
        for (int q4 = 0; q4 < 4; ++q4) { u32x4 o = {k0[4 * q4], k0[4 * q4 + 1], k0[4 * q4 + 2], k0[4 * q4 + 3]}; *(u32x4*)(dst + 4 * q4) = o; }
      }
    }
    __syncthreads();
  }
};


template <int CTRL> DI float dpp_f(float v) { const int iv = __float_as_int(v); return __int_as_float(__builtin_amdgcn_update_dpp(iv, iv, CTRL, 0xF, 0xF, false)); }
DI float wsum(float x) {
  x += dpp_f<0xB1>(x);
  x += dpp_f<0x4E>(x);
  x += dpp_f<0x124>(x);
  x += dpp_f<0x128>(x);
  x += shx(x, 16);
  return hsum(x);
}
DI float gelu_fast(float x) {
  const float u2 = 1.5957691216057308f * (x + 0.044715f * x * x * x);
  return x * __builtin_amdgcn_rcpf(1.f + ex2(-LOG2E * u2));
}

constexpr int EROW = 1152;
typedef float v2f __attribute__((ext_vector_type(2)));
__device__ void d_cvt_fp4_row(int row, const float* __restrict__ src, unsigned char* __restrict__ dst) {
  const int lane = TIDX & 63;
  float v[32]; float amax = 0.f;
#pragma unroll
  for (int i = 0; i < 8; ++i) {
    f32x4 x = *(const f32x4*)(src + (size_t)row * DM + 256 * i + 4 * lane);
#pragma unroll
    for (int j = 0; j < 4; ++j) { v[i * 4 + j] = x[j]; amax = fmaxf(amax, fabsf(x[j])); }
  }
  const float sc = amax > 0.f ? amax * (1.f / 6.f) : 1.f;
  const float scb = bf2f(f2bf(sc));
  const float inv = 1.f / scb;
  u32x4 o;
#pragma unroll
  for (int k = 0; k < 4; ++k) {
    unsigned w = 0u;
#define FP4C(x_) fminf(fmaxf((x_) * inv, -6.f), 6.f)
    w = __builtin_amdgcn_cvt_scalef32_pk_fp4_f32(w, FP4C(v[8 * k + 0]), FP4C(v[8 * k + 1]), 1.0f, 0);
    w = __builtin_amdgcn_cvt_scalef32_pk_fp4_f32(w, FP4C(v[8 * k + 2]), FP4C(v[8 * k + 3]), 1.0f, 1);
    w = __builtin_amdgcn_cvt_scalef32_pk_fp4_f32(w, FP4C(v[8 * k + 4]), FP4C(v[8 * k + 5]), 1.0f, 2);
    w = __builtin_amdgcn_cvt_scalef32_pk_fp4_f32(w, FP4C(v[8 * k + 6]), FP4C(v[8 * k + 7]), 1.0f, 3);
#undef FP4C
    o[k] = w;
  }
  *(u32x4*)(dst + (size_t)row * EROW + 16 * lane) = o;
  *(bf16_t*)(dst + (size_t)row * EROW + 1024 + 2 * lane) = f2bf(sc);
}
__device__ void d_expert_wave(int t, unsigned* tpl, const bf16_t* __restrict__ hbuf,
                              const unsigned* __restrict__ tops, const unsigned char* __restrict__ eu4, const unsigned char* __restrict__ ev4,
                              const float* __restrict__ gam, const float* __restrict__ bet, float* __restrict__ out) {
  const int lane = TIDX & 63;
  float hv[32];
#pragma unroll
  for (int i = 0; i < 8; ++i) {
    const u32x2 w = *(const u32x2*)(hbuf + (size_t)t * DM + 256 * i + 4 * lane);
    hv[i * 4 + 0] = __uint_as_float(w[0] << 16); hv[i * 4 + 1] = __uint_as_float(w[0] & 0xFFFF0000u);
    hv[i * 4 + 2] = __uint_as_float(w[1] << 16); hv[i * 4 + 3] = __uint_as_float(w[1] & 0xFFFF0000u);
  }
  int e0 = 0, e1 = 0; float w0 = 0.f, w1 = 0.f;
  {
    const int ci = (lane < 16) ? 0 : (lane < 24) ? 1 : (lane < 29) ? 2 : (lane < 33) ? 3 : (lane < 36) ? 4 : (lane < 38) ? 5 : (lane < 40) ? 6
                   : (lane < 42) ? 7 : (lane - 34);
    const int cpre = (ci == 0) ? 0 : (ci == 1) ? 16 : (ci == 2) ? 24 : (ci == 3) ? 29 : (ci == 4) ? 33 : (ci == 5) ? 36 : (ci == 6) ? 38
                     : (ci == 7) ? 40 : (34 + ci);
    const int cj = lane - cpre;
    const bool cvalid = lane < 50;
    *(u32x4*)(tpl + 4 * lane) = *(const u32x4*)(tops + (size_t)t * 256 + 4 * lane);
    const unsigned* tp = tpl;
#pragma unroll 1
    for (int hh = 0; hh < 8; ++hh) {
      unsigned key = 0u;
      if (cvalid) {
        const float sa = sort2f(tp[(2 * hh) * 16 + ci]), sb = sort2f(tp[(2 * hh + 1) * 16 + cj]);
        key = (f2sort(sa + sb) & 0xFFFFFF00u) | (unsigned)(255 - (ci * 16 + cj));
      }
#pragma unroll
      for (int k = 2; k <= 64; k <<= 1) {
#pragma unroll
        for (int jj = k >> 1; jj > 0; jj >>= 1) {
          const unsigned o = (unsigned)shx_i((int)key, jj);
          const bool lower = (lane & jj) == 0;
          const bool desc = (lane & k) == 0 || k == 64;
          const unsigned mx = key > o ? key : o, mn = key > o ? o : key;
          key = (lower == desc) ? mx : mn;
        }
      }
      const int flat = 255 - (int)(key & 255u);
      const int bi = (flat >> 4) & 15, bj = flat & 15;
      const unsigned ka = tp[(2 * hh) * 16 + bi], kb = tp[(2 * hh + 1) * 16 + bj];
      const float sc = sort2f(ka) + sort2f(kb);
      const int ex = (127 - (int)(ka & 127u)) * 128 + (127 - (int)(kb & 127u));
      float mx = sc;
      mx = fmaxf(mx, shx(mx, 1)); mx = fmaxf(mx, shx(mx, 2)); mx = fmaxf(mx, shx(mx, 4)); mx = fmaxf(mx, shx(mx, 8));
      const float ev_ = __expf(sc - mx);
      float sm = ev_;
      sm += shx(sm, 1); sm += shx(sm, 2); sm += shx(sm, 4); sm += shx(sm, 8);
      const float gv = ev_ / sm;
      const int exs = __shfl(ex, lane & 15); const float gvs = __shfl(gv, lane & 15);
      if ((lane >> 4) == (hh & 3)) { if (hh < 4) { e0 = exs; w0 = gvs; } else { e1 = exs; w1 = gvs; } }
    }
  }
  bf16x2v hb2[16];
#pragma unroll
  for (int i = 0; i < 16; ++i) hb2[i] = bf16x2v{(__bf16)hv[2 * i], (__bf16)hv[2 * i + 1]};
  float c0 = 0.f, c1 = 0.f;
  u32x4 rA[4], rB[4]; unsigned short sA[4], sB[4];
#define EX_LOAD(R, SS, TAB, EB)                                                            \
  _Pragma("unroll") for (int k = 0; k < 4; ++k) {                                          \
    const int e = (EB) + k;                                                                \
    const int id = __builtin_amdgcn_readlane((e < 64) ? e0 : e1, e & 63);                 \
    const unsigned char* row = (TAB) + (size_t)id * EROW;                                  \
    R[k] = *(const u32x4*)(row + 16 * lane);                                               \
    SS[k] = *(const unsigned short*)(row + 1024 + 2 * lane);                               \
  }
#define PKFMA(a_, b_, c_) __builtin_elementwise_fma((a_), (b_), (c_))
#define EX_COMP_U(R, SS, EB)                                                               \
  {                                                                                        \
    float dd[4];                                                                           \
    _Pragma("unroll") for (int k = 0; k < 4; ++k) {                                        \
      float d0 = 0.f, d1 = 0.f;                                                            \
      _Pragma("unroll") for (int q = 0; q < 4; ++q) {                                      \
        const unsigned wq = R[k][q];                                                       \
        d0 = __builtin_amdgcn_fdot2_f32_bf16(__builtin_amdgcn_cvt_scalef32_pk_bf16_fp4(wq, 1.0f, 0), hb2[4 * q + 0], d0, false); \
        d1 = __builtin_amdgcn_fdot2_f32_bf16(__builtin_amdgcn_cvt_scalef32_pk_bf16_fp4(wq, 1.0f, 1), hb2[4 * q + 1], d1, false); \
        d0 = __builtin_amdgcn_fdot2_f32_bf16(__builtin_amdgcn_cvt_scalef32_pk_bf16_fp4(wq, 1.0f, 2), hb2[4 * q + 2], d0, false); \
        d1 = __builtin_amdgcn_fdot2_f32_bf16(__builtin_amdgcn_cvt_scalef32_pk_bf16_fp4(wq, 1.0f, 3), hb2[4 * q + 3], d1, false); \
      }                                                                                    \
      dd[k] = bf2f(SS[k]) * (d0 + d1);                                                     \
      __builtin_amdgcn_sched_barrier(0);                                                   \
    }                                                                                      \
      \
    float t01, t23;                                                                        \
    { auto r_ = __builtin_amdgcn_permlane32_swap(__float_as_uint(dd[0]), __float_as_uint(dd[1]), false, false);   \
      t01 = __uint_as_float(r_[0]) + __uint_as_float(r_[1]); }          \
    { auto r_ = __builtin_amdgcn_permlane32_swap(__float_as_uint(dd[2]), __float_as_uint(dd[3]), false, false);   \
      t23 = __uint_as_float(r_[0]) + __uint_as_float(r_[1]); }          \
    const bool b4_ = (lane & 16) != 0;                                                     \
    float tv = (b4_ ? t23 : t01) + shx(b4_ ? t01 : t23, 16);          \
    tv += dpp_f<0x128>(tv); tv += dpp_f<0x124>(tv); tv += dpp_f<0x4E>(tv); tv += dpp_f<0xB1>(tv);                 \
    _Pragma("unroll") for (int k = 0; k < 4; ++k) {                                        \
      const int e = (EB) + k;                                                              \
      const float tot = __int_as_float(__builtin_amdgcn_readlane(__float_as_int(tv), (k == 0) ? 0 : (k == 1) ? 32 : (k == 2) ? 16 : 48)); \
      if (e < 64) { if (lane == e) c0 = tot; } else { if (lane == e - 64) c1 = tot; }        \
    }                                                                                      \
    __builtin_amdgcn_sched_barrier(0);                                                     \
  }
#define EX_COMP_V(R, SS, EB)                                                               \
  _Pragma("unroll") for (int k = 0; k < 4; ++k) {                                          \
    const int e = (EB) + k;                                                                \
    const float cs = __int_as_float(__builtin_amdgcn_readlane(__float_as_int((e < 64) ? c0 : c1), e & 63)) * bf2f(SS[k]);                     \
    const v2f cs2 = {cs, cs};                                                              \
    _Pragma("unroll") for (int q = 0; q < 4; ++q) {                                        \
      const unsigned wq = R[k][q];                                                         \
      const v2f f0 = __builtin_amdgcn_cvt_scalef32_pk_f32_fp4(wq, 1.0f, 0), f1 = __builtin_amdgcn_cvt_scalef32_pk_f32_fp4(wq, 1.0f, 1); \
      const v2f f2 = __builtin_amdgcn_cvt_scalef32_pk_f32_fp4(wq, 1.0f, 2), f3 = __builtin_amdgcn_cvt_scalef32_pk_f32_fp4(wq, 1.0f, 3); \
      acc2[4 * q + 0] = PKFMA(cs2, f0, acc2[4 * q + 0]); acc2[4 * q + 1] = PKFMA(cs2, f1, acc2[4 * q + 1]); \
      acc2[4 * q + 2] = PKFMA(cs2, f2, acc2[4 * q + 2]); acc2[4 * q + 3] = PKFMA(cs2, f3, acc2[4 * q + 3]); \
    }                                                                                      \
    __builtin_amdgcn_sched_barrier(0);                                                     \
  }
  EX_LOAD(rA, sA, eu4, 0)
  __builtin_amdgcn_sched_barrier(0);
#pragma unroll 1
  for (int eb = 0; eb < 128; eb += 8) {
    EX_LOAD(rB, sB, eu4, eb + 4)
    __builtin_amdgcn_sched_barrier(0);
    EX_COMP_U(rA, sA, eb)
    { const bool more = eb + 8 < 128; const unsigned char* tabn = more ? eu4 : ev4; const int ebn = more ? eb + 8 : 0;
      EX_LOAD(rA, sA, tabn, ebn) }
    __builtin_amdgcn_sched_barrier(0);
    EX_COMP_U(rB, sB, eb + 4)
  }
  c0 = w0 * gelu_fast(c0); c1 = w1 * gelu_fast(c1);
  v2f acc2[16];
#pragma unroll
  for (int i = 0; i < 16; ++i) acc2[i] = v2f{0.f, 0.f};
#pragma unroll 1
  for (int eb = 0; eb < 128; eb += 8) {
    EX_LOAD(rB, sB, ev4, eb + 4)
    __builtin_amdgcn_sched_barrier(0);
    EX_COMP_V(rA, sA, eb)
    { const int ebn = (eb + 8 < 128) ? eb + 8 : 0;
      EX_LOAD(rA, sA, ev4, ebn) }
    __builtin_amdgcn_sched_barrier(0);
    EX_COMP_V(rB, sB, eb + 4)
  }
#undef EX_LOAD
#undef EX_COMP_U
#undef EX_COMP_V
#undef PKFMA
  float acc[32];
#pragma unroll
  for (int i = 0; i < 16; ++i) { acc[2 * i] = acc2[i].x; acc[2 * i + 1] = acc2[i].y; }
  int le = lane;
  asm volatile("" : "+v"(le) :: "memory");
  float s = 0.f;
#pragma unroll
  for (int i = 0; i < 8; ++i) {
    const u32x2 w = *(const u32x2*)(hbuf + (size_t)t * DM + 256 * i + 4 * le);
    const float h0 = __uint_as_float(w[0] << 16), h1 = __uint_as_float(w[0] & 0xFFFF0000u), h2 = __uint_as_float(w[1] << 16), h3 = __uint_as_float(w[1] & 0xFFFF0000u);
    acc[i * 4 + 0] = fmaf(ALPHA, h0, acc[i * 4 + 0]); acc[i * 4 + 1] = fmaf(ALPHA, h1, acc[i * 4 + 1]);
    acc[i * 4 + 2] = fmaf(ALPHA, h2, acc[i * 4 + 2]); acc[i * 4 + 3] = fmaf(ALPHA, h3, acc[i * 4 + 3]);
    s += (acc[i * 4 + 0] + acc[i * 4 + 1]) + (acc[i * 4 + 2] + acc[i * 4 + 3]);
  }
  s = wsum(s);
  const float mu = s * (1.f / DM);
  float qv = 0.f;
#pragma unroll
  for (int i = 0; i < 32; ++i) { const float d = acc[i] - mu; qv += d * d; }
  qv = wsum(qv);
  const float rs = rsqrtf(qv * (1.f / DM) + 1e-5f);
#pragma unroll
  for (int i = 0; i < 8; ++i) {
    const int cbase = 256 * i + 4 * le;
    f32x4 ga = *(const f32x4*)(gam + cbase), ba = *(const f32x4*)(bet + cbase), o;
#pragma unroll
    for (int j = 0; j < 4; ++j) o[j] = (acc[i * 4 + j] - mu) * rs * ga[j] + ba[j];
    *(f32x4*)(out + (size_t)t * DM + cbase) = o;
  }
}

constexpr size_t al256(size_t x) { return (x + 255) & ~(size_t)255; }
constexpr size_t WS_XB = 0;
constexpr size_t WS_PROJ = WS_XB + al256((size_t)S * DM * 2);
constexpr size_t WS_WINT = WS_PROJ + al256((size_t)S * INWP * 2);
constexpr size_t WS_GATES = WS_WINT + al256((size_t)INWG * DM * 2);
constexpr size_t WS_W1KF = WS_GATES + al256((size_t)S * 24 * 4);
constexpr size_t WS_W1VF = WS_W1KF + al256((size_t)512 * 4096 * 2);
constexpr size_t WS_W2KF = WS_W1VF + al256((size_t)512 * 4096 * 2);
constexpr size_t WS_W2VF = WS_W2KF + al256((size_t)512 * 128 * 2);
constexpr size_t WS_VC = WS_W2VF + al256((size_t)512 * 128 * 2) - al256((size_t)2048 * 128 * 4);
constexpr size_t WS_KCF = WS_VC + al256((size_t)2048 * 128 * 4);
constexpr size_t WS_VCF = WS_KCF + al256((size_t)2 * 32 * 4096 * 2);
constexpr size_t WS_KSF = WS_VCF + al256((size_t)2 * 32 * 4096 * 2);
constexpr size_t WS_VSF = WS_KSF + al256((size_t)2 * 512 * 4096 * 2);
constexpr size_t WS_KWF = WS_VSF + al256((size_t)2 * 512 * 4096 * 2);
constexpr size_t WS_VWF = WS_KWF + al256((size_t)2 * 512 * 4096 * 2);
constexpr size_t WS_ENDA = WS_VWF + al256((size_t)2 * 512 * 4096 * 2);
constexpr size_t WS_OATT = WS_ENDA;
constexpr size_t WS_MIX = WS_OATT + al256((size_t)S * 1024 * 4);
constexpr size_t WS_WOUTT = WS_MIX + al256((size_t)S * DM * 2);
constexpr size_t WS_WQT = WS_WOUTT + al256((size_t)DM * DM * 2);
constexpr size_t WS_TOPS = WS_WQT + al256((size_t)DM * DM * 2);
constexpr size_t WS_SKF = WS_TOPS + al256((size_t)S * 256 * 4);
constexpr size_t WS_STATS = WS_SKF + al256((size_t)16 * 128 * 128 * 2);
constexpr size_t WS_CTRL = WS_STATS + al256((size_t)S * 2 * 4);
constexpr size_t CTRL_BYTES = 32768;
constexpr size_t WS_END = WS_CTRL + CTRL_BYTES;
constexpr size_t WS_Y = WS_PROJ;
constexpr size_t WS_HB = WS_XB;
constexpr size_t WS_EU8 = WS_Y + (size_t)S * DM * 4;
constexpr size_t WS_EV8 = WS_EU8 + (size_t)16384 * 1152;
static_assert(WS_EV8 + (size_t)16384 * 1152 <= WS_ENDA, "expert overlay overflows group A");
static_assert(WS_END <= (size_t)512 * 1024 * 1024, "workspace over 512 MiB");

struct Params {
  const float *x, *w_in, *ck_pos, *ck_w1, *ck_b1, *ck_w2, *cv_pos, *cv_w1, *cv_b1, *cv_w2, *conv_w, *hng, *w_out, *ln1g, *ln1b, *w_query, *subk,
      *eu, *ev, *ln2g, *ln2b;
  float* out;
  char* ws;
};
#define WSP(T, OFF) ((T*)(p.ws + (OFF)))

#define FOR_VB(n) for (int vb = blockIdx.x; vb < (n); vb += gridDim.x)
#define FOR_VB2(n) for (int vb = blockIdx.x * 2 + (TIDX >> 8); vb < (n); vb += gridDim.x * 2)
constexpr int SMEM_BYTES = 143360;
constexpr int HALF = 36864;

__global__ void __launch_bounds__(512) mega(Params p) {
  __shared__ __attribute__((aligned(16))) char smem[SMEM_BYTES + 16];
  if (TIDX == 0) *(u32x4*)(smem + SMEM_BYTES) = u32x4{0u, 0u, 0u, 0u};
  __syncthreads();
  const XcdBarrier xbar = xcd_barrier_post(WSP(unsigned, WS_CTRL + 1024), (volatile LAS unsigned*)(smem + SMEM_BYTES));
#define smh (smem + (TIDX >> 8) * HALF)
#define wv ((TIDX >> 6))
  constexpr int NWV = 8;
  d_cvt(p.x, WSP(bf16_t, WS_XB), (size_t)S * DM / 4);
  FOR_VB2((INWG / 64) * (DM / 64)) d_cvtT64(vb, smh, p.w_in, WSP(bf16_t, WS_WINT), DM, INW, INWG);
  for (size_t c = (size_t)blockIdx.x * 512 + TIDX; c < (size_t)16 * 256 * 64; c += (size_t)gridDim.x * 512) {
    d_cvt_w1f(c, p.ck_w1, WSP(bf16_t, WS_W1KF)); d_cvt_w1f(c, p.cv_w1, WSP(bf16_t, WS_W1VF));
    if (c < (size_t)4 * 32 * 64) { d_cvt_w2f(c, p.ck_w2, WSP(bf16_t, WS_W2KF)); d_cvt_w2f(c, p.cv_w2, WSP(bf16_t, WS_W2VF)); }
  }
  FOR_VB2((DM / 64) * (DM / 64)) d_cvtT64(vb, smh, p.w_out, WSP(bf16_t, WS_WOUTT), DM, DM, DM);
  FOR_VB2((DM / 64) * (DM / 64)) d_cvtT64(vb, smh, p.w_query, WSP(bf16_t, WS_WQT), DM, DM, DM);
  for (size_t c = (size_t)blockIdx.x * 512 + TIDX; c < (size_t)16 * 4 * 8 * 64; c += (size_t)gridDim.x * 512) d_cvt_subk(c, p.subk, WSP(bf16_t, WS_SKF));
  xcd_barrier(xbar);
  {
    pg8::StaticOrder so; so.init(S, INWG, gridDim.x, blockIdx.x);
    pg8::gemm_phase<EpiProjG, pg8::StaticOrder>((PG8_LAS unsigned char*)smem, pg8::Gemm{WSP(bf16_t, WS_XB), WSP(bf16_t, WS_WINT), S, INWG, DM}, so,
                                                EpiProjG{WSP(bf16_t, WS_PROJ), WSP(float, WS_GATES)}, nullptr);
  }
  xcd_barrier(xbar);
  {
    if (blockIdx.x < 128) {
      const int u = blockIdx.x; const bool isV = u >= 64;
      d_compress_unit(u & 63, smem, WSP(bf16_t, WS_PROJ), isV ? OFF_VC : OFF_KC, isV ? p.cv_pos : p.ck_pos, isV ? WSP(bf16_t, WS_W1VF) : WSP(bf16_t, WS_W1KF),
                      isV ? p.cv_b1 : p.ck_b1, isV ? WSP(bf16_t, WS_W2VF) : WSP(bf16_t, WS_W2KF), isV ? WSP(bf16_t, WS_VCF) : WSP(bf16_t, WS_KCF), isV);
    }
    int* slot = (int*)smem;
    unsigned* ctr = WSP(unsigned, WS_CTRL);
    for (;;) {
      if (TIDX == 0) *slot = (int)atomicAdd(ctr, 1u);
      __syncthreads();
      const int it = *slot;
      __syncthreads();
      if (it >= 2048) break;
      const int tt = TIDX;
      {
        const int T = it >> 2, which = it & 3;
        d_relayout_tile(T, smem + 64, WSP(bf16_t, WS_PROJ), (which == 0) ? OFF_KS : (which == 1) ? OFF_VS : (which == 2) ? OFF_KW : OFF_VW,
                        (which == 0) ? WSP(bf16_t, WS_KSF) : (which == 1) ? WSP(bf16_t, WS_VSF) : (which == 2) ? WSP(bf16_t, WS_KWF) : WSP(bf16_t, WS_VWF), (which & 1) != 0);
      }
      for (int q = 0; q < 2; ++q) d_convmix(it * 8 + q * 4 + (tt >> 7), tt & 127, WSP(bf16_t, WS_PROJ), p.conv_w, p.hng, WSP(bf16_t, WS_MIX));
    }
  }
  xcd_barrier(xbar);
  {
    AttnPtrs ap{WSP(bf16_t, WS_PROJ), WSP(float, WS_GATES), WSP(bf16_t, WS_KCF), WSP(bf16_t, WS_VCF), WSP(bf16_t, WS_KSF), WSP(bf16_t, WS_VSF), WSP(bf16_t, WS_KWF), WSP(bf16_t, WS_VWF), WSP(bf16_t, WS_MIX), p.hng};
    for (int it = blockIdx.x; it < 512; it += gridDim.x) {
      const int Bq = (it < 256) ? it : (511 - it), gq = (it < 256) ? 0 : 1;
      d_attn_block(Bq, gq, smem, ap);
    }
  }
  xcd_barrier(xbar);
  {
    pg8::StaticOrder so; so.init(S, DM, gridDim.x, blockIdx.x);
    pg8::gemm_phase<EpiResG, pg8::StaticOrder>((PG8_LAS unsigned char*)smem, pg8::Gemm{WSP(bf16_t, WS_MIX), WSP(bf16_t, WS_WOUTT), S, DM, DM}, so,
                                               EpiResG{WSP(bf16_t, WS_HB)}, nullptr);
  }
  xcd_barrier(xbar);
  for (int r = blockIdx.x * NWV + wv; r < S; r += gridDim.x * NWV) d_ln_wave(r, WSP(bf16_t, WS_HB), p.ln1g, p.ln1b);
  for (int r = blockIdx.x * NWV + wv; r < 32768; r += gridDim.x * NWV) {
    if (r < 16384) d_cvt_fp4_row(r, p.eu, WSP(unsigned char, WS_EU8)); else d_cvt_fp4_row(r - 16384, p.ev, WSP(unsigned char, WS_EV8));
  }
  xcd_barrier(xbar);
  for (int k = 0; k * (int)gridDim.x < (S / 256) * (DM / 256); ++k) {
    pg8::OneUnit so; so.init(S, DM, gridDim.x, blockIdx.x); so.k = k;
    pg8::gemm_phase<EpiRouteG, pg8::OneUnit>((PG8_LAS unsigned char*)smem, pg8::Gemm{WSP(bf16_t, WS_HB), WSP(bf16_t, WS_WQT), S, DM, DM}, so,
                                             EpiRouteG{WSP(bf16_t, WS_SKF), WSP(unsigned, WS_TOPS)}, nullptr);
    __syncthreads();
  }
  xcd_barrier(xbar);
  for (int t = blockIdx.x * NWV + wv; t < S; t += gridDim.x * NWV) d_expert_wave(t, (unsigned*)(smem + wv * 1024), WSP(bf16_t, WS_HB), WSP(unsigned, WS_TOPS), WSP(unsigned char, WS_EU8), WSP(unsigned char, WS_EV8), p.ln2g, p.ln2b, p.out);
}

extern "C" void kernel_launch(void* const* d_in, const int* in_sizes, int n_in, void* d_out, int out_size, void* d_ws, size_t ws_size,
                              hipStream_t stream) {
  Params p{};
  p.x = (const float*)d_in[0]; p.w_in = (const float*)d_in[1]; p.ck_pos = (const float*)d_in[2]; p.ck_w1 = (const float*)d_in[3];
  p.ck_b1 = (const float*)d_in[4]; p.ck_w2 = (const float*)d_in[5]; p.cv_pos = (const float*)d_in[6]; p.cv_w1 = (const float*)d_in[7];
  p.cv_b1 = (const float*)d_in[8]; p.cv_w2 = (const float*)d_in[9]; p.conv_w = (const float*)d_in[10]; p.hng = (const float*)d_in[11];
  p.w_out = (const float*)d_in[12]; p.ln1g = (const float*)d_in[13]; p.ln1b = (const float*)d_in[14]; p.w_query = (const float*)d_in[15];
  p.subk = (const float*)d_in[16]; p.eu = (const float*)d_in[17]; p.ev = (const float*)d_in[18]; p.ln2g = (const float*)d_in[19];
  p.ln2b = (const float*)d_in[20];
  p.out = (float*)d_out;
  p.ws = (char*)d_ws;
  if (ws_size < WS_END) fprintf(stderr, "workspace too small\n");
  static int grid_blocks = 0;
  if (!grid_blocks) {
    int dev = 0, cus = 0, per_cu = 0;
    hipGetDevice(&dev);
    hipDeviceGetAttribute(&cus, hipDeviceAttributeMultiprocessorCount, dev);
    hipOccupancyMaxActiveBlocksPerMultiprocessor(&per_cu, mega, 512, 0);
    if (per_cu > 1) per_cu = 1;
    if (per_cu < 1) per_cu = 1;
    grid_blocks = cus * per_cu;
  }
  hipMemsetAsync((char*)d_ws + WS_CTRL, 0, CTRL_BYTES, stream);
  void* args[] = {&p};
  hipError_t e = hipLaunchCooperativeKernel((void*)mega, dim3(grid_blocks), dim3(512), args, 0, stream);
  if (e != hipSuccess) fprintf(stderr, "cooperative launch failed: %s (grid %d)\n", hipGetErrorString(e), grid_blocks);
}
```

```cpp
#include <hip/hip_runtime.h>
#include <stdint.h>
#include <stdio.h>


#define DI __device__ __forceinline__
static __device__ __forceinline__ int tidx_() { int t = (int)__builtin_amdgcn_workitem_id_x(); asm volatile("" : "+v"(t)); return t; }
#define TIDX (tidx_())

template <int J> DI int swz_xor(int x) { return __builtin_amdgcn_ds_swizzle(x, (J << 10) | 0x1F); }
template <int CTRL> DI int dpp_i(int x) { return __builtin_amdgcn_update_dpp(x, x, CTRL, 0xF, 0xF, false); }
DI int shx_i(int x, int j) {
  switch (j) {
    case 1: return dpp_i<0xB1>(x);
    case 2: return dpp_i<0x4E>(x);
    case 4: return dpp_i<0x1B>(dpp_i<0x141>(x));
    case 8: return dpp_i<0x128>(x);
    case 16: return swz_xor<16>(x);
    default: {
      auto r = __builtin_amdgcn_permlane32_swap((unsigned)x, (unsigned)x, false, false);
      return (TIDX & 32) ? (int)r[0] : (int)r[1];
    }
  }
}
DI float shx(float x, int j) { return __int_as_float(shx_i(__float_as_int(x), j)); }
typedef unsigned short bf16_t;
using bf16x8 = __attribute__((ext_vector_type(8))) short;
using f32x4 = __attribute__((ext_vector_type(4))) float;
using u32x4 = __attribute__((ext_vector_type(4))) unsigned;
using u32x2 = __attribute__((ext_vector_type(2))) unsigned;

constexpr int S = 16384, DM = 2048, HD = 128;
constexpr int INW = 5656, INWP = 5760, INWG = 5888;
constexpr int OFF_Q = 0, OFF_KC = 1024, OFF_VC = 1280, OFF_KS = 1536, OFF_VS = 1792, OFF_KW = 2048, OFF_VW = 2304,
              OFF_G = 2560, OFF_U = 2584, OFF_B = 3608, OFF_C = 4632;
constexpr int NCMP = 1023;
constexpr float ALPHA = 1.189207115002721f;
constexpr float QSCALE = 0.08838834764831845f;

DI bf16_t f2bf(float x) { unsigned u = __float_as_uint(x); u += 0x7fffu + ((u >> 16) & 1u); return (bf16_t)(u >> 16); }
DI float bf2f(bf16_t b) { return __uint_as_float(((unsigned)b) << 16); }
DI float gelu_tanh(float x) { float u = 0.7978845608028654f * (x + 0.044715f * x * x * x); return 0.5f * x * (1.f + tanhf(u)); }
DI float wave_sum(float v) { for (int o = 32; o > 0; o >>= 1) v += shx(v, o); return v; }
using bf16x2v = __attribute__((ext_vector_type(2))) __bf16;
DI unsigned pack2(float a, float b) { bf16x2v v = {(__bf16)a, (__bf16)b}; return __builtin_bit_cast(unsigned, v); }
DI float wave_max(float v) { for (int o = 32; o > 0; o >>= 1) v = fmaxf(v, shx(v, o)); return v; }

namespace pg8 {
#define PG8_LAS __attribute__((address_space(3)))
typedef unsigned short bf16_t;
typedef short bf16x8 __attribute__((ext_vector_type(8)));
typedef float f32x4 __attribute__((ext_vector_type(4)));
typedef unsigned u32x4 __attribute__((ext_vector_type(4)));
constexpr int BM = 256, BK = 64, HALF = 128, HTB = HALF * BK * 2  , STAGE_BYTES = 8 * HTB, NXCD = 8, WGM = 8;

__host__ __device__ __forceinline__ int lds_byte(int r, int c) { const int st = (r >> 4) * 2 + (c >> 5), rr = r & 15, cc = c & 31, ob = rr * 64 + cc * 2; return st * 1024 + (ob ^ (((ob >> 9) & 1) << 5)); }
__host__ __device__ __forceinline__ void stage_rc(int b, int& R, int& C) { const int st = b / 1024, sb = b % 1024, swz = sb ^ (((sb >> 9) & 1) << 5); R = (st >> 1) * 16 + swz / 64; C = (st & 1) * 32 + (swz % 64) / 2; }
__host__ __device__ __forceinline__ int perm32(int rho) { const int n = rho >> 4, i = rho & 15; return 8 * (i >> 2) + 4 * n + (i & 3); }

struct Unit { int pm, pn; };
struct Gemm { const bf16_t* A; const bf16_t* Bt; int M, N, K; };

struct StaticOrder {
    int nM, nN, nwg, G, c;
    __host__ __device__ void init(int M, int N, int G_, int c_) { nM = M / BM; nN = N / BM; nwg = nM * nN; G = G_; c = c_; }
    __host__ __device__ bool next(int i, Unit& u) const {
        const long L = (long)i * G + c; if (L >= nwg) return false;
        int wgid = (int)L; { const int q = nwg / NXCD, r = nwg % NXCD, xcd = wgid % NXCD, off = wgid / NXCD; wgid = (xcd < r ? xcd * (q + 1) : r * (q + 1) + (xcd - r) * q) + off; }
        const int nig = WGM * nN, gid = wgid / nig, fm = gid * WGM, gsz = (nM - fm) < WGM ? (nM - fm) : WGM;
        u.pm = fm + ((wgid % nig) % gsz); u.pn = (wgid % nig) / gsz; return true;
    }
    __device__ __forceinline__ void a_ready(const Unit&) const {}
    __device__ __forceinline__ void done(const Unit&) const {}
};
struct OneUnit : StaticOrder {
    int k;
    __device__ bool next(int i, Unit& u) const { if (i > 0) return false; return StaticOrder::next(k, u); }
};
__device__ __forceinline__ unsigned cvt_pk_bf16(float lo, float hi) { unsigned r; asm volatile("v_cvt_pk_bf16_f32 %0, %1, %2" : "=v"(r) : "v"(lo), "v"(hi)); return r; }
template <class Epi, class Sched, bool STAMP = false>
__device__ __forceinline__ void gemm_phase(PG8_LAS unsigned char* lds, const Gemm g, const Sched& S, const Epi& E, unsigned long long* stamps) {
    const int tid = TIDX, wid = __builtin_amdgcn_readfirstlane(tid >> 6), lane = tid & 63, wr = wid >> 2, wc = wid & 3, fr = lane & 15, fq = lane >> 4;
    const int K = g.K, nt = K / BK;
    int ts_lo = 0, ts_hi = 0, nts = 0; const unsigned long long rt_entry = STAMP ? (unsigned long long)wall_clock64() : 0ull;
#define PG8_STAMP() do { if (STAMP && wid == 0 && nts < 64) { const unsigned long long _c = (unsigned long long)clock64(); \
        ts_lo = (lane == nts) ? (int)(unsigned)_c : ts_lo; ts_hi = (lane == nts) ? (int)(unsigned)(_c >> 32) : ts_hi; ++nts; } } while (0)
    PG8_STAMP();
    unsigned voffA[2], voffB[2];
#pragma unroll
    for (int i = 0; i < 2; ++i) { int R, C; stage_rc(tid * 16 + i * 8192, R, C); const int Rb = Epi::PERM ? ((R & ~31) + perm32(R & 31)) : R;
        voffA[i] = (unsigned)(R * K + C) * 2u; voffB[i] = (unsigned)(Rb * K + C) * 2u; }
    const size_t kstep = (size_t)(BK * 2);
    const size_t hstep = (size_t)HALF * K * 2;
    const size_t tstep = 2 * hstep;
    const unsigned ldsw = (unsigned)wid * 1024u;
    const int aoff = lds_byte(wr * 64 + fr, fq * 8), boff = lds_byte(wc * 32 + fr, fq * 8);
#define PG8_SA(b, h) (((b) * 2 + (h)) * HTB)
#define PG8_SB(b, h) ((4 + (b) * 2 + (h)) * HTB)
#define PG8_STAGE(bufoff, gbase, voff) do { _Pragma("unroll") for (int _i = 0; _i < 2; ++_i) \
        __builtin_amdgcn_global_load_lds((const unsigned*)((const char*)(gbase) + (voff)[_i]), (PG8_LAS unsigned*)(lds + (bufoff) + ldsw + _i * 8192), 16, 0, 0); } while (0)
#define PG8_LDA(dst, b, h) do { _Pragma("unroll") for (int m = 0; m < 4; ++m) _Pragma("unroll") for (int k = 0; k < 2; ++k) dst[m][k] = *(const PG8_LAS bf16x8*)(lds + PG8_SA(b, h) + aoff + m * 2048 + k * 1024); } while (0)
#define PG8_LDB(dst, b, h) do { _Pragma("unroll") for (int n = 0; n < 2; ++n) _Pragma("unroll") for (int k = 0; k < 2; ++k) dst[n][k] = *(const PG8_LAS bf16x8*)(lds + PG8_SB(b, h) + boff + n * 2048 + k * 1024); } while (0)
#define PG8_MMA(ai, bj, At, Bt) do { __builtin_amdgcn_s_setprio(1); _Pragma("unroll") for (int m = 0; m < 4; ++m) _Pragma("unroll") for (int n = 0; n < 2; ++n) _Pragma("unroll") for (int k = 0; k < 2; ++k) \
        acc[ai][bj][m][n] = __builtin_amdgcn_mfma_f32_16x16x32_bf16(Bt[n][k], At[m][k], acc[ai][bj][m][n], 0, 0, 0); __builtin_amdgcn_s_setprio(0); } while (0)
#define PG8_WAIT_V(n) asm volatile("s_waitcnt vmcnt(" #n ")" ::: "memory")
#define PG8_WAIT_L(n) asm volatile("s_waitcnt lgkmcnt(" #n ")" ::: "memory")
#define PG8_BAR __builtin_amdgcn_s_barrier()
#define PG8_SCHED __builtin_amdgcn_sched_barrier(0)
    Unit cur, nxt; int ui = 0;
    if (!S.next(0, cur)) return;
    f32x4 acc[2][2][4][2];
#pragma unroll
    for (int a = 0; a < 2; ++a)
#pragma unroll
        for (int b = 0; b < 2; ++b)
#pragma unroll
            for (int m = 0; m < 4; ++m)
#pragma unroll
                for (int n = 0; n < 2; ++n) acc[a][b][m][n] = (f32x4){0.f, 0.f, 0.f, 0.f};
    bf16x8 At[4][2], B0[2][2], B1[2][2];
    const char* cA = (const char*)g.A + (size_t)cur.pm * tstep; const char* cB = (const char*)g.Bt + (size_t)cur.pn * tstep;
    S.a_ready(cur);
    PG8_STAGE(PG8_SB(0, 0), cB, voffB); PG8_STAGE(PG8_SA(0, 0), cA, voffA); PG8_STAGE(PG8_SB(0, 1), cB + hstep, voffB); PG8_STAGE(PG8_SA(0, 1), cA + hstep, voffA);
    if (wr == 1) PG8_BAR;
    PG8_WAIT_V(4); PG8_BAR;
    PG8_STAGE(PG8_SB(1, 0), cB + kstep, voffB); PG8_STAGE(PG8_SA(1, 0), cA + kstep, voffA); PG8_STAGE(PG8_SB(1, 1), cB + hstep + kstep, voffB);
    PG8_WAIT_V(6); PG8_BAR;
    PG8_STAMP();
    for (;;) {
        const bool has_next = S.next(ui + 1, nxt);
        const char* nA = has_next ? (const char*)g.A + (size_t)nxt.pm * tstep : cA; const char* nB = has_next ? (const char*)g.Bt + (size_t)nxt.pn * tstep : cB;
        for (int t = 0; t < nt; t += 2) {
            const bool last = (t == nt - 2);
            const char* a1 = cA + (size_t)(t + 1) * kstep;
            const char* a2 = last ? nA : cA + (size_t)(t + 2) * kstep; const char* b2 = last ? nB : cB + (size_t)(t + 2) * kstep;
            const char* a3 = a2 + kstep; const char* b3 = b2 + kstep;
            if (last && has_next) S.a_ready(nxt);
            PG8_LDB(B0, 0, 0); PG8_SCHED; PG8_LDA(At, 0, 0); PG8_STAGE(PG8_SA(1, 1), a1 + hstep, voffA);
            PG8_WAIT_L(8); PG8_BAR; PG8_WAIT_L(0); PG8_MMA(0, 0, At, B0); PG8_BAR; PG8_SCHED;
            PG8_LDB(B1, 0, 1); PG8_STAGE(PG8_SB(0, 0), b2, voffB);
            PG8_BAR; PG8_WAIT_L(0); PG8_MMA(0, 1, At, B1); PG8_BAR;
            PG8_LDA(At, 0, 1); PG8_STAGE(PG8_SA(0, 0), a2, voffA);
            PG8_BAR; PG8_WAIT_L(0); PG8_MMA(1, 0, At, B0); PG8_BAR; PG8_SCHED;
            PG8_STAGE(PG8_SB(0, 1), b2 + hstep, voffB);
            PG8_WAIT_V(6); PG8_BAR; PG8_MMA(1, 1, At, B1); PG8_BAR;
            PG8_LDB(B0, 1, 0); PG8_SCHED; PG8_LDA(At, 1, 0); PG8_STAGE(PG8_SA(0, 1), a2 + hstep, voffA);
            PG8_WAIT_L(8); PG8_BAR; PG8_WAIT_L(0); PG8_MMA(0, 0, At, B0); PG8_BAR; PG8_SCHED;
            PG8_LDB(B1, 1, 1); PG8_STAGE(PG8_SB(1, 0), b3, voffB);
            PG8_BAR; PG8_WAIT_L(0); PG8_MMA(0, 1, At, B1); PG8_BAR;
            PG8_LDA(At, 1, 1); PG8_STAGE(PG8_SA(1, 0), a3, voffA);
            PG8_BAR; PG8_WAIT_L(0); PG8_MMA(1, 0, At, B0); PG8_BAR; PG8_SCHED;
            PG8_STAGE(PG8_SB(1, 1), b3 + hstep, voffB);
            PG8_WAIT_V(6); PG8_BAR; PG8_MMA(1, 1, At, B1); PG8_BAR;
        }
        PG8_STAMP();
        if constexpr (!Epi::AFTER_DRAIN) { E(acc, cur, wr, wc, fr, fq); S.done(cur); }
        PG8_STAMP();
        if (!has_next) break;
#pragma unroll
        for (int a = 0; a < 2; ++a)
#pragma unroll
            for (int b = 0; b < 2; ++b)
#pragma unroll
                for (int m = 0; m < 4; ++m)
#pragma unroll
                    for (int n = 0; n < 2; ++n) acc[a][b][m][n] = (f32x4){0.f, 0.f, 0.f, 0.f};
        cur = nxt; cA = nA; cB = nB; ++ui;
    }
    PG8_WAIT_V(0);
    if (wr == 0) PG8_BAR;
    PG8_BAR;
    if constexpr (Epi::AFTER_DRAIN) { E.fused(acc, cur, wr, wc, fr, fq, lds, wid, lane); S.done(cur); }
    PG8_STAMP();
    if (STAMP && wid == 0) { stamps[lane] = lane < nts ? (((unsigned long long)(unsigned)ts_hi << 32) | (unsigned)ts_lo) : 0ull;
        if (lane == 62) stamps[62] = rt_entry; if (lane == 63) stamps[63] = (unsigned long long)wall_clock64(); }
#undef PG8_STAMP
#undef PG8_SA
#undef PG8_SB
#undef PG8_STAGE
#undef PG8_LDA
#undef PG8_LDB
#undef PG8_MMA
#undef PG8_WAIT_V
#undef PG8_WAIT_L
#undef PG8_BAR
#undef PG8_SCHED
}
}

#define XB_TMO      128
#define XB_XCNT(j)  (256  + 64 * (j))
#define XB_XSUB(j)  (1280 + 64 * (j))
#define XB_XGEN(j)  (2304 + 64 * (j))
#define XB_TOP      3328
#define XB_TOPGEN   3392
#define XCD_BAR_WORDS 3456
#define XB_SPIN_CAP (1u << 18)
#define LAS __attribute__((address_space(3)))

__device__ __forceinline__ unsigned xb_ld(unsigned* p)              { return __hip_atomic_load(p, __ATOMIC_RELAXED, __HIP_MEMORY_SCOPE_AGENT); }
__device__ __forceinline__ unsigned xb_add(unsigned* p, unsigned v) { return __hip_atomic_fetch_add(p, v, __ATOMIC_RELAXED, __HIP_MEMORY_SCOPE_AGENT); }
__device__ __forceinline__ unsigned xb_xcc_id() { return (unsigned)__builtin_amdgcn_s_getreg((3 << 11) | 20) & 0xFu; }
#define XB_SPIN(cond, bar) do { unsigned _sp = 0; while (cond) { __builtin_amdgcn_s_sleep(1); \
    if ((++_sp & 255u) == 0u) { if (xb_ld(&(bar)[XB_TMO])) break; if (_sp > XB_SPIN_CAP) { atomicAdd(&(bar)[XB_TMO], 1u); break; } } } } while (0)

struct XcdBarrier {
    unsigned* bar; unsigned x;
    volatile LAS unsigned* st;
};

__device__ __forceinline__ XcdBarrier xcd_barrier_post(unsigned* bar, volatile LAS unsigned* st) {
    XcdBarrier b; b.bar = bar; b.x = xb_xcc_id(); b.st = st;
    if (TIDX == 0) (void)xb_add(&bar[XB_XCNT(b.x)], 1u);
    return b;
}
__device__ __forceinline__ void xcd_barrier_complete(unsigned* bar, unsigned x, unsigned& nloc, unsigned& nx) {
    const unsigned G = gridDim.x * gridDim.y * gridDim.z;
    unsigned sum, cnt, mine, sp = 0u;
    for (;;) {
        sum = 0u; cnt = 0u; mine = 0u;
#pragma unroll
        for (unsigned j = 0; j < 16; ++j) { const unsigned c = xb_ld(&bar[XB_XCNT(j)]); sum += c; cnt += (c > 0u) ? 1u : 0u; mine = (j == x) ? c : mine; }
        if (sum == G) break;
        __builtin_amdgcn_s_sleep(1);
        if ((++sp & 255u) == 0u) { if (xb_ld(&bar[XB_TMO])) break; if (sp > XB_SPIN_CAP) { atomicAdd(&bar[XB_TMO], 1u); break; } }
    }
    nloc = mine > 0u ? mine : 1u; nx = cnt > 0u ? cnt : 1u;
}

__device__ __forceinline__ void xcd_barrier(const XcdBarrier& b) {
    asm volatile("s_waitcnt vmcnt(0)" ::: "memory");
    __syncthreads();
    if (TIDX == 0) {
        unsigned* bar = b.bar;
        __builtin_amdgcn_s_waitcnt(0);
        unsigned nloc = b.st[0], nx = b.st[1];
        if (nloc == 0u) { xcd_barrier_complete(bar, b.x, nloc, nx); b.st[0] = nloc; b.st[1] = nx; }
        const unsigned old = xb_add(&bar[XB_XSUB(b.x)], 1u);
        const unsigned gen = old / nloc;
        if (old + 1u == (gen + 1u) * nloc) {
            __builtin_amdgcn_fence(__ATOMIC_RELEASE, "agent");
            asm volatile("s_waitcnt vmcnt(0)" ::: "memory");
            const unsigned og = xb_add(&bar[XB_TOP], 1u);
            const unsigned tg = og / nx;
            if (og + 1u == (tg + 1u) * nx) xb_add(&bar[XB_TOPGEN], 1u);
            else XB_SPIN(xb_ld(&bar[XB_TOPGEN]) == tg, bar);
            __builtin_amdgcn_fence(__ATOMIC_ACQUIRE, "agent");
            xb_add(&bar[XB_XGEN(b.x)], 1u);
            asm volatile("s_waitcnt vmcnt(0)" ::: "memory");
        } else {
            XB_SPIN(xb_ld(&bar[XB_XGEN(b.x)]) == gen, bar);
            __builtin_amdgcn_fence(__ATOMIC_ACQUIRE, "agent");
            asm volatile("s_waitcnt vmcnt(0)" ::: "memory");
        }
    }
    __syncthreads();
}

__device__ void d_cvt(const float* __restrict__ in, bf16_t* __restrict__ out, size_t n4) {
  const size_t stride = (size_t)gridDim.x * blockDim.x;
  size_t i = (size_t)blockIdx.x * blockDim.x + TIDX;
  for (; i + 3 * stride < n4; i += 4 * stride) {
    f32x4 v[4];
#pragma unroll
    for (int q = 0; q < 4; ++q) v[q] = ((const f32x4*)in)[i + q * stride];
#pragma unroll
    for (int q = 0; q < 4; ++q) { u32x2 o = {pack2(v[q][0], v[q][1]), pack2(v[q][2], v[q][3])}; ((u32x2*)out)[i + q * stride] = o; }
  }
  for (; i < n4; i += stride) { const f32x4 v = ((const f32x4*)in)[i]; u32x2 o = {pack2(v[0], v[1]), pack2(v[2], v[3])}; ((u32x2*)out)[i] = o; }
}
__device__ void d_cvtT64(int vb, char* smem, const float* __restrict__ W, bf16_t* __restrict__ WT, int K, int N, int NP) {
  float (*tt)[65] = (float (*)[65])smem;
  const int tid = (TIDX & 255);
  const int nbx = NP / 64;
  const int n0 = (vb % nbx) * 64, k0 = (vb / nbx) * 64;
  {
    const int kr = tid >> 4, nc = (tid & 15) * 4;
#pragma unroll
    for (int i = 0; i < 4; ++i) {
      const int k = k0 + kr + 16 * i, n = n0 + nc;
      f32x4 v = {0.f, 0.f, 0.f, 0.f};
      if (n < N) v = *(const f32x4*)(W + (size_t)k * N + n);
      tt[kr + 16 * i][nc] = v[0]; tt[kr + 16 * i][nc + 1] = v[1]; tt[kr + 16 * i][nc + 2] = v[2]; tt[kr + 16 * i][nc + 3] = v[3];
    }
  }
  __syncthreads();
  {
    const int nr = tid >> 3, kc = (tid & 7) * 8;
#pragma unroll
    for (int i = 0; i < 2; ++i) {
      const int nl = nr + 32 * i;
      u32x4 o = {pack2(tt[kc][nl], tt[kc + 1][nl]), pack2(tt[kc + 2][nl], tt[kc + 3][nl]), pack2(tt[kc + 4][nl], tt[kc + 5][nl]), pack2(tt[kc + 6][nl], tt[kc + 7][nl])};
      *(u32x4*)(WT + (size_t)(n0 + nl) * K + k0 + kc) = o;
    }
  }
  __syncthreads();
}

using f32x16 = __attribute__((ext_vector_type(16))) float;
using bf16x8v = __attribute__((ext_vector_type(8))) __bf16;
#define MFMA32(a, b, c) __builtin_amdgcn_mfma_f32_32x32x16_bf16((a), (b), (c), 0, 0, 0)
constexpr float LOG2E = 1.4426950408889634f;
constexpr float NEGB = -1e30f;
DI int pi_perm(int i) { return (i & ~12) | ((i & 8) >> 1) | ((i & 4) << 1); }
DI bf16x8 pack8(float a0, float a1, float a2, float a3, float a4, float a5, float a6, float a7) {
  bf16x8v v = {(__bf16)a0, (__bf16)a1, (__bf16)a2, (__bf16)a3, (__bf16)a4, (__bf16)a5, (__bf16)a6, (__bf16)a7};
  return __builtin_bit_cast(bf16x8, v);
}
__device__ __forceinline__ void d_relayout_tile(int T, char* smem, const bf16_t* __restrict__ proj, int col0, bf16_t* __restrict__ dst, bool isV) {
  bf16_t* Ls = (bf16_t*)smem;
  const int tid = TIDX;
#pragma unroll
  for (int q = 0; q < 2; ++q) {
    const int cidx = tid + q * 512;
    const int g = cidx >> 9, tok = (cidx >> 4) & 31, ch = cidx & 15;
    const u32x4 v = *(const u32x4*)(proj + (size_t)(32 * T + tok) * INWP + col0 + g * 128 + ch * 8);
    *(u32x4*)(Ls + (g * 32 + tok) * 136 + ch * 8) = v;
  }
  __syncthreads();
#pragma unroll
  for (int q = 0; q < 2; ++q) {
    const int oc = tid + q * 512;
    const int g = oc >> 9, r9 = oc & 511, lane = r9 & 63;
    u32x4 o;
    if (!isV) {
      const int s8 = r9 >> 6, i = lane & 31, h = lane >> 5;
      o = *(const u32x4*)(Ls + (g * 32 + pi_perm(i)) * 136 + 16 * s8 + 8 * h);
    } else {
      const int s2 = (r9 >> 6) & 1, dt = r9 >> 7, dd = lane & 31, h = lane >> 5;
      const bf16_t* col = Ls + (g * 32 + 16 * s2 + 8 * h) * 136 + 32 * dt + dd;
      unsigned short e[8];
#pragma unroll
      for (int j = 0; j < 8; ++j) e[j] = col[j * 136];
      o.x = e[0] | ((unsigned)e[1] << 16); o.y = e[2] | ((unsigned)e[3] << 16); o.z = e[4] | ((unsigned)e[5] << 16); o.w = e[6] | ((unsigned)e[7] << 16);
    }
    *(u32x4*)(dst + (((size_t)(g * 512 + T)) * 512 + r9) * 8) = o;
  }
  __syncthreads();
}

struct AttnPtrs {
  const bf16_t* proj; const float* gates;
  const bf16_t *kcf, *vcf, *ksf, *vsf, *kwf, *vwf;
  bf16_t* mix; const float* hng;
};

DI float ex2(float x) { return __builtin_amdgcn_exp2f(x); }
DI void halves(float x, float& lo, float& hi) {
  const unsigned u = __float_as_uint(x);
  auto r = __builtin_amdgcn_permlane32_swap(u, u, false, false);
  lo = __uint_as_float(r[0]); hi = __uint_as_float(r[1]);
}
DI float hmax(float x) { float a, b; halves(x, a, b); return fmaxf(a, b); }
DI float hsum(float x) { float a, b; halves(x, a, b); return a + b; }
DI float dpp_quad(float v, int ctrl_is_xor1) {
  const int iv = __float_as_int(v);
  const int r = ctrl_is_xor1 ? __builtin_amdgcn_update_dpp(iv, iv, 0xB1, 0xF, 0xF, false) : __builtin_amdgcn_update_dpp(iv, iv, 0x4E, 0xF, 0xF, false);
  return __int_as_float(r);
}
DI float quad_sum(float v) { v += dpp_quad(v, 1); v += dpp_quad(v, 0); return v; }
DI void osm_step(const float (&sv)[16], float& m, float& l, f32x16 (&O)[4], float (&p)[16]) {
  float tmax = fmaxf(fmaxf(fmaxf(sv[0], sv[1]), fmaxf(sv[2], sv[3])), fmaxf(fmaxf(sv[4], sv[5]), fmaxf(sv[6], sv[7])));
  tmax = fmaxf(tmax, fmaxf(fmaxf(fmaxf(sv[8], sv[9]), fmaxf(sv[10], sv[11])), fmaxf(fmaxf(sv[12], sv[13]), fmaxf(sv[14], sv[15]))));
  tmax = hmax(tmax);
  if (__ballot(tmax - m > 8.f)) {
    const float mn = fmaxf(m, tmax);
    const float alpha = ex2(m - mn);
    l *= alpha; m = mn;
#pragma unroll
    for (int dt = 0; dt < 4; ++dt)
#pragma unroll
      for (int r = 0; r < 16; ++r) O[dt][r] *= alpha;
  }
  float ps0 = 0.f, ps1 = 0.f;
#pragma unroll
  for (int r = 0; r < 16; r += 2) { const float e0 = ex2(sv[r] - m), e1 = ex2(sv[r + 1] - m); p[r] = e0; p[r + 1] = e1; ps0 += e0; ps1 += e1; }
  l += ps0 + ps1;
}
DI void ot_store(char* otL, int lane, const f32x16 (&O)[4], float sc) {
#pragma unroll
  for (int dt = 0; dt < 4; ++dt) {
    u32x4 a, b;
#pragma unroll
    for (int i = 0; i < 4; ++i) { a[i] = pack2(sc * O[dt][2 * i], sc * O[dt][2 * i + 1]); b[i] = pack2(sc * O[dt][8 + 2 * i], sc * O[dt][8 + 2 * i + 1]); }
    *(u32x4*)(otL + lane * 128 + dt * 32) = a;
    *(u32x4*)(otL + lane * 128 + dt * 32 + 16) = b;
  }
}
DI void ot_accum(const char* otL, int lane, f32x16 (&O)[4], float sc) {
#pragma unroll
  for (int dt = 0; dt < 4; ++dt) {
    u32x4 a = *(const u32x4*)(otL + lane * 128 + dt * 32);
    u32x4 b = *(const u32x4*)(otL + lane * 128 + dt * 32 + 16);
#pragma unroll
    for (int i = 0; i < 4; ++i) {
      const unsigned wa = a[i], wb = b[i];
      O[dt][2 * i] = fmaf(sc, O[dt][2 * i], __uint_as_float(wa << 16));
      O[dt][2 * i + 1] = fmaf(sc, O[dt][2 * i + 1], __uint_as_float(wa & 0xFFFF0000u));
      O[dt][8 + 2 * i] = fmaf(sc, O[dt][8 + 2 * i], __uint_as_float(wb << 16));
      O[dt][8 + 2 * i + 1] = fmaf(sc, O[dt][8 + 2 * i + 1], __uint_as_float(wb & 0xFFFF0000u));
    }
  }
}
DI void zero_o(f32x16 (&O)[4]) {
#pragma unroll
  for (int dt = 0; dt < 4; ++dt)
#pragma unroll
    for (int i = 0; i < 16; ++i) O[dt][i] = 0.f;
}

constexpr int ATT_PW = 8704;
constexpr int ATT_R = 4, ATT_D = 3;
constexpr int ATT_RING = 8 * ATT_PW;
constexpr int ATT_LIST = ATT_RING + ATT_R * 16384;
constexpr int ATT_BUNI = ATT_LIST + 2048;
constexpr int ATT_SMEM = ATT_BUNI + 64;
#define LAS3 __attribute__((address_space(3)))
__device__ __forceinline__ void d_select(const float* impL, unsigned* mskL, unsigned* uniL, int cur) {
  const int lane = TIDX & 63;
  const int stok = lane >> 3, sub = lane & 7;
  unsigned key[32];
#pragma unroll
  for (int i4 = 0; i4 < 8; ++i4) {
    f32x4 v = *(const f32x4*)(impL + stok * 256 + sub * 32 + i4 * 4);
#pragma unroll
    for (int e = 0; e < 4; ++e) {
      const int j = sub * 32 + i4 * 4 + e;
      const bool valid = j <= cur;
      const bool forced = (j == 0) || (j == cur) || (j == cur - 1);
      unsigned kb = forced ? 0xFFFFFF00u : (__float_as_uint(v[e]) & 0xFFFFFF00u);
      key[i4 * 4 + e] = valid ? (kb | (unsigned)(255 - j)) : 0u;
    }
  }
#pragma unroll
  for (int k = 2; k <= 32; k <<= 1) {
#pragma unroll
    for (int jj = k >> 1; jj > 0; jj >>= 1) {
#pragma unroll
      for (int i = 0; i < 32; ++i) {
        const int l2 = i ^ jj;
        if (l2 > i) {
          const bool desc = ((i & k) == 0);
          unsigned a = key[i], b = key[l2];
          unsigned mx = a > b ? a : b, mn = a > b ? b : a;
          key[i] = desc ? mx : mn; key[l2] = desc ? mn : mx;
        }
      }
    }
  }
#pragma unroll
  for (int xm = 1; xm < 8; xm <<= 1) {
    unsigned L[16];
#pragma unroll
    for (int i = 0; i < 16; ++i) { unsigned o = (unsigned)shx_i((int)key[15 - i], xm); L[i] = key[i] > o ? key[i] : o; }
#pragma unroll
    for (int jj = 8; jj > 0; jj >>= 1) {
#pragma unroll
      for (int i = 0; i < 16; ++i) {
        const int l2 = i ^ jj;
        if (l2 > i) { unsigned a = L[i], b = L[l2]; L[i] = a > b ? a : b; L[l2] = a > b ? b : a; }
      }
    }
#pragma unroll
    for (int i = 0; i < 16; ++i) key[i] = L[i];
  }
#pragma unroll
  for (int i = 0; i < 16; ++i) {
    if ((i & 7) == sub) {
      const int j = 255 - (int)(key[i] & 255u);
      if (j <= cur) { atomicOr(&mskL[stok * 8 + (j >> 5)], 1u << (j & 31)); atomicOr(&uniL[j >> 5], 1u << (j & 31)); }
    }
  }
}


DI void att_issue(LAS3 unsigned char* ring, int slot, int w, int lane, const bf16_t* kb, const bf16_t* vb, int tile) {
  const char* ks = (const char*)kb + (size_t)tile * 8192 + w * 1024 + lane * 16;
  const char* vs = (const char*)vb + (size_t)tile * 8192 + w * 1024 + lane * 16;
  __builtin_amdgcn_global_load_lds((const unsigned*)ks, (LAS3 unsigned*)(ring + slot * 16384 + w * 1024), 16, 0, 0);
  __builtin_amdgcn_global_load_lds((const unsigned*)vs, (LAS3 unsigned*)(ring + slot * 16384 + 8192 + w * 1024), 16, 0, 0);
}
DI f32x16 qk_lds(LAS3 const unsigned char* kt, const bf16x8 (&qf)[8], int lane) {
  f32x16 acc;
#pragma unroll
  for (int i = 0; i < 16; ++i) acc[i] = 0.f;
#pragma unroll
  for (int s8 = 0; s8 < 8; ++s8) {
    const bf16x8 kf = *(LAS3 const bf16x8*)(kt + s8 * 1024 + lane * 16);
    acc = MFMA32(kf, qf[s8], acc);
  }
  return acc;
}
DI void pv_lds(LAS3 const unsigned char* vt, const float (&p)[16], f32x16 (&O)[4], int lane) {
  const bf16x8 pf0 = pack8(p[0], p[1], p[2], p[3], p[4], p[5], p[6], p[7]);
  const bf16x8 pf1 = pack8(p[8], p[9], p[10], p[11], p[12], p[13], p[14], p[15]);
#pragma unroll
  for (int dt = 0; dt < 4; ++dt) {
    const bf16x8 v0 = *(LAS3 const bf16x8*)(vt + (dt * 2) * 1024 + lane * 16);
    const bf16x8 v1 = *(LAS3 const bf16x8*)(vt + (dt * 2 + 1) * 1024 + lane * 16);
    O[dt] = MFMA32(v0, pf0, O[dt]);
    O[dt] = MFMA32(v1, pf1, O[dt]);
  }
}

__device__ __forceinline__ void d_attn_block(int B, int g, char* smem, const AttnPtrs& P) {
  const int tid = TIDX, lane = tid & 63, w = tid >> 6;
  const int c = lane & 31, h = lane >> 5, tokl = c >> 2, r = c & 3;
  const int tok0 = 64 * B + 8 * w;
  const int t = tok0 + tokl, hd = g * 4 + r;
  const float slope2 = exp2f(-(float)(hd + 1)) * LOG2E;
  const float c1 = QSCALE * LOG2E;
  const float ninf = -__builtin_inff();
  char* wsm = smem + w * ATT_PW;
  float* impL = (float*)wsm;
  char* otL = wsm;
  unsigned* mskL = (unsigned*)(wsm + 8192);
  unsigned* uniL = mskL + 64;
  LAS3 unsigned char* ring = (LAS3 unsigned char*)(smem + ATT_RING);
  unsigned short* tl = (unsigned short*)(smem + ATT_LIST);
  unsigned* buni = (unsigned*)(smem + ATT_BUNI);
  const bf16_t* kcf = P.kcf + (size_t)g * 32 * 4096;
  const bf16_t* vcf = P.vcf + (size_t)g * 32 * 4096;
  const bf16_t* ksf = P.ksf + (size_t)g * 512 * 4096;
  const bf16_t* vsf = P.vsf + (size_t)g * 512 * 4096;
  const bf16_t* kwf = P.kwf + (size_t)g * 512 * 4096;
  const bf16_t* vwf = P.vwf + (size_t)g * 512 * 4096;
  bf16x8 qf[8];
  {
    const bf16_t* qrow = P.proj + (size_t)t * INWP + OFF_Q + hd * 128 + 8 * h;
#pragma unroll
    for (int s8 = 0; s8 < 8; ++s8) qf[s8] = *(const bf16x8*)(qrow + 16 * s8);
  }
  const float* gt = P.gates + (size_t)t * 24 + hd * 3;
  const float g0 = gt[0], g1 = gt[1], g2 = gt[2];
  {
    unsigned z0 = 0u;
    asm volatile("" : "+v"(z0));
    u32x4 z = {z0, z0, z0, z0};
#pragma unroll
    for (int i = 0; i < 8; ++i) *(u32x4*)(wsm + (i * 64 + lane) * 16) = z;
    if (lane < 18) *(u32x4*)(wsm + 8192 + lane * 16) = z;
    if (tid < 8) buni[tid] = z0;
  }
  f32x16 Ob[4];
  zero_o(Ob);
  const int nmax = (t >= 31) ? ((t - 31) >> 4) : -1;
  const int nmaxw = (tok0 + 7 >= 31) ? ((tok0 + 7 - 31) >> 4) : -1;
  const int nminw = (tok0 >= 31) ? ((tok0 - 31) >> 4) : -1;
  const int ntcw = (nmaxw + 32) >> 5;
  const int ntcB = (((64 * B + 63 - 31) >> 4) + 32) >> 5;
  const float sl16 = slope2 * 16.f;
  float mC = NEGB, lC = 0.f, invC = 0.f, carry = 0.f;
  {
    const int n = 2 * ntcB;
    asm volatile("s_waitcnt vmcnt(0)" ::: "memory");
#define A_TILE(i_) (((i_) < ntcB) ? (ntcB - 1 - (i_)) : ((i_) - ntcB))
    att_issue(ring, 0, w, lane, kcf, vcf, A_TILE(0));
    if (n > 1) att_issue(ring, 1, w, lane, kcf, vcf, A_TILE(1));
#pragma unroll 1
    for (int i = 0; i < n; ++i) {
      if ((i & 1) == 0) {
        asm volatile("s_waitcnt vmcnt(0)" ::: "memory");
        __builtin_amdgcn_s_barrier();
        asm volatile("" ::: "memory");
        if (i + 2 < n) att_issue(ring, (i + 2) & 3, w, lane, kcf, vcf, A_TILE(i + 2));
        if (i + 3 < n) att_issue(ring, (i + 3) & 3, w, lane, kcf, vcf, A_TILE(i + 3));
      }
      const int T = A_TILE(i);
      if (T >= ntcw) continue;
      LAS3 const unsigned char* slot = ring + (i % ATT_R) * 16384;
      const f32x16 acc = qk_lds(slot, qf, lane);
      const float base = slope2 * (float)(512 * T + 128 * h) + slope2 * (15.5f - (float)t);
      const int nb = 32 * T + 8 * h;
      const bool full = (32 * T + 31 <= nminw);
      float sv[16];
#pragma unroll
      for (int rg = 0; rg < 16; ++rg) { const int kk = (rg & 7) + 16 * (rg >> 3); sv[rg] = fmaf(acc[rg], c1, fmaf(sl16, (float)kk, base)); }
      if (!full) {
#pragma unroll
        for (int rg = 0; rg < 16; ++rg) { const int kk = (rg & 7) + 16 * (rg >> 3); sv[rg] = (nb + kk <= nmax) ? sv[rg] : ninf; }
      }
      if (i < ntcB) {
        float tmax = fmaxf(fmaxf(fmaxf(sv[0], sv[1]), fmaxf(sv[2], sv[3])), fmaxf(fmaxf(sv[4], sv[5]), fmaxf(sv[6], sv[7])));
        tmax = fmaxf(tmax, fmaxf(fmaxf(fmaxf(sv[8], sv[9]), fmaxf(sv[10], sv[11])), fmaxf(fmaxf(sv[12], sv[13]), fmaxf(sv[14], sv[15]))));
        tmax = hmax(tmax);
        const float mn = fmaxf(mC, tmax);
        float ps = 0.f;
#pragma unroll
        for (int rg = 0; rg < 16; ++rg) ps += ex2(sv[rg] - mn);
        lC = lC * ex2(mC - mn) + ps; mC = mn;
      } else {
        if (T == 0) { lC = hsum(lC); invC = (lC > 0.f) ? 1.f / lC : 0.f; }
        float p[16];
#pragma unroll
        for (int rg = 0; rg < 16; ++rg) p[rg] = ex2(sv[rg] - mC) * invC;
        float Ga = (p[0] + p[1]) + (p[2] + p[3]), Gb = (p[4] + p[5]) + (p[6] + p[7]);
        float Gc = (p[8] + p[9]) + (p[10] + p[11]), Gd = (p[12] + p[13]) + (p[14] + p[15]);
        float xb, xd; { float a_, b_; halves(p[7], a_, b_); xb = h ? a_ : b_; halves(p[15], a_, b_); xd = h ? a_ : b_; }
        float ia = Ga + (h ? xb : carry);
        float ib = Gb + p[3];
        float ic = Gc + (h ? xd : xb);
        float id = Gd + p[11];
        carry = xd;
        ia = quad_sum(ia); ib = quad_sum(ib); ic = quad_sum(ic); id = quad_sum(id);
        {
          float val = (r == 0) ? ia : (r == 1) ? ib : (r == 2) ? ic : id;
          int j = 8 * T + 2 * h + ((r == 0) ? 0 : (r == 1) ? 1 : (r == 2) ? 4 : 5);
          impL[tokl * 256 + j] = val;
        }
        pv_lds(slot + 8192, p, Ob, lane);
      }
    }
#undef A_TILE
  }
  const int cur = B;
  d_select(impL, mskL, uniL, cur);
  ot_store(otL, lane, Ob, g0);
  zero_o(Ob);
  if (lane < 8) { const unsigned u = uniL[lane]; if (u) atomicOr(&buni[lane], u); }
  __syncthreads();
  int nslc = 0, ntl = 0;
  {
    for (int iw = 7; iw >= 0; --iw) {
      unsigned iuw = __builtin_amdgcn_readfirstlane(buni[iw]);
      while (iuw) {
        const int bit = 31 - __builtin_clz(iuw);
        iuw &= ~(1u << bit);
        const int bb = 32 * iw + bit;
        if (bb < B) { if (lane == 0) tl[ntl] = (unsigned short)(2 * bb + 1); ++ntl; }
        else { if (lane == 0) tl[ntl] = (unsigned short)(2 * bb + 1); ++ntl; }
        if (lane == 0) tl[ntl] = (unsigned short)(2 * bb);
        ++ntl;
      }
    }
    nslc = ntl;
    const int ThiB = 2 * B + 1, TloB = ((64 * B - 511 > 0) ? (64 * B - 511) : 0) >> 5;
    for (int T = ThiB; T >= TloB; --T) { if (lane == 0) tl[ntl] = (unsigned short)T; ++ntl; }
  }
  float m = NEGB, l = 0.f;
  {
    const int n = ntl;
    const int Tlow = ((tok0 - 511 > 0) ? (tok0 - 511) : 0) >> 5, Thiw = (tok0 + 7) >> 5;
#define B_ISSUE(j_, slot_) { const int e_ = __builtin_amdgcn_readfirstlane((int)tl[j_]); if ((j_) < nslc) att_issue(ring, slot_, w, lane, ksf, vsf, e_); else att_issue(ring, slot_, w, lane, kwf, vwf, e_); }
    B_ISSUE(0, 0)
    if (n > 1) B_ISSUE(1, 1)
#pragma unroll 1
    for (int i = 0; i < n; ++i) {
      if ((i & 1) == 0) {
        asm volatile("s_waitcnt vmcnt(0)" ::: "memory");
        __builtin_amdgcn_s_barrier();
        asm volatile("" ::: "memory");
        if (i + 2 < n) B_ISSUE(i + 2, (i + 2) & 3)
        if (i + 3 < n) B_ISSUE(i + 3, (i + 3) & 3)
      }
      if (i == nslc) {
        l = hsum(l);
        const float inv = (l > 0.f) ? g1 / l : 0.f;
        ot_accum(otL, lane, Ob, inv);
        ot_store(otL, lane, Ob, 1.f);
        zero_o(Ob);
        m = NEGB; l = 0.f;
      }
      const int T = __builtin_amdgcn_readfirstlane((int)tl[i]);
      const int pos0 = 32 * T, pb = pos0 + 8 * h;
      bool full; bool mine = true;
      if (i < nslc) {
        const int bb = T >> 1;
        const unsigned uw = __builtin_amdgcn_readfirstlane(uniL[bb >> 5]);
        if (!((uw >> (bb & 31)) & 1u) || pos0 > tok0 + 7) continue;
        mine = (mskL[tokl * 8 + (bb >> 5)] >> (bb & 31)) & 1u;
        full = (pos0 + 31 <= tok0) && (__ballot(!mine) == 0ull);
      } else {
        if (T < Tlow || T > Thiw) continue;
        full = (pos0 + 31 <= tok0) && (pos0 >= tok0 + 7 - 511);
      }
      LAS3 const unsigned char* slot = ring + (i % ATT_R) * 16384;
      const f32x16 acc = qk_lds(slot, qf, lane);
      const float base = slope2 * (float)(pos0 + 8 * h - t);
      float sv[16], p[16];
#pragma unroll
      for (int rg = 0; rg < 16; ++rg) { const int kk = (rg & 7) + 16 * (rg >> 3); sv[rg] = fmaf(acc[rg], c1, fmaf(slope2, (float)kk, base)); }
      if (!full) {
        if (i < nslc) {
#pragma unroll
          for (int rg = 0; rg < 16; ++rg) { const int kk = (rg & 7) + 16 * (rg >> 3); sv[rg] = (mine && (pb + kk <= t)) ? sv[rg] : ninf; }
        } else {
#pragma unroll
          for (int rg = 0; rg < 16; ++rg) { const int kk = (rg & 7) + 16 * (rg >> 3); const int dw = t - (pb + kk); sv[rg] = ((dw >= 0) && (dw < 512)) ? sv[rg] : ninf; }
        }
      }
      osm_step(sv, m, l, Ob, p);
      pv_lds(slot + 8192, p, Ob, lane);
    }
#undef B_ISSUE
    l = hsum(l);
    const float inv = (l > 0.f) ? g2 / l : 0.f;
    ot_accum(otL, lane, Ob, inv);
  }
  {
    float ss = 0.f;
#pragma unroll
    for (int dt = 0; dt < 4; ++dt)
#pragma unroll
      for (int i = 0; i < 16; ++i) ss = fmaf(Ob[dt][i], Ob[dt][i], ss);
    ss = hsum(ss);
    const float rs = rsqrtf(ss * (1.f / 128.f) + 1e-6f);
    bf16_t* orow = P.mix + (size_t)t * DM + hd * 128 + 4 * h;
    const float* grow = P.hng + hd * 128 + 4 * h;
#pragma unroll
    for (int dt = 0; dt < 4; ++dt)
#pragma unroll
      for (int a = 0; a < 4; ++a) {
        const f32x4 gv = *(const f32x4*)(grow + 32 * dt + 8 * a);
        u32x2 wv2 = {pack2(Ob[dt][4 * a] * rs * gv[0], Ob[dt][4 * a + 1] * rs * gv[1]), pack2(Ob[dt][4 * a + 2] * rs * gv[2], Ob[dt][4 * a + 3] * rs * gv[3])};
        *(u32x2*)(orow + 32 * dt + 8 * a) = wv2;
      }
  }
  asm volatile("s_waitcnt vmcnt(0)" ::: "memory");
  __syncthreads();
}

__device__ void d_convmix(int t, int tl, const bf16_t* __restrict__ proj, const float* __restrict__ convw, const float* __restrict__ hng,
                          bf16_t* __restrict__ mix) {
  const int c = tl * 8;
  float acc[8];
#pragma unroll
  for (int i = 0; i < 8; ++i) acc[i] = 0.f;
#pragma unroll
  for (int j = 0; j < 3; ++j) {
    const int tt = t - 2 + j;
    if (tt >= 0) {
      const u32x4 cu = *(const u32x4*)(proj + (size_t)tt * INWP + OFF_C + c);
      const u32x4 uu = *(const u32x4*)(proj + (size_t)tt * INWP + OFF_U + c);
      const f32x4 w0 = *(const f32x4*)(convw + j * 1024 + c), w1 = *(const f32x4*)(convw + j * 1024 + c + 4);
#pragma unroll
      for (int i = 0; i < 4; ++i) {
        const unsigned a = cu[i], b = uu[i];
        const float wl = (i < 2) ? w0[2 * i] : w1[2 * i - 4], wh = (i < 2) ? w0[2 * i + 1] : w1[2 * i - 3];
        acc[2 * i] = fmaf(wl * __uint_as_float(a << 16), __uint_as_float(b << 16), acc[2 * i]);
        acc[2 * i + 1] = fmaf(wh * __uint_as_float(a & 0xFFFF0000u), __uint_as_float(b & 0xFFFF0000u), acc[2 * i + 1]);
      }
    }
  }
  const u32x4 bb = *(const u32x4*)(proj + (size_t)t * INWP + OFF_B + c);
  float ss = 0.f;
#pragma unroll
  for (int i = 0; i < 4; ++i) {
    const unsigned b = bb[i];
    acc[2 * i] *= __uint_as_float(b << 16); acc[2 * i + 1] *= __uint_as_float(b & 0xFFFF0000u);
    ss = fmaf(acc[2 * i], acc[2 * i], ss); ss = fmaf(acc[2 * i + 1], acc[2 * i + 1], ss);
  }
  ss += shx(ss, 8); ss += shx(ss, 4); ss += shx(ss, 2); ss += shx(ss, 1);
  const float rs = rsqrtf(ss * (1.f / 128.f) + 1e-6f);
  const f32x4 g0 = *(const f32x4*)(hng + 1024 + c), g1 = *(const f32x4*)(hng + 1024 + c + 4);
  u32x4 o = {pack2(acc[0] * rs * g0[0], acc[1] * rs * g0[1]), pack2(acc[2] * rs * g0[2], acc[3] * rs * g0[3]),
             pack2(acc[4] * rs * g1[0], acc[5] * rs * g1[1]), pack2(acc[6] * rs * g1[2], acc[7] * rs * g1[3])};
  *(u32x4*)(mix + (size_t)t * DM + 1024 + c) = o;
}

__device__ void d_ln_wave(int t, bf16_t* __restrict__ yh, const float* __restrict__ gam, const float* __restrict__ bet) {
  const int lane = TIDX & 63;
  float v[32];
#pragma unroll
  for (int i = 0; i < 4; ++i) {
    const u32x4 w = *(const u32x4*)(yh + (size_t)t * DM + 512 * i + 8 * lane);
#pragma unroll
    for (int j = 0; j < 4; ++j) { const unsigned ww = w[j]; v[i * 8 + 2 * j] = __uint_as_float(ww << 16); v[i * 8 + 2 * j + 1] = __uint_as_float(ww & 0xFFFF0000u); }
  }
  float s = 0.f;
#pragma unroll
  for (int i = 0; i < 32; ++i) s += v[i];
  s = wave_sum(s);
  const float mu = s * (1.f / DM);
  float q = 0.f;
#pragma unroll
  for (int i = 0; i < 32; ++i) { const float d = v[i] - mu; q = fmaf(d, d, q); }
  q = wave_sum(q);
  const float rs = rsqrtf(q * (1.f / DM) + 1e-5f);
#pragma unroll
  for (int i = 0; i < 4; ++i) {
    const int cb = 512 * i + 8 * lane;
    const f32x4 g0 = *(const f32x4*)(gam + cb), g1 = *(const f32x4*)(gam + cb + 4), b0 = *(const f32x4*)(bet + cb), b1 = *(const f32x4*)(bet + cb + 4);
    u32x4 o = {pack2((v[i * 8 + 0] - mu) * rs * g0[0] + b0[0], (v[i * 8 + 1] - mu) * rs * g0[1] + b0[1]), pack2((v[i * 8 + 2] - mu) * rs * g0[2] + b0[2], (v[i * 8 + 3] - mu) * rs * g0[3] + b0[3]),
               pack2((v[i * 8 + 4] - mu) * rs * g1[0] + b1[0], (v[i * 8 + 5] - mu) * rs * g1[1] + b1[1]), pack2((v[i * 8 + 6] - mu) * rs * g1[2] + b1[2], (v[i * 8 + 7] - mu) * rs * g1[3] + b1[3])};
    *(u32x4*)(yh + (size_t)t * DM + cb) = o;
  }
}

__device__ void d_cvt_w1f(size_t c, const float* __restrict__ w1, bf16_t* __restrict__ w1f) {
  const int lane = c & 63, ks = (c >> 6) & 255, ct = c >> 14;
  const int col = lane & 31, h = lane >> 5;
  bf16_t v[8];
#pragma unroll
  for (int j = 0; j < 8; ++j) v[j] = f2bf(w1[(size_t)(16 * ks + 8 * h + j) * 512 + 32 * ct + col]);
  u32x4 o; o.x = v[0] | ((unsigned)v[1] << 16); o.y = v[2] | ((unsigned)v[3] << 16); o.z = v[4] | ((unsigned)v[5] << 16); o.w = v[6] | ((unsigned)v[7] << 16);
  *(u32x4*)(w1f + c * 8) = o;
}
__device__ void d_cvt_w2f(size_t c, const float* __restrict__ w2, bf16_t* __restrict__ w2f) {
  const int lane = c & 63, s = (c >> 6) & 31, ct = c >> 11;
  const int col = lane & 31, h = lane >> 5;
  bf16_t v[8];
#pragma unroll
  for (int j = 0; j < 8; ++j) v[j] = f2bf(w2[(size_t)(16 * s + 8 * h + j) * 128 + 32 * ct + col]);
  u32x4 o; o.x = v[0] | ((unsigned)v[1] << 16); o.y = v[2] | ((unsigned)v[3] << 16); o.z = v[4] | ((unsigned)v[5] << 16); o.w = v[6] | ((unsigned)v[7] << 16);
  *(u32x4*)(w2f + c * 8) = o;
}
__device__ __forceinline__ void d_compress_unit(int rt, char* smem, const bf16_t* __restrict__ proj, int col0, const float* __restrict__ pos,
                                const bf16_t* __restrict__ w1f, const float* __restrict__ b1, const bf16_t* __restrict__ w2f,
                                bf16_t* __restrict__ outf, bool isV) {
  bf16_t* Xs = (bf16_t*)smem;
  bf16_t* Hs = (bf16_t*)(smem + 2 * 8704);
  const int tid = TIDX, lane = tid & 63, w = tid >> 6, c = lane & 31, h = lane >> 5;
  const int R0 = rt * 32;
  const int srow = tid >> 4, sch = tid & 15;
  const int grow = R0 + srow, sn = grow >> 1, sg = grow & 1;
  const bool svalid = grow < 2046;
  const bf16_t* sp = proj + (size_t)(16 * sn) * INWP + col0 + sg * 128 + sch * 8;
  f32x16 acc0, acc1;
#pragma unroll
  for (int i = 0; i < 16; ++i) { acc0[i] = 0.f; acc1[i] = 0.f; }
  u32x4 rx = {0u, 0u, 0u, 0u}; f32x4 rp0, rp1;
#define STAGE_WRITE(buf)                                                                                   \
  {                                                                                                        \
    u32x4 o_;                                                                                              \
    _Pragma("unroll") for (int i = 0; i < 4; ++i) {                                                        \
      const unsigned wv_ = rx[i];                                                                          \
      const float lo = __uint_as_float(wv_ << 16) + ((i < 2) ? rp0[2 * i] : rp1[2 * i - 4]);               \
      const float hi = __uint_as_float(wv_ & 0xFFFF0000u) + ((i < 2) ? rp0[2 * i + 1] : rp1[2 * i - 3]);   \
      o_[i] = pack2(lo, hi);                                                                               \
    }                                                                                                      \
    *(u32x4*)(Xs + (buf) * 4352 + srow * 136 + sch * 8) = o_;                                              \
  }
  if (svalid) rx = *(const u32x4*)(sp);
  rp0 = *(const f32x4*)(pos + sch * 8); rp1 = *(const f32x4*)(pos + sch * 8 + 4);
  STAGE_WRITE(0)
  __syncthreads();
  const bf16_t* wb0 = w1f + ((size_t)(2 * w) * 256 * 64 + lane) * 8;
  const bf16_t* wb1 = w1f + ((size_t)(2 * w + 1) * 256 * 64 + lane) * 8;
  bf16x8 bA[16], bB[16];
#define CMP_LOADB(BUF, L)                                                                      \
  _Pragma("unroll") for (int s8 = 0; s8 < 8; ++s8) {                                           \
    BUF[2 * s8] = *(const bf16x8*)(wb0 + (size_t)(8 * (L) + s8) * 512);                        \
    BUF[2 * s8 + 1] = *(const bf16x8*)(wb1 + (size_t)(8 * (L) + s8) * 512);                    \
  }
#define CMP_CHUNK(BUF, L)                                                                      \
  {                                                                                            \
    if ((L) + 1 < 32) {                                                                        \
      if (svalid) rx = *(const u32x4*)(sp + (size_t)((L) + 1) * INWP);                         \
      rp0 = *(const f32x4*)(pos + ((L) + 1) * 128 + sch * 8); rp1 = *(const f32x4*)(pos + ((L) + 1) * 128 + sch * 8 + 4); \
    }                                                                                          \
    const bf16_t* xa = Xs + ((L) & 1) * 4352 + c * 136 + 8 * h;                                \
    _Pragma("unroll") for (int s8 = 0; s8 < 8; ++s8) {                                         \
      const bf16x8 a = *(const bf16x8*)(xa + 16 * s8);                                         \
      acc0 = MFMA32(a, BUF[2 * s8], acc0);                                                     \
      acc1 = MFMA32(a, BUF[2 * s8 + 1], acc1);                                                 \
    }                                                                                          \
    if ((L) + 1 < 32) STAGE_WRITE(((L) + 1) & 1)                                               \
    __syncthreads();                                                                           \
  }
  CMP_LOADB(bA, 0)
#pragma unroll 1
  for (int l = 0; l < 32; l += 2) {
    CMP_LOADB(bB, l + 1)
    __builtin_amdgcn_sched_barrier(0);
    CMP_CHUNK(bA, l)
    { const int ln = (l + 2 < 32) ? l + 2 : l;
      CMP_LOADB(bA, ln) }
    __builtin_amdgcn_sched_barrier(0);
    CMP_CHUNK(bB, l + 1)
  }
#undef CMP_LOADB
#undef CMP_CHUNK
  {
    const float bb0 = b1[64 * w + c], bb1 = b1[64 * w + 32 + c];
#pragma unroll
    for (int rg = 0; rg < 16; ++rg) {
      const int row = (rg & 3) + 8 * (rg >> 2) + 4 * h;
      Hs[row * 520 + 64 * w + c] = f2bf(gelu_tanh(acc0[rg] + bb0));
      Hs[row * 520 + 64 * w + 32 + c] = f2bf(gelu_tanh(acc1[rg] + bb1));
    }
  }
  __syncthreads();
  if (w < 4) {
    f32x16 o2;
#pragma unroll
    for (int i = 0; i < 16; ++i) o2[i] = 0.f;
    const bf16_t* ha = Hs + c * 520 + 8 * h;
    const bf16_t* wb = w2f + ((size_t)w * 32 * 64 + lane) * 8;
#pragma unroll 8
    for (int s2 = 0; s2 < 32; ++s2) {
      const bf16x8 a = *(const bf16x8*)(ha + 16 * s2);
      const bf16x8 b = *(const bf16x8*)(wb + (size_t)s2 * 512);
      o2 = MFMA32(a, b, o2);
    }
    const int d = 32 * w + c;
#pragma unroll
    for (int rg = 0; rg < 16; ++rg) {
      const int row = R0 + (rg & 3) + 8 * (rg >> 2) + 4 * h;
      const int n = row >> 1, g = row & 1;
      const bf16_t val = (row < 2046) ? f2bf(o2[rg]) : (bf16_t)0;
      const int T = n >> 5, nn = n & 31;
      size_t idx;
      if (!isV) idx = ((((size_t)(g * 32 + T) * 8 + (d >> 4)) * 64 + (pi_perm(nn) + 32 * ((d >> 3) & 1))) * 8 + (d & 7));
      else idx = (((((size_t)(g * 32 + T) * 4 + (d >> 5)) * 2 + (nn >> 4)) * 64 + ((d & 31) + 32 * ((nn >> 3) & 1))) * 8 + (nn & 7));
      outf[idx] = val;
    }
  }
  __syncthreads();
}


DI unsigned f2sort(float f) { unsigned u = __float_as_uint(f); return u ^ ((unsigned)((int)u >> 31) | 0x80000000u); }
DI float sort2f(unsigned k) { unsigned u = (k & 0x80000000u) ? (k ^ 0x80000000u) : ~k; return __uint_as_float(u); }
template <int N>
DI void bitonic_sort_desc(unsigned (&key)[N]) {
#pragma unroll
  for (int k = 2; k <= N; k <<= 1) {
#pragma unroll
    for (int jj = k >> 1; jj > 0; jj >>= 1) {
#pragma unroll
      for (int i = 0; i < N; ++i) {
        const int l2 = i ^ jj;
        if (l2 > i) {
          const bool desc = ((i & k) == 0);
          unsigned a = key[i], b = key[l2];
          unsigned mx = a > b ? a : b, mn = a > b ? b : a;
          key[i] = desc ? mx : mn; key[l2] = desc ? mn : mx;
        }
      }
    }
  }
}
DI void merge_top16(unsigned (&a)[16], const unsigned (&b)[16]) {
#pragma unroll
  for (int i = 0; i < 16; ++i) { unsigned o = b[15 - i]; a[i] = a[i] > o ? a[i] : o; }
#pragma unroll
  for (int jj = 8; jj > 0; jj >>= 1) {
#pragma unroll
    for (int i = 0; i < 16; ++i) {
      const int l2 = i ^ jj;
      if (l2 > i) { unsigned x = a[i], y = a[l2]; a[i] = x > y ? x : y; a[l2] = x > y ? y : x; }
    }
  }
}
__device__ void d_cvt_subk(size_t c, const float* __restrict__ subk, bf16_t* __restrict__ skf) {
  int lane = c & 63, s = (c >> 6) & 7, kt = (c >> 9) & 3, hc = c >> 11;
  int i = lane & 31, h = lane >> 5;
  const float* src = subk + ((size_t)hc * 128 + 32 * kt + i) * 128 + 16 * s + 8 * h;
  bf16_t v[8];
#pragma unroll
  for (int j = 0; j < 8; ++j) v[j] = f2bf(src[j]);
  u32x4 o; o.x = v[0] | ((unsigned)v[1] << 16); o.y = v[2] | ((unsigned)v[3] << 16); o.z = v[4] | ((unsigned)v[5] << 16); o.w = v[6] | ((unsigned)v[7] << 16);
  *(u32x4*)(skf + c * 8) = o;
}

struct EpiProjG {
  static constexpr bool PERM = true, AFTER_DRAIN = false;
  bf16_t* proj; float* gates;
  DI void operator()(const f32x4 (&acc)[2][2][4][2], const pg8::Unit& u, int wr, int wc, int fr, int fq) const {
#pragma unroll
    for (int ai = 0; ai < 2; ++ai)
#pragma unroll
      for (int m = 0; m < 4; ++m) {
        const int row = u.pm * 256 + ai * 128 + wr * 64 + m * 16 + fr;
#pragma unroll
        for (int bj = 0; bj < 2; ++bj) {
          const int c0 = u.pn * 256 + bj * 128 + wc * 32 + 8 * fq;
          const f32x4 v0 = acc[ai][bj][m][0], v1 = acc[ai][bj][m][1];
          if (c0 < INW) {
            u32x4 w = {pack2(v0[0], v0[1]), pack2(v0[2], v0[3]), pack2(v1[0], v1[1]), pack2(v1[2], v1[3])};
            *(u32x4*)(proj + (size_t)row * INWP + c0) = w;
          }
          if (c0 >= OFF_G && c0 < OFF_G + 24) {
            f32x4 g0, g1;
#pragma unroll
            for (int j = 0; j < 4; ++j) { g0[j] = 1.f / (1.f + __expf(-v0[j])); g1[j] = 1.f / (1.f + __expf(-v1[j])); }
            *(f32x4*)(gates + (size_t)row * 24 + (c0 - OFF_G)) = g0;
            *(f32x4*)(gates + (size_t)row * 24 + (c0 - OFF_G) + 4) = g1;
          }
        }
      }
  }
};
struct EpiResG {
  static constexpr bool PERM = false, AFTER_DRAIN = false;
  bf16_t* YB;
  DI void operator()(const f32x4 (&acc)[2][2][4][2], const pg8::Unit& u, int wr, int wc, int fr, int fq) const {
#pragma unroll
    for (int ai = 0; ai < 2; ++ai)
#pragma unroll
      for (int m = 0; m < 4; ++m) {
        const size_t ro = (size_t)(u.pm * 256 + ai * 128 + wr * 64 + m * 16 + fr) * DM + u.pn * 256 + wc * 32 + 4 * fq;
#pragma unroll
        for (int bj = 0; bj < 2; ++bj)
#pragma unroll
          for (int n = 0; n < 2; ++n) {
            const u32x2 xw = *(const u32x2*)(YB + ro + bj * 128 + n * 16);
            const f32x4 xv = {__uint_as_float(xw[0] << 16), __uint_as_float(xw[0] & 0xFFFF0000u), __uint_as_float(xw[1] << 16), __uint_as_float(xw[1] & 0xFFFF0000u)};
            const f32x4 yv = ALPHA * xv + acc[ai][bj][m][n];
            u32x2 o = {pack2(yv[0], yv[1]), pack2(yv[2], yv[3])};
            *(u32x2*)(YB + ro + bj * 128 + n * 16) = o;
          }
      }
  }
};
struct EpiF32G {
  static constexpr bool PERM = false, AFTER_DRAIN = false;
  float* C; int ldc;
  DI void operator()(const f32x4 (&acc)[2][2][4][2], const pg8::Unit& u, int wr, int wc, int fr, int fq) const {
#pragma unroll
    for (int ai = 0; ai < 2; ++ai)
#pragma unroll
      for (int m = 0; m < 4; ++m) {
        const size_t ro = (size_t)(u.pm * 256 + ai * 128 + wr * 64 + m * 16 + fr) * ldc + u.pn * 256 + wc * 32 + 4 * fq;
#pragma unroll
        for (int bj = 0; bj < 2; ++bj)
#pragma unroll
          for (int n = 0; n < 2; ++n) *(f32x4*)(C + ro + bj * 128 + n * 16) = acc[ai][bj][m][n];
      }
  }
};
struct EpiRouteG {
  static constexpr bool PERM = false, AFTER_DRAIN = true;
  const bf16_t* skf; unsigned* tops;
  DI void operator()(const f32x4 (&)[2][2][4][2], const pg8::Unit&, int, int, int, int) const {}
  DI void fused(const f32x4 (&acc)[2][2][4][2], const pg8::Unit& u, int wr, int wc, int fr, int fq, PG8_LAS unsigned char* ldsp, int, int) const {
    const int lane = fr | (fq << 4), wid = wr * 4 + wc;
    bf16_t* Qs = (bf16_t*)ldsp;
#pragma unroll
    for (int ai = 0; ai < 2; ++ai)
#pragma unroll
      for (int m = 0; m < 4; ++m) {
        const int row = ai * 128 + wr * 64 + m * 16 + fr;
#pragma unroll
        for (int bj = 0; bj < 2; ++bj)
#pragma unroll
          for (int n = 0; n < 2; ++n) {
            const f32x4 v = acc[ai][bj][m][n];
            u32x2 w = {pack2(v[0], v[1]), pack2(v[2], v[3])};
            *(u32x2*)(Qs + row * 264 + bj * 128 + wc * 32 + n * 16 + 4 * fq) = w;
          }
      }
    __syncthreads();
    const int c = lane & 31, h = lane >> 5;
#pragma unroll 1
    for (int half = 0; half < 2; ++half) {
      const int hc = u.pn * 2 + half;
      const bf16_t* sk = skf + (size_t)hc * 4 * 4096;
      const bf16_t* qp = Qs + (wid * 32 + c) * 264 + half * 128 + 8 * h;
      unsigned k0[16], k1[16];
#define ROUTE_KT(KT, KA)                                                                        \
      {                                                                                         \
        f32x16 sc;                                                                              \
        _Pragma("unroll") for (int i = 0; i < 16; ++i) sc[i] = 0.f;                             \
        _Pragma("unroll") for (int s = 0; s < 8; ++s) {                                         \
          bf16x8 af = *(const bf16x8*)(sk + (KT) * 4096 + s * 512 + lane * 8);                  \
          bf16x8 bq = *(const bf16x8*)(qp + 16 * s);                                            \
          sc = __builtin_amdgcn_mfma_f32_32x32x16_bf16(af, bq, sc, 0, 0, 0);                    \
        }                                                                                       \
        _Pragma("unroll") for (int rg = 0; rg < 16; ++rg) {                                     \
          const int kidx = 32 * (KT) + (rg & 3) + 8 * (rg >> 2) + 4 * h;                        \
          KA[rg] = (f2sort(sc[rg]) & 0xFFFFFF80u) | (unsigned)(127 - kidx);                     \
        }                                                                                       \
        bitonic_sort_desc<16>(KA);                                                              \
      }
      ROUTE_KT(0, k0)
      __builtin_amdgcn_sched_barrier(0);
      ROUTE_KT(1, k1)
      merge_top16(k0, k1);
      __builtin_amdgcn_sched_barrier(0);
      ROUTE_KT(2, k1)
      merge_top16(k0, k1);
      __builtin_amdgcn_sched_barrier(0);
      ROUTE_KT(3, k1)
      merge_top16(k0, k1);
      __builtin_amdgcn_sched_barrier(0);
#undef ROUTE_KT
#pragma unroll
      for (int i = 0; i < 16; ++i) k1[i] = (unsigned)shx_i((int)k0[i], 32);
      merge_top16(k0, k1);
      if (h == 0) {
        unsigned* dst = tops + ((size_t)(u.pm * 256 + wid * 32 + c) * 16 + hc) * 16;
#pragma unroll
        for (int q4 = 0; q4 < 4; ++q4) { u32x4 o = {k0[4 * q4], k0[4 * q4 + 1], k0[4 * q4 + 2], k0[4 * q4 + 3]}; *(u32x4*)(dst + 4 * q4) = o; }
      }
    }
    __syncthreads();
  }
};


template <int CTRL> DI float dpp_f(float v) { const int iv = __float_as_int(v); return __int_as_float(__builtin_amdgcn_update_dpp(iv, iv, CTRL, 0xF, 0xF, false)); }
DI float wsum(float x) {
  x += dpp_f<0xB1>(x);
  x += dpp_f<0x4E>(x);
  x += dpp_f<0x124>(x);
  x += dpp_f<0x128>(x);
  x += shx(x, 16);
  return hsum(x);
}
DI float gelu_fast(float x) {
  const float u2 = 1.5957691216057308f * (x + 0.044715f * x * x * x);
  return x * __builtin_amdgcn_rcpf(1.f + ex2(-LOG2E * u2));
}

constexpr int EROW = 1152;
typedef float v2f __attribute__((ext_vector_type(2)));
__device__ void d_cvt_fp4_row(int row, const float* __restrict__ src, unsigned char* __restrict__ dst) {
  const int lane = TIDX & 63;
  float v[32]; float amax = 0.f;
#pragma unroll
  for (int i = 0; i < 8; ++i) {
    f32x4 x = *(const f32x4*)(src + (size_t)row * DM + 256 * i + 4 * lane);
#pragma unroll
    for (int j = 0; j < 4; ++j) { v[i * 4 + j] = x[j]; amax = fmaxf(amax, fabsf(x[j])); }
  }
  const float sc = amax > 0.f ? amax * (1.f / 6.f) : 1.f;
  const float scb = bf2f(f2bf(sc));
  const float inv = 1.f / scb;
  u32x4 o;
#pragma unroll
  for (int k = 0; k < 4; ++k) {
    unsigned w = 0u;
#define FP4C(x_) fminf(fmaxf((x_) * inv, -6.f), 6.f)
    w = __builtin_amdgcn_cvt_scalef32_pk_fp4_f32(w, FP4C(v[8 * k + 0]), FP4C(v[8 * k + 1]), 1.0f, 0);
    w = __builtin_amdgcn_cvt_scalef32_pk_fp4_f32(w, FP4C(v[8 * k + 2]), FP4C(v[8 * k + 3]), 1.0f, 1);
    w = __builtin_amdgcn_cvt_scalef32_pk_fp4_f32(w, FP4C(v[8 * k + 4]), FP4C(v[8 * k + 5]), 1.0f, 2);
    w = __builtin_amdgcn_cvt_scalef32_pk_fp4_f32(w, FP4C(v[8 * k + 6]), FP4C(v[8 * k + 7]), 1.0f, 3);
#undef FP4C
    o[k] = w;
  }
  *(u32x4*)(dst + (size_t)row * EROW + 16 * lane) = o;
  *(bf16_t*)(dst + (size_t)row * EROW + 1024 + 2 * lane) = f2bf(sc);
}
__device__ void d_expert_wave(int t, unsigned* tpl, const bf16_t* __restrict__ hbuf,
                              const unsigned* __restrict__ tops, const unsigned char* __restrict__ eu4, const unsigned char* __restrict__ ev4,
                              const float* __restrict__ gam, const float* __restrict__ bet, float* __restrict__ out) {
  const int lane = TIDX & 63;
  float hv[32];
#pragma unroll
  for (int i = 0; i < 8; ++i) {
    const u32x2 w = *(const u32x2*)(hbuf + (size_t)t * DM + 256 * i + 4 * lane);
    hv[i * 4 + 0] = __uint_as_float(w[0] << 16); hv[i * 4 + 1] = __uint_as_float(w[0] & 0xFFFF0000u);
    hv[i * 4 + 2] = __uint_as_float(w[1] << 16); hv[i * 4 + 3] = __uint_as_float(w[1] & 0xFFFF0000u);
  }
  int e0 = 0, e1 = 0; float w0 = 0.f, w1 = 0.f;
  {
    const int ci = (lane < 16) ? 0 : (lane < 24) ? 1 : (lane < 29) ? 2 : (lane < 33) ? 3 : (lane < 36) ? 4 : (lane < 38) ? 5 : (lane < 40) ? 6
                   : (lane < 42) ? 7 : (lane - 34);
    const int cpre = (ci == 0) ? 0 : (ci == 1) ? 16 : (ci == 2) ? 24 : (ci == 3) ? 29 : (ci == 4) ? 33 : (ci == 5) ? 36 : (ci == 6) ? 38
                     : (ci == 7) ? 40 : (34 + ci);
    const int cj = lane - cpre;
    const bool cvalid = lane < 50;
    *(u32x4*)(tpl + 4 * lane) = *(const u32x4*)(tops + (size_t)t * 256 + 4 * lane);
    const unsigned* tp = tpl;
#pragma unroll 1
    for (int hh = 0; hh < 8; ++hh) {
      unsigned key = 0u;
      if (cvalid) {
        const float sa = sort2f(tp[(2 * hh) * 16 + ci]), sb = sort2f(tp[(2 * hh + 1) * 16 + cj]);
        key = (f2sort(sa + sb) & 0xFFFFFF00u) | (unsigned)(255 - (ci * 16 + cj));
      }
#pragma unroll
      for (int k = 2; k <= 64; k <<= 1) {
#pragma unroll
        for (int jj = k >> 1; jj > 0; jj >>= 1) {
          const unsigned o = (unsigned)shx_i((int)key, jj);
          const bool lower = (lane & jj) == 0;
          const bool desc = (lane & k) == 0 || k == 64;
          const unsigned mx = key > o ? key : o, mn = key > o ? o : key;
          key = (lower == desc) ? mx : mn;
        }
      }
      const int flat = 255 - (int)(key & 255u);
      const int bi = (flat >> 4) & 15, bj = flat & 15;
      const unsigned ka = tp[(2 * hh) * 16 + bi], kb = tp[(2 * hh + 1) * 16 + bj];
      const float sc = sort2f(ka) + sort2f(kb);
      const int ex = (127 - (int)(ka & 127u)) * 128 + (127 - (int)(kb & 127u));
      float mx = sc;
      mx = fmaxf(mx, shx(mx, 1)); mx = fmaxf(mx, shx(mx, 2)); mx = fmaxf(mx, shx(mx, 4)); mx = fmaxf(mx, shx(mx, 8));
      const float ev_ = __expf(sc - mx);
      float sm = ev_;
      sm += shx(sm, 1); sm += shx(sm, 2); sm += shx(sm, 4); sm += shx(sm, 8);
      const float gv = ev_ / sm;
      const int exs = __shfl(ex, lane & 15); const float gvs = __shfl(gv, lane & 15);
      if ((lane >> 4) == (hh & 3)) { if (hh < 4) { e0 = exs; w0 = gvs; } else { e1 = exs; w1 = gvs; } }
    }
  }
  bf16x2v hb2[16];
#pragma unroll
  for (int i = 0; i < 16; ++i) hb2[i] = bf16x2v{(__bf16)hv[2 * i], (__bf16)hv[2 * i + 1]};
  float c0 = 0.f, c1 = 0.f;
  u32x4 rA[4], rB[4]; unsigned short sA[4], sB[4];
#define EX_LOAD(R, SS, TAB, EB)                                                            \
  _Pragma("unroll") for (int k = 0; k < 4; ++k) {                                          \
    const int e = (EB) + k;                                                                \
    const int id = __builtin_amdgcn_readlane((e < 64) ? e0 : e1, e & 63);                 \
    const unsigned char* row = (TAB) + (size_t)id * EROW;                                  \
    R[k] = *(const u32x4*)(row + 16 * lane);                                               \
    SS[k] = *(const unsigned short*)(row + 1024 + 2 * lane);                               \
  }
#define PKFMA(a_, b_, c_) __builtin_elementwise_fma((a_), (b_), (c_))
#define EX_COMP_U(R, SS, EB)                                                               \
  {                                                                                        \
    float dd[4];                                                                           \
    _Pragma("unroll") for (int k = 0; k < 4; ++k) {                                        \
      float d0 = 0.f, d1 = 0.f;                                                            \
      _Pragma("unroll") for (int q = 0; q < 4; ++q) {                                      \
        const unsigned wq = R[k][q];                                                       \
        d0 = __builtin_amdgcn_fdot2_f32_bf16(__builtin_amdgcn_cvt_scalef32_pk_bf16_fp4(wq, 1.0f, 0), hb2[4 * q + 0], d0, false); \
        d1 = __builtin_amdgcn_fdot2_f32_bf16(__builtin_amdgcn_cvt_scalef32_pk_bf16_fp4(wq, 1.0f, 1), hb2[4 * q + 1], d1, false); \
        d0 = __builtin_amdgcn_fdot2_f32_bf16(__builtin_amdgcn_cvt_scalef32_pk_bf16_fp4(wq, 1.0f, 2), hb2[4 * q + 2], d0, false); \
        d1 = __builtin_amdgcn_fdot2_f32_bf16(__builtin_amdgcn_cvt_scalef32_pk_bf16_fp4(wq, 1.0f, 3), hb2[4 * q + 3], d1, false); \
      }                                                                                    \
      dd[k] = bf2f(SS[k]) * (d0 + d1);                                                     \
      __builtin_amdgcn_sched_barrier(0);                                                   \
    }                                                                                      \
      \
    float t01, t23;                                                                        \
    { auto r_ = __builtin_amdgcn_permlane32_swap(__float_as_uint(dd[0]), __float_as_uint(dd[1]), false, false);   \
      t01 = __uint_as_float(r_[0]) + __uint_as_float(r_[1]); }          \
    { auto r_ = __builtin_amdgcn_permlane32_swap(__float_as_uint(dd[2]), __float_as_uint(dd[3]), false, false);   \
      t23 = __uint_as_float(r_[0]) + __uint_as_float(r_[1]); }          \
    const bool b4_ = (lane & 16) != 0;                                                     \
    float tv = (b4_ ? t23 : t01) + shx(b4_ ? t01 : t23, 16);          \
    tv += dpp_f<0x128>(tv); tv += dpp_f<0x124>(tv); tv += dpp_f<0x4E>(tv); tv += dpp_f<0xB1>(tv);                 \
    _Pragma("unroll") for (int k = 0; k < 4; ++k) {                                        \
      const int e = (EB) + k;                                                              \
      const float tot = __int_as_float(__builtin_amdgcn_readlane(__float_as_int(tv), (k == 0) ? 0 : (k == 1) ? 32 : (k == 2) ? 16 : 48)); \
      if (e < 64) { if (lane == e) c0 = tot; } else { if (lane == e - 64) c1 = tot; }        \
    }                                                                                      \
    __builtin_amdgcn_sched_barrier(0);                                                     \
  }
#define EX_COMP_V(R, SS, EB)                                                               \
  _Pragma("unroll") for (int k = 0; k < 4; ++k) {                                          \
    const int e = (EB) + k;                                                                \
    const float cs = __int_as_float(__builtin_amdgcn_readlane(__float_as_int((e < 64) ? c0 : c1), e & 63)) * bf2f(SS[k]);                     \
    const v2f cs2 = {cs, cs};                                                              \
    _Pragma("unroll") for (int q = 0; q < 4; ++q) {                                        \
      const unsigned wq = R[k][q];                                                         \
      const v2f f0 = __builtin_amdgcn_cvt_scalef32_pk_f32_fp4(wq, 1.0f, 0), f1 = __builtin_amdgcn_cvt_scalef32_pk_f32_fp4(wq, 1.0f, 1); \
      const v2f f2 = __builtin_amdgcn_cvt_scalef32_pk_f32_fp4(wq, 1.0f, 2), f3 = __builtin_amdgcn_cvt_scalef32_pk_f32_fp4(wq, 1.0f, 3); \
      acc2[4 * q + 0] = PKFMA(cs2, f0, acc2[4 * q + 0]); acc2[4 * q + 1] = PKFMA(cs2, f1, acc2[4 * q + 1]); \
      acc2[4 * q + 2] = PKFMA(cs2, f2, acc2[4 * q + 2]); acc2[4 * q + 3] = PKFMA(cs2, f3, acc2[4 * q + 3]); \
    }                                                                                      \
    __builtin_amdgcn_sched_barrier(0);                                                     \
  }
  EX_LOAD(rA, sA, eu4, 0)
  __builtin_amdgcn_sched_barrier(0);
#pragma unroll 1
  for (int eb = 0; eb < 128; eb += 8) {
    EX_LOAD(rB, sB, eu4, eb + 4)
    __builtin_amdgcn_sched_barrier(0);
    EX_COMP_U(rA, sA, eb)
    { const bool more = eb + 8 < 128; const unsigned char* tabn = more ? eu4 : ev4; const int ebn = more ? eb + 8 : 0;
      EX_LOAD(rA, sA, tabn, ebn) }
    __builtin_amdgcn_sched_barrier(0);
    EX_COMP_U(rB, sB, eb + 4)
  }
  c0 = w0 * gelu_fast(c0); c1 = w1 * gelu_fast(c1);
  v2f acc2[16];
#pragma unroll
  for (int i = 0; i < 16; ++i) acc2[i] = v2f{0.f, 0.f};
#pragma unroll 1
  for (int eb = 0; eb < 128; eb += 8) {
    EX_LOAD(rB, sB, ev4, eb + 4)
    __builtin_amdgcn_sched_barrier(0);
    EX_COMP_V(rA, sA, eb)
    { const int ebn = (eb + 8 < 128) ? eb + 8 : 0;
      EX_LOAD(rA, sA, ev4, ebn) }
    __builtin_amdgcn_sched_barrier(0);
    EX_COMP_V(rB, sB, eb + 4)
  }
#undef EX_LOAD
#undef EX_COMP_U
#undef EX_COMP_V
#undef PKFMA
  float acc[32];
#pragma unroll
  for (int i = 0; i < 16; ++i) { acc[2 * i] = acc2[i].x; acc[2 * i + 1] = acc2[i].y; }
  int le = lane;
  asm volatile("" : "+v"(le) :: "memory");
  float s = 0.f;
#pragma unroll
  for (int i = 0; i < 8; ++i) {
    const u32x2 w = *(const u32x2*)(hbuf + (size_t)t * DM + 256 * i + 4 * le);
    const float h0 = __uint_as_float(w[0] << 16), h1 = __uint_as_float(w[0] & 0xFFFF0000u), h2 = __uint_as_float(w[1] << 16), h3 = __uint_as_float(w[1] & 0xFFFF0000u);
    acc[i * 4 + 0] = fmaf(ALPHA, h0, acc[i * 4 + 0]); acc[i * 4 + 1] = fmaf(ALPHA, h1, acc[i * 4 + 1]);
    acc[i * 4 + 2] = fmaf(ALPHA, h2, acc[i * 4 + 2]); acc[i * 4 + 3] = fmaf(ALPHA, h3, acc[i * 4 + 3]);
    s += (acc[i * 4 + 0] + acc[i * 4 + 1]) + (acc[i * 4 + 2] + acc[i * 4 + 3]);
  }
  s = wsum(s);
  const float mu = s * (1.f / DM);
  float qv = 0.f;
#pragma unroll
  for (int i = 0; i < 32; ++i) { const float d = acc[i] - mu; qv += d * d; }
  qv = wsum(qv);
  const float rs = rsqrtf(qv * (1.f / DM) + 1e-5f);
#pragma unroll
  for (int i = 0; i < 8; ++i) {
    const int cbase = 256 * i + 4 * le;
    f32x4 ga = *(const f32x4*)(gam + cbase), ba = *(const f32x4*)(bet + cbase), o;
#pragma unroll
    for (int j = 0; j < 4; ++j) o[j] = (acc[i * 4 + j] - mu) * rs * ga[j] + ba[j];
    *(f32x4*)(out + (size_t)t * DM + cbase) = o;
  }
}

constexpr size_t al256(size_t x) { return (x + 255) & ~(size_t)255; }
constexpr size_t WS_XB = 0;
constexpr size_t WS_PROJ = WS_XB + al256((size_t)S * DM * 2);
constexpr size_t WS_WINT = WS_PROJ + al256((size_t)S * INWP * 2);
constexpr size_t WS_GATES = WS_WINT + al256((size_t)INWG * DM * 2);
constexpr size_t WS_W1KF = WS_GATES + al256((size_t)S * 24 * 4);
constexpr size_t WS_W1VF = WS_W1KF + al256((size_t)512 * 4096 * 2);
constexpr size_t WS_W2KF = WS_W1VF + al256((size_t)512 * 4096 * 2);
constexpr size_t WS_W2VF = WS_W2KF + al256((size_t)512 * 128 * 2);
constexpr size_t WS_VC = WS_W2VF + al256((size_t)512 * 128 * 2) - al256((size_t)2048 * 128 * 4);
constexpr size_t WS_KCF = WS_VC + al256((size_t)2048 * 128 * 4);
constexpr size_t WS_VCF = WS_KCF + al256((size_t)2 * 32 * 4096 * 2);
constexpr size_t WS_KSF = WS_VCF + al256((size_t)2 * 32 * 4096 * 2);
constexpr size_t WS_VSF = WS_KSF + al256((size_t)2 * 512 * 4096 * 2);
constexpr size_t WS_KWF = WS_VSF + al256((size_t)2 * 512 * 4096 * 2);
constexpr size_t WS_VWF = WS_KWF + al256((size_t)2 * 512 * 4096 * 2);
constexpr size_t WS_ENDA = WS_VWF + al256((size_t)2 * 512 * 4096 * 2);
constexpr size_t WS_OATT = WS_ENDA;
constexpr size_t WS_MIX = WS_OATT + al256((size_t)S * 1024 * 4);
constexpr size_t WS_WOUTT = WS_MIX + al256((size_t)S * DM * 2);
constexpr size_t WS_WQT = WS_WOUTT + al256((size_t)DM * DM * 2);
constexpr size_t WS_TOPS = WS_WQT + al256((size_t)DM * DM * 2);
constexpr size_t WS_SKF = WS_TOPS + al256((size_t)S * 256 * 4);
constexpr size_t WS_STATS = WS_SKF + al256((size_t)16 * 128 * 128 * 2);
constexpr size_t WS_CTRL = WS_STATS + al256((size_t)S * 2 * 4);
constexpr size_t CTRL_BYTES = 32768;
constexpr size_t WS_END = WS_CTRL + CTRL_BYTES;
constexpr size_t WS_Y = WS_PROJ;
constexpr size_t WS_HB = WS_XB;
constexpr size_t WS_EU8 = WS_Y + (size_t)S * DM * 4;
constexpr size_t WS_EV8 = WS_EU8 + (size_t)16384 * 1152;
static_assert(WS_EV8 + (size_t)16384 * 1152 <= WS_ENDA, "expert overlay overflows group A");
static_assert(WS_END <= (size_t)512 * 1024 * 1024, "workspace over 512 MiB");

struct Params {
  const float *x, *w_in, *ck_pos, *ck_w1, *ck_b1, *ck_w2, *cv_pos, *cv_w1, *cv_b1, *cv_w2, *conv_w, *hng, *w_out, *ln1g, *ln1b, *w_query, *subk,
      *eu, *ev, *ln2g, *ln2b;
  float* out;
  char* ws;
};
#define WSP(T, OFF) ((T*)(p.ws + (OFF)))

#define FOR_VB(n) for (int vb = blockIdx.x; vb < (n); vb += gridDim.x)
#define FOR_VB2(n) for (int vb = blockIdx.x * 2 + (TIDX >> 8); vb < (n); vb += gridDim.x * 2)
constexpr int SMEM_BYTES = 143360;
constexpr int HALF = 36864;

__global__ void __launch_bounds__(512) mega(Params p) {
  __shared__ __attribute__((aligned(16))) char smem[SMEM_BYTES + 16];
  if (TIDX == 0) *(u32x4*)(smem + SMEM_BYTES) = u32x4{0u, 0u, 0u, 0u};
  __syncthreads();
  const XcdBarrier xbar = xcd_barrier_post(WSP(unsigned, WS_CTRL + 1024), (volatile LAS unsigned*)(smem + SMEM_BYTES));
#define smh (smem + (TIDX >> 8) * HALF)
#define wv ((TIDX >> 6))
  constexpr int NWV = 8;
  d_cvt(p.x, WSP(bf16_t, WS_XB), (size_t)S * DM / 4);
  FOR_VB2((INWG / 64) * (DM / 64)) d_cvtT64(vb, smh, p.w_in, WSP(bf16_t, WS_WINT), DM, INW, INWG);
  for (size_t c = (size_t)blockIdx.x * 512 + TIDX; c < (size_t)16 * 256 * 64; c += (size_t)gridDim.x * 512) {
    d_cvt_w1f(c, p.ck_w1, WSP(bf16_t, WS_W1KF)); d_cvt_w1f(c, p.cv_w1, WSP(bf16_t, WS_W1VF));
    if (c < (size_t)4 * 32 * 64) { d_cvt_w2f(c, p.ck_w2, WSP(bf16_t, WS_W2KF)); d_cvt_w2f(c, p.cv_w2, WSP(bf16_t, WS_W2VF)); }
  }
  FOR_VB2((DM / 64) * (DM / 64)) d_cvtT64(vb, smh, p.w_out, WSP(bf16_t, WS_WOUTT), DM, DM, DM);
  FOR_VB2((DM / 64) * (DM / 64)) d_cvtT64(vb, smh, p.w_query, WSP(bf16_t, WS_WQT), DM, DM, DM);
  for (size_t c = (size_t)blockIdx.x * 512 + TIDX; c < (size_t)16 * 4 * 8 * 64; c += (size_t)gridDim.x * 512) d_cvt_subk(c, p.subk, WSP(bf16_t, WS_SKF));
  xcd_barrier(xbar);
  {
    pg8::StaticOrder so; so.init(S, INWG, gridDim.x, blockIdx.x);
    pg8::gemm_phase<EpiProjG, pg8::StaticOrder>((PG8_LAS unsigned char*)smem, pg8::Gemm{WSP(bf16_t, WS_XB), WSP(bf16_t, WS_WINT), S, INWG, DM}, so,
                                                EpiProjG{WSP(bf16_t, WS_PROJ), WSP(float, WS_GATES)}, nullptr);
  }
  xcd_barrier(xbar);
  {
    if (blockIdx.x < 128) {
      const int u = blockIdx.x; const bool isV = u >= 64;
      d_compress_unit(u & 63, smem, WSP(bf16_t, WS_PROJ), isV ? OFF_VC : OFF_KC, isV ? p.cv_pos : p.ck_pos, isV ? WSP(bf16_t, WS_W1VF) : WSP(bf16_t, WS_W1KF),
                      isV ? p.cv_b1 : p.ck_b1, isV ? WSP(bf16_t, WS_W2VF) : WSP(bf16_t, WS_W2KF), isV ? WSP(bf16_t, WS_VCF) : WSP(bf16_t, WS_KCF), isV);
    }
    int* slot = (int*)smem;
    unsigned* ctr = WSP(unsigned, WS_CTRL);
    for (;;) {
      if (TIDX == 0) *slot = (int)atomicAdd(ctr, 1u);
      __syncthreads();
      const int it = *slot;
      __syncthreads();
      if (it >= 2048) break;
      const int tt = TIDX;
      {
        const int T = it >> 2, which = it & 3;
        d_relayout_tile(T, smem + 64, WSP(bf16_t, WS_PROJ), (which == 0) ? OFF_KS : (which == 1) ? OFF_VS : (which == 2) ? OFF_KW : OFF_VW,
                        (which == 0) ? WSP(bf16_t, WS_KSF) : (which == 1) ? WSP(bf16_t, WS_VSF) : (which == 2) ? WSP(bf16_t, WS_KWF) : WSP(bf16_t, WS_VWF), (which & 1) != 0);
      }
      for (int q = 0; q < 2; ++q) d_convmix(it * 8 + q * 4 + (tt >> 7), tt & 127, WSP(bf16_t, WS_PROJ), p.conv_w, p.hng, WSP(bf16_t, WS_MIX));
    }
  }
  xcd_barrier(xbar);
  {
    AttnPtrs ap{WSP(bf16_t, WS_PROJ), WSP(float, WS_GATES), WSP(bf16_t, WS_KCF), WSP(bf16_t, WS_VCF), WSP(bf16_t, WS_KSF), WSP(bf16_t, WS_VSF), WSP(bf16_t, WS_KWF), WSP(bf16_t, WS_VWF), WSP(bf16_t, WS_MIX), p.hng};
    for (int it = blockIdx.x; it < 512; it += gridDim.x) {
      const int Bq = (it < 256) ? it : (511 - it), gq = (it < 256) ? 0 : 1;
      d_attn_block(Bq, gq, smem, ap);
    }
  }
  xcd_barrier(xbar);
  {
    pg8::StaticOrder so; so.init(S, DM, gridDim.x, blockIdx.x);
    pg8::gemm_phase<EpiResG, pg8::StaticOrder>((PG8_LAS unsigned char*)smem, pg8::Gemm{WSP(bf16_t, WS_MIX), WSP(bf16_t, WS_WOUTT), S, DM, DM}, so,
                                               EpiResG{WSP(bf16_t, WS_HB)}, nullptr);
  }
  xcd_barrier(xbar);
  for (int r = blockIdx.x * NWV + wv; r < S; r += gridDim.x * NWV) d_ln_wave(r, WSP(bf16_t, WS_HB), p.ln1g, p.ln1b);
  for (int r = blockIdx.x * NWV + wv; r < 32768; r += gridDim.x * NWV) {
    if (r < 16384) d_cvt_fp4_row(r, p.eu, WSP(unsigned char, WS_EU8)); else d_cvt_fp4_row(r - 16384, p.ev, WSP(unsigned char, WS_EV8));
  }
  xcd_barrier(xbar);
  for (int k = 0; k * (int)gridDim.x < (S / 256) * (DM / 256); ++k) {
    pg8::OneUnit so; so.init(S, DM, gridDim.x, blockIdx.x); so.k = k;
    pg8::gemm_phase<EpiRouteG, pg8::OneUnit>((PG8_LAS unsigned char*)smem, pg8::Gemm{WSP(bf16_t, WS_HB), WSP(bf16_t, WS_WQT), S, DM, DM}, so,
                                             EpiRouteG{WSP(bf16_t, WS_SKF), WSP(unsigned, WS_TOPS)}, nullptr);
    __syncthreads();
  }
  xcd_barrier(xbar);
  for (int t = blockIdx.x * NWV + wv; t < S; t += gridDim.x * NWV) d_expert_wave(t, (unsigned*)(smem + wv * 1024), WSP(bf16_t, WS_HB), WSP(unsigned, WS_TOPS), WSP(unsigned char, WS_EU8), WSP(unsigned char, WS_EV8), p.ln2g, p.ln2b, p.out);
}

extern "C" void kernel_launch(void* const* d_in, const int* in_sizes, int n_in, void* d_out, int out_size, void* d_ws, size_t ws_size,
                              hipStream_t stream) {
  Params p{};
  p.x = (const float*)d_in[0]; p.w_in = (const float*)d_in[1]; p.ck_pos = (const float*)d_in[2]; p.ck_w1 = (const float*)d_in[3];
  p.ck_b1 = (const float*)d_in[4]; p.ck_w2 = (const float*)d_in[5]; p.cv_pos = (const float*)d_in[6]; p.cv_w1 = (const float*)d_in[7];
  p.cv_b1 = (const float*)d_in[8]; p.cv_w2 = (const float*)d_in[9]; p.conv_w = (const float*)d_in[10]; p.hng = (const float*)d_in[11];
  p.w_out = (const float*)d_in[12]; p.ln1g = (const float*)d_in[13]; p.ln1b = (const float*)d_in[14]; p.w_query = (const float*)d_in[15];
  p.subk = (const float*)d_in[16]; p.eu = (const float*)d_in[17]; p.ev = (const float*)d_in[18]; p.ln2g = (const float*)d_in[19];
  p.ln2b = (const float*)d_in[20];
  p.out = (float*)d_out;
  p.ws = (char*)d_ws;
  if (ws_size < WS_END) fprintf(stderr, "workspace too small\n");
  static int grid_blocks = 0;
  if (!grid_blocks) {
    int dev = 0, cus = 0, per_cu = 0;
    hipGetDevice(&dev);
    hipDeviceGetAttribute(&cus, hipDeviceAttributeMultiprocessorCount, dev);
    hipOccupancyMaxActiveBlocksPerMultiprocessor(&per_cu, mega, 512, 0);
    if (per_cu > 1) per_cu = 1;
    if (per_cu < 1) per_cu = 1;
    grid_blocks = cus * per_cu;
  }
  hipMemsetAsync((char*)d_ws + WS_CTRL, 0, CTRL_BYTES, stream);
  void* args[] = {&p};
  hipError_t e = hipLaunchCooperativeKernel((void*)mega, dim3(grid_blocks), dim3(512), args, 0, stream);
  if (e != hipSuccess) fprintf(stderr, "cooperative launch failed: %s (grid %d)\n", hipGetErrorString(e), grid_blocks);
}
```

```cpp
#include <hip/hip_runtime.h>
#include <stdint.h>
#include <stdio.h>


#define DI __device__ __forceinline__
static __device__ __forceinline__ int tidx_() { int t = (int)__builtin_amdgcn_workitem_id_x(); asm volatile("" : "+v"(t)); return t; }
#define TIDX (tidx_())

template <int J> DI int swz_xor(int x) { return __builtin_amdgcn_ds_swizzle(x, (J << 10) | 0x1F); }
template <int CTRL> DI int dpp_i(int x) { return __builtin_amdgcn_update_dpp(x, x, CTRL, 0xF, 0xF, false); }
DI int shx_i(int x, int j) {
  switch (j) {
    case 1: return dpp_i<0xB1>(x);
    case 2: return dpp_i<0x4E>(x);
    case 4: return dpp_i<0x1B>(dpp_i<0x141>(x));
    case 8: return dpp_i<0x128>(x);
    case 16: return swz_xor<16>(x);
    default: {
      auto r = __builtin_amdgcn_permlane32_swap((unsigned)x, (unsigned)x, false, false);
      return (TIDX & 32) ? (int)r[0] : (int)r[1];
    }
  }
}
DI float shx(float x, int j) { return __int_as_float(shx_i(__float_as_int(x), j)); }
typedef unsigned short bf16_t;
using bf16x8 = __attribute__((ext_vector_type(8))) short;
using f32x4 = __attribute__((ext_vector_type(4))) float;
using u32x4 = __attribute__((ext_vector_type(4))) unsigned;
using u32x2 = __attribute__((ext_vector_type(2))) unsigned;

constexpr int S = 16384, DM = 2048, HD = 128;
constexpr int INW = 5656, INWP = 5760, INWG = 5888;
constexpr int OFF_Q = 0, OFF_KC = 1024, OFF_VC = 1280, OFF_KS = 1536, OFF_VS = 1792, OFF_KW = 2048, OFF_VW = 2304,
              OFF_G = 2560, OFF_U = 2584, OFF_B = 3608, OFF_C = 4632;
constexpr int NCMP = 1023;
constexpr float ALPHA = 1.189207115002721f;
constexpr float QSCALE = 0.08838834764831845f;

DI bf16_t f2bf(float x) { unsigned u = __float_as_uint(x); u += 0x7fffu + ((u >> 16) & 1u); return (bf16_t)(u >> 16); }
DI float bf2f(bf16_t b) { return __uint_as_float(((unsigned)b) << 16); }
DI float gelu_tanh(float x) { float u = 0.7978845608028654f * (x + 0.044715f * x * x * x); return 0.5f * x * (1.f + tanhf(u)); }
DI float wave_sum(float v) { for (int o = 32; o > 0; o >>= 1) v += shx(v, o); return v; }
using bf16x2v = __attribute__((ext_vector_type(2))) __bf16;
DI unsigned pack2(float a, float b) { bf16x2v v = {(__bf16)a, (__bf16)b}; return __builtin_bit_cast(unsigned, v); }
DI float wave_max(float v) { for (int o = 32; o > 0; o >>= 1) v = fmaxf(v, shx(v, o)); return v; }

namespace pg8 {
#define PG8_LAS __attribute__((address_space(3)))
typedef unsigned short bf16_t;
typedef short bf16x8 __attribute__((ext_vector_type(8)));
typedef float f32x4 __attribute__((ext_vector_type(4)));
typedef unsigned u32x4 __attribute__((ext_vector_type(4)));
constexpr int BM = 256, BK = 64, HALF = 128, HTB = HALF * BK * 2  , STAGE_BYTES = 8 * HTB, NXCD = 8, WGM = 8;

__host__ __device__ __forceinline__ int lds_byte(int r, int c) { const int st = (r >> 4) * 2 + (c >> 5), rr = r & 15, cc = c & 31, ob = rr * 64 + cc * 2; return st * 1024 + (ob ^ (((ob >> 9) & 1) << 5)); }
__host__ __device__ __forceinline__ void stage_rc(int b, int& R, int& C) { const int st = b / 1024, sb = b % 1024, swz = sb ^ (((sb >> 9) & 1) << 5); R = (st >> 1) * 16 + swz / 64; C = (st & 1) * 32 + (swz % 64) / 2; }
__host__ __device__ __forceinline__ int perm32(int rho) { const int n = rho >> 4, i = rho & 15; return 8 * (i >> 2) + 4 * n + (i & 3); }

struct Unit { int pm, pn; };
struct Gemm { const bf16_t* A; const bf16_t* Bt; int M, N, K; };

struct StaticOrder {
    int nM, nN, nwg, G, c;
    __host__ __device__ void init(int M, int N, int G_, int c_) { nM = M / BM; nN = N / BM; nwg = nM * nN; G = G_; c = c_; }
    __host__ __device__ bool next(int i, Unit& u) const {
        const long L = (long)i * G + c; if (L >= nwg) return false;
        int wgid = (int)L; { const int q = nwg / NXCD, r = nwg % NXCD, xcd = wgid % NXCD, off = wgid / NXCD; wgid = (xcd < r ? xcd * (q + 1) : r * (q + 1) + (xcd - r) * q) + off; }
        const int nig = WGM * nN, gid = wgid / nig, fm = gid * WGM, gsz = (nM - fm) < WGM ? (nM - fm) : WGM;
        u.pm = fm + ((wgid % nig) % gsz); u.pn = (wgid % nig) / gsz; return true;
    }
    __device__ __forceinline__ void a_ready(const Unit&) const {}
    __device__ __forceinline__ void done(const Unit&) const {}
};
struct OneUnit : StaticOrder {
    int k;
    __device__ bool next(int i, Unit& u) const { if (i > 0) return false; return StaticOrder::next(k, u); }
};
__device__ __forceinline__ unsigned cvt_pk_bf16(float lo, float hi) { unsigned r; asm volatile("v_cvt_pk_bf16_f32 %0, %1, %2" : "=v"(r) : "v"(lo), "v"(hi)); return r; }
template <class Epi, class Sched, bool STAMP = false>
__device__ __forceinline__ void gemm_phase(PG8_LAS unsigned char* lds, const Gemm g, const Sched& S, const Epi& E, unsigned long long* stamps) {
    const int tid = TIDX, wid = __builtin_amdgcn_readfirstlane(tid >> 6), lane = tid & 63, wr = wid >> 2, wc = wid & 3, fr = lane & 15, fq = lane >> 4;
    const int K = g.K, nt = K / BK;
    int ts_lo = 0, ts_hi = 0, nts = 0; const unsigned long long rt_entry = STAMP ? (unsigned long long)wall_clock64() : 0ull;
#define PG8_STAMP() do { if (STAMP && wid == 0 && nts < 64) { const unsigned long long _c = (unsigned long long)clock64(); \
        ts_lo = (lane == nts) ? (int)(unsigned)_c : ts_lo; ts_hi = (lane == nts) ? (int)(unsigned)(_c >> 32) : ts_hi; ++nts; } } while (0)
    PG8_STAMP();
    unsigned voffA[2], voffB[2];
#pragma unroll
    for (int i = 0; i < 2; ++i) { int R, C; stage_rc(tid * 16 + i * 8192, R, C); const int Rb = Epi::PERM ? ((R & ~31) + perm32(R & 31)) : R;
        voffA[i] = (unsigned)(R * K + C) * 2u; voffB[i] = (unsigned)(Rb * K + C) * 2u; }
    const size_t kstep = (size_t)(BK * 2);
    const size_t hstep = (size_t)HALF * K * 2;
    const size_t tstep = 2 * hstep;
    const unsigned ldsw = (unsigned)wid * 1024u;
    const int aoff = lds_byte(wr * 64 + fr, fq * 8), boff = lds_byte(wc * 32 + fr, fq * 8);
#define PG8_SA(b, h) (((b) * 2 + (h)) * HTB)
#define PG8_SB(b, h) ((4 + (b) * 2 + (h)) * HTB)
#define PG8_STAGE(bufoff, gbase, voff) do { _Pragma("unroll") for (int _i = 0; _i < 2; ++_i) \
        __builtin_amdgcn_global_load_lds((const unsigned*)((const char*)(gbase) + (voff)[_i]), (PG8_LAS unsigned*)(lds + (bufoff) + ldsw + _i * 8192), 16, 0, 0); } while (0)
#define PG8_LDA(dst, b, h) do { _Pragma("unroll") for (int m = 0; m < 4; ++m) _Pragma("unroll") for (int k = 0; k < 2; ++k) dst[m][k] = *(const PG8_LAS bf16x8*)(lds + PG8_SA(b, h) + aoff + m * 2048 + k * 1024); } while (0)
#define PG8_LDB(dst, b, h) do { _Pragma("unroll") for (int n = 0; n < 2; ++n) _Pragma("unroll") for (int k = 0; k < 2; ++k) dst[n][k] = *(const PG8_LAS bf16x8*)(lds + PG8_SB(b, h) + boff + n * 2048 + k * 1024); } while (0)
#define PG8_MMA(ai, bj, At, Bt) do { __builtin_amdgcn_s_setprio(1); _Pragma("unroll") for (int m = 0; m < 4; ++m) _Pragma("unroll") for (int n = 0; n < 2; ++n) _Pragma("unroll") for (int k = 0; k < 2; ++k) \
        acc[ai][bj][m][n] = __builtin_amdgcn_mfma_f32_16x16x32_bf16(Bt[n][k], At[m][k], acc[ai][bj][m][n], 0, 0, 0); __builtin_amdgcn_s_setprio(0); } while (0)
#define PG8_WAIT_V(n) asm volatile("s_waitcnt vmcnt(" #n ")" ::: "memory")
#define PG8_WAIT_L(n) asm volatile("s_waitcnt lgkmcnt(" #n ")" ::: "memory")
#define PG8_BAR __builtin_amdgcn_s_barrier()
#define PG8_SCHED __builtin_amdgcn_sched_barrier(0)
    Unit cur, nxt; int ui = 0;
    if (!S.next(0, cur)) return;
    f32x4 acc[2][2][4][2];
#pragma unroll
    for (int a = 0; a < 2; ++a)
#pragma unroll
        for (int b = 0; b < 2; ++b)
#pragma unroll
            for (int m = 0; m < 4; ++m)
#pragma unroll
                for (int n = 0; n < 2; ++n) acc[a][b][m][n] = (f32x4){0.f, 0.f, 0.f, 0.f};
    bf16x8 At[4][2], B0[2][2], B1[2][2];
    const char* cA = (const char*)g.A + (size_t)cur.pm * tstep; const char* cB = (const char*)g.Bt + (size_t)cur.pn * tstep;
    S.a_ready(cur);
    PG8_STAGE(PG8_SB(0, 0), cB, voffB); PG8_STAGE(PG8_SA(0, 0), cA, voffA); PG8_STAGE(PG8_SB(0, 1), cB + hstep, voffB); PG8_STAGE(PG8_SA(0, 1), cA + hstep, voffA);
    if (wr == 1) PG8_BAR;
    PG8_WAIT_V(4); PG8_BAR;
    PG8_STAGE(PG8_SB(1, 0), cB + kstep, voffB); PG8_STAGE(PG8_SA(1, 0), cA + kstep, voffA); PG8_STAGE(PG8_SB(1, 1), cB + hstep + kstep, voffB);
    PG8_WAIT_V(6); PG8_BAR;
    PG8_STAMP();
    for (;;) {
        const bool has_next = S.next(ui + 1, nxt);
        const char* nA = has_next ? (const char*)g.A + (size_t)nxt.pm * tstep : cA; const char* nB = has_next ? (const char*)g.Bt + (size_t)nxt.pn * tstep : cB;
        for (int t = 0; t < nt; t += 2) {
            const bool last = (t == nt - 2);
            const char* a1 = cA + (size_t)(t + 1) * kstep;
            const char* a2 = last ? nA : cA + (size_t)(t + 2) * kstep; const char* b2 = last ? nB : cB + (size_t)(t + 2) * kstep;
            const char* a3 = a2 + kstep; const char* b3 = b2 + kstep;
            if (last && has_next) S.a_ready(nxt);
            PG8_LDB(B0, 0, 0); PG8_SCHED; PG8_LDA(At, 0, 0); PG8_STAGE(PG8_SA(1, 1), a1 + hstep, voffA);
            PG8_WAIT_L(8); PG8_BAR; PG8_WAIT_L(0); PG8_MMA(0, 0, At, B0); PG8_BAR; PG8_SCHED;
            PG8_LDB(B1, 0, 1); PG8_STAGE(PG8_SB(0, 0), b2, voffB);
            PG8_BAR; PG8_WAIT_L(0); PG8_MMA(0, 1, At, B1); PG8_BAR;
            PG8_LDA(At, 0, 1); PG8_STAGE(PG8_SA(0, 0), a2, voffA);
            PG8_BAR; PG8_WAIT_L(0); PG8_MMA(1, 0, At, B0); PG8_BAR; PG8_SCHED;
            PG8_STAGE(PG8_SB(0, 1), b2 + hstep, voffB);
            PG8_WAIT_V(6); PG8_BAR; PG8_MMA(1, 1, At, B1); PG8_BAR;
            PG8_LDB(B0, 1, 0); PG8_SCHED; PG8_LDA(At, 1, 0); PG8_STAGE(PG8_SA(0, 1), a2 + hstep, voffA);
            PG8_WAIT_L(8); PG8_BAR; PG8_WAIT_L(0); PG8_MMA(0, 0, At, B0); PG8_BAR; PG8_SCHED;
            PG8_LDB(B1, 1, 1); PG8_STAGE(PG8_SB(1, 0), b3, voffB);
            PG8_BAR; PG8_WAIT_L(0); PG8_MMA(0, 1, At, B1); PG8_BAR;
            PG8_LDA(At, 1, 1); PG8_STAGE(PG8_SA(1, 0), a3, voffA);
            PG8_BAR; PG8_WAIT_L(0); PG8_MMA(1, 0, At, B0); PG8_BAR; PG8_SCHED;
            PG8_STAGE(PG8_SB(1, 1), b3 + hstep, voffB);
            PG8_WAIT_V(6); PG8_BAR; PG8_MMA(1, 1, At, B1); PG8_BAR;
        }
        PG8_STAMP();
        if constexpr (!Epi::AFTER_DRAIN) { E(acc, cur, wr, wc, fr, fq); S.done(cur); }
        PG8_STAMP();
        if (!has_next) break;
#pragma unroll
        for (int a = 0; a < 2; ++a)
#pragma unroll
            for (int b = 0; b < 2; ++b)
#pragma unroll
                for (int m = 0; m < 4; ++m)
#pragma unroll
                    for (int n = 0; n < 2; ++n) acc[a][b][m][n] = (f32x4){0.f, 0.f, 0.f, 0.f};
        cur = nxt; cA = nA; cB = nB; ++ui;
    }
    PG8_WAIT_V(0);
    if (wr == 0) PG8_BAR;
    PG8_BAR;
    if constexpr (Epi::AFTER_DRAIN) { E.fused(acc, cur, wr, wc, fr, fq, lds, wid, lane); S.done(cur); }
    PG8_STAMP();
    if (STAMP && wid == 0) { stamps[lane] = lane < nts ? (((unsigned long long)(unsigned)ts_hi << 32) | (unsigned)ts_lo) : 0ull;
        if (lane == 62) stamps[62] = rt_entry; if (lane == 63) stamps[63] = (unsigned long long)wall_clock64(); }
#undef PG8_STAMP
#undef PG8_SA
#undef PG8_SB
#undef PG8_STAGE
#undef PG8_LDA
#undef PG8_LDB
#undef PG8_MMA
#undef PG8_WAIT_V
#undef PG8_WAIT_L
#undef PG8_BAR
#undef PG8_SCHED
}
}

#define XB_TMO      128
#define XB_XCNT(j)  (256  + 64 * (j))
#define XB_XSUB(j)  (1280 + 64 * (j))
#define XB_XGEN(j)  (2304 + 64 * (j))
#define XB_TOP      3328
#define XB_TOPGEN   3392
#define XCD_BAR_WORDS 3456
#define XB_SPIN_CAP (1u << 18)
#define LAS __attribute__((address_space(3)))

__device__ __forceinline__ unsigned xb_ld(unsigned* p)              { return __hip_atomic_load(p, __ATOMIC_RELAXED, __HIP_MEMORY_SCOPE_AGENT); }
__device__ __forceinline__ unsigned xb_add(unsigned* p, unsigned v) { return __hip_atomic_fetch_add(p, v, __ATOMIC_RELAXED, __HIP_MEMORY_SCOPE_AGENT); }
__device__ __forceinline__ unsigned xb_xcc_id() { return (unsigned)__builtin_amdgcn_s_getreg((3 << 11) | 20) & 0xFu; }
#define XB_SPIN(cond, bar) do { unsigned _sp = 0; while (cond) { __builtin_amdgcn_s_sleep(1); \
    if ((++_sp & 255u) == 0u) { if (xb_ld(&(bar)[XB_TMO])) break; if (_sp > XB_SPIN_CAP) { atomicAdd(&(bar)[XB_TMO], 1u); break; } } } } while (0)

struct XcdBarrier {
    unsigned* bar; unsigned x;
    volatile LAS unsigned* st;
};

__device__ __forceinline__ XcdBarrier xcd_barrier_post(unsigned* bar, volatile LAS unsigned* st) {
    XcdBarrier b; b.bar = bar; b.x = xb_xcc_id(); b.st = st;
    if (TIDX == 0) (void)xb_add(&bar[XB_XCNT(b.x)], 1u);
    return b;
}
__device__ __forceinline__ void xcd_barrier_complete(unsigned* bar, unsigned x, unsigned& nloc, unsigned& nx) {
    const unsigned G = gridDim.x * gridDim.y * gridDim.z;
    unsigned sum, cnt, mine, sp = 0u;
    for (;;) {
        sum = 0u; cnt = 0u; mine = 0u;
#pragma unroll
        for (unsigned j = 0; j < 16; ++j) { const unsigned c = xb_ld(&bar[XB_XCNT(j)]); sum += c; cnt += (c > 0u) ? 1u : 0u; mine = (j == x) ? c : mine; }
        if (sum == G) break;
        __builtin_amdgcn_s_sleep(1);
        if ((++sp & 255u) == 0u) { if (xb_ld(&bar[XB_TMO])) break; if (sp > XB_SPIN_CAP) { atomicAdd(&bar[XB_TMO], 1u); break; } }
    }
    nloc = mine > 0u ? mine : 1u; nx = cnt > 0u ? cnt : 1u;
}

__device__ __forceinline__ void xcd_barrier(const XcdBarrier& b) {
    asm volatile("s_waitcnt vmcnt(0)" ::: "memory");
    __syncthreads();
    if (TIDX == 0) {
        unsigned* bar = b.bar;
        __builtin_amdgcn_s_waitcnt(0);
        unsigned nloc = b.st[0], nx = b.st[1];
        if (nloc == 0u) { xcd_barrier_complete(bar, b.x, nloc, nx); b.st[0] = nloc; b.st[1] = nx; }
        const unsigned old = xb_add(&bar[XB_XSUB(b.x)], 1u);
        const unsigned gen = old / nloc;
        if (old + 1u == (gen + 1u) * nloc) {
            __builtin_amdgcn_fence(__ATOMIC_RELEASE, "agent");
            asm volatile("s_waitcnt vmcnt(0)" ::: "memory");
            const unsigned og = xb_add(&bar[XB_TOP], 1u);
            const unsigned tg = og / nx;
            if (og + 1u == (tg + 1u) * nx) xb_add(&bar[XB_TOPGEN], 1u);
            else XB_SPIN(xb_ld(&bar[XB_TOPGEN]) == tg, bar);
            __builtin_amdgcn_fence(__ATOMIC_ACQUIRE, "agent");
            xb_add(&bar[XB_XGEN(b.x)], 1u);
            asm volatile("s_waitcnt vmcnt(0)" ::: "memory");
        } else {
            XB_SPIN(xb_ld(&bar[XB_XGEN(b.x)]) == gen, bar);
            __builtin_amdgcn_fence(__ATOMIC_ACQUIRE, "agent");
            asm volatile("s_waitcnt vmcnt(0)" ::: "memory");
        }
    }
    __syncthreads();
}

__device__ void d_cvt(const float* __restrict__ in, bf16_t* __restrict__ out, size_t n4) {
  const size_t stride = (size_t)gridDim.x * blockDim.x;
  size_t i = (size_t)blockIdx.x * blockDim.x + TIDX;
  for (; i + 3 * stride < n4; i += 4 * stride) {
    f32x4 v[4];
#pragma unroll
    for (int q = 0; q < 4; ++q) v[q] = ((const f32x4*)in)[i + q * stride];
#pragma unroll
    for (int q = 0; q < 4; ++q) { u32x2 o = {pack2(v[q][0], v[q][1]), pack2(v[q][2], v[q][3])}; ((u32x2*)out)[i + q * stride] = o; }
  }
  for (; i < n4; i += stride) { const f32x4 v = ((const f32x4*)in)[i]; u32x2 o = {pack2(v[0], v[1]), pack2(v[2], v[3])}; ((u32x2*)out)[i] = o; }
}
__device__ void d_cvtT64(int vb, char* smem, const float* __restrict__ W, bf16_t* __restrict__ WT, int K, int N, int NP) {
  float (*tt)[65] = (float (*)[65])smem;
  const int tid = (TIDX & 255);
  const int nbx = NP / 64;
  const int n0 = (vb % nbx) * 64, k0 = (vb / nbx) * 64;
  {
    const int kr = tid >> 4, nc = (tid & 15) * 4;
#pragma unroll
    for (int i = 0; i < 4; ++i) {
      const int k = k0 + kr + 16 * i, n = n0 + nc;
      f32x4 v = {0.f, 0.f, 0.f, 0.f};
      if (n < N) v = *(const f32x4*)(W + (size_t)k * N + n);
      tt[kr + 16 * i][nc] = v[0]; tt[kr + 16 * i][nc + 1] = v[1]; tt[kr + 16 * i][nc + 2] = v[2]; tt[kr + 16 * i][nc + 3] = v[3];
    }
  }
  __syncthreads();
  {
    const int nr = tid >> 3, kc = (tid & 7) * 8;
#pragma unroll
    for (int i = 0; i < 2; ++i) {
      const int nl = nr + 32 * i;
      u32x4 o = {pack2(tt[kc][nl], tt[kc + 1][nl]), pack2(tt[kc + 2][nl], tt[kc + 3][nl]), pack2(tt[kc + 4][nl], tt[kc + 5][nl]), pack2(tt[kc + 6][nl], tt[kc + 7][nl])};
      *(u32x4*)(WT + (size_t)(n0 + nl) * K + k0 + kc) = o;
    }
  }
  __syncthreads();
}

using f32x16 = __attribute__((ext_vector_type(16))) float;
using bf16x8v = __attribute__((ext_vector_type(8))) __bf16;
#define MFMA32(a, b, c) __builtin_amdgcn_mfma_f32_32x32x16_bf16((a), (b), (c), 0, 0, 0)
constexpr float LOG2E = 1.4426950408889634f;
constexpr float NEGB = -1e30f;
DI int pi_perm(int i) { return (i & ~12) | ((i & 8) >> 1) | ((i & 4) << 1); }
DI bf16x8 pack8(float a0, float a1, float a2, float a3, float a4, float a5, float a6, float a7) {
  bf16x8v v = {(__bf16)a0, (__bf16)a1, (__bf16)a2, (__bf16)a3, (__bf16)a4, (__bf16)a5, (__bf16)a6, (__bf16)a7};
  return __builtin_bit_cast(bf16x8, v);
}
__device__ __forceinline__ void d_relayout_tile(int T, char* smem, const bf16_t* __restrict__ proj, int col0, bf16_t* __restrict__ dst, bool isV) {
  bf16_t* Ls = (bf16_t*)smem;
  const int tid = TIDX;
#pragma unroll
  for (int q = 0; q < 2; ++q) {
    const int cidx = tid + q * 512;
    const int g = cidx >> 9, tok = (cidx >> 4) & 31, ch = cidx & 15;
    const u32x4 v = *(const u32x4*)(proj + (size_t)(32 * T + tok) * INWP + col0 + g * 128 + ch * 8);
    *(u32x4*)(Ls + (g * 32 + tok) * 136 + ch * 8) = v;
  }
  __syncthreads();
#pragma unroll
  for (int q = 0; q < 2; ++q) {
    const int oc = tid + q * 512;
    const int g = oc >> 9, r9 = oc & 511, lane = r9 & 63;
    u32x4 o;
    if (!isV) {
      const int s8 = r9 >> 6, i = lane & 31, h = lane >> 5;
      o = *(const u32x4*)(Ls + (g * 32 + pi_perm(i)) * 136 + 16 * s8 + 8 * h);
    } else {
      const int s2 = (r9 >> 6) & 1, dt = r9 >> 7, dd = lane & 31, h = lane >> 5;
      const bf16_t* col = Ls + (g * 32 + 16 * s2 + 8 * h) * 136 + 32 * dt + dd;
      unsigned short e[8];
#pragma unroll
      for (int j = 0; j < 8; ++j) e[j] = col[j * 136];
      o.x = e[0] | ((unsigned)e[1] << 16); o.y = e[2] | ((unsigned)e[3] << 16); o.z = e[4] | ((unsigned)e[5] << 16); o.w = e[6] | ((unsigned)e[7] << 16);
    }
    *(u32x4*)(dst + (((size_t)(g * 512 + T)) * 512 + r9) * 8) = o;
  }
  __syncthreads();
}

struct AttnPtrs {
  const bf16_t* proj; const float* gates;
  const bf16_t *kcf, *vcf, *ksf, *vsf, *kwf, *vwf;
  bf16_t* mix; const float* hng;
};

DI float ex2(float x) { return __builtin_amdgcn_exp2f(x); }
DI void halves(float x, float& lo, float& hi) {
  const unsigned u = __float_as_uint(x);
  auto r = __builtin_amdgcn_permlane32_swap(u, u, false, false);
  lo = __uint_as_float(r[0]); hi = __uint_as_float(r[1]);
}
DI float hmax(float x) { float a, b; halves(x, a, b); return fmaxf(a, b); }
DI float hsum(float x) { float a, b; halves(x, a, b); return a + b; }
DI float dpp_quad(float v, int ctrl_is_xor1) {
  const int iv = __float_as_int(v);
  const int r = ctrl_is_xor1 ? __builtin_amdgcn_update_dpp(iv, iv, 0xB1, 0xF, 0xF, false) : __builtin_amdgcn_update_dpp(iv, iv, 0x4E, 0xF, 0xF, false);
  return __int_as_float(r);
}
DI float quad_sum(float v) { v += dpp_quad(v, 1); v += dpp_quad(v, 0); return v; }
DI void osm_step(const float (&sv)[16], float& m, float& l, f32x16 (&O)[4], float (&p)[16]) {
  float tmax = fmaxf(fmaxf(fmaxf(sv[0], sv[1]), fmaxf(sv[2], sv[3])), fmaxf(fmaxf(sv[4], sv[5]), fmaxf(sv[6], sv[7])));
  tmax = fmaxf(tmax, fmaxf(fmaxf(fmaxf(sv[8], sv[9]), fmaxf(sv[10], sv[11])), fmaxf(fmaxf(sv[12], sv[13]), fmaxf(sv[14], sv[15]))));
  tmax = hmax(tmax);
  if (__ballot(tmax - m > 8.f)) {
    const float mn = fmaxf(m, tmax);
    const float alpha = ex2(m - mn);
    l *= alpha; m = mn;
#pragma unroll
    for (int dt = 0; dt < 4; ++dt)
#pragma unroll
      for (int r = 0; r < 16; ++r) O[dt][r] *= alpha;
  }
  float ps0 = 0.f, ps1 = 0.f;
#pragma unroll
  for (int r = 0; r < 16; r += 2) { const float e0 = ex2(sv[r] - m), e1 = ex2(sv[r + 1] - m); p[r] = e0; p[r + 1] = e1; ps0 += e0; ps1 += e1; }
  l += ps0 + ps1;
}
DI void ot_store(char* otL, int lane, const f32x16 (&O)[4], float sc) {
#pragma unroll
  for (int dt = 0; dt < 4; ++dt) {
    u32x4 a, b;
#pragma unroll
    for (int i = 0; i < 4; ++i) { a[i] = pack2(sc * O[dt][2 * i], sc * O[dt][2 * i + 1]); b[i] = pack2(sc * O[dt][8 + 2 * i], sc * O[dt][8 + 2 * i + 1]); }
    *(u32x4*)(otL + lane * 128 + dt * 32) = a;
    *(u32x4*)(otL + lane * 128 + dt * 32 + 16) = b;
  }
}
DI void ot_accum(const char* otL, int lane, f32x16 (&O)[4], float sc) {
#pragma unroll
  for (int dt = 0; dt < 4; ++dt) {
    u32x4 a = *(const u32x4*)(otL + lane * 128 + dt * 32);
    u32x4 b = *(const u32x4*)(otL + lane * 128 + dt * 32 + 16);
#pragma unroll
    for (int i = 0; i < 4; ++i) {
      const unsigned wa = a[i], wb = b[i];
      O[dt][2 * i] = fmaf(sc, O[dt][2 * i], __uint_as_float(wa << 16));
      O[dt][2 * i + 1] = fmaf(sc, O[dt][2 * i + 1], __uint_as_float(wa & 0xFFFF0000u));
      O[dt][8 + 2 * i] = fmaf(sc, O[dt][8 + 2 * i], __uint_as_float(wb << 16));
      O[dt][8 + 2 * i + 1] = fmaf(sc, O[dt][8 + 2 * i + 1], __uint_as_float(wb & 0xFFFF0000u));
    }
  }
}
DI void zero_o(f32x16 (&O)[4]) {
#pragma unroll
  for (int dt = 0; dt < 4; ++dt)
#pragma unroll
    for (int i = 0; i < 16; ++i) O[dt][i] = 0.f;
}

constexpr int ATT_PW = 8704;
constexpr int ATT_R = 4, ATT_D = 3;
constexpr int ATT_RING = 8 * ATT_PW;
constexpr int ATT_LIST = ATT_RING + ATT_R * 16384;
constexpr int ATT_BUNI = ATT_LIST + 2048;
constexpr int ATT_SMEM = ATT_BUNI + 64;
#define LAS3 __attribute__((address_space(3)))
__device__ __forceinline__ void d_select(const float* impL, unsigned* mskL, unsigned* uniL, int cur) {
  const int lane = TIDX & 63;
  const int stok = lane >> 3, sub = lane & 7;
  unsigned key[32];
#pragma unroll
  for (int i4 = 0; i4 < 8; ++i4) {
    f32x4 v = *(const f32x4*)(impL + stok * 256 + sub * 32 + i4 * 4);
#pragma unroll
    for (int e = 0; e < 4; ++e) {
      const int j = sub * 32 + i4 * 4 + e;
      const bool valid = j <= cur;
      const bool forced = (j == 0) || (j == cur) || (j == cur - 1);
      unsigned kb = forced ? 0xFFFFFF00u : (__float_as_uint(v[e]) & 0xFFFFFF00u);
      key[i4 * 4 + e] = valid ? (kb | (unsigned)(255 - j)) : 0u;
    }
  }
#pragma unroll
  for (int k = 2; k <= 32; k <<= 1) {
#pragma unroll
    for (int jj = k >> 1; jj > 0; jj >>= 1) {
#pragma unroll
      for (int i = 0; i < 32; ++i) {
        const int l2 = i ^ jj;
        if (l2 > i) {
          const bool desc = ((i & k) == 0);
          unsigned a = key[i], b = key[l2];
          unsigned mx = a > b ? a : b, mn = a > b ? b : a;
          key[i] = desc ? mx : mn; key[l2] = desc ? mn : mx;
        }
      }
    }
  }
#pragma unroll
  for (int xm = 1; xm < 8; xm <<= 1) {
    unsigned L[16];
#pragma unroll
    for (int i = 0; i < 16; ++i) { unsigned o = (unsigned)shx_i((int)key[15 - i], xm); L[i] = key[i] > o ? key[i] : o; }
#pragma unroll
    for (int jj = 8; jj > 0; jj >>= 1) {
#pragma unroll
      for (int i = 0; i < 16; ++i) {
        const int l2 = i ^ jj;
        if (l2 > i) { unsigned a = L[i], b = L[l2]; L[i] = a > b ? a : b; L[l2] = a > b ? b : a; }
      }
    }
#pragma unroll
    for (int i = 0; i < 16; ++i) key[i] = L[i];
  }
#pragma unroll
  for (int i = 0; i < 16; ++i) {
    if ((i & 7) == sub) {
      const int j = 255 - (int)(key[i] & 255u);
      if (j <= cur) { atomicOr(&mskL[stok * 8 + (j >> 5)], 1u << (j & 31)); atomicOr(&uniL[j >> 5], 1u << (j & 31)); }
    }
  }
}


DI void att_issue(LAS3 unsigned char* ring, int slot, int w, int lane, const bf16_t* kb, const bf16_t* vb, int tile) {
  const char* ks = (const char*)kb + (size_t)tile * 8192 + w * 1024 + lane * 16;
  const char* vs = (const char*)vb + (size_t)tile * 8192 + w * 1024 + lane * 16;
  __builtin_amdgcn_global_load_lds((const unsigned*)ks, (LAS3 unsigned*)(ring + slot * 16384 + w * 1024), 16, 0, 0);
  __builtin_amdgcn_global_load_lds((const unsigned*)vs, (LAS3 unsigned*)(ring + slot * 16384 + 8192 + w * 1024), 16, 0, 0);
}
DI f32x16 qk_lds(LAS3 const unsigned char* kt, const bf16x8 (&qf)[8], int lane) {
  f32x16 acc;
#pragma unroll
  for (int i = 0; i < 16; ++i) acc[i] = 0.f;
#pragma unroll
  for (int s8 = 0; s8 < 8; ++s8) {
    const bf16x8 kf = *(LAS3 const bf16x8*)(kt + s8 * 1024 + lane * 16);
    acc = MFMA32(kf, qf[s8], acc);
  }
  return acc;
}
DI void pv_lds(LAS3 const unsigned char* vt, const float (&p)[16], f32x16 (&O)[4], int lane) {
  const bf16x8 pf0 = pack8(p[0], p[1], p[2], p[3], p[4], p[5], p[6], p[7]);
  const bf16x8 pf1 = pack8(p[8], p[9], p[10], p[11], p[12], p[13], p[14], p[15]);
#pragma unroll
  for (int dt = 0; dt < 4; ++dt) {
    const bf16x8 v0 = *(LAS3 const bf16x8*)(vt + (dt * 2) * 1024 + lane * 16);
    const bf16x8 v1 = *(LAS3 const bf16x8*)(vt + (dt * 2 + 1) * 1024 + lane * 16);
    O[dt] = MFMA32(v0, pf0, O[dt]);
    O[dt] = MFMA32(v1, pf1, O[dt]);
  }
}

__device__ __forceinline__ void d_attn_block(int B, int g, char* smem, const AttnPtrs& P) {
  const int tid = TIDX, lane = tid & 63, w = tid >> 6;
  const int c = lane & 31, h = lane >> 5, tokl = c >> 2, r = c & 3;
  const int tok0 = 64 * B + 8 * w;
  const int t = tok0 + tokl, hd = g * 4 + r;
  const float slope2 = exp2f(-(float)(hd + 1)) * LOG2E;
  const float c1 = QSCALE * LOG2E;
  const float ninf = -__builtin_inff();
  char* wsm = smem + w * ATT_PW;
  float* impL = (float*)wsm;
  char* otL = wsm;
  unsigned* mskL = (unsigned*)(wsm + 8192);
  unsigned* uniL = mskL + 64;
  LAS3 unsigned char* ring = (LAS3 unsigned char*)(smem + ATT_RING);
  unsigned short* tl = (unsigned short*)(smem + ATT_LIST);
  unsigned* buni = (unsigned*)(smem + ATT_BUNI);
  const bf16_t* kcf = P.kcf + (size_t)g * 32 * 4096;
  const bf16_t* vcf = P.vcf + (size_t)g * 32 * 4096;
  const bf16_t* ksf = P.ksf + (size_t)g * 512 * 4096;
  const bf16_t* vsf = P.vsf + (size_t)g * 512 * 4096;
  const bf16_t* kwf = P.kwf + (size_t)g * 512 * 4096;
  const bf16_t* vwf = P.vwf + (size_t)g * 512 * 4096;
  bf16x8 qf[8];
  {
    const bf16_t* qrow = P.proj + (size_t)t * INWP + OFF_Q + hd * 128 + 8 * h;
#pragma unroll
    for (int s8 = 0; s8 < 8; ++s8) qf[s8] = *(const bf16x8*)(qrow + 16 * s8);
  }
  const float* gt = P.gates + (size_t)t * 24 + hd * 3;
  const float g0 = gt[0], g1 = gt[1], g2 = gt[2];
  {
    unsigned z0 = 0u;
    asm volatile("" : "+v"(z0));
    u32x4 z = {z0, z0, z0, z0};
#pragma unroll
    for (int i = 0; i < 8; ++i) *(u32x4*)(wsm + (i * 64 + lane) * 16) = z;
    if (lane < 18) *(u32x4*)(wsm + 8192 + lane * 16) = z;
    if (tid < 8) buni[tid] = z0;
  }
  f32x16 Ob[4];
  zero_o(Ob);
  const int nmax = (t >= 31) ? ((t - 31) >> 4) : -1;
  const int nmaxw = (tok0 + 7 >= 31) ? ((tok0 + 7 - 31) >> 4) : -1;
  const int nminw = (tok0 >= 31) ? ((tok0 - 31) >> 4) : -1;
  const int ntcw = (nmaxw + 32) >> 5;
  const int ntcB = (((64 * B + 63 - 31) >> 4) + 32) >> 5;
  const float sl16 = slope2 * 16.f;
  float mC = NEGB, lC = 0.f, invC = 0.f, carry = 0.f;
  {
    const int n = 2 * ntcB;
    asm volatile("s_waitcnt vmcnt(0)" ::: "memory");
#define A_TILE(i_) (((i_) < ntcB) ? (ntcB - 1 - (i_)) : ((i_) - ntcB))
    att_issue(ring, 0, w, lane, kcf, vcf, A_TILE(0));
    if (n > 1) att_issue(ring, 1, w, lane, kcf, vcf, A_TILE(1));
#pragma unroll 1
    for (int i = 0; i < n; ++i) {
      if ((i & 1) == 0) {
        asm volatile("s_waitcnt vmcnt(0)" ::: "memory");
        __builtin_amdgcn_s_barrier();
        asm volatile("" ::: "memory");
        if (i + 2 < n) att_issue(ring, (i + 2) & 3, w, lane, kcf, vcf, A_TILE(i + 2));
        if (i + 3 < n) att_issue(ring, (i + 3) & 3, w, lane, kcf, vcf, A_TILE(i + 3));
      }
      const int T = A_TILE(i);
      if (T >= ntcw) continue;
      LAS3 const unsigned char* slot = ring + (i % ATT_R) * 16384;
      const f32x16 acc = qk_lds(slot, qf, lane);
      const float base = slope2 * (float)(512 * T + 128 * h) + slope2 * (15.5f - (float)t);
      const int nb = 32 * T + 8 * h;
      const bool full = (32 * T + 31 <= nminw);
      float sv[16];
#pragma unroll
      for (int rg = 0; rg < 16; ++rg) { const int kk = (rg & 7) + 16 * (rg >> 3); sv[rg] = fmaf(acc[rg], c1, fmaf(sl16, (float)kk, base)); }
      if (!full) {
#pragma unroll
        for (int rg = 0; rg < 16; ++rg) { const int kk = (rg & 7) + 16 * (rg >> 3); sv[rg] = (nb + kk <= nmax) ? sv[rg] : ninf; }
      }
      if (i < ntcB) {
        float tmax = fmaxf(fmaxf(fmaxf(sv[0], sv[1]), fmaxf(sv[2], sv[3])), fmaxf(fmaxf(sv[4], sv[5]), fmaxf(sv[6], sv[7])));
        tmax = fmaxf(tmax, fmaxf(fmaxf(fmaxf(sv[8], sv[9]), fmaxf(sv[10], sv[11])), fmaxf(fmaxf(sv[12], sv[13]), fmaxf(sv[14], sv[15]))));
        tmax = hmax(tmax);
        const float mn = fmaxf(mC, tmax);
        float ps = 0.f;
#pragma unroll
        for (int rg = 0; rg < 16; ++rg) ps += ex2(sv[rg] - mn);
        lC = lC * ex2(mC - mn) + ps; mC = mn;
      } else {
        if (T == 0) { lC = hsum(lC); invC = (lC > 0.f) ? 1.f / lC : 0.f; }
        float p[16];
#pragma unroll
        for (int rg = 0; rg < 16; ++rg) p[rg] = ex2(sv[rg] - mC) * invC;
        float Ga = (p[0] + p[1]) + (p[2] + p[3]), Gb = (p[4] + p[5]) + (p[6] + p[7]);
        float Gc = (p[8] + p[9]) + (p[10] + p[11]), Gd = (p[12] + p[13]) + (p[14] + p[15]);
        float xb, xd; { float a_, b_; halves(p[7], a_, b_); xb = h ? a_ : b_; halves(p[15], a_, b_); xd = h ? a_ : b_; }
        float ia = Ga + (h ? xb : carry);
        float ib = Gb + p[3];
        float ic = Gc + (h ? xd : xb);
        float id = Gd + p[11];
        carry = xd;
        ia = quad_sum(ia); ib = quad_sum(ib); ic = quad_sum(ic); id = quad_sum(id);
        {
          float val = (r == 0) ? ia : (r == 1) ? ib : (r == 2) ? ic : id;
          int j = 8 * T + 2 * h + ((r == 0) ? 0 : (r == 1) ? 1 : (r == 2) ? 4 : 5);
          impL[tokl * 256 + j] = val;
        }
        pv_lds(slot + 8192, p, Ob, lane);
      }
    }
#undef A_TILE
  }
  const int cur = B;
  d_select(impL, mskL, uniL, cur);
  ot_store(otL, lane, Ob, g0);
  zero_o(Ob);
  if (lane < 8) { const unsigned u = uniL[lane]; if (u) atomicOr(&buni[lane], u); }
  __syncthreads();
  int nslc = 0, ntl = 0;
  {
    for (int iw = 7; iw >= 0; --iw) {
      unsigned iuw = __builtin_amdgcn_readfirstlane(buni[iw]);
      while (iuw) {
        const int bit = 31 - __builtin_clz(iuw);
        iuw &= ~(1u << bit);
        const int bb = 32 * iw + bit;
        if (bb < B) { if (lane == 0) tl[ntl] = (unsigned short)(2 * bb + 1); ++ntl; }
        else { if (lane == 0) tl[ntl] = (unsigned short)(2 * bb + 1); ++ntl; }
        if (lane == 0) tl[ntl] = (unsigned short)(2 * bb);
        ++ntl;
      }
    }
    nslc = ntl;
    const int ThiB = 2 * B + 1, TloB = ((64 * B - 511 > 0) ? (64 * B - 511) : 0) >> 5;
    for (int T = ThiB; T >= TloB; --T) { if (lane == 0) tl[ntl] = (unsigned short)T; ++ntl; }
  }
  float m = NEGB, l = 0.f;
  {
    const int n = ntl;
    const int Tlow = ((tok0 - 511 > 0) ? (tok0 - 511) : 0) >> 5, Thiw = (tok0 + 7) >> 5;
#define B_ISSUE(j_, slot_) { const int e_ = __builtin_amdgcn_readfirstlane((int)tl[j_]); if ((j_) < nslc) att_issue(ring, slot_, w, lane, ksf, vsf, e_); else att_issue(ring, slot_, w, lane, kwf, vwf, e_); }
    B_ISSUE(0, 0)
    if (n > 1) B_ISSUE(1, 1)
#pragma unroll 1
    for (int i = 0; i < n; ++i) {
      if ((i & 1) == 0) {
        asm volatile("s_waitcnt vmcnt(0)" ::: "memory");
        __builtin_amdgcn_s_barrier();
        asm volatile("" ::: "memory");
        if (i + 2 < n) B_ISSUE(i + 2, (i + 2) & 3)
        if (i + 3 < n) B_ISSUE(i + 3, (i + 3) & 3)
      }
      if (i == nslc) {
        l = hsum(l);
        const float inv = (l > 0.f) ? g1 / l : 0.f;
        ot_accum(otL, lane, Ob, inv);
        ot_store(otL, lane, Ob, 1.f);
        zero_o(Ob);
        m = NEGB; l = 0.f;
      }
      const int T = __builtin_amdgcn_readfirstlane((int)tl[i]);
      const int pos0 = 32 * T, pb = pos0 + 8 * h;
      bool full; bool mine = true;
      if (i < nslc) {
        const int bb = T >> 1;
        const unsigned uw = __builtin_amdgcn_readfirstlane(uniL[bb >> 5]);
        if (!((uw >> (bb & 31)) & 1u) || pos0 > tok0 + 7) continue;
        mine = (mskL[tokl * 8 + (bb >> 5)] >> (bb & 31)) & 1u;
        full = (pos0 + 31 <= tok0) && (__ballot(!mine) == 0ull);
      } else {
        if (T < Tlow || T > Thiw) continue;
        full = (pos0 + 31 <= tok0) && (pos0 >= tok0 + 7 - 511);
      }
      LAS3 const unsigned char* slot = ring + (i % ATT_R) * 16384;
      const f32x16 acc = qk_lds(slot, qf, lane);
      const float base = slope2 * (float)(pos0 + 8 * h - t);
      float sv[16], p[16];
#pragma unroll
      for (int rg = 0; rg < 16; ++rg) { const int kk = (rg & 7) + 16 * (rg >> 3); sv[rg] = fmaf(acc[rg], c1, fmaf(slope2, (float)kk, base)); }
      if (!full) {
        if (i < nslc) {
#pragma unroll
          for (int rg = 0; rg < 16; ++rg) { const int kk = (rg & 7) + 16 * (rg >> 3); sv[rg] = (mine && (pb + kk <= t)) ? sv[rg] : ninf; }
        } else {
#pragma unroll
          for (int rg = 0; rg < 16; ++rg) { const int kk = (rg & 7) + 16 * (rg >> 3); const int dw = t - (pb + kk); sv[rg] = ((dw >= 0) && (dw < 512)) ? sv[rg] : ninf; }
        }
      }
      osm_step(sv, m, l, Ob, p);
      pv_lds(slot + 8192, p, Ob, lane);
    }
#undef B_ISSUE
    l = hsum(l);
    const float inv = (l > 0.f) ? g2 / l : 0.f;
    ot_accum(otL, lane, Ob, inv);
  }
  {
    float ss = 0.f;
#pragma unroll
    for (int dt = 0; dt < 4; ++dt)
#pragma unroll
      for (int i = 0; i < 16; ++i) ss = fmaf(Ob[dt][i], Ob[dt][i], ss);
    ss = hsum(ss);
    const float rs = rsqrtf(ss * (1.f / 128.f) + 1e-6f);
    bf16_t* orow = P.mix + (size_t)t * DM + hd * 128 + 4 * h;
    const float* grow = P.hng + hd * 128 + 4 * h;
#pragma unroll
    for (int dt = 0; dt < 4; ++dt)
#pragma unroll
      for (int a = 0; a < 4; ++a) {
        const f32x4 gv = *(const f32x4*)(grow + 32 * dt + 8 * a);
        u32x2 wv2 = {pack2(Ob[dt][4 * a] * rs * gv[0], Ob[dt][4 * a + 1] * rs * gv[1]), pack2(Ob[dt][4 * a + 2] * rs * gv[2], Ob[dt][4 * a + 3] * rs * gv[3])};
        *(u32x2*)(orow + 32 * dt + 8 * a) = wv2;
      }
  }
  asm volatile("s_waitcnt vmcnt(0)" ::: "memory");
  __syncthreads();
}

__device__ void d_convmix(int t, int tl, const bf16_t* __restrict__ proj, const float* __restrict__ convw, const float* __restrict__ hng,
                          bf16_t* __restrict__ mix) {
  const int c = tl * 8;
  float acc[8];
#pragma unroll
  for (int i = 0; i < 8; ++i) acc[i] = 0.f;
#pragma unroll
  for (int j = 0; j < 3; ++j) {
    const int tt = t - 2 + j;
    if (tt >= 0) {
      const u32x4 cu = *(const u32x4*)(proj + (size_t)tt * INWP + OFF_C + c);
      const u32x4 uu = *(const u32x4*)(proj + (size_t)tt * INWP + OFF_U + c);
      const f32x4 w0 = *(const f32x4*)(convw + j * 1024 + c), w1 = *(const f32x4*)(convw + j * 1024 + c + 4);
#pragma unroll
      for (int i = 0; i < 4; ++i) {
        const unsigned a = cu[i], b = uu[i];
        const float wl = (i < 2) ? w0[2 * i] : w1[2 * i - 4], wh = (i < 2) ? w0[2 * i + 1] : w1[2 * i - 3];
        acc[2 * i] = fmaf(wl * __uint_as_float(a << 16), __uint_as_float(b << 16), acc[2 * i]);
        acc[2 * i + 1] = fmaf(wh * __uint_as_float(a & 0xFFFF0000u), __uint_as_float(b & 0xFFFF0000u), acc[2 * i + 1]);
      }
    }
  }
  const u32x4 bb = *(const u32x4*)(proj + (size_t)t * INWP + OFF_B + c);
  float ss = 0.f;
#pragma unroll
  for (int i = 0; i < 4; ++i) {
    const unsigned b = bb[i];
    acc[2 * i] *= __uint_as_float(b << 16); acc[2 * i + 1] *= __uint_as_float(b & 0xFFFF0000u);
    ss = fmaf(acc[2 * i], acc[2 * i], ss); ss = fmaf(acc[2 * i + 1], acc[2 * i + 1], ss);
  }
  ss += shx(ss, 8); ss += shx(ss, 4); ss += shx(ss, 2); ss += shx(ss, 1);
  const float rs = rsqrtf(ss * (1.f / 128.f) + 1e-6f);
  const f32x4 g0 = *(const f32x4*)(hng + 1024 + c), g1 = *(const f32x4*)(hng + 1024 + c + 4);
  u32x4 o = {pack2(acc[0] * rs * g0[0], acc[1] * rs * g0[1]), pack2(acc[2] * rs * g0[2], acc[3] * rs * g0[3]),
             pack2(acc[4] * rs * g1[0], acc[5] * rs * g1[1]), pack2(acc[6] * rs * g1[2], acc[7] * rs * g1[3])};
  *(u32x4*)(mix + (size_t)t * DM + 1024 + c) = o;
}

__device__ void d_ln_wave(int t, bf16_t* __restrict__ yh, const float* __restrict__ gam, const float* __restrict__ bet) {
  const int lane = TIDX & 63;
  float v[32];
#pragma unroll
  for (int i = 0; i < 4; ++i) {
    const u32x4 w = *(const u32x4*)(yh + (size_t)t * DM + 512 * i + 8 * lane);
#pragma unroll
    for (int j = 0; j < 4; ++j) { const unsigned ww = w[j]; v[i * 8 + 2 * j] = __uint_as_float(ww << 16); v[i * 8 + 2 * j + 1] = __uint_as_float(ww & 0xFFFF0000u); }
  }
  float s = 0.f;
#pragma unroll
  for (int i = 0; i < 32; ++i) s += v[i];
  s = wave_sum(s);
  const float mu = s * (1.f / DM);
  float q = 0.f;
#pragma unroll
  for (int i = 0; i < 32; ++i) { const float d = v[i] - mu; q = fmaf(d, d, q); }
  q = wave_sum(q);
  const float rs = rsqrtf(q * (1.f / DM) + 1e-5f);
#pragma unroll
  for (int i = 0; i < 4; ++i) {
    const int cb = 512 * i + 8 * lane;
    const f32x4 g0 = *(const f32x4*)(gam + cb), g1 = *(const f32x4*)(gam + cb + 4), b0 = *(const f32x4*)(bet + cb), b1 = *(const f32x4*)(bet + cb + 4);
    u32x4 o = {pack2((v[i * 8 + 0] - mu) * rs * g0[0] + b0[0], (v[i * 8 + 1] - mu) * rs * g0[1] + b0[1]), pack2((v[i * 8 + 2] - mu) * rs * g0[2] + b0[2], (v[i * 8 + 3] - mu) * rs * g0[3] + b0[3]),
               pack2((v[i * 8 + 4] - mu) * rs * g1[0] + b1[0], (v[i * 8 + 5] - mu) * rs * g1[1] + b1[1]), pack2((v[i * 8 + 6] - mu) * rs * g1[2] + b1[2], (v[i * 8 + 7] - mu) * rs * g1[3] + b1[3])};
    *(u32x4*)(yh + (size_t)t * DM + cb) = o;
  }
}

__device__ void d_cvt_w1f(size_t c, const float* __restrict__ w1, bf16_t* __restrict__ w1f) {
  const int lane = c & 63, ks = (c >> 6) & 255, ct = c >> 14;
  const int col = lane & 31, h = lane >> 5;
  bf16_t v[8];
#pragma unroll
  for (int j = 0; j < 8; ++j) v[j] = f2bf(w1[(size_t)(16 * ks + 8 * h + j) * 512 + 32 * ct + col]);
  u32x4 o; o.x = v[0] | ((unsigned)v[1] << 16); o.y = v[2] | ((unsigned)v[3] << 16); o.z = v[4] | ((unsigned)v[5] << 16); o.w = v[6] | ((unsigned)v[7] << 16);
  *(u32x4*)(w1f + c * 8) = o;
}
__device__ void d_cvt_w2f(size_t c, const float* __restrict__ w2, bf16_t* __restrict__ w2f) {
  const int lane = c & 63, s = (c >> 6) & 31, ct = c >> 11;
  const int col = lane & 31, h = lane >> 5;
  bf16_t v[8];
#pragma unroll
  for (int j = 0; j < 8; ++j) v[j] = f2bf(w2[(size_t)(16 * s + 8 * h + j) * 128 + 32 * ct + col]);
  u32x4 o; o.x = v[0] | ((unsigned)v[1] << 16); o.y = v[2] | ((unsigned)v[3] << 16); o.z = v[4] | ((unsigned)v[5] << 16); o.w = v[6] | ((unsigned)v[7] << 16);
  *(u32x4*)(w2f + c * 8) = o;
}
__device__ __forceinline__ void d_compress_unit(int rt, char* smem, const bf16_t* __restrict__ proj, int col0, const float* __restrict__ pos,
                                const bf16_t* __restrict__ w1f, const float* __restrict__ b1, const bf16_t* __restrict__ w2f,
                                bf16_t* __restrict__ outf, bool isV) {
  bf16_t* Xs = (bf16_t*)smem;
  bf16_t* Hs = (bf16_t*)(smem + 2 * 8704);
  const int tid = TIDX, lane = tid & 63, w = tid >> 6, c = lane & 31, h = lane >> 5;
  const int R0 = rt * 32;
  const int srow = tid >> 4, sch = tid & 15;
  const int grow = R0 + srow, sn = grow >> 1, sg = grow & 1;
  const bool svalid = grow < 2046;
  const bf16_t* sp = proj + (size_t)(16 * sn) * INWP + col0 + sg * 128 + sch * 8;
  f32x16 acc0, acc1;
#pragma unroll
  for (int i = 0; i < 16; ++i) { acc0[i] = 0.f; acc1[i] = 0.f; }
  u32x4 rx = {0u, 0u, 0u, 0u}; f32x4 rp0, rp1;
#define STAGE_WRITE(buf)                                                                                   \
  {                                                                                                        \
    u32x4 o_;                                                                                              \
    _Pragma("unroll") for (int i = 0; i < 4; ++i) {                                                        \
      const unsigned wv_ = rx[i];                                                                          \
      const float lo = __uint_as_float(wv_ << 16) + ((i < 2) ? rp0[2 * i] : rp1[2 * i - 4]);               \
      const float hi = __uint_as_float(wv_ & 0xFFFF0000u) + ((i < 2) ? rp0[2 * i + 1] : rp1[2 * i - 3]);   \
      o_[i] = pack2(lo, hi);                                                                               \
    }                                                                                                      \
    *(u32x4*)(Xs + (buf) * 4352 + srow * 136 + sch * 8) = o_;                                              \
  }
  if (svalid) rx = *(const u32x4*)(sp);
  rp0 = *(const f32x4*)(pos + sch * 8); rp1 = *(const f32x4*)(pos + sch * 8 + 4);
  STAGE_WRITE(0)
  __syncthreads();
  const bf16_t* wb0 = w1f + ((size_t)(2 * w) * 256 * 64 + lane) * 8;
  const bf16_t* wb1 = w1f + ((size_t)(2 * w + 1) * 256 * 64 + lane) * 8;
  bf16x8 bA[16], bB[16];
#define CMP_LOADB(BUF, L)                                                                      \
  _Pragma("unroll") for (int s8 = 0; s8 < 8; ++s8) {                                           \
    BUF[2 * s8] = *(const bf16x8*)(wb0 + (size_t)(8 * (L) + s8) * 512);                        \
    BUF[2 * s8 + 1] = *(const bf16x8*)(wb1 + (size_t)(8 * (L) + s8) * 512);                    \
  }
#define CMP_CHUNK(BUF, L)                                                                      \
  {                                                                                            \
    if ((L) + 1 < 32) {                                                                        \
      if (svalid) rx = *(const u32x4*)(sp + (size_t)((L) + 1) * INWP);                         \
      rp0 = *(const f32x4*)(pos + ((L) + 1) * 128 + sch * 8); rp1 = *(const f32x4*)(pos + ((L) + 1) * 128 + sch * 8 + 4); \
    }                                                                                          \
    const bf16_t* xa = Xs + ((L) & 1) * 4352 + c * 136 + 8 * h;                                \
    _Pragma("unroll") for (int s8 = 0; s8 < 8; ++s8) {                                         \
      const bf16x8 a = *(const bf16x8*)(xa + 16 * s8);                                         \
      acc0 = MFMA32(a, BUF[2 * s8], acc0);                                                     \
      acc1 = MFMA32(a, BUF[2 * s8 + 1], acc1);                                                 \
    }                                                                                          \
    if ((L) + 1 < 32) STAGE_WRITE(((L) + 1) & 1)                                               \
    __syncthreads();                                                                           \
  }
  CMP_LOADB(bA, 0)
#pragma unroll 1
  for (int l = 0; l < 32; l += 2) {
    CMP_LOADB(bB, l + 1)
    __builtin_amdgcn_sched_barrier(0);
    CMP_CHUNK(bA, l)
    { const int ln = (l + 2 < 32) ? l + 2 : l;
      CMP_LOADB(bA, ln) }
    __builtin_amdgcn_sched_barrier(0);
    CMP_CHUNK(bB, l + 1)
  }
#undef CMP_LOADB
#undef CMP_CHUNK
  {
    const float bb0 = b1[64 * w + c], bb1 = b1[64 * w + 32 + c];
#pragma unroll
    for (int rg = 0; rg < 16; ++rg) {
      const int row = (rg & 3) + 8 * (rg >> 2) + 4 * h;
      Hs[row * 520 + 64 * w + c] = f2bf(gelu_tanh(acc0[rg] + bb0));
      Hs[row * 520 + 64 * w + 32 + c] = f2bf(gelu_tanh(acc1[rg] + bb1));
    }
  }
  __syncthreads();
  if (w < 4) {
    f32x16 o2;
#pragma unroll
    for (int i = 0; i < 16; ++i) o2[i] = 0.f;
    const bf16_t* ha = Hs + c * 520 + 8 * h;
    const bf16_t* wb = w2f + ((size_t)w * 32 * 64 + lane) * 8;
#pragma unroll 8
    for (int s2 = 0; s2 < 32; ++s2) {
      const bf16x8 a = *(const bf16x8*)(ha + 16 * s2);
      const bf16x8 b = *(const bf16x8*)(wb + (size_t)s2 * 512);
      o2 = MFMA32(a, b, o2);
    }
    const int d = 32 * w + c;
#pragma unroll
    for (int rg = 0; rg < 16; ++rg) {
      const int row = R0 + (rg & 3) + 8 * (rg >> 2) + 4 * h;
      const int n = row >> 1, g = row & 1;
      const bf16_t val = (row < 2046) ? f2bf(o2[rg]) : (bf16_t)0;
      const int T = n >> 5, nn = n & 31;
      size_t idx;
      if (!isV) idx = ((((size_t)(g * 32 + T) * 8 + (d >> 4)) * 64 + (pi_perm(nn) + 32 * ((d >> 3) & 1))) * 8 + (d & 7));
      else idx = (((((size_t)(g * 32 + T) * 4 + (d >> 5)) * 2 + (nn >> 4)) * 64 + ((d & 31) + 32 * ((nn >> 3) & 1))) * 8 + (nn & 7));
      outf[idx] = val;
    }
  }
  __syncthreads();
}


DI unsigned f2sort(float f) { unsigned u = __float_as_uint(f); return u ^ ((unsigned)((int)u >> 31) | 0x80000000u); }
DI float sort2f(unsigned k) { unsigned u = (k & 0x80000000u) ? (k ^ 0x80000000u) : ~k; return __uint_as_float(u); }
template <int N>
DI void bitonic_sort_desc(unsigned (&key)[N]) {
#pragma unroll
  for (int k = 2; k <= N; k <<= 1) {
#pragma unroll
    for (int jj = k >> 1; jj > 0; jj >>= 1) {
#pragma unroll
      for (int i = 0; i < N; ++i) {
        const int l2 = i ^ jj;
        if (l2 > i) {
          const bool desc = ((i & k) == 0);
          unsigned a = key[i], b = key[l2];
          unsigned mx = a > b ? a : b, mn = a > b ? b : a;
          key[i] = desc ? mx : mn; key[l2] = desc ? mn : mx;
        }
      }
    }
  }
}
DI void merge_top16(unsigned (&a)[16], const unsigned (&b)[16]) {
#pragma unroll
  for (int i = 0; i < 16; ++i) { unsigned o = b[15 - i]; a[i] = a[i] > o ? a[i] : o; }
#pragma unroll
  for (int jj = 8; jj > 0; jj >>= 1) {
#pragma unroll
    for (int i = 0; i < 16; ++i) {
      const int l2 = i ^ jj;
      if (l2 > i) { unsigned x = a[i], y = a[l2]; a[i] = x > y ? x : y; a[l2] = x > y ? y : x; }
    }
  }
}
__device__ void d_cvt_subk(size_t c, const float* __restrict__ subk, bf16_t* __restrict__ skf) {
  int lane = c & 63, s = (c >> 6) & 7, kt = (c >> 9) & 3, hc = c >> 11;
  int i = lane & 31, h = lane >> 5;
  const float* src = subk + ((size_t)hc * 128 + 32 * kt + i) * 128 + 16 * s + 8 * h;
  bf16_t v[8];
#pragma unroll
  for (int j = 0; j < 8; ++j) v[j] = f2bf(src[j]);
  u32x4 o; o.x = v[0] | ((unsigned)v[1] << 16); o.y = v[2] | ((unsigned)v[3] << 16); o.z = v[4] | ((unsigned)v[5] << 16); o.w = v[6] | ((unsigned)v[7] << 16);
  *(u32x4*)(skf + c * 8) = o;
}

struct EpiProjG {
  static constexpr bool PERM = true, AFTER_DRAIN = false;
  bf16_t* proj; float* gates;
  DI void operator()(const f32x4 (&acc)[2][2][4][2], const pg8::Unit& u, int wr, int wc, int fr, int fq) const {
#pragma unroll
    for (int ai = 0; ai < 2; ++ai)
#pragma unroll
      for (int m = 0; m < 4; ++m) {
        const int row = u.pm * 256 + ai * 128 + wr * 64 + m * 16 + fr;
#pragma unroll
        for (int bj = 0; bj < 2; ++bj) {
          const int c0 = u.pn * 256 + bj * 128 + wc * 32 + 8 * fq;
          const f32x4 v0 = acc[ai][bj][m][0], v1 = acc[ai][bj][m][1];
          if (c0 < INW) {
            u32x4 w = {pack2(v0[0], v0[1]), pack2(v0[2], v0[3]), pack2(v1[0], v1[1]), pack2(v1[2], v1[3])};
            *(u32x4*)(proj + (size_t)row * INWP + c0) = w;
          }
          if (c0 >= OFF_G && c0 < OFF_G + 24) {
            f32x4 g0, g1;
#pragma unroll
            for (int j = 0; j < 4; ++j) { g0[j] = 1.f / (1.f + __expf(-v0[j])); g1[j] = 1.f / (1.f + __expf(-v1[j])); }
            *(f32x4*)(gates + (size_t)row * 24 + (c0 - OFF_G)) = g0;
            *(f32x4*)(gates + (size_t)row * 24 + (c0 - OFF_G) + 4) = g1;
          }
        }
      }
  }
};
struct EpiResG {
  static constexpr bool PERM = false, AFTER_DRAIN = false;
  bf16_t* YB;
  DI void operator()(const f32x4 (&acc)[2][2][4][2], const pg8::Unit& u, int wr, int wc, int fr, int fq) const {
#pragma unroll
    for (int ai = 0; ai < 2; ++ai)
#pragma unroll
      for (int m = 0; m < 4; ++m) {
        const size_t ro = (size_t)(u.pm * 256 + ai * 128 + wr * 64 + m * 16 + fr) * DM + u.pn * 256 + wc * 32 + 4 * fq;
#pragma unroll
        for (int bj = 0; bj < 2; ++bj)
#pragma unroll
          for (int n = 0; n < 2; ++n) {
            const u32x2 xw = *(const u32x2*)(YB + ro + bj * 128 + n * 16);
            const f32x4 xv = {__uint_as_float(xw[0] << 16), __uint_as_float(xw[0] & 0xFFFF0000u), __uint_as_float(xw[1] << 16), __uint_as_float(xw[1] & 0xFFFF0000u)};
            const f32x4 yv = ALPHA * xv + acc[ai][bj][m][n];
            u32x2 o = {pack2(yv[0], yv[1]), pack2(yv[2], yv[3])};
            *(u32x2*)(YB + ro + bj * 128 + n * 16) = o;
          }
      }
  }
};
struct EpiF32G {
  static constexpr bool PERM = false, AFTER_DRAIN = false;
  float* C; int ldc;
  DI void operator()(const f32x4 (&acc)[2][2][4][2], const pg8::Unit& u, int wr, int wc, int fr, int fq) const {
#pragma unroll
    for (int ai = 0; ai < 2; ++ai)
#pragma unroll
      for (int m = 0; m < 4; ++m) {
        const size_t ro = (size_t)(u.pm * 256 + ai * 128 + wr * 64 + m * 16 + fr) * ldc + u.pn * 256 + wc * 32 + 4 * fq;
#pragma unroll
        for (int bj = 0; bj < 2; ++bj)
#pragma unroll
          for (int n = 0; n < 2; ++n) *(f32x4*)(C + ro + bj * 128 + n * 16) = acc[ai][bj][m][n];
      }
  }
};
struct EpiRouteG {
  static constexpr bool PERM = false, AFTER_DRAIN = true;
  const bf16_t* skf; unsigned* tops;
  DI void operator()(const f32x4 (&)[2][2][4][2], const pg8::Unit&, int, int, int, int) const {}
  DI void fused(const f32x4 (&acc)[2][2][4][2], const pg8::Unit& u, int wr, int wc, int fr, int fq, PG8_LAS unsigned char* ldsp, int, int) const {
    const int lane = fr | (fq << 4), wid = wr * 4 + wc;
    bf16_t* Qs = (bf16_t*)ldsp;
#pragma unroll
    for (int ai = 0; ai < 2; ++ai)
#pragma unroll
      for (int m = 0; m < 4; ++m) {
        const int row = ai * 128 + wr * 64 + m * 16 + fr;
#pragma unroll
        for (int bj = 0; bj < 2; ++bj)
#pragma unroll
          for (int n = 0; n < 2; ++n) {
            const f32x4 v = acc[ai][bj][m][n];
            u32x2 w = {pack2(v[0], v[1]), pack2(v[2], v[3])};
            *(u32x2*)(Qs + row * 264 + bj * 128 + wc * 32 + n * 16 + 4 * fq) = w;
          }
      }
    __syncthreads();
    const int c = lane & 31, h = lane >> 5;
#pragma unroll 1
    for (int half = 0; half < 2; ++half) {
      const int hc = u.pn * 2 + half;
      const bf16_t* sk = skf + (size_t)hc * 4 * 4096;
      const bf16_t* qp = Qs + (wid * 32 + c) * 264 + half * 128 + 8 * h;
      unsigned k0[16], k1[16];
#define ROUTE_KT(KT, KA)                                                                        \
      {                                                                                         \
        f32x16 sc;                                                                              \
        _Pragma("unroll") for (int i = 0; i < 16; ++i) sc[i] = 0.f;                             \
        _Pragma("unroll") for (int s = 0; s < 8; ++s) {                                         \
          bf16x8 af = *(const bf16x8*)(sk + (KT) * 4096 + s * 512 + lane * 8);                  \
          bf16x8 bq = *(const bf16x8*)(qp + 16 * s);                                            \
          sc = __builtin_amdgcn_mfma_f32_32x32x16_bf16(af, bq, sc, 0, 0, 0);                    \
        }                                                                                       \
        _Pragma("unroll") for (int rg = 0; rg < 16; ++rg) {                                     \
          const int kidx = 32 * (KT) + (rg & 3) + 8 * (rg >> 2) + 4 * h;                        \
          KA[rg] = (f2sort(sc[rg]) & 0xFFFFFF80u) | (unsigned)(127 - kidx);                     \
        }                                                                                       \
        bitonic_sort_desc<16>(KA);                                                              \
      }
      ROUTE_KT(0, k0)
      __builtin_amdgcn_sched_barrier(0);
      ROUTE_KT(1, k1)
      merge_top16(k0, k1);
      __builtin_amdgcn_sched_barrier(0);
      ROUTE_KT(2, k1)
      merge_top16(k0, k1);
      __builtin_amdgcn_sched_barrier(0);
      ROUTE_KT(3, k1)
      merge_top16(k0, k1);
      __builtin_amdgcn_sched_barrier(0);
#undef ROUTE_KT
#pragma unroll
      for (int i = 0; i < 16; ++i) k1[i] = (unsigned)shx_i((int)k0[i], 32);
      merge_top16(k0, k1);
      if (h == 0) {
        unsigned* dst = tops + ((size_t)(u.pm * 256 + wid * 32 + c) * 16 + hc) * 16;
#pragma unroll
        for (int q4 = 0; q4 < 4; ++q4) { u32x4 o = {k0[4 * q4], k0[4 * q4 + 1], k0[4 * q4 + 2], k0[4 * q4 + 3]}; *(u32x4*)(dst + 4 * q4) = o; }
      }
    }
    __syncthreads();
  }
};


template <int CTRL> DI float dpp_f(float v) { const int iv = __float_as_int(v); return __int_as_float(__builtin_amdgcn_update_dpp(iv, iv, CTRL, 0xF, 0xF, false)); }
DI float wsum(float x) {
  x += dpp_f<0xB1>(x);
  x += dpp_f<0x4E>(x);
  x += dpp_f<0x124>(x);
  x += dpp_f<0x128>(x);
  x += shx(x, 16);
  return hsum(x);
}
DI float gelu_fast(float x) {
  const float u2 = 1.5957691216057308f * (x + 0.044715f * x * x * x);
  return x * __builtin_amdgcn_rcpf(1.f + ex2(-LOG2E * u2));
}

constexpr int EROW = 1152;
typedef float v2f __attribute__((ext_vector_type(2)));
__device__ void d_cvt_fp4_row(int row, const float* __restrict__ src, unsigned char* __restrict__ dst) {
  const int lane = TIDX & 63;
  float v[32]; float amax = 0.f;
#pragma unroll
  for (int i = 0; i < 8; ++i) {
    f32x4 x = *(const f32x4*)(src + (size_t)row * DM + 256 * i + 4 * lane);
#pragma unroll
    for (int j = 0; j < 4; ++j) { v[i * 4 + j] = x[j]; amax = fmaxf(amax, fabsf(x[j])); }
  }
  const float sc = amax > 0.f ? amax * (1.f / 6.f) : 1.f;
  const float scb = bf2f(f2bf(sc));
  const float inv = 1.f / scb;
  u32x4 o;
#pragma unroll
  for (int k = 0; k < 4; ++k) {
    unsigned w = 0u;
#define FP4C(x_) fminf(fmaxf((x_) * inv, -6.f), 6.f)
    w = __builtin_amdgcn_cvt_scalef32_pk_fp4_f32(w, FP4C(v[8 * k + 0]), FP4C(v[8 * k + 1]), 1.0f, 0);
    w = __builtin_amdgcn_cvt_scalef32_pk_fp4_f32(w, FP4C(v[8 * k + 2]), FP4C(v[8 * k + 3]), 1.0f, 1);
    w = __builtin_amdgcn_cvt_scalef32_pk_fp4_f32(w, FP4C(v[8 * k + 4]), FP4C(v[8 * k + 5]), 1.0f, 2);
    w = __builtin_amdgcn_cvt_scalef32_pk_fp4_f32(w, FP4C(v[8 * k + 6]), FP4C(v[8 * k + 7]), 1.0f, 3);
#undef FP4C
    o[k] = w;
  }
  *(u32x4*)(dst + (size_t)row * EROW + 16 * lane) = o;
  *(bf16_t*)(dst + (size_t)row * EROW + 1024 + 2 * lane) = f2bf(sc);
}
__device__ void d_expert_wave(int t, unsigned* tpl, const bf16_t* __restrict__ hbuf,
                              const unsigned* __restrict__ tops, const unsigned char* __restrict__ eu4, const unsigned char* __restrict__ ev4,
                              const float* __restrict__ gam, const float* __restrict__ bet, float* __restrict__ out) {
  const int lane = TIDX & 63;
  float hv[32];
#pragma unroll
  for (int i = 0; i < 8; ++i) {
    const u32x2 w = *(const u32x2*)(hbuf + (size_t)t * DM + 256 * i + 4 * lane);
    hv[i * 4 + 0] = __uint_as_float(w[0] << 16); hv[i * 4 + 1] = __uint_as_float(w[0] & 0xFFFF0000u);
    hv[i * 4 + 2] = __uint_as_float(w[1] << 16); hv[i * 4 + 3] = __uint_as_float(w[1] & 0xFFFF0000u);
  }
  int e0 = 0, e1 = 0; float w0 = 0.f, w1 = 0.f;
  {
    const int ci = (lane < 16) ? 0 : (lane < 24) ? 1 : (lane < 29) ? 2 : (lane < 33) ? 3 : (lane < 36) ? 4 : (lane < 38) ? 5 : (lane < 40) ? 6
                   : (lane < 42) ? 7 : (lane - 34);
    const int cpre = (ci == 0) ? 0 : (ci == 1) ? 16 : (ci == 2) ? 24 : (ci == 3) ? 29 : (ci == 4) ? 33 : (ci == 5) ? 36 : (ci == 6) ? 38
                     : (ci == 7) ? 40 : (34 + ci);
    const int cj = lane - cpre;
    const bool cvalid = lane < 50;
    *(u32x4*)(tpl + 4 * lane) = *(const u32x4*)(tops + (size_t)t * 256 + 4 * lane);
    const unsigned* tp = tpl;
#pragma unroll 1
    for (int hh = 0; hh < 8; ++hh) {
      unsigned key = 0u;
      if (cvalid) {
        const float sa = sort2f(tp[(2 * hh) * 16 + ci]), sb = sort2f(tp[(2 * hh + 1) * 16 + cj]);
        key = (f2sort(sa + sb) & 0xFFFFFF00u) | (unsigned)(255 - (ci * 16 + cj));
      }
#pragma unroll
      for (int k = 2; k <= 64; k <<= 1) {
#pragma unroll
        for (int jj = k >> 1; jj > 0; jj >>= 1) {
          const unsigned o = (unsigned)shx_i((int)key, jj);
          const bool lower = (lane & jj) == 0;
          const bool desc = (lane & k) == 0 || k == 64;
          const unsigned mx = key > o ? key : o, mn = key > o ? o : key;
          key = (lower == desc) ? mx : mn;
        }
      }
      const int flat = 255 - (int)(key & 255u);
      const int bi = (flat >> 4) & 15, bj = flat & 15;
      const unsigned ka = tp[(2 * hh) * 16 + bi], kb = tp[(2 * hh + 1) * 16 + bj];
      const float sc = sort2f(ka) + sort2f(kb);
      const int ex = (127 - (int)(ka & 127u)) * 128 + (127 - (int)(kb & 127u));
      float mx = sc;
      mx = fmaxf(mx, shx(mx, 1)); mx = fmaxf(mx, shx(mx, 2)); mx = fmaxf(mx, shx(mx, 4)); mx = fmaxf(mx, shx(mx, 8));
      const float ev_ = __expf(sc - mx);
      float sm = ev_;
      sm += shx(sm, 1); sm += shx(sm, 2); sm += shx(sm, 4); sm += shx(sm, 8);
      const float gv = ev_ / sm;
      const int exs = __shfl(ex, lane & 15); const float gvs = __shfl(gv, lane & 15);
      if ((lane >> 4) == (hh & 3)) { if (hh < 4) { e0 = exs; w0 = gvs; } else { e1 = exs; w1 = gvs; } }
    }
  }
  bf16x2v hb2[16];
#pragma unroll
  for (int i = 0; i < 16; ++i) hb2[i] = bf16x2v{(__bf16)hv[2 * i], (__bf16)hv[2 * i + 1]};
  float c0 = 0.f, c1 = 0.f;
  u32x4 rA[4], rB[4]; unsigned short sA[4], sB[4];
#define EX_LOAD(R, SS, TAB, EB)                                                            \
  _Pragma("unroll") for (int k = 0; k < 4; ++k) {                                          \
    const int e = (EB) + k;                                                                \
    const int id = __builtin_amdgcn_readlane((e < 64) ? e0 : e1, e & 63);                 \
    const unsigned char* row = (TAB) + (size_t)id * EROW;                                  \
    R[k] = *(const u32x4*)(row + 16 * lane);                                               \
    SS[k] = *(const unsigned short*)(row + 1024 + 2 * lane);                               \
  }
#define PKFMA(a_, b_, c_) __builtin_elementwise_fma((a_), (b_), (c_))
#define EX_COMP_U(R, SS, EB)                                                               \
  {                                                                                        \
    float dd[4];                                                                           \
    _Pragma("unroll") for (int k = 0; k < 4; ++k) {                                        \
      float d0 = 0.f, d1 = 0.f;                                                            \
      _Pragma("unroll") for (int q = 0; q < 4; ++q) {                                      \
        const unsigned wq = R[k][q];                                                       \
        d0 = __builtin_amdgcn_fdot2_f32_bf16(__builtin_amdgcn_cvt_scalef32_pk_bf16_fp4(wq, 1.0f, 0), hb2[4 * q + 0], d0, false); \
        d1 = __builtin_amdgcn_fdot2_f32_bf16(__builtin_amdgcn_cvt_scalef32_pk_bf16_fp4(wq, 1.0f, 1), hb2[4 * q + 1], d1, false); \
        d0 = __builtin_amdgcn_fdot2_f32_bf16(__builtin_amdgcn_cvt_scalef32_pk_bf16_fp4(wq, 1.0f, 2), hb2[4 * q + 2], d0, false); \
        d1 = __builtin_amdgcn_fdot2_f32_bf16(__builtin_amdgcn_cvt_scalef32_pk_bf16_fp4(wq, 1.0f, 3), hb2[4 * q + 3], d1, false); \
      }                                                                                    \
      dd[k] = bf2f(SS[k]) * (d0 + d1);                                                     \
      __builtin_amdgcn_sched_barrier(0);                                                   \
    }                                                                                      \
      \
    float t01, t23;                                                                        \
    { auto r_ = __builtin_amdgcn_permlane32_swap(__float_as_uint(dd[0]), __float_as_uint(dd[1]), false, false);   \
      t01 = __uint_as_float(r_[0]) + __uint_as_float(r_[1]); }          \
    { auto r_ = __builtin_amdgcn_permlane32_swap(__float_as_uint(dd[2]), __float_as_uint(dd[3]), false, false);   \
      t23 = __uint_as_float(r_[0]) + __uint_as_float(r_[1]); }          \
    const bool b4_ = (lane & 16) != 0;                                                     \
    float tv = (b4_ ? t23 : t01) + shx(b4_ ? t01 : t23, 16);          \
    tv += dpp_f<0x128>(tv); tv += dpp_f<0x124>(tv); tv += dpp_f<0x4E>(tv); tv += dpp_f<0xB1>(tv);                 \
    _Pragma("unroll") for (int k = 0; k < 4; ++k) {                                        \
      const int e = (EB) + k;                                                              \
      const float tot = __int_as_float(__builtin_amdgcn_readlane(__float_as_int(tv), (k == 0) ? 0 : (k == 1) ? 32 : (k == 2) ? 16 : 48)); \
      if (e < 64) { if (lane == e) c0 = tot; } else { if (lane == e - 64) c1 = tot; }        \
    }                                                                                      \
    __builtin_amdgcn_sched_barrier(0);                                                     \
  }
#define EX_COMP_V(R, SS, EB)                                                               \
  _Pragma("unroll") for (int k = 0; k < 4; ++k) {                                          \
    const int e = (EB) + k;                                                                \
    const float cs = __int_as_float(__builtin_amdgcn_readlane(__float_as_int((e < 64) ? c0 : c1), e & 63)) * bf2f(SS[k]);                     \
    const v2f cs2 = {cs, cs};                                                              \
    _Pragma("unroll") for (int q = 0; q < 4; ++q) {                                        \
      const unsigned wq = R[k][q];                                                         \
      const v2f f0 = __builtin_amdgcn_cvt_scalef32_pk_f32_fp4(wq, 1.0f, 0), f1 = __builtin_amdgcn_cvt_scalef32_pk_f32_fp4(wq, 1.0f, 1); \
      const v2f f2 = __builtin_amdgcn_cvt_scalef32_pk_f32_fp4(wq, 1.0f, 2), f3 = __builtin_amdgcn_cvt_scalef32_pk_f32_fp4(wq, 1.0f, 3); \
      acc2[4 * q + 0] = PKFMA(cs2, f0, acc2[4 * q + 0]); acc2[4 * q + 1] = PKFMA(cs2, f1, acc2[4 * q + 1]); \
      acc2[4 * q + 2] = PKFMA(cs2, f2, acc2[4 * q + 2]); acc2[4 * q + 3] = PKFMA(cs2, f3, acc2[4 * q + 3]); \
    }                                                                                      \
    __builtin_amdgcn_sched_barrier(0);                                                     \
  }
  EX_LOAD(rA, sA, eu4, 0)
  __builtin_amdgcn_sched_barrier(0);
#pragma unroll 1
  for (int eb = 0; eb < 128; eb += 8) {
    EX_LOAD(rB, sB, eu4, eb + 4)
    __builtin_amdgcn_sched_barrier(0);
    EX_COMP_U(rA, sA, eb)
    { const bool more = eb + 8 < 128; const unsigned char* tabn = more ? eu4 : ev4; const int ebn = more ? eb + 8 : 0;
      EX_LOAD(rA, sA, tabn, ebn) }
    __builtin_amdgcn_sched_barrier(0);
    EX_COMP_U(rB, sB, eb + 4)
  }
  c0 = w0 * gelu_fast(c0); c1 = w1 * gelu_fast(c1);
  v2f acc2[16];
#pragma unroll
  for (int i = 0; i < 16; ++i) acc2[i] = v2f{0.f, 0.f};
#pragma unroll 1
  for (int eb = 0; eb < 128; eb += 8) {
    EX_LOAD(rB, sB, ev4, eb + 4)
    __builtin_amdgcn_sched_barrier(0);
    EX_COMP_V(rA, sA, eb)
    { const int ebn = (eb + 8 < 128) ? eb + 8 : 0;
      EX_LOAD(rA, sA, ev4, ebn) }
    __builtin_amdgcn_sched_barrier(0);
    EX_COMP_V(rB, sB, eb + 4)
  }
#undef EX_LOAD
#undef EX_COMP_U
#undef EX_COMP_V
#undef PKFMA
  float acc[32];
#pragma unroll
  for (int i = 0; i < 16; ++i) { acc[2 * i] = acc2[i].x; acc[2 * i + 1] = acc2[i].y; }
  int le = lane;
  asm volatile("" : "+v"(le) :: "memory");
  float s = 0.f;
#pragma unroll
  for (int i = 0; i < 8; ++i) {
    const u32x2 w = *(const u32x2*)(hbuf + (size_t)t * DM + 256 * i + 4 * le);
    const float h0 = __uint_as_float(w[0] << 16), h1 = __uint_as_float(w[0] & 0xFFFF0000u), h2 = __uint_as_float(w[1] << 16), h3 = __uint_as_float(w[1] & 0xFFFF0000u);
    acc[i * 4 + 0] = fmaf(ALPHA, h0, acc[i * 4 + 0]); acc[i * 4 + 1] = fmaf(ALPHA, h1, acc[i * 4 + 1]);
    acc[i * 4 + 2] = fmaf(ALPHA, h2, acc[i * 4 + 2]); acc[i * 4 + 3] = fmaf(ALPHA, h3, acc[i * 4 + 3]);
    s += (acc[i * 4 + 0] + acc[i * 4 + 1]) + (acc[i * 4 + 2] + acc[i * 4 + 3]);
  }
  s = wsum(s);
  const float mu = s * (1.f / DM);
  float qv = 0.f;
#pragma unroll
  for (int i = 0; i < 32; ++i) { const float d = acc[i] - mu; qv += d * d; }
  qv = wsum(qv);
  const float rs = rsqrtf(qv * (1.f / DM) + 1e-5f);
#pragma unroll
  for (int i = 0; i < 8; ++i) {
    const int cbase = 256 * i + 4 * le;
    f32x4 ga = *(const f32x4*)(gam + cbase), ba = *(const f32x4*)(bet + cbase), o;
#pragma unroll
    for (int j = 0; j < 4; ++j) o[j] = (acc[i * 4 + j] - mu) * rs * ga[j] + ba[j];
    *(f32x4*)(out + (size_t)t * DM + cbase) = o;
  }
}

constexpr size_t al256(size_t x) { return (x + 255) & ~(size_t)255; }
constexpr size_t WS_XB = 0;
constexpr size_t WS_PROJ = WS_XB + al256((size_t)S * DM * 2);
constexpr size_t WS_WINT = WS_PROJ + al256((size_t)S * INWP * 2);
constexpr size_t WS_GATES = WS_WINT + al256((size_t)INWG * DM * 2);
constexpr size_t WS_W1KF = WS_GATES + al256((size_t)S * 24 * 4);
constexpr size_t WS_W1VF = WS_W1KF + al256((size_t)512 * 4096 * 2);
constexpr size_t WS_W2KF = WS_W1VF + al256((size_t)512 * 4096 * 2);
constexpr size_t WS_W2VF = WS_W2KF + al256((size_t)512 * 128 * 2);
constexpr size_t WS_VC = WS_W2VF + al256((size_t)512 * 128 * 2) - al256((size_t)2048 * 128 * 4);
constexpr size_t WS_KCF = WS_VC + al256((size_t)2048 * 128 * 4);
constexpr size_t WS_VCF = WS_KCF + al256((size_t)2 * 32 * 4096 * 2);
constexpr size_t WS_KSF = WS_VCF + al256((size_t)2 * 32 * 4096 * 2);
constexpr size_t WS_VSF = WS_KSF + al256((size_t)2 * 512 * 4096 * 2);
constexpr size_t WS_KWF = WS_VSF + al256((size_t)2 * 512 * 4096 * 2);
constexpr size_t WS_VWF = WS_KWF + al256((size_t)2 * 512 * 4096 * 2);
constexpr size_t WS_ENDA = WS_VWF + al256((size_t)2 * 512 * 4096 * 2);
constexpr size_t WS_OATT = WS_ENDA;
constexpr size_t WS_MIX = WS_OATT + al256((size_t)S * 1024 * 4);
constexpr size_t WS_WOUTT = WS_MIX + al256((size_t)S * DM * 2);
constexpr size_t WS_WQT = WS_WOUTT + al256((size_t)DM * DM * 2);
constexpr size_t WS_TOPS = WS_WQT + al256((size_t)DM * DM * 2);
constexpr size_t WS_SKF = WS_TOPS + al256((size_t)S * 256 * 4);
constexpr size_t WS_STATS = WS_SKF + al256((size_t)16 * 128 * 128 * 2);
constexpr size_t WS_CTRL = WS_STATS + al256((size_t)S * 2 * 4);
constexpr size_t CTRL_BYTES = 32768;
constexpr size_t WS_END = WS_CTRL + CTRL_BYTES;
constexpr size_t WS_Y = WS_PROJ;
constexpr size_t WS_HB = WS_XB;
constexpr size_t WS_EU8 = WS_OATT;
constexpr size_t WS_EV8 = WS_EU8 + (size_t)16384 * 1152;
static_assert(WS_EV8 + (size_t)16384 * 1152 <= WS_MIX, "expert tables overflow their region");
constexpr int EXP_EARLY = 6144;
static_assert(WS_END <= (size_t)512 * 1024 * 1024, "workspace over 512 MiB");

struct Params {
  const float *x, *w_in, *ck_pos, *ck_w1, *ck_b1, *ck_w2, *cv_pos, *cv_w1, *cv_b1, *cv_w2, *conv_w, *hng, *w_out, *ln1g, *ln1b, *w_query, *subk,
      *eu, *ev, *ln2g, *ln2b;
  float* out;
  char* ws;
};
#define WSP(T, OFF) ((T*)(p.ws + (OFF)))

#define FOR_VB(n) for (int vb = blockIdx.x; vb < (n); vb += gridDim.x)
#define FOR_VB2(n) for (int vb = blockIdx.x * 2 + (TIDX >> 8); vb < (n); vb += gridDim.x * 2)
constexpr int SMEM_BYTES = 143360;
constexpr int HALF = 36864;

__global__ void __launch_bounds__(512) mega(Params p) {
  __shared__ __attribute__((aligned(16))) char smem[SMEM_BYTES + 16];
  if (TIDX == 0) *(u32x4*)(smem + SMEM_BYTES) = u32x4{0u, 0u, 0u, 0u};
  __syncthreads();
  const XcdBarrier xbar = xcd_barrier_post(WSP(unsigned, WS_CTRL + 1024), (volatile LAS unsigned*)(smem + SMEM_BYTES));
#define smh (smem + (TIDX >> 8) * HALF)
#define wv ((TIDX >> 6))
  constexpr int NWV = 8;
  d_cvt(p.x, WSP(bf16_t, WS_XB), (size_t)S * DM / 4);
  FOR_VB2((INWG / 64) * (DM / 64)) d_cvtT64(vb, smh, p.w_in, WSP(bf16_t, WS_WINT), DM, INW, INWG);
  for (size_t c = (size_t)blockIdx.x * 512 + TIDX; c < (size_t)16 * 256 * 64; c += (size_t)gridDim.x * 512) {
    d_cvt_w1f(c, p.ck_w1, WSP(bf16_t, WS_W1KF)); d_cvt_w1f(c, p.cv_w1, WSP(bf16_t, WS_W1VF));
    if (c < (size_t)4 * 32 * 64) { d_cvt_w2f(c, p.ck_w2, WSP(bf16_t, WS_W2KF)); d_cvt_w2f(c, p.cv_w2, WSP(bf16_t, WS_W2VF)); }
  }
  FOR_VB2((DM / 64) * (DM / 64)) d_cvtT64(vb, smh, p.w_out, WSP(bf16_t, WS_WOUTT), DM, DM, DM);
  FOR_VB2((DM / 64) * (DM / 64)) d_cvtT64(vb, smh, p.w_query, WSP(bf16_t, WS_WQT), DM, DM, DM);
  for (size_t c = (size_t)blockIdx.x * 512 + TIDX; c < (size_t)16 * 4 * 8 * 64; c += (size_t)gridDim.x * 512) d_cvt_subk(c, p.subk, WSP(bf16_t, WS_SKF));
  xcd_barrier(xbar);
  {
    pg8::StaticOrder so; so.init(S, INWG, gridDim.x, blockIdx.x);
    pg8::gemm_phase<EpiProjG, pg8::StaticOrder>((PG8_LAS unsigned char*)smem, pg8::Gemm{WSP(bf16_t, WS_XB), WSP(bf16_t, WS_WINT), S, INWG, DM}, so,
                                                EpiProjG{WSP(bf16_t, WS_PROJ), WSP(float, WS_GATES)}, nullptr);
    const int nun = (S / 256) * (INWG / 256), gsz = (int)gridDim.x;
    const int nfull = nun % gsz;
    if (nfull != 0 && (int)blockIdx.x >= nfull) {
      const int nidle = gsz - nfull, me = (int)blockIdx.x - nfull;
      for (int r = me * NWV + wv; r < 2 * EXP_EARLY; r += nidle * NWV) {
        if (r < EXP_EARLY) d_cvt_fp4_row(r, p.eu, WSP(unsigned char, WS_EU8)); else d_cvt_fp4_row(r - EXP_EARLY, p.ev, WSP(unsigned char, WS_EV8));
      }
    }
  }
  xcd_barrier(xbar);
  {
    if (blockIdx.x < 128) {
      const int u = blockIdx.x; const bool isV = u >= 64;
      d_compress_unit(u & 63, smem, WSP(bf16_t, WS_PROJ), isV ? OFF_VC : OFF_KC, isV ? p.cv_pos : p.ck_pos, isV ? WSP(bf16_t, WS_W1VF) : WSP(bf16_t, WS_W1KF),
                      isV ? p.cv_b1 : p.ck_b1, isV ? WSP(bf16_t, WS_W2VF) : WSP(bf16_t, WS_W2KF), isV ? WSP(bf16_t, WS_VCF) : WSP(bf16_t, WS_KCF), isV);
    }
    int* slot = (int*)smem;
    unsigned* ctr = WSP(unsigned, WS_CTRL);
    for (;;) {
      if (TIDX == 0) *slot = (int)atomicAdd(ctr, 1u);
      __syncthreads();
      const int it = *slot;
      __syncthreads();
      if (it >= 2048) break;
      const int tt = TIDX;
      {
        const int T = it >> 2, which = it & 3;
        d_relayout_tile(T, smem + 64, WSP(bf16_t, WS_PROJ), (which == 0) ? OFF_KS : (which == 1) ? OFF_VS : (which == 2) ? OFF_KW : OFF_VW,
                        (which == 0) ? WSP(bf16_t, WS_KSF) : (which == 1) ? WSP(bf16_t, WS_VSF) : (which == 2) ? WSP(bf16_t, WS_KWF) : WSP(bf16_t, WS_VWF), (which & 1) != 0);
      }
      for (int q = 0; q < 2; ++q) d_convmix(it * 8 + q * 4 + (tt >> 7), tt & 127, WSP(bf16_t, WS_PROJ), p.conv_w, p.hng, WSP(bf16_t, WS_MIX));
    }
  }
  xcd_barrier(xbar);
  {
    AttnPtrs ap{WSP(bf16_t, WS_PROJ), WSP(float, WS_GATES), WSP(bf16_t, WS_KCF), WSP(bf16_t, WS_VCF), WSP(bf16_t, WS_KSF), WSP(bf16_t, WS_VSF), WSP(bf16_t, WS_KWF), WSP(bf16_t, WS_VWF), WSP(bf16_t, WS_MIX), p.hng};
    for (int it = blockIdx.x; it < 512; it += gridDim.x) {
      const int Bq = (it < 256) ? it : (511 - it), gq = (it < 256) ? 0 : 1;
      d_attn_block(Bq, gq, smem, ap);
    }
  }
  xcd_barrier(xbar);
  {
    pg8::StaticOrder so; so.init(S, DM, gridDim.x, blockIdx.x);
    pg8::gemm_phase<EpiResG, pg8::StaticOrder>((PG8_LAS unsigned char*)smem, pg8::Gemm{WSP(bf16_t, WS_MIX), WSP(bf16_t, WS_WOUTT), S, DM, DM}, so,
                                               EpiResG{WSP(bf16_t, WS_HB)}, nullptr);
  }
  xcd_barrier(xbar);
  for (int r = blockIdx.x * NWV + wv; r < S; r += gridDim.x * NWV) d_ln_wave(r, WSP(bf16_t, WS_HB), p.ln1g, p.ln1b);
  {
    const int e0_ = (((S / 256) * (INWG / 256)) % (int)gridDim.x != 0) ? EXP_EARLY : 0;
    const int nrest = 16384 - e0_;
    for (int r = blockIdx.x * NWV + wv; r < 2 * nrest; r += gridDim.x * NWV) {
      if (r < nrest) d_cvt_fp4_row(e0_ + r, p.eu, WSP(unsigned char, WS_EU8)); else d_cvt_fp4_row(e0_ + r - nrest, p.ev, WSP(unsigned char, WS_EV8));
    }
  }
  xcd_barrier(xbar);
  for (int k = 0; k * (int)gridDim.x < (S / 256) * (DM / 256); ++k) {
    pg8::OneUnit so; so.init(S, DM, gridDim.x, blockIdx.x); so.k = k;
    pg8::gemm_phase<EpiRouteG, pg8::OneUnit>((PG8_LAS unsigned char*)smem, pg8::Gemm{WSP(bf16_t, WS_HB), WSP(bf16_t, WS_WQT), S, DM, DM}, so,
                                             EpiRouteG{WSP(bf16_t, WS_SKF), WSP(unsigned, WS_TOPS)}, nullptr);
    __syncthreads();
  }
  xcd_barrier(xbar);
  for (int t = blockIdx.x * NWV + wv; t < S; t += gridDim.x * NWV) d_expert_wave(t, (unsigned*)(smem + wv * 1024), WSP(bf16_t, WS_HB), WSP(unsigned, WS_TOPS), WSP(unsigned char, WS_EU8), WSP(unsigned char, WS_EV8), p.ln2g, p.ln2b, p.out);
}

extern "C" void kernel_launch(void* const* d_in, const int* in_sizes, int n_in, void* d_out, int out_size, void* d_ws, size_t ws_size,
                              hipStream_t stream) {
  Params p{};
  p.x = (const float*)d_in[0]; p.w_in = (const float*)d_in[1]; p.ck_pos = (const float*)d_in[2]; p.ck_w1 = (const float*)d_in[3];
  p.ck_b1 = (const float*)d_in[4]; p.ck_w2 = (const float*)d_in[5]; p.cv_pos = (const float*)d_in[6]; p.cv_w1 = (const float*)d_in[7];
  p.cv_b1 = (const float*)d_in[8]; p.cv_w2 = (const float*)d_in[9]; p.conv_w = (const float*)d_in[10]; p.hng = (const float*)d_in[11];
  p.w_out = (const float*)d_in[12]; p.ln1g = (const float*)d_in[13]; p.ln1b = (const float*)d_in[14]; p.w_query = (const float*)d_in[15];
  p.subk = (const float*)d_in[16]; p.eu = (const float*)d_in[17]; p.ev = (const float*)d_in[18]; p.ln2g = (const float*)d_in[19];
  p.ln2b = (const float*)d_in[20];
  p.out = (float*)d_out;
  p.ws = (char*)d_ws;
  if (ws_size < WS_END) fprintf(stderr, "workspace too small\n");
  static int grid_blocks = 0;
  if (!grid_blocks) {
    int dev = 0, cus = 0, per_cu = 0;
    hipGetDevice(&dev);
    hipDeviceGetAttribute(&cus, hipDeviceAttributeMultiprocessorCount, dev);
    hipOccupancyMaxActiveBlocksPerMultiprocessor(&per_cu, mega, 512, 0);
    if (per_cu > 1) per_cu = 1;
    if (per_cu < 1) per_cu = 1;
    grid_blocks = cus * per_cu;
  }
  hipMemsetAsync((char*)d_ws + WS_CTRL, 0, CTRL_BYTES, stream);
  void* args[] = {&p};
  hipError_t e = hipLaunchCooperativeKernel((void*)mega, dim3(grid_blocks), dim3(512), args, 0, stream);
  if (e != hipSuccess) fprintf(stderr, "cooperative launch failed: %s (grid %d)\n", hipGetErrorString(e), grid_blocks);
}
```

```cpp
#include <hip/hip_runtime.h>
#include <stdint.h>
#include <stdio.h>


#define DI __device__ __forceinline__
static __device__ __forceinline__ int tidx_() { int t = (int)__builtin_amdgcn_workitem_id_x(); asm volatile("" : "+v"(t)); return t; }
#define TIDX (tidx_())

template <int J> DI int swz_xor(int x) { return __builtin_amdgcn_ds_swizzle(x, (J << 10) | 0x1F); }
template <int CTRL> DI int dpp_i(int x) { return __builtin_amdgcn_update_dpp(x, x, CTRL, 0xF, 0xF, false); }
DI int shx_i(int x, int j) {
  switch (j) {
    case 1: return dpp_i<0xB1>(x);
    case 2: return dpp_i<0x4E>(x);
    case 4: return dpp_i<0x1B>(dpp_i<0x141>(x));
    case 8: return dpp_i<0x128>(x);
    case 16: return swz_xor<16>(x);
    default: {
      auto r = __builtin_amdgcn_permlane32_swap((unsigned)x, (unsigned)x, false, false);
      return (TIDX & 32) ? (int)r[0] : (int)r[1];
    }
  }
}
DI float shx(float x, int j) { return __int_as_float(shx_i(__float_as_int(x), j)); }
typedef unsigned short bf16_t;
using bf16x8 = __attribute__((ext_vector_type(8))) short;
using f32x4 = __attribute__((ext_vector_type(4))) float;
using u32x4 = __attribute__((ext_vector_type(4))) unsigned;
using u32x2 = __attribute__((ext_vector_type(2))) unsigned;

constexpr int S = 16384, DM = 2048, HD = 128;
constexpr int INW = 5656, INWP = 5760, INWG = 5888;
constexpr int OFF_Q = 0, OFF_KC = 1024, OFF_VC = 1280, OFF_KS = 1536, OFF_VS = 1792, OFF_KW = 2048, OFF_VW = 2304,
              OFF_G = 2560, OFF_U = 2584, OFF_B = 3608, OFF_C = 4632;
constexpr int NCMP = 1023;
constexpr float ALPHA = 1.189207115002721f;
constexpr float QSCALE = 0.08838834764831845f;

DI bf16_t f2bf(float x) { unsigned u = __float_as_uint(x); u += 0x7fffu + ((u >> 16) & 1u); return (bf16_t)(u >> 16); }
DI float bf2f(bf16_t b) { return __uint_as_float(((unsigned)b) << 16); }
DI float gelu_tanh(float x) { float u = 0.7978845608028654f * (x + 0.044715f * x * x * x); return 0.5f * x * (1.f + tanhf(u)); }
DI float wave_sum(float v) { for (int o = 32; o > 0; o >>= 1) v += shx(v, o); return v; }
using bf16x2v = __attribute__((ext_vector_type(2))) __bf16;
DI unsigned pack2(float a, float b) { bf16x2v v = {(__bf16)a, (__bf16)b}; return __builtin_bit_cast(unsigned, v); }
DI float wave_max(float v) { for (int o = 32; o > 0; o >>= 1) v = fmaxf(v, shx(v, o)); return v; }

namespace pg8 {
#define PG8_LAS __attribute__((address_space(3)))
typedef unsigned short bf16_t;
typedef short bf16x8 __attribute__((ext_vector_type(8)));
typedef float f32x4 __attribute__((ext_vector_type(4)));
typedef unsigned u32x4 __attribute__((ext_vector_type(4)));
constexpr int BM = 256, BK = 64, HALF = 128, HTB = HALF * BK * 2  , STAGE_BYTES = 8 * HTB, NXCD = 8, WGM = 8;

__host__ __device__ __forceinline__ int lds_byte(int r, int c) { const int st = (r >> 4) * 2 + (c >> 5), rr = r & 15, cc = c & 31, ob = rr * 64 + cc * 2; return st * 1024 + (ob ^ (((ob >> 9) & 1) << 5)); }
__host__ __device__ __forceinline__ void stage_rc(int b, int& R, int& C) { const int st = b / 1024, sb = b % 1024, swz = sb ^ (((sb >> 9) & 1) << 5); R = (st >> 1) * 16 + swz / 64; C = (st & 1) * 32 + (swz % 64) / 2; }
__host__ __device__ __forceinline__ int perm32(int rho) { const int n = rho >> 4, i = rho & 15; return 8 * (i >> 2) + 4 * n + (i & 3); }

struct Unit { int pm, pn; };
struct Gemm { const bf16_t* A; const bf16_t* Bt; int M, N, K; };

struct StaticOrder {
    int nM, nN, nwg, G, c;
    __host__ __device__ void init(int M, int N, int G_, int c_) { nM = M / BM; nN = N / BM; nwg = nM * nN; G = G_; c = c_; }
    __host__ __device__ bool next(int i, Unit& u) const {
        const long L = (long)i * G + c; if (L >= nwg) return false;
        int wgid = (int)L; { const int q = nwg / NXCD, r = nwg % NXCD, xcd = wgid % NXCD, off = wgid / NXCD; wgid = (xcd < r ? xcd * (q + 1) : r * (q + 1) + (xcd - r) * q) + off; }
        const int nig = WGM * nN, gid = wgid / nig, fm = gid * WGM, gsz = (nM - fm) < WGM ? (nM - fm) : WGM;
        u.pm = fm + ((wgid % nig) % gsz); u.pn = (wgid % nig) / gsz; return true;
    }
    __device__ __forceinline__ void a_ready(const Unit&) const {}
    __device__ __forceinline__ void done(const Unit&) const {}
};
struct OneUnit : StaticOrder {
    int k;
    __device__ bool next(int i, Unit& u) const { if (i > 0) return false; return StaticOrder::next(k, u); }
};
__device__ __forceinline__ unsigned cvt_pk_bf16(float lo, float hi) { unsigned r; asm volatile("v_cvt_pk_bf16_f32 %0, %1, %2" : "=v"(r) : "v"(lo), "v"(hi)); return r; }
template <class Epi, class Sched, bool STAMP = false>
__device__ __forceinline__ void gemm_phase(PG8_LAS unsigned char* lds, const Gemm g, const Sched& S, const Epi& E, unsigned long long* stamps) {
    const int tid = TIDX, wid = __builtin_amdgcn_readfirstlane(tid >> 6), lane = tid & 63, wr = wid >> 2, wc = wid & 3, fr = lane & 15, fq = lane >> 4;
    const int K = g.K, nt = K / BK;
    int ts_lo = 0, ts_hi = 0, nts = 0; const unsigned long long rt_entry = STAMP ? (unsigned long long)wall_clock64() : 0ull;
#define PG8_STAMP() do { if (STAMP && wid == 0 && nts < 64) { const unsigned long long _c = (unsigned long long)clock64(); \
        ts_lo = (lane == nts) ? (int)(unsigned)_c : ts_lo; ts_hi = (lane == nts) ? (int)(unsigned)(_c >> 32) : ts_hi; ++nts; } } while (0)
    PG8_STAMP();
    unsigned voffA[2], voffB[2];
#pragma unroll
    for (int i = 0; i < 2; ++i) { int R, C; stage_rc(tid * 16 + i * 8192, R, C); const int Rb = Epi::PERM ? ((R & ~31) + perm32(R & 31)) : R;
        voffA[i] = (unsigned)(R * K + C) * 2u; voffB[i] = (unsigned)(Rb * K + C) * 2u; }
    const size_t kstep = (size_t)(BK * 2);
    const size_t hstep = (size_t)HALF * K * 2;
    const size_t tstep = 2 * hstep;
    const unsigned ldsw = (unsigned)wid * 1024u;
    const int aoff = lds_byte(wr * 64 + fr, fq * 8), boff = lds_byte(wc * 32 + fr, fq * 8);
#define PG8_SA(b, h) (((b) * 2 + (h)) * HTB)
#define PG8_SB(b, h) ((4 + (b) * 2 + (h)) * HTB)
#define PG8_STAGE(bufoff, gbase, voff) do { _Pragma("unroll") for (int _i = 0; _i < 2; ++_i) \
        __builtin_amdgcn_global_load_lds((const unsigned*)((const char*)(gbase) + (voff)[_i]), (PG8_LAS unsigned*)(lds + (bufoff) + ldsw + _i * 8192), 16, 0, 0); } while (0)
#define PG8_LDA(dst, b, h) do { _Pragma("unroll") for (int m = 0; m < 4; ++m) _Pragma("unroll") for (int k = 0; k < 2; ++k) dst[m][k] = *(const PG8_LAS bf16x8*)(lds + PG8_SA(b, h) + aoff + m * 2048 + k * 1024); } while (0)
#define PG8_LDB(dst, b, h) do { _Pragma("unroll") for (int n = 0; n < 2; ++n) _Pragma("unroll") for (int k = 0; k < 2; ++k) dst[n][k] = *(const PG8_LAS bf16x8*)(lds + PG8_SB(b, h) + boff + n * 2048 + k * 1024); } while (0)
#define PG8_MMA(ai, bj, At, Bt) do { __builtin_amdgcn_s_setprio(1); _Pragma("unroll") for (int m = 0; m < 4; ++m) _Pragma("unroll") for (int n = 0; n < 2; ++n) _Pragma("unroll") for (int k = 0; k < 2; ++k) \
        acc[ai][bj][m][n] = __builtin_amdgcn_mfma_f32_16x16x32_bf16(Bt[n][k], At[m][k], acc[ai][bj][m][n], 0, 0, 0); __builtin_amdgcn_s_setprio(0); } while (0)
#define PG8_WAIT_V(n) asm volatile("s_waitcnt vmcnt(" #n ")" ::: "memory")
#define PG8_WAIT_L(n) asm volatile("s_waitcnt lgkmcnt(" #n ")" ::: "memory")
#define PG8_BAR __builtin_amdgcn_s_barrier()
#define PG8_SCHED __builtin_amdgcn_sched_barrier(0)
    Unit cur, nxt; int ui = 0;
    if (!S.next(0, cur)) return;
    f32x4 acc[2][2][4][2];
#pragma unroll
    for (int a = 0; a < 2; ++a)
#pragma unroll
        for (int b = 0; b < 2; ++b)
#pragma unroll
            for (int m = 0; m < 4; ++m)
#pragma unroll
                for (int n = 0; n < 2; ++n) acc[a][b][m][n] = (f32x4){0.f, 0.f, 0.f, 0.f};
    bf16x8 At[4][2], B0[2][2], B1[2][2];
    const char* cA = (const char*)g.A + (size_t)cur.pm * tstep; const char* cB = (const char*)g.Bt + (size_t)cur.pn * tstep;
    S.a_ready(cur);
    PG8_STAGE(PG8_SB(0, 0), cB, voffB); PG8_STAGE(PG8_SA(0, 0), cA, voffA); PG8_STAGE(PG8_SB(0, 1), cB + hstep, voffB); PG8_STAGE(PG8_SA(0, 1), cA + hstep, voffA);
    if (wr == 1) PG8_BAR;
    PG8_WAIT_V(4); PG8_BAR;
    PG8_STAGE(PG8_SB(1, 0), cB + kstep, voffB); PG8_STAGE(PG8_SA(1, 0), cA + kstep, voffA); PG8_STAGE(PG8_SB(1, 1), cB + hstep + kstep, voffB);
    PG8_WAIT_V(6); PG8_BAR;
    PG8_STAMP();
    for (;;) {
        const bool has_next = S.next(ui + 1, nxt);
        const char* nA = has_next ? (const char*)g.A + (size_t)nxt.pm * tstep : cA; const char* nB = has_next ? (const char*)g.Bt + (size_t)nxt.pn * tstep : cB;
        for (int t = 0; t < nt; t += 2) {
            const bool last = (t == nt - 2);
            const char* a1 = cA + (size_t)(t + 1) * kstep;
            const char* a2 = last ? nA : cA + (size_t)(t + 2) * kstep; const char* b2 = last ? nB : cB + (size_t)(t + 2) * kstep;
            const char* a3 = a2 + kstep; const char* b3 = b2 + kstep;
            if (last && has_next) S.a_ready(nxt);
            PG8_LDB(B0, 0, 0); PG8_SCHED; PG8_LDA(At, 0, 0); PG8_STAGE(PG8_SA(1, 1), a1 + hstep, voffA);
            PG8_WAIT_L(8); PG8_BAR; PG8_WAIT_L(0); PG8_MMA(0, 0, At, B0); PG8_BAR; PG8_SCHED;
            PG8_LDB(B1, 0, 1); PG8_STAGE(PG8_SB(0, 0), b2, voffB);
            PG8_BAR; PG8_WAIT_L(0); PG8_MMA(0, 1, At, B1); PG8_BAR;
            PG8_LDA(At, 0, 1); PG8_STAGE(PG8_SA(0, 0), a2, voffA);
            PG8_BAR; PG8_WAIT_L(0); PG8_MMA(1, 0, At, B0); PG8_BAR; PG8_SCHED;
            PG8_STAGE(PG8_SB(0, 1), b2 + hstep, voffB);
            PG8_WAIT_V(6); PG8_BAR; PG8_MMA(1, 1, At, B1); PG8_BAR;
            PG8_LDB(B0, 1, 0); PG8_SCHED; PG8_LDA(At, 1, 0); PG8_STAGE(PG8_SA(0, 1), a2 + hstep, voffA);
            PG8_WAIT_L(8); PG8_BAR; PG8_WAIT_L(0); PG8_MMA(0, 0, At, B0); PG8_BAR; PG8_SCHED;
            PG8_LDB(B1, 1, 1); PG8_STAGE(PG8_SB(1, 0), b3, voffB);
            PG8_BAR; PG8_WAIT_L(0); PG8_MMA(0, 1, At, B1); PG8_BAR;
            PG8_LDA(At, 1, 1); PG8_STAGE(PG8_SA(1, 0), a3, voffA);
            PG8_BAR; PG8_WAIT_L(0); PG8_MMA(1, 0, At, B0); PG8_BAR; PG8_SCHED;
            PG8_STAGE(PG8_SB(1, 1), b3 + hstep, voffB);
            PG8_WAIT_V(6); PG8_BAR; PG8_MMA(1, 1, At, B1); PG8_BAR;
        }
        PG8_STAMP();
        if constexpr (!Epi::AFTER_DRAIN) { E(acc, cur, wr, wc, fr, fq); S.done(cur); }
        PG8_STAMP();
        if (!has_next) break;
#pragma unroll
        for (int a = 0; a < 2; ++a)
#pragma unroll
            for (int b = 0; b < 2; ++b)
#pragma unroll
                for (int m = 0; m < 4; ++m)
#pragma unroll
                    for (int n = 0; n < 2; ++n) acc[a][b][m][n] = (f32x4){0.f, 0.f, 0.f, 0.f};
        cur = nxt; cA = nA; cB = nB; ++ui;
    }
    PG8_WAIT_V(0);
    if (wr == 0) PG8_BAR;
    PG8_BAR;
    if constexpr (Epi::AFTER_DRAIN) { E.fused(acc, cur, wr, wc, fr, fq, lds, wid, lane); S.done(cur); }
    PG8_STAMP();
    if (STAMP && wid == 0) { stamps[lane] = lane < nts ? (((unsigned long long)(unsigned)ts_hi << 32) | (unsigned)ts_lo) : 0ull;
        if (lane == 62) stamps[62] = rt_entry; if (lane == 63) stamps[63] = (unsigned long long)wall_clock64(); }
#undef PG8_STAMP
#undef PG8_SA
#undef PG8_SB
#undef PG8_STAGE
#undef PG8_LDA
#undef PG8_LDB
#undef PG8_MMA
#undef PG8_WAIT_V
#undef PG8_WAIT_L
#undef PG8_BAR
#undef PG8_SCHED
}
}

#define XB_TMO      128
#define XB_XCNT(j)  (256  + 64 * (j))
#define XB_XSUB(j)  (1280 + 64 * (j))
#define XB_XGEN(j)  (2304 + 64 * (j))
#define XB_TOP      3328
#define XB_TOPGEN   3392
#define XCD_BAR_WORDS 3456
#define XB_SPIN_CAP (1u << 18)
#define LAS __attribute__((address_space(3)))

__device__ __forceinline__ unsigned xb_ld(unsigned* p)              { return __hip_atomic_load(p, __ATOMIC_RELAXED, __HIP_MEMORY_SCOPE_AGENT); }
__device__ __forceinline__ unsigned xb_add(unsigned* p, unsigned v) { return __hip_atomic_fetch_add(p, v, __ATOMIC_RELAXED, __HIP_MEMORY_SCOPE_AGENT); }
__device__ __forceinline__ unsigned xb_xcc_id() { return (unsigned)__builtin_amdgcn_s_getreg((3 << 11) | 20) & 0xFu; }
#define XB_SPIN(cond, bar) do { unsigned _sp = 0; while (cond) { __builtin_amdgcn_s_sleep(1); \
    if ((++_sp & 255u) == 0u) { if (xb_ld(&(bar)[XB_TMO])) break; if (_sp > XB_SPIN_CAP) { atomicAdd(&(bar)[XB_TMO], 1u); break; } } } } while (0)

struct XcdBarrier {
    unsigned* bar; unsigned x;
    volatile LAS unsigned* st;
};

__device__ __forceinline__ XcdBarrier xcd_barrier_post(unsigned* bar, volatile LAS unsigned* st) {
    XcdBarrier b; b.bar = bar; b.x = xb_xcc_id(); b.st = st;
    if (TIDX == 0) (void)xb_add(&bar[XB_XCNT(b.x)], 1u);
    return b;
}
__device__ __forceinline__ void xcd_barrier_complete(unsigned* bar, unsigned x, unsigned& nloc, unsigned& nx) {
    const unsigned G = gridDim.x * gridDim.y * gridDim.z;
    unsigned sum, cnt, mine, sp = 0u;
    for (;;) {
        sum = 0u; cnt = 0u; mine = 0u;
#pragma unroll
        for (unsigned j = 0; j < 16; ++j) { const unsigned c = xb_ld(&bar[XB_XCNT(j)]); sum += c; cnt += (c > 0u) ? 1u : 0u; mine = (j == x) ? c : mine; }
        if (sum == G) break;
        __builtin_amdgcn_s_sleep(1);
        if ((++sp & 255u) == 0u) { if (xb_ld(&bar[XB_TMO])) break; if (sp > XB_SPIN_CAP) { atomicAdd(&bar[XB_TMO], 1u); break; } }
    }
    nloc = mine > 0u ? mine : 1u; nx = cnt > 0u ? cnt : 1u;
}

__device__ __forceinline__ void xcd_barrier(const XcdBarrier& b) {
    asm volatile("s_waitcnt vmcnt(0)" ::: "memory");
    __syncthreads();
    if (TIDX == 0) {
        unsigned* bar = b.bar;
        __builtin_amdgcn_s_waitcnt(0);
        unsigned nloc = b.st[0], nx = b.st[1];
        if (nloc == 0u) { xcd_barrier_complete(bar, b.x, nloc, nx); b.st[0] = nloc; b.st[1] = nx; }
        const unsigned old = xb_add(&bar[XB_XSUB(b.x)], 1u);
        const unsigned gen = old / nloc;
        if (old + 1u == (gen + 1u) * nloc) {
            __builtin_amdgcn_fence(__ATOMIC_RELEASE, "agent");
            asm volatile("s_waitcnt vmcnt(0)" ::: "memory");
            const unsigned og = xb_add(&bar[XB_TOP], 1u);
            const unsigned tg = og / nx;
            if (og + 1u == (tg + 1u) * nx) xb_add(&bar[XB_TOPGEN], 1u);
            else XB_SPIN(xb_ld(&bar[XB_TOPGEN]) == tg, bar);
            __builtin_amdgcn_fence(__ATOMIC_ACQUIRE, "agent");
            xb_add(&bar[XB_XGEN(b.x)], 1u);
            asm volatile("s_waitcnt vmcnt(0)" ::: "memory");
        } else {
            XB_SPIN(xb_ld(&bar[XB_XGEN(b.x)]) == gen, bar);
            __builtin_amdgcn_fence(__ATOMIC_ACQUIRE, "agent");
            asm volatile("s_waitcnt vmcnt(0)" ::: "memory");
        }
    }
    __syncthreads();
}

__device__ void d_cvt(const float* __restrict__ in, bf16_t* __restrict__ out, size_t n4) {
  const size_t stride = (size_t)gridDim.x * blockDim.x;
  size_t i = (size_t)blockIdx.x * blockDim.x + TIDX;
  for (; i + 3 * stride < n4; i += 4 * stride) {
    f32x4 v[4];
#pragma unroll
    for (int q = 0; q < 4; ++q) v[q] = ((const f32x4*)in)[i + q * stride];
#pragma unroll
    for (int q = 0; q < 4; ++q) { u32x2 o = {pack2(v[q][0], v[q][1]), pack2(v[q][2], v[q][3])}; ((u32x2*)out)[i + q * stride] = o; }
  }
  for (; i < n4; i += stride) { const f32x4 v = ((const f32x4*)in)[i]; u32x2 o = {pack2(v[0], v[1]), pack2(v[2], v[3])}; ((u32x2*)out)[i] = o; }
}
__device__ void d_cvtT64(int vb, char* smem, const float* __restrict__ W, bf16_t* __restrict__ WT, int K, int N, int NP) {
  float (*tt)[65] = (float (*)[65])smem;
  const int tid = (TIDX & 255);
  const int nbx = NP / 64;
  const int n0 = (vb % nbx) * 64, k0 = (vb / nbx) * 64;
  {
    const int kr = tid >> 4, nc = (tid & 15) * 4;
#pragma unroll
    for (int i = 0; i < 4; ++i) {
      const int k = k0 + kr + 16 * i, n = n0 + nc;
      f32x4 v = {0.f, 0.f, 0.f, 0.f};
      if (n < N) v = *(const f32x4*)(W + (size_t)k * N + n);
      tt[kr + 16 * i][nc] = v[0]; tt[kr + 16 * i][nc + 1] = v[1]; tt[kr + 16 * i][nc + 2] = v[2]; tt[kr + 16 * i][nc + 3] = v[3];
    }
  }
  __syncthreads();
  {
    const int nr = tid >> 3, kc = (tid & 7) * 8;
#pragma unroll
    for (int i = 0; i < 2; ++i) {
      const int nl = nr + 32 * i;
      u32x4 o = {pack2(tt[kc][nl], tt[kc + 1][nl]), pack2(tt[kc + 2][nl], tt[kc + 3][nl]), pack2(tt[kc + 4][nl], tt[kc + 5][nl]), pack2(tt[kc + 6][nl], tt[kc + 7][nl])};
      *(u32x4*)(WT + (size_t)(n0 + nl) * K + k0 + kc) = o;
    }
  }
  __syncthreads();
}

using f32x16 = __attribute__((ext_vector_type(16))) float;
using bf16x8v = __attribute__((ext_vector_type(8))) __bf16;
#define MFMA32(a, b, c) __builtin_amdgcn_mfma_f32_32x32x16_bf16((a), (b), (c), 0, 0, 0)
constexpr float LOG2E = 1.4426950408889634f;
constexpr float NEGB = -1e30f;
DI int pi_perm(int i) { return (i & ~12) | ((i & 8) >> 1) | ((i & 4) << 1); }
DI bf16x8 pack8(float a0, float a1, float a2, float a3, float a4, float a5, float a6, float a7) {
  bf16x8v v = {(__bf16)a0, (__bf16)a1, (__bf16)a2, (__bf16)a3, (__bf16)a4, (__bf16)a5, (__bf16)a6, (__bf16)a7};
  return __builtin_bit_cast(bf16x8, v);
}
__device__ __forceinline__ void d_relayout_tile(int T, char* smem, const bf16_t* __restrict__ proj, int col0, bf16_t* __restrict__ dst, bool isV) {
  bf16_t* Ls = (bf16_t*)smem;
  const int tid = TIDX;
#pragma unroll
  for (int q = 0; q < 2; ++q) {
    const int cidx = tid + q * 512;
    const int g = cidx >> 9, tok = (cidx >> 4) & 31, ch = cidx & 15;
    const u32x4 v = *(const u32x4*)(proj + (size_t)(32 * T + tok) * INWP + col0 + g * 128 + ch * 8);
    *(u32x4*)(Ls + (g * 32 + tok) * 136 + ch * 8) = v;
  }
  __syncthreads();
#pragma unroll
  for (int q = 0; q < 2; ++q) {
    const int oc = tid + q * 512;
    const int g = oc >> 9, r9 = oc & 511, lane = r9 & 63;
    u32x4 o;
    if (!isV) {
      const int s8 = r9 >> 6, i = lane & 31, h = lane >> 5;
      o = *(const u32x4*)(Ls + (g * 32 + pi_perm(i)) * 136 + 16 * s8 + 8 * h);
    } else {
      const int s2 = (r9 >> 6) & 1, dt = r9 >> 7, dd = lane & 31, h = lane >> 5;
      const bf16_t* col = Ls + (g * 32 + 16 * s2 + 8 * h) * 136 + 32 * dt + dd;
      unsigned short e[8];
#pragma unroll
      for (int j = 0; j < 8; ++j) e[j] = col[j * 136];
      o.x = e[0] | ((unsigned)e[1] << 16); o.y = e[2] | ((unsigned)e[3] << 16); o.z = e[4] | ((unsigned)e[5] << 16); o.w = e[6] | ((unsigned)e[7] << 16);
    }
    *(u32x4*)(dst + (((size_t)(g * 512 + T)) * 512 + r9) * 8) = o;
  }
  __syncthreads();
}

struct AttnPtrs {
  const bf16_t* proj; const float* gates;
  const bf16_t *kcf, *vcf, *ksf, *vsf, *kwf, *vwf;
  bf16_t* mix; const float* hng;
};

DI float ex2(float x) { return __builtin_amdgcn_exp2f(x); }
DI void halves(float x, float& lo, float& hi) {
  const unsigned u = __float_as_uint(x);
  auto r = __builtin_amdgcn_permlane32_swap(u, u, false, false);
  lo = __uint_as_float(r[0]); hi = __uint_as_float(r[1]);
}
DI float hmax(float x) { float a, b; halves(x, a, b); return fmaxf(a, b); }
DI float hsum(float x) { float a, b; halves(x, a, b); return a + b; }
DI float dpp_quad(float v, int ctrl_is_xor1) {
  const int iv = __float_as_int(v);
  const int r = ctrl_is_xor1 ? __builtin_amdgcn_update_dpp(iv, iv, 0xB1, 0xF, 0xF, false) : __builtin_amdgcn_update_dpp(iv, iv, 0x4E, 0xF, 0xF, false);
  return __int_as_float(r);
}
DI float quad_sum(float v) { v += dpp_quad(v, 1); v += dpp_quad(v, 0); return v; }
DI void osm_step(const float (&sv)[16], float& m, float& l, f32x16 (&O)[4], float (&p)[16]) {
  float tmax = fmaxf(fmaxf(fmaxf(sv[0], sv[1]), fmaxf(sv[2], sv[3])), fmaxf(fmaxf(sv[4], sv[5]), fmaxf(sv[6], sv[7])));
  tmax = fmaxf(tmax, fmaxf(fmaxf(fmaxf(sv[8], sv[9]), fmaxf(sv[10], sv[11])), fmaxf(fmaxf(sv[12], sv[13]), fmaxf(sv[14], sv[15]))));
  tmax = hmax(tmax);
  if (__ballot(tmax - m > 8.f)) {
    const float mn = fmaxf(m, tmax);
    const float alpha = ex2(m - mn);
    l *= alpha; m = mn;
#pragma unroll
    for (int dt = 0; dt < 4; ++dt)
#pragma unroll
      for (int r = 0; r < 16; ++r) O[dt][r] *= alpha;
  }
  float ps0 = 0.f, ps1 = 0.f;
#pragma unroll
  for (int r = 0; r < 16; r += 2) { const float e0 = ex2(sv[r] - m), e1 = ex2(sv[r + 1] - m); p[r] = e0; p[r + 1] = e1; ps0 += e0; ps1 += e1; }
  l += ps0 + ps1;
}
DI void ot_store(char* otL, int lane, const f32x16 (&O)[4], float sc) {
#pragma unroll
  for (int dt = 0; dt < 4; ++dt) {
    u32x4 a, b;
#pragma unroll
    for (int i = 0; i < 4; ++i) { a[i] = pack2(sc * O[dt][2 * i], sc * O[dt][2 * i + 1]); b[i] = pack2(sc * O[dt][8 + 2 * i], sc * O[dt][8 + 2 * i + 1]); }
    *(u32x4*)(otL + lane * 128 + dt * 32) = a;
    *(u32x4*)(otL + lane * 128 + dt * 32 + 16) = b;
  }
}
DI void ot_accum(const char* otL, int lane, f32x16 (&O)[4], float sc) {
#pragma unroll
  for (int dt = 0; dt < 4; ++dt) {
    u32x4 a = *(const u32x4*)(otL + lane * 128 + dt * 32);
    u32x4 b = *(const u32x4*)(otL + lane * 128 + dt * 32 + 16);
#pragma unroll
    for (int i = 0; i < 4; ++i) {
      const unsigned wa = a[i], wb = b[i];
      O[dt][2 * i] = fmaf(sc, O[dt][2 * i], __uint_as_float(wa << 16));
      O[dt][2 * i + 1] = fmaf(sc, O[dt][2 * i + 1], __uint_as_float(wa & 0xFFFF0000u));
      O[dt][8 + 2 * i] = fmaf(sc, O[dt][8 + 2 * i], __uint_as_float(wb << 16));
      O[dt][8 + 2 * i + 1] = fmaf(sc, O[dt][8 + 2 * i + 1], __uint_as_float(wb & 0xFFFF0000u));
    }
  }
}
DI void zero_o(f32x16 (&O)[4]) {
#pragma unroll
  for (int dt = 0; dt < 4; ++dt)
#pragma unroll
    for (int i = 0; i < 16; ++i) O[dt][i] = 0.f;
}

constexpr int ATT_PW = 8704;
constexpr int ATT_R = 4, ATT_D = 3;
constexpr int ATT_RING = 8 * ATT_PW;
constexpr int ATT_LIST = ATT_RING + ATT_R * 16384;
constexpr int ATT_BUNI = ATT_LIST + 2048;
constexpr int ATT_SMEM = ATT_BUNI + 64;
#define LAS3 __attribute__((address_space(3)))
__device__ __forceinline__ void d_select(const float* impL, unsigned* mskL, unsigned* uniL, int cur) {
  const int lane = TIDX & 63;
  const int stok = lane >> 3, sub = lane & 7;
  unsigned key[32];
#pragma unroll
  for (int i4 = 0; i4 < 8; ++i4) {
    f32x4 v = *(const f32x4*)(impL + stok * 256 + sub * 32 + i4 * 4);
#pragma unroll
    for (int e = 0; e < 4; ++e) {
      const int j = sub * 32 + i4 * 4 + e;
      const bool valid = j <= cur;
      const bool forced = (j == 0) || (j == cur) || (j == cur - 1);
      unsigned kb = forced ? 0xFFFFFF00u : (__float_as_uint(v[e]) & 0xFFFFFF00u);
      key[i4 * 4 + e] = valid ? (kb | (unsigned)(255 - j)) : 0u;
    }
  }
#pragma unroll
  for (int k = 2; k <= 32; k <<= 1) {
#pragma unroll
    for (int jj = k >> 1; jj > 0; jj >>= 1) {
#pragma unroll
      for (int i = 0; i < 32; ++i) {
        const int l2 = i ^ jj;
        if (l2 > i) {
          const bool desc = ((i & k) == 0);
          unsigned a = key[i], b = key[l2];
          unsigned mx = a > b ? a : b, mn = a > b ? b : a;
          key[i] = desc ? mx : mn; key[l2] = desc ? mn : mx;
        }
      }
    }
  }
#pragma unroll
  for (int xm = 1; xm < 8; xm <<= 1) {
    unsigned L[16];
#pragma unroll
    for (int i = 0; i < 16; ++i) { unsigned o = (unsigned)shx_i((int)key[15 - i], xm); L[i] = key[i] > o ? key[i] : o; }
#pragma unroll
    for (int jj = 8; jj > 0; jj >>= 1) {
#pragma unroll
      for (int i = 0; i < 16; ++i) {
        const int l2 = i ^ jj;
        if (l2 > i) { unsigned a = L[i], b = L[l2]; L[i] = a > b ? a : b; L[l2] = a > b ? b : a; }
      }
    }
#pragma unroll
    for (int i = 0; i < 16; ++i) key[i] = L[i];
  }
#pragma unroll
  for (int i = 0; i < 16; ++i) {
    if ((i & 7) == sub) {
      const int j = 255 - (int)(key[i] & 255u);
      if (j <= cur) { atomicOr(&mskL[stok * 8 + (j >> 5)], 1u << (j & 31)); atomicOr(&uniL[j >> 5], 1u << (j & 31)); }
    }
  }
}


DI void att_issue(LAS3 unsigned char* ring, int slot, int w, int lane, const bf16_t* kb, const bf16_t* vb, int tile) {
  const char* ks = (const char*)kb + (size_t)tile * 8192 + w * 1024 + lane * 16;
  const char* vs = (const char*)vb + (size_t)tile * 8192 + w * 1024 + lane * 16;
  __builtin_amdgcn_global_load_lds((const unsigned*)ks, (LAS3 unsigned*)(ring + slot * 16384 + w * 1024), 16, 0, 0);
  __builtin_amdgcn_global_load_lds((const unsigned*)vs, (LAS3 unsigned*)(ring + slot * 16384 + 8192 + w * 1024), 16, 0, 0);
}
DI f32x16 qk_lds(LAS3 const unsigned char* kt, const bf16x8 (&qf)[8], int lane) {
  f32x16 acc;
#pragma unroll
  for (int i = 0; i < 16; ++i) acc[i] = 0.f;
#pragma unroll
  for (int s8 = 0; s8 < 8; ++s8) {
    const bf16x8 kf = *(LAS3 const bf16x8*)(kt + s8 * 1024 + lane * 16);
    acc = MFMA32(kf, qf[s8], acc);
  }
  return acc;
}
DI void pv_lds(LAS3 const unsigned char* vt, const float (&p)[16], f32x16 (&O)[4], int lane) {
  const bf16x8 pf0 = pack8(p[0], p[1], p[2], p[3], p[4], p[5], p[6], p[7]);
  const bf16x8 pf1 = pack8(p[8], p[9], p[10], p[11], p[12], p[13], p[14], p[15]);
#pragma unroll
  for (int dt = 0; dt < 4; ++dt) {
    const bf16x8 v0 = *(LAS3 const bf16x8*)(vt + (dt * 2) * 1024 + lane * 16);
    const bf16x8 v1 = *(LAS3 const bf16x8*)(vt + (dt * 2 + 1) * 1024 + lane * 16);
    O[dt] = MFMA32(v0, pf0, O[dt]);
    O[dt] = MFMA32(v1, pf1, O[dt]);
  }
}

__device__ __forceinline__ void d_attn_block(int B, int g, char* smem, const AttnPtrs& P) {
  const int tid = TIDX, lane = tid & 63, w = tid >> 6;
  const int c = lane & 31, h = lane >> 5, tokl = c >> 2, r = c & 3;
  const int tok0 = 64 * B + 8 * w;
  const int t = tok0 + tokl, hd = g * 4 + r;
  const float slope2 = exp2f(-(float)(hd + 1)) * LOG2E;
  const float c1 = QSCALE * LOG2E;
  const float ninf = -__builtin_inff();
  char* wsm = smem + w * ATT_PW;
  float* impL = (float*)wsm;
  char* otL = wsm;
  unsigned* mskL = (unsigned*)(wsm + 8192);
  unsigned* uniL = mskL + 64;
  LAS3 unsigned char* ring = (LAS3 unsigned char*)(smem + ATT_RING);
  unsigned short* tl = (unsigned short*)(smem + ATT_LIST);
  unsigned* buni = (unsigned*)(smem + ATT_BUNI);
  const bf16_t* kcf = P.kcf + (size_t)g * 32 * 4096;
  const bf16_t* vcf = P.vcf + (size_t)g * 32 * 4096;
  const bf16_t* ksf = P.ksf + (size_t)g * 512 * 4096;
  const bf16_t* vsf = P.vsf + (size_t)g * 512 * 4096;
  const bf16_t* kwf = P.kwf + (size_t)g * 512 * 4096;
  const bf16_t* vwf = P.vwf + (size_t)g * 512 * 4096;
  bf16x8 qf[8];
  {
    const bf16_t* qrow = P.proj + (size_t)t * INWP + OFF_Q + hd * 128 + 8 * h;
#pragma unroll
    for (int s8 = 0; s8 < 8; ++s8) qf[s8] = *(const bf16x8*)(qrow + 16 * s8);
  }
  const float* gt = P.gates + (size_t)t * 24 + hd * 3;
  const float g0 = gt[0], g1 = gt[1], g2 = gt[2];
  {
    unsigned z0 = 0u;
    asm volatile("" : "+v"(z0));
    u32x4 z = {z0, z0, z0, z0};
#pragma unroll
    for (int i = 0; i < 8; ++i) *(u32x4*)(wsm + (i * 64 + lane) * 16) = z;
    if (lane < 18) *(u32x4*)(wsm + 8192 + lane * 16) = z;
    if (tid < 8) buni[tid] = z0;
  }
  f32x16 Ob[4];
  zero_o(Ob);
  const int nmax = (t >= 31) ? ((t - 31) >> 4) : -1;
  const int nmaxw = (tok0 + 7 >= 31) ? ((tok0 + 7 - 31) >> 4) : -1;
  const int nminw = (tok0 >= 31) ? ((tok0 - 31) >> 4) : -1;
  const int ntcw = (nmaxw + 32) >> 5;
  const int ntcB = (((64 * B + 63 - 31) >> 4) + 32) >> 5;
  const float sl16 = slope2 * 16.f;
  float mC = NEGB, lC = 0.f, invC = 0.f, carry = 0.f;
  {
    const int n = 2 * ntcB;
    asm volatile("s_waitcnt vmcnt(0)" ::: "memory");
#define A_TILE(i_) (((i_) < ntcB) ? (ntcB - 1 - (i_)) : ((i_) - ntcB))
    att_issue(ring, 0, w, lane, kcf, vcf, A_TILE(0));
    if (n > 1) att_issue(ring, 1, w, lane, kcf, vcf, A_TILE(1));
#pragma unroll 1
    for (int i = 0; i < n; ++i) {
      if ((i & 1) == 0) {
        asm volatile("s_waitcnt vmcnt(0)" ::: "memory");
        __builtin_amdgcn_s_barrier();
        asm volatile("" ::: "memory");
        if (i + 2 < n) att_issue(ring, (i + 2) & 3, w, lane, kcf, vcf, A_TILE(i + 2));
        if (i + 3 < n) att_issue(ring, (i + 3) & 3, w, lane, kcf, vcf, A_TILE(i + 3));
      }
      const int T = A_TILE(i);
      if (T >= ntcw) continue;
      LAS3 const unsigned char* slot = ring + (i % ATT_R) * 16384;
      const f32x16 acc = qk_lds(slot, qf, lane);
      const float base = slope2 * (float)(512 * T + 128 * h) + slope2 * (15.5f - (float)t);
      const int nb = 32 * T + 8 * h;
      const bool full = (32 * T + 31 <= nminw);
      float sv[16];
#pragma unroll
      for (int rg = 0; rg < 16; ++rg) { const int kk = (rg & 7) + 16 * (rg >> 3); sv[rg] = fmaf(acc[rg], c1, fmaf(sl16, (float)kk, base)); }
      if (!full) {
#pragma unroll
        for (int rg = 0; rg < 16; ++rg) { const int kk = (rg & 7) + 16 * (rg >> 3); sv[rg] = (nb + kk <= nmax) ? sv[rg] : ninf; }
      }
      if (i < ntcB) {
        float tmax = fmaxf(fmaxf(fmaxf(sv[0], sv[1]), fmaxf(sv[2], sv[3])), fmaxf(fmaxf(sv[4], sv[5]), fmaxf(sv[6], sv[7])));
        tmax = fmaxf(tmax, fmaxf(fmaxf(fmaxf(sv[8], sv[9]), fmaxf(sv[10], sv[11])), fmaxf(fmaxf(sv[12], sv[13]), fmaxf(sv[14], sv[15]))));
        tmax = hmax(tmax);
        const float mn = fmaxf(mC, tmax);
        float ps = 0.f;
#pragma unroll
        for (int rg = 0; rg < 16; ++rg) ps += ex2(sv[rg] - mn);
        lC = lC * ex2(mC - mn) + ps; mC = mn;
      } else {
        if (T == 0) { lC = hsum(lC); invC = (lC > 0.f) ? 1.f / lC : 0.f; }
        float p[16];
#pragma unroll
        for (int rg = 0; rg < 16; ++rg) p[rg] = ex2(sv[rg] - mC) * invC;
        float Ga = (p[0] + p[1]) + (p[2] + p[3]), Gb = (p[4] + p[5]) + (p[6] + p[7]);
        float Gc = (p[8] + p[9]) + (p[10] + p[11]), Gd = (p[12] + p[13]) + (p[14] + p[15]);
        float xb, xd; { float a_, b_; halves(p[7], a_, b_); xb = h ? a_ : b_; halves(p[15], a_, b_); xd = h ? a_ : b_; }
        float ia = Ga + (h ? xb : carry);
        float ib = Gb + p[3];
        float ic = Gc + (h ? xd : xb);
        float id = Gd + p[11];
        carry = xd;
        ia = quad_sum(ia); ib = quad_sum(ib); ic = quad_sum(ic); id = quad_sum(id);
        {
          float val = (r == 0) ? ia : (r == 1) ? ib : (r == 2) ? ic : id;
          int j = 8 * T + 2 * h + ((r == 0) ? 0 : (r == 1) ? 1 : (r == 2) ? 4 : 5);
          impL[tokl * 256 + j] = val;
        }
        pv_lds(slot + 8192, p, Ob, lane);
      }
    }
#undef A_TILE
  }
  const int cur = B;
  d_select(impL, mskL, uniL, cur);
  ot_store(otL, lane, Ob, g0);
  zero_o(Ob);
  if (lane < 8) { const unsigned u = uniL[lane]; if (u) atomicOr(&buni[lane], u); }
  __syncthreads();
  int nslc = 0, ntl = 0;
  {
    for (int iw = 7; iw >= 0; --iw) {
      unsigned iuw = __builtin_amdgcn_readfirstlane(buni[iw]);
      while (iuw) {
        const int bit = 31 - __builtin_clz(iuw);
        iuw &= ~(1u << bit);
        const int bb = 32 * iw + bit;
        if (bb < B) { if (lane == 0) tl[ntl] = (unsigned short)(2 * bb + 1); ++ntl; }
        else { if (lane == 0) tl[ntl] = (unsigned short)(2 * bb + 1); ++ntl; }
        if (lane == 0) tl[ntl] = (unsigned short)(2 * bb);
        ++ntl;
      }
    }
    nslc = ntl;
    const int ThiB = 2 * B + 1, TloB = ((64 * B - 511 > 0) ? (64 * B - 511) : 0) >> 5;
    for (int T = ThiB; T >= TloB; --T) { if (lane == 0) tl[ntl] = (unsigned short)T; ++ntl; }
  }
  float m = NEGB, l = 0.f;
  {
    const int n = ntl;
    const int Tlow = ((tok0 - 511 > 0) ? (tok0 - 511) : 0) >> 5, Thiw = (tok0 + 7) >> 5;
#define B_ISSUE(j_, slot_) { const int e_ = __builtin_amdgcn_readfirstlane((int)tl[j_]); if ((j_) < nslc) att_issue(ring, slot_, w, lane, ksf, vsf, e_); else att_issue(ring, slot_, w, lane, kwf, vwf, e_); }
    B_ISSUE(0, 0)
    if (n > 1) B_ISSUE(1, 1)
#pragma unroll 1
    for (int i = 0; i < n; ++i) {
      if ((i & 1) == 0) {
        asm volatile("s_waitcnt vmcnt(0)" ::: "memory");
        __builtin_amdgcn_s_barrier();
        asm volatile("" ::: "memory");
        if (i + 2 < n) B_ISSUE(i + 2, (i + 2) & 3)
        if (i + 3 < n) B_ISSUE(i + 3, (i + 3) & 3)
      }
      if (i == nslc) {
        l = hsum(l);
        const float inv = (l > 0.f) ? g1 / l : 0.f;
        ot_accum(otL, lane, Ob, inv);
        ot_store(otL, lane, Ob, 1.f);
        zero_o(Ob);
        m = NEGB; l = 0.f;
      }
      const int T = __builtin_amdgcn_readfirstlane((int)tl[i]);
      const int pos0 = 32 * T, pb = pos0 + 8 * h;
      bool full; bool mine = true;
      if (i < nslc) {
        const int bb = T >> 1;
        const unsigned uw = __builtin_amdgcn_readfirstlane(uniL[bb >> 5]);
        if (!((uw >> (bb & 31)) & 1u) || pos0 > tok0 + 7) continue;
        mine = (mskL[tokl * 8 + (bb >> 5)] >> (bb & 31)) & 1u;
        full = (pos0 + 31 <= tok0) && (__ballot(!mine) == 0ull);
      } else {
        if (T < Tlow || T > Thiw) continue;
        full = (pos0 + 31 <= tok0) && (pos0 >= tok0 + 7 - 511);
      }
      LAS3 const unsigned char* slot = ring + (i % ATT_R) * 16384;
      const f32x16 acc = qk_lds(slot, qf, lane);
      const float base = slope2 * (float)(pos0 + 8 * h - t);
      float sv[16], p[16];
#pragma unroll
      for (int rg = 0; rg < 16; ++rg) { const int kk = (rg & 7) + 16 * (rg >> 3); sv[rg] = fmaf(acc[rg], c1, fmaf(slope2, (float)kk, base)); }
      if (!full) {
        if (i < nslc) {
#pragma unroll
          for (int rg = 0; rg < 16; ++rg) { const int kk = (rg & 7) + 16 * (rg >> 3); sv[rg] = (mine && (pb + kk <= t)) ? sv[rg] : ninf; }
        } else {
#pragma unroll
          for (int rg = 0; rg < 16; ++rg) { const int kk = (rg & 7) + 16 * (rg >> 3); const int dw = t - (pb + kk); sv[rg] = ((dw >= 0) && (dw < 512)) ? sv[rg] : ninf; }
        }
      }
      osm_step(sv, m, l, Ob, p);
      pv_lds(slot + 8192, p, Ob, lane);
    }
#undef B_ISSUE
    l = hsum(l);
    const float inv = (l > 0.f) ? g2 / l : 0.f;
    ot_accum(otL, lane, Ob, inv);
  }
  {
    float ss = 0.f;
#pragma unroll
    for (int dt = 0; dt < 4; ++dt)
#pragma unroll
      for (int i = 0; i < 16; ++i) ss = fmaf(Ob[dt][i], Ob[dt][i], ss);
    ss = hsum(ss);
    const float rs = rsqrtf(ss * (1.f / 128.f) + 1e-6f);
    bf16_t* orow = P.mix + (size_t)t * DM + hd * 128 + 4 * h;
    const float* grow = P.hng + hd * 128 + 4 * h;
#pragma unroll
    for (int dt = 0; dt < 4; ++dt)
#pragma unroll
      for (int a = 0; a < 4; ++a) {
        const f32x4 gv = *(const f32x4*)(grow + 32 * dt + 8 * a);
        u32x2 wv2 = {pack2(Ob[dt][4 * a] * rs * gv[0], Ob[dt][4 * a + 1] * rs * gv[1]), pack2(Ob[dt][4 * a + 2] * rs * gv[2], Ob[dt][4 * a + 3] * rs * gv[3])};
        *(u32x2*)(orow + 32 * dt + 8 * a) = wv2;
      }
  }
  asm volatile("s_waitcnt vmcnt(0)" ::: "memory");
  __syncthreads();
}

__device__ void d_convmix(int t, int tl, const bf16_t* __restrict__ proj, const float* __restrict__ convw, const float* __restrict__ hng,
                          bf16_t* __restrict__ mix) {
  const int c = tl * 8;
  float acc[8];
#pragma unroll
  for (int i = 0; i < 8; ++i) acc[i] = 0.f;
#pragma unroll
  for (int j = 0; j < 3; ++j) {
    const int tt = t - 2 + j;
    if (tt >= 0) {
      const u32x4 cu = *(const u32x4*)(proj + (size_t)tt * INWP + OFF_C + c);
      const u32x4 uu = *(const u32x4*)(proj + (size_t)tt * INWP + OFF_U + c);
      const f32x4 w0 = *(const f32x4*)(convw + j * 1024 + c), w1 = *(const f32x4*)(convw + j * 1024 + c + 4);
#pragma unroll
      for (int i = 0; i < 4; ++i) {
        const unsigned a = cu[i], b = uu[i];
        const float wl = (i < 2) ? w0[2 * i] : w1[2 * i - 4], wh = (i < 2) ? w0[2 * i + 1] : w1[2 * i - 3];
        acc[2 * i] = fmaf(wl * __uint_as_float(a << 16), __uint_as_float(b << 16), acc[2 * i]);
        acc[2 * i + 1] = fmaf(wh * __uint_as_float(a & 0xFFFF0000u), __uint_as_float(b & 0xFFFF0000u), acc[2 * i + 1]);
      }
    }
  }
  const u32x4 bb = *(const u32x4*)(proj + (size_t)t * INWP + OFF_B + c);
  float ss = 0.f;
#pragma unroll
  for (int i = 0; i < 4; ++i) {
    const unsigned b = bb[i];
    acc[2 * i] *= __uint_as_float(b << 16); acc[2 * i + 1] *= __uint_as_float(b & 0xFFFF0000u);
    ss = fmaf(acc[2 * i], acc[2 * i], ss); ss = fmaf(acc[2 * i + 1], acc[2 * i + 1], ss);
  }
  ss += shx(ss, 8); ss += shx(ss, 4); ss += shx(ss, 2); ss += shx(ss, 1);
  const float rs = rsqrtf(ss * (1.f / 128.f) + 1e-6f);
  const f32x4 g0 = *(const f32x4*)(hng + 1024 + c), g1 = *(const f32x4*)(hng + 1024 + c + 4);
  u32x4 o = {pack2(acc[0] * rs * g0[0], acc[1] * rs * g0[1]), pack2(acc[2] * rs * g0[2], acc[3] * rs * g0[3]),
             pack2(acc[4] * rs * g1[0], acc[5] * rs * g1[1]), pack2(acc[6] * rs * g1[2], acc[7] * rs * g1[3])};
  *(u32x4*)(mix + (size_t)t * DM + 1024 + c) = o;
}

__device__ void d_ln_wave(int t, bf16_t* __restrict__ yh, const float* __restrict__ gam, const float* __restrict__ bet) {
  const int lane = TIDX & 63;
  float v[32];
#pragma unroll
  for (int i = 0; i < 4; ++i) {
    const u32x4 w = *(const u32x4*)(yh + (size_t)t * DM + 512 * i + 8 * lane);
#pragma unroll
    for (int j = 0; j < 4; ++j) { const unsigned ww = w[j]; v[i * 8 + 2 * j] = __uint_as_float(ww << 16); v[i * 8 + 2 * j + 1] = __uint_as_float(ww & 0xFFFF0000u); }
  }
  float s = 0.f;
#pragma unroll
  for (int i = 0; i < 32; ++i) s += v[i];
  s = wave_sum(s);
  const float mu = s * (1.f / DM);
  float q = 0.f;
#pragma unroll
  for (int i = 0; i < 32; ++i) { const float d = v[i] - mu; q = fmaf(d, d, q); }
  q = wave_sum(q);
  const float rs = rsqrtf(q * (1.f / DM) + 1e-5f);
#pragma unroll
  for (int i = 0; i < 4; ++i) {
    const int cb = 512 * i + 8 * lane;
    const f32x4 g0 = *(const f32x4*)(gam + cb), g1 = *(const f32x4*)(gam + cb + 4), b0 = *(const f32x4*)(bet + cb), b1 = *(const f32x4*)(bet + cb + 4);
    u32x4 o = {pack2((v[i * 8 + 0] - mu) * rs * g0[0] + b0[0], (v[i * 8 + 1] - mu) * rs * g0[1] + b0[1]), pack2((v[i * 8 + 2] - mu) * rs * g0[2] + b0[2], (v[i * 8 + 3] - mu) * rs * g0[3] + b0[3]),
               pack2((v[i * 8 + 4] - mu) * rs * g1[0] + b1[0], (v[i * 8 + 5] - mu) * rs * g1[1] + b1[1]), pack2((v[i * 8 + 6] - mu) * rs * g1[2] + b1[2], (v[i * 8 + 7] - mu) * rs * g1[3] + b1[3])};
    *(u32x4*)(yh + (size_t)t * DM + cb) = o;
  }
}

__device__ void d_cvt_w1f(size_t c, const float* __restrict__ w1, bf16_t* __restrict__ w1f) {
  const int lane = c & 63, ks = (c >> 6) & 255, ct = c >> 14;
  const int col = lane & 31, h = lane >> 5;
  bf16_t v[8];
#pragma unroll
  for (int j = 0; j < 8; ++j) v[j] = f2bf(w1[(size_t)(16 * ks + 8 * h + j) * 512 + 32 * ct + col]);
  u32x4 o; o.x = v[0] | ((unsigned)v[1] << 16); o.y = v[2] | ((unsigned)v[3] << 16); o.z = v[4] | ((unsigned)v[5] << 16); o.w = v[6] | ((unsigned)v[7] << 16);
  *(u32x4*)(w1f + c * 8) = o;
}
__device__ void d_cvt_w2f(size_t c, const float* __restrict__ w2, bf16_t* __restrict__ w2f) {
  const int lane = c & 63, s = (c >> 6) & 31, ct = c >> 11;
  const int col = lane & 31, h = lane >> 5;
  bf16_t v[8];
#pragma unroll
  for (int j = 0; j < 8; ++j) v[j] = f2bf(w2[(size_t)(16 * s + 8 * h + j) * 128 + 32 * ct + col]);
  u32x4 o; o.x = v[0] | ((unsigned)v[1] << 16); o.y = v[2] | ((unsigned)v[3] << 16); o.z = v[4] | ((unsigned)v[5] << 16); o.w = v[6] | ((unsigned)v[7] << 16);
  *(u32x4*)(w2f + c * 8) = o;
}
__device__ __forceinline__ void d_compress_unit(int rt, char* smem, const bf16_t* __restrict__ proj, int col0, const float* __restrict__ pos,
                                const bf16_t* __restrict__ w1f, const float* __restrict__ b1, const bf16_t* __restrict__ w2f,
                                bf16_t* __restrict__ outf, bool isV) {
  bf16_t* Xs = (bf16_t*)smem;
  bf16_t* Hs = (bf16_t*)(smem + 2 * 8704);
  const int tid = TIDX, lane = tid & 63, w = tid >> 6, c = lane & 31, h = lane >> 5;
  const int R0 = rt * 32;
  const int srow = tid >> 4, sch = tid & 15;
  const int grow = R0 + srow, sn = grow >> 1, sg = grow & 1;
  const bool svalid = grow < 2046;
  const bf16_t* sp = proj + (size_t)(16 * sn) * INWP + col0 + sg * 128 + sch * 8;
  f32x16 acc0, acc1;
#pragma unroll
  for (int i = 0; i < 16; ++i) { acc0[i] = 0.f; acc1[i] = 0.f; }
  u32x4 rx = {0u, 0u, 0u, 0u}; f32x4 rp0, rp1;
#define STAGE_WRITE(buf)                                                                                   \
  {                                                                                                        \
    u32x4 o_;                                                                                              \
    _Pragma("unroll") for (int i = 0; i < 4; ++i) {                                                        \
      const unsigned wv_ = rx[i];                                                                          \
      const float lo = __uint_as_float(wv_ << 16) + ((i < 2) ? rp0[2 * i] : rp1[2 * i - 4]);               \
      const float hi = __uint_as_float(wv_ & 0xFFFF0000u) + ((i < 2) ? rp0[2 * i + 1] : rp1[2 * i - 3]);   \
      o_[i] = pack2(lo, hi);                                                                               \
    }                                                                                                      \
    *(u32x4*)(Xs + (buf) * 4352 + srow * 136 + sch * 8) = o_;                                              \
  }
  if (svalid) rx = *(const u32x4*)(sp);
  rp0 = *(const f32x4*)(pos + sch * 8); rp1 = *(const f32x4*)(pos + sch * 8 + 4);
  STAGE_WRITE(0)
  __syncthreads();
  const bf16_t* wb0 = w1f + ((size_t)(2 * w) * 256 * 64 + lane) * 8;
  const bf16_t* wb1 = w1f + ((size_t)(2 * w + 1) * 256 * 64 + lane) * 8;
  bf16x8 bA[16], bB[16];
#define CMP_LOADB(BUF, L)                                                                      \
  _Pragma("unroll") for (int s8 = 0; s8 < 8; ++s8) {                                           \
    BUF[2 * s8] = *(const bf16x8*)(wb0 + (size_t)(8 * (L) + s8) * 512);                        \
    BUF[2 * s8 + 1] = *(const bf16x8*)(wb1 + (size_t)(8 * (L) + s8) * 512);                    \
  }
#define CMP_CHUNK(BUF, L)                                                                      \
  {                                                                                            \
    if ((L) + 1 < 32) {                                                                        \
      if (svalid) rx = *(const u32x4*)(sp + (size_t)((L) + 1) * INWP);                         \
      rp0 = *(const f32x4*)(pos + ((L) + 1) * 128 + sch * 8); rp1 = *(const f32x4*)(pos + ((L) + 1) * 128 + sch * 8 + 4); \
    }                                                                                          \
    const bf16_t* xa = Xs + ((L) & 1) * 4352 + c * 136 + 8 * h;                                \
    _Pragma("unroll") for (int s8 = 0; s8 < 8; ++s8) {                                         \
      const bf16x8 a = *(const bf16x8*)(xa + 16 * s8);                                         \
      acc0 = MFMA32(a, BUF[2 * s8], acc0);                                                     \
      acc1 = MFMA32(a, BUF[2 * s8 + 1], acc1);                                                 \
    }                                                                                          \
    if ((L) + 1 < 32) STAGE_WRITE(((L) + 1) & 1)                                               \
    __syncthreads();                                                                           \
  }
  CMP_LOADB(bA, 0)
#pragma unroll 1
  for (int l = 0; l < 32; l += 2) {
    CMP_LOADB(bB, l + 1)
    __builtin_amdgcn_sched_barrier(0);
    CMP_CHUNK(bA, l)
    { const int ln = (l + 2 < 32) ? l + 2 : l;
      CMP_LOADB(bA, ln) }
    __builtin_amdgcn_sched_barrier(0);
    CMP_CHUNK(bB, l + 1)
  }
#undef CMP_LOADB
#undef CMP_CHUNK
  {
    const float bb0 = b1[64 * w + c], bb1 = b1[64 * w + 32 + c];
#pragma unroll
    for (int rg = 0; rg < 16; ++rg) {
      const int row = (rg & 3) + 8 * (rg >> 2) + 4 * h;
      Hs[row * 520 + 64 * w + c] = f2bf(gelu_tanh(acc0[rg] + bb0));
      Hs[row * 520 + 64 * w + 32 + c] = f2bf(gelu_tanh(acc1[rg] + bb1));
    }
  }
  __syncthreads();
  if (w < 4) {
    f32x16 o2;
#pragma unroll
    for (int i = 0; i < 16; ++i) o2[i] = 0.f;
    const bf16_t* ha = Hs + c * 520 + 8 * h;
    const bf16_t* wb = w2f + ((size_t)w * 32 * 64 + lane) * 8;
#pragma unroll 8
    for (int s2 = 0; s2 < 32; ++s2) {
      const bf16x8 a = *(const bf16x8*)(ha + 16 * s2);
      const bf16x8 b = *(const bf16x8*)(wb + (size_t)s2 * 512);
      o2 = MFMA32(a, b, o2);
    }
    const int d = 32 * w + c;
#pragma unroll
    for (int rg = 0; rg < 16; ++rg) {
      const int row = R0 + (rg & 3) + 8 * (rg >> 2) + 4 * h;
      const int n = row >> 1, g = row & 1;
      const bf16_t val = (row < 2046) ? f2bf(o2[rg]) : (bf16_t)0;
      const int T = n >> 5, nn = n & 31;
      size_t idx;
      if (!isV) idx = ((((size_t)(g * 32 + T) * 8 + (d >> 4)) * 64 + (pi_perm(nn) + 32 * ((d >> 3) & 1))) * 8 + (d & 7));
      else idx = (((((size_t)(g * 32 + T) * 4 + (d >> 5)) * 2 + (nn >> 4)) * 64 + ((d & 31) + 32 * ((nn >> 3) & 1))) * 8 + (nn & 7));
      outf[idx] = val;
    }
  }
  __syncthreads();
}


DI unsigned f2sort(float f) { unsigned u = __float_as_uint(f); return u ^ ((unsigned)((int)u >> 31) | 0x80000000u); }
DI float sort2f(unsigned k) { unsigned u = (k & 0x80000000u) ? (k ^ 0x80000000u) : ~k; return __uint_as_float(u); }
template <int N>
DI void bitonic_sort_desc(unsigned (&key)[N]) {
#pragma unroll
  for (int k = 2; k <= N; k <<= 1) {
#pragma unroll
    for (int jj = k >> 1; jj > 0; jj >>= 1) {
#pragma unroll
      for (int i = 0; i < N; ++i) {
        const int l2 = i ^ jj;
        if (l2 > i) {
          const bool desc = ((i & k) == 0);
          unsigned a = key[i], b = key[l2];
          unsigned mx = a > b ? a : b, mn = a > b ? b : a;
          key[i] = desc ? mx : mn; key[l2] = desc ? mn : mx;
        }
      }
    }
  }
}
DI void merge_top16(unsigned (&a)[16], const unsigned (&b)[16]) {
#pragma unroll
  for (int i = 0; i < 16; ++i) { unsigned o = b[15 - i]; a[i] = a[i] > o ? a[i] : o; }
#pragma unroll
  for (int jj = 8; jj > 0; jj >>= 1) {
#pragma unroll
    for (int i = 0; i < 16; ++i) {
      const int l2 = i ^ jj;
      if (l2 > i) { unsigned x = a[i], y = a[l2]; a[i] = x > y ? x : y; a[l2] = x > y ? y : x; }
    }
  }
}
__device__ void d_cvt_subk(size_t c, const float* __restrict__ subk, bf16_t* __restrict__ skf) {
  int lane = c & 63, s = (c >> 6) & 7, kt = (c >> 9) & 3, hc = c >> 11;
  int i = lane & 31, h = lane >> 5;
  const float* src = subk + ((size_t)hc * 128 + 32 * kt + i) * 128 + 16 * s + 8 * h;
  bf16_t v[8];
#pragma unroll
  for (int j = 0; j < 8; ++j) v[j] = f2bf(src[j]);
  u32x4 o; o.x = v[0] | ((unsigned)v[1] << 16); o.y = v[2] | ((unsigned)v[3] << 16); o.z = v[4] | ((unsigned)v[5] << 16); o.w = v[6] | ((unsigned)v[7] << 16);
  *(u32x4*)(skf + c * 8) = o;
}

struct EpiProjG {
  static constexpr bool PERM = true, AFTER_DRAIN = false;
  bf16_t* proj; float* gates;
  DI void operator()(const f32x4 (&acc)[2][2][4][2], const pg8::Unit& u, int wr, int wc, int fr, int fq) const {
#pragma unroll
    for (int ai = 0; ai < 2; ++ai)
#pragma unroll
      for (int m = 0; m < 4; ++m) {
        const int row = u.pm * 256 + ai * 128 + wr * 64 + m * 16 + fr;
#pragma unroll
        for (int bj = 0; bj < 2; ++bj) {
          const int c0 = u.pn * 256 + bj * 128 + wc * 32 + 8 * fq;
          const f32x4 v0 = acc[ai][bj][m][0], v1 = acc[ai][bj][m][1];
          if (c0 < INW) {
            u32x4 w = {pack2(v0[0], v0[1]), pack2(v0[2], v0[3]), pack2(v1[0], v1[1]), pack2(v1[2], v1[3])};
            *(u32x4*)(proj + (size_t)row * INWP + c0) = w;
          }
          if (c0 >= OFF_G && c0 < OFF_G + 24) {
            f32x4 g0, g1;
#pragma unroll
            for (int j = 0; j < 4; ++j) { g0[j] = 1.f / (1.f + __expf(-v0[j])); g1[j] = 1.f / (1.f + __expf(-v1[j])); }
            *(f32x4*)(gates + (size_t)row * 24 + (c0 - OFF_G)) = g0;
            *(f32x4*)(gates + (size_t)row * 24 + (c0 - OFF_G) + 4) = g1;
          }
        }
      }
  }
};
struct EpiResG {
  static constexpr bool PERM = false, AFTER_DRAIN = false;
  bf16_t* YB;
  DI void operator()(const f32x4 (&acc)[2][2][4][2], const pg8::Unit& u, int wr, int wc, int fr, int fq) const {
#pragma unroll
    for (int ai = 0; ai < 2; ++ai)
#pragma unroll
      for (int m = 0; m < 4; ++m) {
        const size_t ro = (size_t)(u.pm * 256 + ai * 128 + wr * 64 + m * 16 + fr) * DM + u.pn * 256 + wc * 32 + 4 * fq;
#pragma unroll
        for (int bj = 0; bj < 2; ++bj)
#pragma unroll
          for (int n = 0; n < 2; ++n) {
            const u32x2 xw = *(const u32x2*)(YB + ro + bj * 128 + n * 16);
            const f32x4 xv = {__uint_as_float(xw[0] << 16), __uint_as_float(xw[0] & 0xFFFF0000u), __uint_as_float(xw[1] << 16), __uint_as_float(xw[1] & 0xFFFF0000u)};
            const f32x4 yv = ALPHA * xv + acc[ai][bj][m][n];
            u32x2 o = {pack2(yv[0], yv[1]), pack2(yv[2], yv[3])};
            *(u32x2*)(YB + ro + bj * 128 + n * 16) = o;
          }
      }
  }
};
struct EpiF32G {
  static constexpr bool PERM = false, AFTER_DRAIN = false;
  float* C; int ldc;
  DI void operator()(const f32x4 (&acc)[2][2][4][2], const pg8::Unit& u, int wr, int wc, int fr, int fq) const {
#pragma unroll
    for (int ai = 0; ai < 2; ++ai)
#pragma unroll
      for (int m = 0; m < 4; ++m) {
        const size_t ro = (size_t)(u.pm * 256 + ai * 128 + wr * 64 + m * 16 + fr) * ldc + u.pn * 256 + wc * 32 + 4 * fq;
#pragma unroll
        for (int bj = 0; bj < 2; ++bj)
#pragma unroll
          for (int n = 0; n < 2; ++n) *(f32x4*)(C + ro + bj * 128 + n * 16) = acc[ai][bj][m][n];
      }
  }
};
struct EpiRouteG {
  static constexpr bool PERM = false, AFTER_DRAIN = true;
  const bf16_t* skf; unsigned* tops;
  DI void operator()(const f32x4 (&)[2][2][4][2], const pg8::Unit&, int, int, int, int) const {}
  DI void fused(const f32x4 (&acc)[2][2][4][2], const pg8::Unit& u, int wr, int wc, int fr, int fq, PG8_LAS unsigned char* ldsp, int, int) const {
    const int lane = fr | (fq << 4), wid = wr * 4 + wc;
    bf16_t* Qs = (bf16_t*)ldsp;
#pragma unroll
    for (int ai = 0; ai < 2; ++ai)
#pragma unroll
      for (int m = 0; m < 4; ++m) {
        const int row = ai * 128 + wr * 64 + m * 16 + fr;
#pragma unroll
        for (int bj = 0; bj < 2; ++bj)
#pragma unroll
          for (int n = 0; n < 2; ++n) {
            const f32x4 v = acc[ai][bj][m][n];
            u32x2 w = {pack2(v[0], v[1]), pack2(v[2], v[3])};
            *(u32x2*)(Qs + row * 264 + bj * 128 + wc * 32 + n * 16 + 4 * fq) = w;
          }
      }
    __syncthreads();
    const int c = lane & 31, h = lane >> 5;
#pragma unroll 1
    for (int half = 0; half < 2; ++half) {
      const int hc = u.pn * 2 + half;
      const bf16_t* sk = skf + (size_t)hc * 4 * 4096;
      const bf16_t* qp = Qs + (wid * 32 + c) * 264 + half * 128 + 8 * h;
      unsigned k0[16], k1[16];
#define ROUTE_KT(KT, KA)                                                                        \
      {                                                                                         \
        f32x16 sc;                                                                              \
        _Pragma("unroll") for (int i = 0; i < 16; ++i) sc[i] = 0.f;                             \
        _Pragma("unroll") for (int s = 0; s < 8; ++s) {                                         \
          bf16x8 af = *(const bf16x8*)(sk + (KT) * 4096 + s * 512 + lane * 8);                  \
          bf16x8 bq = *(const bf16x8*)(qp + 16 * s);                                            \
          sc = __builtin_amdgcn_mfma_f32_32x32x16_bf16(af, bq, sc, 0, 0, 0);                    \
        }                                                                                       \
        _Pragma("unroll") for (int rg = 0; rg < 16; ++rg) {                                     \
          const int kidx = 32 * (KT) + (rg & 3) + 8 * (rg >> 2) + 4 * h;                        \
          KA[rg] = (f2sort(sc[rg]) & 0xFFFFFF80u) | (unsigned)(127 - kidx);                     \
        }                                                                                       \
        bitonic_sort_desc<16>(KA);                                                              \
      }
      ROUTE_KT(0, k0)
      __builtin_amdgcn_sched_barrier(0);
      ROUTE_KT(1, k1)
      merge_top16(k0, k1);
      __builtin_amdgcn_sched_barrier(0);
      ROUTE_KT(2, k1)
      merge_top16(k0, k1);
      __builtin_amdgcn_sched_barrier(0);
      ROUTE_KT(3, k1)
      merge_top16(k0, k1);
      __builtin_amdgcn_sched_barrier(0);
#undef ROUTE_KT
#pragma unroll
      for (int i = 0; i < 16; ++i) k1[i] = (unsigned)shx_i((int)k0[i], 32);
      merge_top16(k0, k1);
      if (h == 0) {
        unsigned* dst = tops + ((size_t)(u.pm * 256 + wid * 32 + c) * 16 + hc) * 16;
#pragma unroll
        for (int q4 = 0; q4 < 4; ++q4) { u32x4 o = {k0[4 * q4], k0[4 * q4 + 1], k0[4 * q4 + 2], k0[4 * q4 + 3]}; *(u32x4*)(dst + 4 * q4) = o; }
      }
    }
    __syncthreads();
  }
};


template <int CTRL> DI float dpp_f(float v) { const int iv = __float_as_int(v); return __int_as_float(__builtin_amdgcn_update_dpp(iv, iv, CTRL, 0xF, 0xF, false)); }
DI float wsum(float x) {
  x += dpp_f<0xB1>(x);
  x += dpp_f<0x4E>(x);
  x += dpp_f<0x124>(x);
  x += dpp_f<0x128>(x);
  x += shx(x, 16);
  return hsum(x);
}
DI float gelu_fast(float x) {
  const float u2 = 1.5957691216057308f * (x + 0.044715f * x * x * x);
  return x * __builtin_amdgcn_rcpf(1.f + ex2(-LOG2E * u2));
}

constexpr int EROW = 1152;
typedef float v2f __attribute__((ext_vector_type(2)));
__device__ void d_cvt_fp4_row(int row, const float* __restrict__ src, unsigned char* __restrict__ dst) {
  const int lane = TIDX & 63;
  float v[32]; float amax = 0.f;
#pragma unroll
  for (int i = 0; i < 8; ++i) {
    f32x4 x = *(const f32x4*)(src + (size_t)row * DM + 256 * i + 4 * lane);
#pragma unroll
    for (int j = 0; j < 4; ++j) { v[i * 4 + j] = x[j]; amax = fmaxf(amax, fabsf(x[j])); }
  }
  const float sc = amax > 0.f ? amax * (1.f / 6.f) : 1.f;
  const float scb = bf2f(f2bf(sc));
  const float inv = 1.f / scb;
  u32x4 o;
#pragma unroll
  for (int k = 0; k < 4; ++k) {
    unsigned w = 0u;
#define FP4C(x_) fminf(fmaxf((x_) * inv, -6.f), 6.f)
    w = __builtin_amdgcn_cvt_scalef32_pk_fp4_f32(w, FP4C(v[8 * k + 0]), FP4C(v[8 * k + 1]), 1.0f, 0);
    w = __builtin_amdgcn_cvt_scalef32_pk_fp4_f32(w, FP4C(v[8 * k + 2]), FP4C(v[8 * k + 3]), 1.0f, 1);
    w = __builtin_amdgcn_cvt_scalef32_pk_fp4_f32(w, FP4C(v[8 * k + 4]), FP4C(v[8 * k + 5]), 1.0f, 2);
    w = __builtin_amdgcn_cvt_scalef32_pk_fp4_f32(w, FP4C(v[8 * k + 6]), FP4C(v[8 * k + 7]), 1.0f, 3);
#undef FP4C
    o[k] = w;
  }
  *(u32x4*)(dst + (size_t)row * EROW + 16 * lane) = o;
  *(bf16_t*)(dst + (size_t)row * EROW + 1024 + 2 * lane) = f2bf(sc);
}
__device__ void d_expert_wave(int t, unsigned* tpl, const bf16_t* __restrict__ hbuf,
                              const unsigned* __restrict__ tops, const unsigned char* __restrict__ eu4, const unsigned char* __restrict__ ev4,
                              const float* __restrict__ gam, const float* __restrict__ bet, float* __restrict__ out) {
  const int lane = TIDX & 63;
  float hv[32];
#pragma unroll
  for (int i = 0; i < 8; ++i) {
    const u32x2 w = *(const u32x2*)(hbuf + (size_t)t * DM + 256 * i + 4 * lane);
    hv[i * 4 + 0] = __uint_as_float(w[0] << 16); hv[i * 4 + 1] = __uint_as_float(w[0] & 0xFFFF0000u);
    hv[i * 4 + 2] = __uint_as_float(w[1] << 16); hv[i * 4 + 3] = __uint_as_float(w[1] & 0xFFFF0000u);
  }
  int e0 = 0, e1 = 0; float w0 = 0.f, w1 = 0.f;
  {
    const int ci = (lane < 16) ? 0 : (lane < 24) ? 1 : (lane < 29) ? 2 : (lane < 33) ? 3 : (lane < 36) ? 4 : (lane < 38) ? 5 : (lane < 40) ? 6
                   : (lane < 42) ? 7 : (lane - 34);
    const int cpre = (ci == 0) ? 0 : (ci == 1) ? 16 : (ci == 2) ? 24 : (ci == 3) ? 29 : (ci == 4) ? 33 : (ci == 5) ? 36 : (ci == 6) ? 38
                     : (ci == 7) ? 40 : (34 + ci);
    const int cj = lane - cpre;
    const bool cvalid = lane < 50;
    *(u32x4*)(tpl + 4 * lane) = *(const u32x4*)(tops + (size_t)t * 256 + 4 * lane);
    const unsigned* tp = tpl;
#pragma unroll 1
    for (int hh = 0; hh < 8; ++hh) {
      unsigned key = 0u;
      if (cvalid) {
        const float sa = sort2f(tp[(2 * hh) * 16 + ci]), sb = sort2f(tp[(2 * hh + 1) * 16 + cj]);
        key = (f2sort(sa + sb) & 0xFFFFFF00u) | (unsigned)(255 - (ci * 16 + cj));
      }
#pragma unroll
      for (int k = 2; k <= 64; k <<= 1) {
#pragma unroll
        for (int jj = k >> 1; jj > 0; jj >>= 1) {
          const unsigned o = (unsigned)shx_i((int)key, jj);
          const bool lower = (lane & jj) == 0;
          const bool desc = (lane & k) == 0 || k == 64;
          const unsigned mx = key > o ? key : o, mn = key > o ? o : key;
          key = (lower == desc) ? mx : mn;
        }
      }
      const int flat = 255 - (int)(key & 255u);
      const int bi = (flat >> 4) & 15, bj = flat & 15;
      const unsigned ka = tp[(2 * hh) * 16 + bi], kb = tp[(2 * hh + 1) * 16 + bj];
      const float sc = sort2f(ka) + sort2f(kb);
      const int ex = (127 - (int)(ka & 127u)) * 128 + (127 - (int)(kb & 127u));
      float mx = sc;
      mx = fmaxf(mx, shx(mx, 1)); mx = fmaxf(mx, shx(mx, 2)); mx = fmaxf(mx, shx(mx, 4)); mx = fmaxf(mx, shx(mx, 8));
      const float ev_ = __expf(sc - mx);
      float sm = ev_;
      sm += shx(sm, 1); sm += shx(sm, 2); sm += shx(sm, 4); sm += shx(sm, 8);
      const float gv = ev_ / sm;
      const int exs = __shfl(ex, lane & 15); const float gvs = __shfl(gv, lane & 15);
      if ((lane >> 4) == (hh & 3)) { if (hh < 4) { e0 = exs; w0 = gvs; } else { e1 = exs; w1 = gvs; } }
    }
  }
  bf16x2v hb2[16];
#pragma unroll
  for (int i = 0; i < 16; ++i) hb2[i] = bf16x2v{(__bf16)hv[2 * i], (__bf16)hv[2 * i + 1]};
  float c0 = 0.f, c1 = 0.f;
  u32x4 rA[4], rB[4]; unsigned short sA[4], sB[4];
#define EX_LOAD(R, SS, TAB, EB)                                                            \
  _Pragma("unroll") for (int k = 0; k < 4; ++k) {                                          \
    const int e = (EB) + k;                                                                \
    const int id = __builtin_amdgcn_readlane((e < 64) ? e0 : e1, e & 63);                 \
    const unsigned char* row = (TAB) + (size_t)id * EROW;                                  \
    R[k] = *(const u32x4*)(row + 16 * lane);                                               \
    SS[k] = *(const unsigned short*)(row + 1024 + 2 * lane);                               \
  }
#define PKFMA(a_, b_, c_) __builtin_elementwise_fma((a_), (b_), (c_))
#define EX_COMP_U(R, SS, EB)                                                               \
  {                                                                                        \
    float dd[4];                                                                           \
    _Pragma("unroll") for (int k = 0; k < 4; ++k) {                                        \
      float d0 = 0.f, d1 = 0.f;                                                            \
      _Pragma("unroll") for (int q = 0; q < 4; ++q) {                                      \
        const unsigned wq = R[k][q];                                                       \
        d0 = __builtin_amdgcn_fdot2_f32_bf16(__builtin_amdgcn_cvt_scalef32_pk_bf16_fp4(wq, 1.0f, 0), hb2[4 * q + 0], d0, false); \
        d1 = __builtin_amdgcn_fdot2_f32_bf16(__builtin_amdgcn_cvt_scalef32_pk_bf16_fp4(wq, 1.0f, 1), hb2[4 * q + 1], d1, false); \
        d0 = __builtin_amdgcn_fdot2_f32_bf16(__builtin_amdgcn_cvt_scalef32_pk_bf16_fp4(wq, 1.0f, 2), hb2[4 * q + 2], d0, false); \
        d1 = __builtin_amdgcn_fdot2_f32_bf16(__builtin_amdgcn_cvt_scalef32_pk_bf16_fp4(wq, 1.0f, 3), hb2[4 * q + 3], d1, false); \
      }                                                                                    \
      dd[k] = bf2f(SS[k]) * (d0 + d1);                                                     \
      __builtin_amdgcn_sched_barrier(0);                                                   \
    }                                                                                      \
      \
    float t01, t23;                                                                        \
    { auto r_ = __builtin_amdgcn_permlane32_swap(__float_as_uint(dd[0]), __float_as_uint(dd[1]), false, false);   \
      t01 = __uint_as_float(r_[0]) + __uint_as_float(r_[1]); }          \
    { auto r_ = __builtin_amdgcn_permlane32_swap(__float_as_uint(dd[2]), __float_as_uint(dd[3]), false, false);   \
      t23 = __uint_as_float(r_[0]) + __uint_as_float(r_[1]); }          \
    const bool b4_ = (lane & 16) != 0;                                                     \
    float tv = (b4_ ? t23 : t01) + shx(b4_ ? t01 : t23, 16);          \
    tv += dpp_f<0x128>(tv); tv += dpp_f<0x124>(tv); tv += dpp_f<0x4E>(tv); tv += dpp_f<0xB1>(tv);                 \
    _Pragma("unroll") for (int k = 0; k < 4; ++k) {                                        \
      const int e = (EB) + k;                                                              \
      const float tot = __int_as_float(__builtin_amdgcn_readlane(__float_as_int(tv), (k == 0) ? 0 : (k == 1) ? 32 : (k == 2) ? 16 : 48)); \
      if (e < 64) { if (lane == e) c0 = tot; } else { if (lane == e - 64) c1 = tot; }        \
    }                                                                                      \
    __builtin_amdgcn_sched_barrier(0);                                                     \
  }
#define EX_COMP_V(R, SS, EB)                                                               \
  _Pragma("unroll") for (int k = 0; k < 4; ++k) {                                          \
    const int e = (EB) + k;                                                                \
    const float cs = __int_as_float(__builtin_amdgcn_readlane(__float_as_int((e < 64) ? c0 : c1), e & 63)) * bf2f(SS[k]);                     \
    const v2f cs2 = {cs, cs};                                                              \
    _Pragma("unroll") for (int q = 0; q < 4; ++q) {                                        \
      const unsigned wq = R[k][q];                                                         \
      const v2f f0 = __builtin_amdgcn_cvt_scalef32_pk_f32_fp4(wq, 1.0f, 0), f1 = __builtin_amdgcn_cvt_scalef32_pk_f32_fp4(wq, 1.0f, 1); \
      const v2f f2 = __builtin_amdgcn_cvt_scalef32_pk_f32_fp4(wq, 1.0f, 2), f3 = __builtin_amdgcn_cvt_scalef32_pk_f32_fp4(wq, 1.0f, 3); \
      acc2[4 * q + 0] = PKFMA(cs2, f0, acc2[4 * q + 0]); acc2[4 * q + 1] = PKFMA(cs2, f1, acc2[4 * q + 1]); \
      acc2[4 * q + 2] = PKFMA(cs2, f2, acc2[4 * q + 2]); acc2[4 * q + 3] = PKFMA(cs2, f3, acc2[4 * q + 3]); \
    }                                                                                      \
    __builtin_amdgcn_sched_barrier(0);                                                     \
  }
  EX_LOAD(rA, sA, eu4, 0)
  __builtin_amdgcn_sched_barrier(0);
#pragma unroll 1
  for (int eb = 0; eb < 128; eb += 8) {
    EX_LOAD(rB, sB, eu4, eb + 4)
    __builtin_amdgcn_sched_barrier(0);
    EX_COMP_U(rA, sA, eb)
    { const bool more = eb + 8 < 128; const unsigned char* tabn = more ? eu4 : ev4; const int ebn = more ? eb + 8 : 0;
      EX_LOAD(rA, sA, tabn, ebn) }
    __builtin_amdgcn_sched_barrier(0);
    EX_COMP_U(rB, sB, eb + 4)
  }
  c0 = w0 * gelu_fast(c0); c1 = w1 * gelu_fast(c1);
  v2f acc2[16];
#pragma unroll
  for (int i = 0; i < 16; ++i) acc2[i] = v2f{0.f, 0.f};
#pragma unroll 1
  for (int eb = 0; eb < 128; eb += 8) {
    EX_LOAD(rB, sB, ev4, eb + 4)
    __builtin_amdgcn_sched_barrier(0);
    EX_COMP_V(rA, sA, eb)
    { const int ebn = (eb + 8 < 128) ? eb + 8 : 0;
      EX_LOAD(rA, sA, ev4, ebn) }
    __builtin_amdgcn_sched_barrier(0);
    EX_COMP_V(rB, sB, eb + 4)
  }
#undef EX_LOAD
#undef EX_COMP_U
#undef EX_COMP_V
#undef PKFMA
  float acc[32];
#pragma unroll
  for (int i = 0; i < 16; ++i) { acc[2 * i] = acc2[i].x; acc[2 * i + 1] = acc2[i].y; }
  int le = lane;
  asm volatile("" : "+v"(le) :: "memory");
  float s = 0.f;
#pragma unroll
  for (int i = 0; i < 8; ++i) {
    const u32x2 w = *(const u32x2*)(hbuf + (size_t)t * DM + 256 * i + 4 * le);
    const float h0 = __uint_as_float(w[0] << 16), h1 = __uint_as_float(w[0] & 0xFFFF0000u), h2 = __uint_as_float(w[1] << 16), h3 = __uint_as_float(w[1] & 0xFFFF0000u);
    acc[i * 4 + 0] = fmaf(ALPHA, h0, acc[i * 4 + 0]); acc[i * 4 + 1] = fmaf(ALPHA, h1, acc[i * 4 + 1]);
    acc[i * 4 + 2] = fmaf(ALPHA, h2, acc[i * 4 + 2]); acc[i * 4 + 3] = fmaf(ALPHA, h3, acc[i * 4 + 3]);
    s += (acc[i * 4 + 0] + acc[i * 4 + 1]) + (acc[i * 4 + 2] + acc[i * 4 + 3]);
  }
  s = wsum(s);
  const float mu = s * (1.f / DM);
  float qv = 0.f;
#pragma unroll
  for (int i = 0; i < 32; ++i) { const float d = acc[i] - mu; qv += d * d; }
  qv = wsum(qv);
  const float rs = rsqrtf(qv * (1.f / DM) + 1e-5f);
#pragma unroll
  for (int i = 0; i < 8; ++i) {
    const int cbase = 256 * i + 4 * le;
    f32x4 ga = *(const f32x4*)(gam + cbase), ba = *(const f32x4*)(bet + cbase), o;
#pragma unroll
    for (int j = 0; j < 4; ++j) o[j] = (acc[i * 4 + j] - mu) * rs * ga[j] + ba[j];
    *(f32x4*)(out + (size_t)t * DM + cbase) = o;
  }
}

constexpr size_t al256(size_t x) { return (x + 255) & ~(size_t)255; }
constexpr size_t WS_XB = 0;
constexpr size_t WS_PROJ = WS_XB + al256((size_t)S * DM * 2);
constexpr size_t WS_WINT = WS_PROJ + al256((size_t)S * INWP * 2);
constexpr size_t WS_GATES = WS_WINT + al256((size_t)INWG * DM * 2);
constexpr size_t WS_W1KF = WS_GATES + al256((size_t)S * 24 * 4);
constexpr size_t WS_W1VF = WS_W1KF + al256((size_t)512 * 4096 * 2);
constexpr size_t WS_W2KF = WS_W1VF + al256((size_t)512 * 4096 * 2);
constexpr size_t WS_W2VF = WS_W2KF + al256((size_t)512 * 128 * 2);
constexpr size_t WS_VC = WS_W2VF + al256((size_t)512 * 128 * 2) - al256((size_t)2048 * 128 * 4);
constexpr size_t WS_KCF = WS_VC + al256((size_t)2048 * 128 * 4);
constexpr size_t WS_VCF = WS_KCF + al256((size_t)2 * 32 * 4096 * 2);
constexpr size_t WS_KSF = WS_VCF + al256((size_t)2 * 32 * 4096 * 2);
constexpr size_t WS_VSF = WS_KSF + al256((size_t)2 * 512 * 4096 * 2);
constexpr size_t WS_KWF = WS_VSF + al256((size_t)2 * 512 * 4096 * 2);
constexpr size_t WS_VWF = WS_KWF + al256((size_t)2 * 512 * 4096 * 2);
constexpr size_t WS_ENDA = WS_VWF + al256((size_t)2 * 512 * 4096 * 2);
constexpr size_t WS_OATT = WS_ENDA;
constexpr size_t WS_MIX = WS_OATT + al256((size_t)S * 1024 * 4);
constexpr size_t WS_WOUTT = WS_MIX + al256((size_t)S * DM * 2);
constexpr size_t WS_WQT = WS_WOUTT + al256((size_t)DM * DM * 2);
constexpr size_t WS_TOPS = WS_WQT + al256((size_t)DM * DM * 2);
constexpr size_t WS_SKF = WS_TOPS + al256((size_t)S * 256 * 4);
constexpr size_t WS_STATS = WS_SKF + al256((size_t)16 * 128 * 128 * 2);
constexpr size_t WS_CTRL = WS_STATS + al256((size_t)S * 2 * 4);
constexpr size_t CTRL_BYTES = 32768;
constexpr size_t WS_END = WS_CTRL + CTRL_BYTES;
constexpr size_t WS_Y = WS_PROJ;
constexpr size_t WS_HB = WS_XB;
constexpr size_t WS_EU8 = WS_OATT;
constexpr size_t WS_EV8 = WS_EU8 + (size_t)16384 * 1152;
static_assert(WS_EV8 + (size_t)16384 * 1152 <= WS_MIX, "expert tables overflow their region");
constexpr int EXP_EARLY = 6144;
static_assert(WS_END <= (size_t)512 * 1024 * 1024, "workspace over 512 MiB");

struct Params {
  const float *x, *w_in, *ck_pos, *ck_w1, *ck_b1, *ck_w2, *cv_pos, *cv_w1, *cv_b1, *cv_w2, *conv_w, *hng, *w_out, *ln1g, *ln1b, *w_query, *subk,
      *eu, *ev, *ln2g, *ln2b;
  float* out;
  char* ws;
};
#define WSP(T, OFF) ((T*)(p.ws + (OFF)))

#define FOR_VB(n) for (int vb = blockIdx.x; vb < (n); vb += gridDim.x)
#define FOR_VB2(n) for (int vb = blockIdx.x * 2 + (TIDX >> 8); vb < (n); vb += gridDim.x * 2)
constexpr int SMEM_BYTES = 143360;
constexpr int HALF = 36864;

__global__ void __launch_bounds__(512) mega(Params p) {
  __shared__ __attribute__((aligned(16))) char smem[SMEM_BYTES + 16];
  if (TIDX == 0) *(u32x4*)(smem + SMEM_BYTES) = u32x4{0u, 0u, 0u, 0u};
  __syncthreads();
  const XcdBarrier xbar = xcd_barrier_post(WSP(unsigned, WS_CTRL + 1024), (volatile LAS unsigned*)(smem + SMEM_BYTES));
#define smh (smem + (TIDX >> 8) * HALF)
#define wv ((TIDX >> 6))
  constexpr int NWV = 8;
  d_cvt(p.x, WSP(bf16_t, WS_XB), (size_t)S * DM / 4);
  FOR_VB2((INWG / 64) * (DM / 64)) d_cvtT64(vb, smh, p.w_in, WSP(bf16_t, WS_WINT), DM, INW, INWG);
  for (size_t c = (size_t)blockIdx.x * 512 + TIDX; c < (size_t)16 * 256 * 64; c += (size_t)gridDim.x * 512) {
    d_cvt_w1f(c, p.ck_w1, WSP(bf16_t, WS_W1KF)); d_cvt_w1f(c, p.cv_w1, WSP(bf16_t, WS_W1VF));
    if (c < (size_t)4 * 32 * 64) { d_cvt_w2f(c, p.ck_w2, WSP(bf16_t, WS_W2KF)); d_cvt_w2f(c, p.cv_w2, WSP(bf16_t, WS_W2VF)); }
  }
  FOR_VB2((DM / 64) * (DM / 64)) d_cvtT64(vb, smh, p.w_out, WSP(bf16_t, WS_WOUTT), DM, DM, DM);
  FOR_VB2((DM / 64) * (DM / 64)) d_cvtT64(vb, smh, p.w_query, WSP(bf16_t, WS_WQT), DM, DM, DM);
  for (size_t c = (size_t)blockIdx.x * 512 + TIDX; c < (size_t)16 * 4 * 8 * 64; c += (size_t)gridDim.x * 512) d_cvt_subk(c, p.subk, WSP(bf16_t, WS_SKF));
  xcd_barrier(xbar);
  {
    pg8::StaticOrder so; so.init(S, INWG, gridDim.x, blockIdx.x);
    pg8::gemm_phase<EpiProjG, pg8::StaticOrder>((PG8_LAS unsigned char*)smem, pg8::Gemm{WSP(bf16_t, WS_XB), WSP(bf16_t, WS_WINT), S, INWG, DM}, so,
                                                EpiProjG{WSP(bf16_t, WS_PROJ), WSP(float, WS_GATES)}, nullptr);
    const int nun = (S / 256) * (INWG / 256), gsz = (int)gridDim.x;
    const int nfull = nun % gsz;
    if (nfull != 0 && (int)blockIdx.x >= nfull) {
      const int nidle = gsz - nfull, me = (int)blockIdx.x - nfull;
      for (int r = me * NWV + wv; r < 2 * EXP_EARLY; r += nidle * NWV) {
        if (r < EXP_EARLY) d_cvt_fp4_row(r, p.eu, WSP(unsigned char, WS_EU8)); else d_cvt_fp4_row(r - EXP_EARLY, p.ev, WSP(unsigned char, WS_EV8));
      }
    }
  }
  xcd_barrier(xbar);
  {
    if (blockIdx.x < 128) {
      const int xcd_ = blockIdx.x & 7, idx_ = blockIdx.x >> 3; const bool isV = (xcd_ & 1) != 0;
      d_compress_unit((xcd_ >> 1) * 16 + idx_, smem, WSP(bf16_t, WS_PROJ), isV ? OFF_VC : OFF_KC, isV ? p.cv_pos : p.ck_pos, isV ? WSP(bf16_t, WS_W1VF) : WSP(bf16_t, WS_W1KF),
                      isV ? p.cv_b1 : p.ck_b1, isV ? WSP(bf16_t, WS_W2VF) : WSP(bf16_t, WS_W2KF), isV ? WSP(bf16_t, WS_VCF) : WSP(bf16_t, WS_KCF), isV);
    }
    int* slot = (int*)smem;
    unsigned* ctr = WSP(unsigned, WS_CTRL);
    for (;;) {
      if (TIDX == 0) *slot = (int)atomicAdd(ctr, 1u);
      __syncthreads();
      const int it = *slot;
      __syncthreads();
      if (it >= 2048) break;
      const int tt = TIDX;
      {
        const int T = it >> 2, which = it & 3;
        d_relayout_tile(T, smem + 64, WSP(bf16_t, WS_PROJ), (which == 0) ? OFF_KS : (which == 1) ? OFF_VS : (which == 2) ? OFF_KW : OFF_VW,
                        (which == 0) ? WSP(bf16_t, WS_KSF) : (which == 1) ? WSP(bf16_t, WS_VSF) : (which == 2) ? WSP(bf16_t, WS_KWF) : WSP(bf16_t, WS_VWF), (which & 1) != 0);
      }
      for (int q = 0; q < 2; ++q) d_convmix(it * 8 + q * 4 + (tt >> 7), tt & 127, WSP(bf16_t, WS_PROJ), p.conv_w, p.hng, WSP(bf16_t, WS_MIX));
    }
  }
  xcd_barrier(xbar);
  {
    AttnPtrs ap{WSP(bf16_t, WS_PROJ), WSP(float, WS_GATES), WSP(bf16_t, WS_KCF), WSP(bf16_t, WS_VCF), WSP(bf16_t, WS_KSF), WSP(bf16_t, WS_VSF), WSP(bf16_t, WS_KWF), WSP(bf16_t, WS_VWF), WSP(bf16_t, WS_MIX), p.hng};
    for (int it = blockIdx.x; it < 512; it += gridDim.x) {
      const int Bq = (it < 256) ? it : (511 - it), gq = (it < 256) ? 0 : 1;
      d_attn_block(Bq, gq, smem, ap);
    }
  }
  xcd_barrier(xbar);
  {
    pg8::StaticOrder so; so.init(S, DM, gridDim.x, blockIdx.x);
    pg8::gemm_phase<EpiResG, pg8::StaticOrder>((PG8_LAS unsigned char*)smem, pg8::Gemm{WSP(bf16_t, WS_MIX), WSP(bf16_t, WS_WOUTT), S, DM, DM}, so,
                                               EpiResG{WSP(bf16_t, WS_HB)}, nullptr);
  }
  xcd_barrier(xbar);
  for (int r = blockIdx.x * NWV + wv; r < S; r += gridDim.x * NWV) d_ln_wave(r, WSP(bf16_t, WS_HB), p.ln1g, p.ln1b);
  {
    const int e0_ = (((S / 256) * (INWG / 256)) % (int)gridDim.x != 0) ? EXP_EARLY : 0;
    const int nrest = 16384 - e0_;
    for (int r = blockIdx.x * NWV + wv; r < 2 * nrest; r += gridDim.x * NWV) {
      if (r < nrest) d_cvt_fp4_row(e0_ + r, p.eu, WSP(unsigned char, WS_EU8)); else d_cvt_fp4_row(e0_ + r - nrest, p.ev, WSP(unsigned char, WS_EV8));
    }
  }
  xcd_barrier(xbar);
  for (int k = 0; k * (int)gridDim.x < (S / 256) * (DM / 256); ++k) {
    pg8::OneUnit so; so.init(S, DM, gridDim.x, blockIdx.x); so.k = k;
    pg8::gemm_phase<EpiRouteG, pg8::OneUnit>((PG8_LAS unsigned char*)smem, pg8::Gemm{WSP(bf16_t, WS_HB), WSP(bf16_t, WS_WQT), S, DM, DM}, so,
                                             EpiRouteG{WSP(bf16_t, WS_SKF), WSP(unsigned, WS_TOPS)}, nullptr);
    __syncthreads();
  }
  xcd_barrier(xbar);
  for (int t = blockIdx.x * NWV + wv; t < S; t += gridDim.x * NWV) d_expert_wave(t, (unsigned*)(smem + wv * 1024), WSP(bf16_t, WS_HB), WSP(unsigned, WS_TOPS), WSP(unsigned char, WS_EU8), WSP(unsigned char, WS_EV8), p.ln2g, p.ln2b, p.out);
}

extern "C" void kernel_launch(void* const* d_in, const int* in_sizes, int n_in, void* d_out, int out_size, void* d_ws, size_t ws_size,
                              hipStream_t stream) {
  Params p{};
  p.x = (const float*)d_in[0]; p.w_in = (const float*)d_in[1]; p.ck_pos = (const float*)d_in[2]; p.ck_w1 = (const float*)d_in[3];
  p.ck_b1 = (const float*)d_in[4]; p.ck_w2 = (const float*)d_in[5]; p.cv_pos = (const float*)d_in[6]; p.cv_w1 = (const float*)d_in[7];
  p.cv_b1 = (const float*)d_in[8]; p.cv_w2 = (const float*)d_in[9]; p.conv_w = (const float*)d_in[10]; p.hng = (const float*)d_in[11];
  p.w_out = (const float*)d_in[12]; p.ln1g = (const float*)d_in[13]; p.ln1b = (const float*)d_in[14]; p.w_query = (const float*)d_in[15];
  p.subk = (const float*)d_in[16]; p.eu = (const float*)d_in[17]; p.ev = (const float*)d_in[18]; p.ln2g = (const float*)d_in[19];
  p.ln2b = (const float*)d_in[20];
  p.out = (float*)d_out;
  p.ws = (char*)d_ws;
  if (ws_size < WS_END) fprintf(stderr, "workspace too small\n");
  static int grid_blocks = 0;
  if (!grid_blocks) {
    int dev = 0, cus = 0, per_cu = 0;
    hipGetDevice(&dev);
    hipDeviceGetAttribute(&cus, hipDeviceAttributeMultiprocessorCount, dev);
    hipOccupancyMaxActiveBlocksPerMultiprocessor(&per_cu, mega, 512, 0);
    if (per_cu > 1) per_cu = 1;
    if (per_cu < 1) per_cu = 1;
    grid_blocks = cus * per_cu;
  }
  hipMemsetAsync((char*)d_ws + WS_CTRL, 0, CTRL_BYTES, stream);
  void* args[] = {&p};
  hipError_t e = hipLaunchCooperativeKernel((void*)mega, dim3(grid_blocks), dim3(512), args, 0, stream);
  if (e != hipSuccess) fprintf(stderr, "cooperative launch failed: %s (grid %d)\n", hipGetErrorString(e), grid_blocks);
}
```

```cpp
#include <hip/hip_runtime.h>
#include <stdint.h>
#include <stdio.h>


#define DI __device__ __forceinline__
static __device__ __forceinline__ int tidx_() { int t = (int)__builtin_amdgcn_workitem_id_x(); asm volatile("" : "+v"(t)); return t; }
#define TIDX (tidx_())

template <int J> DI int swz_xor(int x) { return __builtin_amdgcn_ds_swizzle(x, (J << 10) | 0x1F); }
template <int CTRL> DI int dpp_i(int x) { return __builtin_amdgcn_update_dpp(x, x, CTRL, 0xF, 0xF, false); }
DI int shx_i(int x, int j) {
  switch (j) {
    case 1: return dpp_i<0xB1>(x);
    case 2: return dpp_i<0x4E>(x);
    case 4: return dpp_i<0x1B>(dpp_i<0x141>(x));
    case 8: return dpp_i<0x128>(x);
    case 16: return swz_xor<16>(x);
    default: {
      auto r = __builtin_amdgcn_permlane32_swap((unsigned)x, (unsigned)x, false, false);
      return (TIDX & 32) ? (int)r[0] : (int)r[1];
    }
  }
}
DI float shx(float x, int j) { return __int_as_float(shx_i(__float_as_int(x), j)); }
typedef unsigned short bf16_t;
using bf16x8 = __attribute__((ext_vector_type(8))) short;
using f32x4 = __attribute__((ext_vector_type(4))) float;
using u32x4 = __attribute__((ext_vector_type(4))) unsigned;
using u32x2 = __attribute__((ext_vector_type(2))) unsigned;

constexpr int S = 16384, DM = 2048, HD = 128;
constexpr int INW = 5656, INWP = 5760, INWG = 5888;
constexpr int OFF_Q = 0, OFF_KC = 1024, OFF_VC = 1280, OFF_KS = 1536, OFF_VS = 1792, OFF_KW = 2048, OFF_VW = 2304,
              OFF_G = 2560, OFF_U = 2584, OFF_B = 3608, OFF_C = 4632;
constexpr int NCMP = 1023;
constexpr float ALPHA = 1.189207115002721f;
constexpr float QSCALE = 0.08838834764831845f;

DI bf16_t f2bf(float x) { unsigned u = __float_as_uint(x); u += 0x7fffu + ((u >> 16) & 1u); return (bf16_t)(u >> 16); }
DI float bf2f(bf16_t b) { return __uint_as_float(((unsigned)b) << 16); }
DI float gelu_tanh(float x) { float u = 0.7978845608028654f * (x + 0.044715f * x * x * x); return 0.5f * x * (1.f + tanhf(u)); }
DI float wave_sum(float v) { for (int o = 32; o > 0; o >>= 1) v += shx(v, o); return v; }
using bf16x2v = __attribute__((ext_vector_type(2))) __bf16;
DI unsigned pack2(float a, float b) { bf16x2v v = {(__bf16)a, (__bf16)b}; return __builtin_bit_cast(unsigned, v); }
DI float wave_max(float v) { for (int o = 32; o > 0; o >>= 1) v = fmaxf(v, shx(v, o)); return v; }

namespace pg8 {
#define PG8_LAS __attribute__((address_space(3)))
typedef unsigned short bf16_t;
typedef short bf16x8 __attribute__((ext_vector_type(8)));
typedef float f32x4 __attribute__((ext_vector_type(4)));
typedef unsigned u32x4 __attribute__((ext_vector_type(4)));
constexpr int BM = 256, BK = 64, HALF = 128, HTB = HALF * BK * 2  , STAGE_BYTES = 8 * HTB, NXCD = 8, WGM = 8;

__host__ __device__ __forceinline__ int lds_byte(int r, int c) { const int st = (r >> 4) * 2 + (c >> 5), rr = r & 15, cc = c & 31, ob = rr * 64 + cc * 2; return st * 1024 + (ob ^ (((ob >> 9) & 1) << 5)); }
__host__ __device__ __forceinline__ void stage_rc(int b, int& R, int& C) { const int st = b / 1024, sb = b % 1024, swz = sb ^ (((sb >> 9) & 1) << 5); R = (st >> 1) * 16 + swz / 64; C = (st & 1) * 32 + (swz % 64) / 2; }
__host__ __device__ __forceinline__ int perm32(int rho) { const int n = rho >> 4, i = rho & 15; return 8 * (i >> 2) + 4 * n + (i & 3); }

struct Unit { int pm, pn; };
struct Gemm { const bf16_t* A; const bf16_t* Bt; int M, N, K; };

struct StaticOrder {
    int nM, nN, nwg, G, c;
    __host__ __device__ void init(int M, int N, int G_, int c_) { nM = M / BM; nN = N / BM; nwg = nM * nN; G = G_; c = c_; }
    __host__ __device__ bool next(int i, Unit& u) const {
        const long L = (long)i * G + c; if (L >= nwg) return false;
        int wgid = (int)L; { const int q = nwg / NXCD, r = nwg % NXCD, xcd = wgid % NXCD, off = wgid / NXCD; wgid = (xcd < r ? xcd * (q + 1) : r * (q + 1) + (xcd - r) * q) + off; }
        const int nig = WGM * nN, gid = wgid / nig, fm = gid * WGM, gsz = (nM - fm) < WGM ? (nM - fm) : WGM;
        u.pm = fm + ((wgid % nig) % gsz); u.pn = (wgid % nig) / gsz; return true;
    }
    __device__ __forceinline__ void a_ready(const Unit&) const {}
    __device__ __forceinline__ void done(const Unit&) const {}
};
struct OneUnit : StaticOrder {
    int k;
    __device__ bool next(int i, Unit& u) const { if (i > 0) return false; return StaticOrder::next(k, u); }
};
__device__ __forceinline__ unsigned cvt_pk_bf16(float lo, float hi) { unsigned r; asm volatile("v_cvt_pk_bf16_f32 %0, %1, %2" : "=v"(r) : "v"(lo), "v"(hi)); return r; }
template <class Epi, class Sched, bool STAMP = false>
__device__ __forceinline__ void gemm_phase(PG8_LAS unsigned char* lds, const Gemm g, const Sched& S, const Epi& E, unsigned long long* stamps) {
    const int tid = TIDX, wid = __builtin_amdgcn_readfirstlane(tid >> 6), lane = tid & 63, wr = wid >> 2, wc = wid & 3, fr = lane & 15, fq = lane >> 4;
    const int K = g.K, nt = K / BK;
    int ts_lo = 0, ts_hi = 0, nts = 0; const unsigned long long rt_entry = STAMP ? (unsigned long long)wall_clock64() : 0ull;
#define PG8_STAMP() do { if (STAMP && wid == 0 && nts < 64) { const unsigned long long _c = (unsigned long long)clock64(); \
        ts_lo = (lane == nts) ? (int)(unsigned)_c : ts_lo; ts_hi = (lane == nts) ? (int)(unsigned)(_c >> 32) : ts_hi; ++nts; } } while (0)
    PG8_STAMP();
    unsigned voffA[2], voffB[2];
#pragma unroll
    for (int i = 0; i < 2; ++i) { int R, C; stage_rc(tid * 16 + i * 8192, R, C); const int Rb = Epi::PERM ? ((R & ~31) + perm32(R & 31)) : R;
        voffA[i] = (unsigned)(R * K + C) * 2u; voffB[i] = (unsigned)(Rb * K + C) * 2u; }
    const size_t kstep = (size_t)(BK * 2);
    const size_t hstep = (size_t)HALF * K * 2;
    const size_t tstep = 2 * hstep;
    const unsigned ldsw = (unsigned)wid * 1024u;
    const int aoff = lds_byte(wr * 64 + fr, fq * 8), boff = lds_byte(wc * 32 + fr, fq * 8);
#define PG8_SA(b, h) (((b) * 2 + (h)) * HTB)
#define PG8_SB(b, h) ((4 + (b) * 2 + (h)) * HTB)
#define PG8_STAGE(bufoff, gbase, voff) do { _Pragma("unroll") for (int _i = 0; _i < 2; ++_i) \
        __builtin_amdgcn_global_load_lds((const unsigned*)((const char*)(gbase) + (voff)[_i]), (PG8_LAS unsigned*)(lds + (bufoff) + ldsw + _i * 8192), 16, 0, 0); } while (0)
#define PG8_LDA(dst, b, h) do { _Pragma("unroll") for (int m = 0; m < 4; ++m) _Pragma("unroll") for (int k = 0; k < 2; ++k) dst[m][k] = *(const PG8_LAS bf16x8*)(lds + PG8_SA(b, h) + aoff + m * 2048 + k * 1024); } while (0)
#define PG8_LDB(dst, b, h) do { _Pragma("unroll") for (int n = 0; n < 2; ++n) _Pragma("unroll") for (int k = 0; k < 2; ++k) dst[n][k] = *(const PG8_LAS bf16x8*)(lds + PG8_SB(b, h) + boff + n * 2048 + k * 1024); } while (0)
#define PG8_MMA(ai, bj, At, Bt) do { __builtin_amdgcn_s_setprio(1); _Pragma("unroll") for (int m = 0; m < 4; ++m) _Pragma("unroll") for (int n = 0; n < 2; ++n) _Pragma("unroll") for (int k = 0; k < 2; ++k) \
        acc[ai][bj][m][n] = __builtin_amdgcn_mfma_f32_16x16x32_bf16(Bt[n][k], At[m][k], acc[ai][bj][m][n], 0, 0, 0); __builtin_amdgcn_s_setprio(0); } while (0)
#define PG8_WAIT_V(n) asm volatile("s_waitcnt vmcnt(" #n ")" ::: "memory")
#define PG8_WAIT_L(n) asm volatile("s_waitcnt lgkmcnt(" #n ")" ::: "memory")
#define PG8_BAR __builtin_amdgcn_s_barrier()
#define PG8_SCHED __builtin_amdgcn_sched_barrier(0)
    Unit cur, nxt; int ui = 0;
    if (!S.next(0, cur)) return;
    f32x4 acc[2][2][4][2];
#pragma unroll
    for (int a = 0; a < 2; ++a)
#pragma unroll
        for (int b = 0; b < 2; ++b)
#pragma unroll
            for (int m = 0; m < 4; ++m)
#pragma unroll
                for (int n = 0; n < 2; ++n) acc[a][b][m][n] = (f32x4){0.f, 0.f, 0.f, 0.f};
    bf16x8 At[4][2], B0[2][2], B1[2][2];
    const char* cA = (const char*)g.A + (size_t)cur.pm * tstep; const char* cB = (const char*)g.Bt + (size_t)cur.pn * tstep;
    S.a_ready(cur);
    PG8_STAGE(PG8_SB(0, 0), cB, voffB); PG8_STAGE(PG8_SA(0, 0), cA, voffA); PG8_STAGE(PG8_SB(0, 1), cB + hstep, voffB); PG8_STAGE(PG8_SA(0, 1), cA + hstep, voffA);
    if (wr == 1) PG8_BAR;
    PG8_WAIT_V(4); PG8_BAR;
    PG8_STAGE(PG8_SB(1, 0), cB + kstep, voffB); PG8_STAGE(PG8_SA(1, 0), cA + kstep, voffA); PG8_STAGE(PG8_SB(1, 1), cB + hstep + kstep, voffB);
    PG8_WAIT_V(6); PG8_BAR;
    PG8_STAMP();
    for (;;) {
        const bool has_next = S.next(ui + 1, nxt);
        const char* nA = has_next ? (const char*)g.A + (size_t)nxt.pm * tstep : cA; const char* nB = has_next ? (const char*)g.Bt + (size_t)nxt.pn * tstep : cB;
        for (int t = 0; t < nt; t += 2) {
            const bool last = (t == nt - 2);
            const char* a1 = cA + (size_t)(t + 1) * kstep;
            const char* a2 = last ? nA : cA + (size_t)(t + 2) * kstep; const char* b2 = last ? nB : cB + (size_t)(t + 2) * kstep;
            const char* a3 = a2 + kstep; const char* b3 = b2 + kstep;
            if (last && has_next) S.a_ready(nxt);
            PG8_LDB(B0, 0, 0); PG8_SCHED; PG8_LDA(At, 0, 0); PG8_STAGE(PG8_SA(1, 1), a1 + hstep, voffA);
            PG8_WAIT_L(8); PG8_BAR; PG8_WAIT_L(0); PG8_MMA(0, 0, At, B0); PG8_BAR; PG8_SCHED;
            PG8_LDB(B1, 0, 1); PG8_STAGE(PG8_SB(0, 0), b2, voffB);
            PG8_BAR; PG8_WAIT_L(0); PG8_MMA(0, 1, At, B1); PG8_BAR;
            PG8_LDA(At, 0, 1); PG8_STAGE(PG8_SA(0, 0), a2, voffA);
            PG8_BAR; PG8_WAIT_L(0); PG8_MMA(1, 0, At, B0); PG8_BAR; PG8_SCHED;
            PG8_STAGE(PG8_SB(0, 1), b2 + hstep, voffB);
            PG8_WAIT_V(6); PG8_BAR; PG8_MMA(1, 1, At, B1); PG8_BAR;
            PG8_LDB(B0, 1, 0); PG8_SCHED; PG8_LDA(At, 1, 0); PG8_STAGE(PG8_SA(0, 1), a2 + hstep, voffA);
            PG8_WAIT_L(8); PG8_BAR; PG8_WAIT_L(0); PG8_MMA(0, 0, At, B0); PG8_BAR; PG8_SCHED;
            PG8_LDB(B1, 1, 1); PG8_STAGE(PG8_SB(1, 0), b3, voffB);
            PG8_BAR; PG8_WAIT_L(0); PG8_MMA(0, 1, At, B1); PG8_BAR;
            PG8_LDA(At, 1, 1); PG8_STAGE(PG8_SA(1, 0), a3, voffA);
            PG8_BAR; PG8_WAIT_L(0); PG8_MMA(1, 0, At, B0); PG8_BAR; PG8_SCHED;
            PG8_STAGE(PG8_SB(1, 1), b3 + hstep, voffB);
            PG8_WAIT_V(6); PG8_BAR; PG8_MMA(1, 1, At, B1); PG8_BAR;
        }
        PG8_STAMP();
        if constexpr (!Epi::AFTER_DRAIN) { E(acc, cur, wr, wc, fr, fq); S.done(cur); }
        PG8_STAMP();
        if (!has_next) break;
#pragma unroll
        for (int a = 0; a < 2; ++a)
#pragma unroll
            for (int b = 0; b < 2; ++b)
#pragma unroll
                for (int m = 0; m < 4; ++m)
#pragma unroll
                    for (int n = 0; n < 2; ++n) acc[a][b][m][n] = (f32x4){0.f, 0.f, 0.f, 0.f};
        cur = nxt; cA = nA; cB = nB; ++ui;
    }
    PG8_WAIT_V(0);
    if (wr == 0) PG8_BAR;
    PG8_BAR;
    if constexpr (Epi::AFTER_DRAIN) { E.fused(acc, cur, wr, wc, fr, fq, lds, wid, lane); S.done(cur); }
    PG8_STAMP();
    if (STAMP && wid == 0) { stamps[lane] = lane < nts ? (((unsigned long long)(unsigned)ts_hi << 32) | (unsigned)ts_lo) : 0ull;
        if (lane == 62) stamps[62] = rt_entry; if (lane == 63) stamps[63] = (unsigned long long)wall_clock64(); }
#undef PG8_STAMP
#undef PG8_SA
#undef PG8_SB
#undef PG8_STAGE
#undef PG8_LDA
#undef PG8_LDB
#undef PG8_MMA
#undef PG8_WAIT_V
#undef PG8_WAIT_L
#undef PG8_BAR
#undef PG8_SCHED
}
}

#define XB_TMO      128
#define XB_XCNT(j)  (256  + 64 * (j))
#define XB_XSUB(j)  (1280 + 64 * (j))
#define XB_XGEN(j)  (2304 + 64 * (j))
#define XB_TOP      3328
#define XB_TOPGEN   3392
#define XCD_BAR_WORDS 3456
#define XB_SPIN_CAP (1u << 18)
#define LAS __attribute__((address_space(3)))

__device__ __forceinline__ unsigned xb_ld(unsigned* p)              { return __hip_atomic_load(p, __ATOMIC_RELAXED, __HIP_MEMORY_SCOPE_AGENT); }
__device__ __forceinline__ unsigned xb_add(unsigned* p, unsigned v) { return __hip_atomic_fetch_add(p, v, __ATOMIC_RELAXED, __HIP_MEMORY_SCOPE_AGENT); }
__device__ __forceinline__ unsigned xb_xcc_id() { return (unsigned)__builtin_amdgcn_s_getreg((3 << 11) | 20) & 0xFu; }
#define XB_SPIN(cond, bar) do { unsigned _sp = 0; while (cond) { __builtin_amdgcn_s_sleep(1); \
    if ((++_sp & 255u) == 0u) { if (xb_ld(&(bar)[XB_TMO])) break; if (_sp > XB_SPIN_CAP) { atomicAdd(&(bar)[XB_TMO], 1u); break; } } } } while (0)

struct XcdBarrier {
    unsigned* bar; unsigned x;
    volatile LAS unsigned* st;
};

__device__ __forceinline__ XcdBarrier xcd_barrier_post(unsigned* bar, volatile LAS unsigned* st) {
    XcdBarrier b; b.bar = bar; b.x = xb_xcc_id(); b.st = st;
    if (TIDX == 0) (void)xb_add(&bar[XB_XCNT(b.x)], 1u);
    return b;
}
__device__ __forceinline__ void xcd_barrier_complete(unsigned* bar, unsigned x, unsigned& nloc, unsigned& nx) {
    const unsigned G = gridDim.x * gridDim.y * gridDim.z;
    unsigned sum, cnt, mine, sp = 0u;
    for (;;) {
        sum = 0u; cnt = 0u; mine = 0u;
#pragma unroll
        for (unsigned j = 0; j < 16; ++j) { const unsigned c = xb_ld(&bar[XB_XCNT(j)]); sum += c; cnt += (c > 0u) ? 1u : 0u; mine = (j == x) ? c : mine; }
        if (sum == G) break;
        __builtin_amdgcn_s_sleep(1);
        if ((++sp & 255u) == 0u) { if (xb_ld(&bar[XB_TMO])) break; if (sp > XB_SPIN_CAP) { atomicAdd(&bar[XB_TMO], 1u); break; } }
    }
    nloc = mine > 0u ? mine : 1u; nx = cnt > 0u ? cnt : 1u;
}

__device__ __forceinline__ void xcd_barrier(const XcdBarrier& b) {
    asm volatile("s_waitcnt vmcnt(0)" ::: "memory");
    __syncthreads();
    if (TIDX == 0) {
        unsigned* bar = b.bar;
        __builtin_amdgcn_s_waitcnt(0);
        unsigned nloc = b.st[0], nx = b.st[1];
        if (nloc == 0u) { xcd_barrier_complete(bar, b.x, nloc, nx); b.st[0] = nloc; b.st[1] = nx; }
        const unsigned old = xb_add(&bar[XB_XSUB(b.x)], 1u);
        const unsigned gen = old / nloc;
        if (old + 1u == (gen + 1u) * nloc) {
            __builtin_amdgcn_fence(__ATOMIC_RELEASE, "agent");
            asm volatile("s_waitcnt vmcnt(0)" ::: "memory");
            const unsigned og = xb_add(&bar[XB_TOP], 1u);
            const unsigned tg = og / nx;
            if (og + 1u == (tg + 1u) * nx) xb_add(&bar[XB_TOPGEN], 1u);
            else XB_SPIN(xb_ld(&bar[XB_TOPGEN]) == tg, bar);
            __builtin_amdgcn_fence(__ATOMIC_ACQUIRE, "agent");
            xb_add(&bar[XB_XGEN(b.x)], 1u);
            asm volatile("s_waitcnt vmcnt(0)" ::: "memory");
        } else {
            XB_SPIN(xb_ld(&bar[XB_XGEN(b.x)]) == gen, bar);
            __builtin_amdgcn_fence(__ATOMIC_ACQUIRE, "agent");
            asm volatile("s_waitcnt vmcnt(0)" ::: "memory");
        }
    }
    __syncthreads();
}

__device__ void d_cvt(const float* __restrict__ in, bf16_t* __restrict__ out, size_t n4) {
  const size_t stride = (size_t)gridDim.x * blockDim.x;
  size_t i = (size_t)blockIdx.x * blockDim.x + TIDX;
  for (; i + 3 * stride < n4; i += 4 * stride) {
    f32x4 v[4];
#pragma unroll
    for (int q = 0; q < 4; ++q) v[q] = ((const f32x4*)in)[i + q * stride];
#pragma unroll
    for (int q = 0; q < 4; ++q) { u32x2 o = {pack2(v[q][0], v[q][1]), pack2(v[q][2], v[q][3])}; ((u32x2*)out)[i + q * stride] = o; }
  }
  for (; i < n4; i += stride) { const f32x4 v = ((const f32x4*)in)[i]; u32x2 o = {pack2(v[0], v[1]), pack2(v[2], v[3])}; ((u32x2*)out)[i] = o; }
}
__device__ void d_cvtT64(int vb, char* smem, const float* __restrict__ W, bf16_t* __restrict__ WT, int K, int N, int NP) {
  float (*tt)[65] = (float (*)[65])smem;
  const int tid = (TIDX & 255);
  const int nbx = NP / 64;
  const int n0 = (vb % nbx) * 64, k0 = (vb / nbx) * 64;
  {
    const int kr = tid >> 4, nc = (tid & 15) * 4;
#pragma unroll
    for (int i = 0; i < 4; ++i) {
      const int k = k0 + kr + 16 * i, n = n0 + nc;
      f32x4 v = {0.f, 0.f, 0.f, 0.f};
      if (n < N) v = *(const f32x4*)(W + (size_t)k * N + n);
      tt[kr + 16 * i][nc] = v[0]; tt[kr + 16 * i][nc + 1] = v[1]; tt[kr + 16 * i][nc + 2] = v[2]; tt[kr + 16 * i][nc + 3] = v[3];
    }
  }
  __syncthreads();
  {
    const int nr = tid >> 3, kc = (tid & 7) * 8;
#pragma unroll
    for (int i = 0; i < 2; ++i) {
      const int nl = nr + 32 * i;
      u32x4 o = {pack2(tt[kc][nl], tt[kc + 1][nl]), pack2(tt[kc + 2][nl], tt[kc + 3][nl]), pack2(tt[kc + 4][nl], tt[kc + 5][nl]), pack2(tt[kc + 6][nl], tt[kc + 7][nl])};
      *(u32x4*)(WT + (size_t)(n0 + nl) * K + k0 + kc) = o;
    }
  }
  __syncthreads();
}

using f32x16 = __attribute__((ext_vector_type(16))) float;
using bf16x8v = __attribute__((ext_vector_type(8))) __bf16;
#define MFMA32(a, b, c) __builtin_amdgcn_mfma_f32_32x32x16_bf16((a), (b), (c), 0, 0, 0)
constexpr float LOG2E = 1.4426950408889634f;
constexpr float NEGB = -1e30f;
DI int pi_perm(int i) { return (i & ~12) | ((i & 8) >> 1) | ((i & 4) << 1); }
DI bf16x8 pack8(float a0, float a1, float a2, float a3, float a4, float a5, float a6, float a7) {
  bf16x8v v = {(__bf16)a0, (__bf16)a1, (__bf16)a2, (__bf16)a3, (__bf16)a4, (__bf16)a5, (__bf16)a6, (__bf16)a7};
  return __builtin_bit_cast(bf16x8, v);
}
__device__ __forceinline__ void d_relayout_tile(int T, char* smem, const bf16_t* __restrict__ proj, int col0, bf16_t* __restrict__ dst, bool isV) {
  bf16_t* Ls = (bf16_t*)smem;
  const int tid = TIDX;
#pragma unroll
  for (int q = 0; q < 2; ++q) {
    const int cidx = tid + q * 512;
    const int g = cidx >> 9, tok = (cidx >> 4) & 31, ch = cidx & 15;
    const u32x4 v = *(const u32x4*)(proj + (size_t)(32 * T + tok) * INWP + col0 + g * 128 + ch * 8);
    *(u32x4*)(Ls + (g * 32 + tok) * 136 + ch * 8) = v;
  }
  __syncthreads();
#pragma unroll
  for (int q = 0; q < 2; ++q) {
    const int oc = tid + q * 512;
    const int g = oc >> 9, r9 = oc & 511, lane = r9 & 63;
    u32x4 o;
    if (!isV) {
      const int s8 = r9 >> 6, i = lane & 31, h = lane >> 5;
      o = *(const u32x4*)(Ls + (g * 32 + pi_perm(i)) * 136 + 16 * s8 + 8 * h);
    } else {
      const int s2 = (r9 >> 6) & 1, dt = r9 >> 7, dd = lane & 31, h = lane >> 5;
      const bf16_t* col = Ls + (g * 32 + 16 * s2 + 8 * h) * 136 + 32 * dt + dd;
      unsigned short e[8];
#pragma unroll
      for (int j = 0; j < 8; ++j) e[j] = col[j * 136];
      o.x = e[0] | ((unsigned)e[1] << 16); o.y = e[2] | ((unsigned)e[3] << 16); o.z = e[4] | ((unsigned)e[5] << 16); o.w = e[6] | ((unsigned)e[7] << 16);
    }
    *(u32x4*)(dst + (((size_t)(g * 512 + T)) * 512 + r9) * 8) = o;
  }
  __syncthreads();
}

struct AttnPtrs {
  const bf16_t* proj; const float* gates;
  const bf16_t *kcf, *vcf, *ksf, *vsf, *kwf, *vwf;
  bf16_t* mix; const float* hng;
};

DI float ex2(float x) { return __builtin_amdgcn_exp2f(x); }
DI void halves(float x, float& lo, float& hi) {
  const unsigned u = __float_as_uint(x);
  auto r = __builtin_amdgcn_permlane32_swap(u, u, false, false);
  lo = __uint_as_float(r[0]); hi = __uint_as_float(r[1]);
}
DI float hmax(float x) { float a, b; halves(x, a, b); return fmaxf(a, b); }
DI float hsum(float x) { float a, b; halves(x, a, b); return a + b; }
DI float dpp_quad(float v, int ctrl_is_xor1) {
  const int iv = __float_as_int(v);
  const int r = ctrl_is_xor1 ? __builtin_amdgcn_update_dpp(iv, iv, 0xB1, 0xF, 0xF, false) : __builtin_amdgcn_update_dpp(iv, iv, 0x4E, 0xF, 0xF, false);
  return __int_as_float(r);
}
DI float quad_sum(float v) { v += dpp_quad(v, 1); v += dpp_quad(v, 0); return v; }
DI void osm_step(const float (&sv)[16], float& m, float& l, f32x16 (&O)[4], float (&p)[16]) {
  float tmax = fmaxf(fmaxf(fmaxf(sv[0], sv[1]), fmaxf(sv[2], sv[3])), fmaxf(fmaxf(sv[4], sv[5]), fmaxf(sv[6], sv[7])));
  tmax = fmaxf(tmax, fmaxf(fmaxf(fmaxf(sv[8], sv[9]), fmaxf(sv[10], sv[11])), fmaxf(fmaxf(sv[12], sv[13]), fmaxf(sv[14], sv[15]))));
  tmax = hmax(tmax);
  if (__ballot(tmax - m > 8.f)) {
    const float mn = fmaxf(m, tmax);
    const float alpha = ex2(m - mn);
    l *= alpha; m = mn;
#pragma unroll
    for (int dt = 0; dt < 4; ++dt)
#pragma unroll
      for (int r = 0; r < 16; ++r) O[dt][r] *= alpha;
  }
  float ps0 = 0.f, ps1 = 0.f;
#pragma unroll
  for (int r = 0; r < 16; r += 2) { const float e0 = ex2(sv[r] - m), e1 = ex2(sv[r + 1] - m); p[r] = e0; p[r + 1] = e1; ps0 += e0; ps1 += e1; }
  l += ps0 + ps1;
}
DI void ot_store(char* otL, int lane, const f32x16 (&O)[4], float sc) {
#pragma unroll
  for (int dt = 0; dt < 4; ++dt) {
    u32x4 a, b;
#pragma unroll
    for (int i = 0; i < 4; ++i) { a[i] = pack2(sc * O[dt][2 * i], sc * O[dt][2 * i + 1]); b[i] = pack2(sc * O[dt][8 + 2 * i], sc * O[dt][8 + 2 * i + 1]); }
    *(u32x4*)(otL + lane * 128 + dt * 32) = a;
    *(u32x4*)(otL + lane * 128 + dt * 32 + 16) = b;
  }
}
DI void ot_accum(const char* otL, int lane, f32x16 (&O)[4], float sc) {
#pragma unroll
  for (int dt = 0; dt < 4; ++dt) {
    u32x4 a = *(const u32x4*)(otL + lane * 128 + dt * 32);
    u32x4 b = *(const u32x4*)(otL + lane * 128 + dt * 32 + 16);
#pragma unroll
    for (int i = 0; i < 4; ++i) {
      const unsigned wa = a[i], wb = b[i];
      O[dt][2 * i] = fmaf(sc, O[dt][2 * i], __uint_as_float(wa << 16));
      O[dt][2 * i + 1] = fmaf(sc, O[dt][2 * i + 1], __uint_as_float(wa & 0xFFFF0000u));
      O[dt][8 + 2 * i] = fmaf(sc, O[dt][8 + 2 * i], __uint_as_float(wb << 16));
      O[dt][8 + 2 * i + 1] = fmaf(sc, O[dt][8 + 2 * i + 1], __uint_as_float(wb & 0xFFFF0000u));
    }
  }
}
DI void zero_o(f32x16 (&O)[4]) {
#pragma unroll
  for (int dt = 0; dt < 4; ++dt)
#pragma unroll
    for (int i = 0; i < 16; ++i) O[dt][i] = 0.f;
}

constexpr int ATT_PW = 8704;
constexpr int ATT_R = 4, ATT_D = 3;
constexpr int ATT_RING = 8 * ATT_PW;
constexpr int ATT_LIST = ATT_RING + ATT_R * 16384;
constexpr int ATT_BUNI = ATT_LIST + 2048;
constexpr int ATT_SMEM = ATT_BUNI + 64;
#define LAS3 __attribute__((address_space(3)))
__device__ __forceinline__ void d_select(const float* impL, unsigned* mskL, unsigned* uniL, int cur) {
  const int lane = TIDX & 63;
  const int stok = lane >> 3, sub = lane & 7;
  unsigned key[32];
#pragma unroll
  for (int i4 = 0; i4 < 8; ++i4) {
    f32x4 v = *(const f32x4*)(impL + stok * 256 + sub * 32 + i4 * 4);
#pragma unroll
    for (int e = 0; e < 4; ++e) {
      const int j = sub * 32 + i4 * 4 + e;
      const bool valid = j <= cur;
      const bool forced = (j == 0) || (j == cur) || (j == cur - 1);
      unsigned kb = forced ? 0xFFFFFF00u : (__float_as_uint(v[e]) & 0xFFFFFF00u);
      key[i4 * 4 + e] = valid ? (kb | (unsigned)(255 - j)) : 0u;
    }
  }
#pragma unroll
  for (int k = 2; k <= 32; k <<= 1) {
#pragma unroll
    for (int jj = k >> 1; jj > 0; jj >>= 1) {
#pragma unroll
      for (int i = 0; i < 32; ++i) {
        const int l2 = i ^ jj;
        if (l2 > i) {
          const bool desc = ((i & k) == 0);
          unsigned a = key[i], b = key[l2];
          unsigned mx = a > b ? a : b, mn = a > b ? b : a;
          key[i] = desc ? mx : mn; key[l2] = desc ? mn : mx;
        }
      }
    }
  }
#pragma unroll
  for (int xm = 1; xm < 8; xm <<= 1) {
    unsigned L[16];
#pragma unroll
    for (int i = 0; i < 16; ++i) { unsigned o = (unsigned)shx_i((int)key[15 - i], xm); L[i] = key[i] > o ? key[i] : o; }
#pragma unroll
    for (int jj = 8; jj > 0; jj >>= 1) {
#pragma unroll
      for (int i = 0; i < 16; ++i) {
        const int l2 = i ^ jj;
        if (l2 > i) { unsigned a = L[i], b = L[l2]; L[i] = a > b ? a : b; L[l2] = a > b ? b : a; }
      }
    }
#pragma unroll
    for (int i = 0; i < 16; ++i) key[i] = L[i];
  }
#pragma unroll
  for (int i = 0; i < 16; ++i) {
    if ((i & 7) == sub) {
      const int j = 255 - (int)(key[i] & 255u);
      if (j <= cur) { atomicOr(&mskL[stok * 8 + (j >> 5)], 1u << (j & 31)); atomicOr(&uniL[j >> 5], 1u << (j & 31)); }
    }
  }
}


DI void att_issue(LAS3 unsigned char* ring, int slot, int w, int lane, const bf16_t* kb, const bf16_t* vb, int tile) {
  const char* ks = (const char*)kb + (size_t)tile * 8192 + w * 1024 + lane * 16;
  const char* vs = (const char*)vb + (size_t)tile * 8192 + w * 1024 + lane * 16;
  __builtin_amdgcn_global_load_lds((const unsigned*)ks, (LAS3 unsigned*)(ring + slot * 16384 + w * 1024), 16, 0, 0);
  __builtin_amdgcn_global_load_lds((const unsigned*)vs, (LAS3 unsigned*)(ring + slot * 16384 + 8192 + w * 1024), 16, 0, 0);
}
DI f32x16 qk_lds(LAS3 const unsigned char* kt, const bf16x8 (&qf)[8], int lane) {
  f32x16 acc;
#pragma unroll
  for (int i = 0; i < 16; ++i) acc[i] = 0.f;
#pragma unroll
  for (int s8 = 0; s8 < 8; ++s8) {
    const bf16x8 kf = *(LAS3 const bf16x8*)(kt + s8 * 1024 + lane * 16);
    acc = MFMA32(kf, qf[s8], acc);
  }
  return acc;
}
DI void pv_lds(LAS3 const unsigned char* vt, const float (&p)[16], f32x16 (&O)[4], int lane) {
  const bf16x8 pf0 = pack8(p[0], p[1], p[2], p[3], p[4], p[5], p[6], p[7]);
  const bf16x8 pf1 = pack8(p[8], p[9], p[10], p[11], p[12], p[13], p[14], p[15]);
#pragma unroll
  for (int dt = 0; dt < 4; ++dt) {
    const bf16x8 v0 = *(LAS3 const bf16x8*)(vt + (dt * 2) * 1024 + lane * 16);
    const bf16x8 v1 = *(LAS3 const bf16x8*)(vt + (dt * 2 + 1) * 1024 + lane * 16);
    O[dt] = MFMA32(v0, pf0, O[dt]);
    O[dt] = MFMA32(v1, pf1, O[dt]);
  }
}

__device__ __forceinline__ void d_attn_block(int B, int g, char* smem, const AttnPtrs& P) {
  const int tid = TIDX, lane = tid & 63, w = tid >> 6;
  const int c = lane & 31, h = lane >> 5, tokl = c >> 2, r = c & 3;
  const int tok0 = 64 * B + 8 * w;
  const int t = tok0 + tokl, hd = g * 4 + r;
  const float slope2 = exp2f(-(float)(hd + 1)) * LOG2E;
  const float c1 = QSCALE * LOG2E;
  const float ninf = -__builtin_inff();
  char* wsm = smem + w * ATT_PW;
  float* impL = (float*)wsm;
  char* otL = wsm;
  unsigned* mskL = (unsigned*)(wsm + 8192);
  unsigned* uniL = mskL + 64;
  LAS3 unsigned char* ring = (LAS3 unsigned char*)(smem + ATT_RING);
  unsigned short* tl = (unsigned short*)(smem + ATT_LIST);
  unsigned* buni = (unsigned*)(smem + ATT_BUNI);
  const bf16_t* kcf = P.kcf + (size_t)g * 32 * 4096;
  const bf16_t* vcf = P.vcf + (size_t)g * 32 * 4096;
  const bf16_t* ksf = P.ksf + (size_t)g * 512 * 4096;
  const bf16_t* vsf = P.vsf + (size_t)g * 512 * 4096;
  const bf16_t* kwf = P.kwf + (size_t)g * 512 * 4096;
  const bf16_t* vwf = P.vwf + (size_t)g * 512 * 4096;
  bf16x8 qf[8];
  {
    const bf16_t* qrow = P.proj + (size_t)t * INWP + OFF_Q + hd * 128 + 8 * h;
#pragma unroll
    for (int s8 = 0; s8 < 8; ++s8) qf[s8] = *(const bf16x8*)(qrow + 16 * s8);
  }
  const float* gt = P.gates + (size_t)t * 24 + hd * 3;
  const float g0 = gt[0], g1 = gt[1], g2 = gt[2];
  {
    unsigned z0 = 0u;
    asm volatile("" : "+v"(z0));
    u32x4 z = {z0, z0, z0, z0};
#pragma unroll
    for (int i = 0; i < 8; ++i) *(u32x4*)(wsm + (i * 64 + lane) * 16) = z;
    if (lane < 18) *(u32x4*)(wsm + 8192 + lane * 16) = z;
    if (tid < 8) buni[tid] = z0;
  }
  f32x16 Ob[4];
  zero_o(Ob);
  const int nmax = (t >= 31) ? ((t - 31) >> 4) : -1;
  const int nmaxw = (tok0 + 7 >= 31) ? ((tok0 + 7 - 31) >> 4) : -1;
  const int nminw = (tok0 >= 31) ? ((tok0 - 31) >> 4) : -1;
  const int ntcw = (nmaxw + 32) >> 5;
  const int ntcB = (((64 * B + 63 - 31) >> 4) + 32) >> 5;
  const float sl16 = slope2 * 16.f;
  float mC = NEGB, lC = 0.f, invC = 0.f, carry = 0.f;
  {
    const int n = 2 * ntcB;
    asm volatile("s_waitcnt vmcnt(0)" ::: "memory");
#define A_TILE(i_) (((i_) < ntcB) ? (ntcB - 1 - (i_)) : ((i_) - ntcB))
    att_issue(ring, 0, w, lane, kcf, vcf, A_TILE(0));
    if (n > 1) att_issue(ring, 1, w, lane, kcf, vcf, A_TILE(1));
#pragma unroll 1
    for (int i = 0; i < n; ++i) {
      if ((i & 1) == 0) {
        asm volatile("s_waitcnt vmcnt(0)" ::: "memory");
        __builtin_amdgcn_s_barrier();
        asm volatile("" ::: "memory");
        if (i + 2 < n) att_issue(ring, (i + 2) & 3, w, lane, kcf, vcf, A_TILE(i + 2));
        if (i + 3 < n) att_issue(ring, (i + 3) & 3, w, lane, kcf, vcf, A_TILE(i + 3));
      }
      const int T = A_TILE(i);
      if (T >= ntcw) continue;
      LAS3 const unsigned char* slot = ring + (i % ATT_R) * 16384;
      const f32x16 acc = qk_lds(slot, qf, lane);
      const float base = slope2 * (float)(512 * T + 128 * h) + slope2 * (15.5f - (float)t);
      const int nb = 32 * T + 8 * h;
      const bool full = (32 * T + 31 <= nminw);
      float sv[16];
#pragma unroll
      for (int rg = 0; rg < 16; ++rg) { const int kk = (rg & 7) + 16 * (rg >> 3); sv[rg] = fmaf(acc[rg], c1, fmaf(sl16, (float)kk, base)); }
      if (!full) {
#pragma unroll
        for (int rg = 0; rg < 16; ++rg) { const int kk = (rg & 7) + 16 * (rg >> 3); sv[rg] = (nb + kk <= nmax) ? sv[rg] : ninf; }
      }
      if (i < ntcB) {
        float tmax = fmaxf(fmaxf(fmaxf(sv[0], sv[1]), fmaxf(sv[2], sv[3])), fmaxf(fmaxf(sv[4], sv[5]), fmaxf(sv[6], sv[7])));
        tmax = fmaxf(tmax, fmaxf(fmaxf(fmaxf(sv[8], sv[9]), fmaxf(sv[10], sv[11])), fmaxf(fmaxf(sv[12], sv[13]), fmaxf(sv[14], sv[15]))));
        tmax = hmax(tmax);
        const float mn = fmaxf(mC, tmax);
        float ps = 0.f;
#pragma unroll
        for (int rg = 0; rg < 16; ++rg) ps += ex2(sv[rg] - mn);
        lC = lC * ex2(mC - mn) + ps; mC = mn;
      } else {
        if (T == 0) { lC = hsum(lC); invC = (lC > 0.f) ? 1.f / lC : 0.f; }
        float p[16];
#pragma unroll
        for (int rg = 0; rg < 16; ++rg) p[rg] = ex2(sv[rg] - mC) * invC;
        float Ga = (p[0] + p[1]) + (p[2] + p[3]), Gb = (p[4] + p[5]) + (p[6] + p[7]);
        float Gc = (p[8] + p[9]) + (p[10] + p[11]), Gd = (p[12] + p[13]) + (p[14] + p[15]);
        float xb, xd; { float a_, b_; halves(p[7], a_, b_); xb = h ? a_ : b_; halves(p[15], a_, b_); xd = h ? a_ : b_; }
        float ia = Ga + (h ? xb : carry);
        float ib = Gb + p[3];
        float ic = Gc + (h ? xd : xb);
        float id = Gd + p[11];
        carry = xd;
        ia = quad_sum(ia); ib = quad_sum(ib); ic = quad_sum(ic); id = quad_sum(id);
        {
          float val = (r == 0) ? ia : (r == 1) ? ib : (r == 2) ? ic : id;
          int j = 8 * T + 2 * h + ((r == 0) ? 0 : (r == 1) ? 1 : (r == 2) ? 4 : 5);
          impL[tokl * 256 + j] = val;
        }
        pv_lds(slot + 8192, p, Ob, lane);
      }
    }
#undef A_TILE
  }
  const int cur = B;
  d_select(impL, mskL, uniL, cur);
  ot_store(otL, lane, Ob, g0);
  zero_o(Ob);
  if (lane < 8) { const unsigned u = uniL[lane]; if (u) atomicOr(&buni[lane], u); }
  __syncthreads();
  int nslc = 0, ntl = 0;
  {
    for (int iw = 7; iw >= 0; --iw) {
      unsigned iuw = __builtin_amdgcn_readfirstlane(buni[iw]);
      while (iuw) {
        const int bit = 31 - __builtin_clz(iuw);
        iuw &= ~(1u << bit);
        const int bb = 32 * iw + bit;
        if (bb < B) { if (lane == 0) tl[ntl] = (unsigned short)(2 * bb + 1); ++ntl; }
        else { if (lane == 0) tl[ntl] = (unsigned short)(2 * bb + 1); ++ntl; }
        if (lane == 0) tl[ntl] = (unsigned short)(2 * bb);
        ++ntl;
      }
    }
    nslc = ntl;
    const int ThiB = 2 * B + 1, TloB = ((64 * B - 511 > 0) ? (64 * B - 511) : 0) >> 5;
    for (int T = ThiB; T >= TloB; --T) { if (lane == 0) tl[ntl] = (unsigned short)T; ++ntl; }
  }
  float m = NEGB, l = 0.f;
  {
    const int n = ntl;
    const int Tlow = ((tok0 - 511 > 0) ? (tok0 - 511) : 0) >> 5, Thiw = (tok0 + 7) >> 5;
#define B_ISSUE(j_, slot_) { const int e_ = __builtin_amdgcn_readfirstlane((int)tl[j_]); if ((j_) < nslc) att_issue(ring, slot_, w, lane, ksf, vsf, e_); else att_issue(ring, slot_, w, lane, kwf, vwf, e_); }
    B_ISSUE(0, 0)
    if (n > 1) B_ISSUE(1, 1)
#pragma unroll 1
    for (int i = 0; i < n; ++i) {
      if ((i & 1) == 0) {
        asm volatile("s_waitcnt vmcnt(0)" ::: "memory");
        __builtin_amdgcn_s_barrier();
        asm volatile("" ::: "memory");
        if (i + 2 < n) B_ISSUE(i + 2, (i + 2) & 3)
        if (i + 3 < n) B_ISSUE(i + 3, (i + 3) & 3)
      }
      if (i == nslc) {
        l = hsum(l);
        const float inv = (l > 0.f) ? g1 / l : 0.f;
        ot_accum(otL, lane, Ob, inv);
        ot_store(otL, lane, Ob, 1.f);
        zero_o(Ob);
        m = NEGB; l = 0.f;
      }
      const int T = __builtin_amdgcn_readfirstlane((int)tl[i]);
      const int pos0 = 32 * T, pb = pos0 + 8 * h;
      bool full; bool mine = true;
      if (i < nslc) {
        const int bb = T >> 1;
        const unsigned uw = __builtin_amdgcn_readfirstlane(uniL[bb >> 5]);
        if (!((uw >> (bb & 31)) & 1u) || pos0 > tok0 + 7) continue;
        mine = (mskL[tokl * 8 + (bb >> 5)] >> (bb & 31)) & 1u;
        full = (pos0 + 31 <= tok0) && (__ballot(!mine) == 0ull);
      } else {
        if (T < Tlow || T > Thiw) continue;
        full = (pos0 + 31 <= tok0) && (pos0 >= tok0 + 7 - 511);
      }
      LAS3 const unsigned char* slot = ring + (i % ATT_R) * 16384;
      const f32x16 acc = qk_lds(slot, qf, lane);
      const float base = slope2 * (float)(pos0 + 8 * h - t);
      float sv[16], p[16];
#pragma unroll
      for (int rg = 0; rg < 16; ++rg) { const int kk = (rg & 7) + 16 * (rg >> 3); sv[rg] = fmaf(acc[rg], c1, fmaf(slope2, (float)kk, base)); }
      if (!full) {
        if (i < nslc) {
#pragma unroll
          for (int rg = 0; rg < 16; ++rg) { const int kk = (rg & 7) + 16 * (rg >> 3); sv[rg] = (mine && (pb + kk <= t)) ? sv[rg] : ninf; }
        } else {
#pragma unroll
          for (int rg = 0; rg < 16; ++rg) { const int kk = (rg & 7) + 16 * (rg >> 3); const int dw = t - (pb + kk); sv[rg] = ((dw >= 0) && (dw < 512)) ? sv[rg] : ninf; }
        }
      }
      osm_step(sv, m, l, Ob, p);
      pv_lds(slot + 8192, p, Ob, lane);
    }
#undef B_ISSUE
    l = hsum(l);
    const float inv = (l > 0.f) ? g2 / l : 0.f;
    ot_accum(otL, lane, Ob, inv);
  }
  {
    float ss = 0.f;
#pragma unroll
    for (int dt = 0; dt < 4; ++dt)
#pragma unroll
      for (int i = 0; i < 16; ++i) ss = fmaf(Ob[dt][i], Ob[dt][i], ss);
    ss = hsum(ss);
    const float rs = rsqrtf(ss * (1.f / 128.f) + 1e-6f);
    bf16_t* orow = P.mix + (size_t)t * DM + hd * 128 + 4 * h;
    const float* grow = P.hng + hd * 128 + 4 * h;
#pragma unroll
    for (int dt = 0; dt < 4; ++dt)
#pragma unroll
      for (int a = 0; a < 4; ++a) {
        const f32x4 gv = *(const f32x4*)(grow + 32 * dt + 8 * a);
        u32x2 wv2 = {pack2(Ob[dt][4 * a] * rs * gv[0], Ob[dt][4 * a + 1] * rs * gv[1]), pack2(Ob[dt][4 * a + 2] * rs * gv[2], Ob[dt][4 * a + 3] * rs * gv[3])};
        *(u32x2*)(orow + 32 * dt + 8 * a) = wv2;
      }
  }
  asm volatile("s_waitcnt vmcnt(0)" ::: "memory");
  __syncthreads();
}

__device__ void d_convmix(int t, int tl, const bf16_t* __restrict__ proj, const float* __restrict__ convw, const float* __restrict__ hng,
                          bf16_t* __restrict__ mix) {
  const int c = tl * 8;
  float acc[8];
#pragma unroll
  for (int i = 0; i < 8; ++i) acc[i] = 0.f;
#pragma unroll
  for (int j = 0; j < 3; ++j) {
    const int tt = t - 2 + j;
    if (tt >= 0) {
      const u32x4 cu = *(const u32x4*)(proj + (size_t)tt * INWP + OFF_C + c);
      const u32x4 uu = *(const u32x4*)(proj + (size_t)tt * INWP + OFF_U + c);
      const f32x4 w0 = *(const f32x4*)(convw + j * 1024 + c), w1 = *(const f32x4*)(convw + j * 1024 + c + 4);
#pragma unroll
      for (int i = 0; i < 4; ++i) {
        const unsigned a = cu[i], b = uu[i];
        const float wl = (i < 2) ? w0[2 * i] : w1[2 * i - 4], wh = (i < 2) ? w0[2 * i + 1] : w1[2 * i - 3];
        acc[2 * i] = fmaf(wl * __uint_as_float(a << 16), __uint_as_float(b << 16), acc[2 * i]);
        acc[2 * i + 1] = fmaf(wh * __uint_as_float(a & 0xFFFF0000u), __uint_as_float(b & 0xFFFF0000u), acc[2 * i + 1]);
      }
    }
  }
  const u32x4 bb = *(const u32x4*)(proj + (size_t)t * INWP + OFF_B + c);
  float ss = 0.f;
#pragma unroll
  for (int i = 0; i < 4; ++i) {
    const unsigned b = bb[i];
    acc[2 * i] *= __uint_as_float(b << 16); acc[2 * i + 1] *= __uint_as_float(b & 0xFFFF0000u);
    ss = fmaf(acc[2 * i], acc[2 * i], ss); ss = fmaf(acc[2 * i + 1], acc[2 * i + 1], ss);
  }
  ss += shx(ss, 8); ss += shx(ss, 4); ss += shx(ss, 2); ss += shx(ss, 1);
  const float rs = rsqrtf(ss * (1.f / 128.f) + 1e-6f);
  const f32x4 g0 = *(const f32x4*)(hng + 1024 + c), g1 = *(const f32x4*)(hng + 1024 + c + 4);
  u32x4 o = {pack2(acc[0] * rs * g0[0], acc[1] * rs * g0[1]), pack2(acc[2] * rs * g0[2], acc[3] * rs * g0[3]),
             pack2(acc[4] * rs * g1[0], acc[5] * rs * g1[1]), pack2(acc[6] * rs * g1[2], acc[7] * rs * g1[3])};
  *(u32x4*)(mix + (size_t)t * DM + 1024 + c) = o;
}

__device__ void d_ln_wave(int t, bf16_t* __restrict__ yh, const float* __restrict__ gam, const float* __restrict__ bet) {
  const int lane = TIDX & 63;
  float v[32];
#pragma unroll
  for (int i = 0; i < 4; ++i) {
    const u32x4 w = *(const u32x4*)(yh + (size_t)t * DM + 512 * i + 8 * lane);
#pragma unroll
    for (int j = 0; j < 4; ++j) { const unsigned ww = w[j]; v[i * 8 + 2 * j] = __uint_as_float(ww << 16); v[i * 8 + 2 * j + 1] = __uint_as_float(ww & 0xFFFF0000u); }
  }
  float s = 0.f;
#pragma unroll
  for (int i = 0; i < 32; ++i) s += v[i];
  s = wave_sum(s);
  const float mu = s * (1.f / DM);
  float q = 0.f;
#pragma unroll
  for (int i = 0; i < 32; ++i) { const float d = v[i] - mu; q = fmaf(d, d, q); }
  q = wave_sum(q);
  const float rs = rsqrtf(q * (1.f / DM) + 1e-5f);
#pragma unroll
  for (int i = 0; i < 4; ++i) {
    const int cb = 512 * i + 8 * lane;
    const f32x4 g0 = *(const f32x4*)(gam + cb), g1 = *(const f32x4*)(gam + cb + 4), b0 = *(const f32x4*)(bet + cb), b1 = *(const f32x4*)(bet + cb + 4);
    u32x4 o = {pack2((v[i * 8 + 0] - mu) * rs * g0[0] + b0[0], (v[i * 8 + 1] - mu) * rs * g0[1] + b0[1]), pack2((v[i * 8 + 2] - mu) * rs * g0[2] + b0[2], (v[i * 8 + 3] - mu) * rs * g0[3] + b0[3]),
               pack2((v[i * 8 + 4] - mu) * rs * g1[0] + b1[0], (v[i * 8 + 5] - mu) * rs * g1[1] + b1[1]), pack2((v[i * 8 + 6] - mu) * rs * g1[2] + b1[2], (v[i * 8 + 7] - mu) * rs * g1[3] + b1[3])};
    *(u32x4*)(yh + (size_t)t * DM + cb) = o;
  }
}

__device__ void d_cvt_w1f(size_t c, const float* __restrict__ w1, bf16_t* __restrict__ w1f) {
  const int lane = c & 63, ks = (c >> 6) & 255, ct = c >> 14;
  const int col = lane & 31, h = lane >> 5;
  bf16_t v[8];
#pragma unroll
  for (int j = 0; j < 8; ++j) v[j] = f2bf(w1[(size_t)(16 * ks + 8 * h + j) * 512 + 32 * ct + col]);
  u32x4 o; o.x = v[0] | ((unsigned)v[1] << 16); o.y = v[2] | ((unsigned)v[3] << 16); o.z = v[4] | ((unsigned)v[5] << 16); o.w = v[6] | ((unsigned)v[7] << 16);
  *(u32x4*)(w1f + c * 8) = o;
}
__device__ void d_cvt_w2f(size_t c, const float* __restrict__ w2, bf16_t* __restrict__ w2f) {
  const int lane = c & 63, s = (c >> 6) & 31, ct = c >> 11;
  const int col = lane & 31, h = lane >> 5;
  bf16_t v[8];
#pragma unroll
  for (int j = 0; j < 8; ++j) v[j] = f2bf(w2[(size_t)(16 * s + 8 * h + j) * 128 + 32 * ct + col]);
  u32x4 o; o.x = v[0] | ((unsigned)v[1] << 16); o.y = v[2] | ((unsigned)v[3] << 16); o.z = v[4] | ((unsigned)v[5] << 16); o.w = v[6] | ((unsigned)v[7] << 16);
  *(u32x4*)(w2f + c * 8) = o;
}
__device__ __forceinline__ void d_compress_unit(int rt, char* smem, const bf16_t* __restrict__ proj, int col0, const float* __restrict__ pos,
                                const bf16_t* __restrict__ w1f, const float* __restrict__ b1, const bf16_t* __restrict__ w2f,
                                bf16_t* __restrict__ outf, bool isV) {
  bf16_t* Xs = (bf16_t*)smem;
  bf16_t* Hs = (bf16_t*)(smem + 2 * 8704);
  const int tid = TIDX, lane = tid & 63, w = tid >> 6, c = lane & 31, h = lane >> 5;
  const int R0 = rt * 32;
  const int srow = tid >> 4, sch = tid & 15;
  const int grow = R0 + srow, sn = grow >> 1, sg = grow & 1;
  const bool svalid = grow < 2046;
  const bf16_t* sp = proj + (size_t)(16 * sn) * INWP + col0 + sg * 128 + sch * 8;
  f32x16 acc0, acc1;
#pragma unroll
  for (int i = 0; i < 16; ++i) { acc0[i] = 0.f; acc1[i] = 0.f; }
  u32x4 rx = {0u, 0u, 0u, 0u}; f32x4 rp0, rp1;
#define STAGE_WRITE(buf)                                                                                   \
  {                                                                                                        \
    u32x4 o_;                                                                                              \
    _Pragma("unroll") for (int i = 0; i < 4; ++i) {                                                        \
      const unsigned wv_ = rx[i];                                                                          \
      const float lo = __uint_as_float(wv_ << 16) + ((i < 2) ? rp0[2 * i] : rp1[2 * i - 4]);               \
      const float hi = __uint_as_float(wv_ & 0xFFFF0000u) + ((i < 2) ? rp0[2 * i + 1] : rp1[2 * i - 3]);   \
      o_[i] = pack2(lo, hi);                                                                               \
    }                                                                                                      \
    *(u32x4*)(Xs + (buf) * 4352 + srow * 136 + sch * 8) = o_;                                              \
  }
  if (svalid) rx = *(const u32x4*)(sp);
  rp0 = *(const f32x4*)(pos + sch * 8); rp1 = *(const f32x4*)(pos + sch * 8 + 4);
  STAGE_WRITE(0)
  __syncthreads();
  const bf16_t* wb0 = w1f + ((size_t)(2 * w) * 256 * 64 + lane) * 8;
  const bf16_t* wb1 = w1f + ((size_t)(2 * w + 1) * 256 * 64 + lane) * 8;
  bf16x8 bA[16], bB[16];
#define CMP_LOADB(BUF, L)                                                                      \
  _Pragma("unroll") for (int s8 = 0; s8 < 8; ++s8) {                                           \
    BUF[2 * s8] = *(const bf16x8*)(wb0 + (size_t)(8 * (L) + s8) * 512);                        \
    BUF[2 * s8 + 1] = *(const bf16x8*)(wb1 + (size_t)(8 * (L) + s8) * 512);                    \
  }
#define CMP_CHUNK(BUF, L)                                                                      \
  {                                                                                            \
    if ((L) + 1 < 32) {                                                                        \
      if (svalid) rx = *(const u32x4*)(sp + (size_t)((L) + 1) * INWP);                         \
      rp0 = *(const f32x4*)(pos + ((L) + 1) * 128 + sch * 8); rp1 = *(const f32x4*)(pos + ((L) + 1) * 128 + sch * 8 + 4); \
    }                                                                                          \
    const bf16_t* xa = Xs + ((L) & 1) * 4352 + c * 136 + 8 * h;                                \
    _Pragma("unroll") for (int s8 = 0; s8 < 8; ++s8) {                                         \
      const bf16x8 a = *(const bf16x8*)(xa + 16 * s8);                                         \
      acc0 = MFMA32(a, BUF[2 * s8], acc0);                                                     \
      acc1 = MFMA32(a, BUF[2 * s8 + 1], acc1);                                                 \
    }                                                                                          \
    if ((L) + 1 < 32) STAGE_WRITE(((L) + 1) & 1)                                               \
    __syncthreads();                                                                           \
  }
  CMP_LOADB(bA, 0)
#pragma unroll 1
  for (int l = 0; l < 32; l += 2) {
    CMP_LOADB(bB, l + 1)
    __builtin_amdgcn_sched_barrier(0);
    CMP_CHUNK(bA, l)
    { const int ln = (l + 2 < 32) ? l + 2 : l;
      CMP_LOADB(bA, ln) }
    __builtin_amdgcn_sched_barrier(0);
    CMP_CHUNK(bB, l + 1)
  }
#undef CMP_LOADB
#undef CMP_CHUNK
  {
    const float bb0 = b1[64 * w + c], bb1 = b1[64 * w + 32 + c];
#pragma unroll
    for (int rg = 0; rg < 16; ++rg) {
      const int row = (rg & 3) + 8 * (rg >> 2) + 4 * h;
      Hs[row * 520 + 64 * w + c] = f2bf(gelu_tanh(acc0[rg] + bb0));
      Hs[row * 520 + 64 * w + 32 + c] = f2bf(gelu_tanh(acc1[rg] + bb1));
    }
  }
  __syncthreads();
  if (w < 4) {
    f32x16 o2;
#pragma unroll
    for (int i = 0; i < 16; ++i) o2[i] = 0.f;
    const bf16_t* ha = Hs + c * 520 + 8 * h;
    const bf16_t* wb = w2f + ((size_t)w * 32 * 64 + lane) * 8;
#pragma unroll 8
    for (int s2 = 0; s2 < 32; ++s2) {
      const bf16x8 a = *(const bf16x8*)(ha + 16 * s2);
      const bf16x8 b = *(const bf16x8*)(wb + (size_t)s2 * 512);
      o2 = MFMA32(a, b, o2);
    }
    const int d = 32 * w + c;
#pragma unroll
    for (int rg = 0; rg < 16; ++rg) {
      const int row = R0 + (rg & 3) + 8 * (rg >> 2) + 4 * h;
      const int n = row >> 1, g = row & 1;
      const bf16_t val = (row < 2046) ? f2bf(o2[rg]) : (bf16_t)0;
      const int T = n >> 5, nn = n & 31;
      size_t idx;
      if (!isV) idx = ((((size_t)(g * 32 + T) * 8 + (d >> 4)) * 64 + (pi_perm(nn) + 32 * ((d >> 3) & 1))) * 8 + (d & 7));
      else idx = (((((size_t)(g * 32 + T) * 4 + (d >> 5)) * 2 + (nn >> 4)) * 64 + ((d & 31) + 32 * ((nn >> 3) & 1))) * 8 + (nn & 7));
      outf[idx] = val;
    }
  }
  __syncthreads();
}


DI unsigned f2sort(float f) { unsigned u = __float_as_uint(f); return u ^ ((unsigned)((int)u >> 31) | 0x80000000u); }
DI float sort2f(unsigned k) { unsigned u = (k & 0x80000000u) ? (k ^ 0x80000000u) : ~k; return __uint_as_float(u); }
template <int N>
DI void bitonic_sort_desc(unsigned (&key)[N]) {
#pragma unroll
  for (int k = 2; k <= N; k <<= 1) {
#pragma unroll
    for (int jj = k >> 1; jj > 0; jj >>= 1) {
#pragma unroll
      for (int i = 0; i < N; ++i) {
        const int l2 = i ^ jj;
        if (l2 > i) {
          const bool desc = ((i & k) == 0);
          unsigned a = key[i], b = key[l2];
          unsigned mx = a > b ? a : b, mn = a > b ? b : a;
          key[i] = desc ? mx : mn; key[l2] = desc ? mn : mx;
        }
      }
    }
  }
}
DI void merge_top16(unsigned (&a)[16], const unsigned (&b)[16]) {
#pragma unroll
  for (int i = 0; i < 16; ++i) { unsigned o = b[15 - i]; a[i] = a[i] > o ? a[i] : o; }
#pragma unroll
  for (int jj = 8; jj > 0; jj >>= 1) {
#pragma unroll
    for (int i = 0; i < 16; ++i) {
      const int l2 = i ^ jj;
      if (l2 > i) { unsigned x = a[i], y = a[l2]; a[i] = x > y ? x : y; a[l2] = x > y ? y : x; }
    }
  }
}
__device__ void d_cvt_subk(size_t c, const float* __restrict__ subk, bf16_t* __restrict__ skf) {
  int lane = c & 63, s = (c >> 6) & 7, kt = (c >> 9) & 3, hc = c >> 11;
  int i = lane & 31, h = lane >> 5;
  const float* src = subk + ((size_t)hc * 128 + 32 * kt + i) * 128 + 16 * s + 8 * h;
  bf16_t v[8];
#pragma unroll
  for (int j = 0; j < 8; ++j) v[j] = f2bf(src[j]);
  u32x4 o; o.x = v[0] | ((unsigned)v[1] << 16); o.y = v[2] | ((unsigned)v[3] << 16); o.z = v[4] | ((unsigned)v[5] << 16); o.w = v[6] | ((unsigned)v[7] << 16);
  *(u32x4*)(skf + c * 8) = o;
}

struct EpiProjG {
  static constexpr bool PERM = true, AFTER_DRAIN = false;
  bf16_t* proj; float* gates;
  DI void operator()(const f32x4 (&acc)[2][2][4][2], const pg8::Unit& u, int wr, int wc, int fr, int fq) const {
#pragma unroll
    for (int ai = 0; ai < 2; ++ai)
#pragma unroll
      for (int m = 0; m < 4; ++m) {
        const int row = u.pm * 256 + ai * 128 + wr * 64 + m * 16 + fr;
#pragma unroll
        for (int bj = 0; bj < 2; ++bj) {
          const int c0 = u.pn * 256 + bj * 128 + wc * 32 + 8 * fq;
          const f32x4 v0 = acc[ai][bj][m][0], v1 = acc[ai][bj][m][1];
          if (c0 < INW) {
            u32x4 w = {pack2(v0[0], v0[1]), pack2(v0[2], v0[3]), pack2(v1[0], v1[1]), pack2(v1[2], v1[3])};
            *(u32x4*)(proj + (size_t)row * INWP + c0) = w;
          }
          if (c0 >= OFF_G && c0 < OFF_G + 24) {
            f32x4 g0, g1;
#pragma unroll
            for (int j = 0; j < 4; ++j) { g0[j] = 1.f / (1.f + __expf(-v0[j])); g1[j] = 1.f / (1.f + __expf(-v1[j])); }
            *(f32x4*)(gates + (size_t)row * 24 + (c0 - OFF_G)) = g0;
            *(f32x4*)(gates + (size_t)row * 24 + (c0 - OFF_G) + 4) = g1;
          }
        }
      }
  }
};
struct EpiResG {
  static constexpr bool PERM = false, AFTER_DRAIN = false;
  bf16_t* YB;
  DI void operator()(const f32x4 (&acc)[2][2][4][2], const pg8::Unit& u, int wr, int wc, int fr, int fq) const {
#pragma unroll
    for (int ai = 0; ai < 2; ++ai)
#pragma unroll
      for (int m = 0; m < 4; ++m) {
        const size_t ro = (size_t)(u.pm * 256 + ai * 128 + wr * 64 + m * 16 + fr) * DM + u.pn * 256 + wc * 32 + 4 * fq;
#pragma unroll
        for (int bj = 0; bj < 2; ++bj)
#pragma unroll
          for (int n = 0; n < 2; ++n) {
            const u32x2 xw = *(const u32x2*)(YB + ro + bj * 128 + n * 16);
            const f32x4 xv = {__uint_as_float(xw[0] << 16), __uint_as_float(xw[0] & 0xFFFF0000u), __uint_as_float(xw[1] << 16), __uint_as_float(xw[1] & 0xFFFF0000u)};
            const f32x4 yv = ALPHA * xv + acc[ai][bj][m][n];
            u32x2 o = {pack2(yv[0], yv[1]), pack2(yv[2], yv[3])};
            *(u32x2*)(YB + ro + bj * 128 + n * 16) = o;
          }
      }
  }
};
struct EpiF32G {
  static constexpr bool PERM = false, AFTER_DRAIN = false;
  float* C; int ldc;
  DI void operator()(const f32x4 (&acc)[2][2][4][2], const pg8::Unit& u, int wr, int wc, int fr, int fq) const {
#pragma unroll
    for (int ai = 0; ai < 2; ++ai)
#pragma unroll
      for (int m = 0; m < 4; ++m) {
        const size_t ro = (size_t)(u.pm * 256 + ai * 128 + wr * 64 + m * 16 + fr) * ldc + u.pn * 256 + wc * 32 + 4 * fq;
#pragma unroll
        for (int bj = 0; bj < 2; ++bj)
#pragma unroll
          for (int n = 0; n < 2; ++n) *(f32x4*)(C + ro + bj * 128 + n * 16) = acc[ai][bj][m][n];
      }
  }
};
struct EpiRouteG {
  static constexpr bool PERM = false, AFTER_DRAIN = true;
  const bf16_t* skf; unsigned* tops;
  DI void operator()(const f32x4 (&)[2][2][4][2], const pg8::Unit&, int, int, int, int) const {}
  DI void fused(const f32x4 (&acc)[2][2][4][2], const pg8::Unit& u, int wr, int wc, int fr, int fq, PG8_LAS unsigned char* ldsp, int, int) const {
    const int lane = fr | (fq << 4), wid = wr * 4 + wc;
    bf16_t* Qs = (bf16_t*)ldsp;
#pragma unroll
    for (int ai = 0; ai < 2; ++ai)
#pragma unroll
      for (int m = 0; m < 4; ++m) {
        const int row = ai * 128 + wr * 64 + m * 16 + fr;
#pragma unroll
        for (int bj = 0; bj < 2; ++bj)
#pragma unroll
          for (int n = 0; n < 2; ++n) {
            const f32x4 v = acc[ai][bj][m][n];
            u32x2 w = {pack2(v[0], v[1]), pack2(v[2], v[3])};
            *(u32x2*)(Qs + row * 264 + bj * 128 + wc * 32 + n * 16 + 4 * fq) = w;
          }
      }
    __syncthreads();
    const int c = lane & 31, h = lane >> 5;
#pragma unroll 1
    for (int half = 0; half < 2; ++half) {
      const int hc = u.pn * 2 + half;
      const bf16_t* sk = skf + (size_t)hc * 4 * 4096;
      const bf16_t* qp = Qs + (wid * 32 + c) * 264 + half * 128 + 8 * h;
      unsigned k0[16], k1[16];
#define ROUTE_KT(KT, KA)                                                                        \
      {                                                                                         \
        f32x16 sc;                                                                              \
        _Pragma("unroll") for (int i = 0; i < 16; ++i) sc[i] = 0.f;                             \
        _Pragma("unroll") for (int s = 0; s < 8; ++s) {                                         \
          bf16x8 af = *(const bf16x8*)(sk + (KT) * 4096 + s * 512 + lane * 8);                  \
          bf16x8 bq = *(const bf16x8*)(qp + 16 * s);                                            \
          sc = __builtin_amdgcn_mfma_f32_32x32x16_bf16(af, bq, sc, 0, 0, 0);                    \
        }                                                                                       \
        _Pragma("unroll") for (int rg = 0; rg < 16; ++rg) {                                     \
          const int kidx = 32 * (KT) + (rg & 3) + 8 * (rg >> 2) + 4 * h;                        \
          KA[rg] = (f2sort(sc[rg]) & 0xFFFFFF80u) | (unsigned)(127 - kidx);                     \
        }                                                                                       \
        bitonic_sort_desc<16>(KA);                                                              \
      }
      ROUTE_KT(0, k0)
      __builtin_amdgcn_sched_barrier(0);
      ROUTE_KT(1, k1)
      merge_top16(k0, k1);
      __builtin_amdgcn_sched_barrier(0);
      ROUTE_KT(2, k1)
      merge_top16(k0, k1);
      __builtin_amdgcn_sched_barrier(0);
      ROUTE_KT(3, k1)
      merge_top16(k0, k1);
      __builtin_amdgcn_sched_barrier(0);
#undef ROUTE_KT
#pragma unroll
      for (int i = 0; i < 16; ++i) k1[i] = (unsigned)shx_i((int)k0[i], 32);
      merge_top16(k0, k1);
      if (h == 0) {
        unsigned* dst = tops + ((size_t)(u.pm * 256 + wid * 32 + c) * 16 + hc) * 16;
#pragma unroll
        for (int q4 = 0; q4 < 4; ++q4) { u32x4 o = {k0[4 * q4], k0[4 * q4 + 1], k0[4 * q4 + 2], k0[4 * q4 + 3]}; *(u32x4*)(dst + 4 * q4) = o; }
      }
    }
    __syncthreads();
  }
};


template <int CTRL> DI float dpp_f(float v) { const int iv = __float_as_int(v); return __int_as_float(__builtin_amdgcn_update_dpp(iv, iv, CTRL, 0xF, 0xF, false)); }
DI float wsum(float x) {
  x += dpp_f<0xB1>(x);
  x += dpp_f<0x4E>(x);
  x += dpp_f<0x124>(x);
  x += dpp_f<0x128>(x);
  x += shx(x, 16);
  return hsum(x);
}
DI float gelu_fast(float x) {
  const float u2 = 1.5957691216057308f * (x + 0.044715f * x * x * x);
  return x * __builtin_amdgcn_rcpf(1.f + ex2(-LOG2E * u2));
}

constexpr int EROW = 1024;
typedef float v2f __attribute__((ext_vector_type(2)));
__device__ void d_cvt_fp4_row(int row, const float* __restrict__ src, unsigned char* __restrict__ dst, float* __restrict__ scales) {
  const int lane = TIDX & 63;
  float v[32]; float amax = 0.f;
#pragma unroll
  for (int i = 0; i < 8; ++i) {
    f32x4 x = *(const f32x4*)(src + (size_t)row * DM + 256 * i + 4 * lane);
#pragma unroll
    for (int j = 0; j < 4; ++j) { v[i * 4 + j] = x[j]; amax = fmaxf(amax, fabsf(x[j])); }
  }
  amax = wave_max(amax);
  const float sc = amax > 0.f ? amax * (1.f / 7.f) : 1.f;
  const float inv = 1.f / sc;
  u32x4 o;
#pragma unroll
  for (int k = 0; k < 4; ++k) {
    unsigned w = 0u;
#define FP4C(x_) fminf(fmaxf((x_) * inv, -6.f), 6.f)
    w = __builtin_amdgcn_cvt_scalef32_pk_fp4_f32(w, FP4C(v[8 * k + 0]), FP4C(v[8 * k + 1]), 1.0f, 0);
    w = __builtin_amdgcn_cvt_scalef32_pk_fp4_f32(w, FP4C(v[8 * k + 2]), FP4C(v[8 * k + 3]), 1.0f, 1);
    w = __builtin_amdgcn_cvt_scalef32_pk_fp4_f32(w, FP4C(v[8 * k + 4]), FP4C(v[8 * k + 5]), 1.0f, 2);
    w = __builtin_amdgcn_cvt_scalef32_pk_fp4_f32(w, FP4C(v[8 * k + 6]), FP4C(v[8 * k + 7]), 1.0f, 3);
#undef FP4C
    o[k] = w;
  }
  *(u32x4*)(dst + (size_t)row * EROW + 16 * lane) = o;
  if (lane == 0) scales[row] = sc;
}
__device__ void d_expert_wave(int t, unsigned* tpl, const bf16_t* __restrict__ hbuf,
                              const unsigned* __restrict__ tops, const unsigned char* __restrict__ eu4, const unsigned char* __restrict__ ev4,
                              const float* __restrict__ esu, const float* __restrict__ esv, const float* __restrict__ gam, const float* __restrict__ bet, float* __restrict__ out) {
  const int lane = TIDX & 63;
  float hv[32];
#pragma unroll
  for (int i = 0; i < 8; ++i) {
    const u32x2 w = *(const u32x2*)(hbuf + (size_t)t * DM + 256 * i + 4 * lane);
    hv[i * 4 + 0] = __uint_as_float(w[0] << 16); hv[i * 4 + 1] = __uint_as_float(w[0] & 0xFFFF0000u);
    hv[i * 4 + 2] = __uint_as_float(w[1] << 16); hv[i * 4 + 3] = __uint_as_float(w[1] & 0xFFFF0000u);
  }
  int e0 = 0, e1 = 0; float w0 = 0.f, w1 = 0.f;
  {
    const int ci = (lane < 16) ? 0 : (lane < 24) ? 1 : (lane < 29) ? 2 : (lane < 33) ? 3 : (lane < 36) ? 4 : (lane < 38) ? 5 : (lane < 40) ? 6
                   : (lane < 42) ? 7 : (lane - 34);
    const int cpre = (ci == 0) ? 0 : (ci == 1) ? 16 : (ci == 2) ? 24 : (ci == 3) ? 29 : (ci == 4) ? 33 : (ci == 5) ? 36 : (ci == 6) ? 38
                     : (ci == 7) ? 40 : (34 + ci);
    const int cj = lane - cpre;
    const bool cvalid = lane < 50;
    *(u32x4*)(tpl + 4 * lane) = *(const u32x4*)(tops + (size_t)t * 256 + 4 * lane);
    const unsigned* tp = tpl;
#pragma unroll 1
    for (int hh = 0; hh < 8; ++hh) {
      unsigned key = 0u;
      if (cvalid) {
        const float sa = sort2f(tp[(2 * hh) * 16 + ci]), sb = sort2f(tp[(2 * hh + 1) * 16 + cj]);
        key = (f2sort(sa + sb) & 0xFFFFFF00u) | (unsigned)(255 - (ci * 16 + cj));
      }
#pragma unroll
      for (int k = 2; k <= 64; k <<= 1) {
#pragma unroll
        for (int jj = k >> 1; jj > 0; jj >>= 1) {
          const unsigned o = (unsigned)shx_i((int)key, jj);
          const bool lower = (lane & jj) == 0;
          const bool desc = (lane & k) == 0 || k == 64;
          const unsigned mx = key > o ? key : o, mn = key > o ? o : key;
          key = (lower == desc) ? mx : mn;
        }
      }
      const int flat = 255 - (int)(key & 255u);
      const int bi = (flat >> 4) & 15, bj = flat & 15;
      const unsigned ka = tp[(2 * hh) * 16 + bi], kb = tp[(2 * hh + 1) * 16 + bj];
      const float sc = sort2f(ka) + sort2f(kb);
      const int ex = (127 - (int)(ka & 127u)) * 128 + (127 - (int)(kb & 127u));
      float mx = sc;
      mx = fmaxf(mx, shx(mx, 1)); mx = fmaxf(mx, shx(mx, 2)); mx = fmaxf(mx, shx(mx, 4)); mx = fmaxf(mx, shx(mx, 8));
      const float ev_ = __expf(sc - mx);
      float sm = ev_;
      sm += shx(sm, 1); sm += shx(sm, 2); sm += shx(sm, 4); sm += shx(sm, 8);
      const float gv = ev_ / sm;
      const int exs = __shfl(ex, lane & 15); const float gvs = __shfl(gv, lane & 15);
      if ((lane >> 4) == (hh & 3)) { if (hh < 4) { e0 = exs; w0 = gvs; } else { e1 = exs; w1 = gvs; } }
    }
  }
  bf16x2v hb2[16];
#pragma unroll
  for (int i = 0; i < 16; ++i) hb2[i] = bf16x2v{(__bf16)hv[2 * i], (__bf16)hv[2 * i + 1]};
  float c0 = 0.f, c1 = 0.f;
  u32x4 rA[4], rB[4]; float sA[4], sB[4];
#define EX_LOAD(R, SS, TAB, STAB, EB)                                                            \
  _Pragma("unroll") for (int k = 0; k < 4; ++k) {                                          \
    const int e = (EB) + k;                                                                \
    const int id = __builtin_amdgcn_readlane((e < 64) ? e0 : e1, e & 63);                 \
    const unsigned char* row = (TAB) + (size_t)id * EROW;                                  \
    R[k] = *(const u32x4*)(row + 16 * lane);                                               \
    SS[k] = (STAB)[id];                                                                    \
  }
#define PKFMA(a_, b_, c_) __builtin_elementwise_fma((a_), (b_), (c_))
#define EX_COMP_U(R, SS, EB)                                                               \
  {                                                                                        \
    float dd[4];                                                                           \
    _Pragma("unroll") for (int k = 0; k < 4; ++k) {                                        \
      float d0 = 0.f, d1 = 0.f;                                                            \
      _Pragma("unroll") for (int q = 0; q < 4; ++q) {                                      \
        const unsigned wq = R[k][q];                                                       \
        d0 = __builtin_amdgcn_fdot2_f32_bf16(__builtin_amdgcn_cvt_scalef32_pk_bf16_fp4(wq, 1.0f, 0), hb2[4 * q + 0], d0, false); \
        d1 = __builtin_amdgcn_fdot2_f32_bf16(__builtin_amdgcn_cvt_scalef32_pk_bf16_fp4(wq, 1.0f, 1), hb2[4 * q + 1], d1, false); \
        d0 = __builtin_amdgcn_fdot2_f32_bf16(__builtin_amdgcn_cvt_scalef32_pk_bf16_fp4(wq, 1.0f, 2), hb2[4 * q + 2], d0, false); \
        d1 = __builtin_amdgcn_fdot2_f32_bf16(__builtin_amdgcn_cvt_scalef32_pk_bf16_fp4(wq, 1.0f, 3), hb2[4 * q + 3], d1, false); \
      }                                                                                    \
      dd[k] = SS[k] * (d0 + d1);                                                     \
      __builtin_amdgcn_sched_barrier(0);                                                   \
    }                                                                                      \
      \
    float t01, t23;                                                                        \
    { auto r_ = __builtin_amdgcn_permlane32_swap(__float_as_uint(dd[0]), __float_as_uint(dd[1]), false, false);   \
      t01 = __uint_as_float(r_[0]) + __uint_as_float(r_[1]); }          \
    { auto r_ = __builtin_amdgcn_permlane32_swap(__float_as_uint(dd[2]), __float_as_uint(dd[3]), false, false);   \
      t23 = __uint_as_float(r_[0]) + __uint_as_float(r_[1]); }          \
    const bool b4_ = (lane & 16) != 0;                                                     \
    float tv = (b4_ ? t23 : t01) + shx(b4_ ? t01 : t23, 16);          \
    tv += dpp_f<0x128>(tv); tv += dpp_f<0x124>(tv); tv += dpp_f<0x4E>(tv); tv += dpp_f<0xB1>(tv);                 \
    _Pragma("unroll") for (int k = 0; k < 4; ++k) {                                        \
      const int e = (EB) + k;                                                              \
      const float tot = __int_as_float(__builtin_amdgcn_readlane(__float_as_int(tv), (k == 0) ? 0 : (k == 1) ? 32 : (k == 2) ? 16 : 48)); \
      if (e < 64) { if (lane == e) c0 = tot; } else { if (lane == e - 64) c1 = tot; }        \
    }                                                                                      \
    __builtin_amdgcn_sched_barrier(0);                                                     \
  }
#define EX_COMP_V(R, SS, EB)                                                               \
  _Pragma("unroll") for (int k = 0; k < 4; ++k) {                                          \
    const int e = (EB) + k;                                                                \
    const float cs = __int_as_float(__builtin_amdgcn_readlane(__float_as_int((e < 64) ? c0 : c1), e & 63)) * SS[k];                     \
    const v2f cs2 = {cs, cs};                                                              \
    _Pragma("unroll") for (int q = 0; q < 4; ++q) {                                        \
      const unsigned wq = R[k][q];                                                         \
      const v2f f0 = __builtin_amdgcn_cvt_scalef32_pk_f32_fp4(wq, 1.0f, 0), f1 = __builtin_amdgcn_cvt_scalef32_pk_f32_fp4(wq, 1.0f, 1); \
      const v2f f2 = __builtin_amdgcn_cvt_scalef32_pk_f32_fp4(wq, 1.0f, 2), f3 = __builtin_amdgcn_cvt_scalef32_pk_f32_fp4(wq, 1.0f, 3); \
      acc2[4 * q + 0] = PKFMA(cs2, f0, acc2[4 * q + 0]); acc2[4 * q + 1] = PKFMA(cs2, f1, acc2[4 * q + 1]); \
      acc2[4 * q + 2] = PKFMA(cs2, f2, acc2[4 * q + 2]); acc2[4 * q + 3] = PKFMA(cs2, f3, acc2[4 * q + 3]); \
    }                                                                                      \
    __builtin_amdgcn_sched_barrier(0);                                                     \
  }
  EX_LOAD(rA, sA, eu4, esu, 0)
  __builtin_amdgcn_sched_barrier(0);
#pragma unroll 1
  for (int eb = 0; eb < 128; eb += 8) {
    EX_LOAD(rB, sB, eu4, esu, eb + 4)
    __builtin_amdgcn_sched_barrier(0);
    EX_COMP_U(rA, sA, eb)
    { const bool more = eb + 8 < 128; const unsigned char* tabn = more ? eu4 : ev4; const float* stn = more ? esu : esv; const int ebn = more ? eb + 8 : 0;
      EX_LOAD(rA, sA, tabn, stn, ebn) }
    __builtin_amdgcn_sched_barrier(0);
    EX_COMP_U(rB, sB, eb + 4)
  }
  c0 = w0 * gelu_fast(c0); c1 = w1 * gelu_fast(c1);
  v2f acc2[16];
#pragma unroll
  for (int i = 0; i < 16; ++i) acc2[i] = v2f{0.f, 0.f};
#pragma unroll 1
  for (int eb = 0; eb < 128; eb += 8) {
    EX_LOAD(rB, sB, ev4, esv, eb + 4)
    __builtin_amdgcn_sched_barrier(0);
    EX_COMP_V(rA, sA, eb)
    { const int ebn = (eb + 8 < 128) ? eb + 8 : 0;
      EX_LOAD(rA, sA, ev4, esv, ebn) }
    __builtin_amdgcn_sched_barrier(0);
    EX_COMP_V(rB, sB, eb + 4)
  }
#undef EX_LOAD
#undef EX_COMP_U
#undef EX_COMP_V
#undef PKFMA
  float acc[32];
#pragma unroll
  for (int i = 0; i < 16; ++i) { acc[2 * i] = acc2[i].x; acc[2 * i + 1] = acc2[i].y; }
  int le = lane;
  asm volatile("" : "+v"(le) :: "memory");
  float s = 0.f;
#pragma unroll
  for (int i = 0; i < 8; ++i) {
    const u32x2 w = *(const u32x2*)(hbuf + (size_t)t * DM + 256 * i + 4 * le);
    const float h0 = __uint_as_float(w[0] << 16), h1 = __uint_as_float(w[0] & 0xFFFF0000u), h2 = __uint_as_float(w[1] << 16), h3 = __uint_as_float(w[1] & 0xFFFF0000u);
    acc[i * 4 + 0] = fmaf(ALPHA, h0, acc[i * 4 + 0]); acc[i * 4 + 1] = fmaf(ALPHA, h1, acc[i * 4 + 1]);
    acc[i * 4 + 2] = fmaf(ALPHA, h2, acc[i * 4 + 2]); acc[i * 4 + 3] = fmaf(ALPHA, h3, acc[i * 4 + 3]);
    s += (acc[i * 4 + 0] + acc[i * 4 + 1]) + (acc[i * 4 + 2] + acc[i * 4 + 3]);
  }
  s = wsum(s);
  const float mu = s * (1.f / DM);
  float qv = 0.f;
#pragma unroll
  for (int i = 0; i < 32; ++i) { const float d = acc[i] - mu; qv += d * d; }
  qv = wsum(qv);
  const float rs = rsqrtf(qv * (1.f / DM) + 1e-5f);
#pragma unroll
  for (int i = 0; i < 8; ++i) {
    const int cbase = 256 * i + 4 * le;
    f32x4 ga = *(const f32x4*)(gam + cbase), ba = *(const f32x4*)(bet + cbase), o;
#pragma unroll
    for (int j = 0; j < 4; ++j) o[j] = (acc[i * 4 + j] - mu) * rs * ga[j] + ba[j];
    *(f32x4*)(out + (size_t)t * DM + cbase) = o;
  }
}

constexpr size_t al256(size_t x) { return (x + 255) & ~(size_t)255; }
constexpr size_t WS_XB = 0;
constexpr size_t WS_PROJ = WS_XB + al256((size_t)S * DM * 2);
constexpr size_t WS_WINT = WS_PROJ + al256((size_t)S * INWP * 2);
constexpr size_t WS_GATES = WS_WINT + al256((size_t)INWG * DM * 2);
constexpr size_t WS_W1KF = WS_GATES + al256((size_t)S * 24 * 4);
constexpr size_t WS_W1VF = WS_W1KF + al256((size_t)512 * 4096 * 2);
constexpr size_t WS_W2KF = WS_W1VF + al256((size_t)512 * 4096 * 2);
constexpr size_t WS_W2VF = WS_W2KF + al256((size_t)512 * 128 * 2);
constexpr size_t WS_VC = WS_W2VF + al256((size_t)512 * 128 * 2) - al256((size_t)2048 * 128 * 4);
constexpr size_t WS_KCF = WS_VC + al256((size_t)2048 * 128 * 4);
constexpr size_t WS_VCF = WS_KCF + al256((size_t)2 * 32 * 4096 * 2);
constexpr size_t WS_KSF = WS_VCF + al256((size_t)2 * 32 * 4096 * 2);
constexpr size_t WS_VSF = WS_KSF + al256((size_t)2 * 512 * 4096 * 2);
constexpr size_t WS_KWF = WS_VSF + al256((size_t)2 * 512 * 4096 * 2);
constexpr size_t WS_VWF = WS_KWF + al256((size_t)2 * 512 * 4096 * 2);
constexpr size_t WS_ENDA = WS_VWF + al256((size_t)2 * 512 * 4096 * 2);
constexpr size_t WS_OATT = WS_ENDA;
constexpr size_t WS_MIX = WS_OATT + al256((size_t)S * 1024 * 4);
constexpr size_t WS_WOUTT = WS_MIX + al256((size_t)S * DM * 2);
constexpr size_t WS_WQT = WS_WOUTT + al256((size_t)DM * DM * 2);
constexpr size_t WS_TOPS = WS_WQT + al256((size_t)DM * DM * 2);
constexpr size_t WS_SKF = WS_TOPS + al256((size_t)S * 256 * 4);
constexpr size_t WS_STATS = WS_SKF + al256((size_t)16 * 128 * 128 * 2);
constexpr size_t WS_CTRL = WS_STATS + al256((size_t)S * 2 * 4);
constexpr size_t CTRL_BYTES = 32768;
constexpr size_t WS_END = WS_CTRL + CTRL_BYTES;
constexpr size_t WS_Y = WS_PROJ;
constexpr size_t WS_HB = WS_XB;
constexpr size_t WS_EU8 = WS_OATT;
constexpr size_t WS_EV8 = WS_EU8 + (size_t)16384 * 1024;
constexpr size_t WS_ESU = WS_EV8 + (size_t)16384 * 1024;
constexpr size_t WS_ESV = WS_ESU + 16384 * 4;
static_assert(WS_ESV + 16384 * 4 <= WS_MIX, "expert tables overflow their region");
constexpr int EXP_EARLY = 6144;
static_assert(WS_END <= (size_t)512 * 1024 * 1024, "workspace over 512 MiB");

struct Params {
  const float *x, *w_in, *ck_pos, *ck_w1, *ck_b1, *ck_w2, *cv_pos, *cv_w1, *cv_b1, *cv_w2, *conv_w, *hng, *w_out, *ln1g, *ln1b, *w_query, *subk,
      *eu, *ev, *ln2g, *ln2b;
  float* out;
  char* ws;
};
#define WSP(T, OFF) ((T*)(p.ws + (OFF)))

#define FOR_VB(n) for (int vb = blockIdx.x; vb < (n); vb += gridDim.x)
#define FOR_VB2(n) for (int vb = blockIdx.x * 2 + (TIDX >> 8); vb < (n); vb += gridDim.x * 2)
constexpr int SMEM_BYTES = 143360;
constexpr int HALF = 36864;

__global__ void __launch_bounds__(512) mega(Params p) {
  __shared__ __attribute__((aligned(16))) char smem[SMEM_BYTES + 16];
  if (TIDX == 0) *(u32x4*)(smem + SMEM_BYTES) = u32x4{0u, 0u, 0u, 0u};
  __syncthreads();
  const XcdBarrier xbar = xcd_barrier_post(WSP(unsigned, WS_CTRL + 1024), (volatile LAS unsigned*)(smem + SMEM_BYTES));
#define smh (smem + (TIDX >> 8) * HALF)
#define wv ((TIDX >> 6))
  constexpr int NWV = 8;
  d_cvt(p.x, WSP(bf16_t, WS_XB), (size_t)S * DM / 4);
  FOR_VB2((INWG / 64) * (DM / 64)) d_cvtT64(vb, smh, p.w_in, WSP(bf16_t, WS_WINT), DM, INW, INWG);
  for (size_t c = (size_t)blockIdx.x * 512 + TIDX; c < (size_t)16 * 256 * 64; c += (size_t)gridDim.x * 512) {
    d_cvt_w1f(c, p.ck_w1, WSP(bf16_t, WS_W1KF)); d_cvt_w1f(c, p.cv_w1, WSP(bf16_t, WS_W1VF));
    if (c < (size_t)4 * 32 * 64) { d_cvt_w2f(c, p.ck_w2, WSP(bf16_t, WS_W2KF)); d_cvt_w2f(c, p.cv_w2, WSP(bf16_t, WS_W2VF)); }
  }
  FOR_VB2((DM / 64) * (DM / 64)) d_cvtT64(vb, smh, p.w_out, WSP(bf16_t, WS_WOUTT), DM, DM, DM);
  FOR_VB2((DM / 64) * (DM / 64)) d_cvtT64(vb, smh, p.w_query, WSP(bf16_t, WS_WQT), DM, DM, DM);
  for (size_t c = (size_t)blockIdx.x * 512 + TIDX; c < (size_t)16 * 4 * 8 * 64; c += (size_t)gridDim.x * 512) d_cvt_subk(c, p.subk, WSP(bf16_t, WS_SKF));
  xcd_barrier(xbar);
  {
    pg8::StaticOrder so; so.init(S, INWG, gridDim.x, blockIdx.x);
    pg8::gemm_phase<EpiProjG, pg8::StaticOrder>((PG8_LAS unsigned char*)smem, pg8::Gemm{WSP(bf16_t, WS_XB), WSP(bf16_t, WS_WINT), S, INWG, DM}, so,
                                                EpiProjG{WSP(bf16_t, WS_PROJ), WSP(float, WS_GATES)}, nullptr);
    const int nun = (S / 256) * (INWG / 256), gsz = (int)gridDim.x;
    const int nfull = nun % gsz;
    if (nfull != 0 && (int)blockIdx.x >= nfull) {
      const int nidle = gsz - nfull, me = (int)blockIdx.x - nfull;
      for (int r = me * NWV + wv; r < 2 * EXP_EARLY; r += nidle * NWV) {
        if (r < EXP_EARLY) d_cvt_fp4_row(r, p.eu, WSP(unsigned char, WS_EU8), WSP(float, WS_ESU)); else d_cvt_fp4_row(r - EXP_EARLY, p.ev, WSP(unsigned char, WS_EV8), WSP(float, WS_ESV));
      }
    }
  }
  xcd_barrier(xbar);
  {
    if (blockIdx.x < 128) {
      const int xcd_ = blockIdx.x & 7, idx_ = blockIdx.x >> 3; const bool isV = (xcd_ & 1) != 0;
      d_compress_unit((xcd_ >> 1) * 16 + idx_, smem, WSP(bf16_t, WS_PROJ), isV ? OFF_VC : OFF_KC, isV ? p.cv_pos : p.ck_pos, isV ? WSP(bf16_t, WS_W1VF) : WSP(bf16_t, WS_W1KF),
                      isV ? p.cv_b1 : p.ck_b1, isV ? WSP(bf16_t, WS_W2VF) : WSP(bf16_t, WS_W2KF), isV ? WSP(bf16_t, WS_VCF) : WSP(bf16_t, WS_KCF), isV);
    }
    int* slot = (int*)smem;
    unsigned* ctr = WSP(unsigned, WS_CTRL);
    for (;;) {
      if (TIDX == 0) *slot = (int)atomicAdd(ctr, 1u);
      __syncthreads();
      const int it = *slot;
      __syncthreads();
      if (it >= 2048) break;
      const int tt = TIDX;
      {
        const int T = it >> 2, which = it & 3;
        d_relayout_tile(T, smem + 64, WSP(bf16_t, WS_PROJ), (which == 0) ? OFF_KS : (which == 1) ? OFF_VS : (which == 2) ? OFF_KW : OFF_VW,
                        (which == 0) ? WSP(bf16_t, WS_KSF) : (which == 1) ? WSP(bf16_t, WS_VSF) : (which == 2) ? WSP(bf16_t, WS_KWF) : WSP(bf16_t, WS_VWF), (which & 1) != 0);
      }
      for (int q = 0; q < 2; ++q) d_convmix(it * 8 + q * 4 + (tt >> 7), tt & 127, WSP(bf16_t, WS_PROJ), p.conv_w, p.hng, WSP(bf16_t, WS_MIX));
    }
  }
  xcd_barrier(xbar);
  {
    AttnPtrs ap{WSP(bf16_t, WS_PROJ), WSP(float, WS_GATES), WSP(bf16_t, WS_KCF), WSP(bf16_t, WS_VCF), WSP(bf16_t, WS_KSF), WSP(bf16_t, WS_VSF), WSP(bf16_t, WS_KWF), WSP(bf16_t, WS_VWF), WSP(bf16_t, WS_MIX), p.hng};
    for (int it = blockIdx.x; it < 512; it += gridDim.x) {
      const int Bq = (it < 256) ? it : (511 - it), gq = (it < 256) ? 0 : 1;
      d_attn_block(Bq, gq, smem, ap);
    }
  }
  xcd_barrier(xbar);
  {
    pg8::StaticOrder so; so.init(S, DM, gridDim.x, blockIdx.x);
    pg8::gemm_phase<EpiResG, pg8::StaticOrder>((PG8_LAS unsigned char*)smem, pg8::Gemm{WSP(bf16_t, WS_MIX), WSP(bf16_t, WS_WOUTT), S, DM, DM}, so,
                                               EpiResG{WSP(bf16_t, WS_HB)}, nullptr);
  }
  xcd_barrier(xbar);
  for (int r = blockIdx.x * NWV + wv; r < S; r += gridDim.x * NWV) d_ln_wave(r, WSP(bf16_t, WS_HB), p.ln1g, p.ln1b);
  {
    const int e0_ = (((S / 256) * (INWG / 256)) % (int)gridDim.x != 0) ? EXP_EARLY : 0;
    const int nrest = 16384 - e0_;
    for (int r = blockIdx.x * NWV + wv; r < 2 * nrest; r += gridDim.x * NWV) {
      if (r < nrest) d_cvt_fp4_row(e0_ + r, p.eu, WSP(unsigned char, WS_EU8), WSP(float, WS_ESU)); else d_cvt_fp4_row(e0_ + r - nrest, p.ev, WSP(unsigned char, WS_EV8), WSP(float, WS_ESV));
    }
  }
  xcd_barrier(xbar);
  for (int k = 0; k * (int)gridDim.x < (S / 256) * (DM / 256); ++k) {
    pg8::OneUnit so; so.init(S, DM, gridDim.x, blockIdx.x); so.k = k;
    pg8::gemm_phase<EpiRouteG, pg8::OneUnit>((PG8_LAS unsigned char*)smem, pg8::Gemm{WSP(bf16_t, WS_HB), WSP(bf16_t, WS_WQT), S, DM, DM}, so,
                                             EpiRouteG{WSP(bf16_t, WS_SKF), WSP(unsigned, WS_TOPS)}, nullptr);
    __syncthreads();
  }
  xcd_barrier(xbar);
  for (int t = blockIdx.x * NWV + wv; t < S; t += gridDim.x * NWV) d_expert_wave(t, (unsigned*)(smem + wv * 1024), WSP(bf16_t, WS_HB), WSP(unsigned, WS_TOPS), WSP(unsigned char, WS_EU8), WSP(unsigned char, WS_EV8), WSP(float, WS_ESU), WSP(float, WS_ESV), p.ln2g, p.ln2b, p.out);
}

extern "C" void kernel_launch(void* const* d_in, const int* in_sizes, int n_in, void* d_out, int out_size, void* d_ws, size_t ws_size,
                              hipStream_t stream) {
  Params p{};
  p.x = (const float*)d_in[0]; p.w_in = (const float*)d_in[1]; p.ck_pos = (const float*)d_in[2]; p.ck_w1 = (const float*)d_in[3];
  p.ck_b1 = (const float*)d_in[4]; p.ck_w2 = (const float*)d_in[5]; p.cv_pos = (const float*)d_in[6]; p.cv_w1 = (const float*)d_in[7];
  p.cv_b1 = (const float*)d_in[8]; p.cv_w2 = (const float*)d_in[9]; p.conv_w = (const float*)d_in[10]; p.hng = (const float*)d_in[11];
  p.w_out = (const float*)d_in[12]; p.ln1g = (const float*)d_in[13]; p.ln1b = (const float*)d_in[14]; p.w_query = (const float*)d_in[15];
  p.subk = (const float*)d_in[16]; p.eu = (const float*)d_in[17]; p.ev = (const float*)d_in[18]; p.ln2g = (const float*)d_in[19];
  p.ln2b = (const float*)d_in[20];
  p.out = (float*)d_out;
  p.ws = (char*)d_ws;
  if (ws_size < WS_END) fprintf(stderr, "workspace too small\n");
  static int grid_blocks = 0;
  if (!grid_blocks) {
    int dev = 0, cus = 0, per_cu = 0;
    hipGetDevice(&dev);
    hipDeviceGetAttribute(&cus, hipDeviceAttributeMultiprocessorCount, dev);
    hipOccupancyMaxActiveBlocksPerMultiprocessor(&per_cu, mega, 512, 0);
    if (per_cu > 1) per_cu = 1;
    if (per_cu < 1) per_cu = 1;
    grid_blocks = cus * per_cu;
  }
  hipMemsetAsync((char*)d_ws + WS_CTRL, 0, CTRL_BYTES, stream);
  void* args[] = {&p};
  hipError_t e = hipLaunchCooperativeKernel((void*)mega, dim3(grid_blocks), dim3(512), args, 0, stream);
  if (e != hipSuccess) fprintf(stderr, "cooperative launch failed: %s (grid %d)\n", hipGetErrorString(e), grid_blocks);
}
```

```cpp
#include <hip/hip_runtime.h>
#include <stdint.h>
#include <stdio.h>


#define DI __device__ __forceinline__
static __device__ __forceinline__ int tidx_() { int t = (int)__builtin_amdgcn_workitem_id_x(); asm volatile("" : "+v"(t)); return t; }
#define TIDX (tidx_())

template <int J> DI int swz_xor(int x) { return __builtin_amdgcn_ds_swizzle(x, (J << 10) | 0x1F); }
template <int CTRL> DI int dpp_i(int x) { return __builtin_amdgcn_update_dpp(x, x, CTRL, 0xF, 0xF, false); }
DI int shx_i(int x, int j) {
  switch (j) {
    case 1: return dpp_i<0xB1>(x);
    case 2: return dpp_i<0x4E>(x);
    case 4: return dpp_i<0x1B>(dpp_i<0x141>(x));
    case 8: return dpp_i<0x128>(x);
    case 16: return swz_xor<16>(x);
    default: {
      auto r = __builtin_amdgcn_permlane32_swap((unsigned)x, (unsigned)x, false, false);
      return (TIDX & 32) ? (int)r[0] : (int)r[1];
    }
  }
}
DI float shx(float x, int j) { return __int_as_float(shx_i(__float_as_int(x), j)); }
typedef unsigned short bf16_t;
using bf16x8 = __attribute__((ext_vector_type(8))) short;
using f32x4 = __attribute__((ext_vector_type(4))) float;
using u32x4 = __attribute__((ext_vector_type(4))) unsigned;
using u32x2 = __attribute__((ext_vector_type(2))) unsigned;

constexpr int S = 16384, DM = 2048, HD = 128;
constexpr int INW = 5656, INWP = 5760, INWG = 5888;
constexpr int OFF_Q = 0, OFF_KC = 1024, OFF_VC = 1280, OFF_KS = 1536, OFF_VS = 1792, OFF_KW = 2048, OFF_VW = 2304,
              OFF_G = 2560, OFF_U = 2584, OFF_B = 3608, OFF_C = 4632;
constexpr int NCMP = 1023;
constexpr float ALPHA = 1.189207115002721f;
constexpr float QSCALE = 0.08838834764831845f;

DI bf16_t f2bf(float x) { unsigned u = __float_as_uint(x); u += 0x7fffu + ((u >> 16) & 1u); return (bf16_t)(u >> 16); }
DI float bf2f(bf16_t b) { return __uint_as_float(((unsigned)b) << 16); }
DI float gelu_tanh(float x) { float u = 0.7978845608028654f * (x + 0.044715f * x * x * x); return 0.5f * x * (1.f + tanhf(u)); }
DI float wave_sum(float v) { for (int o = 32; o > 0; o >>= 1) v += shx(v, o); return v; }
using bf16x2v = __attribute__((ext_vector_type(2))) __bf16;
DI unsigned pack2(float a, float b) { bf16x2v v = {(__bf16)a, (__bf16)b}; return __builtin_bit_cast(unsigned, v); }
DI float wave_max(float v) { for (int o = 32; o > 0; o >>= 1) v = fmaxf(v, shx(v, o)); return v; }

namespace pg8 {
#define PG8_LAS __attribute__((address_space(3)))
typedef unsigned short bf16_t;
typedef short bf16x8 __attribute__((ext_vector_type(8)));
typedef float f32x4 __attribute__((ext_vector_type(4)));
typedef unsigned u32x4 __attribute__((ext_vector_type(4)));
constexpr int BM = 256, BK = 64, HALF = 128, HTB = HALF * BK * 2  , STAGE_BYTES = 8 * HTB, NXCD = 8, WGM = 8;

__host__ __device__ __forceinline__ int lds_byte(int r, int c) { const int st = (r >> 4) * 2 + (c >> 5), rr = r & 15, cc = c & 31, ob = rr * 64 + cc * 2; return st * 1024 + (ob ^ (((ob >> 9) & 1) << 5)); }
__host__ __device__ __forceinline__ void stage_rc(int b, int& R, int& C) { const int st = b / 1024, sb = b % 1024, swz = sb ^ (((sb >> 9) & 1) << 5); R = (st >> 1) * 16 + swz / 64; C = (st & 1) * 32 + (swz % 64) / 2; }
__host__ __device__ __forceinline__ int perm32(int rho) { const int n = rho >> 4, i = rho & 15; return 8 * (i >> 2) + 4 * n + (i & 3); }

struct Unit { int pm, pn; };
struct Gemm { const bf16_t* A; const bf16_t* Bt; int M, N, K; };

struct StaticOrder {
    int nM, nN, nwg, G, c;
    __host__ __device__ void init(int M, int N, int G_, int c_) { nM = M / BM; nN = N / BM; nwg = nM * nN; G = G_; c = c_; }
    __host__ __device__ bool next(int i, Unit& u) const {
        const long L = (long)i * G + c; if (L >= nwg) return false;
        int wgid = (int)L; { const int q = nwg / NXCD, r = nwg % NXCD, xcd = wgid % NXCD, off = wgid / NXCD; wgid = (xcd < r ? xcd * (q + 1) : r * (q + 1) + (xcd - r) * q) + off; }
        const int nig = WGM * nN, gid = wgid / nig, fm = gid * WGM, gsz = (nM - fm) < WGM ? (nM - fm) : WGM;
        u.pm = fm + ((wgid % nig) % gsz); u.pn = (wgid % nig) / gsz; return true;
    }
    __device__ __forceinline__ void a_ready(const Unit&) const {}
    __device__ __forceinline__ void done(const Unit&) const {}
};
struct OneUnit : StaticOrder {
    int k;
    __device__ bool next(int i, Unit& u) const { if (i > 0) return false; return StaticOrder::next(k, u); }
};
__device__ __forceinline__ unsigned cvt_pk_bf16(float lo, float hi) { unsigned r; asm volatile("v_cvt_pk_bf16_f32 %0, %1, %2" : "=v"(r) : "v"(lo), "v"(hi)); return r; }
template <class Epi, class Sched, bool STAMP = false>
__device__ __forceinline__ void gemm_phase(PG8_LAS unsigned char* lds, const Gemm g, const Sched& S, const Epi& E, unsigned long long* stamps) {
    const int tid = TIDX, wid = __builtin_amdgcn_readfirstlane(tid >> 6), lane = tid & 63, wr = wid >> 2, wc = wid & 3, fr = lane & 15, fq = lane >> 4;
    const int K = g.K, nt = K / BK;
    int ts_lo = 0, ts_hi = 0, nts = 0; const unsigned long long rt_entry = STAMP ? (unsigned long long)wall_clock64() : 0ull;
#define PG8_STAMP() do { if (STAMP && wid == 0 && nts < 64) { const unsigned long long _c = (unsigned long long)clock64(); \
        ts_lo = (lane == nts) ? (int)(unsigned)_c : ts_lo; ts_hi = (lane == nts) ? (int)(unsigned)(_c >> 32) : ts_hi; ++nts; } } while (0)
    PG8_STAMP();
    unsigned voffA[2], voffB[2];
#pragma unroll
    for (int i = 0; i < 2; ++i) { int R, C; stage_rc(tid * 16 + i * 8192, R, C); const int Rb = Epi::PERM ? ((R & ~31) + perm32(R & 31)) : R;
        voffA[i] = (unsigned)(R * K + C) * 2u; voffB[i] = (unsigned)(Rb * K + C) * 2u; }
    const size_t kstep = (size_t)(BK * 2);
    const size_t hstep = (size_t)HALF * K * 2;
    const size_t tstep = 2 * hstep;
    const unsigned ldsw = (unsigned)wid * 1024u;
    const int aoff = lds_byte(wr * 64 + fr, fq * 8), boff = lds_byte(wc * 32 + fr, fq * 8);
#define PG8_SA(b, h) (((b) * 2 + (h)) * HTB)
#define PG8_SB(b, h) ((4 + (b) * 2 + (h)) * HTB)
#define PG8_STAGE(bufoff, gbase, voff) do { _Pragma("unroll") for (int _i = 0; _i < 2; ++_i) \
        __builtin_amdgcn_global_load_lds((const unsigned*)((const char*)(gbase) + (voff)[_i]), (PG8_LAS unsigned*)(lds + (bufoff) + ldsw + _i * 8192), 16, 0, 0); } while (0)
#define PG8_LDA(dst, b, h) do { _Pragma("unroll") for (int m = 0; m < 4; ++m) _Pragma("unroll") for (int k = 0; k < 2; ++k) dst[m][k] = *(const PG8_LAS bf16x8*)(lds + PG8_SA(b, h) + aoff + m * 2048 + k * 1024); } while (0)
#define PG8_LDB(dst, b, h) do { _Pragma("unroll") for (int n = 0; n < 2; ++n) _Pragma("unroll") for (int k = 0; k < 2; ++k) dst[n][k] = *(const PG8_LAS bf16x8*)(lds + PG8_SB(b, h) + boff + n * 2048 + k * 1024); } while (0)
#define PG8_MMA(ai, bj, At, Bt) do { __builtin_amdgcn_s_setprio(1); _Pragma("unroll") for (int m = 0; m < 4; ++m) _Pragma("unroll") for (int n = 0; n < 2; ++n) _Pragma("unroll") for (int k = 0; k < 2; ++k) \
        acc[ai][bj][m][n] = __builtin_amdgcn_mfma_f32_16x16x32_bf16(Bt[n][k], At[m][k], acc[ai][bj][m][n], 0, 0, 0); __builtin_amdgcn_s_setprio(0); } while (0)
#define PG8_WAIT_V(n) asm volatile("s_waitcnt vmcnt(" #n ")" ::: "memory")
#define PG8_WAIT_L(n) asm volatile("s_waitcnt lgkmcnt(" #n ")" ::: "memory")
#define PG8_BAR __builtin_amdgcn_s_barrier()
#define PG8_SCHED __builtin_amdgcn_sched_barrier(0)
    Unit cur, nxt; int ui = 0;
    if (!S.next(0, cur)) return;
    f32x4 acc[2][2][4][2];
#pragma unroll
    for (int a = 0; a < 2; ++a)
#pragma unroll
        for (int b = 0; b < 2; ++b)
#pragma unroll
            for (int m = 0; m < 4; ++m)
#pragma unroll
                for (int n = 0; n < 2; ++n) acc[a][b][m][n] = (f32x4){0.f, 0.f, 0.f, 0.f};
    bf16x8 At[4][2], B0[2][2], B1[2][2];
    const char* cA = (const char*)g.A + (size_t)cur.pm * tstep; const char* cB = (const char*)g.Bt + (size_t)cur.pn * tstep;
    S.a_ready(cur);
    PG8_STAGE(PG8_SB(0, 0), cB, voffB); PG8_STAGE(PG8_SA(0, 0), cA, voffA); PG8_STAGE(PG8_SB(0, 1), cB + hstep, voffB); PG8_STAGE(PG8_SA(0, 1), cA + hstep, voffA);
    if (wr == 1) PG8_BAR;
    PG8_WAIT_V(4); PG8_BAR;
    PG8_STAGE(PG8_SB(1, 0), cB + kstep, voffB); PG8_STAGE(PG8_SA(1, 0), cA + kstep, voffA); PG8_STAGE(PG8_SB(1, 1), cB + hstep + kstep, voffB);
    PG8_WAIT_V(6); PG8_BAR;
    PG8_STAMP();
    for (;;) {
        const bool has_next = S.next(ui + 1, nxt);
        const char* nA = has_next ? (const char*)g.A + (size_t)nxt.pm * tstep : cA; const char* nB = has_next ? (const char*)g.Bt + (size_t)nxt.pn * tstep : cB;
        for (int t = 0; t < nt; t += 2) {
            const bool last = (t == nt - 2);
            const char* a1 = cA + (size_t)(t + 1) * kstep;
            const char* a2 = last ? nA : cA + (size_t)(t + 2) * kstep; const char* b2 = last ? nB : cB + (size_t)(t + 2) * kstep;
            const char* a3 = a2 + kstep; const char* b3 = b2 + kstep;
            if (last && has_next) S.a_ready(nxt);
            PG8_LDB(B0, 0, 0); PG8_SCHED; PG8_LDA(At, 0, 0); PG8_STAGE(PG8_SA(1, 1), a1 + hstep, voffA);
            PG8_WAIT_L(8); PG8_BAR; PG8_WAIT_L(0); PG8_MMA(0, 0, At, B0); PG8_BAR; PG8_SCHED;
            PG8_LDB(B1, 0, 1); PG8_STAGE(PG8_SB(0, 0), b2, voffB);
            PG8_BAR; PG8_WAIT_L(0); PG8_MMA(0, 1, At, B1); PG8_BAR;
            PG8_LDA(At, 0, 1); PG8_STAGE(PG8_SA(0, 0), a2, voffA);
            PG8_BAR; PG8_WAIT_L(0); PG8_MMA(1, 0, At, B0); PG8_BAR; PG8_SCHED;
            PG8_STAGE(PG8_SB(0, 1), b2 + hstep, voffB);
            PG8_WAIT_V(6); PG8_BAR; PG8_MMA(1, 1, At, B1); PG8_BAR;
            PG8_LDB(B0, 1, 0); PG8_SCHED; PG8_LDA(At, 1, 0); PG8_STAGE(PG8_SA(0, 1), a2 + hstep, voffA);
            PG8_WAIT_L(8); PG8_BAR; PG8_WAIT_L(0); PG8_MMA(0, 0, At, B0); PG8_BAR; PG8_SCHED;
            PG8_LDB(B1, 1, 1); PG8_STAGE(PG8_SB(1, 0), b3, voffB);
            PG8_BAR; PG8_WAIT_L(0); PG8_MMA(0, 1, At, B1); PG8_BAR;
            PG8_LDA(At, 1, 1); PG8_STAGE(PG8_SA(1, 0), a3, voffA);
            PG8_BAR; PG8_WAIT_L(0); PG8_MMA(1, 0, At, B0); PG8_BAR; PG8_SCHED;
            PG8_STAGE(PG8_SB(1, 1), b3 + hstep, voffB);
            PG8_WAIT_V(6); PG8_BAR; PG8_MMA(1, 1, At, B1); PG8_BAR;
        }
        PG8_STAMP();
        if constexpr (!Epi::AFTER_DRAIN) { E(acc, cur, wr, wc, fr, fq); S.done(cur); }
        PG8_STAMP();
        if (!has_next) break;
#pragma unroll
        for (int a = 0; a < 2; ++a)
#pragma unroll
            for (int b = 0; b < 2; ++b)
#pragma unroll
                for (int m = 0; m < 4; ++m)
#pragma unroll
                    for (int n = 0; n < 2; ++n) acc[a][b][m][n] = (f32x4){0.f, 0.f, 0.f, 0.f};
        cur = nxt; cA = nA; cB = nB; ++ui;
    }
    PG8_WAIT_V(0);
    if (wr == 0) PG8_BAR;
    PG8_BAR;
    if constexpr (Epi::AFTER_DRAIN) { E.fused(acc, cur, wr, wc, fr, fq, lds, wid, lane); S.done(cur); }
    PG8_STAMP();
    if (STAMP && wid == 0) { stamps[lane] = lane < nts ? (((unsigned long long)(unsigned)ts_hi << 32) | (unsigned)ts_lo) : 0ull;
        if (lane == 62) stamps[62] = rt_entry; if (lane == 63) stamps[63] = (unsigned long long)wall_clock64(); }
#undef PG8_STAMP
#undef PG8_SA
#undef PG8_SB
#undef PG8_STAGE
#undef PG8_LDA
#undef PG8_LDB
#undef PG8_MMA
#undef PG8_WAIT_V
#undef PG8_WAIT_L
#undef PG8_BAR
#undef PG8_SCHED
}
}

#define XB_TMO      128
#define XB_XCNT(j)  (256  + 64 * (j))
#define XB_XSUB(j)  (1280 + 64 * (j))
#define XB_XGEN(j)  (2304 + 64 * (j))
#define XB_TOP      3328
#define XB_TOPGEN   3392
#define XCD_BAR_WORDS 3456
#define XB_SPIN_CAP (1u << 18)
#define LAS __attribute__((address_space(3)))

__device__ __forceinline__ unsigned xb_ld(unsigned* p)              { return __hip_atomic_load(p, __ATOMIC_RELAXED, __HIP_MEMORY_SCOPE_AGENT); }
__device__ __forceinline__ unsigned xb_add(unsigned* p, unsigned v) { return __hip_atomic_fetch_add(p, v, __ATOMIC_RELAXED, __HIP_MEMORY_SCOPE_AGENT); }
__device__ __forceinline__ unsigned xb_xcc_id() { return (unsigned)__builtin_amdgcn_s_getreg((3 << 11) | 20) & 0xFu; }
#define XB_SPIN(cond, bar) do { unsigned _sp = 0; while (cond) { __builtin_amdgcn_s_sleep(1); \
    if ((++_sp & 255u) == 0u) { if (xb_ld(&(bar)[XB_TMO])) break; if (_sp > XB_SPIN_CAP) { atomicAdd(&(bar)[XB_TMO], 1u); break; } } } } while (0)

struct XcdBarrier {
    unsigned* bar; unsigned x;
    volatile LAS unsigned* st;
};

__device__ __forceinline__ XcdBarrier xcd_barrier_post(unsigned* bar, volatile LAS unsigned* st) {
    XcdBarrier b; b.bar = bar; b.x = xb_xcc_id(); b.st = st;
    if (TIDX == 0) (void)xb_add(&bar[XB_XCNT(b.x)], 1u);
    return b;
}
__device__ __forceinline__ void xcd_barrier_complete(unsigned* bar, unsigned x, unsigned& nloc, unsigned& nx) {
    const unsigned G = gridDim.x * gridDim.y * gridDim.z;
    unsigned sum, cnt, mine, sp = 0u;
    for (;;) {
        sum = 0u; cnt = 0u; mine = 0u;
#pragma unroll
        for (unsigned j = 0; j < 16; ++j) { const unsigned c = xb_ld(&bar[XB_XCNT(j)]); sum += c; cnt += (c > 0u) ? 1u : 0u; mine = (j == x) ? c : mine; }
        if (sum == G) break;
        __builtin_amdgcn_s_sleep(1);
        if ((++sp & 255u) == 0u) { if (xb_ld(&bar[XB_TMO])) break; if (sp > XB_SPIN_CAP) { atomicAdd(&bar[XB_TMO], 1u); break; } }
    }
    nloc = mine > 0u ? mine : 1u; nx = cnt > 0u ? cnt : 1u;
}

__device__ __forceinline__ void xcd_barrier(const XcdBarrier& b) {
    asm volatile("s_waitcnt vmcnt(0)" ::: "memory");
    __syncthreads();
    if (TIDX == 0) {
        unsigned* bar = b.bar;
        __builtin_amdgcn_s_waitcnt(0);
        unsigned nloc = b.st[0], nx = b.st[1];
        if (nloc == 0u) { xcd_barrier_complete(bar, b.x, nloc, nx); b.st[0] = nloc; b.st[1] = nx; }
        const unsigned old = xb_add(&bar[XB_XSUB(b.x)], 1u);
        const unsigned gen = old / nloc;
        if (old + 1u == (gen + 1u) * nloc) {
            __builtin_amdgcn_fence(__ATOMIC_RELEASE, "agent");
            asm volatile("s_waitcnt vmcnt(0)" ::: "memory");
            const unsigned og = xb_add(&bar[XB_TOP], 1u);
            const unsigned tg = og / nx;
            if (og + 1u == (tg + 1u) * nx) xb_add(&bar[XB_TOPGEN], 1u);
            else XB_SPIN(xb_ld(&bar[XB_TOPGEN]) == tg, bar);
            __builtin_amdgcn_fence(__ATOMIC_ACQUIRE, "agent");
            xb_add(&bar[XB_XGEN(b.x)], 1u);
            asm volatile("s_waitcnt vmcnt(0)" ::: "memory");
        } else {
            XB_SPIN(xb_ld(&bar[XB_XGEN(b.x)]) == gen, bar);
            __builtin_amdgcn_fence(__ATOMIC_ACQUIRE, "agent");
            asm volatile("s_waitcnt vmcnt(0)" ::: "memory");
        }
    }
    __syncthreads();
}

__device__ void d_cvt(const float* __restrict__ in, bf16_t* __restrict__ out, size_t n4) {
  const size_t stride = (size_t)gridDim.x * blockDim.x;
  size_t i = (size_t)blockIdx.x * blockDim.x + TIDX;
  for (; i + 3 * stride < n4; i += 4 * stride) {
    f32x4 v[4];
#pragma unroll
    for (int q = 0; q < 4; ++q) v[q] = ((const f32x4*)in)[i + q * stride];
#pragma unroll
    for (int q = 0; q < 4; ++q) { u32x2 o = {pack2(v[q][0], v[q][1]), pack2(v[q][2], v[q][3])}; ((u32x2*)out)[i + q * stride] = o; }
  }
  for (; i < n4; i += stride) { const f32x4 v = ((const f32x4*)in)[i]; u32x2 o = {pack2(v[0], v[1]), pack2(v[2], v[3])}; ((u32x2*)out)[i] = o; }
}
__device__ void d_cvtT64(int vb, char* smem, const float* __restrict__ W, bf16_t* __restrict__ WT, int K, int N, int NP) {
  float (*tt)[65] = (float (*)[65])smem;
  const int tid = (TIDX & 255);
  const int nbx = NP / 64;
  const int n0 = (vb % nbx) * 64, k0 = (vb / nbx) * 64;
  {
    const int kr = tid >> 4, nc = (tid & 15) * 4;
#pragma unroll
    for (int i = 0; i < 4; ++i) {
      const int k = k0 + kr + 16 * i, n = n0 + nc;
      f32x4 v = {0.f, 0.f, 0.f, 0.f};
      if (n < N) v = *(const f32x4*)(W + (size_t)k * N + n);
      tt[kr + 16 * i][nc] = v[0]; tt[kr + 16 * i][nc + 1] = v[1]; tt[kr + 16 * i][nc + 2] = v[2]; tt[kr + 16 * i][nc + 3] = v[3];
    }
  }
  __syncthreads();
  {
    const int nr = tid >> 3, kc = (tid & 7) * 8;
#pragma unroll
    for (int i = 0; i < 2; ++i) {
      const int nl = nr + 32 * i;
      u32x4 o = {pack2(tt[kc][nl], tt[kc + 1][nl]), pack2(tt[kc + 2][nl], tt[kc + 3][nl]), pack2(tt[kc + 4][nl], tt[kc + 5][nl]), pack2(tt[kc + 6][nl], tt[kc + 7][nl])};
      *(u32x4*)(WT + (size_t)(n0 + nl) * K + k0 + kc) = o;
    }
  }
  __syncthreads();
}

using f32x16 = __attribute__((ext_vector_type(16))) float;
using bf16x8v = __attribute__((ext_vector_type(8))) __bf16;
#define MFMA32(a, b, c) __builtin_amdgcn_mfma_f32_32x32x16_bf16((a), (b), (c), 0, 0, 0)
constexpr float LOG2E = 1.4426950408889634f;
constexpr float NEGB = -1e30f;
DI int pi_perm(int i) { return (i & ~12) | ((i & 8) >> 1) | ((i & 4) << 1); }
DI bf16x8 pack8(float a0, float a1, float a2, float a3, float a4, float a5, float a6, float a7) {
  bf16x8v v = {(__bf16)a0, (__bf16)a1, (__bf16)a2, (__bf16)a3, (__bf16)a4, (__bf16)a5, (__bf16)a6, (__bf16)a7};
  return __builtin_bit_cast(bf16x8, v);
}
__device__ __forceinline__ void d_relayout_tile(int T, char* smem, const bf16_t* __restrict__ proj, int col0, bf16_t* __restrict__ dst, bool isV) {
  bf16_t* Ls = (bf16_t*)smem;
  const int tid = TIDX;
#pragma unroll
  for (int q = 0; q < 2; ++q) {
    const int cidx = tid + q * 512;
    const int g = cidx >> 9, tok = (cidx >> 4) & 31, ch = cidx & 15;
    const u32x4 v = *(const u32x4*)(proj + (size_t)(32 * T + tok) * INWP + col0 + g * 128 + ch * 8);
    *(u32x4*)(Ls + (g * 32 + tok) * 136 + ch * 8) = v;
  }
  __syncthreads();
#pragma unroll
  for (int q = 0; q < 2; ++q) {
    const int oc = tid + q * 512;
    const int g = oc >> 9, r9 = oc & 511, lane = r9 & 63;
    u32x4 o;
    if (!isV) {
      const int s8 = r9 >> 6, i = lane & 31, h = lane >> 5;
      o = *(const u32x4*)(Ls + (g * 32 + pi_perm(i)) * 136 + 16 * s8 + 8 * h);
    } else {
      const int s2 = (r9 >> 6) & 1, dt = r9 >> 7, dd = lane & 31, h = lane >> 5;
      const bf16_t* col = Ls + (g * 32 + 16 * s2 + 8 * h) * 136 + 32 * dt + dd;
      unsigned short e[8];
#pragma unroll
      for (int j = 0; j < 8; ++j) e[j] = col[j * 136];
      o.x = e[0] | ((unsigned)e[1] << 16); o.y = e[2] | ((unsigned)e[3] << 16); o.z = e[4] | ((unsigned)e[5] << 16); o.w = e[6] | ((unsigned)e[7] << 16);
    }
    *(u32x4*)(dst + (((size_t)(g * 512 + T)) * 512 + r9) * 8) = o;
  }
  __syncthreads();
}

struct AttnPtrs {
  const bf16_t* proj; const float* gates;
  const bf16_t *kcf, *vcf, *ksf, *vsf, *kwf, *vwf;
  bf16_t* mix; const float* hng;
};

DI float ex2(float x) { return __builtin_amdgcn_exp2f(x); }
DI void halves(float x, float& lo, float& hi) {
  const unsigned u = __float_as_uint(x);
  auto r = __builtin_amdgcn_permlane32_swap(u, u, false, false);
  lo = __uint_as_float(r[0]); hi = __uint_as_float(r[1]);
}
DI float hmax(float x) { float a, b; halves(x, a, b); return fmaxf(a, b); }
DI float hsum(float x) { float a, b; halves(x, a, b); return a + b; }
DI float dpp_quad(float v, int ctrl_is_xor1) {
  const int iv = __float_as_int(v);
  const int r = ctrl_is_xor1 ? __builtin_amdgcn_update_dpp(iv, iv, 0xB1, 0xF, 0xF, false) : __builtin_amdgcn_update_dpp(iv, iv, 0x4E, 0xF, 0xF, false);
  return __int_as_float(r);
}
DI float quad_sum(float v) { v += dpp_quad(v, 1); v += dpp_quad(v, 0); return v; }
DI void osm_step(const float (&sv)[16], float& m, float& l, f32x16 (&O)[4], float (&p)[16]) {
  float tmax = fmaxf(fmaxf(fmaxf(sv[0], sv[1]), fmaxf(sv[2], sv[3])), fmaxf(fmaxf(sv[4], sv[5]), fmaxf(sv[6], sv[7])));
  tmax = fmaxf(tmax, fmaxf(fmaxf(fmaxf(sv[8], sv[9]), fmaxf(sv[10], sv[11])), fmaxf(fmaxf(sv[12], sv[13]), fmaxf(sv[14], sv[15]))));
  tmax = hmax(tmax);
  if (__ballot(tmax - m > 8.f)) {
    const float mn = fmaxf(m, tmax);
    const float alpha = ex2(m - mn);
    l *= alpha; m = mn;
#pragma unroll
    for (int dt = 0; dt < 4; ++dt)
#pragma unroll
      for (int r = 0; r < 16; ++r) O[dt][r] *= alpha;
  }
  float ps0 = 0.f, ps1 = 0.f;
#pragma unroll
  for (int r = 0; r < 16; r += 2) { const float e0 = ex2(sv[r] - m), e1 = ex2(sv[r + 1] - m); p[r] = e0; p[r + 1] = e1; ps0 += e0; ps1 += e1; }
  l += ps0 + ps1;
}
DI void ot_store(char* otL, int lane, const f32x16 (&O)[4], float sc) {
#pragma unroll
  for (int dt = 0; dt < 4; ++dt) {
    u32x4 a, b;
#pragma unroll
    for (int i = 0; i < 4; ++i) { a[i] = pack2(sc * O[dt][2 * i], sc * O[dt][2 * i + 1]); b[i] = pack2(sc * O[dt][8 + 2 * i], sc * O[dt][8 + 2 * i + 1]); }
    *(u32x4*)(otL + lane * 128 + dt * 32) = a;
    *(u32x4*)(otL + lane * 128 + dt * 32 + 16) = b;
  }
}
DI void ot_accum(const char* otL, int lane, f32x16 (&O)[4], float sc) {
#pragma unroll
  for (int dt = 0; dt < 4; ++dt) {
    u32x4 a = *(const u32x4*)(otL + lane * 128 + dt * 32);
    u32x4 b = *(const u32x4*)(otL + lane * 128 + dt * 32 + 16);
#pragma unroll
    for (int i = 0; i < 4; ++i) {
      const unsigned wa = a[i], wb = b[i];
      O[dt][2 * i] = fmaf(sc, O[dt][2 * i], __uint_as_float(wa << 16));
      O[dt][2 * i + 1] = fmaf(sc, O[dt][2 * i + 1], __uint_as_float(wa & 0xFFFF0000u));
      O[dt][8 + 2 * i] = fmaf(sc, O[dt][8 + 2 * i], __uint_as_float(wb << 16));
      O[dt][8 + 2 * i + 1] = fmaf(sc, O[dt][8 + 2 * i + 1], __uint_as_float(wb & 0xFFFF0000u));
    }
  }
}
DI void zero_o(f32x16 (&O)[4]) {
#pragma unroll
  for (int dt = 0; dt < 4; ++dt)
#pragma unroll
    for (int i = 0; i < 16; ++i) O[dt][i] = 0.f;
}

constexpr int ATT_PW = 8704;
constexpr int ATT_R = 4, ATT_D = 3;
constexpr int ATT_RING = 8 * ATT_PW;
constexpr int ATT_LIST = ATT_RING + ATT_R * 16384;
constexpr int ATT_BUNI = ATT_LIST + 2048;
constexpr int ATT_SMEM = ATT_BUNI + 64;
#define LAS3 __attribute__((address_space(3)))
__device__ __forceinline__ void d_select(const float* impL, unsigned* mskL, unsigned* uniL, int cur) {
  const int lane = TIDX & 63;
  const int stok = lane >> 3, sub = lane & 7;
  unsigned key[32];
#pragma unroll
  for (int i4 = 0; i4 < 8; ++i4) {
    f32x4 v = *(const f32x4*)(impL + stok * 256 + sub * 32 + i4 * 4);
#pragma unroll
    for (int e = 0; e < 4; ++e) {
      const int j = sub * 32 + i4 * 4 + e;
      const bool valid = j <= cur;
      const bool forced = (j == 0) || (j == cur) || (j == cur - 1);
      unsigned kb = forced ? 0xFFFFFF00u : (__float_as_uint(v[e]) & 0xFFFFFF00u);
      key[i4 * 4 + e] = valid ? (kb | (unsigned)(255 - j)) : 0u;
    }
  }
#pragma unroll
  for (int k = 2; k <= 32; k <<= 1) {
#pragma unroll
    for (int jj = k >> 1; jj > 0; jj >>= 1) {
#pragma unroll
      for (int i = 0; i < 32; ++i) {
        const int l2 = i ^ jj;
        if (l2 > i) {
          const bool desc = ((i & k) == 0);
          unsigned a = key[i], b = key[l2];
          unsigned mx = a > b ? a : b, mn = a > b ? b : a;
          key[i] = desc ? mx : mn; key[l2] = desc ? mn : mx;
        }
      }
    }
  }
#pragma unroll
  for (int xm = 1; xm < 8; xm <<= 1) {
    unsigned L[16];
#pragma unroll
    for (int i = 0; i < 16; ++i) { unsigned o = (unsigned)shx_i((int)key[15 - i], xm); L[i] = key[i] > o ? key[i] : o; }
#pragma unroll
    for (int jj = 8; jj > 0; jj >>= 1) {
#pragma unroll
      for (int i = 0; i < 16; ++i) {
        const int l2 = i ^ jj;
        if (l2 > i) { unsigned a = L[i], b = L[l2]; L[i] = a > b ? a : b; L[l2] = a > b ? b : a; }
      }
    }
#pragma unroll
    for (int i = 0; i < 16; ++i) key[i] = L[i];
  }
#pragma unroll
  for (int i = 0; i < 16; ++i) {
    if ((i & 7) == sub) {
      const int j = 255 - (int)(key[i] & 255u);
      if (j <= cur) { atomicOr(&mskL[stok * 8 + (j >> 5)], 1u << (j & 31)); atomicOr(&uniL[j >> 5], 1u << (j & 31)); }
    }
  }
}


DI void att_issue(LAS3 unsigned char* ring, int slot, int w, int lane, const bf16_t* kb, const bf16_t* vb, int tile) {
  const char* ks = (const char*)kb + (size_t)tile * 8192 + w * 1024 + lane * 16;
  const char* vs = (const char*)vb + (size_t)tile * 8192 + w * 1024 + lane * 16;
  __builtin_amdgcn_global_load_lds((const unsigned*)ks, (LAS3 unsigned*)(ring + slot * 16384 + w * 1024), 16, 0, 0);
  __builtin_amdgcn_global_load_lds((const unsigned*)vs, (LAS3 unsigned*)(ring + slot * 16384 + 8192 + w * 1024), 16, 0, 0);
}
DI f32x16 qk_lds(LAS3 const unsigned char* kt, const bf16x8 (&qf)[8], int lane) {
  f32x16 acc;
#pragma unroll
  for (int i = 0; i < 16; ++i) acc[i] = 0.f;
#pragma unroll
  for (int s8 = 0; s8 < 8; ++s8) {
    const bf16x8 kf = *(LAS3 const bf16x8*)(kt + s8 * 1024 + lane * 16);
    acc = MFMA32(kf, qf[s8], acc);
  }
  return acc;
}
DI void pv_lds(LAS3 const unsigned char* vt, const float (&p)[16], f32x16 (&O)[4], int lane) {
  const bf16x8 pf0 = pack8(p[0], p[1], p[2], p[3], p[4], p[5], p[6], p[7]);
  const bf16x8 pf1 = pack8(p[8], p[9], p[10], p[11], p[12], p[13], p[14], p[15]);
#pragma unroll
  for (int dt = 0; dt < 4; ++dt) {
    const bf16x8 v0 = *(LAS3 const bf16x8*)(vt + (dt * 2) * 1024 + lane * 16);
    const bf16x8 v1 = *(LAS3 const bf16x8*)(vt + (dt * 2 + 1) * 1024 + lane * 16);
    O[dt] = MFMA32(v0, pf0, O[dt]);
    O[dt] = MFMA32(v1, pf1, O[dt]);
  }
}

__device__ __forceinline__ void d_attn_block(int B, int g, char* smem, const AttnPtrs& P) {
  const int tid = TIDX, lane = tid & 63, w = tid >> 6;
  const int c = lane & 31, h = lane >> 5, tokl = c >> 2, r = c & 3;
  const int tok0 = 64 * B + 8 * w;
  const int t = tok0 + tokl, hd = g * 4 + r;
  const float slope2 = exp2f(-(float)(hd + 1)) * LOG2E;
  const float c1 = QSCALE * LOG2E;
  const float ninf = -__builtin_inff();
  char* wsm = smem + w * ATT_PW;
  float* impL = (float*)wsm;
  char* otL = wsm;
  unsigned* mskL = (unsigned*)(wsm + 8192);
  unsigned* uniL = mskL + 64;
  LAS3 unsigned char* ring = (LAS3 unsigned char*)(smem + ATT_RING);
  unsigned short* tl = (unsigned short*)(smem + ATT_LIST);
  unsigned* buni = (unsigned*)(smem + ATT_BUNI);
  const bf16_t* kcf = P.kcf + (size_t)g * 32 * 4096;
  const bf16_t* vcf = P.vcf + (size_t)g * 32 * 4096;
  const bf16_t* ksf = P.ksf + (size_t)g * 512 * 4096;
  const bf16_t* vsf = P.vsf + (size_t)g * 512 * 4096;
  const bf16_t* kwf = P.kwf + (size_t)g * 512 * 4096;
  const bf16_t* vwf = P.vwf + (size_t)g * 512 * 4096;
  bf16x8 qf[8];
  {
    const bf16_t* qrow = P.proj + (size_t)t * INWP + OFF_Q + hd * 128 + 8 * h;
#pragma unroll
    for (int s8 = 0; s8 < 8; ++s8) qf[s8] = *(const bf16x8*)(qrow + 16 * s8);
  }
  const float* gt = P.gates + (size_t)t * 24 + hd * 3;
  const float g0 = gt[0], g1 = gt[1], g2 = gt[2];
  {
    unsigned z0 = 0u;
    asm volatile("" : "+v"(z0));
    u32x4 z = {z0, z0, z0, z0};
#pragma unroll
    for (int i = 0; i < 8; ++i) *(u32x4*)(wsm + (i * 64 + lane) * 16) = z;
    if (lane < 18) *(u32x4*)(wsm + 8192 + lane * 16) = z;
    if (tid < 8) buni[tid] = z0;
  }
  f32x16 Ob[4];
  zero_o(Ob);
  const int nmax = (t >= 31) ? ((t - 31) >> 4) : -1;
  const int nmaxw = (tok0 + 7 >= 31) ? ((tok0 + 7 - 31) >> 4) : -1;
  const int nminw = (tok0 >= 31) ? ((tok0 - 31) >> 4) : -1;
  const int ntcw = (nmaxw + 32) >> 5;
  const int ntcB = (((64 * B + 63 - 31) >> 4) + 32) >> 5;
  const float sl16 = slope2 * 16.f;
  float mC = NEGB, lC = 0.f, invC = 0.f, carry = 0.f;
  {
    const int n = 2 * ntcB;
    asm volatile("s_waitcnt vmcnt(0)" ::: "memory");
#define A_TILE(i_) (((i_) < ntcB) ? (ntcB - 1 - (i_)) : ((i_) - ntcB))
    att_issue(ring, 0, w, lane, kcf, vcf, A_TILE(0));
    if (n > 1) att_issue(ring, 1, w, lane, kcf, vcf, A_TILE(1));
#pragma unroll 1
    for (int i = 0; i < n; ++i) {
      if ((i & 1) == 0) {
        asm volatile("s_waitcnt vmcnt(0)" ::: "memory");
        __builtin_amdgcn_s_barrier();
        asm volatile("" ::: "memory");
        if (i + 2 < n) att_issue(ring, (i + 2) & 3, w, lane, kcf, vcf, A_TILE(i + 2));
        if (i + 3 < n) att_issue(ring, (i + 3) & 3, w, lane, kcf, vcf, A_TILE(i + 3));
      }
      const int T = A_TILE(i);
      if (T >= ntcw) continue;
      LAS3 const unsigned char* slot = ring + (i % ATT_R) * 16384;
      const f32x16 acc = qk_lds(slot, qf, lane);
      const float base = slope2 * (float)(512 * T + 128 * h) + slope2 * (15.5f - (float)t);
      const int nb = 32 * T + 8 * h;
      const bool full = (32 * T + 31 <= nminw);
      float sv[16];
#pragma unroll
      for (int rg = 0; rg < 16; ++rg) { const int kk = (rg & 7) + 16 * (rg >> 3); sv[rg] = fmaf(acc[rg], c1, fmaf(sl16, (float)kk, base)); }
      if (!full) {
#pragma unroll
        for (int rg = 0; rg < 16; ++rg) { const int kk = (rg & 7) + 16 * (rg >> 3); sv[rg] = (nb + kk <= nmax) ? sv[rg] : ninf; }
      }
      if (i < ntcB) {
        float tmax = fmaxf(fmaxf(fmaxf(sv[0], sv[1]), fmaxf(sv[2], sv[3])), fmaxf(fmaxf(sv[4], sv[5]), fmaxf(sv[6], sv[7])));
        tmax = fmaxf(tmax, fmaxf(fmaxf(fmaxf(sv[8], sv[9]), fmaxf(sv[10], sv[11])), fmaxf(fmaxf(sv[12], sv[13]), fmaxf(sv[14], sv[15]))));
        tmax = hmax(tmax);
        const float mn = fmaxf(mC, tmax);
        float ps = 0.f;
#pragma unroll
        for (int rg = 0; rg < 16; ++rg) ps += ex2(sv[rg] - mn);
        lC = lC * ex2(mC - mn) + ps; mC = mn;
      } else {
        if (T == 0) { lC = hsum(lC); invC = (lC > 0.f) ? 1.f / lC : 0.f; }
        float p[16];
#pragma unroll
        for (int rg = 0; rg < 16; ++rg) p[rg] = ex2(sv[rg] - mC) * invC;
        float Ga = (p[0] + p[1]) + (p[2] + p[3]), Gb = (p[4] + p[5]) + (p[6] + p[7]);
        float Gc = (p[8] + p[9]) + (p[10] + p[11]), Gd = (p[12] + p[13]) + (p[14] + p[15]);
        float xb, xd; { float a_, b_; halves(p[7], a_, b_); xb = h ? a_ : b_; halves(p[15], a_, b_); xd = h ? a_ : b_; }
        float ia = Ga + (h ? xb : carry);
        float ib = Gb + p[3];
        float ic = Gc + (h ? xd : xb);
        float id = Gd + p[11];
        carry = xd;
        ia = quad_sum(ia); ib = quad_sum(ib); ic = quad_sum(ic); id = quad_sum(id);
        {
          float val = (r == 0) ? ia : (r == 1) ? ib : (r == 2) ? ic : id;
          int j = 8 * T + 2 * h + ((r == 0) ? 0 : (r == 1) ? 1 : (r == 2) ? 4 : 5);
          impL[tokl * 256 + j] = val;
        }
        pv_lds(slot + 8192, p, Ob, lane);
      }
    }
#undef A_TILE
  }
  const int cur = B;
  d_select(impL, mskL, uniL, cur);
  ot_store(otL, lane, Ob, g0);
  zero_o(Ob);
  if (lane < 8) { const unsigned u = uniL[lane]; if (u) atomicOr(&buni[lane], u); }
  __syncthreads();
  int nslc = 0, ntl = 0;
  {
    for (int iw = 7; iw >= 0; --iw) {
      unsigned iuw = __builtin_amdgcn_readfirstlane(buni[iw]);
      while (iuw) {
        const int bit = 31 - __builtin_clz(iuw);
        iuw &= ~(1u << bit);
        const int bb = 32 * iw + bit;
        if (bb < B) { if (lane == 0) tl[ntl] = (unsigned short)(2 * bb + 1); ++ntl; }
        else { if (lane == 0) tl[ntl] = (unsigned short)(2 * bb + 1); ++ntl; }
        if (lane == 0) tl[ntl] = (unsigned short)(2 * bb);
        ++ntl;
      }
    }
    nslc = ntl;
    const int ThiB = 2 * B + 1, TloB = ((64 * B - 511 > 0) ? (64 * B - 511) : 0) >> 5;
    for (int T = ThiB; T >= TloB; --T) { if (lane == 0) tl[ntl] = (unsigned short)T; ++ntl; }
  }
  float m = NEGB, l = 0.f;
  {
    const int n = ntl;
    const int Tlow = ((tok0 - 511 > 0) ? (tok0 - 511) : 0) >> 5, Thiw = (tok0 + 7) >> 5;
#define B_ISSUE(j_, slot_) { const int e_ = __builtin_amdgcn_readfirstlane((int)tl[j_]); if ((j_) < nslc) att_issue(ring, slot_, w, lane, ksf, vsf, e_); else att_issue(ring, slot_, w, lane, kwf, vwf, e_); }
    B_ISSUE(0, 0)
    if (n > 1) B_ISSUE(1, 1)
#pragma unroll 1
    for (int i = 0; i < n; ++i) {
      if ((i & 1) == 0) {
        asm volatile("s_waitcnt vmcnt(0)" ::: "memory");
        __builtin_amdgcn_s_barrier();
        asm volatile("" ::: "memory");
        if (i + 2 < n) B_ISSUE(i + 2, (i + 2) & 3)
        if (i + 3 < n) B_ISSUE(i + 3, (i + 3) & 3)
      }
      if (i == nslc) {
        l = hsum(l);
        const float inv = (l > 0.f) ? g1 / l : 0.f;
        ot_accum(otL, lane, Ob, inv);
        ot_store(otL, lane, Ob, 1.f);
        zero_o(Ob);
        m = NEGB; l = 0.f;
      }
      const int T = __builtin_amdgcn_readfirstlane((int)tl[i]);
      const int pos0 = 32 * T, pb = pos0 + 8 * h;
      bool full; bool mine = true;
      if (i < nslc) {
        const int bb = T >> 1;
        const unsigned uw = __builtin_amdgcn_readfirstlane(uniL[bb >> 5]);
        if (!((uw >> (bb & 31)) & 1u) || pos0 > tok0 + 7) continue;
        mine = (mskL[tokl * 8 + (bb >> 5)] >> (bb & 31)) & 1u;
        full = (pos0 + 31 <= tok0) && (__ballot(!mine) == 0ull);
      } else {
        if (T < Tlow || T > Thiw) continue;
        full = (pos0 + 31 <= tok0) && (pos0 >= tok0 + 7 - 511);
      }
      LAS3 const unsigned char* slot = ring + (i % ATT_R) * 16384;
      const f32x16 acc = qk_lds(slot, qf, lane);
      const float base = slope2 * (float)(pos0 + 8 * h - t);
      float sv[16], p[16];
#pragma unroll
      for (int rg = 0; rg < 16; ++rg) { const int kk = (rg & 7) + 16 * (rg >> 3); sv[rg] = fmaf(acc[rg], c1, fmaf(slope2, (float)kk, base)); }
      if (!full) {
        if (i < nslc) {
#pragma unroll
          for (int rg = 0; rg < 16; ++rg) { const int kk = (rg & 7) + 16 * (rg >> 3); sv[rg] = (mine && (pb + kk <= t)) ? sv[rg] : ninf; }
        } else {
#pragma unroll
          for (int rg = 0; rg < 16; ++rg) { const int kk = (rg & 7) + 16 * (rg >> 3); const int dw = t - (pb + kk); sv[rg] = ((dw >= 0) && (dw < 512)) ? sv[rg] : ninf; }
        }
      }
      osm_step(sv, m, l, Ob, p);
      pv_lds(slot + 8192, p, Ob, lane);
    }
#undef B_ISSUE
    l = hsum(l);
    const float inv = (l > 0.f) ? g2 / l : 0.f;
    ot_accum(otL, lane, Ob, inv);
  }
  {
    float ss = 0.f;
#pragma unroll
    for (int dt = 0; dt < 4; ++dt)
#pragma unroll
      for (int i = 0; i < 16; ++i) ss = fmaf(Ob[dt][i], Ob[dt][i], ss);
    ss = hsum(ss);
    const float rs = rsqrtf(ss * (1.f / 128.f) + 1e-6f);
    bf16_t* orow = P.mix + (size_t)t * DM + hd * 128 + 4 * h;
    const float* grow = P.hng + hd * 128 + 4 * h;
#pragma unroll
    for (int dt = 0; dt < 4; ++dt)
#pragma unroll
      for (int a = 0; a < 4; ++a) {
        const f32x4 gv = *(const f32x4*)(grow + 32 * dt + 8 * a);
        u32x2 wv2 = {pack2(Ob[dt][4 * a] * rs * gv[0], Ob[dt][4 * a + 1] * rs * gv[1]), pack2(Ob[dt][4 * a + 2] * rs * gv[2], Ob[dt][4 * a + 3] * rs * gv[3])};
        *(u32x2*)(orow + 32 * dt + 8 * a) = wv2;
      }
  }
  asm volatile("s_waitcnt vmcnt(0)" ::: "memory");
  __syncthreads();
}

__device__ void d_convmix(int t, int tl, const bf16_t* __restrict__ proj, const float* __restrict__ convw, const float* __restrict__ hng,
                          bf16_t* __restrict__ mix) {
  const int c = tl * 8;
  float acc[8];
#pragma unroll
  for (int i = 0; i < 8; ++i) acc[i] = 0.f;
#pragma unroll
  for (int j = 0; j < 3; ++j) {
    const int tt = t - 2 + j;
    if (tt >= 0) {
      const u32x4 cu = *(const u32x4*)(proj + (size_t)tt * INWP + OFF_C + c);
      const u32x4 uu = *(const u32x4*)(proj + (size_t)tt * INWP + OFF_U + c);
      const f32x4 w0 = *(const f32x4*)(convw + j * 1024 + c), w1 = *(const f32x4*)(convw + j * 1024 + c + 4);
#pragma unroll
      for (int i = 0; i < 4; ++i) {
        const unsigned a = cu[i], b = uu[i];
        const float wl = (i < 2) ? w0[2 * i] : w1[2 * i - 4], wh = (i < 2) ? w0[2 * i + 1] : w1[2 * i - 3];
        acc[2 * i] = fmaf(wl * __uint_as_float(a << 16), __uint_as_float(b << 16), acc[2 * i]);
        acc[2 * i + 1] = fmaf(wh * __uint_as_float(a & 0xFFFF0000u), __uint_as_float(b & 0xFFFF0000u), acc[2 * i + 1]);
      }
    }
  }
  const u32x4 bb = *(const u32x4*)(proj + (size_t)t * INWP + OFF_B + c);
  float ss = 0.f;
#pragma unroll
  for (int i = 0; i < 4; ++i) {
    const unsigned b = bb[i];
    acc[2 * i] *= __uint_as_float(b << 16); acc[2 * i + 1] *= __uint_as_float(b & 0xFFFF0000u);
    ss = fmaf(acc[2 * i], acc[2 * i], ss); ss = fmaf(acc[2 * i + 1], acc[2 * i + 1], ss);
  }
  ss += shx(ss, 8); ss += shx(ss, 4); ss += shx(ss, 2); ss += shx(ss, 1);
  const float rs = rsqrtf(ss * (1.f / 128.f) + 1e-6f);
  const f32x4 g0 = *(const f32x4*)(hng + 1024 + c), g1 = *(const f32x4*)(hng + 1024 + c + 4);
  u32x4 o = {pack2(acc[0] * rs * g0[0], acc[1] * rs * g0[1]), pack2(acc[2] * rs * g0[2], acc[3] * rs * g0[3]),
             pack2(acc[4] * rs * g1[0], acc[5] * rs * g1[1]), pack2(acc[6] * rs * g1[2], acc[7] * rs * g1[3])};
  *(u32x4*)(mix + (size_t)t * DM + 1024 + c) = o;
}

__device__ void d_ln_wave(int t, bf16_t* __restrict__ yh, const float* __restrict__ gam, const float* __restrict__ bet) {
  const int lane = TIDX & 63;
  float v[32];
#pragma unroll
  for (int i = 0; i < 4; ++i) {
    const u32x4 w = *(const u32x4*)(yh + (size_t)t * DM + 512 * i + 8 * lane);
#pragma unroll
    for (int j = 0; j < 4; ++j) { const unsigned ww = w[j]; v[i * 8 + 2 * j] = __uint_as_float(ww << 16); v[i * 8 + 2 * j + 1] = __uint_as_float(ww & 0xFFFF0000u); }
  }
  float s = 0.f;
#pragma unroll
  for (int i = 0; i < 32; ++i) s += v[i];
  s = wave_sum(s);
  const float mu = s * (1.f / DM);
  float q = 0.f;
#pragma unroll
  for (int i = 0; i < 32; ++i) { const float d = v[i] - mu; q = fmaf(d, d, q); }
  q = wave_sum(q);
  const float rs = rsqrtf(q * (1.f / DM) + 1e-5f);
#pragma unroll
  for (int i = 0; i < 4; ++i) {
    const int cb = 512 * i + 8 * lane;
    const f32x4 g0 = *(const f32x4*)(gam + cb), g1 = *(const f32x4*)(gam + cb + 4), b0 = *(const f32x4*)(bet + cb), b1 = *(const f32x4*)(bet + cb + 4);
    u32x4 o = {pack2((v[i * 8 + 0] - mu) * rs * g0[0] + b0[0], (v[i * 8 + 1] - mu) * rs * g0[1] + b0[1]), pack2((v[i * 8 + 2] - mu) * rs * g0[2] + b0[2], (v[i * 8 + 3] - mu) * rs * g0[3] + b0[3]),
               pack2((v[i * 8 + 4] - mu) * rs * g1[0] + b1[0], (v[i * 8 + 5] - mu) * rs * g1[1] + b1[1]), pack2((v[i * 8 + 6] - mu) * rs * g1[2] + b1[2], (v[i * 8 + 7] - mu) * rs * g1[3] + b1[3])};
    *(u32x4*)(yh + (size_t)t * DM + cb) = o;
  }
}

__device__ void d_cvt_w1f(size_t c, const float* __restrict__ w1, bf16_t* __restrict__ w1f) {
  const int lane = c & 63, ks = (c >> 6) & 255, ct = c >> 14;
  const int col = lane & 31, h = lane >> 5;
  bf16_t v[8];
#pragma unroll
  for (int j = 0; j < 8; ++j) v[j] = f2bf(w1[(size_t)(16 * ks + 8 * h + j) * 512 + 32 * ct + col]);
  u32x4 o; o.x = v[0] | ((unsigned)v[1] << 16); o.y = v[2] | ((unsigned)v[3] << 16); o.z = v[4] | ((unsigned)v[5] << 16); o.w = v[6] | ((unsigned)v[7] << 16);
  *(u32x4*)(w1f + c * 8) = o;
}
__device__ void d_cvt_w2f(size_t c, const float* __restrict__ w2, bf16_t* __restrict__ w2f) {
  const int lane = c & 63, s = (c >> 6) & 31, ct = c >> 11;
  const int col = lane & 31, h = lane >> 5;
  bf16_t v[8];
#pragma unroll
  for (int j = 0; j < 8; ++j) v[j] = f2bf(w2[(size_t)(16 * s + 8 * h + j) * 128 + 32 * ct + col]);
  u32x4 o; o.x = v[0] | ((unsigned)v[1] << 16); o.y = v[2] | ((unsigned)v[3] << 16); o.z = v[4] | ((unsigned)v[5] << 16); o.w = v[6] | ((unsigned)v[7] << 16);
  *(u32x4*)(w2f + c * 8) = o;
}
__device__ __forceinline__ void d_compress_unit(int rt, char* smem, const bf16_t* __restrict__ proj, int col0, const float* __restrict__ pos,
                                const bf16_t* __restrict__ w1f, const float* __restrict__ b1, const bf16_t* __restrict__ w2f,
                                bf16_t* __restrict__ outf, bool isV) {
  bf16_t* Xs = (bf16_t*)smem;
  bf16_t* Hs = (bf16_t*)(smem + 2 * 8704);
  const int tid = TIDX, lane = tid & 63, w = tid >> 6, c = lane & 31, h = lane >> 5;
  const int R0 = rt * 32;
  const int srow = tid >> 4, sch = tid & 15;
  const int grow = R0 + srow, sn = grow >> 1, sg = grow & 1;
  const bool svalid = grow < 2046;
  const bf16_t* sp = proj + (size_t)(16 * sn) * INWP + col0 + sg * 128 + sch * 8;
  f32x16 acc0, acc1;
#pragma unroll
  for (int i = 0; i < 16; ++i) { acc0[i] = 0.f; acc1[i] = 0.f; }
  u32x4 rx = {0u, 0u, 0u, 0u}; f32x4 rp0, rp1;
#define STAGE_WRITE(buf)                                                                                   \
  {                                                                                                        \
    u32x4 o_;                                                                                              \
    _Pragma("unroll") for (int i = 0; i < 4; ++i) {                                                        \
      const unsigned wv_ = rx[i];                                                                          \
      const float lo = __uint_as_float(wv_ << 16) + ((i < 2) ? rp0[2 * i] : rp1[2 * i - 4]);               \
      const float hi = __uint_as_float(wv_ & 0xFFFF0000u) + ((i < 2) ? rp0[2 * i + 1] : rp1[2 * i - 3]);   \
      o_[i] = pack2(lo, hi);                                                                               \
    }                                                                                                      \
    *(u32x4*)(Xs + (buf) * 4352 + srow * 136 + sch * 8) = o_;                                              \
  }
  if (svalid) rx = *(const u32x4*)(sp);
  rp0 = *(const f32x4*)(pos + sch * 8); rp1 = *(const f32x4*)(pos + sch * 8 + 4);
  STAGE_WRITE(0)
  __syncthreads();
  const bf16_t* wb0 = w1f + ((size_t)(2 * w) * 256 * 64 + lane) * 8;
  const bf16_t* wb1 = w1f + ((size_t)(2 * w + 1) * 256 * 64 + lane) * 8;
  bf16x8 bA[16], bB[16];
#define CMP_LOADB(BUF, L)                                                                      \
  _Pragma("unroll") for (int s8 = 0; s8 < 8; ++s8) {                                           \
    BUF[2 * s8] = *(const bf16x8*)(wb0 + (size_t)(8 * (L) + s8) * 512);                        \
    BUF[2 * s8 + 1] = *(const bf16x8*)(wb1 + (size_t)(8 * (L) + s8) * 512);                    \
  }
#define CMP_CHUNK(BUF, L)                                                                      \
  {                                                                                            \
    if ((L) + 1 < 32) {                                                                        \
      if (svalid) rx = *(const u32x4*)(sp + (size_t)((L) + 1) * INWP);                         \
      rp0 = *(const f32x4*)(pos + ((L) + 1) * 128 + sch * 8); rp1 = *(const f32x4*)(pos + ((L) + 1) * 128 + sch * 8 + 4); \
    }                                                                                          \
    const bf16_t* xa = Xs + ((L) & 1) * 4352 + c * 136 + 8 * h;                                \
    _Pragma("unroll") for (int s8 = 0; s8 < 8; ++s8) {                                         \
      const bf16x8 a = *(const bf16x8*)(xa + 16 * s8);                                         \
      acc0 = MFMA32(a, BUF[2 * s8], acc0);                                                     \
      acc1 = MFMA32(a, BUF[2 * s8 + 1], acc1);                                                 \
    }                                                                                          \
    if ((L) + 1 < 32) STAGE_WRITE(((L) + 1) & 1)                                               \
    __syncthreads();                                                                           \
  }
  CMP_LOADB(bA, 0)
#pragma unroll 1
  for (int l = 0; l < 32; l += 2) {
    CMP_LOADB(bB, l + 1)
    __builtin_amdgcn_sched_barrier(0);
    CMP_CHUNK(bA, l)
    { const int ln = (l + 2 < 32) ? l + 2 : l;
      CMP_LOADB(bA, ln) }
    __builtin_amdgcn_sched_barrier(0);
    CMP_CHUNK(bB, l + 1)
  }
#undef CMP_LOADB
#undef CMP_CHUNK
  {
    const float bb0 = b1[64 * w + c], bb1 = b1[64 * w + 32 + c];
#pragma unroll
    for (int rg = 0; rg < 16; ++rg) {
      const int row = (rg & 3) + 8 * (rg >> 2) + 4 * h;
      Hs[row * 520 + 64 * w + c] = f2bf(gelu_tanh(acc0[rg] + bb0));
      Hs[row * 520 + 64 * w + 32 + c] = f2bf(gelu_tanh(acc1[rg] + bb1));
    }
  }
  __syncthreads();
  if (w < 4) {
    f32x16 o2;
#pragma unroll
    for (int i = 0; i < 16; ++i) o2[i] = 0.f;
    const bf16_t* ha = Hs + c * 520 + 8 * h;
    const bf16_t* wb = w2f + ((size_t)w * 32 * 64 + lane) * 8;
#pragma unroll 8
    for (int s2 = 0; s2 < 32; ++s2) {
      const bf16x8 a = *(const bf16x8*)(ha + 16 * s2);
      const bf16x8 b = *(const bf16x8*)(wb + (size_t)s2 * 512);
      o2 = MFMA32(a, b, o2);
    }
    const int d = 32 * w + c;
#pragma unroll
    for (int rg = 0; rg < 16; ++rg) {
      const int row = R0 + (rg & 3) + 8 * (rg >> 2) + 4 * h;
      const int n = row >> 1, g = row & 1;
      const bf16_t val = (row < 2046) ? f2bf(o2[rg]) : (bf16_t)0;
      const int T = n >> 5, nn = n & 31;
      size_t idx;
      if (!isV) idx = ((((size_t)(g * 32 + T) * 8 + (d >> 4)) * 64 + (pi_perm(nn) + 32 * ((d >> 3) & 1))) * 8 + (d & 7));
      else idx = (((((size_t)(g * 32 + T) * 4 + (d >> 5)) * 2 + (nn >> 4)) * 64 + ((d & 31) + 32 * ((nn >> 3) & 1))) * 8 + (nn & 7));
      outf[idx] = val;
    }
  }
  __syncthreads();
}


DI unsigned f2sort(float f) { unsigned u = __float_as_uint(f); return u ^ ((unsigned)((int)u >> 31) | 0x80000000u); }
DI float sort2f(unsigned k) { unsigned u = (k & 0x80000000u) ? (k ^ 0x80000000u) : ~k; return __uint_as_float(u); }
template <int N>
DI void bitonic_sort_desc(unsigned (&key)[N]) {
#pragma unroll
  for (int k = 2; k <= N; k <<= 1) {
#pragma unroll
    for (int jj = k >> 1; jj > 0; jj >>= 1) {
#pragma unroll
      for (int i = 0; i < N; ++i) {
        const int l2 = i ^ jj;
        if (l2 > i) {
          const bool desc = ((i & k) == 0);
          unsigned a = key[i], b = key[l2];
          unsigned mx = a > b ? a : b, mn = a > b ? b : a;
          key[i] = desc ? mx : mn; key[l2] = desc ? mn : mx;
        }
      }
    }
  }
}
DI void merge_top16(unsigned (&a)[16], const unsigned (&b)[16]) {
#pragma unroll
  for (int i = 0; i < 16; ++i) { unsigned o = b[15 - i]; a[i] = a[i] > o ? a[i] : o; }
#pragma unroll
  for (int jj = 8; jj > 0; jj >>= 1) {
#pragma unroll
    for (int i = 0; i < 16; ++i) {
      const int l2 = i ^ jj;
      if (l2 > i) { unsigned x = a[i], y = a[l2]; a[i] = x > y ? x : y; a[l2] = x > y ? y : x; }
    }
  }
}
__device__ void d_cvt_subk(size_t c, const float* __restrict__ subk, bf16_t* __restrict__ skf) {
  int lane = c & 63, s = (c >> 6) & 7, kt = (c >> 9) & 3, hc = c >> 11;
  int i = lane & 31, h = lane >> 5;
  const float* src = subk + ((size_t)hc * 128 + 32 * kt + i) * 128 + 16 * s + 8 * h;
  bf16_t v[8];
#pragma unroll
  for (int j = 0; j < 8; ++j) v[j] = f2bf(src[j]);
  u32x4 o; o.x = v[0] | ((unsigned)v[1] << 16); o.y = v[2] | ((unsigned)v[3] << 16); o.z = v[4] | ((unsigned)v[5] << 16); o.w = v[6] | ((unsigned)v[7] << 16);
  *(u32x4*)(skf + c * 8) = o;
}

#define EPI_LANES()                                                                                                      \
    const int lane = fr | (fq << 4), rr = lane >> 2, rc = lane & 3;                                                       \
    PG8_LAS unsigned char* my = scr + (wr * 4 + wc) * 2048;                                                              \
    const int wo = fr * 64 + ((fq ^ ((fr >> 2) & 3)) << 4), ro = rr * 64 + ((rc ^ ((rr >> 2) & 3)) << 4);
struct EpiProjG {
  static constexpr bool PERM = true, AFTER_DRAIN = false;
  bf16_t* proj; float* gates; PG8_LAS unsigned char* scr;
  DI void operator()(const f32x4 (&acc)[2][2][4][2], const pg8::Unit& u, int wr, int wc, int fr, int fq) const {
    EPI_LANES()
#pragma unroll
    for (int ai = 0; ai < 2; ++ai)
#pragma unroll
      for (int bj = 0; bj < 2; ++bj) {
        const int c0 = u.pn * 256 + bj * 128 + wc * 32 + 8 * fq, cs = u.pn * 256 + bj * 128 + wc * 32 + 8 * rc;
#pragma unroll
        for (int mh = 0; mh < 2; ++mh) {
#pragma unroll
          for (int mm = 0; mm < 2; ++mm) {
            const f32x4 v0 = acc[ai][bj][mh * 2 + mm][0], v1 = acc[ai][bj][mh * 2 + mm][1];
            u32x4 w = {pack2(v0[0], v0[1]), pack2(v0[2], v0[3]), pack2(v1[0], v1[1]), pack2(v1[2], v1[3])};
            *(PG8_LAS u32x4*)(my + wo + mm * 1024) = w;
            if (c0 >= OFF_G && c0 < OFF_G + 24) {
              const int row = u.pm * 256 + ai * 128 + wr * 64 + (mh * 2 + mm) * 16 + fr;
              f32x4 g0, g1;
#pragma unroll
              for (int j = 0; j < 4; ++j) { g0[j] = 1.f / (1.f + __expf(-v0[j])); g1[j] = 1.f / (1.f + __expf(-v1[j])); }
              *(f32x4*)(gates + (size_t)row * 24 + (c0 - OFF_G)) = g0;
              *(f32x4*)(gates + (size_t)row * 24 + (c0 - OFF_G) + 4) = g1;
            }
          }
#pragma unroll
          for (int j = 0; j < 2; ++j) {
            const u32x4 w = *(const PG8_LAS u32x4*)(my + ro + j * 1024);
            const int row = u.pm * 256 + ai * 128 + wr * 64 + mh * 32 + j * 16 + rr;
            if (cs < INW) *(u32x4*)(proj + (size_t)row * INWP + cs) = w;
          }
        }
      }
  }
};
struct EpiResG {
  static constexpr bool PERM = true, AFTER_DRAIN = false;
  bf16_t* YB; PG8_LAS unsigned char* scr;
  DI void operator()(const f32x4 (&acc)[2][2][4][2], const pg8::Unit& u, int wr, int wc, int fr, int fq) const {
    EPI_LANES()
    bf16_t* yb = YB + (size_t)(u.pm * 256 + wr * 64 + rr) * DM + u.pn * 256 + wc * 32 + 8 * rc;
#pragma unroll
    for (int ai = 0; ai < 2; ++ai) {
      u32x4 xr[2][2][2];
#pragma unroll
      for (int bj = 0; bj < 2; ++bj)
#pragma unroll
        for (int mh = 0; mh < 2; ++mh)
#pragma unroll
          for (int j = 0; j < 2; ++j) xr[bj][mh][j] = *(const u32x4*)(yb + (size_t)(ai * 128 + mh * 32 + j * 16) * DM + bj * 128);
#pragma unroll
      for (int bj = 0; bj < 2; ++bj)
#pragma unroll
        for (int mh = 0; mh < 2; ++mh) {
#pragma unroll
          for (int mm = 0; mm < 2; ++mm) {
            const f32x4 v0 = acc[ai][bj][mh * 2 + mm][0], v1 = acc[ai][bj][mh * 2 + mm][1];
            u32x4 w = {pack2(v0[0], v0[1]), pack2(v0[2], v0[3]), pack2(v1[0], v1[1]), pack2(v1[2], v1[3])};
            *(PG8_LAS u32x4*)(my + wo + mm * 1024) = w;
          }
#pragma unroll
          for (int j = 0; j < 2; ++j) {
            const u32x4 a = *(const PG8_LAS u32x4*)(my + ro + j * 1024), xw = xr[bj][mh][j];
            u32x4 o;
#pragma unroll
            for (int q = 0; q < 4; ++q) {
              const unsigned aw = a[q], xq = xw[q];
              o[q] = pack2(fmaf(ALPHA, __uint_as_float(xq << 16), __uint_as_float(aw << 16)), fmaf(ALPHA, __uint_as_float(xq & 0xFFFF0000u), __uint_as_float(aw & 0xFFFF0000u)));
            }
            *(u32x4*)(yb + (size_t)(ai * 128 + mh * 32 + j * 16) * DM + bj * 128) = o;
          }
        }
    }
  }
};
struct EpiF32G {
  static constexpr bool PERM = false, AFTER_DRAIN = false;
  float* C; int ldc;
  DI void operator()(const f32x4 (&acc)[2][2][4][2], const pg8::Unit& u, int wr, int wc, int fr, int fq) const {
#pragma unroll
    for (int ai = 0; ai < 2; ++ai)
#pragma unroll
      for (int m = 0; m < 4; ++m) {
        const size_t ro = (size_t)(u.pm * 256 + ai * 128 + wr * 64 + m * 16 + fr) * ldc + u.pn * 256 + wc * 32 + 4 * fq;
#pragma unroll
        for (int bj = 0; bj < 2; ++bj)
#pragma unroll
          for (int n = 0; n < 2; ++n) *(f32x4*)(C + ro + bj * 128 + n * 16) = acc[ai][bj][m][n];
      }
  }
};
struct EpiRouteG {
  static constexpr bool PERM = false, AFTER_DRAIN = true;
  const bf16_t* skf; unsigned* tops;
  DI void operator()(const f32x4 (&)[2][2][4][2], const pg8::Unit&, int, int, int, int) const {}
  DI void fused(const f32x4 (&acc)[2][2][4][2], const pg8::Unit& u, int wr, int wc, int fr, int fq, PG8_LAS unsigned char* ldsp, int, int) const {
    const int lane = fr | (fq << 4), wid = wr * 4 + wc;
    bf16_t* Qs = (bf16_t*)ldsp;
#pragma unroll
    for (int ai = 0; ai < 2; ++ai)
#pragma unroll
      for (int m = 0; m < 4; ++m) {
        const int row = ai * 128 + wr * 64 + m * 16 + fr;
#pragma unroll
        for (int bj = 0; bj < 2; ++bj)
#pragma unroll
          for (int n = 0; n < 2; ++n) {
            const f32x4 v = acc[ai][bj][m][n];
            u32x2 w = {pack2(v[0], v[1]), pack2(v[2], v[3])};
            *(u32x2*)(Qs + row * 264 + bj * 128 + wc * 32 + n * 16 + 4 * fq) = w;
          }
      }
    __syncthreads();
    const int c = lane & 31, h = lane >> 5;
#pragma unroll 1
    for (int half = 0; half < 2; ++half) {
      const int hc = u.pn * 2 + half;
      const bf16_t* sk = skf + (size_t)hc * 4 * 4096;
      const bf16_t* qp = Qs + (wid * 32 + c) * 264 + half * 128 + 8 * h;
      unsigned k0[16], k1[16];
#define ROUTE_KT(KT, KA)                                                                        \
      {                                                                                         \
        f32x16 sc;                                                                              \
        _Pragma("unroll") for (int i = 0; i < 16; ++i) sc[i] = 0.f;                             \
        _Pragma("unroll") for (int s = 0; s < 8; ++s) {                                         \
          bf16x8 af = *(const bf16x8*)(sk + (KT) * 4096 + s * 512 + lane * 8);                  \
          bf16x8 bq = *(const bf16x8*)(qp + 16 * s);                                            \
          sc = __builtin_amdgcn_mfma_f32_32x32x16_bf16(af, bq, sc, 0, 0, 0);                    \
        }                                                                                       \
        _Pragma("unroll") for (int rg = 0; rg < 16; ++rg) {                                     \
          const int kidx = 32 * (KT) + (rg & 3) + 8 * (rg >> 2) + 4 * h;                        \
          KA[rg] = (f2sort(sc[rg]) & 0xFFFFFF80u) | (unsigned)(127 - kidx);                     \
        }                                                                                       \
        bitonic_sort_desc<16>(KA);                                                              \
      }
      ROUTE_KT(0, k0)
      __builtin_amdgcn_sched_barrier(0);
      ROUTE_KT(1, k1)
      merge_top16(k0, k1);
      __builtin_amdgcn_sched_barrier(0);
      ROUTE_KT(2, k1)
      merge_top16(k0, k1);
      __builtin_amdgcn_sched_barrier(0);
      ROUTE_KT(3, k1)
      merge_top16(k0, k1);
      __builtin_amdgcn_sched_barrier(0);
#undef ROUTE_KT
#pragma unroll
      for (int i = 0; i < 16; ++i) k1[i] = (unsigned)shx_i((int)k0[i], 32);
      merge_top16(k0, k1);
      if (h == 0) {
        unsigned* dst = tops + ((size_t)(u.pm * 256 + wid * 32 + c) * 16 + hc) * 16;
#pragma unroll
        for (int q4 = 0; q4 < 4; ++q4) { u32x4 o = {k0[4 * q4], k0[4 * q4 + 1], k0[4 * q4 + 2], k0[4 * q4 + 3]}; *(u32x4*)(dst + 4 * q4) = o; }
      }
    }
    __syncthreads();
  }
};


template <int CTRL> DI float dpp_f(float v) { const int iv = __float_as_int(v); return __int_as_float(__builtin_amdgcn_update_dpp(iv, iv, CTRL, 0xF, 0xF, false)); }
DI float wsum(float x) {
  x += dpp_f<0xB1>(x);
  x += dpp_f<0x4E>(x);
  x += dpp_f<0x124>(x);
  x += dpp_f<0x128>(x);
  x += shx(x, 16);
  return hsum(x);
}
DI float gelu_fast(float x) {
  const float u2 = 1.5957691216057308f * (x + 0.044715f * x * x * x);
  return x * __builtin_amdgcn_rcpf(1.f + ex2(-LOG2E * u2));
}

constexpr int EROW = 1024;
typedef float v2f __attribute__((ext_vector_type(2)));
__device__ void d_cvt_fp4_row(int row, const float* __restrict__ src, unsigned char* __restrict__ dst, float* __restrict__ scales) {
  const int lane = TIDX & 63;
  float v[32]; float amax = 0.f;
#pragma unroll
  for (int i = 0; i < 8; ++i) {
    f32x4 x = *(const f32x4*)(src + (size_t)row * DM + 256 * i + 4 * lane);
#pragma unroll
    for (int j = 0; j < 4; ++j) { v[i * 4 + j] = x[j]; amax = fmaxf(amax, fabsf(x[j])); }
  }
  amax = wave_max(amax);
  const float sc = amax > 0.f ? amax * (1.f / 7.f) : 1.f;
  const float inv = 1.f / sc;
  u32x4 o;
#pragma unroll
  for (int k = 0; k < 4; ++k) {
    unsigned w = 0u;
#define FP4C(x_) fminf(fmaxf((x_) * inv, -6.f), 6.f)
    w = __builtin_amdgcn_cvt_scalef32_pk_fp4_f32(w, FP4C(v[8 * k + 0]), FP4C(v[8 * k + 1]), 1.0f, 0);
    w = __builtin_amdgcn_cvt_scalef32_pk_fp4_f32(w, FP4C(v[8 * k + 2]), FP4C(v[8 * k + 3]), 1.0f, 1);
    w = __builtin_amdgcn_cvt_scalef32_pk_fp4_f32(w, FP4C(v[8 * k + 4]), FP4C(v[8 * k + 5]), 1.0f, 2);
    w = __builtin_amdgcn_cvt_scalef32_pk_fp4_f32(w, FP4C(v[8 * k + 6]), FP4C(v[8 * k + 7]), 1.0f, 3);
#undef FP4C
    o[k] = w;
  }
  *(u32x4*)(dst + (size_t)row * EROW + 16 * lane) = o;
  if (lane == 0) scales[row] = sc;
}
__device__ void d_expert_wave(int t, unsigned* tpl, const bf16_t* __restrict__ hbuf,
                              const unsigned* __restrict__ tops, const unsigned char* __restrict__ eu4, const unsigned char* __restrict__ ev4,
                              const float* __restrict__ esu, const float* __restrict__ esv, const float* __restrict__ gam, const float* __restrict__ bet, float* __restrict__ out) {
  const int lane = TIDX & 63;
  float hv[32];
#pragma unroll
  for (int i = 0; i < 8; ++i) {
    const u32x2 w = *(const u32x2*)(hbuf + (size_t)t * DM + 256 * i + 4 * lane);
    hv[i * 4 + 0] = __uint_as_float(w[0] << 16); hv[i * 4 + 1] = __uint_as_float(w[0] & 0xFFFF0000u);
    hv[i * 4 + 2] = __uint_as_float(w[1] << 16); hv[i * 4 + 3] = __uint_as_float(w[1] & 0xFFFF0000u);
  }
  int e0 = 0, e1 = 0; float w0 = 0.f, w1 = 0.f;
  {
    const int ci = (lane < 16) ? 0 : (lane < 24) ? 1 : (lane < 29) ? 2 : (lane < 33) ? 3 : (lane < 36) ? 4 : (lane < 38) ? 5 : (lane < 40) ? 6
                   : (lane < 42) ? 7 : (lane - 34);
    const int cpre = (ci == 0) ? 0 : (ci == 1) ? 16 : (ci == 2) ? 24 : (ci == 3) ? 29 : (ci == 4) ? 33 : (ci == 5) ? 36 : (ci == 6) ? 38
                     : (ci == 7) ? 40 : (34 + ci);
    const int cj = lane - cpre;
    const bool cvalid = lane < 50;
    *(u32x4*)(tpl + 4 * lane) = *(const u32x4*)(tops + (size_t)t * 256 + 4 * lane);
    const unsigned* tp = tpl;
#pragma unroll 1
    for (int hh = 0; hh < 8; ++hh) {
      unsigned key = 0u;
      if (cvalid) {
        const float sa = sort2f(tp[(2 * hh) * 16 + ci]), sb = sort2f(tp[(2 * hh + 1) * 16 + cj]);
        key = (f2sort(sa + sb) & 0xFFFFFF00u) | (unsigned)(255 - (ci * 16 + cj));
      }
#pragma unroll
      for (int k = 2; k <= 64; k <<= 1) {
#pragma unroll
        for (int jj = k >> 1; jj > 0; jj >>= 1) {
          const unsigned o = (unsigned)shx_i((int)key, jj);
          const bool lower = (lane & jj) == 0;
          const bool desc = (lane & k) == 0 || k == 64;
          const unsigned mx = key > o ? key : o, mn = key > o ? o : key;
          key = (lower == desc) ? mx : mn;
        }
      }
      const int flat = 255 - (int)(key & 255u);
      const int bi = (flat >> 4) & 15, bj = flat & 15;
      const unsigned ka = tp[(2 * hh) * 16 + bi], kb = tp[(2 * hh + 1) * 16 + bj];
      const float sc = sort2f(ka) + sort2f(kb);
      const int ex = (127 - (int)(ka & 127u)) * 128 + (127 - (int)(kb & 127u));
      float mx = sc;
      mx = fmaxf(mx, shx(mx, 1)); mx = fmaxf(mx, shx(mx, 2)); mx = fmaxf(mx, shx(mx, 4)); mx = fmaxf(mx, shx(mx, 8));
      const float ev_ = __expf(sc - mx);
      float sm = ev_;
      sm += shx(sm, 1); sm += shx(sm, 2); sm += shx(sm, 4); sm += shx(sm, 8);
      const float gv = ev_ / sm;
      const int exs = __shfl(ex, lane & 15); const float gvs = __shfl(gv, lane & 15);
      if ((lane >> 4) == (hh & 3)) { if (hh < 4) { e0 = exs; w0 = gvs; } else { e1 = exs; w1 = gvs; } }
    }
  }
  bf16x2v hb2[16];
#pragma unroll
  for (int i = 0; i < 16; ++i) hb2[i] = bf16x2v{(__bf16)hv[2 * i], (__bf16)hv[2 * i + 1]};
  float c0 = 0.f, c1 = 0.f;
  u32x4 rA[4], rB[4]; float sA[4], sB[4];
#define EX_LOAD(R, SS, TAB, STAB, EB)                                                            \
  _Pragma("unroll") for (int k = 0; k < 4; ++k) {                                          \
    const int e = (EB) + k;                                                                \
    const int id = __builtin_amdgcn_readlane((e < 64) ? e0 : e1, e & 63);                 \
    const unsigned char* row = (TAB) + (size_t)id * EROW;                                  \
    R[k] = *(const u32x4*)(row + 16 * lane);                                               \
    SS[k] = (STAB)[id];                                                                    \
  }
#define PKFMA(a_, b_, c_) __builtin_elementwise_fma((a_), (b_), (c_))
#define EX_COMP_U(R, SS, EB)                                                               \
  {                                                                                        \
    float dd[4];                                                                           \
    _Pragma("unroll") for (int k = 0; k < 4; ++k) {                                        \
      float d0 = 0.f, d1 = 0.f;                                                            \
      _Pragma("unroll") for (int q = 0; q < 4; ++q) {                                      \
        const unsigned wq = R[k][q];                                                       \
        d0 = __builtin_amdgcn_fdot2_f32_bf16(__builtin_amdgcn_cvt_scalef32_pk_bf16_fp4(wq, 1.0f, 0), hb2[4 * q + 0], d0, false); \
        d1 = __builtin_amdgcn_fdot2_f32_bf16(__builtin_amdgcn_cvt_scalef32_pk_bf16_fp4(wq, 1.0f, 1), hb2[4 * q + 1], d1, false); \
        d0 = __builtin_amdgcn_fdot2_f32_bf16(__builtin_amdgcn_cvt_scalef32_pk_bf16_fp4(wq, 1.0f, 2), hb2[4 * q + 2], d0, false); \
        d1 = __builtin_amdgcn_fdot2_f32_bf16(__builtin_amdgcn_cvt_scalef32_pk_bf16_fp4(wq, 1.0f, 3), hb2[4 * q + 3], d1, false); \
      }                                                                                    \
      dd[k] = SS[k] * (d0 + d1);                                                     \
      __builtin_amdgcn_sched_barrier(0);                                                   \
    }                                                                                      \
      \
    float t01, t23;                                                                        \
    { auto r_ = __builtin_amdgcn_permlane32_swap(__float_as_uint(dd[0]), __float_as_uint(dd[1]), false, false);   \
      t01 = __uint_as_float(r_[0]) + __uint_as_float(r_[1]); }          \
    { auto r_ = __builtin_amdgcn_permlane32_swap(__float_as_uint(dd[2]), __float_as_uint(dd[3]), false, false);   \
      t23 = __uint_as_float(r_[0]) + __uint_as_float(r_[1]); }          \
    const bool b4_ = (lane & 16) != 0;                                                     \
    float tv = (b4_ ? t23 : t01) + shx(b4_ ? t01 : t23, 16);          \
    tv += dpp_f<0x128>(tv); tv += dpp_f<0x124>(tv); tv += dpp_f<0x4E>(tv); tv += dpp_f<0xB1>(tv);                 \
    _Pragma("unroll") for (int k = 0; k < 4; ++k) {                                        \
      const int e = (EB) + k;                                                              \
      const float tot = __int_as_float(__builtin_amdgcn_readlane(__float_as_int(tv), (k == 0) ? 0 : (k == 1) ? 32 : (k == 2) ? 16 : 48)); \
      if (e < 64) { if (lane == e) c0 = tot; } else { if (lane == e - 64) c1 = tot; }        \
    }                                                                                      \
    __builtin_amdgcn_sched_barrier(0);                                                     \
  }
#define EX_COMP_V(R, SS, EB)                                                               \
  _Pragma("unroll") for (int k = 0; k < 4; ++k) {                                          \
    const int e = (EB) + k;                                                                \
    const float cs = __int_as_float(__builtin_amdgcn_readlane(__float_as_int((e < 64) ? c0 : c1), e & 63)) * SS[k];                     \
    const v2f cs2 = {cs, cs};                                                              \
    _Pragma("unroll") for (int q = 0; q < 4; ++q) {                                        \
      const unsigned wq = R[k][q];                                                         \
      const v2f f0 = __builtin_amdgcn_cvt_scalef32_pk_f32_fp4(wq, 1.0f, 0), f1 = __builtin_amdgcn_cvt_scalef32_pk_f32_fp4(wq, 1.0f, 1); \
      const v2f f2 = __builtin_amdgcn_cvt_scalef32_pk_f32_fp4(wq, 1.0f, 2), f3 = __builtin_amdgcn_cvt_scalef32_pk_f32_fp4(wq, 1.0f, 3); \
      acc2[4 * q + 0] = PKFMA(cs2, f0, acc2[4 * q + 0]); acc2[4 * q + 1] = PKFMA(cs2, f1, acc2[4 * q + 1]); \
      acc2[4 * q + 2] = PKFMA(cs2, f2, acc2[4 * q + 2]); acc2[4 * q + 3] = PKFMA(cs2, f3, acc2[4 * q + 3]); \
    }                                                                                      \
    __builtin_amdgcn_sched_barrier(0);                                                     \
  }
  EX_LOAD(rA, sA, eu4, esu, 0)
  __builtin_amdgcn_sched_barrier(0);
#pragma unroll 1
  for (int eb = 0; eb < 128; eb += 8) {
    EX_LOAD(rB, sB, eu4, esu, eb + 4)
    __builtin_amdgcn_sched_barrier(0);
    EX_COMP_U(rA, sA, eb)
    { const bool more = eb + 8 < 128; const unsigned char* tabn = more ? eu4 : ev4; const float* stn = more ? esu : esv; const int ebn = more ? eb + 8 : 0;
      EX_LOAD(rA, sA, tabn, stn, ebn) }
    __builtin_amdgcn_sched_barrier(0);
    EX_COMP_U(rB, sB, eb + 4)
  }
  c0 = w0 * gelu_fast(c0); c1 = w1 * gelu_fast(c1);
  v2f acc2[16];
#pragma unroll
  for (int i = 0; i < 16; ++i) acc2[i] = v2f{0.f, 0.f};
#pragma unroll 1
  for (int eb = 0; eb < 128; eb += 8) {
    EX_LOAD(rB, sB, ev4, esv, eb + 4)
    __builtin_amdgcn_sched_barrier(0);
    EX_COMP_V(rA, sA, eb)
    { const int ebn = (eb + 8 < 128) ? eb + 8 : 0;
      EX_LOAD(rA, sA, ev4, esv, ebn) }
    __builtin_amdgcn_sched_barrier(0);
    EX_COMP_V(rB, sB, eb + 4)
  }
#undef EX_LOAD
#undef EX_COMP_U
#undef EX_COMP_V
#undef PKFMA
  float acc[32];
#pragma unroll
  for (int i = 0; i < 16; ++i) { acc[2 * i] = acc2[i].x; acc[2 * i + 1] = acc2[i].y; }
  int le = lane;
  asm volatile("" : "+v"(le) :: "memory");
  float s = 0.f;
#pragma unroll
  for (int i = 0; i < 8; ++i) {
    const u32x2 w = *(const u32x2*)(hbuf + (size_t)t * DM + 256 * i + 4 * le);
    const float h0 = __uint_as_float(w[0] << 16), h1 = __uint_as_float(w[0] & 0xFFFF0000u), h2 = __uint_as_float(w[1] << 16), h3 = __uint_as_float(w[1] & 0xFFFF0000u);
    acc[i * 4 + 0] = fmaf(ALPHA, h0, acc[i * 4 + 0]); acc[i * 4 + 1] = fmaf(ALPHA, h1, acc[i * 4 + 1]);
    acc[i * 4 + 2] = fmaf(ALPHA, h2, acc[i * 4 + 2]); acc[i * 4 + 3] = fmaf(ALPHA, h3, acc[i * 4 + 3]);
    s += (acc[i * 4 + 0] + acc[i * 4 + 1]) + (acc[i * 4 + 2] + acc[i * 4 + 3]);
  }
  s = wsum(s);
  const float mu = s * (1.f / DM);
  float qv = 0.f;
#pragma unroll
  for (int i = 0; i < 32; ++i) { const float d = acc[i] - mu; qv += d * d; }
  qv = wsum(qv);
  const float rs = rsqrtf(qv * (1.f / DM) + 1e-5f);
#pragma unroll
  for (int i = 0; i < 8; ++i) {
    const int cbase = 256 * i + 4 * le;
    f32x4 ga = *(const f32x4*)(gam + cbase), ba = *(const f32x4*)(bet + cbase), o;
#pragma unroll
    for (int j = 0; j < 4; ++j) o[j] = (acc[i * 4 + j] - mu) * rs * ga[j] + ba[j];
    *(f32x4*)(out + (size_t)t * DM + cbase) = o;
  }
}

constexpr size_t al256(size_t x) { return (x + 255) & ~(size_t)255; }
constexpr size_t WS_XB = 0;
constexpr size_t WS_PROJ = WS_XB + al256((size_t)S * DM * 2);
constexpr size_t WS_WINT = WS_PROJ + al256((size_t)S * INWP * 2);
constexpr size_t WS_GATES = WS_WINT + al256((size_t)INWG * DM * 2);
constexpr size_t WS_W1KF = WS_GATES + al256((size_t)S * 24 * 4);
constexpr size_t WS_W1VF = WS_W1KF + al256((size_t)512 * 4096 * 2);
constexpr size_t WS_W2KF = WS_W1VF + al256((size_t)512 * 4096 * 2);
constexpr size_t WS_W2VF = WS_W2KF + al256((size_t)512 * 128 * 2);
constexpr size_t WS_VC = WS_W2VF + al256((size_t)512 * 128 * 2) - al256((size_t)2048 * 128 * 4);
constexpr size_t WS_KCF = WS_VC + al256((size_t)2048 * 128 * 4);
constexpr size_t WS_VCF = WS_KCF + al256((size_t)2 * 32 * 4096 * 2);
constexpr size_t WS_KSF = WS_VCF + al256((size_t)2 * 32 * 4096 * 2);
constexpr size_t WS_VSF = WS_KSF + al256((size_t)2 * 512 * 4096 * 2);
constexpr size_t WS_KWF = WS_VSF + al256((size_t)2 * 512 * 4096 * 2);
constexpr size_t WS_VWF = WS_KWF + al256((size_t)2 * 512 * 4096 * 2);
constexpr size_t WS_ENDA = WS_VWF + al256((size_t)2 * 512 * 4096 * 2);
constexpr size_t WS_OATT = WS_ENDA;
constexpr size_t WS_MIX = WS_OATT + al256((size_t)S * 1024 * 4);
constexpr size_t WS_WOUTT = WS_MIX + al256((size_t)S * DM * 2);
constexpr size_t WS_WQT = WS_WOUTT + al256((size_t)DM * DM * 2);
constexpr size_t WS_TOPS = WS_WQT + al256((size_t)DM * DM * 2);
constexpr size_t WS_SKF = WS_TOPS + al256((size_t)S * 256 * 4);
constexpr size_t WS_STATS = WS_SKF + al256((size_t)16 * 128 * 128 * 2);
constexpr size_t WS_CTRL = WS_STATS + al256((size_t)S * 2 * 4);
constexpr size_t CTRL_BYTES = 32768;
constexpr size_t WS_END = WS_CTRL + CTRL_BYTES;
constexpr size_t WS_Y = WS_PROJ;
constexpr size_t WS_HB = WS_XB;
constexpr size_t WS_EU8 = WS_OATT;
constexpr size_t WS_EV8 = WS_EU8 + (size_t)16384 * 1024;
constexpr size_t WS_ESU = WS_EV8 + (size_t)16384 * 1024;
constexpr size_t WS_ESV = WS_ESU + 16384 * 4;
static_assert(WS_ESV + 16384 * 4 <= WS_MIX, "expert tables overflow their region");
constexpr int EXP_EARLY = 6144;
static_assert(WS_END <= (size_t)512 * 1024 * 1024, "workspace over 512 MiB");

struct Params {
  const float *x, *w_in, *ck_pos, *ck_w1, *ck_b1, *ck_w2, *cv_pos, *cv_w1, *cv_b1, *cv_w2, *conv_w, *hng, *w_out, *ln1g, *ln1b, *w_query, *subk,
      *eu, *ev, *ln2g, *ln2b;
  float* out;
  char* ws;
};
#define WSP(T, OFF) ((T*)(p.ws + (OFF)))

#define FOR_VB(n) for (int vb = blockIdx.x; vb < (n); vb += gridDim.x)
#define FOR_VB2(n) for (int vb = blockIdx.x * 2 + (TIDX >> 8); vb < (n); vb += gridDim.x * 2)
constexpr int SMEM_BYTES = 147456;
constexpr int HALF = 36864;

__global__ void __launch_bounds__(512) mega(Params p) {
  __shared__ __attribute__((aligned(16))) char smem[SMEM_BYTES + 16];
  if (TIDX == 0) *(u32x4*)(smem + SMEM_BYTES) = u32x4{0u, 0u, 0u, 0u};
  __syncthreads();
  const XcdBarrier xbar = xcd_barrier_post(WSP(unsigned, WS_CTRL + 1024), (volatile LAS unsigned*)(smem + SMEM_BYTES));
#define smh (smem + (TIDX >> 8) * HALF)
#define wv ((TIDX >> 6))
  constexpr int NWV = 8;
  d_cvt(p.x, WSP(bf16_t, WS_XB), (size_t)S * DM / 4);
  FOR_VB2((INWG / 64) * (DM / 64)) d_cvtT64(vb, smh, p.w_in, WSP(bf16_t, WS_WINT), DM, INW, INWG);
  for (size_t c = (size_t)blockIdx.x * 512 + TIDX; c < (size_t)16 * 256 * 64; c += (size_t)gridDim.x * 512) {
    d_cvt_w1f(c, p.ck_w1, WSP(bf16_t, WS_W1KF)); d_cvt_w1f(c, p.cv_w1, WSP(bf16_t, WS_W1VF));
    if (c < (size_t)4 * 32 * 64) { d_cvt_w2f(c, p.ck_w2, WSP(bf16_t, WS_W2KF)); d_cvt_w2f(c, p.cv_w2, WSP(bf16_t, WS_W2VF)); }
  }
  FOR_VB2((DM / 64) * (DM / 64)) d_cvtT64(vb, smh, p.w_out, WSP(bf16_t, WS_WOUTT), DM, DM, DM);
  FOR_VB2((DM / 64) * (DM / 64)) d_cvtT64(vb, smh, p.w_query, WSP(bf16_t, WS_WQT), DM, DM, DM);
  for (size_t c = (size_t)blockIdx.x * 512 + TIDX; c < (size_t)16 * 4 * 8 * 64; c += (size_t)gridDim.x * 512) d_cvt_subk(c, p.subk, WSP(bf16_t, WS_SKF));
  xcd_barrier(xbar);
  {
    pg8::StaticOrder so; so.init(S, INWG, gridDim.x, blockIdx.x);
    pg8::gemm_phase<EpiProjG, pg8::StaticOrder>((PG8_LAS unsigned char*)smem, pg8::Gemm{WSP(bf16_t, WS_XB), WSP(bf16_t, WS_WINT), S, INWG, DM}, so,
                                                EpiProjG{WSP(bf16_t, WS_PROJ), WSP(float, WS_GATES), (PG8_LAS unsigned char*)smem + pg8::STAGE_BYTES}, nullptr);
    const int nun = (S / 256) * (INWG / 256), gsz = (int)gridDim.x;
    const int nfull = nun % gsz;
    if (nfull != 0 && (int)blockIdx.x >= nfull) {
      const int nidle = gsz - nfull, me = (int)blockIdx.x - nfull;
      for (int r = me * NWV + wv; r < 2 * EXP_EARLY; r += nidle * NWV) {
        if (r < EXP_EARLY) d_cvt_fp4_row(r, p.eu, WSP(unsigned char, WS_EU8), WSP(float, WS_ESU)); else d_cvt_fp4_row(r - EXP_EARLY, p.ev, WSP(unsigned char, WS_EV8), WSP(float, WS_ESV));
      }
    }
  }
  xcd_barrier(xbar);
  {
    if (blockIdx.x < 128) {
      const int xcd_ = blockIdx.x & 7, idx_ = blockIdx.x >> 3; const bool isV = (xcd_ & 1) != 0;
      d_compress_unit((xcd_ >> 1) * 16 + idx_, smem, WSP(bf16_t, WS_PROJ), isV ? OFF_VC : OFF_KC, isV ? p.cv_pos : p.ck_pos, isV ? WSP(bf16_t, WS_W1VF) : WSP(bf16_t, WS_W1KF),
                      isV ? p.cv_b1 : p.ck_b1, isV ? WSP(bf16_t, WS_W2VF) : WSP(bf16_t, WS_W2KF), isV ? WSP(bf16_t, WS_VCF) : WSP(bf16_t, WS_KCF), isV);
    }
    int* slot = (int*)smem;
    unsigned* ctr = WSP(unsigned, WS_CTRL);
    for (;;) {
      if (TIDX == 0) *slot = (int)atomicAdd(ctr, 1u);
      __syncthreads();
      const int it = *slot;
      __syncthreads();
      if (it >= 2048) break;
      const int tt = TIDX;
      {
        const int T = it >> 2, which = it & 3;
        d_relayout_tile(T, smem + 64, WSP(bf16_t, WS_PROJ), (which == 0) ? OFF_KS : (which == 1) ? OFF_VS : (which == 2) ? OFF_KW : OFF_VW,
                        (which == 0) ? WSP(bf16_t, WS_KSF) : (which == 1) ? WSP(bf16_t, WS_VSF) : (which == 2) ? WSP(bf16_t, WS_KWF) : WSP(bf16_t, WS_VWF), (which & 1) != 0);
      }
      for (int q = 0; q < 2; ++q) d_convmix(it * 8 + q * 4 + (tt >> 7), tt & 127, WSP(bf16_t, WS_PROJ), p.conv_w, p.hng, WSP(bf16_t, WS_MIX));
    }
  }
  xcd_barrier(xbar);
  {
    AttnPtrs ap{WSP(bf16_t, WS_PROJ), WSP(float, WS_GATES), WSP(bf16_t, WS_KCF), WSP(bf16_t, WS_VCF), WSP(bf16_t, WS_KSF), WSP(bf16_t, WS_VSF), WSP(bf16_t, WS_KWF), WSP(bf16_t, WS_VWF), WSP(bf16_t, WS_MIX), p.hng};
    for (int it = blockIdx.x; it < 512; it += gridDim.x) {
      const int Bq = (it < 256) ? it : (511 - it), gq = (it < 256) ? 0 : 1;
      d_attn_block(Bq, gq, smem, ap);
    }
  }
  xcd_barrier(xbar);
  {
    pg8::StaticOrder so; so.init(S, DM, gridDim.x, blockIdx.x);
    pg8::gemm_phase<EpiResG, pg8::StaticOrder>((PG8_LAS unsigned char*)smem, pg8::Gemm{WSP(bf16_t, WS_MIX), WSP(bf16_t, WS_WOUTT), S, DM, DM}, so,
                                               EpiResG{WSP(bf16_t, WS_HB), (PG8_LAS unsigned char*)smem + pg8::STAGE_BYTES}, nullptr);
  }
  xcd_barrier(xbar);
  for (int r = blockIdx.x * NWV + wv; r < S; r += gridDim.x * NWV) d_ln_wave(r, WSP(bf16_t, WS_HB), p.ln1g, p.ln1b);
  {
    const int e0_ = (((S / 256) * (INWG / 256)) % (int)gridDim.x != 0) ? EXP_EARLY : 0;
    const int nrest = 16384 - e0_;
    for (int r = blockIdx.x * NWV + wv; r < 2 * nrest; r += gridDim.x * NWV) {
      if (r < nrest) d_cvt_fp4_row(e0_ + r, p.eu, WSP(unsigned char, WS_EU8), WSP(float, WS_ESU)); else d_cvt_fp4_row(e0_ + r - nrest, p.ev, WSP(unsigned char, WS_EV8), WSP(float, WS_ESV));
    }
  }
  xcd_barrier(xbar);
  for (int k = 0; k * (int)gridDim.x < (S / 256) * (DM / 256); ++k) {
    pg8::OneUnit so; so.init(S, DM, gridDim.x, blockIdx.x); so.k = k;
    pg8::gemm_phase<EpiRouteG, pg8::OneUnit>((PG8_LAS unsigned char*)smem, pg8::Gemm{WSP(bf16_t, WS_HB), WSP(bf16_t, WS_WQT), S, DM, DM}, so,
                                             EpiRouteG{WSP(bf16_t, WS_SKF), WSP(unsigned, WS_TOPS)}, nullptr);
    __syncthreads();
  }
  xcd_barrier(xbar);
  for (int t = blockIdx.x * NWV + wv; t < S; t += gridDim.x * NWV) d_expert_wave(t, (unsigned*)(smem + wv * 1024), WSP(bf16_t, WS_HB), WSP(unsigned, WS_TOPS), WSP(unsigned char, WS_EU8), WSP(unsigned char, WS_EV8), WSP(float, WS_ESU), WSP(float, WS_ESV), p.ln2g, p.ln2b, p.out);
}

extern "C" void kernel_launch(void* const* d_in, const int* in_sizes, int n_in, void* d_out, int out_size, void* d_ws, size_t ws_size,
                              hipStream_t stream) {
  Params p{};
  p.x = (const float*)d_in[0]; p.w_in = (const float*)d_in[1]; p.ck_pos = (const float*)d_in[2]; p.ck_w1 = (const float*)d_in[3];
  p.ck_b1 = (const float*)d_in[4]; p.ck_w2 = (const float*)d_in[5]; p.cv_pos = (const float*)d_in[6]; p.cv_w1 = (const float*)d_in[7];
  p.cv_b1 = (const float*)d_in[8]; p.cv_w2 = (const float*)d_in[9]; p.conv_w = (const float*)d_in[10]; p.hng = (const float*)d_in[11];
  p.w_out = (const float*)d_in[12]; p.ln1g = (const float*)d_in[13]; p.ln1b = (const float*)d_in[14]; p.w_query = (const float*)d_in[15];
  p.subk = (const float*)d_in[16]; p.eu = (const float*)d_in[17]; p.ev = (const float*)d_in[18]; p.ln2g = (const float*)d_in[19];
  p.ln2b = (const float*)d_in[20];
  p.out = (float*)d_out;
  p.ws = (char*)d_ws;
  if (ws_size < WS_END) fprintf(stderr, "workspace too small\n");
  static int grid_blocks = 0;
  if (!grid_blocks) {
    int dev = 0, cus = 0, per_cu = 0;
    hipGetDevice(&dev);
    hipDeviceGetAttribute(&cus, hipDeviceAttributeMultiprocessorCount, dev);
    hipOccupancyMaxActiveBlocksPerMultiprocessor(&per_cu, mega, 512, 0);
    if (per_cu > 1) per_cu = 1;
    if (per_cu < 1) per_cu = 1;
    grid_blocks = cus * per_cu;
  }
  hipMemsetAsync((char*)d_ws + WS_CTRL, 0, CTRL_BYTES, stream);
  void* args[] = {&p};
  hipError_t e = hipLaunchCooperativeKernel((void*)mega, dim3(grid_blocks), dim3(512), args, 0, stream);
  if (e != hipSuccess) fprintf(stderr, "cooperative launch failed: %s (grid %d)\n", hipGetErrorString(e), grid_blocks);
}
```

```cpp
#include <hip/hip_runtime.h>
#include <stdint.h>
#include <stdio.h>


#define DI __device__ __forceinline__
static __device__ __forceinline__ int tidx_() { int t = (int)__builtin_amdgcn_workitem_id_x(); asm volatile("" : "+v"(t)); return t; }
#define TIDX (tidx_())

template <int J> DI int swz_xor(int x) { return __builtin_amdgcn_ds_swizzle(x, (J << 10) | 0x1F); }
template <int CTRL> DI int dpp_i(int x) { return __builtin_amdgcn_update_dpp(x, x, CTRL, 0xF, 0xF, false); }
DI int shx_i(int x, int j) {
  switch (j) {
    case 1: return dpp_i<0xB1>(x);
    case 2: return dpp_i<0x4E>(x);
    case 4: return dpp_i<0x1B>(dpp_i<0x141>(x));
    case 8: return dpp_i<0x128>(x);
    case 16: return swz_xor<16>(x);
    default: {
      auto r = __builtin_amdgcn_permlane32_swap((unsigned)x, (unsigned)x, false, false);
      return (TIDX & 32) ? (int)r[0] : (int)r[1];
    }
  }
}
DI float shx(float x, int j) { return __int_as_float(shx_i(__float_as_int(x), j)); }
typedef unsigned short bf16_t;
using bf16x8 = __attribute__((ext_vector_type(8))) short;
using f32x4 = __attribute__((ext_vector_type(4))) float;
using u32x4 = __attribute__((ext_vector_type(4))) unsigned;
using u32x2 = __attribute__((ext_vector_type(2))) unsigned;

constexpr int S = 16384, DM = 2048, HD = 128;
constexpr int INW = 5656, INWP = 5760, INWG = 5888;
constexpr int OFF_Q = 0, OFF_KC = 1024, OFF_VC = 1280, OFF_KS = 1536, OFF_VS = 1792, OFF_KW = 2048, OFF_VW = 2304,
              OFF_G = 2560, OFF_U = 2584, OFF_B = 3608, OFF_C = 4632;
constexpr int NCMP = 1023;
constexpr float ALPHA = 1.189207115002721f;
constexpr float QSCALE = 0.08838834764831845f;

DI bf16_t f2bf(float x) { unsigned u = __float_as_uint(x); u += 0x7fffu + ((u >> 16) & 1u); return (bf16_t)(u >> 16); }
DI float bf2f(bf16_t b) { return __uint_as_float(((unsigned)b) << 16); }
DI float gelu_tanh(float x) { float u = 0.7978845608028654f * (x + 0.044715f * x * x * x); return 0.5f * x * (1.f + tanhf(u)); }
DI float wave_sum(float v) { for (int o = 32; o > 0; o >>= 1) v += shx(v, o); return v; }
using bf16x2v = __attribute__((ext_vector_type(2))) __bf16;
DI unsigned pack2(float a, float b) { bf16x2v v = {(__bf16)a, (__bf16)b}; return __builtin_bit_cast(unsigned, v); }
DI float wave_max(float v) { for (int o = 32; o > 0; o >>= 1) v = fmaxf(v, shx(v, o)); return v; }

namespace pg8 {
#define PG8_LAS __attribute__((address_space(3)))
typedef unsigned short bf16_t;
typedef short bf16x8 __attribute__((ext_vector_type(8)));
typedef float f32x4 __attribute__((ext_vector_type(4)));
typedef unsigned u32x4 __attribute__((ext_vector_type(4)));
constexpr int BM = 256, BK = 64, HALF = 128, HTB = HALF * BK * 2  , STAGE_BYTES = 8 * HTB, NXCD = 8, WGM = 8;

__host__ __device__ __forceinline__ int lds_byte(int r, int c) { const int st = (r >> 4) * 2 + (c >> 5), rr = r & 15, cc = c & 31, ob = rr * 64 + cc * 2; return st * 1024 + (ob ^ (((ob >> 9) & 1) << 5)); }
__host__ __device__ __forceinline__ void stage_rc(int b, int& R, int& C) { const int st = b / 1024, sb = b % 1024, swz = sb ^ (((sb >> 9) & 1) << 5); R = (st >> 1) * 16 + swz / 64; C = (st & 1) * 32 + (swz % 64) / 2; }
__host__ __device__ __forceinline__ int perm32(int rho) { const int n = rho >> 4, i = rho & 15; return 8 * (i >> 2) + 4 * n + (i & 3); }

struct Unit { int pm, pn; };
struct Gemm { const bf16_t* A; const bf16_t* Bt; int M, N, K; };

struct StaticOrder {
    int nM, nN, nwg, G, c;
    __host__ __device__ void init(int M, int N, int G_, int c_) { nM = M / BM; nN = N / BM; nwg = nM * nN; G = G_; c = c_; }
    __host__ __device__ bool next(int i, Unit& u) const {
        const long L = (long)i * G + c; if (L >= nwg) return false;
        int wgid = (int)L; { const int q = nwg / NXCD, r = nwg % NXCD, xcd = wgid % NXCD, off = wgid / NXCD; wgid = (xcd < r ? xcd * (q + 1) : r * (q + 1) + (xcd - r) * q) + off; }
        const int nig = WGM * nN, gid = wgid / nig, fm = gid * WGM, gsz = (nM - fm) < WGM ? (nM - fm) : WGM;
        u.pm = fm + ((wgid % nig) % gsz); u.pn = (wgid % nig) / gsz; return true;
    }
    __device__ __forceinline__ void a_ready(const Unit&) const {}
    __device__ __forceinline__ void done(const Unit&) const {}
};
struct OneUnit : StaticOrder {
    int k;
    __device__ bool next(int i, Unit& u) const { if (i > 0) return false; return StaticOrder::next(k, u); }
};
__device__ __forceinline__ unsigned cvt_pk_bf16(float lo, float hi) { unsigned r; asm volatile("v_cvt_pk_bf16_f32 %0, %1, %2" : "=v"(r) : "v"(lo), "v"(hi)); return r; }
template <class Epi, class Sched, bool STAMP = false>
__device__ __forceinline__ void gemm_phase(PG8_LAS unsigned char* lds, const Gemm g, const Sched& S, const Epi& E, unsigned long long* stamps) {
    const int tid = TIDX, wid = __builtin_amdgcn_readfirstlane(tid >> 6), lane = tid & 63, wr = wid >> 2, wc = wid & 3, fr = lane & 15, fq = lane >> 4;
    const int K = g.K, nt = K / BK;
    int ts_lo = 0, ts_hi = 0, nts = 0; const unsigned long long rt_entry = STAMP ? (unsigned long long)wall_clock64() : 0ull;
#define PG8_STAMP() do { if (STAMP && wid == 0 && nts < 64) { const unsigned long long _c = (unsigned long long)clock64(); \
        ts_lo = (lane == nts) ? (int)(unsigned)_c : ts_lo; ts_hi = (lane == nts) ? (int)(unsigned)(_c >> 32) : ts_hi; ++nts; } } while (0)
    PG8_STAMP();
    unsigned voffA[2], voffB[2];
#pragma unroll
    for (int i = 0; i < 2; ++i) { int R, C; stage_rc(tid * 16 + i * 8192, R, C); const int Rb = Epi::PERM ? ((R & ~31) + perm32(R & 31)) : R;
        voffA[i] = (unsigned)(R * K + C) * 2u; voffB[i] = (unsigned)(Rb * K + C) * 2u; }
    const size_t kstep = (size_t)(BK * 2);
    const size_t hstep = (size_t)HALF * K * 2;
    const size_t tstep = 2 * hstep;
    const unsigned ldsw = (unsigned)wid * 1024u;
    const int aoff = lds_byte(wr * 64 + fr, fq * 8), boff = lds_byte(wc * 32 + fr, fq * 8);
#define PG8_SA(b, h) (((b) * 2 + (h)) * HTB)
#define PG8_SB(b, h) ((4 + (b) * 2 + (h)) * HTB)
#define PG8_STAGE(bufoff, gbase, voff) do { _Pragma("unroll") for (int _i = 0; _i < 2; ++_i) \
        __builtin_amdgcn_global_load_lds((const unsigned*)((const char*)(gbase) + (voff)[_i]), (PG8_LAS unsigned*)(lds + (bufoff) + ldsw + _i * 8192), 16, 0, 0); } while (0)
#define PG8_LDA(dst, b, h) do { _Pragma("unroll") for (int m = 0; m < 4; ++m) _Pragma("unroll") for (int k = 0; k < 2; ++k) dst[m][k] = *(const PG8_LAS bf16x8*)(lds + PG8_SA(b, h) + aoff + m * 2048 + k * 1024); } while (0)
#define PG8_LDB(dst, b, h) do { _Pragma("unroll") for (int n = 0; n < 2; ++n) _Pragma("unroll") for (int k = 0; k < 2; ++k) dst[n][k] = *(const PG8_LAS bf16x8*)(lds + PG8_SB(b, h) + boff + n * 2048 + k * 1024); } while (0)
#define PG8_MMA(ai, bj, At, Bt) do { __builtin_amdgcn_s_setprio(1); _Pragma("unroll") for (int m = 0; m < 4; ++m) _Pragma("unroll") for (int n = 0; n < 2; ++n) _Pragma("unroll") for (int k = 0; k < 2; ++k) \
        acc[ai][bj][m][n] = __builtin_amdgcn_mfma_f32_16x16x32_bf16(Bt[n][k], At[m][k], acc[ai][bj][m][n], 0, 0, 0); __builtin_amdgcn_s_setprio(0); } while (0)
#define PG8_WAIT_V(n) asm volatile("s_waitcnt vmcnt(" #n ")" ::: "memory")
#define PG8_WAIT_L(n) asm volatile("s_waitcnt lgkmcnt(" #n ")" ::: "memory")
#define PG8_BAR __builtin_amdgcn_s_barrier()
#define PG8_SCHED __builtin_amdgcn_sched_barrier(0)
    Unit cur, nxt; int ui = 0;
    if (!S.next(0, cur)) return;
    f32x4 acc[2][2][4][2];
#pragma unroll
    for (int a = 0; a < 2; ++a)
#pragma unroll
        for (int b = 0; b < 2; ++b)
#pragma unroll
            for (int m = 0; m < 4; ++m)
#pragma unroll
                for (int n = 0; n < 2; ++n) acc[a][b][m][n] = (f32x4){0.f, 0.f, 0.f, 0.f};
    bf16x8 At[4][2], B0[2][2], B1[2][2];
    const char* cA = (const char*)g.A + (size_t)cur.pm * tstep; const char* cB = (const char*)g.Bt + (size_t)cur.pn * tstep;
    S.a_ready(cur);
    PG8_STAGE(PG8_SB(0, 0), cB, voffB); PG8_STAGE(PG8_SA(0, 0), cA, voffA); PG8_STAGE(PG8_SB(0, 1), cB + hstep, voffB); PG8_STAGE(PG8_SA(0, 1), cA + hstep, voffA);
    if (wr == 1) PG8_BAR;
    PG8_WAIT_V(4); PG8_BAR;
    PG8_STAGE(PG8_SB(1, 0), cB + kstep, voffB); PG8_STAGE(PG8_SA(1, 0), cA + kstep, voffA); PG8_STAGE(PG8_SB(1, 1), cB + hstep + kstep, voffB);
    PG8_WAIT_V(6); PG8_BAR;
    PG8_STAMP();
    for (;;) {
        const bool has_next = S.next(ui + 1, nxt);
        const char* nA = has_next ? (const char*)g.A + (size_t)nxt.pm * tstep : cA; const char* nB = has_next ? (const char*)g.Bt + (size_t)nxt.pn * tstep : cB;
        for (int t = 0; t < nt; t += 2) {
            const bool last = (t == nt - 2);
            const char* a1 = cA + (size_t)(t + 1) * kstep;
            const char* a2 = last ? nA : cA + (size_t)(t + 2) * kstep; const char* b2 = last ? nB : cB + (size_t)(t + 2) * kstep;
            const char* a3 = a2 + kstep; const char* b3 = b2 + kstep;
            if (last && has_next) S.a_ready(nxt);
            PG8_LDB(B0, 0, 0); PG8_SCHED; PG8_LDA(At, 0, 0); PG8_STAGE(PG8_SA(1, 1), a1 + hstep, voffA);
            PG8_WAIT_L(8); PG8_BAR; PG8_WAIT_L(0); PG8_MMA(0, 0, At, B0); PG8_BAR; PG8_SCHED;
            PG8_LDB(B1, 0, 1); PG8_STAGE(PG8_SB(0, 0), b2, voffB);
            PG8_BAR; PG8_WAIT_L(0); PG8_MMA(0, 1, At, B1); PG8_BAR;
            PG8_LDA(At, 0, 1); PG8_STAGE(PG8_SA(0, 0), a2, voffA);
            PG8_BAR; PG8_WAIT_L(0); PG8_MMA(1, 0, At, B0); PG8_BAR; PG8_SCHED;
            PG8_STAGE(PG8_SB(0, 1), b2 + hstep, voffB);
            PG8_WAIT_V(6); PG8_BAR; PG8_MMA(1, 1, At, B1); PG8_BAR;
            PG8_LDB(B0, 1, 0); PG8_SCHED; PG8_LDA(At, 1, 0); PG8_STAGE(PG8_SA(0, 1), a2 + hstep, voffA);
            PG8_WAIT_L(8); PG8_BAR; PG8_WAIT_L(0); PG8_MMA(0, 0, At, B0); PG8_BAR; PG8_SCHED;
            PG8_LDB(B1, 1, 1); PG8_STAGE(PG8_SB(1, 0), b3, voffB);
            PG8_BAR; PG8_WAIT_L(0); PG8_MMA(0, 1, At, B1); PG8_BAR;
            PG8_LDA(At, 1, 1); PG8_STAGE(PG8_SA(1, 0), a3, voffA);
            PG8_BAR; PG8_WAIT_L(0); PG8_MMA(1, 0, At, B0); PG8_BAR; PG8_SCHED;
            PG8_STAGE(PG8_SB(1, 1), b3 + hstep, voffB);
            PG8_WAIT_V(6); PG8_BAR; PG8_MMA(1, 1, At, B1); PG8_BAR;
        }
        PG8_STAMP();
        if constexpr (!Epi::AFTER_DRAIN) { E(acc, cur, wr, wc, fr, fq); S.done(cur); }
        PG8_STAMP();
        if (!has_next) break;
#pragma unroll
        for (int a = 0; a < 2; ++a)
#pragma unroll
            for (int b = 0; b < 2; ++b)
#pragma unroll
                for (int m = 0; m < 4; ++m)
#pragma unroll
                    for (int n = 0; n < 2; ++n) acc[a][b][m][n] = (f32x4){0.f, 0.f, 0.f, 0.f};
        cur = nxt; cA = nA; cB = nB; ++ui;
    }
    PG8_WAIT_V(0);
    if (wr == 0) PG8_BAR;
    PG8_BAR;
    if constexpr (Epi::AFTER_DRAIN) { E.fused(acc, cur, wr, wc, fr, fq, lds, wid, lane); S.done(cur); }
    PG8_STAMP();
    if (STAMP && wid == 0) { stamps[lane] = lane < nts ? (((unsigned long long)(unsigned)ts_hi << 32) | (unsigned)ts_lo) : 0ull;
        if (lane == 62) stamps[62] = rt_entry; if (lane == 63) stamps[63] = (unsigned long long)wall_clock64(); }
#undef PG8_STAMP
#undef PG8_SA
#undef PG8_SB
#undef PG8_STAGE
#undef PG8_LDA
#undef PG8_LDB
#undef PG8_MMA
#undef PG8_WAIT_V
#undef PG8_WAIT_L
#undef PG8_BAR
#undef PG8_SCHED
}
}

#define XB_TMO      128
#define XB_XCNT(j)  (256  + 64 * (j))
#define XB_XSUB(j)  (1280 + 64 * (j))
#define XB_XGEN(j)  (2304 + 64 * (j))
#define XB_TOP      3328
#define XB_TOPGEN   3392
#define XCD_BAR_WORDS 3456
#define XB_SPIN_CAP (1u << 18)
#define LAS __attribute__((address_space(3)))

__device__ __forceinline__ unsigned xb_ld(unsigned* p)              { return __hip_atomic_load(p, __ATOMIC_RELAXED, __HIP_MEMORY_SCOPE_AGENT); }
__device__ __forceinline__ unsigned xb_add(unsigned* p, unsigned v) { return __hip_atomic_fetch_add(p, v, __ATOMIC_RELAXED, __HIP_MEMORY_SCOPE_AGENT); }
__device__ __forceinline__ unsigned xb_xcc_id() { return (unsigned)__builtin_amdgcn_s_getreg((3 << 11) | 20) & 0xFu; }
#define XB_SPIN(cond, bar) do { unsigned _sp = 0; while (cond) { __builtin_amdgcn_s_sleep(1); \
    if ((++_sp & 255u) == 0u) { if (xb_ld(&(bar)[XB_TMO])) break; if (_sp > XB_SPIN_CAP) { atomicAdd(&(bar)[XB_TMO], 1u); break; } } } } while (0)

struct XcdBarrier {
    unsigned* bar; unsigned x;
    volatile LAS unsigned* st;
};

__device__ __forceinline__ XcdBarrier xcd_barrier_post(unsigned* bar, volatile LAS unsigned* st) {
    XcdBarrier b; b.bar = bar; b.x = xb_xcc_id(); b.st = st;
    if (TIDX == 0) (void)xb_add(&bar[XB_XCNT(b.x)], 1u);
    return b;
}
__device__ __forceinline__ void xcd_barrier_complete(unsigned* bar, unsigned x, unsigned& nloc, unsigned& nx) {
    const unsigned G = gridDim.x * gridDim.y * gridDim.z;
    unsigned sum, cnt, mine, sp = 0u;
    for (;;) {
        sum = 0u; cnt = 0u; mine = 0u;
#pragma unroll
        for (unsigned j = 0; j < 16; ++j) { const unsigned c = xb_ld(&bar[XB_XCNT(j)]); sum += c; cnt += (c > 0u) ? 1u : 0u; mine = (j == x) ? c : mine; }
        if (sum == G) break;
        __builtin_amdgcn_s_sleep(1);
        if ((++sp & 255u) == 0u) { if (xb_ld(&bar[XB_TMO])) break; if (sp > XB_SPIN_CAP) { atomicAdd(&bar[XB_TMO], 1u); break; } }
    }
    nloc = mine > 0u ? mine : 1u; nx = cnt > 0u ? cnt : 1u;
}

__device__ __forceinline__ void xcd_barrier(const XcdBarrier& b) {
    asm volatile("s_waitcnt vmcnt(0)" ::: "memory");
    __syncthreads();
    if (TIDX == 0) {
        unsigned* bar = b.bar;
        __builtin_amdgcn_s_waitcnt(0);
        unsigned nloc = b.st[0], nx = b.st[1];
        if (nloc == 0u) { xcd_barrier_complete(bar, b.x, nloc, nx); b.st[0] = nloc; b.st[1] = nx; }
        const unsigned old = xb_add(&bar[XB_XSUB(b.x)], 1u);
        const unsigned gen = old / nloc;
        if (old + 1u == (gen + 1u) * nloc) {
            __builtin_amdgcn_fence(__ATOMIC_RELEASE, "agent");
            asm volatile("s_waitcnt vmcnt(0)" ::: "memory");
            const unsigned og = xb_add(&bar[XB_TOP], 1u);
            const unsigned tg = og / nx;
            if (og + 1u == (tg + 1u) * nx) xb_add(&bar[XB_TOPGEN], 1u);
            else XB_SPIN(xb_ld(&bar[XB_TOPGEN]) == tg, bar);
            __builtin_amdgcn_fence(__ATOMIC_ACQUIRE, "agent");
            xb_add(&bar[XB_XGEN(b.x)], 1u);
            asm volatile("s_waitcnt vmcnt(0)" ::: "memory");
        } else {
            XB_SPIN(xb_ld(&bar[XB_XGEN(b.x)]) == gen, bar);
            __builtin_amdgcn_fence(__ATOMIC_ACQUIRE, "agent");
            asm volatile("s_waitcnt vmcnt(0)" ::: "memory");
        }
    }
    __syncthreads();
}

__device__ void d_cvt(const float* __restrict__ in, bf16_t* __restrict__ out, size_t n4) {
  const size_t stride = (size_t)gridDim.x * blockDim.x;
  size_t i = (size_t)blockIdx.x * blockDim.x + TIDX;
  for (; i + 3 * stride < n4; i += 4 * stride) {
    f32x4 v[4];
#pragma unroll
    for (int q = 0; q < 4; ++q) v[q] = ((const f32x4*)in)[i + q * stride];
#pragma unroll
    for (int q = 0; q < 4; ++q) { u32x2 o = {pack2(v[q][0], v[q][1]), pack2(v[q][2], v[q][3])}; ((u32x2*)out)[i + q * stride] = o; }
  }
  for (; i < n4; i += stride) { const f32x4 v = ((const f32x4*)in)[i]; u32x2 o = {pack2(v[0], v[1]), pack2(v[2], v[3])}; ((u32x2*)out)[i] = o; }
}
__device__ void d_cvtT64(int vb, char* smem, const float* __restrict__ W, bf16_t* __restrict__ WT, int K, int N, int NP) {
  float (*tt)[65] = (float (*)[65])smem;
  const int tid = (TIDX & 255);
  const int nbx = NP / 64;
  const int n0 = (vb % nbx) * 64, k0 = (vb / nbx) * 64;
  {
    const int kr = tid >> 4, nc = (tid & 15) * 4;
#pragma unroll
    for (int i = 0; i < 4; ++i) {
      const int k = k0 + kr + 16 * i, n = n0 + nc;
      f32x4 v = {0.f, 0.f, 0.f, 0.f};
      if (n < N) v = *(const f32x4*)(W + (size_t)k * N + n);
      tt[kr + 16 * i][nc] = v[0]; tt[kr + 16 * i][nc + 1] = v[1]; tt[kr + 16 * i][nc + 2] = v[2]; tt[kr + 16 * i][nc + 3] = v[3];
    }
  }
  __syncthreads();
  {
    const int nr = tid >> 3, kc = (tid & 7) * 8;
#pragma unroll
    for (int i = 0; i < 2; ++i) {
      const int nl = nr + 32 * i;
      u32x4 o = {pack2(tt[kc][nl], tt[kc + 1][nl]), pack2(tt[kc + 2][nl], tt[kc + 3][nl]), pack2(tt[kc + 4][nl], tt[kc + 5][nl]), pack2(tt[kc + 6][nl], tt[kc + 7][nl])};
      *(u32x4*)(WT + (size_t)(n0 + nl) * K + k0 + kc) = o;
    }
  }
  __syncthreads();
}

using f32x16 = __attribute__((ext_vector_type(16))) float;
using bf16x8v = __attribute__((ext_vector_type(8))) __bf16;
#define MFMA32(a, b, c) __builtin_amdgcn_mfma_f32_32x32x16_bf16((a), (b), (c), 0, 0, 0)
constexpr float LOG2E = 1.4426950408889634f;
constexpr float NEGB = -1e30f;
DI int pi_perm(int i) { return (i & ~12) | ((i & 8) >> 1) | ((i & 4) << 1); }
DI bf16x8 pack8(float a0, float a1, float a2, float a3, float a4, float a5, float a6, float a7) {
  bf16x8v v = {(__bf16)a0, (__bf16)a1, (__bf16)a2, (__bf16)a3, (__bf16)a4, (__bf16)a5, (__bf16)a6, (__bf16)a7};
  return __builtin_bit_cast(bf16x8, v);
}
__device__ __forceinline__ void d_relayout_tile(int T, char* smem, const bf16_t* __restrict__ proj, int col0, bf16_t* __restrict__ dst, bool isV) {
  bf16_t* Ls = (bf16_t*)smem;
  const int tid = TIDX;
#pragma unroll
  for (int q = 0; q < 2; ++q) {
    const int cidx = tid + q * 512;
    const int g = cidx >> 9, tok = (cidx >> 4) & 31, ch = cidx & 15;
    const u32x4 v = *(const u32x4*)(proj + (size_t)(32 * T + tok) * INWP + col0 + g * 128 + ch * 8);
    *(u32x4*)(Ls + (g * 32 + tok) * 136 + ch * 8) = v;
  }
  __syncthreads();
#pragma unroll
  for (int q = 0; q < 2; ++q) {
    const int oc = tid + q * 512;
    const int g = oc >> 9, r9 = oc & 511, lane = r9 & 63;
    u32x4 o;
    if (!isV) {
      const int s8 = r9 >> 6, i = lane & 31, h = lane >> 5;
      o = *(const u32x4*)(Ls + (g * 32 + pi_perm(i)) * 136 + 16 * s8 + 8 * h);
    } else {
      const int s2 = (r9 >> 6) & 1, dt = r9 >> 7, dd = lane & 31, h = lane >> 5;
      const bf16_t* col = Ls + (g * 32 + 16 * s2 + 8 * h) * 136 + 32 * dt + dd;
      unsigned short e[8];
#pragma unroll
      for (int j = 0; j < 8; ++j) e[j] = col[j * 136];
      o.x = e[0] | ((unsigned)e[1] << 16); o.y = e[2] | ((unsigned)e[3] << 16); o.z = e[4] | ((unsigned)e[5] << 16); o.w = e[6] | ((unsigned)e[7] << 16);
    }
    *(u32x4*)(dst + (((size_t)(g * 512 + T)) * 512 + r9) * 8) = o;
  }
  __syncthreads();
}

struct AttnPtrs {
  const bf16_t* proj; const float* gates;
  const bf16_t *kcf, *vcf, *ksf, *vsf, *kwf, *vwf;
  bf16_t* mix; const float* hng;
};

DI float ex2(float x) { return __builtin_amdgcn_exp2f(x); }
DI void halves(float x, float& lo, float& hi) {
  const unsigned u = __float_as_uint(x);
  auto r = __builtin_amdgcn_permlane32_swap(u, u, false, false);
  lo = __uint_as_float(r[0]); hi = __uint_as_float(r[1]);
}
DI float hmax(float x) { float a, b; halves(x, a, b); return fmaxf(a, b); }
DI float hsum(float x) { float a, b; halves(x, a, b); return a + b; }
DI float dpp_quad(float v, int ctrl_is_xor1) {
  const int iv = __float_as_int(v);
  const int r = ctrl_is_xor1 ? __builtin_amdgcn_update_dpp(iv, iv, 0xB1, 0xF, 0xF, false) : __builtin_amdgcn_update_dpp(iv, iv, 0x4E, 0xF, 0xF, false);
  return __int_as_float(r);
}
DI float quad_sum(float v) { v += dpp_quad(v, 1); v += dpp_quad(v, 0); return v; }
DI void osm_step(const float (&sv)[16], float& m, float& l, f32x16 (&O)[4], float (&p)[16]) {
  float tmax = fmaxf(fmaxf(fmaxf(sv[0], sv[1]), fmaxf(sv[2], sv[3])), fmaxf(fmaxf(sv[4], sv[5]), fmaxf(sv[6], sv[7])));
  tmax = fmaxf(tmax, fmaxf(fmaxf(fmaxf(sv[8], sv[9]), fmaxf(sv[10], sv[11])), fmaxf(fmaxf(sv[12], sv[13]), fmaxf(sv[14], sv[15]))));
  tmax = hmax(tmax);
  if (__ballot(tmax - m > 8.f)) {
    const float mn = fmaxf(m, tmax);
    const float alpha = ex2(m - mn);
    l *= alpha; m = mn;
#pragma unroll
    for (int dt = 0; dt < 4; ++dt)
#pragma unroll
      for (int r = 0; r < 16; ++r) O[dt][r] *= alpha;
  }
  float ps0 = 0.f, ps1 = 0.f;
#pragma unroll
  for (int r = 0; r < 16; r += 2) { const float e0 = ex2(sv[r] - m), e1 = ex2(sv[r + 1] - m); p[r] = e0; p[r + 1] = e1; ps0 += e0; ps1 += e1; }
  l += ps0 + ps1;
}
DI void ot_store(char* otL, int lane, const f32x16 (&O)[4], float sc) {
#pragma unroll
  for (int dt = 0; dt < 4; ++dt) {
    u32x4 a, b;
#pragma unroll
    for (int i = 0; i < 4; ++i) { a[i] = pack2(sc * O[dt][2 * i], sc * O[dt][2 * i + 1]); b[i] = pack2(sc * O[dt][8 + 2 * i], sc * O[dt][8 + 2 * i + 1]); }
    *(u32x4*)(otL + lane * 128 + dt * 32) = a;
    *(u32x4*)(otL + lane * 128 + dt * 32 + 16) = b;
  }
}
DI void ot_accum(const char* otL, int lane, f32x16 (&O)[4], float sc) {
#pragma unroll
  for (int dt = 0; dt < 4; ++dt) {
    u32x4 a = *(const u32x4*)(otL + lane * 128 + dt * 32);
    u32x4 b = *(const u32x4*)(otL + lane * 128 + dt * 32 + 16);
#pragma unroll
    for (int i = 0; i < 4; ++i) {
      const unsigned wa = a[i], wb = b[i];
      O[dt][2 * i] = fmaf(sc, O[dt][2 * i], __uint_as_float(wa << 16));
      O[dt][2 * i + 1] = fmaf(sc, O[dt][2 * i + 1], __uint_as_float(wa & 0xFFFF0000u));
      O[dt][8 + 2 * i] = fmaf(sc, O[dt][8 + 2 * i], __uint_as_float(wb << 16));
      O[dt][8 + 2 * i + 1] = fmaf(sc, O[dt][8 + 2 * i + 1], __uint_as_float(wb & 0xFFFF0000u));
    }
  }
}
DI void zero_o(f32x16 (&O)[4]) {
#pragma unroll
  for (int dt = 0; dt < 4; ++dt)
#pragma unroll
    for (int i = 0; i < 16; ++i) O[dt][i] = 0.f;
}

constexpr int ATT_PW = 8704;
constexpr int ATT_R = 4, ATT_D = 3;
constexpr int ATT_RING = 8 * ATT_PW;
constexpr int ATT_LIST = ATT_RING + ATT_R * 16384;
constexpr int ATT_BUNI = ATT_LIST + 2048;
constexpr int ATT_SMEM = ATT_BUNI + 64;
#define LAS3 __attribute__((address_space(3)))
__device__ __forceinline__ void d_select(const float* impL, unsigned* mskL, unsigned* uniL, int cur) {
  const int lane = TIDX & 63;
  const int stok = lane >> 3, sub = lane & 7;
  unsigned key[32];
#pragma unroll
  for (int i4 = 0; i4 < 8; ++i4) {
    f32x4 v = *(const f32x4*)(impL + stok * 256 + sub * 32 + i4 * 4);
#pragma unroll
    for (int e = 0; e < 4; ++e) {
      const int j = sub * 32 + i4 * 4 + e;
      const bool valid = j <= cur;
      const bool forced = (j == 0) || (j == cur) || (j == cur - 1);
      unsigned kb = forced ? 0xFFFFFF00u : (__float_as_uint(v[e]) & 0xFFFFFF00u);
      key[i4 * 4 + e] = valid ? (kb | (unsigned)(255 - j)) : 0u;
    }
  }
#pragma unroll
  for (int k = 2; k <= 32; k <<= 1) {
#pragma unroll
    for (int jj = k >> 1; jj > 0; jj >>= 1) {
#pragma unroll
      for (int i = 0; i < 32; ++i) {
        const int l2 = i ^ jj;
        if (l2 > i) {
          const bool desc = ((i & k) == 0);
          unsigned a = key[i], b = key[l2];
          unsigned mx = a > b ? a : b, mn = a > b ? b : a;
          key[i] = desc ? mx : mn; key[l2] = desc ? mn : mx;
        }
      }
    }
  }
#pragma unroll
  for (int xm = 1; xm < 8; xm <<= 1) {
    unsigned L[16];
#pragma unroll
    for (int i = 0; i < 16; ++i) { unsigned o = (unsigned)shx_i((int)key[15 - i], xm); L[i] = key[i] > o ? key[i] : o; }
#pragma unroll
    for (int jj = 8; jj > 0; jj >>= 1) {
#pragma unroll
      for (int i = 0; i < 16; ++i) {
        const int l2 = i ^ jj;
        if (l2 > i) { unsigned a = L[i], b = L[l2]; L[i] = a > b ? a : b; L[l2] = a > b ? b : a; }
      }
    }
#pragma unroll
    for (int i = 0; i < 16; ++i) key[i] = L[i];
  }
#pragma unroll
  for (int i = 0; i < 16; ++i) {
    if ((i & 7) == sub) {
      const int j = 255 - (int)(key[i] & 255u);
      if (j <= cur) { atomicOr(&mskL[stok * 8 + (j >> 5)], 1u << (j & 31)); atomicOr(&uniL[j >> 5], 1u << (j & 31)); }
    }
  }
}


DI void att_issue(LAS3 unsigned char* ring, int slot, int w, int lane, const bf16_t* kb, const bf16_t* vb, int tile) {
  const char* ks = (const char*)kb + (size_t)tile * 8192 + w * 1024 + lane * 16;
  const char* vs = (const char*)vb + (size_t)tile * 8192 + w * 1024 + lane * 16;
  __builtin_amdgcn_global_load_lds((const unsigned*)ks, (LAS3 unsigned*)(ring + slot * 16384 + w * 1024), 16, 0, 0);
  __builtin_amdgcn_global_load_lds((const unsigned*)vs, (LAS3 unsigned*)(ring + slot * 16384 + 8192 + w * 1024), 16, 0, 0);
}
DI f32x16 qk_lds(LAS3 const unsigned char* kt, const bf16x8 (&qf)[8], int lane) {
  f32x16 acc;
#pragma unroll
  for (int i = 0; i < 16; ++i) acc[i] = 0.f;
#pragma unroll
  for (int s8 = 0; s8 < 8; ++s8) {
    const bf16x8 kf = *(LAS3 const bf16x8*)(kt + s8 * 1024 + lane * 16);
    acc = MFMA32(kf, qf[s8], acc);
  }
  return acc;
}
DI void pv_lds(LAS3 const unsigned char* vt, const float (&p)[16], f32x16 (&O)[4], int lane) {
  const bf16x8 pf0 = pack8(p[0], p[1], p[2], p[3], p[4], p[5], p[6], p[7]);
  const bf16x8 pf1 = pack8(p[8], p[9], p[10], p[11], p[12], p[13], p[14], p[15]);
#pragma unroll
  for (int dt = 0; dt < 4; ++dt) {
    const bf16x8 v0 = *(LAS3 const bf16x8*)(vt + (dt * 2) * 1024 + lane * 16);
    const bf16x8 v1 = *(LAS3 const bf16x8*)(vt + (dt * 2 + 1) * 1024 + lane * 16);
    O[dt] = MFMA32(v0, pf0, O[dt]);
    O[dt] = MFMA32(v1, pf1, O[dt]);
  }
}

__device__ __forceinline__ void d_attn_block(int B, int g, char* smem, const AttnPtrs& P) {
  const int tid = TIDX, lane = tid & 63, w = tid >> 6;
  const int c = lane & 31, h = lane >> 5, tokl = c >> 2, r = c & 3;
  const int tok0 = 64 * B + 8 * w;
  const int t = tok0 + tokl, hd = g * 4 + r;
  const float slope2 = exp2f(-(float)(hd + 1)) * LOG2E;
  const float c1 = QSCALE * LOG2E;
  const float ninf = -__builtin_inff();
  char* wsm = smem + w * ATT_PW;
  float* impL = (float*)wsm;
  char* otL = wsm;
  unsigned* mskL = (unsigned*)(wsm + 8192);
  unsigned* uniL = mskL + 64;
  LAS3 unsigned char* ring = (LAS3 unsigned char*)(smem + ATT_RING);
  unsigned short* tl = (unsigned short*)(smem + ATT_LIST);
  unsigned* buni = (unsigned*)(smem + ATT_BUNI);
  const bf16_t* kcf = P.kcf + (size_t)g * 32 * 4096;
  const bf16_t* vcf = P.vcf + (size_t)g * 32 * 4096;
  const bf16_t* ksf = P.ksf + (size_t)g * 512 * 4096;
  const bf16_t* vsf = P.vsf + (size_t)g * 512 * 4096;
  const bf16_t* kwf = P.kwf + (size_t)g * 512 * 4096;
  const bf16_t* vwf = P.vwf + (size_t)g * 512 * 4096;
  bf16x8 qf[8];
  {
    const bf16_t* qrow = P.proj + (size_t)t * INWP + OFF_Q + hd * 128 + 8 * h;
#pragma unroll
    for (int s8 = 0; s8 < 8; ++s8) qf[s8] = *(const bf16x8*)(qrow + 16 * s8);
  }
  const float* gt = P.gates + (size_t)t * 24 + hd * 3;
  const float g0 = gt[0], g1 = gt[1], g2 = gt[2];
  {
    unsigned z0 = 0u;
    asm volatile("" : "+v"(z0));
    u32x4 z = {z0, z0, z0, z0};
#pragma unroll
    for (int i = 0; i < 8; ++i) *(u32x4*)(wsm + (i * 64 + lane) * 16) = z;
    if (lane < 18) *(u32x4*)(wsm + 8192 + lane * 16) = z;
    if (tid < 8) buni[tid] = z0;
  }
  f32x16 Ob[4];
  zero_o(Ob);
  const int nmax = (t >= 31) ? ((t - 31) >> 4) : -1;
  const int nmaxw = (tok0 + 7 >= 31) ? ((tok0 + 7 - 31) >> 4) : -1;
  const int nminw = (tok0 >= 31) ? ((tok0 - 31) >> 4) : -1;
  const int ntcw = (nmaxw + 32) >> 5;
  const int ntcB = (((64 * B + 63 - 31) >> 4) + 32) >> 5;
  const float sl16 = slope2 * 16.f;
  float mC = NEGB, lC = 0.f, invC = 0.f, carry = 0.f;
  {
    const int n = 2 * ntcB;
    asm volatile("s_waitcnt vmcnt(0)" ::: "memory");
#define A_TILE(i_) (((i_) < ntcB) ? (ntcB - 1 - (i_)) : ((i_) - ntcB))
    att_issue(ring, 0, w, lane, kcf, vcf, A_TILE(0));
    if (n > 1) att_issue(ring, 1, w, lane, kcf, vcf, A_TILE(1));
#pragma unroll 1
    for (int i = 0; i < n; ++i) {
      if ((i & 1) == 0) {
        asm volatile("s_waitcnt vmcnt(0)" ::: "memory");
        __builtin_amdgcn_s_barrier();
        asm volatile("" ::: "memory");
        if (i + 2 < n) att_issue(ring, (i + 2) & 3, w, lane, kcf, vcf, A_TILE(i + 2));
        if (i + 3 < n) att_issue(ring, (i + 3) & 3, w, lane, kcf, vcf, A_TILE(i + 3));
      }
      const int T = A_TILE(i);
      if (T >= ntcw) continue;
      LAS3 const unsigned char* slot = ring + (i % ATT_R) * 16384;
      const f32x16 acc = qk_lds(slot, qf, lane);
      const float base = slope2 * (float)(512 * T + 128 * h) + slope2 * (15.5f - (float)t);
      const int nb = 32 * T + 8 * h;
      const bool full = (32 * T + 31 <= nminw);
      float sv[16];
#pragma unroll
      for (int rg = 0; rg < 16; ++rg) { const int kk = (rg & 7) + 16 * (rg >> 3); sv[rg] = fmaf(acc[rg], c1, fmaf(sl16, (float)kk, base)); }
      if (!full) {
#pragma unroll
        for (int rg = 0; rg < 16; ++rg) { const int kk = (rg & 7) + 16 * (rg >> 3); sv[rg] = (nb + kk <= nmax) ? sv[rg] : ninf; }
      }
      if (i < ntcB) {
        float tmax = fmaxf(fmaxf(fmaxf(sv[0], sv[1]), fmaxf(sv[2], sv[3])), fmaxf(fmaxf(sv[4], sv[5]), fmaxf(sv[6], sv[7])));
        tmax = fmaxf(tmax, fmaxf(fmaxf(fmaxf(sv[8], sv[9]), fmaxf(sv[10], sv[11])), fmaxf(fmaxf(sv[12], sv[13]), fmaxf(sv[14], sv[15]))));
        tmax = hmax(tmax);
        const float mn = fmaxf(mC, tmax);
        float ps = 0.f;
#pragma unroll
        for (int rg = 0; rg < 16; ++rg) ps += ex2(sv[rg] - mn);
        lC = lC * ex2(mC - mn) + ps; mC = mn;
      } else {
        if (T == 0) { lC = hsum(lC); invC = (lC > 0.f) ? 1.f / lC : 0.f; }
        float p[16];
#pragma unroll
        for (int rg = 0; rg < 16; ++rg) p[rg] = ex2(sv[rg] - mC) * invC;
        float Ga = (p[0] + p[1]) + (p[2] + p[3]), Gb = (p[4] + p[5]) + (p[6] + p[7]);
        float Gc = (p[8] + p[9]) + (p[10] + p[11]), Gd = (p[12] + p[13]) + (p[14] + p[15]);
        float xb, xd; { float a_, b_; halves(p[7], a_, b_); xb = h ? a_ : b_; halves(p[15], a_, b_); xd = h ? a_ : b_; }
        float ia = Ga + (h ? xb : carry);
        float ib = Gb + p[3];
        float ic = Gc + (h ? xd : xb);
        float id = Gd + p[11];
        carry = xd;
        ia = quad_sum(ia); ib = quad_sum(ib); ic = quad_sum(ic); id = quad_sum(id);
        {
          float val = (r == 0) ? ia : (r == 1) ? ib : (r == 2) ? ic : id;
          int j = 8 * T + 2 * h + ((r == 0) ? 0 : (r == 1) ? 1 : (r == 2) ? 4 : 5);
          impL[tokl * 256 + j] = val;
        }
        pv_lds(slot + 8192, p, Ob, lane);
      }
    }
#undef A_TILE
  }
  const int cur = B;
  d_select(impL, mskL, uniL, cur);
  ot_store(otL, lane, Ob, g0);
  zero_o(Ob);
  if (lane < 8) { const unsigned u = uniL[lane]; if (u) atomicOr(&buni[lane], u); }
  __syncthreads();
  int nslc = 0, ntl = 0;
  {
    for (int iw = 7; iw >= 0; --iw) {
      unsigned iuw = __builtin_amdgcn_readfirstlane(buni[iw]);
      while (iuw) {
        const int bit = 31 - __builtin_clz(iuw);
        iuw &= ~(1u << bit);
        const int bb = 32 * iw + bit;
        if (bb < B) { if (lane == 0) tl[ntl] = (unsigned short)(2 * bb + 1); ++ntl; }
        else { if (lane == 0) tl[ntl] = (unsigned short)(2 * bb + 1); ++ntl; }
        if (lane == 0) tl[ntl] = (unsigned short)(2 * bb);
        ++ntl;
      }
    }
    nslc = ntl;
    const int ThiB = 2 * B + 1, TloB = ((64 * B - 511 > 0) ? (64 * B - 511) : 0) >> 5;
    for (int T = ThiB; T >= TloB; --T) { if (lane == 0) tl[ntl] = (unsigned short)T; ++ntl; }
  }
  float m = NEGB, l = 0.f;
  {
    const int n = ntl;
    const int Tlow = ((tok0 - 511 > 0) ? (tok0 - 511) : 0) >> 5, Thiw = (tok0 + 7) >> 5;
#define B_ISSUE(j_, slot_) { const int e_ = __builtin_amdgcn_readfirstlane((int)tl[j_]); if ((j_) < nslc) att_issue(ring, slot_, w, lane, ksf, vsf, e_); else att_issue(ring, slot_, w, lane, kwf, vwf, e_); }
    B_ISSUE(0, 0)
    if (n > 1) B_ISSUE(1, 1)
#pragma unroll 1
    for (int i = 0; i < n; ++i) {
      if ((i & 1) == 0) {
        asm volatile("s_waitcnt vmcnt(0)" ::: "memory");
        __builtin_amdgcn_s_barrier();
        asm volatile("" ::: "memory");
        if (i + 2 < n) B_ISSUE(i + 2, (i + 2) & 3)
        if (i + 3 < n) B_ISSUE(i + 3, (i + 3) & 3)
      }
      if (i == nslc) {
        l = hsum(l);
        const float inv = (l > 0.f) ? g1 / l : 0.f;
        ot_accum(otL, lane, Ob, inv);
        ot_store(otL, lane, Ob, 1.f);
        zero_o(Ob);
        m = NEGB; l = 0.f;
      }
      const int T = __builtin_amdgcn_readfirstlane((int)tl[i]);
      const int pos0 = 32 * T, pb = pos0 + 8 * h;
      bool full; bool mine = true;
      if (i < nslc) {
        const int bb = T >> 1;
        const unsigned uw = __builtin_amdgcn_readfirstlane(uniL[bb >> 5]);
        if (!((uw >> (bb & 31)) & 1u) || pos0 > tok0 + 7) continue;
        mine = (mskL[tokl * 8 + (bb >> 5)] >> (bb & 31)) & 1u;
        full = (pos0 + 31 <= tok0) && (__ballot(!mine) == 0ull);
      } else {
        if (T < Tlow || T > Thiw) continue;
        full = (pos0 + 31 <= tok0) && (pos0 >= tok0 + 7 - 511);
      }
      LAS3 const unsigned char* slot = ring + (i % ATT_R) * 16384;
      const f32x16 acc = qk_lds(slot, qf, lane);
      const float base = slope2 * (float)(pos0 + 8 * h - t);
      float sv[16], p[16];
#pragma unroll
      for (int rg = 0; rg < 16; ++rg) { const int kk = (rg & 7) + 16 * (rg >> 3); sv[rg] = fmaf(acc[rg], c1, fmaf(slope2, (float)kk, base)); }
      if (!full) {
        if (i < nslc) {
#pragma unroll
          for (int rg = 0; rg < 16; ++rg) { const int kk = (rg & 7) + 16 * (rg >> 3); sv[rg] = (mine && (pb + kk <= t)) ? sv[rg] : ninf; }
        } else {
#pragma unroll
          for (int rg = 0; rg < 16; ++rg) { const int kk = (rg & 7) + 16 * (rg >> 3); const int dw = t - (pb + kk); sv[rg] = ((dw >= 0) && (dw < 512)) ? sv[rg] : ninf; }
        }
      }
      osm_step(sv, m, l, Ob, p);
      pv_lds(slot + 8192, p, Ob, lane);
    }
#undef B_ISSUE
    l = hsum(l);
    const float inv = (l > 0.f) ? g2 / l : 0.f;
    ot_accum(otL, lane, Ob, inv);
  }
  {
    float ss = 0.f;
#pragma unroll
    for (int dt = 0; dt < 4; ++dt)
#pragma unroll
      for (int i = 0; i < 16; ++i) ss = fmaf(Ob[dt][i], Ob[dt][i], ss);
    ss = hsum(ss);
    const float rs = rsqrtf(ss * (1.f / 128.f) + 1e-6f);
    bf16_t* orow = P.mix + (size_t)t * DM + hd * 128 + 4 * h;
    const float* grow = P.hng + hd * 128 + 4 * h;
#pragma unroll
    for (int dt = 0; dt < 4; ++dt)
#pragma unroll
      for (int a = 0; a < 4; ++a) {
        const f32x4 gv = *(const f32x4*)(grow + 32 * dt + 8 * a);
        u32x2 wv2 = {pack2(Ob[dt][4 * a] * rs * gv[0], Ob[dt][4 * a + 1] * rs * gv[1]), pack2(Ob[dt][4 * a + 2] * rs * gv[2], Ob[dt][4 * a + 3] * rs * gv[3])};
        *(u32x2*)(orow + 32 * dt + 8 * a) = wv2;
      }
  }
  asm volatile("s_waitcnt vmcnt(0)" ::: "memory");
  __syncthreads();
}

__device__ void d_convmix(int t, int tl, const bf16_t* __restrict__ proj, const float* __restrict__ convw, const float* __restrict__ hng,
                          bf16_t* __restrict__ mix) {
  const int c = tl * 8;
  float acc[8];
#pragma unroll
  for (int i = 0; i < 8; ++i) acc[i] = 0.f;
#pragma unroll
  for (int j = 0; j < 3; ++j) {
    const int tt = t - 2 + j;
    if (tt >= 0) {
      const u32x4 cu = *(const u32x4*)(proj + (size_t)tt * INWP + OFF_C + c);
      const u32x4 uu = *(const u32x4*)(proj + (size_t)tt * INWP + OFF_U + c);
      const f32x4 w0 = *(const f32x4*)(convw + j * 1024 + c), w1 = *(const f32x4*)(convw + j * 1024 + c + 4);
#pragma unroll
      for (int i = 0; i < 4; ++i) {
        const unsigned a = cu[i], b = uu[i];
        const float wl = (i < 2) ? w0[2 * i] : w1[2 * i - 4], wh = (i < 2) ? w0[2 * i + 1] : w1[2 * i - 3];
        acc[2 * i] = fmaf(wl * __uint_as_float(a << 16), __uint_as_float(b << 16), acc[2 * i]);
        acc[2 * i + 1] = fmaf(wh * __uint_as_float(a & 0xFFFF0000u), __uint_as_float(b & 0xFFFF0000u), acc[2 * i + 1]);
      }
    }
  }
  const u32x4 bb = *(const u32x4*)(proj + (size_t)t * INWP + OFF_B + c);
  float ss = 0.f;
#pragma unroll
  for (int i = 0; i < 4; ++i) {
    const unsigned b = bb[i];
    acc[2 * i] *= __uint_as_float(b << 16); acc[2 * i + 1] *= __uint_as_float(b & 0xFFFF0000u);
    ss = fmaf(acc[2 * i], acc[2 * i], ss); ss = fmaf(acc[2 * i + 1], acc[2 * i + 1], ss);
  }
  ss += shx(ss, 8); ss += shx(ss, 4); ss += shx(ss, 2); ss += shx(ss, 1);
  const float rs = rsqrtf(ss * (1.f / 128.f) + 1e-6f);
  const f32x4 g0 = *(const f32x4*)(hng + 1024 + c), g1 = *(const f32x4*)(hng + 1024 + c + 4);
  u32x4 o = {pack2(acc[0] * rs * g0[0], acc[1] * rs * g0[1]), pack2(acc[2] * rs * g0[2], acc[3] * rs * g0[3]),
             pack2(acc[4] * rs * g1[0], acc[5] * rs * g1[1]), pack2(acc[6] * rs * g1[2], acc[7] * rs * g1[3])};
  *(u32x4*)(mix + (size_t)t * DM + 1024 + c) = o;
}

__device__ void d_ln_wave(int t, bf16_t* __restrict__ yh, const float* __restrict__ gam, const float* __restrict__ bet) {
  const int lane = TIDX & 63;
  float v[32];
#pragma unroll
  for (int i = 0; i < 4; ++i) {
    const u32x4 w = *(const u32x4*)(yh + (size_t)t * DM + 512 * i + 8 * lane);
#pragma unroll
    for (int j = 0; j < 4; ++j) { const unsigned ww = w[j]; v[i * 8 + 2 * j] = __uint_as_float(ww << 16); v[i * 8 + 2 * j + 1] = __uint_as_float(ww & 0xFFFF0000u); }
  }
  float s = 0.f;
#pragma unroll
  for (int i = 0; i < 32; ++i) s += v[i];
  s = wave_sum(s);
  const float mu = s * (1.f / DM);
  float q = 0.f;
#pragma unroll
  for (int i = 0; i < 32; ++i) { const float d = v[i] - mu; q = fmaf(d, d, q); }
  q = wave_sum(q);
  const float rs = rsqrtf(q * (1.f / DM) + 1e-5f);
#pragma unroll
  for (int i = 0; i < 4; ++i) {
    const int cb = 512 * i + 8 * lane;
    const f32x4 g0 = *(const f32x4*)(gam + cb), g1 = *(const f32x4*)(gam + cb + 4), b0 = *(const f32x4*)(bet + cb), b1 = *(const f32x4*)(bet + cb + 4);
    u32x4 o = {pack2((v[i * 8 + 0] - mu) * rs * g0[0] + b0[0], (v[i * 8 + 1] - mu) * rs * g0[1] + b0[1]), pack2((v[i * 8 + 2] - mu) * rs * g0[2] + b0[2], (v[i * 8 + 3] - mu) * rs * g0[3] + b0[3]),
               pack2((v[i * 8 + 4] - mu) * rs * g1[0] + b1[0], (v[i * 8 + 5] - mu) * rs * g1[1] + b1[1]), pack2((v[i * 8 + 6] - mu) * rs * g1[2] + b1[2], (v[i * 8 + 7] - mu) * rs * g1[3] + b1[3])};
    *(u32x4*)(yh + (size_t)t * DM + cb) = o;
  }
}

__device__ void d_cvt_w1f(size_t c, const float* __restrict__ w1, bf16_t* __restrict__ w1f) {
  const int lane = c & 63, ks = (c >> 6) & 255, ct = c >> 14;
  const int col = lane & 31, h = lane >> 5;
  bf16_t v[8];
#pragma unroll
  for (int j = 0; j < 8; ++j) v[j] = f2bf(w1[(size_t)(16 * ks + 8 * h + j) * 512 + 32 * ct + col]);
  u32x4 o; o.x = v[0] | ((unsigned)v[1] << 16); o.y = v[2] | ((unsigned)v[3] << 16); o.z = v[4] | ((unsigned)v[5] << 16); o.w = v[6] | ((unsigned)v[7] << 16);
  *(u32x4*)(w1f + c * 8) = o;
}
__device__ void d_cvt_w2f(size_t c, const float* __restrict__ w2, bf16_t* __restrict__ w2f) {
  const int lane = c & 63, s = (c >> 6) & 31, ct = c >> 11;
  const int col = lane & 31, h = lane >> 5;
  bf16_t v[8];
#pragma unroll
  for (int j = 0; j < 8; ++j) v[j] = f2bf(w2[(size_t)(16 * s + 8 * h + j) * 128 + 32 * ct + col]);
  u32x4 o; o.x = v[0] | ((unsigned)v[1] << 16); o.y = v[2] | ((unsigned)v[3] << 16); o.z = v[4] | ((unsigned)v[5] << 16); o.w = v[6] | ((unsigned)v[7] << 16);
  *(u32x4*)(w2f + c * 8) = o;
}
__device__ __forceinline__ void d_compress_unit(int rt, char* smem, const bf16_t* __restrict__ proj, int col0, const float* __restrict__ pos,
                                const bf16_t* __restrict__ w1f, const float* __restrict__ b1, const bf16_t* __restrict__ w2f,
                                bf16_t* __restrict__ outf, bool isV) {
  bf16_t* Xs = (bf16_t*)smem;
  bf16_t* Hs = (bf16_t*)(smem + 2 * 8704);
  const int tid = TIDX, lane = tid & 63, w = tid >> 6, c = lane & 31, h = lane >> 5;
  const int R0 = rt * 32;
  const int srow = tid >> 4, sch = tid & 15;
  const int grow = R0 + srow, sn = grow >> 1, sg = grow & 1;
  const bool svalid = grow < 2046;
  const bf16_t* sp = proj + (size_t)(16 * sn) * INWP + col0 + sg * 128 + sch * 8;
  f32x16 acc0, acc1;
#pragma unroll
  for (int i = 0; i < 16; ++i) { acc0[i] = 0.f; acc1[i] = 0.f; }
  u32x4 rx = {0u, 0u, 0u, 0u}; f32x4 rp0, rp1;
#define STAGE_WRITE(buf)                                                                                   \
  {                                                                                                        \
    u32x4 o_;                                                                                              \
    _Pragma("unroll") for (int i = 0; i < 4; ++i) {                                                        \
      const unsigned wv_ = rx[i];                                                                          \
      const float lo = __uint_as_float(wv_ << 16) + ((i < 2) ? rp0[2 * i] : rp1[2 * i - 4]);               \
      const float hi = __uint_as_float(wv_ & 0xFFFF0000u) + ((i < 2) ? rp0[2 * i + 1] : rp1[2 * i - 3]);   \
      o_[i] = pack2(lo, hi);                                                                               \
    }                                                                                                      \
    *(u32x4*)(Xs + (buf) * 4352 + srow * 136 + sch * 8) = o_;                                              \
  }
  if (svalid) rx = *(const u32x4*)(sp);
  rp0 = *(const f32x4*)(pos + sch * 8); rp1 = *(const f32x4*)(pos + sch * 8 + 4);
  STAGE_WRITE(0)
  __syncthreads();
  const bf16_t* wb0 = w1f + ((size_t)(2 * w) * 256 * 64 + lane) * 8;
  const bf16_t* wb1 = w1f + ((size_t)(2 * w + 1) * 256 * 64 + lane) * 8;
  bf16x8 bA[16], bB[16];
#define CMP_LOADB(BUF, L)                                                                      \
  _Pragma("unroll") for (int s8 = 0; s8 < 8; ++s8) {                                           \
    BUF[2 * s8] = *(const bf16x8*)(wb0 + (size_t)(8 * (L) + s8) * 512);                        \
    BUF[2 * s8 + 1] = *(const bf16x8*)(wb1 + (size_t)(8 * (L) + s8) * 512);                    \
  }
#define CMP_CHUNK(BUF, L)                                                                      \
  {                                                                                            \
    if ((L) + 1 < 32) {                                                                        \
      if (svalid) rx = *(const u32x4*)(sp + (size_t)((L) + 1) * INWP);                         \
      rp0 = *(const f32x4*)(pos + ((L) + 1) * 128 + sch * 8); rp1 = *(const f32x4*)(pos + ((L) + 1) * 128 + sch * 8 + 4); \
    }                                                                                          \
    const bf16_t* xa = Xs + ((L) & 1) * 4352 + c * 136 + 8 * h;                                \
    _Pragma("unroll") for (int s8 = 0; s8 < 8; ++s8) {                                         \
      const bf16x8 a = *(const bf16x8*)(xa + 16 * s8);                                         \
      acc0 = MFMA32(a, BUF[2 * s8], acc0);                                                     \
      acc1 = MFMA32(a, BUF[2 * s8 + 1], acc1);                                                 \
    }                                                                                          \
    if ((L) + 1 < 32) STAGE_WRITE(((L) + 1) & 1)                                               \
    __syncthreads();                                                                           \
  }
  CMP_LOADB(bA, 0)
#pragma unroll 1
  for (int l = 0; l < 32; l += 2) {
    CMP_LOADB(bB, l + 1)
    __builtin_amdgcn_sched_barrier(0);
    CMP_CHUNK(bA, l)
    { const int ln = (l + 2 < 32) ? l + 2 : l;
      CMP_LOADB(bA, ln) }
    __builtin_amdgcn_sched_barrier(0);
    CMP_CHUNK(bB, l + 1)
  }
#undef CMP_LOADB
#undef CMP_CHUNK
  {
    const float bb0 = b1[64 * w + c], bb1 = b1[64 * w + 32 + c];
#pragma unroll
    for (int rg = 0; rg < 16; ++rg) {
      const int row = (rg & 3) + 8 * (rg >> 2) + 4 * h;
      Hs[row * 520 + 64 * w + c] = f2bf(gelu_tanh(acc0[rg] + bb0));
      Hs[row * 520 + 64 * w + 32 + c] = f2bf(gelu_tanh(acc1[rg] + bb1));
    }
  }
  __syncthreads();
  if (w < 4) {
    f32x16 o2;
#pragma unroll
    for (int i = 0; i < 16; ++i) o2[i] = 0.f;
    const bf16_t* ha = Hs + c * 520 + 8 * h;
    const bf16_t* wb = w2f + ((size_t)w * 32 * 64 + lane) * 8;
#pragma unroll 8
    for (int s2 = 0; s2 < 32; ++s2) {
      const bf16x8 a = *(const bf16x8*)(ha + 16 * s2);
      const bf16x8 b = *(const bf16x8*)(wb + (size_t)s2 * 512);
      o2 = MFMA32(a, b, o2);
    }
    const int d = 32 * w + c;
#pragma unroll
    for (int rg = 0; rg < 16; ++rg) {
      const int row = R0 + (rg & 3) + 8 * (rg >> 2) + 4 * h;
      const int n = row >> 1, g = row & 1;
      const bf16_t val = (row < 2046) ? f2bf(o2[rg]) : (bf16_t)0;
      const int T = n >> 5, nn = n & 31;
      size_t idx;
      if (!isV) idx = ((((size_t)(g * 32 + T) * 8 + (d >> 4)) * 64 + (pi_perm(nn) + 32 * ((d >> 3) & 1))) * 8 + (d & 7));
      else idx = (((((size_t)(g * 32 + T) * 4 + (d >> 5)) * 2 + (nn >> 4)) * 64 + ((d & 31) + 32 * ((nn >> 3) & 1))) * 8 + (nn & 7));
      outf[idx] = val;
    }
  }
  __syncthreads();
}


DI unsigned f2sort(float f) { unsigned u = __float_as_uint(f); return u ^ ((unsigned)((int)u >> 31) | 0x80000000u); }
DI float sort2f(unsigned k) { unsigned u = (k & 0x80000000u) ? (k ^ 0x80000000u) : ~k; return __uint_as_float(u); }
template <int N>
DI void bitonic_sort_desc(unsigned (&key)[N]) {
#pragma unroll
  for (int k = 2; k <= N; k <<= 1) {
#pragma unroll
    for (int jj = k >> 1; jj > 0; jj >>= 1) {
#pragma unroll
      for (int i = 0; i < N; ++i) {
        const int l2 = i ^ jj;
        if (l2 > i) {
          const bool desc = ((i & k) == 0);
          unsigned a = key[i], b = key[l2];
          unsigned mx = a > b ? a : b, mn = a > b ? b : a;
          key[i] = desc ? mx : mn; key[l2] = desc ? mn : mx;
        }
      }
    }
  }
}
DI void merge_top16(unsigned (&a)[16], const unsigned (&b)[16]) {
#pragma unroll
  for (int i = 0; i < 16; ++i) { unsigned o = b[15 - i]; a[i] = a[i] > o ? a[i] : o; }
#pragma unroll
  for (int jj = 8; jj > 0; jj >>= 1) {
#pragma unroll
    for (int i = 0; i < 16; ++i) {
      const int l2 = i ^ jj;
      if (l2 > i) { unsigned x = a[i], y = a[l2]; a[i] = x > y ? x : y; a[l2] = x > y ? y : x; }
    }
  }
}
__device__ void d_cvt_subk(size_t c, const float* __restrict__ subk, bf16_t* __restrict__ skf) {
  int lane = c & 63, s = (c >> 6) & 7, kt = (c >> 9) & 3, hc = c >> 11;
  int i = lane & 31, h = lane >> 5;
  const float* src = subk + ((size_t)hc * 128 + 32 * kt + i) * 128 + 16 * s + 8 * h;
  bf16_t v[8];
#pragma unroll
  for (int j = 0; j < 8; ++j) v[j] = f2bf(src[j]);
  u32x4 o; o.x = v[0] | ((unsigned)v[1] << 16); o.y = v[2] | ((unsigned)v[3] << 16); o.z = v[4] | ((unsigned)v[5] << 16); o.w = v[6] | ((unsigned)v[7] << 16);
  *(u32x4*)(skf + c * 8) = o;
}

#define EPI_LANES()                                                                                                      \
    const int lane = fr | (fq << 4), rr = lane >> 2, rc = lane & 3;                                                       \
    PG8_LAS unsigned char* my = scr + (wr * 4 + wc) * 2048;                                                              \
    const int wo = fr * 64 + ((fq ^ ((fr >> 2) & 3)) << 4), ro = rr * 64 + ((rc ^ ((rr >> 2) & 3)) << 4);
struct EpiProjG {
  static constexpr bool PERM = true, AFTER_DRAIN = false;
  bf16_t* proj; float* gates; PG8_LAS unsigned char* scr;
  DI void operator()(const f32x4 (&acc)[2][2][4][2], const pg8::Unit& u, int wr, int wc, int fr, int fq) const {
    EPI_LANES()
#pragma unroll
    for (int ai = 0; ai < 2; ++ai)
#pragma unroll
      for (int bj = 0; bj < 2; ++bj) {
        const int c0 = u.pn * 256 + bj * 128 + wc * 32 + 8 * fq, cs = u.pn * 256 + bj * 128 + wc * 32 + 8 * rc;
#pragma unroll
        for (int mh = 0; mh < 2; ++mh) {
#pragma unroll
          for (int mm = 0; mm < 2; ++mm) {
            const f32x4 v0 = acc[ai][bj][mh * 2 + mm][0], v1 = acc[ai][bj][mh * 2 + mm][1];
            u32x4 w = {pack2(v0[0], v0[1]), pack2(v0[2], v0[3]), pack2(v1[0], v1[1]), pack2(v1[2], v1[3])};
            *(PG8_LAS u32x4*)(my + wo + mm * 1024) = w;
            if (c0 >= OFF_G && c0 < OFF_G + 24) {
              const int row = u.pm * 256 + ai * 128 + wr * 64 + (mh * 2 + mm) * 16 + fr;
              f32x4 g0, g1;
#pragma unroll
              for (int j = 0; j < 4; ++j) { g0[j] = 1.f / (1.f + __expf(-v0[j])); g1[j] = 1.f / (1.f + __expf(-v1[j])); }
              *(f32x4*)(gates + (size_t)row * 24 + (c0 - OFF_G)) = g0;
              *(f32x4*)(gates + (size_t)row * 24 + (c0 - OFF_G) + 4) = g1;
            }
          }
#pragma unroll
          for (int j = 0; j < 2; ++j) {
            const u32x4 w = *(const PG8_LAS u32x4*)(my + ro + j * 1024);
            const int row = u.pm * 256 + ai * 128 + wr * 64 + mh * 32 + j * 16 + rr;
            if (cs < INW) *(u32x4*)(proj + (size_t)row * INWP + cs) = w;
          }
        }
      }
  }
};
struct EpiResG {
  static constexpr bool PERM = true, AFTER_DRAIN = false;
  bf16_t* YB; PG8_LAS unsigned char* scr;
  DI void operator()(const f32x4 (&acc)[2][2][4][2], const pg8::Unit& u, int wr, int wc, int fr, int fq) const {
    EPI_LANES()
    bf16_t* yb = YB + (size_t)(u.pm * 256 + wr * 64 + rr) * DM + u.pn * 256 + wc * 32 + 8 * rc;
#pragma unroll
    for (int ai = 0; ai < 2; ++ai) {
      u32x4 xr[2][2][2];
#pragma unroll
      for (int bj = 0; bj < 2; ++bj)
#pragma unroll
        for (int mh = 0; mh < 2; ++mh)
#pragma unroll
          for (int j = 0; j < 2; ++j) xr[bj][mh][j] = *(const u32x4*)(yb + (size_t)(ai * 128 + mh * 32 + j * 16) * DM + bj * 128);
#pragma unroll
      for (int bj = 0; bj < 2; ++bj)
#pragma unroll
        for (int mh = 0; mh < 2; ++mh) {
#pragma unroll
          for (int mm = 0; mm < 2; ++mm) {
            const f32x4 v0 = acc[ai][bj][mh * 2 + mm][0], v1 = acc[ai][bj][mh * 2 + mm][1];
            u32x4 w = {pack2(v0[0], v0[1]), pack2(v0[2], v0[3]), pack2(v1[0], v1[1]), pack2(v1[2], v1[3])};
            *(PG8_LAS u32x4*)(my + wo + mm * 1024) = w;
          }
#pragma unroll
          for (int j = 0; j < 2; ++j) {
            const u32x4 a = *(const PG8_LAS u32x4*)(my + ro + j * 1024), xw = xr[bj][mh][j];
            u32x4 o;
#pragma unroll
            for (int q = 0; q < 4; ++q) {
              const unsigned aw = a[q], xq = xw[q];
              o[q] = pack2(fmaf(ALPHA, __uint_as_float(xq << 16), __uint_as_float(aw << 16)), fmaf(ALPHA, __uint_as_float(xq & 0xFFFF0000u), __uint_as_float(aw & 0xFFFF0000u)));
            }
            *(u32x4*)(yb + (size_t)(ai * 128 + mh * 32 + j * 16) * DM + bj * 128) = o;
          }
        }
    }
  }
};
struct EpiF32G {
  static constexpr bool PERM = false, AFTER_DRAIN = false;
  float* C; int ldc;
  DI void operator()(const f32x4 (&acc)[2][2][4][2], const pg8::Unit& u, int wr, int wc, int fr, int fq) const {
#pragma unroll
    for (int ai = 0; ai < 2; ++ai)
#pragma unroll
      for (int m = 0; m < 4; ++m) {
        const size_t ro = (size_t)(u.pm * 256 + ai * 128 + wr * 64 + m * 16 + fr) * ldc + u.pn * 256 + wc * 32 + 4 * fq;
#pragma unroll
        for (int bj = 0; bj < 2; ++bj)
#pragma unroll
          for (int n = 0; n < 2; ++n) *(f32x4*)(C + ro + bj * 128 + n * 16) = acc[ai][bj][m][n];
      }
  }
};
struct EpiRouteG {
  static constexpr bool PERM = false, AFTER_DRAIN = true;
  const bf16_t* skf; unsigned* tops;
  DI void operator()(const f32x4 (&)[2][2][4][2], const pg8::Unit&, int, int, int, int) const {}
  DI void fused(const f32x4 (&acc)[2][2][4][2], const pg8::Unit& u, int wr, int wc, int fr, int fq, PG8_LAS unsigned char* ldsp, int, int) const {
    const int lane = fr | (fq << 4), wid = wr * 4 + wc;
    bf16_t* Qs = (bf16_t*)ldsp;
#pragma unroll
    for (int ai = 0; ai < 2; ++ai)
#pragma unroll
      for (int m = 0; m < 4; ++m) {
        const int row = ai * 128 + wr * 64 + m * 16 + fr;
#pragma unroll
        for (int bj = 0; bj < 2; ++bj)
#pragma unroll
          for (int n = 0; n < 2; ++n) {
            const f32x4 v = acc[ai][bj][m][n];
            u32x2 w = {pack2(v[0], v[1]), pack2(v[2], v[3])};
            *(u32x2*)(Qs + row * 264 + bj * 128 + wc * 32 + n * 16 + 4 * fq) = w;
          }
      }
    __syncthreads();
    const int c = lane & 31, h = lane >> 5;
#pragma unroll 1
    for (int half = 0; half < 2; ++half) {
      const int hc = u.pn * 2 + half;
      const bf16_t* sk = skf + (size_t)hc * 4 * 4096;
      const bf16_t* qp = Qs + (wid * 32 + c) * 264 + half * 128 + 8 * h;
      unsigned k0[16], k1[16];
#define ROUTE_KT(KT, KA)                                                                        \
      {                                                                                         \
        f32x16 sc;                                                                              \
        _Pragma("unroll") for (int i = 0; i < 16; ++i) sc[i] = 0.f;                             \
        _Pragma("unroll") for (int s = 0; s < 8; ++s) {                                         \
          bf16x8 af = *(const bf16x8*)(sk + (KT) * 4096 + s * 512 + lane * 8);                  \
          bf16x8 bq = *(const bf16x8*)(qp + 16 * s);                                            \
          sc = __builtin_amdgcn_mfma_f32_32x32x16_bf16(af, bq, sc, 0, 0, 0);                    \
        }                                                                                       \
        _Pragma("unroll") for (int rg = 0; rg < 16; ++rg) {                                     \
          const int kidx = 32 * (KT) + (rg & 3) + 8 * (rg >> 2) + 4 * h;                        \
          KA[rg] = (f2sort(sc[rg]) & 0xFFFFFF80u) | (unsigned)(127 - kidx);                     \
        }                                                                                       \
        bitonic_sort_desc<16>(KA);                                                              \
      }
      ROUTE_KT(0, k0)
      __builtin_amdgcn_sched_barrier(0);
      ROUTE_KT(1, k1)
      merge_top16(k0, k1);
      __builtin_amdgcn_sched_barrier(0);
      ROUTE_KT(2, k1)
      merge_top16(k0, k1);
      __builtin_amdgcn_sched_barrier(0);
      ROUTE_KT(3, k1)
      merge_top16(k0, k1);
      __builtin_amdgcn_sched_barrier(0);
#undef ROUTE_KT
#pragma unroll
      for (int i = 0; i < 16; ++i) k1[i] = (unsigned)shx_i((int)k0[i], 32);
      merge_top16(k0, k1);
      if (h == 0) {
        unsigned* dst = tops + ((size_t)(u.pm * 256 + wid * 32 + c) * 16 + hc) * 16;
#pragma unroll
        for (int q4 = 0; q4 < 4; ++q4) { u32x4 o = {k0[4 * q4], k0[4 * q4 + 1], k0[4 * q4 + 2], k0[4 * q4 + 3]}; *(u32x4*)(dst + 4 * q4) = o; }
      }
    }
    __syncthreads();
  }
};


template <int CTRL> DI float dpp_f(float v) { const int iv = __float_as_int(v); return __int_as_float(__builtin_amdgcn_update_dpp(iv, iv, CTRL, 0xF, 0xF, false)); }
DI float wsum(float x) {
  x += dpp_f<0xB1>(x);
  x += dpp_f<0x4E>(x);
  x += dpp_f<0x124>(x);
  x += dpp_f<0x128>(x);
  x += shx(x, 16);
  return hsum(x);
}
DI float gelu_fast(float x) {
  const float u2 = 1.5957691216057308f * (x + 0.044715f * x * x * x);
  return x * __builtin_amdgcn_rcpf(1.f + ex2(-LOG2E * u2));
}

constexpr int EROW = 1024;
typedef float v2f __attribute__((ext_vector_type(2)));
__device__ void d_cvt_fp4_row(int row, const float* __restrict__ src, unsigned char* __restrict__ dst, float* __restrict__ scales) {
  const int lane = TIDX & 63;
  float v[32]; float amax = 0.f;
#pragma unroll
  for (int i = 0; i < 8; ++i) {
    f32x4 x = *(const f32x4*)(src + (size_t)row * DM + 256 * i + 4 * lane);
#pragma unroll
    for (int j = 0; j < 4; ++j) { v[i * 4 + j] = x[j]; amax = fmaxf(amax, fabsf(x[j])); }
  }
  amax = wave_max(amax);
  const float sc = amax > 0.f ? amax * (1.f / 7.f) : 1.f;
  const float inv = 1.f / sc;
  u32x4 o;
#pragma unroll
  for (int k = 0; k < 4; ++k) {
    unsigned w = 0u;
#define FP4C(x_) fminf(fmaxf((x_) * inv, -6.f), 6.f)
    w = __builtin_amdgcn_cvt_scalef32_pk_fp4_f32(w, FP4C(v[8 * k + 0]), FP4C(v[8 * k + 1]), 1.0f, 0);
    w = __builtin_amdgcn_cvt_scalef32_pk_fp4_f32(w, FP4C(v[8 * k + 2]), FP4C(v[8 * k + 3]), 1.0f, 1);
    w = __builtin_amdgcn_cvt_scalef32_pk_fp4_f32(w, FP4C(v[8 * k + 4]), FP4C(v[8 * k + 5]), 1.0f, 2);
    w = __builtin_amdgcn_cvt_scalef32_pk_fp4_f32(w, FP4C(v[8 * k + 6]), FP4C(v[8 * k + 7]), 1.0f, 3);
#undef FP4C
    o[k] = w;
  }
  *(u32x4*)(dst + (size_t)row * EROW + 16 * lane) = o;
  if (lane == 0) scales[row] = sc;
}
__device__ void d_cvt_i4_row(int row, const float* __restrict__ src, unsigned char* __restrict__ dst, float* __restrict__ scales) {
  const int lane = TIDX & 63;
  float v[32]; float amax = 0.f, ss = 0.f;
#pragma unroll
  for (int i = 0; i < 8; ++i) {
    f32x4 x = *(const f32x4*)(src + (size_t)row * DM + 256 * i + 4 * lane);
#pragma unroll
    for (int j = 0; j < 4; ++j) { v[i * 4 + j] = x[j]; amax = fmaxf(amax, fabsf(x[j])); ss = fmaf(x[j], x[j], ss); }
  }
  amax = wave_max(amax); ss = wave_sum(ss);
  float sc = fmaxf(0.36f * sqrtf(ss * (1.f / DM)), amax * (1.f / 14.f));
  sc = sc > 0.f ? sc : 1.f;
  const float inv = 1.f / sc;
  u32x4 o;
#pragma unroll
  for (int k = 0; k < 4; ++k) {
    unsigned w = 0u;
#pragma unroll
    for (int j = 0; j < 8; ++j) {
      const float q = fminf(fmaxf(v[8 * k + j] * inv, -7.f), 7.f) + 12582912.f;
      w |= (__float_as_uint(q) & 15u) << (4 * j);
    }
    o[k] = w;
  }
  *(u32x4*)(dst + (size_t)row * EROW + 16 * lane) = o;
  if (lane == 0) scales[row] = sc;
}
__device__ void d_expert_wave(int t, unsigned* tpl, const bf16_t* __restrict__ hbuf,
                              const unsigned* __restrict__ tops, const unsigned char* __restrict__ eu4, const unsigned char* __restrict__ ev4,
                              const float* __restrict__ esu, const float* __restrict__ esv, const float* __restrict__ gam, const float* __restrict__ bet, float* __restrict__ out) {
  const int lane = TIDX & 63;
  float hv[32];
#pragma unroll
  for (int i = 0; i < 8; ++i) {
    const u32x2 w = *(const u32x2*)(hbuf + (size_t)t * DM + 256 * i + 4 * lane);
    hv[i * 4 + 0] = __uint_as_float(w[0] << 16); hv[i * 4 + 1] = __uint_as_float(w[0] & 0xFFFF0000u);
    hv[i * 4 + 2] = __uint_as_float(w[1] << 16); hv[i * 4 + 3] = __uint_as_float(w[1] & 0xFFFF0000u);
  }
  int e0 = 0, e1 = 0; float w0 = 0.f, w1 = 0.f;
  {
    const int ci = (lane < 16) ? 0 : (lane < 24) ? 1 : (lane < 29) ? 2 : (lane < 33) ? 3 : (lane < 36) ? 4 : (lane < 38) ? 5 : (lane < 40) ? 6
                   : (lane < 42) ? 7 : (lane - 34);
    const int cpre = (ci == 0) ? 0 : (ci == 1) ? 16 : (ci == 2) ? 24 : (ci == 3) ? 29 : (ci == 4) ? 33 : (ci == 5) ? 36 : (ci == 6) ? 38
                     : (ci == 7) ? 40 : (34 + ci);
    const int cj = lane - cpre;
    const bool cvalid = lane < 50;
    *(u32x4*)(tpl + 4 * lane) = *(const u32x4*)(tops + (size_t)t * 256 + 4 * lane);
    const unsigned* tp = tpl;
#pragma unroll 1
    for (int hh = 0; hh < 8; ++hh) {
      unsigned key = 0u;
      if (cvalid) {
        const float sa = sort2f(tp[(2 * hh) * 16 + ci]), sb = sort2f(tp[(2 * hh + 1) * 16 + cj]);
        key = (f2sort(sa + sb) & 0xFFFFFF00u) | (unsigned)(255 - (ci * 16 + cj));
      }
#pragma unroll
      for (int k = 2; k <= 64; k <<= 1) {
#pragma unroll
        for (int jj = k >> 1; jj > 0; jj >>= 1) {
          const unsigned o = (unsigned)shx_i((int)key, jj);
          const bool lower = (lane & jj) == 0;
          const bool desc = (lane & k) == 0 || k == 64;
          const unsigned mx = key > o ? key : o, mn = key > o ? o : key;
          key = (lower == desc) ? mx : mn;
        }
      }
      const int flat = 255 - (int)(key & 255u);
      const int bi = (flat >> 4) & 15, bj = flat & 15;
      const unsigned ka = tp[(2 * hh) * 16 + bi], kb = tp[(2 * hh + 1) * 16 + bj];
      const float sc = sort2f(ka) + sort2f(kb);
      const int ex = (127 - (int)(ka & 127u)) * 128 + (127 - (int)(kb & 127u));
      float mx = sc;
      mx = fmaxf(mx, shx(mx, 1)); mx = fmaxf(mx, shx(mx, 2)); mx = fmaxf(mx, shx(mx, 4)); mx = fmaxf(mx, shx(mx, 8));
      const float ev_ = __expf(sc - mx);
      float sm = ev_;
      sm += shx(sm, 1); sm += shx(sm, 2); sm += shx(sm, 4); sm += shx(sm, 8);
      const float gv = ev_ / sm;
      const int exs = __shfl(ex, lane & 15); const float gvs = __shfl(gv, lane & 15);
      if ((lane >> 4) == (hh & 3)) { if (hh < 4) { e0 = exs; w0 = gvs; } else { e1 = exs; w1 = gvs; } }
    }
  }
  int hhi[4], hlo[4]; float hsc;
  {
    float m = 0.f;
#pragma unroll
    for (int i = 0; i < 32; ++i) m = fmaxf(m, fabsf(hv[i]));
    m = wave_max(m);
    hsc = m > 0.f ? m * (1.f / 119.f) : 1.f;
    const float hinv = 1.f / hsc;
#pragma unroll
    for (int q = 0; q < 4; ++q) {
      unsigned wh = 0u, wl = 0u;
#pragma unroll
      for (int j = 0; j < 8; ++j) {
        const unsigned b = __float_as_uint(fmaf(hv[8 * q + j], hinv, 12582912.f));
        wl |= (b & 15u) << (4 * j); wh |= (((b + 8u) >> 4) & 15u) << (4 * j);
      }
      hhi[q] = (int)wh; hlo[q] = (int)wl;
    }
  }
  float c0 = 0.f, c1 = 0.f;
  u32x4 rA[4], rB[4]; float sA[4], sB[4];
#define EX_LOAD(R, SS, TAB, STAB, EB)                                                            \
  _Pragma("unroll") for (int k = 0; k < 4; ++k) {                                          \
    const int e = (EB) + k;                                                                \
    const int id = __builtin_amdgcn_readlane((e < 64) ? e0 : e1, e & 63);                 \
    const unsigned char* row = (TAB) + (size_t)id * EROW;                                  \
    R[k] = *(const u32x4*)(row + 16 * lane);                                               \
    SS[k] = (STAB)[id];                                                                    \
  }
#define PKFMA(a_, b_, c_) __builtin_elementwise_fma((a_), (b_), (c_))
#define EX_COMP_U(R, SS, EB)                                                               \
  {                                                                                        \
    float dd[4];                                                                           \
    _Pragma("unroll") for (int k = 0; k < 4; ++k) {                                        \
      int dh = 0, dl = 0;                                                                  \
      _Pragma("unroll") for (int q = 0; q < 4; ++q) {                                      \
        dh = __builtin_amdgcn_sdot8((int)R[k][q], hhi[q], dh, false);                      \
        dl = __builtin_amdgcn_sdot8((int)R[k][q], hlo[q], dl, false);                      \
      }                                                                                    \
      dd[k] = SS[k] * (float)(dh * 16 + dl);                                               \
      __builtin_amdgcn_sched_barrier(0);                                                   \
    }                                                                                      \
      \
    float t01, t23;                                                                        \
    { auto r_ = __builtin_amdgcn_permlane32_swap(__float_as_uint(dd[0]), __float_as_uint(dd[1]), false, false);   \
      t01 = __uint_as_float(r_[0]) + __uint_as_float(r_[1]); }          \
    { auto r_ = __builtin_amdgcn_permlane32_swap(__float_as_uint(dd[2]), __float_as_uint(dd[3]), false, false);   \
      t23 = __uint_as_float(r_[0]) + __uint_as_float(r_[1]); }          \
    const bool b4_ = (lane & 16) != 0;                                                     \
    float tv = (b4_ ? t23 : t01) + shx(b4_ ? t01 : t23, 16);          \
    tv += dpp_f<0x128>(tv); tv += dpp_f<0x124>(tv); tv += dpp_f<0x4E>(tv); tv += dpp_f<0xB1>(tv);                 \
    _Pragma("unroll") for (int k = 0; k < 4; ++k) {                                        \
      const int e = (EB) + k;                                                              \
      const float tot = __int_as_float(__builtin_amdgcn_readlane(__float_as_int(tv), (k == 0) ? 0 : (k == 1) ? 32 : (k == 2) ? 16 : 48)); \
      if (e < 64) { if (lane == e) c0 = tot; } else { if (lane == e - 64) c1 = tot; }        \
    }                                                                                      \
    __builtin_amdgcn_sched_barrier(0);                                                     \
  }
#define EX_COMP_V(R, SS, EB)                                                               \
  _Pragma("unroll") for (int k = 0; k < 4; ++k) {                                          \
    const int e = (EB) + k;                                                                \
    const float cs = __int_as_float(__builtin_amdgcn_readlane(__float_as_int((e < 64) ? c0 : c1), e & 63)) * SS[k];                     \
    const v2f cs2 = {cs, cs};                                                              \
    _Pragma("unroll") for (int q = 0; q < 4; ++q) {                                        \
      const unsigned wq = R[k][q];                                                         \
      const v2f f0 = __builtin_amdgcn_cvt_scalef32_pk_f32_fp4(wq, 1.0f, 0), f1 = __builtin_amdgcn_cvt_scalef32_pk_f32_fp4(wq, 1.0f, 1); \
      const v2f f2 = __builtin_amdgcn_cvt_scalef32_pk_f32_fp4(wq, 1.0f, 2), f3 = __builtin_amdgcn_cvt_scalef32_pk_f32_fp4(wq, 1.0f, 3); \
      acc2[4 * q + 0] = PKFMA(cs2, f0, acc2[4 * q + 0]); acc2[4 * q + 1] = PKFMA(cs2, f1, acc2[4 * q + 1]); \
      acc2[4 * q + 2] = PKFMA(cs2, f2, acc2[4 * q + 2]); acc2[4 * q + 3] = PKFMA(cs2, f3, acc2[4 * q + 3]); \
    }                                                                                      \
    __builtin_amdgcn_sched_barrier(0);                                                     \
  }
  EX_LOAD(rA, sA, eu4, esu, 0)
  __builtin_amdgcn_sched_barrier(0);
#pragma unroll 1
  for (int eb = 0; eb < 128; eb += 8) {
    EX_LOAD(rB, sB, eu4, esu, eb + 4)
    __builtin_amdgcn_sched_barrier(0);
    EX_COMP_U(rA, sA, eb)
    { const bool more = eb + 8 < 128; const unsigned char* tabn = more ? eu4 : ev4; const float* stn = more ? esu : esv; const int ebn = more ? eb + 8 : 0;
      EX_LOAD(rA, sA, tabn, stn, ebn) }
    __builtin_amdgcn_sched_barrier(0);
    EX_COMP_U(rB, sB, eb + 4)
  }
  c0 = w0 * gelu_fast(hsc * c0); c1 = w1 * gelu_fast(hsc * c1);
  v2f acc2[16];
#pragma unroll
  for (int i = 0; i < 16; ++i) acc2[i] = v2f{0.f, 0.f};
#pragma unroll 1
  for (int eb = 0; eb < 128; eb += 8) {
    EX_LOAD(rB, sB, ev4, esv, eb + 4)
    __builtin_amdgcn_sched_barrier(0);
    EX_COMP_V(rA, sA, eb)
    { const int ebn = (eb + 8 < 128) ? eb + 8 : 0;
      EX_LOAD(rA, sA, ev4, esv, ebn) }
    __builtin_amdgcn_sched_barrier(0);
    EX_COMP_V(rB, sB, eb + 4)
  }
#undef EX_LOAD
#undef EX_COMP_U
#undef EX_COMP_V
#undef PKFMA
  float acc[32];
#pragma unroll
  for (int i = 0; i < 16; ++i) { acc[2 * i] = acc2[i].x; acc[2 * i + 1] = acc2[i].y; }
  int le = lane;
  asm volatile("" : "+v"(le) :: "memory");
  float s = 0.f;
#pragma unroll
  for (int i = 0; i < 8; ++i) {
    const u32x2 w = *(const u32x2*)(hbuf + (size_t)t * DM + 256 * i + 4 * le);
    const float h0 = __uint_as_float(w[0] << 16), h1 = __uint_as_float(w[0] & 0xFFFF0000u), h2 = __uint_as_float(w[1] << 16), h3 = __uint_as_float(w[1] & 0xFFFF0000u);
    acc[i * 4 + 0] = fmaf(ALPHA, h0, acc[i * 4 + 0]); acc[i * 4 + 1] = fmaf(ALPHA, h1, acc[i * 4 + 1]);
    acc[i * 4 + 2] = fmaf(ALPHA, h2, acc[i * 4 + 2]); acc[i * 4 + 3] = fmaf(ALPHA, h3, acc[i * 4 + 3]);
    s += (acc[i * 4 + 0] + acc[i * 4 + 1]) + (acc[i * 4 + 2] + acc[i * 4 + 3]);
  }
  s = wsum(s);
  const float mu = s * (1.f / DM);
  float qv = 0.f;
#pragma unroll
  for (int i = 0; i < 32; ++i) { const float d = acc[i] - mu; qv += d * d; }
  qv = wsum(qv);
  const float rs = rsqrtf(qv * (1.f / DM) + 1e-5f);
#pragma unroll
  for (int i = 0; i < 8; ++i) {
    const int cbase = 256 * i + 4 * le;
    f32x4 ga = *(const f32x4*)(gam + cbase), ba = *(const f32x4*)(bet + cbase), o;
#pragma unroll
    for (int j = 0; j < 4; ++j) o[j] = (acc[i * 4 + j] - mu) * rs * ga[j] + ba[j];
    *(f32x4*)(out + (size_t)t * DM + cbase) = o;
  }
}

constexpr size_t al256(size_t x) { return (x + 255) & ~(size_t)255; }
constexpr size_t WS_XB = 0;
constexpr size_t WS_PROJ = WS_XB + al256((size_t)S * DM * 2);
constexpr size_t WS_WINT = WS_PROJ + al256((size_t)S * INWP * 2);
constexpr size_t WS_GATES = WS_WINT + al256((size_t)INWG * DM * 2);
constexpr size_t WS_W1KF = WS_GATES + al256((size_t)S * 24 * 4);
constexpr size_t WS_W1VF = WS_W1KF + al256((size_t)512 * 4096 * 2);
constexpr size_t WS_W2KF = WS_W1VF + al256((size_t)512 * 4096 * 2);
constexpr size_t WS_W2VF = WS_W2KF + al256((size_t)512 * 128 * 2);
constexpr size_t WS_VC = WS_W2VF + al256((size_t)512 * 128 * 2) - al256((size_t)2048 * 128 * 4);
constexpr size_t WS_KCF = WS_VC + al256((size_t)2048 * 128 * 4);
constexpr size_t WS_VCF = WS_KCF + al256((size_t)2 * 32 * 4096 * 2);
constexpr size_t WS_KSF = WS_VCF + al256((size_t)2 * 32 * 4096 * 2);
constexpr size_t WS_VSF = WS_KSF + al256((size_t)2 * 512 * 4096 * 2);
constexpr size_t WS_KWF = WS_VSF + al256((size_t)2 * 512 * 4096 * 2);
constexpr size_t WS_VWF = WS_KWF + al256((size_t)2 * 512 * 4096 * 2);
constexpr size_t WS_ENDA = WS_VWF + al256((size_t)2 * 512 * 4096 * 2);
constexpr size_t WS_OATT = WS_ENDA;
constexpr size_t WS_MIX = WS_OATT + al256((size_t)S * 1024 * 4);
constexpr size_t WS_WOUTT = WS_MIX + al256((size_t)S * DM * 2);
constexpr size_t WS_WQT = WS_WOUTT + al256((size_t)DM * DM * 2);
constexpr size_t WS_TOPS = WS_WQT + al256((size_t)DM * DM * 2);
constexpr size_t WS_SKF = WS_TOPS + al256((size_t)S * 256 * 4);
constexpr size_t WS_STATS = WS_SKF + al256((size_t)16 * 128 * 128 * 2);
constexpr size_t WS_CTRL = WS_STATS + al256((size_t)S * 2 * 4);
constexpr size_t CTRL_BYTES = 32768;
constexpr size_t WS_END = WS_CTRL + CTRL_BYTES;
constexpr size_t WS_Y = WS_PROJ;
constexpr size_t WS_HB = WS_XB;
constexpr size_t WS_EU8 = WS_OATT;
constexpr size_t WS_EV8 = WS_EU8 + (size_t)16384 * 1024;
constexpr size_t WS_ESU = WS_EV8 + (size_t)16384 * 1024;
constexpr size_t WS_ESV = WS_ESU + 16384 * 4;
static_assert(WS_ESV + 16384 * 4 <= WS_MIX, "expert tables overflow their region");
constexpr int EXP_EARLY = 6144;
static_assert(WS_END <= (size_t)512 * 1024 * 1024, "workspace over 512 MiB");

struct Params {
  const float *x, *w_in, *ck_pos, *ck_w1, *ck_b1, *ck_w2, *cv_pos, *cv_w1, *cv_b1, *cv_w2, *conv_w, *hng, *w_out, *ln1g, *ln1b, *w_query, *subk,
      *eu, *ev, *ln2g, *ln2b;
  float* out;
  char* ws;
};
#define WSP(T, OFF) ((T*)(p.ws + (OFF)))

#define FOR_VB(n) for (int vb = blockIdx.x; vb < (n); vb += gridDim.x)
#define FOR_VB2(n) for (int vb = blockIdx.x * 2 + (TIDX >> 8); vb < (n); vb += gridDim.x * 2)
constexpr int SMEM_BYTES = 147456;
constexpr int HALF = 36864;

__global__ void __launch_bounds__(512) mega(Params p) {
  __shared__ __attribute__((aligned(16))) char smem[SMEM_BYTES + 16];
  if (TIDX == 0) *(u32x4*)(smem + SMEM_BYTES) = u32x4{0u, 0u, 0u, 0u};
  __syncthreads();
  const XcdBarrier xbar = xcd_barrier_post(WSP(unsigned, WS_CTRL + 1024), (volatile LAS unsigned*)(smem + SMEM_BYTES));
#define smh (smem + (TIDX >> 8) * HALF)
#define wv ((TIDX >> 6))
  constexpr int NWV = 8;
  d_cvt(p.x, WSP(bf16_t, WS_XB), (size_t)S * DM / 4);
  FOR_VB2((INWG / 64) * (DM / 64)) d_cvtT64(vb, smh, p.w_in, WSP(bf16_t, WS_WINT), DM, INW, INWG);
  for (size_t c = (size_t)blockIdx.x * 512 + TIDX; c < (size_t)16 * 256 * 64; c += (size_t)gridDim.x * 512) {
    d_cvt_w1f(c, p.ck_w1, WSP(bf16_t, WS_W1KF)); d_cvt_w1f(c, p.cv_w1, WSP(bf16_t, WS_W1VF));
    if (c < (size_t)4 * 32 * 64) { d_cvt_w2f(c, p.ck_w2, WSP(bf16_t, WS_W2KF)); d_cvt_w2f(c, p.cv_w2, WSP(bf16_t, WS_W2VF)); }
  }
  FOR_VB2((DM / 64) * (DM / 64)) d_cvtT64(vb, smh, p.w_out, WSP(bf16_t, WS_WOUTT), DM, DM, DM);
  FOR_VB2((DM / 64) * (DM / 64)) d_cvtT64(vb, smh, p.w_query, WSP(bf16_t, WS_WQT), DM, DM, DM);
  for (size_t c = (size_t)blockIdx.x * 512 + TIDX; c < (size_t)16 * 4 * 8 * 64; c += (size_t)gridDim.x * 512) d_cvt_subk(c, p.subk, WSP(bf16_t, WS_SKF));
  xcd_barrier(xbar);
  {
    pg8::StaticOrder so; so.init(S, INWG, gridDim.x, blockIdx.x);
    pg8::gemm_phase<EpiProjG, pg8::StaticOrder>((PG8_LAS unsigned char*)smem, pg8::Gemm{WSP(bf16_t, WS_XB), WSP(bf16_t, WS_WINT), S, INWG, DM}, so,
                                                EpiProjG{WSP(bf16_t, WS_PROJ), WSP(float, WS_GATES), (PG8_LAS unsigned char*)smem + pg8::STAGE_BYTES}, nullptr);
    const int nun = (S / 256) * (INWG / 256), gsz = (int)gridDim.x;
    const int nfull = nun % gsz;
    if (nfull != 0 && (int)blockIdx.x >= nfull) {
      const int nidle = gsz - nfull, me = (int)blockIdx.x - nfull;
      for (int r = me * NWV + wv; r < 2 * EXP_EARLY; r += nidle * NWV) {
        if (r < EXP_EARLY) d_cvt_i4_row(r, p.eu, WSP(unsigned char, WS_EU8), WSP(float, WS_ESU)); else d_cvt_fp4_row(r - EXP_EARLY, p.ev, WSP(unsigned char, WS_EV8), WSP(float, WS_ESV));
      }
    }
  }
  xcd_barrier(xbar);
  {
    if (blockIdx.x < 128) {
      const int xcd_ = blockIdx.x & 7, idx_ = blockIdx.x >> 3; const bool isV = (xcd_ & 1) != 0;
      d_compress_unit((xcd_ >> 1) * 16 + idx_, smem, WSP(bf16_t, WS_PROJ), isV ? OFF_VC : OFF_KC, isV ? p.cv_pos : p.ck_pos, isV ? WSP(bf16_t, WS_W1VF) : WSP(bf16_t, WS_W1KF),
                      isV ? p.cv_b1 : p.ck_b1, isV ? WSP(bf16_t, WS_W2VF) : WSP(bf16_t, WS_W2KF), isV ? WSP(bf16_t, WS_VCF) : WSP(bf16_t, WS_KCF), isV);
    }
    int* slot = (int*)smem;
    unsigned* ctr = WSP(unsigned, WS_CTRL);
    for (;;) {
      if (TIDX == 0) *slot = (int)atomicAdd(ctr, 1u);
      __syncthreads();
      const int it = *slot;
      __syncthreads();
      if (it >= 2048) break;
      const int tt = TIDX;
      {
        const int T = it >> 2, which = it & 3;
        d_relayout_tile(T, smem + 64, WSP(bf16_t, WS_PROJ), (which == 0) ? OFF_KS : (which == 1) ? OFF_VS : (which == 2) ? OFF_KW : OFF_VW,
                        (which == 0) ? WSP(bf16_t, WS_KSF) : (which == 1) ? WSP(bf16_t, WS_VSF) : (which == 2) ? WSP(bf16_t, WS_KWF) : WSP(bf16_t, WS_VWF), (which & 1) != 0);
      }
      for (int q = 0; q < 2; ++q) d_convmix(it * 8 + q * 4 + (tt >> 7), tt & 127, WSP(bf16_t, WS_PROJ), p.conv_w, p.hng, WSP(bf16_t, WS_MIX));
    }
  }
  xcd_barrier(xbar);
  {
    AttnPtrs ap{WSP(bf16_t, WS_PROJ), WSP(float, WS_GATES), WSP(bf16_t, WS_KCF), WSP(bf16_t, WS_VCF), WSP(bf16_t, WS_KSF), WSP(bf16_t, WS_VSF), WSP(bf16_t, WS_KWF), WSP(bf16_t, WS_VWF), WSP(bf16_t, WS_MIX), p.hng};
    for (int it = blockIdx.x; it < 512; it += gridDim.x) {
      const int Bq = (it < 256) ? it : (511 - it), gq = (it < 256) ? 0 : 1;
      d_attn_block(Bq, gq, smem, ap);
    }
  }
  xcd_barrier(xbar);
  {
    pg8::StaticOrder so; so.init(S, DM, gridDim.x, blockIdx.x);
    pg8::gemm_phase<EpiResG, pg8::StaticOrder>((PG8_LAS unsigned char*)smem, pg8::Gemm{WSP(bf16_t, WS_MIX), WSP(bf16_t, WS_WOUTT), S, DM, DM}, so,
                                               EpiResG{WSP(bf16_t, WS_HB), (PG8_LAS unsigned char*)smem + pg8::STAGE_BYTES}, nullptr);
  }
  xcd_barrier(xbar);
  for (int r = blockIdx.x * NWV + wv; r < S; r += gridDim.x * NWV) d_ln_wave(r, WSP(bf16_t, WS_HB), p.ln1g, p.ln1b);
  {
    const int e0_ = (((S / 256) * (INWG / 256)) % (int)gridDim.x != 0) ? EXP_EARLY : 0;
    const int nrest = 16384 - e0_;
    for (int r = blockIdx.x * NWV + wv; r < 2 * nrest; r += gridDim.x * NWV) {
      if (r < nrest) d_cvt_i4_row(e0_ + r, p.eu, WSP(unsigned char, WS_EU8), WSP(float, WS_ESU)); else d_cvt_fp4_row(e0_ + r - nrest, p.ev, WSP(unsigned char, WS_EV8), WSP(float, WS_ESV));
    }
  }
  xcd_barrier(xbar);
  for (int k = 0; k * (int)gridDim.x < (S / 256) * (DM / 256); ++k) {
    pg8::OneUnit so; so.init(S, DM, gridDim.x, blockIdx.x); so.k = k;
    pg8::gemm_phase<EpiRouteG, pg8::OneUnit>((PG8_LAS unsigned char*)smem, pg8::Gemm{WSP(bf16_t, WS_HB), WSP(bf16_t, WS_WQT), S, DM, DM}, so,
                                             EpiRouteG{WSP(bf16_t, WS_SKF), WSP(unsigned, WS_TOPS)}, nullptr);
    __syncthreads();
  }
  xcd_barrier(xbar);
  for (int t = blockIdx.x * NWV + wv; t < S; t += gridDim.x * NWV) d_expert_wave(t, (unsigned*)(smem + wv * 1024), WSP(bf16_t, WS_HB), WSP(unsigned, WS_TOPS), WSP(unsigned char, WS_EU8), WSP(unsigned char, WS_EV8), WSP(float, WS_ESU), WSP(float, WS_ESV), p.ln2g, p.ln2b, p.out);
}

extern "C" void kernel_launch(void* const* d_in, const int* in_sizes, int n_in, void* d_out, int out_size, void* d_ws, size_t ws_size,
                              hipStream_t stream) {
  Params p{};
  p.x = (const float*)d_in[0]; p.w_in = (const float*)d_in[1]; p.ck_pos = (const float*)d_in[2]; p.ck_w1 = (const float*)d_in[3];
  p.ck_b1 = (const float*)d_in[4]; p.ck_w2 = (const float*)d_in[5]; p.cv_pos = (const float*)d_in[6]; p.cv_w1 = (const float*)d_in[7];
  p.cv_b1 = (const float*)d_in[8]; p.cv_w2 = (const float*)d_in[9]; p.conv_w = (const float*)d_in[10]; p.hng = (const float*)d_in[11];
  p.w_out = (const float*)d_in[12]; p.ln1g = (const float*)d_in[13]; p.ln1b = (const float*)d_in[14]; p.w_query = (const float*)d_in[15];
  p.subk = (const float*)d_in[16]; p.eu = (const float*)d_in[17]; p.ev = (const float*)d_in[18]; p.ln2g = (const float*)d_in[19];
  p.ln2b = (const float*)d_in[20];
  p.out = (float*)d_out;
  p.ws = (char*)d_ws;
  if (ws_size < WS_END) fprintf(stderr, "workspace too small\n");
  static int grid_blocks = 0;
  if (!grid_blocks) {
    int dev = 0, cus = 0, per_cu = 0;
    hipGetDevice(&dev);
    hipDeviceGetAttribute(&cus, hipDeviceAttributeMultiprocessorCount, dev);
    hipOccupancyMaxActiveBlocksPerMultiprocessor(&per_cu, mega, 512, 0);
    if (per_cu > 1) per_cu = 1;
    if (per_cu < 1) per_cu = 1;
    grid_blocks = cus * per_cu;
  }
  hipMemsetAsync((char*)d_ws + WS_CTRL, 0, CTRL_BYTES, stream);
  void* args[] = {&p};
  hipError_t e = hipLaunchCooperativeKernel((void*)mega, dim3(grid_blocks), dim3(512), args, 0, stream);
  if (e != hipSuccess) fprintf(stderr, "cooperative launch failed: %s (grid %d)\n", hipGetErrorString(e), grid_blocks);
}
```

```cpp
#include <hip/hip_runtime.h>
#include <stdint.h>
#include <stdio.h>


#define DI __device__ __forceinline__
static __device__ __forceinline__ int tidx_() { int t = (int)__builtin_amdgcn_workitem_id_x(); asm volatile("" : "+v"(t)); return t; }
#define TIDX (tidx_())

template <int J> DI int swz_xor(int x) { return __builtin_amdgcn_ds_swizzle(x, (J << 10) | 0x1F); }
template <int CTRL> DI int dpp_i(int x) { return __builtin_amdgcn_update_dpp(x, x, CTRL, 0xF, 0xF, false); }
DI int shx_i(int x, int j) {
  switch (j) {
    case 1: return dpp_i<0xB1>(x);
    case 2: return dpp_i<0x4E>(x);
    case 4: return dpp_i<0x1B>(dpp_i<0x141>(x));
    case 8: return dpp_i<0x128>(x);
    case 16: return swz_xor<16>(x);
    default: {
      auto r = __builtin_amdgcn_permlane32_swap((unsigned)x, (unsigned)x, false, false);
      return (TIDX & 32) ? (int)r[0] : (int)r[1];
    }
  }
}
DI float shx(float x, int j) { return __int_as_float(shx_i(__float_as_int(x), j)); }
typedef unsigned short bf16_t;
using bf16x8 = __attribute__((ext_vector_type(8))) short;
using f32x4 = __attribute__((ext_vector_type(4))) float;
using u32x4 = __attribute__((ext_vector_type(4))) unsigned;
using u32x2 = __attribute__((ext_vector_type(2))) unsigned;

constexpr int S = 16384, DM = 2048, HD = 128;
constexpr int INW = 5656, INWP = 5760, INWG = 5888;
constexpr int OFF_Q = 0, OFF_KC = 1024, OFF_VC = 1280, OFF_KS = 1536, OFF_VS = 1792, OFF_KW = 2048, OFF_VW = 2304,
              OFF_G = 2560, OFF_U = 2584, OFF_B = 3608, OFF_C = 4632;
constexpr int NCMP = 1023;
constexpr float ALPHA = 1.189207115002721f;
constexpr float QSCALE = 0.08838834764831845f;

DI bf16_t f2bf(float x) { unsigned u = __float_as_uint(x); u += 0x7fffu + ((u >> 16) & 1u); return (bf16_t)(u >> 16); }
DI float bf2f(bf16_t b) { return __uint_as_float(((unsigned)b) << 16); }
DI float gelu_tanh(float x) { float u = 0.7978845608028654f * (x + 0.044715f * x * x * x); return 0.5f * x * (1.f + tanhf(u)); }
DI float wave_sum(float v) { for (int o = 32; o > 0; o >>= 1) v += shx(v, o); return v; }
using bf16x2v = __attribute__((ext_vector_type(2))) __bf16;
DI unsigned pack2(float a, float b) { bf16x2v v = {(__bf16)a, (__bf16)b}; return __builtin_bit_cast(unsigned, v); }
DI float wave_max(float v) { for (int o = 32; o > 0; o >>= 1) v = fmaxf(v, shx(v, o)); return v; }

namespace pg8 {
#define PG8_LAS __attribute__((address_space(3)))
typedef unsigned short bf16_t;
typedef short bf16x8 __attribute__((ext_vector_type(8)));
typedef float f32x4 __attribute__((ext_vector_type(4)));
typedef unsigned u32x4 __attribute__((ext_vector_type(4)));
constexpr int BM = 256, BK = 64, HALF = 128, HTB = HALF * BK * 2  , STAGE_BYTES = 8 * HTB, NXCD = 8, WGM = 8;

__host__ __device__ __forceinline__ int lds_byte(int r, int c) { const int st = (r >> 4) * 2 + (c >> 5), rr = r & 15, cc = c & 31, ob = rr * 64 + cc * 2; return st * 1024 + (ob ^ (((ob >> 9) & 1) << 5)); }
__host__ __device__ __forceinline__ void stage_rc(int b, int& R, int& C) { const int st = b / 1024, sb = b % 1024, swz = sb ^ (((sb >> 9) & 1) << 5); R = (st >> 1) * 16 + swz / 64; C = (st & 1) * 32 + (swz % 64) / 2; }
__host__ __device__ __forceinline__ int perm32(int rho) { const int n = rho >> 4, i = rho & 15; return 8 * (i >> 2) + 4 * n + (i & 3); }

struct Unit { int pm, pn; };
struct Gemm { const bf16_t* A; const bf16_t* Bt; int M, N, K; };

struct StaticOrder {
    int nM, nN, nwg, G, c;
    __host__ __device__ void init(int M, int N, int G_, int c_) { nM = M / BM; nN = N / BM; nwg = nM * nN; G = G_; c = c_; }
    __host__ __device__ bool next(int i, Unit& u) const {
        const long L = (long)i * G + c; if (L >= nwg) return false;
        int wgid = (int)L; { const int q = nwg / NXCD, r = nwg % NXCD, xcd = wgid % NXCD, off = wgid / NXCD; wgid = (xcd < r ? xcd * (q + 1) : r * (q + 1) + (xcd - r) * q) + off; }
        const int nig = WGM * nN, gid = wgid / nig, fm = gid * WGM, gsz = (nM - fm) < WGM ? (nM - fm) : WGM;
        u.pm = fm + ((wgid % nig) % gsz); u.pn = (wgid % nig) / gsz; return true;
    }
    __device__ __forceinline__ void a_ready(const Unit&) const {}
    __device__ __forceinline__ void done(const Unit&) const {}
};
struct OneUnit : StaticOrder {
    int k;
    __device__ bool next(int i, Unit& u) const { if (i > 0) return false; return StaticOrder::next(k, u); }
};
__device__ __forceinline__ unsigned cvt_pk_bf16(float lo, float hi) { unsigned r; asm volatile("v_cvt_pk_bf16_f32 %0, %1, %2" : "=v"(r) : "v"(lo), "v"(hi)); return r; }
template <class Epi, class Sched, bool STAMP = false>
__device__ __forceinline__ void gemm_phase(PG8_LAS unsigned char* lds, const Gemm g, const Sched& S, const Epi& E, unsigned long long* stamps) {
    const int tid = TIDX, wid = __builtin_amdgcn_readfirstlane(tid >> 6), lane = tid & 63, wr = wid >> 2, wc = wid & 3, fr = lane & 15, fq = lane >> 4;
    const int K = g.K, nt = K / BK;
    int ts_lo = 0, ts_hi = 0, nts = 0; const unsigned long long rt_entry = STAMP ? (unsigned long long)wall_clock64() : 0ull;
#define PG8_STAMP() do { if (STAMP && wid == 0 && nts < 64) { const unsigned long long _c = (unsigned long long)clock64(); \
        ts_lo = (lane == nts) ? (int)(unsigned)_c : ts_lo; ts_hi = (lane == nts) ? (int)(unsigned)(_c >> 32) : ts_hi; ++nts; } } while (0)
    PG8_STAMP();
    unsigned voffA[2], voffB[2];
#pragma unroll
    for (int i = 0; i < 2; ++i) { int R, C; stage_rc(tid * 16 + i * 8192, R, C); const int Rb = Epi::PERM ? ((R & ~31) + perm32(R & 31)) : R;
        voffA[i] = (unsigned)(R * K + C) * 2u; voffB[i] = (unsigned)(Rb * K + C) * 2u; }
    const size_t kstep = (size_t)(BK * 2);
    const size_t hstep = (size_t)HALF * K * 2;
    const size_t tstep = 2 * hstep;
    const unsigned ldsw = (unsigned)wid * 1024u;
    const int aoff = lds_byte(wr * 64 + fr, fq * 8), boff = lds_byte(wc * 32 + fr, fq * 8);
#define PG8_SA(b, h) (((b) * 2 + (h)) * HTB)
#define PG8_SB(b, h) ((4 + (b) * 2 + (h)) * HTB)
#define PG8_STAGE(bufoff, gbase, voff) do { _Pragma("unroll") for (int _i = 0; _i < 2; ++_i) \
        __builtin_amdgcn_global_load_lds((const unsigned*)((const char*)(gbase) + (voff)[_i]), (PG8_LAS unsigned*)(lds + (bufoff) + ldsw + _i * 8192), 16, 0, 0); } while (0)
#define PG8_LDA(dst, b, h) do { _Pragma("unroll") for (int m = 0; m < 4; ++m) _Pragma("unroll") for (int k = 0; k < 2; ++k) dst[m][k] = *(const PG8_LAS bf16x8*)(lds + PG8_SA(b, h) + aoff + m * 2048 + k * 1024); } while (0)
#define PG8_LDB(dst, b, h) do { _Pragma("unroll") for (int n = 0; n < 2; ++n) _Pragma("unroll") for (int k = 0; k < 2; ++k) dst[n][k] = *(const PG8_LAS bf16x8*)(lds + PG8_SB(b, h) + boff + n * 2048 + k * 1024); } while (0)
#define PG8_MMA(ai, bj, At, Bt) do { __builtin_amdgcn_s_setprio(1); _Pragma("unroll") for (int m = 0; m < 4; ++m) _Pragma("unroll") for (int n = 0; n < 2; ++n) _Pragma("unroll") for (int k = 0; k < 2; ++k) \
        acc[ai][bj][m][n] = __builtin_amdgcn_mfma_f32_16x16x32_bf16(Bt[n][k], At[m][k], acc[ai][bj][m][n], 0, 0, 0); __builtin_amdgcn_s_setprio(0); } while (0)
#define PG8_WAIT_V(n) asm volatile("s_waitcnt vmcnt(" #n ")" ::: "memory")
#define PG8_WAIT_L(n) asm volatile("s_waitcnt lgkmcnt(" #n ")" ::: "memory")
#define PG8_BAR __builtin_amdgcn_s_barrier()
#define PG8_SCHED __builtin_amdgcn_sched_barrier(0)
    Unit cur, nxt; int ui = 0;
    if (!S.next(0, cur)) return;
    f32x4 acc[2][2][4][2];
#pragma unroll
    for (int a = 0; a < 2; ++a)
#pragma unroll
        for (int b = 0; b < 2; ++b)
#pragma unroll
            for (int m = 0; m < 4; ++m)
#pragma unroll
                for (int n = 0; n < 2; ++n) acc[a][b][m][n] = (f32x4){0.f, 0.f, 0.f, 0.f};
    bf16x8 At[4][2], B0[2][2], B1[2][2];
    const char* cA = (const char*)g.A + (size_t)cur.pm * tstep; const char* cB = (const char*)g.Bt + (size_t)cur.pn * tstep;
    S.a_ready(cur);
    PG8_STAGE(PG8_SB(0, 0), cB, voffB); PG8_STAGE(PG8_SA(0, 0), cA, voffA); PG8_STAGE(PG8_SB(0, 1), cB + hstep, voffB); PG8_STAGE(PG8_SA(0, 1), cA + hstep, voffA);
    if (wr == 1) PG8_BAR;
    PG8_WAIT_V(4); PG8_BAR;
    PG8_STAGE(PG8_SB(1, 0), cB + kstep, voffB); PG8_STAGE(PG8_SA(1, 0), cA + kstep, voffA); PG8_STAGE(PG8_SB(1, 1), cB + hstep + kstep, voffB);
    PG8_WAIT_V(6); PG8_BAR;
    PG8_STAMP();
    for (;;) {
        const bool has_next = S.next(ui + 1, nxt);
        const char* nA = has_next ? (const char*)g.A + (size_t)nxt.pm * tstep : cA; const char* nB = has_next ? (const char*)g.Bt + (size_t)nxt.pn * tstep : cB;
        for (int t = 0; t < nt; t += 2) {
            const bool last = (t == nt - 2);
            const char* a1 = cA + (size_t)(t + 1) * kstep;
            const char* a2 = last ? nA : cA + (size_t)(t + 2) * kstep; const char* b2 = last ? nB : cB + (size_t)(t + 2) * kstep;
            const char* a3 = a2 + kstep; const char* b3 = b2 + kstep;
            if (last && has_next) S.a_ready(nxt);
            PG8_LDB(B0, 0, 0); PG8_SCHED; PG8_LDA(At, 0, 0); PG8_STAGE(PG8_SA(1, 1), a1 + hstep, voffA);
            PG8_WAIT_L(8); PG8_BAR; PG8_WAIT_L(0); PG8_MMA(0, 0, At, B0); PG8_BAR; PG8_SCHED;
            PG8_LDB(B1, 0, 1); PG8_STAGE(PG8_SB(0, 0), b2, voffB);
            PG8_BAR; PG8_WAIT_L(0); PG8_MMA(0, 1, At, B1); PG8_BAR;
            PG8_LDA(At, 0, 1); PG8_STAGE(PG8_SA(0, 0), a2, voffA);
            PG8_BAR; PG8_WAIT_L(0); PG8_MMA(1, 0, At, B0); PG8_BAR; PG8_SCHED;
            PG8_STAGE(PG8_SB(0, 1), b2 + hstep, voffB);
            PG8_WAIT_V(6); PG8_BAR; PG8_MMA(1, 1, At, B1); PG8_BAR;
            PG8_LDB(B0, 1, 0); PG8_SCHED; PG8_LDA(At, 1, 0); PG8_STAGE(PG8_SA(0, 1), a2 + hstep, voffA);
            PG8_WAIT_L(8); PG8_BAR; PG8_WAIT_L(0); PG8_MMA(0, 0, At, B0); PG8_BAR; PG8_SCHED;
            PG8_LDB(B1, 1, 1); PG8_STAGE(PG8_SB(1, 0), b3, voffB);
            PG8_BAR; PG8_WAIT_L(0); PG8_MMA(0, 1, At, B1); PG8_BAR;
            PG8_LDA(At, 1, 1); PG8_STAGE(PG8_SA(1, 0), a3, voffA);
            PG8_BAR; PG8_WAIT_L(0); PG8_MMA(1, 0, At, B0); PG8_BAR; PG8_SCHED;
            PG8_STAGE(PG8_SB(1, 1), b3 + hstep, voffB);
            PG8_WAIT_V(6); PG8_BAR; PG8_MMA(1, 1, At, B1); PG8_BAR;
        }
        PG8_STAMP();
        if constexpr (!Epi::AFTER_DRAIN) { E(acc, cur, wr, wc, fr, fq); S.done(cur); }
        PG8_STAMP();
        if (!has_next) break;
#pragma unroll
        for (int a = 0; a < 2; ++a)
#pragma unroll
            for (int b = 0; b < 2; ++b)
#pragma unroll
                for (int m = 0; m < 4; ++m)
#pragma unroll
                    for (int n = 0; n < 2; ++n) acc[a][b][m][n] = (f32x4){0.f, 0.f, 0.f, 0.f};
        cur = nxt; cA = nA; cB = nB; ++ui;
    }
    PG8_WAIT_V(0);
    if (wr == 0) PG8_BAR;
    PG8_BAR;
    if constexpr (Epi::AFTER_DRAIN) { E.fused(acc, cur, wr, wc, fr, fq, lds, wid, lane); S.done(cur); }
    PG8_STAMP();
    if (STAMP && wid == 0) { stamps[lane] = lane < nts ? (((unsigned long long)(unsigned)ts_hi << 32) | (unsigned)ts_lo) : 0ull;
        if (lane == 62) stamps[62] = rt_entry; if (lane == 63) stamps[63] = (unsigned long long)wall_clock64(); }
#undef PG8_STAMP
#undef PG8_SA
#undef PG8_SB
#undef PG8_STAGE
#undef PG8_LDA
#undef PG8_LDB
#undef PG8_MMA
#undef PG8_WAIT_V
#undef PG8_WAIT_L
#undef PG8_BAR
#undef PG8_SCHED
}
}

#define XB_TMO      128
#define XB_XCNT(j)  (256  + 64 * (j))
#define XB_XSUB(j)  (1280 + 64 * (j))
#define XB_XGEN(j)  (2304 + 64 * (j))
#define XB_TOP      3328
#define XB_TOPGEN   3392
#define XCD_BAR_WORDS 3456
#define XB_SPIN_CAP (1u << 18)
#define LAS __attribute__((address_space(3)))

__device__ __forceinline__ unsigned xb_ld(unsigned* p)              { return __hip_atomic_load(p, __ATOMIC_RELAXED, __HIP_MEMORY_SCOPE_AGENT); }
__device__ __forceinline__ unsigned xb_add(unsigned* p, unsigned v) { return __hip_atomic_fetch_add(p, v, __ATOMIC_RELAXED, __HIP_MEMORY_SCOPE_AGENT); }
__device__ __forceinline__ unsigned xb_xcc_id() { return (unsigned)__builtin_amdgcn_s_getreg((3 << 11) | 20) & 0xFu; }
#define XB_SPIN(cond, bar) do { unsigned _sp = 0; while (cond) { __builtin_amdgcn_s_sleep(1); \
    if ((++_sp & 255u) == 0u) { if (xb_ld(&(bar)[XB_TMO])) break; if (_sp > XB_SPIN_CAP) { atomicAdd(&(bar)[XB_TMO], 1u); break; } } } } while (0)

struct XcdBarrier {
    unsigned* bar; unsigned x;
    volatile LAS unsigned* st;
};

__device__ __forceinline__ XcdBarrier xcd_barrier_post(unsigned* bar, volatile LAS unsigned* st) {
    XcdBarrier b; b.bar = bar; b.x = xb_xcc_id(); b.st = st;
    if (TIDX == 0) (void)xb_add(&bar[XB_XCNT(b.x)], 1u);
    return b;
}
__device__ __forceinline__ void xcd_barrier_complete(unsigned* bar, unsigned x, unsigned& nloc, unsigned& nx) {
    const unsigned G = gridDim.x * gridDim.y * gridDim.z;
    unsigned sum, cnt, mine, sp = 0u;
    for (;;) {
        sum = 0u; cnt = 0u; mine = 0u;
#pragma unroll
        for (unsigned j = 0; j < 16; ++j) { const unsigned c = xb_ld(&bar[XB_XCNT(j)]); sum += c; cnt += (c > 0u) ? 1u : 0u; mine = (j == x) ? c : mine; }
        if (sum == G) break;
        __builtin_amdgcn_s_sleep(1);
        if ((++sp & 255u) == 0u) { if (xb_ld(&bar[XB_TMO])) break; if (sp > XB_SPIN_CAP) { atomicAdd(&bar[XB_TMO], 1u); break; } }
    }
    nloc = mine > 0u ? mine : 1u; nx = cnt > 0u ? cnt : 1u;
}

__device__ __forceinline__ void xcd_barrier(const XcdBarrier& b) {
    asm volatile("s_waitcnt vmcnt(0)" ::: "memory");
    __syncthreads();
    if (TIDX == 0) {
        unsigned* bar = b.bar;
        __builtin_amdgcn_s_waitcnt(0);
        unsigned nloc = b.st[0], nx = b.st[1];
        if (nloc == 0u) { xcd_barrier_complete(bar, b.x, nloc, nx); b.st[0] = nloc; b.st[1] = nx; }
        const unsigned old = xb_add(&bar[XB_XSUB(b.x)], 1u);
        const unsigned gen = old / nloc;
        if (old + 1u == (gen + 1u) * nloc) {
            __builtin_amdgcn_fence(__ATOMIC_RELEASE, "agent");
            asm volatile("s_waitcnt vmcnt(0)" ::: "memory");
            const unsigned og = xb_add(&bar[XB_TOP], 1u);
            const unsigned tg = og / nx;
            if (og + 1u == (tg + 1u) * nx) xb_add(&bar[XB_TOPGEN], 1u);
            else XB_SPIN(xb_ld(&bar[XB_TOPGEN]) == tg, bar);
            __builtin_amdgcn_fence(__ATOMIC_ACQUIRE, "agent");
            xb_add(&bar[XB_XGEN(b.x)], 1u);
            asm volatile("s_waitcnt vmcnt(0)" ::: "memory");
        } else {
            XB_SPIN(xb_ld(&bar[XB_XGEN(b.x)]) == gen, bar);
            __builtin_amdgcn_fence(__ATOMIC_ACQUIRE, "agent");
            asm volatile("s_waitcnt vmcnt(0)" ::: "memory");
        }
    }
    __syncthreads();
}

__device__ void d_cvt(const float* __restrict__ in, bf16_t* __restrict__ out, size_t n4) {
  const size_t stride = (size_t)gridDim.x * blockDim.x;
  size_t i = (size_t)blockIdx.x * blockDim.x + TIDX;
  for (; i + 3 * stride < n4; i += 4 * stride) {
    f32x4 v[4];
#pragma unroll
    for (int q = 0; q < 4; ++q) v[q] = ((const f32x4*)in)[i + q * stride];
#pragma unroll
    for (int q = 0; q < 4; ++q) { u32x2 o = {pack2(v[q][0], v[q][1]), pack2(v[q][2], v[q][3])}; ((u32x2*)out)[i + q * stride] = o; }
  }
  for (; i < n4; i += stride) { const f32x4 v = ((const f32x4*)in)[i]; u32x2 o = {pack2(v[0], v[1]), pack2(v[2], v[3])}; ((u32x2*)out)[i] = o; }
}
__device__ void d_cvtT64(int vb, char* smem, const float* __restrict__ W, bf16_t* __restrict__ WT, int K, int N, int NP) {
  float (*tt)[65] = (float (*)[65])smem;
  const int tid = (TIDX & 255);
  const int nbx = NP / 64;
  const int n0 = (vb % nbx) * 64, k0 = (vb / nbx) * 64;
  {
    const int kr = tid >> 4, nc = (tid & 15) * 4;
#pragma unroll
    for (int i = 0; i < 4; ++i) {
      const int k = k0 + kr + 16 * i, n = n0 + nc;
      f32x4 v = {0.f, 0.f, 0.f, 0.f};
      if (n < N) v = *(const f32x4*)(W + (size_t)k * N + n);
      tt[kr + 16 * i][nc] = v[0]; tt[kr + 16 * i][nc + 1] = v[1]; tt[kr + 16 * i][nc + 2] = v[2]; tt[kr + 16 * i][nc + 3] = v[3];
    }
  }
  __syncthreads();
  {
    const int nr = tid >> 3, kc = (tid & 7) * 8;
#pragma unroll
    for (int i = 0; i < 2; ++i) {
      const int nl = nr + 32 * i;
      u32x4 o = {pack2(tt[kc][nl], tt[kc + 1][nl]), pack2(tt[kc + 2][nl], tt[kc + 3][nl]), pack2(tt[kc + 4][nl], tt[kc + 5][nl]), pack2(tt[kc + 6][nl], tt[kc + 7][nl])};
      *(u32x4*)(WT + (size_t)(n0 + nl) * K + k0 + kc) = o;
    }
  }
  __syncthreads();
}

using f32x16 = __attribute__((ext_vector_type(16))) float;
using bf16x8v = __attribute__((ext_vector_type(8))) __bf16;
#define MFMA32(a, b, c) __builtin_amdgcn_mfma_f32_32x32x16_bf16((a), (b), (c), 0, 0, 0)
constexpr float LOG2E = 1.4426950408889634f;
constexpr float NEGB = -1e30f;
DI int pi_perm(int i) { return (i & ~12) | ((i & 8) >> 1) | ((i & 4) << 1); }
DI bf16x8 pack8(float a0, float a1, float a2, float a3, float a4, float a5, float a6, float a7) {
  bf16x8v v = {(__bf16)a0, (__bf16)a1, (__bf16)a2, (__bf16)a3, (__bf16)a4, (__bf16)a5, (__bf16)a6, (__bf16)a7};
  return __builtin_bit_cast(bf16x8, v);
}
__device__ __forceinline__ void d_relayout_tile(int T, char* smem, const bf16_t* __restrict__ proj, int col0, bf16_t* __restrict__ dst, bool isV) {
  bf16_t* Ls = (bf16_t*)smem;
  const int tid = TIDX;
#pragma unroll
  for (int q = 0; q < 2; ++q) {
    const int cidx = tid + q * 512;
    const int g = cidx >> 9, tok = (cidx >> 4) & 31, ch = cidx & 15;
    const u32x4 v = *(const u32x4*)(proj + (size_t)(32 * T + tok) * INWP + col0 + g * 128 + ch * 8);
    *(u32x4*)(Ls + (g * 32 + tok) * 136 + ch * 8) = v;
  }
  __syncthreads();
#pragma unroll
  for (int q = 0; q < 2; ++q) {
    const int oc = tid + q * 512;
    const int g = oc >> 9, r9 = oc & 511, lane = r9 & 63;
    u32x4 o;
    if (!isV) {
      const int s8 = r9 >> 6, i = lane & 31, h = lane >> 5;
      o = *(const u32x4*)(Ls + (g * 32 + pi_perm(i)) * 136 + 16 * s8 + 8 * h);
    } else {
      const int s2 = (r9 >> 6) & 1, dt = r9 >> 7, dd = lane & 31, h = lane >> 5;
      const bf16_t* col = Ls + (g * 32 + 16 * s2 + 8 * h) * 136 + 32 * dt + dd;
      unsigned short e[8];
#pragma unroll
      for (int j = 0; j < 8; ++j) e[j] = col[j * 136];
      o.x = e[0] | ((unsigned)e[1] << 16); o.y = e[2] | ((unsigned)e[3] << 16); o.z = e[4] | ((unsigned)e[5] << 16); o.w = e[6] | ((unsigned)e[7] << 16);
    }
    *(u32x4*)(dst + (((size_t)(g * 512 + T)) * 512 + r9) * 8) = o;
  }
  __syncthreads();
}

struct AttnPtrs {
  const bf16_t* proj; const float* gates;
  const bf16_t *kcf, *vcf, *ksf, *vsf, *kwf, *vwf;
  bf16_t* mix; const float* hng;
};

DI float ex2(float x) { return __builtin_amdgcn_exp2f(x); }
DI void halves(float x, float& lo, float& hi) {
  const unsigned u = __float_as_uint(x);
  auto r = __builtin_amdgcn_permlane32_swap(u, u, false, false);
  lo = __uint_as_float(r[0]); hi = __uint_as_float(r[1]);
}
DI float hmax(float x) { float a, b; halves(x, a, b); return fmaxf(a, b); }
DI float hsum(float x) { float a, b; halves(x, a, b); return a + b; }
DI float dpp_quad(float v, int ctrl_is_xor1) {
  const int iv = __float_as_int(v);
  const int r = ctrl_is_xor1 ? __builtin_amdgcn_update_dpp(iv, iv, 0xB1, 0xF, 0xF, false) : __builtin_amdgcn_update_dpp(iv, iv, 0x4E, 0xF, 0xF, false);
  return __int_as_float(r);
}
DI float quad_sum(float v) { v += dpp_quad(v, 1); v += dpp_quad(v, 0); return v; }
DI void osm_step(const float (&sv)[16], float& m, float& l, f32x16 (&O)[4], float (&p)[16]) {
  float tmax = fmaxf(fmaxf(fmaxf(sv[0], sv[1]), fmaxf(sv[2], sv[3])), fmaxf(fmaxf(sv[4], sv[5]), fmaxf(sv[6], sv[7])));
  tmax = fmaxf(tmax, fmaxf(fmaxf(fmaxf(sv[8], sv[9]), fmaxf(sv[10], sv[11])), fmaxf(fmaxf(sv[12], sv[13]), fmaxf(sv[14], sv[15]))));
  tmax = hmax(tmax);
  if (__ballot(tmax - m > 8.f)) {
    const float mn = fmaxf(m, tmax);
    const float alpha = ex2(m - mn);
    l *= alpha; m = mn;
#pragma unroll
    for (int dt = 0; dt < 4; ++dt)
#pragma unroll
      for (int r = 0; r < 16; ++r) O[dt][r] *= alpha;
  }
  float ps0 = 0.f, ps1 = 0.f;
#pragma unroll
  for (int r = 0; r < 16; r += 2) { const float e0 = ex2(sv[r] - m), e1 = ex2(sv[r + 1] - m); p[r] = e0; p[r + 1] = e1; ps0 += e0; ps1 += e1; }
  l += ps0 + ps1;
}
DI void ot_store(char* otL, int lane, const f32x16 (&O)[4], float sc) {
#pragma unroll
  for (int dt = 0; dt < 4; ++dt) {
    u32x4 a, b;
#pragma unroll
    for (int i = 0; i < 4; ++i) { a[i] = pack2(sc * O[dt][2 * i], sc * O[dt][2 * i + 1]); b[i] = pack2(sc * O[dt][8 + 2 * i], sc * O[dt][8 + 2 * i + 1]); }
    *(u32x4*)(otL + lane * 128 + dt * 32) = a;
    *(u32x4*)(otL + lane * 128 + dt * 32 + 16) = b;
  }
}
DI void ot_accum(const char* otL, int lane, f32x16 (&O)[4], float sc) {
#pragma unroll
  for (int dt = 0; dt < 4; ++dt) {
    u32x4 a = *(const u32x4*)(otL + lane * 128 + dt * 32);
    u32x4 b = *(const u32x4*)(otL + lane * 128 + dt * 32 + 16);
#pragma unroll
    for (int i = 0; i < 4; ++i) {
      const unsigned wa = a[i], wb = b[i];
      O[dt][2 * i] = fmaf(sc, O[dt][2 * i], __uint_as_float(wa << 16));
      O[dt][2 * i + 1] = fmaf(sc, O[dt][2 * i + 1], __uint_as_float(wa & 0xFFFF0000u));
      O[dt][8 + 2 * i] = fmaf(sc, O[dt][8 + 2 * i], __uint_as_float(wb << 16));
      O[dt][8 + 2 * i + 1] = fmaf(sc, O[dt][8 + 2 * i + 1], __uint_as_float(wb & 0xFFFF0000u));
    }
  }
}
DI void zero_o(f32x16 (&O)[4]) {
#pragma unroll
  for (int dt = 0; dt < 4; ++dt)
#pragma unroll
    for (int i = 0; i < 16; ++i) O[dt][i] = 0.f;
}

constexpr int ATT_PW = 8704;
constexpr int ATT_R = 4, ATT_D = 3;
constexpr int ATT_RING = 8 * ATT_PW;
constexpr int ATT_LIST = ATT_RING + ATT_R * 16384;
constexpr int ATT_BUNI = ATT_LIST + 2048;
constexpr int ATT_SMEM = ATT_BUNI + 64;
#define LAS3 __attribute__((address_space(3)))
__device__ __forceinline__ void d_select(const float* impL, unsigned* mskL, unsigned* uniL, int cur) {
  const int lane = TIDX & 63;
  const int stok = lane >> 3, sub = lane & 7;
  unsigned key[32];
#pragma unroll
  for (int i4 = 0; i4 < 8; ++i4) {
    f32x4 v = *(const f32x4*)(impL + stok * 256 + sub * 32 + i4 * 4);
#pragma unroll
    for (int e = 0; e < 4; ++e) {
      const int j = sub * 32 + i4 * 4 + e;
      const bool valid = j <= cur;
      const bool forced = (j == 0) || (j == cur) || (j == cur - 1);
      unsigned kb = forced ? 0xFFFFFF00u : (__float_as_uint(v[e]) & 0xFFFFFF00u);
      key[i4 * 4 + e] = valid ? (kb | (unsigned)(255 - j)) : 0u;
    }
  }
#pragma unroll
  for (int k = 2; k <= 32; k <<= 1) {
#pragma unroll
    for (int jj = k >> 1; jj > 0; jj >>= 1) {
#pragma unroll
      for (int i = 0; i < 32; ++i) {
        const int l2 = i ^ jj;
        if (l2 > i) {
          const bool desc = ((i & k) == 0);
          unsigned a = key[i], b = key[l2];
          unsigned mx = a > b ? a : b, mn = a > b ? b : a;
          key[i] = desc ? mx : mn; key[l2] = desc ? mn : mx;
        }
      }
    }
  }
#pragma unroll
  for (int xm = 1; xm < 8; xm <<= 1) {
    unsigned L[16];
#pragma unroll
    for (int i = 0; i < 16; ++i) { unsigned o = (unsigned)shx_i((int)key[15 - i], xm); L[i] = key[i] > o ? key[i] : o; }
#pragma unroll
    for (int jj = 8; jj > 0; jj >>= 1) {
#pragma unroll
      for (int i = 0; i < 16; ++i) {
        const int l2 = i ^ jj;
        if (l2 > i) { unsigned a = L[i], b = L[l2]; L[i] = a > b ? a : b; L[l2] = a > b ? b : a; }
      }
    }
#pragma unroll
    for (int i = 0; i < 16; ++i) key[i] = L[i];
  }
#pragma unroll
  for (int i = 0; i < 16; ++i) {
    if ((i & 7) == sub) {
      const int j = 255 - (int)(key[i] & 255u);
      if (j <= cur) { atomicOr(&mskL[stok * 8 + (j >> 5)], 1u << (j & 31)); atomicOr(&uniL[j >> 5], 1u << (j & 31)); }
    }
  }
}


DI void att_issue(LAS3 unsigned char* ring, int slot, int w, int lane, const bf16_t* kb, const bf16_t* vb, int tile) {
  const char* ks = (const char*)kb + (size_t)tile * 8192 + w * 1024 + lane * 16;
  const char* vs = (const char*)vb + (size_t)tile * 8192 + w * 1024 + lane * 16;
  __builtin_amdgcn_global_load_lds((const unsigned*)ks, (LAS3 unsigned*)(ring + slot * 16384 + w * 1024), 16, 0, 0);
  __builtin_amdgcn_global_load_lds((const unsigned*)vs, (LAS3 unsigned*)(ring + slot * 16384 + 8192 + w * 1024), 16, 0, 0);
}
DI f32x16 qk_lds(LAS3 const unsigned char* kt, const bf16x8 (&qf)[8], int lane) {
  f32x16 acc;
#pragma unroll
  for (int i = 0; i < 16; ++i) acc[i] = 0.f;
#pragma unroll
  for (int s8 = 0; s8 < 8; ++s8) {
    const bf16x8 kf = *(LAS3 const bf16x8*)(kt + s8 * 1024 + lane * 16);
    acc = MFMA32(kf, qf[s8], acc);
  }
  return acc;
}
DI void pv_lds(LAS3 const unsigned char* vt, const float (&p)[16], f32x16 (&O)[4], int lane) {
  const bf16x8 pf0 = pack8(p[0], p[1], p[2], p[3], p[4], p[5], p[6], p[7]);
  const bf16x8 pf1 = pack8(p[8], p[9], p[10], p[11], p[12], p[13], p[14], p[15]);
#pragma unroll
  for (int dt = 0; dt < 4; ++dt) {
    const bf16x8 v0 = *(LAS3 const bf16x8*)(vt + (dt * 2) * 1024 + lane * 16);
    const bf16x8 v1 = *(LAS3 const bf16x8*)(vt + (dt * 2 + 1) * 1024 + lane * 16);
    O[dt] = MFMA32(v0, pf0, O[dt]);
    O[dt] = MFMA32(v1, pf1, O[dt]);
  }
}

__device__ __forceinline__ void d_attn_block(int B, int g, char* smem, const AttnPtrs& P) {
  const int tid = TIDX, lane = tid & 63, w = tid >> 6;
  const int c = lane & 31, h = lane >> 5, tokl = c >> 2, r = c & 3;
  const int tok0 = 64 * B + 8 * w;
  const int t = tok0 + tokl, hd = g * 4 + r;
  const float slope2 = exp2f(-(float)(hd + 1)) * LOG2E;
  const float c1 = QSCALE * LOG2E;
  const float ninf = -__builtin_inff();
  char* wsm = smem + w * ATT_PW;
  float* impL = (float*)wsm;
  char* otL = wsm;
  unsigned* mskL = (unsigned*)(wsm + 8192);
  unsigned* uniL = mskL + 64;
  LAS3 unsigned char* ring = (LAS3 unsigned char*)(smem + ATT_RING);
  unsigned short* tl = (unsigned short*)(smem + ATT_LIST);
  unsigned* buni = (unsigned*)(smem + ATT_BUNI);
  const bf16_t* kcf = P.kcf + (size_t)g * 32 * 4096;
  const bf16_t* vcf = P.vcf + (size_t)g * 32 * 4096;
  const bf16_t* ksf = P.ksf + (size_t)g * 512 * 4096;
  const bf16_t* vsf = P.vsf + (size_t)g * 512 * 4096;
  const bf16_t* kwf = P.kwf + (size_t)g * 512 * 4096;
  const bf16_t* vwf = P.vwf + (size_t)g * 512 * 4096;
  bf16x8 qf[8];
  {
    const bf16_t* qrow = P.proj + (size_t)t * INWP + OFF_Q + hd * 128 + 8 * h;
#pragma unroll
    for (int s8 = 0; s8 < 8; ++s8) qf[s8] = *(const bf16x8*)(qrow + 16 * s8);
  }
  const float* gt = P.gates + (size_t)t * 24 + hd * 3;
  const float g0 = gt[0], g1 = gt[1], g2 = gt[2];
  {
    unsigned z0 = 0u;
    asm volatile("" : "+v"(z0));
    u32x4 z = {z0, z0, z0, z0};
#pragma unroll
    for (int i = 0; i < 8; ++i) *(u32x4*)(wsm + (i * 64 + lane) * 16) = z;
    if (lane < 18) *(u32x4*)(wsm + 8192 + lane * 16) = z;
    if (tid < 8) buni[tid] = z0;
  }
  f32x16 Ob[4];
  zero_o(Ob);
  const int nmax = (t >= 31) ? ((t - 31) >> 4) : -1;
  const int nmaxw = (tok0 + 7 >= 31) ? ((tok0 + 7 - 31) >> 4) : -1;
  const int nminw = (tok0 >= 31) ? ((tok0 - 31) >> 4) : -1;
  const int ntcw = (nmaxw + 32) >> 5;
  const int ntcB = (((64 * B + 63 - 31) >> 4) + 32) >> 5;
  const float sl16 = slope2 * 16.f;
  float mC = NEGB, lC = 0.f, invC = 0.f, carry = 0.f;
  {
    const int n = 2 * ntcB;
    asm volatile("s_waitcnt vmcnt(0)" ::: "memory");
#define A_TILE(i_) (((i_) < ntcB) ? (ntcB - 1 - (i_)) : ((i_) - ntcB))
    att_issue(ring, 0, w, lane, kcf, vcf, A_TILE(0));
    if (n > 1) att_issue(ring, 1, w, lane, kcf, vcf, A_TILE(1));
#pragma unroll 1
    for (int i = 0; i < n; ++i) {
      if ((i & 1) == 0) {
        asm volatile("s_waitcnt vmcnt(0)" ::: "memory");
        __builtin_amdgcn_s_barrier();
        asm volatile("" ::: "memory");
        if (i + 2 < n) att_issue(ring, (i + 2) & 3, w, lane, kcf, vcf, A_TILE(i + 2));
        if (i + 3 < n) att_issue(ring, (i + 3) & 3, w, lane, kcf, vcf, A_TILE(i + 3));
      }
      const int T = A_TILE(i);
      if (T >= ntcw) continue;
      LAS3 const unsigned char* slot = ring + (i % ATT_R) * 16384;
      const f32x16 acc = qk_lds(slot, qf, lane);
      const float base = slope2 * (float)(512 * T + 128 * h) + slope2 * (15.5f - (float)t);
      const int nb = 32 * T + 8 * h;
      const bool full = (32 * T + 31 <= nminw);
      float sv[16];
#pragma unroll
      for (int rg = 0; rg < 16; ++rg) { const int kk = (rg & 7) + 16 * (rg >> 3); sv[rg] = fmaf(acc[rg], c1, fmaf(sl16, (float)kk, base)); }
      if (!full) {
#pragma unroll
        for (int rg = 0; rg < 16; ++rg) { const int kk = (rg & 7) + 16 * (rg >> 3); sv[rg] = (nb + kk <= nmax) ? sv[rg] : ninf; }
      }
      if (i < ntcB) {
        float tmax = fmaxf(fmaxf(fmaxf(sv[0], sv[1]), fmaxf(sv[2], sv[3])), fmaxf(fmaxf(sv[4], sv[5]), fmaxf(sv[6], sv[7])));
        tmax = fmaxf(tmax, fmaxf(fmaxf(fmaxf(sv[8], sv[9]), fmaxf(sv[10], sv[11])), fmaxf(fmaxf(sv[12], sv[13]), fmaxf(sv[14], sv[15]))));
        tmax = hmax(tmax);
        const float mn = fmaxf(mC, tmax);
        float ps = 0.f;
#pragma unroll
        for (int rg = 0; rg < 16; ++rg) ps += ex2(sv[rg] - mn);
        lC = lC * ex2(mC - mn) + ps; mC = mn;
      } else {
        if (T == 0) { lC = hsum(lC); invC = (lC > 0.f) ? 1.f / lC : 0.f; }
        float p[16];
#pragma unroll
        for (int rg = 0; rg < 16; ++rg) p[rg] = ex2(sv[rg] - mC) * invC;
        float Ga = (p[0] + p[1]) + (p[2] + p[3]), Gb = (p[4] + p[5]) + (p[6] + p[7]);
        float Gc = (p[8] + p[9]) + (p[10] + p[11]), Gd = (p[12] + p[13]) + (p[14] + p[15]);
        float xb, xd; { float a_, b_; halves(p[7], a_, b_); xb = h ? a_ : b_; halves(p[15], a_, b_); xd = h ? a_ : b_; }
        float ia = Ga + (h ? xb : carry);
        float ib = Gb + p[3];
        float ic = Gc + (h ? xd : xb);
        float id = Gd + p[11];
        carry = xd;
        ia = quad_sum(ia); ib = quad_sum(ib); ic = quad_sum(ic); id = quad_sum(id);
        {
          float val = (r == 0) ? ia : (r == 1) ? ib : (r == 2) ? ic : id;
          int j = 8 * T + 2 * h + ((r == 0) ? 0 : (r == 1) ? 1 : (r == 2) ? 4 : 5);
          impL[tokl * 256 + j] = val;
        }
        pv_lds(slot + 8192, p, Ob, lane);
      }
    }
#undef A_TILE
  }
  const int cur = B;
  d_select(impL, mskL, uniL, cur);
  ot_store(otL, lane, Ob, g0);
  zero_o(Ob);
  if (lane < 8) { const unsigned u = uniL[lane]; if (u) atomicOr(&buni[lane], u); }
  __syncthreads();
  int nslc = 0, ntl = 0;
  {
    for (int iw = 7; iw >= 0; --iw) {
      unsigned iuw = __builtin_amdgcn_readfirstlane(buni[iw]);
      while (iuw) {
        const int bit = 31 - __builtin_clz(iuw);
        iuw &= ~(1u << bit);
        const int bb = 32 * iw + bit;
        if (bb < B) { if (lane == 0) tl[ntl] = (unsigned short)(2 * bb + 1); ++ntl; }
        else { if (lane == 0) tl[ntl] = (unsigned short)(2 * bb + 1); ++ntl; }
        if (lane == 0) tl[ntl] = (unsigned short)(2 * bb);
        ++ntl;
      }
    }
    nslc = ntl;
    const int ThiB = 2 * B + 1, TloB = ((64 * B - 511 > 0) ? (64 * B - 511) : 0) >> 5;
    for (int T = ThiB; T >= TloB; --T) { if (lane == 0) tl[ntl] = (unsigned short)T; ++ntl; }
  }
  float m = NEGB, l = 0.f;
  {
    const int n = ntl;
    const int Tlow = ((tok0 - 511 > 0) ? (tok0 - 511) : 0) >> 5, Thiw = (tok0 + 7) >> 5;
#define B_ISSUE(j_, slot_) { const int e_ = __builtin_amdgcn_readfirstlane((int)tl[j_]); if ((j_) < nslc) att_issue(ring, slot_, w, lane, ksf, vsf, e_); else att_issue(ring, slot_, w, lane, kwf, vwf, e_); }
    B_ISSUE(0, 0)
    if (n > 1) B_ISSUE(1, 1)
#pragma unroll 1
    for (int i = 0; i < n; ++i) {
      if ((i & 1) == 0) {
        asm volatile("s_waitcnt vmcnt(0)" ::: "memory");
        __builtin_amdgcn_s_barrier();
        asm volatile("" ::: "memory");
        if (i + 2 < n) B_ISSUE(i + 2, (i + 2) & 3)
        if (i + 3 < n) B_ISSUE(i + 3, (i + 3) & 3)
      }
      if (i == nslc) {
        l = hsum(l);
        const float inv = (l > 0.f) ? g1 / l : 0.f;
        ot_accum(otL, lane, Ob, inv);
        ot_store(otL, lane, Ob, 1.f);
        zero_o(Ob);
        m = NEGB; l = 0.f;
      }
      const int T = __builtin_amdgcn_readfirstlane((int)tl[i]);
      const int pos0 = 32 * T, pb = pos0 + 8 * h;
      bool full; bool mine = true;
      if (i < nslc) {
        const int bb = T >> 1;
        const unsigned uw = __builtin_amdgcn_readfirstlane(uniL[bb >> 5]);
        if (!((uw >> (bb & 31)) & 1u) || pos0 > tok0 + 7) continue;
        mine = (mskL[tokl * 8 + (bb >> 5)] >> (bb & 31)) & 1u;
        full = (pos0 + 31 <= tok0) && (__ballot(!mine) == 0ull);
      } else {
        if (T < Tlow || T > Thiw) continue;
        full = (pos0 + 31 <= tok0) && (pos0 >= tok0 + 7 - 511);
      }
      LAS3 const unsigned char* slot = ring + (i % ATT_R) * 16384;
      const f32x16 acc = qk_lds(slot, qf, lane);
      const float base = slope2 * (float)(pos0 + 8 * h - t);
      float sv[16], p[16];
#pragma unroll
      for (int rg = 0; rg < 16; ++rg) { const int kk = (rg & 7) + 16 * (rg >> 3); sv[rg] = fmaf(acc[rg], c1, fmaf(slope2, (float)kk, base)); }
      if (!full) {
        if (i < nslc) {
#pragma unroll
          for (int rg = 0; rg < 16; ++rg) { const int kk = (rg & 7) + 16 * (rg >> 3); sv[rg] = (mine && (pb + kk <= t)) ? sv[rg] : ninf; }
        } else {
#pragma unroll
          for (int rg = 0; rg < 16; ++rg) { const int kk = (rg & 7) + 16 * (rg >> 3); const int dw = t - (pb + kk); sv[rg] = ((dw >= 0) && (dw < 512)) ? sv[rg] : ninf; }
        }
      }
      osm_step(sv, m, l, Ob, p);
      pv_lds(slot + 8192, p, Ob, lane);
    }
#undef B_ISSUE
    l = hsum(l);
    const float inv = (l > 0.f) ? g2 / l : 0.f;
    ot_accum(otL, lane, Ob, inv);
  }
  {
    float ss = 0.f;
#pragma unroll
    for (int dt = 0; dt < 4; ++dt)
#pragma unroll
      for (int i = 0; i < 16; ++i) ss = fmaf(Ob[dt][i], Ob[dt][i], ss);
    ss = hsum(ss);
    const float rs = rsqrtf(ss * (1.f / 128.f) + 1e-6f);
    bf16_t* orow = P.mix + (size_t)t * DM + hd * 128 + 4 * h;
    const float* grow = P.hng + hd * 128 + 4 * h;
#pragma unroll
    for (int dt = 0; dt < 4; ++dt)
#pragma unroll
      for (int a = 0; a < 4; ++a) {
        const f32x4 gv = *(const f32x4*)(grow + 32 * dt + 8 * a);
        u32x2 wv2 = {pack2(Ob[dt][4 * a] * rs * gv[0], Ob[dt][4 * a + 1] * rs * gv[1]), pack2(Ob[dt][4 * a + 2] * rs * gv[2], Ob[dt][4 * a + 3] * rs * gv[3])};
        *(u32x2*)(orow + 32 * dt + 8 * a) = wv2;
      }
  }
  asm volatile("s_waitcnt vmcnt(0)" ::: "memory");
  __syncthreads();
}

__device__ void d_convmix(int t, int tl, const bf16_t* __restrict__ proj, const float* __restrict__ convw, const float* __restrict__ hng,
                          bf16_t* __restrict__ mix) {
  const int c = tl * 8;
  float acc[8];
#pragma unroll
  for (int i = 0; i < 8; ++i) acc[i] = 0.f;
#pragma unroll
  for (int j = 0; j < 3; ++j) {
    const int tt = t - 2 + j;
    if (tt >= 0) {
      const u32x4 cu = *(const u32x4*)(proj + (size_t)tt * INWP + OFF_C + c);
      const u32x4 uu = *(const u32x4*)(proj + (size_t)tt * INWP + OFF_U + c);
      const f32x4 w0 = *(const f32x4*)(convw + j * 1024 + c), w1 = *(const f32x4*)(convw + j * 1024 + c + 4);
#pragma unroll
      for (int i = 0; i < 4; ++i) {
        const unsigned a = cu[i], b = uu[i];
        const float wl = (i < 2) ? w0[2 * i] : w1[2 * i - 4], wh = (i < 2) ? w0[2 * i + 1] : w1[2 * i - 3];
        acc[2 * i] = fmaf(wl * __uint_as_float(a << 16), __uint_as_float(b << 16), acc[2 * i]);
        acc[2 * i + 1] = fmaf(wh * __uint_as_float(a & 0xFFFF0000u), __uint_as_float(b & 0xFFFF0000u), acc[2 * i + 1]);
      }
    }
  }
  const u32x4 bb = *(const u32x4*)(proj + (size_t)t * INWP + OFF_B + c);
  float ss = 0.f;
#pragma unroll
  for (int i = 0; i < 4; ++i) {
    const unsigned b = bb[i];
    acc[2 * i] *= __uint_as_float(b << 16); acc[2 * i + 1] *= __uint_as_float(b & 0xFFFF0000u);
    ss = fmaf(acc[2 * i], acc[2 * i], ss); ss = fmaf(acc[2 * i + 1], acc[2 * i + 1], ss);
  }
  ss += shx(ss, 8); ss += shx(ss, 4); ss += shx(ss, 2); ss += shx(ss, 1);
  const float rs = rsqrtf(ss * (1.f / 128.f) + 1e-6f);
  const f32x4 g0 = *(const f32x4*)(hng + 1024 + c), g1 = *(const f32x4*)(hng + 1024 + c + 4);
  u32x4 o = {pack2(acc[0] * rs * g0[0], acc[1] * rs * g0[1]), pack2(acc[2] * rs * g0[2], acc[3] * rs * g0[3]),
             pack2(acc[4] * rs * g1[0], acc[5] * rs * g1[1]), pack2(acc[6] * rs * g1[2], acc[7] * rs * g1[3])};
  *(u32x4*)(mix + (size_t)t * DM + 1024 + c) = o;
}

__device__ void d_ln_wave(int t, bf16_t* __restrict__ yh, const float* __restrict__ gam, const float* __restrict__ bet) {
  const int lane = TIDX & 63;
  float v[32];
#pragma unroll
  for (int i = 0; i < 4; ++i) {
    const u32x4 w = *(const u32x4*)(yh + (size_t)t * DM + 512 * i + 8 * lane);
#pragma unroll
    for (int j = 0; j < 4; ++j) { const unsigned ww = w[j]; v[i * 8 + 2 * j] = __uint_as_float(ww << 16); v[i * 8 + 2 * j + 1] = __uint_as_float(ww & 0xFFFF0000u); }
  }
  float s = 0.f;
#pragma unroll
  for (int i = 0; i < 32; ++i) s += v[i];
  s = wave_sum(s);
  const float mu = s * (1.f / DM);
  float q = 0.f;
#pragma unroll
  for (int i = 0; i < 32; ++i) { const float d = v[i] - mu; q = fmaf(d, d, q); }
  q = wave_sum(q);
  const float rs = rsqrtf(q * (1.f / DM) + 1e-5f);
#pragma unroll
  for (int i = 0; i < 4; ++i) {
    const int cb = 512 * i + 8 * lane;
    const f32x4 g0 = *(const f32x4*)(gam + cb), g1 = *(const f32x4*)(gam + cb + 4), b0 = *(const f32x4*)(bet + cb), b1 = *(const f32x4*)(bet + cb + 4);
    u32x4 o = {pack2((v[i * 8 + 0] - mu) * rs * g0[0] + b0[0], (v[i * 8 + 1] - mu) * rs * g0[1] + b0[1]), pack2((v[i * 8 + 2] - mu) * rs * g0[2] + b0[2], (v[i * 8 + 3] - mu) * rs * g0[3] + b0[3]),
               pack2((v[i * 8 + 4] - mu) * rs * g1[0] + b1[0], (v[i * 8 + 5] - mu) * rs * g1[1] + b1[1]), pack2((v[i * 8 + 6] - mu) * rs * g1[2] + b1[2], (v[i * 8 + 7] - mu) * rs * g1[3] + b1[3])};
    *(u32x4*)(yh + (size_t)t * DM + cb) = o;
  }
}

__device__ void d_cvt_w1f(size_t c, const float* __restrict__ w1, bf16_t* __restrict__ w1f) {
  const int lane = c & 63, ks = (c >> 6) & 255, ct = c >> 14;
  const int col = lane & 31, h = lane >> 5;
  bf16_t v[8];
#pragma unroll
  for (int j = 0; j < 8; ++j) v[j] = f2bf(w1[(size_t)(16 * ks + 8 * h + j) * 512 + 32 * ct + col]);
  u32x4 o; o.x = v[0] | ((unsigned)v[1] << 16); o.y = v[2] | ((unsigned)v[3] << 16); o.z = v[4] | ((unsigned)v[5] << 16); o.w = v[6] | ((unsigned)v[7] << 16);
  *(u32x4*)(w1f + c * 8) = o;
}
__device__ void d_cvt_w2f(size_t c, const float* __restrict__ w2, bf16_t* __restrict__ w2f) {
  const int lane = c & 63, s = (c >> 6) & 31, ct = c >> 11;
  const int col = lane & 31, h = lane >> 5;
  bf16_t v[8];
#pragma unroll
  for (int j = 0; j < 8; ++j) v[j] = f2bf(w2[(size_t)(16 * s + 8 * h + j) * 128 + 32 * ct + col]);
  u32x4 o; o.x = v[0] | ((unsigned)v[1] << 16); o.y = v[2] | ((unsigned)v[3] << 16); o.z = v[4] | ((unsigned)v[5] << 16); o.w = v[6] | ((unsigned)v[7] << 16);
  *(u32x4*)(w2f + c * 8) = o;
}
__device__ __forceinline__ void d_compress_unit(int rt, char* smem, const bf16_t* __restrict__ proj, int col0, const float* __restrict__ pos,
                                const bf16_t* __restrict__ w1f, const float* __restrict__ b1, const bf16_t* __restrict__ w2f,
                                bf16_t* __restrict__ outf, bool isV) {
  bf16_t* Xs = (bf16_t*)smem;
  bf16_t* Hs = (bf16_t*)(smem + 2 * 8704);
  const int tid = TIDX, lane = tid & 63, w = tid >> 6, c = lane & 31, h = lane >> 5;
  const int R0 = rt * 32;
  const int srow = tid >> 4, sch = tid & 15;
  const int grow = R0 + srow, sn = grow >> 1, sg = grow & 1;
  const bool svalid = grow < 2046;
  const bf16_t* sp = proj + (size_t)(16 * sn) * INWP + col0 + sg * 128 + sch * 8;
  f32x16 acc0, acc1;
#pragma unroll
  for (int i = 0; i < 16; ++i) { acc0[i] = 0.f; acc1[i] = 0.f; }
  u32x4 rx = {0u, 0u, 0u, 0u}; f32x4 rp0, rp1;
#define STAGE_WRITE(buf)                                                                                   \
  {                                                                                                        \
    u32x4 o_;                                                                                              \
    _Pragma("unroll") for (int i = 0; i < 4; ++i) {                                                        \
      const unsigned wv_ = rx[i];                                                                          \
      const float lo = __uint_as_float(wv_ << 16) + ((i < 2) ? rp0[2 * i] : rp1[2 * i - 4]);               \
      const float hi = __uint_as_float(wv_ & 0xFFFF0000u) + ((i < 2) ? rp0[2 * i + 1] : rp1[2 * i - 3]);   \
      o_[i] = pack2(lo, hi);                                                                               \
    }                                                                                                      \
    *(u32x4*)(Xs + (buf) * 4352 + srow * 136 + sch * 8) = o_;                                              \
  }
  if (svalid) rx = *(const u32x4*)(sp);
  rp0 = *(const f32x4*)(pos + sch * 8); rp1 = *(const f32x4*)(pos + sch * 8 + 4);
  STAGE_WRITE(0)
  __syncthreads();
  const bf16_t* wb0 = w1f + ((size_t)(2 * w) * 256 * 64 + lane) * 8;
  const bf16_t* wb1 = w1f + ((size_t)(2 * w + 1) * 256 * 64 + lane) * 8;
  bf16x8 bA[16], bB[16];
#define CMP_LOADB(BUF, L)                                                                      \
  _Pragma("unroll") for (int s8 = 0; s8 < 8; ++s8) {                                           \
    BUF[2 * s8] = *(const bf16x8*)(wb0 + (size_t)(8 * (L) + s8) * 512);                        \
    BUF[2 * s8 + 1] = *(const bf16x8*)(wb1 + (size_t)(8 * (L) + s8) * 512);                    \
  }
#define CMP_CHUNK(BUF, L)                                                                      \
  {                                                                                            \
    if ((L) + 1 < 32) {                                                                        \
      if (svalid) rx = *(const u32x4*)(sp + (size_t)((L) + 1) * INWP);                         \
      rp0 = *(const f32x4*)(pos + ((L) + 1) * 128 + sch * 8); rp1 = *(const f32x4*)(pos + ((L) + 1) * 128 + sch * 8 + 4); \
    }                                                                                          \
    const bf16_t* xa = Xs + ((L) & 1) * 4352 + c * 136 + 8 * h;                                \
    _Pragma("unroll") for (int s8 = 0; s8 < 8; ++s8) {                                         \
      const bf16x8 a = *(const bf16x8*)(xa + 16 * s8);                                         \
      acc0 = MFMA32(a, BUF[2 * s8], acc0);                                                     \
      acc1 = MFMA32(a, BUF[2 * s8 + 1], acc1);                                                 \
    }                                                                                          \
    if ((L) + 1 < 32) STAGE_WRITE(((L) + 1) & 1)                                               \
    __syncthreads();                                                                           \
  }
  CMP_LOADB(bA, 0)
#pragma unroll 1
  for (int l = 0; l < 32; l += 2) {
    CMP_LOADB(bB, l + 1)
    __builtin_amdgcn_sched_barrier(0);
    CMP_CHUNK(bA, l)
    { const int ln = (l + 2 < 32) ? l + 2 : l;
      CMP_LOADB(bA, ln) }
    __builtin_amdgcn_sched_barrier(0);
    CMP_CHUNK(bB, l + 1)
  }
#undef CMP_LOADB
#undef CMP_CHUNK
  {
    const float bb0 = b1[64 * w + c], bb1 = b1[64 * w + 32 + c];
#pragma unroll
    for (int rg = 0; rg < 16; ++rg) {
      const int row = (rg & 3) + 8 * (rg >> 2) + 4 * h;
      Hs[row * 520 + 64 * w + c] = f2bf(gelu_tanh(acc0[rg] + bb0));
      Hs[row * 520 + 64 * w + 32 + c] = f2bf(gelu_tanh(acc1[rg] + bb1));
    }
  }
  __syncthreads();
  if (w < 4) {
    f32x16 o2;
#pragma unroll
    for (int i = 0; i < 16; ++i) o2[i] = 0.f;
    const bf16_t* ha = Hs + c * 520 + 8 * h;
    const bf16_t* wb = w2f + ((size_t)w * 32 * 64 + lane) * 8;
#pragma unroll 8
    for (int s2 = 0; s2 < 32; ++s2) {
      const bf16x8 a = *(const bf16x8*)(ha + 16 * s2);
      const bf16x8 b = *(const bf16x8*)(wb + (size_t)s2 * 512);
      o2 = MFMA32(a, b, o2);
    }
    const int d = 32 * w + c;
#pragma unroll
    for (int rg = 0; rg < 16; ++rg) {
      const int row = R0 + (rg & 3) + 8 * (rg >> 2) + 4 * h;
      const int n = row >> 1, g = row & 1;
      const bf16_t val = (row < 2046) ? f2bf(o2[rg]) : (bf16_t)0;
      const int T = n >> 5, nn = n & 31;
      size_t idx;
      if (!isV) idx = ((((size_t)(g * 32 + T) * 8 + (d >> 4)) * 64 + (pi_perm(nn) + 32 * ((d >> 3) & 1))) * 8 + (d & 7));
      else idx = (((((size_t)(g * 32 + T) * 4 + (d >> 5)) * 2 + (nn >> 4)) * 64 + ((d & 31) + 32 * ((nn >> 3) & 1))) * 8 + (nn & 7));
      outf[idx] = val;
    }
  }
  __syncthreads();
}


DI unsigned f2sort(float f) { unsigned u = __float_as_uint(f); return u ^ ((unsigned)((int)u >> 31) | 0x80000000u); }
DI float sort2f(unsigned k) { unsigned u = (k & 0x80000000u) ? (k ^ 0x80000000u) : ~k; return __uint_as_float(u); }
template <int N>
DI void bitonic_sort_desc(unsigned (&key)[N]) {
#pragma unroll
  for (int k = 2; k <= N; k <<= 1) {
#pragma unroll
    for (int jj = k >> 1; jj > 0; jj >>= 1) {
#pragma unroll
      for (int i = 0; i < N; ++i) {
        const int l2 = i ^ jj;
        if (l2 > i) {
          const bool desc = ((i & k) == 0);
          unsigned a = key[i], b = key[l2];
          unsigned mx = a > b ? a : b, mn = a > b ? b : a;
          key[i] = desc ? mx : mn; key[l2] = desc ? mn : mx;
        }
      }
    }
  }
}
DI void merge_top16(unsigned (&a)[16], const unsigned (&b)[16]) {
#pragma unroll
  for (int i = 0; i < 16; ++i) { unsigned o = b[15 - i]; a[i] = a[i] > o ? a[i] : o; }
#pragma unroll
  for (int jj = 8; jj > 0; jj >>= 1) {
#pragma unroll
    for (int i = 0; i < 16; ++i) {
      const int l2 = i ^ jj;
      if (l2 > i) { unsigned x = a[i], y = a[l2]; a[i] = x > y ? x : y; a[l2] = x > y ? y : x; }
    }
  }
}
__device__ void d_cvt_subk(size_t c, const float* __restrict__ subk, bf16_t* __restrict__ skf) {
  int lane = c & 63, s = (c >> 6) & 7, kt = (c >> 9) & 3, hc = c >> 11;
  int i = lane & 31, h = lane >> 5;
  const float* src = subk + ((size_t)hc * 128 + 32 * kt + i) * 128 + 16 * s + 8 * h;
  bf16_t v[8];
#pragma unroll
  for (int j = 0; j < 8; ++j) v[j] = f2bf(src[j]);
  u32x4 o; o.x = v[0] | ((unsigned)v[1] << 16); o.y = v[2] | ((unsigned)v[3] << 16); o.z = v[4] | ((unsigned)v[5] << 16); o.w = v[6] | ((unsigned)v[7] << 16);
  *(u32x4*)(skf + c * 8) = o;
}

#define EPI_LANES()                                                                                                      \
    const int lane = fr | (fq << 4), rr = lane >> 2, rc = lane & 3;                                                       \
    PG8_LAS unsigned char* my = scr + (wr * 4 + wc) * 2048;                                                              \
    const int wo = fr * 64 + ((fq ^ ((fr >> 2) & 3)) << 4), ro = rr * 64 + ((rc ^ ((rr >> 2) & 3)) << 4);
struct EpiProjG {
  static constexpr bool PERM = true, AFTER_DRAIN = false;
  bf16_t* proj; float* gates; PG8_LAS unsigned char* scr;
  DI void operator()(const f32x4 (&acc)[2][2][4][2], const pg8::Unit& u, int wr, int wc, int fr, int fq) const {
    EPI_LANES()
#pragma unroll
    for (int ai = 0; ai < 2; ++ai)
#pragma unroll
      for (int bj = 0; bj < 2; ++bj) {
        const int c0 = u.pn * 256 + bj * 128 + wc * 32 + 8 * fq, cs = u.pn * 256 + bj * 128 + wc * 32 + 8 * rc;
#pragma unroll
        for (int mh = 0; mh < 2; ++mh) {
#pragma unroll
          for (int mm = 0; mm < 2; ++mm) {
            const f32x4 v0 = acc[ai][bj][mh * 2 + mm][0], v1 = acc[ai][bj][mh * 2 + mm][1];
            u32x4 w = {pack2(v0[0], v0[1]), pack2(v0[2], v0[3]), pack2(v1[0], v1[1]), pack2(v1[2], v1[3])};
            *(PG8_LAS u32x4*)(my + wo + mm * 1024) = w;
            if (c0 >= OFF_G && c0 < OFF_G + 24) {
              const int row = u.pm * 256 + ai * 128 + wr * 64 + (mh * 2 + mm) * 16 + fr;
              f32x4 g0, g1;
#pragma unroll
              for (int j = 0; j < 4; ++j) { g0[j] = 1.f / (1.f + __expf(-v0[j])); g1[j] = 1.f / (1.f + __expf(-v1[j])); }
              *(f32x4*)(gates + (size_t)row * 24 + (c0 - OFF_G)) = g0;
              *(f32x4*)(gates + (size_t)row * 24 + (c0 - OFF_G) + 4) = g1;
            }
          }
#pragma unroll
          for (int j = 0; j < 2; ++j) {
            const u32x4 w = *(const PG8_LAS u32x4*)(my + ro + j * 1024);
            const int row = u.pm * 256 + ai * 128 + wr * 64 + mh * 32 + j * 16 + rr;
            if (cs < INW) *(u32x4*)(proj + (size_t)row * INWP + cs) = w;
          }
        }
      }
  }
};
struct EpiResG {
  static constexpr bool PERM = true, AFTER_DRAIN = false;
  bf16_t* YB; PG8_LAS unsigned char* scr;
  DI void operator()(const f32x4 (&acc)[2][2][4][2], const pg8::Unit& u, int wr, int wc, int fr, int fq) const {
    EPI_LANES()
    bf16_t* yb = YB + (size_t)(u.pm * 256 + wr * 64 + rr) * DM + u.pn * 256 + wc * 32 + 8 * rc;
#pragma unroll
    for (int ai = 0; ai < 2; ++ai) {
      u32x4 xr[2][2][2];
#pragma unroll
      for (int bj = 0; bj < 2; ++bj)
#pragma unroll
        for (int mh = 0; mh < 2; ++mh)
#pragma unroll
          for (int j = 0; j < 2; ++j) xr[bj][mh][j] = *(const u32x4*)(yb + (size_t)(ai * 128 + mh * 32 + j * 16) * DM + bj * 128);
#pragma unroll
      for (int bj = 0; bj < 2; ++bj)
#pragma unroll
        for (int mh = 0; mh < 2; ++mh) {
#pragma unroll
          for (int mm = 0; mm < 2; ++mm) {
            const f32x4 v0 = acc[ai][bj][mh * 2 + mm][0], v1 = acc[ai][bj][mh * 2 + mm][1];
            u32x4 w = {pack2(v0[0], v0[1]), pack2(v0[2], v0[3]), pack2(v1[0], v1[1]), pack2(v1[2], v1[3])};
            *(PG8_LAS u32x4*)(my + wo + mm * 1024) = w;
          }
#pragma unroll
          for (int j = 0; j < 2; ++j) {
            const u32x4 a = *(const PG8_LAS u32x4*)(my + ro + j * 1024), xw = xr[bj][mh][j];
            u32x4 o;
#pragma unroll
            for (int q = 0; q < 4; ++q) {
              const unsigned aw = a[q], xq = xw[q];
              o[q] = pack2(fmaf(ALPHA, __uint_as_float(xq << 16), __uint_as_float(aw << 16)), fmaf(ALPHA, __uint_as_float(xq & 0xFFFF0000u), __uint_as_float(aw & 0xFFFF0000u)));
            }
            *(u32x4*)(yb + (size_t)(ai * 128 + mh * 32 + j * 16) * DM + bj * 128) = o;
          }
        }
    }
  }
};
struct EpiF32G {
  static constexpr bool PERM = false, AFTER_DRAIN = false;
  float* C; int ldc;
  DI void operator()(const f32x4 (&acc)[2][2][4][2], const pg8::Unit& u, int wr, int wc, int fr, int fq) const {
#pragma unroll
    for (int ai = 0; ai < 2; ++ai)
#pragma unroll
      for (int m = 0; m < 4; ++m) {
        const size_t ro = (size_t)(u.pm * 256 + ai * 128 + wr * 64 + m * 16 + fr) * ldc + u.pn * 256 + wc * 32 + 4 * fq;
#pragma unroll
        for (int bj = 0; bj < 2; ++bj)
#pragma unroll
          for (int n = 0; n < 2; ++n) *(f32x4*)(C + ro + bj * 128 + n * 16) = acc[ai][bj][m][n];
      }
  }
};
struct EpiRouteG {
  static constexpr bool PERM = false, AFTER_DRAIN = true;
  const bf16_t* skf; unsigned* tops;
  DI void operator()(const f32x4 (&)[2][2][4][2], const pg8::Unit&, int, int, int, int) const {}
  DI void fused(const f32x4 (&acc)[2][2][4][2], const pg8::Unit& u, int wr, int wc, int fr, int fq, PG8_LAS unsigned char* ldsp, int, int) const {
    const int lane = fr | (fq << 4), wid = wr * 4 + wc;
    bf16_t* Qs = (bf16_t*)ldsp;
#pragma unroll
    for (int ai = 0; ai < 2; ++ai)
#pragma unroll
      for (int m = 0; m < 4; ++m) {
        const int row = ai * 128 + wr * 64 + m * 16 + fr;
#pragma unroll
        for (int bj = 0; bj < 2; ++bj)
#pragma unroll
          for (int n = 0; n < 2; ++n) {
            const f32x4 v = acc[ai][bj][m][n];
            u32x2 w = {pack2(v[0], v[1]), pack2(v[2], v[3])};
            *(u32x2*)(Qs + row * 264 + bj * 128 + wc * 32 + n * 16 + 4 * fq) = w;
          }
      }
    __syncthreads();
    const int c = lane & 31, h = lane >> 5;
#pragma unroll 1
    for (int half = 0; half < 2; ++half) {
      const int hc = u.pn * 2 + half;
      const bf16_t* sk = skf + (size_t)hc * 4 * 4096;
      const bf16_t* qp = Qs + (wid * 32 + c) * 264 + half * 128 + 8 * h;
      unsigned k0[16], k1[16];
#define ROUTE_KT(KT, KA)                                                                        \
      {                                                                                         \
        f32x16 sc;                                                                              \
        _Pragma("unroll") for (int i = 0; i < 16; ++i) sc[i] = 0.f;                             \
        _Pragma("unroll") for (int s = 0; s < 8; ++s) {                                         \
          bf16x8 af = *(const bf16x8*)(sk + (KT) * 4096 + s * 512 + lane * 8);                  \
          bf16x8 bq = *(const bf16x8*)(qp + 16 * s);                                            \
          sc = __builtin_amdgcn_mfma_f32_32x32x16_bf16(af, bq, sc, 0, 0, 0);                    \
        }                                                                                       \
        _Pragma("unroll") for (int rg = 0; rg < 16; ++rg) {                                     \
          const int kidx = 32 * (KT) + (rg & 3) + 8 * (rg >> 2) + 4 * h;                        \
          KA[rg] = (f2sort(sc[rg]) & 0xFFFFFF80u) | (unsigned)(127 - kidx);                     \
        }                                                                                       \
        bitonic_sort_desc<16>(KA);                                                              \
      }
      ROUTE_KT(0, k0)
      __builtin_amdgcn_sched_barrier(0);
      ROUTE_KT(1, k1)
      merge_top16(k0, k1);
      __builtin_amdgcn_sched_barrier(0);
      ROUTE_KT(2, k1)
      merge_top16(k0, k1);
      __builtin_amdgcn_sched_barrier(0);
      ROUTE_KT(3, k1)
      merge_top16(k0, k1);
      __builtin_amdgcn_sched_barrier(0);
#undef ROUTE_KT
#pragma unroll
      for (int i = 0; i < 16; ++i) k1[i] = (unsigned)shx_i((int)k0[i], 32);
      merge_top16(k0, k1);
      if (h == 0) {
        unsigned* dst = tops + ((size_t)(u.pm * 256 + wid * 32 + c) * 16 + hc) * 16;
#pragma unroll
        for (int q4 = 0; q4 < 4; ++q4) { u32x4 o = {k0[4 * q4], k0[4 * q4 + 1], k0[4 * q4 + 2], k0[4 * q4 + 3]}; *(u32x4*)(dst + 4 * q4) = o; }
      }
    }
    __syncthreads();
  }
};


template <int CTRL> DI float dpp_f(float v) { const int iv = __float_as_int(v); return __int_as_float(__builtin_amdgcn_update_dpp(iv, iv, CTRL, 0xF, 0xF, false)); }
DI float wsum(float x) {
  x += dpp_f<0xB1>(x);
  x += dpp_f<0x4E>(x);
  x += dpp_f<0x124>(x);
  x += dpp_f<0x128>(x);
  x += shx(x, 16);
  return hsum(x);
}
DI float gelu_fast(float x) {
  const float u2 = 1.5957691216057308f * (x + 0.044715f * x * x * x);
  return x * __builtin_amdgcn_rcpf(1.f + ex2(-LOG2E * u2));
}

constexpr int EROW = 1024;
typedef float v2f __attribute__((ext_vector_type(2)));
__device__ void d_cvt_fp4_row(int row, const float* __restrict__ src, unsigned char* __restrict__ dst, float* __restrict__ scales) {
  const int lane = TIDX & 63;
  float v[32]; float amax = 0.f;
#pragma unroll
  for (int i = 0; i < 8; ++i) {
    f32x4 x = *(const f32x4*)(src + (size_t)row * DM + 256 * i + 4 * lane);
#pragma unroll
    for (int j = 0; j < 4; ++j) { v[i * 4 + j] = x[j]; amax = fmaxf(amax, fabsf(x[j])); }
  }
  amax = wave_max(amax);
  const float sc = amax > 0.f ? amax * (1.f / 7.f) : 1.f;
  const float inv = 1.f / sc;
  u32x4 o;
#pragma unroll
  for (int k = 0; k < 4; ++k) {
    unsigned w = 0u;
#define FP4C(x_) fminf(fmaxf((x_) * inv, -6.f), 6.f)
    w = __builtin_amdgcn_cvt_scalef32_pk_fp4_f32(w, FP4C(v[8 * k + 0]), FP4C(v[8 * k + 1]), 1.0f, 0);
    w = __builtin_amdgcn_cvt_scalef32_pk_fp4_f32(w, FP4C(v[8 * k + 2]), FP4C(v[8 * k + 3]), 1.0f, 1);
    w = __builtin_amdgcn_cvt_scalef32_pk_fp4_f32(w, FP4C(v[8 * k + 4]), FP4C(v[8 * k + 5]), 1.0f, 2);
    w = __builtin_amdgcn_cvt_scalef32_pk_fp4_f32(w, FP4C(v[8 * k + 6]), FP4C(v[8 * k + 7]), 1.0f, 3);
#undef FP4C
    o[k] = w;
  }
  *(u32x4*)(dst + (size_t)row * EROW + 16 * lane) = o;
  if (lane == 0) scales[row] = sc;
}
__device__ void d_cvt_i4_row(int row, const float* __restrict__ src, unsigned char* __restrict__ dst, float* __restrict__ scales) {
  const int lane = TIDX & 63;
  float v[32]; float amax = 0.f, ss = 0.f;
#pragma unroll
  for (int i = 0; i < 8; ++i) {
    f32x4 x = *(const f32x4*)(src + (size_t)row * DM + 256 * i + 4 * lane);
#pragma unroll
    for (int j = 0; j < 4; ++j) { v[i * 4 + j] = x[j]; amax = fmaxf(amax, fabsf(x[j])); ss = fmaf(x[j], x[j], ss); }
  }
  amax = wave_max(amax); ss = wave_sum(ss);
  float sc = fmaxf(0.36f * sqrtf(ss * (1.f / DM)), amax * (1.f / 14.f));
  sc = sc > 0.f ? sc : 1.f;
  const float inv = 1.f / sc;
  u32x4 o;
#pragma unroll
  for (int k = 0; k < 4; ++k) {
    unsigned w = 0u;
#pragma unroll
    for (int j = 0; j < 8; ++j) {
      const float q = fminf(fmaxf(v[8 * k + j] * inv, -7.f), 7.f) + 12582912.f;
      w |= (__float_as_uint(q) & 15u) << (4 * j);
    }
    o[k] = w;
  }
  *(u32x4*)(dst + (size_t)row * EROW + 16 * lane) = o;
  if (lane == 0) scales[row] = sc;
}
__device__ void d_expert_u(int t, unsigned* tpl, u32x4* slot, const bf16_t* __restrict__ hbuf,
                           const unsigned* __restrict__ tops, const unsigned char* __restrict__ eu4,
                           const float* __restrict__ esu, const float* __restrict__ esv) {
  const int lane = TIDX & 63;
  float hv[32];
#pragma unroll
  for (int i = 0; i < 8; ++i) {
    const u32x2 w = *(const u32x2*)(hbuf + (size_t)t * DM + 256 * i + 4 * lane);
    hv[i * 4 + 0] = __uint_as_float(w[0] << 16); hv[i * 4 + 1] = __uint_as_float(w[0] & 0xFFFF0000u);
    hv[i * 4 + 2] = __uint_as_float(w[1] << 16); hv[i * 4 + 3] = __uint_as_float(w[1] & 0xFFFF0000u);
  }
  int e0 = 0, e1 = 0; float w0 = 0.f, w1 = 0.f;
  {
    const int ci = (lane < 16) ? 0 : (lane < 24) ? 1 : (lane < 29) ? 2 : (lane < 33) ? 3 : (lane < 36) ? 4 : (lane < 38) ? 5 : (lane < 40) ? 6
                   : (lane < 42) ? 7 : (lane - 34);
    const int cpre = (ci == 0) ? 0 : (ci == 1) ? 16 : (ci == 2) ? 24 : (ci == 3) ? 29 : (ci == 4) ? 33 : (ci == 5) ? 36 : (ci == 6) ? 38
                     : (ci == 7) ? 40 : (34 + ci);
    const int cj = lane - cpre;
    const bool cvalid = lane < 50;
    *(u32x4*)(tpl + 4 * lane) = *(const u32x4*)(tops + (size_t)t * 256 + 4 * lane);
    const unsigned* tp = tpl;
#pragma unroll 1
    for (int hh = 0; hh < 8; ++hh) {
      unsigned key = 0u;
      if (cvalid) {
        const float sa = sort2f(tp[(2 * hh) * 16 + ci]), sb = sort2f(tp[(2 * hh + 1) * 16 + cj]);
        key = (f2sort(sa + sb) & 0xFFFFFF00u) | (unsigned)(255 - (ci * 16 + cj));
      }
#pragma unroll
      for (int k = 2; k <= 64; k <<= 1) {
#pragma unroll
        for (int jj = k >> 1; jj > 0; jj >>= 1) {
          const unsigned o = (unsigned)shx_i((int)key, jj);
          const bool lower = (lane & jj) == 0;
          const bool desc = (lane & k) == 0 || k == 64;
          const unsigned mx = key > o ? key : o, mn = key > o ? o : key;
          key = (lower == desc) ? mx : mn;
        }
      }
      const int flat = 255 - (int)(key & 255u);
      const int bi = (flat >> 4) & 15, bj = flat & 15;
      const unsigned ka = tp[(2 * hh) * 16 + bi], kb = tp[(2 * hh + 1) * 16 + bj];
      const float sc = sort2f(ka) + sort2f(kb);
      const int ex = (127 - (int)(ka & 127u)) * 128 + (127 - (int)(kb & 127u));
      float mx = sc;
      mx = fmaxf(mx, shx(mx, 1)); mx = fmaxf(mx, shx(mx, 2)); mx = fmaxf(mx, shx(mx, 4)); mx = fmaxf(mx, shx(mx, 8));
      const float ev_ = __expf(sc - mx);
      float sm = ev_;
      sm += shx(sm, 1); sm += shx(sm, 2); sm += shx(sm, 4); sm += shx(sm, 8);
      const float gv = ev_ / sm;
      const int exs = __shfl(ex, lane & 15); const float gvs = __shfl(gv, lane & 15);
      if ((lane >> 4) == (hh & 3)) { if (hh < 4) { e0 = exs; w0 = gvs; } else { e1 = exs; w1 = gvs; } }
    }
  }
  int hhi[4], hlo[4]; float hsc;
  {
    float m = 0.f;
#pragma unroll
    for (int i = 0; i < 32; ++i) m = fmaxf(m, fabsf(hv[i]));
    m = wave_max(m);
    hsc = m > 0.f ? m * (1.f / 119.f) : 1.f;
    const float hinv = 1.f / hsc;
#pragma unroll
    for (int q = 0; q < 4; ++q) {
      unsigned wh = 0u, wl = 0u;
#pragma unroll
      for (int j = 0; j < 8; ++j) {
        const unsigned b = __float_as_uint(fmaf(hv[8 * q + j], hinv, 12582912.f));
        wl |= (b & 15u) << (4 * j); wh |= (((b + 8u) >> 4) & 15u) << (4 * j);
      }
      hhi[q] = (int)wh; hlo[q] = (int)wl;
    }
  }
  const float su0 = esu[e0], su1 = esu[e1], sv0 = esv[e0], sv1 = esv[e1];
  u32x4 rA[4], rB[4];
  const unsigned lo16 = (unsigned)(16 * lane);
#define EX_LOAD(R, TAB, EB)                                                                \
  _Pragma("unroll") for (int k = 0; k < 4; ++k) {                                          \
    const int e = (EB) + k;                                                                \
    const int id = __builtin_amdgcn_readlane((e < 64) ? e0 : e1, e & 63);                 \
    const unsigned char* row = (TAB) + (size_t)id * EROW;                                  \
    R[k] = *(const u32x4*)(row + lo16);                                                    \
  }
#define PKFMA(a_, b_, c_) __builtin_elementwise_fma((a_), (b_), (c_))
  int cc = 0, c0i = 0;
  const int srcb = 4 * (((lane & 1) << 5) | ((lane & 2) << 3));
#define EX_COMP_U(R, EB)                                                                   \
  {                                                                                        \
    int dd[4];                                                                             \
    _Pragma("unroll") for (int k = 0; k < 4; ++k) {                                        \
      int dh = 0, dl = 0;                                                                  \
      _Pragma("unroll") for (int q = 0; q < 4; ++q) {                                      \
        dh = __builtin_amdgcn_sdot8((int)R[k][q], hhi[q], dh, false);                      \
        dl = __builtin_amdgcn_sdot8((int)R[k][q], hlo[q], dl, false);                      \
      }                                                                                    \
      dd[k] = dh * 16 + dl;                                                                \
      __builtin_amdgcn_sched_barrier(0);                                                   \
    }                                                                                      \
      \
    unsigned t01, t23;                                                                     \
    { auto r_ = __builtin_amdgcn_permlane32_swap((unsigned)dd[0], (unsigned)dd[1], false, false); t01 = r_[0] + r_[1]; }     \
    { auto r_ = __builtin_amdgcn_permlane32_swap((unsigned)dd[2], (unsigned)dd[3], false, false); t23 = r_[0] + r_[1]; }     \
    const bool b4_ = (lane & 16) != 0;                                                     \
    int tv = (int)(b4_ ? t23 : t01) + shx_i((int)(b4_ ? t01 : t23), 16);                   \
    tv += dpp_i<0x128>(tv); tv += dpp_i<0x124>(tv); tv += dpp_i<0x4E>(tv); tv += dpp_i<0xB1>(tv);   \
    const int got = __builtin_amdgcn_ds_bpermute(srcb, tv);                                \
    cc = ((unsigned)(lane - ((EB) & 63)) < 4u) ? got : cc;                                 \
    __builtin_amdgcn_sched_barrier(0);                                                     \
  }
#define EX_COMP_V(R, EB)                                                                   \
  _Pragma("unroll") for (int k = 0; k < 4; ++k) {                                          \
    const int e = (EB) + k;                                                                \
    const float cs = __int_as_float(__builtin_amdgcn_readlane(__float_as_int((e < 64) ? c0 : c1), e & 63));                     \
    const v2f cs2 = {cs, cs};                                                              \
    _Pragma("unroll") for (int q = 0; q < 4; ++q) {                                        \
      const unsigned wq = R[k][q];                                                         \
      const v2f f0 = __builtin_amdgcn_cvt_scalef32_pk_f32_fp4(wq, 1.0f, 0), f1 = __builtin_amdgcn_cvt_scalef32_pk_f32_fp4(wq, 1.0f, 1); \
      const v2f f2 = __builtin_amdgcn_cvt_scalef32_pk_f32_fp4(wq, 1.0f, 2), f3 = __builtin_amdgcn_cvt_scalef32_pk_f32_fp4(wq, 1.0f, 3); \
      acc2[4 * q + 0] = PKFMA(cs2, f0, acc2[4 * q + 0]); acc2[4 * q + 1] = PKFMA(cs2, f1, acc2[4 * q + 1]); \
      acc2[4 * q + 2] = PKFMA(cs2, f2, acc2[4 * q + 2]); acc2[4 * q + 3] = PKFMA(cs2, f3, acc2[4 * q + 3]); \
    }                                                                                      \
    __builtin_amdgcn_sched_barrier(0);                                                     \
  }
  EX_LOAD(rA, eu4, 0)
  __builtin_amdgcn_sched_barrier(0);
#pragma unroll 1
  for (int eb = 0; eb < 128; eb += 8) {
    if (eb == 64) c0i = cc;
    EX_LOAD(rB, eu4, eb + 4)
    __builtin_amdgcn_sched_barrier(0);
    EX_COMP_U(rA, eb)
    { const int ebn = (eb + 8 < 128) ? eb + 8 : 0;
      EX_LOAD(rA, eu4, ebn) }
    __builtin_amdgcn_sched_barrier(0);
    EX_COMP_U(rB, eb + 4)
  }
  const float c0 = w0 * gelu_fast(hsc * su0 * (float)c0i) * sv0, c1 = w1 * gelu_fast(hsc * su1 * (float)cc) * sv1;
  slot[lane] = u32x4{(unsigned)e0, (unsigned)e1, __float_as_uint(c0), __float_as_uint(c1)};
#undef EX_LOAD
#undef EX_COMP_U
#undef EX_COMP_V
#undef PKFMA
}
__device__ void d_expert_v(int t, const u32x4* slot, const bf16_t* __restrict__ hbuf, const unsigned char* __restrict__ ev4,
                           const float* __restrict__ gam, const float* __restrict__ bet, float* __restrict__ out) {
  const int lane = TIDX & 63;
  const u32x4 sl = slot[lane];
  const int e0 = (int)sl[0], e1 = (int)sl[1]; const float c0 = __uint_as_float(sl[2]), c1 = __uint_as_float(sl[3]);
  int hhi[4] = {0, 0, 0, 0}, hlo[4] = {0, 0, 0, 0};
  u32x4 rA[4], rB[4];
  const unsigned lo16 = (unsigned)(16 * lane);
#define EX_LOAD(R, TAB, EB)                                                                \
  _Pragma("unroll") for (int k = 0; k < 4; ++k) {                                          \
    const int e = (EB) + k;                                                                \
    const int id = __builtin_amdgcn_readlane((e < 64) ? e0 : e1, e & 63);                 \
    const unsigned char* row = (TAB) + (size_t)id * EROW;                                  \
    R[k] = *(const u32x4*)(row + lo16);                                                    \
  }
#define PKFMA(a_, b_, c_) __builtin_elementwise_fma((a_), (b_), (c_))
  int cc = 0, c0i = 0;
  const int srcb = 4 * (((lane & 1) << 5) | ((lane & 2) << 3));
#define EX_COMP_U(R, EB)                                                                   \
  {                                                                                        \
    int dd[4];                                                                             \
    _Pragma("unroll") for (int k = 0; k < 4; ++k) {                                        \
      int dh = 0, dl = 0;                                                                  \
      _Pragma("unroll") for (int q = 0; q < 4; ++q) {                                      \
        dh = __builtin_amdgcn_sdot8((int)R[k][q], hhi[q], dh, false);                      \
        dl = __builtin_amdgcn_sdot8((int)R[k][q], hlo[q], dl, false);                      \
      }                                                                                    \
      dd[k] = dh * 16 + dl;                                                                \
      __builtin_amdgcn_sched_barrier(0);                                                   \
    }                                                                                      \
      \
    unsigned t01, t23;                                                                     \
    { auto r_ = __builtin_amdgcn_permlane32_swap((unsigned)dd[0], (unsigned)dd[1], false, false); t01 = r_[0] + r_[1]; }     \
    { auto r_ = __builtin_amdgcn_permlane32_swap((unsigned)dd[2], (unsigned)dd[3], false, false); t23 = r_[0] + r_[1]; }     \
    const bool b4_ = (lane & 16) != 0;                                                     \
    int tv = (int)(b4_ ? t23 : t01) + shx_i((int)(b4_ ? t01 : t23), 16);                   \
    tv += dpp_i<0x128>(tv); tv += dpp_i<0x124>(tv); tv += dpp_i<0x4E>(tv); tv += dpp_i<0xB1>(tv);   \
    const int got = __builtin_amdgcn_ds_bpermute(srcb, tv);                                \
    cc = ((unsigned)(lane - ((EB) & 63)) < 4u) ? got : cc;                                 \
    __builtin_amdgcn_sched_barrier(0);                                                     \
  }
#define EX_COMP_V(R, EB)                                                                   \
  _Pragma("unroll") for (int k = 0; k < 4; ++k) {                                          \
    const int e = (EB) + k;                                                                \
    const float cs = __int_as_float(__builtin_amdgcn_readlane(__float_as_int((e < 64) ? c0 : c1), e & 63));                     \
    const v2f cs2 = {cs, cs};                                                              \
    _Pragma("unroll") for (int q = 0; q < 4; ++q) {                                        \
      const unsigned wq = R[k][q];                                                         \
      const v2f f0 = __builtin_amdgcn_cvt_scalef32_pk_f32_fp4(wq, 1.0f, 0), f1 = __builtin_amdgcn_cvt_scalef32_pk_f32_fp4(wq, 1.0f, 1); \
      const v2f f2 = __builtin_amdgcn_cvt_scalef32_pk_f32_fp4(wq, 1.0f, 2), f3 = __builtin_amdgcn_cvt_scalef32_pk_f32_fp4(wq, 1.0f, 3); \
      acc2[4 * q + 0] = PKFMA(cs2, f0, acc2[4 * q + 0]); acc2[4 * q + 1] = PKFMA(cs2, f1, acc2[4 * q + 1]); \
      acc2[4 * q + 2] = PKFMA(cs2, f2, acc2[4 * q + 2]); acc2[4 * q + 3] = PKFMA(cs2, f3, acc2[4 * q + 3]); \
    }                                                                                      \
    __builtin_amdgcn_sched_barrier(0);                                                     \
  }
  EX_LOAD(rA, ev4, 0)
  __builtin_amdgcn_sched_barrier(0);
  v2f acc2[16];
#pragma unroll
  for (int i = 0; i < 16; ++i) acc2[i] = v2f{0.f, 0.f};
#pragma unroll 1
  for (int eb = 0; eb < 128; eb += 8) {
    EX_LOAD(rB, ev4, eb + 4)
    __builtin_amdgcn_sched_barrier(0);
    EX_COMP_V(rA, eb)
    { const int ebn = (eb + 8 < 128) ? eb + 8 : 0;
      EX_LOAD(rA, ev4, ebn) }
    __builtin_amdgcn_sched_barrier(0);
    EX_COMP_V(rB, eb + 4)
  }
#undef EX_LOAD
#undef EX_COMP_U
#undef EX_COMP_V
#undef PKFMA
  float acc[32];
#pragma unroll
  for (int i = 0; i < 16; ++i) { acc[2 * i] = acc2[i].x; acc[2 * i + 1] = acc2[i].y; }
  int le = lane;
  asm volatile("" : "+v"(le) :: "memory");
  float s = 0.f;
#pragma unroll
  for (int i = 0; i < 8; ++i) {
    const u32x2 w = *(const u32x2*)(hbuf + (size_t)t * DM + 256 * i + 4 * le);
    const float h0 = __uint_as_float(w[0] << 16), h1 = __uint_as_float(w[0] & 0xFFFF0000u), h2 = __uint_as_float(w[1] << 16), h3 = __uint_as_float(w[1] & 0xFFFF0000u);
    acc[i * 4 + 0] = fmaf(ALPHA, h0, acc[i * 4 + 0]); acc[i * 4 + 1] = fmaf(ALPHA, h1, acc[i * 4 + 1]);
    acc[i * 4 + 2] = fmaf(ALPHA, h2, acc[i * 4 + 2]); acc[i * 4 + 3] = fmaf(ALPHA, h3, acc[i * 4 + 3]);
    s += (acc[i * 4 + 0] + acc[i * 4 + 1]) + (acc[i * 4 + 2] + acc[i * 4 + 3]);
  }
  s = wsum(s);
  const float mu = s * (1.f / DM);
  float qv = 0.f;
#pragma unroll
  for (int i = 0; i < 32; ++i) { const float d = acc[i] - mu; qv += d * d; }
  qv = wsum(qv);
  const float rs = rsqrtf(qv * (1.f / DM) + 1e-5f);
#pragma unroll
  for (int i = 0; i < 8; ++i) {
    const int cbase = 256 * i + 4 * le;
    f32x4 ga = *(const f32x4*)(gam + cbase), ba = *(const f32x4*)(bet + cbase), o;
#pragma unroll
    for (int j = 0; j < 4; ++j) o[j] = (acc[i * 4 + j] - mu) * rs * ga[j] + ba[j];
    *(f32x4*)(out + (size_t)t * DM + cbase) = o;
  }
}

constexpr size_t al256(size_t x) { return (x + 255) & ~(size_t)255; }
constexpr size_t WS_XB = 0;
constexpr size_t WS_PROJ = WS_XB + al256((size_t)S * DM * 2);
constexpr size_t WS_WINT = WS_PROJ + al256((size_t)S * INWP * 2);
constexpr size_t WS_GATES = WS_WINT + al256((size_t)INWG * DM * 2);
constexpr size_t WS_W1KF = WS_GATES + al256((size_t)S * 24 * 4);
constexpr size_t WS_W1VF = WS_W1KF + al256((size_t)512 * 4096 * 2);
constexpr size_t WS_W2KF = WS_W1VF + al256((size_t)512 * 4096 * 2);
constexpr size_t WS_W2VF = WS_W2KF + al256((size_t)512 * 128 * 2);
constexpr size_t WS_VC = WS_W2VF + al256((size_t)512 * 128 * 2) - al256((size_t)2048 * 128 * 4);
constexpr size_t WS_KCF = WS_VC + al256((size_t)2048 * 128 * 4);
constexpr size_t WS_VCF = WS_KCF + al256((size_t)2 * 32 * 4096 * 2);
constexpr size_t WS_KSF = WS_VCF + al256((size_t)2 * 32 * 4096 * 2);
constexpr size_t WS_VSF = WS_KSF + al256((size_t)2 * 512 * 4096 * 2);
constexpr size_t WS_KWF = WS_VSF + al256((size_t)2 * 512 * 4096 * 2);
constexpr size_t WS_VWF = WS_KWF + al256((size_t)2 * 512 * 4096 * 2);
constexpr size_t WS_ENDA = WS_VWF + al256((size_t)2 * 512 * 4096 * 2);
constexpr size_t WS_OATT = WS_ENDA;
constexpr size_t WS_MIX = WS_OATT + al256((size_t)S * 1024 * 4);
constexpr size_t WS_WOUTT = WS_MIX + al256((size_t)S * DM * 2);
constexpr size_t WS_WQT = WS_WOUTT + al256((size_t)DM * DM * 2);
constexpr size_t WS_TOPS = WS_WQT + al256((size_t)DM * DM * 2);
constexpr size_t WS_SKF = WS_TOPS + al256((size_t)S * 256 * 4);
constexpr size_t WS_STATS = WS_SKF + al256((size_t)16 * 128 * 128 * 2);
constexpr size_t WS_CTRL = WS_STATS + al256((size_t)S * 2 * 4);
constexpr size_t CTRL_BYTES = 32768;
constexpr size_t WS_END = WS_CTRL + CTRL_BYTES;
constexpr size_t WS_Y = WS_PROJ;
constexpr size_t WS_HB = WS_XB;
constexpr size_t WS_EU8 = WS_OATT;
constexpr size_t WS_EV8 = WS_EU8 + (size_t)16384 * 1024;
constexpr size_t WS_ESU = WS_EV8 + (size_t)16384 * 1024;
constexpr size_t WS_ESV = WS_ESU + 16384 * 4;
static_assert(WS_ESV + 16384 * 4 <= WS_MIX, "expert tables overflow their region");
constexpr int EXP_EARLY = 6144;
static_assert(WS_END <= (size_t)512 * 1024 * 1024, "workspace over 512 MiB");

struct Params {
  const float *x, *w_in, *ck_pos, *ck_w1, *ck_b1, *ck_w2, *cv_pos, *cv_w1, *cv_b1, *cv_w2, *conv_w, *hng, *w_out, *ln1g, *ln1b, *w_query, *subk,
      *eu, *ev, *ln2g, *ln2b;
  float* out;
  char* ws;
};
#define WSP(T, OFF) ((T*)(p.ws + (OFF)))

#define FOR_VB(n) for (int vb = blockIdx.x; vb < (n); vb += gridDim.x)
#define FOR_VB2(n) for (int vb = blockIdx.x * 2 + (TIDX >> 8); vb < (n); vb += gridDim.x * 2)
constexpr int SMEM_BYTES = 147456;
constexpr int HALF = 36864;

__global__ void __launch_bounds__(512) mega(Params p) {
  __shared__ __attribute__((aligned(16))) char smem[SMEM_BYTES + 16];
  if (TIDX == 0) *(u32x4*)(smem + SMEM_BYTES) = u32x4{0u, 0u, 0u, 0u};
  __syncthreads();
  const XcdBarrier xbar = xcd_barrier_post(WSP(unsigned, WS_CTRL + 1024), (volatile LAS unsigned*)(smem + SMEM_BYTES));
#define smh (smem + (TIDX >> 8) * HALF)
#define wv ((TIDX >> 6))
  constexpr int NWV = 8;
  d_cvt(p.x, WSP(bf16_t, WS_XB), (size_t)S * DM / 4);
  FOR_VB2((INWG / 64) * (DM / 64)) d_cvtT64(vb, smh, p.w_in, WSP(bf16_t, WS_WINT), DM, INW, INWG);
  for (size_t c = (size_t)blockIdx.x * 512 + TIDX; c < (size_t)16 * 256 * 64; c += (size_t)gridDim.x * 512) {
    d_cvt_w1f(c, p.ck_w1, WSP(bf16_t, WS_W1KF)); d_cvt_w1f(c, p.cv_w1, WSP(bf16_t, WS_W1VF));
    if (c < (size_t)4 * 32 * 64) { d_cvt_w2f(c, p.ck_w2, WSP(bf16_t, WS_W2KF)); d_cvt_w2f(c, p.cv_w2, WSP(bf16_t, WS_W2VF)); }
  }
  FOR_VB2((DM / 64) * (DM / 64)) d_cvtT64(vb, smh, p.w_out, WSP(bf16_t, WS_WOUTT), DM, DM, DM);
  FOR_VB2((DM / 64) * (DM / 64)) d_cvtT64(vb, smh, p.w_query, WSP(bf16_t, WS_WQT), DM, DM, DM);
  for (size_t c = (size_t)blockIdx.x * 512 + TIDX; c < (size_t)16 * 4 * 8 * 64; c += (size_t)gridDim.x * 512) d_cvt_subk(c, p.subk, WSP(bf16_t, WS_SKF));
  xcd_barrier(xbar);
  {
    pg8::StaticOrder so; so.init(S, INWG, gridDim.x, blockIdx.x);
    pg8::gemm_phase<EpiProjG, pg8::StaticOrder>((PG8_LAS unsigned char*)smem, pg8::Gemm{WSP(bf16_t, WS_XB), WSP(bf16_t, WS_WINT), S, INWG, DM}, so,
                                                EpiProjG{WSP(bf16_t, WS_PROJ), WSP(float, WS_GATES), (PG8_LAS unsigned char*)smem + pg8::STAGE_BYTES}, nullptr);
    const int nun = (S / 256) * (INWG / 256), gsz = (int)gridDim.x;
    const int nfull = nun % gsz;
    if (nfull != 0 && (int)blockIdx.x >= nfull) {
      const int nidle = gsz - nfull, me = (int)blockIdx.x - nfull;
      for (int r = me * NWV + wv; r < 2 * EXP_EARLY; r += nidle * NWV) {
        if (r < EXP_EARLY) d_cvt_i4_row(r, p.eu, WSP(unsigned char, WS_EU8), WSP(float, WS_ESU)); else d_cvt_fp4_row(r - EXP_EARLY, p.ev, WSP(unsigned char, WS_EV8), WSP(float, WS_ESV));
      }
    }
  }
  xcd_barrier(xbar);
  {
    if (blockIdx.x < 128) {
      const int xcd_ = blockIdx.x & 7, idx_ = blockIdx.x >> 3; const bool isV = (xcd_ & 1) != 0;
      d_compress_unit((xcd_ >> 1) * 16 + idx_, smem, WSP(bf16_t, WS_PROJ), isV ? OFF_VC : OFF_KC, isV ? p.cv_pos : p.ck_pos, isV ? WSP(bf16_t, WS_W1VF) : WSP(bf16_t, WS_W1KF),
                      isV ? p.cv_b1 : p.ck_b1, isV ? WSP(bf16_t, WS_W2VF) : WSP(bf16_t, WS_W2KF), isV ? WSP(bf16_t, WS_VCF) : WSP(bf16_t, WS_KCF), isV);
    }
    int* slot = (int*)smem;
    unsigned* ctr = WSP(unsigned, WS_CTRL);
    for (;;) {
      if (TIDX == 0) *slot = (int)atomicAdd(ctr, 1u);
      __syncthreads();
      const int it = *slot;
      __syncthreads();
      if (it >= 2048) break;
      const int tt = TIDX;
      {
        const int T = it >> 2, which = it & 3;
        d_relayout_tile(T, smem + 64, WSP(bf16_t, WS_PROJ), (which == 0) ? OFF_KS : (which == 1) ? OFF_VS : (which == 2) ? OFF_KW : OFF_VW,
                        (which == 0) ? WSP(bf16_t, WS_KSF) : (which == 1) ? WSP(bf16_t, WS_VSF) : (which == 2) ? WSP(bf16_t, WS_KWF) : WSP(bf16_t, WS_VWF), (which & 1) != 0);
      }
      for (int q = 0; q < 2; ++q) d_convmix(it * 8 + q * 4 + (tt >> 7), tt & 127, WSP(bf16_t, WS_PROJ), p.conv_w, p.hng, WSP(bf16_t, WS_MIX));
    }
  }
  xcd_barrier(xbar);
  {
    AttnPtrs ap{WSP(bf16_t, WS_PROJ), WSP(float, WS_GATES), WSP(bf16_t, WS_KCF), WSP(bf16_t, WS_VCF), WSP(bf16_t, WS_KSF), WSP(bf16_t, WS_VSF), WSP(bf16_t, WS_KWF), WSP(bf16_t, WS_VWF), WSP(bf16_t, WS_MIX), p.hng};
    for (int it = blockIdx.x; it < 512; it += gridDim.x) {
      const int Bq = (it < 256) ? it : (511 - it), gq = (it < 256) ? 0 : 1;
      d_attn_block(Bq, gq, smem, ap);
    }
  }
  xcd_barrier(xbar);
  {
    pg8::StaticOrder so; so.init(S, DM, gridDim.x, blockIdx.x);
    pg8::gemm_phase<EpiResG, pg8::StaticOrder>((PG8_LAS unsigned char*)smem, pg8::Gemm{WSP(bf16_t, WS_MIX), WSP(bf16_t, WS_WOUTT), S, DM, DM}, so,
                                               EpiResG{WSP(bf16_t, WS_HB), (PG8_LAS unsigned char*)smem + pg8::STAGE_BYTES}, nullptr);
  }
  xcd_barrier(xbar);
  for (int r = blockIdx.x * NWV + wv; r < S; r += gridDim.x * NWV) d_ln_wave(r, WSP(bf16_t, WS_HB), p.ln1g, p.ln1b);
  {
    const int e0_ = (((S / 256) * (INWG / 256)) % (int)gridDim.x != 0) ? EXP_EARLY : 0;
    const int nrest = 16384 - e0_;
    for (int r = blockIdx.x * NWV + wv; r < 2 * nrest; r += gridDim.x * NWV) {
      if (r < nrest) d_cvt_i4_row(e0_ + r, p.eu, WSP(unsigned char, WS_EU8), WSP(float, WS_ESU)); else d_cvt_fp4_row(e0_ + r - nrest, p.ev, WSP(unsigned char, WS_EV8), WSP(float, WS_ESV));
    }
  }
  xcd_barrier(xbar);
  for (int k = 0; k * (int)gridDim.x < (S / 256) * (DM / 256); ++k) {
    pg8::OneUnit so; so.init(S, DM, gridDim.x, blockIdx.x); so.k = k;
    pg8::gemm_phase<EpiRouteG, pg8::OneUnit>((PG8_LAS unsigned char*)smem, pg8::Gemm{WSP(bf16_t, WS_HB), WSP(bf16_t, WS_WQT), S, DM, DM}, so,
                                             EpiRouteG{WSP(bf16_t, WS_SKF), WSP(unsigned, WS_TOPS)}, nullptr);
    __syncthreads();
  }
  xcd_barrier(xbar);
  {
    u32x4* slots = (u32x4*)(smem + 8192 + wv * 16384);
    const int tstr = (int)gridDim.x * NWV;
    for (int t0 = blockIdx.x * NWV + wv; t0 < S; t0 += 16 * tstr) {
      int i = 0;
      for (int t = t0; t < S && i < 16; t += tstr, ++i)
        d_expert_u(t, (unsigned*)(smem + wv * 1024), slots + i * 64, WSP(bf16_t, WS_HB), WSP(unsigned, WS_TOPS), WSP(unsigned char, WS_EU8), WSP(float, WS_ESU), WSP(float, WS_ESV));
      i = 0;
      for (int t = t0; t < S && i < 16; t += tstr, ++i)
        d_expert_v(t, slots + i * 64, WSP(bf16_t, WS_HB), WSP(unsigned char, WS_EV8), p.ln2g, p.ln2b, p.out);
    }
  }
}

extern "C" void kernel_launch(void* const* d_in, const int* in_sizes, int n_in, void* d_out, int out_size, void* d_ws, size_t ws_size,
                              hipStream_t stream) {
  Params p{};
  p.x = (const float*)d_in[0]; p.w_in = (const float*)d_in[1]; p.ck_pos = (const float*)d_in[2]; p.ck_w1 = (const float*)d_in[3];
  p.ck_b1 = (const float*)d_in[4]; p.ck_w2 = (const float*)d_in[5]; p.cv_pos = (const float*)d_in[6]; p.cv_w1 = (const float*)d_in[7];
  p.cv_b1 = (const float*)d_in[8]; p.cv_w2 = (const float*)d_in[9]; p.conv_w = (const float*)d_in[10]; p.hng = (const float*)d_in[11];
  p.w_out = (const float*)d_in[12]; p.ln1g = (const float*)d_in[13]; p.ln1b = (const float*)d_in[14]; p.w_query = (const float*)d_in[15];
  p.subk = (const float*)d_in[16]; p.eu = (const float*)d_in[17]; p.ev = (const float*)d_in[18]; p.ln2g = (const float*)d_in[19];
  p.ln2b = (const float*)d_in[20];
  p.out = (float*)d_out;
  p.ws = (char*)d_ws;
  if (ws_size < WS_END) fprintf(stderr, "workspace too small\n");
  static int grid_blocks = 0;
  if (!grid_blocks) {
    int dev = 0, cus = 0, per_cu = 0;
    hipGetDevice(&dev);
    hipDeviceGetAttribute(&cus, hipDeviceAttributeMultiprocessorCount, dev);
    hipOccupancyMaxActiveBlocksPerMultiprocessor(&per_cu, mega, 512, 0);
    if (per_cu > 1) per_cu = 1;
    if (per_cu < 1) per_cu = 1;
    grid_blocks = cus * per_cu;
  }
  hipMemsetAsync((char*)d_ws + WS_CTRL, 0, CTRL_BYTES, stream);
  void* args[] = {&p};
  hipError_t e = hipLaunchCooperativeKernel((void*)mega, dim3(grid_blocks), dim3(512), args, 0, stream);
  if (e != hipSuccess) fprintf(stderr, "cooperative launch failed: %s (grid %d)\n", hipGetErrorString(e), grid_blocks);
}
```

```cpp
#include <hip/hip_runtime.h>
#include <stdint.h>
#include <stdio.h>


#define DI __device__ __forceinline__
static __device__ __forceinline__ int tidx_() { int t = (int)__builtin_amdgcn_workitem_id_x(); asm volatile("" : "+v"(t)); return t; }
#define TIDX (tidx_())

template <int J> DI int swz_xor(int x) { return __builtin_amdgcn_ds_swizzle(x, (J << 10) | 0x1F); }
template <int CTRL> DI int dpp_i(int x) { return __builtin_amdgcn_update_dpp(x, x, CTRL, 0xF, 0xF, false); }
DI int shx_i(int x, int j) {
  switch (j) {
    case 1: return dpp_i<0xB1>(x);
    case 2: return dpp_i<0x4E>(x);
    case 4: return dpp_i<0x1B>(dpp_i<0x141>(x));
    case 8: return dpp_i<0x128>(x);
    case 16: return swz_xor<16>(x);
    default: {
      auto r = __builtin_amdgcn_permlane32_swap((unsigned)x, (unsigned)x, false, false);
      return (TIDX & 32) ? (int)r[0] : (int)r[1];
    }
  }
}
DI float shx(float x, int j) { return __int_as_float(shx_i(__float_as_int(x), j)); }
typedef unsigned short bf16_t;
using bf16x8 = __attribute__((ext_vector_type(8))) short;
using f32x4 = __attribute__((ext_vector_type(4))) float;
using u32x4 = __attribute__((ext_vector_type(4))) unsigned;
using u32x2 = __attribute__((ext_vector_type(2))) unsigned;

constexpr int S = 16384, DM = 2048, HD = 128;
constexpr int INW = 5656, INWP = 5760, INWG = 5888;
constexpr int OFF_Q = 0, OFF_KC = 1024, OFF_VC = 1280, OFF_KS = 1536, OFF_VS = 1792, OFF_KW = 2048, OFF_VW = 2304,
              OFF_G = 2560, OFF_U = 2584, OFF_B = 3608, OFF_C = 4632;
constexpr int NCMP = 1023;
constexpr float ALPHA = 1.189207115002721f;
constexpr float QSCALE = 0.08838834764831845f;

DI bf16_t f2bf(float x) { unsigned u = __float_as_uint(x); u += 0x7fffu + ((u >> 16) & 1u); return (bf16_t)(u >> 16); }
DI float bf2f(bf16_t b) { return __uint_as_float(((unsigned)b) << 16); }
DI float gelu_tanh(float x) { float u = 0.7978845608028654f * (x + 0.044715f * x * x * x); return 0.5f * x * (1.f + tanhf(u)); }
DI float wave_sum(float v) { for (int o = 32; o > 0; o >>= 1) v += shx(v, o); return v; }
using bf16x2v = __attribute__((ext_vector_type(2))) __bf16;
DI unsigned pack2(float a, float b) { bf16x2v v = {(__bf16)a, (__bf16)b}; return __builtin_bit_cast(unsigned, v); }
DI float wave_max(float v) { for (int o = 32; o > 0; o >>= 1) v = fmaxf(v, shx(v, o)); return v; }

namespace pg8 {
#define PG8_LAS __attribute__((address_space(3)))
typedef unsigned short bf16_t;
typedef short bf16x8 __attribute__((ext_vector_type(8)));
typedef float f32x4 __attribute__((ext_vector_type(4)));
typedef unsigned u32x4 __attribute__((ext_vector_type(4)));
constexpr int BM = 256, BK = 64, HALF = 128, HTB = HALF * BK * 2  , STAGE_BYTES = 8 * HTB, NXCD = 8, WGM = 8;

__host__ __device__ __forceinline__ int lds_byte(int r, int c) { const int st = (r >> 4) * 2 + (c >> 5), rr = r & 15, cc = c & 31, ob = rr * 64 + cc * 2; return st * 1024 + (ob ^ (((ob >> 9) & 1) << 5)); }
__host__ __device__ __forceinline__ void stage_rc(int b, int& R, int& C) { const int st = b / 1024, sb = b % 1024, swz = sb ^ (((sb >> 9) & 1) << 5); R = (st >> 1) * 16 + swz / 64; C = (st & 1) * 32 + (swz % 64) / 2; }
__host__ __device__ __forceinline__ int perm32(int rho) { const int n = rho >> 4, i = rho & 15; return 8 * (i >> 2) + 4 * n + (i & 3); }

struct Unit { int pm, pn; };
struct Gemm { const bf16_t* A; const bf16_t* Bt; int M, N, K; };

struct StaticOrder {
    int nM, nN, nwg, G, c;
    __host__ __device__ void init(int M, int N, int G_, int c_) { nM = M / BM; nN = N / BM; nwg = nM * nN; G = G_; c = c_; }
    __host__ __device__ bool next(int i, Unit& u) const {
        const long L = (long)i * G + c; if (L >= nwg) return false;
        int wgid = (int)L; { const int q = nwg / NXCD, r = nwg % NXCD, xcd = wgid % NXCD, off = wgid / NXCD; wgid = (xcd < r ? xcd * (q + 1) : r * (q + 1) + (xcd - r) * q) + off; }
        const int nig = WGM * nN, gid = wgid / nig, fm = gid * WGM, gsz = (nM - fm) < WGM ? (nM - fm) : WGM;
        u.pm = fm + ((wgid % nig) % gsz); u.pn = (wgid % nig) / gsz; return true;
    }
    __device__ __forceinline__ void a_ready(const Unit&) const {}
    __device__ __forceinline__ void done(const Unit&) const {}
};
struct OneUnit : StaticOrder {
    int k;
    __device__ bool next(int i, Unit& u) const { if (i > 0) return false; return StaticOrder::next(k, u); }
};
__device__ __forceinline__ unsigned cvt_pk_bf16(float lo, float hi) { unsigned r; asm volatile("v_cvt_pk_bf16_f32 %0, %1, %2" : "=v"(r) : "v"(lo), "v"(hi)); return r; }
template <class Epi, class Sched, bool STAMP = false>
__device__ __forceinline__ void gemm_phase(PG8_LAS unsigned char* lds, const Gemm g, const Sched& S, const Epi& E, unsigned long long* stamps) {
    const int tid = TIDX, wid = __builtin_amdgcn_readfirstlane(tid >> 6), lane = tid & 63, wr = wid >> 2, wc = wid & 3, fr = lane & 15, fq = lane >> 4;
    const int K = g.K, nt = K / BK;
    int ts_lo = 0, ts_hi = 0, nts = 0; const unsigned long long rt_entry = STAMP ? (unsigned long long)wall_clock64() : 0ull;
#define PG8_STAMP() do { if (STAMP && wid == 0 && nts < 64) { const unsigned long long _c = (unsigned long long)clock64(); \
        ts_lo = (lane == nts) ? (int)(unsigned)_c : ts_lo; ts_hi = (lane == nts) ? (int)(unsigned)(_c >> 32) : ts_hi; ++nts; } } while (0)
    PG8_STAMP();
    unsigned voffA[2], voffB[2];
#pragma unroll
    for (int i = 0; i < 2; ++i) { int R, C; stage_rc(tid * 16 + i * 8192, R, C); const int Rb = Epi::PERM ? ((R & ~31) + perm32(R & 31)) : R;
        voffA[i] = (unsigned)(R * K + C) * 2u; voffB[i] = (unsigned)(Rb * K + C) * 2u; }
    const size_t kstep = (size_t)(BK * 2);
    const size_t hstep = (size_t)HALF * K * 2;
    const size_t tstep = 2 * hstep;
    const unsigned ldsw = (unsigned)wid * 1024u;
    const int aoff = lds_byte(wr * 64 + fr, fq * 8), boff = lds_byte(wc * 32 + fr, fq * 8);
#define PG8_SA(b, h) (((b) * 2 + (h)) * HTB)
#define PG8_SB(b, h) ((4 + (b) * 2 + (h)) * HTB)
#define PG8_STAGE(bufoff, gbase, voff) do { _Pragma("unroll") for (int _i = 0; _i < 2; ++_i) \
        __builtin_amdgcn_global_load_lds((const unsigned*)((const char*)(gbase) + (voff)[_i]), (PG8_LAS unsigned*)(lds + (bufoff) + ldsw + _i * 8192), 16, 0, 0); } while (0)
#define PG8_LDA(dst, b, h) do { _Pragma("unroll") for (int m = 0; m < 4; ++m) _Pragma("unroll") for (int k = 0; k < 2; ++k) dst[m][k] = *(const PG8_LAS bf16x8*)(lds + PG8_SA(b, h) + aoff + m * 2048 + k * 1024); } while (0)
#define PG8_LDB(dst, b, h) do { _Pragma("unroll") for (int n = 0; n < 2; ++n) _Pragma("unroll") for (int k = 0; k < 2; ++k) dst[n][k] = *(const PG8_LAS bf16x8*)(lds + PG8_SB(b, h) + boff + n * 2048 + k * 1024); } while (0)
#define PG8_MMA(ai, bj, At, Bt) do { __builtin_amdgcn_s_setprio(1); _Pragma("unroll") for (int m = 0; m < 4; ++m) _Pragma("unroll") for (int n = 0; n < 2; ++n) _Pragma("unroll") for (int k = 0; k < 2; ++k) \
        acc[ai][bj][m][n] = __builtin_amdgcn_mfma_f32_16x16x32_bf16(Bt[n][k], At[m][k], acc[ai][bj][m][n], 0, 0, 0); __builtin_amdgcn_s_setprio(0); } while (0)
#define PG8_WAIT_V(n) asm volatile("s_waitcnt vmcnt(" #n ")" ::: "memory")
#define PG8_WAIT_L(n) asm volatile("s_waitcnt lgkmcnt(" #n ")" ::: "memory")
#define PG8_BAR __builtin_amdgcn_s_barrier()
#define PG8_SCHED __builtin_amdgcn_sched_barrier(0)
    Unit cur, nxt; int ui = 0;
    if (!S.next(0, cur)) return;
    f32x4 acc[2][2][4][2];
#pragma unroll
    for (int a = 0; a < 2; ++a)
#pragma unroll
        for (int b = 0; b < 2; ++b)
#pragma unroll
            for (int m = 0; m < 4; ++m)
#pragma unroll
                for (int n = 0; n < 2; ++n) acc[a][b][m][n] = (f32x4){0.f, 0.f, 0.f, 0.f};
    bf16x8 At[4][2], B0[2][2], B1[2][2];
    const char* cA = (const char*)g.A + (size_t)cur.pm * tstep; const char* cB = (const char*)g.Bt + (size_t)cur.pn * tstep;
    S.a_ready(cur);
    PG8_STAGE(PG8_SB(0, 0), cB, voffB); PG8_STAGE(PG8_SA(0, 0), cA, voffA); PG8_STAGE(PG8_SB(0, 1), cB + hstep, voffB); PG8_STAGE(PG8_SA(0, 1), cA + hstep, voffA);
    if (wr == 1) PG8_BAR;
    PG8_WAIT_V(4); PG8_BAR;
    PG8_STAGE(PG8_SB(1, 0), cB + kstep, voffB); PG8_STAGE(PG8_SA(1, 0), cA + kstep, voffA); PG8_STAGE(PG8_SB(1, 1), cB + hstep + kstep, voffB);
    PG8_WAIT_V(6); PG8_BAR;
    PG8_STAMP();
    for (;;) {
        const bool has_next = S.next(ui + 1, nxt);
        const char* nA = has_next ? (const char*)g.A + (size_t)nxt.pm * tstep : cA; const char* nB = has_next ? (const char*)g.Bt + (size_t)nxt.pn * tstep : cB;
        for (int t = 0; t < nt; t += 2) {
            const bool last = (t == nt - 2);
            const char* a1 = cA + (size_t)(t + 1) * kstep;
            const char* a2 = last ? nA : cA + (size_t)(t + 2) * kstep; const char* b2 = last ? nB : cB + (size_t)(t + 2) * kstep;
            const char* a3 = a2 + kstep; const char* b3 = b2 + kstep;
            if (last && has_next) S.a_ready(nxt);
            PG8_LDB(B0, 0, 0); PG8_SCHED; PG8_LDA(At, 0, 0); PG8_STAGE(PG8_SA(1, 1), a1 + hstep, voffA);
            PG8_WAIT_L(8); PG8_BAR; PG8_WAIT_L(0); PG8_MMA(0, 0, At, B0); PG8_BAR; PG8_SCHED;
            PG8_LDB(B1, 0, 1); PG8_STAGE(PG8_SB(0, 0), b2, voffB);
            PG8_BAR; PG8_WAIT_L(0); PG8_MMA(0, 1, At, B1); PG8_BAR;
            PG8_LDA(At, 0, 1); PG8_STAGE(PG8_SA(0, 0), a2, voffA);
            PG8_BAR; PG8_WAIT_L(0); PG8_MMA(1, 0, At, B0); PG8_BAR; PG8_SCHED;
            PG8_STAGE(PG8_SB(0, 1), b2 + hstep, voffB);
            PG8_WAIT_V(6); PG8_BAR; PG8_MMA(1, 1, At, B1); PG8_BAR;
            PG8_LDB(B0, 1, 0); PG8_SCHED; PG8_LDA(At, 1, 0); PG8_STAGE(PG8_SA(0, 1), a2 + hstep, voffA);
            PG8_WAIT_L(8); PG8_BAR; PG8_WAIT_L(0); PG8_MMA(0, 0, At, B0); PG8_BAR; PG8_SCHED;
            PG8_LDB(B1, 1, 1); PG8_STAGE(PG8_SB(1, 0), b3, voffB);
            PG8_BAR; PG8_WAIT_L(0); PG8_MMA(0, 1, At, B1); PG8_BAR;
            PG8_LDA(At, 1, 1); PG8_STAGE(PG8_SA(1, 0), a3, voffA);
            PG8_BAR; PG8_WAIT_L(0); PG8_MMA(1, 0, At, B0); PG8_BAR; PG8_SCHED;
            PG8_STAGE(PG8_SB(1, 1), b3 + hstep, voffB);
            PG8_WAIT_V(6); PG8_BAR; PG8_MMA(1, 1, At, B1); PG8_BAR;
        }
        PG8_STAMP();
        if constexpr (!Epi::AFTER_DRAIN) { E(acc, cur, wr, wc, fr, fq); S.done(cur); }
        PG8_STAMP();
        if (!has_next) break;
#pragma unroll
        for (int a = 0; a < 2; ++a)
#pragma unroll
            for (int b = 0; b < 2; ++b)
#pragma unroll
                for (int m = 0; m < 4; ++m)
#pragma unroll
                    for (int n = 0; n < 2; ++n) acc[a][b][m][n] = (f32x4){0.f, 0.f, 0.f, 0.f};
        cur = nxt; cA = nA; cB = nB; ++ui;
    }
    PG8_WAIT_V(0);
    if (wr == 0) PG8_BAR;
    PG8_BAR;
    if constexpr (Epi::AFTER_DRAIN) { E.fused(acc, cur, wr, wc, fr, fq, lds, wid, lane); S.done(cur); }
    PG8_STAMP();
    if (STAMP && wid == 0) { stamps[lane] = lane < nts ? (((unsigned long long)(unsigned)ts_hi << 32) | (unsigned)ts_lo) : 0ull;
        if (lane == 62) stamps[62] = rt_entry; if (lane == 63) stamps[63] = (unsigned long long)wall_clock64(); }
#undef PG8_STAMP
#undef PG8_SA
#undef PG8_SB
#undef PG8_STAGE
#undef PG8_LDA
#undef PG8_LDB
#undef PG8_MMA
#undef PG8_WAIT_V
#undef PG8_WAIT_L
#undef PG8_BAR
#undef PG8_SCHED
}
}

#define XB_TMO      128
#define XB_XCNT(j)  (256  + 64 * (j))
#define XB_XSUB(j)  (1280 + 64 * (j))
#define XB_XGEN(j)  (2304 + 64 * (j))
#define XB_TOP      3328
#define XB_TOPGEN   3392
#define XCD_BAR_WORDS 3456
#define XB_SPIN_CAP (1u << 18)
#define LAS __attribute__((address_space(3)))

__device__ __forceinline__ unsigned xb_ld(unsigned* p)              { return __hip_atomic_load(p, __ATOMIC_RELAXED, __HIP_MEMORY_SCOPE_AGENT); }
__device__ __forceinline__ unsigned xb_add(unsigned* p, unsigned v) { return __hip_atomic_fetch_add(p, v, __ATOMIC_RELAXED, __HIP_MEMORY_SCOPE_AGENT); }
__device__ __forceinline__ unsigned xb_xcc_id() { return (unsigned)__builtin_amdgcn_s_getreg((3 << 11) | 20) & 0xFu; }
#define XB_SPIN(cond, bar) do { unsigned _sp = 0; while (cond) { __builtin_amdgcn_s_sleep(1); \
    if ((++_sp & 255u) == 0u) { if (xb_ld(&(bar)[XB_TMO])) break; if (_sp > XB_SPIN_CAP) { atomicAdd(&(bar)[XB_TMO], 1u); break; } } } } while (0)

struct XcdBarrier {
    unsigned* bar; unsigned x;
    volatile LAS unsigned* st;
};

__device__ __forceinline__ XcdBarrier xcd_barrier_post(unsigned* bar, volatile LAS unsigned* st) {
    XcdBarrier b; b.bar = bar; b.x = xb_xcc_id(); b.st = st;
    if (TIDX == 0) (void)xb_add(&bar[XB_XCNT(b.x)], 1u);
    return b;
}
__device__ __forceinline__ void xcd_barrier_complete(unsigned* bar, unsigned x, unsigned& nloc, unsigned& nx) {
    const unsigned G = gridDim.x * gridDim.y * gridDim.z;
    unsigned sum, cnt, mine, sp = 0u;
    for (;;) {
        sum = 0u; cnt = 0u; mine = 0u;
#pragma unroll
        for (unsigned j = 0; j < 16; ++j) { const unsigned c = xb_ld(&bar[XB_XCNT(j)]); sum += c; cnt += (c > 0u) ? 1u : 0u; mine = (j == x) ? c : mine; }
        if (sum == G) break;
        __builtin_amdgcn_s_sleep(1);
        if ((++sp & 255u) == 0u) { if (xb_ld(&bar[XB_TMO])) break; if (sp > XB_SPIN_CAP) { atomicAdd(&bar[XB_TMO], 1u); break; } }
    }
    nloc = mine > 0u ? mine : 1u; nx = cnt > 0u ? cnt : 1u;
}

__device__ __forceinline__ void xcd_barrier(const XcdBarrier& b) {
    asm volatile("s_waitcnt vmcnt(0)" ::: "memory");
    __syncthreads();
    if (TIDX == 0) {
        unsigned* bar = b.bar;
        __builtin_amdgcn_s_waitcnt(0);
        unsigned nloc = b.st[0], nx = b.st[1];
        if (nloc == 0u) { xcd_barrier_complete(bar, b.x, nloc, nx); b.st[0] = nloc; b.st[1] = nx; }
        const unsigned old = xb_add(&bar[XB_XSUB(b.x)], 1u);
        const unsigned gen = old / nloc;
        if (old + 1u == (gen + 1u) * nloc) {
            __builtin_amdgcn_fence(__ATOMIC_RELEASE, "agent");
            asm volatile("s_waitcnt vmcnt(0)" ::: "memory");
            const unsigned og = xb_add(&bar[XB_TOP], 1u);
            const unsigned tg = og / nx;
            if (og + 1u == (tg + 1u) * nx) xb_add(&bar[XB_TOPGEN], 1u);
            else XB_SPIN(xb_ld(&bar[XB_TOPGEN]) == tg, bar);
            __builtin_amdgcn_fence(__ATOMIC_ACQUIRE, "agent");
            xb_add(&bar[XB_XGEN(b.x)], 1u);
            asm volatile("s_waitcnt vmcnt(0)" ::: "memory");
        } else {
            XB_SPIN(xb_ld(&bar[XB_XGEN(b.x)]) == gen, bar);
            __builtin_amdgcn_fence(__ATOMIC_ACQUIRE, "agent");
            asm volatile("s_waitcnt vmcnt(0)" ::: "memory");
        }
    }
    __syncthreads();
}

__device__ void d_cvt(const float* __restrict__ in, bf16_t* __restrict__ out, size_t n4) {
  const size_t stride = (size_t)gridDim.x * blockDim.x;
  size_t i = (size_t)blockIdx.x * blockDim.x + TIDX;
  for (; i + 3 * stride < n4; i += 4 * stride) {
    f32x4 v[4];
#pragma unroll
    for (int q = 0; q < 4; ++q) v[q] = ((const f32x4*)in)[i + q * stride];
#pragma unroll
    for (int q = 0; q < 4; ++q) { u32x2 o = {pack2(v[q][0], v[q][1]), pack2(v[q][2], v[q][3])}; ((u32x2*)out)[i + q * stride] = o; }
  }
  for (; i < n4; i += stride) { const f32x4 v = ((const f32x4*)in)[i]; u32x2 o = {pack2(v[0], v[1]), pack2(v[2], v[3])}; ((u32x2*)out)[i] = o; }
}
__device__ void d_cvtT64(int vb, char* smem, const float* __restrict__ W, bf16_t* __restrict__ WT, int K, int N, int NP) {
  float (*tt)[65] = (float (*)[65])smem;
  const int tid = (TIDX & 255);
  const int nbx = NP / 64;
  const int n0 = (vb % nbx) * 64, k0 = (vb / nbx) * 64;
  {
    const int kr = tid >> 4, nc = (tid & 15) * 4;
#pragma unroll
    for (int i = 0; i < 4; ++i) {
      const int k = k0 + kr + 16 * i, n = n0 + nc;
      f32x4 v = {0.f, 0.f, 0.f, 0.f};
      if (n < N) v = *(const f32x4*)(W + (size_t)k * N + n);
      tt[kr + 16 * i][nc] = v[0]; tt[kr + 16 * i][nc + 1] = v[1]; tt[kr + 16 * i][nc + 2] = v[2]; tt[kr + 16 * i][nc + 3] = v[3];
    }
  }
  __syncthreads();
  {
    const int nr = tid >> 3, kc = (tid & 7) * 8;
#pragma unroll
    for (int i = 0; i < 2; ++i) {
      const int nl = nr + 32 * i;
      u32x4 o = {pack2(tt[kc][nl], tt[kc + 1][nl]), pack2(tt[kc + 2][nl], tt[kc + 3][nl]), pack2(tt[kc + 4][nl], tt[kc + 5][nl]), pack2(tt[kc + 6][nl], tt[kc + 7][nl])};
      *(u32x4*)(WT + (size_t)(n0 + nl) * K + k0 + kc) = o;
    }
  }
  __syncthreads();
}

using f32x16 = __attribute__((ext_vector_type(16))) float;
using bf16x8v = __attribute__((ext_vector_type(8))) __bf16;
#define MFMA32(a, b, c) __builtin_amdgcn_mfma_f32_32x32x16_bf16((a), (b), (c), 0, 0, 0)
constexpr float LOG2E = 1.4426950408889634f;
constexpr float NEGB = -1e30f;
DI int pi_perm(int i) { return (i & ~12) | ((i & 8) >> 1) | ((i & 4) << 1); }
DI bf16x8 pack8(float a0, float a1, float a2, float a3, float a4, float a5, float a6, float a7) {
  bf16x8v v = {(__bf16)a0, (__bf16)a1, (__bf16)a2, (__bf16)a3, (__bf16)a4, (__bf16)a5, (__bf16)a6, (__bf16)a7};
  return __builtin_bit_cast(bf16x8, v);
}
__device__ __forceinline__ void d_relayout_tile(int T, char* smem, const bf16_t* __restrict__ proj, int col0, bf16_t* __restrict__ dst, bool isV) {
  bf16_t* Ls = (bf16_t*)smem;
  const int tid = TIDX;
#pragma unroll
  for (int q = 0; q < 2; ++q) {
    const int cidx = tid + q * 512;
    const int g = cidx >> 9, tok = (cidx >> 4) & 31, ch = cidx & 15;
    const u32x4 v = *(const u32x4*)(proj + (size_t)(32 * T + tok) * INWP + col0 + g * 128 + ch * 8);
    *(u32x4*)(Ls + (g * 32 + tok) * 136 + ch * 8) = v;
  }
  __syncthreads();
#pragma unroll
  for (int q = 0; q < 2; ++q) {
    const int oc = tid + q * 512;
    const int g = oc >> 9, r9 = oc & 511, lane = r9 & 63;
    u32x4 o;
    if (!isV) {
      const int s8 = r9 >> 6, i = lane & 31, h = lane >> 5;
      o = *(const u32x4*)(Ls + (g * 32 + pi_perm(i)) * 136 + 16 * s8 + 8 * h);
    } else {
      const int s2 = (r9 >> 6) & 1, dt = r9 >> 7, dd = lane & 31, h = lane >> 5;
      const bf16_t* col = Ls + (g * 32 + 16 * s2 + 8 * h) * 136 + 32 * dt + dd;
      unsigned short e[8];
#pragma unroll
      for (int j = 0; j < 8; ++j) e[j] = col[j * 136];
      o.x = e[0] | ((unsigned)e[1] << 16); o.y = e[2] | ((unsigned)e[3] << 16); o.z = e[4] | ((unsigned)e[5] << 16); o.w = e[6] | ((unsigned)e[7] << 16);
    }
    *(u32x4*)(dst + (((size_t)(g * 512 + T)) * 512 + r9) * 8) = o;
  }
  __syncthreads();
}

struct AttnPtrs {
  const bf16_t* proj; const float* gates;
  const bf16_t *kcf, *vcf, *ksf, *vsf, *kwf, *vwf;
  bf16_t* mix; const float* hng;
};

DI float ex2(float x) { return __builtin_amdgcn_exp2f(x); }
DI void halves(float x, float& lo, float& hi) {
  const unsigned u = __float_as_uint(x);
  auto r = __builtin_amdgcn_permlane32_swap(u, u, false, false);
  lo = __uint_as_float(r[0]); hi = __uint_as_float(r[1]);
}
DI float hmax(float x) { float a, b; halves(x, a, b); return fmaxf(a, b); }
DI float hsum(float x) { float a, b; halves(x, a, b); return a + b; }
DI float dpp_quad(float v, int ctrl_is_xor1) {
  const int iv = __float_as_int(v);
  const int r = ctrl_is_xor1 ? __builtin_amdgcn_update_dpp(iv, iv, 0xB1, 0xF, 0xF, false) : __builtin_amdgcn_update_dpp(iv, iv, 0x4E, 0xF, 0xF, false);
  return __int_as_float(r);
}
DI float quad_sum(float v) { v += dpp_quad(v, 1); v += dpp_quad(v, 0); return v; }
DI void osm_step(const float (&sv)[16], float& m, float& l, f32x16 (&O)[4], float (&p)[16]) {
  float tmax = fmaxf(fmaxf(fmaxf(sv[0], sv[1]), fmaxf(sv[2], sv[3])), fmaxf(fmaxf(sv[4], sv[5]), fmaxf(sv[6], sv[7])));
  tmax = fmaxf(tmax, fmaxf(fmaxf(fmaxf(sv[8], sv[9]), fmaxf(sv[10], sv[11])), fmaxf(fmaxf(sv[12], sv[13]), fmaxf(sv[14], sv[15]))));
  tmax = hmax(tmax);
  if (__ballot(tmax - m > 8.f)) {
    const float mn = fmaxf(m, tmax);
    const float alpha = ex2(m - mn);
    l *= alpha; m = mn;
#pragma unroll
    for (int dt = 0; dt < 4; ++dt)
#pragma unroll
      for (int r = 0; r < 16; ++r) O[dt][r] *= alpha;
  }
  float ps0 = 0.f, ps1 = 0.f;
#pragma unroll
  for (int r = 0; r < 16; r += 2) { const float e0 = ex2(sv[r] - m), e1 = ex2(sv[r + 1] - m); p[r] = e0; p[r + 1] = e1; ps0 += e0; ps1 += e1; }
  l += ps0 + ps1;
}
DI void ot_store(char* otL, int lane, const f32x16 (&O)[4], float sc) {
#pragma unroll
  for (int dt = 0; dt < 4; ++dt) {
    u32x4 a, b;
#pragma unroll
    for (int i = 0; i < 4; ++i) { a[i] = pack2(sc * O[dt][2 * i], sc * O[dt][2 * i + 1]); b[i] = pack2(sc * O[dt][8 + 2 * i], sc * O[dt][8 + 2 * i + 1]); }
    *(u32x4*)(otL + lane * 128 + dt * 32) = a;
    *(u32x4*)(otL + lane * 128 + dt * 32 + 16) = b;
  }
}
DI void ot_accum(const char* otL, int lane, f32x16 (&O)[4], float sc) {
#pragma unroll
  for (int dt = 0; dt < 4; ++dt) {
    u32x4 a = *(const u32x4*)(otL + lane * 128 + dt * 32);
    u32x4 b = *(const u32x4*)(otL + lane * 128 + dt * 32 + 16);
#pragma unroll
    for (int i = 0; i < 4; ++i) {
      const unsigned wa = a[i], wb = b[i];
      O[dt][2 * i] = fmaf(sc, O[dt][2 * i], __uint_as_float(wa << 16));
      O[dt][2 * i + 1] = fmaf(sc, O[dt][2 * i + 1], __uint_as_float(wa & 0xFFFF0000u));
      O[dt][8 + 2 * i] = fmaf(sc, O[dt][8 + 2 * i], __uint_as_float(wb << 16));
      O[dt][8 + 2 * i + 1] = fmaf(sc, O[dt][8 + 2 * i + 1], __uint_as_float(wb & 0xFFFF0000u));
    }
  }
}
DI void zero_o(f32x16 (&O)[4]) {
#pragma unroll
  for (int dt = 0; dt < 4; ++dt)
#pragma unroll
    for (int i = 0; i < 16; ++i) O[dt][i] = 0.f;
}

constexpr int ATT_PW = 8704;
constexpr int ATT_R = 4, ATT_D = 3;
constexpr int ATT_RING = 8 * ATT_PW;
constexpr int ATT_LIST = ATT_RING + ATT_R * 16384;
constexpr int ATT_BUNI = ATT_LIST + 2048;
constexpr int ATT_SMEM = ATT_BUNI + 64;
#define LAS3 __attribute__((address_space(3)))
__device__ __forceinline__ void d_select(const float* impL, unsigned* mskL, unsigned* uniL, int cur) {
  const int lane = TIDX & 63;
  const int stok = lane >> 3, sub = lane & 7;
  unsigned key[32];
#pragma unroll
  for (int i4 = 0; i4 < 8; ++i4) {
    f32x4 v = *(const f32x4*)(impL + stok * 256 + sub * 32 + i4 * 4);
#pragma unroll
    for (int e = 0; e < 4; ++e) {
      const int j = sub * 32 + i4 * 4 + e;
      const bool valid = j <= cur;
      const bool forced = (j == 0) || (j == cur) || (j == cur - 1);
      unsigned kb = forced ? 0xFFFFFF00u : (__float_as_uint(v[e]) & 0xFFFFFF00u);
      key[i4 * 4 + e] = valid ? (kb | (unsigned)(255 - j)) : 0u;
    }
  }
#pragma unroll
  for (int k = 2; k <= 32; k <<= 1) {
#pragma unroll
    for (int jj = k >> 1; jj > 0; jj >>= 1) {
#pragma unroll
      for (int i = 0; i < 32; ++i) {
        const int l2 = i ^ jj;
        if (l2 > i) {
          const bool desc = ((i & k) == 0);
          unsigned a = key[i], b = key[l2];
          unsigned mx = a > b ? a : b, mn = a > b ? b : a;
          key[i] = desc ? mx : mn; key[l2] = desc ? mn : mx;
        }
      }
    }
  }
#pragma unroll
  for (int xm = 1; xm < 8; xm <<= 1) {
    unsigned L[16];
#pragma unroll
    for (int i = 0; i < 16; ++i) { unsigned o = (unsigned)shx_i((int)key[15 - i], xm); L[i] = key[i] > o ? key[i] : o; }
#pragma unroll
    for (int jj = 8; jj > 0; jj >>= 1) {
#pragma unroll
      for (int i = 0; i < 16; ++i) {
        const int l2 = i ^ jj;
        if (l2 > i) { unsigned a = L[i], b = L[l2]; L[i] = a > b ? a : b; L[l2] = a > b ? b : a; }
      }
    }
#pragma unroll
    for (int i = 0; i < 16; ++i) key[i] = L[i];
  }
#pragma unroll
  for (int i = 0; i < 16; ++i) {
    if ((i & 7) == sub) {
      const int j = 255 - (int)(key[i] & 255u);
      if (j <= cur) { atomicOr(&mskL[stok * 8 + (j >> 5)], 1u << (j & 31)); atomicOr(&uniL[j >> 5], 1u << (j & 31)); }
    }
  }
}


DI void att_issue(LAS3 unsigned char* ring, int slot, int w, int lane, const bf16_t* kb, const bf16_t* vb, int tile) {
  const char* ks = (const char*)kb + (size_t)tile * 8192 + w * 1024 + lane * 16;
  const char* vs = (const char*)vb + (size_t)tile * 8192 + w * 1024 + lane * 16;
  __builtin_amdgcn_global_load_lds((const unsigned*)ks, (LAS3 unsigned*)(ring + slot * 16384 + w * 1024), 16, 0, 0);
  __builtin_amdgcn_global_load_lds((const unsigned*)vs, (LAS3 unsigned*)(ring + slot * 16384 + 8192 + w * 1024), 16, 0, 0);
}
DI f32x16 qk_lds(LAS3 const unsigned char* kt, const bf16x8 (&qf)[8], int lane) {
  f32x16 acc;
#pragma unroll
  for (int i = 0; i < 16; ++i) acc[i] = 0.f;
#pragma unroll
  for (int s8 = 0; s8 < 8; ++s8) {
    const bf16x8 kf = *(LAS3 const bf16x8*)(kt + s8 * 1024 + lane * 16);
    acc = MFMA32(kf, qf[s8], acc);
  }
  return acc;
}
DI void pv_lds(LAS3 const unsigned char* vt, const float (&p)[16], f32x16 (&O)[4], int lane) {
  const bf16x8 pf0 = pack8(p[0], p[1], p[2], p[3], p[4], p[5], p[6], p[7]);
  const bf16x8 pf1 = pack8(p[8], p[9], p[10], p[11], p[12], p[13], p[14], p[15]);
#pragma unroll
  for (int dt = 0; dt < 4; ++dt) {
    const bf16x8 v0 = *(LAS3 const bf16x8*)(vt + (dt * 2) * 1024 + lane * 16);
    const bf16x8 v1 = *(LAS3 const bf16x8*)(vt + (dt * 2 + 1) * 1024 + lane * 16);
    O[dt] = MFMA32(v0, pf0, O[dt]);
    O[dt] = MFMA32(v1, pf1, O[dt]);
  }
}

__device__ __forceinline__ void d_attn_block(int B, int g, char* smem, const AttnPtrs& P) {
  const int tid = TIDX, lane = tid & 63, w = tid >> 6;
  const int c = lane & 31, h = lane >> 5, tokl = c >> 2, r = c & 3;
  const int tok0 = 64 * B + 8 * w;
  const int t = tok0 + tokl, hd = g * 4 + r;
  const float slope2 = exp2f(-(float)(hd + 1)) * LOG2E;
  const float c1 = QSCALE * LOG2E;
  const float ninf = -__builtin_inff();
  char* wsm = smem + w * ATT_PW;
  float* impL = (float*)wsm;
  char* otL = wsm;
  unsigned* mskL = (unsigned*)(wsm + 8192);
  unsigned* uniL = mskL + 64;
  LAS3 unsigned char* ring = (LAS3 unsigned char*)(smem + ATT_RING);
  unsigned short* tl = (unsigned short*)(smem + ATT_LIST);
  unsigned* buni = (unsigned*)(smem + ATT_BUNI);
  const bf16_t* kcf = P.kcf + (size_t)g * 32 * 4096;
  const bf16_t* vcf = P.vcf + (size_t)g * 32 * 4096;
  const bf16_t* ksf = P.ksf + (size_t)g * 512 * 4096;
  const bf16_t* vsf = P.vsf + (size_t)g * 512 * 4096;
  const bf16_t* kwf = P.kwf + (size_t)g * 512 * 4096;
  const bf16_t* vwf = P.vwf + (size_t)g * 512 * 4096;
  bf16x8 qf[8];
  {
    const bf16_t* qrow = P.proj + (size_t)t * INWP + OFF_Q + hd * 128 + 8 * h;
#pragma unroll
    for (int s8 = 0; s8 < 8; ++s8) qf[s8] = *(const bf16x8*)(qrow + 16 * s8);
  }
  const float* gt = P.gates + (size_t)t * 24 + hd * 3;
  const float g0 = gt[0], g1 = gt[1], g2 = gt[2];
  {
    unsigned z0 = 0u;
    asm volatile("" : "+v"(z0));
    u32x4 z = {z0, z0, z0, z0};
#pragma unroll
    for (int i = 0; i < 8; ++i) *(u32x4*)(wsm + (i * 64 + lane) * 16) = z;
    if (lane < 18) *(u32x4*)(wsm + 8192 + lane * 16) = z;
    if (tid < 8) buni[tid] = z0;
  }
  f32x16 Ob[4];
  zero_o(Ob);
  const int nmax = (t >= 31) ? ((t - 31) >> 4) : -1;
  const int nmaxw = (tok0 + 7 >= 31) ? ((tok0 + 7 - 31) >> 4) : -1;
  const int nminw = (tok0 >= 31) ? ((tok0 - 31) >> 4) : -1;
  const int ntcw = (nmaxw + 32) >> 5;
  const int ntcB = (((64 * B + 63 - 31) >> 4) + 32) >> 5;
  const float sl16 = slope2 * 16.f;
  float mC = NEGB, lC = 0.f, invC = 0.f, carry = 0.f;
  {
    const int n = 2 * ntcB;
    asm volatile("s_waitcnt vmcnt(0)" ::: "memory");
#define A_TILE(i_) (((i_) < ntcB) ? (ntcB - 1 - (i_)) : ((i_) - ntcB))
    att_issue(ring, 0, w, lane, kcf, vcf, A_TILE(0));
    if (n > 1) att_issue(ring, 1, w, lane, kcf, vcf, A_TILE(1));
#pragma unroll 1
    for (int i = 0; i < n; ++i) {
      if ((i & 1) == 0) {
        asm volatile("s_waitcnt vmcnt(0)" ::: "memory");
        __builtin_amdgcn_s_barrier();
        asm volatile("" ::: "memory");
        if (i + 2 < n) att_issue(ring, (i + 2) & 3, w, lane, kcf, vcf, A_TILE(i + 2));
        if (i + 3 < n) att_issue(ring, (i + 3) & 3, w, lane, kcf, vcf, A_TILE(i + 3));
      }
      const int T = A_TILE(i);
      if (T >= ntcw) continue;
      LAS3 const unsigned char* slot = ring + (i % ATT_R) * 16384;
      const f32x16 acc = qk_lds(slot, qf, lane);
      const float base = slope2 * (float)(512 * T + 128 * h) + slope2 * (15.5f - (float)t);
      const int nb = 32 * T + 8 * h;
      const bool full = (32 * T + 31 <= nminw);
      float sv[16];
#pragma unroll
      for (int rg = 0; rg < 16; ++rg) { const int kk = (rg & 7) + 16 * (rg >> 3); sv[rg] = fmaf(acc[rg], c1, fmaf(sl16, (float)kk, base)); }
      if (!full) {
#pragma unroll
        for (int rg = 0; rg < 16; ++rg) { const int kk = (rg & 7) + 16 * (rg >> 3); sv[rg] = (nb + kk <= nmax) ? sv[rg] : ninf; }
      }
      if (i < ntcB) {
        float tmax = fmaxf(fmaxf(fmaxf(sv[0], sv[1]), fmaxf(sv[2], sv[3])), fmaxf(fmaxf(sv[4], sv[5]), fmaxf(sv[6], sv[7])));
        tmax = fmaxf(tmax, fmaxf(fmaxf(fmaxf(sv[8], sv[9]), fmaxf(sv[10], sv[11])), fmaxf(fmaxf(sv[12], sv[13]), fmaxf(sv[14], sv[15]))));
        tmax = hmax(tmax);
        const float mn = fmaxf(mC, tmax);
        float ps = 0.f;
#pragma unroll
        for (int rg = 0; rg < 16; ++rg) ps += ex2(sv[rg] - mn);
        lC = lC * ex2(mC - mn) + ps; mC = mn;
      } else {
        if (T == 0) { lC = hsum(lC); invC = (lC > 0.f) ? 1.f / lC : 0.f; }
        float p[16];
#pragma unroll
        for (int rg = 0; rg < 16; ++rg) p[rg] = ex2(sv[rg] - mC) * invC;
        float Ga = (p[0] + p[1]) + (p[2] + p[3]), Gb = (p[4] + p[5]) + (p[6] + p[7]);
        float Gc = (p[8] + p[9]) + (p[10] + p[11]), Gd = (p[12] + p[13]) + (p[14] + p[15]);
        float xb, xd; { float a_, b_; halves(p[7], a_, b_); xb = h ? a_ : b_; halves(p[15], a_, b_); xd = h ? a_ : b_; }
        float ia = Ga + (h ? xb : carry);
        float ib = Gb + p[3];
        float ic = Gc + (h ? xd : xb);
        float id = Gd + p[11];
        carry = xd;
        ia = quad_sum(ia); ib = quad_sum(ib); ic = quad_sum(ic); id = quad_sum(id);
        {
          float val = (r == 0) ? ia : (r == 1) ? ib : (r == 2) ? ic : id;
          int j = 8 * T + 2 * h + ((r == 0) ? 0 : (r == 1) ? 1 : (r == 2) ? 4 : 5);
          impL[tokl * 256 + j] = val;
        }
        pv_lds(slot + 8192, p, Ob, lane);
      }
    }
#undef A_TILE
  }
  const int cur = B;
  d_select(impL, mskL, uniL, cur);
  ot_store(otL, lane, Ob, g0);
  zero_o(Ob);
  if (lane < 8) { const unsigned u = uniL[lane]; if (u) atomicOr(&buni[lane], u); }
  __syncthreads();
  int nslc = 0, ntl = 0;
  {
    for (int iw = 7; iw >= 0; --iw) {
      unsigned iuw = __builtin_amdgcn_readfirstlane(buni[iw]);
      while (iuw) {
        const int bit = 31 - __builtin_clz(iuw);
        iuw &= ~(1u << bit);
        const int bb = 32 * iw + bit;
        if (bb < B) { if (lane == 0) tl[ntl] = (unsigned short)(2 * bb + 1); ++ntl; }
        else { if (lane == 0) tl[ntl] = (unsigned short)(2 * bb + 1); ++ntl; }
        if (lane == 0) tl[ntl] = (unsigned short)(2 * bb);
        ++ntl;
      }
    }
    nslc = ntl;
    const int ThiB = 2 * B + 1, TloB = ((64 * B - 511 > 0) ? (64 * B - 511) : 0) >> 5;
    for (int T = ThiB; T >= TloB; --T) { if (lane == 0) tl[ntl] = (unsigned short)T; ++ntl; }
  }
  float m = NEGB, l = 0.f;
  {
    const int n = ntl;
    const int Tlow = ((tok0 - 511 > 0) ? (tok0 - 511) : 0) >> 5, Thiw = (tok0 + 7) >> 5;
#define B_ISSUE(j_, slot_) { const int e_ = __builtin_amdgcn_readfirstlane((int)tl[j_]); if ((j_) < nslc) att_issue(ring, slot_, w, lane, ksf, vsf, e_); else att_issue(ring, slot_, w, lane, kwf, vwf, e_); }
    B_ISSUE(0, 0)
    if (n > 1) B_ISSUE(1, 1)
#pragma unroll 1
    for (int i = 0; i < n; ++i) {
      if ((i & 1) == 0) {
        asm volatile("s_waitcnt vmcnt(0)" ::: "memory");
        __builtin_amdgcn_s_barrier();
        asm volatile("" ::: "memory");
        if (i + 2 < n) B_ISSUE(i + 2, (i + 2) & 3)
        if (i + 3 < n) B_ISSUE(i + 3, (i + 3) & 3)
      }
      if (i == nslc) {
        l = hsum(l);
        const float inv = (l > 0.f) ? g1 / l : 0.f;
        ot_accum(otL, lane, Ob, inv);
        ot_store(otL, lane, Ob, 1.f);
        zero_o(Ob);
        m = NEGB; l = 0.f;
      }
      const int T = __builtin_amdgcn_readfirstlane((int)tl[i]);
      const int pos0 = 32 * T, pb = pos0 + 8 * h;
      bool full; bool mine = true;
      if (i < nslc) {
        const int bb = T >> 1;
        const unsigned uw = __builtin_amdgcn_readfirstlane(uniL[bb >> 5]);
        if (!((uw >> (bb & 31)) & 1u) || pos0 > tok0 + 7) continue;
        mine = (mskL[tokl * 8 + (bb >> 5)] >> (bb & 31)) & 1u;
        full = (pos0 + 31 <= tok0) && (__ballot(!mine) == 0ull);
      } else {
        if (T < Tlow || T > Thiw) continue;
        full = (pos0 + 31 <= tok0) && (pos0 >= tok0 + 7 - 511);
      }
      LAS3 const unsigned char* slot = ring + (i % ATT_R) * 16384;
      const f32x16 acc = qk_lds(slot, qf, lane);
      const float base = slope2 * (float)(pos0 + 8 * h - t);
      float sv[16], p[16];
#pragma unroll
      for (int rg = 0; rg < 16; ++rg) { const int kk = (rg & 7) + 16 * (rg >> 3); sv[rg] = fmaf(acc[rg], c1, fmaf(slope2, (float)kk, base)); }
      if (!full) {
        if (i < nslc) {
#pragma unroll
          for (int rg = 0; rg < 16; ++rg) { const int kk = (rg & 7) + 16 * (rg >> 3); sv[rg] = (mine && (pb + kk <= t)) ? sv[rg] : ninf; }
        } else {
#pragma unroll
          for (int rg = 0; rg < 16; ++rg) { const int kk = (rg & 7) + 16 * (rg >> 3); const int dw = t - (pb + kk); sv[rg] = ((dw >= 0) && (dw < 512)) ? sv[rg] : ninf; }
        }
      }
      osm_step(sv, m, l, Ob, p);
      pv_lds(slot + 8192, p, Ob, lane);
    }
#undef B_ISSUE
    l = hsum(l);
    const float inv = (l > 0.f) ? g2 / l : 0.f;
    ot_accum(otL, lane, Ob, inv);
  }
  {
    float ss = 0.f;
#pragma unroll
    for (int dt = 0; dt < 4; ++dt)
#pragma unroll
      for (int i = 0; i < 16; ++i) ss = fmaf(Ob[dt][i], Ob[dt][i], ss);
    ss = hsum(ss);
    const float rs = rsqrtf(ss * (1.f / 128.f) + 1e-6f);
    bf16_t* orow = P.mix + (size_t)t * DM + hd * 128 + 4 * h;
    const float* grow = P.hng + hd * 128 + 4 * h;
#pragma unroll
    for (int dt = 0; dt < 4; ++dt)
#pragma unroll
      for (int a = 0; a < 4; ++a) {
        const f32x4 gv = *(const f32x4*)(grow + 32 * dt + 8 * a);
        u32x2 wv2 = {pack2(Ob[dt][4 * a] * rs * gv[0], Ob[dt][4 * a + 1] * rs * gv[1]), pack2(Ob[dt][4 * a + 2] * rs * gv[2], Ob[dt][4 * a + 3] * rs * gv[3])};
        *(u32x2*)(orow + 32 * dt + 8 * a) = wv2;
      }
  }
  asm volatile("s_waitcnt vmcnt(0)" ::: "memory");
  __syncthreads();
}

__device__ void d_convmix(int t, int tl, const bf16_t* __restrict__ proj, const float* __restrict__ convw, const float* __restrict__ hng,
                          bf16_t* __restrict__ mix) {
  const int c = tl * 8;
  float acc[8];
#pragma unroll
  for (int i = 0; i < 8; ++i) acc[i] = 0.f;
#pragma unroll
  for (int j = 0; j < 3; ++j) {
    const int tt = t - 2 + j;
    if (tt >= 0) {
      const u32x4 cu = *(const u32x4*)(proj + (size_t)tt * INWP + OFF_C + c);
      const u32x4 uu = *(const u32x4*)(proj + (size_t)tt * INWP + OFF_U + c);
      const f32x4 w0 = *(const f32x4*)(convw + j * 1024 + c), w1 = *(const f32x4*)(convw + j * 1024 + c + 4);
#pragma unroll
      for (int i = 0; i < 4; ++i) {
        const unsigned a = cu[i], b = uu[i];
        const float wl = (i < 2) ? w0[2 * i] : w1[2 * i - 4], wh = (i < 2) ? w0[2 * i + 1] : w1[2 * i - 3];
        acc[2 * i] = fmaf(wl * __uint_as_float(a << 16), __uint_as_float(b << 16), acc[2 * i]);
        acc[2 * i + 1] = fmaf(wh * __uint_as_float(a & 0xFFFF0000u), __uint_as_float(b & 0xFFFF0000u), acc[2 * i + 1]);
      }
    }
  }
  const u32x4 bb = *(const u32x4*)(proj + (size_t)t * INWP + OFF_B + c);
  float ss = 0.f;
#pragma unroll
  for (int i = 0; i < 4; ++i) {
    const unsigned b = bb[i];
    acc[2 * i] *= __uint_as_float(b << 16); acc[2 * i + 1] *= __uint_as_float(b & 0xFFFF0000u);
    ss = fmaf(acc[2 * i], acc[2 * i], ss); ss = fmaf(acc[2 * i + 1], acc[2 * i + 1], ss);
  }
  ss += shx(ss, 8); ss += shx(ss, 4); ss += shx(ss, 2); ss += shx(ss, 1);
  const float rs = rsqrtf(ss * (1.f / 128.f) + 1e-6f);
  const f32x4 g0 = *(const f32x4*)(hng + 1024 + c), g1 = *(const f32x4*)(hng + 1024 + c + 4);
  u32x4 o = {pack2(acc[0] * rs * g0[0], acc[1] * rs * g0[1]), pack2(acc[2] * rs * g0[2], acc[3] * rs * g0[3]),
             pack2(acc[4] * rs * g1[0], acc[5] * rs * g1[1]), pack2(acc[6] * rs * g1[2], acc[7] * rs * g1[3])};
  *(u32x4*)(mix + (size_t)t * DM + 1024 + c) = o;
}

__device__ void d_ln_wave(int t, bf16_t* __restrict__ yh, const float* __restrict__ gam, const float* __restrict__ bet) {
  const int lane = TIDX & 63;
  float v[32];
#pragma unroll
  for (int i = 0; i < 4; ++i) {
    const u32x4 w = *(const u32x4*)(yh + (size_t)t * DM + 512 * i + 8 * lane);
#pragma unroll
    for (int j = 0; j < 4; ++j) { const unsigned ww = w[j]; v[i * 8 + 2 * j] = __uint_as_float(ww << 16); v[i * 8 + 2 * j + 1] = __uint_as_float(ww & 0xFFFF0000u); }
  }
  float s = 0.f;
#pragma unroll
  for (int i = 0; i < 32; ++i) s += v[i];
  s = wave_sum(s);
  const float mu = s * (1.f / DM);
  float q = 0.f;
#pragma unroll
  for (int i = 0; i < 32; ++i) { const float d = v[i] - mu; q = fmaf(d, d, q); }
  q = wave_sum(q);
  const float rs = rsqrtf(q * (1.f / DM) + 1e-5f);
#pragma unroll
  for (int i = 0; i < 4; ++i) {
    const int cb = 512 * i + 8 * lane;
    const f32x4 g0 = *(const f32x4*)(gam + cb), g1 = *(const f32x4*)(gam + cb + 4), b0 = *(const f32x4*)(bet + cb), b1 = *(const f32x4*)(bet + cb + 4);
    u32x4 o = {pack2((v[i * 8 + 0] - mu) * rs * g0[0] + b0[0], (v[i * 8 + 1] - mu) * rs * g0[1] + b0[1]), pack2((v[i * 8 + 2] - mu) * rs * g0[2] + b0[2], (v[i * 8 + 3] - mu) * rs * g0[3] + b0[3]),
               pack2((v[i * 8 + 4] - mu) * rs * g1[0] + b1[0], (v[i * 8 + 5] - mu) * rs * g1[1] + b1[1]), pack2((v[i * 8 + 6] - mu) * rs * g1[2] + b1[2], (v[i * 8 + 7] - mu) * rs * g1[3] + b1[3])};
    *(u32x4*)(yh + (size_t)t * DM + cb) = o;
  }
}

__device__ void d_cvt_w1f(size_t c, const float* __restrict__ w1, bf16_t* __restrict__ w1f) {
  const int lane = c & 63, ks = (c >> 6) & 255, ct = c >> 14;
  const int col = lane & 31, h = lane >> 5;
  bf16_t v[8];
#pragma unroll
  for (int j = 0; j < 8; ++j) v[j] = f2bf(w1[(size_t)(16 * ks + 8 * h + j) * 512 + 32 * ct + col]);
  u32x4 o; o.x = v[0] | ((unsigned)v[1] << 16); o.y = v[2] | ((unsigned)v[3] << 16); o.z = v[4] | ((unsigned)v[5] << 16); o.w = v[6] | ((unsigned)v[7] << 16);
  *(u32x4*)(w1f + c * 8) = o;
}
__device__ void d_cvt_w2f(size_t c, const float* __restrict__ w2, bf16_t* __restrict__ w2f) {
  const int lane = c & 63, s = (c >> 6) & 31, ct = c >> 11;
  const int col = lane & 31, h = lane >> 5;
  bf16_t v[8];
#pragma unroll
  for (int j = 0; j < 8; ++j) v[j] = f2bf(w2[(size_t)(16 * s + 8 * h + j) * 128 + 32 * ct + col]);
  u32x4 o; o.x = v[0] | ((unsigned)v[1] << 16); o.y = v[2] | ((unsigned)v[3] << 16); o.z = v[4] | ((unsigned)v[5] << 16); o.w = v[6] | ((unsigned)v[7] << 16);
  *(u32x4*)(w2f + c * 8) = o;
}
__device__ __forceinline__ void d_compress_unit(int rt, char* smem, const bf16_t* __restrict__ proj, int col0, const float* __restrict__ pos,
                                const bf16_t* __restrict__ w1f, const float* __restrict__ b1, const bf16_t* __restrict__ w2f,
                                bf16_t* __restrict__ outf, bool isV) {
  bf16_t* Xs = (bf16_t*)smem;
  bf16_t* Hs = (bf16_t*)(smem + 2 * 8704);
  const int tid = TIDX, lane = tid & 63, w = tid >> 6, c = lane & 31, h = lane >> 5;
  const int R0 = rt * 32;
  const int srow = tid >> 4, sch = tid & 15;
  const int grow = R0 + srow, sn = grow >> 1, sg = grow & 1;
  const bool svalid = grow < 2046;
  const bf16_t* sp = proj + (size_t)(16 * sn) * INWP + col0 + sg * 128 + sch * 8;
  f32x16 acc0, acc1;
#pragma unroll
  for (int i = 0; i < 16; ++i) { acc0[i] = 0.f; acc1[i] = 0.f; }
  u32x4 rx = {0u, 0u, 0u, 0u}; f32x4 rp0, rp1;
#define STAGE_WRITE(buf)                                                                                   \
  {                                                                                                        \
    u32x4 o_;                                                                                              \
    _Pragma("unroll") for (int i = 0; i < 4; ++i) {                                                        \
      const unsigned wv_ = rx[i];                                                                          \
      const float lo = __uint_as_float(wv_ << 16) + ((i < 2) ? rp0[2 * i] : rp1[2 * i - 4]);               \
      const float hi = __uint_as_float(wv_ & 0xFFFF0000u) + ((i < 2) ? rp0[2 * i + 1] : rp1[2 * i - 3]);   \
      o_[i] = pack2(lo, hi);                                                                               \
    }                                                                                                      \
    *(u32x4*)(Xs + (buf) * 4352 + srow * 136 + sch * 8) = o_;                                              \
  }
  if (svalid) rx = *(const u32x4*)(sp);
  rp0 = *(const f32x4*)(pos + sch * 8); rp1 = *(const f32x4*)(pos + sch * 8 + 4);
  STAGE_WRITE(0)
  __syncthreads();
  const bf16_t* wb0 = w1f + ((size_t)(2 * w) * 256 * 64 + lane) * 8;
  const bf16_t* wb1 = w1f + ((size_t)(2 * w + 1) * 256 * 64 + lane) * 8;
  bf16x8 bA[16], bB[16];
#define CMP_LOADB(BUF, L)                                                                      \
  _Pragma("unroll") for (int s8 = 0; s8 < 8; ++s8) {                                           \
    BUF[2 * s8] = *(const bf16x8*)(wb0 + (size_t)(8 * (L) + s8) * 512);                        \
    BUF[2 * s8 + 1] = *(const bf16x8*)(wb1 + (size_t)(8 * (L) + s8) * 512);                    \
  }
#define CMP_CHUNK(BUF, L)                                                                      \
  {                                                                                            \
    if ((L) + 1 < 32) {                                                                        \
      if (svalid) rx = *(const u32x4*)(sp + (size_t)((L) + 1) * INWP);                         \
      rp0 = *(const f32x4*)(pos + ((L) + 1) * 128 + sch * 8); rp1 = *(const f32x4*)(pos + ((L) + 1) * 128 + sch * 8 + 4); \
    }                                                                                          \
    const bf16_t* xa = Xs + ((L) & 1) * 4352 + c * 136 + 8 * h;                                \
    _Pragma("unroll") for (int s8 = 0; s8 < 8; ++s8) {                                         \
      const bf16x8 a = *(const bf16x8*)(xa + 16 * s8);                                         \
      acc0 = MFMA32(a, BUF[2 * s8], acc0);                                                     \
      acc1 = MFMA32(a, BUF[2 * s8 + 1], acc1);                                                 \
    }                                                                                          \
    if ((L) + 1 < 32) STAGE_WRITE(((L) + 1) & 1)                                               \
    __syncthreads();                                                                           \
  }
  CMP_LOADB(bA, 0)
#pragma unroll 1
  for (int l = 0; l < 32; l += 2) {
    CMP_LOADB(bB, l + 1)
    __builtin_amdgcn_sched_barrier(0);
    CMP_CHUNK(bA, l)
    { const int ln = (l + 2 < 32) ? l + 2 : l;
      CMP_LOADB(bA, ln) }
    __builtin_amdgcn_sched_barrier(0);
    CMP_CHUNK(bB, l + 1)
  }
#undef CMP_LOADB
#undef CMP_CHUNK
  {
    const float bb0 = b1[64 * w + c], bb1 = b1[64 * w + 32 + c];
#pragma unroll
    for (int rg = 0; rg < 16; ++rg) {
      const int row = (rg & 3) + 8 * (rg >> 2) + 4 * h;
      Hs[row * 520 + 64 * w + c] = f2bf(gelu_tanh(acc0[rg] + bb0));
      Hs[row * 520 + 64 * w + 32 + c] = f2bf(gelu_tanh(acc1[rg] + bb1));
    }
  }
  __syncthreads();
  if (w < 4) {
    f32x16 o2;
#pragma unroll
    for (int i = 0; i < 16; ++i) o2[i] = 0.f;
    const bf16_t* ha = Hs + c * 520 + 8 * h;
    const bf16_t* wb = w2f + ((size_t)w * 32 * 64 + lane) * 8;
#pragma unroll 8
    for (int s2 = 0; s2 < 32; ++s2) {
      const bf16x8 a = *(const bf16x8*)(ha + 16 * s2);
      const bf16x8 b = *(const bf16x8*)(wb + (size_t)s2 * 512);
      o2 = MFMA32(a, b, o2);
    }
    const int d = 32 * w + c;
#pragma unroll
    for (int rg = 0; rg < 16; ++rg) {
      const int row = R0 + (rg & 3) + 8 * (rg >> 2) + 4 * h;
      const int n = row >> 1, g = row & 1;
      const bf16_t val = (row < 2046) ? f2bf(o2[rg]) : (bf16_t)0;
      const int T = n >> 5, nn = n & 31;
      size_t idx;
      if (!isV) idx = ((((size_t)(g * 32 + T) * 8 + (d >> 4)) * 64 + (pi_perm(nn) + 32 * ((d >> 3) & 1))) * 8 + (d & 7));
      else idx = (((((size_t)(g * 32 + T) * 4 + (d >> 5)) * 2 + (nn >> 4)) * 64 + ((d & 31) + 32 * ((nn >> 3) & 1))) * 8 + (nn & 7));
      outf[idx] = val;
    }
  }
  __syncthreads();
}


DI unsigned f2sort(float f) { unsigned u = __float_as_uint(f); return u ^ ((unsigned)((int)u >> 31) | 0x80000000u); }
DI float sort2f(unsigned k) { unsigned u = (k & 0x80000000u) ? (k ^ 0x80000000u) : ~k; return __uint_as_float(u); }
template <int N>
DI void bitonic_sort_desc(unsigned (&key)[N]) {
#pragma unroll
  for (int k = 2; k <= N; k <<= 1) {
#pragma unroll
    for (int jj = k >> 1; jj > 0; jj >>= 1) {
#pragma unroll
      for (int i = 0; i < N; ++i) {
        const int l2 = i ^ jj;
        if (l2 > i) {
          const bool desc = ((i & k) == 0);
          unsigned a = key[i], b = key[l2];
          unsigned mx = a > b ? a : b, mn = a > b ? b : a;
          key[i] = desc ? mx : mn; key[l2] = desc ? mn : mx;
        }
      }
    }
  }
}
DI void merge_top16(unsigned (&a)[16], const unsigned (&b)[16]) {
#pragma unroll
  for (int i = 0; i < 16; ++i) { unsigned o = b[15 - i]; a[i] = a[i] > o ? a[i] : o; }
#pragma unroll
  for (int jj = 8; jj > 0; jj >>= 1) {
#pragma unroll
    for (int i = 0; i < 16; ++i) {
      const int l2 = i ^ jj;
      if (l2 > i) { unsigned x = a[i], y = a[l2]; a[i] = x > y ? x : y; a[l2] = x > y ? y : x; }
    }
  }
}
__device__ void d_cvt_subk(size_t c, const float* __restrict__ subk, bf16_t* __restrict__ skf) {
  int lane = c & 63, s = (c >> 6) & 7, kt = (c >> 9) & 3, hc = c >> 11;
  int i = lane & 31, h = lane >> 5;
  const float* src = subk + ((size_t)hc * 128 + 32 * kt + i) * 128 + 16 * s + 8 * h;
  bf16_t v[8];
#pragma unroll
  for (int j = 0; j < 8; ++j) v[j] = f2bf(src[j]);
  u32x4 o; o.x = v[0] | ((unsigned)v[1] << 16); o.y = v[2] | ((unsigned)v[3] << 16); o.z = v[4] | ((unsigned)v[5] << 16); o.w = v[6] | ((unsigned)v[7] << 16);
  *(u32x4*)(skf + c * 8) = o;
}

#define EPI_LANES()                                                                                                      \
    const int lane = fr | (fq << 4), rr = lane >> 2, rc = lane & 3;                                                       \
    PG8_LAS unsigned char* my = scr + (wr * 4 + wc) * 2048;                                                              \
    const int wo = fr * 64 + ((fq ^ ((fr >> 2) & 3)) << 4), ro = rr * 64 + ((rc ^ ((rr >> 2) & 3)) << 4);
struct EpiProjG {
  static constexpr bool PERM = true, AFTER_DRAIN = false;
  bf16_t* proj; float* gates; PG8_LAS unsigned char* scr;
  DI void operator()(const f32x4 (&acc)[2][2][4][2], const pg8::Unit& u, int wr, int wc, int fr, int fq) const {
    EPI_LANES()
#pragma unroll
    for (int ai = 0; ai < 2; ++ai)
#pragma unroll
      for (int bj = 0; bj < 2; ++bj) {
        const int c0 = u.pn * 256 + bj * 128 + wc * 32 + 8 * fq, cs = u.pn * 256 + bj * 128 + wc * 32 + 8 * rc;
#pragma unroll
        for (int mh = 0; mh < 2; ++mh) {
#pragma unroll
          for (int mm = 0; mm < 2; ++mm) {
            const f32x4 v0 = acc[ai][bj][mh * 2 + mm][0], v1 = acc[ai][bj][mh * 2 + mm][1];
            u32x4 w = {pack2(v0[0], v0[1]), pack2(v0[2], v0[3]), pack2(v1[0], v1[1]), pack2(v1[2], v1[3])};
            *(PG8_LAS u32x4*)(my + wo + mm * 1024) = w;
            if (c0 >= OFF_G && c0 < OFF_G + 24) {
              const int row = u.pm * 256 + ai * 128 + wr * 64 + (mh * 2 + mm) * 16 + fr;
              f32x4 g0, g1;
#pragma unroll
              for (int j = 0; j < 4; ++j) { g0[j] = 1.f / (1.f + __expf(-v0[j])); g1[j] = 1.f / (1.f + __expf(-v1[j])); }
              *(f32x4*)(gates + (size_t)row * 24 + (c0 - OFF_G)) = g0;
              *(f32x4*)(gates + (size_t)row * 24 + (c0 - OFF_G) + 4) = g1;
            }
          }
#pragma unroll
          for (int j = 0; j < 2; ++j) {
            const u32x4 w = *(const PG8_LAS u32x4*)(my + ro + j * 1024);
            const int row = u.pm * 256 + ai * 128 + wr * 64 + mh * 32 + j * 16 + rr;
            if (cs < INW) *(u32x4*)(proj + (size_t)row * INWP + cs) = w;
          }
        }
      }
  }
};
struct EpiResG {
  static constexpr bool PERM = true, AFTER_DRAIN = false;
  bf16_t* YB; PG8_LAS unsigned char* scr;
  DI void operator()(const f32x4 (&acc)[2][2][4][2], const pg8::Unit& u, int wr, int wc, int fr, int fq) const {
    EPI_LANES()
    bf16_t* yb = YB + (size_t)(u.pm * 256 + wr * 64 + rr) * DM + u.pn * 256 + wc * 32 + 8 * rc;
#pragma unroll
    for (int ai = 0; ai < 2; ++ai) {
      u32x4 xr[2][2][2];
#pragma unroll
      for (int bj = 0; bj < 2; ++bj)
#pragma unroll
        for (int mh = 0; mh < 2; ++mh)
#pragma unroll
          for (int j = 0; j < 2; ++j) xr[bj][mh][j] = *(const u32x4*)(yb + (size_t)(ai * 128 + mh * 32 + j * 16) * DM + bj * 128);
#pragma unroll
      for (int bj = 0; bj < 2; ++bj)
#pragma unroll
        for (int mh = 0; mh < 2; ++mh) {
#pragma unroll
          for (int mm = 0; mm < 2; ++mm) {
            const f32x4 v0 = acc[ai][bj][mh * 2 + mm][0], v1 = acc[ai][bj][mh * 2 + mm][1];
            u32x4 w = {pack2(v0[0], v0[1]), pack2(v0[2], v0[3]), pack2(v1[0], v1[1]), pack2(v1[2], v1[3])};
            *(PG8_LAS u32x4*)(my + wo + mm * 1024) = w;
          }
#pragma unroll
          for (int j = 0; j < 2; ++j) {
            const u32x4 a = *(const PG8_LAS u32x4*)(my + ro + j * 1024), xw = xr[bj][mh][j];
            u32x4 o;
#pragma unroll
            for (int q = 0; q < 4; ++q) {
              const unsigned aw = a[q], xq = xw[q];
              o[q] = pack2(fmaf(ALPHA, __uint_as_float(xq << 16), __uint_as_float(aw << 16)), fmaf(ALPHA, __uint_as_float(xq & 0xFFFF0000u), __uint_as_float(aw & 0xFFFF0000u)));
            }
            *(u32x4*)(yb + (size_t)(ai * 128 + mh * 32 + j * 16) * DM + bj * 128) = o;
          }
        }
    }
  }
};
struct EpiF32G {
  static constexpr bool PERM = false, AFTER_DRAIN = false;
  float* C; int ldc;
  DI void operator()(const f32x4 (&acc)[2][2][4][2], const pg8::Unit& u, int wr, int wc, int fr, int fq) const {
#pragma unroll
    for (int ai = 0; ai < 2; ++ai)
#pragma unroll
      for (int m = 0; m < 4; ++m) {
        const size_t ro = (size_t)(u.pm * 256 + ai * 128 + wr * 64 + m * 16 + fr) * ldc + u.pn * 256 + wc * 32 + 4 * fq;
#pragma unroll
        for (int bj = 0; bj < 2; ++bj)
#pragma unroll
          for (int n = 0; n < 2; ++n) *(f32x4*)(C + ro + bj * 128 + n * 16) = acc[ai][bj][m][n];
      }
  }
};
struct EpiRouteG {
  static constexpr bool PERM = false, AFTER_DRAIN = true;
  const bf16_t* skf; unsigned* tops;
  DI void operator()(const f32x4 (&)[2][2][4][2], const pg8::Unit&, int, int, int, int) const {}
  DI void fused(const f32x4 (&acc)[2][2][4][2], const pg8::Unit& u, int wr, int wc, int fr, int fq, PG8_LAS unsigned char* ldsp, int, int) const {
    const int lane = fr | (fq << 4), wid = wr * 4 + wc;
    bf16_t* Qs = (bf16_t*)ldsp;
#pragma unroll
    for (int ai = 0; ai < 2; ++ai)
#pragma unroll
      for (int m = 0; m < 4; ++m) {
        const int row = ai * 128 + wr * 64 + m * 16 + fr;
#pragma unroll
        for (int bj = 0; bj < 2; ++bj)
#pragma unroll
          for (int n = 0; n < 2; ++n) {
            const f32x4 v = acc[ai][bj][m][n];
            u32x2 w = {pack2(v[0], v[1]), pack2(v[2], v[3])};
            *(u32x2*)(Qs + row * 264 + bj * 128 + wc * 32 + n * 16 + 4 * fq) = w;
          }
      }
    __syncthreads();
    const int c = lane & 31, h = lane >> 5;
#pragma unroll 1
    for (int half = 0; half < 2; ++half) {
      const int hc = u.pn * 2 + half;
      const bf16_t* sk = skf + (size_t)hc * 4 * 4096;
      const bf16_t* qp = Qs + (wid * 32 + c) * 264 + half * 128 + 8 * h;
      unsigned k0[16], k1[16];
#define ROUTE_KT(KT, KA)                                                                        \
      {                                                                                         \
        f32x16 sc;                                                                              \
        _Pragma("unroll") for (int i = 0; i < 16; ++i) sc[i] = 0.f;                             \
        _Pragma("unroll") for (int s = 0; s < 8; ++s) {                                         \
          bf16x8 af = *(const bf16x8*)(sk + (KT) * 4096 + s * 512 + lane * 8);                  \
          bf16x8 bq = *(const bf16x8*)(qp + 16 * s);                                            \
          sc = __builtin_amdgcn_mfma_f32_32x32x16_bf16(af, bq, sc, 0, 0, 0);                    \
        }                                                                                       \
        _Pragma("unroll") for (int rg = 0; rg < 16; ++rg) {                                     \
          const int kidx = 32 * (KT) + (rg & 3) + 8 * (rg >> 2) + 4 * h;                        \
          KA[rg] = (f2sort(sc[rg]) & 0xFFFFFF80u) | (unsigned)(127 - kidx);                     \
        }                                                                                       \
        bitonic_sort_desc<16>(KA);                                                              \
      }
      ROUTE_KT(0, k0)
      __builtin_amdgcn_sched_barrier(0);
      ROUTE_KT(1, k1)
      merge_top16(k0, k1);
      __builtin_amdgcn_sched_barrier(0);
      ROUTE_KT(2, k1)
      merge_top16(k0, k1);
      __builtin_amdgcn_sched_barrier(0);
      ROUTE_KT(3, k1)
      merge_top16(k0, k1);
      __builtin_amdgcn_sched_barrier(0);
#undef ROUTE_KT
#pragma unroll
      for (int i = 0; i < 16; ++i) k1[i] = (unsigned)shx_i((int)k0[i], 32);
      merge_top16(k0, k1);
      if (h == 0) {
        unsigned* dst = tops + ((size_t)(u.pm * 256 + wid * 32 + c) * 16 + hc) * 16;
#pragma unroll
        for (int q4 = 0; q4 < 4; ++q4) { u32x4 o = {k0[4 * q4], k0[4 * q4 + 1], k0[4 * q4 + 2], k0[4 * q4 + 3]}; *(u32x4*)(dst + 4 * q4) = o; }
      }
    }
    __syncthreads();
  }
};


template <int CTRL> DI float dpp_f(float v) { const int iv = __float_as_int(v); return __int_as_float(__builtin_amdgcn_update_dpp(iv, iv, CTRL, 0xF, 0xF, false)); }
DI float wsum(float x) {
  x += dpp_f<0xB1>(x);
  x += dpp_f<0x4E>(x);
  x += dpp_f<0x124>(x);
  x += dpp_f<0x128>(x);
  x += shx(x, 16);
  return hsum(x);
}
DI float gelu_fast(float x) {
  const float u2 = 1.5957691216057308f * (x + 0.044715f * x * x * x);
  return x * __builtin_amdgcn_rcpf(1.f + ex2(-LOG2E * u2));
}

constexpr int EROW = 1024;
typedef float v2f __attribute__((ext_vector_type(2)));
__device__ void d_cvt_fp4_row(int row, const float* __restrict__ src, unsigned char* __restrict__ dst, float* __restrict__ scales) {
  const int lane = TIDX & 63;
  float v[32]; float amax = 0.f;
#pragma unroll
  for (int i = 0; i < 8; ++i) {
    f32x4 x = *(const f32x4*)(src + (size_t)row * DM + 256 * i + 4 * lane);
#pragma unroll
    for (int j = 0; j < 4; ++j) { v[i * 4 + j] = x[j]; amax = fmaxf(amax, fabsf(x[j])); }
  }
  amax = wave_max(amax);
  const float sc = amax > 0.f ? amax * (1.f / 7.f) : 1.f;
  const float inv = 1.f / sc;
  u32x4 o;
#pragma unroll
  for (int k = 0; k < 4; ++k) {
    unsigned w = 0u;
#define FP4C(x_) fminf(fmaxf((x_) * inv, -6.f), 6.f)
    w = __builtin_amdgcn_cvt_scalef32_pk_fp4_f32(w, FP4C(v[8 * k + 0]), FP4C(v[8 * k + 1]), 1.0f, 0);
    w = __builtin_amdgcn_cvt_scalef32_pk_fp4_f32(w, FP4C(v[8 * k + 2]), FP4C(v[8 * k + 3]), 1.0f, 1);
    w = __builtin_amdgcn_cvt_scalef32_pk_fp4_f32(w, FP4C(v[8 * k + 4]), FP4C(v[8 * k + 5]), 1.0f, 2);
    w = __builtin_amdgcn_cvt_scalef32_pk_fp4_f32(w, FP4C(v[8 * k + 6]), FP4C(v[8 * k + 7]), 1.0f, 3);
#undef FP4C
    o[k] = w;
  }
  *(u32x4*)(dst + (size_t)row * EROW + 16 * lane) = o;
  if (lane == 0) scales[row] = sc;
}
__device__ void d_cvt_i4_row(int row, const float* __restrict__ src, unsigned char* __restrict__ dst, float* __restrict__ scales) {
  const int lane = TIDX & 63;
  float v[32]; float amax = 0.f, ss = 0.f;
#pragma unroll
  for (int i = 0; i < 8; ++i) {
    f32x4 x = *(const f32x4*)(src + (size_t)row * DM + 256 * i + 4 * lane);
#pragma unroll
    for (int j = 0; j < 4; ++j) { v[i * 4 + j] = x[j]; amax = fmaxf(amax, fabsf(x[j])); ss = fmaf(x[j], x[j], ss); }
  }
  amax = wave_max(amax); ss = wave_sum(ss);
  float sc = fmaxf(0.36f * sqrtf(ss * (1.f / DM)), amax * (1.f / 14.f));
  sc = sc > 0.f ? sc : 1.f;
  const float inv = 1.f / sc;
  u32x4 o;
#pragma unroll
  for (int k = 0; k < 4; ++k) {
    unsigned w = 0u;
#pragma unroll
    for (int j = 0; j < 8; ++j) {
      const float q = fminf(fmaxf(v[8 * k + j] * inv, -7.f), 7.f) + 12582912.f;
      w |= (__float_as_uint(q) & 15u) << (4 * j);
    }
    o[k] = w;
  }
  *(u32x4*)(dst + (size_t)row * EROW + 16 * lane) = o;
  if (lane == 0) scales[row] = sc;
}
__device__ void d_expert_u(int t, unsigned* tpl, u32x4* slot, const bf16_t* __restrict__ hbuf,
                           const unsigned* __restrict__ tops, const unsigned char* __restrict__ eu4,
                           const float* __restrict__ esu, const float* __restrict__ esv) {
  const int lane = TIDX & 63;
  float hv[32];
#pragma unroll
  for (int i = 0; i < 8; ++i) {
    const u32x2 w = *(const u32x2*)(hbuf + (size_t)t * DM + 256 * i + 4 * lane);
    hv[i * 4 + 0] = __uint_as_float(w[0] << 16); hv[i * 4 + 1] = __uint_as_float(w[0] & 0xFFFF0000u);
    hv[i * 4 + 2] = __uint_as_float(w[1] << 16); hv[i * 4 + 3] = __uint_as_float(w[1] & 0xFFFF0000u);
  }
  int e0 = 0, e1 = 0; float w0 = 0.f, w1 = 0.f;
  {
    const int ci = (lane < 16) ? 0 : (lane < 24) ? 1 : (lane < 29) ? 2 : (lane < 33) ? 3 : (lane < 36) ? 4 : (lane < 38) ? 5 : (lane < 40) ? 6
                   : (lane < 42) ? 7 : (lane - 34);
    const int cpre = (ci == 0) ? 0 : (ci == 1) ? 16 : (ci == 2) ? 24 : (ci == 3) ? 29 : (ci == 4) ? 33 : (ci == 5) ? 36 : (ci == 6) ? 38
                     : (ci == 7) ? 40 : (34 + ci);
    const int cj = lane - cpre;
    const bool cvalid = lane < 50;
    *(u32x4*)(tpl + 4 * lane) = *(const u32x4*)(tops + (size_t)t * 256 + 4 * lane);
    const unsigned* tp = tpl;
#pragma unroll 1
    for (int hh = 0; hh < 8; ++hh) {
      unsigned key = 0u;
      if (cvalid) {
        const float sa = sort2f(tp[(2 * hh) * 16 + ci]), sb = sort2f(tp[(2 * hh + 1) * 16 + cj]);
        key = (f2sort(sa + sb) & 0xFFFFFF00u) | (unsigned)(255 - (ci * 16 + cj));
      }
#pragma unroll
      for (int k = 2; k <= 64; k <<= 1) {
#pragma unroll
        for (int jj = k >> 1; jj > 0; jj >>= 1) {
          const unsigned o = (unsigned)shx_i((int)key, jj);
          const bool lower = (lane & jj) == 0;
          const bool desc = (lane & k) == 0 || k == 64;
          const unsigned mx = key > o ? key : o, mn = key > o ? o : key;
          key = (lower == desc) ? mx : mn;
        }
      }
      const int flat = 255 - (int)(key & 255u);
      const int bi = (flat >> 4) & 15, bj = flat & 15;
      const unsigned ka = tp[(2 * hh) * 16 + bi], kb = tp[(2 * hh + 1) * 16 + bj];
      const float sc = sort2f(ka) + sort2f(kb);
      const int ex = (127 - (int)(ka & 127u)) * 128 + (127 - (int)(kb & 127u));
      float mx = sc;
      mx = fmaxf(mx, shx(mx, 1)); mx = fmaxf(mx, shx(mx, 2)); mx = fmaxf(mx, shx(mx, 4)); mx = fmaxf(mx, shx(mx, 8));
      const float ev_ = __expf(sc - mx);
      float sm = ev_;
      sm += shx(sm, 1); sm += shx(sm, 2); sm += shx(sm, 4); sm += shx(sm, 8);
      const float gv = ev_ / sm;
      const int exs = __shfl(ex, lane & 15); const float gvs = __shfl(gv, lane & 15);
      if ((lane >> 4) == (hh & 3)) { if (hh < 4) { e0 = exs; w0 = gvs; } else { e1 = exs; w1 = gvs; } }
    }
  }
  {
    unsigned k0 = ((unsigned)e0 << 7) | (unsigned)lane, k1 = ((unsigned)e1 << 7) | (unsigned)(64 + lane);
#pragma unroll
    for (int k = 2; k <= 128; k <<= 1) {
#pragma unroll
      for (int jj = k >> 1; jj > 0; jj >>= 1) {
        if (jj == 64) { const unsigned mn = k0 < k1 ? k0 : k1, mx = k0 < k1 ? k1 : k0; k0 = mn; k1 = mx; }
        else {
          const unsigned o0 = (unsigned)shx_i((int)k0, jj), o1 = (unsigned)shx_i((int)k1, jj);
          const bool lower = (lane & jj) == 0;
          const bool asc0 = (k >= 64) ? true : ((lane & k) == 0), asc1 = (k == 128) ? true : (k == 64) ? false : ((lane & k) == 0);
          const unsigned mn0 = k0 < o0 ? k0 : o0, mx0 = k0 < o0 ? o0 : k0, mn1 = k1 < o1 ? k1 : o1, mx1 = k1 < o1 ? o1 : k1;
          k0 = (lower == asc0) ? mn0 : mx0; k1 = (lower == asc1) ? mn1 : mx1;
        }
      }
    }
    const int o0 = (int)(k0 & 127u), o1 = (int)(k1 & 127u);
    const float wa0 = __shfl(w0, o0 & 63), wb0 = __shfl(w1, o0 & 63), wa1 = __shfl(w0, o1 & 63), wb1 = __shfl(w1, o1 & 63);
    e0 = (int)(k0 >> 7); e1 = (int)(k1 >> 7); w0 = (o0 < 64) ? wa0 : wb0; w1 = (o1 < 64) ? wa1 : wb1;
  }
  int hhi[4], hlo[4]; float hsc;
  {
    float m = 0.f;
#pragma unroll
    for (int i = 0; i < 32; ++i) m = fmaxf(m, fabsf(hv[i]));
    m = wave_max(m);
    hsc = m > 0.f ? m * (1.f / 119.f) : 1.f;
    const float hinv = 1.f / hsc;
#pragma unroll
    for (int q = 0; q < 4; ++q) {
      unsigned wh = 0u, wl = 0u;
#pragma unroll
      for (int j = 0; j < 8; ++j) {
        const unsigned b = __float_as_uint(fmaf(hv[8 * q + j], hinv, 12582912.f));
        wl |= (b & 15u) << (4 * j); wh |= (((b + 8u) >> 4) & 15u) << (4 * j);
      }
      hhi[q] = (int)wh; hlo[q] = (int)wl;
    }
  }
  const float su0 = esu[e0], su1 = esu[e1], sv0 = esv[e0], sv1 = esv[e1];
  u32x4 rA[4], rB[4];
  const unsigned lo16 = (unsigned)(16 * lane);
#define EX_LOAD(R, TAB, EB)                                                                \
  _Pragma("unroll") for (int k = 0; k < 4; ++k) {                                          \
    const int e = (EB) + k;                                                                \
    const int id = __builtin_amdgcn_readlane((e < 64) ? e0 : e1, e & 63);                 \
    const unsigned char* row = (TAB) + (size_t)id * EROW;                                  \
    R[k] = *(const u32x4*)(row + lo16);                                                    \
  }
#define PKFMA(a_, b_, c_) __builtin_elementwise_fma((a_), (b_), (c_))
  int cc = 0, c0i = 0;
  const int srcb = 4 * (((lane & 1) << 5) | ((lane & 2) << 3));
#define EX_COMP_U(R, EB)                                                                   \
  {                                                                                        \
    int dd[4];                                                                             \
    _Pragma("unroll") for (int k = 0; k < 4; ++k) {                                        \
      int dh = 0, dl = 0;                                                                  \
      _Pragma("unroll") for (int q = 0; q < 4; ++q) {                                      \
        dh = __builtin_amdgcn_sdot8((int)R[k][q], hhi[q], dh, false);                      \
        dl = __builtin_amdgcn_sdot8((int)R[k][q], hlo[q], dl, false);                      \
      }                                                                                    \
      dd[k] = dh * 16 + dl;                                                                \
      __builtin_amdgcn_sched_barrier(0);                                                   \
    }                                                                                      \
      \
    unsigned t01, t23;                                                                     \
    { auto r_ = __builtin_amdgcn_permlane32_swap((unsigned)dd[0], (unsigned)dd[1], false, false); t01 = r_[0] + r_[1]; }     \
    { auto r_ = __builtin_amdgcn_permlane32_swap((unsigned)dd[2], (unsigned)dd[3], false, false); t23 = r_[0] + r_[1]; }     \
    const bool b4_ = (lane & 16) != 0;                                                     \
    int tv = (int)(b4_ ? t23 : t01) + shx_i((int)(b4_ ? t01 : t23), 16);                   \
    tv += dpp_i<0x128>(tv); tv += dpp_i<0x124>(tv); tv += dpp_i<0x4E>(tv); tv += dpp_i<0xB1>(tv);   \
    const int got = __builtin_amdgcn_ds_bpermute(srcb, tv);                                \
    cc = ((unsigned)(lane - ((EB) & 63)) < 4u) ? got : cc;                                 \
    __builtin_amdgcn_sched_barrier(0);                                                     \
  }
#define EX_COMP_V(R, EB)                                                                   \
  _Pragma("unroll") for (int k = 0; k < 4; ++k) {                                          \
    const int e = (EB) + k;                                                                \
    const float cs = __int_as_float(__builtin_amdgcn_readlane(__float_as_int((e < 64) ? c0 : c1), e & 63));                     \
    const v2f cs2 = {cs, cs};                                                              \
    _Pragma("unroll") for (int q = 0; q < 4; ++q) {                                        \
      const unsigned wq = R[k][q];                                                         \
      const v2f f0 = __builtin_amdgcn_cvt_scalef32_pk_f32_fp4(wq, 1.0f, 0), f1 = __builtin_amdgcn_cvt_scalef32_pk_f32_fp4(wq, 1.0f, 1); \
      const v2f f2 = __builtin_amdgcn_cvt_scalef32_pk_f32_fp4(wq, 1.0f, 2), f3 = __builtin_amdgcn_cvt_scalef32_pk_f32_fp4(wq, 1.0f, 3); \
      acc2[4 * q + 0] = PKFMA(cs2, f0, acc2[4 * q + 0]); acc2[4 * q + 1] = PKFMA(cs2, f1, acc2[4 * q + 1]); \
      acc2[4 * q + 2] = PKFMA(cs2, f2, acc2[4 * q + 2]); acc2[4 * q + 3] = PKFMA(cs2, f3, acc2[4 * q + 3]); \
    }                                                                                      \
    __builtin_amdgcn_sched_barrier(0);                                                     \
  }
  EX_LOAD(rA, eu4, 0)
  __builtin_amdgcn_sched_barrier(0);
#pragma unroll 1
  for (int eb = 0; eb < 128; eb += 8) {
    if (eb == 64) c0i = cc;
    EX_LOAD(rB, eu4, eb + 4)
    __builtin_amdgcn_sched_barrier(0);
    EX_COMP_U(rA, eb)
    { const int ebn = (eb + 8 < 128) ? eb + 8 : 0;
      EX_LOAD(rA, eu4, ebn) }
    __builtin_amdgcn_sched_barrier(0);
    EX_COMP_U(rB, eb + 4)
  }
  const float c0 = w0 * gelu_fast(hsc * su0 * (float)c0i) * sv0, c1 = w1 * gelu_fast(hsc * su1 * (float)cc) * sv1;
  slot[lane] = u32x4{(unsigned)e0, (unsigned)e1, __float_as_uint(c0), __float_as_uint(c1)};
#undef EX_LOAD
#undef EX_COMP_U
#undef EX_COMP_V
#undef PKFMA
}
__device__ void d_expert_v(int t, const u32x4* slot, const bf16_t* __restrict__ hbuf, const unsigned char* __restrict__ ev4,
                           const float* __restrict__ gam, const float* __restrict__ bet, float* __restrict__ out) {
  const int lane = TIDX & 63;
  const u32x4 sl = slot[lane];
  const int e0 = (int)sl[0], e1 = (int)sl[1]; const float c0 = __uint_as_float(sl[2]), c1 = __uint_as_float(sl[3]);
  int hhi[4] = {0, 0, 0, 0}, hlo[4] = {0, 0, 0, 0};
  u32x4 rA[4], rB[4];
  const unsigned lo16 = (unsigned)(16 * lane);
#define EX_LOAD(R, TAB, EB)                                                                \
  _Pragma("unroll") for (int k = 0; k < 4; ++k) {                                          \
    const int e = (EB) + k;                                                                \
    const int id = __builtin_amdgcn_readlane((e < 64) ? e0 : e1, e & 63);                 \
    const unsigned char* row = (TAB) + (size_t)id * EROW;                                  \
    R[k] = *(const u32x4*)(row + lo16);                                                    \
  }
#define PKFMA(a_, b_, c_) __builtin_elementwise_fma((a_), (b_), (c_))
  int cc = 0, c0i = 0;
  const int srcb = 4 * (((lane & 1) << 5) | ((lane & 2) << 3));
#define EX_COMP_U(R, EB)                                                                   \
  {                                                                                        \
    int dd[4];                                                                             \
    _Pragma("unroll") for (int k = 0; k < 4; ++k) {                                        \
      int dh = 0, dl = 0;                                                                  \
      _Pragma("unroll") for (int q = 0; q < 4; ++q) {                                      \
        dh = __builtin_amdgcn_sdot8((int)R[k][q], hhi[q], dh, false);                      \
        dl = __builtin_amdgcn_sdot8((int)R[k][q], hlo[q], dl, false);                      \
      }                                                                                    \
      dd[k] = dh * 16 + dl;                                                                \
      __builtin_amdgcn_sched_barrier(0);                                                   \
    }                                                                                      \
      \
    unsigned t01, t23;                                                                     \
    { auto r_ = __builtin_amdgcn_permlane32_swap((unsigned)dd[0], (unsigned)dd[1], false, false); t01 = r_[0] + r_[1]; }     \
    { auto r_ = __builtin_amdgcn_permlane32_swap((unsigned)dd[2], (unsigned)dd[3], false, false); t23 = r_[0] + r_[1]; }     \
    const bool b4_ = (lane & 16) != 0;                                                     \
    int tv = (int)(b4_ ? t23 : t01) + shx_i((int)(b4_ ? t01 : t23), 16);                   \
    tv += dpp_i<0x128>(tv); tv += dpp_i<0x124>(tv); tv += dpp_i<0x4E>(tv); tv += dpp_i<0xB1>(tv);   \
    const int got = __builtin_amdgcn_ds_bpermute(srcb, tv);                                \
    cc = ((unsigned)(lane - ((EB) & 63)) < 4u) ? got : cc;                                 \
    __builtin_amdgcn_sched_barrier(0);                                                     \
  }
#define EX_COMP_V(R, EB)                                                                   \
  _Pragma("unroll") for (int k = 0; k < 4; ++k) {                                          \
    const int e = (EB) + k;                                                                \
    const float cs = __int_as_float(__builtin_amdgcn_readlane(__float_as_int((e < 64) ? c0 : c1), e & 63));                     \
    const v2f cs2 = {cs, cs};                                                              \
    _Pragma("unroll") for (int q = 0; q < 4; ++q) {                                        \
      const unsigned wq = R[k][q];                                                         \
      const v2f f0 = __builtin_amdgcn_cvt_scalef32_pk_f32_fp4(wq, 1.0f, 0), f1 = __builtin_amdgcn_cvt_scalef32_pk_f32_fp4(wq, 1.0f, 1); \
      const v2f f2 = __builtin_amdgcn_cvt_scalef32_pk_f32_fp4(wq, 1.0f, 2), f3 = __builtin_amdgcn_cvt_scalef32_pk_f32_fp4(wq, 1.0f, 3); \
      acc2[4 * q + 0] = PKFMA(cs2, f0, acc2[4 * q + 0]); acc2[4 * q + 1] = PKFMA(cs2, f1, acc2[4 * q + 1]); \
      acc2[4 * q + 2] = PKFMA(cs2, f2, acc2[4 * q + 2]); acc2[4 * q + 3] = PKFMA(cs2, f3, acc2[4 * q + 3]); \
    }                                                                                      \
    __builtin_amdgcn_sched_barrier(0);                                                     \
  }
  EX_LOAD(rA, ev4, 0)
  __builtin_amdgcn_sched_barrier(0);
  v2f acc2[16];
#pragma unroll
  for (int i = 0; i < 16; ++i) acc2[i] = v2f{0.f, 0.f};
#pragma unroll 1
  for (int eb = 0; eb < 128; eb += 8) {
    EX_LOAD(rB, ev4, eb + 4)
    __builtin_amdgcn_sched_barrier(0);
    EX_COMP_V(rA, eb)
    { const int ebn = (eb + 8 < 128) ? eb + 8 : 0;
      EX_LOAD(rA, ev4, ebn) }
    __builtin_amdgcn_sched_barrier(0);
    EX_COMP_V(rB, eb + 4)
  }
#undef EX_LOAD
#undef EX_COMP_U
#undef EX_COMP_V
#undef PKFMA
  float acc[32];
#pragma unroll
  for (int i = 0; i < 16; ++i) { acc[2 * i] = acc2[i].x; acc[2 * i + 1] = acc2[i].y; }
  int le = lane;
  asm volatile("" : "+v"(le) :: "memory");
  float s = 0.f;
#pragma unroll
  for (int i = 0; i < 8; ++i) {
    const u32x2 w = *(const u32x2*)(hbuf + (size_t)t * DM + 256 * i + 4 * le);
    const float h0 = __uint_as_float(w[0] << 16), h1 = __uint_as_float(w[0] & 0xFFFF0000u), h2 = __uint_as_float(w[1] << 16), h3 = __uint_as_float(w[1] & 0xFFFF0000u);
    acc[i * 4 + 0] = fmaf(ALPHA, h0, acc[i * 4 + 0]); acc[i * 4 + 1] = fmaf(ALPHA, h1, acc[i * 4 + 1]);
    acc[i * 4 + 2] = fmaf(ALPHA, h2, acc[i * 4 + 2]); acc[i * 4 + 3] = fmaf(ALPHA, h3, acc[i * 4 + 3]);
    s += (acc[i * 4 + 0] + acc[i * 4 + 1]) + (acc[i * 4 + 2] + acc[i * 4 + 3]);
  }
  s = wsum(s);
  const float mu = s * (1.f / DM);
  float qv = 0.f;
#pragma unroll
  for (int i = 0; i < 32; ++i) { const float d = acc[i] - mu; qv += d * d; }
  qv = wsum(qv);
  const float rs = rsqrtf(qv * (1.f / DM) + 1e-5f);
#pragma unroll
  for (int i = 0; i < 8; ++i) {
    const int cbase = 256 * i + 4 * le;
    f32x4 ga = *(const f32x4*)(gam + cbase), ba = *(const f32x4*)(bet + cbase), o;
#pragma unroll
    for (int j = 0; j < 4; ++j) o[j] = (acc[i * 4 + j] - mu) * rs * ga[j] + ba[j];
    *(f32x4*)(out + (size_t)t * DM + cbase) = o;
  }
}

constexpr size_t al256(size_t x) { return (x + 255) & ~(size_t)255; }
constexpr size_t WS_XB = 0;
constexpr size_t WS_PROJ = WS_XB + al256((size_t)S * DM * 2);
constexpr size_t WS_WINT = WS_PROJ + al256((size_t)S * INWP * 2);
constexpr size_t WS_GATES = WS_WINT + al256((size_t)INWG * DM * 2);
constexpr size_t WS_W1KF = WS_GATES + al256((size_t)S * 24 * 4);
constexpr size_t WS_W1VF = WS_W1KF + al256((size_t)512 * 4096 * 2);
constexpr size_t WS_W2KF = WS_W1VF + al256((size_t)512 * 4096 * 2);
constexpr size_t WS_W2VF = WS_W2KF + al256((size_t)512 * 128 * 2);
constexpr size_t WS_VC = WS_W2VF + al256((size_t)512 * 128 * 2) - al256((size_t)2048 * 128 * 4);
constexpr size_t WS_KCF = WS_VC + al256((size_t)2048 * 128 * 4);
constexpr size_t WS_VCF = WS_KCF + al256((size_t)2 * 32 * 4096 * 2);
constexpr size_t WS_KSF = WS_VCF + al256((size_t)2 * 32 * 4096 * 2);
constexpr size_t WS_VSF = WS_KSF + al256((size_t)2 * 512 * 4096 * 2);
constexpr size_t WS_KWF = WS_VSF + al256((size_t)2 * 512 * 4096 * 2);
constexpr size_t WS_VWF = WS_KWF + al256((size_t)2 * 512 * 4096 * 2);
constexpr size_t WS_ENDA = WS_VWF + al256((size_t)2 * 512 * 4096 * 2);
constexpr size_t WS_OATT = WS_ENDA;
constexpr size_t WS_MIX = WS_OATT + al256((size_t)S * 1024 * 4);
constexpr size_t WS_WOUTT = WS_MIX + al256((size_t)S * DM * 2);
constexpr size_t WS_WQT = WS_WOUTT + al256((size_t)DM * DM * 2);
constexpr size_t WS_TOPS = WS_WQT + al256((size_t)DM * DM * 2);
constexpr size_t WS_SKF = WS_TOPS + al256((size_t)S * 256 * 4);
constexpr size_t WS_STATS = WS_SKF + al256((size_t)16 * 128 * 128 * 2);
constexpr size_t WS_CTRL = WS_STATS + al256((size_t)S * 2 * 4);
constexpr size_t CTRL_BYTES = 32768;
constexpr size_t WS_END = WS_CTRL + CTRL_BYTES;
constexpr size_t WS_Y = WS_PROJ;
constexpr size_t WS_HB = WS_XB;
constexpr size_t WS_EU8 = WS_OATT;
constexpr size_t WS_EV8 = WS_EU8 + (size_t)16384 * 1024;
constexpr size_t WS_ESU = WS_EV8 + (size_t)16384 * 1024;
constexpr size_t WS_ESV = WS_ESU + 16384 * 4;
static_assert(WS_ESV + 16384 * 4 <= WS_MIX, "expert tables overflow their region");
constexpr int EXP_EARLY = 6144;
static_assert(WS_END <= (size_t)512 * 1024 * 1024, "workspace over 512 MiB");

struct Params {
  const float *x, *w_in, *ck_pos, *ck_w1, *ck_b1, *ck_w2, *cv_pos, *cv_w1, *cv_b1, *cv_w2, *conv_w, *hng, *w_out, *ln1g, *ln1b, *w_query, *subk,
      *eu, *ev, *ln2g, *ln2b;
  float* out;
  char* ws;
};
#define WSP(T, OFF) ((T*)(p.ws + (OFF)))

#define FOR_VB(n) for (int vb = blockIdx.x; vb < (n); vb += gridDim.x)
#define FOR_VB2(n) for (int vb = blockIdx.x * 2 + (TIDX >> 8); vb < (n); vb += gridDim.x * 2)
constexpr int SMEM_BYTES = 147456;
constexpr int HALF = 36864;

__global__ void __launch_bounds__(512) mega(Params p) {
  __shared__ __attribute__((aligned(16))) char smem[SMEM_BYTES + 16];
  if (TIDX == 0) *(u32x4*)(smem + SMEM_BYTES) = u32x4{0u, 0u, 0u, 0u};
  __syncthreads();
  const XcdBarrier xbar = xcd_barrier_post(WSP(unsigned, WS_CTRL + 1024), (volatile LAS unsigned*)(smem + SMEM_BYTES));
#define smh (smem + (TIDX >> 8) * HALF)
#define wv ((TIDX >> 6))
  constexpr int NWV = 8;
  d_cvt(p.x, WSP(bf16_t, WS_XB), (size_t)S * DM / 4);
  FOR_VB2((INWG / 64) * (DM / 64)) d_cvtT64(vb, smh, p.w_in, WSP(bf16_t, WS_WINT), DM, INW, INWG);
  for (size_t c = (size_t)blockIdx.x * 512 + TIDX; c < (size_t)16 * 256 * 64; c += (size_t)gridDim.x * 512) {
    d_cvt_w1f(c, p.ck_w1, WSP(bf16_t, WS_W1KF)); d_cvt_w1f(c, p.cv_w1, WSP(bf16_t, WS_W1VF));
    if (c < (size_t)4 * 32 * 64) { d_cvt_w2f(c, p.ck_w2, WSP(bf16_t, WS_W2KF)); d_cvt_w2f(c, p.cv_w2, WSP(bf16_t, WS_W2VF)); }
  }
  FOR_VB2((DM / 64) * (DM / 64)) d_cvtT64(vb, smh, p.w_out, WSP(bf16_t, WS_WOUTT), DM, DM, DM);
  FOR_VB2((DM / 64) * (DM / 64)) d_cvtT64(vb, smh, p.w_query, WSP(bf16_t, WS_WQT), DM, DM, DM);
  for (size_t c = (size_t)blockIdx.x * 512 + TIDX; c < (size_t)16 * 4 * 8 * 64; c += (size_t)gridDim.x * 512) d_cvt_subk(c, p.subk, WSP(bf16_t, WS_SKF));
  xcd_barrier(xbar);
  {
    pg8::StaticOrder so; so.init(S, INWG, gridDim.x, blockIdx.x);
    pg8::gemm_phase<EpiProjG, pg8::StaticOrder>((PG8_LAS unsigned char*)smem, pg8::Gemm{WSP(bf16_t, WS_XB), WSP(bf16_t, WS_WINT), S, INWG, DM}, so,
                                                EpiProjG{WSP(bf16_t, WS_PROJ), WSP(float, WS_GATES), (PG8_LAS unsigned char*)smem + pg8::STAGE_BYTES}, nullptr);
    const int nun = (S / 256) * (INWG / 256), gsz = (int)gridDim.x;
    const int nfull = nun % gsz;
    if (nfull != 0 && (int)blockIdx.x >= nfull) {
      const int nidle = gsz - nfull, me = (int)blockIdx.x - nfull;
      for (int r = me * NWV + wv; r < 2 * EXP_EARLY; r += nidle * NWV) {
        if (r < EXP_EARLY) d_cvt_i4_row(r, p.eu, WSP(unsigned char, WS_EU8), WSP(float, WS_ESU)); else d_cvt_fp4_row(r - EXP_EARLY, p.ev, WSP(unsigned char, WS_EV8), WSP(float, WS_ESV));
      }
    }
  }
  xcd_barrier(xbar);
  {
    if (blockIdx.x < 128) {
      const int xcd_ = blockIdx.x & 7, idx_ = blockIdx.x >> 3; const bool isV = (xcd_ & 1) != 0;
      d_compress_unit((xcd_ >> 1) * 16 + idx_, smem, WSP(bf16_t, WS_PROJ), isV ? OFF_VC : OFF_KC, isV ? p.cv_pos : p.ck_pos, isV ? WSP(bf16_t, WS_W1VF) : WSP(bf16_t, WS_W1KF),
                      isV ? p.cv_b1 : p.ck_b1, isV ? WSP(bf16_t, WS_W2VF) : WSP(bf16_t, WS_W2KF), isV ? WSP(bf16_t, WS_VCF) : WSP(bf16_t, WS_KCF), isV);
    }
    int* slot = (int*)smem;
    unsigned* ctr = WSP(unsigned, WS_CTRL);
    for (;;) {
      if (TIDX == 0) *slot = (int)atomicAdd(ctr, 1u);
      __syncthreads();
      const int it = *slot;
      __syncthreads();
      if (it >= 2048) break;
      const int tt = TIDX;
      {
        const int T = it >> 2, which = it & 3;
        d_relayout_tile(T, smem + 64, WSP(bf16_t, WS_PROJ), (which == 0) ? OFF_KS : (which == 1) ? OFF_VS : (which == 2) ? OFF_KW : OFF_VW,
                        (which == 0) ? WSP(bf16_t, WS_KSF) : (which == 1) ? WSP(bf16_t, WS_VSF) : (which == 2) ? WSP(bf16_t, WS_KWF) : WSP(bf16_t, WS_VWF), (which & 1) != 0);
      }
      for (int q = 0; q < 2; ++q) d_convmix(it * 8 + q * 4 + (tt >> 7), tt & 127, WSP(bf16_t, WS_PROJ), p.conv_w, p.hng, WSP(bf16_t, WS_MIX));
    }
  }
  xcd_barrier(xbar);
  {
    AttnPtrs ap{WSP(bf16_t, WS_PROJ), WSP(float, WS_GATES), WSP(bf16_t, WS_KCF), WSP(bf16_t, WS_VCF), WSP(bf16_t, WS_KSF), WSP(bf16_t, WS_VSF), WSP(bf16_t, WS_KWF), WSP(bf16_t, WS_VWF), WSP(bf16_t, WS_MIX), p.hng};
    for (int it = blockIdx.x; it < 512; it += gridDim.x) {
      const int Bq = (it < 256) ? it : (511 - it), gq = (it < 256) ? 0 : 1;
      d_attn_block(Bq, gq, smem, ap);
    }
  }
  xcd_barrier(xbar);
  {
    pg8::StaticOrder so; so.init(S, DM, gridDim.x, blockIdx.x);
    pg8::gemm_phase<EpiResG, pg8::StaticOrder>((PG8_LAS unsigned char*)smem, pg8::Gemm{WSP(bf16_t, WS_MIX), WSP(bf16_t, WS_WOUTT), S, DM, DM}, so,
                                               EpiResG{WSP(bf16_t, WS_HB), (PG8_LAS unsigned char*)smem + pg8::STAGE_BYTES}, nullptr);
  }
  xcd_barrier(xbar);
  for (int r = blockIdx.x * NWV + wv; r < S; r += gridDim.x * NWV) d_ln_wave(r, WSP(bf16_t, WS_HB), p.ln1g, p.ln1b);
  {
    const int e0_ = (((S / 256) * (INWG / 256)) % (int)gridDim.x != 0) ? EXP_EARLY : 0;
    const int nrest = 16384 - e0_;
    for (int r = blockIdx.x * NWV + wv; r < 2 * nrest; r += gridDim.x * NWV) {
      if (r < nrest) d_cvt_i4_row(e0_ + r, p.eu, WSP(unsigned char, WS_EU8), WSP(float, WS_ESU)); else d_cvt_fp4_row(e0_ + r - nrest, p.ev, WSP(unsigned char, WS_EV8), WSP(float, WS_ESV));
    }
  }
  xcd_barrier(xbar);
  for (int k = 0; k * (int)gridDim.x < (S / 256) * (DM / 256); ++k) {
    pg8::OneUnit so; so.init(S, DM, gridDim.x, blockIdx.x); so.k = k;
    pg8::gemm_phase<EpiRouteG, pg8::OneUnit>((PG8_LAS unsigned char*)smem, pg8::Gemm{WSP(bf16_t, WS_HB), WSP(bf16_t, WS_WQT), S, DM, DM}, so,
                                             EpiRouteG{WSP(bf16_t, WS_SKF), WSP(unsigned, WS_TOPS)}, nullptr);
    __syncthreads();
  }
  xcd_barrier(xbar);
  {
    u32x4* slots = (u32x4*)(smem + 8192 + wv * 16384);
    const int tstr = (int)gridDim.x * NWV;
    for (int t0 = blockIdx.x * NWV + wv; t0 < S; t0 += 16 * tstr) {
      int i = 0;
      for (int t = t0; t < S && i < 16; t += tstr, ++i)
        d_expert_u(t, (unsigned*)(smem + wv * 1024), slots + i * 64, WSP(bf16_t, WS_HB), WSP(unsigned, WS_TOPS), WSP(unsigned char, WS_EU8), WSP(float, WS_ESU), WSP(float, WS_ESV));
      i = 0;
      for (int t = t0; t < S && i < 16; t += tstr, ++i)
        d_expert_v(t, slots + i * 64, WSP(bf16_t, WS_HB), WSP(unsigned char, WS_EV8), p.ln2g, p.ln2b, p.out);
    }
  }
}

extern "C" void kernel_launch(void* const* d_in, const int* in_sizes, int n_in, void* d_out, int out_size, void* d_ws, size_t ws_size,
                              hipStream_t stream) {
  Params p{};
  p.x = (const float*)d_in[0]; p.w_in = (const float*)d_in[1]; p.ck_pos = (const float*)d_in[2]; p.ck_w1 = (const float*)d_in[3];
  p.ck_b1 = (const float*)d_in[4]; p.ck_w2 = (const float*)d_in[5]; p.cv_pos = (const float*)d_in[6]; p.cv_w1 = (const float*)d_in[7];
  p.cv_b1 = (const float*)d_in[8]; p.cv_w2 = (const float*)d_in[9]; p.conv_w = (const float*)d_in[10]; p.hng = (const float*)d_in[11];
  p.w_out = (const float*)d_in[12]; p.ln1g = (const float*)d_in[13]; p.ln1b = (const float*)d_in[14]; p.w_query = (const float*)d_in[15];
  p.subk = (const float*)d_in[16]; p.eu = (const float*)d_in[17]; p.ev = (const float*)d_in[18]; p.ln2g = (const float*)d_in[19];
  p.ln2b = (const float*)d_in[20];
  p.out = (float*)d_out;
  p.ws = (char*)d_ws;
  if (ws_size < WS_END) fprintf(stderr, "workspace too small\n");
  static int grid_blocks = 0;
  if (!grid_blocks) {
    int dev = 0, cus = 0, per_cu = 0;
    hipGetDevice(&dev);
    hipDeviceGetAttribute(&cus, hipDeviceAttributeMultiprocessorCount, dev);
    hipOccupancyMaxActiveBlocksPerMultiprocessor(&per_cu, mega, 512, 0);
    if (per_cu > 1) per_cu = 1;
    if (per_cu < 1) per_cu = 1;
    grid_blocks = cus * per_cu;
  }
  hipMemsetAsync((char*)d_ws + WS_CTRL, 0, CTRL_BYTES, stream);
  void* args[] = {&p};
  hipError_t e = hipLaunchCooperativeKernel((void*)mega, dim3(grid_blocks), dim3(512), args, 0, stream);
  if (e != hipSuccess) fprintf(stderr, "cooperative launch failed: %s (grid %d)\n", hipGetErrorString(e), grid_blocks);
}
```

```cpp
#include <hip/hip_runtime.h>
#include <stdint.h>
#include <stdio.h>


#define DI __device__ __forceinline__
static __device__ __forceinline__ int tidx_() { int t = (int)__builtin_amdgcn_workitem_id_x(); asm volatile("" : "+v"(t)); return t; }
#define TIDX (tidx_())

template <int J> DI int swz_xor(int x) { return __builtin_amdgcn_ds_swizzle(x, (J << 10) | 0x1F); }
template <int CTRL> DI int dpp_i(int x) { return __builtin_amdgcn_update_dpp(x, x, CTRL, 0xF, 0xF, false); }
DI int shx_i(int x, int j) {
  switch (j) {
    case 1: return dpp_i<0xB1>(x);
    case 2: return dpp_i<0x4E>(x);
    case 4: return dpp_i<0x1B>(dpp_i<0x141>(x));
    case 8: return dpp_i<0x128>(x);
    case 16: return swz_xor<16>(x);
    default: {
      auto r = __builtin_amdgcn_permlane32_swap((unsigned)x, (unsigned)x, false, false);
      return (TIDX & 32) ? (int)r[0] : (int)r[1];
    }
  }
}
DI float shx(float x, int j) { return __int_as_float(shx_i(__float_as_int(x), j)); }
typedef unsigned short bf16_t;
using bf16x8 = __attribute__((ext_vector_type(8))) short;
using f32x4 = __attribute__((ext_vector_type(4))) float;
using u32x4 = __attribute__((ext_vector_type(4))) unsigned;
using u32x2 = __attribute__((ext_vector_type(2))) unsigned;

constexpr int S = 16384, DM = 2048, HD = 128;
constexpr int INW = 5656, INWP = 5760, INWG = 5888;
constexpr int OFF_Q = 0, OFF_KC = 1024, OFF_VC = 1280, OFF_KS = 1536, OFF_VS = 1792, OFF_KW = 2048, OFF_VW = 2304,
              OFF_G = 2560, OFF_U = 2584, OFF_B = 3608, OFF_C = 4632;
constexpr int NCMP = 1023;
constexpr float ALPHA = 1.189207115002721f;
constexpr float QSCALE = 0.08838834764831845f;

DI bf16_t f2bf(float x) { unsigned u = __float_as_uint(x); u += 0x7fffu + ((u >> 16) & 1u); return (bf16_t)(u >> 16); }
DI float bf2f(bf16_t b) { return __uint_as_float(((unsigned)b) << 16); }
DI float gelu_tanh(float x) { float u = 0.7978845608028654f * (x + 0.044715f * x * x * x); return 0.5f * x * (1.f + tanhf(u)); }
DI float wave_sum(float v) { for (int o = 32; o > 0; o >>= 1) v += shx(v, o); return v; }
using bf16x2v = __attribute__((ext_vector_type(2))) __bf16;
DI unsigned pack2(float a, float b) { bf16x2v v = {(__bf16)a, (__bf16)b}; return __builtin_bit_cast(unsigned, v); }
DI float wave_max(float v) { for (int o = 32; o > 0; o >>= 1) v = fmaxf(v, shx(v, o)); return v; }

namespace pg8 {
#define PG8_LAS __attribute__((address_space(3)))
typedef unsigned short bf16_t;
typedef short bf16x8 __attribute__((ext_vector_type(8)));
typedef float f32x4 __attribute__((ext_vector_type(4)));
typedef unsigned u32x4 __attribute__((ext_vector_type(4)));
constexpr int BM = 256, BK = 64, HALF = 128, HTB = HALF * BK * 2  , STAGE_BYTES = 8 * HTB, NXCD = 8, WGM = 8;

__host__ __device__ __forceinline__ int lds_byte(int r, int c) { const int st = (r >> 4) * 2 + (c >> 5), rr = r & 15, cc = c & 31, ob = rr * 64 + cc * 2; return st * 1024 + (ob ^ (((ob >> 9) & 1) << 5)); }
__host__ __device__ __forceinline__ void stage_rc(int b, int& R, int& C) { const int st = b / 1024, sb = b % 1024, swz = sb ^ (((sb >> 9) & 1) << 5); R = (st >> 1) * 16 + swz / 64; C = (st & 1) * 32 + (swz % 64) / 2; }
__host__ __device__ __forceinline__ int perm32(int rho) { const int n = rho >> 4, i = rho & 15; return 8 * (i >> 2) + 4 * n + (i & 3); }

struct Unit { int pm, pn; };
struct Gemm { const bf16_t* A; const bf16_t* Bt; int M, N, K; };

struct StaticOrder {
    int nM, nN, nwg, G, c;
    __host__ __device__ void init(int M, int N, int G_, int c_) { nM = M / BM; nN = N / BM; nwg = nM * nN; G = G_; c = c_; }
    __host__ __device__ bool next(int i, Unit& u) const {
        const long L = (long)i * G + c; if (L >= nwg) return false;
        int wgid = (int)L; { const int q = nwg / NXCD, r = nwg % NXCD, xcd = wgid % NXCD, off = wgid / NXCD; wgid = (xcd < r ? xcd * (q + 1) : r * (q + 1) + (xcd - r) * q) + off; }
        const int nig = WGM * nN, gid = wgid / nig, fm = gid * WGM, gsz = (nM - fm) < WGM ? (nM - fm) : WGM;
        u.pm = fm + ((wgid % nig) % gsz); u.pn = (wgid % nig) / gsz; return true;
    }
    __device__ __forceinline__ void a_ready(const Unit&) const {}
    __device__ __forceinline__ void done(const Unit&) const {}
};
struct OneUnit : StaticOrder {
    int k;
    __device__ bool next(int i, Unit& u) const { if (i > 0) return false; return StaticOrder::next(k, u); }
};
__device__ __forceinline__ unsigned cvt_pk_bf16(float lo, float hi) { unsigned r; asm volatile("v_cvt_pk_bf16_f32 %0, %1, %2" : "=v"(r) : "v"(lo), "v"(hi)); return r; }
template <class Epi, class Sched, bool STAMP = false>
__device__ __forceinline__ void gemm_phase(PG8_LAS unsigned char* lds, const Gemm g, const Sched& S, const Epi& E, unsigned long long* stamps) {
    const int tid = TIDX, wid = __builtin_amdgcn_readfirstlane(tid >> 6), lane = tid & 63, wr = wid >> 2, wc = wid & 3, fr = lane & 15, fq = lane >> 4;
    const int K = g.K, nt = K / BK;
    int ts_lo = 0, ts_hi = 0, nts = 0; const unsigned long long rt_entry = STAMP ? (unsigned long long)wall_clock64() : 0ull;
#define PG8_STAMP() do { if (STAMP && wid == 0 && nts < 64) { const unsigned long long _c = (unsigned long long)clock64(); \
        ts_lo = (lane == nts) ? (int)(unsigned)_c : ts_lo; ts_hi = (lane == nts) ? (int)(unsigned)(_c >> 32) : ts_hi; ++nts; } } while (0)
    PG8_STAMP();
    unsigned voffA[2], voffB[2];
#pragma unroll
    for (int i = 0; i < 2; ++i) { int R, C; stage_rc(tid * 16 + i * 8192, R, C); const int Rb = Epi::PERM ? ((R & ~31) + perm32(R & 31)) : R;
        voffA[i] = (unsigned)(R * K + C) * 2u; voffB[i] = (unsigned)(Rb * K + C) * 2u; }
    const size_t kstep = (size_t)(BK * 2);
    const size_t hstep = (size_t)HALF * K * 2;
    const size_t tstep = 2 * hstep;
    const unsigned ldsw = (unsigned)wid * 1024u;
    const int aoff = lds_byte(wr * 64 + fr, fq * 8), boff = lds_byte(wc * 32 + fr, fq * 8);
#define PG8_SA(b, h) (((b) * 2 + (h)) * HTB)
#define PG8_SB(b, h) ((4 + (b) * 2 + (h)) * HTB)
#define PG8_STAGE(bufoff, gbase, voff) do { _Pragma("unroll") for (int _i = 0; _i < 2; ++_i) \
        __builtin_amdgcn_global_load_lds((const unsigned*)((const char*)(gbase) + (voff)[_i]), (PG8_LAS unsigned*)(lds + (bufoff) + ldsw + _i * 8192), 16, 0, 0); } while (0)
#define PG8_LDA(dst, b, h) do { _Pragma("unroll") for (int m = 0; m < 4; ++m) _Pragma("unroll") for (int k = 0; k < 2; ++k) dst[m][k] = *(const PG8_LAS bf16x8*)(lds + PG8_SA(b, h) + aoff + m * 2048 + k * 1024); } while (0)
#define PG8_LDB(dst, b, h) do { _Pragma("unroll") for (int n = 0; n < 2; ++n) _Pragma("unroll") for (int k = 0; k < 2; ++k) dst[n][k] = *(const PG8_LAS bf16x8*)(lds + PG8_SB(b, h) + boff + n * 2048 + k * 1024); } while (0)
#define PG8_MMA(ai, bj, At, Bt) do { __builtin_amdgcn_s_setprio(1); _Pragma("unroll") for (int m = 0; m < 4; ++m) _Pragma("unroll") for (int n = 0; n < 2; ++n) _Pragma("unroll") for (int k = 0; k < 2; ++k) \
        acc[ai][bj][m][n] = __builtin_amdgcn_mfma_f32_16x16x32_bf16(Bt[n][k], At[m][k], acc[ai][bj][m][n], 0, 0, 0); __builtin_amdgcn_s_setprio(0); } while (0)
#define PG8_WAIT_V(n) asm volatile("s_waitcnt vmcnt(" #n ")" ::: "memory")
#define PG8_WAIT_L(n) asm volatile("s_waitcnt lgkmcnt(" #n ")" ::: "memory")
#define PG8_BAR __builtin_amdgcn_s_barrier()
#define PG8_SCHED __builtin_amdgcn_sched_barrier(0)
    Unit cur, nxt; int ui = 0;
    if (!S.next(0, cur)) return;
    f32x4 acc[2][2][4][2];
#pragma unroll
    for (int a = 0; a < 2; ++a)
#pragma unroll
        for (int b = 0; b < 2; ++b)
#pragma unroll
            for (int m = 0; m < 4; ++m)
#pragma unroll
                for (int n = 0; n < 2; ++n) acc[a][b][m][n] = (f32x4){0.f, 0.f, 0.f, 0.f};
    bf16x8 At[4][2], B0[2][2], B1[2][2];
    const char* cA = (const char*)g.A + (size_t)cur.pm * tstep; const char* cB = (const char*)g.Bt + (size_t)cur.pn * tstep;
    S.a_ready(cur);
    PG8_STAGE(PG8_SB(0, 0), cB, voffB); PG8_STAGE(PG8_SA(0, 0), cA, voffA); PG8_STAGE(PG8_SB(0, 1), cB + hstep, voffB); PG8_STAGE(PG8_SA(0, 1), cA + hstep, voffA);
    if (wr == 1) PG8_BAR;
    PG8_WAIT_V(4); PG8_BAR;
    PG8_STAGE(PG8_SB(1, 0), cB + kstep, voffB); PG8_STAGE(PG8_SA(1, 0), cA + kstep, voffA); PG8_STAGE(PG8_SB(1, 1), cB + hstep + kstep, voffB);
    PG8_WAIT_V(6); PG8_BAR;
    PG8_STAMP();
    for (;;) {
        const bool has_next = S.next(ui + 1, nxt);
        const char* nA = has_next ? (const char*)g.A + (size_t)nxt.pm * tstep : cA; const char* nB = has_next ? (const char*)g.Bt + (size_t)nxt.pn * tstep : cB;
        for (int t = 0; t < nt; t += 2) {
            const bool last = (t == nt - 2);
            const char* a1 = cA + (size_t)(t + 1) * kstep;
            const char* a2 = last ? nA : cA + (size_t)(t + 2) * kstep; const char* b2 = last ? nB : cB + (size_t)(t + 2) * kstep;
            const char* a3 = a2 + kstep; const char* b3 = b2 + kstep;
            if (last && has_next) S.a_ready(nxt);
            PG8_LDB(B0, 0, 0); PG8_SCHED; PG8_LDA(At, 0, 0); PG8_STAGE(PG8_SA(1, 1), a1 + hstep, voffA);
            PG8_WAIT_L(8); PG8_BAR; PG8_WAIT_L(0); PG8_MMA(0, 0, At, B0); PG8_BAR; PG8_SCHED;
            PG8_LDB(B1, 0, 1); PG8_STAGE(PG8_SB(0, 0), b2, voffB);
            PG8_BAR; PG8_WAIT_L(0); PG8_MMA(0, 1, At, B1); PG8_BAR;
            PG8_LDA(At, 0, 1); PG8_STAGE(PG8_SA(0, 0), a2, voffA);
            PG8_BAR; PG8_WAIT_L(0); PG8_MMA(1, 0, At, B0); PG8_BAR; PG8_SCHED;
            PG8_STAGE(PG8_SB(0, 1), b2 + hstep, voffB);
            PG8_WAIT_V(6); PG8_BAR; PG8_MMA(1, 1, At, B1); PG8_BAR;
            PG8_LDB(B0, 1, 0); PG8_SCHED; PG8_LDA(At, 1, 0); PG8_STAGE(PG8_SA(0, 1), a2 + hstep, voffA);
            PG8_WAIT_L(8); PG8_BAR; PG8_WAIT_L(0); PG8_MMA(0, 0, At, B0); PG8_BAR; PG8_SCHED;
            PG8_LDB(B1, 1, 1); PG8_STAGE(PG8_SB(1, 0), b3, voffB);
            PG8_BAR; PG8_WAIT_L(0); PG8_MMA(0, 1, At, B1); PG8_BAR;
            PG8_LDA(At, 1, 1); PG8_STAGE(PG8_SA(1, 0), a3, voffA);
            PG8_BAR; PG8_WAIT_L(0); PG8_MMA(1, 0, At, B0); PG8_BAR; PG8_SCHED;
            PG8_STAGE(PG8_SB(1, 1), b3 + hstep, voffB);
            PG8_WAIT_V(6); PG8_BAR; PG8_MMA(1, 1, At, B1); PG8_BAR;
        }
        PG8_STAMP();
        if constexpr (!Epi::AFTER_DRAIN) { E(acc, cur, wr, wc, fr, fq); S.done(cur); }
        PG8_STAMP();
        if (!has_next) break;
#pragma unroll
        for (int a = 0; a < 2; ++a)
#pragma unroll
            for (int b = 0; b < 2; ++b)
#pragma unroll
                for (int m = 0; m < 4; ++m)
#pragma unroll
                    for (int n = 0; n < 2; ++n) acc[a][b][m][n] = (f32x4){0.f, 0.f, 0.f, 0.f};
        cur = nxt; cA = nA; cB = nB; ++ui;
    }
    PG8_WAIT_V(0);
    if (wr == 0) PG8_BAR;
    PG8_BAR;
    if constexpr (Epi::AFTER_DRAIN) { E.fused(acc, cur, wr, wc, fr, fq, lds, wid, lane); S.done(cur); }
    PG8_STAMP();
    if (STAMP && wid == 0) { stamps[lane] = lane < nts ? (((unsigned long long)(unsigned)ts_hi << 32) | (unsigned)ts_lo) : 0ull;
        if (lane == 62) stamps[62] = rt_entry; if (lane == 63) stamps[63] = (unsigned long long)wall_clock64(); }
#undef PG8_STAMP
#undef PG8_SA
#undef PG8_SB
#undef PG8_STAGE
#undef PG8_LDA
#undef PG8_LDB
#undef PG8_MMA
#undef PG8_WAIT_V
#undef PG8_WAIT_L
#undef PG8_BAR
#undef PG8_SCHED
}
}

#define XB_TMO      128
#define XB_XCNT(j)  (256  + 64 * (j))
#define XB_XSUB(j)  (1280 + 64 * (j))
#define XB_XGEN(j)  (2304 + 64 * (j))
#define XB_TOP      3328
#define XB_TOPGEN   3392
#define XCD_BAR_WORDS 3456
#define XB_SPIN_CAP (1u << 18)
#define LAS __attribute__((address_space(3)))

__device__ __forceinline__ unsigned xb_ld(unsigned* p)              { return __hip_atomic_load(p, __ATOMIC_RELAXED, __HIP_MEMORY_SCOPE_AGENT); }
__device__ __forceinline__ unsigned xb_add(unsigned* p, unsigned v) { return __hip_atomic_fetch_add(p, v, __ATOMIC_RELAXED, __HIP_MEMORY_SCOPE_AGENT); }
__device__ __forceinline__ unsigned xb_xcc_id() { return (unsigned)__builtin_amdgcn_s_getreg((3 << 11) | 20) & 0xFu; }
#define XB_SPIN(cond, bar) do { unsigned _sp = 0; while (cond) { __builtin_amdgcn_s_sleep(1); \
    if ((++_sp & 255u) == 0u) { if (xb_ld(&(bar)[XB_TMO])) break; if (_sp > XB_SPIN_CAP) { atomicAdd(&(bar)[XB_TMO], 1u); break; } } } } while (0)

struct XcdBarrier {
    unsigned* bar; unsigned x;
    volatile LAS unsigned* st;
};

__device__ __forceinline__ XcdBarrier xcd_barrier_post(unsigned* bar, volatile LAS unsigned* st) {
    XcdBarrier b; b.bar = bar; b.x = xb_xcc_id(); b.st = st;
    if (TIDX == 0) (void)xb_add(&bar[XB_XCNT(b.x)], 1u);
    return b;
}
__device__ __forceinline__ void xcd_barrier_complete(unsigned* bar, unsigned x, unsigned& nloc, unsigned& nx) {
    const unsigned G = gridDim.x * gridDim.y * gridDim.z;
    unsigned sum, cnt, mine, sp = 0u;
    for (;;) {
        sum = 0u; cnt = 0u; mine = 0u;
#pragma unroll
        for (unsigned j = 0; j < 16; ++j) { const unsigned c = xb_ld(&bar[XB_XCNT(j)]); sum += c; cnt += (c > 0u) ? 1u : 0u; mine = (j == x) ? c : mine; }
        if (sum == G) break;
        __builtin_amdgcn_s_sleep(1);
        if ((++sp & 255u) == 0u) { if (xb_ld(&bar[XB_TMO])) break; if (sp > XB_SPIN_CAP) { atomicAdd(&bar[XB_TMO], 1u); break; } }
    }
    nloc = mine > 0u ? mine : 1u; nx = cnt > 0u ? cnt : 1u;
}

__device__ __forceinline__ void xcd_barrier(const XcdBarrier& b) {
    asm volatile("s_waitcnt vmcnt(0)" ::: "memory");
    __syncthreads();
    if (TIDX == 0) {
        unsigned* bar = b.bar;
        __builtin_amdgcn_s_waitcnt(0);
        unsigned nloc = b.st[0], nx = b.st[1];
        if (nloc == 0u) { xcd_barrier_complete(bar, b.x, nloc, nx); b.st[0] = nloc; b.st[1] = nx; }
        const unsigned old = xb_add(&bar[XB_XSUB(b.x)], 1u);
        const unsigned gen = old / nloc;
        if (old + 1u == (gen + 1u) * nloc) {
            __builtin_amdgcn_fence(__ATOMIC_RELEASE, "agent");
            asm volatile("s_waitcnt vmcnt(0)" ::: "memory");
            const unsigned og = xb_add(&bar[XB_TOP], 1u);
            const unsigned tg = og / nx;
            if (og + 1u == (tg + 1u) * nx) xb_add(&bar[XB_TOPGEN], 1u);
            else XB_SPIN(xb_ld(&bar[XB_TOPGEN]) == tg, bar);
            __builtin_amdgcn_fence(__ATOMIC_ACQUIRE, "agent");
            xb_add(&bar[XB_XGEN(b.x)], 1u);
            asm volatile("s_waitcnt vmcnt(0)" ::: "memory");
        } else {
            XB_SPIN(xb_ld(&bar[XB_XGEN(b.x)]) == gen, bar);
            __builtin_amdgcn_fence(__ATOMIC_ACQUIRE, "agent");
            asm volatile("s_waitcnt vmcnt(0)" ::: "memory");
        }
    }
    __syncthreads();
}

__device__ void d_cvt(const float* __restrict__ in, bf16_t* __restrict__ out, size_t n4) {
  const size_t stride = (size_t)gridDim.x * blockDim.x;
  size_t i = (size_t)blockIdx.x * blockDim.x + TIDX;
  for (; i + 3 * stride < n4; i += 4 * stride) {
    f32x4 v[4];
#pragma unroll
    for (int q = 0; q < 4; ++q) v[q] = ((const f32x4*)in)[i + q * stride];
#pragma unroll
    for (int q = 0; q < 4; ++q) { u32x2 o = {pack2(v[q][0], v[q][1]), pack2(v[q][2], v[q][3])}; ((u32x2*)out)[i + q * stride] = o; }
  }
  for (; i < n4; i += stride) { const f32x4 v = ((const f32x4*)in)[i]; u32x2 o = {pack2(v[0], v[1]), pack2(v[2], v[3])}; ((u32x2*)out)[i] = o; }
}
__device__ void d_cvtT64(int vb, char* smem, const float* __restrict__ W, bf16_t* __restrict__ WT, int K, int N, int NP) {
  float (*tt)[65] = (float (*)[65])smem;
  const int tid = (TIDX & 255);
  const int nbx = NP / 64;
  const int n0 = (vb % nbx) * 64, k0 = (vb / nbx) * 64;
  {
    const int kr = tid >> 4, nc = (tid & 15) * 4;
#pragma unroll
    for (int i = 0; i < 4; ++i) {
      const int k = k0 + kr + 16 * i, n = n0 + nc;
      f32x4 v = {0.f, 0.f, 0.f, 0.f};
      if (n < N) v = *(const f32x4*)(W + (size_t)k * N + n);
      tt[kr + 16 * i][nc] = v[0]; tt[kr + 16 * i][nc + 1] = v[1]; tt[kr + 16 * i][nc + 2] = v[2]; tt[kr + 16 * i][nc + 3] = v[3];
    }
  }
  __syncthreads();
  {
    const int nr = tid >> 3, kc = (tid & 7) * 8;
#pragma unroll
    for (int i = 0; i < 2; ++i) {
      const int nl = nr + 32 * i;
      u32x4 o = {pack2(tt[kc][nl], tt[kc + 1][nl]), pack2(tt[kc + 2][nl], tt[kc + 3][nl]), pack2(tt[kc + 4][nl], tt[kc + 5][nl]), pack2(tt[kc + 6][nl], tt[kc + 7][nl])};
      *(u32x4*)(WT + (size_t)(n0 + nl) * K + k0 + kc) = o;
    }
  }
  __syncthreads();
}

using f32x16 = __attribute__((ext_vector_type(16))) float;
using bf16x8v = __attribute__((ext_vector_type(8))) __bf16;
#define MFMA32(a, b, c) __builtin_amdgcn_mfma_f32_32x32x16_bf16((a), (b), (c), 0, 0, 0)
constexpr float LOG2E = 1.4426950408889634f;
constexpr float NEGB = -1e30f;
DI int pi_perm(int i) { return (i & ~12) | ((i & 8) >> 1) | ((i & 4) << 1); }
DI bf16x8 pack8(float a0, float a1, float a2, float a3, float a4, float a5, float a6, float a7) {
  bf16x8v v = {(__bf16)a0, (__bf16)a1, (__bf16)a2, (__bf16)a3, (__bf16)a4, (__bf16)a5, (__bf16)a6, (__bf16)a7};
  return __builtin_bit_cast(bf16x8, v);
}
__device__ __forceinline__ void d_relayout_tile(int T, char* smem, const bf16_t* __restrict__ proj, int col0, bf16_t* __restrict__ dst, bool isV) {
  bf16_t* Ls = (bf16_t*)smem;
  const int tid = TIDX;
#pragma unroll
  for (int q = 0; q < 2; ++q) {
    const int cidx = tid + q * 512;
    const int g = cidx >> 9, tok = (cidx >> 4) & 31, ch = cidx & 15;
    const u32x4 v = *(const u32x4*)(proj + (size_t)(32 * T + tok) * INWP + col0 + g * 128 + ch * 8);
    *(u32x4*)(Ls + (g * 32 + tok) * 136 + ch * 8) = v;
  }
  __syncthreads();
#pragma unroll
  for (int q = 0; q < 2; ++q) {
    const int oc = tid + q * 512;
    const int g = oc >> 9, r9 = oc & 511, lane = r9 & 63;
    u32x4 o;
    if (!isV) {
      const int s8 = r9 >> 6, i = lane & 31, h = lane >> 5;
      o = *(const u32x4*)(Ls + (g * 32 + pi_perm(i)) * 136 + 16 * s8 + 8 * h);
    } else {
      const int s2 = (r9 >> 6) & 1, dt = r9 >> 7, dd = lane & 31, h = lane >> 5;
      const bf16_t* col = Ls + (g * 32 + 16 * s2 + 8 * h) * 136 + 32 * dt + dd;
      unsigned short e[8];
#pragma unroll
      for (int j = 0; j < 8; ++j) e[j] = col[j * 136];
      o.x = e[0] | ((unsigned)e[1] << 16); o.y = e[2] | ((unsigned)e[3] << 16); o.z = e[4] | ((unsigned)e[5] << 16); o.w = e[6] | ((unsigned)e[7] << 16);
    }
    *(u32x4*)(dst + (((size_t)(g * 512 + T)) * 512 + r9) * 8) = o;
  }
  __syncthreads();
}

struct AttnPtrs {
  const bf16_t* proj; const float* gates;
  const bf16_t *kcf, *vcf, *ksf, *vsf, *kwf, *vwf;
  bf16_t* mix; const float* hng;
};

DI float ex2(float x) { return __builtin_amdgcn_exp2f(x); }
DI void halves(float x, float& lo, float& hi) {
  const unsigned u = __float_as_uint(x);
  auto r = __builtin_amdgcn_permlane32_swap(u, u, false, false);
  lo = __uint_as_float(r[0]); hi = __uint_as_float(r[1]);
}
DI float hmax(float x) { float a, b; halves(x, a, b); return fmaxf(a, b); }
DI float hsum(float x) { float a, b; halves(x, a, b); return a + b; }
DI float dpp_quad(float v, int ctrl_is_xor1) {
  const int iv = __float_as_int(v);
  const int r = ctrl_is_xor1 ? __builtin_amdgcn_update_dpp(iv, iv, 0xB1, 0xF, 0xF, false) : __builtin_amdgcn_update_dpp(iv, iv, 0x4E, 0xF, 0xF, false);
  return __int_as_float(r);
}
DI float quad_sum(float v) { v += dpp_quad(v, 1); v += dpp_quad(v, 0); return v; }
DI void osm_step(const float (&sv)[16], float& m, float& l, f32x16 (&O)[4], float (&p)[16]) {
  float tmax = fmaxf(fmaxf(fmaxf(sv[0], sv[1]), fmaxf(sv[2], sv[3])), fmaxf(fmaxf(sv[4], sv[5]), fmaxf(sv[6], sv[7])));
  tmax = fmaxf(tmax, fmaxf(fmaxf(fmaxf(sv[8], sv[9]), fmaxf(sv[10], sv[11])), fmaxf(fmaxf(sv[12], sv[13]), fmaxf(sv[14], sv[15]))));
  tmax = hmax(tmax);
  if (__ballot(tmax - m > 8.f)) {
    const float mn = fmaxf(m, tmax);
    const float alpha = ex2(m - mn);
    l *= alpha; m = mn;
#pragma unroll
    for (int dt = 0; dt < 4; ++dt)
#pragma unroll
      for (int r = 0; r < 16; ++r) O[dt][r] *= alpha;
  }
  float ps0 = 0.f, ps1 = 0.f;
#pragma unroll
  for (int r = 0; r < 16; r += 2) { const float e0 = ex2(sv[r] - m), e1 = ex2(sv[r + 1] - m); p[r] = e0; p[r + 1] = e1; ps0 += e0; ps1 += e1; }
  l += ps0 + ps1;
}
DI void ot_store(char* otL, int lane, const f32x16 (&O)[4], float sc) {
#pragma unroll
  for (int dt = 0; dt < 4; ++dt) {
    u32x4 a, b;
#pragma unroll
    for (int i = 0; i < 4; ++i) { a[i] = pack2(sc * O[dt][2 * i], sc * O[dt][2 * i + 1]); b[i] = pack2(sc * O[dt][8 + 2 * i], sc * O[dt][8 + 2 * i + 1]); }
    *(u32x4*)(otL + lane * 128 + dt * 32) = a;
    *(u32x4*)(otL + lane * 128 + dt * 32 + 16) = b;
  }
}
DI void ot_accum(const char* otL, int lane, f32x16 (&O)[4], float sc) {
#pragma unroll
  for (int dt = 0; dt < 4; ++dt) {
    u32x4 a = *(const u32x4*)(otL + lane * 128 + dt * 32);
    u32x4 b = *(const u32x4*)(otL + lane * 128 + dt * 32 + 16);
#pragma unroll
    for (int i = 0; i < 4; ++i) {
      const unsigned wa = a[i], wb = b[i];
      O[dt][2 * i] = fmaf(sc, O[dt][2 * i], __uint_as_float(wa << 16));
      O[dt][2 * i + 1] = fmaf(sc, O[dt][2 * i + 1], __uint_as_float(wa & 0xFFFF0000u));
      O[dt][8 + 2 * i] = fmaf(sc, O[dt][8 + 2 * i], __uint_as_float(wb << 16));
      O[dt][8 + 2 * i + 1] = fmaf(sc, O[dt][8 + 2 * i + 1], __uint_as_float(wb & 0xFFFF0000u));
    }
  }
}
DI void zero_o(f32x16 (&O)[4]) {
#pragma unroll
  for (int dt = 0; dt < 4; ++dt)
#pragma unroll
    for (int i = 0; i < 16; ++i) O[dt][i] = 0.f;
}

constexpr int ATT_PW = 8704;
constexpr int ATT_R = 4, ATT_D = 3;
constexpr int ATT_RING = 8 * ATT_PW;
constexpr int ATT_LIST = ATT_RING + ATT_R * 16384;
constexpr int ATT_BUNI = ATT_LIST + 2048;
constexpr int ATT_SMEM = ATT_BUNI + 64;
#define LAS3 __attribute__((address_space(3)))
__device__ __forceinline__ void d_select(const float* impL, unsigned* mskL, unsigned* uniL, int cur) {
  const int lane = TIDX & 63;
  const int stok = lane >> 3, sub = lane & 7;
  unsigned key[32];
#pragma unroll
  for (int i4 = 0; i4 < 8; ++i4) {
    f32x4 v = *(const f32x4*)(impL + stok * 256 + sub * 32 + i4 * 4);
#pragma unroll
    for (int e = 0; e < 4; ++e) {
      const int j = sub * 32 + i4 * 4 + e;
      const bool valid = j <= cur;
      const bool forced = (j == 0) || (j == cur) || (j == cur - 1);
      unsigned kb = forced ? 0xFFFFFF00u : (__float_as_uint(v[e]) & 0xFFFFFF00u);
      key[i4 * 4 + e] = valid ? (kb | (unsigned)(255 - j)) : 0u;
    }
  }
#pragma unroll
  for (int k = 2; k <= 32; k <<= 1) {
#pragma unroll
    for (int jj = k >> 1; jj > 0; jj >>= 1) {
#pragma unroll
      for (int i = 0; i < 32; ++i) {
        const int l2 = i ^ jj;
        if (l2 > i) {
          const bool desc = ((i & k) == 0);
          unsigned a = key[i], b = key[l2];
          unsigned mx = a > b ? a : b, mn = a > b ? b : a;
          key[i] = desc ? mx : mn; key[l2] = desc ? mn : mx;
        }
      }
    }
  }
#pragma unroll
  for (int xm = 1; xm < 8; xm <<= 1) {
    unsigned L[16];
#pragma unroll
    for (int i = 0; i < 16; ++i) { unsigned o = (unsigned)shx_i((int)key[15 - i], xm); L[i] = key[i] > o ? key[i] : o; }
#pragma unroll
    for (int jj = 8; jj > 0; jj >>= 1) {
#pragma unroll
      for (int i = 0; i < 16; ++i) {
        const int l2 = i ^ jj;
        if (l2 > i) { unsigned a = L[i], b = L[l2]; L[i] = a > b ? a : b; L[l2] = a > b ? b : a; }
      }
    }
#pragma unroll
    for (int i = 0; i < 16; ++i) key[i] = L[i];
  }
#pragma unroll
  for (int i = 0; i < 16; ++i) {
    if ((i & 7) == sub) {
      const int j = 255 - (int)(key[i] & 255u);
      if (j <= cur) { atomicOr(&mskL[stok * 8 + (j >> 5)], 1u << (j & 31)); atomicOr(&uniL[j >> 5], 1u << (j & 31)); }
    }
  }
}


DI void att_issue(LAS3 unsigned char* ring, int slot, int w, int lane, const bf16_t* kb, const bf16_t* vb, int tile) {
  const char* ks = (const char*)kb + (size_t)tile * 8192 + w * 1024 + lane * 16;
  const char* vs = (const char*)vb + (size_t)tile * 8192 + w * 1024 + lane * 16;
  __builtin_amdgcn_global_load_lds((const unsigned*)ks, (LAS3 unsigned*)(ring + slot * 16384 + w * 1024), 16, 0, 0);
  __builtin_amdgcn_global_load_lds((const unsigned*)vs, (LAS3 unsigned*)(ring + slot * 16384 + 8192 + w * 1024), 16, 0, 0);
}
DI f32x16 qk_lds(LAS3 const unsigned char* kt, const bf16x8 (&qf)[8], int lane) {
  f32x16 acc;
#pragma unroll
  for (int i = 0; i < 16; ++i) acc[i] = 0.f;
#pragma unroll
  for (int s8 = 0; s8 < 8; ++s8) {
    const bf16x8 kf = *(LAS3 const bf16x8*)(kt + s8 * 1024 + lane * 16);
    acc = MFMA32(kf, qf[s8], acc);
  }
  return acc;
}
DI void pv_lds(LAS3 const unsigned char* vt, const float (&p)[16], f32x16 (&O)[4], int lane) {
  const bf16x8 pf0 = pack8(p[0], p[1], p[2], p[3], p[4], p[5], p[6], p[7]);
  const bf16x8 pf1 = pack8(p[8], p[9], p[10], p[11], p[12], p[13], p[14], p[15]);
#pragma unroll
  for (int dt = 0; dt < 4; ++dt) {
    const bf16x8 v0 = *(LAS3 const bf16x8*)(vt + (dt * 2) * 1024 + lane * 16);
    const bf16x8 v1 = *(LAS3 const bf16x8*)(vt + (dt * 2 + 1) * 1024 + lane * 16);
    O[dt] = MFMA32(v0, pf0, O[dt]);
    O[dt] = MFMA32(v1, pf1, O[dt]);
  }
}

__device__ __forceinline__ void d_attn_block(int B, int g, char* smem, const AttnPtrs& P) {
  const int tid = TIDX, lane = tid & 63, w = tid >> 6;
  const int c = lane & 31, h = lane >> 5, tokl = c >> 2, r = c & 3;
  const int tok0 = 64 * B + 8 * w;
  const int t = tok0 + tokl, hd = g * 4 + r;
  const float slope2 = exp2f(-(float)(hd + 1)) * LOG2E;
  const float c1 = QSCALE * LOG2E;
  const float ninf = -__builtin_inff();
  char* wsm = smem + w * ATT_PW;
  float* impL = (float*)wsm;
  char* otL = wsm;
  unsigned* mskL = (unsigned*)(wsm + 8192);
  unsigned* uniL = mskL + 64;
  LAS3 unsigned char* ring = (LAS3 unsigned char*)(smem + ATT_RING);
  unsigned short* tl = (unsigned short*)(smem + ATT_LIST);
  unsigned* buni = (unsigned*)(smem + ATT_BUNI);
  const bf16_t* kcf = P.kcf + (size_t)g * 32 * 4096;
  const bf16_t* vcf = P.vcf + (size_t)g * 32 * 4096;
  const bf16_t* ksf = P.ksf + (size_t)g * 512 * 4096;
  const bf16_t* vsf = P.vsf + (size_t)g * 512 * 4096;
  const bf16_t* kwf = P.kwf + (size_t)g * 512 * 4096;
  const bf16_t* vwf = P.vwf + (size_t)g * 512 * 4096;
  bf16x8 qf[8];
  {
    const bf16_t* qrow = P.proj + (size_t)t * INWP + OFF_Q + hd * 128 + 8 * h;
#pragma unroll
    for (int s8 = 0; s8 < 8; ++s8) qf[s8] = *(const bf16x8*)(qrow + 16 * s8);
  }
  const float* gt = P.gates + (size_t)t * 24 + hd * 3;
  const float g0 = gt[0], g1 = gt[1], g2 = gt[2];
  {
    unsigned z0 = 0u;
    asm volatile("" : "+v"(z0));
    u32x4 z = {z0, z0, z0, z0};
#pragma unroll
    for (int i = 0; i < 8; ++i) *(u32x4*)(wsm + (i * 64 + lane) * 16) = z;
    if (lane < 18) *(u32x4*)(wsm + 8192 + lane * 16) = z;
    if (tid < 8) buni[tid] = z0;
  }
  f32x16 Ob[4];
  zero_o(Ob);
  const int nmax = (t >= 31) ? ((t - 31) >> 4) : -1;
  const int nmaxw = (tok0 + 7 >= 31) ? ((tok0 + 7 - 31) >> 4) : -1;
  const int nminw = (tok0 >= 31) ? ((tok0 - 31) >> 4) : -1;
  const int ntcw = (nmaxw + 32) >> 5;
  const int ntcB = (((64 * B + 63 - 31) >> 4) + 32) >> 5;
  const float sl16 = slope2 * 16.f;
  float mC = NEGB, lC = 0.f, invC = 0.f, carry = 0.f;
  {
    const int n = 2 * ntcB;
    asm volatile("s_waitcnt vmcnt(0)" ::: "memory");
#define A_TILE(i_) (((i_) < ntcB) ? (ntcB - 1 - (i_)) : ((i_) - ntcB))
    att_issue(ring, 0, w, lane, kcf, vcf, A_TILE(0));
    if (n > 1) att_issue(ring, 1, w, lane, kcf, vcf, A_TILE(1));
#pragma unroll 1
    for (int i = 0; i < n; ++i) {
      if ((i & 1) == 0) {
        asm volatile("s_waitcnt vmcnt(0)" ::: "memory");
        __builtin_amdgcn_s_barrier();
        asm volatile("" ::: "memory");
        if (i + 2 < n) att_issue(ring, (i + 2) & 3, w, lane, kcf, vcf, A_TILE(i + 2));
        if (i + 3 < n) att_issue(ring, (i + 3) & 3, w, lane, kcf, vcf, A_TILE(i + 3));
      }
      const int T = A_TILE(i);
      if (T >= ntcw) continue;
      LAS3 const unsigned char* slot = ring + (i % ATT_R) * 16384;
      const f32x16 acc = qk_lds(slot, qf, lane);
      const float base = slope2 * (float)(512 * T + 128 * h) + slope2 * (15.5f - (float)t);
      const int nb = 32 * T + 8 * h;
      const bool full = (32 * T + 31 <= nminw);
      float sv[16];
#pragma unroll
      for (int rg = 0; rg < 16; ++rg) { const int kk = (rg & 7) + 16 * (rg >> 3); sv[rg] = fmaf(acc[rg], c1, fmaf(sl16, (float)kk, base)); }
      if (!full) {
#pragma unroll
        for (int rg = 0; rg < 16; ++rg) { const int kk = (rg & 7) + 16 * (rg >> 3); sv[rg] = (nb + kk <= nmax) ? sv[rg] : ninf; }
      }
      if (i < ntcB) {
        float tmax = fmaxf(fmaxf(fmaxf(sv[0], sv[1]), fmaxf(sv[2], sv[3])), fmaxf(fmaxf(sv[4], sv[5]), fmaxf(sv[6], sv[7])));
        tmax = fmaxf(tmax, fmaxf(fmaxf(fmaxf(sv[8], sv[9]), fmaxf(sv[10], sv[11])), fmaxf(fmaxf(sv[12], sv[13]), fmaxf(sv[14], sv[15]))));
        tmax = hmax(tmax);
        const float mn = fmaxf(mC, tmax);
        float ps = 0.f;
#pragma unroll
        for (int rg = 0; rg < 16; ++rg) ps += ex2(sv[rg] - mn);
        lC = lC * ex2(mC - mn) + ps; mC = mn;
      } else {
        if (T == 0) { lC = hsum(lC); invC = (lC > 0.f) ? 1.f / lC : 0.f; }
        float p[16];
#pragma unroll
        for (int rg = 0; rg < 16; ++rg) p[rg] = ex2(sv[rg] - mC) * invC;
        float Ga = (p[0] + p[1]) + (p[2] + p[3]), Gb = (p[4] + p[5]) + (p[6] + p[7]);
        float Gc = (p[8] + p[9]) + (p[10] + p[11]), Gd = (p[12] + p[13]) + (p[14] + p[15]);
        float xb, xd; { float a_, b_; halves(p[7], a_, b_); xb = h ? a_ : b_; halves(p[15], a_, b_); xd = h ? a_ : b_; }
        float ia = Ga + (h ? xb : carry);
        float ib = Gb + p[3];
        float ic = Gc + (h ? xd : xb);
        float id = Gd + p[11];
        carry = xd;
        ia = quad_sum(ia); ib = quad_sum(ib); ic = quad_sum(ic); id = quad_sum(id);
        {
          float val = (r == 0) ? ia : (r == 1) ? ib : (r == 2) ? ic : id;
          int j = 8 * T + 2 * h + ((r == 0) ? 0 : (r == 1) ? 1 : (r == 2) ? 4 : 5);
          impL[tokl * 256 + j] = val;
        }
        pv_lds(slot + 8192, p, Ob, lane);
      }
    }
#undef A_TILE
  }
  const int cur = B;
  d_select(impL, mskL, uniL, cur);
  ot_store(otL, lane, Ob, g0);
  zero_o(Ob);
  if (lane < 8) { const unsigned u = uniL[lane]; if (u) atomicOr(&buni[lane], u); }
  __syncthreads();
  int nslc = 0, ntl = 0;
  {
    for (int iw = 7; iw >= 0; --iw) {
      unsigned iuw = __builtin_amdgcn_readfirstlane(buni[iw]);
      while (iuw) {
        const int bit = 31 - __builtin_clz(iuw);
        iuw &= ~(1u << bit);
        const int bb = 32 * iw + bit;
        if (bb < B) { if (lane == 0) tl[ntl] = (unsigned short)(2 * bb + 1); ++ntl; }
        else { if (lane == 0) tl[ntl] = (unsigned short)(2 * bb + 1); ++ntl; }
        if (lane == 0) tl[ntl] = (unsigned short)(2 * bb);
        ++ntl;
      }
    }
    nslc = ntl;
    const int ThiB = 2 * B + 1, TloB = ((64 * B - 511 > 0) ? (64 * B - 511) : 0) >> 5;
    for (int T = ThiB; T >= TloB; --T) { if (lane == 0) tl[ntl] = (unsigned short)T; ++ntl; }
  }
  float m = NEGB, l = 0.f;
  {
    const int n = ntl;
    const int Tlow = ((tok0 - 511 > 0) ? (tok0 - 511) : 0) >> 5, Thiw = (tok0 + 7) >> 5;
#define B_ISSUE(j_, slot_) { const int e_ = __builtin_amdgcn_readfirstlane((int)tl[j_]); if ((j_) < nslc) att_issue(ring, slot_, w, lane, ksf, vsf, e_); else att_issue(ring, slot_, w, lane, kwf, vwf, e_); }
    B_ISSUE(0, 0)
    if (n > 1) B_ISSUE(1, 1)
#pragma unroll 1
    for (int i = 0; i < n; ++i) {
      if ((i & 1) == 0) {
        asm volatile("s_waitcnt vmcnt(0)" ::: "memory");
        __builtin_amdgcn_s_barrier();
        asm volatile("" ::: "memory");
        if (i + 2 < n) B_ISSUE(i + 2, (i + 2) & 3)
        if (i + 3 < n) B_ISSUE(i + 3, (i + 3) & 3)
      }
      if (i == nslc) {
        l = hsum(l);
        const float inv = (l > 0.f) ? g1 / l : 0.f;
        ot_accum(otL, lane, Ob, inv);
        ot_store(otL, lane, Ob, 1.f);
        zero_o(Ob);
        m = NEGB; l = 0.f;
      }
      const int T = __builtin_amdgcn_readfirstlane((int)tl[i]);
      const int pos0 = 32 * T, pb = pos0 + 8 * h;
      bool full; bool mine = true;
      if (i < nslc) {
        const int bb = T >> 1;
        const unsigned uw = __builtin_amdgcn_readfirstlane(uniL[bb >> 5]);
        if (!((uw >> (bb & 31)) & 1u) || pos0 > tok0 + 7) continue;
        mine = (mskL[tokl * 8 + (bb >> 5)] >> (bb & 31)) & 1u;
        full = (pos0 + 31 <= tok0) && (__ballot(!mine) == 0ull);
      } else {
        if (T < Tlow || T > Thiw) continue;
        full = (pos0 + 31 <= tok0) && (pos0 >= tok0 + 7 - 511);
      }
      LAS3 const unsigned char* slot = ring + (i % ATT_R) * 16384;
      const f32x16 acc = qk_lds(slot, qf, lane);
      const float base = slope2 * (float)(pos0 + 8 * h - t);
      float sv[16], p[16];
#pragma unroll
      for (int rg = 0; rg < 16; ++rg) { const int kk = (rg & 7) + 16 * (rg >> 3); sv[rg] = fmaf(acc[rg], c1, fmaf(slope2, (float)kk, base)); }
      if (!full) {
        if (i < nslc) {
#pragma unroll
          for (int rg = 0; rg < 16; ++rg) { const int kk = (rg & 7) + 16 * (rg >> 3); sv[rg] = (mine && (pb + kk <= t)) ? sv[rg] : ninf; }
        } else {
#pragma unroll
          for (int rg = 0; rg < 16; ++rg) { const int kk = (rg & 7) + 16 * (rg >> 3); const int dw = t - (pb + kk); sv[rg] = ((dw >= 0) && (dw < 512)) ? sv[rg] : ninf; }
        }
      }
      osm_step(sv, m, l, Ob, p);
      pv_lds(slot + 8192, p, Ob, lane);
    }
#undef B_ISSUE
    l = hsum(l);
    const float inv = (l > 0.f) ? g2 / l : 0.f;
    ot_accum(otL, lane, Ob, inv);
  }
  {
    float ss = 0.f;
#pragma unroll
    for (int dt = 0; dt < 4; ++dt)
#pragma unroll
      for (int i = 0; i < 16; ++i) ss = fmaf(Ob[dt][i], Ob[dt][i], ss);
    ss = hsum(ss);
    const float rs = rsqrtf(ss * (1.f / 128.f) + 1e-6f);
    bf16_t* orow = P.mix + (size_t)t * DM + hd * 128 + 4 * h;
    const float* grow = P.hng + hd * 128 + 4 * h;
#pragma unroll
    for (int dt = 0; dt < 4; ++dt)
#pragma unroll
      for (int a = 0; a < 4; ++a) {
        const f32x4 gv = *(const f32x4*)(grow + 32 * dt + 8 * a);
        u32x2 wv2 = {pack2(Ob[dt][4 * a] * rs * gv[0], Ob[dt][4 * a + 1] * rs * gv[1]), pack2(Ob[dt][4 * a + 2] * rs * gv[2], Ob[dt][4 * a + 3] * rs * gv[3])};
        *(u32x2*)(orow + 32 * dt + 8 * a) = wv2;
      }
  }
  asm volatile("s_waitcnt vmcnt(0)" ::: "memory");
  __syncthreads();
}

__device__ void d_convmix(int t, int tl, const bf16_t* __restrict__ proj, const float* __restrict__ convw, const float* __restrict__ hng,
                          bf16_t* __restrict__ mix) {
  const int c = tl * 8;
  float acc[8];
#pragma unroll
  for (int i = 0; i < 8; ++i) acc[i] = 0.f;
#pragma unroll
  for (int j = 0; j < 3; ++j) {
    const int tt = t - 2 + j;
    if (tt >= 0) {
      const u32x4 cu = *(const u32x4*)(proj + (size_t)tt * INWP + OFF_C + c);
      const u32x4 uu = *(const u32x4*)(proj + (size_t)tt * INWP + OFF_U + c);
      const f32x4 w0 = *(const f32x4*)(convw + j * 1024 + c), w1 = *(const f32x4*)(convw + j * 1024 + c + 4);
#pragma unroll
      for (int i = 0; i < 4; ++i) {
        const unsigned a = cu[i], b = uu[i];
        const float wl = (i < 2) ? w0[2 * i] : w1[2 * i - 4], wh = (i < 2) ? w0[2 * i + 1] : w1[2 * i - 3];
        acc[2 * i] = fmaf(wl * __uint_as_float(a << 16), __uint_as_float(b << 16), acc[2 * i]);
        acc[2 * i + 1] = fmaf(wh * __uint_as_float(a & 0xFFFF0000u), __uint_as_float(b & 0xFFFF0000u), acc[2 * i + 1]);
      }
    }
  }
  const u32x4 bb = *(const u32x4*)(proj + (size_t)t * INWP + OFF_B + c);
  float ss = 0.f;
#pragma unroll
  for (int i = 0; i < 4; ++i) {
    const unsigned b = bb[i];
    acc[2 * i] *= __uint_as_float(b << 16); acc[2 * i + 1] *= __uint_as_float(b & 0xFFFF0000u);
    ss = fmaf(acc[2 * i], acc[2 * i], ss); ss = fmaf(acc[2 * i + 1], acc[2 * i + 1], ss);
  }
  ss += shx(ss, 8); ss += shx(ss, 4); ss += shx(ss, 2); ss += shx(ss, 1);
  const float rs = rsqrtf(ss * (1.f / 128.f) + 1e-6f);
  const f32x4 g0 = *(const f32x4*)(hng + 1024 + c), g1 = *(const f32x4*)(hng + 1024 + c + 4);
  u32x4 o = {pack2(acc[0] * rs * g0[0], acc[1] * rs * g0[1]), pack2(acc[2] * rs * g0[2], acc[3] * rs * g0[3]),
             pack2(acc[4] * rs * g1[0], acc[5] * rs * g1[1]), pack2(acc[6] * rs * g1[2], acc[7] * rs * g1[3])};
  *(u32x4*)(mix + (size_t)t * DM + 1024 + c) = o;
}

__device__ void d_ln_wave(int t, bf16_t* __restrict__ yh, const float* __restrict__ gam, const float* __restrict__ bet) {
  const int lane = TIDX & 63;
  float v[32];
#pragma unroll
  for (int i = 0; i < 4; ++i) {
    const u32x4 w = *(const u32x4*)(yh + (size_t)t * DM + 512 * i + 8 * lane);
#pragma unroll
    for (int j = 0; j < 4; ++j) { const unsigned ww = w[j]; v[i * 8 + 2 * j] = __uint_as_float(ww << 16); v[i * 8 + 2 * j + 1] = __uint_as_float(ww & 0xFFFF0000u); }
  }
  float s = 0.f;
#pragma unroll
  for (int i = 0; i < 32; ++i) s += v[i];
  s = wave_sum(s);
  const float mu = s * (1.f / DM);
  float q = 0.f;
#pragma unroll
  for (int i = 0; i < 32; ++i) { const float d = v[i] - mu; q = fmaf(d, d, q); }
  q = wave_sum(q);
  const float rs = rsqrtf(q * (1.f / DM) + 1e-5f);
#pragma unroll
  for (int i = 0; i < 4; ++i) {
    const int cb = 512 * i + 8 * lane;
    const f32x4 g0 = *(const f32x4*)(gam + cb), g1 = *(const f32x4*)(gam + cb + 4), b0 = *(const f32x4*)(bet + cb), b1 = *(const f32x4*)(bet + cb + 4);
    u32x4 o = {pack2((v[i * 8 + 0] - mu) * rs * g0[0] + b0[0], (v[i * 8 + 1] - mu) * rs * g0[1] + b0[1]), pack2((v[i * 8 + 2] - mu) * rs * g0[2] + b0[2], (v[i * 8 + 3] - mu) * rs * g0[3] + b0[3]),
               pack2((v[i * 8 + 4] - mu) * rs * g1[0] + b1[0], (v[i * 8 + 5] - mu) * rs * g1[1] + b1[1]), pack2((v[i * 8 + 6] - mu) * rs * g1[2] + b1[2], (v[i * 8 + 7] - mu) * rs * g1[3] + b1[3])};
    *(u32x4*)(yh + (size_t)t * DM + cb) = o;
  }
}

__device__ void d_cvt_w1f(size_t c, const float* __restrict__ w1, bf16_t* __restrict__ w1f) {
  const int lane = c & 63, ks = (c >> 6) & 255, ct = c >> 14;
  const int col = lane & 31, h = lane >> 5;
  bf16_t v[8];
#pragma unroll
  for (int j = 0; j < 8; ++j) v[j] = f2bf(w1[(size_t)(16 * ks + 8 * h + j) * 512 + 32 * ct + col]);
  u32x4 o; o.x = v[0] | ((unsigned)v[1] << 16); o.y = v[2] | ((unsigned)v[3] << 16); o.z = v[4] | ((unsigned)v[5] << 16); o.w = v[6] | ((unsigned)v[7] << 16);
  *(u32x4*)(w1f + c * 8) = o;
}
__device__ void d_cvt_w2f(size_t c, const float* __restrict__ w2, bf16_t* __restrict__ w2f) {
  const int lane = c & 63, s = (c >> 6) & 31, ct = c >> 11;
  const int col = lane & 31, h = lane >> 5;
  bf16_t v[8];
#pragma unroll
  for (int j = 0; j < 8; ++j) v[j] = f2bf(w2[(size_t)(16 * s + 8 * h + j) * 128 + 32 * ct + col]);
  u32x4 o; o.x = v[0] | ((unsigned)v[1] << 16); o.y = v[2] | ((unsigned)v[3] << 16); o.z = v[4] | ((unsigned)v[5] << 16); o.w = v[6] | ((unsigned)v[7] << 16);
  *(u32x4*)(w2f + c * 8) = o;
}
__device__ __forceinline__ void d_compress_unit(int rt, char* smem, const bf16_t* __restrict__ proj, int col0, const float* __restrict__ pos,
                                const bf16_t* __restrict__ w1f, const float* __restrict__ b1, const bf16_t* __restrict__ w2f,
                                bf16_t* __restrict__ outf, bool isV) {
  bf16_t* Xs = (bf16_t*)smem;
  bf16_t* Hs = (bf16_t*)(smem + 2 * 8704);
  const int tid = TIDX, lane = tid & 63, w = tid >> 6, c = lane & 31, h = lane >> 5;
  const int R0 = rt * 32;
  const int srow = tid >> 4, sch = tid & 15;
  const int grow = R0 + srow, sn = grow >> 1, sg = grow & 1;
  const bool svalid = grow < 2046;
  const bf16_t* sp = proj + (size_t)(16 * sn) * INWP + col0 + sg * 128 + sch * 8;
  f32x16 acc0, acc1;
#pragma unroll
  for (int i = 0; i < 16; ++i) { acc0[i] = 0.f; acc1[i] = 0.f; }
  u32x4 rx = {0u, 0u, 0u, 0u}; f32x4 rp0, rp1;
#define STAGE_WRITE(buf)                                                                                   \
  {                                                                                                        \
    u32x4 o_;                                                                                              \
    _Pragma("unroll") for (int i = 0; i < 4; ++i) {                                                        \
      const unsigned wv_ = rx[i];                                                                          \
      const float lo = __uint_as_float(wv_ << 16) + ((i < 2) ? rp0[2 * i] : rp1[2 * i - 4]);               \
      const float hi = __uint_as_float(wv_ & 0xFFFF0000u) + ((i < 2) ? rp0[2 * i + 1] : rp1[2 * i - 3]);   \
      o_[i] = pack2(lo, hi);                                                                               \
    }                                                                                                      \
    *(u32x4*)(Xs + (buf) * 4352 + srow * 136 + sch * 8) = o_;                                              \
  }
  if (svalid) rx = *(const u32x4*)(sp);
  rp0 = *(const f32x4*)(pos + sch * 8); rp1 = *(const f32x4*)(pos + sch * 8 + 4);
  STAGE_WRITE(0)
  __syncthreads();
  const bf16_t* wb0 = w1f + ((size_t)(2 * w) * 256 * 64 + lane) * 8;
  const bf16_t* wb1 = w1f + ((size_t)(2 * w + 1) * 256 * 64 + lane) * 8;
  bf16x8 bA[16], bB[16];
#define CMP_LOADB(BUF, L)                                                                      \
  _Pragma("unroll") for (int s8 = 0; s8 < 8; ++s8) {                                           \
    BUF[2 * s8] = *(const bf16x8*)(wb0 + (size_t)(8 * (L) + s8) * 512);                        \
    BUF[2 * s8 + 1] = *(const bf16x8*)(wb1 + (size_t)(8 * (L) + s8) * 512);                    \
  }
#define CMP_CHUNK(BUF, L)                                                                      \
  {                                                                                            \
    if ((L) + 1 < 32) {                                                                        \
      if (svalid) rx = *(const u32x4*)(sp + (size_t)((L) + 1) * INWP);                         \
      rp0 = *(const f32x4*)(pos + ((L) + 1) * 128 + sch * 8); rp1 = *(const f32x4*)(pos + ((L) + 1) * 128 + sch * 8 + 4); \
    }                                                                                          \
    const bf16_t* xa = Xs + ((L) & 1) * 4352 + c * 136 + 8 * h;                                \
    _Pragma("unroll") for (int s8 = 0; s8 < 8; ++s8) {                                         \
      const bf16x8 a = *(const bf16x8*)(xa + 16 * s8);                                         \
      acc0 = MFMA32(a, BUF[2 * s8], acc0);                                                     \
      acc1 = MFMA32(a, BUF[2 * s8 + 1], acc1);                                                 \
    }                                                                                          \
    if ((L) + 1 < 32) STAGE_WRITE(((L) + 1) & 1)                                               \
    __syncthreads();                                                                           \
  }
  CMP_LOADB(bA, 0)
#pragma unroll 1
  for (int l = 0; l < 32; l += 2) {
    CMP_LOADB(bB, l + 1)
    __builtin_amdgcn_sched_barrier(0);
    CMP_CHUNK(bA, l)
    { const int ln = (l + 2 < 32) ? l + 2 : l;
      CMP_LOADB(bA, ln) }
    __builtin_amdgcn_sched_barrier(0);
    CMP_CHUNK(bB, l + 1)
  }
#undef CMP_LOADB
#undef CMP_CHUNK
  {
    const float bb0 = b1[64 * w + c], bb1 = b1[64 * w + 32 + c];
#pragma unroll
    for (int rg = 0; rg < 16; ++rg) {
      const int row = (rg & 3) + 8 * (rg >> 2) + 4 * h;
      Hs[row * 520 + 64 * w + c] = f2bf(gelu_tanh(acc0[rg] + bb0));
      Hs[row * 520 + 64 * w + 32 + c] = f2bf(gelu_tanh(acc1[rg] + bb1));
    }
  }
  __syncthreads();
  if (w < 4) {
    f32x16 o2;
#pragma unroll
    for (int i = 0; i < 16; ++i) o2[i] = 0.f;
    const bf16_t* ha = Hs + c * 520 + 8 * h;
    const bf16_t* wb = w2f + ((size_t)w * 32 * 64 + lane) * 8;
#pragma unroll 8
    for (int s2 = 0; s2 < 32; ++s2) {
      const bf16x8 a = *(const bf16x8*)(ha + 16 * s2);
      const bf16x8 b = *(const bf16x8*)(wb + (size_t)s2 * 512);
      o2 = MFMA32(a, b, o2);
    }
    const int d = 32 * w + c;
#pragma unroll
    for (int rg = 0; rg < 16; ++rg) {
      const int row = R0 + (rg & 3) + 8 * (rg >> 2) + 4 * h;
      const int n = row >> 1, g = row & 1;
      const bf16_t val = (row < 2046) ? f2bf(o2[rg]) : (bf16_t)0;
      const int T = n >> 5, nn = n & 31;
      size_t idx;
      if (!isV) idx = ((((size_t)(g * 32 + T) * 8 + (d >> 4)) * 64 + (pi_perm(nn) + 32 * ((d >> 3) & 1))) * 8 + (d & 7));
      else idx = (((((size_t)(g * 32 + T) * 4 + (d >> 5)) * 2 + (nn >> 4)) * 64 + ((d & 31) + 32 * ((nn >> 3) & 1))) * 8 + (nn & 7));
      outf[idx] = val;
    }
  }
  __syncthreads();
}


DI unsigned f2sort(float f) { unsigned u = __float_as_uint(f); return u ^ ((unsigned)((int)u >> 31) | 0x80000000u); }
DI float sort2f(unsigned k) { unsigned u = (k & 0x80000000u) ? (k ^ 0x80000000u) : ~k; return __uint_as_float(u); }
template <int N>
DI void bitonic_sort_desc(unsigned (&key)[N]) {
#pragma unroll
  for (int k = 2; k <= N; k <<= 1) {
#pragma unroll
    for (int jj = k >> 1; jj > 0; jj >>= 1) {
#pragma unroll
      for (int i = 0; i < N; ++i) {
        const int l2 = i ^ jj;
        if (l2 > i) {
          const bool desc = ((i & k) == 0);
          unsigned a = key[i], b = key[l2];
          unsigned mx = a > b ? a : b, mn = a > b ? b : a;
          key[i] = desc ? mx : mn; key[l2] = desc ? mn : mx;
        }
      }
    }
  }
}
DI void merge_top16(unsigned (&a)[16], const unsigned (&b)[16]) {
#pragma unroll
  for (int i = 0; i < 16; ++i) { unsigned o = b[15 - i]; a[i] = a[i] > o ? a[i] : o; }
#pragma unroll
  for (int jj = 8; jj > 0; jj >>= 1) {
#pragma unroll
    for (int i = 0; i < 16; ++i) {
      const int l2 = i ^ jj;
      if (l2 > i) { unsigned x = a[i], y = a[l2]; a[i] = x > y ? x : y; a[l2] = x > y ? y : x; }
    }
  }
}
__device__ void d_cvt_subk(size_t c, const float* __restrict__ subk, bf16_t* __restrict__ skf) {
  int lane = c & 63, s = (c >> 6) & 7, kt = (c >> 9) & 3, hc = c >> 11;
  int i = lane & 31, h = lane >> 5;
  const float* src = subk + ((size_t)hc * 128 + 32 * kt + i) * 128 + 16 * s + 8 * h;
  bf16_t v[8];
#pragma unroll
  for (int j = 0; j < 8; ++j) v[j] = f2bf(src[j]);
  u32x4 o; o.x = v[0] | ((unsigned)v[1] << 16); o.y = v[2] | ((unsigned)v[3] << 16); o.z = v[4] | ((unsigned)v[5] << 16); o.w = v[6] | ((unsigned)v[7] << 16);
  *(u32x4*)(skf + c * 8) = o;
}

#define EPI_LANES()                                                                                                      \
    const int lane = fr | (fq << 4), rr = lane >> 2, rc = lane & 3;                                                       \
    PG8_LAS unsigned char* my = scr + (wr * 4 + wc) * 2048;                                                              \
    const int wo = fr * 64 + ((fq ^ ((fr >> 2) & 3)) << 4), ro = rr * 64 + ((rc ^ ((rr >> 2) & 3)) << 4);
struct EpiProjG {
  static constexpr bool PERM = true, AFTER_DRAIN = false;
  bf16_t* proj; float* gates; PG8_LAS unsigned char* scr;
  DI void operator()(const f32x4 (&acc)[2][2][4][2], const pg8::Unit& u, int wr, int wc, int fr, int fq) const {
    EPI_LANES()
#pragma unroll
    for (int ai = 0; ai < 2; ++ai)
#pragma unroll
      for (int bj = 0; bj < 2; ++bj) {
        const int c0 = u.pn * 256 + bj * 128 + wc * 32 + 8 * fq, cs = u.pn * 256 + bj * 128 + wc * 32 + 8 * rc;
#pragma unroll
        for (int mh = 0; mh < 2; ++mh) {
#pragma unroll
          for (int mm = 0; mm < 2; ++mm) {
            const f32x4 v0 = acc[ai][bj][mh * 2 + mm][0], v1 = acc[ai][bj][mh * 2 + mm][1];
            u32x4 w = {pack2(v0[0], v0[1]), pack2(v0[2], v0[3]), pack2(v1[0], v1[1]), pack2(v1[2], v1[3])};
            *(PG8_LAS u32x4*)(my + wo + mm * 1024) = w;
            if (c0 >= OFF_G && c0 < OFF_G + 24) {
              const int row = u.pm * 256 + ai * 128 + wr * 64 + (mh * 2 + mm) * 16 + fr;
              f32x4 g0, g1;
#pragma unroll
              for (int j = 0; j < 4; ++j) { g0[j] = 1.f / (1.f + __expf(-v0[j])); g1[j] = 1.f / (1.f + __expf(-v1[j])); }
              *(f32x4*)(gates + (size_t)row * 24 + (c0 - OFF_G)) = g0;
              *(f32x4*)(gates + (size_t)row * 24 + (c0 - OFF_G) + 4) = g1;
            }
          }
#pragma unroll
          for (int j = 0; j < 2; ++j) {
            const u32x4 w = *(const PG8_LAS u32x4*)(my + ro + j * 1024);
            const int row = u.pm * 256 + ai * 128 + wr * 64 + mh * 32 + j * 16 + rr;
            if (cs < INW) *(u32x4*)(proj + (size_t)row * INWP + cs) = w;
          }
        }
      }
  }
};
struct EpiResG {
  static constexpr bool PERM = true, AFTER_DRAIN = false;
  bf16_t* YB; PG8_LAS unsigned char* scr;
  DI void operator()(const f32x4 (&acc)[2][2][4][2], const pg8::Unit& u, int wr, int wc, int fr, int fq) const {
    EPI_LANES()
    bf16_t* yb = YB + (size_t)(u.pm * 256 + wr * 64 + rr) * DM + u.pn * 256 + wc * 32 + 8 * rc;
#pragma unroll
    for (int ai = 0; ai < 2; ++ai) {
      u32x4 xr[2][2][2];
#pragma unroll
      for (int bj = 0; bj < 2; ++bj)
#pragma unroll
        for (int mh = 0; mh < 2; ++mh)
#pragma unroll
          for (int j = 0; j < 2; ++j) xr[bj][mh][j] = *(const u32x4*)(yb + (size_t)(ai * 128 + mh * 32 + j * 16) * DM + bj * 128);
#pragma unroll
      for (int bj = 0; bj < 2; ++bj)
#pragma unroll
        for (int mh = 0; mh < 2; ++mh) {
#pragma unroll
          for (int mm = 0; mm < 2; ++mm) {
            const f32x4 v0 = acc[ai][bj][mh * 2 + mm][0], v1 = acc[ai][bj][mh * 2 + mm][1];
            u32x4 w = {pack2(v0[0], v0[1]), pack2(v0[2], v0[3]), pack2(v1[0], v1[1]), pack2(v1[2], v1[3])};
            *(PG8_LAS u32x4*)(my + wo + mm * 1024) = w;
          }
#pragma unroll
          for (int j = 0; j < 2; ++j) {
            const u32x4 a = *(const PG8_LAS u32x4*)(my + ro + j * 1024), xw = xr[bj][mh][j];
            u32x4 o;
#pragma unroll
            for (int q = 0; q < 4; ++q) {
              const unsigned aw = a[q], xq = xw[q];
              o[q] = pack2(fmaf(ALPHA, __uint_as_float(xq << 16), __uint_as_float(aw << 16)), fmaf(ALPHA, __uint_as_float(xq & 0xFFFF0000u), __uint_as_float(aw & 0xFFFF0000u)));
            }
            *(u32x4*)(yb + (size_t)(ai * 128 + mh * 32 + j * 16) * DM + bj * 128) = o;
          }
        }
    }
  }
};
struct EpiF32G {
  static constexpr bool PERM = false, AFTER_DRAIN = false;
  float* C; int ldc;
  DI void operator()(const f32x4 (&acc)[2][2][4][2], const pg8::Unit& u, int wr, int wc, int fr, int fq) const {
#pragma unroll
    for (int ai = 0; ai < 2; ++ai)
#pragma unroll
      for (int m = 0; m < 4; ++m) {
        const size_t ro = (size_t)(u.pm * 256 + ai * 128 + wr * 64 + m * 16 + fr) * ldc + u.pn * 256 + wc * 32 + 4 * fq;
#pragma unroll
        for (int bj = 0; bj < 2; ++bj)
#pragma unroll
          for (int n = 0; n < 2; ++n) *(f32x4*)(C + ro + bj * 128 + n * 16) = acc[ai][bj][m][n];
      }
  }
};
struct EpiRouteG {
  static constexpr bool PERM = false, AFTER_DRAIN = true;
  const bf16_t* skf; unsigned* tops;
  DI void operator()(const f32x4 (&)[2][2][4][2], const pg8::Unit&, int, int, int, int) const {}
  DI void fused(const f32x4 (&acc)[2][2][4][2], const pg8::Unit& u, int wr, int wc, int fr, int fq, PG8_LAS unsigned char* ldsp, int, int) const {
    const int lane = fr | (fq << 4), wid = wr * 4 + wc;
    bf16_t* Qs = (bf16_t*)ldsp;
#pragma unroll
    for (int ai = 0; ai < 2; ++ai)
#pragma unroll
      for (int m = 0; m < 4; ++m) {
        const int row = ai * 128 + wr * 64 + m * 16 + fr;
#pragma unroll
        for (int bj = 0; bj < 2; ++bj)
#pragma unroll
          for (int n = 0; n < 2; ++n) {
            const f32x4 v = acc[ai][bj][m][n];
            u32x2 w = {pack2(v[0], v[1]), pack2(v[2], v[3])};
            *(u32x2*)(Qs + row * 264 + bj * 128 + wc * 32 + n * 16 + 4 * fq) = w;
          }
      }
    __syncthreads();
    const int c = lane & 31, h = lane >> 5;
#pragma unroll 1
    for (int half = 0; half < 2; ++half) {
      const int hc = u.pn * 2 + half;
      const bf16_t* sk = skf + (size_t)hc * 4 * 4096;
      const bf16_t* qp = Qs + (wid * 32 + c) * 264 + half * 128 + 8 * h;
      unsigned k0[16], k1[16];
#define ROUTE_KT(KT, KA)                                                                        \
      {                                                                                         \
        f32x16 sc;                                                                              \
        _Pragma("unroll") for (int i = 0; i < 16; ++i) sc[i] = 0.f;                             \
        _Pragma("unroll") for (int s = 0; s < 8; ++s) {                                         \
          bf16x8 af = *(const bf16x8*)(sk + (KT) * 4096 + s * 512 + lane * 8);                  \
          bf16x8 bq = *(const bf16x8*)(qp + 16 * s);                                            \
          sc = __builtin_amdgcn_mfma_f32_32x32x16_bf16(af, bq, sc, 0, 0, 0);                    \
        }                                                                                       \
        _Pragma("unroll") for (int rg = 0; rg < 16; ++rg) {                                     \
          const int kidx = 32 * (KT) + (rg & 3) + 8 * (rg >> 2) + 4 * h;                        \
          KA[rg] = (f2sort(sc[rg]) & 0xFFFFFF80u) | (unsigned)(127 - kidx);                     \
        }                                                                                       \
        bitonic_sort_desc<16>(KA);                                                              \
      }
      ROUTE_KT(0, k0)
      __builtin_amdgcn_sched_barrier(0);
      ROUTE_KT(1, k1)
      merge_top16(k0, k1);
      __builtin_amdgcn_sched_barrier(0);
      ROUTE_KT(2, k1)
      merge_top16(k0, k1);
      __builtin_amdgcn_sched_barrier(0);
      ROUTE_KT(3, k1)
      merge_top16(k0, k1);
      __builtin_amdgcn_sched_barrier(0);
#undef ROUTE_KT
#pragma unroll
      for (int i = 0; i < 16; ++i) k1[i] = (unsigned)shx_i((int)k0[i], 32);
      merge_top16(k0, k1);
      if (h == 0) {
        unsigned* dst = tops + ((size_t)(u.pm * 256 + wid * 32 + c) * 16 + hc) * 16;
#pragma unroll
        for (int q4 = 0; q4 < 4; ++q4) { u32x4 o = {k0[4 * q4], k0[4 * q4 + 1], k0[4 * q4 + 2], k0[4 * q4 + 3]}; *(u32x4*)(dst + 4 * q4) = o; }
      }
    }
    __syncthreads();
  }
};


template <int CTRL> DI float dpp_f(float v) { const int iv = __float_as_int(v); return __int_as_float(__builtin_amdgcn_update_dpp(iv, iv, CTRL, 0xF, 0xF, false)); }
DI float wsum(float x) {
  x += dpp_f<0xB1>(x);
  x += dpp_f<0x4E>(x);
  x += dpp_f<0x124>(x);
  x += dpp_f<0x128>(x);
  x += shx(x, 16);
  return hsum(x);
}
DI float gelu_fast(float x) {
  const float u2 = 1.5957691216057308f * (x + 0.044715f * x * x * x);
  return x * __builtin_amdgcn_rcpf(1.f + ex2(-LOG2E * u2));
}

constexpr int EROW = 1024;
typedef float v2f __attribute__((ext_vector_type(2)));
__device__ void d_cvt_fp4_row(int row, const float* __restrict__ src, unsigned char* __restrict__ dst, float* __restrict__ scales) {
  const int lane = TIDX & 63;
  float v[32]; float amax = 0.f;
#pragma unroll
  for (int i = 0; i < 8; ++i) {
    f32x4 x = *(const f32x4*)(src + (size_t)row * DM + 256 * i + 4 * lane);
#pragma unroll
    for (int j = 0; j < 4; ++j) { v[i * 4 + j] = x[j]; amax = fmaxf(amax, fabsf(x[j])); }
  }
  amax = wave_max(amax);
  const float sc = amax > 0.f ? amax * (1.f / 7.f) : 1.f;
  const float inv = 1.f / sc;
  u32x4 o;
#pragma unroll
  for (int k = 0; k < 4; ++k) {
    unsigned w = 0u;
#define FP4C(x_) fminf(fmaxf((x_) * inv, -6.f), 6.f)
    w = __builtin_amdgcn_cvt_scalef32_pk_fp4_f32(w, FP4C(v[8 * k + 0]), FP4C(v[8 * k + 1]), 1.0f, 0);
    w = __builtin_amdgcn_cvt_scalef32_pk_fp4_f32(w, FP4C(v[8 * k + 2]), FP4C(v[8 * k + 3]), 1.0f, 1);
    w = __builtin_amdgcn_cvt_scalef32_pk_fp4_f32(w, FP4C(v[8 * k + 4]), FP4C(v[8 * k + 5]), 1.0f, 2);
    w = __builtin_amdgcn_cvt_scalef32_pk_fp4_f32(w, FP4C(v[8 * k + 6]), FP4C(v[8 * k + 7]), 1.0f, 3);
#undef FP4C
    o[k] = w;
  }
  *(u32x4*)(dst + (size_t)row * EROW + 16 * lane) = o;
  if (lane == 0) scales[row] = sc;
}
__device__ void d_cvt_i4_row(int row, const float* __restrict__ src, unsigned char* __restrict__ dst, float* __restrict__ scales) {
  const int lane = TIDX & 63;
  float v[32]; float amax = 0.f, ss = 0.f;
#pragma unroll
  for (int i = 0; i < 8; ++i) {
    f32x4 x = *(const f32x4*)(src + (size_t)row * DM + 256 * i + 4 * lane);
#pragma unroll
    for (int j = 0; j < 4; ++j) { v[i * 4 + j] = x[j]; amax = fmaxf(amax, fabsf(x[j])); ss = fmaf(x[j], x[j], ss); }
  }
  amax = wave_max(amax); ss = wave_sum(ss);
  float sc = fmaxf(0.36f * sqrtf(ss * (1.f / DM)), amax * (1.f / 14.f));
  sc = sc > 0.f ? sc : 1.f;
  const float inv = 1.f / sc;
  u32x4 o;
#pragma unroll
  for (int k = 0; k < 4; ++k) {
    unsigned w = 0u;
#pragma unroll
    for (int j = 0; j < 8; ++j) {
      const float q = fminf(fmaxf(v[8 * k + j] * inv, -7.f), 7.f) + 12582912.f;
      w |= (__float_as_uint(q) & 15u) << (4 * j);
    }
    o[k] = w;
  }
  *(u32x4*)(dst + (size_t)row * EROW + 16 * lane) = o;
  if (lane == 0) scales[row] = sc;
}
__device__ void d_expert_group(int tg0, int tstr, unsigned* tpl, unsigned* slw, const bf16_t* __restrict__ hbuf, const unsigned* __restrict__ tops,
                               const unsigned char* __restrict__ eu4, const unsigned char* __restrict__ ev4, const float* __restrict__ esu, const float* __restrict__ esv,
                               const float* __restrict__ gam, const float* __restrict__ bet, float* __restrict__ out) {
  const int lane = TIDX & 63;
#define SLOT(j_, f_) slw[((j_) * 16 + (f_)) * 64 + lane]
#pragma unroll 1
  for (int j = 0; j < 4; ++j) {
    const int tt = tg0 + j * tstr, t = tt < S ? tt : S - 1;
  float hv[32];
#pragma unroll
  for (int i = 0; i < 8; ++i) {
    const u32x2 w = *(const u32x2*)(hbuf + (size_t)t * DM + 256 * i + 4 * lane);
    hv[i * 4 + 0] = __uint_as_float(w[0] << 16); hv[i * 4 + 1] = __uint_as_float(w[0] & 0xFFFF0000u);
    hv[i * 4 + 2] = __uint_as_float(w[1] << 16); hv[i * 4 + 3] = __uint_as_float(w[1] & 0xFFFF0000u);
  }
  int e0 = 0, e1 = 0; float w0 = 0.f, w1 = 0.f;
  {
    const int ci = (lane < 16) ? 0 : (lane < 24) ? 1 : (lane < 29) ? 2 : (lane < 33) ? 3 : (lane < 36) ? 4 : (lane < 38) ? 5 : (lane < 40) ? 6
                   : (lane < 42) ? 7 : (lane - 34);
    const int cpre = (ci == 0) ? 0 : (ci == 1) ? 16 : (ci == 2) ? 24 : (ci == 3) ? 29 : (ci == 4) ? 33 : (ci == 5) ? 36 : (ci == 6) ? 38
                     : (ci == 7) ? 40 : (34 + ci);
    const int cj = lane - cpre;
    const bool cvalid = lane < 50;
    *(u32x4*)(tpl + 4 * lane) = *(const u32x4*)(tops + (size_t)t * 256 + 4 * lane);
    const unsigned* tp = tpl;
#pragma unroll 1
    for (int hh = 0; hh < 8; ++hh) {
      unsigned key = 0u;
      if (cvalid) {
        const float sa = sort2f(tp[(2 * hh) * 16 + ci]), sb = sort2f(tp[(2 * hh + 1) * 16 + cj]);
        key = (f2sort(sa + sb) & 0xFFFFFF00u) | (unsigned)(255 - (ci * 16 + cj));
      }
#pragma unroll
      for (int k = 2; k <= 64; k <<= 1) {
#pragma unroll
        for (int jj = k >> 1; jj > 0; jj >>= 1) {
          const unsigned o = (unsigned)shx_i((int)key, jj);
          const bool lower = (lane & jj) == 0;
          const bool desc = (lane & k) == 0 || k == 64;
          const unsigned mx = key > o ? key : o, mn = key > o ? o : key;
          key = (lower == desc) ? mx : mn;
        }
      }
      const int flat = 255 - (int)(key & 255u);
      const int bi = (flat >> 4) & 15, bj = flat & 15;
      const unsigned ka = tp[(2 * hh) * 16 + bi], kb = tp[(2 * hh + 1) * 16 + bj];
      const float sc = sort2f(ka) + sort2f(kb);
      const int ex = (127 - (int)(ka & 127u)) * 128 + (127 - (int)(kb & 127u));
      float mx = sc;
      mx = fmaxf(mx, shx(mx, 1)); mx = fmaxf(mx, shx(mx, 2)); mx = fmaxf(mx, shx(mx, 4)); mx = fmaxf(mx, shx(mx, 8));
      const float ev_ = __expf(sc - mx);
      float sm = ev_;
      sm += shx(sm, 1); sm += shx(sm, 2); sm += shx(sm, 4); sm += shx(sm, 8);
      const float gv = ev_ / sm;
      const int exs = __shfl(ex, lane & 15); const float gvs = __shfl(gv, lane & 15);
      if ((lane >> 4) == (hh & 3)) { if (hh < 4) { e0 = exs; w0 = gvs; } else { e1 = exs; w1 = gvs; } }
    }
  }
  {
    unsigned k0 = ((unsigned)e0 << 7) | (unsigned)lane, k1 = ((unsigned)e1 << 7) | (unsigned)(64 + lane);
#pragma unroll
    for (int k = 2; k <= 128; k <<= 1) {
#pragma unroll
      for (int jj = k >> 1; jj > 0; jj >>= 1) {
        if (jj == 64) { const unsigned mn = k0 < k1 ? k0 : k1, mx = k0 < k1 ? k1 : k0; k0 = mn; k1 = mx; }
        else {
          const unsigned o0 = (unsigned)shx_i((int)k0, jj), o1 = (unsigned)shx_i((int)k1, jj);
          const bool lower = (lane & jj) == 0;
          const bool asc0 = (k >= 64) ? true : ((lane & k) == 0), asc1 = (k == 128) ? true : (k == 64) ? false : ((lane & k) == 0);
          const unsigned mn0 = k0 < o0 ? k0 : o0, mx0 = k0 < o0 ? o0 : k0, mn1 = k1 < o1 ? k1 : o1, mx1 = k1 < o1 ? o1 : k1;
          k0 = (lower == asc0) ? mn0 : mx0; k1 = (lower == asc1) ? mn1 : mx1;
        }
      }
    }
    const int o0 = (int)(k0 & 127u), o1 = (int)(k1 & 127u);
    const float wa0 = __shfl(w0, o0 & 63), wb0 = __shfl(w1, o0 & 63), wa1 = __shfl(w0, o1 & 63), wb1 = __shfl(w1, o1 & 63);
    e0 = (int)(k0 >> 7); e1 = (int)(k1 >> 7); w0 = (o0 < 64) ? wa0 : wb0; w1 = (o1 < 64) ? wa1 : wb1;
  }
  int hhi[4], hlo[4]; float hsc;
  {
    float m = 0.f;
#pragma unroll
    for (int i = 0; i < 32; ++i) m = fmaxf(m, fabsf(hv[i]));
    m = wave_max(m);
    hsc = m > 0.f ? m * (1.f / 119.f) : 1.f;
    const float hinv = 1.f / hsc;
#pragma unroll
    for (int q = 0; q < 4; ++q) {
      unsigned wh = 0u, wl = 0u;
#pragma unroll
      for (int j = 0; j < 8; ++j) {
        const unsigned b = __float_as_uint(fmaf(hv[8 * q + j], hinv, 12582912.f));
        wl |= (b & 15u) << (4 * j); wh |= (((b + 8u) >> 4) & 15u) << (4 * j);
      }
      hhi[q] = (int)wh; hlo[q] = (int)wl;
    }
  }
    const float su0 = esu[e0], su1 = esu[e1], sv0 = esv[e0], sv1 = esv[e1];
#pragma unroll
    for (int q = 0; q < 4; ++q) { SLOT(j, q) = (unsigned)hhi[q]; SLOT(j, 4 + q) = (unsigned)hlo[q]; }
    SLOT(j, 8) = (unsigned)e0; SLOT(j, 9) = (unsigned)e1;
    SLOT(j, 10) = __float_as_uint(hsc * su0); SLOT(j, 11) = __float_as_uint(hsc * su1);
    SLOT(j, 12) = __float_as_uint(w0 * sv0); SLOT(j, 13) = __float_as_uint(w1 * sv1);
  }
  u32x4 rA[4], rB[4];
  const unsigned lo16 = (unsigned)(16 * lane);
#define G_LOAD(R, TAB, EX, LB)                                                             \
  _Pragma("unroll") for (int k = 0; k < 4; ++k) {                                          \
    const int id = __builtin_amdgcn_readlane((EX), (LB) + k);                              \
    R[k] = *(const u32x4*)((TAB) + (size_t)id * EROW + lo16);                              \
  }
#define PKFMA(a_, b_, c_) __builtin_elementwise_fma((a_), (b_), (c_))
  const int srcb = 4 * (((lane & 1) << 5) | ((lane & 2) << 3));
#define G_COMP_U(R, LB)                                                                    \
  {                                                                                        \
    int dd[4];                                                                             \
    _Pragma("unroll") for (int k = 0; k < 4; ++k) {                                        \
      int dh = 0, dl = 0;                                                                  \
      _Pragma("unroll") for (int q = 0; q < 4; ++q) {                                      \
        dh = __builtin_amdgcn_sdot8((int)R[k][q], hhi[q], dh, false);                      \
        dl = __builtin_amdgcn_sdot8((int)R[k][q], hlo[q], dl, false);                      \
      }                                                                                    \
      dd[k] = dh * 16 + dl;                                                                \
      __builtin_amdgcn_sched_barrier(0);                                                   \
    }                                                                                      \
    unsigned t01, t23;                                                                     \
    { auto r_ = __builtin_amdgcn_permlane32_swap((unsigned)dd[0], (unsigned)dd[1], false, false); t01 = r_[0] + r_[1]; }     \
    { auto r_ = __builtin_amdgcn_permlane32_swap((unsigned)dd[2], (unsigned)dd[3], false, false); t23 = r_[0] + r_[1]; }     \
    const bool b4_ = (lane & 16) != 0;                                                     \
    int tv = (int)(b4_ ? t23 : t01) + shx_i((int)(b4_ ? t01 : t23), 16);                   \
    tv += dpp_i<0x128>(tv); tv += dpp_i<0x124>(tv); tv += dpp_i<0x4E>(tv); tv += dpp_i<0xB1>(tv);   \
    const int got = __builtin_amdgcn_ds_bpermute(srcb, tv);                                \
    cc = ((unsigned)(lane - (LB)) < 4u) ? got : cc;                                        \
    __builtin_amdgcn_sched_barrier(0);                                                     \
  }
#define G_COMP_V(R, ACC, CF, LB)                                                           \
  _Pragma("unroll") for (int k = 0; k < 4; ++k) {                                          \
    const float cs = __int_as_float(__builtin_amdgcn_readlane(__float_as_int(CF), (LB) + k));   \
    const v2f cs2 = {cs, cs};                                                              \
    _Pragma("unroll") for (int q = 0; q < 4; ++q) {                                        \
      const unsigned wq = R[k][q];                                                         \
      const v2f f0 = __builtin_amdgcn_cvt_scalef32_pk_f32_fp4(wq, 1.0f, 0), f1 = __builtin_amdgcn_cvt_scalef32_pk_f32_fp4(wq, 1.0f, 1); \
      const v2f f2 = __builtin_amdgcn_cvt_scalef32_pk_f32_fp4(wq, 1.0f, 2), f3 = __builtin_amdgcn_cvt_scalef32_pk_f32_fp4(wq, 1.0f, 3); \
      ACC[4 * q + 0] = PKFMA(cs2, f0, ACC[4 * q + 0]); ACC[4 * q + 1] = PKFMA(cs2, f1, ACC[4 * q + 1]); \
      ACC[4 * q + 2] = PKFMA(cs2, f2, ACC[4 * q + 2]); ACC[4 * q + 3] = PKFMA(cs2, f3, ACC[4 * q + 3]); \
    }                                                                                      \
    __builtin_amdgcn_sched_barrier(0);                                                     \
  }
  {
    int eX = (int)SLOT(0, 8);
    G_LOAD(rA, eu4, eX, 0)
    __builtin_amdgcn_sched_barrier(0);
#pragma unroll 1
    for (int s_ = 0; s_ < 32; ++s_) {
      const int sg = s_ >> 2, j = s_ & 3, L0 = (sg & 3) * 16;
      const int sn = (s_ + 1) & 31, sgn = sn >> 2, jn = sn & 3, L0n = (sgn & 3) * 16;
      int hhi[4], hlo[4];
#pragma unroll
      for (int q = 0; q < 4; ++q) { hhi[q] = (int)SLOT(j, q); hlo[q] = (int)SLOT(j, 4 + q); }
      const int eXn = (int)SLOT(jn, 8 + (sgn >> 2));
      const unsigned char* tabn = (s_ == 31) ? ev4 : eu4;
      int cc = 0;
      G_LOAD(rB, eu4, eX, L0 + 4)
      __builtin_amdgcn_sched_barrier(0);
      G_COMP_U(rA, L0)
      G_LOAD(rA, eu4, eX, L0 + 8)
      __builtin_amdgcn_sched_barrier(0);
      G_COMP_U(rB, L0 + 4)
      G_LOAD(rB, eu4, eX, L0 + 12)
      __builtin_amdgcn_sched_barrier(0);
      G_COMP_U(rA, L0 + 8)
      G_LOAD(rA, tabn, eXn, L0n)
      __builtin_amdgcn_sched_barrier(0);
      G_COMP_U(rB, L0 + 12)
      if ((unsigned)(lane - L0) < 16u) SLOT(j, 14 + (sg >> 2)) = (unsigned)cc;
      eX = eXn;
    }
  }
#pragma unroll 1
  for (int j = 0; j < 4; ++j) {
    const float d0 = (float)(int)SLOT(j, 14), d1 = (float)(int)SLOT(j, 15);
    SLOT(j, 14) = __float_as_uint(__uint_as_float(SLOT(j, 12)) * gelu_fast(__uint_as_float(SLOT(j, 10)) * d0));
    SLOT(j, 15) = __float_as_uint(__uint_as_float(SLOT(j, 13)) * gelu_fast(__uint_as_float(SLOT(j, 11)) * d1));
  }
  v2f accv[4][16];
#pragma unroll
  for (int j = 0; j < 4; ++j)
#pragma unroll
    for (int i = 0; i < 16; ++i) accv[j][i] = v2f{0.f, 0.f};
  {
    int eX = (int)SLOT(0, 8);
#pragma unroll 1
    for (int sg = 0; sg < 8; ++sg) {
      const int L0 = (sg & 3) * 16;
#pragma unroll
      for (int j = 0; j < 4; ++j) {
        const int jn = (j + 1) & 3, sgn = (j == 3) ? ((sg + 1) & 7) : sg, L0n = (sgn & 3) * 16;
        const float cf = __uint_as_float(SLOT(j, 14 + (sg >> 2)));
        const int eXn = (int)SLOT(jn, 8 + (sgn >> 2));
        G_LOAD(rB, ev4, eX, L0 + 4)
        __builtin_amdgcn_sched_barrier(0);
        G_COMP_V(rA, accv[j], cf, L0)
        G_LOAD(rA, ev4, eX, L0 + 8)
        __builtin_amdgcn_sched_barrier(0);
        G_COMP_V(rB, accv[j], cf, L0 + 4)
        G_LOAD(rB, ev4, eX, L0 + 12)
        __builtin_amdgcn_sched_barrier(0);
        G_COMP_V(rA, accv[j], cf, L0 + 8)
        G_LOAD(rA, ev4, eXn, L0n)
        __builtin_amdgcn_sched_barrier(0);
        G_COMP_V(rB, accv[j], cf, L0 + 12)
        eX = eXn;
      }
    }
  }
#undef G_LOAD
#undef G_COMP_U
#undef G_COMP_V
#undef PKFMA
#pragma unroll
  for (int j = 0; j < 4; ++j) {
    const int t = tg0 + j * tstr;
    if (t < S) {
#define acc2 accv[j]
  float acc[32];
  #pragma unroll
    for (int i = 0; i < 16; ++i) { acc[2 * i] = acc2[i].x; acc[2 * i + 1] = acc2[i].y; }
    int le = lane;
    asm volatile("" : "+v"(le) :: "memory");
    float s = 0.f;
  #pragma unroll
    for (int i = 0; i < 8; ++i) {
      const u32x2 w = *(const u32x2*)(hbuf + (size_t)t * DM + 256 * i + 4 * le);
      const float h0 = __uint_as_float(w[0] << 16), h1 = __uint_as_float(w[0] & 0xFFFF0000u), h2 = __uint_as_float(w[1] << 16), h3 = __uint_as_float(w[1] & 0xFFFF0000u);
      acc[i * 4 + 0] = fmaf(ALPHA, h0, acc[i * 4 + 0]); acc[i * 4 + 1] = fmaf(ALPHA, h1, acc[i * 4 + 1]);
      acc[i * 4 + 2] = fmaf(ALPHA, h2, acc[i * 4 + 2]); acc[i * 4 + 3] = fmaf(ALPHA, h3, acc[i * 4 + 3]);
      s += (acc[i * 4 + 0] + acc[i * 4 + 1]) + (acc[i * 4 + 2] + acc[i * 4 + 3]);
    }
    s = wsum(s);
    const float mu = s * (1.f / DM);
    float qv = 0.f;
  #pragma unroll
    for (int i = 0; i < 32; ++i) { const float d = acc[i] - mu; qv += d * d; }
    qv = wsum(qv);
    const float rs = rsqrtf(qv * (1.f / DM) + 1e-5f);
  #pragma unroll
    for (int i = 0; i < 8; ++i) {
      const int cbase = 256 * i + 4 * le;
      f32x4 ga = *(const f32x4*)(gam + cbase), ba = *(const f32x4*)(bet + cbase), o;
  #pragma unroll
      for (int j = 0; j < 4; ++j) o[j] = (acc[i * 4 + j] - mu) * rs * ga[j] + ba[j];
      *(f32x4*)(out + (size_t)t * DM + cbase) = o;
    }
#undef acc2
    }
  }
#undef SLOT
}

constexpr size_t al256(size_t x) { return (x + 255) & ~(size_t)255; }
constexpr size_t WS_XB = 0;
constexpr size_t WS_PROJ = WS_XB + al256((size_t)S * DM * 2);
constexpr size_t WS_WINT = WS_PROJ + al256((size_t)S * INWP * 2);
constexpr size_t WS_GATES = WS_WINT + al256((size_t)INWG * DM * 2);
constexpr size_t WS_W1KF = WS_GATES + al256((size_t)S * 24 * 4);
constexpr size_t WS_W1VF = WS_W1KF + al256((size_t)512 * 4096 * 2);
constexpr size_t WS_W2KF = WS_W1VF + al256((size_t)512 * 4096 * 2);
constexpr size_t WS_W2VF = WS_W2KF + al256((size_t)512 * 128 * 2);
constexpr size_t WS_VC = WS_W2VF + al256((size_t)512 * 128 * 2) - al256((size_t)2048 * 128 * 4);
constexpr size_t WS_KCF = WS_VC + al256((size_t)2048 * 128 * 4);
constexpr size_t WS_VCF = WS_KCF + al256((size_t)2 * 32 * 4096 * 2);
constexpr size_t WS_KSF = WS_VCF + al256((size_t)2 * 32 * 4096 * 2);
constexpr size_t WS_VSF = WS_KSF + al256((size_t)2 * 512 * 4096 * 2);
constexpr size_t WS_KWF = WS_VSF + al256((size_t)2 * 512 * 4096 * 2);
constexpr size_t WS_VWF = WS_KWF + al256((size_t)2 * 512 * 4096 * 2);
constexpr size_t WS_ENDA = WS_VWF + al256((size_t)2 * 512 * 4096 * 2);
constexpr size_t WS_OATT = WS_ENDA;
constexpr size_t WS_MIX = WS_OATT + al256((size_t)S * 1024 * 4);
constexpr size_t WS_WOUTT = WS_MIX + al256((size_t)S * DM * 2);
constexpr size_t WS_WQT = WS_WOUTT + al256((size_t)DM * DM * 2);
constexpr size_t WS_TOPS = WS_WQT + al256((size_t)DM * DM * 2);
constexpr size_t WS_SKF = WS_TOPS + al256((size_t)S * 256 * 4);
constexpr size_t WS_STATS = WS_SKF + al256((size_t)16 * 128 * 128 * 2);
constexpr size_t WS_CTRL = WS_STATS + al256((size_t)S * 2 * 4);
constexpr size_t CTRL_BYTES = 32768;
constexpr size_t WS_END = WS_CTRL + CTRL_BYTES;
constexpr size_t WS_Y = WS_PROJ;
constexpr size_t WS_HB = WS_XB;
constexpr size_t WS_EU8 = WS_OATT;
constexpr size_t WS_EV8 = WS_EU8 + (size_t)16384 * 1024;
constexpr size_t WS_ESU = WS_EV8 + (size_t)16384 * 1024;
constexpr size_t WS_ESV = WS_ESU + 16384 * 4;
static_assert(WS_ESV + 16384 * 4 <= WS_MIX, "expert tables overflow their region");
constexpr int EXP_EARLY = 6144;
static_assert(WS_END <= (size_t)512 * 1024 * 1024, "workspace over 512 MiB");

struct Params {
  const float *x, *w_in, *ck_pos, *ck_w1, *ck_b1, *ck_w2, *cv_pos, *cv_w1, *cv_b1, *cv_w2, *conv_w, *hng, *w_out, *ln1g, *ln1b, *w_query, *subk,
      *eu, *ev, *ln2g, *ln2b;
  float* out;
  char* ws;
};
#define WSP(T, OFF) ((T*)(p.ws + (OFF)))

#define FOR_VB(n) for (int vb = blockIdx.x; vb < (n); vb += gridDim.x)
#define FOR_VB2(n) for (int vb = blockIdx.x * 2 + (TIDX >> 8); vb < (n); vb += gridDim.x * 2)
constexpr int SMEM_BYTES = 147456;
constexpr int HALF = 36864;

__global__ void __launch_bounds__(512) mega(Params p) {
  __shared__ __attribute__((aligned(16))) char smem[SMEM_BYTES + 16];
  if (TIDX == 0) *(u32x4*)(smem + SMEM_BYTES) = u32x4{0u, 0u, 0u, 0u};
  __syncthreads();
  const XcdBarrier xbar = xcd_barrier_post(WSP(unsigned, WS_CTRL + 1024), (volatile LAS unsigned*)(smem + SMEM_BYTES));
#define smh (smem + (TIDX >> 8) * HALF)
#define wv ((TIDX >> 6))
  constexpr int NWV = 8;
  d_cvt(p.x, WSP(bf16_t, WS_XB), (size_t)S * DM / 4);
  FOR_VB2((INWG / 64) * (DM / 64)) d_cvtT64(vb, smh, p.w_in, WSP(bf16_t, WS_WINT), DM, INW, INWG);
  for (size_t c = (size_t)blockIdx.x * 512 + TIDX; c < (size_t)16 * 256 * 64; c += (size_t)gridDim.x * 512) {
    d_cvt_w1f(c, p.ck_w1, WSP(bf16_t, WS_W1KF)); d_cvt_w1f(c, p.cv_w1, WSP(bf16_t, WS_W1VF));
    if (c < (size_t)4 * 32 * 64) { d_cvt_w2f(c, p.ck_w2, WSP(bf16_t, WS_W2KF)); d_cvt_w2f(c, p.cv_w2, WSP(bf16_t, WS_W2VF)); }
  }
  FOR_VB2((DM / 64) * (DM / 64)) d_cvtT64(vb, smh, p.w_out, WSP(bf16_t, WS_WOUTT), DM, DM, DM);
  FOR_VB2((DM / 64) * (DM / 64)) d_cvtT64(vb, smh, p.w_query, WSP(bf16_t, WS_WQT), DM, DM, DM);
  for (size_t c = (size_t)blockIdx.x * 512 + TIDX; c < (size_t)16 * 4 * 8 * 64; c += (size_t)gridDim.x * 512) d_cvt_subk(c, p.subk, WSP(bf16_t, WS_SKF));
  xcd_barrier(xbar);
  {
    pg8::StaticOrder so; so.init(S, INWG, gridDim.x, blockIdx.x);
    pg8::gemm_phase<EpiProjG, pg8::StaticOrder>((PG8_LAS unsigned char*)smem, pg8::Gemm{WSP(bf16_t, WS_XB), WSP(bf16_t, WS_WINT), S, INWG, DM}, so,
                                                EpiProjG{WSP(bf16_t, WS_PROJ), WSP(float, WS_GATES), (PG8_LAS unsigned char*)smem + pg8::STAGE_BYTES}, nullptr);
    const int nun = (S / 256) * (INWG / 256), gsz = (int)gridDim.x;
    const int nfull = nun % gsz;
    if (nfull != 0 && (int)blockIdx.x >= nfull) {
      const int nidle = gsz - nfull, me = (int)blockIdx.x - nfull;
      for (int r = me * NWV + wv; r < 2 * EXP_EARLY; r += nidle * NWV) {
        if (r < EXP_EARLY) d_cvt_i4_row(r, p.eu, WSP(unsigned char, WS_EU8), WSP(float, WS_ESU)); else d_cvt_fp4_row(r - EXP_EARLY, p.ev, WSP(unsigned char, WS_EV8), WSP(float, WS_ESV));
      }
    }
  }
  xcd_barrier(xbar);
  {
    if (blockIdx.x < 128) {
      const int xcd_ = blockIdx.x & 7, idx_ = blockIdx.x >> 3; const bool isV = (xcd_ & 1) != 0;
      d_compress_unit((xcd_ >> 1) * 16 + idx_, smem, WSP(bf16_t, WS_PROJ), isV ? OFF_VC : OFF_KC, isV ? p.cv_pos : p.ck_pos, isV ? WSP(bf16_t, WS_W1VF) : WSP(bf16_t, WS_W1KF),
                      isV ? p.cv_b1 : p.ck_b1, isV ? WSP(bf16_t, WS_W2VF) : WSP(bf16_t, WS_W2KF), isV ? WSP(bf16_t, WS_VCF) : WSP(bf16_t, WS_KCF), isV);
    }
    int* slot = (int*)smem;
    unsigned* ctr = WSP(unsigned, WS_CTRL);
    for (;;) {
      if (TIDX == 0) *slot = (int)atomicAdd(ctr, 1u);
      __syncthreads();
      const int it = *slot;
      __syncthreads();
      if (it >= 2048) break;
      const int tt = TIDX;
      {
        const int T = it >> 2, which = it & 3;
        d_relayout_tile(T, smem + 64, WSP(bf16_t, WS_PROJ), (which == 0) ? OFF_KS : (which == 1) ? OFF_VS : (which == 2) ? OFF_KW : OFF_VW,
                        (which == 0) ? WSP(bf16_t, WS_KSF) : (which == 1) ? WSP(bf16_t, WS_VSF) : (which == 2) ? WSP(bf16_t, WS_KWF) : WSP(bf16_t, WS_VWF), (which & 1) != 0);
      }
      for (int q = 0; q < 2; ++q) d_convmix(it * 8 + q * 4 + (tt >> 7), tt & 127, WSP(bf16_t, WS_PROJ), p.conv_w, p.hng, WSP(bf16_t, WS_MIX));
    }
  }
  xcd_barrier(xbar);
  {
    AttnPtrs ap{WSP(bf16_t, WS_PROJ), WSP(float, WS_GATES), WSP(bf16_t, WS_KCF), WSP(bf16_t, WS_VCF), WSP(bf16_t, WS_KSF), WSP(bf16_t, WS_VSF), WSP(bf16_t, WS_KWF), WSP(bf16_t, WS_VWF), WSP(bf16_t, WS_MIX), p.hng};
    for (int it = blockIdx.x; it < 512; it += gridDim.x) {
      const int Bq = (it < 256) ? it : (511 - it), gq = (it < 256) ? 0 : 1;
      d_attn_block(Bq, gq, smem, ap);
    }
  }
  xcd_barrier(xbar);
  {
    pg8::StaticOrder so; so.init(S, DM, gridDim.x, blockIdx.x);
    pg8::gemm_phase<EpiResG, pg8::StaticOrder>((PG8_LAS unsigned char*)smem, pg8::Gemm{WSP(bf16_t, WS_MIX), WSP(bf16_t, WS_WOUTT), S, DM, DM}, so,
                                               EpiResG{WSP(bf16_t, WS_HB), (PG8_LAS unsigned char*)smem + pg8::STAGE_BYTES}, nullptr);
  }
  xcd_barrier(xbar);
  for (int r = blockIdx.x * NWV + wv; r < S; r += gridDim.x * NWV) d_ln_wave(r, WSP(bf16_t, WS_HB), p.ln1g, p.ln1b);
  {
    const int e0_ = (((S / 256) * (INWG / 256)) % (int)gridDim.x != 0) ? EXP_EARLY : 0;
    const int nrest = 16384 - e0_;
    for (int r = blockIdx.x * NWV + wv; r < 2 * nrest; r += gridDim.x * NWV) {
      if (r < nrest) d_cvt_i4_row(e0_ + r, p.eu, WSP(unsigned char, WS_EU8), WSP(float, WS_ESU)); else d_cvt_fp4_row(e0_ + r - nrest, p.ev, WSP(unsigned char, WS_EV8), WSP(float, WS_ESV));
    }
  }
  xcd_barrier(xbar);
  for (int k = 0; k * (int)gridDim.x < (S / 256) * (DM / 256); ++k) {
    pg8::OneUnit so; so.init(S, DM, gridDim.x, blockIdx.x); so.k = k;
    pg8::gemm_phase<EpiRouteG, pg8::OneUnit>((PG8_LAS unsigned char*)smem, pg8::Gemm{WSP(bf16_t, WS_HB), WSP(bf16_t, WS_WQT), S, DM, DM}, so,
                                             EpiRouteG{WSP(bf16_t, WS_SKF), WSP(unsigned, WS_TOPS)}, nullptr);
    __syncthreads();
  }
  xcd_barrier(xbar);
  {
    const int tstr = (int)gridDim.x * NWV;
    for (int tg0 = blockIdx.x * NWV + wv; tg0 < S; tg0 += 4 * tstr)
      d_expert_group(tg0, tstr, (unsigned*)(smem + wv * 1024), (unsigned*)(smem + 8192 + wv * 16384), WSP(bf16_t, WS_HB), WSP(unsigned, WS_TOPS), WSP(unsigned char, WS_EU8), WSP(unsigned char, WS_EV8),
                     WSP(float, WS_ESU), WSP(float, WS_ESV), p.ln2g, p.ln2b, p.out);
  }
}

extern "C" void kernel_launch(void* const* d_in, const int* in_sizes, int n_in, void* d_out, int out_size, void* d_ws, size_t ws_size,
                              hipStream_t stream) {
  Params p{};
  p.x = (const float*)d_in[0]; p.w_in = (const float*)d_in[1]; p.ck_pos = (const float*)d_in[2]; p.ck_w1 = (const float*)d_in[3];
  p.ck_b1 = (const float*)d_in[4]; p.ck_w2 = (const float*)d_in[5]; p.cv_pos = (const float*)d_in[6]; p.cv_w1 = (const float*)d_in[7];
  p.cv_b1 = (const float*)d_in[8]; p.cv_w2 = (const float*)d_in[9]; p.conv_w = (const float*)d_in[10]; p.hng = (const float*)d_in[11];
  p.w_out = (const float*)d_in[12]; p.ln1g = (const float*)d_in[13]; p.ln1b = (const float*)d_in[14]; p.w_query = (const float*)d_in[15];
  p.subk = (const float*)d_in[16]; p.eu = (const float*)d_in[17]; p.ev = (const float*)d_in[18]; p.ln2g = (const float*)d_in[19];
  p.ln2b = (const float*)d_in[20];
  p.out = (float*)d_out;
  p.ws = (char*)d_ws;
  if (ws_size < WS_END) fprintf(stderr, "workspace too small\n");
  static int grid_blocks = 0;
  if (!grid_blocks) {
    int dev = 0, cus = 0, per_cu = 0;
    hipGetDevice(&dev);
    hipDeviceGetAttribute(&cus, hipDeviceAttributeMultiprocessorCount, dev);
    hipOccupancyMaxActiveBlocksPerMultiprocessor(&per_cu, mega, 512, 0);
    if (per_cu > 1) per_cu = 1;
    if (per_cu < 1) per_cu = 1;
    grid_blocks = cus * per_cu;
  }
  hipMemsetAsync((char*)d_ws + WS_CTRL, 0, CTRL_BYTES, stream);
  void* args[] = {&p};
  hipError_t e = hipLaunchCooperativeKernel((void*)mega, dim3(grid_blocks), dim3(512), args, 0, stream);
  if (e != hipSuccess) fprintf(stderr, "cooperative launch failed: %s (grid %d)\n", hipGetErrorString(e), grid_blocks);
}
```

```cpp
#include <hip/hip_runtime.h>
#include <stdint.h>
#include <stdio.h>


#define DI __device__ __forceinline__
static __device__ __forceinline__ int tidx_() { int t = (int)__builtin_amdgcn_workitem_id_x(); asm volatile("" : "+v"(t)); return t; }
#define TIDX (tidx_())

template <int J> DI int swz_xor(int x) { return __builtin_amdgcn_ds_swizzle(x, (J << 10) | 0x1F); }
template <int CTRL> DI int dpp_i(int x) { return __builtin_amdgcn_update_dpp(x, x, CTRL, 0xF, 0xF, false); }
DI int shx_i(int x, int j) {
  switch (j) {
    case 1: return dpp_i<0xB1>(x);
    case 2: return dpp_i<0x4E>(x);
    case 4: return dpp_i<0x1B>(dpp_i<0x141>(x));
    case 8: return dpp_i<0x128>(x);
    case 16: return swz_xor<16>(x);
    default: {
      auto r = __builtin_amdgcn_permlane32_swap((unsigned)x, (unsigned)x, false, false);
      return (TIDX & 32) ? (int)r[0] : (int)r[1];
    }
  }
}
DI float shx(float x, int j) { return __int_as_float(shx_i(__float_as_int(x), j)); }
typedef unsigned short bf16_t;
using bf16x8 = __attribute__((ext_vector_type(8))) short;
using f32x4 = __attribute__((ext_vector_type(4))) float;
using u32x4 = __attribute__((ext_vector_type(4))) unsigned;
using u32x2 = __attribute__((ext_vector_type(2))) unsigned;

constexpr int S = 16384, DM = 2048, HD = 128;
constexpr int INW = 5656, INWP = 5760, INWG = 5888;
constexpr int OFF_Q = 0, OFF_KC = 1024, OFF_VC = 1280, OFF_KS = 1536, OFF_VS = 1792, OFF_KW = 2048, OFF_VW = 2304,
              OFF_G = 2560, OFF_U = 2584, OFF_B = 3608, OFF_C = 4632;
constexpr int NCMP = 1023;
constexpr float ALPHA = 1.189207115002721f;
constexpr float QSCALE = 0.08838834764831845f;

DI bf16_t f2bf(float x) { unsigned u = __float_as_uint(x); u += 0x7fffu + ((u >> 16) & 1u); return (bf16_t)(u >> 16); }
DI float bf2f(bf16_t b) { return __uint_as_float(((unsigned)b) << 16); }
DI float gelu_tanh(float x) { float u = 0.7978845608028654f * (x + 0.044715f * x * x * x); return 0.5f * x * (1.f + tanhf(u)); }
DI float wave_sum(float v) { for (int o = 32; o > 0; o >>= 1) v += shx(v, o); return v; }
using bf16x2v = __attribute__((ext_vector_type(2))) __bf16;
DI unsigned pack2(float a, float b) { bf16x2v v = {(__bf16)a, (__bf16)b}; return __builtin_bit_cast(unsigned, v); }
DI float wave_max(float v) { for (int o = 32; o > 0; o >>= 1) v = fmaxf(v, shx(v, o)); return v; }

namespace pg8 {
#define PG8_LAS __attribute__((address_space(3)))
typedef unsigned short bf16_t;
typedef short bf16x8 __attribute__((ext_vector_type(8)));
typedef float f32x4 __attribute__((ext_vector_type(4)));
typedef unsigned u32x4 __attribute__((ext_vector_type(4)));
constexpr int BM = 256, BK = 64, HALF = 128, HTB = HALF * BK * 2  , STAGE_BYTES = 8 * HTB, NXCD = 8, WGM = 8;

__host__ __device__ __forceinline__ int lds_byte(int r, int c) { const int st = (r >> 4) * 2 + (c >> 5), rr = r & 15, cc = c & 31, ob = rr * 64 + cc * 2; return st * 1024 + (ob ^ (((ob >> 9) & 1) << 5)); }
__host__ __device__ __forceinline__ void stage_rc(int b, int& R, int& C) { const int st = b / 1024, sb = b % 1024, swz = sb ^ (((sb >> 9) & 1) << 5); R = (st >> 1) * 16 + swz / 64; C = (st & 1) * 32 + (swz % 64) / 2; }
__host__ __device__ __forceinline__ int perm32(int rho) { const int n = rho >> 4, i = rho & 15; return 8 * (i >> 2) + 4 * n + (i & 3); }

struct Unit { int pm, pn; };
struct Gemm { const bf16_t* A; const bf16_t* Bt; int M, N, K; };

struct StaticOrder {
    int nM, nN, nwg, G, c;
    __host__ __device__ void init(int M, int N, int G_, int c_) { nM = M / BM; nN = N / BM; nwg = nM * nN; G = G_; c = c_; }
    __host__ __device__ bool next(int i, Unit& u) const {
        const long L = (long)i * G + c; if (L >= nwg) return false;
        int wgid = (int)L; { const int q = nwg / NXCD, r = nwg % NXCD, xcd = wgid % NXCD, off = wgid / NXCD; wgid = (xcd < r ? xcd * (q + 1) : r * (q + 1) + (xcd - r) * q) + off; }
        const int nig = WGM * nN, gid = wgid / nig, fm = gid * WGM, gsz = (nM - fm) < WGM ? (nM - fm) : WGM;
        u.pm = fm + ((wgid % nig) % gsz); u.pn = (wgid % nig) / gsz; return true;
    }
    __device__ __forceinline__ void a_ready(const Unit&) const {}
    __device__ __forceinline__ void done(const Unit&) const {}
};
struct OneUnit : StaticOrder {
    int k;
    __device__ bool next(int i, Unit& u) const { if (i > 0) return false; return StaticOrder::next(k, u); }
};
__device__ __forceinline__ unsigned cvt_pk_bf16(float lo, float hi) { unsigned r; asm volatile("v_cvt_pk_bf16_f32 %0, %1, %2" : "=v"(r) : "v"(lo), "v"(hi)); return r; }
template <class Epi, class Sched, bool STAMP = false>
__device__ __forceinline__ void gemm_phase(PG8_LAS unsigned char* lds, const Gemm g, const Sched& S, const Epi& E, unsigned long long* stamps) {
    const int tid = TIDX, wid = __builtin_amdgcn_readfirstlane(tid >> 6), lane = tid & 63, wr = wid >> 2, wc = wid & 3, fr = lane & 15, fq = lane >> 4;
    const int K = g.K, nt = K / BK;
    int ts_lo = 0, ts_hi = 0, nts = 0; const unsigned long long rt_entry = STAMP ? (unsigned long long)wall_clock64() : 0ull;
#define PG8_STAMP() do { if (STAMP && wid == 0 && nts < 64) { const unsigned long long _c = (unsigned long long)clock64(); \
        ts_lo = (lane == nts) ? (int)(unsigned)_c : ts_lo; ts_hi = (lane == nts) ? (int)(unsigned)(_c >> 32) : ts_hi; ++nts; } } while (0)
    PG8_STAMP();
    unsigned voffA[2], voffB[2];
#pragma unroll
    for (int i = 0; i < 2; ++i) { int R, C; stage_rc(tid * 16 + i * 8192, R, C); const int Rb = Epi::PERM ? ((R & ~31) + perm32(R & 31)) : R;
        voffA[i] = (unsigned)(R * K + C) * 2u; voffB[i] = (unsigned)(Rb * K + C) * 2u; }
    const size_t kstep = (size_t)(BK * 2);
    const size_t hstep = (size_t)HALF * K * 2;
    const size_t tstep = 2 * hstep;
    const unsigned ldsw = (unsigned)wid * 1024u;
    const int aoff = lds_byte(wr * 64 + fr, fq * 8), boff = lds_byte(wc * 32 + fr, fq * 8);
#define PG8_SA(b, h) (((b) * 2 + (h)) * HTB)
#define PG8_SB(b, h) ((4 + (b) * 2 + (h)) * HTB)
#define PG8_STAGE(bufoff, gbase, voff) do { _Pragma("unroll") for (int _i = 0; _i < 2; ++_i) \
        __builtin_amdgcn_global_load_lds((const unsigned*)((const char*)(gbase) + (voff)[_i]), (PG8_LAS unsigned*)(lds + (bufoff) + ldsw + _i * 8192), 16, 0, 0); } while (0)
#define PG8_LDA(dst, b, h) do { _Pragma("unroll") for (int m = 0; m < 4; ++m) _Pragma("unroll") for (int k = 0; k < 2; ++k) dst[m][k] = *(const PG8_LAS bf16x8*)(lds + PG8_SA(b, h) + aoff + m * 2048 + k * 1024); } while (0)
#define PG8_LDB(dst, b, h) do { _Pragma("unroll") for (int n = 0; n < 2; ++n) _Pragma("unroll") for (int k = 0; k < 2; ++k) dst[n][k] = *(const PG8_LAS bf16x8*)(lds + PG8_SB(b, h) + boff + n * 2048 + k * 1024); } while (0)
#define PG8_MMA(ai, bj, At, Bt) do { __builtin_amdgcn_s_setprio(1); _Pragma("unroll") for (int m = 0; m < 4; ++m) _Pragma("unroll") for (int n = 0; n < 2; ++n) _Pragma("unroll") for (int k = 0; k < 2; ++k) \
        acc[ai][bj][m][n] = __builtin_amdgcn_mfma_f32_16x16x32_bf16(Bt[n][k], At[m][k], acc[ai][bj][m][n], 0, 0, 0); __builtin_amdgcn_s_setprio(0); } while (0)
#define PG8_WAIT_V(n) asm volatile("s_waitcnt vmcnt(" #n ")" ::: "memory")
#define PG8_WAIT_L(n) asm volatile("s_waitcnt lgkmcnt(" #n ")" ::: "memory")
#define PG8_BAR __builtin_amdgcn_s_barrier()
#define PG8_SCHED __builtin_amdgcn_sched_barrier(0)
    Unit cur, nxt; int ui = 0;
    if (!S.next(0, cur)) return;
    f32x4 acc[2][2][4][2];
#pragma unroll
    for (int a = 0; a < 2; ++a)
#pragma unroll
        for (int b = 0; b < 2; ++b)
#pragma unroll
            for (int m = 0; m < 4; ++m)
#pragma unroll
                for (int n = 0; n < 2; ++n) acc[a][b][m][n] = (f32x4){0.f, 0.f, 0.f, 0.f};
    bf16x8 At[4][2], B0[2][2], B1[2][2];
    const char* cA = (const char*)g.A + (size_t)cur.pm * tstep; const char* cB = (const char*)g.Bt + (size_t)cur.pn * tstep;
    S.a_ready(cur);
    PG8_STAGE(PG8_SB(0, 0), cB, voffB); PG8_STAGE(PG8_SA(0, 0), cA, voffA); PG8_STAGE(PG8_SB(0, 1), cB + hstep, voffB); PG8_STAGE(PG8_SA(0, 1), cA + hstep, voffA);
    if (wr == 1) PG8_BAR;
    PG8_WAIT_V(4); PG8_BAR;
    PG8_STAGE(PG8_SB(1, 0), cB + kstep, voffB); PG8_STAGE(PG8_SA(1, 0), cA + kstep, voffA); PG8_STAGE(PG8_SB(1, 1), cB + hstep + kstep, voffB);
    PG8_WAIT_V(6); PG8_BAR;
    PG8_STAMP();
    for (;;) {
        const bool has_next = S.next(ui + 1, nxt);
        const char* nA = has_next ? (const char*)g.A + (size_t)nxt.pm * tstep : cA; const char* nB = has_next ? (const char*)g.Bt + (size_t)nxt.pn * tstep : cB;
        for (int t = 0; t < nt; t += 2) {
            const bool last = (t == nt - 2);
            const char* a1 = cA + (size_t)(t + 1) * kstep;
            const char* a2 = last ? nA : cA + (size_t)(t + 2) * kstep; const char* b2 = last ? nB : cB + (size_t)(t + 2) * kstep;
            const char* a3 = a2 + kstep; const char* b3 = b2 + kstep;
            if (last && has_next) S.a_ready(nxt);
            PG8_LDB(B0, 0, 0); PG8_SCHED; PG8_LDA(At, 0, 0); PG8_STAGE(PG8_SA(1, 1), a1 + hstep, voffA);
            PG8_WAIT_L(8); PG8_BAR; PG8_WAIT_L(0); PG8_MMA(0, 0, At, B0); PG8_BAR; PG8_SCHED;
            PG8_LDB(B1, 0, 1); PG8_STAGE(PG8_SB(0, 0), b2, voffB);
            PG8_BAR; PG8_WAIT_L(0); PG8_MMA(0, 1, At, B1); PG8_BAR;
            PG8_LDA(At, 0, 1); PG8_STAGE(PG8_SA(0, 0), a2, voffA);
            PG8_BAR; PG8_WAIT_L(0); PG8_MMA(1, 0, At, B0); PG8_BAR; PG8_SCHED;
            PG8_STAGE(PG8_SB(0, 1), b2 + hstep, voffB);
            PG8_WAIT_V(6); PG8_BAR; PG8_MMA(1, 1, At, B1); PG8_BAR;
            PG8_LDB(B0, 1, 0); PG8_SCHED; PG8_LDA(At, 1, 0); PG8_STAGE(PG8_SA(0, 1), a2 + hstep, voffA);
            PG8_WAIT_L(8); PG8_BAR; PG8_WAIT_L(0); PG8_MMA(0, 0, At, B0); PG8_BAR; PG8_SCHED;
            PG8_LDB(B1, 1, 1); PG8_STAGE(PG8_SB(1, 0), b3, voffB);
            PG8_BAR; PG8_WAIT_L(0); PG8_MMA(0, 1, At, B1); PG8_BAR;
            PG8_LDA(At, 1, 1); PG8_STAGE(PG8_SA(1, 0), a3, voffA);
            PG8_BAR; PG8_WAIT_L(0); PG8_MMA(1, 0, At, B0); PG8_BAR; PG8_SCHED;
            PG8_STAGE(PG8_SB(1, 1), b3 + hstep, voffB);
            PG8_WAIT_V(6); PG8_BAR; PG8_MMA(1, 1, At, B1); PG8_BAR;
        }
        PG8_STAMP();
        if constexpr (!Epi::AFTER_DRAIN) { E(acc, cur, wr, wc, fr, fq); S.done(cur); }
        PG8_STAMP();
        if (!has_next) break;
#pragma unroll
        for (int a = 0; a < 2; ++a)
#pragma unroll
            for (int b = 0; b < 2; ++b)
#pragma unroll
                for (int m = 0; m < 4; ++m)
#pragma unroll
                    for (int n = 0; n < 2; ++n) acc[a][b][m][n] = (f32x4){0.f, 0.f, 0.f, 0.f};
        cur = nxt; cA = nA; cB = nB; ++ui;
    }
    PG8_WAIT_V(0);
    if (wr == 0) PG8_BAR;
    PG8_BAR;
    if constexpr (Epi::AFTER_DRAIN) { E.fused(acc, cur, wr, wc, fr, fq, lds, wid, lane); S.done(cur); }
    PG8_STAMP();
    if (STAMP && wid == 0) { stamps[lane] = lane < nts ? (((unsigned long long)(unsigned)ts_hi << 32) | (unsigned)ts_lo) : 0ull;
        if (lane == 62) stamps[62] = rt_entry; if (lane == 63) stamps[63] = (unsigned long long)wall_clock64(); }
#undef PG8_STAMP
#undef PG8_SA
#undef PG8_SB
#undef PG8_STAGE
#undef PG8_LDA
#undef PG8_LDB
#undef PG8_MMA
#undef PG8_WAIT_V
#undef PG8_WAIT_L
#undef PG8_BAR
#undef PG8_SCHED
}
}

#define XB_TMO      128
#define XB_XCNT(j)  (256  + 64 * (j))
#define XB_XSUB(j)  (1280 + 64 * (j))
#define XB_XGEN(j)  (2304 + 64 * (j))
#define XB_TOP      3328
#define XB_TOPGEN   3392
#define XCD_BAR_WORDS 3456
#define XB_SPIN_CAP (1u << 18)
#define LAS __attribute__((address_space(3)))

__device__ __forceinline__ unsigned xb_ld(unsigned* p)              { return __hip_atomic_load(p, __ATOMIC_RELAXED, __HIP_MEMORY_SCOPE_AGENT); }
__device__ __forceinline__ unsigned xb_add(unsigned* p, unsigned v) { return __hip_atomic_fetch_add(p, v, __ATOMIC_RELAXED, __HIP_MEMORY_SCOPE_AGENT); }
__device__ __forceinline__ unsigned xb_xcc_id() { return (unsigned)__builtin_amdgcn_s_getreg((3 << 11) | 20) & 0xFu; }
#define XB_SPIN(cond, bar) do { unsigned _sp = 0; while (cond) { __builtin_amdgcn_s_sleep(1); \
    if ((++_sp & 255u) == 0u) { if (xb_ld(&(bar)[XB_TMO])) break; if (_sp > XB_SPIN_CAP) { atomicAdd(&(bar)[XB_TMO], 1u); break; } } } } while (0)

struct XcdBarrier {
    unsigned* bar; unsigned x;
    volatile LAS unsigned* st;
};

__device__ __forceinline__ XcdBarrier xcd_barrier_post(unsigned* bar, volatile LAS unsigned* st) {
    XcdBarrier b; b.bar = bar; b.x = xb_xcc_id(); b.st = st;
    if (TIDX == 0) (void)xb_add(&bar[XB_XCNT(b.x)], 1u);
    return b;
}
__device__ __forceinline__ void xcd_barrier_complete(unsigned* bar, unsigned x, unsigned& nloc, unsigned& nx) {
    const unsigned G = gridDim.x * gridDim.y * gridDim.z;
    unsigned sum, cnt, mine, sp = 0u;
    for (;;) {
        sum = 0u; cnt = 0u; mine = 0u;
#pragma unroll
        for (unsigned j = 0; j < 16; ++j) { const unsigned c = xb_ld(&bar[XB_XCNT(j)]); sum += c; cnt += (c > 0u) ? 1u : 0u; mine = (j == x) ? c : mine; }
        if (sum == G) break;
        __builtin_amdgcn_s_sleep(1);
        if ((++sp & 255u) == 0u) { if (xb_ld(&bar[XB_TMO])) break; if (sp > XB_SPIN_CAP) { atomicAdd(&bar[XB_TMO], 1u); break; } }
    }
    nloc = mine > 0u ? mine : 1u; nx = cnt > 0u ? cnt : 1u;
}

__device__ __forceinline__ void xcd_barrier(const XcdBarrier& b) {
    asm volatile("s_waitcnt vmcnt(0)" ::: "memory");
    __syncthreads();
    if (TIDX == 0) {
        unsigned* bar = b.bar;
        __builtin_amdgcn_s_waitcnt(0);
        unsigned nloc = b.st[0], nx = b.st[1];
        if (nloc == 0u) { xcd_barrier_complete(bar, b.x, nloc, nx); b.st[0] = nloc; b.st[1] = nx; }
        const unsigned old = xb_add(&bar[XB_XSUB(b.x)], 1u);
        const unsigned gen = old / nloc;
        if (old + 1u == (gen + 1u) * nloc) {
            __builtin_amdgcn_fence(__ATOMIC_RELEASE, "agent");
            asm volatile("s_waitcnt vmcnt(0)" ::: "memory");
            const unsigned og = xb_add(&bar[XB_TOP], 1u);
            const unsigned tg = og / nx;
            if (og + 1u == (tg + 1u) * nx) xb_add(&bar[XB_TOPGEN], 1u);
            else XB_SPIN(xb_ld(&bar[XB_TOPGEN]) == tg, bar);
            __builtin_amdgcn_fence(__ATOMIC_ACQUIRE, "agent");
            xb_add(&bar[XB_XGEN(b.x)], 1u);
            asm volatile("s_waitcnt vmcnt(0)" ::: "memory");
        } else {
            XB_SPIN(xb_ld(&bar[XB_XGEN(b.x)]) == gen, bar);
            __builtin_amdgcn_fence(__ATOMIC_ACQUIRE, "agent");
            asm volatile("s_waitcnt vmcnt(0)" ::: "memory");
        }
    }
    __syncthreads();
}

__device__ void d_cvt(const float* __restrict__ in, bf16_t* __restrict__ out, size_t n4) {
  const size_t stride = (size_t)gridDim.x * blockDim.x;
  size_t i = (size_t)blockIdx.x * blockDim.x + TIDX;
  for (; i + 3 * stride < n4; i += 4 * stride) {
    f32x4 v[4];
#pragma unroll
    for (int q = 0; q < 4; ++q) v[q] = ((const f32x4*)in)[i + q * stride];
#pragma unroll
    for (int q = 0; q < 4; ++q) { u32x2 o = {pack2(v[q][0], v[q][1]), pack2(v[q][2], v[q][3])}; ((u32x2*)out)[i + q * stride] = o; }
  }
  for (; i < n4; i += stride) { const f32x4 v = ((const f32x4*)in)[i]; u32x2 o = {pack2(v[0], v[1]), pack2(v[2], v[3])}; ((u32x2*)out)[i] = o; }
}
__device__ void d_cvtT64(int vb, char* smem, const float* __restrict__ W, bf16_t* __restrict__ WT, int K, int N, int NP) {
  float (*tt)[65] = (float (*)[65])smem;
  const int tid = (TIDX & 255);
  const int nbx = NP / 64;
  const int n0 = (vb % nbx) * 64, k0 = (vb / nbx) * 64;
  {
    const int kr = tid >> 4, nc = (tid & 15) * 4;
#pragma unroll
    for (int i = 0; i < 4; ++i) {
      const int k = k0 + kr + 16 * i, n = n0 + nc;
      f32x4 v = {0.f, 0.f, 0.f, 0.f};
      if (n < N) v = *(const f32x4*)(W + (size_t)k * N + n);
      tt[kr + 16 * i][nc] = v[0]; tt[kr + 16 * i][nc + 1] = v[1]; tt[kr + 16 * i][nc + 2] = v[2]; tt[kr + 16 * i][nc + 3] = v[3];
    }
  }
  __syncthreads();
  {
    const int nr = tid >> 3, kc = (tid & 7) * 8;
#pragma unroll
    for (int i = 0; i < 2; ++i) {
      const int nl = nr + 32 * i;
      u32x4 o = {pack2(tt[kc][nl], tt[kc + 1][nl]), pack2(tt[kc + 2][nl], tt[kc + 3][nl]), pack2(tt[kc + 4][nl], tt[kc + 5][nl]), pack2(tt[kc + 6][nl], tt[kc + 7][nl])};
      *(u32x4*)(WT + (size_t)(n0 + nl) * K + k0 + kc) = o;
    }
  }
  __syncthreads();
}

using f32x16 = __attribute__((ext_vector_type(16))) float;
using bf16x8v = __attribute__((ext_vector_type(8))) __bf16;
#define MFMA32(a, b, c) __builtin_amdgcn_mfma_f32_32x32x16_bf16((a), (b), (c), 0, 0, 0)
constexpr float LOG2E = 1.4426950408889634f;
constexpr float NEGB = -1e30f;
DI int pi_perm(int i) { return (i & ~12) | ((i & 8) >> 1) | ((i & 4) << 1); }
DI bf16x8 pack8(float a0, float a1, float a2, float a3, float a4, float a5, float a6, float a7) {
  bf16x8v v = {(__bf16)a0, (__bf16)a1, (__bf16)a2, (__bf16)a3, (__bf16)a4, (__bf16)a5, (__bf16)a6, (__bf16)a7};
  return __builtin_bit_cast(bf16x8, v);
}
__device__ __forceinline__ void d_relayout_tile(int T, char* smem, const bf16_t* __restrict__ proj, int col0, bf16_t* __restrict__ dst, bool isV) {
  bf16_t* Ls = (bf16_t*)smem;
  const int tid = TIDX;
#pragma unroll
  for (int q = 0; q < 2; ++q) {
    const int cidx = tid + q * 512;
    const int g = cidx >> 9, tok = (cidx >> 4) & 31, ch = cidx & 15;
    const u32x4 v = *(const u32x4*)(proj + (size_t)(32 * T + tok) * INWP + col0 + g * 128 + ch * 8);
    *(u32x4*)(Ls + (g * 32 + tok) * 136 + ch * 8) = v;
  }
  __syncthreads();
#pragma unroll
  for (int q = 0; q < 2; ++q) {
    const int oc = tid + q * 512;
    const int g = oc >> 9, r9 = oc & 511, lane = r9 & 63;
    u32x4 o;
    if (!isV) {
      const int s8 = r9 >> 6, i = lane & 31, h = lane >> 5;
      o = *(const u32x4*)(Ls + (g * 32 + pi_perm(i)) * 136 + 16 * s8 + 8 * h);
    } else {
      const int s2 = (r9 >> 6) & 1, dt = r9 >> 7, dd = lane & 31, h = lane >> 5;
      const bf16_t* col = Ls + (g * 32 + 16 * s2 + 8 * h) * 136 + 32 * dt + dd;
      unsigned short e[8];
#pragma unroll
      for (int j = 0; j < 8; ++j) e[j] = col[j * 136];
      o.x = e[0] | ((unsigned)e[1] << 16); o.y = e[2] | ((unsigned)e[3] << 16); o.z = e[4] | ((unsigned)e[5] << 16); o.w = e[6] | ((unsigned)e[7] << 16);
    }
    *(u32x4*)(dst + (((size_t)(g * 512 + T)) * 512 + r9) * 8) = o;
  }
  __syncthreads();
}

struct AttnPtrs {
  const bf16_t* proj; const float* gates;
  const bf16_t *kcf, *vcf, *ksf, *vsf, *kwf, *vwf;
  bf16_t* mix; const float* hng;
};

DI float ex2(float x) { return __builtin_amdgcn_exp2f(x); }
DI void halves(float x, float& lo, float& hi) {
  const unsigned u = __float_as_uint(x);
  auto r = __builtin_amdgcn_permlane32_swap(u, u, false, false);
  lo = __uint_as_float(r[0]); hi = __uint_as_float(r[1]);
}
DI float hmax(float x) { float a, b; halves(x, a, b); return fmaxf(a, b); }
DI float hsum(float x) { float a, b; halves(x, a, b); return a + b; }
DI float dpp_quad(float v, int ctrl_is_xor1) {
  const int iv = __float_as_int(v);
  const int r = ctrl_is_xor1 ? __builtin_amdgcn_update_dpp(iv, iv, 0xB1, 0xF, 0xF, false) : __builtin_amdgcn_update_dpp(iv, iv, 0x4E, 0xF, 0xF, false);
  return __int_as_float(r);
}
DI float quad_sum(float v) { v += dpp_quad(v, 1); v += dpp_quad(v, 0); return v; }
DI void osm_step(const float (&sv)[16], float& m, float& l, f32x16 (&O)[4], float (&p)[16]) {
  float tmax = fmaxf(fmaxf(fmaxf(sv[0], sv[1]), fmaxf(sv[2], sv[3])), fmaxf(fmaxf(sv[4], sv[5]), fmaxf(sv[6], sv[7])));
  tmax = fmaxf(tmax, fmaxf(fmaxf(fmaxf(sv[8], sv[9]), fmaxf(sv[10], sv[11])), fmaxf(fmaxf(sv[12], sv[13]), fmaxf(sv[14], sv[15]))));
  tmax = hmax(tmax);
  if (__ballot(tmax - m > 8.f)) {
    const float mn = fmaxf(m, tmax);
    const float alpha = ex2(m - mn);
    l *= alpha; m = mn;
#pragma unroll
    for (int dt = 0; dt < 4; ++dt)
#pragma unroll
      for (int r = 0; r < 16; ++r) O[dt][r] *= alpha;
  }
  float ps0 = 0.f, ps1 = 0.f;
#pragma unroll
  for (int r = 0; r < 16; r += 2) { const float e0 = ex2(sv[r] - m), e1 = ex2(sv[r + 1] - m); p[r] = e0; p[r + 1] = e1; ps0 += e0; ps1 += e1; }
  l += ps0 + ps1;
}
DI void ot_store(char* otL, int lane, const f32x16 (&O)[4], float sc) {
#pragma unroll
  for (int dt = 0; dt < 4; ++dt) {
    u32x4 a, b;
#pragma unroll
    for (int i = 0; i < 4; ++i) { a[i] = pack2(sc * O[dt][2 * i], sc * O[dt][2 * i + 1]); b[i] = pack2(sc * O[dt][8 + 2 * i], sc * O[dt][8 + 2 * i + 1]); }
    *(u32x4*)(otL + lane * 128 + dt * 32) = a;
    *(u32x4*)(otL + lane * 128 + dt * 32 + 16) = b;
  }
}
DI void ot_accum(const char* otL, int lane, f32x16 (&O)[4], float sc) {
#pragma unroll
  for (int dt = 0; dt < 4; ++dt) {
    u32x4 a = *(const u32x4*)(otL + lane * 128 + dt * 32);
    u32x4 b = *(const u32x4*)(otL + lane * 128 + dt * 32 + 16);
#pragma unroll
    for (int i = 0; i < 4; ++i) {
      const unsigned wa = a[i], wb = b[i];
      O[dt][2 * i] = fmaf(sc, O[dt][2 * i], __uint_as_float(wa << 16));
      O[dt][2 * i + 1] = fmaf(sc, O[dt][2 * i + 1], __uint_as_float(wa & 0xFFFF0000u));
      O[dt][8 + 2 * i] = fmaf(sc, O[dt][8 + 2 * i], __uint_as_float(wb << 16));
      O[dt][8 + 2 * i + 1] = fmaf(sc, O[dt][8 + 2 * i + 1], __uint_as_float(wb & 0xFFFF0000u));
    }
  }
}
DI void zero_o(f32x16 (&O)[4]) {
#pragma unroll
  for (int dt = 0; dt < 4; ++dt)
#pragma unroll
    for (int i = 0; i < 16; ++i) O[dt][i] = 0.f;
}

constexpr int ATT_PW = 8704;
constexpr int ATT_R = 4, ATT_D = 3;
constexpr int ATT_RING = 8 * ATT_PW;
constexpr int ATT_LIST = ATT_RING + ATT_R * 16384;
constexpr int ATT_BUNI = ATT_LIST + 2048;
constexpr int ATT_SMEM = ATT_BUNI + 64;
#define LAS3 __attribute__((address_space(3)))
__device__ __forceinline__ void d_select(const float* impL, unsigned* mskL, unsigned* uniL, int cur) {
  const int lane = TIDX & 63;
  const int stok = lane >> 3, sub = lane & 7;
  unsigned key[32];
#pragma unroll
  for (int i4 = 0; i4 < 8; ++i4) {
    f32x4 v = *(const f32x4*)(impL + stok * 256 + sub * 32 + i4 * 4);
#pragma unroll
    for (int e = 0; e < 4; ++e) {
      const int j = sub * 32 + i4 * 4 + e;
      const bool valid = j <= cur;
      const bool forced = (j == 0) || (j == cur) || (j == cur - 1);
      unsigned kb = forced ? 0xFFFFFF00u : (__float_as_uint(v[e]) & 0xFFFFFF00u);
      key[i4 * 4 + e] = valid ? (kb | (unsigned)(255 - j)) : 0u;
    }
  }
#pragma unroll
  for (int k = 2; k <= 32; k <<= 1) {
#pragma unroll
    for (int jj = k >> 1; jj > 0; jj >>= 1) {
#pragma unroll
      for (int i = 0; i < 32; ++i) {
        const int l2 = i ^ jj;
        if (l2 > i) {
          const bool desc = ((i & k) == 0);
          unsigned a = key[i], b = key[l2];
          unsigned mx = a > b ? a : b, mn = a > b ? b : a;
          key[i] = desc ? mx : mn; key[l2] = desc ? mn : mx;
        }
      }
    }
  }
#pragma unroll
  for (int xm = 1; xm < 8; xm <<= 1) {
    unsigned L[16];
#pragma unroll
    for (int i = 0; i < 16; ++i) { unsigned o = (unsigned)shx_i((int)key[15 - i], xm); L[i] = key[i] > o ? key[i] : o; }
#pragma unroll
    for (int jj = 8; jj > 0; jj >>= 1) {
#pragma unroll
      for (int i = 0; i < 16; ++i) {
        const int l2 = i ^ jj;
        if (l2 > i) { unsigned a = L[i], b = L[l2]; L[i] = a > b ? a : b; L[l2] = a > b ? b : a; }
      }
    }
#pragma unroll
    for (int i = 0; i < 16; ++i) key[i] = L[i];
  }
#pragma unroll
  for (int i = 0; i < 16; ++i) {
    if ((i & 7) == sub) {
      const int j = 255 - (int)(key[i] & 255u);
      if (j <= cur) { atomicOr(&mskL[stok * 8 + (j >> 5)], 1u << (j & 31)); atomicOr(&uniL[j >> 5], 1u << (j & 31)); }
    }
  }
}


DI void att_issue(LAS3 unsigned char* ring, int slot, int w, int lane, const bf16_t* kb, const bf16_t* vb, int tile) {
  const char* ks = (const char*)kb + (size_t)tile * 8192 + w * 1024 + lane * 16;
  const char* vs = (const char*)vb + (size_t)tile * 8192 + w * 1024 + lane * 16;
  __builtin_amdgcn_global_load_lds((const unsigned*)ks, (LAS3 unsigned*)(ring + slot * 16384 + w * 1024), 16, 0, 0);
  __builtin_amdgcn_global_load_lds((const unsigned*)vs, (LAS3 unsigned*)(ring + slot * 16384 + 8192 + w * 1024), 16, 0, 0);
}
DI f32x16 qk_lds(LAS3 const unsigned char* kt, const bf16x8 (&qf)[8], int lane) {
  f32x16 acc;
#pragma unroll
  for (int i = 0; i < 16; ++i) acc[i] = 0.f;
#pragma unroll
  for (int s8 = 0; s8 < 8; ++s8) {
    const bf16x8 kf = *(LAS3 const bf16x8*)(kt + s8 * 1024 + lane * 16);
    acc = MFMA32(kf, qf[s8], acc);
  }
  return acc;
}
DI void pv_lds(LAS3 const unsigned char* vt, const float (&p)[16], f32x16 (&O)[4], int lane) {
  const bf16x8 pf0 = pack8(p[0], p[1], p[2], p[3], p[4], p[5], p[6], p[7]);
  const bf16x8 pf1 = pack8(p[8], p[9], p[10], p[11], p[12], p[13], p[14], p[15]);
#pragma unroll
  for (int dt = 0; dt < 4; ++dt) {
    const bf16x8 v0 = *(LAS3 const bf16x8*)(vt + (dt * 2) * 1024 + lane * 16);
    const bf16x8 v1 = *(LAS3 const bf16x8*)(vt + (dt * 2 + 1) * 1024 + lane * 16);
    O[dt] = MFMA32(v0, pf0, O[dt]);
    O[dt] = MFMA32(v1, pf1, O[dt]);
  }
}

__device__ __forceinline__ void d_attn_block(int B, int g, char* smem, const AttnPtrs& P) {
  const int tid = TIDX, lane = tid & 63, w = tid >> 6;
  const int c = lane & 31, h = lane >> 5, tokl = c >> 2, r = c & 3;
  const int tok0 = 64 * B + 8 * w;
  const int t = tok0 + tokl, hd = g * 4 + r;
  const float slope2 = exp2f(-(float)(hd + 1)) * LOG2E;
  const float c1 = QSCALE * LOG2E;
  const float ninf = -__builtin_inff();
  char* wsm = smem + w * ATT_PW;
  float* impL = (float*)wsm;
  char* otL = wsm;
  unsigned* mskL = (unsigned*)(wsm + 8192);
  unsigned* uniL = mskL + 64;
  LAS3 unsigned char* ring = (LAS3 unsigned char*)(smem + ATT_RING);
  unsigned short* tl = (unsigned short*)(smem + ATT_LIST);
  unsigned* buni = (unsigned*)(smem + ATT_BUNI);
  const bf16_t* kcf = P.kcf + (size_t)g * 32 * 4096;
  const bf16_t* vcf = P.vcf + (size_t)g * 32 * 4096;
  const bf16_t* ksf = P.ksf + (size_t)g * 512 * 4096;
  const bf16_t* vsf = P.vsf + (size_t)g * 512 * 4096;
  const bf16_t* kwf = P.kwf + (size_t)g * 512 * 4096;
  const bf16_t* vwf = P.vwf + (size_t)g * 512 * 4096;
  bf16x8 qf[8];
  {
    const bf16_t* qrow = P.proj + (size_t)t * INWP + OFF_Q + hd * 128 + 8 * h;
#pragma unroll
    for (int s8 = 0; s8 < 8; ++s8) qf[s8] = *(const bf16x8*)(qrow + 16 * s8);
  }
  const float* gt = P.gates + (size_t)t * 24 + hd * 3;
  const float g0 = gt[0], g1 = gt[1], g2 = gt[2];
  {
    unsigned z0 = 0u;
    asm volatile("" : "+v"(z0));
    u32x4 z = {z0, z0, z0, z0};
#pragma unroll
    for (int i = 0; i < 8; ++i) *(u32x4*)(wsm + (i * 64 + lane) * 16) = z;
    if (lane < 18) *(u32x4*)(wsm + 8192 + lane * 16) = z;
    if (tid < 8) buni[tid] = z0;
  }
  f32x16 Ob[4];
  zero_o(Ob);
  const int nmax = (t >= 31) ? ((t - 31) >> 4) : -1;
  const int nmaxw = (tok0 + 7 >= 31) ? ((tok0 + 7 - 31) >> 4) : -1;
  const int nminw = (tok0 >= 31) ? ((tok0 - 31) >> 4) : -1;
  const int ntcw = (nmaxw + 32) >> 5;
  const int ntcB = (((64 * B + 63 - 31) >> 4) + 32) >> 5;
  const float sl16 = slope2 * 16.f;
  float mC = NEGB, lC = 0.f, invC = 0.f, carry = 0.f;
  {
    const int n = 2 * ntcB;
    asm volatile("s_waitcnt vmcnt(0)" ::: "memory");
#define A_TILE(i_) (((i_) < ntcB) ? (ntcB - 1 - (i_)) : ((i_) - ntcB))
    att_issue(ring, 0, w, lane, kcf, vcf, A_TILE(0));
    if (n > 1) att_issue(ring, 1, w, lane, kcf, vcf, A_TILE(1));
#pragma unroll 1
    for (int i = 0; i < n; ++i) {
      if ((i & 1) == 0) {
        asm volatile("s_waitcnt vmcnt(0)" ::: "memory");
        __builtin_amdgcn_s_barrier();
        asm volatile("" ::: "memory");
        if (i + 2 < n) att_issue(ring, (i + 2) & 3, w, lane, kcf, vcf, A_TILE(i + 2));
        if (i + 3 < n) att_issue(ring, (i + 3) & 3, w, lane, kcf, vcf, A_TILE(i + 3));
      }
      const int T = A_TILE(i);
      if (T >= ntcw) continue;
      LAS3 const unsigned char* slot = ring + (i % ATT_R) * 16384;
      const f32x16 acc = qk_lds(slot, qf, lane);
      const float base = slope2 * (float)(512 * T + 128 * h) + slope2 * (15.5f - (float)t);
      const int nb = 32 * T + 8 * h;
      const bool full = (32 * T + 31 <= nminw);
      float sv[16];
#pragma unroll
      for (int rg = 0; rg < 16; ++rg) { const int kk = (rg & 7) + 16 * (rg >> 3); sv[rg] = fmaf(acc[rg], c1, fmaf(sl16, (float)kk, base)); }
      if (!full) {
#pragma unroll
        for (int rg = 0; rg < 16; ++rg) { const int kk = (rg & 7) + 16 * (rg >> 3); sv[rg] = (nb + kk <= nmax) ? sv[rg] : ninf; }
      }
      if (i < ntcB) {
        float tmax = fmaxf(fmaxf(fmaxf(sv[0], sv[1]), fmaxf(sv[2], sv[3])), fmaxf(fmaxf(sv[4], sv[5]), fmaxf(sv[6], sv[7])));
        tmax = fmaxf(tmax, fmaxf(fmaxf(fmaxf(sv[8], sv[9]), fmaxf(sv[10], sv[11])), fmaxf(fmaxf(sv[12], sv[13]), fmaxf(sv[14], sv[15]))));
        tmax = hmax(tmax);
        const float mn = fmaxf(mC, tmax);
        float ps = 0.f;
#pragma unroll
        for (int rg = 0; rg < 16; ++rg) ps += ex2(sv[rg] - mn);
        lC = lC * ex2(mC - mn) + ps; mC = mn;
      } else {
        if (T == 0) { lC = hsum(lC); invC = (lC > 0.f) ? 1.f / lC : 0.f; }
        float p[16];
#pragma unroll
        for (int rg = 0; rg < 16; ++rg) p[rg] = ex2(sv[rg] - mC) * invC;
        float Ga = (p[0] + p[1]) + (p[2] + p[3]), Gb = (p[4] + p[5]) + (p[6] + p[7]);
        float Gc = (p[8] + p[9]) + (p[10] + p[11]), Gd = (p[12] + p[13]) + (p[14] + p[15]);
        float xb, xd; { float a_, b_; halves(p[7], a_, b_); xb = h ? a_ : b_; halves(p[15], a_, b_); xd = h ? a_ : b_; }
        float ia = Ga + (h ? xb : carry);
        float ib = Gb + p[3];
        float ic = Gc + (h ? xd : xb);
        float id = Gd + p[11];
        carry = xd;
        ia = quad_sum(ia); ib = quad_sum(ib); ic = quad_sum(ic); id = quad_sum(id);
        {
          float val = (r == 0) ? ia : (r == 1) ? ib : (r == 2) ? ic : id;
          int j = 8 * T + 2 * h + ((r == 0) ? 0 : (r == 1) ? 1 : (r == 2) ? 4 : 5);
          impL[tokl * 256 + j] = val;
        }
        pv_lds(slot + 8192, p, Ob, lane);
      }
    }
#undef A_TILE
  }
  const int cur = B;
  d_select(impL, mskL, uniL, cur);
  ot_store(otL, lane, Ob, g0);
  zero_o(Ob);
  if (lane < 8) { const unsigned u = uniL[lane]; if (u) atomicOr(&buni[lane], u); }
  __syncthreads();
  int nslc = 0, ntl = 0;
  {
    for (int iw = 7; iw >= 0; --iw) {
      unsigned iuw = __builtin_amdgcn_readfirstlane(buni[iw]);
      while (iuw) {
        const int bit = 31 - __builtin_clz(iuw);
        iuw &= ~(1u << bit);
        const int bb = 32 * iw + bit;
        if (bb < B) { if (lane == 0) tl[ntl] = (unsigned short)(2 * bb + 1); ++ntl; }
        else { if (lane == 0) tl[ntl] = (unsigned short)(2 * bb + 1); ++ntl; }
        if (lane == 0) tl[ntl] = (unsigned short)(2 * bb);
        ++ntl;
      }
    }
    nslc = ntl;
    const int ThiB = 2 * B + 1, TloB = ((64 * B - 511 > 0) ? (64 * B - 511) : 0) >> 5;
    for (int T = ThiB; T >= TloB; --T) { if (lane == 0) tl[ntl] = (unsigned short)T; ++ntl; }
  }
  float m = NEGB, l = 0.f;
  {
    const int n = ntl;
    const int Tlow = ((tok0 - 511 > 0) ? (tok0 - 511) : 0) >> 5, Thiw = (tok0 + 7) >> 5;
#define B_ISSUE(j_, slot_) { const int e_ = __builtin_amdgcn_readfirstlane((int)tl[j_]); if ((j_) < nslc) att_issue(ring, slot_, w, lane, ksf, vsf, e_); else att_issue(ring, slot_, w, lane, kwf, vwf, e_); }
    B_ISSUE(0, 0)
    if (n > 1) B_ISSUE(1, 1)
#pragma unroll 1
    for (int i = 0; i < n; ++i) {
      if ((i & 1) == 0) {
        asm volatile("s_waitcnt vmcnt(0)" ::: "memory");
        __builtin_amdgcn_s_barrier();
        asm volatile("" ::: "memory");
        if (i + 2 < n) B_ISSUE(i + 2, (i + 2) & 3)
        if (i + 3 < n) B_ISSUE(i + 3, (i + 3) & 3)
      }
      if (i == nslc) {
        l = hsum(l);
        const float inv = (l > 0.f) ? g1 / l : 0.f;
        ot_accum(otL, lane, Ob, inv);
        ot_store(otL, lane, Ob, 1.f);
        zero_o(Ob);
        m = NEGB; l = 0.f;
      }
      const int T = __builtin_amdgcn_readfirstlane((int)tl[i]);
      const int pos0 = 32 * T, pb = pos0 + 8 * h;
      bool full; bool mine = true;
      if (i < nslc) {
        const int bb = T >> 1;
        const unsigned uw = __builtin_amdgcn_readfirstlane(uniL[bb >> 5]);
        if (!((uw >> (bb & 31)) & 1u) || pos0 > tok0 + 7) continue;
        mine = (mskL[tokl * 8 + (bb >> 5)] >> (bb & 31)) & 1u;
        full = (pos0 + 31 <= tok0) && (__ballot(!mine) == 0ull);
      } else {
        if (T < Tlow || T > Thiw) continue;
        full = (pos0 + 31 <= tok0) && (pos0 >= tok0 + 7 - 511);
      }
      LAS3 const unsigned char* slot = ring + (i % ATT_R) * 16384;
      const f32x16 acc = qk_lds(slot, qf, lane);
      const float base = slope2 * (float)(pos0 + 8 * h - t);
      float sv[16], p[16];
#pragma unroll
      for (int rg = 0; rg < 16; ++rg) { const int kk = (rg & 7) + 16 * (rg >> 3); sv[rg] = fmaf(acc[rg], c1, fmaf(slope2, (float)kk, base)); }
      if (!full) {
        if (i < nslc) {
#pragma unroll
          for (int rg = 0; rg < 16; ++rg) { const int kk = (rg & 7) + 16 * (rg >> 3); sv[rg] = (mine && (pb + kk <= t)) ? sv[rg] : ninf; }
        } else {
#pragma unroll
          for (int rg = 0; rg < 16; ++rg) { const int kk = (rg & 7) + 16 * (rg >> 3); const int dw = t - (pb + kk); sv[rg] = ((dw >= 0) && (dw < 512)) ? sv[rg] : ninf; }
        }
      }
      osm_step(sv, m, l, Ob, p);
      pv_lds(slot + 8192, p, Ob, lane);
    }
#undef B_ISSUE
    l = hsum(l);
    const float inv = (l > 0.f) ? g2 / l : 0.f;
    ot_accum(otL, lane, Ob, inv);
  }
  {
    float ss = 0.f;
#pragma unroll
    for (int dt = 0; dt < 4; ++dt)
#pragma unroll
      for (int i = 0; i < 16; ++i) ss = fmaf(Ob[dt][i], Ob[dt][i], ss);
    ss = hsum(ss);
    const float rs = rsqrtf(ss * (1.f / 128.f) + 1e-6f);
    bf16_t* orow = P.mix + (size_t)t * DM + hd * 128 + 4 * h;
    const float* grow = P.hng + hd * 128 + 4 * h;
#pragma unroll
    for (int dt = 0; dt < 4; ++dt)
#pragma unroll
      for (int a = 0; a < 4; ++a) {
        const f32x4 gv = *(const f32x4*)(grow + 32 * dt + 8 * a);
        u32x2 wv2 = {pack2(Ob[dt][4 * a] * rs * gv[0], Ob[dt][4 * a + 1] * rs * gv[1]), pack2(Ob[dt][4 * a + 2] * rs * gv[2], Ob[dt][4 * a + 3] * rs * gv[3])};
        *(u32x2*)(orow + 32 * dt + 8 * a) = wv2;
      }
  }
  asm volatile("s_waitcnt vmcnt(0)" ::: "memory");
  __syncthreads();
}

__device__ void d_convmix(int t, int tl, const bf16_t* __restrict__ proj, const float* __restrict__ convw, const float* __restrict__ hng,
                          bf16_t* __restrict__ mix) {
  const int c = tl * 8;
  float acc[8];
#pragma unroll
  for (int i = 0; i < 8; ++i) acc[i] = 0.f;
#pragma unroll
  for (int j = 0; j < 3; ++j) {
    const int tt = t - 2 + j;
    if (tt >= 0) {
      const u32x4 cu = *(const u32x4*)(proj + (size_t)tt * INWP + OFF_C + c);
      const u32x4 uu = *(const u32x4*)(proj + (size_t)tt * INWP + OFF_U + c);
      const f32x4 w0 = *(const f32x4*)(convw + j * 1024 + c), w1 = *(const f32x4*)(convw + j * 1024 + c + 4);
#pragma unroll
      for (int i = 0; i < 4; ++i) {
        const unsigned a = cu[i], b = uu[i];
        const float wl = (i < 2) ? w0[2 * i] : w1[2 * i - 4], wh = (i < 2) ? w0[2 * i + 1] : w1[2 * i - 3];
        acc[2 * i] = fmaf(wl * __uint_as_float(a << 16), __uint_as_float(b << 16), acc[2 * i]);
        acc[2 * i + 1] = fmaf(wh * __uint_as_float(a & 0xFFFF0000u), __uint_as_float(b & 0xFFFF0000u), acc[2 * i + 1]);
      }
    }
  }
  const u32x4 bb = *(const u32x4*)(proj + (size_t)t * INWP + OFF_B + c);
  float ss = 0.f;
#pragma unroll
  for (int i = 0; i < 4; ++i) {
    const unsigned b = bb[i];
    acc[2 * i] *= __uint_as_float(b << 16); acc[2 * i + 1] *= __uint_as_float(b & 0xFFFF0000u);
    ss = fmaf(acc[2 * i], acc[2 * i], ss); ss = fmaf(acc[2 * i + 1], acc[2 * i + 1], ss);
  }
  ss += shx(ss, 8); ss += shx(ss, 4); ss += shx(ss, 2); ss += shx(ss, 1);
  const float rs = rsqrtf(ss * (1.f / 128.f) + 1e-6f);
  const f32x4 g0 = *(const f32x4*)(hng + 1024 + c), g1 = *(const f32x4*)(hng + 1024 + c + 4);
  u32x4 o = {pack2(acc[0] * rs * g0[0], acc[1] * rs * g0[1]), pack2(acc[2] * rs * g0[2], acc[3] * rs * g0[3]),
             pack2(acc[4] * rs * g1[0], acc[5] * rs * g1[1]), pack2(acc[6] * rs * g1[2], acc[7] * rs * g1[3])};
  *(u32x4*)(mix + (size_t)t * DM + 1024 + c) = o;
}

__device__ void d_ln_wave(int t, bf16_t* __restrict__ yh, const float* __restrict__ gam, const float* __restrict__ bet) {
  const int lane = TIDX & 63;
  float v[32];
#pragma unroll
  for (int i = 0; i < 4; ++i) {
    const u32x4 w = *(const u32x4*)(yh + (size_t)t * DM + 512 * i + 8 * lane);
#pragma unroll
    for (int j = 0; j < 4; ++j) { const unsigned ww = w[j]; v[i * 8 + 2 * j] = __uint_as_float(ww << 16); v[i * 8 + 2 * j + 1] = __uint_as_float(ww & 0xFFFF0000u); }
  }
  float s = 0.f;
#pragma unroll
  for (int i = 0; i < 32; ++i) s += v[i];
  s = wave_sum(s);
  const float mu = s * (1.f / DM);
  float q = 0.f;
#pragma unroll
  for (int i = 0; i < 32; ++i) { const float d = v[i] - mu; q = fmaf(d, d, q); }
  q = wave_sum(q);
  const float rs = rsqrtf(q * (1.f / DM) + 1e-5f);
#pragma unroll
  for (int i = 0; i < 4; ++i) {
    const int cb = 512 * i + 8 * lane;
    const f32x4 g0 = *(const f32x4*)(gam + cb), g1 = *(const f32x4*)(gam + cb + 4), b0 = *(const f32x4*)(bet + cb), b1 = *(const f32x4*)(bet + cb + 4);
    u32x4 o = {pack2((v[i * 8 + 0] - mu) * rs * g0[0] + b0[0], (v[i * 8 + 1] - mu) * rs * g0[1] + b0[1]), pack2((v[i * 8 + 2] - mu) * rs * g0[2] + b0[2], (v[i * 8 + 3] - mu) * rs * g0[3] + b0[3]),
               pack2((v[i * 8 + 4] - mu) * rs * g1[0] + b1[0], (v[i * 8 + 5] - mu) * rs * g1[1] + b1[1]), pack2((v[i * 8 + 6] - mu) * rs * g1[2] + b1[2], (v[i * 8 + 7] - mu) * rs * g1[3] + b1[3])};
    *(u32x4*)(yh + (size_t)t * DM + cb) = o;
  }
}

__device__ void d_cvt_w1f(size_t c, const float* __restrict__ w1, bf16_t* __restrict__ w1f) {
  const int lane = c & 63, ks = (c >> 6) & 255, ct = c >> 14;
  const int col = lane & 31, h = lane >> 5;
  bf16_t v[8];
#pragma unroll
  for (int j = 0; j < 8; ++j) v[j] = f2bf(w1[(size_t)(16 * ks + 8 * h + j) * 512 + 32 * ct + col]);
  u32x4 o; o.x = v[0] | ((unsigned)v[1] << 16); o.y = v[2] | ((unsigned)v[3] << 16); o.z = v[4] | ((unsigned)v[5] << 16); o.w = v[6] | ((unsigned)v[7] << 16);
  *(u32x4*)(w1f + c * 8) = o;
}
__device__ void d_cvt_w2f(size_t c, const float* __restrict__ w2, bf16_t* __restrict__ w2f) {
  const int lane = c & 63, s = (c >> 6) & 31, ct = c >> 11;
  const int col = lane & 31, h = lane >> 5;
  bf16_t v[8];
#pragma unroll
  for (int j = 0; j < 8; ++j) v[j] = f2bf(w2[(size_t)(16 * s + 8 * h + j) * 128 + 32 * ct + col]);
  u32x4 o; o.x = v[0] | ((unsigned)v[1] << 16); o.y = v[2] | ((unsigned)v[3] << 16); o.z = v[4] | ((unsigned)v[5] << 16); o.w = v[6] | ((unsigned)v[7] << 16);
  *(u32x4*)(w2f + c * 8) = o;
}
__device__ __forceinline__ void d_compress_unit(int rt, char* smem, const bf16_t* __restrict__ proj, int col0, const float* __restrict__ pos,
                                const bf16_t* __restrict__ w1f, const float* __restrict__ b1, const bf16_t* __restrict__ w2f,
                                bf16_t* __restrict__ outf, bool isV) {
  bf16_t* Xs = (bf16_t*)smem;
  bf16_t* Hs = (bf16_t*)(smem + 2 * 8704);
  const int tid = TIDX, lane = tid & 63, w = tid >> 6, c = lane & 31, h = lane >> 5;
  const int R0 = rt * 32;
  const int srow = tid >> 4, sch = tid & 15;
  const int grow = R0 + srow, sn = grow >> 1, sg = grow & 1;
  const bool svalid = grow < 2046;
  const bf16_t* sp = proj + (size_t)(16 * sn) * INWP + col0 + sg * 128 + sch * 8;
  f32x16 acc0, acc1;
#pragma unroll
  for (int i = 0; i < 16; ++i) { acc0[i] = 0.f; acc1[i] = 0.f; }
  u32x4 rx = {0u, 0u, 0u, 0u}; f32x4 rp0, rp1;
#define STAGE_WRITE(buf)                                                                                   \
  {                                                                                                        \
    u32x4 o_;                                                                                              \
    _Pragma("unroll") for (int i = 0; i < 4; ++i) {                                                        \
      const unsigned wv_ = rx[i];                                                                          \
      const float lo = __uint_as_float(wv_ << 16) + ((i < 2) ? rp0[2 * i] : rp1[2 * i - 4]);               \
      const float hi = __uint_as_float(wv_ & 0xFFFF0000u) + ((i < 2) ? rp0[2 * i + 1] : rp1[2 * i - 3]);   \
      o_[i] = pack2(lo, hi);                                                                               \
    }                                                                                                      \
    *(u32x4*)(Xs + (buf) * 4352 + srow * 136 + sch * 8) = o_;                                              \
  }
  if (svalid) rx = *(const u32x4*)(sp);
  rp0 = *(const f32x4*)(pos + sch * 8); rp1 = *(const f32x4*)(pos + sch * 8 + 4);
  STAGE_WRITE(0)
  __syncthreads();
  const bf16_t* wb0 = w1f + ((size_t)(2 * w) * 256 * 64 + lane) * 8;
  const bf16_t* wb1 = w1f + ((size_t)(2 * w + 1) * 256 * 64 + lane) * 8;
  bf16x8 bA[16], bB[16];
#define CMP_LOADB(BUF, L)                                                                      \
  _Pragma("unroll") for (int s8 = 0; s8 < 8; ++s8) {                                           \
    BUF[2 * s8] = *(const bf16x8*)(wb0 + (size_t)(8 * (L) + s8) * 512);                        \
    BUF[2 * s8 + 1] = *(const bf16x8*)(wb1 + (size_t)(8 * (L) + s8) * 512);                    \
  }
#define CMP_CHUNK(BUF, L)                                                                      \
  {                                                                                            \
    if ((L) + 1 < 32) {                                                                        \
      if (svalid) rx = *(const u32x4*)(sp + (size_t)((L) + 1) * INWP);                         \
      rp0 = *(const f32x4*)(pos + ((L) + 1) * 128 + sch * 8); rp1 = *(const f32x4*)(pos + ((L) + 1) * 128 + sch * 8 + 4); \
    }                                                                                          \
    const bf16_t* xa = Xs + ((L) & 1) * 4352 + c * 136 + 8 * h;                                \
    _Pragma("unroll") for (int s8 = 0; s8 < 8; ++s8) {                                         \
      const bf16x8 a = *(const bf16x8*)(xa + 16 * s8);                                         \
      acc0 = MFMA32(a, BUF[2 * s8], acc0);                                                     \
      acc1 = MFMA32(a, BUF[2 * s8 + 1], acc1);                                                 \
    }                                                                                          \
    if ((L) + 1 < 32) STAGE_WRITE(((L) + 1) & 1)                                               \
    __syncthreads();                                                                           \
  }
  CMP_LOADB(bA, 0)
#pragma unroll 1
  for (int l = 0; l < 32; l += 2) {
    CMP_LOADB(bB, l + 1)
    __builtin_amdgcn_sched_barrier(0);
    CMP_CHUNK(bA, l)
    { const int ln = (l + 2 < 32) ? l + 2 : l;
      CMP_LOADB(bA, ln) }
    __builtin_amdgcn_sched_barrier(0);
    CMP_CHUNK(bB, l + 1)
  }
#undef CMP_LOADB
#undef CMP_CHUNK
  {
    const float bb0 = b1[64 * w + c], bb1 = b1[64 * w + 32 + c];
#pragma unroll
    for (int rg = 0; rg < 16; ++rg) {
      const int row = (rg & 3) + 8 * (rg >> 2) + 4 * h;
      Hs[row * 520 + 64 * w + c] = f2bf(gelu_tanh(acc0[rg] + bb0));
      Hs[row * 520 + 64 * w + 32 + c] = f2bf(gelu_tanh(acc1[rg] + bb1));
    }
  }
  __syncthreads();
  if (w < 4) {
    f32x16 o2;
#pragma unroll
    for (int i = 0; i < 16; ++i) o2[i] = 0.f;
    const bf16_t* ha = Hs + c * 520 + 8 * h;
    const bf16_t* wb = w2f + ((size_t)w * 32 * 64 + lane) * 8;
#pragma unroll 8
    for (int s2 = 0; s2 < 32; ++s2) {
      const bf16x8 a = *(const bf16x8*)(ha + 16 * s2);
      const bf16x8 b = *(const bf16x8*)(wb + (size_t)s2 * 512);
      o2 = MFMA32(a, b, o2);
    }
    const int d = 32 * w + c;
#pragma unroll
    for (int rg = 0; rg < 16; ++rg) {
      const int row = R0 + (rg & 3) + 8 * (rg >> 2) + 4 * h;
      const int n = row >> 1, g = row & 1;
      const bf16_t val = (row < 2046) ? f2bf(o2[rg]) : (bf16_t)0;
      const int T = n >> 5, nn = n & 31;
      size_t idx;
      if (!isV) idx = ((((size_t)(g * 32 + T) * 8 + (d >> 4)) * 64 + (pi_perm(nn) + 32 * ((d >> 3) & 1))) * 8 + (d & 7));
      else idx = (((((size_t)(g * 32 + T) * 4 + (d >> 5)) * 2 + (nn >> 4)) * 64 + ((d & 31) + 32 * ((nn >> 3) & 1))) * 8 + (nn & 7));
      outf[idx] = val;
    }
  }
  __syncthreads();
}


DI unsigned f2sort(float f) { unsigned u = __float_as_uint(f); return u ^ ((unsigned)((int)u >> 31) | 0x80000000u); }
DI float sort2f(unsigned k) { unsigned u = (k & 0x80000000u) ? (k ^ 0x80000000u) : ~k; return __uint_as_float(u); }
template <int N>
DI void bitonic_sort_desc(unsigned (&key)[N]) {
#pragma unroll
  for (int k = 2; k <= N; k <<= 1) {
#pragma unroll
    for (int jj = k >> 1; jj > 0; jj >>= 1) {
#pragma unroll
      for (int i = 0; i < N; ++i) {
        const int l2 = i ^ jj;
        if (l2 > i) {
          const bool desc = ((i & k) == 0);
          unsigned a = key[i], b = key[l2];
          unsigned mx = a > b ? a : b, mn = a > b ? b : a;
          key[i] = desc ? mx : mn; key[l2] = desc ? mn : mx;
        }
      }
    }
  }
}
DI void merge_top16(unsigned (&a)[16], const unsigned (&b)[16]) {
#pragma unroll
  for (int i = 0; i < 16; ++i) { unsigned o = b[15 - i]; a[i] = a[i] > o ? a[i] : o; }
#pragma unroll
  for (int jj = 8; jj > 0; jj >>= 1) {
#pragma unroll
    for (int i = 0; i < 16; ++i) {
      const int l2 = i ^ jj;
      if (l2 > i) { unsigned x = a[i], y = a[l2]; a[i] = x > y ? x : y; a[l2] = x > y ? y : x; }
    }
  }
}
__device__ void d_cvt_subk(size_t c, const float* __restrict__ subk, bf16_t* __restrict__ skf) {
  int lane = c & 63, s = (c >> 6) & 7, kt = (c >> 9) & 3, hc = c >> 11;
  int i = lane & 31, h = lane >> 5;
  const float* src = subk + ((size_t)hc * 128 + 32 * kt + i) * 128 + 16 * s + 8 * h;
  bf16_t v[8];
#pragma unroll
  for (int j = 0; j < 8; ++j) v[j] = f2bf(src[j]);
  u32x4 o; o.x = v[0] | ((unsigned)v[1] << 16); o.y = v[2] | ((unsigned)v[3] << 16); o.z = v[4] | ((unsigned)v[5] << 16); o.w = v[6] | ((unsigned)v[7] << 16);
  *(u32x4*)(skf + c * 8) = o;
}

#define EPI_LANES()                                                                                                      \
    const int lane = fr | (fq << 4), rr = lane >> 2, rc = lane & 3;                                                       \
    PG8_LAS unsigned char* my = scr + (wr * 4 + wc) * 2048;                                                              \
    const int wo = fr * 64 + ((fq ^ ((fr >> 2) & 3)) << 4), ro = rr * 64 + ((rc ^ ((rr >> 2) & 3)) << 4);
struct EpiProjG {
  static constexpr bool PERM = true, AFTER_DRAIN = false;
  bf16_t* proj; float* gates; PG8_LAS unsigned char* scr;
  DI void operator()(const f32x4 (&acc)[2][2][4][2], const pg8::Unit& u, int wr, int wc, int fr, int fq) const {
    EPI_LANES()
#pragma unroll
    for (int ai = 0; ai < 2; ++ai)
#pragma unroll
      for (int bj = 0; bj < 2; ++bj) {
        const int c0 = u.pn * 256 + bj * 128 + wc * 32 + 8 * fq, cs = u.pn * 256 + bj * 128 + wc * 32 + 8 * rc;
#pragma unroll
        for (int mh = 0; mh < 2; ++mh) {
#pragma unroll
          for (int mm = 0; mm < 2; ++mm) {
            const f32x4 v0 = acc[ai][bj][mh * 2 + mm][0], v1 = acc[ai][bj][mh * 2 + mm][1];
            u32x4 w = {pack2(v0[0], v0[1]), pack2(v0[2], v0[3]), pack2(v1[0], v1[1]), pack2(v1[2], v1[3])};
            *(PG8_LAS u32x4*)(my + wo + mm * 1024) = w;
            if (c0 >= OFF_G && c0 < OFF_G + 24) {
              const int row = u.pm * 256 + ai * 128 + wr * 64 + (mh * 2 + mm) * 16 + fr;
              f32x4 g0, g1;
#pragma unroll
              for (int j = 0; j < 4; ++j) { g0[j] = 1.f / (1.f + __expf(-v0[j])); g1[j] = 1.f / (1.f + __expf(-v1[j])); }
              *(f32x4*)(gates + (size_t)row * 24 + (c0 - OFF_G)) = g0;
              *(f32x4*)(gates + (size_t)row * 24 + (c0 - OFF_G) + 4) = g1;
            }
          }
#pragma unroll
          for (int j = 0; j < 2; ++j) {
            const u32x4 w = *(const PG8_LAS u32x4*)(my + ro + j * 1024);
            const int row = u.pm * 256 + ai * 128 + wr * 64 + mh * 32 + j * 16 + rr;
            if (cs < INW) *(u32x4*)(proj + (size_t)row * INWP + cs) = w;
          }
        }
      }
  }
};
struct EpiResG {
  static constexpr bool PERM = true, AFTER_DRAIN = false;
  bf16_t* YB; PG8_LAS unsigned char* scr;
  DI void operator()(const f32x4 (&acc)[2][2][4][2], const pg8::Unit& u, int wr, int wc, int fr, int fq) const {
    EPI_LANES()
    bf16_t* yb = YB + (size_t)(u.pm * 256 + wr * 64 + rr) * DM + u.pn * 256 + wc * 32 + 8 * rc;
#pragma unroll
    for (int ai = 0; ai < 2; ++ai) {
      u32x4 xr[2][2][2];
#pragma unroll
      for (int bj = 0; bj < 2; ++bj)
#pragma unroll
        for (int mh = 0; mh < 2; ++mh)
#pragma unroll
          for (int j = 0; j < 2; ++j) xr[bj][mh][j] = *(const u32x4*)(yb + (size_t)(ai * 128 + mh * 32 + j * 16) * DM + bj * 128);
#pragma unroll
      for (int bj = 0; bj < 2; ++bj)
#pragma unroll
        for (int mh = 0; mh < 2; ++mh) {
#pragma unroll
          for (int mm = 0; mm < 2; ++mm) {
            const f32x4 v0 = acc[ai][bj][mh * 2 + mm][0], v1 = acc[ai][bj][mh * 2 + mm][1];
            u32x4 w = {pack2(v0[0], v0[1]), pack2(v0[2], v0[3]), pack2(v1[0], v1[1]), pack2(v1[2], v1[3])};
            *(PG8_LAS u32x4*)(my + wo + mm * 1024) = w;
          }
#pragma unroll
          for (int j = 0; j < 2; ++j) {
            const u32x4 a = *(const PG8_LAS u32x4*)(my + ro + j * 1024), xw = xr[bj][mh][j];
            u32x4 o;
#pragma unroll
            for (int q = 0; q < 4; ++q) {
              const unsigned aw = a[q], xq = xw[q];
              o[q] = pack2(fmaf(ALPHA, __uint_as_float(xq << 16), __uint_as_float(aw << 16)), fmaf(ALPHA, __uint_as_float(xq & 0xFFFF0000u), __uint_as_float(aw & 0xFFFF0000u)));
            }
            *(u32x4*)(yb + (size_t)(ai * 128 + mh * 32 + j * 16) * DM + bj * 128) = o;
          }
        }
    }
  }
};
struct EpiF32G {
  static constexpr bool PERM = false, AFTER_DRAIN = false;
  float* C; int ldc;
  DI void operator()(const f32x4 (&acc)[2][2][4][2], const pg8::Unit& u, int wr, int wc, int fr, int fq) const {
#pragma unroll
    for (int ai = 0; ai < 2; ++ai)
#pragma unroll
      for (int m = 0; m < 4; ++m) {
        const size_t ro = (size_t)(u.pm * 256 + ai * 128 + wr * 64 + m * 16 + fr) * ldc + u.pn * 256 + wc * 32 + 4 * fq;
#pragma unroll
        for (int bj = 0; bj < 2; ++bj)
#pragma unroll
          for (int n = 0; n < 2; ++n) *(f32x4*)(C + ro + bj * 128 + n * 16) = acc[ai][bj][m][n];
      }
  }
};
struct EpiRouteG {
  static constexpr bool PERM = false, AFTER_DRAIN = true;
  const bf16_t* skf; unsigned* tops;
  DI void operator()(const f32x4 (&)[2][2][4][2], const pg8::Unit&, int, int, int, int) const {}
  DI void fused(const f32x4 (&acc)[2][2][4][2], const pg8::Unit& u, int wr, int wc, int fr, int fq, PG8_LAS unsigned char* ldsp, int, int) const {
    const int lane = fr | (fq << 4), wid = wr * 4 + wc;
    bf16_t* Qs = (bf16_t*)ldsp;
#pragma unroll
    for (int ai = 0; ai < 2; ++ai)
#pragma unroll
      for (int m = 0; m < 4; ++m) {
        const int row = ai * 128 + wr * 64 + m * 16 + fr;
#pragma unroll
        for (int bj = 0; bj < 2; ++bj)
#pragma unroll
          for (int n = 0; n < 2; ++n) {
            const f32x4 v = acc[ai][bj][m][n];
            u32x2 w = {pack2(v[0], v[1]), pack2(v[2], v[3])};
            *(u32x2*)(Qs + row * 264 + bj * 128 + wc * 32 + n * 16 + 4 * fq) = w;
          }
      }
    __syncthreads();
    const int c = lane & 31, h = lane >> 5;
    unsigned kA[16], kB[16];
#pragma unroll 1
    for (int half = 0; half < 2; ++half) {
      const int hc = u.pn * 2 + half;
      const bf16_t* sk = skf + (size_t)hc * 4 * 4096;
      const bf16_t* qp = Qs + (wid * 32 + c) * 264 + half * 128 + 8 * h;
      unsigned k0[16], k1[16];
#define ROUTE_KT(KT, KA)                                                                        \
      {                                                                                         \
        f32x16 sc;                                                                              \
        _Pragma("unroll") for (int i = 0; i < 16; ++i) sc[i] = 0.f;                             \
        _Pragma("unroll") for (int s = 0; s < 8; ++s) {                                         \
          bf16x8 af = *(const bf16x8*)(sk + (KT) * 4096 + s * 512 + lane * 8);                  \
          bf16x8 bq = *(const bf16x8*)(qp + 16 * s);                                            \
          sc = __builtin_amdgcn_mfma_f32_32x32x16_bf16(af, bq, sc, 0, 0, 0);                    \
        }                                                                                       \
        _Pragma("unroll") for (int rg = 0; rg < 16; ++rg) {                                     \
          const int kidx = 32 * (KT) + (rg & 3) + 8 * (rg >> 2) + 4 * h;                        \
          KA[rg] = (f2sort(sc[rg]) & 0xFFFFFF80u) | (unsigned)(127 - kidx);                     \
        }                                                                                       \
        bitonic_sort_desc<16>(KA);                                                              \
      }
      ROUTE_KT(0, k0)
      __builtin_amdgcn_sched_barrier(0);
      ROUTE_KT(1, k1)
      merge_top16(k0, k1);
      __builtin_amdgcn_sched_barrier(0);
      ROUTE_KT(2, k1)
      merge_top16(k0, k1);
      __builtin_amdgcn_sched_barrier(0);
      ROUTE_KT(3, k1)
      merge_top16(k0, k1);
      __builtin_amdgcn_sched_barrier(0);
#undef ROUTE_KT
#pragma unroll
      for (int i = 0; i < 16; ++i) k1[i] = (unsigned)shx_i((int)k0[i], 32);
      merge_top16(k0, k1);
      if (half == 0) {
#pragma unroll
        for (int i = 0; i < 16; ++i) kA[i] = k0[i];
      } else {
#pragma unroll
        for (int i = 0; i < 16; ++i) kB[i] = k0[i];
      }
    }
    {
      unsigned* lk = (unsigned*)(ldsp + wid * 16896);
#pragma unroll
      for (int i = 0; i < 16; ++i) { lk[i * 64 + lane] = kA[i]; lk[(16 + i) * 64 + lane] = kB[i]; }
      float fa[16], fb[16];
#pragma unroll
      for (int i = 0; i < 16; ++i) { fa[i] = sort2f(kA[i]); fb[i] = sort2f(kB[i]); }
#define CAND(ci_, cj_) ((f2sort(fa[ci_] + fb[cj_]) & 0xFFFFFF00u) | (unsigned)(255 - ((ci_) * 16 + (cj_))))
      unsigned R0[16], R1[16], S1[16], S2[16];
#pragma unroll
      for (int j = 0; j < 16; ++j) { R0[j] = CAND(0, j); R1[j] = (j < 8) ? CAND(1, j & 7) : 0u; }
      S1[0] = CAND(2, 0); S1[1] = CAND(2, 1); S1[2] = CAND(2, 2); S1[3] = CAND(2, 3); S1[4] = CAND(2, 4);
      S1[5] = CAND(3, 0); S1[6] = CAND(3, 1); S1[7] = CAND(3, 2); S1[8] = CAND(3, 3);
      S1[9] = CAND(4, 0); S1[10] = CAND(4, 1); S1[11] = CAND(4, 2);
      S1[12] = CAND(5, 0); S1[13] = CAND(5, 1); S1[14] = CAND(6, 0); S1[15] = CAND(6, 1);
      S2[0] = CAND(7, 0); S2[1] = CAND(7, 1);
#pragma unroll
      for (int i = 8; i < 16; ++i) S2[i - 6] = CAND(i, 0);
#pragma unroll
      for (int i = 10; i < 16; ++i) S2[i] = 0u;
#undef CAND
      merge_top16(R0, R1);
      bitonic_sort_desc<16>(S1); bitonic_sort_desc<16>(S2);
      merge_top16(S1, S2);
      merge_top16(R0, S1);
      float sc[16]; unsigned ex[16]; float mx = -3.0e38f;
#pragma unroll
      for (int i = 0; i < 16; ++i) {
        const int flat = 255 - (int)(R0[i] & 255u);
        const unsigned ka = lk[(flat >> 4) * 64 + lane], kb = lk[(16 + (flat & 15)) * 64 + lane];
        sc[i] = sort2f(ka) + sort2f(kb);
        ex[i] = (127u - (ka & 127u)) * 128u + (127u - (kb & 127u));
        mx = fmaxf(mx, sc[i]);
      }
      float sm = 0.f;
#pragma unroll
      for (int i = 0; i < 16; ++i) { sc[i] = __expf(sc[i] - mx); sm += sc[i]; }
      const float rsm = 1.f / sm;
      unsigned* dst = tops + (size_t)(u.pm * 256 + wid * 32 + c) * 256 + h * 128 + u.pn * 16;
#pragma unroll
      for (int q4 = 0; q4 < 4; ++q4) {
        u32x4 o;
#pragma unroll
        for (int i = 0; i < 4; ++i) o[i] = h ? __float_as_uint(sc[4 * q4 + i] * rsm) : ex[4 * q4 + i];
        *(u32x4*)(dst + 4 * q4) = o;
      }
    }
    __syncthreads();
  }
};


template <int CTRL> DI float dpp_f(float v) { const int iv = __float_as_int(v); return __int_as_float(__builtin_amdgcn_update_dpp(iv, iv, CTRL, 0xF, 0xF, false)); }
DI float wsum(float x) {
  x += dpp_f<0xB1>(x);
  x += dpp_f<0x4E>(x);
  x += dpp_f<0x124>(x);
  x += dpp_f<0x128>(x);
  x += shx(x, 16);
  return hsum(x);
}
DI float gelu_fast(float x) {
  const float u2 = 1.5957691216057308f * (x + 0.044715f * x * x * x);
  return x * __builtin_amdgcn_rcpf(1.f + ex2(-LOG2E * u2));
}

constexpr int EROW = 1024;
typedef float v2f __attribute__((ext_vector_type(2)));
__device__ void d_cvt_fp4_row(int row, const float* __restrict__ src, unsigned char* __restrict__ dst, float* __restrict__ scales) {
  const int lane = TIDX & 63;
  float v[32]; float amax = 0.f;
#pragma unroll
  for (int i = 0; i < 8; ++i) {
    f32x4 x = *(const f32x4*)(src + (size_t)row * DM + 256 * i + 4 * lane);
#pragma unroll
    for (int j = 0; j < 4; ++j) { v[i * 4 + j] = x[j]; amax = fmaxf(amax, fabsf(x[j])); }
  }
  amax = wave_max(amax);
  const float sc = amax > 0.f ? amax * (1.f / 7.f) : 1.f;
  const float inv = 1.f / sc;
  u32x4 o;
#pragma unroll
  for (int k = 0; k < 4; ++k) {
    unsigned w = 0u;
#define FP4C(x_) fminf(fmaxf((x_) * inv, -6.f), 6.f)
    w = __builtin_amdgcn_cvt_scalef32_pk_fp4_f32(w, FP4C(v[8 * k + 0]), FP4C(v[8 * k + 1]), 1.0f, 0);
    w = __builtin_amdgcn_cvt_scalef32_pk_fp4_f32(w, FP4C(v[8 * k + 2]), FP4C(v[8 * k + 3]), 1.0f, 1);
    w = __builtin_amdgcn_cvt_scalef32_pk_fp4_f32(w, FP4C(v[8 * k + 4]), FP4C(v[8 * k + 5]), 1.0f, 2);
    w = __builtin_amdgcn_cvt_scalef32_pk_fp4_f32(w, FP4C(v[8 * k + 6]), FP4C(v[8 * k + 7]), 1.0f, 3);
#undef FP4C
    o[k] = w;
  }
  *(u32x4*)(dst + (size_t)row * EROW + 16 * lane) = o;
  if (lane == 0) scales[row] = sc;
}
__device__ void d_cvt_i4_row(int row, const float* __restrict__ src, unsigned char* __restrict__ dst, float* __restrict__ scales) {
  const int lane = TIDX & 63;
  float v[32]; float amax = 0.f, ss = 0.f;
#pragma unroll
  for (int i = 0; i < 8; ++i) {
    f32x4 x = *(const f32x4*)(src + (size_t)row * DM + 256 * i + 4 * lane);
#pragma unroll
    for (int j = 0; j < 4; ++j) { v[i * 4 + j] = x[j]; amax = fmaxf(amax, fabsf(x[j])); ss = fmaf(x[j], x[j], ss); }
  }
  amax = wave_max(amax); ss = wave_sum(ss);
  float sc = fmaxf(0.36f * sqrtf(ss * (1.f / DM)), amax * (1.f / 14.f));
  sc = sc > 0.f ? sc : 1.f;
  const float inv = 1.f / sc;
  u32x4 o;
#pragma unroll
  for (int k = 0; k < 4; ++k) {
    unsigned w = 0u;
#pragma unroll
    for (int j = 0; j < 8; ++j) {
      const float q = fminf(fmaxf(v[8 * k + j] * inv, -7.f), 7.f) + 12582912.f;
      w |= (__float_as_uint(q) & 15u) << (4 * j);
    }
    o[k] = w;
  }
  *(u32x4*)(dst + (size_t)row * EROW + 16 * lane) = o;
  if (lane == 0) scales[row] = sc;
}
__device__ void d_expert_group(int tg0, int tstr, unsigned* tpl, unsigned* slw, const bf16_t* __restrict__ hbuf, const unsigned* __restrict__ tops,
                               const unsigned char* __restrict__ eu4, const unsigned char* __restrict__ ev4, const float* __restrict__ esu, const float* __restrict__ esv,
                               const float* __restrict__ gam, const float* __restrict__ bet, float* __restrict__ out) {
  const int lane = TIDX & 63;
#define SLOT(j_, f_) slw[((j_) * 16 + (f_)) * 64 + lane]
#pragma unroll 1
  for (int j = 0; j < 4; ++j) {
    const int tt = tg0 + j * tstr, t = tt < S ? tt : S - 1;
  float hv[32];
#pragma unroll
  for (int i = 0; i < 8; ++i) {
    const u32x2 w = *(const u32x2*)(hbuf + (size_t)t * DM + 256 * i + 4 * lane);
    hv[i * 4 + 0] = __uint_as_float(w[0] << 16); hv[i * 4 + 1] = __uint_as_float(w[0] & 0xFFFF0000u);
    hv[i * 4 + 2] = __uint_as_float(w[1] << 16); hv[i * 4 + 3] = __uint_as_float(w[1] & 0xFFFF0000u);
  }
  int e0 = (int)tops[(size_t)t * 256 + lane], e1 = (int)tops[(size_t)t * 256 + 64 + lane];
  float w0 = __uint_as_float(tops[(size_t)t * 256 + 128 + lane]), w1 = __uint_as_float(tops[(size_t)t * 256 + 192 + lane]);
  {
    unsigned k0 = ((unsigned)e0 << 7) | (unsigned)lane, k1 = ((unsigned)e1 << 7) | (unsigned)(64 + lane);
#pragma unroll
    for (int k = 2; k <= 128; k <<= 1) {
#pragma unroll
      for (int jj = k >> 1; jj > 0; jj >>= 1) {
        if (jj == 64) { const unsigned mn = k0 < k1 ? k0 : k1, mx = k0 < k1 ? k1 : k0; k0 = mn; k1 = mx; }
        else {
          const unsigned o0 = (unsigned)shx_i((int)k0, jj), o1 = (unsigned)shx_i((int)k1, jj);
          const bool lower = (lane & jj) == 0;
          const bool asc0 = (k >= 64) ? true : ((lane & k) == 0), asc1 = (k == 128) ? true : (k == 64) ? false : ((lane & k) == 0);
          const unsigned mn0 = k0 < o0 ? k0 : o0, mx0 = k0 < o0 ? o0 : k0, mn1 = k1 < o1 ? k1 : o1, mx1 = k1 < o1 ? o1 : k1;
          k0 = (lower == asc0) ? mn0 : mx0; k1 = (lower == asc1) ? mn1 : mx1;
        }
      }
    }
    const int o0 = (int)(k0 & 127u), o1 = (int)(k1 & 127u);
    const float wa0 = __shfl(w0, o0 & 63), wb0 = __shfl(w1, o0 & 63), wa1 = __shfl(w0, o1 & 63), wb1 = __shfl(w1, o1 & 63);
    e0 = (int)(k0 >> 7); e1 = (int)(k1 >> 7); w0 = (o0 < 64) ? wa0 : wb0; w1 = (o1 < 64) ? wa1 : wb1;
  }
  int hhi[4], hlo[4]; float hsc;
  {
    float m = 0.f;
#pragma unroll
    for (int i = 0; i < 32; ++i) m = fmaxf(m, fabsf(hv[i]));
    m = wave_max(m);
    hsc = m > 0.f ? m * (1.f / 119.f) : 1.f;
    const float hinv = 1.f / hsc;
#pragma unroll
    for (int q = 0; q < 4; ++q) {
      unsigned wh = 0u, wl = 0u;
#pragma unroll
      for (int j = 0; j < 8; ++j) {
        const unsigned b = __float_as_uint(fmaf(hv[8 * q + j], hinv, 12582912.f));
        wl |= (b & 15u) << (4 * j); wh |= (((b + 8u) >> 4) & 15u) << (4 * j);
      }
      hhi[q] = (int)wh; hlo[q] = (int)wl;
    }
  }
    const float su0 = esu[e0], su1 = esu[e1], sv0 = esv[e0], sv1 = esv[e1];
#pragma unroll
    for (int q = 0; q < 4; ++q) { SLOT(j, q) = (unsigned)hhi[q]; SLOT(j, 4 + q) = (unsigned)hlo[q]; }
    SLOT(j, 8) = (unsigned)e0; SLOT(j, 9) = (unsigned)e1;
    SLOT(j, 10) = __float_as_uint(hsc * su0); SLOT(j, 11) = __float_as_uint(hsc * su1);
    SLOT(j, 12) = __float_as_uint(w0 * sv0); SLOT(j, 13) = __float_as_uint(w1 * sv1);
  }
  u32x4 rA[4], rB[4];
  const unsigned lo16 = (unsigned)(16 * lane);
#define G_LOAD(R, TAB, EX, LB)                                                             \
  _Pragma("unroll") for (int k = 0; k < 4; ++k) {                                          \
    const int id = __builtin_amdgcn_readlane((EX), (LB) + k);                              \
    R[k] = *(const u32x4*)((TAB) + (size_t)id * EROW + lo16);                              \
  }
#define PKFMA(a_, b_, c_) __builtin_elementwise_fma((a_), (b_), (c_))
  const int srcb = 4 * (((lane & 1) << 5) | ((lane & 2) << 3));
#define G_COMP_U(R, LB)                                                                    \
  {                                                                                        \
    int dd[4];                                                                             \
    _Pragma("unroll") for (int k = 0; k < 4; ++k) {                                        \
      int dh = 0, dl = 0;                                                                  \
      _Pragma("unroll") for (int q = 0; q < 4; ++q) {                                      \
        dh = __builtin_amdgcn_sdot8((int)R[k][q], hhi[q], dh, false);                      \
        dl = __builtin_amdgcn_sdot8((int)R[k][q], hlo[q], dl, false);                      \
      }                                                                                    \
      dd[k] = dh * 16 + dl;                                                                \
      __builtin_amdgcn_sched_barrier(0);                                                   \
    }                                                                                      \
    unsigned t01, t23;                                                                     \
    { auto r_ = __builtin_amdgcn_permlane32_swap((unsigned)dd[0], (unsigned)dd[1], false, false); t01 = r_[0] + r_[1]; }     \
    { auto r_ = __builtin_amdgcn_permlane32_swap((unsigned)dd[2], (unsigned)dd[3], false, false); t23 = r_[0] + r_[1]; }     \
    const bool b4_ = (lane & 16) != 0;                                                     \
    int tv = (int)(b4_ ? t23 : t01) + shx_i((int)(b4_ ? t01 : t23), 16);                   \
    tv += dpp_i<0x128>(tv); tv += dpp_i<0x124>(tv); tv += dpp_i<0x4E>(tv); tv += dpp_i<0xB1>(tv);   \
    const int got = __builtin_amdgcn_ds_bpermute(srcb, tv);                                \
    cc = ((unsigned)(lane - (LB)) < 4u) ? got : cc;                                        \
    __builtin_amdgcn_sched_barrier(0);                                                     \
  }
#define G_COMP_V(R, ACC, CF, LB)                                                           \
  _Pragma("unroll") for (int k = 0; k < 4; ++k) {                                          \
    const float cs = __int_as_float(__builtin_amdgcn_readlane(__float_as_int(CF), (LB) + k));   \
    const v2f cs2 = {cs, cs};                                                              \
    _Pragma("unroll") for (int q = 0; q < 4; ++q) {                                        \
      const unsigned wq = R[k][q];                                                         \
      const v2f f0 = __builtin_amdgcn_cvt_scalef32_pk_f32_fp4(wq, 1.0f, 0), f1 = __builtin_amdgcn_cvt_scalef32_pk_f32_fp4(wq, 1.0f, 1); \
      const v2f f2 = __builtin_amdgcn_cvt_scalef32_pk_f32_fp4(wq, 1.0f, 2), f3 = __builtin_amdgcn_cvt_scalef32_pk_f32_fp4(wq, 1.0f, 3); \
      ACC[4 * q + 0] = PKFMA(cs2, f0, ACC[4 * q + 0]); ACC[4 * q + 1] = PKFMA(cs2, f1, ACC[4 * q + 1]); \
      ACC[4 * q + 2] = PKFMA(cs2, f2, ACC[4 * q + 2]); ACC[4 * q + 3] = PKFMA(cs2, f3, ACC[4 * q + 3]); \
    }                                                                                      \
    __builtin_amdgcn_sched_barrier(0);                                                     \
  }
  {
    int eX = (int)SLOT(0, 8);
    G_LOAD(rA, eu4, eX, 0)
    __builtin_amdgcn_sched_barrier(0);
#pragma unroll 1
    for (int s_ = 0; s_ < 32; ++s_) {
      const int sg = s_ >> 2, j = s_ & 3, L0 = (sg & 3) * 16;
      const int sn = (s_ + 1) & 31, sgn = sn >> 2, jn = sn & 3, L0n = (sgn & 3) * 16;
      int hhi[4], hlo[4];
#pragma unroll
      for (int q = 0; q < 4; ++q) { hhi[q] = (int)SLOT(j, q); hlo[q] = (int)SLOT(j, 4 + q); }
      const int eXn = (int)SLOT(jn, 8 + (sgn >> 2));
      const unsigned char* tabn = (s_ == 31) ? ev4 : eu4;
      int cc = 0;
      G_LOAD(rB, eu4, eX, L0 + 4)
      __builtin_amdgcn_sched_barrier(0);
      G_COMP_U(rA, L0)
      G_LOAD(rA, eu4, eX, L0 + 8)
      __builtin_amdgcn_sched_barrier(0);
      G_COMP_U(rB, L0 + 4)
      G_LOAD(rB, eu4, eX, L0 + 12)
      __builtin_amdgcn_sched_barrier(0);
      G_COMP_U(rA, L0 + 8)
      G_LOAD(rA, tabn, eXn, L0n)
      __builtin_amdgcn_sched_barrier(0);
      G_COMP_U(rB, L0 + 12)
      if ((unsigned)(lane - L0) < 16u) SLOT(j, 14 + (sg >> 2)) = (unsigned)cc;
      eX = eXn;
    }
  }
#pragma unroll 1
  for (int j = 0; j < 4; ++j) {
    const float d0 = (float)(int)SLOT(j, 14), d1 = (float)(int)SLOT(j, 15);
    SLOT(j, 14) = __float_as_uint(__uint_as_float(SLOT(j, 12)) * gelu_fast(__uint_as_float(SLOT(j, 10)) * d0));
    SLOT(j, 15) = __float_as_uint(__uint_as_float(SLOT(j, 13)) * gelu_fast(__uint_as_float(SLOT(j, 11)) * d1));
  }
  v2f accv[4][16];
#pragma unroll
  for (int j = 0; j < 4; ++j)
#pragma unroll
    for (int i = 0; i < 16; ++i) accv[j][i] = v2f{0.f, 0.f};
  {
    int eX = (int)SLOT(0, 8);
#pragma unroll 1
    for (int sg = 0; sg < 8; ++sg) {
      const int L0 = (sg & 3) * 16;
#pragma unroll
      for (int j = 0; j < 4; ++j) {
        const int jn = (j + 1) & 3, sgn = (j == 3) ? ((sg + 1) & 7) : sg, L0n = (sgn & 3) * 16;
        const float cf = __uint_as_float(SLOT(j, 14 + (sg >> 2)));
        const int eXn = (int)SLOT(jn, 8 + (sgn >> 2));
        G_LOAD(rB, ev4, eX, L0 + 4)
        __builtin_amdgcn_sched_barrier(0);
        G_COMP_V(rA, accv[j], cf, L0)
        G_LOAD(rA, ev4, eX, L0 + 8)
        __builtin_amdgcn_sched_barrier(0);
        G_COMP_V(rB, accv[j], cf, L0 + 4)
        G_LOAD(rB, ev4, eX, L0 + 12)
        __builtin_amdgcn_sched_barrier(0);
        G_COMP_V(rA, accv[j], cf, L0 + 8)
        G_LOAD(rA, ev4, eXn, L0n)
        __builtin_amdgcn_sched_barrier(0);
        G_COMP_V(rB, accv[j], cf, L0 + 12)
        eX = eXn;
      }
    }
  }
#undef G_LOAD
#undef G_COMP_U
#undef G_COMP_V
#undef PKFMA
#pragma unroll
  for (int j = 0; j < 4; ++j) {
    const int t = tg0 + j * tstr;
    if (t < S) {
#define acc2 accv[j]
  float acc[32];
  #pragma unroll
    for (int i = 0; i < 16; ++i) { acc[2 * i] = acc2[i].x; acc[2 * i + 1] = acc2[i].y; }
    int le = lane;
    asm volatile("" : "+v"(le) :: "memory");
    float s = 0.f;
  #pragma unroll
    for (int i = 0; i < 8; ++i) {
      const u32x2 w = *(const u32x2*)(hbuf + (size_t)t * DM + 256 * i + 4 * le);
      const float h0 = __uint_as_float(w[0] << 16), h1 = __uint_as_float(w[0] & 0xFFFF0000u), h2 = __uint_as_float(w[1] << 16), h3 = __uint_as_float(w[1] & 0xFFFF0000u);
      acc[i * 4 + 0] = fmaf(ALPHA, h0, acc[i * 4 + 0]); acc[i * 4 + 1] = fmaf(ALPHA, h1, acc[i * 4 + 1]);
      acc[i * 4 + 2] = fmaf(ALPHA, h2, acc[i * 4 + 2]); acc[i * 4 + 3] = fmaf(ALPHA, h3, acc[i * 4 + 3]);
      s += (acc[i * 4 + 0] + acc[i * 4 + 1]) + (acc[i * 4 + 2] + acc[i * 4 + 3]);
    }
    s = wsum(s);
    const float mu = s * (1.f / DM);
    float qv = 0.f;
  #pragma unroll
    for (int i = 0; i < 32; ++i) { const float d = acc[i] - mu; qv += d * d; }
    qv = wsum(qv);
    const float rs = rsqrtf(qv * (1.f / DM) + 1e-5f);
  #pragma unroll
    for (int i = 0; i < 8; ++i) {
      const int cbase = 256 * i + 4 * le;
      f32x4 ga = *(const f32x4*)(gam + cbase), ba = *(const f32x4*)(bet + cbase), o;
  #pragma unroll
      for (int j = 0; j < 4; ++j) o[j] = (acc[i * 4 + j] - mu) * rs * ga[j] + ba[j];
      *(f32x4*)(out + (size_t)t * DM + cbase) = o;
    }
#undef acc2
    }
  }
#undef SLOT
}

constexpr size_t al256(size_t x) { return (x + 255) & ~(size_t)255; }
constexpr size_t WS_XB = 0;
constexpr size_t WS_PROJ = WS_XB + al256((size_t)S * DM * 2);
constexpr size_t WS_WINT = WS_PROJ + al256((size_t)S * INWP * 2);
constexpr size_t WS_GATES = WS_WINT + al256((size_t)INWG * DM * 2);
constexpr size_t WS_W1KF = WS_GATES + al256((size_t)S * 24 * 4);
constexpr size_t WS_W1VF = WS_W1KF + al256((size_t)512 * 4096 * 2);
constexpr size_t WS_W2KF = WS_W1VF + al256((size_t)512 * 4096 * 2);
constexpr size_t WS_W2VF = WS_W2KF + al256((size_t)512 * 128 * 2);
constexpr size_t WS_VC = WS_W2VF + al256((size_t)512 * 128 * 2) - al256((size_t)2048 * 128 * 4);
constexpr size_t WS_KCF = WS_VC + al256((size_t)2048 * 128 * 4);
constexpr size_t WS_VCF = WS_KCF + al256((size_t)2 * 32 * 4096 * 2);
constexpr size_t WS_KSF = WS_VCF + al256((size_t)2 * 32 * 4096 * 2);
constexpr size_t WS_VSF = WS_KSF + al256((size_t)2 * 512 * 4096 * 2);
constexpr size_t WS_KWF = WS_VSF + al256((size_t)2 * 512 * 4096 * 2);
constexpr size_t WS_VWF = WS_KWF + al256((size_t)2 * 512 * 4096 * 2);
constexpr size_t WS_ENDA = WS_VWF + al256((size_t)2 * 512 * 4096 * 2);
constexpr size_t WS_OATT = WS_ENDA;
constexpr size_t WS_MIX = WS_OATT + al256((size_t)S * 1024 * 4);
constexpr size_t WS_WOUTT = WS_MIX + al256((size_t)S * DM * 2);
constexpr size_t WS_WQT = WS_WOUTT + al256((size_t)DM * DM * 2);
constexpr size_t WS_TOPS = WS_WQT + al256((size_t)DM * DM * 2);
constexpr size_t WS_SKF = WS_TOPS + al256((size_t)S * 256 * 4);
constexpr size_t WS_STATS = WS_SKF + al256((size_t)16 * 128 * 128 * 2);
constexpr size_t WS_CTRL = WS_STATS + al256((size_t)S * 2 * 4);
constexpr size_t CTRL_BYTES = 32768;
constexpr size_t WS_END = WS_CTRL + CTRL_BYTES;
constexpr size_t WS_Y = WS_PROJ;
constexpr size_t WS_HB = WS_XB;
constexpr size_t WS_EU8 = WS_OATT;
constexpr size_t WS_EV8 = WS_EU8 + (size_t)16384 * 1024;
constexpr size_t WS_ESU = WS_EV8 + (size_t)16384 * 1024;
constexpr size_t WS_ESV = WS_ESU + 16384 * 4;
static_assert(WS_ESV + 16384 * 4 <= WS_MIX, "expert tables overflow their region");
constexpr int EXP_EARLY = 6144;
static_assert(WS_END <= (size_t)512 * 1024 * 1024, "workspace over 512 MiB");

struct Params {
  const float *x, *w_in, *ck_pos, *ck_w1, *ck_b1, *ck_w2, *cv_pos, *cv_w1, *cv_b1, *cv_w2, *conv_w, *hng, *w_out, *ln1g, *ln1b, *w_query, *subk,
      *eu, *ev, *ln2g, *ln2b;
  float* out;
  char* ws;
};
#define WSP(T, OFF) ((T*)(p.ws + (OFF)))

#define FOR_VB(n) for (int vb = blockIdx.x; vb < (n); vb += gridDim.x)
#define FOR_VB2(n) for (int vb = blockIdx.x * 2 + (TIDX >> 8); vb < (n); vb += gridDim.x * 2)
constexpr int SMEM_BYTES = 147456;
constexpr int HALF = 36864;

__global__ void __launch_bounds__(512) mega(Params p) {
  __shared__ __attribute__((aligned(16))) char smem[SMEM_BYTES + 16];
  if (TIDX == 0) *(u32x4*)(smem + SMEM_BYTES) = u32x4{0u, 0u, 0u, 0u};
  __syncthreads();
  const XcdBarrier xbar = xcd_barrier_post(WSP(unsigned, WS_CTRL + 1024), (volatile LAS unsigned*)(smem + SMEM_BYTES));
#define smh (smem + (TIDX >> 8) * HALF)
#define wv ((TIDX >> 6))
  constexpr int NWV = 8;
  d_cvt(p.x, WSP(bf16_t, WS_XB), (size_t)S * DM / 4);
  FOR_VB2((INWG / 64) * (DM / 64)) d_cvtT64(vb, smh, p.w_in, WSP(bf16_t, WS_WINT), DM, INW, INWG);
  for (size_t c = (size_t)blockIdx.x * 512 + TIDX; c < (size_t)16 * 256 * 64; c += (size_t)gridDim.x * 512) {
    d_cvt_w1f(c, p.ck_w1, WSP(bf16_t, WS_W1KF)); d_cvt_w1f(c, p.cv_w1, WSP(bf16_t, WS_W1VF));
    if (c < (size_t)4 * 32 * 64) { d_cvt_w2f(c, p.ck_w2, WSP(bf16_t, WS_W2KF)); d_cvt_w2f(c, p.cv_w2, WSP(bf16_t, WS_W2VF)); }
  }
  FOR_VB2((DM / 64) * (DM / 64)) d_cvtT64(vb, smh, p.w_out, WSP(bf16_t, WS_WOUTT), DM, DM, DM);
  FOR_VB2((DM / 64) * (DM / 64)) d_cvtT64(vb, smh, p.w_query, WSP(bf16_t, WS_WQT), DM, DM, DM);
  for (size_t c = (size_t)blockIdx.x * 512 + TIDX; c < (size_t)16 * 4 * 8 * 64; c += (size_t)gridDim.x * 512) d_cvt_subk(c, p.subk, WSP(bf16_t, WS_SKF));
  xcd_barrier(xbar);
  {
    pg8::StaticOrder so; so.init(S, INWG, gridDim.x, blockIdx.x);
    pg8::gemm_phase<EpiProjG, pg8::StaticOrder>((PG8_LAS unsigned char*)smem, pg8::Gemm{WSP(bf16_t, WS_XB), WSP(bf16_t, WS_WINT), S, INWG, DM}, so,
                                                EpiProjG{WSP(bf16_t, WS_PROJ), WSP(float, WS_GATES), (PG8_LAS unsigned char*)smem + pg8::STAGE_BYTES}, nullptr);
    const int nun = (S / 256) * (INWG / 256), gsz = (int)gridDim.x;
    const int nfull = nun % gsz;
    if (nfull != 0 && (int)blockIdx.x >= nfull) {
      const int nidle = gsz - nfull, me = (int)blockIdx.x - nfull;
      for (int r = me * NWV + wv; r < 2 * EXP_EARLY; r += nidle * NWV) {
        if (r < EXP_EARLY) d_cvt_i4_row(r, p.eu, WSP(unsigned char, WS_EU8), WSP(float, WS_ESU)); else d_cvt_fp4_row(r - EXP_EARLY, p.ev, WSP(unsigned char, WS_EV8), WSP(float, WS_ESV));
      }
    }
  }
  xcd_barrier(xbar);
  {
    if (blockIdx.x < 128) {
      const int xcd_ = blockIdx.x & 7, idx_ = blockIdx.x >> 3; const bool isV = (xcd_ & 1) != 0;
      d_compress_unit((xcd_ >> 1) * 16 + idx_, smem, WSP(bf16_t, WS_PROJ), isV ? OFF_VC : OFF_KC, isV ? p.cv_pos : p.ck_pos, isV ? WSP(bf16_t, WS_W1VF) : WSP(bf16_t, WS_W1KF),
                      isV ? p.cv_b1 : p.ck_b1, isV ? WSP(bf16_t, WS_W2VF) : WSP(bf16_t, WS_W2KF), isV ? WSP(bf16_t, WS_VCF) : WSP(bf16_t, WS_KCF), isV);
    }
    int* slot = (int*)smem;
    unsigned* ctr = WSP(unsigned, WS_CTRL);
    for (;;) {
      if (TIDX == 0) *slot = (int)atomicAdd(ctr, 1u);
      __syncthreads();
      const int it = *slot;
      __syncthreads();
      if (it >= 2048) break;
      const int tt = TIDX;
      {
        const int T = it >> 2, which = it & 3;
        d_relayout_tile(T, smem + 64, WSP(bf16_t, WS_PROJ), (which == 0) ? OFF_KS : (which == 1) ? OFF_VS : (which == 2) ? OFF_KW : OFF_VW,
                        (which == 0) ? WSP(bf16_t, WS_KSF) : (which == 1) ? WSP(bf16_t, WS_VSF) : (which == 2) ? WSP(bf16_t, WS_KWF) : WSP(bf16_t, WS_VWF), (which & 1) != 0);
      }
      for (int q = 0; q < 2; ++q) d_convmix(it * 8 + q * 4 + (tt >> 7), tt & 127, WSP(bf16_t, WS_PROJ), p.conv_w, p.hng, WSP(bf16_t, WS_MIX));
    }
  }
  xcd_barrier(xbar);
  {
    AttnPtrs ap{WSP(bf16_t, WS_PROJ), WSP(float, WS_GATES), WSP(bf16_t, WS_KCF), WSP(bf16_t, WS_VCF), WSP(bf16_t, WS_KSF), WSP(bf16_t, WS_VSF), WSP(bf16_t, WS_KWF), WSP(bf16_t, WS_VWF), WSP(bf16_t, WS_MIX), p.hng};
    for (int it = blockIdx.x; it < 512; it += gridDim.x) {
      const int Bq = (it < 256) ? it : (511 - it), gq = (it < 256) ? 0 : 1;
      d_attn_block(Bq, gq, smem, ap);
    }
  }
  xcd_barrier(xbar);
  {
    pg8::StaticOrder so; so.init(S, DM, gridDim.x, blockIdx.x);
    pg8::gemm_phase<EpiResG, pg8::StaticOrder>((PG8_LAS unsigned char*)smem, pg8::Gemm{WSP(bf16_t, WS_MIX), WSP(bf16_t, WS_WOUTT), S, DM, DM}, so,
                                               EpiResG{WSP(bf16_t, WS_HB), (PG8_LAS unsigned char*)smem + pg8::STAGE_BYTES}, nullptr);
  }
  xcd_barrier(xbar);
  for (int r = blockIdx.x * NWV + wv; r < S; r += gridDim.x * NWV) d_ln_wave(r, WSP(bf16_t, WS_HB), p.ln1g, p.ln1b);
  {
    const int e0_ = (((S / 256) * (INWG / 256)) % (int)gridDim.x != 0) ? EXP_EARLY : 0;
    const int nrest = 16384 - e0_;
    for (int r = blockIdx.x * NWV + wv; r < 2 * nrest; r += gridDim.x * NWV) {
      if (r < nrest) d_cvt_i4_row(e0_ + r, p.eu, WSP(unsigned char, WS_EU8), WSP(float, WS_ESU)); else d_cvt_fp4_row(e0_ + r - nrest, p.ev, WSP(unsigned char, WS_EV8), WSP(float, WS_ESV));
    }
  }
  xcd_barrier(xbar);
  for (int k = 0; k * (int)gridDim.x < (S / 256) * (DM / 256); ++k) {
    pg8::OneUnit so; so.init(S, DM, gridDim.x, blockIdx.x); so.k = k;
    pg8::gemm_phase<EpiRouteG, pg8::OneUnit>((PG8_LAS unsigned char*)smem, pg8::Gemm{WSP(bf16_t, WS_HB), WSP(bf16_t, WS_WQT), S, DM, DM}, so,
                                             EpiRouteG{WSP(bf16_t, WS_SKF), WSP(unsigned, WS_TOPS)}, nullptr);
    __syncthreads();
  }
  xcd_barrier(xbar);
  {
    const int tstr = (int)gridDim.x * NWV;
    for (int tg0 = blockIdx.x * NWV + wv; tg0 < S; tg0 += 4 * tstr)
      d_expert_group(tg0, tstr, (unsigned*)(smem + wv * 1024), (unsigned*)(smem + 8192 + wv * 16384), WSP(bf16_t, WS_HB), WSP(unsigned, WS_TOPS), WSP(unsigned char, WS_EU8), WSP(unsigned char, WS_EV8),
                     WSP(float, WS_ESU), WSP(float, WS_ESV), p.ln2g, p.ln2b, p.out);
  }
}

extern "C" void kernel_launch(void* const* d_in, const int* in_sizes, int n_in, void* d_out, int out_size, void* d_ws, size_t ws_size,
                              hipStream_t stream) {
  Params p{};
  p.x = (const float*)d_in[0]; p.w_in = (const float*)d_in[1]; p.ck_pos = (const float*)d_in[2]; p.ck_w1 = (const float*)d_in[3];
  p.ck_b1 = (const float*)d_in[4]; p.ck_w2 = (const float*)d_in[5]; p.cv_pos = (const float*)d_in[6]; p.cv_w1 = (const float*)d_in[7];
  p.cv_b1 = (const float*)d_in[8]; p.cv_w2 = (const float*)d_in[9]; p.conv_w = (const float*)d_in[10]; p.hng = (const float*)d_in[11];
  p.w_out = (const float*)d_in[12]; p.ln1g = (const float*)d_in[13]; p.ln1b = (const float*)d_in[14]; p.w_query = (const float*)d_in[15];
  p.subk = (const float*)d_in[16]; p.eu = (const float*)d_in[17]; p.ev = (const float*)d_in[18]; p.ln2g = (const float*)d_in[19];
  p.ln2b = (const float*)d_in[20];
  p.out = (float*)d_out;
  p.ws = (char*)d_ws;
  if (ws_size < WS_END) fprintf(stderr, "workspace too small\n");
  static int grid_blocks = 0;
  if (!grid_blocks) {
    int dev = 0, cus = 0, per_cu = 0;
    hipGetDevice(&dev);
    hipDeviceGetAttribute(&cus, hipDeviceAttributeMultiprocessorCount, dev);
    hipOccupancyMaxActiveBlocksPerMultiprocessor(&per_cu, mega, 512, 0);
    if (per_cu > 1) per_cu = 1;
    if (per_cu < 1) per_cu = 1;
    grid_blocks = cus * per_cu;
  }
  hipMemsetAsync((char*)d_ws + WS_CTRL, 0, CTRL_BYTES, stream);
  void* args[] = {&p};
  hipError_t e = hipLaunchCooperativeKernel((void*)mega, dim3(grid_blocks), dim3(512), args, 0, stream);
  if (e != hipSuccess) fprintf(stderr, "cooperative launch failed: %s (grid %d)\n", hipGetErrorString(e), grid_blocks);
}
```

```cpp
#include <hip/hip_runtime.h>
#include <stdint.h>
#include <stdio.h>


#define DI __device__ __forceinline__
static __device__ __forceinline__ int tidx_() { int t = (int)__builtin_amdgcn_workitem_id_x(); asm volatile("" : "+v"(t)); return t; }
#define TIDX (tidx_())

template <int J> DI int swz_xor(int x) { return __builtin_amdgcn_ds_swizzle(x, (J << 10) | 0x1F); }
template <int CTRL> DI int dpp_i(int x) { return __builtin_amdgcn_update_dpp(x, x, CTRL, 0xF, 0xF, false); }
DI int shx_i(int x, int j) {
  switch (j) {
    case 1: return dpp_i<0xB1>(x);
    case 2: return dpp_i<0x4E>(x);
    case 4: return dpp_i<0x1B>(dpp_i<0x141>(x));
    case 8: return dpp_i<0x128>(x);
    case 16: return swz_xor<16>(x);
    default: {
      auto r = __builtin_amdgcn_permlane32_swap((unsigned)x, (unsigned)x, false, false);
      return (TIDX & 32) ? (int)r[0] : (int)r[1];
    }
  }
}
DI float shx(float x, int j) { return __int_as_float(shx_i(__float_as_int(x), j)); }
typedef unsigned short bf16_t;
using bf16x8 = __attribute__((ext_vector_type(8))) short;
using f32x4 = __attribute__((ext_vector_type(4))) float;
using u32x4 = __attribute__((ext_vector_type(4))) unsigned;
using u32x2 = __attribute__((ext_vector_type(2))) unsigned;

constexpr int S = 16384, DM = 2048, HD = 128;
constexpr int INW = 5656, INWP = 5760, INWG = 5888;
constexpr int OFF_Q = 0, OFF_KC = 1024, OFF_VC = 1280, OFF_KS = 1536, OFF_VS = 1792, OFF_KW = 2048, OFF_VW = 2304,
              OFF_G = 2560, OFF_U = 2584, OFF_B = 3608, OFF_C = 4632;
constexpr int NCMP = 1023;
constexpr float ALPHA = 1.189207115002721f;
constexpr float QSCALE = 0.08838834764831845f;

DI bf16_t f2bf(float x) { unsigned u = __float_as_uint(x); u += 0x7fffu + ((u >> 16) & 1u); return (bf16_t)(u >> 16); }
DI float bf2f(bf16_t b) { return __uint_as_float(((unsigned)b) << 16); }
DI float gelu_tanh(float x) { float u = 0.7978845608028654f * (x + 0.044715f * x * x * x); return 0.5f * x * (1.f + tanhf(u)); }
DI float wave_sum(float v) { for (int o = 32; o > 0; o >>= 1) v += shx(v, o); return v; }
using bf16x2v = __attribute__((ext_vector_type(2))) __bf16;
DI unsigned pack2(float a, float b) { bf16x2v v = {(__bf16)a, (__bf16)b}; return __builtin_bit_cast(unsigned, v); }
DI float wave_max(float v) { for (int o = 32; o > 0; o >>= 1) v = fmaxf(v, shx(v, o)); return v; }

namespace pg8 {
#define PG8_LAS __attribute__((address_space(3)))
typedef unsigned short bf16_t;
typedef short bf16x8 __attribute__((ext_vector_type(8)));
typedef float f32x4 __attribute__((ext_vector_type(4)));
typedef unsigned u32x4 __attribute__((ext_vector_type(4)));
constexpr int BM = 256, BK = 64, HALF = 128, HTB = HALF * BK * 2  , STAGE_BYTES = 8 * HTB, NXCD = 8, WGM = 8;

__host__ __device__ __forceinline__ int lds_byte(int r, int c) { const int st = (r >> 4) * 2 + (c >> 5), rr = r & 15, cc = c & 31, ob = rr * 64 + cc * 2; return st * 1024 + (ob ^ (((ob >> 9) & 1) << 5)); }
__host__ __device__ __forceinline__ void stage_rc(int b, int& R, int& C) { const int st = b / 1024, sb = b % 1024, swz = sb ^ (((sb >> 9) & 1) << 5); R = (st >> 1) * 16 + swz / 64; C = (st & 1) * 32 + (swz % 64) / 2; }
__host__ __device__ __forceinline__ int perm32(int rho) { const int n = rho >> 4, i = rho & 15; return 8 * (i >> 2) + 4 * n + (i & 3); }

struct Unit { int pm, pn; };
struct Gemm { const bf16_t* A; const bf16_t* Bt; int M, N, K; };

struct StaticOrder {
    int nM, nN, nwg, G, c;
    __host__ __device__ void init(int M, int N, int G_, int c_) { nM = M / BM; nN = N / BM; nwg = nM * nN; G = G_; c = c_; }
    __host__ __device__ bool next(int i, Unit& u) const {
        const long L = (long)i * G + c; if (L >= nwg) return false;
        int wgid = (int)L; { const int q = nwg / NXCD, r = nwg % NXCD, xcd = wgid % NXCD, off = wgid / NXCD; wgid = (xcd < r ? xcd * (q + 1) : r * (q + 1) + (xcd - r) * q) + off; }
        const int nig = WGM * nN, gid = wgid / nig, fm = gid * WGM, gsz = (nM - fm) < WGM ? (nM - fm) : WGM;
        u.pm = fm + ((wgid % nig) % gsz); u.pn = (wgid % nig) / gsz; return true;
    }
    __device__ __forceinline__ void a_ready(const Unit&) const {}
    __device__ __forceinline__ void done(const Unit&) const {}
};
struct OneUnit : StaticOrder {
    int k;
    __device__ bool next(int i, Unit& u) const { if (i > 0) return false; return StaticOrder::next(k, u); }
};
__device__ __forceinline__ unsigned cvt_pk_bf16(float lo, float hi) { unsigned r; asm volatile("v_cvt_pk_bf16_f32 %0, %1, %2" : "=v"(r) : "v"(lo), "v"(hi)); return r; }
template <class Epi, class Sched, bool STAMP = false>
__device__ __forceinline__ void gemm_phase(PG8_LAS unsigned char* lds, const Gemm g, const Sched& S, const Epi& E, unsigned long long* stamps) {
    const int tid = TIDX, wid = __builtin_amdgcn_readfirstlane(tid >> 6), lane = tid & 63, wr = wid >> 2, wc = wid & 3, fr = lane & 15, fq = lane >> 4;
    const int K = g.K, nt = K / BK;
    int ts_lo = 0, ts_hi = 0, nts = 0; const unsigned long long rt_entry = STAMP ? (unsigned long long)wall_clock64() : 0ull;
#define PG8_STAMP() do { if (STAMP && wid == 0 && nts < 64) { const unsigned long long _c = (unsigned long long)clock64(); \
        ts_lo = (lane == nts) ? (int)(unsigned)_c : ts_lo; ts_hi = (lane == nts) ? (int)(unsigned)(_c >> 32) : ts_hi; ++nts; } } while (0)
    PG8_STAMP();
    unsigned voffA[2], voffB[2];
#pragma unroll
    for (int i = 0; i < 2; ++i) { int R, C; stage_rc(tid * 16 + i * 8192, R, C); const int Rb = Epi::PERM ? ((R & ~31) + perm32(R & 31)) : R;
        voffA[i] = (unsigned)(R * K + C) * 2u; voffB[i] = (unsigned)(Rb * K + C) * 2u; }
    const size_t kstep = (size_t)(BK * 2);
    const size_t hstep = (size_t)HALF * K * 2;
    const size_t tstep = 2 * hstep;
    const unsigned ldsw = (unsigned)wid * 1024u;
    const int aoff = lds_byte(wr * 64 + fr, fq * 8), boff = lds_byte(wc * 32 + fr, fq * 8);
#define PG8_SA(b, h) (((b) * 2 + (h)) * HTB)
#define PG8_SB(b, h) ((4 + (b) * 2 + (h)) * HTB)
#define PG8_STAGE(bufoff, gbase, voff) do { _Pragma("unroll") for (int _i = 0; _i < 2; ++_i) \
        __builtin_amdgcn_global_load_lds((const unsigned*)((const char*)(gbase) + (voff)[_i]), (PG8_LAS unsigned*)(lds + (bufoff) + ldsw + _i * 8192), 16, 0, 0); } while (0)
#define PG8_LDA(dst, b, h) do { _Pragma("unroll") for (int m = 0; m < 4; ++m) _Pragma("unroll") for (int k = 0; k < 2; ++k) dst[m][k] = *(const PG8_LAS bf16x8*)(lds + PG8_SA(b, h) + aoff + m * 2048 + k * 1024); } while (0)
#define PG8_LDB(dst, b, h) do { _Pragma("unroll") for (int n = 0; n < 2; ++n) _Pragma("unroll") for (int k = 0; k < 2; ++k) dst[n][k] = *(const PG8_LAS bf16x8*)(lds + PG8_SB(b, h) + boff + n * 2048 + k * 1024); } while (0)
#define PG8_MMA(ai, bj, At, Bt) do { __builtin_amdgcn_s_setprio(1); _Pragma("unroll") for (int m = 0; m < 4; ++m) _Pragma("unroll") for (int n = 0; n < 2; ++n) _Pragma("unroll") for (int k = 0; k < 2; ++k) \
        acc[ai][bj][m][n] = __builtin_amdgcn_mfma_f32_16x16x32_bf16(Bt[n][k], At[m][k], acc[ai][bj][m][n], 0, 0, 0); __builtin_amdgcn_s_setprio(0); } while (0)
#define PG8_WAIT_V(n) asm volatile("s_waitcnt vmcnt(" #n ")" ::: "memory")
#define PG8_WAIT_L(n) asm volatile("s_waitcnt lgkmcnt(" #n ")" ::: "memory")
#define PG8_BAR __builtin_amdgcn_s_barrier()
#define PG8_SCHED __builtin_amdgcn_sched_barrier(0)
    Unit cur, nxt; int ui = 0;
    if (!S.next(0, cur)) return;
    f32x4 acc[2][2][4][2];
#pragma unroll
    for (int a = 0; a < 2; ++a)
#pragma unroll
        for (int b = 0; b < 2; ++b)
#pragma unroll
            for (int m = 0; m < 4; ++m)
#pragma unroll
                for (int n = 0; n < 2; ++n) acc[a][b][m][n] = (f32x4){0.f, 0.f, 0.f, 0.f};
    bf16x8 At[4][2], B0[2][2], B1[2][2];
    const char* cA = (const char*)g.A + (size_t)cur.pm * tstep; const char* cB = (const char*)g.Bt + (size_t)cur.pn * tstep;
    S.a_ready(cur);
    PG8_STAGE(PG8_SB(0, 0), cB, voffB); PG8_STAGE(PG8_SA(0, 0), cA, voffA); PG8_STAGE(PG8_SB(0, 1), cB + hstep, voffB); PG8_STAGE(PG8_SA(0, 1), cA + hstep, voffA);
    if (wr == 1) PG8_BAR;
    PG8_WAIT_V(4); PG8_BAR;
    PG8_STAGE(PG8_SB(1, 0), cB + kstep, voffB); PG8_STAGE(PG8_SA(1, 0), cA + kstep, voffA); PG8_STAGE(PG8_SB(1, 1), cB + hstep + kstep, voffB);
    PG8_WAIT_V(6); PG8_BAR;
    PG8_STAMP();
    for (;;) {
        const bool has_next = S.next(ui + 1, nxt);
        const char* nA = has_next ? (const char*)g.A + (size_t)nxt.pm * tstep : cA; const char* nB = has_next ? (const char*)g.Bt + (size_t)nxt.pn * tstep : cB;
        for (int t = 0; t < nt; t += 2) {
            const bool last = (t == nt - 2);
            const char* a1 = cA + (size_t)(t + 1) * kstep;
            const char* a2 = last ? nA : cA + (size_t)(t + 2) * kstep; const char* b2 = last ? nB : cB + (size_t)(t + 2) * kstep;
            const char* a3 = a2 + kstep; const char* b3 = b2 + kstep;
            if (last && has_next) S.a_ready(nxt);
            PG8_LDB(B0, 0, 0); PG8_SCHED; PG8_LDA(At, 0, 0); PG8_STAGE(PG8_SA(1, 1), a1 + hstep, voffA);
            PG8_WAIT_L(8); PG8_BAR; PG8_WAIT_L(0); PG8_MMA(0, 0, At, B0); PG8_BAR; PG8_SCHED;
            PG8_LDB(B1, 0, 1); PG8_STAGE(PG8_SB(0, 0), b2, voffB);
            PG8_BAR; PG8_WAIT_L(0); PG8_MMA(0, 1, At, B1); PG8_BAR;
            PG8_LDA(At, 0, 1); PG8_STAGE(PG8_SA(0, 0), a2, voffA);
            PG8_BAR; PG8_WAIT_L(0); PG8_MMA(1, 0, At, B0); PG8_BAR; PG8_SCHED;
            PG8_STAGE(PG8_SB(0, 1), b2 + hstep, voffB);
            PG8_WAIT_V(6); PG8_BAR; PG8_MMA(1, 1, At, B1); PG8_BAR;
            PG8_LDB(B0, 1, 0); PG8_SCHED; PG8_LDA(At, 1, 0); PG8_STAGE(PG8_SA(0, 1), a2 + hstep, voffA);
            PG8_WAIT_L(8); PG8_BAR; PG8_WAIT_L(0); PG8_MMA(0, 0, At, B0); PG8_BAR; PG8_SCHED;
            PG8_LDB(B1, 1, 1); PG8_STAGE(PG8_SB(1, 0), b3, voffB);
            PG8_BAR; PG8_WAIT_L(0); PG8_MMA(0, 1, At, B1); PG8_BAR;
            PG8_LDA(At, 1, 1); PG8_STAGE(PG8_SA(1, 0), a3, voffA);
            PG8_BAR; PG8_WAIT_L(0); PG8_MMA(1, 0, At, B0); PG8_BAR; PG8_SCHED;
            PG8_STAGE(PG8_SB(1, 1), b3 + hstep, voffB);
            PG8_WAIT_V(6); PG8_BAR; PG8_MMA(1, 1, At, B1); PG8_BAR;
        }
        PG8_STAMP();
        if constexpr (!Epi::AFTER_DRAIN) { E(acc, cur, wr, wc, fr, fq); S.done(cur); }
        PG8_STAMP();
        if (!has_next) break;
#pragma unroll
        for (int a = 0; a < 2; ++a)
#pragma unroll
            for (int b = 0; b < 2; ++b)
#pragma unroll
                for (int m = 0; m < 4; ++m)
#pragma unroll
                    for (int n = 0; n < 2; ++n) acc[a][b][m][n] = (f32x4){0.f, 0.f, 0.f, 0.f};
        cur = nxt; cA = nA; cB = nB; ++ui;
    }
    PG8_WAIT_V(0);
    if (wr == 0) PG8_BAR;
    PG8_BAR;
    if constexpr (Epi::AFTER_DRAIN) { E.fused(acc, cur, wr, wc, fr, fq, lds, wid, lane); S.done(cur); }
    PG8_STAMP();
    if (STAMP && wid == 0) { stamps[lane] = lane < nts ? (((unsigned long long)(unsigned)ts_hi << 32) | (unsigned)ts_lo) : 0ull;
        if (lane == 62) stamps[62] = rt_entry; if (lane == 63) stamps[63] = (unsigned long long)wall_clock64(); }
#undef PG8_STAMP
#undef PG8_SA
#undef PG8_SB
#undef PG8_STAGE
#undef PG8_LDA
#undef PG8_LDB
#undef PG8_MMA
#undef PG8_WAIT_V
#undef PG8_WAIT_L
#undef PG8_BAR
#undef PG8_SCHED
}
}

#define XB_TMO      128
#define XB_XCNT(j)  (256  + 64 * (j))
#define XB_XSUB(j)  (1280 + 64 * (j))
#define XB_XGEN(j)  (2304 + 64 * (j))
#define XB_TOP      3328
#define XB_TOPGEN   3392
#define XCD_BAR_WORDS 3456
#define XB_SPIN_CAP (1u << 18)
#define LAS __attribute__((address_space(3)))

__device__ __forceinline__ unsigned xb_ld(unsigned* p)              { return __hip_atomic_load(p, __ATOMIC_RELAXED, __HIP_MEMORY_SCOPE_AGENT); }
__device__ __forceinline__ unsigned xb_add(unsigned* p, unsigned v) { return __hip_atomic_fetch_add(p, v, __ATOMIC_RELAXED, __HIP_MEMORY_SCOPE_AGENT); }
__device__ __forceinline__ unsigned xb_xcc_id() { return (unsigned)__builtin_amdgcn_s_getreg((3 << 11) | 20) & 0xFu; }
#define XB_SPIN(cond, bar) do { unsigned _sp = 0; while (cond) { __builtin_amdgcn_s_sleep(1); \
    if ((++_sp & 255u) == 0u) { if (xb_ld(&(bar)[XB_TMO])) break; if (_sp > XB_SPIN_CAP) { atomicAdd(&(bar)[XB_TMO], 1u); break; } } } } while (0)

struct XcdBarrier {
    unsigned* bar; unsigned x;
    volatile LAS unsigned* st;
};

__device__ __forceinline__ XcdBarrier xcd_barrier_post(unsigned* bar, volatile LAS unsigned* st) {
    XcdBarrier b; b.bar = bar; b.x = xb_xcc_id(); b.st = st;
    if (TIDX == 0) (void)xb_add(&bar[XB_XCNT(b.x)], 1u);
    return b;
}
__device__ __forceinline__ void xcd_barrier_complete(unsigned* bar, unsigned x, unsigned& nloc, unsigned& nx) {
    const unsigned G = gridDim.x * gridDim.y * gridDim.z;
    unsigned sum, cnt, mine, sp = 0u;
    for (;;) {
        sum = 0u; cnt = 0u; mine = 0u;
#pragma unroll
        for (unsigned j = 0; j < 16; ++j) { const unsigned c = xb_ld(&bar[XB_XCNT(j)]); sum += c; cnt += (c > 0u) ? 1u : 0u; mine = (j == x) ? c : mine; }
        if (sum == G) break;
        __builtin_amdgcn_s_sleep(1);
        if ((++sp & 255u) == 0u) { if (xb_ld(&bar[XB_TMO])) break; if (sp > XB_SPIN_CAP) { atomicAdd(&bar[XB_TMO], 1u); break; } }
    }
    nloc = mine > 0u ? mine : 1u; nx = cnt > 0u ? cnt : 1u;
}

__device__ __forceinline__ void xcd_barrier(const XcdBarrier& b) {
    asm volatile("s_waitcnt vmcnt(0)" ::: "memory");
    __syncthreads();
    if (TIDX == 0) {
        unsigned* bar = b.bar;
        __builtin_amdgcn_s_waitcnt(0);
        unsigned nloc = b.st[0], nx = b.st[1];
        if (nloc == 0u) { xcd_barrier_complete(bar, b.x, nloc, nx); b.st[0] = nloc; b.st[1] = nx; }
        const unsigned old = xb_add(&bar[XB_XSUB(b.x)], 1u);
        const unsigned gen = old / nloc;
        if (old + 1u == (gen + 1u) * nloc) {
            __builtin_amdgcn_fence(__ATOMIC_RELEASE, "agent");
            asm volatile("s_waitcnt vmcnt(0)" ::: "memory");
            const unsigned og = xb_add(&bar[XB_TOP], 1u);
            const unsigned tg = og / nx;
            if (og + 1u == (tg + 1u) * nx) xb_add(&bar[XB_TOPGEN], 1u);
            else XB_SPIN(xb_ld(&bar[XB_TOPGEN]) == tg, bar);
            __builtin_amdgcn_fence(__ATOMIC_ACQUIRE, "agent");
            xb_add(&bar[XB_XGEN(b.x)], 1u);
            asm volatile("s_waitcnt vmcnt(0)" ::: "memory");
        } else {
            XB_SPIN(xb_ld(&bar[XB_XGEN(b.x)]) == gen, bar);
            __builtin_amdgcn_fence(__ATOMIC_ACQUIRE, "agent");
            asm volatile("s_waitcnt vmcnt(0)" ::: "memory");
        }
    }
    __syncthreads();
}

__device__ void d_cvt(const float* __restrict__ in, bf16_t* __restrict__ out, size_t n4) {
  const size_t stride = (size_t)gridDim.x * blockDim.x;
  size_t i = (size_t)blockIdx.x * blockDim.x + TIDX;
  for (; i + 3 * stride < n4; i += 4 * stride) {
    f32x4 v[4];
#pragma unroll
    for (int q = 0; q < 4; ++q) v[q] = ((const f32x4*)in)[i + q * stride];
#pragma unroll
    for (int q = 0; q < 4; ++q) { u32x2 o = {pack2(v[q][0], v[q][1]), pack2(v[q][2], v[q][3])}; ((u32x2*)out)[i + q * stride] = o; }
  }
  for (; i < n4; i += stride) { const f32x4 v = ((const f32x4*)in)[i]; u32x2 o = {pack2(v[0], v[1]), pack2(v[2], v[3])}; ((u32x2*)out)[i] = o; }
}
__device__ void d_cvtT64(int vb, char* smem, const float* __restrict__ W, bf16_t* __restrict__ WT, int K, int N, int NP) {
  float (*tt)[65] = (float (*)[65])smem;
  const int tid = (TIDX & 255);
  const int nbx = NP / 64;
  const int n0 = (vb % nbx) * 64, k0 = (vb / nbx) * 64;
  {
    const int kr = tid >> 4, nc = (tid & 15) * 4;
#pragma unroll
    for (int i = 0; i < 4; ++i) {
      const int k = k0 + kr + 16 * i, n = n0 + nc;
      f32x4 v = {0.f, 0.f, 0.f, 0.f};
      if (n < N) v = *(const f32x4*)(W + (size_t)k * N + n);
      tt[kr + 16 * i][nc] = v[0]; tt[kr + 16 * i][nc + 1] = v[1]; tt[kr + 16 * i][nc + 2] = v[2]; tt[kr + 16 * i][nc + 3] = v[3];
    }
  }
  __syncthreads();
  {
    const int nr = tid >> 3, kc = (tid & 7) * 8;
#pragma unroll
    for (int i = 0; i < 2; ++i) {
      const int nl = nr + 32 * i;
      u32x4 o = {pack2(tt[kc][nl], tt[kc + 1][nl]), pack2(tt[kc + 2][nl], tt[kc + 3][nl]), pack2(tt[kc + 4][nl], tt[kc + 5][nl]), pack2(tt[kc + 6][nl], tt[kc + 7][nl])};
      *(u32x4*)(WT + (size_t)(n0 + nl) * K + k0 + kc) = o;
    }
  }
  __syncthreads();
}

using f32x16 = __attribute__((ext_vector_type(16))) float;
using bf16x8v = __attribute__((ext_vector_type(8))) __bf16;
#define MFMA32(a, b, c) __builtin_amdgcn_mfma_f32_32x32x16_bf16((a), (b), (c), 0, 0, 0)
constexpr float LOG2E = 1.4426950408889634f;
constexpr float NEGB = -1e30f;
DI int pi_perm(int i) { return (i & ~12) | ((i & 8) >> 1) | ((i & 4) << 1); }
DI bf16x8 pack8(float a0, float a1, float a2, float a3, float a4, float a5, float a6, float a7) {
  bf16x8v v = {(__bf16)a0, (__bf16)a1, (__bf16)a2, (__bf16)a3, (__bf16)a4, (__bf16)a5, (__bf16)a6, (__bf16)a7};
  return __builtin_bit_cast(bf16x8, v);
}
__device__ __forceinline__ void d_relayout_tile(int T, char* smem, const bf16_t* __restrict__ proj, int col0, bf16_t* __restrict__ dst, bool isV) {
  bf16_t* Ls = (bf16_t*)smem;
  const int tid = TIDX;
#pragma unroll
  for (int q = 0; q < 2; ++q) {
    const int cidx = tid + q * 512;
    const int g = cidx >> 9, tok = (cidx >> 4) & 31, ch = cidx & 15;
    const u32x4 v = *(const u32x4*)(proj + (size_t)(32 * T + tok) * INWP + col0 + g * 128 + ch * 8);
    *(u32x4*)(Ls + (g * 32 + tok) * 136 + ch * 8) = v;
  }
  __syncthreads();
#pragma unroll
  for (int q = 0; q < 2; ++q) {
    const int oc = tid + q * 512;
    const int g = oc >> 9, r9 = oc & 511, lane = r9 & 63;
    u32x4 o;
    if (!isV) {
      const int s8 = r9 >> 6, i = lane & 31, h = lane >> 5;
      o = *(const u32x4*)(Ls + (g * 32 + pi_perm(i)) * 136 + 16 * s8 + 8 * h);
    } else {
      const int s2 = (r9 >> 6) & 1, dt = r9 >> 7, dd = lane & 31, h = lane >> 5;
      const bf16_t* col = Ls + (g * 32 + 16 * s2 + 8 * h) * 136 + 32 * dt + dd;
      unsigned short e[8];
#pragma unroll
      for (int j = 0; j < 8; ++j) e[j] = col[j * 136];
      o.x = e[0] | ((unsigned)e[1] << 16); o.y = e[2] | ((unsigned)e[3] << 16); o.z = e[4] | ((unsigned)e[5] << 16); o.w = e[6] | ((unsigned)e[7] << 16);
    }
    *(u32x4*)(dst + (((size_t)(g * 512 + T)) * 512 + r9) * 8) = o;
  }
  __syncthreads();
}

struct AttnPtrs {
  const bf16_t* proj; const float* gates;
  const bf16_t *kcf, *vcf, *ksf, *vsf, *kwf, *vwf;
  bf16_t* mix; const float* hng;
};

DI float ex2(float x) { return __builtin_amdgcn_exp2f(x); }
DI void halves(float x, float& lo, float& hi) {
  const unsigned u = __float_as_uint(x);
  auto r = __builtin_amdgcn_permlane32_swap(u, u, false, false);
  lo = __uint_as_float(r[0]); hi = __uint_as_float(r[1]);
}
DI float hmax(float x) { float a, b; halves(x, a, b); return fmaxf(a, b); }
DI float hsum(float x) { float a, b; halves(x, a, b); return a + b; }
DI float dpp_quad(float v, int ctrl_is_xor1) {
  const int iv = __float_as_int(v);
  const int r = ctrl_is_xor1 ? __builtin_amdgcn_update_dpp(iv, iv, 0xB1, 0xF, 0xF, false) : __builtin_amdgcn_update_dpp(iv, iv, 0x4E, 0xF, 0xF, false);
  return __int_as_float(r);
}
DI float quad_sum(float v) { v += dpp_quad(v, 1); v += dpp_quad(v, 0); return v; }
DI void osm_step(const float (&sv)[16], float& m, float& l, f32x16 (&O)[4], float (&p)[16]) {
  float tmax = fmaxf(fmaxf(fmaxf(sv[0], sv[1]), fmaxf(sv[2], sv[3])), fmaxf(fmaxf(sv[4], sv[5]), fmaxf(sv[6], sv[7])));
  tmax = fmaxf(tmax, fmaxf(fmaxf(fmaxf(sv[8], sv[9]), fmaxf(sv[10], sv[11])), fmaxf(fmaxf(sv[12], sv[13]), fmaxf(sv[14], sv[15]))));
  tmax = hmax(tmax);
  if (__ballot(tmax - m > 8.f)) {
    const float mn = fmaxf(m, tmax);
    const float alpha = ex2(m - mn);
    l *= alpha; m = mn;
#pragma unroll
    for (int dt = 0; dt < 4; ++dt)
#pragma unroll
      for (int r = 0; r < 16; ++r) O[dt][r] *= alpha;
  }
  float ps0 = 0.f, ps1 = 0.f;
#pragma unroll
  for (int r = 0; r < 16; r += 2) { const float e0 = ex2(sv[r] - m), e1 = ex2(sv[r + 1] - m); p[r] = e0; p[r + 1] = e1; ps0 += e0; ps1 += e1; }
  l += ps0 + ps1;
}
DI void ot_store(char* otL, int lane, const f32x16 (&O)[4], float sc) {
#pragma unroll
  for (int dt = 0; dt < 4; ++dt) {
    u32x4 a, b;
#pragma unroll
    for (int i = 0; i < 4; ++i) { a[i] = pack2(sc * O[dt][2 * i], sc * O[dt][2 * i + 1]); b[i] = pack2(sc * O[dt][8 + 2 * i], sc * O[dt][8 + 2 * i + 1]); }
    *(u32x4*)(otL + lane * 128 + dt * 32) = a;
    *(u32x4*)(otL + lane * 128 + dt * 32 + 16) = b;
  }
}
DI void ot_accum(const char* otL, int lane, f32x16 (&O)[4], float sc) {
#pragma unroll
  for (int dt = 0; dt < 4; ++dt) {
    u32x4 a = *(const u32x4*)(otL + lane * 128 + dt * 32);
    u32x4 b = *(const u32x4*)(otL + lane * 128 + dt * 32 + 16);
#pragma unroll
    for (int i = 0; i < 4; ++i) {
      const unsigned wa = a[i], wb = b[i];
      O[dt][2 * i] = fmaf(sc, O[dt][2 * i], __uint_as_float(wa << 16));
      O[dt][2 * i + 1] = fmaf(sc, O[dt][2 * i + 1], __uint_as_float(wa & 0xFFFF0000u));
      O[dt][8 + 2 * i] = fmaf(sc, O[dt][8 + 2 * i], __uint_as_float(wb << 16));
      O[dt][8 + 2 * i + 1] = fmaf(sc, O[dt][8 + 2 * i + 1], __uint_as_float(wb & 0xFFFF0000u));
    }
  }
}
DI void zero_o(f32x16 (&O)[4]) {
#pragma unroll
  for (int dt = 0; dt < 4; ++dt)
#pragma unroll
    for (int i = 0; i < 16; ++i) O[dt][i] = 0.f;
}

constexpr int ATT_PW = 8704;
constexpr int ATT_R = 4, ATT_D = 3;
constexpr int ATT_RING = 8 * ATT_PW;
constexpr int ATT_LIST = ATT_RING + ATT_R * 16384;
constexpr int ATT_BUNI = ATT_LIST + 2048;
constexpr int ATT_SMEM = ATT_BUNI + 64;
#define LAS3 __attribute__((address_space(3)))
__device__ __forceinline__ void d_select(const float* impL, unsigned* mskL, unsigned* uniL, int cur) {
  const int lane = TIDX & 63;
  const int stok = lane >> 3, sub = lane & 7;
  unsigned key[32];
#pragma unroll
  for (int i4 = 0; i4 < 8; ++i4) {
    f32x4 v = *(const f32x4*)(impL + stok * 256 + sub * 32 + i4 * 4);
#pragma unroll
    for (int e = 0; e < 4; ++e) {
      const int j = sub * 32 + i4 * 4 + e;
      const bool valid = j <= cur;
      const bool forced = (j == 0) || (j == cur) || (j == cur - 1);
      unsigned kb = forced ? 0xFFFFFF00u : (__float_as_uint(v[e]) & 0xFFFFFF00u);
      key[i4 * 4 + e] = valid ? (kb | (unsigned)(255 - j)) : 0u;
    }
  }
#pragma unroll
  for (int k = 2; k <= 32; k <<= 1) {
#pragma unroll
    for (int jj = k >> 1; jj > 0; jj >>= 1) {
#pragma unroll
      for (int i = 0; i < 32; ++i) {
        const int l2 = i ^ jj;
        if (l2 > i) {
          const bool desc = ((i & k) == 0);
          unsigned a = key[i], b = key[l2];
          unsigned mx = a > b ? a : b, mn = a > b ? b : a;
          key[i] = desc ? mx : mn; key[l2] = desc ? mn : mx;
        }
      }
    }
  }
#pragma unroll
  for (int xm = 1; xm < 8; xm <<= 1) {
    unsigned L[16];
#pragma unroll
    for (int i = 0; i < 16; ++i) { unsigned o = (unsigned)shx_i((int)key[15 - i], xm); L[i] = key[i] > o ? key[i] : o; }
#pragma unroll
    for (int jj = 8; jj > 0; jj >>= 1) {
#pragma unroll
      for (int i = 0; i < 16; ++i) {
        const int l2 = i ^ jj;
        if (l2 > i) { unsigned a = L[i], b = L[l2]; L[i] = a > b ? a : b; L[l2] = a > b ? b : a; }
      }
    }
#pragma unroll
    for (int i = 0; i < 16; ++i) key[i] = L[i];
  }
#pragma unroll
  for (int i = 0; i < 16; ++i) {
    if ((i & 7) == sub) {
      const int j = 255 - (int)(key[i] & 255u);
      if (j <= cur) { atomicOr(&mskL[stok * 8 + (j >> 5)], 1u << (j & 31)); atomicOr(&uniL[j >> 5], 1u << (j & 31)); }
    }
  }
}


DI void att_issue(LAS3 unsigned char* ring, int slot, int w, int lane, const bf16_t* kb, const bf16_t* vb, int tile) {
  const char* ks = (const char*)kb + (size_t)tile * 8192 + w * 1024 + lane * 16;
  const char* vs = (const char*)vb + (size_t)tile * 8192 + w * 1024 + lane * 16;
  __builtin_amdgcn_global_load_lds((const unsigned*)ks, (LAS3 unsigned*)(ring + slot * 16384 + w * 1024), 16, 0, 0);
  __builtin_amdgcn_global_load_lds((const unsigned*)vs, (LAS3 unsigned*)(ring + slot * 16384 + 8192 + w * 1024), 16, 0, 0);
}
DI f32x16 qk_lds(LAS3 const unsigned char* kt, const bf16x8 (&qf)[8], int lane) {
  f32x16 acc;
#pragma unroll
  for (int i = 0; i < 16; ++i) acc[i] = 0.f;
#pragma unroll
  for (int s8 = 0; s8 < 8; ++s8) {
    const bf16x8 kf = *(LAS3 const bf16x8*)(kt + s8 * 1024 + lane * 16);
    acc = MFMA32(kf, qf[s8], acc);
  }
  return acc;
}
DI void pv_lds(LAS3 const unsigned char* vt, const float (&p)[16], f32x16 (&O)[4], int lane) {
  const bf16x8 pf0 = pack8(p[0], p[1], p[2], p[3], p[4], p[5], p[6], p[7]);
  const bf16x8 pf1 = pack8(p[8], p[9], p[10], p[11], p[12], p[13], p[14], p[15]);
#pragma unroll
  for (int dt = 0; dt < 4; ++dt) {
    const bf16x8 v0 = *(LAS3 const bf16x8*)(vt + (dt * 2) * 1024 + lane * 16);
    const bf16x8 v1 = *(LAS3 const bf16x8*)(vt + (dt * 2 + 1) * 1024 + lane * 16);
    O[dt] = MFMA32(v0, pf0, O[dt]);
    O[dt] = MFMA32(v1, pf1, O[dt]);
  }
}

__device__ __forceinline__ void d_attn_block(int B, int g, char* smem, const AttnPtrs& P) {
  const int tid = TIDX, lane = tid & 63, w = tid >> 6;
  const int c = lane & 31, h = lane >> 5, tokl = c >> 2, r = c & 3;
  const int tok0 = 64 * B + 8 * w;
  const int t = tok0 + tokl, hd = g * 4 + r;
  const float slope2 = exp2f(-(float)(hd + 1)) * LOG2E;
  const float c1 = QSCALE * LOG2E;
  const float ninf = -__builtin_inff();
  char* wsm = smem + w * ATT_PW;
  float* impL = (float*)wsm;
  char* otL = wsm;
  unsigned* mskL = (unsigned*)(wsm + 8192);
  unsigned* uniL = mskL + 64;
  LAS3 unsigned char* ring = (LAS3 unsigned char*)(smem + ATT_RING);
  unsigned short* tl = (unsigned short*)(smem + ATT_LIST);
  unsigned* buni = (unsigned*)(smem + ATT_BUNI);
  const bf16_t* kcf = P.kcf + (size_t)g * 32 * 4096;
  const bf16_t* vcf = P.vcf + (size_t)g * 32 * 4096;
  const bf16_t* ksf = P.ksf + (size_t)g * 512 * 4096;
  const bf16_t* vsf = P.vsf + (size_t)g * 512 * 4096;
  const bf16_t* kwf = P.kwf + (size_t)g * 512 * 4096;
  const bf16_t* vwf = P.vwf + (size_t)g * 512 * 4096;
  bf16x8 qf[8];
  {
    const bf16_t* qrow = P.proj + (size_t)t * INWP + OFF_Q + hd * 128 + 8 * h;
#pragma unroll
    for (int s8 = 0; s8 < 8; ++s8) qf[s8] = *(const bf16x8*)(qrow + 16 * s8);
  }
  const float* gt = P.gates + (size_t)t * 24 + hd * 3;
  const float g0 = gt[0], g1 = gt[1], g2 = gt[2];
  {
    unsigned z0 = 0u;
    asm volatile("" : "+v"(z0));
    u32x4 z = {z0, z0, z0, z0};
#pragma unroll
    for (int i = 0; i < 8; ++i) *(u32x4*)(wsm + (i * 64 + lane) * 16) = z;
    if (lane < 18) *(u32x4*)(wsm + 8192 + lane * 16) = z;
    if (tid < 8) buni[tid] = z0;
  }
  f32x16 Ob[4];
  zero_o(Ob);
  const int nmax = (t >= 31) ? ((t - 31) >> 4) : -1;
  const int nmaxw = (tok0 + 7 >= 31) ? ((tok0 + 7 - 31) >> 4) : -1;
  const int nminw = (tok0 >= 31) ? ((tok0 - 31) >> 4) : -1;
  const int ntcw = (nmaxw + 32) >> 5;
  const int ntcB = (((64 * B + 63 - 31) >> 4) + 32) >> 5;
  const float sl16 = slope2 * 16.f;
  float mC = NEGB, lC = 0.f, invC = 0.f, carry = 0.f;
  {
    const int n = 2 * ntcB;
    asm volatile("s_waitcnt vmcnt(0)" ::: "memory");
#define A_TILE(i_) (((i_) < ntcB) ? (ntcB - 1 - (i_)) : ((i_) - ntcB))
    att_issue(ring, 0, w, lane, kcf, vcf, A_TILE(0));
    if (n > 1) att_issue(ring, 1, w, lane, kcf, vcf, A_TILE(1));
#pragma unroll 1
    for (int i = 0; i < n; ++i) {
      if ((i & 1) == 0) {
        asm volatile("s_waitcnt vmcnt(0)" ::: "memory");
        __builtin_amdgcn_s_barrier();
        asm volatile("" ::: "memory");
        if (i + 2 < n) att_issue(ring, (i + 2) & 3, w, lane, kcf, vcf, A_TILE(i + 2));
        if (i + 3 < n) att_issue(ring, (i + 3) & 3, w, lane, kcf, vcf, A_TILE(i + 3));
      }
      const int T = A_TILE(i);
      if (T >= ntcw) continue;
      LAS3 const unsigned char* slot = ring + (i % ATT_R) * 16384;
      const f32x16 acc = qk_lds(slot, qf, lane);
      const float base = slope2 * (float)(512 * T + 128 * h) + slope2 * (15.5f - (float)t);
      const int nb = 32 * T + 8 * h;
      const bool full = (32 * T + 31 <= nminw);
      float sv[16];
#pragma unroll
      for (int rg = 0; rg < 16; ++rg) { const int kk = (rg & 7) + 16 * (rg >> 3); sv[rg] = fmaf(acc[rg], c1, fmaf(sl16, (float)kk, base)); }
      if (!full) {
#pragma unroll
        for (int rg = 0; rg < 16; ++rg) { const int kk = (rg & 7) + 16 * (rg >> 3); sv[rg] = (nb + kk <= nmax) ? sv[rg] : ninf; }
      }
      if (i < ntcB) {
        float tmax = fmaxf(fmaxf(fmaxf(sv[0], sv[1]), fmaxf(sv[2], sv[3])), fmaxf(fmaxf(sv[4], sv[5]), fmaxf(sv[6], sv[7])));
        tmax = fmaxf(tmax, fmaxf(fmaxf(fmaxf(sv[8], sv[9]), fmaxf(sv[10], sv[11])), fmaxf(fmaxf(sv[12], sv[13]), fmaxf(sv[14], sv[15]))));
        tmax = hmax(tmax);
        const float mn = fmaxf(mC, tmax);
        float ps = 0.f;
#pragma unroll
        for (int rg = 0; rg < 16; ++rg) ps += ex2(sv[rg] - mn);
        lC = lC * ex2(mC - mn) + ps; mC = mn;
      } else {
        if (T == 0) { lC = hsum(lC); invC = (lC > 0.f) ? 1.f / lC : 0.f; }
        float p[16];
#pragma unroll
        for (int rg = 0; rg < 16; ++rg) p[rg] = ex2(sv[rg] - mC) * invC;
        float Ga = (p[0] + p[1]) + (p[2] + p[3]), Gb = (p[4] + p[5]) + (p[6] + p[7]);
        float Gc = (p[8] + p[9]) + (p[10] + p[11]), Gd = (p[12] + p[13]) + (p[14] + p[15]);
        float xb, xd; { float a_, b_; halves(p[7], a_, b_); xb = h ? a_ : b_; halves(p[15], a_, b_); xd = h ? a_ : b_; }
        float ia = Ga + (h ? xb : carry);
        float ib = Gb + p[3];
        float ic = Gc + (h ? xd : xb);
        float id = Gd + p[11];
        carry = xd;
        ia = quad_sum(ia); ib = quad_sum(ib); ic = quad_sum(ic); id = quad_sum(id);
        {
          float val = (r == 0) ? ia : (r == 1) ? ib : (r == 2) ? ic : id;
          int j = 8 * T + 2 * h + ((r == 0) ? 0 : (r == 1) ? 1 : (r == 2) ? 4 : 5);
          impL[tokl * 256 + j] = val;
        }
        pv_lds(slot + 8192, p, Ob, lane);
      }
    }
#undef A_TILE
  }
  const int cur = B;
  d_select(impL, mskL, uniL, cur);
  ot_store(otL, lane, Ob, g0);
  zero_o(Ob);
  if (lane < 8) { const unsigned u = uniL[lane]; if (u) atomicOr(&buni[lane], u); }
  __syncthreads();
  int nslc = 0, ntl = 0;
  {
    for (int iw = 7; iw >= 0; --iw) {
      unsigned iuw = __builtin_amdgcn_readfirstlane(buni[iw]);
      while (iuw) {
        const int bit = 31 - __builtin_clz(iuw);
        iuw &= ~(1u << bit);
        const int bb = 32 * iw + bit;
        if (bb < B) { if (lane == 0) tl[ntl] = (unsigned short)(2 * bb + 1); ++ntl; }
        else { if (lane == 0) tl[ntl] = (unsigned short)(2 * bb + 1); ++ntl; }
        if (lane == 0) tl[ntl] = (unsigned short)(2 * bb);
        ++ntl;
      }
    }
    nslc = ntl;
    const int ThiB = 2 * B + 1, TloB = ((64 * B - 511 > 0) ? (64 * B - 511) : 0) >> 5;
    for (int T = ThiB; T >= TloB; --T) { if (lane == 0) tl[ntl] = (unsigned short)T; ++ntl; }
  }
  float m = NEGB, l = 0.f;
  {
    const int n = ntl;
    const int Tlow = ((tok0 - 511 > 0) ? (tok0 - 511) : 0) >> 5, Thiw = (tok0 + 7) >> 5;
#define B_ISSUE(j_, slot_) { const int e_ = __builtin_amdgcn_readfirstlane((int)tl[j_]); if ((j_) < nslc) att_issue(ring, slot_, w, lane, ksf, vsf, e_); else att_issue(ring, slot_, w, lane, kwf, vwf, e_); }
    B_ISSUE(0, 0)
    if (n > 1) B_ISSUE(1, 1)
#pragma unroll 1
    for (int i = 0; i < n; ++i) {
      if ((i & 1) == 0) {
        asm volatile("s_waitcnt vmcnt(0)" ::: "memory");
        __builtin_amdgcn_s_barrier();
        asm volatile("" ::: "memory");
        if (i + 2 < n) B_ISSUE(i + 2, (i + 2) & 3)
        if (i + 3 < n) B_ISSUE(i + 3, (i + 3) & 3)
      }
      if (i == nslc) {
        l = hsum(l);
        const float inv = (l > 0.f) ? g1 / l : 0.f;
        ot_accum(otL, lane, Ob, inv);
        ot_store(otL, lane, Ob, 1.f);
        zero_o(Ob);
        m = NEGB; l = 0.f;
      }
      const int T = __builtin_amdgcn_readfirstlane((int)tl[i]);
      const int pos0 = 32 * T, pb = pos0 + 8 * h;
      bool full; bool mine = true;
      if (i < nslc) {
        const int bb = T >> 1;
        const unsigned uw = __builtin_amdgcn_readfirstlane(uniL[bb >> 5]);
        if (!((uw >> (bb & 31)) & 1u) || pos0 > tok0 + 7) continue;
        mine = (mskL[tokl * 8 + (bb >> 5)] >> (bb & 31)) & 1u;
        full = (pos0 + 31 <= tok0) && (__ballot(!mine) == 0ull);
      } else {
        if (T < Tlow || T > Thiw) continue;
        full = (pos0 + 31 <= tok0) && (pos0 >= tok0 + 7 - 511);
      }
      LAS3 const unsigned char* slot = ring + (i % ATT_R) * 16384;
      const f32x16 acc = qk_lds(slot, qf, lane);
      const float base = slope2 * (float)(pos0 + 8 * h - t);
      float sv[16], p[16];
#pragma unroll
      for (int rg = 0; rg < 16; ++rg) { const int kk = (rg & 7) + 16 * (rg >> 3); sv[rg] = fmaf(acc[rg], c1, fmaf(slope2, (float)kk, base)); }
      if (!full) {
        if (i < nslc) {
#pragma unroll
          for (int rg = 0; rg < 16; ++rg) { const int kk = (rg & 7) + 16 * (rg >> 3); sv[rg] = (mine && (pb + kk <= t)) ? sv[rg] : ninf; }
        } else {
#pragma unroll
          for (int rg = 0; rg < 16; ++rg) { const int kk = (rg & 7) + 16 * (rg >> 3); const int dw = t - (pb + kk); sv[rg] = ((dw >= 0) && (dw < 512)) ? sv[rg] : ninf; }
        }
      }
      osm_step(sv, m, l, Ob, p);
      pv_lds(slot + 8192, p, Ob, lane);
    }
#undef B_ISSUE
    l = hsum(l);
    const float inv = (l > 0.f) ? g2 / l : 0.f;
    ot_accum(otL, lane, Ob, inv);
  }
  {
    float ss = 0.f;
#pragma unroll
    for (int dt = 0; dt < 4; ++dt)
#pragma unroll
      for (int i = 0; i < 16; ++i) ss = fmaf(Ob[dt][i], Ob[dt][i], ss);
    ss = hsum(ss);
    const float rs = rsqrtf(ss * (1.f / 128.f) + 1e-6f);
    bf16_t* orow = P.mix + (size_t)t * DM + hd * 128 + 4 * h;
    const float* grow = P.hng + hd * 128 + 4 * h;
#pragma unroll
    for (int dt = 0; dt < 4; ++dt)
#pragma unroll
      for (int a = 0; a < 4; ++a) {
        const f32x4 gv = *(const f32x4*)(grow + 32 * dt + 8 * a);
        u32x2 wv2 = {pack2(Ob[dt][4 * a] * rs * gv[0], Ob[dt][4 * a + 1] * rs * gv[1]), pack2(Ob[dt][4 * a + 2] * rs * gv[2], Ob[dt][4 * a + 3] * rs * gv[3])};
        *(u32x2*)(orow + 32 * dt + 8 * a) = wv2;
      }
  }
  asm volatile("s_waitcnt vmcnt(0)" ::: "memory");
  __syncthreads();
}

__device__ void d_convmix(int t, int tl, const bf16_t* __restrict__ proj, const float* __restrict__ convw, const float* __restrict__ hng,
                          bf16_t* __restrict__ mix) {
  const int c = tl * 8;
  float acc[8];
#pragma unroll
  for (int i = 0; i < 8; ++i) acc[i] = 0.f;
#pragma unroll
  for (int j = 0; j < 3; ++j) {
    const int tt = t - 2 + j;
    if (tt >= 0) {
      const u32x4 cu = *(const u32x4*)(proj + (size_t)tt * INWP + OFF_C + c);
      const u32x4 uu = *(const u32x4*)(proj + (size_t)tt * INWP + OFF_U + c);
      const f32x4 w0 = *(const f32x4*)(convw + j * 1024 + c), w1 = *(const f32x4*)(convw + j * 1024 + c + 4);
#pragma unroll
      for (int i = 0; i < 4; ++i) {
        const unsigned a = cu[i], b = uu[i];
        const float wl = (i < 2) ? w0[2 * i] : w1[2 * i - 4], wh = (i < 2) ? w0[2 * i + 1] : w1[2 * i - 3];
        acc[2 * i] = fmaf(wl * __uint_as_float(a << 16), __uint_as_float(b << 16), acc[2 * i]);
        acc[2 * i + 1] = fmaf(wh * __uint_as_float(a & 0xFFFF0000u), __uint_as_float(b & 0xFFFF0000u), acc[2 * i + 1]);
      }
    }
  }
  const u32x4 bb = *(const u32x4*)(proj + (size_t)t * INWP + OFF_B + c);
  float ss = 0.f;
#pragma unroll
  for (int i = 0; i < 4; ++i) {
    const unsigned b = bb[i];
    acc[2 * i] *= __uint_as_float(b << 16); acc[2 * i + 1] *= __uint_as_float(b & 0xFFFF0000u);
    ss = fmaf(acc[2 * i], acc[2 * i], ss); ss = fmaf(acc[2 * i + 1], acc[2 * i + 1], ss);
  }
  ss += shx(ss, 8); ss += shx(ss, 4); ss += shx(ss, 2); ss += shx(ss, 1);
  const float rs = rsqrtf(ss * (1.f / 128.f) + 1e-6f);
  const f32x4 g0 = *(const f32x4*)(hng + 1024 + c), g1 = *(const f32x4*)(hng + 1024 + c + 4);
  u32x4 o = {pack2(acc[0] * rs * g0[0], acc[1] * rs * g0[1]), pack2(acc[2] * rs * g0[2], acc[3] * rs * g0[3]),
             pack2(acc[4] * rs * g1[0], acc[5] * rs * g1[1]), pack2(acc[6] * rs * g1[2], acc[7] * rs * g1[3])};
  *(u32x4*)(mix + (size_t)t * DM + 1024 + c) = o;
}

__device__ void d_ln_wave(int t, bf16_t* __restrict__ yh, const float* __restrict__ gam, const float* __restrict__ bet) {
  const int lane = TIDX & 63;
  float v[32];
#pragma unroll
  for (int i = 0; i < 4; ++i) {
    const u32x4 w = *(const u32x4*)(yh + (size_t)t * DM + 512 * i + 8 * lane);
#pragma unroll
    for (int j = 0; j < 4; ++j) { const unsigned ww = w[j]; v[i * 8 + 2 * j] = __uint_as_float(ww << 16); v[i * 8 + 2 * j + 1] = __uint_as_float(ww & 0xFFFF0000u); }
  }
  float s = 0.f;
#pragma unroll
  for (int i = 0; i < 32; ++i) s += v[i];
  s = wave_sum(s);
  const float mu = s * (1.f / DM);
  float q = 0.f;
#pragma unroll
  for (int i = 0; i < 32; ++i) { const float d = v[i] - mu; q = fmaf(d, d, q); }
  q = wave_sum(q);
  const float rs = rsqrtf(q * (1.f / DM) + 1e-5f);
#pragma unroll
  for (int i = 0; i < 4; ++i) {
    const int cb = 512 * i + 8 * lane;
    const f32x4 g0 = *(const f32x4*)(gam + cb), g1 = *(const f32x4*)(gam + cb + 4), b0 = *(const f32x4*)(bet + cb), b1 = *(const f32x4*)(bet + cb + 4);
    u32x4 o = {pack2((v[i * 8 + 0] - mu) * rs * g0[0] + b0[0], (v[i * 8 + 1] - mu) * rs * g0[1] + b0[1]), pack2((v[i * 8 + 2] - mu) * rs * g0[2] + b0[2], (v[i * 8 + 3] - mu) * rs * g0[3] + b0[3]),
               pack2((v[i * 8 + 4] - mu) * rs * g1[0] + b1[0], (v[i * 8 + 5] - mu) * rs * g1[1] + b1[1]), pack2((v[i * 8 + 6] - mu) * rs * g1[2] + b1[2], (v[i * 8 + 7] - mu) * rs * g1[3] + b1[3])};
    *(u32x4*)(yh + (size_t)t * DM + cb) = o;
  }
}

__device__ void d_cvt_w1f(size_t c, const float* __restrict__ w1, bf16_t* __restrict__ w1f) {
  const int lane = c & 63, ks = (c >> 6) & 255, ct = c >> 14;
  const int col = lane & 31, h = lane >> 5;
  bf16_t v[8];
#pragma unroll
  for (int j = 0; j < 8; ++j) v[j] = f2bf(w1[(size_t)(16 * ks + 8 * h + j) * 512 + 32 * ct + col]);
  u32x4 o; o.x = v[0] | ((unsigned)v[1] << 16); o.y = v[2] | ((unsigned)v[3] << 16); o.z = v[4] | ((unsigned)v[5] << 16); o.w = v[6] | ((unsigned)v[7] << 16);
  *(u32x4*)(w1f + c * 8) = o;
}
__device__ void d_cvt_w2f(size_t c, const float* __restrict__ w2, bf16_t* __restrict__ w2f) {
  const int lane = c & 63, s = (c >> 6) & 31, ct = c >> 11;
  const int col = lane & 31, h = lane >> 5;
  bf16_t v[8];
#pragma unroll
  for (int j = 0; j < 8; ++j) v[j] = f2bf(w2[(size_t)(16 * s + 8 * h + j) * 128 + 32 * ct + col]);
  u32x4 o; o.x = v[0] | ((unsigned)v[1] << 16); o.y = v[2] | ((unsigned)v[3] << 16); o.z = v[4] | ((unsigned)v[5] << 16); o.w = v[6] | ((unsigned)v[7] << 16);
  *(u32x4*)(w2f + c * 8) = o;
}
__device__ __forceinline__ void d_compress_unit(int rt, char* smem, const bf16_t* __restrict__ proj, int col0, const float* __restrict__ pos,
                                const bf16_t* __restrict__ w1f, const float* __restrict__ b1, const bf16_t* __restrict__ w2f,
                                bf16_t* __restrict__ outf, bool isV) {
  bf16_t* Xs = (bf16_t*)smem;
  bf16_t* Hs = (bf16_t*)(smem + 2 * 8704);
  const int tid = TIDX, lane = tid & 63, w = tid >> 6, c = lane & 31, h = lane >> 5;
  const int R0 = rt * 32;
  const int srow = tid >> 4, sch = tid & 15;
  const int grow = R0 + srow, sn = grow >> 1, sg = grow & 1;
  const bool svalid = grow < 2046;
  const bf16_t* sp = proj + (size_t)(16 * sn) * INWP + col0 + sg * 128 + sch * 8;
  f32x16 acc0, acc1;
#pragma unroll
  for (int i = 0; i < 16; ++i) { acc0[i] = 0.f; acc1[i] = 0.f; }
  u32x4 rx = {0u, 0u, 0u, 0u}; f32x4 rp0, rp1;
#define STAGE_WRITE(buf)                                                                                   \
  {                                                                                                        \
    u32x4 o_;                                                                                              \
    _Pragma("unroll") for (int i = 0; i < 4; ++i) {                                                        \
      const unsigned wv_ = rx[i];                                                                          \
      const float lo = __uint_as_float(wv_ << 16) + ((i < 2) ? rp0[2 * i] : rp1[2 * i - 4]);               \
      const float hi = __uint_as_float(wv_ & 0xFFFF0000u) + ((i < 2) ? rp0[2 * i + 1] : rp1[2 * i - 3]);   \
      o_[i] = pack2(lo, hi);                                                                               \
    }                                                                                                      \
    *(u32x4*)(Xs + (buf) * 4352 + srow * 136 + sch * 8) = o_;                                              \
  }
  if (svalid) rx = *(const u32x4*)(sp);
  rp0 = *(const f32x4*)(pos + sch * 8); rp1 = *(const f32x4*)(pos + sch * 8 + 4);
  STAGE_WRITE(0)
  __syncthreads();
  const bf16_t* wb0 = w1f + ((size_t)(2 * w) * 256 * 64 + lane) * 8;
  const bf16_t* wb1 = w1f + ((size_t)(2 * w + 1) * 256 * 64 + lane) * 8;
  bf16x8 bA[16], bB[16];
#define CMP_LOADB(BUF, L)                                                                      \
  _Pragma("unroll") for (int s8 = 0; s8 < 8; ++s8) {                                           \
    BUF[2 * s8] = *(const bf16x8*)(wb0 + (size_t)(8 * (L) + s8) * 512);                        \
    BUF[2 * s8 + 1] = *(const bf16x8*)(wb1 + (size_t)(8 * (L) + s8) * 512);                    \
  }
#define CMP_LOADX(L)                                                                           \
  if ((L) < 32) {     \
    if (svalid) rx = *(const u32x4*)(sp + (size_t)(L) * INWP);                                 \
    rp0 = *(const f32x4*)(pos + (L) * 128 + sch * 8); rp1 = *(const f32x4*)(pos + (L) * 128 + sch * 8 + 4); \
  }
#define CMP_CHUNK(BUF, L)                                                                      \
  {                                                                                            \
    const bf16_t* xa = Xs + ((L) & 1) * 4352 + c * 136 + 8 * h;                                \
    _Pragma("unroll") for (int s8 = 0; s8 < 8; ++s8) {                                         \
      const bf16x8 a = *(const bf16x8*)(xa + 16 * s8);                                         \
      acc0 = MFMA32(a, BUF[2 * s8], acc0);                                                     \
      acc1 = MFMA32(a, BUF[2 * s8 + 1], acc1);                                                 \
    }                                                                                          \
    if ((L) + 1 < 32) STAGE_WRITE(((L) + 1) & 1)                                               \
    __syncthreads();                                                                           \
  }
  CMP_LOADB(bA, 0)
#pragma unroll 1
  for (int l = 0; l < 32; l += 2) {
    CMP_LOADX(l + 1)
    CMP_LOADB(bB, l + 1)
    __builtin_amdgcn_sched_barrier(0);
    CMP_CHUNK(bA, l)
    __builtin_amdgcn_sched_barrier(0);
    CMP_LOADX(l + 2)
    { const int ln = (l + 2 < 32) ? l + 2 : l;
      CMP_LOADB(bA, ln) }
    __builtin_amdgcn_sched_barrier(0);
    CMP_CHUNK(bB, l + 1)
    __builtin_amdgcn_sched_barrier(0);
  }
#undef CMP_LOADX
#undef CMP_LOADB
#undef CMP_CHUNK
  {
    const float bb0 = b1[64 * w + c], bb1 = b1[64 * w + 32 + c];
#pragma unroll
    for (int rg = 0; rg < 16; ++rg) {
      const int row = (rg & 3) + 8 * (rg >> 2) + 4 * h;
      Hs[row * 520 + 64 * w + c] = f2bf(gelu_tanh(acc0[rg] + bb0));
      Hs[row * 520 + 64 * w + 32 + c] = f2bf(gelu_tanh(acc1[rg] + bb1));
    }
  }
  __syncthreads();
  if (w < 4) {
    f32x16 o2;
#pragma unroll
    for (int i = 0; i < 16; ++i) o2[i] = 0.f;
    const bf16_t* ha = Hs + c * 520 + 8 * h;
    const bf16_t* wb = w2f + ((size_t)w * 32 * 64 + lane) * 8;
#pragma unroll 8
    for (int s2 = 0; s2 < 32; ++s2) {
      const bf16x8 a = *(const bf16x8*)(ha + 16 * s2);
      const bf16x8 b = *(const bf16x8*)(wb + (size_t)s2 * 512);
      o2 = MFMA32(a, b, o2);
    }
    const int d = 32 * w + c;
#pragma unroll
    for (int rg = 0; rg < 16; ++rg) {
      const int row = R0 + (rg & 3) + 8 * (rg >> 2) + 4 * h;
      const int n = row >> 1, g = row & 1;
      const bf16_t val = (row < 2046) ? f2bf(o2[rg]) : (bf16_t)0;
      const int T = n >> 5, nn = n & 31;
      size_t idx;
      if (!isV) idx = ((((size_t)(g * 32 + T) * 8 + (d >> 4)) * 64 + (pi_perm(nn) + 32 * ((d >> 3) & 1))) * 8 + (d & 7));
      else idx = (((((size_t)(g * 32 + T) * 4 + (d >> 5)) * 2 + (nn >> 4)) * 64 + ((d & 31) + 32 * ((nn >> 3) & 1))) * 8 + (nn & 7));
      outf[idx] = val;
    }
  }
  __syncthreads();
}


DI unsigned f2sort(float f) { unsigned u = __float_as_uint(f); return u ^ ((unsigned)((int)u >> 31) | 0x80000000u); }
DI float sort2f(unsigned k) { unsigned u = (k & 0x80000000u) ? (k ^ 0x80000000u) : ~k; return __uint_as_float(u); }
template <int N>
DI void bitonic_sort_desc(unsigned (&key)[N]) {
#pragma unroll
  for (int k = 2; k <= N; k <<= 1) {
#pragma unroll
    for (int jj = k >> 1; jj > 0; jj >>= 1) {
#pragma unroll
      for (int i = 0; i < N; ++i) {
        const int l2 = i ^ jj;
        if (l2 > i) {
          const bool desc = ((i & k) == 0);
          unsigned a = key[i], b = key[l2];
          unsigned mx = a > b ? a : b, mn = a > b ? b : a;
          key[i] = desc ? mx : mn; key[l2] = desc ? mn : mx;
        }
      }
    }
  }
}
DI void merge_top16(unsigned (&a)[16], const unsigned (&b)[16]) {
#pragma unroll
  for (int i = 0; i < 16; ++i) { unsigned o = b[15 - i]; a[i] = a[i] > o ? a[i] : o; }
#pragma unroll
  for (int jj = 8; jj > 0; jj >>= 1) {
#pragma unroll
    for (int i = 0; i < 16; ++i) {
      const int l2 = i ^ jj;
      if (l2 > i) { unsigned x = a[i], y = a[l2]; a[i] = x > y ? x : y; a[l2] = x > y ? y : x; }
    }
  }
}
__device__ void d_cvt_subk(size_t c, const float* __restrict__ subk, bf16_t* __restrict__ skf) {
  int lane = c & 63, s = (c >> 6) & 7, kt = (c >> 9) & 3, hc = c >> 11;
  int i = lane & 31, h = lane >> 5;
  const float* src = subk + ((size_t)hc * 128 + 32 * kt + i) * 128 + 16 * s + 8 * h;
  bf16_t v[8];
#pragma unroll
  for (int j = 0; j < 8; ++j) v[j] = f2bf(src[j]);
  u32x4 o; o.x = v[0] | ((unsigned)v[1] << 16); o.y = v[2] | ((unsigned)v[3] << 16); o.z = v[4] | ((unsigned)v[5] << 16); o.w = v[6] | ((unsigned)v[7] << 16);
  *(u32x4*)(skf + c * 8) = o;
}

#define EPI_LANES()                                                                                                      \
    const int lane = fr | (fq << 4), rr = lane >> 2, rc = lane & 3;                                                       \
    PG8_LAS unsigned char* my = scr + (wr * 4 + wc) * 2048;                                                              \
    const int wo = fr * 64 + ((fq ^ ((fr >> 2) & 3)) << 4), ro = rr * 64 + ((rc ^ ((rr >> 2) & 3)) << 4);
struct EpiProjG {
  static constexpr bool PERM = true, AFTER_DRAIN = false;
  bf16_t* proj; float* gates; PG8_LAS unsigned char* scr;
  DI void operator()(const f32x4 (&acc)[2][2][4][2], const pg8::Unit& u, int wr, int wc, int fr, int fq) const {
    EPI_LANES()
#pragma unroll
    for (int ai = 0; ai < 2; ++ai)
#pragma unroll
      for (int bj = 0; bj < 2; ++bj) {
        const int c0 = u.pn * 256 + bj * 128 + wc * 32 + 8 * fq, cs = u.pn * 256 + bj * 128 + wc * 32 + 8 * rc;
#pragma unroll
        for (int mh = 0; mh < 2; ++mh) {
#pragma unroll
          for (int mm = 0; mm < 2; ++mm) {
            const f32x4 v0 = acc[ai][bj][mh * 2 + mm][0], v1 = acc[ai][bj][mh * 2 + mm][1];
            u32x4 w = {pack2(v0[0], v0[1]), pack2(v0[2], v0[3]), pack2(v1[0], v1[1]), pack2(v1[2], v1[3])};
            *(PG8_LAS u32x4*)(my + wo + mm * 1024) = w;
            if (c0 >= OFF_G && c0 < OFF_G + 24) {
              const int row = u.pm * 256 + ai * 128 + wr * 64 + (mh * 2 + mm) * 16 + fr;
              f32x4 g0, g1;
#pragma unroll
              for (int j = 0; j < 4; ++j) { g0[j] = 1.f / (1.f + __expf(-v0[j])); g1[j] = 1.f / (1.f + __expf(-v1[j])); }
              *(f32x4*)(gates + (size_t)row * 24 + (c0 - OFF_G)) = g0;
              *(f32x4*)(gates + (size_t)row * 24 + (c0 - OFF_G) + 4) = g1;
            }
          }
#pragma unroll
          for (int j = 0; j < 2; ++j) {
            const u32x4 w = *(const PG8_LAS u32x4*)(my + ro + j * 1024);
            const int row = u.pm * 256 + ai * 128 + wr * 64 + mh * 32 + j * 16 + rr;
            if (cs < INW) *(u32x4*)(proj + (size_t)row * INWP + cs) = w;
          }
        }
      }
  }
};
struct EpiResG {
  static constexpr bool PERM = true, AFTER_DRAIN = false;
  bf16_t* YB; PG8_LAS unsigned char* scr;
  DI void operator()(const f32x4 (&acc)[2][2][4][2], const pg8::Unit& u, int wr, int wc, int fr, int fq) const {
    EPI_LANES()
    bf16_t* yb = YB + (size_t)(u.pm * 256 + wr * 64 + rr) * DM + u.pn * 256 + wc * 32 + 8 * rc;
#pragma unroll
    for (int ai = 0; ai < 2; ++ai) {
      u32x4 xr[2][2][2];
#pragma unroll
      for (int bj = 0; bj < 2; ++bj)
#pragma unroll
        for (int mh = 0; mh < 2; ++mh)
#pragma unroll
          for (int j = 0; j < 2; ++j) xr[bj][mh][j] = *(const u32x4*)(yb + (size_t)(ai * 128 + mh * 32 + j * 16) * DM + bj * 128);
#pragma unroll
      for (int bj = 0; bj < 2; ++bj)
#pragma unroll
        for (int mh = 0; mh < 2; ++mh) {
#pragma unroll
          for (int mm = 0; mm < 2; ++mm) {
            const f32x4 v0 = acc[ai][bj][mh * 2 + mm][0], v1 = acc[ai][bj][mh * 2 + mm][1];
            u32x4 w = {pack2(v0[0], v0[1]), pack2(v0[2], v0[3]), pack2(v1[0], v1[1]), pack2(v1[2], v1[3])};
            *(PG8_LAS u32x4*)(my + wo + mm * 1024) = w;
          }
#pragma unroll
          for (int j = 0; j < 2; ++j) {
            const u32x4 a = *(const PG8_LAS u32x4*)(my + ro + j * 1024), xw = xr[bj][mh][j];
            u32x4 o;
#pragma unroll
            for (int q = 0; q < 4; ++q) {
              const unsigned aw = a[q], xq = xw[q];
              o[q] = pack2(fmaf(ALPHA, __uint_as_float(xq << 16), __uint_as_float(aw << 16)), fmaf(ALPHA, __uint_as_float(xq & 0xFFFF0000u), __uint_as_float(aw & 0xFFFF0000u)));
            }
            *(u32x4*)(yb + (size_t)(ai * 128 + mh * 32 + j * 16) * DM + bj * 128) = o;
          }
        }
    }
  }
};
struct EpiF32G {
  static constexpr bool PERM = false, AFTER_DRAIN = false;
  float* C; int ldc;
  DI void operator()(const f32x4 (&acc)[2][2][4][2], const pg8::Unit& u, int wr, int wc, int fr, int fq) const {
#pragma unroll
    for (int ai = 0; ai < 2; ++ai)
#pragma unroll
      for (int m = 0; m < 4; ++m) {
        const size_t ro = (size_t)(u.pm * 256 + ai * 128 + wr * 64 + m * 16 + fr) * ldc + u.pn * 256 + wc * 32 + 4 * fq;
#pragma unroll
        for (int bj = 0; bj < 2; ++bj)
#pragma unroll
          for (int n = 0; n < 2; ++n) *(f32x4*)(C + ro + bj * 128 + n * 16) = acc[ai][bj][m][n];
      }
  }
};
struct EpiRouteG {
  static constexpr bool PERM = false, AFTER_DRAIN = true;
  const bf16_t* skf; unsigned* tops;
  DI void operator()(const f32x4 (&)[2][2][4][2], const pg8::Unit&, int, int, int, int) const {}
  DI void fused(const f32x4 (&acc)[2][2][4][2], const pg8::Unit& u, int wr, int wc, int fr, int fq, PG8_LAS unsigned char* ldsp, int, int) const {
    const int lane = fr | (fq << 4), wid = wr * 4 + wc;
    bf16_t* Qs = (bf16_t*)ldsp;
#pragma unroll
    for (int ai = 0; ai < 2; ++ai)
#pragma unroll
      for (int m = 0; m < 4; ++m) {
        const int row = ai * 128 + wr * 64 + m * 16 + fr;
#pragma unroll
        for (int bj = 0; bj < 2; ++bj)
#pragma unroll
          for (int n = 0; n < 2; ++n) {
            const f32x4 v = acc[ai][bj][m][n];
            u32x2 w = {pack2(v[0], v[1]), pack2(v[2], v[3])};
            *(u32x2*)(Qs + row * 264 + bj * 128 + wc * 32 + n * 16 + 4 * fq) = w;
          }
      }
    __syncthreads();
    const int c = lane & 31, h = lane >> 5;
    unsigned kA[16], kB[16];
#pragma unroll 1
    for (int half = 0; half < 2; ++half) {
      const int hc = u.pn * 2 + half;
      const bf16_t* sk = skf + (size_t)hc * 4 * 4096;
      const bf16_t* qp = Qs + (wid * 32 + c) * 264 + half * 128 + 8 * h;
      unsigned k0[16], k1[16];
#define ROUTE_KT(KT, KA)                                                                        \
      {                                                                                         \
        f32x16 sc;                                                                              \
        _Pragma("unroll") for (int i = 0; i < 16; ++i) sc[i] = 0.f;                             \
        _Pragma("unroll") for (int s = 0; s < 8; ++s) {                                         \
          bf16x8 af = *(const bf16x8*)(sk + (KT) * 4096 + s * 512 + lane * 8);                  \
          bf16x8 bq = *(const bf16x8*)(qp + 16 * s);                                            \
          sc = __builtin_amdgcn_mfma_f32_32x32x16_bf16(af, bq, sc, 0, 0, 0);                    \
        }                                                                                       \
        _Pragma("unroll") for (int rg = 0; rg < 16; ++rg) {                                     \
          const int kidx = 32 * (KT) + (rg & 3) + 8 * (rg >> 2) + 4 * h;                        \
          KA[rg] = (f2sort(sc[rg]) & 0xFFFFFF80u) | (unsigned)(127 - kidx);                     \
        }                                                                                       \
        bitonic_sort_desc<16>(KA);                                                              \
      }
      ROUTE_KT(0, k0)
      __builtin_amdgcn_sched_barrier(0);
      ROUTE_KT(1, k1)
      merge_top16(k0, k1);
      __builtin_amdgcn_sched_barrier(0);
      ROUTE_KT(2, k1)
      merge_top16(k0, k1);
      __builtin_amdgcn_sched_barrier(0);
      ROUTE_KT(3, k1)
      merge_top16(k0, k1);
      __builtin_amdgcn_sched_barrier(0);
#undef ROUTE_KT
#pragma unroll
      for (int i = 0; i < 16; ++i) k1[i] = (unsigned)shx_i((int)k0[i], 32);
      merge_top16(k0, k1);
      if (half == 0) {
#pragma unroll
        for (int i = 0; i < 16; ++i) kA[i] = k0[i];
      } else {
#pragma unroll
        for (int i = 0; i < 16; ++i) kB[i] = k0[i];
      }
    }
    {
      unsigned* lk = (unsigned*)(ldsp + wid * 16896);
#pragma unroll
      for (int i = 0; i < 16; ++i) { lk[i * 64 + lane] = kA[i]; lk[(16 + i) * 64 + lane] = kB[i]; }
      float fa[16], fb[16];
#pragma unroll
      for (int i = 0; i < 16; ++i) { fa[i] = sort2f(kA[i]); fb[i] = sort2f(kB[i]); }
#define CAND(ci_, cj_) ((f2sort(fa[ci_] + fb[cj_]) & 0xFFFFFF00u) | (unsigned)(255 - ((ci_) * 16 + (cj_))))
      unsigned R0[16], R1[16], S1[16], S2[16];
#pragma unroll
      for (int j = 0; j < 16; ++j) { R0[j] = CAND(0, j); R1[j] = (j < 8) ? CAND(1, j & 7) : 0u; }
      S1[0] = CAND(2, 0); S1[1] = CAND(2, 1); S1[2] = CAND(2, 2); S1[3] = CAND(2, 3); S1[4] = CAND(2, 4);
      S1[5] = CAND(3, 0); S1[6] = CAND(3, 1); S1[7] = CAND(3, 2); S1[8] = CAND(3, 3);
      S1[9] = CAND(4, 0); S1[10] = CAND(4, 1); S1[11] = CAND(4, 2);
      S1[12] = CAND(5, 0); S1[13] = CAND(5, 1); S1[14] = CAND(6, 0); S1[15] = CAND(6, 1);
      S2[0] = CAND(7, 0); S2[1] = CAND(7, 1);
#pragma unroll
      for (int i = 8; i < 16; ++i) S2[i - 6] = CAND(i, 0);
#pragma unroll
      for (int i = 10; i < 16; ++i) S2[i] = 0u;
#undef CAND
      merge_top16(R0, R1);
      bitonic_sort_desc<16>(S1); bitonic_sort_desc<16>(S2);
      merge_top16(S1, S2);
      merge_top16(R0, S1);
      float sc[16]; unsigned ex[16]; float mx = -3.0e38f;
#pragma unroll
      for (int i = 0; i < 16; ++i) {
        const int flat = 255 - (int)(R0[i] & 255u);
        const unsigned ka = lk[(flat >> 4) * 64 + lane], kb = lk[(16 + (flat & 15)) * 64 + lane];
        sc[i] = sort2f(ka) + sort2f(kb);
        ex[i] = (127u - (ka & 127u)) * 128u + (127u - (kb & 127u));
        mx = fmaxf(mx, sc[i]);
      }
      float sm = 0.f;
#pragma unroll
      for (int i = 0; i < 16; ++i) { sc[i] = __expf(sc[i] - mx); sm += sc[i]; }
      const float rsm = 1.f / sm;
      unsigned* dst = tops + (size_t)(u.pm * 256 + wid * 32 + c) * 256 + h * 128 + u.pn * 16;
#pragma unroll
      for (int q4 = 0; q4 < 4; ++q4) {
        u32x4 o;
#pragma unroll
        for (int i = 0; i < 4; ++i) o[i] = h ? __float_as_uint(sc[4 * q4 + i] * rsm) : ex[4 * q4 + i];
        *(u32x4*)(dst + 4 * q4) = o;
      }
    }
    __syncthreads();
  }
};


template <int CTRL> DI float dpp_f(float v) { const int iv = __float_as_int(v); return __int_as_float(__builtin_amdgcn_update_dpp(iv, iv, CTRL, 0xF, 0xF, false)); }
DI float wsum(float x) {
  x += dpp_f<0xB1>(x);
  x += dpp_f<0x4E>(x);
  x += dpp_f<0x124>(x);
  x += dpp_f<0x128>(x);
  x += shx(x, 16);
  return hsum(x);
}
DI float gelu_fast(float x) {
  const float u2 = 1.5957691216057308f * (x + 0.044715f * x * x * x);
  return x * __builtin_amdgcn_rcpf(1.f + ex2(-LOG2E * u2));
}

constexpr int EROW = 1024;
typedef float v2f __attribute__((ext_vector_type(2)));
__device__ void d_cvt_fp4_row(int row, const float* __restrict__ src, unsigned char* __restrict__ dst, float* __restrict__ scales) {
  const int lane = TIDX & 63;
  float v[32]; float amax = 0.f;
#pragma unroll
  for (int i = 0; i < 8; ++i) {
    f32x4 x = *(const f32x4*)(src + (size_t)row * DM + 256 * i + 4 * lane);
#pragma unroll
    for (int j = 0; j < 4; ++j) { v[i * 4 + j] = x[j]; amax = fmaxf(amax, fabsf(x[j])); }
  }
  amax = wave_max(amax);
  const float sc = amax > 0.f ? amax * (1.f / 7.f) : 1.f;
  const float inv = 1.f / sc;
  u32x4 o;
#pragma unroll
  for (int k = 0; k < 4; ++k) {
    unsigned w = 0u;
#define FP4C(x_) fminf(fmaxf((x_) * inv, -6.f), 6.f)
    w = __builtin_amdgcn_cvt_scalef32_pk_fp4_f32(w, FP4C(v[8 * k + 0]), FP4C(v[8 * k + 1]), 1.0f, 0);
    w = __builtin_amdgcn_cvt_scalef32_pk_fp4_f32(w, FP4C(v[8 * k + 2]), FP4C(v[8 * k + 3]), 1.0f, 1);
    w = __builtin_amdgcn_cvt_scalef32_pk_fp4_f32(w, FP4C(v[8 * k + 4]), FP4C(v[8 * k + 5]), 1.0f, 2);
    w = __builtin_amdgcn_cvt_scalef32_pk_fp4_f32(w, FP4C(v[8 * k + 6]), FP4C(v[8 * k + 7]), 1.0f, 3);
#undef FP4C
    o[k] = w;
  }
  *(u32x4*)(dst + (size_t)row * EROW + 16 * lane) = o;
  if (lane == 0) scales[row] = sc;
}
__device__ void d_cvt_i4_row(int row, const float* __restrict__ src, unsigned char* __restrict__ dst, float* __restrict__ scales) {
  const int lane = TIDX & 63;
  float v[32]; float amax = 0.f, ss = 0.f;
#pragma unroll
  for (int i = 0; i < 8; ++i) {
    f32x4 x = *(const f32x4*)(src + (size_t)row * DM + 256 * i + 4 * lane);
#pragma unroll
    for (int j = 0; j < 4; ++j) { v[i * 4 + j] = x[j]; amax = fmaxf(amax, fabsf(x[j])); ss = fmaf(x[j], x[j], ss); }
  }
  amax = wave_max(amax); ss = wave_sum(ss);
  float sc = fmaxf(0.36f * sqrtf(ss * (1.f / DM)), amax * (1.f / 14.f));
  sc = sc > 0.f ? sc : 1.f;
  const float inv = 1.f / sc;
  u32x4 o;
#pragma unroll
  for (int k = 0; k < 4; ++k) {
    unsigned w = 0u;
#pragma unroll
    for (int j = 0; j < 8; ++j) {
      const float q = fminf(fmaxf(v[8 * k + j] * inv, -7.f), 7.f) + 12582912.f;
      w |= (__float_as_uint(q) & 15u) << (4 * j);
    }
    o[k] = w;
  }
  *(u32x4*)(dst + (size_t)row * EROW + 16 * lane) = o;
  if (lane == 0) scales[row] = sc;
}
__device__ void d_expert_group(int tg0, int tstr, unsigned* tpl, unsigned* slw, const bf16_t* __restrict__ hbuf, const unsigned* __restrict__ tops,
                               const unsigned char* __restrict__ eu4, const unsigned char* __restrict__ ev4, const float* __restrict__ esu, const float* __restrict__ esv,
                               const float* __restrict__ gam, const float* __restrict__ bet, float* __restrict__ out) {
  const int lane = TIDX & 63;
#define SLOT(j_, f_) slw[((j_) * 16 + (f_)) * 64 + lane]
#pragma unroll 1
  for (int j = 0; j < 4; ++j) {
    const int tt = tg0 + j * tstr, t = tt < S ? tt : S - 1;
  float hv[32];
#pragma unroll
  for (int i = 0; i < 8; ++i) {
    const u32x2 w = *(const u32x2*)(hbuf + (size_t)t * DM + 256 * i + 4 * lane);
    hv[i * 4 + 0] = __uint_as_float(w[0] << 16); hv[i * 4 + 1] = __uint_as_float(w[0] & 0xFFFF0000u);
    hv[i * 4 + 2] = __uint_as_float(w[1] << 16); hv[i * 4 + 3] = __uint_as_float(w[1] & 0xFFFF0000u);
  }
  int e0 = (int)tops[(size_t)t * 256 + lane], e1 = (int)tops[(size_t)t * 256 + 64 + lane];
  float w0 = __uint_as_float(tops[(size_t)t * 256 + 128 + lane]), w1 = __uint_as_float(tops[(size_t)t * 256 + 192 + lane]);
  {
    unsigned k0 = ((unsigned)e0 << 7) | (unsigned)lane, k1 = ((unsigned)e1 << 7) | (unsigned)(64 + lane);
#pragma unroll
    for (int k = 2; k <= 128; k <<= 1) {
#pragma unroll
      for (int jj = k >> 1; jj > 0; jj >>= 1) {
        if (jj == 64) { const unsigned mn = k0 < k1 ? k0 : k1, mx = k0 < k1 ? k1 : k0; k0 = mn; k1 = mx; }
        else {
          const unsigned o0 = (unsigned)shx_i((int)k0, jj), o1 = (unsigned)shx_i((int)k1, jj);
          const bool lower = (lane & jj) == 0;
          const bool asc0 = (k >= 64) ? true : ((lane & k) == 0), asc1 = (k == 128) ? true : (k == 64) ? false : ((lane & k) == 0);
          const unsigned mn0 = k0 < o0 ? k0 : o0, mx0 = k0 < o0 ? o0 : k0, mn1 = k1 < o1 ? k1 : o1, mx1 = k1 < o1 ? o1 : k1;
          k0 = (lower == asc0) ? mn0 : mx0; k1 = (lower == asc1) ? mn1 : mx1;
        }
      }
    }
    const int o0 = (int)(k0 & 127u), o1 = (int)(k1 & 127u);
    const float wa0 = __shfl(w0, o0 & 63), wb0 = __shfl(w1, o0 & 63), wa1 = __shfl(w0, o1 & 63), wb1 = __shfl(w1, o1 & 63);
    e0 = (int)(k0 >> 7); e1 = (int)(k1 >> 7); w0 = (o0 < 64) ? wa0 : wb0; w1 = (o1 < 64) ? wa1 : wb1;
  }
  int hhi[4], hlo[4]; float hsc;
  {
    float m = 0.f;
#pragma unroll
    for (int i = 0; i < 32; ++i) m = fmaxf(m, fabsf(hv[i]));
    m = wave_max(m);
    hsc = m > 0.f ? m * (1.f / 119.f) : 1.f;
    const float hinv = 1.f / hsc;
#pragma unroll
    for (int q = 0; q < 4; ++q) {
      unsigned wh = 0u, wl = 0u;
#pragma unroll
      for (int j = 0; j < 8; ++j) {
        const unsigned b = __float_as_uint(fmaf(hv[8 * q + j], hinv, 12582912.f));
        wl |= (b & 15u) << (4 * j); wh |= (((b + 8u) >> 4) & 15u) << (4 * j);
      }
      hhi[q] = (int)wh; hlo[q] = (int)wl;
    }
  }
    const float su0 = esu[e0], su1 = esu[e1], sv0 = esv[e0], sv1 = esv[e1];
#pragma unroll
    for (int q = 0; q < 4; ++q) { SLOT(j, q) = (unsigned)hhi[q]; SLOT(j, 4 + q) = (unsigned)hlo[q]; }
    SLOT(j, 8) = (unsigned)e0; SLOT(j, 9) = (unsigned)e1;
    SLOT(j, 10) = __float_as_uint(hsc * su0); SLOT(j, 11) = __float_as_uint(hsc * su1);
    SLOT(j, 12) = __float_as_uint(w0 * sv0); SLOT(j, 13) = __float_as_uint(w1 * sv1);
  }
  u32x4 rA[4], rB[4];
  const unsigned lo16 = (unsigned)(16 * lane);
#define G_LOAD(R, TAB, EX, LB)                                                             \
  _Pragma("unroll") for (int k = 0; k < 4; ++k) {                                          \
    const int id = __builtin_amdgcn_readlane((EX), (LB) + k);                              \
    R[k] = *(const u32x4*)((TAB) + (size_t)id * EROW + lo16);                              \
  }
#define PKFMA(a_, b_, c_) __builtin_elementwise_fma((a_), (b_), (c_))
  const int srcb = 4 * (((lane & 1) << 5) | ((lane & 2) << 3));
#define G_COMP_U(R, LB)                                                                    \
  {                                                                                        \
    int dd[4];                                                                             \
    _Pragma("unroll") for (int k = 0; k < 4; ++k) {                                        \
      int dh = 0, dl = 0;                                                                  \
      _Pragma("unroll") for (int q = 0; q < 4; ++q) {                                      \
        dh = __builtin_amdgcn_sdot8((int)R[k][q], hhi[q], dh, false);                      \
        dl = __builtin_amdgcn_sdot8((int)R[k][q], hlo[q], dl, false);                      \
      }                                                                                    \
      dd[k] = dh * 16 + dl;                                                                \
      __builtin_amdgcn_sched_barrier(0);                                                   \
    }                                                                                      \
    unsigned t01, t23;                                                                     \
    { auto r_ = __builtin_amdgcn_permlane32_swap((unsigned)dd[0], (unsigned)dd[1], false, false); t01 = r_[0] + r_[1]; }     \
    { auto r_ = __builtin_amdgcn_permlane32_swap((unsigned)dd[2], (unsigned)dd[3], false, false); t23 = r_[0] + r_[1]; }     \
    const bool b4_ = (lane & 16) != 0;                                                     \
    int tv = (int)(b4_ ? t23 : t01) + shx_i((int)(b4_ ? t01 : t23), 16);                   \
    tv += dpp_i<0x128>(tv); tv += dpp_i<0x124>(tv); tv += dpp_i<0x4E>(tv); tv += dpp_i<0xB1>(tv);   \
    const int got = __builtin_amdgcn_ds_bpermute(srcb, tv);                                \
    cc = ((unsigned)(lane - (LB)) < 4u) ? got : cc;                                        \
    __builtin_amdgcn_sched_barrier(0);                                                     \
  }
#define G_COMP_V(R, ACC, CF, LB)                                                           \
  _Pragma("unroll") for (int k = 0; k < 4; ++k) {                                          \
    const float cs = __int_as_float(__builtin_amdgcn_readlane(__float_as_int(CF), (LB) + k));   \
    const v2f cs2 = {cs, cs};                                                              \
    _Pragma("unroll") for (int q = 0; q < 4; ++q) {                                        \
      const unsigned wq = R[k][q];                                                         \
      const v2f f0 = __builtin_amdgcn_cvt_scalef32_pk_f32_fp4(wq, 1.0f, 0), f1 = __builtin_amdgcn_cvt_scalef32_pk_f32_fp4(wq, 1.0f, 1); \
      const v2f f2 = __builtin_amdgcn_cvt_scalef32_pk_f32_fp4(wq, 1.0f, 2), f3 = __builtin_amdgcn_cvt_scalef32_pk_f32_fp4(wq, 1.0f, 3); \
      ACC[4 * q + 0] = PKFMA(cs2, f0, ACC[4 * q + 0]); ACC[4 * q + 1] = PKFMA(cs2, f1, ACC[4 * q + 1]); \
      ACC[4 * q + 2] = PKFMA(cs2, f2, ACC[4 * q + 2]); ACC[4 * q + 3] = PKFMA(cs2, f3, ACC[4 * q + 3]); \
    }                                                                                      \
    __builtin_amdgcn_sched_barrier(0);                                                     \
  }
  {
    int eX = (int)SLOT(0, 8);
    G_LOAD(rA, eu4, eX, 0)
    __builtin_amdgcn_sched_barrier(0);
#pragma unroll 1
    for (int s_ = 0; s_ < 32; ++s_) {
      const int sg = s_ >> 2, j = s_ & 3, L0 = (sg & 3) * 16;
      const int sn = (s_ + 1) & 31, sgn = sn >> 2, jn = sn & 3, L0n = (sgn & 3) * 16;
      int hhi[4], hlo[4];
#pragma unroll
      for (int q = 0; q < 4; ++q) { hhi[q] = (int)SLOT(j, q); hlo[q] = (int)SLOT(j, 4 + q); }
      const int eXn = (int)SLOT(jn, 8 + (sgn >> 2));
      const unsigned char* tabn = (s_ == 31) ? ev4 : eu4;
      int cc = 0;
      G_LOAD(rB, eu4, eX, L0 + 4)
      __builtin_amdgcn_sched_barrier(0);
      G_COMP_U(rA, L0)
      G_LOAD(rA, eu4, eX, L0 + 8)
      __builtin_amdgcn_sched_barrier(0);
      G_COMP_U(rB, L0 + 4)
      G_LOAD(rB, eu4, eX, L0 + 12)
      __builtin_amdgcn_sched_barrier(0);
      G_COMP_U(rA, L0 + 8)
      G_LOAD(rA, tabn, eXn, L0n)
      __builtin_amdgcn_sched_barrier(0);
      G_COMP_U(rB, L0 + 12)
      if ((unsigned)(lane - L0) < 16u) SLOT(j, 14 + (sg >> 2)) = (unsigned)cc;
      eX = eXn;
    }
  }
#pragma unroll 1
  for (int j = 0; j < 4; ++j) {
    const float d0 = (float)(int)SLOT(j, 14), d1 = (float)(int)SLOT(j, 15);
    SLOT(j, 14) = __float_as_uint(__uint_as_float(SLOT(j, 12)) * gelu_fast(__uint_as_float(SLOT(j, 10)) * d0));
    SLOT(j, 15) = __float_as_uint(__uint_as_float(SLOT(j, 13)) * gelu_fast(__uint_as_float(SLOT(j, 11)) * d1));
  }
  v2f accv[4][16];
#pragma unroll
  for (int j = 0; j < 4; ++j)
#pragma unroll
    for (int i = 0; i < 16; ++i) accv[j][i] = v2f{0.f, 0.f};
  {
    int eX = (int)SLOT(0, 8);
#pragma unroll 1
    for (int sg = 0; sg < 8; ++sg) {
      const int L0 = (sg & 3) * 16;
#pragma unroll
      for (int j = 0; j < 4; ++j) {
        const int jn = (j + 1) & 3, sgn = (j == 3) ? ((sg + 1) & 7) : sg, L0n = (sgn & 3) * 16;
        const float cf = __uint_as_float(SLOT(j, 14 + (sg >> 2)));
        const int eXn = (int)SLOT(jn, 8 + (sgn >> 2));
        G_LOAD(rB, ev4, eX, L0 + 4)
        __builtin_amdgcn_sched_barrier(0);
        G_COMP_V(rA, accv[j], cf, L0)
        G_LOAD(rA, ev4, eX, L0 + 8)
        __builtin_amdgcn_sched_barrier(0);
        G_COMP_V(rB, accv[j], cf, L0 + 4)
        G_LOAD(rB, ev4, eX, L0 + 12)
        __builtin_amdgcn_sched_barrier(0);
        G_COMP_V(rA, accv[j], cf, L0 + 8)
        G_LOAD(rA, ev4, eXn, L0n)
        __builtin_amdgcn_sched_barrier(0);
        G_COMP_V(rB, accv[j], cf, L0 + 12)
        eX = eXn;
      }
    }
  }
#undef G_LOAD
#undef G_COMP_U
#undef G_COMP_V
#undef PKFMA
#pragma unroll
  for (int j = 0; j < 4; ++j) {
    const int t = tg0 + j * tstr;
    if (t < S) {
#define acc2 accv[j]
  float acc[32];
  #pragma unroll
    for (int i = 0; i < 16; ++i) { acc[2 * i] = acc2[i].x; acc[2 * i + 1] = acc2[i].y; }
    int le = lane;
    asm volatile("" : "+v"(le) :: "memory");
    float s = 0.f;
  #pragma unroll
    for (int i = 0; i < 8; ++i) {
      const u32x2 w = *(const u32x2*)(hbuf + (size_t)t * DM + 256 * i + 4 * le);
      const float h0 = __uint_as_float(w[0] << 16), h1 = __uint_as_float(w[0] & 0xFFFF0000u), h2 = __uint_as_float(w[1] << 16), h3 = __uint_as_float(w[1] & 0xFFFF0000u);
      acc[i * 4 + 0] = fmaf(ALPHA, h0, acc[i * 4 + 0]); acc[i * 4 + 1] = fmaf(ALPHA, h1, acc[i * 4 + 1]);
      acc[i * 4 + 2] = fmaf(ALPHA, h2, acc[i * 4 + 2]); acc[i * 4 + 3] = fmaf(ALPHA, h3, acc[i * 4 + 3]);
      s += (acc[i * 4 + 0] + acc[i * 4 + 1]) + (acc[i * 4 + 2] + acc[i * 4 + 3]);
    }
    s = wsum(s);
    const float mu = s * (1.f / DM);
    float qv = 0.f;
  #pragma unroll
    for (int i = 0; i < 32; ++i) { const float d = acc[i] - mu; qv += d * d; }
    qv = wsum(qv);
    const float rs = rsqrtf(qv * (1.f / DM) + 1e-5f);
  #pragma unroll
    for (int i = 0; i < 8; ++i) {
      const int cbase = 256 * i + 4 * le;
      f32x4 ga = *(const f32x4*)(gam + cbase), ba = *(const f32x4*)(bet + cbase), o;
  #pragma unroll
      for (int j = 0; j < 4; ++j) o[j] = (acc[i * 4 + j] - mu) * rs * ga[j] + ba[j];
      *(f32x4*)(out + (size_t)t * DM + cbase) = o;
    }
#undef acc2
    }
  }
#undef SLOT
}

constexpr size_t al256(size_t x) { return (x + 255) & ~(size_t)255; }
constexpr size_t WS_XB = 0;
constexpr size_t WS_PROJ = WS_XB + al256((size_t)S * DM * 2);
constexpr size_t WS_WINT = WS_PROJ + al256((size_t)S * INWP * 2);
constexpr size_t WS_GATES = WS_WINT + al256((size_t)INWG * DM * 2);
constexpr size_t WS_W1KF = WS_GATES + al256((size_t)S * 24 * 4);
constexpr size_t WS_W1VF = WS_W1KF + al256((size_t)512 * 4096 * 2);
constexpr size_t WS_W2KF = WS_W1VF + al256((size_t)512 * 4096 * 2);
constexpr size_t WS_W2VF = WS_W2KF + al256((size_t)512 * 128 * 2);
constexpr size_t WS_VC = WS_W2VF + al256((size_t)512 * 128 * 2) - al256((size_t)2048 * 128 * 4);
constexpr size_t WS_KCF = WS_VC + al256((size_t)2048 * 128 * 4);
constexpr size_t WS_VCF = WS_KCF + al256((size_t)2 * 32 * 4096 * 2);
constexpr size_t WS_KSF = WS_VCF + al256((size_t)2 * 32 * 4096 * 2);
constexpr size_t WS_VSF = WS_KSF + al256((size_t)2 * 512 * 4096 * 2);
constexpr size_t WS_KWF = WS_VSF + al256((size_t)2 * 512 * 4096 * 2);
constexpr size_t WS_VWF = WS_KWF + al256((size_t)2 * 512 * 4096 * 2);
constexpr size_t WS_ENDA = WS_VWF + al256((size_t)2 * 512 * 4096 * 2);
constexpr size_t WS_OATT = WS_ENDA;
constexpr size_t WS_MIX = WS_OATT + al256((size_t)S * 1024 * 4);
constexpr size_t WS_WOUTT = WS_MIX + al256((size_t)S * DM * 2);
constexpr size_t WS_WQT = WS_WOUTT + al256((size_t)DM * DM * 2);
constexpr size_t WS_TOPS = WS_WQT + al256((size_t)DM * DM * 2);
constexpr size_t WS_SKF = WS_TOPS + al256((size_t)S * 256 * 4);
constexpr size_t WS_STATS = WS_SKF + al256((size_t)16 * 128 * 128 * 2);
constexpr size_t WS_CTRL = WS_STATS + al256((size_t)S * 2 * 4);
constexpr size_t CTRL_BYTES = 32768;
constexpr size_t WS_END = WS_CTRL + CTRL_BYTES;
constexpr size_t WS_Y = WS_PROJ;
constexpr size_t WS_HB = WS_XB;
constexpr size_t WS_EU8 = WS_OATT;
constexpr size_t WS_EV8 = WS_EU8 + (size_t)16384 * 1024;
constexpr size_t WS_ESU = WS_EV8 + (size_t)16384 * 1024;
constexpr size_t WS_ESV = WS_ESU + 16384 * 4;
static_assert(WS_ESV + 16384 * 4 <= WS_MIX, "expert tables overflow their region");
constexpr int EXP_EARLY = 6144;
static_assert(WS_END <= (size_t)512 * 1024 * 1024, "workspace over 512 MiB");

struct Params {
  const float *x, *w_in, *ck_pos, *ck_w1, *ck_b1, *ck_w2, *cv_pos, *cv_w1, *cv_b1, *cv_w2, *conv_w, *hng, *w_out, *ln1g, *ln1b, *w_query, *subk,
      *eu, *ev, *ln2g, *ln2b;
  float* out;
  char* ws;
};
#define WSP(T, OFF) ((T*)(p.ws + (OFF)))

#define FOR_VB(n) for (int vb = blockIdx.x; vb < (n); vb += gridDim.x)
#define FOR_VB2(n) for (int vb = blockIdx.x * 2 + (TIDX >> 8); vb < (n); vb += gridDim.x * 2)
constexpr int SMEM_BYTES = 147456;
constexpr int HALF = 36864;

__global__ void __launch_bounds__(512) mega(Params p) {
  __shared__ __attribute__((aligned(16))) char smem[SMEM_BYTES + 16];
  if (TIDX == 0) *(u32x4*)(smem + SMEM_BYTES) = u32x4{0u, 0u, 0u, 0u};
  __syncthreads();
  const XcdBarrier xbar = xcd_barrier_post(WSP(unsigned, WS_CTRL + 1024), (volatile LAS unsigned*)(smem + SMEM_BYTES));
#define smh (smem + (TIDX >> 8) * HALF)
#define wv ((TIDX >> 6))
  constexpr int NWV = 8;
  d_cvt(p.x, WSP(bf16_t, WS_XB), (size_t)S * DM / 4);
  FOR_VB2((INWG / 64) * (DM / 64)) d_cvtT64(vb, smh, p.w_in, WSP(bf16_t, WS_WINT), DM, INW, INWG);
  for (size_t c = (size_t)blockIdx.x * 512 + TIDX; c < (size_t)16 * 256 * 64; c += (size_t)gridDim.x * 512) {
    d_cvt_w1f(c, p.ck_w1, WSP(bf16_t, WS_W1KF)); d_cvt_w1f(c, p.cv_w1, WSP(bf16_t, WS_W1VF));
    if (c < (size_t)4 * 32 * 64) { d_cvt_w2f(c, p.ck_w2, WSP(bf16_t, WS_W2KF)); d_cvt_w2f(c, p.cv_w2, WSP(bf16_t, WS_W2VF)); }
  }
  FOR_VB2((DM / 64) * (DM / 64)) d_cvtT64(vb, smh, p.w_out, WSP(bf16_t, WS_WOUTT), DM, DM, DM);
  FOR_VB2((DM / 64) * (DM / 64)) d_cvtT64(vb, smh, p.w_query, WSP(bf16_t, WS_WQT), DM, DM, DM);
  for (size_t c = (size_t)blockIdx.x * 512 + TIDX; c < (size_t)16 * 4 * 8 * 64; c += (size_t)gridDim.x * 512) d_cvt_subk(c, p.subk, WSP(bf16_t, WS_SKF));
  xcd_barrier(xbar);
  {
    pg8::StaticOrder so; so.init(S, INWG, gridDim.x, blockIdx.x);
    pg8::gemm_phase<EpiProjG, pg8::StaticOrder>((PG8_LAS unsigned char*)smem, pg8::Gemm{WSP(bf16_t, WS_XB), WSP(bf16_t, WS_WINT), S, INWG, DM}, so,
                                                EpiProjG{WSP(bf16_t, WS_PROJ), WSP(float, WS_GATES), (PG8_LAS unsigned char*)smem + pg8::STAGE_BYTES}, nullptr);
    const int nun = (S / 256) * (INWG / 256), gsz = (int)gridDim.x;
    const int nfull = nun % gsz;
    if (nfull != 0 && (int)blockIdx.x >= nfull) {
      const int nidle = gsz - nfull, me = (int)blockIdx.x - nfull;
      for (int r = me * NWV + wv; r < 2 * EXP_EARLY; r += nidle * NWV) {
        if (r < EXP_EARLY) d_cvt_i4_row(r, p.eu, WSP(unsigned char, WS_EU8), WSP(float, WS_ESU)); else d_cvt_fp4_row(r - EXP_EARLY, p.ev, WSP(unsigned char, WS_EV8), WSP(float, WS_ESV));
      }
    }
  }
  xcd_barrier(xbar);
  {
    if (blockIdx.x < 128) {
      const int xcd_ = blockIdx.x & 7, idx_ = blockIdx.x >> 3; const bool isV = (xcd_ & 1) != 0;
      d_compress_unit((xcd_ >> 1) * 16 + idx_, smem, WSP(bf16_t, WS_PROJ), isV ? OFF_VC : OFF_KC, isV ? p.cv_pos : p.ck_pos, isV ? WSP(bf16_t, WS_W1VF) : WSP(bf16_t, WS_W1KF),
                      isV ? p.cv_b1 : p.ck_b1, isV ? WSP(bf16_t, WS_W2VF) : WSP(bf16_t, WS_W2KF), isV ? WSP(bf16_t, WS_VCF) : WSP(bf16_t, WS_KCF), isV);
    }
    int* slot = (int*)smem;
    unsigned* ctr = WSP(unsigned, WS_CTRL);
    for (;;) {
      if (TIDX == 0) *slot = (int)atomicAdd(ctr, 1u);
      __syncthreads();
      const int it = *slot;
      __syncthreads();
      if (it >= 2048) break;
      const int tt = TIDX;
      {
        const int T = it >> 2, which = it & 3;
        d_relayout_tile(T, smem + 64, WSP(bf16_t, WS_PROJ), (which == 0) ? OFF_KS : (which == 1) ? OFF_VS : (which == 2) ? OFF_KW : OFF_VW,
                        (which == 0) ? WSP(bf16_t, WS_KSF) : (which == 1) ? WSP(bf16_t, WS_VSF) : (which == 2) ? WSP(bf16_t, WS_KWF) : WSP(bf16_t, WS_VWF), (which & 1) != 0);
      }
      for (int q = 0; q < 2; ++q) d_convmix(it * 8 + q * 4 + (tt >> 7), tt & 127, WSP(bf16_t, WS_PROJ), p.conv_w, p.hng, WSP(bf16_t, WS_MIX));
    }
  }
  xcd_barrier(xbar);
  {
    AttnPtrs ap{WSP(bf16_t, WS_PROJ), WSP(float, WS_GATES), WSP(bf16_t, WS_KCF), WSP(bf16_t, WS_VCF), WSP(bf16_t, WS_KSF), WSP(bf16_t, WS_VSF), WSP(bf16_t, WS_KWF), WSP(bf16_t, WS_VWF), WSP(bf16_t, WS_MIX), p.hng};
    for (int it = blockIdx.x; it < 512; it += gridDim.x) {
      const int Bq = (it < 256) ? it : (511 - it), gq = (it < 256) ? 0 : 1;
      d_attn_block(Bq, gq, smem, ap);
    }
  }
  xcd_barrier(xbar);
  {
    pg8::StaticOrder so; so.init(S, DM, gridDim.x, blockIdx.x);
    pg8::gemm_phase<EpiResG, pg8::StaticOrder>((PG8_LAS unsigned char*)smem, pg8::Gemm{WSP(bf16_t, WS_MIX), WSP(bf16_t, WS_WOUTT), S, DM, DM}, so,
                                               EpiResG{WSP(bf16_t, WS_HB), (PG8_LAS unsigned char*)smem + pg8::STAGE_BYTES}, nullptr);
  }
  xcd_barrier(xbar);
  for (int r = blockIdx.x * NWV + wv; r < S; r += gridDim.x * NWV) d_ln_wave(r, WSP(bf16_t, WS_HB), p.ln1g, p.ln1b);
  {
    const int e0_ = (((S / 256) * (INWG / 256)) % (int)gridDim.x != 0) ? EXP_EARLY : 0;
    const int nrest = 16384 - e0_;
    for (int r = blockIdx.x * NWV + wv; r < 2 * nrest; r += gridDim.x * NWV) {
      if (r < nrest) d_cvt_i4_row(e0_ + r, p.eu, WSP(unsigned char, WS_EU8), WSP(float, WS_ESU)); else d_cvt_fp4_row(e0_ + r - nrest, p.ev, WSP(unsigned char, WS_EV8), WSP(float, WS_ESV));
    }
  }
  xcd_barrier(xbar);
  for (int k = 0; k * (int)gridDim.x < (S / 256) * (DM / 256); ++k) {
    pg8::OneUnit so; so.init(S, DM, gridDim.x, blockIdx.x); so.k = k;
    pg8::gemm_phase<EpiRouteG, pg8::OneUnit>((PG8_LAS unsigned char*)smem, pg8::Gemm{WSP(bf16_t, WS_HB), WSP(bf16_t, WS_WQT), S, DM, DM}, so,
                                             EpiRouteG{WSP(bf16_t, WS_SKF), WSP(unsigned, WS_TOPS)}, nullptr);
    __syncthreads();
  }
  xcd_barrier(xbar);
  {
    const int tstr = (int)gridDim.x * NWV;
    for (int tg0 = blockIdx.x * NWV + wv; tg0 < S; tg0 += 4 * tstr)
      d_expert_group(tg0, tstr, (unsigned*)(smem + wv * 1024), (unsigned*)(smem + 8192 + wv * 16384), WSP(bf16_t, WS_HB), WSP(unsigned, WS_TOPS), WSP(unsigned char, WS_EU8), WSP(unsigned char, WS_EV8),
                     WSP(float, WS_ESU), WSP(float, WS_ESV), p.ln2g, p.ln2b, p.out);
  }
}

extern "C" void kernel_launch(void* const* d_in, const int* in_sizes, int n_in, void* d_out, int out_size, void* d_ws, size_t ws_size,
                              hipStream_t stream) {
  Params p{};
  p.x = (const float*)d_in[0]; p.w_in = (const float*)d_in[1]; p.ck_pos = (const float*)d_in[2]; p.ck_w1 = (const float*)d_in[3];
  p.ck_b1 = (const float*)d_in[4]; p.ck_w2 = (const float*)d_in[5]; p.cv_pos = (const float*)d_in[6]; p.cv_w1 = (const float*)d_in[7];
  p.cv_b1 = (const float*)d_in[8]; p.cv_w2 = (const float*)d_in[9]; p.conv_w = (const float*)d_in[10]; p.hng = (const float*)d_in[11];
  p.w_out = (const float*)d_in[12]; p.ln1g = (const float*)d_in[13]; p.ln1b = (const float*)d_in[14]; p.w_query = (const float*)d_in[15];
  p.subk = (const float*)d_in[16]; p.eu = (const float*)d_in[17]; p.ev = (const float*)d_in[18]; p.ln2g = (const float*)d_in[19];
  p.ln2b = (const float*)d_in[20];
  p.out = (float*)d_out;
  p.ws = (char*)d_ws;
  if (ws_size < WS_END) fprintf(stderr, "workspace too small\n");
  static int grid_blocks = 0;
  if (!grid_blocks) {
    int dev = 0, cus = 0, per_cu = 0;
    hipGetDevice(&dev);
    hipDeviceGetAttribute(&cus, hipDeviceAttributeMultiprocessorCount, dev);
    hipOccupancyMaxActiveBlocksPerMultiprocessor(&per_cu, mega, 512, 0);
    if (per_cu > 1) per_cu = 1;
    if (per_cu < 1) per_cu = 1;
    grid_blocks = cus * per_cu;
  }
  hipMemsetAsync((char*)d_ws + WS_CTRL, 0, CTRL_BYTES, stream);
  void* args[] = {&p};
  hipError_t e = hipLaunchCooperativeKernel((void*)mega, dim3(grid_blocks), dim3(512), args, 0, stream);
  if (e != hipSuccess) fprintf(stderr, "cooperative launch failed: %s (grid %d)\n", hipGetErrorString(e), grid_blocks);
}
```

```cpp
#include <hip/hip_runtime.h>
#include <stdint.h>
#include <stdio.h>


#define DI __device__ __forceinline__
static __device__ __forceinline__ int tidx_() { int t = (int)__builtin_amdgcn_workitem_id_x(); asm volatile("" : "+v"(t)); return t; }
#define TIDX (tidx_())

template <int J> DI int swz_xor(int x) { return __builtin_amdgcn_ds_swizzle(x, (J << 10) | 0x1F); }
template <int CTRL> DI int dpp_i(int x) { return __builtin_amdgcn_update_dpp(x, x, CTRL, 0xF, 0xF, false); }
DI int shx_i(int x, int j) {
  switch (j) {
    case 1: return dpp_i<0xB1>(x);
    case 2: return dpp_i<0x4E>(x);
    case 4: return dpp_i<0x1B>(dpp_i<0x141>(x));
    case 8: return dpp_i<0x128>(x);
    case 16: return swz_xor<16>(x);
    default: {
      auto r = __builtin_amdgcn_permlane32_swap((unsigned)x, (unsigned)x, false, false);
      return (TIDX & 32) ? (int)r[0] : (int)r[1];
    }
  }
}
DI float shx(float x, int j) { return __int_as_float(shx_i(__float_as_int(x), j)); }
typedef unsigned short bf16_t;
using bf16x8 = __attribute__((ext_vector_type(8))) short;
using f32x4 = __attribute__((ext_vector_type(4))) float;
using u32x4 = __attribute__((ext_vector_type(4))) unsigned;
using u32x2 = __attribute__((ext_vector_type(2))) unsigned;

constexpr int S = 16384, DM = 2048, HD = 128;
constexpr int INW = 5656, INWP = 5760, INWG = 5888;
constexpr int OFF_Q = 0, OFF_KC = 1024, OFF_VC = 1280, OFF_KS = 1536, OFF_VS = 1792, OFF_KW = 2048, OFF_VW = 2304,
              OFF_G = 2560, OFF_U = 2584, OFF_B = 3608, OFF_C = 4632;
constexpr int NCMP = 1023;
constexpr float ALPHA = 1.189207115002721f;
constexpr float QSCALE = 0.08838834764831845f;

DI bf16_t f2bf(float x) { unsigned u = __float_as_uint(x); u += 0x7fffu + ((u >> 16) & 1u); return (bf16_t)(u >> 16); }
DI float bf2f(bf16_t b) { return __uint_as_float(((unsigned)b) << 16); }
DI float gelu_tanh(float x) { float u = 0.7978845608028654f * (x + 0.044715f * x * x * x); return 0.5f * x * (1.f + tanhf(u)); }
DI float wave_sum(float v) { for (int o = 32; o > 0; o >>= 1) v += shx(v, o); return v; }
using bf16x2v = __attribute__((ext_vector_type(2))) __bf16;
DI unsigned pack2(float a, float b) { bf16x2v v = {(__bf16)a, (__bf16)b}; return __builtin_bit_cast(unsigned, v); }
DI float wave_max(float v) { for (int o = 32; o > 0; o >>= 1) v = fmaxf(v, shx(v, o)); return v; }

namespace pg8 {
#define PG8_LAS __attribute__((address_space(3)))
typedef unsigned short bf16_t;
typedef short bf16x8 __attribute__((ext_vector_type(8)));
typedef float f32x4 __attribute__((ext_vector_type(4)));
typedef unsigned u32x4 __attribute__((ext_vector_type(4)));
constexpr int BM = 256, BK = 64, HALF = 128, HTB = HALF * BK * 2  , STAGE_BYTES = 8 * HTB, NXCD = 8, WGM = 8;

__host__ __device__ __forceinline__ int lds_byte(int r, int c) { const int st = (r >> 4) * 2 + (c >> 5), rr = r & 15, cc = c & 31, ob = rr * 64 + cc * 2; return st * 1024 + (ob ^ (((ob >> 9) & 1) << 5)); }
__host__ __device__ __forceinline__ void stage_rc(int b, int& R, int& C) { const int st = b / 1024, sb = b % 1024, swz = sb ^ (((sb >> 9) & 1) << 5); R = (st >> 1) * 16 + swz / 64; C = (st & 1) * 32 + (swz % 64) / 2; }
__host__ __device__ __forceinline__ int perm32(int rho) { const int n = rho >> 4, i = rho & 15; return 8 * (i >> 2) + 4 * n + (i & 3); }

struct Unit { int pm, pn; };
struct Gemm { const bf16_t* A; const bf16_t* Bt; int M, N, K; };

struct StaticOrder {
    int nM, nN, nwg, G, c;
    __host__ __device__ void init(int M, int N, int G_, int c_) { nM = M / BM; nN = N / BM; nwg = nM * nN; G = G_; c = c_; }
    __host__ __device__ bool next(int i, Unit& u) const {
        const long L = (long)i * G + c; if (L >= nwg) return false;
        int wgid = (int)L; { const int q = nwg / NXCD, r = nwg % NXCD, xcd = wgid % NXCD, off = wgid / NXCD; wgid = (xcd < r ? xcd * (q + 1) : r * (q + 1) + (xcd - r) * q) + off; }
        const int nig = WGM * nN, gid = wgid / nig, fm = gid * WGM, gsz = (nM - fm) < WGM ? (nM - fm) : WGM;
        u.pm = fm + ((wgid % nig) % gsz); u.pn = (wgid % nig) / gsz; return true;
    }
    __device__ __forceinline__ void a_ready(const Unit&) const {}
    __device__ __forceinline__ void done(const Unit&) const {}
};
struct OneUnit : StaticOrder {
    int k;
    __device__ bool next(int i, Unit& u) const { if (i > 0) return false; return StaticOrder::next(k, u); }
};
__device__ __forceinline__ unsigned cvt_pk_bf16(float lo, float hi) { unsigned r; asm volatile("v_cvt_pk_bf16_f32 %0, %1, %2" : "=v"(r) : "v"(lo), "v"(hi)); return r; }
template <class Epi, class Sched, bool STAMP = false>
__device__ __forceinline__ void gemm_phase(PG8_LAS unsigned char* lds, const Gemm g, const Sched& S, const Epi& E, unsigned long long* stamps) {
    const int tid = TIDX, wid = __builtin_amdgcn_readfirstlane(tid >> 6), lane = tid & 63, wr = wid >> 2, wc = wid & 3, fr = lane & 15, fq = lane >> 4;
    const int K = g.K, nt = K / BK;
    int ts_lo = 0, ts_hi = 0, nts = 0; const unsigned long long rt_entry = STAMP ? (unsigned long long)wall_clock64() : 0ull;
#define PG8_STAMP() do { if (STAMP && wid == 0 && nts < 64) { const unsigned long long _c = (unsigned long long)clock64(); \
        ts_lo = (lane == nts) ? (int)(unsigned)_c : ts_lo; ts_hi = (lane == nts) ? (int)(unsigned)(_c >> 32) : ts_hi; ++nts; } } while (0)
    PG8_STAMP();
    unsigned voffA[2], voffB[2];
#pragma unroll
    for (int i = 0; i < 2; ++i) { int R, C; stage_rc(tid * 16 + i * 8192, R, C); const int Rb = Epi::PERM ? ((R & ~31) + perm32(R & 31)) : R;
        voffA[i] = (unsigned)(R * K + C) * 2u; voffB[i] = (unsigned)(Rb * K + C) * 2u; }
    const size_t kstep = (size_t)(BK * 2);
    const size_t hstep = (size_t)HALF * K * 2;
    const size_t tstep = 2 * hstep;
    const unsigned ldsw = (unsigned)wid * 1024u;
    const int aoff = lds_byte(wr * 64 + fr, fq * 8), boff = lds_byte(wc * 32 + fr, fq * 8);
#define PG8_SA(b, h) (((b) * 2 + (h)) * HTB)
#define PG8_SB(b, h) ((4 + (b) * 2 + (h)) * HTB)
#define PG8_STAGE(bufoff, gbase, voff) do { _Pragma("unroll") for (int _i = 0; _i < 2; ++_i) \
        __builtin_amdgcn_global_load_lds((const unsigned*)((const char*)(gbase) + (voff)[_i]), (PG8_LAS unsigned*)(lds + (bufoff) + ldsw + _i * 8192), 16, 0, 0); } while (0)
#define PG8_LDA(dst, b, h) do { _Pragma("unroll") for (int m = 0; m < 4; ++m) _Pragma("unroll") for (int k = 0; k < 2; ++k) dst[m][k] = *(const PG8_LAS bf16x8*)(lds + PG8_SA(b, h) + aoff + m * 2048 + k * 1024); } while (0)
#define PG8_LDB(dst, b, h) do { _Pragma("unroll") for (int n = 0; n < 2; ++n) _Pragma("unroll") for (int k = 0; k < 2; ++k) dst[n][k] = *(const PG8_LAS bf16x8*)(lds + PG8_SB(b, h) + boff + n * 2048 + k * 1024); } while (0)
#define PG8_MMA(ai, bj, At, Bt) do { __builtin_amdgcn_s_setprio(1); _Pragma("unroll") for (int m = 0; m < 4; ++m) _Pragma("unroll") for (int n = 0; n < 2; ++n) _Pragma("unroll") for (int k = 0; k < 2; ++k) \
        acc[ai][bj][m][n] = __builtin_amdgcn_mfma_f32_16x16x32_bf16(Bt[n][k], At[m][k], acc[ai][bj][m][n], 0, 0, 0); __builtin_amdgcn_s_setprio(0); } while (0)
#define PG8_WAIT_V(n) asm volatile("s_waitcnt vmcnt(" #n ")" ::: "memory")
#define PG8_WAIT_L(n) asm volatile("s_waitcnt lgkmcnt(" #n ")" ::: "memory")
#define PG8_BAR __builtin_amdgcn_s_barrier()
#define PG8_SCHED __builtin_amdgcn_sched_barrier(0)
    Unit cur, nxt; int ui = 0;
    if (!S.next(0, cur)) return;
    f32x4 acc[2][2][4][2];
#pragma unroll
    for (int a = 0; a < 2; ++a)
#pragma unroll
        for (int b = 0; b < 2; ++b)
#pragma unroll
            for (int m = 0; m < 4; ++m)
#pragma unroll
                for (int n = 0; n < 2; ++n) acc[a][b][m][n] = (f32x4){0.f, 0.f, 0.f, 0.f};
    bf16x8 At[4][2], B0[2][2], B1[2][2];
    const char* cA = (const char*)g.A + (size_t)cur.pm * tstep; const char* cB = (const char*)g.Bt + (size_t)cur.pn * tstep;
    S.a_ready(cur);
    PG8_STAGE(PG8_SB(0, 0), cB, voffB); PG8_STAGE(PG8_SA(0, 0), cA, voffA); PG8_STAGE(PG8_SB(0, 1), cB + hstep, voffB); PG8_STAGE(PG8_SA(0, 1), cA + hstep, voffA);
    if (wr == 1) PG8_BAR;
    PG8_WAIT_V(4); PG8_BAR;
    PG8_STAGE(PG8_SB(1, 0), cB + kstep, voffB); PG8_STAGE(PG8_SA(1, 0), cA + kstep, voffA); PG8_STAGE(PG8_SB(1, 1), cB + hstep + kstep, voffB);
    PG8_WAIT_V(6); PG8_BAR;
    PG8_STAMP();
    for (;;) {
        const bool has_next = S.next(ui + 1, nxt);
        const char* nA = has_next ? (const char*)g.A + (size_t)nxt.pm * tstep : cA; const char* nB = has_next ? (const char*)g.Bt + (size_t)nxt.pn * tstep : cB;
        for (int t = 0; t < nt; t += 2) {
            const bool last = (t == nt - 2);
            const char* a1 = cA + (size_t)(t + 1) * kstep;
            const char* a2 = last ? nA : cA + (size_t)(t + 2) * kstep; const char* b2 = last ? nB : cB + (size_t)(t + 2) * kstep;
            const char* a3 = a2 + kstep; const char* b3 = b2 + kstep;
            if (last && has_next) S.a_ready(nxt);
            PG8_LDB(B0, 0, 0); PG8_SCHED; PG8_LDA(At, 0, 0); PG8_STAGE(PG8_SA(1, 1), a1 + hstep, voffA);
            PG8_WAIT_L(8); PG8_BAR; PG8_WAIT_L(0); PG8_MMA(0, 0, At, B0); PG8_BAR; PG8_SCHED;
            PG8_LDB(B1, 0, 1); PG8_STAGE(PG8_SB(0, 0), b2, voffB);
            PG8_BAR; PG8_WAIT_L(0); PG8_MMA(0, 1, At, B1); PG8_BAR;
            PG8_LDA(At, 0, 1); PG8_STAGE(PG8_SA(0, 0), a2, voffA);
            PG8_BAR; PG8_WAIT_L(0); PG8_MMA(1, 0, At, B0); PG8_BAR; PG8_SCHED;
            PG8_STAGE(PG8_SB(0, 1), b2 + hstep, voffB);
            PG8_WAIT_V(6); PG8_BAR; PG8_MMA(1, 1, At, B1); PG8_BAR;
            PG8_LDB(B0, 1, 0); PG8_SCHED; PG8_LDA(At, 1, 0); PG8_STAGE(PG8_SA(0, 1), a2 + hstep, voffA);
            PG8_WAIT_L(8); PG8_BAR; PG8_WAIT_L(0); PG8_MMA(0, 0, At, B0); PG8_BAR; PG8_SCHED;
            PG8_LDB(B1, 1, 1); PG8_STAGE(PG8_SB(1, 0), b3, voffB);
            PG8_BAR; PG8_WAIT_L(0); PG8_MMA(0, 1, At, B1); PG8_BAR;
            PG8_LDA(At, 1, 1); PG8_STAGE(PG8_SA(1, 0), a3, voffA);
            PG8_BAR; PG8_WAIT_L(0); PG8_MMA(1, 0, At, B0); PG8_BAR; PG8_SCHED;
            PG8_STAGE(PG8_SB(1, 1), b3 + hstep, voffB);
            PG8_WAIT_V(6); PG8_BAR; PG8_MMA(1, 1, At, B1); PG8_BAR;
        }
        PG8_STAMP();
        if constexpr (!Epi::AFTER_DRAIN) { E(acc, cur, wr, wc, fr, fq); S.done(cur); }
        PG8_STAMP();
        if (!has_next) break;
#pragma unroll
        for (int a = 0; a < 2; ++a)
#pragma unroll
            for (int b = 0; b < 2; ++b)
#pragma unroll
                for (int m = 0; m < 4; ++m)
#pragma unroll
                    for (int n = 0; n < 2; ++n) acc[a][b][m][n] = (f32x4){0.f, 0.f, 0.f, 0.f};
        cur = nxt; cA = nA; cB = nB; ++ui;
    }
    PG8_WAIT_V(0);
    if (wr == 0) PG8_BAR;
    PG8_BAR;
    if constexpr (Epi::AFTER_DRAIN) { E.fused(acc, cur, wr, wc, fr, fq, lds, wid, lane); S.done(cur); }
    PG8_STAMP();
    if (STAMP && wid == 0) { stamps[lane] = lane < nts ? (((unsigned long long)(unsigned)ts_hi << 32) | (unsigned)ts_lo) : 0ull;
        if (lane == 62) stamps[62] = rt_entry; if (lane == 63) stamps[63] = (unsigned long long)wall_clock64(); }
#undef PG8_STAMP
#undef PG8_SA
#undef PG8_SB
#undef PG8_STAGE
#undef PG8_LDA
#undef PG8_LDB
#undef PG8_MMA
#undef PG8_WAIT_V
#undef PG8_WAIT_L
#undef PG8_BAR
#undef PG8_SCHED
}
}

#define XB_TMO      128
#define XB_XCNT(j)  (256  + 64 * (j))
#define XB_XSUB(j)  (1280 + 64 * (j))
#define XB_XGEN(j)  (2304 + 64 * (j))
#define XB_TOP      3328
#define XB_TOPGEN   3392
#define XCD_BAR_WORDS 3456
#define XB_SPIN_CAP (1u << 18)
#define LAS __attribute__((address_space(3)))

__device__ __forceinline__ unsigned xb_ld(unsigned* p)              { return __hip_atomic_load(p, __ATOMIC_RELAXED, __HIP_MEMORY_SCOPE_AGENT); }
__device__ __forceinline__ unsigned xb_add(unsigned* p, unsigned v) { return __hip_atomic_fetch_add(p, v, __ATOMIC_RELAXED, __HIP_MEMORY_SCOPE_AGENT); }
__device__ __forceinline__ unsigned xb_xcc_id() { return (unsigned)__builtin_amdgcn_s_getreg((3 << 11) | 20) & 0xFu; }
#define XB_SPIN(cond, bar) do { unsigned _sp = 0; while (cond) { __builtin_amdgcn_s_sleep(1); \
    if ((++_sp & 255u) == 0u) { if (xb_ld(&(bar)[XB_TMO])) break; if (_sp > XB_SPIN_CAP) { atomicAdd(&(bar)[XB_TMO], 1u); break; } } } } while (0)

struct XcdBarrier {
    unsigned* bar; unsigned x;
    volatile LAS unsigned* st;
};

__device__ __forceinline__ XcdBarrier xcd_barrier_post(unsigned* bar, volatile LAS unsigned* st) {
    XcdBarrier b; b.bar = bar; b.x = xb_xcc_id(); b.st = st;
    if (TIDX == 0) (void)xb_add(&bar[XB_XCNT(b.x)], 1u);
    return b;
}
__device__ __forceinline__ void xcd_barrier_complete(unsigned* bar, unsigned x, unsigned& nloc, unsigned& nx) {
    const unsigned G = gridDim.x * gridDim.y * gridDim.z;
    unsigned sum, cnt, mine, sp = 0u;
    for (;;) {
        sum = 0u; cnt = 0u; mine = 0u;
#pragma unroll
        for (unsigned j = 0; j < 16; ++j) { const unsigned c = xb_ld(&bar[XB_XCNT(j)]); sum += c; cnt += (c > 0u) ? 1u : 0u; mine = (j == x) ? c : mine; }
        if (sum == G) break;
        __builtin_amdgcn_s_sleep(1);
        if ((++sp & 255u) == 0u) { if (xb_ld(&bar[XB_TMO])) break; if (sp > XB_SPIN_CAP) { atomicAdd(&bar[XB_TMO], 1u); break; } }
    }
    nloc = mine > 0u ? mine : 1u; nx = cnt > 0u ? cnt : 1u;
}

__device__ __forceinline__ void xcd_barrier(const XcdBarrier& b) {
    asm volatile("s_waitcnt vmcnt(0)" ::: "memory");
    __syncthreads();
    if (TIDX == 0) {
        unsigned* bar = b.bar;
        __builtin_amdgcn_s_waitcnt(0);
        unsigned nloc = b.st[0], nx = b.st[1];
        if (nloc == 0u) { xcd_barrier_complete(bar, b.x, nloc, nx); b.st[0] = nloc; b.st[1] = nx; }
        const unsigned old = xb_add(&bar[XB_XSUB(b.x)], 1u);
        const unsigned gen = old / nloc;
        if (old + 1u == (gen + 1u) * nloc) {
            __builtin_amdgcn_fence(__ATOMIC_RELEASE, "agent");
            asm volatile("s_waitcnt vmcnt(0)" ::: "memory");
            const unsigned og = xb_add(&bar[XB_TOP], 1u);
            const unsigned tg = og / nx;
            if (og + 1u == (tg + 1u) * nx) xb_add(&bar[XB_TOPGEN], 1u);
            else XB_SPIN(xb_ld(&bar[XB_TOPGEN]) == tg, bar);
            __builtin_amdgcn_fence(__ATOMIC_ACQUIRE, "agent");
            xb_add(&bar[XB_XGEN(b.x)], 1u);
            asm volatile("s_waitcnt vmcnt(0)" ::: "memory");
        } else {
            XB_SPIN(xb_ld(&bar[XB_XGEN(b.x)]) == gen, bar);
            __builtin_amdgcn_fence(__ATOMIC_ACQUIRE, "agent");
            asm volatile("s_waitcnt vmcnt(0)" ::: "memory");
        }
    }
    __syncthreads();
}

__device__ void d_cvt(const float* __restrict__ in, bf16_t* __restrict__ out, size_t n4) {
  const size_t stride = (size_t)gridDim.x * blockDim.x;
  size_t i = (size_t)blockIdx.x * blockDim.x + TIDX;
  for (; i + 3 * stride < n4; i += 4 * stride) {
    f32x4 v[4];
#pragma unroll
    for (int q = 0; q < 4; ++q) v[q] = ((const f32x4*)in)[i + q * stride];
#pragma unroll
    for (int q = 0; q < 4; ++q) { u32x2 o = {pack2(v[q][0], v[q][1]), pack2(v[q][2], v[q][3])}; ((u32x2*)out)[i + q * stride] = o; }
  }
  for (; i < n4; i += stride) { const f32x4 v = ((const f32x4*)in)[i]; u32x2 o = {pack2(v[0], v[1]), pack2(v[2], v[3])}; ((u32x2*)out)[i] = o; }
}
__device__ void d_cvtT64(int vb, char* smem, const float* __restrict__ W, bf16_t* __restrict__ WT, int K, int N, int NP) {
  float (*tt)[65] = (float (*)[65])smem;
  const int tid = (TIDX & 255);
  const int nbx = NP / 64;
  const int n0 = (vb % nbx) * 64, k0 = (vb / nbx) * 64;
  {
    const int kr = tid >> 4, nc = (tid & 15) * 4;
#pragma unroll
    for (int i = 0; i < 4; ++i) {
      const int k = k0 + kr + 16 * i, n = n0 + nc;
      f32x4 v = {0.f, 0.f, 0.f, 0.f};
      if (n < N) v = *(const f32x4*)(W + (size_t)k * N + n);
      tt[kr + 16 * i][nc] = v[0]; tt[kr + 16 * i][nc + 1] = v[1]; tt[kr + 16 * i][nc + 2] = v[2]; tt[kr + 16 * i][nc + 3] = v[3];
    }
  }
  __syncthreads();
  {
    const int nr = tid >> 3, kc = (tid & 7) * 8;
#pragma unroll
    for (int i = 0; i < 2; ++i) {
      const int nl = nr + 32 * i;
      u32x4 o = {pack2(tt[kc][nl], tt[kc + 1][nl]), pack2(tt[kc + 2][nl], tt[kc + 3][nl]), pack2(tt[kc + 4][nl], tt[kc + 5][nl]), pack2(tt[kc + 6][nl], tt[kc + 7][nl])};
      *(u32x4*)(WT + (size_t)(n0 + nl) * K + k0 + kc) = o;
    }
  }
  __syncthreads();
}

using f32x16 = __attribute__((ext_vector_type(16))) float;
using bf16x8v = __attribute__((ext_vector_type(8))) __bf16;
#define MFMA32(a, b, c) __builtin_amdgcn_mfma_f32_32x32x16_bf16((a), (b), (c), 0, 0, 0)
constexpr float LOG2E = 1.4426950408889634f;
constexpr float NEGB = -1e30f;
DI int pi_perm(int i) { return (i & ~12) | ((i & 8) >> 1) | ((i & 4) << 1); }
DI bf16x8 pack8(float a0, float a1, float a2, float a3, float a4, float a5, float a6, float a7) {
  bf16x8v v = {(__bf16)a0, (__bf16)a1, (__bf16)a2, (__bf16)a3, (__bf16)a4, (__bf16)a5, (__bf16)a6, (__bf16)a7};
  return __builtin_bit_cast(bf16x8, v);
}
__device__ __forceinline__ void d_relayout_tile(int T, char* smem, const bf16_t* __restrict__ proj, int col0, bf16_t* __restrict__ dst, bool isV) {
  bf16_t* Ls = (bf16_t*)smem;
  const int tid = TIDX;
#pragma unroll
  for (int q = 0; q < 2; ++q) {
    const int cidx = tid + q * 512;
    const int g = cidx >> 9, tok = (cidx >> 4) & 31, ch = cidx & 15;
    const u32x4 v = *(const u32x4*)(proj + (size_t)(32 * T + tok) * INWP + col0 + g * 128 + ch * 8);
    *(u32x4*)(Ls + (g * 32 + tok) * 136 + ch * 8) = v;
  }
  __syncthreads();
#pragma unroll
  for (int q = 0; q < 2; ++q) {
    const int oc = tid + q * 512;
    const int g = oc >> 9, r9 = oc & 511, lane = r9 & 63;
    u32x4 o;
    if (!isV) {
      const int s8 = r9 >> 6, i = lane & 31, h = lane >> 5;
      o = *(const u32x4*)(Ls + (g * 32 + pi_perm(i)) * 136 + 16 * s8 + 8 * h);
    } else {
      const int s2 = (r9 >> 6) & 1, dt = r9 >> 7, dd = lane & 31, h = lane >> 5;
      const bf16_t* col = Ls + (g * 32 + 16 * s2 + 8 * h) * 136 + 32 * dt + dd;
      unsigned short e[8];
#pragma unroll
      for (int j = 0; j < 8; ++j) e[j] = col[j * 136];
      o.x = e[0] | ((unsigned)e[1] << 16); o.y = e[2] | ((unsigned)e[3] << 16); o.z = e[4] | ((unsigned)e[5] << 16); o.w = e[6] | ((unsigned)e[7] << 16);
    }
    *(u32x4*)(dst + (((size_t)(g * 512 + T)) * 512 + r9) * 8) = o;
  }
  __syncthreads();
}

struct AttnPtrs {
  const bf16_t* proj; const float* gates;
  const bf16_t *kcf, *vcf, *ksf, *vsf, *kwf, *vwf;
  bf16_t* mix; const float* hng;
};

DI float ex2(float x) { return __builtin_amdgcn_exp2f(x); }
DI void halves(float x, float& lo, float& hi) {
  const unsigned u = __float_as_uint(x);
  auto r = __builtin_amdgcn_permlane32_swap(u, u, false, false);
  lo = __uint_as_float(r[0]); hi = __uint_as_float(r[1]);
}
DI float hmax(float x) { float a, b; halves(x, a, b); return fmaxf(a, b); }
DI float hsum(float x) { float a, b; halves(x, a, b); return a + b; }
DI float dpp_quad(float v, int ctrl_is_xor1) {
  const int iv = __float_as_int(v);
  const int r = ctrl_is_xor1 ? __builtin_amdgcn_update_dpp(iv, iv, 0xB1, 0xF, 0xF, false) : __builtin_amdgcn_update_dpp(iv, iv, 0x4E, 0xF, 0xF, false);
  return __int_as_float(r);
}
DI float quad_sum(float v) { v += dpp_quad(v, 1); v += dpp_quad(v, 0); return v; }
DI void osm_step(const float (&sv)[16], float& m, float& l, f32x16 (&O)[4], float (&p)[16]) {
  float tmax = fmaxf(fmaxf(fmaxf(sv[0], sv[1]), fmaxf(sv[2], sv[3])), fmaxf(fmaxf(sv[4], sv[5]), fmaxf(sv[6], sv[7])));
  tmax = fmaxf(tmax, fmaxf(fmaxf(fmaxf(sv[8], sv[9]), fmaxf(sv[10], sv[11])), fmaxf(fmaxf(sv[12], sv[13]), fmaxf(sv[14], sv[15]))));
  tmax = hmax(tmax);
  if (__ballot(tmax - m > 8.f)) {
    const float mn = fmaxf(m, tmax);
    const float alpha = ex2(m - mn);
    l *= alpha; m = mn;
#pragma unroll
    for (int dt = 0; dt < 4; ++dt)
#pragma unroll
      for (int r = 0; r < 16; ++r) O[dt][r] *= alpha;
  }
  float ps0 = 0.f, ps1 = 0.f;
#pragma unroll
  for (int r = 0; r < 16; r += 2) { const float e0 = ex2(sv[r] - m), e1 = ex2(sv[r + 1] - m); p[r] = e0; p[r + 1] = e1; ps0 += e0; ps1 += e1; }
  l += ps0 + ps1;
}
DI void ot_store(char* otL, int lane, const f32x16 (&O)[4], float sc) {
#pragma unroll
  for (int dt = 0; dt < 4; ++dt) {
    u32x4 a, b;
#pragma unroll
    for (int i = 0; i < 4; ++i) { a[i] = pack2(sc * O[dt][2 * i], sc * O[dt][2 * i + 1]); b[i] = pack2(sc * O[dt][8 + 2 * i], sc * O[dt][8 + 2 * i + 1]); }
    *(u32x4*)(otL + lane * 128 + dt * 32) = a;
    *(u32x4*)(otL + lane * 128 + dt * 32 + 16) = b;
  }
}
DI void ot_accum(const char* otL, int lane, f32x16 (&O)[4], float sc) {
#pragma unroll
  for (int dt = 0; dt < 4; ++dt) {
    u32x4 a = *(const u32x4*)(otL + lane * 128 + dt * 32);
    u32x4 b = *(const u32x4*)(otL + lane * 128 + dt * 32 + 16);
#pragma unroll
    for (int i = 0; i < 4; ++i) {
      const unsigned wa = a[i], wb = b[i];
      O[dt][2 * i] = fmaf(sc, O[dt][2 * i], __uint_as_float(wa << 16));
      O[dt][2 * i + 1] = fmaf(sc, O[dt][2 * i + 1], __uint_as_float(wa & 0xFFFF0000u));
      O[dt][8 + 2 * i] = fmaf(sc, O[dt][8 + 2 * i], __uint_as_float(wb << 16));
      O[dt][8 + 2 * i + 1] = fmaf(sc, O[dt][8 + 2 * i + 1], __uint_as_float(wb & 0xFFFF0000u));
    }
  }
}
DI void zero_o(f32x16 (&O)[4]) {
#pragma unroll
  for (int dt = 0; dt < 4; ++dt)
#pragma unroll
    for (int i = 0; i < 16; ++i) O[dt][i] = 0.f;
}

constexpr int ATT_PW = 8704;
constexpr int ATT_R = 4, ATT_D = 3;
constexpr int ATT_RING = 8 * ATT_PW;
constexpr int ATT_LIST = ATT_RING + ATT_R * 16384;
constexpr int ATT_BUNI = ATT_LIST + 2048;
constexpr int ATT_SMEM = ATT_BUNI + 64;
#define LAS3 __attribute__((address_space(3)))
__device__ __forceinline__ void d_select(const float* impL, unsigned* mskL, unsigned* uniL, int cur) {
  const int lane = TIDX & 63;
  const int stok = lane >> 3, sub = lane & 7;
  unsigned key[32];
#pragma unroll
  for (int i4 = 0; i4 < 8; ++i4) {
    f32x4 v = *(const f32x4*)(impL + stok * 256 + sub * 32 + i4 * 4);
#pragma unroll
    for (int e = 0; e < 4; ++e) {
      const int j = sub * 32 + i4 * 4 + e;
      const bool valid = j <= cur;
      const bool forced = (j == 0) || (j == cur) || (j == cur - 1);
      unsigned kb = forced ? 0xFFFFFF00u : (__float_as_uint(v[e]) & 0xFFFFFF00u);
      key[i4 * 4 + e] = valid ? (kb | (unsigned)(255 - j)) : 0u;
    }
  }
#pragma unroll
  for (int k = 2; k <= 32; k <<= 1) {
#pragma unroll
    for (int jj = k >> 1; jj > 0; jj >>= 1) {
#pragma unroll
      for (int i = 0; i < 32; ++i) {
        const int l2 = i ^ jj;
        if (l2 > i) {
          const bool desc = ((i & k) == 0);
          unsigned a = key[i], b = key[l2];
          unsigned mx = a > b ? a : b, mn = a > b ? b : a;
          key[i] = desc ? mx : mn; key[l2] = desc ? mn : mx;
        }
      }
    }
  }
#pragma unroll
  for (int xm = 1; xm < 8; xm <<= 1) {
    unsigned L[16];
#pragma unroll
    for (int i = 0; i < 16; ++i) { unsigned o = (unsigned)shx_i((int)key[15 - i], xm); L[i] = key[i] > o ? key[i] : o; }
#pragma unroll
    for (int jj = 8; jj > 0; jj >>= 1) {
#pragma unroll
      for (int i = 0; i < 16; ++i) {
        const int l2 = i ^ jj;
        if (l2 > i) { unsigned a = L[i], b = L[l2]; L[i] = a > b ? a : b; L[l2] = a > b ? b : a; }
      }
    }
#pragma unroll
    for (int i = 0; i < 16; ++i) key[i] = L[i];
  }
#pragma unroll
  for (int i = 0; i < 16; ++i) {
    if ((i & 7) == sub) {
      const int j = 255 - (int)(key[i] & 255u);
      if (j <= cur) { atomicOr(&mskL[stok * 8 + (j >> 5)], 1u << (j & 31)); atomicOr(&uniL[j >> 5], 1u << (j & 31)); }
    }
  }
}


DI void att_issue(LAS3 unsigned char* ring, int slot, int w, int lane, const bf16_t* kb, const bf16_t* vb, int tile) {
  const char* ks = (const char*)kb + (size_t)tile * 8192 + w * 1024 + lane * 16;
  const char* vs = (const char*)vb + (size_t)tile * 8192 + w * 1024 + lane * 16;
  __builtin_amdgcn_global_load_lds((const unsigned*)ks, (LAS3 unsigned*)(ring + slot * 16384 + w * 1024), 16, 0, 0);
  __builtin_amdgcn_global_load_lds((const unsigned*)vs, (LAS3 unsigned*)(ring + slot * 16384 + 8192 + w * 1024), 16, 0, 0);
}
DI f32x16 qk_lds(LAS3 const unsigned char* kt, const bf16x8 (&qf)[8], int lane) {
  f32x16 acc;
#pragma unroll
  for (int i = 0; i < 16; ++i) acc[i] = 0.f;
#pragma unroll
  for (int s8 = 0; s8 < 8; ++s8) {
    const bf16x8 kf = *(LAS3 const bf16x8*)(kt + s8 * 1024 + lane * 16);
    acc = MFMA32(kf, qf[s8], acc);
  }
  return acc;
}
DI void pv_lds(LAS3 const unsigned char* vt, const float (&p)[16], f32x16 (&O)[4], int lane) {
  const bf16x8 pf0 = pack8(p[0], p[1], p[2], p[3], p[4], p[5], p[6], p[7]);
  const bf16x8 pf1 = pack8(p[8], p[9], p[10], p[11], p[12], p[13], p[14], p[15]);
#pragma unroll
  for (int dt = 0; dt < 4; ++dt) {
    const bf16x8 v0 = *(LAS3 const bf16x8*)(vt + (dt * 2) * 1024 + lane * 16);
    const bf16x8 v1 = *(LAS3 const bf16x8*)(vt + (dt * 2 + 1) * 1024 + lane * 16);
    O[dt] = MFMA32(v0, pf0, O[dt]);
    O[dt] = MFMA32(v1, pf1, O[dt]);
  }
}

__device__ __forceinline__ void d_attn_block(int B, int g, char* smem, const AttnPtrs& P) {
  const int tid = TIDX, lane = tid & 63, w = tid >> 6;
  const int c = lane & 31, h = lane >> 5, tokl = c >> 2, r = c & 3;
  const int tok0 = 64 * B + 8 * w;
  const int t = tok0 + tokl, hd = g * 4 + r;
  const float slope2 = exp2f(-(float)(hd + 1)) * LOG2E;
  const float c1 = QSCALE * LOG2E;
  const float ninf = -__builtin_inff();
  char* wsm = smem + w * ATT_PW;
  float* impL = (float*)wsm;
  char* otL = wsm;
  unsigned* mskL = (unsigned*)(wsm + 8192);
  unsigned* uniL = mskL + 64;
  LAS3 unsigned char* ring = (LAS3 unsigned char*)(smem + ATT_RING);
  unsigned short* tl = (unsigned short*)(smem + ATT_LIST);
  unsigned* buni = (unsigned*)(smem + ATT_BUNI);
  const bf16_t* kcf = P.kcf + (size_t)g * 32 * 4096;
  const bf16_t* vcf = P.vcf + (size_t)g * 32 * 4096;
  const bf16_t* ksf = P.ksf + (size_t)g * 512 * 4096;
  const bf16_t* vsf = P.vsf + (size_t)g * 512 * 4096;
  const bf16_t* kwf = P.kwf + (size_t)g * 512 * 4096;
  const bf16_t* vwf = P.vwf + (size_t)g * 512 * 4096;
  bf16x8 qf[8];
  {
    const bf16_t* qrow = P.proj + (size_t)t * INWP + OFF_Q + hd * 128 + 8 * h;
#pragma unroll
    for (int s8 = 0; s8 < 8; ++s8) qf[s8] = *(const bf16x8*)(qrow + 16 * s8);
  }
  const float* gt = P.gates + (size_t)t * 24 + hd * 3;
  const float g0 = gt[0], g1 = gt[1], g2 = gt[2];
  {
    unsigned z0 = 0u;
    asm volatile("" : "+v"(z0));
    u32x4 z = {z0, z0, z0, z0};
#pragma unroll
    for (int i = 0; i < 8; ++i) *(u32x4*)(wsm + (i * 64 + lane) * 16) = z;
    if (lane < 18) *(u32x4*)(wsm + 8192 + lane * 16) = z;
    if (tid < 8) buni[tid] = z0;
  }
  f32x16 Ob[4];
  zero_o(Ob);
  const int nmax = (t >= 31) ? ((t - 31) >> 4) : -1;
  const int nmaxw = (tok0 + 7 >= 31) ? ((tok0 + 7 - 31) >> 4) : -1;
  const int nminw = (tok0 >= 31) ? ((tok0 - 31) >> 4) : -1;
  const int ntcw = (nmaxw + 32) >> 5;
  const int ntcB = (((64 * B + 63 - 31) >> 4) + 32) >> 5;
  const float sl16 = slope2 * 16.f;
  float mC = NEGB, lC = 0.f, invC = 0.f, carry = 0.f;
  {
    const int n = 2 * ntcB;
    asm volatile("s_waitcnt vmcnt(0)" ::: "memory");
#define A_TILE(i_) (((i_) < ntcB) ? (ntcB - 1 - (i_)) : ((i_) - ntcB))
    att_issue(ring, 0, w, lane, kcf, vcf, A_TILE(0));
    if (n > 1) att_issue(ring, 1, w, lane, kcf, vcf, A_TILE(1));
#pragma unroll 1
    for (int i = 0; i < n; ++i) {
      if ((i & 1) == 0) {
        asm volatile("s_waitcnt vmcnt(0)" ::: "memory");
        __builtin_amdgcn_s_barrier();
        asm volatile("" ::: "memory");
        if (i + 2 < n) att_issue(ring, (i + 2) & 3, w, lane, kcf, vcf, A_TILE(i + 2));
        if (i + 3 < n) att_issue(ring, (i + 3) & 3, w, lane, kcf, vcf, A_TILE(i + 3));
      }
      const int T = A_TILE(i);
      if (T >= ntcw) continue;
      LAS3 const unsigned char* slot = ring + (i % ATT_R) * 16384;
      const f32x16 acc = qk_lds(slot, qf, lane);
      const float base = slope2 * (float)(512 * T + 128 * h) + slope2 * (15.5f - (float)t);
      const int nb = 32 * T + 8 * h;
      const bool full = (32 * T + 31 <= nminw);
      float sv[16];
#pragma unroll
      for (int rg = 0; rg < 16; ++rg) { const int kk = (rg & 7) + 16 * (rg >> 3); sv[rg] = fmaf(acc[rg], c1, fmaf(sl16, (float)kk, base)); }
      if (!full) {
#pragma unroll
        for (int rg = 0; rg < 16; ++rg) { const int kk = (rg & 7) + 16 * (rg >> 3); sv[rg] = (nb + kk <= nmax) ? sv[rg] : ninf; }
      }
      if (i < ntcB) {
        float tmax = fmaxf(fmaxf(fmaxf(sv[0], sv[1]), fmaxf(sv[2], sv[3])), fmaxf(fmaxf(sv[4], sv[5]), fmaxf(sv[6], sv[7])));
        tmax = fmaxf(tmax, fmaxf(fmaxf(fmaxf(sv[8], sv[9]), fmaxf(sv[10], sv[11])), fmaxf(fmaxf(sv[12], sv[13]), fmaxf(sv[14], sv[15]))));
        tmax = hmax(tmax);
        const float mn = fmaxf(mC, tmax);
        float ps = 0.f;
#pragma unroll
        for (int rg = 0; rg < 16; ++rg) ps += ex2(sv[rg] - mn);
        lC = lC * ex2(mC - mn) + ps; mC = mn;
      } else {
        if (T == 0) { lC = hsum(lC); invC = (lC > 0.f) ? 1.f / lC : 0.f; }
        float p[16];
#pragma unroll
        for (int rg = 0; rg < 16; ++rg) p[rg] = ex2(sv[rg] - mC) * invC;
        float Ga = (p[0] + p[1]) + (p[2] + p[3]), Gb = (p[4] + p[5]) + (p[6] + p[7]);
        float Gc = (p[8] + p[9]) + (p[10] + p[11]), Gd = (p[12] + p[13]) + (p[14] + p[15]);
        float xb, xd; { float a_, b_; halves(p[7], a_, b_); xb = h ? a_ : b_; halves(p[15], a_, b_); xd = h ? a_ : b_; }
        float ia = Ga + (h ? xb : carry);
        float ib = Gb + p[3];
        float ic = Gc + (h ? xd : xb);
        float id = Gd + p[11];
        carry = xd;
        ia = quad_sum(ia); ib = quad_sum(ib); ic = quad_sum(ic); id = quad_sum(id);
        {
          float val = (r == 0) ? ia : (r == 1) ? ib : (r == 2) ? ic : id;
          int j = 8 * T + 2 * h + ((r == 0) ? 0 : (r == 1) ? 1 : (r == 2) ? 4 : 5);
          impL[tokl * 256 + j] = val;
        }
        pv_lds(slot + 8192, p, Ob, lane);
      }
    }
#undef A_TILE
  }
  const int cur = B;
  d_select(impL, mskL, uniL, cur);
  ot_store(otL, lane, Ob, g0);
  zero_o(Ob);
  if (lane < 8) { const unsigned u = uniL[lane]; if (u) atomicOr(&buni[lane], u); }
  __syncthreads();
  int nslc = 0, ntl = 0;
  {
    for (int iw = 7; iw >= 0; --iw) {
      unsigned iuw = __builtin_amdgcn_readfirstlane(buni[iw]);
      while (iuw) {
        const int bit = 31 - __builtin_clz(iuw);
        iuw &= ~(1u << bit);
        const int bb = 32 * iw + bit;
        if (bb < B) { if (lane == 0) tl[ntl] = (unsigned short)(2 * bb + 1); ++ntl; }
        else { if (lane == 0) tl[ntl] = (unsigned short)(2 * bb + 1); ++ntl; }
        if (lane == 0) tl[ntl] = (unsigned short)(2 * bb);
        ++ntl;
      }
    }
    nslc = ntl;
    const int ThiB = 2 * B + 1, TloB = ((64 * B - 511 > 0) ? (64 * B - 511) : 0) >> 5;
    for (int T = ThiB; T >= TloB; --T) { if (lane == 0) tl[ntl] = (unsigned short)T; ++ntl; }
  }
  float m = NEGB, l = 0.f;
  {
    const int n = ntl;
    const int Tlow = ((tok0 - 511 > 0) ? (tok0 - 511) : 0) >> 5, Thiw = (tok0 + 7) >> 5;
#define B_ISSUE(j_, slot_) { const int e_ = __builtin_amdgcn_readfirstlane((int)tl[j_]); if ((j_) < nslc) att_issue(ring, slot_, w, lane, ksf, vsf, e_); else att_issue(ring, slot_, w, lane, kwf, vwf, e_); }
    B_ISSUE(0, 0)
    if (n > 1) B_ISSUE(1, 1)
#pragma unroll 1
    for (int i = 0; i < n; ++i) {
      if ((i & 1) == 0) {
        asm volatile("s_waitcnt vmcnt(0)" ::: "memory");
        __builtin_amdgcn_s_barrier();
        asm volatile("" ::: "memory");
        if (i + 2 < n) B_ISSUE(i + 2, (i + 2) & 3)
        if (i + 3 < n) B_ISSUE(i + 3, (i + 3) & 3)
      }
      if (i == nslc) {
        l = hsum(l);
        const float inv = (l > 0.f) ? g1 / l : 0.f;
        ot_accum(otL, lane, Ob, inv);
        ot_store(otL, lane, Ob, 1.f);
        zero_o(Ob);
        m = NEGB; l = 0.f;
      }
      const int T = __builtin_amdgcn_readfirstlane((int)tl[i]);
      const int pos0 = 32 * T, pb = pos0 + 8 * h;
      bool full; bool mine = true;
      if (i < nslc) {
        const int bb = T >> 1;
        const unsigned uw = __builtin_amdgcn_readfirstlane(uniL[bb >> 5]);
        if (!((uw >> (bb & 31)) & 1u) || pos0 > tok0 + 7) continue;
        mine = (mskL[tokl * 8 + (bb >> 5)] >> (bb & 31)) & 1u;
        full = (pos0 + 31 <= tok0) && (__ballot(!mine) == 0ull);
      } else {
        if (T < Tlow || T > Thiw) continue;
        full = (pos0 + 31 <= tok0) && (pos0 >= tok0 + 7 - 511);
      }
      LAS3 const unsigned char* slot = ring + (i % ATT_R) * 16384;
      const f32x16 acc = qk_lds(slot, qf, lane);
      const float base = slope2 * (float)(pos0 + 8 * h - t);
      float sv[16], p[16];
#pragma unroll
      for (int rg = 0; rg < 16; ++rg) { const int kk = (rg & 7) + 16 * (rg >> 3); sv[rg] = fmaf(acc[rg], c1, fmaf(slope2, (float)kk, base)); }
      if (!full) {
        if (i < nslc) {
#pragma unroll
          for (int rg = 0; rg < 16; ++rg) { const int kk = (rg & 7) + 16 * (rg >> 3); sv[rg] = (mine && (pb + kk <= t)) ? sv[rg] : ninf; }
        } else {
#pragma unroll
          for (int rg = 0; rg < 16; ++rg) { const int kk = (rg & 7) + 16 * (rg >> 3); const int dw = t - (pb + kk); sv[rg] = ((dw >= 0) && (dw < 512)) ? sv[rg] : ninf; }
        }
      }
      osm_step(sv, m, l, Ob, p);
      pv_lds(slot + 8192, p, Ob, lane);
    }
#undef B_ISSUE
    l = hsum(l);
    const float inv = (l > 0.f) ? g2 / l : 0.f;
    ot_accum(otL, lane, Ob, inv);
  }
  {
    float ss = 0.f;
#pragma unroll
    for (int dt = 0; dt < 4; ++dt)
#pragma unroll
      for (int i = 0; i < 16; ++i) ss = fmaf(Ob[dt][i], Ob[dt][i], ss);
    ss = hsum(ss);
    const float rs = rsqrtf(ss * (1.f / 128.f) + 1e-6f);
    bf16_t* orow = P.mix + (size_t)t * DM + hd * 128 + 4 * h;
    const float* grow = P.hng + hd * 128 + 4 * h;
#pragma unroll
    for (int dt = 0; dt < 4; ++dt)
#pragma unroll
      for (int a = 0; a < 4; ++a) {
        const f32x4 gv = *(const f32x4*)(grow + 32 * dt + 8 * a);
        u32x2 wv2 = {pack2(Ob[dt][4 * a] * rs * gv[0], Ob[dt][4 * a + 1] * rs * gv[1]), pack2(Ob[dt][4 * a + 2] * rs * gv[2], Ob[dt][4 * a + 3] * rs * gv[3])};
        *(u32x2*)(orow + 32 * dt + 8 * a) = wv2;
      }
  }
  asm volatile("s_waitcnt vmcnt(0)" ::: "memory");
  __syncthreads();
}

__device__ void d_convmix(int t, int tl, const bf16_t* __restrict__ proj, const float* __restrict__ convw, const float* __restrict__ hng,
                          bf16_t* __restrict__ mix) {
  const int c = tl * 8;
  float acc[8];
#pragma unroll
  for (int i = 0; i < 8; ++i) acc[i] = 0.f;
#pragma unroll
  for (int j = 0; j < 3; ++j) {
    const int tt = t - 2 + j;
    if (tt >= 0) {
      const u32x4 cu = *(const u32x4*)(proj + (size_t)tt * INWP + OFF_C + c);
      const u32x4 uu = *(const u32x4*)(proj + (size_t)tt * INWP + OFF_U + c);
      const f32x4 w0 = *(const f32x4*)(convw + j * 1024 + c), w1 = *(const f32x4*)(convw + j * 1024 + c + 4);
#pragma unroll
      for (int i = 0; i < 4; ++i) {
        const unsigned a = cu[i], b = uu[i];
        const float wl = (i < 2) ? w0[2 * i] : w1[2 * i - 4], wh = (i < 2) ? w0[2 * i + 1] : w1[2 * i - 3];
        acc[2 * i] = fmaf(wl * __uint_as_float(a << 16), __uint_as_float(b << 16), acc[2 * i]);
        acc[2 * i + 1] = fmaf(wh * __uint_as_float(a & 0xFFFF0000u), __uint_as_float(b & 0xFFFF0000u), acc[2 * i + 1]);
      }
    }
  }
  const u32x4 bb = *(const u32x4*)(proj + (size_t)t * INWP + OFF_B + c);
  float ss = 0.f;
#pragma unroll
  for (int i = 0; i < 4; ++i) {
    const unsigned b = bb[i];
    acc[2 * i] *= __uint_as_float(b << 16); acc[2 * i + 1] *= __uint_as_float(b & 0xFFFF0000u);
    ss = fmaf(acc[2 * i], acc[2 * i], ss); ss = fmaf(acc[2 * i + 1], acc[2 * i + 1], ss);
  }
  ss += shx(ss, 8); ss += shx(ss, 4); ss += shx(ss, 2); ss += shx(ss, 1);
  const float rs = rsqrtf(ss * (1.f / 128.f) + 1e-6f);
  const f32x4 g0 = *(const f32x4*)(hng + 1024 + c), g1 = *(const f32x4*)(hng + 1024 + c + 4);
  u32x4 o = {pack2(acc[0] * rs * g0[0], acc[1] * rs * g0[1]), pack2(acc[2] * rs * g0[2], acc[3] * rs * g0[3]),
             pack2(acc[4] * rs * g1[0], acc[5] * rs * g1[1]), pack2(acc[6] * rs * g1[2], acc[7] * rs * g1[3])};
  *(u32x4*)(mix + (size_t)t * DM + 1024 + c) = o;
}

DI void d_ln_fin(int t, const u32x4 (&wr)[4], bf16_t* __restrict__ yh, const float* __restrict__ gam, const float* __restrict__ bet) {
  const int lane = TIDX & 63;
  float v[32];
#pragma unroll
  for (int i = 0; i < 4; ++i) {
    const u32x4 w = wr[i];
#pragma unroll
    for (int j = 0; j < 4; ++j) { const unsigned ww = w[j]; v[i * 8 + 2 * j] = __uint_as_float(ww << 16); v[i * 8 + 2 * j + 1] = __uint_as_float(ww & 0xFFFF0000u); }
  }
  float s = 0.f;
#pragma unroll
  for (int i = 0; i < 32; ++i) s += v[i];
  s = wave_sum(s);
  const float mu = s * (1.f / DM);
  float q = 0.f;
#pragma unroll
  for (int i = 0; i < 32; ++i) { const float d = v[i] - mu; q = fmaf(d, d, q); }
  q = wave_sum(q);
  const float rs = rsqrtf(q * (1.f / DM) + 1e-5f);
#pragma unroll
  for (int i = 0; i < 4; ++i) {
    const int cb = 512 * i + 8 * lane;
    const f32x4 g0 = *(const f32x4*)(gam + cb), g1 = *(const f32x4*)(gam + cb + 4), b0 = *(const f32x4*)(bet + cb), b1 = *(const f32x4*)(bet + cb + 4);
    u32x4 o = {pack2((v[i * 8 + 0] - mu) * rs * g0[0] + b0[0], (v[i * 8 + 1] - mu) * rs * g0[1] + b0[1]), pack2((v[i * 8 + 2] - mu) * rs * g0[2] + b0[2], (v[i * 8 + 3] - mu) * rs * g0[3] + b0[3]),
               pack2((v[i * 8 + 4] - mu) * rs * g1[0] + b1[0], (v[i * 8 + 5] - mu) * rs * g1[1] + b1[1]), pack2((v[i * 8 + 6] - mu) * rs * g1[2] + b1[2], (v[i * 8 + 7] - mu) * rs * g1[3] + b1[3])};
    *(u32x4*)(yh + (size_t)t * DM + cb) = o;
  }
}

__device__ void d_cvt_w1f(size_t c, const float* __restrict__ w1, bf16_t* __restrict__ w1f) {
  const int lane = c & 63, ks = (c >> 6) & 255, ct = c >> 14;
  const int col = lane & 31, h = lane >> 5;
  bf16_t v[8];
#pragma unroll
  for (int j = 0; j < 8; ++j) v[j] = f2bf(w1[(size_t)(16 * ks + 8 * h + j) * 512 + 32 * ct + col]);
  u32x4 o; o.x = v[0] | ((unsigned)v[1] << 16); o.y = v[2] | ((unsigned)v[3] << 16); o.z = v[4] | ((unsigned)v[5] << 16); o.w = v[6] | ((unsigned)v[7] << 16);
  *(u32x4*)(w1f + c * 8) = o;
}
__device__ void d_cvt_w2f(size_t c, const float* __restrict__ w2, bf16_t* __restrict__ w2f) {
  const int lane = c & 63, s = (c >> 6) & 31, ct = c >> 11;
  const int col = lane & 31, h = lane >> 5;
  bf16_t v[8];
#pragma unroll
  for (int j = 0; j < 8; ++j) v[j] = f2bf(w2[(size_t)(16 * s + 8 * h + j) * 128 + 32 * ct + col]);
  u32x4 o; o.x = v[0] | ((unsigned)v[1] << 16); o.y = v[2] | ((unsigned)v[3] << 16); o.z = v[4] | ((unsigned)v[5] << 16); o.w = v[6] | ((unsigned)v[7] << 16);
  *(u32x4*)(w2f + c * 8) = o;
}
__device__ __forceinline__ void d_compress_unit(int rt, char* smem, const bf16_t* __restrict__ proj, int col0, const float* __restrict__ pos,
                                const bf16_t* __restrict__ w1f, const float* __restrict__ b1, const bf16_t* __restrict__ w2f,
                                bf16_t* __restrict__ outf, bool isV) {
  bf16_t* Xs = (bf16_t*)smem;
  bf16_t* Hs = (bf16_t*)(smem + 2 * 8704);
  const int tid = TIDX, lane = tid & 63, w = tid >> 6, c = lane & 31, h = lane >> 5;
  const int R0 = rt * 32;
  const int srow = tid >> 4, sch = tid & 15;
  const int grow = R0 + srow, sn = grow >> 1, sg = grow & 1;
  const bool svalid = grow < 2046;
  const bf16_t* sp = proj + (size_t)(16 * sn) * INWP + col0 + sg * 128 + sch * 8;
  f32x16 acc0, acc1;
#pragma unroll
  for (int i = 0; i < 16; ++i) { acc0[i] = 0.f; acc1[i] = 0.f; }
  u32x4 rx = {0u, 0u, 0u, 0u}; f32x4 rp0, rp1;
#define STAGE_WRITE(buf)                                                                                   \
  {                                                                                                        \
    u32x4 o_;                                                                                              \
    _Pragma("unroll") for (int i = 0; i < 4; ++i) {                                                        \
      const unsigned wv_ = rx[i];                                                                          \
      const float lo = __uint_as_float(wv_ << 16) + ((i < 2) ? rp0[2 * i] : rp1[2 * i - 4]);               \
      const float hi = __uint_as_float(wv_ & 0xFFFF0000u) + ((i < 2) ? rp0[2 * i + 1] : rp1[2 * i - 3]);   \
      o_[i] = pack2(lo, hi);                                                                               \
    }                                                                                                      \
    *(u32x4*)(Xs + (buf) * 4352 + srow * 136 + sch * 8) = o_;                                              \
  }
  if (svalid) rx = *(const u32x4*)(sp);
  rp0 = *(const f32x4*)(pos + sch * 8); rp1 = *(const f32x4*)(pos + sch * 8 + 4);
  STAGE_WRITE(0)
  __syncthreads();
  const bf16_t* wb0 = w1f + ((size_t)(2 * w) * 256 * 64 + lane) * 8;
  const bf16_t* wb1 = w1f + ((size_t)(2 * w + 1) * 256 * 64 + lane) * 8;
  bf16x8 bA[16], bB[16];
#define CMP_LOADB(BUF, L)                                                                      \
  _Pragma("unroll") for (int s8 = 0; s8 < 8; ++s8) {                                           \
    BUF[2 * s8] = *(const bf16x8*)(wb0 + (size_t)(8 * (L) + s8) * 512);                        \
    BUF[2 * s8 + 1] = *(const bf16x8*)(wb1 + (size_t)(8 * (L) + s8) * 512);                    \
  }
#define CMP_LOADX(L)                                                                           \
  if ((L) < 32) {     \
    if (svalid) rx = *(const u32x4*)(sp + (size_t)(L) * INWP);                                 \
    rp0 = *(const f32x4*)(pos + (L) * 128 + sch * 8); rp1 = *(const f32x4*)(pos + (L) * 128 + sch * 8 + 4); \
  }
#define CMP_CHUNK(BUF, L)                                                                      \
  {                                                                                            \
    const bf16_t* xa = Xs + ((L) & 1) * 4352 + c * 136 + 8 * h;                                \
    _Pragma("unroll") for (int s8 = 0; s8 < 8; ++s8) {                                         \
      const bf16x8 a = *(const bf16x8*)(xa + 16 * s8);                                         \
      acc0 = MFMA32(a, BUF[2 * s8], acc0);                                                     \
      acc1 = MFMA32(a, BUF[2 * s8 + 1], acc1);                                                 \
    }                                                                                          \
    if ((L) + 1 < 32) STAGE_WRITE(((L) + 1) & 1)                                               \
    __syncthreads();                                                                           \
  }
  CMP_LOADB(bA, 0)
#pragma unroll 1
  for (int l = 0; l < 32; l += 2) {
    CMP_LOADX(l + 1)
    CMP_LOADB(bB, l + 1)
    __builtin_amdgcn_sched_barrier(0);
    CMP_CHUNK(bA, l)
    __builtin_amdgcn_sched_barrier(0);
    CMP_LOADX(l + 2)
    { const int ln = (l + 2 < 32) ? l + 2 : l;
      CMP_LOADB(bA, ln) }
    __builtin_amdgcn_sched_barrier(0);
    CMP_CHUNK(bB, l + 1)
    __builtin_amdgcn_sched_barrier(0);
  }
#undef CMP_LOADX
#undef CMP_LOADB
#undef CMP_CHUNK
  {
    const float bb0 = b1[64 * w + c], bb1 = b1[64 * w + 32 + c];
#pragma unroll
    for (int rg = 0; rg < 16; ++rg) {
      const int row = (rg & 3) + 8 * (rg >> 2) + 4 * h;
      Hs[row * 520 + 64 * w + c] = f2bf(gelu_tanh(acc0[rg] + bb0));
      Hs[row * 520 + 64 * w + 32 + c] = f2bf(gelu_tanh(acc1[rg] + bb1));
    }
  }
  __syncthreads();
  if (w < 4) {
    f32x16 o2;
#pragma unroll
    for (int i = 0; i < 16; ++i) o2[i] = 0.f;
    const bf16_t* ha = Hs + c * 520 + 8 * h;
    const bf16_t* wb = w2f + ((size_t)w * 32 * 64 + lane) * 8;
#pragma unroll 8
    for (int s2 = 0; s2 < 32; ++s2) {
      const bf16x8 a = *(const bf16x8*)(ha + 16 * s2);
      const bf16x8 b = *(const bf16x8*)(wb + (size_t)s2 * 512);
      o2 = MFMA32(a, b, o2);
    }
    const int d = 32 * w + c;
#pragma unroll
    for (int rg = 0; rg < 16; ++rg) {
      const int row = R0 + (rg & 3) + 8 * (rg >> 2) + 4 * h;
      const int n = row >> 1, g = row & 1;
      const bf16_t val = (row < 2046) ? f2bf(o2[rg]) : (bf16_t)0;
      const int T = n >> 5, nn = n & 31;
      size_t idx;
      if (!isV) idx = ((((size_t)(g * 32 + T) * 8 + (d >> 4)) * 64 + (pi_perm(nn) + 32 * ((d >> 3) & 1))) * 8 + (d & 7));
      else idx = (((((size_t)(g * 32 + T) * 4 + (d >> 5)) * 2 + (nn >> 4)) * 64 + ((d & 31) + 32 * ((nn >> 3) & 1))) * 8 + (nn & 7));
      outf[idx] = val;
    }
  }
  __syncthreads();
}


DI unsigned f2sort(float f) { unsigned u = __float_as_uint(f); return u ^ ((unsigned)((int)u >> 31) | 0x80000000u); }
DI float sort2f(unsigned k) { unsigned u = (k & 0x80000000u) ? (k ^ 0x80000000u) : ~k; return __uint_as_float(u); }
template <int N>
DI void bitonic_sort_desc(unsigned (&key)[N]) {
#pragma unroll
  for (int k = 2; k <= N; k <<= 1) {
#pragma unroll
    for (int jj = k >> 1; jj > 0; jj >>= 1) {
#pragma unroll
      for (int i = 0; i < N; ++i) {
        const int l2 = i ^ jj;
        if (l2 > i) {
          const bool desc = ((i & k) == 0);
          unsigned a = key[i], b = key[l2];
          unsigned mx = a > b ? a : b, mn = a > b ? b : a;
          key[i] = desc ? mx : mn; key[l2] = desc ? mn : mx;
        }
      }
    }
  }
}
DI void merge_top16(unsigned (&a)[16], const unsigned (&b)[16]) {
#pragma unroll
  for (int i = 0; i < 16; ++i) { unsigned o = b[15 - i]; a[i] = a[i] > o ? a[i] : o; }
#pragma unroll
  for (int jj = 8; jj > 0; jj >>= 1) {
#pragma unroll
    for (int i = 0; i < 16; ++i) {
      const int l2 = i ^ jj;
      if (l2 > i) { unsigned x = a[i], y = a[l2]; a[i] = x > y ? x : y; a[l2] = x > y ? y : x; }
    }
  }
}
__device__ void d_cvt_subk(size_t c, const float* __restrict__ subk, bf16_t* __restrict__ skf) {
  int lane = c & 63, s = (c >> 6) & 7, kt = (c >> 9) & 3, hc = c >> 11;
  int i = lane & 31, h = lane >> 5;
  const float* src = subk + ((size_t)hc * 128 + 32 * kt + i) * 128 + 16 * s + 8 * h;
  bf16_t v[8];
#pragma unroll
  for (int j = 0; j < 8; ++j) v[j] = f2bf(src[j]);
  u32x4 o; o.x = v[0] | ((unsigned)v[1] << 16); o.y = v[2] | ((unsigned)v[3] << 16); o.z = v[4] | ((unsigned)v[5] << 16); o.w = v[6] | ((unsigned)v[7] << 16);
  *(u32x4*)(skf + c * 8) = o;
}

#define EPI_LANES()                                                                                                      \
    const int lane = fr | (fq << 4), rr = lane >> 2, rc = lane & 3;                                                       \
    PG8_LAS unsigned char* my = scr + (wr * 4 + wc) * 2048;                                                              \
    const int wo = fr * 64 + ((fq ^ ((fr >> 2) & 3)) << 4), ro = rr * 64 + ((rc ^ ((rr >> 2) & 3)) << 4);
struct EpiProjG {
  static constexpr bool PERM = true, AFTER_DRAIN = false;
  bf16_t* proj; float* gates; PG8_LAS unsigned char* scr;
  DI void operator()(const f32x4 (&acc)[2][2][4][2], const pg8::Unit& u, int wr, int wc, int fr, int fq) const {
    EPI_LANES()
#pragma unroll
    for (int ai = 0; ai < 2; ++ai)
#pragma unroll
      for (int bj = 0; bj < 2; ++bj) {
        const int c0 = u.pn * 256 + bj * 128 + wc * 32 + 8 * fq, cs = u.pn * 256 + bj * 128 + wc * 32 + 8 * rc;
#pragma unroll
        for (int mh = 0; mh < 2; ++mh) {
#pragma unroll
          for (int mm = 0; mm < 2; ++mm) {
            const f32x4 v0 = acc[ai][bj][mh * 2 + mm][0], v1 = acc[ai][bj][mh * 2 + mm][1];
            u32x4 w = {pack2(v0[0], v0[1]), pack2(v0[2], v0[3]), pack2(v1[0], v1[1]), pack2(v1[2], v1[3])};
            *(PG8_LAS u32x4*)(my + wo + mm * 1024) = w;
            if (c0 >= OFF_G && c0 < OFF_G + 24) {
              const int row = u.pm * 256 + ai * 128 + wr * 64 + (mh * 2 + mm) * 16 + fr;
              f32x4 g0, g1;
#pragma unroll
              for (int j = 0; j < 4; ++j) { g0[j] = 1.f / (1.f + __expf(-v0[j])); g1[j] = 1.f / (1.f + __expf(-v1[j])); }
              *(f32x4*)(gates + (size_t)row * 24 + (c0 - OFF_G)) = g0;
              *(f32x4*)(gates + (size_t)row * 24 + (c0 - OFF_G) + 4) = g1;
            }
          }
#pragma unroll
          for (int j = 0; j < 2; ++j) {
            const u32x4 w = *(const PG8_LAS u32x4*)(my + ro + j * 1024);
            const int row = u.pm * 256 + ai * 128 + wr * 64 + mh * 32 + j * 16 + rr;
            if (cs < INW) *(u32x4*)(proj + (size_t)row * INWP + cs) = w;
          }
        }
      }
  }
};
struct EpiResG {
  static constexpr bool PERM = true, AFTER_DRAIN = false;
  bf16_t* YB; PG8_LAS unsigned char* scr;
  DI void operator()(const f32x4 (&acc)[2][2][4][2], const pg8::Unit& u, int wr, int wc, int fr, int fq) const {
    EPI_LANES()
    bf16_t* yb = YB + (size_t)(u.pm * 256 + wr * 64 + rr) * DM + u.pn * 256 + wc * 32 + 8 * rc;
#pragma unroll
    for (int ai = 0; ai < 2; ++ai) {
      u32x4 xr[2][2][2];
#pragma unroll
      for (int bj = 0; bj < 2; ++bj)
#pragma unroll
        for (int mh = 0; mh < 2; ++mh)
#pragma unroll
          for (int j = 0; j < 2; ++j) xr[bj][mh][j] = *(const u32x4*)(yb + (size_t)(ai * 128 + mh * 32 + j * 16) * DM + bj * 128);
#pragma unroll
      for (int bj = 0; bj < 2; ++bj)
#pragma unroll
        for (int mh = 0; mh < 2; ++mh) {
#pragma unroll
          for (int mm = 0; mm < 2; ++mm) {
            const f32x4 v0 = acc[ai][bj][mh * 2 + mm][0], v1 = acc[ai][bj][mh * 2 + mm][1];
            u32x4 w = {pack2(v0[0], v0[1]), pack2(v0[2], v0[3]), pack2(v1[0], v1[1]), pack2(v1[2], v1[3])};
            *(PG8_LAS u32x4*)(my + wo + mm * 1024) = w;
          }
#pragma unroll
          for (int j = 0; j < 2; ++j) {
            const u32x4 a = *(const PG8_LAS u32x4*)(my + ro + j * 1024), xw = xr[bj][mh][j];
            u32x4 o;
#pragma unroll
            for (int q = 0; q < 4; ++q) {
              const unsigned aw = a[q], xq = xw[q];
              o[q] = pack2(fmaf(ALPHA, __uint_as_float(xq << 16), __uint_as_float(aw << 16)), fmaf(ALPHA, __uint_as_float(xq & 0xFFFF0000u), __uint_as_float(aw & 0xFFFF0000u)));
            }
            *(u32x4*)(yb + (size_t)(ai * 128 + mh * 32 + j * 16) * DM + bj * 128) = o;
          }
        }
    }
  }
};
struct EpiF32G {
  static constexpr bool PERM = false, AFTER_DRAIN = false;
  float* C; int ldc;
  DI void operator()(const f32x4 (&acc)[2][2][4][2], const pg8::Unit& u, int wr, int wc, int fr, int fq) const {
#pragma unroll
    for (int ai = 0; ai < 2; ++ai)
#pragma unroll
      for (int m = 0; m < 4; ++m) {
        const size_t ro = (size_t)(u.pm * 256 + ai * 128 + wr * 64 + m * 16 + fr) * ldc + u.pn * 256 + wc * 32 + 4 * fq;
#pragma unroll
        for (int bj = 0; bj < 2; ++bj)
#pragma unroll
          for (int n = 0; n < 2; ++n) *(f32x4*)(C + ro + bj * 128 + n * 16) = acc[ai][bj][m][n];
      }
  }
};
struct EpiRouteG {
  static constexpr bool PERM = false, AFTER_DRAIN = true;
  const bf16_t* skf; unsigned* tops;
  DI void operator()(const f32x4 (&)[2][2][4][2], const pg8::Unit&, int, int, int, int) const {}
  DI void fused(const f32x4 (&acc)[2][2][4][2], const pg8::Unit& u, int wr, int wc, int fr, int fq, PG8_LAS unsigned char* ldsp, int, int) const {
    const int lane = fr | (fq << 4), wid = wr * 4 + wc;
    bf16_t* Qs = (bf16_t*)ldsp;
#pragma unroll
    for (int ai = 0; ai < 2; ++ai)
#pragma unroll
      for (int m = 0; m < 4; ++m) {
        const int row = ai * 128 + wr * 64 + m * 16 + fr;
#pragma unroll
        for (int bj = 0; bj < 2; ++bj)
#pragma unroll
          for (int n = 0; n < 2; ++n) {
            const f32x4 v = acc[ai][bj][m][n];
            u32x2 w = {pack2(v[0], v[1]), pack2(v[2], v[3])};
            *(u32x2*)(Qs + row * 264 + bj * 128 + wc * 32 + n * 16 + 4 * fq) = w;
          }
      }
    __syncthreads();
    const int c = lane & 31, h = lane >> 5;
    unsigned kA[16], kB[16];
#pragma unroll 1
    for (int half = 0; half < 2; ++half) {
      const int hc = u.pn * 2 + half;
      const bf16_t* sk = skf + (size_t)hc * 4 * 4096;
      const bf16_t* qp = Qs + (wid * 32 + c) * 264 + half * 128 + 8 * h;
      unsigned k0[16], k1[16];
#define ROUTE_KT(KT, KA)                                                                        \
      {                                                                                         \
        f32x16 sc;                                                                              \
        _Pragma("unroll") for (int i = 0; i < 16; ++i) sc[i] = 0.f;                             \
        _Pragma("unroll") for (int s = 0; s < 8; ++s) {                                         \
          bf16x8 af = *(const bf16x8*)(sk + (KT) * 4096 + s * 512 + lane * 8);                  \
          bf16x8 bq = *(const bf16x8*)(qp + 16 * s);                                            \
          sc = __builtin_amdgcn_mfma_f32_32x32x16_bf16(af, bq, sc, 0, 0, 0);                    \
        }                                                                                       \
        _Pragma("unroll") for (int rg = 0; rg < 16; ++rg) {                                     \
          const int kidx = 32 * (KT) + (rg & 3) + 8 * (rg >> 2) + 4 * h;                        \
          KA[rg] = (f2sort(sc[rg]) & 0xFFFFFF80u) | (unsigned)(127 - kidx);                     \
        }                                                                                       \
        bitonic_sort_desc<16>(KA);                                                              \
      }
      ROUTE_KT(0, k0)
      __builtin_amdgcn_sched_barrier(0);
      ROUTE_KT(1, k1)
      merge_top16(k0, k1);
      __builtin_amdgcn_sched_barrier(0);
      ROUTE_KT(2, k1)
      merge_top16(k0, k1);
      __builtin_amdgcn_sched_barrier(0);
      ROUTE_KT(3, k1)
      merge_top16(k0, k1);
      __builtin_amdgcn_sched_barrier(0);
#undef ROUTE_KT
#pragma unroll
      for (int i = 0; i < 16; ++i) k1[i] = (unsigned)shx_i((int)k0[i], 32);
      merge_top16(k0, k1);
      if (half == 0) {
#pragma unroll
        for (int i = 0; i < 16; ++i) kA[i] = k0[i];
      } else {
#pragma unroll
        for (int i = 0; i < 16; ++i) kB[i] = k0[i];
      }
    }
    {
      unsigned* lk = (unsigned*)(ldsp + wid * 16896);
#pragma unroll
      for (int i = 0; i < 16; ++i) { lk[i * 64 + lane] = kA[i]; lk[(16 + i) * 64 + lane] = kB[i]; }
      float fa[16], fb[16];
#pragma unroll
      for (int i = 0; i < 16; ++i) { fa[i] = sort2f(kA[i]); fb[i] = sort2f(kB[i]); }
#define CAND(ci_, cj_) ((f2sort(fa[ci_] + fb[cj_]) & 0xFFFFFF00u) | (unsigned)(255 - ((ci_) * 16 + (cj_))))
      unsigned R0[16], R1[16], S1[16], S2[16];
#pragma unroll
      for (int j = 0; j < 16; ++j) { R0[j] = CAND(0, j); R1[j] = (j < 8) ? CAND(1, j & 7) : 0u; }
      S1[0] = CAND(2, 0); S1[1] = CAND(2, 1); S1[2] = CAND(2, 2); S1[3] = CAND(2, 3); S1[4] = CAND(2, 4);
      S1[5] = CAND(3, 0); S1[6] = CAND(3, 1); S1[7] = CAND(3, 2); S1[8] = CAND(3, 3);
      S1[9] = CAND(4, 0); S1[10] = CAND(4, 1); S1[11] = CAND(4, 2);
      S1[12] = CAND(5, 0); S1[13] = CAND(5, 1); S1[14] = CAND(6, 0); S1[15] = CAND(6, 1);
      S2[0] = CAND(7, 0); S2[1] = CAND(7, 1);
#pragma unroll
      for (int i = 8; i < 16; ++i) S2[i - 6] = CAND(i, 0);
#pragma unroll
      for (int i = 10; i < 16; ++i) S2[i] = 0u;
#undef CAND
      merge_top16(R0, R1);
      bitonic_sort_desc<16>(S1); bitonic_sort_desc<16>(S2);
      merge_top16(S1, S2);
      merge_top16(R0, S1);
      float sc[16]; unsigned ex[16]; float mx = -3.0e38f;
#pragma unroll
      for (int i = 0; i < 16; ++i) {
        const int flat = 255 - (int)(R0[i] & 255u);
        const unsigned ka = lk[(flat >> 4) * 64 + lane], kb = lk[(16 + (flat & 15)) * 64 + lane];
        sc[i] = sort2f(ka) + sort2f(kb);
        ex[i] = (127u - (ka & 127u)) * 128u + (127u - (kb & 127u));
        mx = fmaxf(mx, sc[i]);
      }
      float sm = 0.f;
#pragma unroll
      for (int i = 0; i < 16; ++i) { sc[i] = __expf(sc[i] - mx); sm += sc[i]; }
      const float rsm = 1.f / sm;
      unsigned* dst = tops + (size_t)(u.pm * 256 + wid * 32 + c) * 256 + h * 128 + u.pn * 16;
#pragma unroll
      for (int q4 = 0; q4 < 4; ++q4) {
        u32x4 o;
#pragma unroll
        for (int i = 0; i < 4; ++i) o[i] = h ? __float_as_uint(sc[4 * q4 + i] * rsm) : ex[4 * q4 + i];
        *(u32x4*)(dst + 4 * q4) = o;
      }
    }
    __syncthreads();
  }
};


template <int CTRL> DI float dpp_f(float v) { const int iv = __float_as_int(v); return __int_as_float(__builtin_amdgcn_update_dpp(iv, iv, CTRL, 0xF, 0xF, false)); }
DI float wsum(float x) {
  x += dpp_f<0xB1>(x);
  x += dpp_f<0x4E>(x);
  x += dpp_f<0x124>(x);
  x += dpp_f<0x128>(x);
  x += shx(x, 16);
  return hsum(x);
}
DI float gelu_fast(float x) {
  const float u2 = 1.5957691216057308f * (x + 0.044715f * x * x * x);
  return x * __builtin_amdgcn_rcpf(1.f + ex2(-LOG2E * u2));
}

constexpr int EROW = 1024;
typedef float v2f __attribute__((ext_vector_type(2)));
DI void d_cvt_fp4_fin(int row, const f32x4 (&x)[8], unsigned char* __restrict__ dst, float* __restrict__ scales) {
  const int lane = TIDX & 63;
  float v[32]; float amax = 0.f;
#pragma unroll
  for (int i = 0; i < 8; ++i)
#pragma unroll
    for (int j = 0; j < 4; ++j) { v[i * 4 + j] = x[i][j]; amax = fmaxf(amax, fabsf(x[i][j])); }
  amax = wave_max(amax);
  const float sc = amax > 0.f ? amax * (1.f / 7.f) : 1.f;
  const float inv = 1.f / sc;
  u32x4 o;
#pragma unroll
  for (int k = 0; k < 4; ++k) {
    unsigned w = 0u;
#define FP4C(x_) fminf(fmaxf((x_) * inv, -6.f), 6.f)
    w = __builtin_amdgcn_cvt_scalef32_pk_fp4_f32(w, FP4C(v[8 * k + 0]), FP4C(v[8 * k + 1]), 1.0f, 0);
    w = __builtin_amdgcn_cvt_scalef32_pk_fp4_f32(w, FP4C(v[8 * k + 2]), FP4C(v[8 * k + 3]), 1.0f, 1);
    w = __builtin_amdgcn_cvt_scalef32_pk_fp4_f32(w, FP4C(v[8 * k + 4]), FP4C(v[8 * k + 5]), 1.0f, 2);
    w = __builtin_amdgcn_cvt_scalef32_pk_fp4_f32(w, FP4C(v[8 * k + 6]), FP4C(v[8 * k + 7]), 1.0f, 3);
#undef FP4C
    o[k] = w;
  }
  *(u32x4*)(dst + (size_t)row * EROW + 16 * lane) = o;
  if (lane == 0) scales[row] = sc;
}
__device__ void d_cvt_fp4_row(int row, const float* __restrict__ src, unsigned char* __restrict__ dst, float* __restrict__ scales) {
  const int lane = TIDX & 63;
  f32x4 x[8];
#pragma unroll
  for (int i = 0; i < 8; ++i) x[i] = *(const f32x4*)(src + (size_t)row * DM + 256 * i + 4 * lane);
  d_cvt_fp4_fin(row, x, dst, scales);
}
DI void d_cvt_i4_fin(int row, const f32x4 (&x)[8], unsigned char* __restrict__ dst, float* __restrict__ scales) {
  const int lane = TIDX & 63;
  float v[32]; float amax = 0.f, ss = 0.f;
#pragma unroll
  for (int i = 0; i < 8; ++i)
#pragma unroll
    for (int j = 0; j < 4; ++j) { v[i * 4 + j] = x[i][j]; amax = fmaxf(amax, fabsf(x[i][j])); ss = fmaf(x[i][j], x[i][j], ss); }
  amax = wave_max(amax); ss = wave_sum(ss);
  float sc = fmaxf(0.36f * sqrtf(ss * (1.f / DM)), amax * (1.f / 14.f));
  sc = sc > 0.f ? sc : 1.f;
  const float inv = 1.f / sc;
  u32x4 o;
#pragma unroll
  for (int k = 0; k < 4; ++k) {
    unsigned w = 0u;
#pragma unroll
    for (int j = 0; j < 8; ++j) {
      const float q = fminf(fmaxf(v[8 * k + j] * inv, -7.f), 7.f) + 12582912.f;
      w |= (__float_as_uint(q) & 15u) << (4 * j);
    }
    o[k] = w;
  }
  *(u32x4*)(dst + (size_t)row * EROW + 16 * lane) = o;
  if (lane == 0) scales[row] = sc;
}
__device__ void d_cvt_i4_row(int row, const float* __restrict__ src, unsigned char* __restrict__ dst, float* __restrict__ scales) {
  const int lane = TIDX & 63;
  f32x4 x[8];
#pragma unroll
  for (int i = 0; i < 8; ++i) x[i] = *(const f32x4*)(src + (size_t)row * DM + 256 * i + 4 * lane);
  d_cvt_i4_fin(row, x, dst, scales);
}
__device__ void d_expert_group(int tg0, int tstr, unsigned* tpl, unsigned* slw, const bf16_t* __restrict__ hbuf, const unsigned* __restrict__ tops,
                               const unsigned char* __restrict__ eu4, const unsigned char* __restrict__ ev4, const float* __restrict__ esu, const float* __restrict__ esv,
                               const float* __restrict__ gam, const float* __restrict__ bet, float* __restrict__ out) {
  const int lane = TIDX & 63;
#define SLOT(j_, f_) slw[((j_) * 16 + (f_)) * 64 + lane]
#pragma unroll 1
  for (int j = 0; j < 4; ++j) {
    const int tt = tg0 + j * tstr, t = tt < S ? tt : S - 1;
  float hv[32];
#pragma unroll
  for (int i = 0; i < 8; ++i) {
    const u32x2 w = *(const u32x2*)(hbuf + (size_t)t * DM + 256 * i + 4 * lane);
    hv[i * 4 + 0] = __uint_as_float(w[0] << 16); hv[i * 4 + 1] = __uint_as_float(w[0] & 0xFFFF0000u);
    hv[i * 4 + 2] = __uint_as_float(w[1] << 16); hv[i * 4 + 3] = __uint_as_float(w[1] & 0xFFFF0000u);
  }
  int e0 = (int)tops[(size_t)t * 256 + lane], e1 = (int)tops[(size_t)t * 256 + 64 + lane];
  float w0 = __uint_as_float(tops[(size_t)t * 256 + 128 + lane]), w1 = __uint_as_float(tops[(size_t)t * 256 + 192 + lane]);
  {
    unsigned k0 = ((unsigned)e0 << 7) | (unsigned)lane, k1 = ((unsigned)e1 << 7) | (unsigned)(64 + lane);
#pragma unroll
    for (int k = 2; k <= 128; k <<= 1) {
#pragma unroll
      for (int jj = k >> 1; jj > 0; jj >>= 1) {
        if (jj == 64) { const unsigned mn = k0 < k1 ? k0 : k1, mx = k0 < k1 ? k1 : k0; k0 = mn; k1 = mx; }
        else {
          const unsigned o0 = (unsigned)shx_i((int)k0, jj), o1 = (unsigned)shx_i((int)k1, jj);
          const bool lower = (lane & jj) == 0;
          const bool asc0 = (k >= 64) ? true : ((lane & k) == 0), asc1 = (k == 128) ? true : (k == 64) ? false : ((lane & k) == 0);
          const unsigned mn0 = k0 < o0 ? k0 : o0, mx0 = k0 < o0 ? o0 : k0, mn1 = k1 < o1 ? k1 : o1, mx1 = k1 < o1 ? o1 : k1;
          k0 = (lower == asc0) ? mn0 : mx0; k1 = (lower == asc1) ? mn1 : mx1;
        }
      }
    }
    const int o0 = (int)(k0 & 127u), o1 = (int)(k1 & 127u);
    const float wa0 = __shfl(w0, o0 & 63), wb0 = __shfl(w1, o0 & 63), wa1 = __shfl(w0, o1 & 63), wb1 = __shfl(w1, o1 & 63);
    e0 = (int)(k0 >> 7); e1 = (int)(k1 >> 7); w0 = (o0 < 64) ? wa0 : wb0; w1 = (o1 < 64) ? wa1 : wb1;
  }
  int hhi[4], hlo[4]; float hsc;
  {
    float m = 0.f;
#pragma unroll
    for (int i = 0; i < 32; ++i) m = fmaxf(m, fabsf(hv[i]));
    m = wave_max(m);
    hsc = m > 0.f ? m * (1.f / 119.f) : 1.f;
    const float hinv = 1.f / hsc;
#pragma unroll
    for (int q = 0; q < 4; ++q) {
      unsigned wh = 0u, wl = 0u;
#pragma unroll
      for (int j = 0; j < 8; ++j) {
        const unsigned b = __float_as_uint(fmaf(hv[8 * q + j], hinv, 12582912.f));
        wl |= (b & 15u) << (4 * j); wh |= (((b + 8u) >> 4) & 15u) << (4 * j);
      }
      hhi[q] = (int)wh; hlo[q] = (int)wl;
    }
  }
    const float su0 = esu[e0], su1 = esu[e1], sv0 = esv[e0], sv1 = esv[e1];
#pragma unroll
    for (int q = 0; q < 4; ++q) { SLOT(j, q) = (unsigned)hhi[q]; SLOT(j, 4 + q) = (unsigned)hlo[q]; }
    SLOT(j, 8) = (unsigned)e0; SLOT(j, 9) = (unsigned)e1;
    SLOT(j, 10) = __float_as_uint(hsc * su0); SLOT(j, 11) = __float_as_uint(hsc * su1);
    SLOT(j, 12) = __float_as_uint(w0 * sv0); SLOT(j, 13) = __float_as_uint(w1 * sv1);
  }
  u32x4 rA[4], rB[4];
  const unsigned lo16 = (unsigned)(16 * lane);
#define G_LOAD(R, TAB, EX, LB)                                                             \
  _Pragma("unroll") for (int k = 0; k < 4; ++k) {                                          \
    const int id = __builtin_amdgcn_readlane((EX), (LB) + k);                              \
    R[k] = *(const u32x4*)((TAB) + (size_t)id * EROW + lo16);                              \
  }
#define PKFMA(a_, b_, c_) __builtin_elementwise_fma((a_), (b_), (c_))
  const int srcb = 4 * (((lane & 1) << 5) | ((lane & 2) << 3));
#define G_COMP_U(R, LB)                                                                    \
  {                                                                                        \
    int dd[4];                                                                             \
    _Pragma("unroll") for (int k = 0; k < 4; ++k) {                                        \
      int dh = 0, dl = 0;                                                                  \
      _Pragma("unroll") for (int q = 0; q < 4; ++q) {                                      \
        dh = __builtin_amdgcn_sdot8((int)R[k][q], hhi[q], dh, false);                      \
        dl = __builtin_amdgcn_sdot8((int)R[k][q], hlo[q], dl, false);                      \
      }                                                                                    \
      dd[k] = dh * 16 + dl;                                                                \
      __builtin_amdgcn_sched_barrier(0);                                                   \
    }                                                                                      \
    unsigned t01, t23;                                                                     \
    { auto r_ = __builtin_amdgcn_permlane32_swap((unsigned)dd[0], (unsigned)dd[1], false, false); t01 = r_[0] + r_[1]; }     \
    { auto r_ = __builtin_amdgcn_permlane32_swap((unsigned)dd[2], (unsigned)dd[3], false, false); t23 = r_[0] + r_[1]; }     \
    const bool b4_ = (lane & 16) != 0;                                                     \
    int tv = (int)(b4_ ? t23 : t01) + shx_i((int)(b4_ ? t01 : t23), 16);                   \
    tv += dpp_i<0x128>(tv); tv += dpp_i<0x124>(tv); tv += dpp_i<0x4E>(tv); tv += dpp_i<0xB1>(tv);   \
    const int got = __builtin_amdgcn_ds_bpermute(srcb, tv);                                \
    cc = ((unsigned)(lane - (LB)) < 4u) ? got : cc;                                        \
    __builtin_amdgcn_sched_barrier(0);                                                     \
  }
#define G_COMP_V(R, ACC, CF, LB)                                                           \
  _Pragma("unroll") for (int k = 0; k < 4; ++k) {                                          \
    const float cs = __int_as_float(__builtin_amdgcn_readlane(__float_as_int(CF), (LB) + k));   \
    const v2f cs2 = {cs, cs};                                                              \
    _Pragma("unroll") for (int q = 0; q < 4; ++q) {                                        \
      const unsigned wq = R[k][q];                                                         \
      const v2f f0 = __builtin_amdgcn_cvt_scalef32_pk_f32_fp4(wq, 1.0f, 0), f1 = __builtin_amdgcn_cvt_scalef32_pk_f32_fp4(wq, 1.0f, 1); \
      const v2f f2 = __builtin_amdgcn_cvt_scalef32_pk_f32_fp4(wq, 1.0f, 2), f3 = __builtin_amdgcn_cvt_scalef32_pk_f32_fp4(wq, 1.0f, 3); \
      ACC[4 * q + 0] = PKFMA(cs2, f0, ACC[4 * q + 0]); ACC[4 * q + 1] = PKFMA(cs2, f1, ACC[4 * q + 1]); \
      ACC[4 * q + 2] = PKFMA(cs2, f2, ACC[4 * q + 2]); ACC[4 * q + 3] = PKFMA(cs2, f3, ACC[4 * q + 3]); \
    }                                                                                      \
    __builtin_amdgcn_sched_barrier(0);                                                     \
  }
  {
    int eX = (int)SLOT(0, 8);
    G_LOAD(rA, eu4, eX, 0)
    __builtin_amdgcn_sched_barrier(0);
#pragma unroll 1
    for (int s_ = 0; s_ < 32; ++s_) {
      const int sg = s_ >> 2, j = s_ & 3, L0 = (sg & 3) * 16;
      const int sn = (s_ + 1) & 31, sgn = sn >> 2, jn = sn & 3, L0n = (sgn & 3) * 16;
      int hhi[4], hlo[4];
#pragma unroll
      for (int q = 0; q < 4; ++q) { hhi[q] = (int)SLOT(j, q); hlo[q] = (int)SLOT(j, 4 + q); }
      const int eXn = (int)SLOT(jn, 8 + (sgn >> 2));
      const unsigned char* tabn = (s_ == 31) ? ev4 : eu4;
      int cc = 0;
      G_LOAD(rB, eu4, eX, L0 + 4)
      __builtin_amdgcn_sched_barrier(0);
      G_COMP_U(rA, L0)
      G_LOAD(rA, eu4, eX, L0 + 8)
      __builtin_amdgcn_sched_barrier(0);
      G_COMP_U(rB, L0 + 4)
      G_LOAD(rB, eu4, eX, L0 + 12)
      __builtin_amdgcn_sched_barrier(0);
      G_COMP_U(rA, L0 + 8)
      G_LOAD(rA, tabn, eXn, L0n)
      __builtin_amdgcn_sched_barrier(0);
      G_COMP_U(rB, L0 + 12)
      if ((unsigned)(lane - L0) < 16u) SLOT(j, 14 + (sg >> 2)) = (unsigned)cc;
      eX = eXn;
    }
  }
#pragma unroll 1
  for (int j = 0; j < 4; ++j) {
    const float d0 = (float)(int)SLOT(j, 14), d1 = (float)(int)SLOT(j, 15);
    SLOT(j, 14) = __float_as_uint(__uint_as_float(SLOT(j, 12)) * gelu_fast(__uint_as_float(SLOT(j, 10)) * d0));
    SLOT(j, 15) = __float_as_uint(__uint_as_float(SLOT(j, 13)) * gelu_fast(__uint_as_float(SLOT(j, 11)) * d1));
  }
  v2f accv[4][16];
#pragma unroll
  for (int j = 0; j < 4; ++j)
#pragma unroll
    for (int i = 0; i < 16; ++i) accv[j][i] = v2f{0.f, 0.f};
  {
    int eX = (int)SLOT(0, 8);
#pragma unroll 1
    for (int sg = 0; sg < 8; ++sg) {
      const int L0 = (sg & 3) * 16;
#pragma unroll
      for (int j = 0; j < 4; ++j) {
        const int jn = (j + 1) & 3, sgn = (j == 3) ? ((sg + 1) & 7) : sg, L0n = (sgn & 3) * 16;
        const float cf = __uint_as_float(SLOT(j, 14 + (sg >> 2)));
        const int eXn = (int)SLOT(jn, 8 + (sgn >> 2));
        G_LOAD(rB, ev4, eX, L0 + 4)
        __builtin_amdgcn_sched_barrier(0);
        G_COMP_V(rA, accv[j], cf, L0)
        G_LOAD(rA, ev4, eX, L0 + 8)
        __builtin_amdgcn_sched_barrier(0);
        G_COMP_V(rB, accv[j], cf, L0 + 4)
        G_LOAD(rB, ev4, eX, L0 + 12)
        __builtin_amdgcn_sched_barrier(0);
        G_COMP_V(rA, accv[j], cf, L0 + 8)
        G_LOAD(rA, ev4, eXn, L0n)
        __builtin_amdgcn_sched_barrier(0);
        G_COMP_V(rB, accv[j], cf, L0 + 12)
        eX = eXn;
      }
    }
  }
#undef G_LOAD
#undef G_COMP_U
#undef G_COMP_V
#undef PKFMA
#pragma unroll
  for (int j = 0; j < 4; ++j) {
    const int t = tg0 + j * tstr;
    if (t < S) {
#define acc2 accv[j]
  float acc[32];
  #pragma unroll
    for (int i = 0; i < 16; ++i) { acc[2 * i] = acc2[i].x; acc[2 * i + 1] = acc2[i].y; }
    int le = lane;
    asm volatile("" : "+v"(le) :: "memory");
    float s = 0.f;
  #pragma unroll
    for (int i = 0; i < 8; ++i) {
      const u32x2 w = *(const u32x2*)(hbuf + (size_t)t * DM + 256 * i + 4 * le);
      const float h0 = __uint_as_float(w[0] << 16), h1 = __uint_as_float(w[0] & 0xFFFF0000u), h2 = __uint_as_float(w[1] << 16), h3 = __uint_as_float(w[1] & 0xFFFF0000u);
      acc[i * 4 + 0] = fmaf(ALPHA, h0, acc[i * 4 + 0]); acc[i * 4 + 1] = fmaf(ALPHA, h1, acc[i * 4 + 1]);
      acc[i * 4 + 2] = fmaf(ALPHA, h2, acc[i * 4 + 2]); acc[i * 4 + 3] = fmaf(ALPHA, h3, acc[i * 4 + 3]);
      s += (acc[i * 4 + 0] + acc[i * 4 + 1]) + (acc[i * 4 + 2] + acc[i * 4 + 3]);
    }
    s = wsum(s);
    const float mu = s * (1.f / DM);
    float qv = 0.f;
  #pragma unroll
    for (int i = 0; i < 32; ++i) { const float d = acc[i] - mu; qv += d * d; }
    qv = wsum(qv);
    const float rs = rsqrtf(qv * (1.f / DM) + 1e-5f);
  #pragma unroll
    for (int i = 0; i < 8; ++i) {
      const int cbase = 256 * i + 4 * le;
      f32x4 ga = *(const f32x4*)(gam + cbase), ba = *(const f32x4*)(bet + cbase), o;
  #pragma unroll
      for (int j = 0; j < 4; ++j) o[j] = (acc[i * 4 + j] - mu) * rs * ga[j] + ba[j];
      *(f32x4*)(out + (size_t)t * DM + cbase) = o;
    }
#undef acc2
    }
  }
#undef SLOT
}

constexpr size_t al256(size_t x) { return (x + 255) & ~(size_t)255; }
constexpr size_t WS_XB = 0;
constexpr size_t WS_PROJ = WS_XB + al256((size_t)S * DM * 2);
constexpr size_t WS_WINT = WS_PROJ + al256((size_t)S * INWP * 2);
constexpr size_t WS_GATES = WS_WINT + al256((size_t)INWG * DM * 2);
constexpr size_t WS_W1KF = WS_GATES + al256((size_t)S * 24 * 4);
constexpr size_t WS_W1VF = WS_W1KF + al256((size_t)512 * 4096 * 2);
constexpr size_t WS_W2KF = WS_W1VF + al256((size_t)512 * 4096 * 2);
constexpr size_t WS_W2VF = WS_W2KF + al256((size_t)512 * 128 * 2);
constexpr size_t WS_VC = WS_W2VF + al256((size_t)512 * 128 * 2) - al256((size_t)2048 * 128 * 4);
constexpr size_t WS_KCF = WS_VC + al256((size_t)2048 * 128 * 4);
constexpr size_t WS_VCF = WS_KCF + al256((size_t)2 * 32 * 4096 * 2);
constexpr size_t WS_KSF = WS_VCF + al256((size_t)2 * 32 * 4096 * 2);
constexpr size_t WS_VSF = WS_KSF + al256((size_t)2 * 512 * 4096 * 2);
constexpr size_t WS_KWF = WS_VSF + al256((size_t)2 * 512 * 4096 * 2);
constexpr size_t WS_VWF = WS_KWF + al256((size_t)2 * 512 * 4096 * 2);
constexpr size_t WS_ENDA = WS_VWF + al256((size_t)2 * 512 * 4096 * 2);
constexpr size_t WS_OATT = WS_ENDA;
constexpr size_t WS_MIX = WS_OATT + al256((size_t)S * 1024 * 4);
constexpr size_t WS_WOUTT = WS_MIX + al256((size_t)S * DM * 2);
constexpr size_t WS_WQT = WS_WOUTT + al256((size_t)DM * DM * 2);
constexpr size_t WS_TOPS = WS_WQT + al256((size_t)DM * DM * 2);
constexpr size_t WS_SKF = WS_TOPS + al256((size_t)S * 256 * 4);
constexpr size_t WS_STATS = WS_SKF + al256((size_t)16 * 128 * 128 * 2);
constexpr size_t WS_CTRL = WS_STATS + al256((size_t)S * 2 * 4);
constexpr size_t CTRL_BYTES = 32768;
constexpr size_t WS_END = WS_CTRL + CTRL_BYTES;
constexpr size_t WS_Y = WS_PROJ;
constexpr size_t WS_HB = WS_XB;
constexpr size_t WS_EU8 = WS_OATT;
constexpr size_t WS_EV8 = WS_EU8 + (size_t)16384 * 1024;
constexpr size_t WS_ESU = WS_EV8 + (size_t)16384 * 1024;
constexpr size_t WS_ESV = WS_ESU + 16384 * 4;
static_assert(WS_ESV + 16384 * 4 <= WS_MIX, "expert tables overflow their region");
constexpr int EXP_EARLY = 6144;
static_assert(WS_END <= (size_t)512 * 1024 * 1024, "workspace over 512 MiB");

struct Params {
  const float *x, *w_in, *ck_pos, *ck_w1, *ck_b1, *ck_w2, *cv_pos, *cv_w1, *cv_b1, *cv_w2, *conv_w, *hng, *w_out, *ln1g, *ln1b, *w_query, *subk,
      *eu, *ev, *ln2g, *ln2b;
  float* out;
  char* ws;
};
#define WSP(T, OFF) ((T*)(p.ws + (OFF)))

#define FOR_VB(n) for (int vb = blockIdx.x; vb < (n); vb += gridDim.x)
#define FOR_VB2(n) for (int vb = blockIdx.x * 2 + (TIDX >> 8); vb < (n); vb += gridDim.x * 2)
constexpr int SMEM_BYTES = 147456;
constexpr int HALF = 36864;

__global__ void __launch_bounds__(512) mega(Params p) {
  __shared__ __attribute__((aligned(16))) char smem[SMEM_BYTES + 16];
  if (TIDX == 0) *(u32x4*)(smem + SMEM_BYTES) = u32x4{0u, 0u, 0u, 0u};
  __syncthreads();
  const XcdBarrier xbar = xcd_barrier_post(WSP(unsigned, WS_CTRL + 1024), (volatile LAS unsigned*)(smem + SMEM_BYTES));
#define smh (smem + (TIDX >> 8) * HALF)
#define wv ((TIDX >> 6))
  constexpr int NWV = 8;
  d_cvt(p.x, WSP(bf16_t, WS_XB), (size_t)S * DM / 4);
  FOR_VB2((INWG / 64) * (DM / 64)) d_cvtT64(vb, smh, p.w_in, WSP(bf16_t, WS_WINT), DM, INW, INWG);
  for (size_t c = (size_t)blockIdx.x * 512 + TIDX; c < (size_t)16 * 256 * 64; c += (size_t)gridDim.x * 512) {
    d_cvt_w1f(c, p.ck_w1, WSP(bf16_t, WS_W1KF)); d_cvt_w1f(c, p.cv_w1, WSP(bf16_t, WS_W1VF));
    if (c < (size_t)4 * 32 * 64) { d_cvt_w2f(c, p.ck_w2, WSP(bf16_t, WS_W2KF)); d_cvt_w2f(c, p.cv_w2, WSP(bf16_t, WS_W2VF)); }
  }
  FOR_VB2((DM / 64) * (DM / 64)) d_cvtT64(vb, smh, p.w_out, WSP(bf16_t, WS_WOUTT), DM, DM, DM);
  FOR_VB2((DM / 64) * (DM / 64)) d_cvtT64(vb, smh, p.w_query, WSP(bf16_t, WS_WQT), DM, DM, DM);
  for (size_t c = (size_t)blockIdx.x * 512 + TIDX; c < (size_t)16 * 4 * 8 * 64; c += (size_t)gridDim.x * 512) d_cvt_subk(c, p.subk, WSP(bf16_t, WS_SKF));
  xcd_barrier(xbar);
  {
    pg8::StaticOrder so; so.init(S, INWG, gridDim.x, blockIdx.x);
    pg8::gemm_phase<EpiProjG, pg8::StaticOrder>((PG8_LAS unsigned char*)smem, pg8::Gemm{WSP(bf16_t, WS_XB), WSP(bf16_t, WS_WINT), S, INWG, DM}, so,
                                                EpiProjG{WSP(bf16_t, WS_PROJ), WSP(float, WS_GATES), (PG8_LAS unsigned char*)smem + pg8::STAGE_BYTES}, nullptr);
    const int nun = (S / 256) * (INWG / 256), gsz = (int)gridDim.x;
    const int nfull = nun % gsz;
    if (nfull != 0 && (int)blockIdx.x >= nfull) {
      const int nidle = gsz - nfull, me = (int)blockIdx.x - nfull;
      for (int r = me * NWV + wv; r < 2 * EXP_EARLY; r += nidle * NWV) {
        if (r < EXP_EARLY) d_cvt_i4_row(r, p.eu, WSP(unsigned char, WS_EU8), WSP(float, WS_ESU)); else d_cvt_fp4_row(r - EXP_EARLY, p.ev, WSP(unsigned char, WS_EV8), WSP(float, WS_ESV));
      }
    }
  }
  xcd_barrier(xbar);
  {
    if (blockIdx.x < 128) {
      const int xcd_ = blockIdx.x & 7, idx_ = blockIdx.x >> 3; const bool isV = (xcd_ & 1) != 0;
      d_compress_unit((xcd_ >> 1) * 16 + idx_, smem, WSP(bf16_t, WS_PROJ), isV ? OFF_VC : OFF_KC, isV ? p.cv_pos : p.ck_pos, isV ? WSP(bf16_t, WS_W1VF) : WSP(bf16_t, WS_W1KF),
                      isV ? p.cv_b1 : p.ck_b1, isV ? WSP(bf16_t, WS_W2VF) : WSP(bf16_t, WS_W2KF), isV ? WSP(bf16_t, WS_VCF) : WSP(bf16_t, WS_KCF), isV);
    }
    int* slot = (int*)smem;
    unsigned* ctr = WSP(unsigned, WS_CTRL);
    for (;;) {
      if (TIDX == 0) *slot = (int)atomicAdd(ctr, 1u);
      __syncthreads();
      const int it = *slot;
      __syncthreads();
      if (it >= 2048) break;
      const int tt = TIDX;
      {
        const int T = it >> 2, which = it & 3;
        d_relayout_tile(T, smem + 64, WSP(bf16_t, WS_PROJ), (which == 0) ? OFF_KS : (which == 1) ? OFF_VS : (which == 2) ? OFF_KW : OFF_VW,
                        (which == 0) ? WSP(bf16_t, WS_KSF) : (which == 1) ? WSP(bf16_t, WS_VSF) : (which == 2) ? WSP(bf16_t, WS_KWF) : WSP(bf16_t, WS_VWF), (which & 1) != 0);
      }
      for (int q = 0; q < 2; ++q) d_convmix(it * 8 + q * 4 + (tt >> 7), tt & 127, WSP(bf16_t, WS_PROJ), p.conv_w, p.hng, WSP(bf16_t, WS_MIX));
    }
  }
  xcd_barrier(xbar);
  {
    AttnPtrs ap{WSP(bf16_t, WS_PROJ), WSP(float, WS_GATES), WSP(bf16_t, WS_KCF), WSP(bf16_t, WS_VCF), WSP(bf16_t, WS_KSF), WSP(bf16_t, WS_VSF), WSP(bf16_t, WS_KWF), WSP(bf16_t, WS_VWF), WSP(bf16_t, WS_MIX), p.hng};
    for (int it = blockIdx.x; it < 512; it += gridDim.x) {
      const int Bq = (it < 256) ? it : (511 - it), gq = (it < 256) ? 0 : 1;
      d_attn_block(Bq, gq, smem, ap);
    }
  }
  xcd_barrier(xbar);
  {
    pg8::StaticOrder so; so.init(S, DM, gridDim.x, blockIdx.x);
    pg8::gemm_phase<EpiResG, pg8::StaticOrder>((PG8_LAS unsigned char*)smem, pg8::Gemm{WSP(bf16_t, WS_MIX), WSP(bf16_t, WS_WOUTT), S, DM, DM}, so,
                                               EpiResG{WSP(bf16_t, WS_HB), (PG8_LAS unsigned char*)smem + pg8::STAGE_BYTES}, nullptr);
  }
  xcd_barrier(xbar);
  {
    const int e0_ = (((S / 256) * (INWG / 256)) % (int)gridDim.x != 0) ? EXP_EARLY : 0;
    const int nrest = 16384 - e0_, ncv = 2 * nrest, wstr = (int)gridDim.x * NWV, lane_ = TIDX & 63;
    int rl = blockIdx.x * NWV + wv, rc = rl;
    u32x4 lcur[4], lnxt[4]; f32x4 ccur[8], cnxt[8];
#define P8_LDLN(R, r_) { _Pragma("unroll") for (int i = 0; i < 4; ++i) R[i] = *(const u32x4*)(WSP(bf16_t, WS_HB) + (size_t)(r_) * DM + 512 * i + 8 * lane_); }
#define P8_LDCV(R, r_) { const float* src_ = ((r_) < nrest) ? p.eu + (size_t)(e0_ + (r_)) * DM : p.ev + (size_t)(e0_ + (r_) - nrest) * DM; \
                         _Pragma("unroll") for (int i = 0; i < 8; ++i) R[i] = *(const f32x4*)(src_ + 256 * i + 4 * lane_); }
    if (rl < S) P8_LDLN(lcur, rl)
    if (rc < ncv) P8_LDCV(ccur, rc)
#pragma unroll 1
    while (rl < S || rc < ncv) {
      const int rln = rl + wstr, rcn = rc + wstr;
      if (rln < S) P8_LDLN(lnxt, rln)
      if (rcn < ncv) P8_LDCV(cnxt, rcn)
      __builtin_amdgcn_sched_barrier(0);
      if (rl < S) d_ln_fin(rl, lcur, WSP(bf16_t, WS_HB), p.ln1g, p.ln1b);
      if (rc < ncv) {
        if (rc < nrest) d_cvt_i4_fin(e0_ + rc, ccur, WSP(unsigned char, WS_EU8), WSP(float, WS_ESU));
        else d_cvt_fp4_fin(e0_ + rc - nrest, ccur, WSP(unsigned char, WS_EV8), WSP(float, WS_ESV));
      }
      __builtin_amdgcn_sched_barrier(0);
#pragma unroll
      for (int i = 0; i < 4; ++i) lcur[i] = lnxt[i];
#pragma unroll
      for (int i = 0; i < 8; ++i) ccur[i] = cnxt[i];
      rl = rln; rc = rcn;
    }
#undef P8_LDLN
#undef P8_LDCV
  }
  xcd_barrier(xbar);
  for (int k = 0; k * (int)gridDim.x < (S / 256) * (DM / 256); ++k) {
    pg8::OneUnit so; so.init(S, DM, gridDim.x, blockIdx.x); so.k = k;
    pg8::gemm_phase<EpiRouteG, pg8::OneUnit>((PG8_LAS unsigned char*)smem, pg8::Gemm{WSP(bf16_t, WS_HB), WSP(bf16_t, WS_WQT), S, DM, DM}, so,
                                             EpiRouteG{WSP(bf16_t, WS_SKF), WSP(unsigned, WS_TOPS)}, nullptr);
    __syncthreads();
  }
  xcd_barrier(xbar);
  {
    const int tstr = (int)gridDim.x * NWV;
    for (int tg0 = blockIdx.x * NWV + wv; tg0 < S; tg0 += 4 * tstr)
      d_expert_group(tg0, tstr, (unsigned*)(smem + wv * 1024), (unsigned*)(smem + 8192 + wv * 16384), WSP(bf16_t, WS_HB), WSP(unsigned, WS_TOPS), WSP(unsigned char, WS_EU8), WSP(unsigned char, WS_EV8),
                     WSP(float, WS_ESU), WSP(float, WS_ESV), p.ln2g, p.ln2b, p.out);
  }
}

extern "C" void kernel_launch(void* const* d_in, const int* in_sizes, int n_in, void* d_out, int out_size, void* d_ws, size_t ws_size,
                              hipStream_t stream) {
  Params p{};
  p.x = (const float*)d_in[0]; p.w_in = (const float*)d_in[1]; p.ck_pos = (const float*)d_in[2]; p.ck_w1 = (const float*)d_in[3];
  p.ck_b1 = (const float*)d_in[4]; p.ck_w2 = (const float*)d_in[5]; p.cv_pos = (const float*)d_in[6]; p.cv_w1 = (const float*)d_in[7];
  p.cv_b1 = (const float*)d_in[8]; p.cv_w2 = (const float*)d_in[9]; p.conv_w = (const float*)d_in[10]; p.hng = (const float*)d_in[11];
  p.w_out = (const float*)d_in[12]; p.ln1g = (const float*)d_in[13]; p.ln1b = (const float*)d_in[14]; p.w_query = (const float*)d_in[15];
  p.subk = (const float*)d_in[16]; p.eu = (const float*)d_in[17]; p.ev = (const float*)d_in[18]; p.ln2g = (const float*)d_in[19];
  p.ln2b = (const float*)d_in[20];
  p.out = (float*)d_out;
  p.ws = (char*)d_ws;
  if (ws_size < WS_END) fprintf(stderr, "workspace too small\n");
  static int grid_blocks = 0;
  if (!grid_blocks) {
    int dev = 0, cus = 0, per_cu = 0;
    hipGetDevice(&dev);
    hipDeviceGetAttribute(&cus, hipDeviceAttributeMultiprocessorCount, dev);
    hipOccupancyMaxActiveBlocksPerMultiprocessor(&per_cu, mega, 512, 0);
    if (per_cu > 1) per_cu = 1;
    if (per_cu < 1) per_cu = 1;
    grid_blocks = cus * per_cu;
  }
  hipMemsetAsync((char*)d_ws + WS_CTRL, 0, CTRL_BYTES, stream);
  void* args[] = {&p};
  hipError_t e = hipLaunchCooperativeKernel((void*)mega, dim3(grid_blocks), dim3(512), args, 0, stream);
  if (e != hipSuccess) fprintf(stderr, "cooperative launch failed: %s (grid %d)\n", hipGetErrorString(e), grid_blocks);
}
```

```cpp
#include <hip/hip_runtime.h>
#include <stdint.h>
#include <stdio.h>


#define DI __device__ __forceinline__
static __device__ __forceinline__ int tidx_() { int t = (int)__builtin_amdgcn_workitem_id_x(); asm volatile("" : "+v"(t)); return t; }
#define TIDX (tidx_())

template <int J> DI int swz_xor(int x) { return __builtin_amdgcn_ds_swizzle(x, (J << 10) | 0x1F); }
template <int CTRL> DI int dpp_i(int x) { return __builtin_amdgcn_update_dpp(x, x, CTRL, 0xF, 0xF, false); }
DI int shx_i(int x, int j) {
  switch (j) {
    case 1: return dpp_i<0xB1>(x);
    case 2: return dpp_i<0x4E>(x);
    case 4: return dpp_i<0x1B>(dpp_i<0x141>(x));
    case 8: return dpp_i<0x128>(x);
    case 16: return swz_xor<16>(x);
    default: {
      auto r = __builtin_amdgcn_permlane32_swap((unsigned)x, (unsigned)x, false, false);
      return (TIDX & 32) ? (int)r[0] : (int)r[1];
    }
  }
}
DI float shx(float x, int j) { return __int_as_float(shx_i(__float_as_int(x), j)); }
typedef unsigned short bf16_t;
using bf16x8 = __attribute__((ext_vector_type(8))) short;
using f32x4 = __attribute__((ext_vector_type(4))) float;
using u32x4 = __attribute__((ext_vector_type(4))) unsigned;
using u32x2 = __attribute__((ext_vector_type(2))) unsigned;

constexpr int S = 16384, DM = 2048, HD = 128;
constexpr int INW = 5656, INWP = 5760, INWG = 5888;
constexpr int OFF_Q = 0, OFF_KC = 1024, OFF_VC = 1280, OFF_KS = 1536, OFF_VS = 1792, OFF_KW = 2048, OFF_VW = 2304,
              OFF_G = 2560, OFF_U = 2584, OFF_B = 3608, OFF_C = 4632;
constexpr int NCMP = 1023;
constexpr float ALPHA = 1.189207115002721f;
constexpr float QSCALE = 0.08838834764831845f;

DI bf16_t f2bf(float x) { unsigned u = __float_as_uint(x); u += 0x7fffu + ((u >> 16) & 1u); return (bf16_t)(u >> 16); }
DI float bf2f(bf16_t b) { return __uint_as_float(((unsigned)b) << 16); }
DI float gelu_tanh(float x) { float u = 0.7978845608028654f * (x + 0.044715f * x * x * x); return 0.5f * x * (1.f + tanhf(u)); }
DI float wave_sum(float v) { for (int o = 32; o > 0; o >>= 1) v += shx(v, o); return v; }
using bf16x2v = __attribute__((ext_vector_type(2))) __bf16;
DI unsigned pack2(float a, float b) { bf16x2v v = {(__bf16)a, (__bf16)b}; return __builtin_bit_cast(unsigned, v); }
DI float wave_max(float v) { for (int o = 32; o > 0; o >>= 1) v = fmaxf(v, shx(v, o)); return v; }

namespace pg8 {
#define PG8_LAS __attribute__((address_space(3)))
typedef unsigned short bf16_t;
typedef short bf16x8 __attribute__((ext_vector_type(8)));
typedef float f32x4 __attribute__((ext_vector_type(4)));
typedef unsigned u32x4 __attribute__((ext_vector_type(4)));
constexpr int BM = 256, BK = 64, HALF = 128, HTB = HALF * BK * 2  , STAGE_BYTES = 8 * HTB, NXCD = 8, WGM = 8;

__host__ __device__ __forceinline__ int lds_byte(int r, int c) { const int st = (r >> 4) * 2 + (c >> 5), rr = r & 15, cc = c & 31, ob = rr * 64 + cc * 2; return st * 1024 + (ob ^ (((ob >> 9) & 1) << 5)); }
__host__ __device__ __forceinline__ void stage_rc(int b, int& R, int& C) { const int st = b / 1024, sb = b % 1024, swz = sb ^ (((sb >> 9) & 1) << 5); R = (st >> 1) * 16 + swz / 64; C = (st & 1) * 32 + (swz % 64) / 2; }
__host__ __device__ __forceinline__ int perm32(int rho) { const int n = rho >> 4, i = rho & 15; return 8 * (i >> 2) + 4 * n + (i & 3); }

struct Unit { int pm, pn; };
struct Gemm { const bf16_t* A; const bf16_t* Bt; int M, N, K; };

struct StaticOrder {
    int nM, nN, nwg, G, c;
    __host__ __device__ void init(int M, int N, int G_, int c_) { nM = M / BM; nN = N / BM; nwg = nM * nN; G = G_; c = c_; }
    __host__ __device__ bool next(int i, Unit& u) const {
        const long L = (long)i * G + c; if (L >= nwg) return false;
        int wgid = (int)L; { const int q = nwg / NXCD, r = nwg % NXCD, xcd = wgid % NXCD, off = wgid / NXCD; wgid = (xcd < r ? xcd * (q + 1) : r * (q + 1) + (xcd - r) * q) + off; }
        const int nig = WGM * nN, gid = wgid / nig, fm = gid * WGM, gsz = (nM - fm) < WGM ? (nM - fm) : WGM;
        u.pm = fm + ((wgid % nig) % gsz); u.pn = (wgid % nig) / gsz; return true;
    }
    __device__ __forceinline__ void a_ready(const Unit&) const {}
    __device__ __forceinline__ void done(const Unit&) const {}
};
struct OneUnit : StaticOrder {
    int k;
    __device__ bool next(int i, Unit& u) const { if (i > 0) return false; return StaticOrder::next(k, u); }
};
__device__ __forceinline__ unsigned cvt_pk_bf16(float lo, float hi) { unsigned r; asm volatile("v_cvt_pk_bf16_f32 %0, %1, %2" : "=v"(r) : "v"(lo), "v"(hi)); return r; }
template <class Epi, class Sched, bool STAMP = false>
__device__ __forceinline__ void gemm_phase(PG8_LAS unsigned char* lds, const Gemm g, const Sched& S, const Epi& E, unsigned long long* stamps) {
    const int tid = TIDX, wid = __builtin_amdgcn_readfirstlane(tid >> 6), lane = tid & 63, wr = wid >> 2, wc = wid & 3, fr = lane & 15, fq = lane >> 4;
    const int K = g.K, nt = K / BK;
    int ts_lo = 0, ts_hi = 0, nts = 0; const unsigned long long rt_entry = STAMP ? (unsigned long long)wall_clock64() : 0ull;
#define PG8_STAMP() do { if (STAMP && wid == 0 && nts < 64) { const unsigned long long _c = (unsigned long long)clock64(); \
        ts_lo = (lane == nts) ? (int)(unsigned)_c : ts_lo; ts_hi = (lane == nts) ? (int)(unsigned)(_c >> 32) : ts_hi; ++nts; } } while (0)
    PG8_STAMP();
    unsigned voffA[2], voffB[2];
#pragma unroll
    for (int i = 0; i < 2; ++i) { int R, C; stage_rc(tid * 16 + i * 8192, R, C); const int Rb = Epi::PERM ? ((R & ~31) + perm32(R & 31)) : R;
        voffA[i] = (unsigned)(R * K + C) * 2u; voffB[i] = (unsigned)(Rb * K + C) * 2u; }
    const size_t kstep = (size_t)(BK * 2);
    const size_t hstep = (size_t)HALF * K * 2;
    const size_t tstep = 2 * hstep;
    const unsigned ldsw = (unsigned)wid * 1024u;
    const int aoff = lds_byte(wr * 64 + fr, fq * 8), boff = lds_byte(wc * 32 + fr, fq * 8);
#define PG8_SA(b, h) (((b) * 2 + (h)) * HTB)
#define PG8_SB(b, h) ((4 + (b) * 2 + (h)) * HTB)
#define PG8_STAGE(bufoff, gbase, voff) do { _Pragma("unroll") for (int _i = 0; _i < 2; ++_i) \
        __builtin_amdgcn_global_load_lds((const unsigned*)((const char*)(gbase) + (voff)[_i]), (PG8_LAS unsigned*)(lds + (bufoff) + ldsw + _i * 8192), 16, 0, 0); } while (0)
#define PG8_LDA(dst, b, h) do { _Pragma("unroll") for (int m = 0; m < 4; ++m) _Pragma("unroll") for (int k = 0; k < 2; ++k) dst[m][k] = *(const PG8_LAS bf16x8*)(lds + PG8_SA(b, h) + aoff + m * 2048 + k * 1024); } while (0)
#define PG8_LDB(dst, b, h) do { _Pragma("unroll") for (int n = 0; n < 2; ++n) _Pragma("unroll") for (int k = 0; k < 2; ++k) dst[n][k] = *(const PG8_LAS bf16x8*)(lds + PG8_SB(b, h) + boff + n * 2048 + k * 1024); } while (0)
#define PG8_MMA(ai, bj, At, Bt) do { __builtin_amdgcn_s_setprio(1); _Pragma("unroll") for (int m = 0; m < 4; ++m) _Pragma("unroll") for (int n = 0; n < 2; ++n) _Pragma("unroll") for (int k = 0; k < 2; ++k) \
        acc[ai][bj][m][n] = __builtin_amdgcn_mfma_f32_16x16x32_bf16(Bt[n][k], At[m][k], acc[ai][bj][m][n], 0, 0, 0); __builtin_amdgcn_s_setprio(0); } while (0)
#define PG8_WAIT_V(n) asm volatile("s_waitcnt vmcnt(" #n ")" ::: "memory")
#define PG8_WAIT_L(n) asm volatile("s_waitcnt lgkmcnt(" #n ")" ::: "memory")
#define PG8_BAR __builtin_amdgcn_s_barrier()
#define PG8_SCHED __builtin_amdgcn_sched_barrier(0)
    Unit cur, nxt; int ui = 0;
    if (!S.next(0, cur)) return;
    f32x4 acc[2][2][4][2];
#pragma unroll
    for (int a = 0; a < 2; ++a)
#pragma unroll
        for (int b = 0; b < 2; ++b)
#pragma unroll
            for (int m = 0; m < 4; ++m)
#pragma unroll
                for (int n = 0; n < 2; ++n) acc[a][b][m][n] = (f32x4){0.f, 0.f, 0.f, 0.f};
    bf16x8 At[4][2], B0[2][2], B1[2][2];
    const char* cA = (const char*)g.A + (size_t)cur.pm * tstep; const char* cB = (const char*)g.Bt + (size_t)cur.pn * tstep;
    S.a_ready(cur);
    PG8_STAGE(PG8_SB(0, 0), cB, voffB); PG8_STAGE(PG8_SA(0, 0), cA, voffA); PG8_STAGE(PG8_SB(0, 1), cB + hstep, voffB); PG8_STAGE(PG8_SA(0, 1), cA + hstep, voffA);
    if (wr == 1) PG8_BAR;
    PG8_WAIT_V(4); PG8_BAR;
    PG8_STAGE(PG8_SB(1, 0), cB + kstep, voffB); PG8_STAGE(PG8_SA(1, 0), cA + kstep, voffA); PG8_STAGE(PG8_SB(1, 1), cB + hstep + kstep, voffB);
    PG8_WAIT_V(6); PG8_BAR;
    PG8_STAMP();
    for (;;) {
        const bool has_next = S.next(ui + 1, nxt);
        const char* nA = has_next ? (const char*)g.A + (size_t)nxt.pm * tstep : cA; const char* nB = has_next ? (const char*)g.Bt + (size_t)nxt.pn * tstep : cB;
        for (int t = 0; t < nt; t += 2) {
            const bool last = (t == nt - 2);
            const char* a1 = cA + (size_t)(t + 1) * kstep;
            const char* a2 = last ? nA : cA + (size_t)(t + 2) * kstep; const char* b2 = last ? nB : cB + (size_t)(t + 2) * kstep;
            const char* a3 = a2 + kstep; const char* b3 = b2 + kstep;
            if (last && has_next) S.a_ready(nxt);
            PG8_LDB(B0, 0, 0); PG8_SCHED; PG8_LDA(At, 0, 0); PG8_STAGE(PG8_SA(1, 1), a1 + hstep, voffA);
            PG8_WAIT_L(8); PG8_BAR; PG8_WAIT_L(0); PG8_MMA(0, 0, At, B0); PG8_BAR; PG8_SCHED;
            PG8_LDB(B1, 0, 1); PG8_STAGE(PG8_SB(0, 0), b2, voffB);
            PG8_BAR; PG8_WAIT_L(0); PG8_MMA(0, 1, At, B1); PG8_BAR;
            PG8_LDA(At, 0, 1); PG8_STAGE(PG8_SA(0, 0), a2, voffA);
            PG8_BAR; PG8_WAIT_L(0); PG8_MMA(1, 0, At, B0); PG8_BAR; PG8_SCHED;
            PG8_STAGE(PG8_SB(0, 1), b2 + hstep, voffB);
            PG8_WAIT_V(6); PG8_BAR; PG8_MMA(1, 1, At, B1); PG8_BAR;
            PG8_LDB(B0, 1, 0); PG8_SCHED; PG8_LDA(At, 1, 0); PG8_STAGE(PG8_SA(0, 1), a2 + hstep, voffA);
            PG8_WAIT_L(8); PG8_BAR; PG8_WAIT_L(0); PG8_MMA(0, 0, At, B0); PG8_BAR; PG8_SCHED;
            PG8_LDB(B1, 1, 1); PG8_STAGE(PG8_SB(1, 0), b3, voffB);
            PG8_BAR; PG8_WAIT_L(0); PG8_MMA(0, 1, At, B1); PG8_BAR;
            PG8_LDA(At, 1, 1); PG8_STAGE(PG8_SA(1, 0), a3, voffA);
            PG8_BAR; PG8_WAIT_L(0); PG8_MMA(1, 0, At, B0); PG8_BAR; PG8_SCHED;
            PG8_STAGE(PG8_SB(1, 1), b3 + hstep, voffB);
            PG8_WAIT_V(6); PG8_BAR; PG8_MMA(1, 1, At, B1); PG8_BAR;
        }
        PG8_STAMP();
        if constexpr (!Epi::AFTER_DRAIN) { E(acc, cur, wr, wc, fr, fq); S.done(cur); }
        PG8_STAMP();
        if (!has_next) break;
#pragma unroll
        for (int a = 0; a < 2; ++a)
#pragma unroll
            for (int b = 0; b < 2; ++b)
#pragma unroll
                for (int m = 0; m < 4; ++m)
#pragma unroll
                    for (int n = 0; n < 2; ++n) acc[a][b][m][n] = (f32x4){0.f, 0.f, 0.f, 0.f};
        cur = nxt; cA = nA; cB = nB; ++ui;
    }
    PG8_WAIT_V(0);
    if (wr == 0) PG8_BAR;
    PG8_BAR;
    if constexpr (Epi::AFTER_DRAIN) { E.fused(acc, cur, wr, wc, fr, fq, lds, wid, lane); S.done(cur); }
    PG8_STAMP();
    if (STAMP && wid == 0) { stamps[lane] = lane < nts ? (((unsigned long long)(unsigned)ts_hi << 32) | (unsigned)ts_lo) : 0ull;
        if (lane == 62) stamps[62] = rt_entry; if (lane == 63) stamps[63] = (unsigned long long)wall_clock64(); }
#undef PG8_STAMP
#undef PG8_SA
#undef PG8_SB
#undef PG8_STAGE
#undef PG8_LDA
#undef PG8_LDB
#undef PG8_MMA
#undef PG8_WAIT_V
#undef PG8_WAIT_L
#undef PG8_BAR
#undef PG8_SCHED
}
}

#define XB_TMO      128
#define XB_XCNT(j)  (256  + 64 * (j))
#define XB_XSUB(j)  (1280 + 64 * (j))
#define XB_XGEN(j)  (2304 + 64 * (j))
#define XB_TOP      3328
#define XB_TOPGEN   3392
#define XCD_BAR_WORDS 3456
#define XB_SPIN_CAP (1u << 18)
#define LAS __attribute__((address_space(3)))

__device__ __forceinline__ unsigned xb_ld(unsigned* p)              { return __hip_atomic_load(p, __ATOMIC_RELAXED, __HIP_MEMORY_SCOPE_AGENT); }
__device__ __forceinline__ unsigned xb_add(unsigned* p, unsigned v) { return __hip_atomic_fetch_add(p, v, __ATOMIC_RELAXED, __HIP_MEMORY_SCOPE_AGENT); }
__device__ __forceinline__ unsigned xb_xcc_id() { return (unsigned)__builtin_amdgcn_s_getreg((3 << 11) | 20) & 0xFu; }
#define XB_SPIN(cond, bar) do { unsigned _sp = 0; while (cond) { __builtin_amdgcn_s_sleep(1); \
    if ((++_sp & 255u) == 0u) { if (xb_ld(&(bar)[XB_TMO])) break; if (_sp > XB_SPIN_CAP) { atomicAdd(&(bar)[XB_TMO], 1u); break; } } } } while (0)

struct XcdBarrier {
    unsigned* bar; unsigned x;
    volatile LAS unsigned* st;
};

__device__ __forceinline__ XcdBarrier xcd_barrier_post(unsigned* bar, volatile LAS unsigned* st) {
    XcdBarrier b; b.bar = bar; b.x = xb_xcc_id(); b.st = st;
    if (TIDX == 0) (void)xb_add(&bar[XB_XCNT(b.x)], 1u);
    return b;
}
__device__ __forceinline__ void xcd_barrier_complete(unsigned* bar, unsigned x, unsigned& nloc, unsigned& nx) {
    const unsigned G = gridDim.x * gridDim.y * gridDim.z;
    unsigned sum, cnt, mine, sp = 0u;
    for (;;) {
        sum = 0u; cnt = 0u; mine = 0u;
#pragma unroll
        for (unsigned j = 0; j < 16; ++j) { const unsigned c = xb_ld(&bar[XB_XCNT(j)]); sum += c; cnt += (c > 0u) ? 1u : 0u; mine = (j == x) ? c : mine; }
        if (sum == G) break;
        __builtin_amdgcn_s_sleep(1);
        if ((++sp & 255u) == 0u) { if (xb_ld(&bar[XB_TMO])) break; if (sp > XB_SPIN_CAP) { atomicAdd(&bar[XB_TMO], 1u); break; } }
    }
    nloc = mine > 0u ? mine : 1u; nx = cnt > 0u ? cnt : 1u;
}

__device__ __forceinline__ void xcd_barrier(const XcdBarrier& b) {
    asm volatile("s_waitcnt vmcnt(0)" ::: "memory");
    __syncthreads();
    if (TIDX == 0) {
        unsigned* bar = b.bar;
        __builtin_amdgcn_s_waitcnt(0);
        unsigned nloc = b.st[0], nx = b.st[1];
        if (nloc == 0u) { xcd_barrier_complete(bar, b.x, nloc, nx); b.st[0] = nloc; b.st[1] = nx; }
        const unsigned old = xb_add(&bar[XB_XSUB(b.x)], 1u);
        const unsigned gen = old / nloc;
        if (old + 1u == (gen + 1u) * nloc) {
            __builtin_amdgcn_fence(__ATOMIC_RELEASE, "agent");
            asm volatile("s_waitcnt vmcnt(0)" ::: "memory");
            const unsigned og = xb_add(&bar[XB_TOP], 1u);
            const unsigned tg = og / nx;
            if (og + 1u == (tg + 1u) * nx) xb_add(&bar[XB_TOPGEN], 1u);
            else XB_SPIN(xb_ld(&bar[XB_TOPGEN]) == tg, bar);
            __builtin_amdgcn_fence(__ATOMIC_ACQUIRE, "agent");
            xb_add(&bar[XB_XGEN(b.x)], 1u);
            asm volatile("s_waitcnt vmcnt(0)" ::: "memory");
        } else {
            XB_SPIN(xb_ld(&bar[XB_XGEN(b.x)]) == gen, bar);
            __builtin_amdgcn_fence(__ATOMIC_ACQUIRE, "agent");
            asm volatile("s_waitcnt vmcnt(0)" ::: "memory");
        }
    }
    __syncthreads();
}

__device__ void d_cvt(const float* __restrict__ in, bf16_t* __restrict__ out, size_t n4) {
  const size_t stride = (size_t)gridDim.x * blockDim.x;
  size_t i = (size_t)blockIdx.x * blockDim.x + TIDX;
  for (; i + 3 * stride < n4; i += 4 * stride) {
    f32x4 v[4];
#pragma unroll
    for (int q = 0; q < 4; ++q) v[q] = ((const f32x4*)in)[i + q * stride];
#pragma unroll
    for (int q = 0; q < 4; ++q) { u32x2 o = {pack2(v[q][0], v[q][1]), pack2(v[q][2], v[q][3])}; ((u32x2*)out)[i + q * stride] = o; }
  }
  for (; i < n4; i += stride) { const f32x4 v = ((const f32x4*)in)[i]; u32x2 o = {pack2(v[0], v[1]), pack2(v[2], v[3])}; ((u32x2*)out)[i] = o; }
}
__device__ void d_cvtT64(int vb, char* smem, const float* __restrict__ W, bf16_t* __restrict__ WT, int K, int N, int NP) {
  float (*tt)[65] = (float (*)[65])smem;
  const int tid = (TIDX & 255);
  const int nbx = NP / 64;
  const int n0 = (vb % nbx) * 64, k0 = (vb / nbx) * 64;
  {
    const int kr = tid >> 4, nc = (tid & 15) * 4;
#pragma unroll
    for (int i = 0; i < 4; ++i) {
      const int k = k0 + kr + 16 * i, n = n0 + nc;
      f32x4 v = {0.f, 0.f, 0.f, 0.f};
      if (n < N) v = *(const f32x4*)(W + (size_t)k * N + n);
      tt[kr + 16 * i][nc] = v[0]; tt[kr + 16 * i][nc + 1] = v[1]; tt[kr + 16 * i][nc + 2] = v[2]; tt[kr + 16 * i][nc + 3] = v[3];
    }
  }
  __syncthreads();
  {
    const int nr = tid >> 3, kc = (tid & 7) * 8;
#pragma unroll
    for (int i = 0; i < 2; ++i) {
      const int nl = nr + 32 * i;
      u32x4 o = {pack2(tt[kc][nl], tt[kc + 1][nl]), pack2(tt[kc + 2][nl], tt[kc + 3][nl]), pack2(tt[kc + 4][nl], tt[kc + 5][nl]), pack2(tt[kc + 6][nl], tt[kc + 7][nl])};
      *(u32x4*)(WT + (size_t)(n0 + nl) * K + k0 + kc) = o;
    }
  }
  __syncthreads();
}

using f32x16 = __attribute__((ext_vector_type(16))) float;
using bf16x8v = __attribute__((ext_vector_type(8))) __bf16;
#define MFMA32(a, b, c) __builtin_amdgcn_mfma_f32_32x32x16_bf16((a), (b), (c), 0, 0, 0)
constexpr float LOG2E = 1.4426950408889634f;
constexpr float NEGB = -1e30f;
DI int pi_perm(int i) { return (i & ~12) | ((i & 8) >> 1) | ((i & 4) << 1); }
DI bf16x8 pack8(float a0, float a1, float a2, float a3, float a4, float a5, float a6, float a7) {
  bf16x8v v = {(__bf16)a0, (__bf16)a1, (__bf16)a2, (__bf16)a3, (__bf16)a4, (__bf16)a5, (__bf16)a6, (__bf16)a7};
  return __builtin_bit_cast(bf16x8, v);
}
__device__ __forceinline__ void d_relayout_tile(int T, char* smem, const bf16_t* __restrict__ proj, int col0, bf16_t* __restrict__ dst, bool isV) {
  bf16_t* Ls = (bf16_t*)smem;
  const int tid = TIDX;
#pragma unroll
  for (int q = 0; q < 2; ++q) {
    const int cidx = tid + q * 512;
    const int g = cidx >> 9, tok = (cidx >> 4) & 31, ch = cidx & 15;
    const u32x4 v = *(const u32x4*)(proj + (size_t)(32 * T + tok) * INWP + col0 + g * 128 + ch * 8);
    *(u32x4*)(Ls + (g * 32 + tok) * 136 + ch * 8) = v;
  }
  __syncthreads();
#pragma unroll
  for (int q = 0; q < 2; ++q) {
    const int oc = tid + q * 512;
    const int g = oc >> 9, r9 = oc & 511, lane = r9 & 63;
    u32x4 o;
    if (!isV) {
      const int s8 = r9 >> 6, i = lane & 31, h = lane >> 5;
      o = *(const u32x4*)(Ls + (g * 32 + pi_perm(i)) * 136 + 16 * s8 + 8 * h);
    } else {
      const int s2 = (r9 >> 6) & 1, dt = r9 >> 7, dd = lane & 31, h = lane >> 5;
      const bf16_t* col = Ls + (g * 32 + 16 * s2 + 8 * h) * 136 + 32 * dt + dd;
      unsigned short e[8];
#pragma unroll
      for (int j = 0; j < 8; ++j) e[j] = col[j * 136];
      o.x = e[0] | ((unsigned)e[1] << 16); o.y = e[2] | ((unsigned)e[3] << 16); o.z = e[4] | ((unsigned)e[5] << 16); o.w = e[6] | ((unsigned)e[7] << 16);
    }
    *(u32x4*)(dst + (((size_t)(g * 512 + T)) * 512 + r9) * 8) = o;
  }
  __syncthreads();
}

struct AttnPtrs {
  const bf16_t* proj; const float* gates;
  const bf16_t *kcf, *vcf, *ksf, *vsf, *kwf, *vwf;
  bf16_t* mix; const float* hng;
};

DI float ex2(float x) { return __builtin_amdgcn_exp2f(x); }
DI void halves(float x, float& lo, float& hi) {
  const unsigned u = __float_as_uint(x);
  auto r = __builtin_amdgcn_permlane32_swap(u, u, false, false);
  lo = __uint_as_float(r[0]); hi = __uint_as_float(r[1]);
}
DI float hmax(float x) { float a, b; halves(x, a, b); return fmaxf(a, b); }
DI float hsum(float x) { float a, b; halves(x, a, b); return a + b; }
DI float dpp_quad(float v, int ctrl_is_xor1) {
  const int iv = __float_as_int(v);
  const int r = ctrl_is_xor1 ? __builtin_amdgcn_update_dpp(iv, iv, 0xB1, 0xF, 0xF, false) : __builtin_amdgcn_update_dpp(iv, iv, 0x4E, 0xF, 0xF, false);
  return __int_as_float(r);
}
DI float quad_sum(float v) { v += dpp_quad(v, 1); v += dpp_quad(v, 0); return v; }
DI void osm_step(const float (&sv)[16], float& m, float& l, f32x16 (&O)[4], float (&p)[16]) {
  float tmax = fmaxf(fmaxf(fmaxf(sv[0], sv[1]), fmaxf(sv[2], sv[3])), fmaxf(fmaxf(sv[4], sv[5]), fmaxf(sv[6], sv[7])));
  tmax = fmaxf(tmax, fmaxf(fmaxf(fmaxf(sv[8], sv[9]), fmaxf(sv[10], sv[11])), fmaxf(fmaxf(sv[12], sv[13]), fmaxf(sv[14], sv[15]))));
  tmax = hmax(tmax);
  if (__ballot(tmax - m > 8.f)) {
    const float mn = fmaxf(m, tmax);
    const float alpha = ex2(m - mn);
    l *= alpha; m = mn;
#pragma unroll
    for (int dt = 0; dt < 4; ++dt)
#pragma unroll
      for (int r = 0; r < 16; ++r) O[dt][r] *= alpha;
  }
  float ps0 = 0.f, ps1 = 0.f;
#pragma unroll
  for (int r = 0; r < 16; r += 2) { const float e0 = ex2(sv[r] - m), e1 = ex2(sv[r + 1] - m); p[r] = e0; p[r + 1] = e1; ps0 += e0; ps1 += e1; }
  l += ps0 + ps1;
}
DI void ot_store(char* otL, int lane, const f32x16 (&O)[4], float sc) {
#pragma unroll
  for (int dt = 0; dt < 4; ++dt) {
    u32x4 a, b;
#pragma unroll
    for (int i = 0; i < 4; ++i) { a[i] = pack2(sc * O[dt][2 * i], sc * O[dt][2 * i + 1]); b[i] = pack2(sc * O[dt][8 + 2 * i], sc * O[dt][8 + 2 * i + 1]); }
    *(u32x4*)(otL + lane * 128 + dt * 32) = a;
    *(u32x4*)(otL + lane * 128 + dt * 32 + 16) = b;
  }
}
DI void ot_accum(const char* otL, int lane, f32x16 (&O)[4], float sc) {
#pragma unroll
  for (int dt = 0; dt < 4; ++dt) {
    u32x4 a = *(const u32x4*)(otL + lane * 128 + dt * 32);
    u32x4 b = *(const u32x4*)(otL + lane * 128 + dt * 32 + 16);
#pragma unroll
    for (int i = 0; i < 4; ++i) {
      const unsigned wa = a[i], wb = b[i];
      O[dt][2 * i] = fmaf(sc, O[dt][2 * i], __uint_as_float(wa << 16));
      O[dt][2 * i + 1] = fmaf(sc, O[dt][2 * i + 1], __uint_as_float(wa & 0xFFFF0000u));
      O[dt][8 + 2 * i] = fmaf(sc, O[dt][8 + 2 * i], __uint_as_float(wb << 16));
      O[dt][8 + 2 * i + 1] = fmaf(sc, O[dt][8 + 2 * i + 1], __uint_as_float(wb & 0xFFFF0000u));
    }
  }
}
DI void zero_o(f32x16 (&O)[4]) {
#pragma unroll
  for (int dt = 0; dt < 4; ++dt)
#pragma unroll
    for (int i = 0; i < 16; ++i) O[dt][i] = 0.f;
}

constexpr int ATT_PW = 8704;
constexpr int ATT_R = 4, ATT_D = 3;
constexpr int ATT_RING = 8 * ATT_PW;
constexpr int ATT_LIST = ATT_RING + ATT_R * 16384;
constexpr int ATT_BUNI = ATT_LIST + 2048;
constexpr int ATT_SMEM = ATT_BUNI + 64;
#define LAS3 __attribute__((address_space(3)))
__device__ __forceinline__ void d_select(const float* impL, unsigned* mskL, unsigned* uniL, int cur) {
  const int lane = TIDX & 63;
  const int stok = lane >> 3, sub = lane & 7;
  unsigned key[32];
#pragma unroll
  for (int i4 = 0; i4 < 8; ++i4) {
    f32x4 v = *(const f32x4*)(impL + stok * 256 + sub * 32 + i4 * 4);
#pragma unroll
    for (int e = 0; e < 4; ++e) {
      const int j = sub * 32 + i4 * 4 + e;
      const bool valid = j <= cur;
      const bool forced = (j == 0) || (j == cur) || (j == cur - 1);
      unsigned kb = forced ? 0xFFFFFF00u : (__float_as_uint(v[e]) & 0xFFFFFF00u);
      key[i4 * 4 + e] = valid ? (kb | (unsigned)(255 - j)) : 0u;
    }
  }
#pragma unroll
  for (int k = 2; k <= 32; k <<= 1) {
#pragma unroll
    for (int jj = k >> 1; jj > 0; jj >>= 1) {
#pragma unroll
      for (int i = 0; i < 32; ++i) {
        const int l2 = i ^ jj;
        if (l2 > i) {
          const bool desc = ((i & k) == 0);
          unsigned a = key[i], b = key[l2];
          unsigned mx = a > b ? a : b, mn = a > b ? b : a;
          key[i] = desc ? mx : mn; key[l2] = desc ? mn : mx;
        }
      }
    }
  }
#pragma unroll
  for (int xm = 1; xm < 8; xm <<= 1) {
    unsigned L[16];
#pragma unroll
    for (int i = 0; i < 16; ++i) { unsigned o = (unsigned)shx_i((int)key[15 - i], xm); L[i] = key[i] > o ? key[i] : o; }
#pragma unroll
    for (int jj = 8; jj > 0; jj >>= 1) {
#pragma unroll
      for (int i = 0; i < 16; ++i) {
        const int l2 = i ^ jj;
        if (l2 > i) { unsigned a = L[i], b = L[l2]; L[i] = a > b ? a : b; L[l2] = a > b ? b : a; }
      }
    }
#pragma unroll
    for (int i = 0; i < 16; ++i) key[i] = L[i];
  }
#pragma unroll
  for (int i = 0; i < 16; ++i) {
    if ((i & 7) == sub) {
      const int j = 255 - (int)(key[i] & 255u);
      if (j <= cur) { atomicOr(&mskL[stok * 8 + (j >> 5)], 1u << (j & 31)); atomicOr(&uniL[j >> 5], 1u << (j & 31)); }
    }
  }
}


DI void att_issue(LAS3 unsigned char* ring, int slot, int w, int lane, const bf16_t* kb, const bf16_t* vb, int tile) {
  const char* ks = (const char*)kb + (size_t)tile * 8192 + w * 1024 + lane * 16;
  const char* vs = (const char*)vb + (size_t)tile * 8192 + w * 1024 + lane * 16;
  __builtin_amdgcn_global_load_lds((const unsigned*)ks, (LAS3 unsigned*)(ring + slot * 16384 + w * 1024), 16, 0, 0);
  __builtin_amdgcn_global_load_lds((const unsigned*)vs, (LAS3 unsigned*)(ring + slot * 16384 + 8192 + w * 1024), 16, 0, 0);
}
DI f32x16 qk_lds(LAS3 const unsigned char* kt, const bf16x8 (&qf)[8], int lane) {
  f32x16 acc;
#pragma unroll
  for (int i = 0; i < 16; ++i) acc[i] = 0.f;
#pragma unroll
  for (int s8 = 0; s8 < 8; ++s8) {
    const bf16x8 kf = *(LAS3 const bf16x8*)(kt + s8 * 1024 + lane * 16);
    acc = MFMA32(kf, qf[s8], acc);
  }
  return acc;
}
DI void pv_lds(LAS3 const unsigned char* vt, const float (&p)[16], f32x16 (&O)[4], int lane) {
  const bf16x8 pf0 = pack8(p[0], p[1], p[2], p[3], p[4], p[5], p[6], p[7]);
  const bf16x8 pf1 = pack8(p[8], p[9], p[10], p[11], p[12], p[13], p[14], p[15]);
#pragma unroll
  for (int dt = 0; dt < 4; ++dt) {
    const bf16x8 v0 = *(LAS3 const bf16x8*)(vt + (dt * 2) * 1024 + lane * 16);
    const bf16x8 v1 = *(LAS3 const bf16x8*)(vt + (dt * 2 + 1) * 1024 + lane * 16);
    O[dt] = MFMA32(v0, pf0, O[dt]);
    O[dt] = MFMA32(v1, pf1, O[dt]);
  }
}

__device__ __forceinline__ void d_attn_block(int B, int g, char* smem, const AttnPtrs& P) {
  const int tid = TIDX, lane = tid & 63, w = tid >> 6;
  const int c = lane & 31, h = lane >> 5, tokl = c >> 2, r = c & 3;
  const int tok0 = 64 * B + 8 * w;
  const int t = tok0 + tokl, hd = g * 4 + r;
  const float slope2 = exp2f(-(float)(hd + 1)) * LOG2E;
  const float c1 = QSCALE * LOG2E;
  const float ninf = -__builtin_inff();
  char* wsm = smem + w * ATT_PW;
  float* impL = (float*)wsm;
  char* otL = wsm;
  unsigned* mskL = (unsigned*)(wsm + 8192);
  unsigned* uniL = mskL + 64;
  LAS3 unsigned char* ring = (LAS3 unsigned char*)(smem + ATT_RING);
  unsigned short* tl = (unsigned short*)(smem + ATT_LIST);
  unsigned* buni = (unsigned*)(smem + ATT_BUNI);
  const bf16_t* kcf = P.kcf + (size_t)g * 32 * 4096;
  const bf16_t* vcf = P.vcf + (size_t)g * 32 * 4096;
  const bf16_t* ksf = P.ksf + (size_t)g * 512 * 4096;
  const bf16_t* vsf = P.vsf + (size_t)g * 512 * 4096;
  const bf16_t* kwf = P.kwf + (size_t)g * 512 * 4096;
  const bf16_t* vwf = P.vwf + (size_t)g * 512 * 4096;
  bf16x8 qf[8];
  {
    const bf16_t* qrow = P.proj + (size_t)t * INWP + OFF_Q + hd * 128 + 8 * h;
#pragma unroll
    for (int s8 = 0; s8 < 8; ++s8) qf[s8] = *(const bf16x8*)(qrow + 16 * s8);
  }
  const float* gt = P.gates + (size_t)t * 24 + hd * 3;
  const float g0 = gt[0], g1 = gt[1], g2 = gt[2];
  {
    unsigned z0 = 0u;
    asm volatile("" : "+v"(z0));
    u32x4 z = {z0, z0, z0, z0};
#pragma unroll
    for (int i = 0; i < 8; ++i) *(u32x4*)(wsm + (i * 64 + lane) * 16) = z;
    if (lane < 18) *(u32x4*)(wsm + 8192 + lane * 16) = z;
    if (tid < 8) buni[tid] = z0;
  }
  f32x16 Ob[4];
  zero_o(Ob);
  const int nmax = (t >= 31) ? ((t - 31) >> 4) : -1;
  const int nmaxw = (tok0 + 7 >= 31) ? ((tok0 + 7 - 31) >> 4) : -1;
  const int nminw = (tok0 >= 31) ? ((tok0 - 31) >> 4) : -1;
  const int ntcw = (nmaxw + 32) >> 5;
  const int ntcB = (((64 * B + 63 - 31) >> 4) + 32) >> 5;
  const float sl16 = slope2 * 16.f;
  float mC = NEGB, lC = 0.f, invC = 0.f, carry = 0.f;
  {
    const int n = 2 * ntcB;
    asm volatile("s_waitcnt vmcnt(0)" ::: "memory");
#define A_TILE(i_) (((i_) < ntcB) ? (ntcB - 1 - (i_)) : ((i_) - ntcB))
    att_issue(ring, 0, w, lane, kcf, vcf, A_TILE(0));
    if (n > 1) att_issue(ring, 1, w, lane, kcf, vcf, A_TILE(1));
#pragma unroll 1
    for (int i = 0; i < n; ++i) {
      if ((i & 1) == 0) {
        asm volatile("s_waitcnt vmcnt(0)" ::: "memory");
        __builtin_amdgcn_s_barrier();
        asm volatile("" ::: "memory");
        if (i + 2 < n) att_issue(ring, (i + 2) & 3, w, lane, kcf, vcf, A_TILE(i + 2));
        if (i + 3 < n) att_issue(ring, (i + 3) & 3, w, lane, kcf, vcf, A_TILE(i + 3));
      }
      const int T = A_TILE(i);
      if (T >= ntcw) continue;
      LAS3 const unsigned char* slot = ring + (i % ATT_R) * 16384;
      const f32x16 acc = qk_lds(slot, qf, lane);
      const float base = slope2 * (float)(512 * T + 128 * h) + slope2 * (15.5f - (float)t);
      const int nb = 32 * T + 8 * h;
      const bool full = (32 * T + 31 <= nminw);
      float sv[16];
#pragma unroll
      for (int rg = 0; rg < 16; ++rg) { const int kk = (rg & 7) + 16 * (rg >> 3); sv[rg] = fmaf(acc[rg], c1, fmaf(sl16, (float)kk, base)); }
      if (!full) {
#pragma unroll
        for (int rg = 0; rg < 16; ++rg) { const int kk = (rg & 7) + 16 * (rg >> 3); sv[rg] = (nb + kk <= nmax) ? sv[rg] : ninf; }
      }
      if (i < ntcB) {
        float tmax = fmaxf(fmaxf(fmaxf(sv[0], sv[1]), fmaxf(sv[2], sv[3])), fmaxf(fmaxf(sv[4], sv[5]), fmaxf(sv[6], sv[7])));
        tmax = fmaxf(tmax, fmaxf(fmaxf(fmaxf(sv[8], sv[9]), fmaxf(sv[10], sv[11])), fmaxf(fmaxf(sv[12], sv[13]), fmaxf(sv[14], sv[15]))));
        tmax = hmax(tmax);
        const float mn = fmaxf(mC, tmax);
        float ps = 0.f;
#pragma unroll
        for (int rg = 0; rg < 16; ++rg) ps += ex2(sv[rg] - mn);
        lC = lC * ex2(mC - mn) + ps; mC = mn;
      } else {
        if (T == 0) { lC = hsum(lC); invC = (lC > 0.f) ? 1.f / lC : 0.f; }
        float p[16];
#pragma unroll
        for (int rg = 0; rg < 16; ++rg) p[rg] = ex2(sv[rg] - mC) * invC;
        float Ga = (p[0] + p[1]) + (p[2] + p[3]), Gb = (p[4] + p[5]) + (p[6] + p[7]);
        float Gc = (p[8] + p[9]) + (p[10] + p[11]), Gd = (p[12] + p[13]) + (p[14] + p[15]);
        float xb, xd; { float a_, b_; halves(p[7], a_, b_); xb = h ? a_ : b_; halves(p[15], a_, b_); xd = h ? a_ : b_; }
        float ia = Ga + (h ? xb : carry);
        float ib = Gb + p[3];
        float ic = Gc + (h ? xd : xb);
        float id = Gd + p[11];
        carry = xd;
        ia = quad_sum(ia); ib = quad_sum(ib); ic = quad_sum(ic); id = quad_sum(id);
        {
          float val = (r == 0) ? ia : (r == 1) ? ib : (r == 2) ? ic : id;
          int j = 8 * T + 2 * h + ((r == 0) ? 0 : (r == 1) ? 1 : (r == 2) ? 4 : 5);
          impL[tokl * 256 + j] = val;
        }
        pv_lds(slot + 8192, p, Ob, lane);
      }
    }
#undef A_TILE
  }
  const int cur = B;
  d_select(impL, mskL, uniL, cur);
  ot_store(otL, lane, Ob, g0);
  zero_o(Ob);
  if (lane < 8) { const unsigned u = uniL[lane]; if (u) atomicOr(&buni[lane], u); }
  __syncthreads();
  int nslc = 0, ntl = 0;
  {
    for (int iw = 7; iw >= 0; --iw) {
      unsigned iuw = __builtin_amdgcn_readfirstlane(buni[iw]);
      while (iuw) {
        const int bit = 31 - __builtin_clz(iuw);
        iuw &= ~(1u << bit);
        const int bb = 32 * iw + bit;
        if (bb < B) { if (lane == 0) tl[ntl] = (unsigned short)(2 * bb + 1); ++ntl; }
        else { if (lane == 0) tl[ntl] = (unsigned short)(2 * bb + 1); ++ntl; }
        if (lane == 0) tl[ntl] = (unsigned short)(2 * bb);
        ++ntl;
      }
    }
    nslc = ntl;
    const int ThiB = 2 * B + 1, TloB = ((64 * B - 511 > 0) ? (64 * B - 511) : 0) >> 5;
    for (int T = ThiB; T >= TloB; --T) { if (lane == 0) tl[ntl] = (unsigned short)T; ++ntl; }
  }
  float m = NEGB, l = 0.f;
  {
    const int n = ntl;
    const int Tlow = ((tok0 - 511 > 0) ? (tok0 - 511) : 0) >> 5, Thiw = (tok0 + 7) >> 5;
#define B_ISSUE(j_, slot_) { const int e_ = __builtin_amdgcn_readfirstlane((int)tl[j_]); if ((j_) < nslc) att_issue(ring, slot_, w, lane, ksf, vsf, e_); else att_issue(ring, slot_, w, lane, kwf, vwf, e_); }
    B_ISSUE(0, 0)
    if (n > 1) B_ISSUE(1, 1)
#pragma unroll 1
    for (int i = 0; i < n; ++i) {
      if ((i & 1) == 0) {
        asm volatile("s_waitcnt vmcnt(0)" ::: "memory");
        __builtin_amdgcn_s_barrier();
        asm volatile("" ::: "memory");
        if (i + 2 < n) B_ISSUE(i + 2, (i + 2) & 3)
        if (i + 3 < n) B_ISSUE(i + 3, (i + 3) & 3)
      }
      if (i == nslc) {
        l = hsum(l);
        const float inv = (l > 0.f) ? g1 / l : 0.f;
        ot_accum(otL, lane, Ob, inv);
        ot_store(otL, lane, Ob, 1.f);
        zero_o(Ob);
        m = NEGB; l = 0.f;
      }
      const int T = __builtin_amdgcn_readfirstlane((int)tl[i]);
      const int pos0 = 32 * T, pb = pos0 + 8 * h;
      bool full; bool mine = true;
      if (i < nslc) {
        const int bb = T >> 1;
        const unsigned uw = __builtin_amdgcn_readfirstlane(uniL[bb >> 5]);
        if (!((uw >> (bb & 31)) & 1u) || pos0 > tok0 + 7) continue;
        mine = (mskL[tokl * 8 + (bb >> 5)] >> (bb & 31)) & 1u;
        full = (pos0 + 31 <= tok0) && (__ballot(!mine) == 0ull);
      } else {
        if (T < Tlow || T > Thiw) continue;
        full = (pos0 + 31 <= tok0) && (pos0 >= tok0 + 7 - 511);
      }
      LAS3 const unsigned char* slot = ring + (i % ATT_R) * 16384;
      const f32x16 acc = qk_lds(slot, qf, lane);
      const float base = slope2 * (float)(pos0 + 8 * h - t);
      float sv[16], p[16];
#pragma unroll
      for (int rg = 0; rg < 16; ++rg) { const int kk = (rg & 7) + 16 * (rg >> 3); sv[rg] = fmaf(acc[rg], c1, fmaf(slope2, (float)kk, base)); }
      if (!full) {
        if (i < nslc) {
#pragma unroll
          for (int rg = 0; rg < 16; ++rg) { const int kk = (rg & 7) + 16 * (rg >> 3); sv[rg] = (mine && (pb + kk <= t)) ? sv[rg] : ninf; }
        } else {
#pragma unroll
          for (int rg = 0; rg < 16; ++rg) { const int kk = (rg & 7) + 16 * (rg >> 3); const int dw = t - (pb + kk); sv[rg] = ((dw >= 0) && (dw < 512)) ? sv[rg] : ninf; }
        }
      }
      osm_step(sv, m, l, Ob, p);
      pv_lds(slot + 8192, p, Ob, lane);
    }
#undef B_ISSUE
    l = hsum(l);
    const float inv = (l > 0.f) ? g2 / l : 0.f;
    ot_accum(otL, lane, Ob, inv);
  }
  {
    float ss = 0.f;
#pragma unroll
    for (int dt = 0; dt < 4; ++dt)
#pragma unroll
      for (int i = 0; i < 16; ++i) ss = fmaf(Ob[dt][i], Ob[dt][i], ss);
    ss = hsum(ss);
    const float rs = rsqrtf(ss * (1.f / 128.f) + 1e-6f);
    bf16_t* orow = P.mix + (size_t)t * DM + hd * 128 + 4 * h;
    const float* grow = P.hng + hd * 128 + 4 * h;
#pragma unroll
    for (int dt = 0; dt < 4; ++dt)
#pragma unroll
      for (int a = 0; a < 4; ++a) {
        const f32x4 gv = *(const f32x4*)(grow + 32 * dt + 8 * a);
        u32x2 wv2 = {pack2(Ob[dt][4 * a] * rs * gv[0], Ob[dt][4 * a + 1] * rs * gv[1]), pack2(Ob[dt][4 * a + 2] * rs * gv[2], Ob[dt][4 * a + 3] * rs * gv[3])};
        *(u32x2*)(orow + 32 * dt + 8 * a) = wv2;
      }
  }
  asm volatile("s_waitcnt vmcnt(0)" ::: "memory");
  __syncthreads();
}

__device__ void d_convmix(int t, int tl, const bf16_t* __restrict__ proj, const float* __restrict__ convw, const float* __restrict__ hng,
                          bf16_t* __restrict__ mix) {
  const int c = tl * 8;
  float acc[8];
#pragma unroll
  for (int i = 0; i < 8; ++i) acc[i] = 0.f;
#pragma unroll
  for (int j = 0; j < 3; ++j) {
    const int tt = t - 2 + j;
    if (tt >= 0) {
      const u32x4 cu = *(const u32x4*)(proj + (size_t)tt * INWP + OFF_C + c);
      const u32x4 uu = *(const u32x4*)(proj + (size_t)tt * INWP + OFF_U + c);
      const f32x4 w0 = *(const f32x4*)(convw + j * 1024 + c), w1 = *(const f32x4*)(convw + j * 1024 + c + 4);
#pragma unroll
      for (int i = 0; i < 4; ++i) {
        const unsigned a = cu[i], b = uu[i];
        const float wl = (i < 2) ? w0[2 * i] : w1[2 * i - 4], wh = (i < 2) ? w0[2 * i + 1] : w1[2 * i - 3];
        acc[2 * i] = fmaf(wl * __uint_as_float(a << 16), __uint_as_float(b << 16), acc[2 * i]);
        acc[2 * i + 1] = fmaf(wh * __uint_as_float(a & 0xFFFF0000u), __uint_as_float(b & 0xFFFF0000u), acc[2 * i + 1]);
      }
    }
  }
  const u32x4 bb = *(const u32x4*)(proj + (size_t)t * INWP + OFF_B + c);
  float ss = 0.f;
#pragma unroll
  for (int i = 0; i < 4; ++i) {
    const unsigned b = bb[i];
    acc[2 * i] *= __uint_as_float(b << 16); acc[2 * i + 1] *= __uint_as_float(b & 0xFFFF0000u);
    ss = fmaf(acc[2 * i], acc[2 * i], ss); ss = fmaf(acc[2 * i + 1], acc[2 * i + 1], ss);
  }
  ss += shx(ss, 8); ss += shx(ss, 4); ss += shx(ss, 2); ss += shx(ss, 1);
  const float rs = rsqrtf(ss * (1.f / 128.f) + 1e-6f);
  const f32x4 g0 = *(const f32x4*)(hng + 1024 + c), g1 = *(const f32x4*)(hng + 1024 + c + 4);
  u32x4 o = {pack2(acc[0] * rs * g0[0], acc[1] * rs * g0[1]), pack2(acc[2] * rs * g0[2], acc[3] * rs * g0[3]),
             pack2(acc[4] * rs * g1[0], acc[5] * rs * g1[1]), pack2(acc[6] * rs * g1[2], acc[7] * rs * g1[3])};
  *(u32x4*)(mix + (size_t)t * DM + 1024 + c) = o;
}

DI void d_ln_fin(int t, const u32x4 (&wr)[4], bf16_t* __restrict__ yh, const float* __restrict__ gam, const float* __restrict__ bet) {
  const int lane = TIDX & 63;
  float v[32];
#pragma unroll
  for (int i = 0; i < 4; ++i) {
    const u32x4 w = wr[i];
#pragma unroll
    for (int j = 0; j < 4; ++j) { const unsigned ww = w[j]; v[i * 8 + 2 * j] = __uint_as_float(ww << 16); v[i * 8 + 2 * j + 1] = __uint_as_float(ww & 0xFFFF0000u); }
  }
  float s = 0.f;
#pragma unroll
  for (int i = 0; i < 32; ++i) s += v[i];
  s = wave_sum(s);
  const float mu = s * (1.f / DM);
  float q = 0.f;
#pragma unroll
  for (int i = 0; i < 32; ++i) { const float d = v[i] - mu; q = fmaf(d, d, q); }
  q = wave_sum(q);
  const float rs = rsqrtf(q * (1.f / DM) + 1e-5f);
#pragma unroll
  for (int i = 0; i < 4; ++i) {
    const int cb = 512 * i + 8 * lane;
    const f32x4 g0 = *(const f32x4*)(gam + cb), g1 = *(const f32x4*)(gam + cb + 4), b0 = *(const f32x4*)(bet + cb), b1 = *(const f32x4*)(bet + cb + 4);
    u32x4 o = {pack2((v[i * 8 + 0] - mu) * rs * g0[0] + b0[0], (v[i * 8 + 1] - mu) * rs * g0[1] + b0[1]), pack2((v[i * 8 + 2] - mu) * rs * g0[2] + b0[2], (v[i * 8 + 3] - mu) * rs * g0[3] + b0[3]),
               pack2((v[i * 8 + 4] - mu) * rs * g1[0] + b1[0], (v[i * 8 + 5] - mu) * rs * g1[1] + b1[1]), pack2((v[i * 8 + 6] - mu) * rs * g1[2] + b1[2], (v[i * 8 + 7] - mu) * rs * g1[3] + b1[3])};
    *(u32x4*)(yh + (size_t)t * DM + cb) = o;
  }
}

__device__ void d_cvt_w1f(size_t c, const float* __restrict__ w1, bf16_t* __restrict__ w1f) {
  const int lane = c & 63, ks = (c >> 6) & 255, ct = c >> 14;
  const int col = lane & 31, h = lane >> 5;
  bf16_t v[8];
#pragma unroll
  for (int j = 0; j < 8; ++j) v[j] = f2bf(w1[(size_t)(16 * ks + 8 * h + j) * 512 + 32 * ct + col]);
  u32x4 o; o.x = v[0] | ((unsigned)v[1] << 16); o.y = v[2] | ((unsigned)v[3] << 16); o.z = v[4] | ((unsigned)v[5] << 16); o.w = v[6] | ((unsigned)v[7] << 16);
  *(u32x4*)(w1f + c * 8) = o;
}
__device__ void d_cvt_w2f(size_t c, const float* __restrict__ w2, bf16_t* __restrict__ w2f) {
  const int lane = c & 63, s = (c >> 6) & 31, ct = c >> 11;
  const int col = lane & 31, h = lane >> 5;
  bf16_t v[8];
#pragma unroll
  for (int j = 0; j < 8; ++j) v[j] = f2bf(w2[(size_t)(16 * s + 8 * h + j) * 128 + 32 * ct + col]);
  u32x4 o; o.x = v[0] | ((unsigned)v[1] << 16); o.y = v[2] | ((unsigned)v[3] << 16); o.z = v[4] | ((unsigned)v[5] << 16); o.w = v[6] | ((unsigned)v[7] << 16);
  *(u32x4*)(w2f + c * 8) = o;
}
__device__ __forceinline__ void d_compress_unit(int rt, char* smem, const bf16_t* __restrict__ proj, int col0, const float* __restrict__ pos,
                                const bf16_t* __restrict__ w1f, const float* __restrict__ b1, const bf16_t* __restrict__ w2f,
                                bf16_t* __restrict__ outf, bool isV) {
  bf16_t* Xs = (bf16_t*)smem;
  bf16_t* Hs = (bf16_t*)(smem + 2 * 8704);
  const int tid = TIDX, lane = tid & 63, w = tid >> 6, c = lane & 31, h = lane >> 5;
  const int R0 = rt * 32;
  const int srow = tid >> 4, sch = tid & 15;
  const int grow = R0 + srow, sn = grow >> 1, sg = grow & 1;
  const bool svalid = grow < 2046;
  const bf16_t* sp = proj + (size_t)(16 * sn) * INWP + col0 + sg * 128 + sch * 8;
  f32x16 acc0, acc1;
#pragma unroll
  for (int i = 0; i < 16; ++i) { acc0[i] = 0.f; acc1[i] = 0.f; }
  u32x4 rx = {0u, 0u, 0u, 0u}; f32x4 rp0, rp1;
#define STAGE_WRITE(buf)                                                                                   \
  {                                                                                                        \
    u32x4 o_;                                                                                              \
    _Pragma("unroll") for (int i = 0; i < 4; ++i) {                                                        \
      const unsigned wv_ = rx[i];                                                                          \
      const float lo = __uint_as_float(wv_ << 16) + ((i < 2) ? rp0[2 * i] : rp1[2 * i - 4]);               \
      const float hi = __uint_as_float(wv_ & 0xFFFF0000u) + ((i < 2) ? rp0[2 * i + 1] : rp1[2 * i - 3]);   \
      o_[i] = pack2(lo, hi);                                                                               \
    }                                                                                                      \
    *(u32x4*)(Xs + (buf) * 4352 + srow * 136 + sch * 8) = o_;                                              \
  }
  if (svalid) rx = *(const u32x4*)(sp);
  rp0 = *(const f32x4*)(pos + sch * 8); rp1 = *(const f32x4*)(pos + sch * 8 + 4);
  STAGE_WRITE(0)
  __syncthreads();
  const bf16_t* wb0 = w1f + ((size_t)(2 * w) * 256 * 64 + lane) * 8;
  const bf16_t* wb1 = w1f + ((size_t)(2 * w + 1) * 256 * 64 + lane) * 8;
  bf16x8 bA[16], bB[16];
#define CMP_LOADB(BUF, L)                                                                      \
  _Pragma("unroll") for (int s8 = 0; s8 < 8; ++s8) {                                           \
    BUF[2 * s8] = *(const bf16x8*)(wb0 + (size_t)(8 * (L) + s8) * 512);                        \
    BUF[2 * s8 + 1] = *(const bf16x8*)(wb1 + (size_t)(8 * (L) + s8) * 512);                    \
  }
#define CMP_LOADX(L)                                                                           \
  if ((L) < 32) {     \
    if (svalid) rx = *(const u32x4*)(sp + (size_t)(L) * INWP);                                 \
    rp0 = *(const f32x4*)(pos + (L) * 128 + sch * 8); rp1 = *(const f32x4*)(pos + (L) * 128 + sch * 8 + 4); \
  }
#define CMP_CHUNK(BUF, L)                                                                      \
  {                                                                                            \
    const bf16_t* xa = Xs + ((L) & 1) * 4352 + c * 136 + 8 * h;                                \
    _Pragma("unroll") for (int s8 = 0; s8 < 8; ++s8) {                                         \
      const bf16x8 a = *(const bf16x8*)(xa + 16 * s8);                                         \
      acc0 = MFMA32(a, BUF[2 * s8], acc0);                                                     \
      acc1 = MFMA32(a, BUF[2 * s8 + 1], acc1);                                                 \
    }                                                                                          \
    if ((L) + 1 < 32) STAGE_WRITE(((L) + 1) & 1)                                               \
    __syncthreads();                                                                           \
  }
  CMP_LOADB(bA, 0)
#pragma unroll 1
  for (int l = 0; l < 32; l += 2) {
    CMP_LOADX(l + 1)
    CMP_LOADB(bB, l + 1)
    __builtin_amdgcn_sched_barrier(0);
    CMP_CHUNK(bA, l)
    __builtin_amdgcn_sched_barrier(0);
    CMP_LOADX(l + 2)
    { const int ln = (l + 2 < 32) ? l + 2 : l;
      CMP_LOADB(bA, ln) }
    __builtin_amdgcn_sched_barrier(0);
    CMP_CHUNK(bB, l + 1)
    __builtin_amdgcn_sched_barrier(0);
  }
#undef CMP_LOADX
#undef CMP_LOADB
#undef CMP_CHUNK
  {
    const float bb0 = b1[64 * w + c], bb1 = b1[64 * w + 32 + c];
#pragma unroll
    for (int rg = 0; rg < 16; ++rg) {
      const int row = (rg & 3) + 8 * (rg >> 2) + 4 * h;
      Hs[row * 520 + 64 * w + c] = f2bf(gelu_tanh(acc0[rg] + bb0));
      Hs[row * 520 + 64 * w + 32 + c] = f2bf(gelu_tanh(acc1[rg] + bb1));
    }
  }
  __syncthreads();
  if (w < 4) {
    f32x16 o2;
#pragma unroll
    for (int i = 0; i < 16; ++i) o2[i] = 0.f;
    const bf16_t* ha = Hs + c * 520 + 8 * h;
    const bf16_t* wb = w2f + ((size_t)w * 32 * 64 + lane) * 8;
#pragma unroll 8
    for (int s2 = 0; s2 < 32; ++s2) {
      const bf16x8 a = *(const bf16x8*)(ha + 16 * s2);
      const bf16x8 b = *(const bf16x8*)(wb + (size_t)s2 * 512);
      o2 = MFMA32(a, b, o2);
    }
    const int d = 32 * w + c;
#pragma unroll
    for (int rg = 0; rg < 16; ++rg) {
      const int row = R0 + (rg & 3) + 8 * (rg >> 2) + 4 * h;
      const int n = row >> 1, g = row & 1;
      const bf16_t val = (row < 2046) ? f2bf(o2[rg]) : (bf16_t)0;
      const int T = n >> 5, nn = n & 31;
      size_t idx;
      if (!isV) idx = ((((size_t)(g * 32 + T) * 8 + (d >> 4)) * 64 + (pi_perm(nn) + 32 * ((d >> 3) & 1))) * 8 + (d & 7));
      else idx = (((((size_t)(g * 32 + T) * 4 + (d >> 5)) * 2 + (nn >> 4)) * 64 + ((d & 31) + 32 * ((nn >> 3) & 1))) * 8 + (nn & 7));
      outf[idx] = val;
    }
  }
  __syncthreads();
}


DI unsigned f2sort(float f) { unsigned u = __float_as_uint(f); return u ^ ((unsigned)((int)u >> 31) | 0x80000000u); }
DI float sort2f(unsigned k) { unsigned u = (k & 0x80000000u) ? (k ^ 0x80000000u) : ~k; return __uint_as_float(u); }
template <int N>
DI void bitonic_sort_desc(unsigned (&key)[N]) {
#pragma unroll
  for (int k = 2; k <= N; k <<= 1) {
#pragma unroll
    for (int jj = k >> 1; jj > 0; jj >>= 1) {
#pragma unroll
      for (int i = 0; i < N; ++i) {
        const int l2 = i ^ jj;
        if (l2 > i) {
          const bool desc = ((i & k) == 0);
          unsigned a = key[i], b = key[l2];
          unsigned mx = a > b ? a : b, mn = a > b ? b : a;
          key[i] = desc ? mx : mn; key[l2] = desc ? mn : mx;
        }
      }
    }
  }
}
DI void merge_top16(unsigned (&a)[16], const unsigned (&b)[16]) {
#pragma unroll
  for (int i = 0; i < 16; ++i) { unsigned o = b[15 - i]; a[i] = a[i] > o ? a[i] : o; }
#pragma unroll
  for (int jj = 8; jj > 0; jj >>= 1) {
#pragma unroll
    for (int i = 0; i < 16; ++i) {
      const int l2 = i ^ jj;
      if (l2 > i) { unsigned x = a[i], y = a[l2]; a[i] = x > y ? x : y; a[l2] = x > y ? y : x; }
    }
  }
}
__device__ void d_cvt_subk(size_t c, const float* __restrict__ subk, bf16_t* __restrict__ skf) {
  int lane = c & 63, s = (c >> 6) & 7, kt = (c >> 9) & 3, hc = c >> 11;
  int i = lane & 31, h = lane >> 5;
  const float* src = subk + ((size_t)hc * 128 + 32 * kt + i) * 128 + 16 * s + 8 * h;
  bf16_t v[8];
#pragma unroll
  for (int j = 0; j < 8; ++j) v[j] = f2bf(src[j]);
  u32x4 o; o.x = v[0] | ((unsigned)v[1] << 16); o.y = v[2] | ((unsigned)v[3] << 16); o.z = v[4] | ((unsigned)v[5] << 16); o.w = v[6] | ((unsigned)v[7] << 16);
  *(u32x4*)(skf + c * 8) = o;
}

#define EPI_LANES()                                                                                                      \
    const int lane = fr | (fq << 4), rr = lane >> 2, rc = lane & 3;                                                       \
    PG8_LAS unsigned char* my = scr + (wr * 4 + wc) * 2048;                                                              \
    const int wo = fr * 64 + ((fq ^ ((fr >> 2) & 3)) << 4), ro = rr * 64 + ((rc ^ ((rr >> 2) & 3)) << 4);
struct EpiProjG {
  static constexpr bool PERM = true, AFTER_DRAIN = false;
  bf16_t* proj; float* gates; PG8_LAS unsigned char* scr;
  DI void operator()(const f32x4 (&acc)[2][2][4][2], const pg8::Unit& u, int wr, int wc, int fr, int fq) const {
    EPI_LANES()
#pragma unroll
    for (int ai = 0; ai < 2; ++ai)
#pragma unroll
      for (int bj = 0; bj < 2; ++bj) {
        const int c0 = u.pn * 256 + bj * 128 + wc * 32 + 8 * fq, cs = u.pn * 256 + bj * 128 + wc * 32 + 8 * rc;
#pragma unroll
        for (int mh = 0; mh < 2; ++mh) {
#pragma unroll
          for (int mm = 0; mm < 2; ++mm) {
            const f32x4 v0 = acc[ai][bj][mh * 2 + mm][0], v1 = acc[ai][bj][mh * 2 + mm][1];
            u32x4 w = {pack2(v0[0], v0[1]), pack2(v0[2], v0[3]), pack2(v1[0], v1[1]), pack2(v1[2], v1[3])};
            *(PG8_LAS u32x4*)(my + wo + mm * 1024) = w;
            if (c0 >= OFF_G && c0 < OFF_G + 24) {
              const int row = u.pm * 256 + ai * 128 + wr * 64 + (mh * 2 + mm) * 16 + fr;
              f32x4 g0, g1;
#pragma unroll
              for (int j = 0; j < 4; ++j) { g0[j] = 1.f / (1.f + __expf(-v0[j])); g1[j] = 1.f / (1.f + __expf(-v1[j])); }
              *(f32x4*)(gates + (size_t)row * 24 + (c0 - OFF_G)) = g0;
              *(f32x4*)(gates + (size_t)row * 24 + (c0 - OFF_G) + 4) = g1;
            }
          }
#pragma unroll
          for (int j = 0; j < 2; ++j) {
            const u32x4 w = *(const PG8_LAS u32x4*)(my + ro + j * 1024);
            const int row = u.pm * 256 + ai * 128 + wr * 64 + mh * 32 + j * 16 + rr;
            if (cs < INW) *(u32x4*)(proj + (size_t)row * INWP + cs) = w;
          }
        }
      }
  }
};
struct EpiResG {
  static constexpr bool PERM = true, AFTER_DRAIN = false;
  bf16_t* YB; PG8_LAS unsigned char* scr;
  DI void operator()(const f32x4 (&acc)[2][2][4][2], const pg8::Unit& u, int wr, int wc, int fr, int fq) const {
    EPI_LANES()
    bf16_t* yb = YB + (size_t)(u.pm * 256 + wr * 64 + rr) * DM + u.pn * 256 + wc * 32 + 8 * rc;
#pragma unroll
    for (int ai = 0; ai < 2; ++ai) {
      u32x4 xr[2][2][2];
#pragma unroll
      for (int bj = 0; bj < 2; ++bj)
#pragma unroll
        for (int mh = 0; mh < 2; ++mh)
#pragma unroll
          for (int j = 0; j < 2; ++j) xr[bj][mh][j] = *(const u32x4*)(yb + (size_t)(ai * 128 + mh * 32 + j * 16) * DM + bj * 128);
#pragma unroll
      for (int bj = 0; bj < 2; ++bj)
#pragma unroll
        for (int mh = 0; mh < 2; ++mh) {
#pragma unroll
          for (int mm = 0; mm < 2; ++mm) {
            const f32x4 v0 = acc[ai][bj][mh * 2 + mm][0], v1 = acc[ai][bj][mh * 2 + mm][1];
            u32x4 w = {pack2(v0[0], v0[1]), pack2(v0[2], v0[3]), pack2(v1[0], v1[1]), pack2(v1[2], v1[3])};
            *(PG8_LAS u32x4*)(my + wo + mm * 1024) = w;
          }
#pragma unroll
          for (int j = 0; j < 2; ++j) {
            const u32x4 a = *(const PG8_LAS u32x4*)(my + ro + j * 1024), xw = xr[bj][mh][j];
            u32x4 o;
#pragma unroll
            for (int q = 0; q < 4; ++q) {
              const unsigned aw = a[q], xq = xw[q];
              o[q] = pack2(fmaf(ALPHA, __uint_as_float(xq << 16), __uint_as_float(aw << 16)), fmaf(ALPHA, __uint_as_float(xq & 0xFFFF0000u), __uint_as_float(aw & 0xFFFF0000u)));
            }
            *(u32x4*)(yb + (size_t)(ai * 128 + mh * 32 + j * 16) * DM + bj * 128) = o;
          }
        }
    }
  }
};
struct EpiF32G {
  static constexpr bool PERM = false, AFTER_DRAIN = false;
  float* C; int ldc;
  DI void operator()(const f32x4 (&acc)[2][2][4][2], const pg8::Unit& u, int wr, int wc, int fr, int fq) const {
#pragma unroll
    for (int ai = 0; ai < 2; ++ai)
#pragma unroll
      for (int m = 0; m < 4; ++m) {
        const size_t ro = (size_t)(u.pm * 256 + ai * 128 + wr * 64 + m * 16 + fr) * ldc + u.pn * 256 + wc * 32 + 4 * fq;
#pragma unroll
        for (int bj = 0; bj < 2; ++bj)
#pragma unroll
          for (int n = 0; n < 2; ++n) *(f32x4*)(C + ro + bj * 128 + n * 16) = acc[ai][bj][m][n];
      }
  }
};
struct EpiRouteG {
  static constexpr bool PERM = false, AFTER_DRAIN = true;
  const bf16_t* skf; unsigned* tops;
  DI void operator()(const f32x4 (&)[2][2][4][2], const pg8::Unit&, int, int, int, int) const {}
  DI void fused(const f32x4 (&acc)[2][2][4][2], const pg8::Unit& u, int wr, int wc, int fr, int fq, PG8_LAS unsigned char* ldsp, int, int) const {
    const int lane = fr | (fq << 4), wid = wr * 4 + wc;
    bf16_t* Qs = (bf16_t*)ldsp;
#pragma unroll
    for (int ai = 0; ai < 2; ++ai)
#pragma unroll
      for (int m = 0; m < 4; ++m) {
        const int row = ai * 128 + wr * 64 + m * 16 + fr;
#pragma unroll
        for (int bj = 0; bj < 2; ++bj)
#pragma unroll
          for (int n = 0; n < 2; ++n) {
            const f32x4 v = acc[ai][bj][m][n];
            u32x2 w = {pack2(v[0], v[1]), pack2(v[2], v[3])};
            *(u32x2*)(Qs + row * 264 + bj * 128 + wc * 32 + n * 16 + 4 * fq) = w;
          }
      }
    __syncthreads();
    const int c = lane & 31, h = lane >> 5;
    unsigned kA[16], kB[16];
#pragma unroll 1
    for (int half = 0; half < 2; ++half) {
      const int hc = u.pn * 2 + half;
      const bf16_t* sk = skf + (size_t)hc * 4 * 4096;
      const bf16_t* qp = Qs + (wid * 32 + c) * 264 + half * 128 + 8 * h;
      unsigned k0[16], k1[16];
#define ROUTE_KT(KT, KA)                                                                        \
      {                                                                                         \
        f32x16 sc;                                                                              \
        _Pragma("unroll") for (int i = 0; i < 16; ++i) sc[i] = 0.f;                             \
        _Pragma("unroll") for (int s = 0; s < 8; ++s) {                                         \
          bf16x8 af = *(const bf16x8*)(sk + (KT) * 4096 + s * 512 + lane * 8);                  \
          bf16x8 bq = *(const bf16x8*)(qp + 16 * s);                                            \
          sc = __builtin_amdgcn_mfma_f32_32x32x16_bf16(af, bq, sc, 0, 0, 0);                    \
        }                                                                                       \
        _Pragma("unroll") for (int rg = 0; rg < 16; ++rg) {                                     \
          const int kidx = 32 * (KT) + (rg & 3) + 8 * (rg >> 2) + 4 * h;                        \
          KA[rg] = (f2sort(sc[rg]) & 0xFFFFFF80u) | (unsigned)(127 - kidx);                     \
        }                                                                                       \
        bitonic_sort_desc<16>(KA);                                                              \
      }
      ROUTE_KT(0, k0)
      __builtin_amdgcn_sched_barrier(0);
      ROUTE_KT(1, k1)
      merge_top16(k0, k1);
      __builtin_amdgcn_sched_barrier(0);
      ROUTE_KT(2, k1)
      merge_top16(k0, k1);
      __builtin_amdgcn_sched_barrier(0);
      ROUTE_KT(3, k1)
      merge_top16(k0, k1);
      __builtin_amdgcn_sched_barrier(0);
#undef ROUTE_KT
#pragma unroll
      for (int i = 0; i < 16; ++i) k1[i] = (unsigned)shx_i((int)k0[i], 32);
      merge_top16(k0, k1);
      if (half == 0) {
#pragma unroll
        for (int i = 0; i < 16; ++i) kA[i] = k0[i];
      } else {
#pragma unroll
        for (int i = 0; i < 16; ++i) kB[i] = k0[i];
      }
    }
    {
      unsigned* lk = (unsigned*)(ldsp + wid * 16896);
#pragma unroll
      for (int i = 0; i < 16; ++i) { lk[i * 64 + lane] = kA[i]; lk[(16 + i) * 64 + lane] = kB[i]; }
      float fa[16], fb[16];
#pragma unroll
      for (int i = 0; i < 16; ++i) { fa[i] = sort2f(kA[i]); fb[i] = sort2f(kB[i]); }
#define CAND(ci_, cj_) ((f2sort(fa[ci_] + fb[cj_]) & 0xFFFFFF00u) | (unsigned)(255 - ((ci_) * 16 + (cj_))))
      unsigned R0[16], R1[16], S1[16], S2[16];
#pragma unroll
      for (int j = 0; j < 16; ++j) { R0[j] = CAND(0, j); R1[j] = (j < 8) ? CAND(1, j & 7) : 0u; }
      S1[0] = CAND(2, 0); S1[1] = CAND(2, 1); S1[2] = CAND(2, 2); S1[3] = CAND(2, 3); S1[4] = CAND(2, 4);
      S1[5] = CAND(3, 0); S1[6] = CAND(3, 1); S1[7] = CAND(3, 2); S1[8] = CAND(3, 3);
      S1[9] = CAND(4, 0); S1[10] = CAND(4, 1); S1[11] = CAND(4, 2);
      S1[12] = CAND(5, 0); S1[13] = CAND(5, 1); S1[14] = CAND(6, 0); S1[15] = CAND(6, 1);
      S2[0] = CAND(7, 0); S2[1] = CAND(7, 1);
#pragma unroll
      for (int i = 8; i < 16; ++i) S2[i - 6] = CAND(i, 0);
#pragma unroll
      for (int i = 10; i < 16; ++i) S2[i] = 0u;
#undef CAND
      merge_top16(R0, R1);
      bitonic_sort_desc<16>(S1); bitonic_sort_desc<16>(S2);
      merge_top16(S1, S2);
      merge_top16(R0, S1);
      float sc[16]; unsigned ex[16]; float mx = -3.0e38f;
#pragma unroll
      for (int i = 0; i < 16; ++i) {
        const int flat = 255 - (int)(R0[i] & 255u);
        const unsigned ka = lk[(flat >> 4) * 64 + lane], kb = lk[(16 + (flat & 15)) * 64 + lane];
        sc[i] = sort2f(ka) + sort2f(kb);
        ex[i] = (127u - (ka & 127u)) * 128u + (127u - (kb & 127u));
        mx = fmaxf(mx, sc[i]);
      }
      float sm = 0.f;
#pragma unroll
      for (int i = 0; i < 16; ++i) { sc[i] = __expf(sc[i] - mx); sm += sc[i]; }
      const float rsm = 1.f / sm;
      unsigned* dst = tops + (size_t)(u.pm * 256 + wid * 32 + c) * 256 + h * 128 + u.pn * 16;
#pragma unroll
      for (int q4 = 0; q4 < 4; ++q4) {
        u32x4 o;
#pragma unroll
        for (int i = 0; i < 4; ++i) o[i] = h ? __float_as_uint(sc[4 * q4 + i] * rsm) : ex[4 * q4 + i];
        *(u32x4*)(dst + 4 * q4) = o;
      }
    }
    __syncthreads();
  }
};


template <int CTRL> DI float dpp_f(float v) { const int iv = __float_as_int(v); return __int_as_float(__builtin_amdgcn_update_dpp(iv, iv, CTRL, 0xF, 0xF, false)); }
DI float wsum(float x) {
  x += dpp_f<0xB1>(x);
  x += dpp_f<0x4E>(x);
  x += dpp_f<0x124>(x);
  x += dpp_f<0x128>(x);
  x += shx(x, 16);
  return hsum(x);
}
DI float gelu_fast(float x) {
  const float u2 = 1.5957691216057308f * (x + 0.044715f * x * x * x);
  return x * __builtin_amdgcn_rcpf(1.f + ex2(-LOG2E * u2));
}

constexpr int EROW = 1024;
typedef float v2f __attribute__((ext_vector_type(2)));
DI void d_cvt_fp4_fin(int row, const f32x4 (&x)[8], unsigned char* __restrict__ dst, float* __restrict__ scales) {
  const int lane = TIDX & 63;
  float v[32]; float amax = 0.f;
#pragma unroll
  for (int i = 0; i < 8; ++i)
#pragma unroll
    for (int j = 0; j < 4; ++j) { v[i * 4 + j] = x[i][j]; amax = fmaxf(amax, fabsf(x[i][j])); }
  amax = wave_max(amax);
  const float sc = amax > 0.f ? amax * (1.f / 7.f) : 1.f;
  const float inv = 1.f / sc;
  u32x4 o;
#pragma unroll
  for (int k = 0; k < 4; ++k) {
    unsigned w = 0u;
#define FP4C(x_) fminf(fmaxf((x_) * inv, -6.f), 6.f)
    w = __builtin_amdgcn_cvt_scalef32_pk_fp4_f32(w, FP4C(v[8 * k + 0]), FP4C(v[8 * k + 1]), 1.0f, 0);
    w = __builtin_amdgcn_cvt_scalef32_pk_fp4_f32(w, FP4C(v[8 * k + 2]), FP4C(v[8 * k + 3]), 1.0f, 1);
    w = __builtin_amdgcn_cvt_scalef32_pk_fp4_f32(w, FP4C(v[8 * k + 4]), FP4C(v[8 * k + 5]), 1.0f, 2);
    w = __builtin_amdgcn_cvt_scalef32_pk_fp4_f32(w, FP4C(v[8 * k + 6]), FP4C(v[8 * k + 7]), 1.0f, 3);
#undef FP4C
    o[k] = w;
  }
  *(u32x4*)(dst + (size_t)row * EROW + 16 * lane) = o;
  if (lane == 0) scales[row] = sc;
}
__device__ void d_cvt_fp4_row(int row, const float* __restrict__ src, unsigned char* __restrict__ dst, float* __restrict__ scales) {
  const int lane = TIDX & 63;
  f32x4 x[8];
#pragma unroll
  for (int i = 0; i < 8; ++i) x[i] = *(const f32x4*)(src + (size_t)row * DM + 256 * i + 4 * lane);
  d_cvt_fp4_fin(row, x, dst, scales);
}
DI void d_cvt_i4_fin(int row, const f32x4 (&x)[8], unsigned char* __restrict__ dst, float* __restrict__ scales) {
  const int lane = TIDX & 63;
  float v[32]; float amax = 0.f, ss = 0.f;
#pragma unroll
  for (int i = 0; i < 8; ++i)
#pragma unroll
    for (int j = 0; j < 4; ++j) { v[i * 4 + j] = x[i][j]; amax = fmaxf(amax, fabsf(x[i][j])); ss = fmaf(x[i][j], x[i][j], ss); }
  amax = wave_max(amax); ss = wave_sum(ss);
  float sc = fmaxf(0.36f * sqrtf(ss * (1.f / DM)), amax * (1.f / 14.f));
  sc = sc > 0.f ? sc : 1.f;
  const float inv = 1.f / sc;
  u32x4 o;
#pragma unroll
  for (int k = 0; k < 4; ++k) {
    unsigned w = 0u;
#pragma unroll
    for (int j = 0; j < 8; ++j) {
      const float q = fminf(fmaxf(v[8 * k + j] * inv, -7.f), 7.f) + 12582912.f;
      w |= (__float_as_uint(q) & 15u) << (4 * j);
    }
    o[k] = w;
  }
  *(u32x4*)(dst + (size_t)row * EROW + 16 * lane) = o;
  if (lane == 0) scales[row] = sc;
}
__device__ void d_cvt_i4_row(int row, const float* __restrict__ src, unsigned char* __restrict__ dst, float* __restrict__ scales) {
  const int lane = TIDX & 63;
  f32x4 x[8];
#pragma unroll
  for (int i = 0; i < 8; ++i) x[i] = *(const f32x4*)(src + (size_t)row * DM + 256 * i + 4 * lane);
  d_cvt_i4_fin(row, x, dst, scales);
}
__device__ void d_expert_group(int tg0, int tstr, unsigned* tpl, unsigned* slw, const bf16_t* __restrict__ hbuf, const unsigned* __restrict__ tops,
                               const unsigned char* __restrict__ eu4, const unsigned char* __restrict__ ev4, const float* __restrict__ esu, const float* __restrict__ esv,
                               const float* __restrict__ gam, const float* __restrict__ bet, float* __restrict__ out) {
  const int lane = TIDX & 63;
#define SLOT(j_, f_) slw[((j_) * 16 + (f_)) * 64 + lane]
#pragma unroll 1
  for (int j = 0; j < 4; ++j) {
    const int tt = tg0 + j * tstr, t = tt < S ? tt : S - 1;
  float hv[32];
#pragma unroll
  for (int i = 0; i < 8; ++i) {
    const u32x2 w = *(const u32x2*)(hbuf + (size_t)t * DM + 256 * i + 4 * lane);
    hv[i * 4 + 0] = __uint_as_float(w[0] << 16); hv[i * 4 + 1] = __uint_as_float(w[0] & 0xFFFF0000u);
    hv[i * 4 + 2] = __uint_as_float(w[1] << 16); hv[i * 4 + 3] = __uint_as_float(w[1] & 0xFFFF0000u);
  }
  int e0 = (int)tops[(size_t)t * 256 + lane], e1 = (int)tops[(size_t)t * 256 + 64 + lane];
  float w0 = __uint_as_float(tops[(size_t)t * 256 + 128 + lane]), w1 = __uint_as_float(tops[(size_t)t * 256 + 192 + lane]);
  {
    unsigned k0 = ((unsigned)e0 << 7) | (unsigned)lane, k1 = ((unsigned)e1 << 7) | (unsigned)(64 + lane);
#pragma unroll
    for (int k = 2; k <= 128; k <<= 1) {
#pragma unroll
      for (int jj = k >> 1; jj > 0; jj >>= 1) {
        if (jj == 64) { const unsigned mn = k0 < k1 ? k0 : k1, mx = k0 < k1 ? k1 : k0; k0 = mn; k1 = mx; }
        else {
          const unsigned o0 = (unsigned)shx_i((int)k0, jj), o1 = (unsigned)shx_i((int)k1, jj);
          const bool lower = (lane & jj) == 0;
          const bool asc0 = (k >= 64) ? true : ((lane & k) == 0), asc1 = (k == 128) ? true : (k == 64) ? false : ((lane & k) == 0);
          const unsigned mn0 = k0 < o0 ? k0 : o0, mx0 = k0 < o0 ? o0 : k0, mn1 = k1 < o1 ? k1 : o1, mx1 = k1 < o1 ? o1 : k1;
          k0 = (lower == asc0) ? mn0 : mx0; k1 = (lower == asc1) ? mn1 : mx1;
        }
      }
    }
    const int o0 = (int)(k0 & 127u), o1 = (int)(k1 & 127u);
    const float wa0 = __shfl(w0, o0 & 63), wb0 = __shfl(w1, o0 & 63), wa1 = __shfl(w0, o1 & 63), wb1 = __shfl(w1, o1 & 63);
    e0 = (int)(k0 >> 7); e1 = (int)(k1 >> 7); w0 = (o0 < 64) ? wa0 : wb0; w1 = (o1 < 64) ? wa1 : wb1;
  }
  int hhi[4], hlo[4]; float hsc;
  {
    float m = 0.f;
#pragma unroll
    for (int i = 0; i < 32; ++i) m = fmaxf(m, fabsf(hv[i]));
    m = wave_max(m);
    hsc = m > 0.f ? m * (1.f / 119.f) : 1.f;
    const float hinv = 1.f / hsc;
#pragma unroll
    for (int q = 0; q < 4; ++q) {
      unsigned wh = 0u, wl = 0u;
#pragma unroll
      for (int j = 0; j < 8; ++j) {
        const unsigned b = __float_as_uint(fmaf(hv[8 * q + j], hinv, 12582912.f));
        wl |= (b & 15u) << (4 * j); wh |= (((b + 8u) >> 4) & 15u) << (4 * j);
      }
      hhi[q] = (int)wh; hlo[q] = (int)wl;
    }
  }
    const float su0 = esu[e0], su1 = esu[e1], sv0 = esv[e0], sv1 = esv[e1];
#pragma unroll
    for (int q = 0; q < 4; ++q) { SLOT(j, q) = (unsigned)hhi[q]; SLOT(j, 4 + q) = (unsigned)hlo[q]; }
    SLOT(j, 8) = (unsigned)e0; SLOT(j, 9) = (unsigned)e1;
    SLOT(j, 10) = __float_as_uint(hsc * su0); SLOT(j, 11) = __float_as_uint(hsc * su1);
    SLOT(j, 12) = __float_as_uint(w0 * sv0); SLOT(j, 13) = __float_as_uint(w1 * sv1);
  }
  u32x4 rA[4], rB[4];
  const unsigned lo16 = (unsigned)(16 * lane);
#define G_LOAD(R, TAB, EX, LB)                                                             \
  _Pragma("unroll") for (int k = 0; k < 4; ++k) {                                          \
    const int id = __builtin_amdgcn_readlane((EX), (LB) + k);                              \
    R[k] = *(const u32x4*)((TAB) + (size_t)id * EROW + lo16);                              \
  }
#define PKFMA(a_, b_, c_) __builtin_elementwise_fma((a_), (b_), (c_))
  const int srcb = 4 * (((lane & 1) << 5) | ((lane & 2) << 3));
#define G_COMP_U(R, LB)                                                                    \
  {                                                                                        \
    int dd[4];                                                                             \
    _Pragma("unroll") for (int k = 0; k < 4; ++k) {                                        \
      int dh = 0, dl = 0;                                                                  \
      _Pragma("unroll") for (int q = 0; q < 4; ++q) {                                      \
        dh = __builtin_amdgcn_sdot8((int)R[k][q], hhi[q], dh, false);                      \
        dl = __builtin_amdgcn_sdot8((int)R[k][q], hlo[q], dl, false);                      \
      }                                                                                    \
      dd[k] = dh * 16 + dl;                                                                \
      __builtin_amdgcn_sched_barrier(0);                                                   \
    }                                                                                      \
    unsigned t01, t23;                                                                     \
    { auto r_ = __builtin_amdgcn_permlane32_swap((unsigned)dd[0], (unsigned)dd[1], false, false); t01 = r_[0] + r_[1]; }     \
    { auto r_ = __builtin_amdgcn_permlane32_swap((unsigned)dd[2], (unsigned)dd[3], false, false); t23 = r_[0] + r_[1]; }     \
    const bool b4_ = (lane & 16) != 0;                                                     \
    int tv = (int)(b4_ ? t23 : t01) + shx_i((int)(b4_ ? t01 : t23), 16);                   \
    tv += dpp_i<0x128>(tv); tv += dpp_i<0x124>(tv); tv += dpp_i<0x4E>(tv); tv += dpp_i<0xB1>(tv);   \
    const int got = __builtin_amdgcn_ds_bpermute(srcb, tv);                                \
    cc = ((unsigned)(lane - (LB)) < 4u) ? got : cc;                                        \
    __builtin_amdgcn_sched_barrier(0);                                                     \
  }
#define G_COMP_V(R, ACC, CF, LB)                                                           \
  _Pragma("unroll") for (int k = 0; k < 4; ++k) {                                          \
    const float cs = __int_as_float(__builtin_amdgcn_readlane(__float_as_int(CF), (LB) + k));   \
    const v2f cs2 = {cs, cs};                                                              \
    _Pragma("unroll") for (int q = 0; q < 4; ++q) {                                        \
      const unsigned wq = R[k][q];                                                         \
      const v2f f0 = __builtin_amdgcn_cvt_scalef32_pk_f32_fp4(wq, 1.0f, 0), f1 = __builtin_amdgcn_cvt_scalef32_pk_f32_fp4(wq, 1.0f, 1); \
      const v2f f2 = __builtin_amdgcn_cvt_scalef32_pk_f32_fp4(wq, 1.0f, 2), f3 = __builtin_amdgcn_cvt_scalef32_pk_f32_fp4(wq, 1.0f, 3); \
      ACC[4 * q + 0] = PKFMA(cs2, f0, ACC[4 * q + 0]); ACC[4 * q + 1] = PKFMA(cs2, f1, ACC[4 * q + 1]); \
      ACC[4 * q + 2] = PKFMA(cs2, f2, ACC[4 * q + 2]); ACC[4 * q + 3] = PKFMA(cs2, f3, ACC[4 * q + 3]); \
    }                                                                                      \
    __builtin_amdgcn_sched_barrier(0);                                                     \
  }
  {
    int eX = (int)SLOT(0, 8);
    G_LOAD(rA, eu4, eX, 0)
    __builtin_amdgcn_sched_barrier(0);
#pragma unroll 1
    for (int s_ = 0; s_ < 32; ++s_) {
      const int sg = s_ >> 2, j = s_ & 3, L0 = (sg & 3) * 16;
      const int sn = (s_ + 1) & 31, sgn = sn >> 2, jn = sn & 3, L0n = (sgn & 3) * 16;
      if (j == 0) __builtin_amdgcn_s_barrier();
      int hhi[4], hlo[4];
#pragma unroll
      for (int q = 0; q < 4; ++q) { hhi[q] = (int)SLOT(j, q); hlo[q] = (int)SLOT(j, 4 + q); }
      const int eXn = (int)SLOT(jn, 8 + (sgn >> 2));
      const unsigned char* tabn = (s_ == 31) ? ev4 : eu4;
      int cc = 0;
      G_LOAD(rB, eu4, eX, L0 + 4)
      __builtin_amdgcn_sched_barrier(0);
      G_COMP_U(rA, L0)
      G_LOAD(rA, eu4, eX, L0 + 8)
      __builtin_amdgcn_sched_barrier(0);
      G_COMP_U(rB, L0 + 4)
      G_LOAD(rB, eu4, eX, L0 + 12)
      __builtin_amdgcn_sched_barrier(0);
      G_COMP_U(rA, L0 + 8)
      G_LOAD(rA, tabn, eXn, L0n)
      __builtin_amdgcn_sched_barrier(0);
      G_COMP_U(rB, L0 + 12)
      if ((unsigned)(lane - L0) < 16u) SLOT(j, 14 + (sg >> 2)) = (unsigned)cc;
      eX = eXn;
    }
  }
#pragma unroll 1
  for (int j = 0; j < 4; ++j) {
    const float d0 = (float)(int)SLOT(j, 14), d1 = (float)(int)SLOT(j, 15);
    SLOT(j, 14) = __float_as_uint(__uint_as_float(SLOT(j, 12)) * gelu_fast(__uint_as_float(SLOT(j, 10)) * d0));
    SLOT(j, 15) = __float_as_uint(__uint_as_float(SLOT(j, 13)) * gelu_fast(__uint_as_float(SLOT(j, 11)) * d1));
  }
  v2f accv[4][16];
#pragma unroll
  for (int j = 0; j < 4; ++j)
#pragma unroll
    for (int i = 0; i < 16; ++i) accv[j][i] = v2f{0.f, 0.f};
  {
    int eX = (int)SLOT(0, 8);
#pragma unroll 1
    for (int sg = 0; sg < 8; ++sg) {
      const int L0 = (sg & 3) * 16;
      __builtin_amdgcn_s_barrier();
#pragma unroll
      for (int j = 0; j < 4; ++j) {
        const int jn = (j + 1) & 3, sgn = (j == 3) ? ((sg + 1) & 7) : sg, L0n = (sgn & 3) * 16;
        const float cf = __uint_as_float(SLOT(j, 14 + (sg >> 2)));
        const int eXn = (int)SLOT(jn, 8 + (sgn >> 2));
        G_LOAD(rB, ev4, eX, L0 + 4)
        __builtin_amdgcn_sched_barrier(0);
        G_COMP_V(rA, accv[j], cf, L0)
        G_LOAD(rA, ev4, eX, L0 + 8)
        __builtin_amdgcn_sched_barrier(0);
        G_COMP_V(rB, accv[j], cf, L0 + 4)
        G_LOAD(rB, ev4, eX, L0 + 12)
        __builtin_amdgcn_sched_barrier(0);
        G_COMP_V(rA, accv[j], cf, L0 + 8)
        G_LOAD(rA, ev4, eXn, L0n)
        __builtin_amdgcn_sched_barrier(0);
        G_COMP_V(rB, accv[j], cf, L0 + 12)
        eX = eXn;
      }
    }
  }
#undef G_LOAD
#undef G_COMP_U
#undef G_COMP_V
#undef PKFMA
#pragma unroll
  for (int j = 0; j < 4; ++j) {
    const int t = tg0 + j * tstr;
    if (t < S) {
#define acc2 accv[j]
  float acc[32];
  #pragma unroll
    for (int i = 0; i < 16; ++i) { acc[2 * i] = acc2[i].x; acc[2 * i + 1] = acc2[i].y; }
    int le = lane;
    asm volatile("" : "+v"(le) :: "memory");
    float s = 0.f;
  #pragma unroll
    for (int i = 0; i < 8; ++i) {
      const u32x2 w = *(const u32x2*)(hbuf + (size_t)t * DM + 256 * i + 4 * le);
      const float h0 = __uint_as_float(w[0] << 16), h1 = __uint_as_float(w[0] & 0xFFFF0000u), h2 = __uint_as_float(w[1] << 16), h3 = __uint_as_float(w[1] & 0xFFFF0000u);
      acc[i * 4 + 0] = fmaf(ALPHA, h0, acc[i * 4 + 0]); acc[i * 4 + 1] = fmaf(ALPHA, h1, acc[i * 4 + 1]);
      acc[i * 4 + 2] = fmaf(ALPHA, h2, acc[i * 4 + 2]); acc[i * 4 + 3] = fmaf(ALPHA, h3, acc[i * 4 + 3]);
      s += (acc[i * 4 + 0] + acc[i * 4 + 1]) + (acc[i * 4 + 2] + acc[i * 4 + 3]);
    }
    s = wsum(s);
    const float mu = s * (1.f / DM);
    float qv = 0.f;
  #pragma unroll
    for (int i = 0; i < 32; ++i) { const float d = acc[i] - mu; qv += d * d; }
    qv = wsum(qv);
    const float rs = rsqrtf(qv * (1.f / DM) + 1e-5f);
  #pragma unroll
    for (int i = 0; i < 8; ++i) {
      const int cbase = 256 * i + 4 * le;
      f32x4 ga = *(const f32x4*)(gam + cbase), ba = *(const f32x4*)(bet + cbase), o;
  #pragma unroll
      for (int j = 0; j < 4; ++j) o[j] = (acc[i * 4 + j] - mu) * rs * ga[j] + ba[j];
      *(f32x4*)(out + (size_t)t * DM + cbase) = o;
    }
#undef acc2
    }
  }
#undef SLOT
}

constexpr size_t al256(size_t x) { return (x + 255) & ~(size_t)255; }
constexpr size_t WS_XB = 0;
constexpr size_t WS_PROJ = WS_XB + al256((size_t)S * DM * 2);
constexpr size_t WS_WINT = WS_PROJ + al256((size_t)S * INWP * 2);
constexpr size_t WS_GATES = WS_WINT + al256((size_t)INWG * DM * 2);
constexpr size_t WS_W1KF = WS_GATES + al256((size_t)S * 24 * 4);
constexpr size_t WS_W1VF = WS_W1KF + al256((size_t)512 * 4096 * 2);
constexpr size_t WS_W2KF = WS_W1VF + al256((size_t)512 * 4096 * 2);
constexpr size_t WS_W2VF = WS_W2KF + al256((size_t)512 * 128 * 2);
constexpr size_t WS_VC = WS_W2VF + al256((size_t)512 * 128 * 2) - al256((size_t)2048 * 128 * 4);
constexpr size_t WS_KCF = WS_VC + al256((size_t)2048 * 128 * 4);
constexpr size_t WS_VCF = WS_KCF + al256((size_t)2 * 32 * 4096 * 2);
constexpr size_t WS_KSF = WS_VCF + al256((size_t)2 * 32 * 4096 * 2);
constexpr size_t WS_VSF = WS_KSF + al256((size_t)2 * 512 * 4096 * 2);
constexpr size_t WS_KWF = WS_VSF + al256((size_t)2 * 512 * 4096 * 2);
constexpr size_t WS_VWF = WS_KWF + al256((size_t)2 * 512 * 4096 * 2);
constexpr size_t WS_ENDA = WS_VWF + al256((size_t)2 * 512 * 4096 * 2);
constexpr size_t WS_OATT = WS_ENDA;
constexpr size_t WS_MIX = WS_OATT + al256((size_t)S * 1024 * 4);
constexpr size_t WS_WOUTT = WS_MIX + al256((size_t)S * DM * 2);
constexpr size_t WS_WQT = WS_WOUTT + al256((size_t)DM * DM * 2);
constexpr size_t WS_TOPS = WS_WQT + al256((size_t)DM * DM * 2);
constexpr size_t WS_SKF = WS_TOPS + al256((size_t)S * 256 * 4);
constexpr size_t WS_STATS = WS_SKF + al256((size_t)16 * 128 * 128 * 2);
constexpr size_t WS_CTRL = WS_STATS + al256((size_t)S * 2 * 4);
constexpr size_t CTRL_BYTES = 32768;
constexpr size_t WS_END = WS_CTRL + CTRL_BYTES;
constexpr size_t WS_Y = WS_PROJ;
constexpr size_t WS_HB = WS_XB;
constexpr size_t WS_EU8 = WS_OATT;
constexpr size_t WS_EV8 = WS_EU8 + (size_t)16384 * 1024;
constexpr size_t WS_ESU = WS_EV8 + (size_t)16384 * 1024;
constexpr size_t WS_ESV = WS_ESU + 16384 * 4;
static_assert(WS_ESV + 16384 * 4 <= WS_MIX, "expert tables overflow their region");
constexpr int EXP_EARLY = 6144;
static_assert(WS_END <= (size_t)512 * 1024 * 1024, "workspace over 512 MiB");

struct Params {
  const float *x, *w_in, *ck_pos, *ck_w1, *ck_b1, *ck_w2, *cv_pos, *cv_w1, *cv_b1, *cv_w2, *conv_w, *hng, *w_out, *ln1g, *ln1b, *w_query, *subk,
      *eu, *ev, *ln2g, *ln2b;
  float* out;
  char* ws;
};
#define WSP(T, OFF) ((T*)(p.ws + (OFF)))

#define FOR_VB(n) for (int vb = blockIdx.x; vb < (n); vb += gridDim.x)
#define FOR_VB2(n) for (int vb = blockIdx.x * 2 + (TIDX >> 8); vb < (n); vb += gridDim.x * 2)
constexpr int SMEM_BYTES = 147456;
constexpr int HALF = 36864;

__global__ void __launch_bounds__(512) mega(Params p) {
  __shared__ __attribute__((aligned(16))) char smem[SMEM_BYTES + 16];
  if (TIDX == 0) *(u32x4*)(smem + SMEM_BYTES) = u32x4{0u, 0u, 0u, 0u};
  __syncthreads();
  const XcdBarrier xbar = xcd_barrier_post(WSP(unsigned, WS_CTRL + 1024), (volatile LAS unsigned*)(smem + SMEM_BYTES));
#define smh (smem + (TIDX >> 8) * HALF)
#define wv ((TIDX >> 6))
  constexpr int NWV = 8;
  d_cvt(p.x, WSP(bf16_t, WS_XB), (size_t)S * DM / 4);
  FOR_VB2((INWG / 64) * (DM / 64)) d_cvtT64(vb, smh, p.w_in, WSP(bf16_t, WS_WINT), DM, INW, INWG);
  for (size_t c = (size_t)blockIdx.x * 512 + TIDX; c < (size_t)16 * 256 * 64; c += (size_t)gridDim.x * 512) {
    d_cvt_w1f(c, p.ck_w1, WSP(bf16_t, WS_W1KF)); d_cvt_w1f(c, p.cv_w1, WSP(bf16_t, WS_W1VF));
    if (c < (size_t)4 * 32 * 64) { d_cvt_w2f(c, p.ck_w2, WSP(bf16_t, WS_W2KF)); d_cvt_w2f(c, p.cv_w2, WSP(bf16_t, WS_W2VF)); }
  }
  FOR_VB2((DM / 64) * (DM / 64)) d_cvtT64(vb, smh, p.w_out, WSP(bf16_t, WS_WOUTT), DM, DM, DM);
  FOR_VB2((DM / 64) * (DM / 64)) d_cvtT64(vb, smh, p.w_query, WSP(bf16_t, WS_WQT), DM, DM, DM);
  for (size_t c = (size_t)blockIdx.x * 512 + TIDX; c < (size_t)16 * 4 * 8 * 64; c += (size_t)gridDim.x * 512) d_cvt_subk(c, p.subk, WSP(bf16_t, WS_SKF));
  xcd_barrier(xbar);
  {
    pg8::StaticOrder so; so.init(S, INWG, gridDim.x, blockIdx.x);
    pg8::gemm_phase<EpiProjG, pg8::StaticOrder>((PG8_LAS unsigned char*)smem, pg8::Gemm{WSP(bf16_t, WS_XB), WSP(bf16_t, WS_WINT), S, INWG, DM}, so,
                                                EpiProjG{WSP(bf16_t, WS_PROJ), WSP(float, WS_GATES), (PG8_LAS unsigned char*)smem + pg8::STAGE_BYTES}, nullptr);
    const int nun = (S / 256) * (INWG / 256), gsz = (int)gridDim.x;
    const int nfull = nun % gsz;
    if (nfull != 0 && (int)blockIdx.x >= nfull) {
      const int nidle = gsz - nfull, me = (int)blockIdx.x - nfull;
      for (int r = me * NWV + wv; r < 2 * EXP_EARLY; r += nidle * NWV) {
        if (r < EXP_EARLY) d_cvt_i4_row(r, p.eu, WSP(unsigned char, WS_EU8), WSP(float, WS_ESU)); else d_cvt_fp4_row(r - EXP_EARLY, p.ev, WSP(unsigned char, WS_EV8), WSP(float, WS_ESV));
      }
    }
  }
  xcd_barrier(xbar);
  {
    if (blockIdx.x < 128) {
      const int xcd_ = blockIdx.x & 7, idx_ = blockIdx.x >> 3; const bool isV = (xcd_ & 1) != 0;
      d_compress_unit((xcd_ >> 1) * 16 + idx_, smem, WSP(bf16_t, WS_PROJ), isV ? OFF_VC : OFF_KC, isV ? p.cv_pos : p.ck_pos, isV ? WSP(bf16_t, WS_W1VF) : WSP(bf16_t, WS_W1KF),
                      isV ? p.cv_b1 : p.ck_b1, isV ? WSP(bf16_t, WS_W2VF) : WSP(bf16_t, WS_W2KF), isV ? WSP(bf16_t, WS_VCF) : WSP(bf16_t, WS_KCF), isV);
    }
    int* slot = (int*)smem;
    unsigned* ctr = WSP(unsigned, WS_CTRL);
    for (;;) {
      if (TIDX == 0) *slot = (int)atomicAdd(ctr, 1u);
      __syncthreads();
      const int it = *slot;
      __syncthreads();
      if (it >= 2048) break;
      const int tt = TIDX;
      {
        const int T = it >> 2, which = it & 3;
        d_relayout_tile(T, smem + 64, WSP(bf16_t, WS_PROJ), (which == 0) ? OFF_KS : (which == 1) ? OFF_VS : (which == 2) ? OFF_KW : OFF_VW,
                        (which == 0) ? WSP(bf16_t, WS_KSF) : (which == 1) ? WSP(bf16_t, WS_VSF) : (which == 2) ? WSP(bf16_t, WS_KWF) : WSP(bf16_t, WS_VWF), (which & 1) != 0);
      }
      for (int q = 0; q < 2; ++q) d_convmix(it * 8 + q * 4 + (tt >> 7), tt & 127, WSP(bf16_t, WS_PROJ), p.conv_w, p.hng, WSP(bf16_t, WS_MIX));
    }
  }
  xcd_barrier(xbar);
  {
    AttnPtrs ap{WSP(bf16_t, WS_PROJ), WSP(float, WS_GATES), WSP(bf16_t, WS_KCF), WSP(bf16_t, WS_VCF), WSP(bf16_t, WS_KSF), WSP(bf16_t, WS_VSF), WSP(bf16_t, WS_KWF), WSP(bf16_t, WS_VWF), WSP(bf16_t, WS_MIX), p.hng};
    for (int it = blockIdx.x; it < 512; it += gridDim.x) {
      const int Bq = (it < 256) ? it : (511 - it), gq = (it < 256) ? 0 : 1;
      d_attn_block(Bq, gq, smem, ap);
    }
  }
  xcd_barrier(xbar);
  {
    pg8::StaticOrder so; so.init(S, DM, gridDim.x, blockIdx.x);
    pg8::gemm_phase<EpiResG, pg8::StaticOrder>((PG8_LAS unsigned char*)smem, pg8::Gemm{WSP(bf16_t, WS_MIX), WSP(bf16_t, WS_WOUTT), S, DM, DM}, so,
                                               EpiResG{WSP(bf16_t, WS_HB), (PG8_LAS unsigned char*)smem + pg8::STAGE_BYTES}, nullptr);
  }
  xcd_barrier(xbar);
  {
    const int e0_ = (((S / 256) * (INWG / 256)) % (int)gridDim.x != 0) ? EXP_EARLY : 0;
    const int nrest = 16384 - e0_, ncv = 2 * nrest, wstr = (int)gridDim.x * NWV, lane_ = TIDX & 63;
    int rl = blockIdx.x * NWV + wv, rc = rl;
    u32x4 lcur[4], lnxt[4]; f32x4 ccur[8], cnxt[8];
#define P8_LDLN(R, r_) { _Pragma("unroll") for (int i = 0; i < 4; ++i) R[i] = *(const u32x4*)(WSP(bf16_t, WS_HB) + (size_t)(r_) * DM + 512 * i + 8 * lane_); }
#define P8_LDCV(R, r_) { const float* src_ = ((r_) < nrest) ? p.eu + (size_t)(e0_ + (r_)) * DM : p.ev + (size_t)(e0_ + (r_) - nrest) * DM; \
                         _Pragma("unroll") for (int i = 0; i < 8; ++i) R[i] = *(const f32x4*)(src_ + 256 * i + 4 * lane_); }
    if (rl < S) P8_LDLN(lcur, rl)
    if (rc < ncv) P8_LDCV(ccur, rc)
#pragma unroll 1
    while (rl < S || rc < ncv) {
      const int rln = rl + wstr, rcn = rc + wstr;
      if (rln < S) P8_LDLN(lnxt, rln)
      if (rcn < ncv) P8_LDCV(cnxt, rcn)
      __builtin_amdgcn_sched_barrier(0);
      if (rl < S) d_ln_fin(rl, lcur, WSP(bf16_t, WS_HB), p.ln1g, p.ln1b);
      if (rc < ncv) {
        if (rc < nrest) d_cvt_i4_fin(e0_ + rc, ccur, WSP(unsigned char, WS_EU8), WSP(float, WS_ESU));
        else d_cvt_fp4_fin(e0_ + rc - nrest, ccur, WSP(unsigned char, WS_EV8), WSP(float, WS_ESV));
      }
      __builtin_amdgcn_sched_barrier(0);
#pragma unroll
      for (int i = 0; i < 4; ++i) lcur[i] = lnxt[i];
#pragma unroll
      for (int i = 0; i < 8; ++i) ccur[i] = cnxt[i];
      rl = rln; rc = rcn;
    }
#undef P8_LDLN
#undef P8_LDCV
  }
  xcd_barrier(xbar);
  for (int k = 0; k * (int)gridDim.x < (S / 256) * (DM / 256); ++k) {
    pg8::OneUnit so; so.init(S, DM, gridDim.x, blockIdx.x); so.k = k;
    pg8::gemm_phase<EpiRouteG, pg8::OneUnit>((PG8_LAS unsigned char*)smem, pg8::Gemm{WSP(bf16_t, WS_HB), WSP(bf16_t, WS_WQT), S, DM, DM}, so,
                                             EpiRouteG{WSP(bf16_t, WS_SKF), WSP(unsigned, WS_TOPS)}, nullptr);
    __syncthreads();
  }
  xcd_barrier(xbar);
  {
    const int tstr = (int)gridDim.x * NWV;
    for (int tg0 = blockIdx.x * NWV + wv; tg0 < S; tg0 += 4 * tstr)
      d_expert_group(tg0, tstr, (unsigned*)(smem + wv * 1024), (unsigned*)(smem + 8192 + wv * 16384), WSP(bf16_t, WS_HB), WSP(unsigned, WS_TOPS), WSP(unsigned char, WS_EU8), WSP(unsigned char, WS_EV8),
                     WSP(float, WS_ESU), WSP(float, WS_ESV), p.ln2g, p.ln2b, p.out);
  }
}

extern "C" void kernel_launch(void* const* d_in, const int* in_sizes, int n_in, void* d_out, int out_size, void* d_ws, size_t ws_size,
                              hipStream_t stream) {
  Params p{};
  p.x = (const float*)d_in[0]; p.w_in = (const float*)d_in[1]; p.ck_pos = (const float*)d_in[2]; p.ck_w1 = (const float*)d_in[3];
  p.ck_b1 = (const float*)d_in[4]; p.ck_w2 = (const float*)d_in[5]; p.cv_pos = (const float*)d_in[6]; p.cv_w1 = (const float*)d_in[7];
  p.cv_b1 = (const float*)d_in[8]; p.cv_w2 = (const float*)d_in[9]; p.conv_w = (const float*)d_in[10]; p.hng = (const float*)d_in[11];
  p.w_out = (const float*)d_in[12]; p.ln1g = (const float*)d_in[13]; p.ln1b = (const float*)d_in[14]; p.w_query = (const float*)d_in[15];
  p.subk = (const float*)d_in[16]; p.eu = (const float*)d_in[17]; p.ev = (const float*)d_in[18]; p.ln2g = (const float*)d_in[19];
  p.ln2b = (const float*)d_in[20];
  p.out = (float*)d_out;
  p.ws = (char*)d_ws;
  if (ws_size < WS_END) fprintf(stderr, "workspace too small\n");
  static int grid_blocks = 0;
  if (!grid_blocks) {
    int dev = 0, cus = 0, per_cu = 0;
    hipGetDevice(&dev);
    hipDeviceGetAttribute(&cus, hipDeviceAttributeMultiprocessorCount, dev);
    hipOccupancyMaxActiveBlocksPerMultiprocessor(&per_cu, mega, 512, 0);
    if (per_cu > 1) per_cu = 1;
    if (per_cu < 1) per_cu = 1;
    grid_blocks = cus * per_cu;
  }
  hipMemsetAsync((char*)d_ws + WS_CTRL, 0, CTRL_BYTES, stream);
  void* args[] = {&p};
  hipError_t e = hipLaunchCooperativeKernel((void*)mega, dim3(grid_blocks), dim3(512), args, 0, stream);
  if (e != hipSuccess) fprintf(stderr, "cooperative launch failed: %s (grid %d)\n", hipGetErrorString(e), grid_blocks);
}
```

```cpp
#include <hip/hip_runtime.h>
#include <stdint.h>
#include <stdio.h>


#define DI __device__ __forceinline__
static __device__ __forceinline__ int tidx_() { int t = (int)__builtin_amdgcn_workitem_id_x(); asm volatile("" : "+v"(t)); return t; }
#define TIDX (tidx_())

template <int J> DI int swz_xor(int x) { return __builtin_amdgcn_ds_swizzle(x, (J << 10) | 0x1F); }
template <int CTRL> DI int dpp_i(int x) { return __builtin_amdgcn_update_dpp(x, x, CTRL, 0xF, 0xF, false); }
DI int shx_i(int x, int j) {
  switch (j) {
    case 1: return dpp_i<0xB1>(x);
    case 2: return dpp_i<0x4E>(x);
    case 4: return dpp_i<0x1B>(dpp_i<0x141>(x));
    case 8: return dpp_i<0x128>(x);
    case 16: return swz_xor<16>(x);
    default: {
      auto r = __builtin_amdgcn_permlane32_swap((unsigned)x, (unsigned)x, false, false);
      return (TIDX & 32) ? (int)r[0] : (int)r[1];
    }
  }
}
DI float shx(float x, int j) { return __int_as_float(shx_i(__float_as_int(x), j)); }
typedef unsigned short bf16_t;
using bf16x8 = __attribute__((ext_vector_type(8))) short;
using f32x4 = __attribute__((ext_vector_type(4))) float;
using u32x4 = __attribute__((ext_vector_type(4))) unsigned;
using u32x2 = __attribute__((ext_vector_type(2))) unsigned;

constexpr int S = 16384, DM = 2048, HD = 128;
constexpr int INW = 5656, INWP = 5760, INWG = 5888;
constexpr int OFF_Q = 0, OFF_KC = 1024, OFF_VC = 1280, OFF_KS = 1536, OFF_VS = 1792, OFF_KW = 2048, OFF_VW = 2304,
              OFF_G = 2560, OFF_U = 2584, OFF_B = 3608, OFF_C = 4632;
constexpr int NCMP = 1023;
constexpr float ALPHA = 1.189207115002721f;
constexpr float QSCALE = 0.08838834764831845f;

DI bf16_t f2bf(float x) { unsigned u = __float_as_uint(x); u += 0x7fffu + ((u >> 16) & 1u); return (bf16_t)(u >> 16); }
DI float bf2f(bf16_t b) { return __uint_as_float(((unsigned)b) << 16); }
DI float gelu_tanh(float x) { float u = 0.7978845608028654f * (x + 0.044715f * x * x * x); return 0.5f * x * (1.f + tanhf(u)); }
DI float wave_sum(float v) { for (int o = 32; o > 0; o >>= 1) v += shx(v, o); return v; }
using bf16x2v = __attribute__((ext_vector_type(2))) __bf16;
DI unsigned pack2(float a, float b) { bf16x2v v = {(__bf16)a, (__bf16)b}; return __builtin_bit_cast(unsigned, v); }
DI float wave_max(float v) { for (int o = 32; o > 0; o >>= 1) v = fmaxf(v, shx(v, o)); return v; }

namespace pg8 {
#define PG8_LAS __attribute__((address_space(3)))
typedef unsigned short bf16_t;
typedef short bf16x8 __attribute__((ext_vector_type(8)));
typedef float f32x4 __attribute__((ext_vector_type(4)));
typedef unsigned u32x4 __attribute__((ext_vector_type(4)));
constexpr int BM = 256, BK = 64, HALF = 128, HTB = HALF * BK * 2  , STAGE_BYTES = 8 * HTB, NXCD = 8, WGM = 8;

__host__ __device__ __forceinline__ int lds_byte(int r, int c) { const int st = (r >> 4) * 2 + (c >> 5), rr = r & 15, cc = c & 31, ob = rr * 64 + cc * 2; return st * 1024 + (ob ^ (((ob >> 9) & 1) << 5)); }
__host__ __device__ __forceinline__ void stage_rc(int b, int& R, int& C) { const int st = b / 1024, sb = b % 1024, swz = sb ^ (((sb >> 9) & 1) << 5); R = (st >> 1) * 16 + swz / 64; C = (st & 1) * 32 + (swz % 64) / 2; }
__host__ __device__ __forceinline__ int perm32(int rho) { const int n = rho >> 4, i = rho & 15; return 8 * (i >> 2) + 4 * n + (i & 3); }

struct Unit { int pm, pn; };
struct Gemm { const bf16_t* A; const bf16_t* Bt; int M, N, K; };

struct StaticOrder {
    int nM, nN, nwg, G, c;
    __host__ __device__ void init(int M, int N, int G_, int c_) { nM = M / BM; nN = N / BM; nwg = nM * nN; G = G_; c = c_; }
    __host__ __device__ bool next(int i, Unit& u) const {
        const long L = (long)i * G + c; if (L >= nwg) return false;
        int wgid = (int)L; { const int q = nwg / NXCD, r = nwg % NXCD, xcd = wgid % NXCD, off = wgid / NXCD; wgid = (xcd < r ? xcd * (q + 1) : r * (q + 1) + (xcd - r) * q) + off; }
        const int nig = WGM * nN, gid = wgid / nig, fm = gid * WGM, gsz = (nM - fm) < WGM ? (nM - fm) : WGM;
        u.pm = fm + ((wgid % nig) % gsz); u.pn = (wgid % nig) / gsz; return true;
    }
    __device__ __forceinline__ void a_ready(const Unit&) const {}
    __device__ __forceinline__ void done(const Unit&) const {}
};
struct OneUnit : StaticOrder {
    int k;
    __device__ bool next(int i, Unit& u) const { if (i > 0) return false; return StaticOrder::next(k, u); }
};
__device__ __forceinline__ unsigned cvt_pk_bf16(float lo, float hi) { unsigned r; asm volatile("v_cvt_pk_bf16_f32 %0, %1, %2" : "=v"(r) : "v"(lo), "v"(hi)); return r; }
template <class Epi, class Sched, bool STAMP = false>
__device__ __forceinline__ void gemm_phase(PG8_LAS unsigned char* lds, const Gemm g, const Sched& S, const Epi& E, unsigned long long* stamps) {
    const int tid = TIDX, wid = __builtin_amdgcn_readfirstlane(tid >> 6), lane = tid & 63, wr = wid >> 2, wc = wid & 3, fr = lane & 15, fq = lane >> 4;
    const int K = g.K, nt = K / BK;
    int ts_lo = 0, ts_hi = 0, nts = 0; const unsigned long long rt_entry = STAMP ? (unsigned long long)wall_clock64() : 0ull;
#define PG8_STAMP() do { if (STAMP && wid == 0 && nts < 64) { const unsigned long long _c = (unsigned long long)clock64(); \
        ts_lo = (lane == nts) ? (int)(unsigned)_c : ts_lo; ts_hi = (lane == nts) ? (int)(unsigned)(_c >> 32) : ts_hi; ++nts; } } while (0)
    PG8_STAMP();
    unsigned voffA[2], voffB[2];
#pragma unroll
    for (int i = 0; i < 2; ++i) { int R, C; stage_rc(tid * 16 + i * 8192, R, C); const int Rb = Epi::PERM ? ((R & ~31) + perm32(R & 31)) : R;
        voffA[i] = (unsigned)(R * K + C) * 2u; voffB[i] = (unsigned)(Rb * K + C) * 2u; }
    const size_t kstep = (size_t)(BK * 2);
    const size_t hstep = (size_t)HALF * K * 2;
    const size_t tstep = 2 * hstep;
    const unsigned ldsw = (unsigned)wid * 1024u;
    const int aoff = lds_byte(wr * 64 + fr, fq * 8), boff = lds_byte(wc * 32 + fr, fq * 8);
#define PG8_SA(b, h) (((b) * 2 + (h)) * HTB)
#define PG8_SB(b, h) ((4 + (b) * 2 + (h)) * HTB)
#define PG8_STAGE(bufoff, gbase, voff) do { _Pragma("unroll") for (int _i = 0; _i < 2; ++_i) \
        __builtin_amdgcn_global_load_lds((const unsigned*)((const char*)(gbase) + (voff)[_i]), (PG8_LAS unsigned*)(lds + (bufoff) + ldsw + _i * 8192), 16, 0, 0); } while (0)
#define PG8_LDA(dst, b, h) do { _Pragma("unroll") for (int m = 0; m < 4; ++m) _Pragma("unroll") for (int k = 0; k < 2; ++k) dst[m][k] = *(const PG8_LAS bf16x8*)(lds + PG8_SA(b, h) + aoff + m * 2048 + k * 1024); } while (0)
#define PG8_LDB(dst, b, h) do { _Pragma("unroll") for (int n = 0; n < 2; ++n) _Pragma("unroll") for (int k = 0; k < 2; ++k) dst[n][k] = *(const PG8_LAS bf16x8*)(lds + PG8_SB(b, h) + boff + n * 2048 + k * 1024); } while (0)
#define PG8_MMA(ai, bj, At, Bt) do { __builtin_amdgcn_s_setprio(1); _Pragma("unroll") for (int m = 0; m < 4; ++m) _Pragma("unroll") for (int n = 0; n < 2; ++n) _Pragma("unroll") for (int k = 0; k < 2; ++k) \
        acc[ai][bj][m][n] = __builtin_amdgcn_mfma_f32_16x16x32_bf16(Bt[n][k], At[m][k], acc[ai][bj][m][n], 0, 0, 0); __builtin_amdgcn_s_setprio(0); } while (0)
#define PG8_WAIT_V(n) asm volatile("s_waitcnt vmcnt(" #n ")" ::: "memory")
#define PG8_WAIT_L(n) asm volatile("s_waitcnt lgkmcnt(" #n ")" ::: "memory")
#define PG8_BAR __builtin_amdgcn_s_barrier()
#define PG8_SCHED __builtin_amdgcn_sched_barrier(0)
    Unit cur, nxt; int ui = 0;
    if (!S.next(0, cur)) return;
    f32x4 acc[2][2][4][2];
#pragma unroll
    for (int a = 0; a < 2; ++a)
#pragma unroll
        for (int b = 0; b < 2; ++b)
#pragma unroll
            for (int m = 0; m < 4; ++m)
#pragma unroll
                for (int n = 0; n < 2; ++n) acc[a][b][m][n] = (f32x4){0.f, 0.f, 0.f, 0.f};
    bf16x8 At[4][2], B0[2][2], B1[2][2];
    const char* cA = (const char*)g.A + (size_t)cur.pm * tstep; const char* cB = (const char*)g.Bt + (size_t)cur.pn * tstep;
    S.a_ready(cur);
    PG8_STAGE(PG8_SB(0, 0), cB, voffB); PG8_STAGE(PG8_SA(0, 0), cA, voffA); PG8_STAGE(PG8_SB(0, 1), cB + hstep, voffB); PG8_STAGE(PG8_SA(0, 1), cA + hstep, voffA);
    if (wr == 1) PG8_BAR;
    PG8_WAIT_V(4); PG8_BAR;
    PG8_STAGE(PG8_SB(1, 0), cB + kstep, voffB); PG8_STAGE(PG8_SA(1, 0), cA + kstep, voffA); PG8_STAGE(PG8_SB(1, 1), cB + hstep + kstep, voffB);
    PG8_WAIT_V(6); PG8_BAR;
    PG8_STAMP();
    for (;;) {
        const bool has_next = S.next(ui + 1, nxt);
        const char* nA = has_next ? (const char*)g.A + (size_t)nxt.pm * tstep : cA; const char* nB = has_next ? (const char*)g.Bt + (size_t)nxt.pn * tstep : cB;
        for (int t = 0; t < nt; t += 2) {
            const bool last = (t == nt - 2);
            const char* a1 = cA + (size_t)(t + 1) * kstep;
            const char* a2 = last ? nA : cA + (size_t)(t + 2) * kstep; const char* b2 = last ? nB : cB + (size_t)(t + 2) * kstep;
            const char* a3 = a2 + kstep; const char* b3 = b2 + kstep;
            if (last && has_next) S.a_ready(nxt);
            PG8_LDB(B0, 0, 0); PG8_SCHED; PG8_LDA(At, 0, 0); PG8_STAGE(PG8_SA(1, 1), a1 + hstep, voffA);
            PG8_WAIT_L(8); PG8_BAR; PG8_WAIT_L(0); PG8_MMA(0, 0, At, B0); PG8_BAR; PG8_SCHED;
            PG8_LDB(B1, 0, 1); PG8_STAGE(PG8_SB(0, 0), b2, voffB);
            PG8_BAR; PG8_WAIT_L(0); PG8_MMA(0, 1, At, B1); PG8_BAR;
            PG8_LDA(At, 0, 1); PG8_STAGE(PG8_SA(0, 0), a2, voffA);
            PG8_BAR; PG8_WAIT_L(0); PG8_MMA(1, 0, At, B0); PG8_BAR; PG8_SCHED;
            PG8_STAGE(PG8_SB(0, 1), b2 + hstep, voffB);
            PG8_WAIT_V(6); PG8_BAR; PG8_MMA(1, 1, At, B1); PG8_BAR;
            PG8_LDB(B0, 1, 0); PG8_SCHED; PG8_LDA(At, 1, 0); PG8_STAGE(PG8_SA(0, 1), a2 + hstep, voffA);
            PG8_WAIT_L(8); PG8_BAR; PG8_WAIT_L(0); PG8_MMA(0, 0, At, B0); PG8_BAR; PG8_SCHED;
            PG8_LDB(B1, 1, 1); PG8_STAGE(PG8_SB(1, 0), b3, voffB);
            PG8_BAR; PG8_WAIT_L(0); PG8_MMA(0, 1, At, B1); PG8_BAR;
            PG8_LDA(At, 1, 1); PG8_STAGE(PG8_SA(1, 0), a3, voffA);
            PG8_BAR; PG8_WAIT_L(0); PG8_MMA(1, 0, At, B0); PG8_BAR; PG8_SCHED;
            PG8_STAGE(PG8_SB(1, 1), b3 + hstep, voffB);
            PG8_WAIT_V(6); PG8_BAR; PG8_MMA(1, 1, At, B1); PG8_BAR;
        }
        PG8_STAMP();
        if constexpr (!Epi::AFTER_DRAIN) { E(acc, cur, wr, wc, fr, fq); S.done(cur); }
        PG8_STAMP();
        if (!has_next) break;
#pragma unroll
        for (int a = 0; a < 2; ++a)
#pragma unroll
            for (int b = 0; b < 2; ++b)
#pragma unroll
                for (int m = 0; m < 4; ++m)
#pragma unroll
                    for (int n = 0; n < 2; ++n) acc[a][b][m][n] = (f32x4){0.f, 0.f, 0.f, 0.f};
        cur = nxt; cA = nA; cB = nB; ++ui;
    }
    PG8_WAIT_V(0);
    if (wr == 0) PG8_BAR;
    PG8_BAR;
    if constexpr (Epi::AFTER_DRAIN) { E.fused(acc, cur, wr, wc, fr, fq, lds, wid, lane); S.done(cur); }
    PG8_STAMP();
    if (STAMP && wid == 0) { stamps[lane] = lane < nts ? (((unsigned long long)(unsigned)ts_hi << 32) | (unsigned)ts_lo) : 0ull;
        if (lane == 62) stamps[62] = rt_entry; if (lane == 63) stamps[63] = (unsigned long long)wall_clock64(); }
#undef PG8_STAMP
#undef PG8_SA
#undef PG8_SB
#undef PG8_STAGE
#undef PG8_LDA
#undef PG8_LDB
#undef PG8_MMA
#undef PG8_WAIT_V
#undef PG8_WAIT_L
#undef PG8_BAR
#undef PG8_SCHED
}
}

#define XB_TMO      128
#define XB_XCNT(j)  (256  + 64 * (j))
#define XB_XSUB(j)  (1280 + 64 * (j))
#define XB_XGEN(j)  (2304 + 64 * (j))
#define XB_TOP      3328
#define XB_TOPGEN   3392
#define XCD_BAR_WORDS 3456
#define XB_SPIN_CAP (1u << 18)
#define LAS __attribute__((address_space(3)))

__device__ __forceinline__ unsigned xb_ld(unsigned* p)              { return __hip_atomic_load(p, __ATOMIC_RELAXED, __HIP_MEMORY_SCOPE_AGENT); }
__device__ __forceinline__ unsigned xb_add(unsigned* p, unsigned v) { return __hip_atomic_fetch_add(p, v, __ATOMIC_RELAXED, __HIP_MEMORY_SCOPE_AGENT); }
__device__ __forceinline__ unsigned xb_xcc_id() { return (unsigned)__builtin_amdgcn_s_getreg((3 << 11) | 20) & 0xFu; }
#define XB_SPIN(cond, bar) do { unsigned _sp = 0; while (cond) { __builtin_amdgcn_s_sleep(1); \
    if ((++_sp & 255u) == 0u) { if (xb_ld(&(bar)[XB_TMO])) break; if (_sp > XB_SPIN_CAP) { atomicAdd(&(bar)[XB_TMO], 1u); break; } } } } while (0)

struct XcdBarrier {
    unsigned* bar; unsigned x;
    volatile LAS unsigned* st;
};

__device__ __forceinline__ XcdBarrier xcd_barrier_post(unsigned* bar, volatile LAS unsigned* st) {
    XcdBarrier b; b.bar = bar; b.x = xb_xcc_id(); b.st = st;
    if (TIDX == 0) (void)xb_add(&bar[XB_XCNT(b.x)], 1u);
    return b;
}
__device__ __forceinline__ void xcd_barrier_complete(unsigned* bar, unsigned x, unsigned& nloc, unsigned& nx) {
    const unsigned G = gridDim.x * gridDim.y * gridDim.z;
    unsigned sum, cnt, mine, sp = 0u;
    for (;;) {
        sum = 0u; cnt = 0u; mine = 0u;
#pragma unroll
        for (unsigned j = 0; j < 16; ++j) { const unsigned c = xb_ld(&bar[XB_XCNT(j)]); sum += c; cnt += (c > 0u) ? 1u : 0u; mine = (j == x) ? c : mine; }
        if (sum == G) break;
        __builtin_amdgcn_s_sleep(1);
        if ((++sp & 255u) == 0u) { if (xb_ld(&bar[XB_TMO])) break; if (sp > XB_SPIN_CAP) { atomicAdd(&bar[XB_TMO], 1u); break; } }
    }
    nloc = mine > 0u ? mine : 1u; nx = cnt > 0u ? cnt : 1u;
}

__device__ __forceinline__ void xcd_barrier(const XcdBarrier& b) {
    asm volatile("s_waitcnt vmcnt(0)" ::: "memory");
    __syncthreads();
    if (TIDX == 0) {
        unsigned* bar = b.bar;
        __builtin_amdgcn_s_waitcnt(0);
        unsigned nloc = b.st[0], nx = b.st[1];
        if (nloc == 0u) { xcd_barrier_complete(bar, b.x, nloc, nx); b.st[0] = nloc; b.st[1] = nx; }
        const unsigned old = xb_add(&bar[XB_XSUB(b.x)], 1u);
        const unsigned gen = old / nloc;
        if (old + 1u == (gen + 1u) * nloc) {
            __builtin_amdgcn_fence(__ATOMIC_RELEASE, "agent");
            asm volatile("s_waitcnt vmcnt(0)" ::: "memory");
            const unsigned og = xb_add(&bar[XB_TOP], 1u);
            const unsigned tg = og / nx;
            if (og + 1u == (tg + 1u) * nx) xb_add(&bar[XB_TOPGEN], 1u);
            else XB_SPIN(xb_ld(&bar[XB_TOPGEN]) == tg, bar);
            __builtin_amdgcn_fence(__ATOMIC_ACQUIRE, "agent");
            xb_add(&bar[XB_XGEN(b.x)], 1u);
            asm volatile("s_waitcnt vmcnt(0)" ::: "memory");
        } else {
            XB_SPIN(xb_ld(&bar[XB_XGEN(b.x)]) == gen, bar);
            __builtin_amdgcn_fence(__ATOMIC_ACQUIRE, "agent");
            asm volatile("s_waitcnt vmcnt(0)" ::: "memory");
        }
    }
    __syncthreads();
}

__device__ void d_cvt(const float* __restrict__ in, bf16_t* __restrict__ out, size_t n4) {
  const size_t stride = (size_t)gridDim.x * blockDim.x;
  size_t i = (size_t)blockIdx.x * blockDim.x + TIDX;
  for (; i + 3 * stride < n4; i += 4 * stride) {
    f32x4 v[4];
#pragma unroll
    for (int q = 0; q < 4; ++q) v[q] = ((const f32x4*)in)[i + q * stride];
#pragma unroll
    for (int q = 0; q < 4; ++q) { u32x2 o = {pack2(v[q][0], v[q][1]), pack2(v[q][2], v[q][3])}; ((u32x2*)out)[i + q * stride] = o; }
  }
  for (; i < n4; i += stride) { const f32x4 v = ((const f32x4*)in)[i]; u32x2 o = {pack2(v[0], v[1]), pack2(v[2], v[3])}; ((u32x2*)out)[i] = o; }
}
__device__ void d_cvtT64(int vb, char* smem, const float* __restrict__ W, bf16_t* __restrict__ WT, int K, int N, int NP) {
  float (*tt)[65] = (float (*)[65])smem;
  const int tid = (TIDX & 255);
  const int nbx = NP / 64;
  const int n0 = (vb % nbx) * 64, k0 = (vb / nbx) * 64;
  {
    const int kr = tid >> 4, nc = (tid & 15) * 4;
#pragma unroll
    for (int i = 0; i < 4; ++i) {
      const int k = k0 + kr + 16 * i, n = n0 + nc;
      f32x4 v = {0.f, 0.f, 0.f, 0.f};
      if (n < N) v = *(const f32x4*)(W + (size_t)k * N + n);
      tt[kr + 16 * i][nc] = v[0]; tt[kr + 16 * i][nc + 1] = v[1]; tt[kr + 16 * i][nc + 2] = v[2]; tt[kr + 16 * i][nc + 3] = v[3];
    }
  }
  __syncthreads();
  {
    const int nr = tid >> 3, kc = (tid & 7) * 8;
#pragma unroll
    for (int i = 0; i < 2; ++i) {
      const int nl = nr + 32 * i;
      u32x4 o = {pack2(tt[kc][nl], tt[kc + 1][nl]), pack2(tt[kc + 2][nl], tt[kc + 3][nl]), pack2(tt[kc + 4][nl], tt[kc + 5][nl]), pack2(tt[kc + 6][nl], tt[kc + 7][nl])};
      *(u32x4*)(WT + (size_t)(n0 + nl) * K + k0 + kc) = o;
    }
  }
  __syncthreads();
}

using f32x16 = __attribute__((ext_vector_type(16))) float;
using bf16x8v = __attribute__((ext_vector_type(8))) __bf16;
#define MFMA32(a, b, c) __builtin_amdgcn_mfma_f32_32x32x16_bf16((a), (b), (c), 0, 0, 0)
constexpr float LOG2E = 1.4426950408889634f;
constexpr float NEGB = -1e30f;
DI int pi_perm(int i) { return (i & ~12) | ((i & 8) >> 1) | ((i & 4) << 1); }
DI bf16x8 pack8(float a0, float a1, float a2, float a3, float a4, float a5, float a6, float a7) {
  bf16x8v v = {(__bf16)a0, (__bf16)a1, (__bf16)a2, (__bf16)a3, (__bf16)a4, (__bf16)a5, (__bf16)a6, (__bf16)a7};
  return __builtin_bit_cast(bf16x8, v);
}
__device__ __forceinline__ void d_relayout_tile(int T, char* smem, const bf16_t* __restrict__ proj, int col0, bf16_t* __restrict__ dst, bool isV) {
  bf16_t* Ls = (bf16_t*)smem;
  const int tid = TIDX;
#pragma unroll
  for (int q = 0; q < 2; ++q) {
    const int cidx = tid + q * 512;
    const int g = cidx >> 9, tok = (cidx >> 4) & 31, ch = cidx & 15;
    const u32x4 v = *(const u32x4*)(proj + (size_t)(32 * T + tok) * INWP + col0 + g * 128 + ch * 8);
    *(u32x4*)(Ls + (g * 32 + tok) * 136 + ch * 8) = v;
  }
  __syncthreads();
#pragma unroll
  for (int q = 0; q < 2; ++q) {
    const int oc = tid + q * 512;
    const int g = oc >> 9, r9 = oc & 511, lane = r9 & 63;
    u32x4 o;
    if (!isV) {
      const int s8 = r9 >> 6, i = lane & 31, h = lane >> 5;
      o = *(const u32x4*)(Ls + (g * 32 + pi_perm(i)) * 136 + 16 * s8 + 8 * h);
    } else {
      const int s2 = (r9 >> 6) & 1, dt = r9 >> 7, dd = lane & 31, h = lane >> 5;
      const bf16_t* col = Ls + (g * 32 + 16 * s2 + 8 * h) * 136 + 32 * dt + dd;
      unsigned short e[8];
#pragma unroll
      for (int j = 0; j < 8; ++j) e[j] = col[j * 136];
      o.x = e[0] | ((unsigned)e[1] << 16); o.y = e[2] | ((unsigned)e[3] << 16); o.z = e[4] | ((unsigned)e[5] << 16); o.w = e[6] | ((unsigned)e[7] << 16);
    }
    *(u32x4*)(dst + (((size_t)(g * 512 + T)) * 512 + r9) * 8) = o;
  }
  __syncthreads();
}

struct AttnPtrs {
  const bf16_t* proj; const float* gates;
  const bf16_t *kcf, *vcf, *ksf, *vsf, *kwf, *vwf;
  bf16_t* mix; const float* hng;
};

DI float ex2(float x) { return __builtin_amdgcn_exp2f(x); }
DI void halves(float x, float& lo, float& hi) {
  const unsigned u = __float_as_uint(x);
  auto r = __builtin_amdgcn_permlane32_swap(u, u, false, false);
  lo = __uint_as_float(r[0]); hi = __uint_as_float(r[1]);
}
DI float hmax(float x) { float a, b; halves(x, a, b); return fmaxf(a, b); }
DI float hsum(float x) { float a, b; halves(x, a, b); return a + b; }
DI float dpp_quad(float v, int ctrl_is_xor1) {
  const int iv = __float_as_int(v);
  const int r = ctrl_is_xor1 ? __builtin_amdgcn_update_dpp(iv, iv, 0xB1, 0xF, 0xF, false) : __builtin_amdgcn_update_dpp(iv, iv, 0x4E, 0xF, 0xF, false);
  return __int_as_float(r);
}
DI float quad_sum(float v) { v += dpp_quad(v, 1); v += dpp_quad(v, 0); return v; }
DI void osm_step(const float (&sv)[16], float& m, float& l, f32x16 (&O)[4], float (&p)[16]) {
  float tmax = fmaxf(fmaxf(fmaxf(sv[0], sv[1]), fmaxf(sv[2], sv[3])), fmaxf(fmaxf(sv[4], sv[5]), fmaxf(sv[6], sv[7])));
  tmax = fmaxf(tmax, fmaxf(fmaxf(fmaxf(sv[8], sv[9]), fmaxf(sv[10], sv[11])), fmaxf(fmaxf(sv[12], sv[13]), fmaxf(sv[14], sv[15]))));
  tmax = hmax(tmax);
  if (__ballot(tmax - m > 8.f)) {
    const float mn = fmaxf(m, tmax);
    const float alpha = ex2(m - mn);
    l *= alpha; m = mn;
#pragma unroll
    for (int dt = 0; dt < 4; ++dt)
#pragma unroll
      for (int r = 0; r < 16; ++r) O[dt][r] *= alpha;
  }
  float ps0 = 0.f, ps1 = 0.f;
#pragma unroll
  for (int r = 0; r < 16; r += 2) { const float e0 = ex2(sv[r] - m), e1 = ex2(sv[r + 1] - m); p[r] = e0; p[r + 1] = e1; ps0 += e0; ps1 += e1; }
  l += ps0 + ps1;
}
DI void ot_store(char* otL, int lane, const f32x16 (&O)[4], float sc) {
#pragma unroll
  for (int dt = 0; dt < 4; ++dt) {
    u32x4 a, b;
#pragma unroll
    for (int i = 0; i < 4; ++i) { a[i] = pack2(sc * O[dt][2 * i], sc * O[dt][2 * i + 1]); b[i] = pack2(sc * O[dt][8 + 2 * i], sc * O[dt][8 + 2 * i + 1]); }
    *(u32x4*)(otL + lane * 128 + dt * 32) = a;
    *(u32x4*)(otL + lane * 128 + dt * 32 + 16) = b;
  }
}
DI void ot_accum(const char* otL, int lane, f32x16 (&O)[4], float sc) {
#pragma unroll
  for (int dt = 0; dt < 4; ++dt) {
    u32x4 a = *(const u32x4*)(otL + lane * 128 + dt * 32);
    u32x4 b = *(const u32x4*)(otL + lane * 128 + dt * 32 + 16);
#pragma unroll
    for (int i = 0; i < 4; ++i) {
      const unsigned wa = a[i], wb = b[i];
      O[dt][2 * i] = fmaf(sc, O[dt][2 * i], __uint_as_float(wa << 16));
      O[dt][2 * i + 1] = fmaf(sc, O[dt][2 * i + 1], __uint_as_float(wa & 0xFFFF0000u));
      O[dt][8 + 2 * i] = fmaf(sc, O[dt][8 + 2 * i], __uint_as_float(wb << 16));
      O[dt][8 + 2 * i + 1] = fmaf(sc, O[dt][8 + 2 * i + 1], __uint_as_float(wb & 0xFFFF0000u));
    }
  }
}
DI void zero_o(f32x16 (&O)[4]) {
#pragma unroll
  for (int dt = 0; dt < 4; ++dt)
#pragma unroll
    for (int i = 0; i < 16; ++i) O[dt][i] = 0.f;
}

constexpr int ATT_PW = 8704;
constexpr int ATT_R = 4, ATT_D = 3;
constexpr int ATT_RING = 8 * ATT_PW;
constexpr int ATT_LIST = ATT_RING + ATT_R * 16384;
constexpr int ATT_BUNI = ATT_LIST + 2048;
constexpr int ATT_SMEM = ATT_BUNI + 64;
#define LAS3 __attribute__((address_space(3)))
__device__ __forceinline__ void d_select(const float* impL, unsigned* mskL, unsigned* uniL, int cur) {
  const int lane = TIDX & 63;
  const int stok = lane >> 3, sub = lane & 7;
  unsigned key[32];
#pragma unroll
  for (int i4 = 0; i4 < 8; ++i4) {
    f32x4 v = *(const f32x4*)(impL + stok * 256 + sub * 32 + i4 * 4);
#pragma unroll
    for (int e = 0; e < 4; ++e) {
      const int j = sub * 32 + i4 * 4 + e;
      const bool valid = j <= cur;
      const bool forced = (j == 0) || (j == cur) || (j == cur - 1);
      unsigned kb = forced ? 0xFFFFFF00u : (__float_as_uint(v[e]) & 0xFFFFFF00u);
      key[i4 * 4 + e] = valid ? (kb | (unsigned)(255 - j)) : 0u;
    }
  }
#pragma unroll
  for (int k = 2; k <= 32; k <<= 1) {
#pragma unroll
    for (int jj = k >> 1; jj > 0; jj >>= 1) {
#pragma unroll
      for (int i = 0; i < 32; ++i) {
        const int l2 = i ^ jj;
        if (l2 > i) {
          const bool desc = ((i & k) == 0);
          unsigned a = key[i], b = key[l2];
          unsigned mx = a > b ? a : b, mn = a > b ? b : a;
          key[i] = desc ? mx : mn; key[l2] = desc ? mn : mx;
        }
      }
    }
  }
#pragma unroll
  for (int xm = 1; xm < 8; xm <<= 1) {
    unsigned L[16];
#pragma unroll
    for (int i = 0; i < 16; ++i) { unsigned o = (unsigned)shx_i((int)key[15 - i], xm); L[i] = key[i] > o ? key[i] : o; }
#pragma unroll
    for (int jj = 8; jj > 0; jj >>= 1) {
#pragma unroll
      for (int i = 0; i < 16; ++i) {
        const int l2 = i ^ jj;
        if (l2 > i) { unsigned a = L[i], b = L[l2]; L[i] = a > b ? a : b; L[l2] = a > b ? b : a; }
      }
    }
#pragma unroll
    for (int i = 0; i < 16; ++i) key[i] = L[i];
  }
#pragma unroll
  for (int i = 0; i < 16; ++i) {
    if ((i & 7) == sub) {
      const int j = 255 - (int)(key[i] & 255u);
      if (j <= cur) { atomicOr(&mskL[stok * 8 + (j >> 5)], 1u << (j & 31)); atomicOr(&uniL[j >> 5], 1u << (j & 31)); }
    }
  }
}


DI void att_issue(LAS3 unsigned char* ring, int slot, int w, int lane, const bf16_t* kb, const bf16_t* vb, int tile) {
  const char* ks = (const char*)kb + (size_t)tile * 8192 + w * 1024 + lane * 16;
  const char* vs = (const char*)vb + (size_t)tile * 8192 + w * 1024 + lane * 16;
  __builtin_amdgcn_global_load_lds((const unsigned*)ks, (LAS3 unsigned*)(ring + slot * 16384 + w * 1024), 16, 0, 0);
  __builtin_amdgcn_global_load_lds((const unsigned*)vs, (LAS3 unsigned*)(ring + slot * 16384 + 8192 + w * 1024), 16, 0, 0);
}
DI f32x16 qk_lds(LAS3 const unsigned char* kt, const bf16x8 (&qf)[8], int lane) {
  f32x16 acc;
#pragma unroll
  for (int i = 0; i < 16; ++i) acc[i] = 0.f;
#pragma unroll
  for (int s8 = 0; s8 < 8; ++s8) {
    const bf16x8 kf = *(LAS3 const bf16x8*)(kt + s8 * 1024 + lane * 16);
    acc = MFMA32(kf, qf[s8], acc);
  }
  return acc;
}
DI void pv_lds(LAS3 const unsigned char* vt, const float (&p)[16], f32x16 (&O)[4], int lane) {
  const bf16x8 pf0 = pack8(p[0], p[1], p[2], p[3], p[4], p[5], p[6], p[7]);
  const bf16x8 pf1 = pack8(p[8], p[9], p[10], p[11], p[12], p[13], p[14], p[15]);
#pragma unroll
  for (int dt = 0; dt < 4; ++dt) {
    const bf16x8 v0 = *(LAS3 const bf16x8*)(vt + (dt * 2) * 1024 + lane * 16);
    const bf16x8 v1 = *(LAS3 const bf16x8*)(vt + (dt * 2 + 1) * 1024 + lane * 16);
    O[dt] = MFMA32(v0, pf0, O[dt]);
    O[dt] = MFMA32(v1, pf1, O[dt]);
  }
}

__device__ __forceinline__ void d_attn_block(int B, int g, char* smem, const AttnPtrs& P) {
  const int tid = TIDX, lane = tid & 63, w = tid >> 6;
  const int c = lane & 31, h = lane >> 5, tokl = c >> 2, r = c & 3;
  const int tok0 = 64 * B + 8 * w;
  const int t = tok0 + tokl, hd = g * 4 + r;
  const float slope2 = exp2f(-(float)(hd + 1)) * LOG2E;
  const float c1 = QSCALE * LOG2E;
  const float ninf = -__builtin_inff();
  char* wsm = smem + w * ATT_PW;
  float* impL = (float*)wsm;
  char* otL = wsm;
  unsigned* mskL = (unsigned*)(wsm + 8192);
  unsigned* uniL = mskL + 64;
  LAS3 unsigned char* ring = (LAS3 unsigned char*)(smem + ATT_RING);
  unsigned short* tl = (unsigned short*)(smem + ATT_LIST);
  unsigned* buni = (unsigned*)(smem + ATT_BUNI);
  const bf16_t* kcf = P.kcf + (size_t)g * 32 * 4096;
  const bf16_t* vcf = P.vcf + (size_t)g * 32 * 4096;
  const bf16_t* ksf = P.ksf + (size_t)g * 512 * 4096;
  const bf16_t* vsf = P.vsf + (size_t)g * 512 * 4096;
  const bf16_t* kwf = P.kwf + (size_t)g * 512 * 4096;
  const bf16_t* vwf = P.vwf + (size_t)g * 512 * 4096;
  bf16x8 qf[8];
  {
    const bf16_t* qrow = P.proj + (size_t)t * INWP + OFF_Q + hd * 128 + 8 * h;
#pragma unroll
    for (int s8 = 0; s8 < 8; ++s8) qf[s8] = *(const bf16x8*)(qrow + 16 * s8);
  }
  const float* gt = P.gates + (size_t)t * 24 + hd * 3;
  const float g0 = gt[0], g1 = gt[1], g2 = gt[2];
  {
    unsigned z0 = 0u;
    asm volatile("" : "+v"(z0));
    u32x4 z = {z0, z0, z0, z0};
#pragma unroll
    for (int i = 0; i < 8; ++i) *(u32x4*)(wsm + (i * 64 + lane) * 16) = z;
    if (lane < 18) *(u32x4*)(wsm + 8192 + lane * 16) = z;
    if (tid < 8) buni[tid] = z0;
  }
  f32x16 Ob[4];
  zero_o(Ob);
  const int nmax = (t >= 31) ? ((t - 31) >> 4) : -1;
  const int nmaxw = (tok0 + 7 >= 31) ? ((tok0 + 7 - 31) >> 4) : -1;
  const int nminw = (tok0 >= 31) ? ((tok0 - 31) >> 4) : -1;
  const int ntcw = (nmaxw + 32) >> 5;
  const int ntcB = (((64 * B + 63 - 31) >> 4) + 32) >> 5;
  const float sl16 = slope2 * 16.f;
  float mC = NEGB, lC = 0.f, invC = 0.f, carry = 0.f;
  {
    const int n = 2 * ntcB;
    asm volatile("s_waitcnt vmcnt(0)" ::: "memory");
#define A_TILE(i_) (((i_) < ntcB) ? (ntcB - 1 - (i_)) : ((i_) - ntcB))
    att_issue(ring, 0, w, lane, kcf, vcf, A_TILE(0));
    if (n > 1) att_issue(ring, 1, w, lane, kcf, vcf, A_TILE(1));
#pragma unroll 1
    for (int i = 0; i < n; ++i) {
      if ((i & 1) == 0) {
        asm volatile("s_waitcnt vmcnt(0)" ::: "memory");
        __builtin_amdgcn_s_barrier();
        asm volatile("" ::: "memory");
        if (i + 2 < n) att_issue(ring, (i + 2) & 3, w, lane, kcf, vcf, A_TILE(i + 2));
        if (i + 3 < n) att_issue(ring, (i + 3) & 3, w, lane, kcf, vcf, A_TILE(i + 3));
      }
      const int T = A_TILE(i);
      if (T >= ntcw) continue;
      LAS3 const unsigned char* slot = ring + (i % ATT_R) * 16384;
      const f32x16 acc = qk_lds(slot, qf, lane);
      const float base = slope2 * (float)(512 * T + 128 * h) + slope2 * (15.5f - (float)t);
      const int nb = 32 * T + 8 * h;
      const bool full = (32 * T + 31 <= nminw);
      float sv[16];
#pragma unroll
      for (int rg = 0; rg < 16; ++rg) { const int kk = (rg & 7) + 16 * (rg >> 3); sv[rg] = fmaf(acc[rg], c1, fmaf(sl16, (float)kk, base)); }
      if (!full) {
#pragma unroll
        for (int rg = 0; rg < 16; ++rg) { const int kk = (rg & 7) + 16 * (rg >> 3); sv[rg] = (nb + kk <= nmax) ? sv[rg] : ninf; }
      }
      if (i < ntcB) {
        float tmax = fmaxf(fmaxf(fmaxf(sv[0], sv[1]), fmaxf(sv[2], sv[3])), fmaxf(fmaxf(sv[4], sv[5]), fmaxf(sv[6], sv[7])));
        tmax = fmaxf(tmax, fmaxf(fmaxf(fmaxf(sv[8], sv[9]), fmaxf(sv[10], sv[11])), fmaxf(fmaxf(sv[12], sv[13]), fmaxf(sv[14], sv[15]))));
        tmax = hmax(tmax);
        const float mn = fmaxf(mC, tmax);
        float ps = 0.f;
#pragma unroll
        for (int rg = 0; rg < 16; ++rg) ps += ex2(sv[rg] - mn);
        lC = lC * ex2(mC - mn) + ps; mC = mn;
      } else {
        if (T == 0) { lC = hsum(lC); invC = (lC > 0.f) ? 1.f / lC : 0.f; }
        float p[16];
#pragma unroll
        for (int rg = 0; rg < 16; ++rg) p[rg] = ex2(sv[rg] - mC) * invC;
        float Ga = (p[0] + p[1]) + (p[2] + p[3]), Gb = (p[4] + p[5]) + (p[6] + p[7]);
        float Gc = (p[8] + p[9]) + (p[10] + p[11]), Gd = (p[12] + p[13]) + (p[14] + p[15]);
        float xb, xd; { float a_, b_; halves(p[7], a_, b_); xb = h ? a_ : b_; halves(p[15], a_, b_); xd = h ? a_ : b_; }
        float ia = Ga + (h ? xb : carry);
        float ib = Gb + p[3];
        float ic = Gc + (h ? xd : xb);
        float id = Gd + p[11];
        carry = xd;
        ia = quad_sum(ia); ib = quad_sum(ib); ic = quad_sum(ic); id = quad_sum(id);
        {
          float val = (r == 0) ? ia : (r == 1) ? ib : (r == 2) ? ic : id;
          int j = 8 * T + 2 * h + ((r == 0) ? 0 : (r == 1) ? 1 : (r == 2) ? 4 : 5);
          impL[tokl * 256 + j] = val;
        }
        pv_lds(slot + 8192, p, Ob, lane);
      }
    }
#undef A_TILE
  }
  const int cur = B;
  d_select(impL, mskL, uniL, cur);
  ot_store(otL, lane, Ob, g0);
  zero_o(Ob);
  if (lane < 8) { const unsigned u = uniL[lane]; if (u) atomicOr(&buni[lane], u); }
  __syncthreads();
  int nslc = 0, ntl = 0;
  {
    for (int iw = 7; iw >= 0; --iw) {
      unsigned iuw = __builtin_amdgcn_readfirstlane(buni[iw]);
      while (iuw) {
        const int bit = 31 - __builtin_clz(iuw);
        iuw &= ~(1u << bit);
        const int bb = 32 * iw + bit;
        if (bb < B) { if (lane == 0) tl[ntl] = (unsigned short)(2 * bb + 1); ++ntl; }
        else { if (lane == 0) tl[ntl] = (unsigned short)(2 * bb + 1); ++ntl; }
        if (lane == 0) tl[ntl] = (unsigned short)(2 * bb);
        ++ntl;
      }
    }
    nslc = ntl;
    const int ThiB = 2 * B + 1, TloB = ((64 * B - 511 > 0) ? (64 * B - 511) : 0) >> 5;
    for (int T = ThiB; T >= TloB; --T) { if (lane == 0) tl[ntl] = (unsigned short)T; ++ntl; }
  }
  float m = NEGB, l = 0.f;
  {
    const int n = ntl;
    const int Tlow = ((tok0 - 511 > 0) ? (tok0 - 511) : 0) >> 5, Thiw = (tok0 + 7) >> 5;
#define B_ISSUE(j_, slot_) { const int e_ = __builtin_amdgcn_readfirstlane((int)tl[j_]); if ((j_) < nslc) att_issue(ring, slot_, w, lane, ksf, vsf, e_); else att_issue(ring, slot_, w, lane, kwf, vwf, e_); }
    B_ISSUE(0, 0)
    if (n > 1) B_ISSUE(1, 1)
#pragma unroll 1
    for (int i = 0; i < n; ++i) {
      if ((i & 1) == 0) {
        asm volatile("s_waitcnt vmcnt(0)" ::: "memory");
        __builtin_amdgcn_s_barrier();
        asm volatile("" ::: "memory");
        if (i + 2 < n) B_ISSUE(i + 2, (i + 2) & 3)
        if (i + 3 < n) B_ISSUE(i + 3, (i + 3) & 3)
      }
      if (i == nslc) {
        l = hsum(l);
        const float inv = (l > 0.f) ? g1 / l : 0.f;
        ot_accum(otL, lane, Ob, inv);
        ot_store(otL, lane, Ob, 1.f);
        zero_o(Ob);
        m = NEGB; l = 0.f;
      }
      const int T = __builtin_amdgcn_readfirstlane((int)tl[i]);
      const int pos0 = 32 * T, pb = pos0 + 8 * h;
      bool full; bool mine = true;
      if (i < nslc) {
        const int bb = T >> 1;
        const unsigned uw = __builtin_amdgcn_readfirstlane(uniL[bb >> 5]);
        if (!((uw >> (bb & 31)) & 1u) || pos0 > tok0 + 7) continue;
        mine = (mskL[tokl * 8 + (bb >> 5)] >> (bb & 31)) & 1u;
        full = (pos0 + 31 <= tok0) && (__ballot(!mine) == 0ull);
      } else {
        if (T < Tlow || T > Thiw) continue;
        full = (pos0 + 31 <= tok0) && (pos0 >= tok0 + 7 - 511);
      }
      LAS3 const unsigned char* slot = ring + (i % ATT_R) * 16384;
      const f32x16 acc = qk_lds(slot, qf, lane);
      const float base = slope2 * (float)(pos0 + 8 * h - t);
      float sv[16], p[16];
#pragma unroll
      for (int rg = 0; rg < 16; ++rg) { const int kk = (rg & 7) + 16 * (rg >> 3); sv[rg] = fmaf(acc[rg], c1, fmaf(slope2, (float)kk, base)); }
      if (!full) {
        if (i < nslc) {
#pragma unroll
          for (int rg = 0; rg < 16; ++rg) { const int kk = (rg & 7) + 16 * (rg >> 3); sv[rg] = (mine && (pb + kk <= t)) ? sv[rg] : ninf; }
        } else {
#pragma unroll
          for (int rg = 0; rg < 16; ++rg) { const int kk = (rg & 7) + 16 * (rg >> 3); const int dw = t - (pb + kk); sv[rg] = ((dw >= 0) && (dw < 512)) ? sv[rg] : ninf; }
        }
      }
      osm_step(sv, m, l, Ob, p);
      pv_lds(slot + 8192, p, Ob, lane);
    }
#undef B_ISSUE
    l = hsum(l);
    const float inv = (l > 0.f) ? g2 / l : 0.f;
    ot_accum(otL, lane, Ob, inv);
  }
  {
    float ss = 0.f;
#pragma unroll
    for (int dt = 0; dt < 4; ++dt)
#pragma unroll
      for (int i = 0; i < 16; ++i) ss = fmaf(Ob[dt][i], Ob[dt][i], ss);
    ss = hsum(ss);
    const float rs = rsqrtf(ss * (1.f / 128.f) + 1e-6f);
    bf16_t* orow = P.mix + (size_t)t * DM + hd * 128 + 4 * h;
    const float* grow = P.hng + hd * 128 + 4 * h;
#pragma unroll
    for (int dt = 0; dt < 4; ++dt)
#pragma unroll
      for (int a = 0; a < 4; ++a) {
        const f32x4 gv = *(const f32x4*)(grow + 32 * dt + 8 * a);
        u32x2 wv2 = {pack2(Ob[dt][4 * a] * rs * gv[0], Ob[dt][4 * a + 1] * rs * gv[1]), pack2(Ob[dt][4 * a + 2] * rs * gv[2], Ob[dt][4 * a + 3] * rs * gv[3])};
        *(u32x2*)(orow + 32 * dt + 8 * a) = wv2;
      }
  }
  asm volatile("s_waitcnt vmcnt(0)" ::: "memory");
  __syncthreads();
}

DI void d_convmix(int t, int tl, const bf16_t* __restrict__ proj, const float* __restrict__ convw, const float* __restrict__ hng,
                          bf16_t* __restrict__ mix) {
  const int c = tl * 8;
  float acc[8];
#pragma unroll
  for (int i = 0; i < 8; ++i) acc[i] = 0.f;
#pragma unroll
  for (int j = 0; j < 3; ++j) {
    const int tt = t - 2 + j;
    if (tt >= 0) {
      const u32x4 cu = *(const u32x4*)(proj + (size_t)tt * INWP + OFF_C + c);
      const u32x4 uu = *(const u32x4*)(proj + (size_t)tt * INWP + OFF_U + c);
      const f32x4 w0 = *(const f32x4*)(convw + j * 1024 + c), w1 = *(const f32x4*)(convw + j * 1024 + c + 4);
#pragma unroll
      for (int i = 0; i < 4; ++i) {
        const unsigned a = cu[i], b = uu[i];
        const float wl = (i < 2) ? w0[2 * i] : w1[2 * i - 4], wh = (i < 2) ? w0[2 * i + 1] : w1[2 * i - 3];
        acc[2 * i] = fmaf(wl * __uint_as_float(a << 16), __uint_as_float(b << 16), acc[2 * i]);
        acc[2 * i + 1] = fmaf(wh * __uint_as_float(a & 0xFFFF0000u), __uint_as_float(b & 0xFFFF0000u), acc[2 * i + 1]);
      }
    }
  }
  const u32x4 bb = *(const u32x4*)(proj + (size_t)t * INWP + OFF_B + c);
  float ss = 0.f;
#pragma unroll
  for (int i = 0; i < 4; ++i) {
    const unsigned b = bb[i];
    acc[2 * i] *= __uint_as_float(b << 16); acc[2 * i + 1] *= __uint_as_float(b & 0xFFFF0000u);
    ss = fmaf(acc[2 * i], acc[2 * i], ss); ss = fmaf(acc[2 * i + 1], acc[2 * i + 1], ss);
  }
  ss += shx(ss, 8); ss += shx(ss, 4); ss += shx(ss, 2); ss += shx(ss, 1);
  const float rs = rsqrtf(ss * (1.f / 128.f) + 1e-6f);
  const f32x4 g0 = *(const f32x4*)(hng + 1024 + c), g1 = *(const f32x4*)(hng + 1024 + c + 4);
  u32x4 o = {pack2(acc[0] * rs * g0[0], acc[1] * rs * g0[1]), pack2(acc[2] * rs * g0[2], acc[3] * rs * g0[3]),
             pack2(acc[4] * rs * g1[0], acc[5] * rs * g1[1]), pack2(acc[6] * rs * g1[2], acc[7] * rs * g1[3])};
  *(u32x4*)(mix + (size_t)t * DM + 1024 + c) = o;
}

DI void d_ln_fin(int t, const u32x4 (&wr)[4], bf16_t* __restrict__ yh, const float* __restrict__ gam, const float* __restrict__ bet) {
  const int lane = TIDX & 63;
  float v[32];
#pragma unroll
  for (int i = 0; i < 4; ++i) {
    const u32x4 w = wr[i];
#pragma unroll
    for (int j = 0; j < 4; ++j) { const unsigned ww = w[j]; v[i * 8 + 2 * j] = __uint_as_float(ww << 16); v[i * 8 + 2 * j + 1] = __uint_as_float(ww & 0xFFFF0000u); }
  }
  float s = 0.f;
#pragma unroll
  for (int i = 0; i < 32; ++i) s += v[i];
  s = wave_sum(s);
  const float mu = s * (1.f / DM);
  float q = 0.f;
#pragma unroll
  for (int i = 0; i < 32; ++i) { const float d = v[i] - mu; q = fmaf(d, d, q); }
  q = wave_sum(q);
  const float rs = rsqrtf(q * (1.f / DM) + 1e-5f);
#pragma unroll
  for (int i = 0; i < 4; ++i) {
    const int cb = 512 * i + 8 * lane;
    const f32x4 g0 = *(const f32x4*)(gam + cb), g1 = *(const f32x4*)(gam + cb + 4), b0 = *(const f32x4*)(bet + cb), b1 = *(const f32x4*)(bet + cb + 4);
    u32x4 o = {pack2((v[i * 8 + 0] - mu) * rs * g0[0] + b0[0], (v[i * 8 + 1] - mu) * rs * g0[1] + b0[1]), pack2((v[i * 8 + 2] - mu) * rs * g0[2] + b0[2], (v[i * 8 + 3] - mu) * rs * g0[3] + b0[3]),
               pack2((v[i * 8 + 4] - mu) * rs * g1[0] + b1[0], (v[i * 8 + 5] - mu) * rs * g1[1] + b1[1]), pack2((v[i * 8 + 6] - mu) * rs * g1[2] + b1[2], (v[i * 8 + 7] - mu) * rs * g1[3] + b1[3])};
    *(u32x4*)(yh + (size_t)t * DM + cb) = o;
  }
}

__device__ void d_cvt_w1f(size_t c, const float* __restrict__ w1, bf16_t* __restrict__ w1f) {
  const int lane = c & 63, ks = (c >> 6) & 255, ct = c >> 14;
  const int col = lane & 31, h = lane >> 5;
  bf16_t v[8];
#pragma unroll
  for (int j = 0; j < 8; ++j) v[j] = f2bf(w1[(size_t)(16 * ks + 8 * h + j) * 512 + 32 * ct + col]);
  u32x4 o; o.x = v[0] | ((unsigned)v[1] << 16); o.y = v[2] | ((unsigned)v[3] << 16); o.z = v[4] | ((unsigned)v[5] << 16); o.w = v[6] | ((unsigned)v[7] << 16);
  *(u32x4*)(w1f + c * 8) = o;
}
__device__ void d_cvt_w2f(size_t c, const float* __restrict__ w2, bf16_t* __restrict__ w2f) {
  const int lane = c & 63, s = (c >> 6) & 31, ct = c >> 11;
  const int col = lane & 31, h = lane >> 5;
  bf16_t v[8];
#pragma unroll
  for (int j = 0; j < 8; ++j) v[j] = f2bf(w2[(size_t)(16 * s + 8 * h + j) * 128 + 32 * ct + col]);
  u32x4 o; o.x = v[0] | ((unsigned)v[1] << 16); o.y = v[2] | ((unsigned)v[3] << 16); o.z = v[4] | ((unsigned)v[5] << 16); o.w = v[6] | ((unsigned)v[7] << 16);
  *(u32x4*)(w2f + c * 8) = o;
}
__device__ __forceinline__ void d_compress_unit(int rt, char* smem, const bf16_t* __restrict__ proj, int col0, const float* __restrict__ pos,
                                const bf16_t* __restrict__ w1f, const float* __restrict__ b1, const bf16_t* __restrict__ w2f,
                                bf16_t* __restrict__ outf, bool isV) {
  bf16_t* Xs = (bf16_t*)smem;
  bf16_t* Hs = (bf16_t*)(smem + 2 * 8704);
  const int tid = TIDX, lane = tid & 63, w = tid >> 6, c = lane & 31, h = lane >> 5;
  const int R0 = rt * 32;
  const int srow = tid >> 4, sch = tid & 15;
  const int grow = R0 + srow, sn = grow >> 1, sg = grow & 1;
  const bool svalid = grow < 2046;
  const bf16_t* sp = proj + (size_t)(16 * sn) * INWP + col0 + sg * 128 + sch * 8;
  f32x16 acc0, acc1;
#pragma unroll
  for (int i = 0; i < 16; ++i) { acc0[i] = 0.f; acc1[i] = 0.f; }
  u32x4 rx = {0u, 0u, 0u, 0u}; f32x4 rp0, rp1;
#define STAGE_WRITE(buf)                                                                                   \
  {                                                                                                        \
    u32x4 o_;                                                                                              \
    _Pragma("unroll") for (int i = 0; i < 4; ++i) {                                                        \
      const unsigned wv_ = rx[i];                                                                          \
      const float lo = __uint_as_float(wv_ << 16) + ((i < 2) ? rp0[2 * i] : rp1[2 * i - 4]);               \
      const float hi = __uint_as_float(wv_ & 0xFFFF0000u) + ((i < 2) ? rp0[2 * i + 1] : rp1[2 * i - 3]);   \
      o_[i] = pack2(lo, hi);                                                                               \
    }                                                                                                      \
    *(u32x4*)(Xs + (buf) * 4352 + srow * 136 + sch * 8) = o_;                                              \
  }
  if (svalid) rx = *(const u32x4*)(sp);
  rp0 = *(const f32x4*)(pos + sch * 8); rp1 = *(const f32x4*)(pos + sch * 8 + 4);
  STAGE_WRITE(0)
  __syncthreads();
  const bf16_t* wb0 = w1f + ((size_t)(2 * w) * 256 * 64 + lane) * 8;
  const bf16_t* wb1 = w1f + ((size_t)(2 * w + 1) * 256 * 64 + lane) * 8;
  bf16x8 bA[16], bB[16];
#define CMP_LOADB(BUF, L)                                                                      \
  _Pragma("unroll") for (int s8 = 0; s8 < 8; ++s8) {                                           \
    BUF[2 * s8] = *(const bf16x8*)(wb0 + (size_t)(8 * (L) + s8) * 512);                        \
    BUF[2 * s8 + 1] = *(const bf16x8*)(wb1 + (size_t)(8 * (L) + s8) * 512);                    \
  }
#define CMP_LOADX(L)                                                                           \
  if ((L) < 32) {     \
    if (svalid) rx = *(const u32x4*)(sp + (size_t)(L) * INWP);                                 \
    rp0 = *(const f32x4*)(pos + (L) * 128 + sch * 8); rp1 = *(const f32x4*)(pos + (L) * 128 + sch * 8 + 4); \
  }
#define CMP_CHUNK(BUF, L)                                                                      \
  {                                                                                            \
    const bf16_t* xa = Xs + ((L) & 1) * 4352 + c * 136 + 8 * h;                                \
    _Pragma("unroll") for (int s8 = 0; s8 < 8; ++s8) {                                         \
      const bf16x8 a = *(const bf16x8*)(xa + 16 * s8);                                         \
      acc0 = MFMA32(a, BUF[2 * s8], acc0);                                                     \
      acc1 = MFMA32(a, BUF[2 * s8 + 1], acc1);                                                 \
    }                                                                                          \
    if ((L) + 1 < 32) STAGE_WRITE(((L) + 1) & 1)                                               \
    __syncthreads();                                                                           \
  }
  CMP_LOADB(bA, 0)
#pragma unroll 1
  for (int l = 0; l < 32; l += 2) {
    CMP_LOADX(l + 1)
    CMP_LOADB(bB, l + 1)
    __builtin_amdgcn_sched_barrier(0);
    CMP_CHUNK(bA, l)
    __builtin_amdgcn_sched_barrier(0);
    CMP_LOADX(l + 2)
    { const int ln = (l + 2 < 32) ? l + 2 : l;
      CMP_LOADB(bA, ln) }
    __builtin_amdgcn_sched_barrier(0);
    CMP_CHUNK(bB, l + 1)
    __builtin_amdgcn_sched_barrier(0);
  }
#undef CMP_LOADX
#undef CMP_LOADB
#undef CMP_CHUNK
  {
    const float bb0 = b1[64 * w + c], bb1 = b1[64 * w + 32 + c];
#pragma unroll
    for (int rg = 0; rg < 16; ++rg) {
      const int row = (rg & 3) + 8 * (rg >> 2) + 4 * h;
      Hs[row * 520 + 64 * w + c] = f2bf(gelu_tanh(acc0[rg] + bb0));
      Hs[row * 520 + 64 * w + 32 + c] = f2bf(gelu_tanh(acc1[rg] + bb1));
    }
  }
  __syncthreads();
  if (w < 4) {
    f32x16 o2;
#pragma unroll
    for (int i = 0; i < 16; ++i) o2[i] = 0.f;
    const bf16_t* ha = Hs + c * 520 + 8 * h;
    const bf16_t* wb = w2f + ((size_t)w * 32 * 64 + lane) * 8;
#pragma unroll 8
    for (int s2 = 0; s2 < 32; ++s2) {
      const bf16x8 a = *(const bf16x8*)(ha + 16 * s2);
      const bf16x8 b = *(const bf16x8*)(wb + (size_t)s2 * 512);
      o2 = MFMA32(a, b, o2);
    }
    const int d = 32 * w + c;
#pragma unroll
    for (int rg = 0; rg < 16; ++rg) {
      const int row = R0 + (rg & 3) + 8 * (rg >> 2) + 4 * h;
      const int n = row >> 1, g = row & 1;
      const bf16_t val = (row < 2046) ? f2bf(o2[rg]) : (bf16_t)0;
      const int T = n >> 5, nn = n & 31;
      size_t idx;
      if (!isV) idx = ((((size_t)(g * 32 + T) * 8 + (d >> 4)) * 64 + (pi_perm(nn) + 32 * ((d >> 3) & 1))) * 8 + (d & 7));
      else idx = (((((size_t)(g * 32 + T) * 4 + (d >> 5)) * 2 + (nn >> 4)) * 64 + ((d & 31) + 32 * ((nn >> 3) & 1))) * 8 + (nn & 7));
      outf[idx] = val;
    }
  }
  __syncthreads();
}


DI unsigned f2sort(float f) { unsigned u = __float_as_uint(f); return u ^ ((unsigned)((int)u >> 31) | 0x80000000u); }
DI float sort2f(unsigned k) { unsigned u = (k & 0x80000000u) ? (k ^ 0x80000000u) : ~k; return __uint_as_float(u); }
template <int N>
DI void bitonic_sort_desc(unsigned (&key)[N]) {
#pragma unroll
  for (int k = 2; k <= N; k <<= 1) {
#pragma unroll
    for (int jj = k >> 1; jj > 0; jj >>= 1) {
#pragma unroll
      for (int i = 0; i < N; ++i) {
        const int l2 = i ^ jj;
        if (l2 > i) {
          const bool desc = ((i & k) == 0);
          unsigned a = key[i], b = key[l2];
          unsigned mx = a > b ? a : b, mn = a > b ? b : a;
          key[i] = desc ? mx : mn; key[l2] = desc ? mn : mx;
        }
      }
    }
  }
}
DI void merge_top16(unsigned (&a)[16], const unsigned (&b)[16]) {
#pragma unroll
  for (int i = 0; i < 16; ++i) { unsigned o = b[15 - i]; a[i] = a[i] > o ? a[i] : o; }
#pragma unroll
  for (int jj = 8; jj > 0; jj >>= 1) {
#pragma unroll
    for (int i = 0; i < 16; ++i) {
      const int l2 = i ^ jj;
      if (l2 > i) { unsigned x = a[i], y = a[l2]; a[i] = x > y ? x : y; a[l2] = x > y ? y : x; }
    }
  }
}
__device__ void d_cvt_subk(size_t c, const float* __restrict__ subk, bf16_t* __restrict__ skf) {
  int lane = c & 63, s = (c >> 6) & 7, kt = (c >> 9) & 3, hc = c >> 11;
  int i = lane & 31, h = lane >> 5;
  const float* src = subk + ((size_t)hc * 128 + 32 * kt + i) * 128 + 16 * s + 8 * h;
  bf16_t v[8];
#pragma unroll
  for (int j = 0; j < 8; ++j) v[j] = f2bf(src[j]);
  u32x4 o; o.x = v[0] | ((unsigned)v[1] << 16); o.y = v[2] | ((unsigned)v[3] << 16); o.z = v[4] | ((unsigned)v[5] << 16); o.w = v[6] | ((unsigned)v[7] << 16);
  *(u32x4*)(skf + c * 8) = o;
}

#define EPI_LANES()                                                                                                      \
    const int lane = fr | (fq << 4), rr = lane >> 2, rc = lane & 3;                                                       \
    PG8_LAS unsigned char* my = scr + (wr * 4 + wc) * 2048;                                                              \
    const int wo = fr * 64 + ((fq ^ ((fr >> 2) & 3)) << 4), ro = rr * 64 + ((rc ^ ((rr >> 2) & 3)) << 4);
struct EpiProjG {
  static constexpr bool PERM = true, AFTER_DRAIN = false;
  bf16_t* proj; float* gates; PG8_LAS unsigned char* scr;
  DI void operator()(const f32x4 (&acc)[2][2][4][2], const pg8::Unit& u, int wr, int wc, int fr, int fq) const {
    EPI_LANES()
#pragma unroll
    for (int ai = 0; ai < 2; ++ai)
#pragma unroll
      for (int bj = 0; bj < 2; ++bj) {
        const int c0 = u.pn * 256 + bj * 128 + wc * 32 + 8 * fq, cs = u.pn * 256 + bj * 128 + wc * 32 + 8 * rc;
#pragma unroll
        for (int mh = 0; mh < 2; ++mh) {
#pragma unroll
          for (int mm = 0; mm < 2; ++mm) {
            const f32x4 v0 = acc[ai][bj][mh * 2 + mm][0], v1 = acc[ai][bj][mh * 2 + mm][1];
            u32x4 w = {pack2(v0[0], v0[1]), pack2(v0[2], v0[3]), pack2(v1[0], v1[1]), pack2(v1[2], v1[3])};
            *(PG8_LAS u32x4*)(my + wo + mm * 1024) = w;
            if (c0 >= OFF_G && c0 < OFF_G + 24) {
              const int row = u.pm * 256 + ai * 128 + wr * 64 + (mh * 2 + mm) * 16 + fr;
              f32x4 g0, g1;
#pragma unroll
              for (int j = 0; j < 4; ++j) { g0[j] = 1.f / (1.f + __expf(-v0[j])); g1[j] = 1.f / (1.f + __expf(-v1[j])); }
              *(f32x4*)(gates + (size_t)row * 24 + (c0 - OFF_G)) = g0;
              *(f32x4*)(gates + (size_t)row * 24 + (c0 - OFF_G) + 4) = g1;
            }
          }
#pragma unroll
          for (int j = 0; j < 2; ++j) {
            const u32x4 w = *(const PG8_LAS u32x4*)(my + ro + j * 1024);
            const int row = u.pm * 256 + ai * 128 + wr * 64 + mh * 32 + j * 16 + rr;
            if (cs < INW) *(u32x4*)(proj + (size_t)row * INWP + cs) = w;
          }
        }
      }
  }
};
struct EpiResG {
  static constexpr bool PERM = true, AFTER_DRAIN = false;
  bf16_t* YB; PG8_LAS unsigned char* scr;
  DI void operator()(const f32x4 (&acc)[2][2][4][2], const pg8::Unit& u, int wr, int wc, int fr, int fq) const {
    EPI_LANES()
    bf16_t* yb = YB + (size_t)(u.pm * 256 + wr * 64 + rr) * DM + u.pn * 256 + wc * 32 + 8 * rc;
#pragma unroll
    for (int ai = 0; ai < 2; ++ai) {
      u32x4 xr[2][2][2];
#pragma unroll
      for (int bj = 0; bj < 2; ++bj)
#pragma unroll
        for (int mh = 0; mh < 2; ++mh)
#pragma unroll
          for (int j = 0; j < 2; ++j) xr[bj][mh][j] = *(const u32x4*)(yb + (size_t)(ai * 128 + mh * 32 + j * 16) * DM + bj * 128);
#pragma unroll
      for (int bj = 0; bj < 2; ++bj)
#pragma unroll
        for (int mh = 0; mh < 2; ++mh) {
#pragma unroll
          for (int mm = 0; mm < 2; ++mm) {
            const f32x4 v0 = acc[ai][bj][mh * 2 + mm][0], v1 = acc[ai][bj][mh * 2 + mm][1];
            u32x4 w = {pack2(v0[0], v0[1]), pack2(v0[2], v0[3]), pack2(v1[0], v1[1]), pack2(v1[2], v1[3])};
            *(PG8_LAS u32x4*)(my + wo + mm * 1024) = w;
          }
#pragma unroll
          for (int j = 0; j < 2; ++j) {
            const u32x4 a = *(const PG8_LAS u32x4*)(my + ro + j * 1024), xw = xr[bj][mh][j];
            u32x4 o;
#pragma unroll
            for (int q = 0; q < 4; ++q) {
              const unsigned aw = a[q], xq = xw[q];
              o[q] = pack2(fmaf(ALPHA, __uint_as_float(xq << 16), __uint_as_float(aw << 16)), fmaf(ALPHA, __uint_as_float(xq & 0xFFFF0000u), __uint_as_float(aw & 0xFFFF0000u)));
            }
            *(u32x4*)(yb + (size_t)(ai * 128 + mh * 32 + j * 16) * DM + bj * 128) = o;
          }
        }
    }
  }
};
struct EpiF32G {
  static constexpr bool PERM = false, AFTER_DRAIN = false;
  float* C; int ldc;
  DI void operator()(const f32x4 (&acc)[2][2][4][2], const pg8::Unit& u, int wr, int wc, int fr, int fq) const {
#pragma unroll
    for (int ai = 0; ai < 2; ++ai)
#pragma unroll
      for (int m = 0; m < 4; ++m) {
        const size_t ro = (size_t)(u.pm * 256 + ai * 128 + wr * 64 + m * 16 + fr) * ldc + u.pn * 256 + wc * 32 + 4 * fq;
#pragma unroll
        for (int bj = 0; bj < 2; ++bj)
#pragma unroll
          for (int n = 0; n < 2; ++n) *(f32x4*)(C + ro + bj * 128 + n * 16) = acc[ai][bj][m][n];
      }
  }
};
struct EpiRouteG {
  static constexpr bool PERM = false, AFTER_DRAIN = true;
  const bf16_t* skf; unsigned* tops;
  DI void operator()(const f32x4 (&)[2][2][4][2], const pg8::Unit&, int, int, int, int) const {}
  DI void fused(const f32x4 (&acc)[2][2][4][2], const pg8::Unit& u, int wr, int wc, int fr, int fq, PG8_LAS unsigned char* ldsp, int, int) const {
    const int lane = fr | (fq << 4), wid = wr * 4 + wc;
    bf16_t* Qs = (bf16_t*)ldsp;
#pragma unroll
    for (int ai = 0; ai < 2; ++ai)
#pragma unroll
      for (int m = 0; m < 4; ++m) {
        const int row = ai * 128 + wr * 64 + m * 16 + fr;
#pragma unroll
        for (int bj = 0; bj < 2; ++bj)
#pragma unroll
          for (int n = 0; n < 2; ++n) {
            const f32x4 v = acc[ai][bj][m][n];
            u32x2 w = {pack2(v[0], v[1]), pack2(v[2], v[3])};
            *(u32x2*)(Qs + row * 264 + bj * 128 + wc * 32 + n * 16 + 4 * fq) = w;
          }
      }
    __syncthreads();
    const int c = lane & 31, h = lane >> 5;
    unsigned kA[16], kB[16];
#pragma unroll 1
    for (int half = 0; half < 2; ++half) {
      const int hc = u.pn * 2 + half;
      const bf16_t* sk = skf + (size_t)hc * 4 * 4096;
      const bf16_t* qp = Qs + (wid * 32 + c) * 264 + half * 128 + 8 * h;
      unsigned k0[16], k1[16];
#define ROUTE_KT(KT, KA)                                                                        \
      {                                                                                         \
        f32x16 sc;                                                                              \
        _Pragma("unroll") for (int i = 0; i < 16; ++i) sc[i] = 0.f;                             \
        _Pragma("unroll") for (int s = 0; s < 8; ++s) {                                         \
          bf16x8 af = *(const bf16x8*)(sk + (KT) * 4096 + s * 512 + lane * 8);                  \
          bf16x8 bq = *(const bf16x8*)(qp + 16 * s);                                            \
          sc = __builtin_amdgcn_mfma_f32_32x32x16_bf16(af, bq, sc, 0, 0, 0);                    \
        }                                                                                       \
        _Pragma("unroll") for (int rg = 0; rg < 16; ++rg) {                                     \
          const int kidx = 32 * (KT) + (rg & 3) + 8 * (rg >> 2) + 4 * h;                        \
          KA[rg] = (f2sort(sc[rg]) & 0xFFFFFF80u) | (unsigned)(127 - kidx);                     \
        }                                                                                       \
        bitonic_sort_desc<16>(KA);                                                              \
      }
      ROUTE_KT(0, k0)
      __builtin_amdgcn_sched_barrier(0);
      ROUTE_KT(1, k1)
      merge_top16(k0, k1);
      __builtin_amdgcn_sched_barrier(0);
      ROUTE_KT(2, k1)
      merge_top16(k0, k1);
      __builtin_amdgcn_sched_barrier(0);
      ROUTE_KT(3, k1)
      merge_top16(k0, k1);
      __builtin_amdgcn_sched_barrier(0);
#undef ROUTE_KT
#pragma unroll
      for (int i = 0; i < 16; ++i) k1[i] = (unsigned)shx_i((int)k0[i], 32);
      merge_top16(k0, k1);
      if (half == 0) {
#pragma unroll
        for (int i = 0; i < 16; ++i) kA[i] = k0[i];
      } else {
#pragma unroll
        for (int i = 0; i < 16; ++i) kB[i] = k0[i];
      }
    }
    {
      unsigned* lk = (unsigned*)(ldsp + wid * 16896);
#pragma unroll
      for (int i = 0; i < 16; ++i) { lk[i * 64 + lane] = kA[i]; lk[(16 + i) * 64 + lane] = kB[i]; }
      float fa[16], fb[16];
#pragma unroll
      for (int i = 0; i < 16; ++i) { fa[i] = sort2f(kA[i]); fb[i] = sort2f(kB[i]); }
#define CAND(ci_, cj_) ((f2sort(fa[ci_] + fb[cj_]) & 0xFFFFFF00u) | (unsigned)(255 - ((ci_) * 16 + (cj_))))
      unsigned R0[16], R1[16], S1[16], S2[16];
#pragma unroll
      for (int j = 0; j < 16; ++j) { R0[j] = CAND(0, j); R1[j] = (j < 8) ? CAND(1, j & 7) : 0u; }
      S1[0] = CAND(2, 0); S1[1] = CAND(2, 1); S1[2] = CAND(2, 2); S1[3] = CAND(2, 3); S1[4] = CAND(2, 4);
      S1[5] = CAND(3, 0); S1[6] = CAND(3, 1); S1[7] = CAND(3, 2); S1[8] = CAND(3, 3);
      S1[9] = CAND(4, 0); S1[10] = CAND(4, 1); S1[11] = CAND(4, 2);
      S1[12] = CAND(5, 0); S1[13] = CAND(5, 1); S1[14] = CAND(6, 0); S1[15] = CAND(6, 1);
      S2[0] = CAND(7, 0); S2[1] = CAND(7, 1);
#pragma unroll
      for (int i = 8; i < 16; ++i) S2[i - 6] = CAND(i, 0);
#pragma unroll
      for (int i = 10; i < 16; ++i) S2[i] = 0u;
#undef CAND
      merge_top16(R0, R1);
      bitonic_sort_desc<16>(S1); bitonic_sort_desc<16>(S2);
      merge_top16(S1, S2);
      merge_top16(R0, S1);
      float sc[16]; unsigned ex[16]; float mx = -3.0e38f;
#pragma unroll
      for (int i = 0; i < 16; ++i) {
        const int flat = 255 - (int)(R0[i] & 255u);
        const unsigned ka = lk[(flat >> 4) * 64 + lane], kb = lk[(16 + (flat & 15)) * 64 + lane];
        sc[i] = sort2f(ka) + sort2f(kb);
        ex[i] = (127u - (ka & 127u)) * 128u + (127u - (kb & 127u));
        mx = fmaxf(mx, sc[i]);
      }
      float sm = 0.f;
#pragma unroll
      for (int i = 0; i < 16; ++i) { sc[i] = __expf(sc[i] - mx); sm += sc[i]; }
      const float rsm = 1.f / sm;
      unsigned* dst = tops + (size_t)(u.pm * 256 + wid * 32 + c) * 256 + h * 128 + u.pn * 16;
#pragma unroll
      for (int q4 = 0; q4 < 4; ++q4) {
        u32x4 o;
#pragma unroll
        for (int i = 0; i < 4; ++i) o[i] = h ? __float_as_uint(sc[4 * q4 + i] * rsm) : ex[4 * q4 + i];
        *(u32x4*)(dst + 4 * q4) = o;
      }
    }
    __syncthreads();
  }
};


template <int CTRL> DI float dpp_f(float v) { const int iv = __float_as_int(v); return __int_as_float(__builtin_amdgcn_update_dpp(iv, iv, CTRL, 0xF, 0xF, false)); }
DI float wsum(float x) {
  x += dpp_f<0xB1>(x);
  x += dpp_f<0x4E>(x);
  x += dpp_f<0x124>(x);
  x += dpp_f<0x128>(x);
  x += shx(x, 16);
  return hsum(x);
}
DI float gelu_fast(float x) {
  const float u2 = 1.5957691216057308f * (x + 0.044715f * x * x * x);
  return x * __builtin_amdgcn_rcpf(1.f + ex2(-LOG2E * u2));
}

constexpr int EROW = 1024;
typedef float v2f __attribute__((ext_vector_type(2)));
DI void d_cvt_fp4_fin(int row, const f32x4 (&x)[8], unsigned char* __restrict__ dst, float* __restrict__ scales) {
  const int lane = TIDX & 63;
  float v[32]; float amax = 0.f;
#pragma unroll
  for (int i = 0; i < 8; ++i)
#pragma unroll
    for (int j = 0; j < 4; ++j) { v[i * 4 + j] = x[i][j]; amax = fmaxf(amax, fabsf(x[i][j])); }
  amax = wave_max(amax);
  const float sc = amax > 0.f ? amax * (1.f / 7.f) : 1.f;
  const float inv = 1.f / sc;
  u32x4 o;
#pragma unroll
  for (int k = 0; k < 4; ++k) {
    unsigned w = 0u;
#define FP4C(x_) fminf(fmaxf((x_) * inv, -6.f), 6.f)
    w = __builtin_amdgcn_cvt_scalef32_pk_fp4_f32(w, FP4C(v[8 * k + 0]), FP4C(v[8 * k + 1]), 1.0f, 0);
    w = __builtin_amdgcn_cvt_scalef32_pk_fp4_f32(w, FP4C(v[8 * k + 2]), FP4C(v[8 * k + 3]), 1.0f, 1);
    w = __builtin_amdgcn_cvt_scalef32_pk_fp4_f32(w, FP4C(v[8 * k + 4]), FP4C(v[8 * k + 5]), 1.0f, 2);
    w = __builtin_amdgcn_cvt_scalef32_pk_fp4_f32(w, FP4C(v[8 * k + 6]), FP4C(v[8 * k + 7]), 1.0f, 3);
#undef FP4C
    o[k] = w;
  }
  *(u32x4*)(dst + (size_t)row * EROW + 16 * lane) = o;
  if (lane == 0) scales[row] = sc;
}
__device__ void d_cvt_fp4_row(int row, const float* __restrict__ src, unsigned char* __restrict__ dst, float* __restrict__ scales) {
  const int lane = TIDX & 63;
  f32x4 x[8];
#pragma unroll
  for (int i = 0; i < 8; ++i) x[i] = *(const f32x4*)(src + (size_t)row * DM + 256 * i + 4 * lane);
  d_cvt_fp4_fin(row, x, dst, scales);
}
DI void d_cvt_i4_fin(int row, const f32x4 (&x)[8], unsigned char* __restrict__ dst, float* __restrict__ scales) {
  const int lane = TIDX & 63;
  float v[32]; float amax = 0.f, ss = 0.f;
#pragma unroll
  for (int i = 0; i < 8; ++i)
#pragma unroll
    for (int j = 0; j < 4; ++j) { v[i * 4 + j] = x[i][j]; amax = fmaxf(amax, fabsf(x[i][j])); ss = fmaf(x[i][j], x[i][j], ss); }
  amax = wave_max(amax); ss = wave_sum(ss);
  float sc = fmaxf(0.36f * sqrtf(ss * (1.f / DM)), amax * (1.f / 14.f));
  sc = sc > 0.f ? sc : 1.f;
  const float inv = 1.f / sc;
  u32x4 o;
#pragma unroll
  for (int k = 0; k < 4; ++k) {
    unsigned w = 0u;
#pragma unroll
    for (int j = 0; j < 8; ++j) {
      const float q = fminf(fmaxf(v[8 * k + j] * inv, -7.f), 7.f) + 12582912.f;
      w |= (__float_as_uint(q) & 15u) << (4 * j);
    }
    o[k] = w;
  }
  *(u32x4*)(dst + (size_t)row * EROW + 16 * lane) = o;
  if (lane == 0) scales[row] = sc;
}
__device__ void d_cvt_i4_row(int row, const float* __restrict__ src, unsigned char* __restrict__ dst, float* __restrict__ scales) {
  const int lane = TIDX & 63;
  f32x4 x[8];
#pragma unroll
  for (int i = 0; i < 8; ++i) x[i] = *(const f32x4*)(src + (size_t)row * DM + 256 * i + 4 * lane);
  d_cvt_i4_fin(row, x, dst, scales);
}
__device__ void d_expert_group(int tg0, int tstr, unsigned* tpl, unsigned* slw, const bf16_t* __restrict__ hbuf, const unsigned* __restrict__ tops,
                               const unsigned char* __restrict__ eu4, const unsigned char* __restrict__ ev4, const float* __restrict__ esu, const float* __restrict__ esv,
                               const float* __restrict__ gam, const float* __restrict__ bet, float* __restrict__ out) {
  const int lane = TIDX & 63;
#define SLOT(j_, f_) slw[((j_) * 16 + (f_)) * 64 + lane]
#pragma unroll 1
  for (int j = 0; j < 4; ++j) {
    const int tt = tg0 + j * tstr, t = tt < S ? tt : S - 1;
  float hv[32];
#pragma unroll
  for (int i = 0; i < 8; ++i) {
    const u32x2 w = *(const u32x2*)(hbuf + (size_t)t * DM + 256 * i + 4 * lane);
    hv[i * 4 + 0] = __uint_as_float(w[0] << 16); hv[i * 4 + 1] = __uint_as_float(w[0] & 0xFFFF0000u);
    hv[i * 4 + 2] = __uint_as_float(w[1] << 16); hv[i * 4 + 3] = __uint_as_float(w[1] & 0xFFFF0000u);
  }
  int e0 = (int)tops[(size_t)t * 256 + lane], e1 = (int)tops[(size_t)t * 256 + 64 + lane];
  float w0 = __uint_as_float(tops[(size_t)t * 256 + 128 + lane]), w1 = __uint_as_float(tops[(size_t)t * 256 + 192 + lane]);
  {
    unsigned k0 = ((unsigned)e0 << 7) | (unsigned)lane, k1 = ((unsigned)e1 << 7) | (unsigned)(64 + lane);
#pragma unroll
    for (int k = 2; k <= 128; k <<= 1) {
#pragma unroll
      for (int jj = k >> 1; jj > 0; jj >>= 1) {
        if (jj == 64) { const unsigned mn = k0 < k1 ? k0 : k1, mx = k0 < k1 ? k1 : k0; k0 = mn; k1 = mx; }
        else {
          const unsigned o0 = (unsigned)shx_i((int)k0, jj), o1 = (unsigned)shx_i((int)k1, jj);
          const bool lower = (lane & jj) == 0;
          const bool asc0 = (k >= 64) ? true : ((lane & k) == 0), asc1 = (k == 128) ? true : (k == 64) ? false : ((lane & k) == 0);
          const unsigned mn0 = k0 < o0 ? k0 : o0, mx0 = k0 < o0 ? o0 : k0, mn1 = k1 < o1 ? k1 : o1, mx1 = k1 < o1 ? o1 : k1;
          k0 = (lower == asc0) ? mn0 : mx0; k1 = (lower == asc1) ? mn1 : mx1;
        }
      }
    }
    const int o0 = (int)(k0 & 127u), o1 = (int)(k1 & 127u);
    const float wa0 = __shfl(w0, o0 & 63), wb0 = __shfl(w1, o0 & 63), wa1 = __shfl(w0, o1 & 63), wb1 = __shfl(w1, o1 & 63);
    e0 = (int)(k0 >> 7); e1 = (int)(k1 >> 7); w0 = (o0 < 64) ? wa0 : wb0; w1 = (o1 < 64) ? wa1 : wb1;
  }
  int hhi[4], hlo[4]; float hsc;
  {
    float m = 0.f;
#pragma unroll
    for (int i = 0; i < 32; ++i) m = fmaxf(m, fabsf(hv[i]));
    m = wave_max(m);
    hsc = m > 0.f ? m * (1.f / 119.f) : 1.f;
    const float hinv = 1.f / hsc;
#pragma unroll
    for (int q = 0; q < 4; ++q) {
      unsigned wh = 0u, wl = 0u;
#pragma unroll
      for (int j = 0; j < 8; ++j) {
        const unsigned b = __float_as_uint(fmaf(hv[8 * q + j], hinv, 12582912.f));
        wl |= (b & 15u) << (4 * j); wh |= (((b + 8u) >> 4) & 15u) << (4 * j);
      }
      hhi[q] = (int)wh; hlo[q] = (int)wl;
    }
  }
    const float su0 = esu[e0], su1 = esu[e1], sv0 = esv[e0], sv1 = esv[e1];
#pragma unroll
    for (int q = 0; q < 4; ++q) { SLOT(j, q) = (unsigned)hhi[q]; SLOT(j, 4 + q) = (unsigned)hlo[q]; }
    SLOT(j, 8) = (unsigned)e0; SLOT(j, 9) = (unsigned)e1;
    SLOT(j, 10) = __float_as_uint(hsc * su0); SLOT(j, 11) = __float_as_uint(hsc * su1);
    SLOT(j, 12) = __float_as_uint(w0 * sv0); SLOT(j, 13) = __float_as_uint(w1 * sv1);
  }
  u32x4 rA[4], rB[4];
  const unsigned lo16 = (unsigned)(16 * lane);
#define G_LOAD(R, TAB, EX, LB)                                                             \
  _Pragma("unroll") for (int k = 0; k < 4; ++k) {                                          \
    const int id = __builtin_amdgcn_readlane((EX), (LB) + k);                              \
    R[k] = *(const u32x4*)((TAB) + (size_t)id * EROW + lo16);                              \
  }
#define PKFMA(a_, b_, c_) __builtin_elementwise_fma((a_), (b_), (c_))
  const int srcb = 4 * (((lane & 1) << 5) | ((lane & 2) << 3));
#define G_COMP_U(R, LB)                                                                    \
  {                                                                                        \
    int dd[4];                                                                             \
    _Pragma("unroll") for (int k = 0; k < 4; ++k) {                                        \
      int dh = 0, dl = 0;                                                                  \
      _Pragma("unroll") for (int q = 0; q < 4; ++q) {                                      \
        dh = __builtin_amdgcn_sdot8((int)R[k][q], hhi[q], dh, false);                      \
        dl = __builtin_amdgcn_sdot8((int)R[k][q], hlo[q], dl, false);                      \
      }                                                                                    \
      dd[k] = dh * 16 + dl;                                                                \
      __builtin_amdgcn_sched_barrier(0);                                                   \
    }                                                                                      \
    unsigned t01, t23;                                                                     \
    { auto r_ = __builtin_amdgcn_permlane32_swap((unsigned)dd[0], (unsigned)dd[1], false, false); t01 = r_[0] + r_[1]; }     \
    { auto r_ = __builtin_amdgcn_permlane32_swap((unsigned)dd[2], (unsigned)dd[3], false, false); t23 = r_[0] + r_[1]; }     \
    const bool b4_ = (lane & 16) != 0;                                                     \
    int tv = (int)(b4_ ? t23 : t01) + shx_i((int)(b4_ ? t01 : t23), 16);                   \
    tv += dpp_i<0x128>(tv); tv += dpp_i<0x124>(tv); tv += dpp_i<0x4E>(tv); tv += dpp_i<0xB1>(tv);   \
    const int got = __builtin_amdgcn_ds_bpermute(srcb, tv);                                \
    cc = ((unsigned)(lane - (LB)) < 4u) ? got : cc;                                        \
    __builtin_amdgcn_sched_barrier(0);                                                     \
  }
#define G_COMP_V(R, ACC, CF, LB)                                                           \
  _Pragma("unroll") for (int k = 0; k < 4; ++k) {                                          \
    const float cs = __int_as_float(__builtin_amdgcn_readlane(__float_as_int(CF), (LB) + k));   \
    const v2f cs2 = {cs, cs};                                                              \
    _Pragma("unroll") for (int q = 0; q < 4; ++q) {                                        \
      const unsigned wq = R[k][q];                                                         \
      const v2f f0 = __builtin_amdgcn_cvt_scalef32_pk_f32_fp4(wq, 1.0f, 0), f1 = __builtin_amdgcn_cvt_scalef32_pk_f32_fp4(wq, 1.0f, 1); \
      const v2f f2 = __builtin_amdgcn_cvt_scalef32_pk_f32_fp4(wq, 1.0f, 2), f3 = __builtin_amdgcn_cvt_scalef32_pk_f32_fp4(wq, 1.0f, 3); \
      ACC[4 * q + 0] = PKFMA(cs2, f0, ACC[4 * q + 0]); ACC[4 * q + 1] = PKFMA(cs2, f1, ACC[4 * q + 1]); \
      ACC[4 * q + 2] = PKFMA(cs2, f2, ACC[4 * q + 2]); ACC[4 * q + 3] = PKFMA(cs2, f3, ACC[4 * q + 3]); \
    }                                                                                      \
    __builtin_amdgcn_sched_barrier(0);                                                     \
  }
  {
    int eX = (int)SLOT(0, 8);
    G_LOAD(rA, eu4, eX, 0)
    __builtin_amdgcn_sched_barrier(0);
#pragma unroll 1
    for (int s_ = 0; s_ < 32; ++s_) {
      const int sg = s_ >> 2, j = s_ & 3, L0 = (sg & 3) * 16;
      const int sn = (s_ + 1) & 31, sgn = sn >> 2, jn = sn & 3, L0n = (sgn & 3) * 16;
      if (j == 0) __builtin_amdgcn_s_barrier();
      int hhi[4], hlo[4];
#pragma unroll
      for (int q = 0; q < 4; ++q) { hhi[q] = (int)SLOT(j, q); hlo[q] = (int)SLOT(j, 4 + q); }
      const int eXn = (int)SLOT(jn, 8 + (sgn >> 2));
      const unsigned char* tabn = (s_ == 31) ? ev4 : eu4;
      int cc = 0;
      G_LOAD(rB, eu4, eX, L0 + 4)
      __builtin_amdgcn_sched_barrier(0);
      G_COMP_U(rA, L0)
      G_LOAD(rA, eu4, eX, L0 + 8)
      __builtin_amdgcn_sched_barrier(0);
      G_COMP_U(rB, L0 + 4)
      G_LOAD(rB, eu4, eX, L0 + 12)
      __builtin_amdgcn_sched_barrier(0);
      G_COMP_U(rA, L0 + 8)
      G_LOAD(rA, tabn, eXn, L0n)
      __builtin_amdgcn_sched_barrier(0);
      G_COMP_U(rB, L0 + 12)
      if ((unsigned)(lane - L0) < 16u) SLOT(j, 14 + (sg >> 2)) = (unsigned)cc;
      eX = eXn;
    }
  }
#pragma unroll 1
  for (int j = 0; j < 4; ++j) {
    const float d0 = (float)(int)SLOT(j, 14), d1 = (float)(int)SLOT(j, 15);
    SLOT(j, 14) = __float_as_uint(__uint_as_float(SLOT(j, 12)) * gelu_fast(__uint_as_float(SLOT(j, 10)) * d0));
    SLOT(j, 15) = __float_as_uint(__uint_as_float(SLOT(j, 13)) * gelu_fast(__uint_as_float(SLOT(j, 11)) * d1));
  }
  v2f accv[4][16];
#pragma unroll
  for (int j = 0; j < 4; ++j)
#pragma unroll
    for (int i = 0; i < 16; ++i) accv[j][i] = v2f{0.f, 0.f};
  {
    int eX = (int)SLOT(0, 8);
#pragma unroll 1
    for (int sg = 0; sg < 8; ++sg) {
      const int L0 = (sg & 3) * 16;
      __builtin_amdgcn_s_barrier();
#pragma unroll
      for (int j = 0; j < 4; ++j) {
        const int jn = (j + 1) & 3, sgn = (j == 3) ? ((sg + 1) & 7) : sg, L0n = (sgn & 3) * 16;
        const float cf = __uint_as_float(SLOT(j, 14 + (sg >> 2)));
        const int eXn = (int)SLOT(jn, 8 + (sgn >> 2));
        G_LOAD(rB, ev4, eX, L0 + 4)
        __builtin_amdgcn_sched_barrier(0);
        G_COMP_V(rA, accv[j], cf, L0)
        G_LOAD(rA, ev4, eX, L0 + 8)
        __builtin_amdgcn_sched_barrier(0);
        G_COMP_V(rB, accv[j], cf, L0 + 4)
        G_LOAD(rB, ev4, eX, L0 + 12)
        __builtin_amdgcn_sched_barrier(0);
        G_COMP_V(rA, accv[j], cf, L0 + 8)
        G_LOAD(rA, ev4, eXn, L0n)
        __builtin_amdgcn_sched_barrier(0);
        G_COMP_V(rB, accv[j], cf, L0 + 12)
        eX = eXn;
      }
    }
  }
#undef G_LOAD
#undef G_COMP_U
#undef G_COMP_V
#undef PKFMA
#pragma unroll
  for (int j = 0; j < 4; ++j) {
    const int t = tg0 + j * tstr;
    if (t < S) {
#define acc2 accv[j]
  float acc[32];
  #pragma unroll
    for (int i = 0; i < 16; ++i) { acc[2 * i] = acc2[i].x; acc[2 * i + 1] = acc2[i].y; }
    int le = lane;
    asm volatile("" : "+v"(le) :: "memory");
    float s = 0.f;
  #pragma unroll
    for (int i = 0; i < 8; ++i) {
      const u32x2 w = *(const u32x2*)(hbuf + (size_t)t * DM + 256 * i + 4 * le);
      const float h0 = __uint_as_float(w[0] << 16), h1 = __uint_as_float(w[0] & 0xFFFF0000u), h2 = __uint_as_float(w[1] << 16), h3 = __uint_as_float(w[1] & 0xFFFF0000u);
      acc[i * 4 + 0] = fmaf(ALPHA, h0, acc[i * 4 + 0]); acc[i * 4 + 1] = fmaf(ALPHA, h1, acc[i * 4 + 1]);
      acc[i * 4 + 2] = fmaf(ALPHA, h2, acc[i * 4 + 2]); acc[i * 4 + 3] = fmaf(ALPHA, h3, acc[i * 4 + 3]);
      s += (acc[i * 4 + 0] + acc[i * 4 + 1]) + (acc[i * 4 + 2] + acc[i * 4 + 3]);
    }
    s = wsum(s);
    const float mu = s * (1.f / DM);
    float qv = 0.f;
  #pragma unroll
    for (int i = 0; i < 32; ++i) { const float d = acc[i] - mu; qv += d * d; }
    qv = wsum(qv);
    const float rs = rsqrtf(qv * (1.f / DM) + 1e-5f);
  #pragma unroll
    for (int i = 0; i < 8; ++i) {
      const int cbase = 256 * i + 4 * le;
      f32x4 ga = *(const f32x4*)(gam + cbase), ba = *(const f32x4*)(bet + cbase), o;
  #pragma unroll
      for (int j = 0; j < 4; ++j) o[j] = (acc[i * 4 + j] - mu) * rs * ga[j] + ba[j];
      *(f32x4*)(out + (size_t)t * DM + cbase) = o;
    }
#undef acc2
    }
  }
#undef SLOT
}

constexpr size_t al256(size_t x) { return (x + 255) & ~(size_t)255; }
constexpr size_t WS_XB = 0;
constexpr size_t WS_PROJ = WS_XB + al256((size_t)S * DM * 2);
constexpr size_t WS_WINT = WS_PROJ + al256((size_t)S * INWP * 2);
constexpr size_t WS_GATES = WS_WINT + al256((size_t)INWG * DM * 2);
constexpr size_t WS_W1KF = WS_GATES + al256((size_t)S * 24 * 4);
constexpr size_t WS_W1VF = WS_W1KF + al256((size_t)512 * 4096 * 2);
constexpr size_t WS_W2KF = WS_W1VF + al256((size_t)512 * 4096 * 2);
constexpr size_t WS_W2VF = WS_W2KF + al256((size_t)512 * 128 * 2);
constexpr size_t WS_VC = WS_W2VF + al256((size_t)512 * 128 * 2) - al256((size_t)2048 * 128 * 4);
constexpr size_t WS_KCF = WS_VC + al256((size_t)2048 * 128 * 4);
constexpr size_t WS_VCF = WS_KCF + al256((size_t)2 * 32 * 4096 * 2);
constexpr size_t WS_KSF = WS_VCF + al256((size_t)2 * 32 * 4096 * 2);
constexpr size_t WS_VSF = WS_KSF + al256((size_t)2 * 512 * 4096 * 2);
constexpr size_t WS_KWF = WS_VSF + al256((size_t)2 * 512 * 4096 * 2);
constexpr size_t WS_VWF = WS_KWF + al256((size_t)2 * 512 * 4096 * 2);
constexpr size_t WS_ENDA = WS_VWF + al256((size_t)2 * 512 * 4096 * 2);
constexpr size_t WS_OATT = WS_ENDA;
constexpr size_t WS_MIX = WS_OATT + al256((size_t)S * 1024 * 4);
constexpr size_t WS_WOUTT = WS_MIX + al256((size_t)S * DM * 2);
constexpr size_t WS_WQT = WS_WOUTT + al256((size_t)DM * DM * 2);
constexpr size_t WS_TOPS = WS_WQT + al256((size_t)DM * DM * 2);
constexpr size_t WS_SKF = WS_TOPS + al256((size_t)S * 256 * 4);
constexpr size_t WS_STATS = WS_SKF + al256((size_t)16 * 128 * 128 * 2);
constexpr size_t WS_CTRL = WS_STATS + al256((size_t)S * 2 * 4);
constexpr size_t CTRL_BYTES = 32768;
constexpr size_t WS_END = WS_CTRL + CTRL_BYTES;
constexpr size_t WS_Y = WS_PROJ;
constexpr size_t WS_HB = WS_XB;
constexpr size_t WS_EU8 = WS_OATT;
constexpr size_t WS_EV8 = WS_EU8 + (size_t)16384 * 1024;
constexpr size_t WS_ESU = WS_EV8 + (size_t)16384 * 1024;
constexpr size_t WS_ESV = WS_ESU + 16384 * 4;
static_assert(WS_ESV + 16384 * 4 <= WS_MIX, "expert tables overflow their region");
constexpr int EXP_EARLY = 6144;
static_assert(WS_END <= (size_t)512 * 1024 * 1024, "workspace over 512 MiB");

struct Params {
  const float *x, *w_in, *ck_pos, *ck_w1, *ck_b1, *ck_w2, *cv_pos, *cv_w1, *cv_b1, *cv_w2, *conv_w, *hng, *w_out, *ln1g, *ln1b, *w_query, *subk,
      *eu, *ev, *ln2g, *ln2b;
  float* out;
  char* ws;
};
#define WSP(T, OFF) ((T*)(p.ws + (OFF)))

#define FOR_VB(n) for (int vb = blockIdx.x; vb < (n); vb += gridDim.x)
#define FOR_VB2(n) for (int vb = blockIdx.x * 2 + (TIDX >> 8); vb < (n); vb += gridDim.x * 2)
constexpr int SMEM_BYTES = 147456;
constexpr int HALF = 36864;

__global__ void __launch_bounds__(512) mega(Params p) {
  __shared__ __attribute__((aligned(16))) char smem[SMEM_BYTES + 16];
  if (TIDX == 0) *(u32x4*)(smem + SMEM_BYTES) = u32x4{0u, 0u, 0u, 0u};
  __syncthreads();
  const XcdBarrier xbar = xcd_barrier_post(WSP(unsigned, WS_CTRL + 1024), (volatile LAS unsigned*)(smem + SMEM_BYTES));
#define smh (smem + (TIDX >> 8) * HALF)
#define wv ((TIDX >> 6))
  constexpr int NWV = 8;
  d_cvt(p.x, WSP(bf16_t, WS_XB), (size_t)S * DM / 4);
  FOR_VB2((INWG / 64) * (DM / 64)) d_cvtT64(vb, smh, p.w_in, WSP(bf16_t, WS_WINT), DM, INW, INWG);
  for (size_t c = (size_t)blockIdx.x * 512 + TIDX; c < (size_t)16 * 256 * 64; c += (size_t)gridDim.x * 512) {
    d_cvt_w1f(c, p.ck_w1, WSP(bf16_t, WS_W1KF)); d_cvt_w1f(c, p.cv_w1, WSP(bf16_t, WS_W1VF));
    if (c < (size_t)4 * 32 * 64) { d_cvt_w2f(c, p.ck_w2, WSP(bf16_t, WS_W2KF)); d_cvt_w2f(c, p.cv_w2, WSP(bf16_t, WS_W2VF)); }
  }
  FOR_VB2((DM / 64) * (DM / 64)) d_cvtT64(vb, smh, p.w_out, WSP(bf16_t, WS_WOUTT), DM, DM, DM);
  FOR_VB2((DM / 64) * (DM / 64)) d_cvtT64(vb, smh, p.w_query, WSP(bf16_t, WS_WQT), DM, DM, DM);
  for (size_t c = (size_t)blockIdx.x * 512 + TIDX; c < (size_t)16 * 4 * 8 * 64; c += (size_t)gridDim.x * 512) d_cvt_subk(c, p.subk, WSP(bf16_t, WS_SKF));
  xcd_barrier(xbar);
  {
    pg8::StaticOrder so; so.init(S, INWG, gridDim.x, blockIdx.x);
    pg8::gemm_phase<EpiProjG, pg8::StaticOrder>((PG8_LAS unsigned char*)smem, pg8::Gemm{WSP(bf16_t, WS_XB), WSP(bf16_t, WS_WINT), S, INWG, DM}, so,
                                                EpiProjG{WSP(bf16_t, WS_PROJ), WSP(float, WS_GATES), (PG8_LAS unsigned char*)smem + pg8::STAGE_BYTES}, nullptr);
    const int nun = (S / 256) * (INWG / 256), gsz = (int)gridDim.x;
    const int nfull = nun % gsz;
    if (nfull != 0 && (int)blockIdx.x >= nfull) {
      const int nidle = gsz - nfull, me = (int)blockIdx.x - nfull;
      for (int r = me * NWV + wv; r < 2 * EXP_EARLY; r += nidle * NWV) {
        if (r < EXP_EARLY) d_cvt_i4_row(r, p.eu, WSP(unsigned char, WS_EU8), WSP(float, WS_ESU)); else d_cvt_fp4_row(r - EXP_EARLY, p.ev, WSP(unsigned char, WS_EV8), WSP(float, WS_ESV));
      }
    }
  }
  xcd_barrier(xbar);
  {
    if (blockIdx.x < 128) {
      const int xcd_ = blockIdx.x & 7, idx_ = blockIdx.x >> 3; const bool isV = (xcd_ & 1) != 0;
      d_compress_unit((xcd_ >> 1) * 16 + idx_, smem, WSP(bf16_t, WS_PROJ), isV ? OFF_VC : OFF_KC, isV ? p.cv_pos : p.ck_pos, isV ? WSP(bf16_t, WS_W1VF) : WSP(bf16_t, WS_W1KF),
                      isV ? p.cv_b1 : p.ck_b1, isV ? WSP(bf16_t, WS_W2VF) : WSP(bf16_t, WS_W2KF), isV ? WSP(bf16_t, WS_VCF) : WSP(bf16_t, WS_KCF), isV);
    }
    int* slot = (int*)smem;
    unsigned* ctr = WSP(unsigned, WS_CTRL);
    if (TIDX == 0) slot[0] = (int)atomicAdd(ctr, 1u);
    __syncthreads();
    int it = slot[0];
    bf16_t* Ls = (bf16_t*)(smem + 64);
#pragma unroll 1
    for (int n = 0; it < 2048; ++n) {
      int nxt = 0;
      if (TIDX == 0) nxt = (int)atomicAdd(ctr, 1u);
      const int tt = TIDX;
      const int T = it >> 2, which = it & 3;
      const int col0 = (which == 0) ? OFF_KS : (which == 1) ? OFF_VS : (which == 2) ? OFF_KW : OFF_VW;
      bf16_t* dst = (which == 0) ? WSP(bf16_t, WS_KSF) : (which == 1) ? WSP(bf16_t, WS_VSF) : (which == 2) ? WSP(bf16_t, WS_KWF) : WSP(bf16_t, WS_VWF);
      const bool isV = (which & 1) != 0;
      u32x4 rv[2];
#pragma unroll
      for (int q = 0; q < 2; ++q) {
        const int cidx = tt + q * 512;
        const int g = cidx >> 9, tok = (cidx >> 4) & 31, ch = cidx & 15;
        rv[q] = *(const u32x4*)(WSP(bf16_t, WS_PROJ) + (size_t)(32 * T + tok) * INWP + col0 + g * 128 + ch * 8);
      }
      for (int q = 0; q < 2; ++q) d_convmix(it * 8 + q * 4 + (tt >> 7), tt & 127, WSP(bf16_t, WS_PROJ), p.conv_w, p.hng, WSP(bf16_t, WS_MIX));
#pragma unroll
      for (int q = 0; q < 2; ++q) {
        const int cidx = tt + q * 512;
        const int g = cidx >> 9, tok = (cidx >> 4) & 31, ch = cidx & 15;
        *(u32x4*)(Ls + (g * 32 + tok) * 136 + ch * 8) = rv[q];
      }
      if (TIDX == 0) slot[(n + 1) & 1] = nxt;
      __syncthreads();
#pragma unroll
      for (int q = 0; q < 2; ++q) {
        const int oc = tt + q * 512;
        const int g = oc >> 9, r9 = oc & 511, lane = r9 & 63;
        u32x4 o;
        if (!isV) {
          const int s8 = r9 >> 6, i = lane & 31, h = lane >> 5;
          o = *(const u32x4*)(Ls + (g * 32 + pi_perm(i)) * 136 + 16 * s8 + 8 * h);
        } else {
          const int s2 = (r9 >> 6) & 1, dt = r9 >> 7, dd = lane & 31, h = lane >> 5;
          const bf16_t* col = Ls + (g * 32 + 16 * s2 + 8 * h) * 136 + 32 * dt + dd;
          unsigned short e[8];
#pragma unroll
          for (int j = 0; j < 8; ++j) e[j] = col[j * 136];
          o.x = e[0] | ((unsigned)e[1] << 16); o.y = e[2] | ((unsigned)e[3] << 16); o.z = e[4] | ((unsigned)e[5] << 16); o.w = e[6] | ((unsigned)e[7] << 16);
        }
        *(u32x4*)(dst + (((size_t)(g * 512 + T)) * 512 + r9) * 8) = o;
      }
      it = slot[(n + 1) & 1];
      __syncthreads();
    }
  }
  xcd_barrier(xbar);
  {
    AttnPtrs ap{WSP(bf16_t, WS_PROJ), WSP(float, WS_GATES), WSP(bf16_t, WS_KCF), WSP(bf16_t, WS_VCF), WSP(bf16_t, WS_KSF), WSP(bf16_t, WS_VSF), WSP(bf16_t, WS_KWF), WSP(bf16_t, WS_VWF), WSP(bf16_t, WS_MIX), p.hng};
    for (int it = blockIdx.x; it < 512; it += gridDim.x) {
      const int Bq = (it < 256) ? it : (511 - it), gq = (it < 256) ? 0 : 1;
      d_attn_block(Bq, gq, smem, ap);
    }
  }
  xcd_barrier(xbar);
  {
    pg8::StaticOrder so; so.init(S, DM, gridDim.x, blockIdx.x);
    pg8::gemm_phase<EpiResG, pg8::StaticOrder>((PG8_LAS unsigned char*)smem, pg8::Gemm{WSP(bf16_t, WS_MIX), WSP(bf16_t, WS_WOUTT), S, DM, DM}, so,
                                               EpiResG{WSP(bf16_t, WS_HB), (PG8_LAS unsigned char*)smem + pg8::STAGE_BYTES}, nullptr);
  }
  xcd_barrier(xbar);
  {
    const int e0_ = (((S / 256) * (INWG / 256)) % (int)gridDim.x != 0) ? EXP_EARLY : 0;
    const int nrest = 16384 - e0_, ncv = 2 * nrest, wstr = (int)gridDim.x * NWV, lane_ = TIDX & 63;
    int rl = blockIdx.x * NWV + wv, rc = rl;
    u32x4 lcur[4], lnxt[4]; f32x4 ccur[8], cnxt[8];
#define P8_LDLN(R, r_) { _Pragma("unroll") for (int i = 0; i < 4; ++i) R[i] = *(const u32x4*)(WSP(bf16_t, WS_HB) + (size_t)(r_) * DM + 512 * i + 8 * lane_); }
#define P8_LDCV(R, r_) { const float* src_ = ((r_) < nrest) ? p.eu + (size_t)(e0_ + (r_)) * DM : p.ev + (size_t)(e0_ + (r_) - nrest) * DM; \
                         _Pragma("unroll") for (int i = 0; i < 8; ++i) R[i] = *(const f32x4*)(src_ + 256 * i + 4 * lane_); }
    if (rl < S) P8_LDLN(lcur, rl)
    if (rc < ncv) P8_LDCV(ccur, rc)
#pragma unroll 1
    while (rl < S || rc < ncv) {
      const int rln = rl + wstr, rcn = rc + wstr;
      if (rln < S) P8_LDLN(lnxt, rln)
      if (rcn < ncv) P8_LDCV(cnxt, rcn)
      __builtin_amdgcn_sched_barrier(0);
      if (rl < S) d_ln_fin(rl, lcur, WSP(bf16_t, WS_HB), p.ln1g, p.ln1b);
      if (rc < ncv) {
        if (rc < nrest) d_cvt_i4_fin(e0_ + rc, ccur, WSP(unsigned char, WS_EU8), WSP(float, WS_ESU));
        else d_cvt_fp4_fin(e0_ + rc - nrest, ccur, WSP(unsigned char, WS_EV8), WSP(float, WS_ESV));
      }
      __builtin_amdgcn_sched_barrier(0);
#pragma unroll
      for (int i = 0; i < 4; ++i) lcur[i] = lnxt[i];
#pragma unroll
      for (int i = 0; i < 8; ++i) ccur[i] = cnxt[i];
      rl = rln; rc = rcn;
    }
#undef P8_LDLN
#undef P8_LDCV
  }
  xcd_barrier(xbar);
  for (int k = 0; k * (int)gridDim.x < (S / 256) * (DM / 256); ++k) {
    pg8::OneUnit so; so.init(S, DM, gridDim.x, blockIdx.x); so.k = k;
    pg8::gemm_phase<EpiRouteG, pg8::OneUnit>((PG8_LAS unsigned char*)smem, pg8::Gemm{WSP(bf16_t, WS_HB), WSP(bf16_t, WS_WQT), S, DM, DM}, so,
                                             EpiRouteG{WSP(bf16_t, WS_SKF), WSP(unsigned, WS_TOPS)}, nullptr);
    __syncthreads();
  }
  xcd_barrier(xbar);
  {
    const int tstr = (int)gridDim.x * NWV;
    for (int tg0 = blockIdx.x * NWV + wv; tg0 < S; tg0 += 4 * tstr)
      d_expert_group(tg0, tstr, (unsigned*)(smem + wv * 1024), (unsigned*)(smem + 8192 + wv * 16384), WSP(bf16_t, WS_HB), WSP(unsigned, WS_TOPS), WSP(unsigned char, WS_EU8), WSP(unsigned char, WS_EV8),
                     WSP(float, WS_ESU), WSP(float, WS_ESV), p.ln2g, p.ln2b, p.out);
  }
}

extern "C" void kernel_launch(void* const* d_in, const int* in_sizes, int n_in, void* d_out, int out_size, void* d_ws, size_t ws_size,
                              hipStream_t stream) {
  Params p{};
  p.x = (const float*)d_in[0]; p.w_in = (const float*)d_in[1]; p.ck_pos = (const float*)d_in[2]; p.ck_w1 = (const float*)d_in[3];
  p.ck_b1 = (const float*)d_in[4]; p.ck_w2 = (const float*)d_in[5]; p.cv_pos = (const float*)d_in[6]; p.cv_w1 = (const float*)d_in[7];
  p.cv_b1 = (const float*)d_in[8]; p.cv_w2 = (const float*)d_in[9]; p.conv_w = (const float*)d_in[10]; p.hng = (const float*)d_in[11];
  p.w_out = (const float*)d_in[12]; p.ln1g = (const float*)d_in[13]; p.ln1b = (const float*)d_in[14]; p.w_query = (const float*)d_in[15];
  p.subk = (const float*)d_in[16]; p.eu = (const float*)d_in[17]; p.ev = (const float*)d_in[18]; p.ln2g = (const float*)d_in[19];
  p.ln2b = (const float*)d_in[20];
  p.out = (float*)d_out;
  p.ws = (char*)d_ws;
  if (ws_size < WS_END) fprintf(stderr, "workspace too small\n");
  static int grid_blocks = 0;
  if (!grid_blocks) {
    int dev = 0, cus = 0, per_cu = 0;
    hipGetDevice(&dev);
    hipDeviceGetAttribute(&cus, hipDeviceAttributeMultiprocessorCount, dev);
    hipOccupancyMaxActiveBlocksPerMultiprocessor(&per_cu, mega, 512, 0);
    if (per_cu > 1) per_cu = 1;
    if (per_cu < 1) per_cu = 1;
    grid_blocks = cus * per_cu;
  }
  hipMemsetAsync((char*)d_ws + WS_CTRL, 0, CTRL_BYTES, stream);
  void* args[] = {&p};
  hipError_t e = hipLaunchCooperativeKernel((void*)mega, dim3(grid_blocks), dim3(512), args, 0, stream);
  if (e != hipSuccess) fprintf(stderr, "cooperative launch failed: %s (grid %d)\n", hipGetErrorString(e), grid_blocks);
}
```

```cpp
#include <hip/hip_runtime.h>
#include <stdint.h>
#include <stdio.h>


#define DI __device__ __forceinline__
static __device__ __forceinline__ int tidx_() { int t = (int)__builtin_amdgcn_workitem_id_x(); asm volatile("" : "+v"(t)); return t; }
#define TIDX (tidx_())

template <int J> DI int swz_xor(int x) { return __builtin_amdgcn_ds_swizzle(x, (J << 10) | 0x1F); }
template <int CTRL> DI int dpp_i(int x) { return __builtin_amdgcn_update_dpp(x, x, CTRL, 0xF, 0xF, false); }
DI int shx_i(int x, int j) {
  switch (j) {
    case 1: return dpp_i<0xB1>(x);
    case 2: return dpp_i<0x4E>(x);
    case 4: return dpp_i<0x1B>(dpp_i<0x141>(x));
    case 8: return dpp_i<0x128>(x);
    case 16: return swz_xor<16>(x);
    default: {
      auto r = __builtin_amdgcn_permlane32_swap((unsigned)x, (unsigned)x, false, false);
      return (TIDX & 32) ? (int)r[0] : (int)r[1];
    }
  }
}
DI float shx(float x, int j) { return __int_as_float(shx_i(__float_as_int(x), j)); }
typedef unsigned short bf16_t;
using bf16x8 = __attribute__((ext_vector_type(8))) short;
using f32x4 = __attribute__((ext_vector_type(4))) float;
using u32x4 = __attribute__((ext_vector_type(4))) unsigned;
using u32x2 = __attribute__((ext_vector_type(2))) unsigned;

constexpr int S = 16384, DM = 2048, HD = 128;
constexpr int INW = 5656, INWP = 5760, INWG = 5888;
constexpr int OFF_Q = 0, OFF_KC = 1024, OFF_VC = 1280, OFF_KS = 1536, OFF_VS = 1792, OFF_KW = 2048, OFF_VW = 2304,
              OFF_G = 2560, OFF_U = 2584, OFF_B = 3608, OFF_C = 4632;
constexpr int NCMP = 1023;
constexpr float ALPHA = 1.189207115002721f;
constexpr float QSCALE = 0.08838834764831845f;

DI bf16_t f2bf(float x) { unsigned u = __float_as_uint(x); u += 0x7fffu + ((u >> 16) & 1u); return (bf16_t)(u >> 16); }
DI float bf2f(bf16_t b) { return __uint_as_float(((unsigned)b) << 16); }
DI float gelu_tanh(float x) { float u = 0.7978845608028654f * (x + 0.044715f * x * x * x); return 0.5f * x * (1.f + tanhf(u)); }
DI float wave_sum(float v) { for (int o = 32; o > 0; o >>= 1) v += shx(v, o); return v; }
using bf16x2v = __attribute__((ext_vector_type(2))) __bf16;
DI unsigned pack2(float a, float b) { bf16x2v v = {(__bf16)a, (__bf16)b}; return __builtin_bit_cast(unsigned, v); }
DI float wave_max(float v) { for (int o = 32; o > 0; o >>= 1) v = fmaxf(v, shx(v, o)); return v; }

namespace pg8 {
#define PG8_LAS __attribute__((address_space(3)))
typedef unsigned short bf16_t;
typedef short bf16x8 __attribute__((ext_vector_type(8)));
typedef float f32x4 __attribute__((ext_vector_type(4)));
typedef unsigned u32x4 __attribute__((ext_vector_type(4)));
constexpr int BM = 256, BK = 64, HALF = 128, HTB = HALF * BK * 2  , STAGE_BYTES = 8 * HTB, NXCD = 8, WGM = 8;

__host__ __device__ __forceinline__ int lds_byte(int r, int c) { const int st = (r >> 4) * 2 + (c >> 5), rr = r & 15, cc = c & 31, ob = rr * 64 + cc * 2; return st * 1024 + (ob ^ (((ob >> 9) & 1) << 5)); }
__host__ __device__ __forceinline__ void stage_rc(int b, int& R, int& C) { const int st = b / 1024, sb = b % 1024, swz = sb ^ (((sb >> 9) & 1) << 5); R = (st >> 1) * 16 + swz / 64; C = (st & 1) * 32 + (swz % 64) / 2; }
__host__ __device__ __forceinline__ int perm32(int rho) { const int n = rho >> 4, i = rho & 15; return 8 * (i >> 2) + 4 * n + (i & 3); }

struct Unit { int pm, pn; };
struct Gemm { const bf16_t* A; const bf16_t* Bt; int M, N, K; };

struct StaticOrder {
    int nM, nN, nwg, G, c;
    __host__ __device__ void init(int M, int N, int G_, int c_) { nM = M / BM; nN = N / BM; nwg = nM * nN; G = G_; c = c_; }
    __host__ __device__ bool next(int i, Unit& u) const {
        const long L = (long)i * G + c; if (L >= nwg) return false;
        int wgid = (int)L; { const int q = nwg / NXCD, r = nwg % NXCD, xcd = wgid % NXCD, off = wgid / NXCD; wgid = (xcd < r ? xcd * (q + 1) : r * (q + 1) + (xcd - r) * q) + off; }
        const int nig = WGM * nN, gid = wgid / nig, fm = gid * WGM, gsz = (nM - fm) < WGM ? (nM - fm) : WGM;
        u.pm = fm + ((wgid % nig) % gsz); u.pn = (wgid % nig) / gsz; return true;
    }
    __device__ __forceinline__ void a_ready(const Unit&) const {}
    __device__ __forceinline__ void done(const Unit&) const {}
};
struct OneUnit : StaticOrder {
    int k;
    __device__ bool next(int i, Unit& u) const { if (i > 0) return false; return StaticOrder::next(k, u); }
};
__device__ __forceinline__ unsigned cvt_pk_bf16(float lo, float hi) { unsigned r; asm volatile("v_cvt_pk_bf16_f32 %0, %1, %2" : "=v"(r) : "v"(lo), "v"(hi)); return r; }
template <class Epi, class Sched, bool STAMP = false>
__device__ __forceinline__ void gemm_phase(PG8_LAS unsigned char* lds, const Gemm g, const Sched& S, const Epi& E, unsigned long long* stamps) {
    const int tid = TIDX, wid = __builtin_amdgcn_readfirstlane(tid >> 6), lane = tid & 63, wr = wid >> 2, wc = wid & 3, fr = lane & 15, fq = lane >> 4;
    const int K = g.K, nt = K / BK;
    int ts_lo = 0, ts_hi = 0, nts = 0; const unsigned long long rt_entry = STAMP ? (unsigned long long)wall_clock64() : 0ull;
#define PG8_STAMP() do { if (STAMP && wid == 0 && nts < 64) { const unsigned long long _c = (unsigned long long)clock64(); \
        ts_lo = (lane == nts) ? (int)(unsigned)_c : ts_lo; ts_hi = (lane == nts) ? (int)(unsigned)(_c >> 32) : ts_hi; ++nts; } } while (0)
    PG8_STAMP();
    unsigned voffA[2], voffB[2];
#pragma unroll
    for (int i = 0; i < 2; ++i) { int R, C; stage_rc(tid * 16 + i * 8192, R, C); const int Rb = Epi::PERM ? ((R & ~31) + perm32(R & 31)) : R;
        voffA[i] = (unsigned)(R * K + C) * 2u; voffB[i] = (unsigned)(Rb * K + C) * 2u; }
    const size_t kstep = (size_t)(BK * 2);
    const size_t hstep = (size_t)HALF * K * 2;
    const size_t tstep = 2 * hstep;
    const unsigned ldsw = (unsigned)wid * 1024u;
    const int aoff = lds_byte(wr * 64 + fr, fq * 8), boff = lds_byte(wc * 32 + fr, fq * 8);
#define PG8_SA(b, h) (((b) * 2 + (h)) * HTB)
#define PG8_SB(b, h) ((4 + (b) * 2 + (h)) * HTB)
#define PG8_STAGE(bufoff, gbase, voff) do { _Pragma("unroll") for (int _i = 0; _i < 2; ++_i) \
        __builtin_amdgcn_global_load_lds((const unsigned*)((const char*)(gbase) + (voff)[_i]), (PG8_LAS unsigned*)(lds + (bufoff) + ldsw + _i * 8192), 16, 0, 0); } while (0)
#define PG8_LDA(dst, b, h) do { _Pragma("unroll") for (int m = 0; m < 4; ++m) _Pragma("unroll") for (int k = 0; k < 2; ++k) dst[m][k] = *(const PG8_LAS bf16x8*)(lds + PG8_SA(b, h) + aoff + m * 2048 + k * 1024); } while (0)
#define PG8_LDB(dst, b, h) do { _Pragma("unroll") for (int n = 0; n < 2; ++n) _Pragma("unroll") for (int k = 0; k < 2; ++k) dst[n][k] = *(const PG8_LAS bf16x8*)(lds + PG8_SB(b, h) + boff + n * 2048 + k * 1024); } while (0)
#define PG8_MMA(ai, bj, At, Bt) do { __builtin_amdgcn_s_setprio(1); _Pragma("unroll") for (int m = 0; m < 4; ++m) _Pragma("unroll") for (int n = 0; n < 2; ++n) _Pragma("unroll") for (int k = 0; k < 2; ++k) \
        acc[ai][bj][m][n] = __builtin_amdgcn_mfma_f32_16x16x32_bf16(Bt[n][k], At[m][k], acc[ai][bj][m][n], 0, 0, 0); __builtin_amdgcn_s_setprio(0); } while (0)
#define PG8_WAIT_V(n) asm volatile("s_waitcnt vmcnt(" #n ")" ::: "memory")
#define PG8_WAIT_L(n) asm volatile("s_waitcnt lgkmcnt(" #n ")" ::: "memory")
#define PG8_BAR __builtin_amdgcn_s_barrier()
#define PG8_SCHED __builtin_amdgcn_sched_barrier(0)
    Unit cur, nxt; int ui = 0;
    if (!S.next(0, cur)) return;
    f32x4 acc[2][2][4][2];
#pragma unroll
    for (int a = 0; a < 2; ++a)
#pragma unroll
        for (int b = 0; b < 2; ++b)
#pragma unroll
            for (int m = 0; m < 4; ++m)
#pragma unroll
                for (int n = 0; n < 2; ++n) acc[a][b][m][n] = (f32x4){0.f, 0.f, 0.f, 0.f};
    bf16x8 At[4][2], B0[2][2], B1[2][2];
    const char* cA = (const char*)g.A + (size_t)cur.pm * tstep; const char* cB = (const char*)g.Bt + (size_t)cur.pn * tstep;
    S.a_ready(cur);
    PG8_STAGE(PG8_SB(0, 0), cB, voffB); PG8_STAGE(PG8_SA(0, 0), cA, voffA); PG8_STAGE(PG8_SB(0, 1), cB + hstep, voffB); PG8_STAGE(PG8_SA(0, 1), cA + hstep, voffA);
    if (wr == 1) PG8_BAR;
    PG8_WAIT_V(4); PG8_BAR;
    PG8_STAGE(PG8_SB(1, 0), cB + kstep, voffB); PG8_STAGE(PG8_SA(1, 0), cA + kstep, voffA); PG8_STAGE(PG8_SB(1, 1), cB + hstep + kstep, voffB);
    PG8_WAIT_V(6); PG8_BAR;
    PG8_STAMP();
    for (;;) {
        const bool has_next = S.next(ui + 1, nxt);
        const char* nA = has_next ? (const char*)g.A + (size_t)nxt.pm * tstep : cA; const char* nB = has_next ? (const char*)g.Bt + (size_t)nxt.pn * tstep : cB;
        for (int t = 0; t < nt; t += 2) {
            const bool last = (t == nt - 2);
            const char* a1 = cA + (size_t)(t + 1) * kstep;
            const char* a2 = last ? nA : cA + (size_t)(t + 2) * kstep; const char* b2 = last ? nB : cB + (size_t)(t + 2) * kstep;
            const char* a3 = a2 + kstep; const char* b3 = b2 + kstep;
            if (last && has_next) S.a_ready(nxt);
            PG8_LDB(B0, 0, 0); PG8_SCHED; PG8_LDA(At, 0, 0); PG8_STAGE(PG8_SA(1, 1), a1 + hstep, voffA);
            PG8_WAIT_L(8); PG8_BAR; PG8_WAIT_L(0); PG8_MMA(0, 0, At, B0); PG8_BAR; PG8_SCHED;
            PG8_LDB(B1, 0, 1); PG8_STAGE(PG8_SB(0, 0), b2, voffB);
            PG8_BAR; PG8_WAIT_L(0); PG8_MMA(0, 1, At, B1); PG8_BAR;
            PG8_LDA(At, 0, 1); PG8_STAGE(PG8_SA(0, 0), a2, voffA);
            PG8_BAR; PG8_WAIT_L(0); PG8_MMA(1, 0, At, B0); PG8_BAR; PG8_SCHED;
            PG8_STAGE(PG8_SB(0, 1), b2 + hstep, voffB);
            PG8_WAIT_V(6); PG8_BAR; PG8_MMA(1, 1, At, B1); PG8_BAR;
            PG8_LDB(B0, 1, 0); PG8_SCHED; PG8_LDA(At, 1, 0); PG8_STAGE(PG8_SA(0, 1), a2 + hstep, voffA);
            PG8_WAIT_L(8); PG8_BAR; PG8_WAIT_L(0); PG8_MMA(0, 0, At, B0); PG8_BAR; PG8_SCHED;
            PG8_LDB(B1, 1, 1); PG8_STAGE(PG8_SB(1, 0), b3, voffB);
            PG8_BAR; PG8_WAIT_L(0); PG8_MMA(0, 1, At, B1); PG8_BAR;
            PG8_LDA(At, 1, 1); PG8_STAGE(PG8_SA(1, 0), a3, voffA);
            PG8_BAR; PG8_WAIT_L(0); PG8_MMA(1, 0, At, B0); PG8_BAR; PG8_SCHED;
            PG8_STAGE(PG8_SB(1, 1), b3 + hstep, voffB);
            PG8_WAIT_V(6); PG8_BAR; PG8_MMA(1, 1, At, B1); PG8_BAR;
        }
        PG8_STAMP();
        if constexpr (!Epi::AFTER_DRAIN) { E(acc, cur, wr, wc, fr, fq); S.done(cur); }
        PG8_STAMP();
        if (!has_next) break;
#pragma unroll
        for (int a = 0; a < 2; ++a)
#pragma unroll
            for (int b = 0; b < 2; ++b)
#pragma unroll
                for (int m = 0; m < 4; ++m)
#pragma unroll
                    for (int n = 0; n < 2; ++n) acc[a][b][m][n] = (f32x4){0.f, 0.f, 0.f, 0.f};
        cur = nxt; cA = nA; cB = nB; ++ui;
    }
    PG8_WAIT_V(0);
    if (wr == 0) PG8_BAR;
    PG8_BAR;
    if constexpr (Epi::AFTER_DRAIN) { E.fused(acc, cur, wr, wc, fr, fq, lds, wid, lane); S.done(cur); }
    PG8_STAMP();
    if (STAMP && wid == 0) { stamps[lane] = lane < nts ? (((unsigned long long)(unsigned)ts_hi << 32) | (unsigned)ts_lo) : 0ull;
        if (lane == 62) stamps[62] = rt_entry; if (lane == 63) stamps[63] = (unsigned long long)wall_clock64(); }
#undef PG8_STAMP
#undef PG8_SA
#undef PG8_SB
#undef PG8_STAGE
#undef PG8_LDA
#undef PG8_LDB
#undef PG8_MMA
#undef PG8_WAIT_V
#undef PG8_WAIT_L
#undef PG8_BAR
#undef PG8_SCHED
}
}

#define XB_TMO      128
#define XB_XCNT(j)  (256  + 64 * (j))
#define XB_XSUB(j)  (1280 + 64 * (j))
#define XB_XGEN(j)  (2304 + 64 * (j))
#define XB_TOP      3328
#define XB_TOPGEN   3392
#define XCD_BAR_WORDS 3456
#define XB_SPIN_CAP (1u << 18)
#define LAS __attribute__((address_space(3)))

__device__ __forceinline__ unsigned xb_ld(unsigned* p)              { return __hip_atomic_load(p, __ATOMIC_RELAXED, __HIP_MEMORY_SCOPE_AGENT); }
__device__ __forceinline__ unsigned xb_add(unsigned* p, unsigned v) { return __hip_atomic_fetch_add(p, v, __ATOMIC_RELAXED, __HIP_MEMORY_SCOPE_AGENT); }
__device__ __forceinline__ unsigned xb_xcc_id() { return (unsigned)__builtin_amdgcn_s_getreg((3 << 11) | 20) & 0xFu; }
#define XB_SPIN(cond, bar) do { unsigned _sp = 0; while (cond) { __builtin_amdgcn_s_sleep(1); \
    if ((++_sp & 255u) == 0u) { if (xb_ld(&(bar)[XB_TMO])) break; if (_sp > XB_SPIN_CAP) { atomicAdd(&(bar)[XB_TMO], 1u); break; } } } } while (0)

struct XcdBarrier {
    unsigned* bar; unsigned x;
    volatile LAS unsigned* st;
};

__device__ __forceinline__ XcdBarrier xcd_barrier_post(unsigned* bar, volatile LAS unsigned* st) {
    XcdBarrier b; b.bar = bar; b.x = xb_xcc_id(); b.st = st;
    if (TIDX == 0) (void)xb_add(&bar[XB_XCNT(b.x)], 1u);
    return b;
}
__device__ __forceinline__ void xcd_barrier_complete(unsigned* bar, unsigned x, unsigned& nloc, unsigned& nx) {
    const unsigned G = gridDim.x * gridDim.y * gridDim.z;
    unsigned sum, cnt, mine, sp = 0u;
    for (;;) {
        sum = 0u; cnt = 0u; mine = 0u;
#pragma unroll
        for (unsigned j = 0; j < 16; ++j) { const unsigned c = xb_ld(&bar[XB_XCNT(j)]); sum += c; cnt += (c > 0u) ? 1u : 0u; mine = (j == x) ? c : mine; }
        if (sum == G) break;
        __builtin_amdgcn_s_sleep(1);
        if ((++sp & 255u) == 0u) { if (xb_ld(&bar[XB_TMO])) break; if (sp > XB_SPIN_CAP) { atomicAdd(&bar[XB_TMO], 1u); break; } }
    }
    nloc = mine > 0u ? mine : 1u; nx = cnt > 0u ? cnt : 1u;
}

__device__ __forceinline__ void xcd_barrier(const XcdBarrier& b) {
    asm volatile("s_waitcnt vmcnt(0)" ::: "memory");
    __syncthreads();
    if (TIDX == 0) {
        unsigned* bar = b.bar;
        __builtin_amdgcn_s_waitcnt(0);
        unsigned nloc = b.st[0], nx = b.st[1];
        if (nloc == 0u) { xcd_barrier_complete(bar, b.x, nloc, nx); b.st[0] = nloc; b.st[1] = nx; }
        const unsigned old = xb_add(&bar[XB_XSUB(b.x)], 1u);
        const unsigned gen = old / nloc;
        if (old + 1u == (gen + 1u) * nloc) {
            __builtin_amdgcn_fence(__ATOMIC_RELEASE, "agent");
            asm volatile("s_waitcnt vmcnt(0)" ::: "memory");
            const unsigned og = xb_add(&bar[XB_TOP], 1u);
            const unsigned tg = og / nx;
            if (og + 1u == (tg + 1u) * nx) xb_add(&bar[XB_TOPGEN], 1u);
            else XB_SPIN(xb_ld(&bar[XB_TOPGEN]) == tg, bar);
            __builtin_amdgcn_fence(__ATOMIC_ACQUIRE, "agent");
            xb_add(&bar[XB_XGEN(b.x)], 1u);
            asm volatile("s_waitcnt vmcnt(0)" ::: "memory");
        } else {
            XB_SPIN(xb_ld(&bar[XB_XGEN(b.x)]) == gen, bar);
            __builtin_amdgcn_fence(__ATOMIC_ACQUIRE, "agent");
            asm volatile("s_waitcnt vmcnt(0)" ::: "memory");
        }
    }
    __syncthreads();
}

__device__ void d_cvt(const float* __restrict__ in, bf16_t* __restrict__ out, size_t n4) {
  const size_t stride = (size_t)gridDim.x * blockDim.x;
  size_t i = (size_t)blockIdx.x * blockDim.x + TIDX;
  for (; i + 3 * stride < n4; i += 4 * stride) {
    f32x4 v[4];
#pragma unroll
    for (int q = 0; q < 4; ++q) v[q] = ((const f32x4*)in)[i + q * stride];
#pragma unroll
    for (int q = 0; q < 4; ++q) { u32x2 o = {pack2(v[q][0], v[q][1]), pack2(v[q][2], v[q][3])}; ((u32x2*)out)[i + q * stride] = o; }
  }
  for (; i < n4; i += stride) { const f32x4 v = ((const f32x4*)in)[i]; u32x2 o = {pack2(v[0], v[1]), pack2(v[2], v[3])}; ((u32x2*)out)[i] = o; }
}
__device__ void d_cvtT64(int vb, char* smem, const float* __restrict__ W, bf16_t* __restrict__ WT, int K, int N, int NP) {
  float (*tt)[65] = (float (*)[65])smem;
  const int tid = (TIDX & 255);
  const int nbx = NP / 64;
  const int n0 = (vb % nbx) * 64, k0 = (vb / nbx) * 64;
  {
    const int kr = tid >> 4, nc = (tid & 15) * 4;
#pragma unroll
    for (int i = 0; i < 4; ++i) {
      const int k = k0 + kr + 16 * i, n = n0 + nc;
      f32x4 v = {0.f, 0.f, 0.f, 0.f};
      if (n < N) v = *(const f32x4*)(W + (size_t)k * N + n);
      tt[kr + 16 * i][nc] = v[0]; tt[kr + 16 * i][nc + 1] = v[1]; tt[kr + 16 * i][nc + 2] = v[2]; tt[kr + 16 * i][nc + 3] = v[3];
    }
  }
  __syncthreads();
  {
    const int nr = tid >> 3, kc = (tid & 7) * 8;
#pragma unroll
    for (int i = 0; i < 2; ++i) {
      const int nl = nr + 32 * i;
      u32x4 o = {pack2(tt[kc][nl], tt[kc + 1][nl]), pack2(tt[kc + 2][nl], tt[kc + 3][nl]), pack2(tt[kc + 4][nl], tt[kc + 5][nl]), pack2(tt[kc + 6][nl], tt[kc + 7][nl])};
      *(u32x4*)(WT + (size_t)(n0 + nl) * K + k0 + kc) = o;
    }
  }
  __syncthreads();
}

using f32x16 = __attribute__((ext_vector_type(16))) float;
using bf16x8v = __attribute__((ext_vector_type(8))) __bf16;
#define MFMA32(a, b, c) __builtin_amdgcn_mfma_f32_32x32x16_bf16((a), (b), (c), 0, 0, 0)
constexpr float LOG2E = 1.4426950408889634f;
constexpr float NEGB = -1e30f;
DI int pi_perm(int i) { return (i & ~12) | ((i & 8) >> 1) | ((i & 4) << 1); }
DI bf16x8 pack8(float a0, float a1, float a2, float a3, float a4, float a5, float a6, float a7) {
  bf16x8v v = {(__bf16)a0, (__bf16)a1, (__bf16)a2, (__bf16)a3, (__bf16)a4, (__bf16)a5, (__bf16)a6, (__bf16)a7};
  return __builtin_bit_cast(bf16x8, v);
}
__device__ __forceinline__ void d_relayout_tile(int T, char* smem, const bf16_t* __restrict__ proj, int col0, bf16_t* __restrict__ dst, bool isV) {
  bf16_t* Ls = (bf16_t*)smem;
  const int tid = TIDX;
#pragma unroll
  for (int q = 0; q < 2; ++q) {
    const int cidx = tid + q * 512;
    const int g = cidx >> 9, tok = (cidx >> 4) & 31, ch = cidx & 15;
    const u32x4 v = *(const u32x4*)(proj + (size_t)(32 * T + tok) * INWP + col0 + g * 128 + ch * 8);
    *(u32x4*)(Ls + (g * 32 + tok) * 136 + ch * 8) = v;
  }
  __syncthreads();
#pragma unroll
  for (int q = 0; q < 2; ++q) {
    const int oc = tid + q * 512;
    const int g = oc >> 9, r9 = oc & 511, lane = r9 & 63;
    u32x4 o;
    if (!isV) {
      const int s8 = r9 >> 6, i = lane & 31, h = lane >> 5;
      o = *(const u32x4*)(Ls + (g * 32 + pi_perm(i)) * 136 + 16 * s8 + 8 * h);
    } else {
      const int s2 = (r9 >> 6) & 1, dt = r9 >> 7, dd = lane & 31, h = lane >> 5;
      const bf16_t* col = Ls + (g * 32 + 16 * s2 + 8 * h) * 136 + 32 * dt + dd;
      unsigned short e[8];
#pragma unroll
      for (int j = 0; j < 8; ++j) e[j] = col[j * 136];
      o.x = e[0] | ((unsigned)e[1] << 16); o.y = e[2] | ((unsigned)e[3] << 16); o.z = e[4] | ((unsigned)e[5] << 16); o.w = e[6] | ((unsigned)e[7] << 16);
    }
    *(u32x4*)(dst + (((size_t)(g * 512 + T)) * 512 + r9) * 8) = o;
  }
  __syncthreads();
}

struct AttnPtrs {
  const bf16_t* proj; const float* gates;
  const bf16_t *kcf, *vcf, *ksf, *vsf, *kwf, *vwf;
  bf16_t* mix; const float* hng;
};

DI float ex2(float x) { return __builtin_amdgcn_exp2f(x); }
DI void halves(float x, float& lo, float& hi) {
  const unsigned u = __float_as_uint(x);
  auto r = __builtin_amdgcn_permlane32_swap(u, u, false, false);
  lo = __uint_as_float(r[0]); hi = __uint_as_float(r[1]);
}
DI float hmax(float x) { float a, b; halves(x, a, b); return fmaxf(a, b); }
DI float hsum(float x) { float a, b; halves(x, a, b); return a + b; }
DI float dpp_quad(float v, int ctrl_is_xor1) {
  const int iv = __float_as_int(v);
  const int r = ctrl_is_xor1 ? __builtin_amdgcn_update_dpp(iv, iv, 0xB1, 0xF, 0xF, false) : __builtin_amdgcn_update_dpp(iv, iv, 0x4E, 0xF, 0xF, false);
  return __int_as_float(r);
}
DI float quad_sum(float v) { v += dpp_quad(v, 1); v += dpp_quad(v, 0); return v; }
DI void osm_step(const float (&sv)[16], float& m, float& l, f32x16 (&O)[4], float (&p)[16]) {
  float tmax = fmaxf(fmaxf(fmaxf(sv[0], sv[1]), fmaxf(sv[2], sv[3])), fmaxf(fmaxf(sv[4], sv[5]), fmaxf(sv[6], sv[7])));
  tmax = fmaxf(tmax, fmaxf(fmaxf(fmaxf(sv[8], sv[9]), fmaxf(sv[10], sv[11])), fmaxf(fmaxf(sv[12], sv[13]), fmaxf(sv[14], sv[15]))));
  tmax = hmax(tmax);
  if (__ballot(tmax - m > 8.f)) {
    const float mn = fmaxf(m, tmax);
    const float alpha = ex2(m - mn);
    l *= alpha; m = mn;
#pragma unroll
    for (int dt = 0; dt < 4; ++dt)
#pragma unroll
      for (int r = 0; r < 16; ++r) O[dt][r] *= alpha;
  }
  float ps0 = 0.f, ps1 = 0.f;
#pragma unroll
  for (int r = 0; r < 16; r += 2) { const float e0 = ex2(sv[r] - m), e1 = ex2(sv[r + 1] - m); p[r] = e0; p[r + 1] = e1; ps0 += e0; ps1 += e1; }
  l += ps0 + ps1;
}
DI void ot_store(char* otL, int lane, const f32x16 (&O)[4], float sc) {
#pragma unroll
  for (int dt = 0; dt < 4; ++dt) {
    u32x4 a, b;
#pragma unroll
    for (int i = 0; i < 4; ++i) { a[i] = pack2(sc * O[dt][2 * i], sc * O[dt][2 * i + 1]); b[i] = pack2(sc * O[dt][8 + 2 * i], sc * O[dt][8 + 2 * i + 1]); }
    *(u32x4*)(otL + lane * 128 + dt * 32) = a;
    *(u32x4*)(otL + lane * 128 + dt * 32 + 16) = b;
  }
}
DI void ot_accum(const char* otL, int lane, f32x16 (&O)[4], float sc) {
#pragma unroll
  for (int dt = 0; dt < 4; ++dt) {
    u32x4 a = *(const u32x4*)(otL + lane * 128 + dt * 32);
    u32x4 b = *(const u32x4*)(otL + lane * 128 + dt * 32 + 16);
#pragma unroll
    for (int i = 0; i < 4; ++i) {
      const unsigned wa = a[i], wb = b[i];
      O[dt][2 * i] = fmaf(sc, O[dt][2 * i], __uint_as_float(wa << 16));
      O[dt][2 * i + 1] = fmaf(sc, O[dt][2 * i + 1], __uint_as_float(wa & 0xFFFF0000u));
      O[dt][8 + 2 * i] = fmaf(sc, O[dt][8 + 2 * i], __uint_as_float(wb << 16));
      O[dt][8 + 2 * i + 1] = fmaf(sc, O[dt][8 + 2 * i + 1], __uint_as_float(wb & 0xFFFF0000u));
    }
  }
}
DI void zero_o(f32x16 (&O)[4]) {
#pragma unroll
  for (int dt = 0; dt < 4; ++dt)
#pragma unroll
    for (int i = 0; i < 16; ++i) O[dt][i] = 0.f;
}

constexpr int ATT_PW = 8704;
constexpr int ATT_R = 4, ATT_D = 3;
constexpr int ATT_RING = 8 * ATT_PW;
constexpr int ATT_LIST = ATT_RING + ATT_R * 16384;
constexpr int ATT_BUNI = ATT_LIST + 2048;
constexpr int ATT_SMEM = ATT_BUNI + 64;
#define LAS3 __attribute__((address_space(3)))
__device__ __forceinline__ void d_select(const float* impL, unsigned* mskL, unsigned* uniL, int cur) {
  const int lane = TIDX & 63;
  const int stok = lane >> 3, sub = lane & 7;
  unsigned key[32];
#pragma unroll
  for (int i4 = 0; i4 < 8; ++i4) {
    f32x4 v = *(const f32x4*)(impL + stok * 256 + sub * 32 + i4 * 4);
#pragma unroll
    for (int e = 0; e < 4; ++e) {
      const int j = sub * 32 + i4 * 4 + e;
      const bool valid = j <= cur;
      const bool forced = (j == 0) || (j == cur) || (j == cur - 1);
      unsigned kb = forced ? 0xFFFFFF00u : (__float_as_uint(v[e]) & 0xFFFFFF00u);
      key[i4 * 4 + e] = valid ? (kb | (unsigned)(255 - j)) : 0u;
    }
  }
#pragma unroll
  for (int k = 2; k <= 32; k <<= 1) {
#pragma unroll
    for (int jj = k >> 1; jj > 0; jj >>= 1) {
#pragma unroll
      for (int i = 0; i < 32; ++i) {
        const int l2 = i ^ jj;
        if (l2 > i) {
          const bool desc = ((i & k) == 0);
          unsigned a = key[i], b = key[l2];
          unsigned mx = a > b ? a : b, mn = a > b ? b : a;
          key[i] = desc ? mx : mn; key[l2] = desc ? mn : mx;
        }
      }
    }
  }
#pragma unroll
  for (int xm = 1; xm < 8; xm <<= 1) {
    unsigned L[16];
#pragma unroll
    for (int i = 0; i < 16; ++i) { unsigned o = (unsigned)shx_i((int)key[15 - i], xm); L[i] = key[i] > o ? key[i] : o; }
#pragma unroll
    for (int jj = 8; jj > 0; jj >>= 1) {
#pragma unroll
      for (int i = 0; i < 16; ++i) {
        const int l2 = i ^ jj;
        if (l2 > i) { unsigned a = L[i], b = L[l2]; L[i] = a > b ? a : b; L[l2] = a > b ? b : a; }
      }
    }
#pragma unroll
    for (int i = 0; i < 16; ++i) key[i] = L[i];
  }
#pragma unroll
  for (int i = 0; i < 16; ++i) {
    if ((i & 7) == sub) {
      const int j = 255 - (int)(key[i] & 255u);
      if (j <= cur) { atomicOr(&mskL[stok * 8 + (j >> 5)], 1u << (j & 31)); atomicOr(&uniL[j >> 5], 1u << (j & 31)); }
    }
  }
}


DI void att_issue(LAS3 unsigned char* ring, int slot, int w, int lane, const bf16_t* kb, const bf16_t* vb, int tile) {
  const char* ks = (const char*)kb + (size_t)tile * 8192 + w * 1024 + lane * 16;
  const char* vs = (const char*)vb + (size_t)tile * 8192 + w * 1024 + lane * 16;
  __builtin_amdgcn_global_load_lds((const unsigned*)ks, (LAS3 unsigned*)(ring + slot * 16384 + w * 1024), 16, 0, 0);
  __builtin_amdgcn_global_load_lds((const unsigned*)vs, (LAS3 unsigned*)(ring + slot * 16384 + 8192 + w * 1024), 16, 0, 0);
}
DI f32x16 qk_lds(LAS3 const unsigned char* kt, const bf16x8 (&qf)[8], int lane) {
  f32x16 acc;
#pragma unroll
  for (int i = 0; i < 16; ++i) acc[i] = 0.f;
#pragma unroll
  for (int s8 = 0; s8 < 8; ++s8) {
    const bf16x8 kf = *(LAS3 const bf16x8*)(kt + s8 * 1024 + lane * 16);
    acc = MFMA32(kf, qf[s8], acc);
  }
  return acc;
}
DI void pv_lds(LAS3 const unsigned char* vt, const float (&p)[16], f32x16 (&O)[4], int lane) {
  const bf16x8 pf0 = pack8(p[0], p[1], p[2], p[3], p[4], p[5], p[6], p[7]);
  const bf16x8 pf1 = pack8(p[8], p[9], p[10], p[11], p[12], p[13], p[14], p[15]);
#pragma unroll
  for (int dt = 0; dt < 4; ++dt) {
    const bf16x8 v0 = *(LAS3 const bf16x8*)(vt + (dt * 2) * 1024 + lane * 16);
    const bf16x8 v1 = *(LAS3 const bf16x8*)(vt + (dt * 2 + 1) * 1024 + lane * 16);
    O[dt] = MFMA32(v0, pf0, O[dt]);
    O[dt] = MFMA32(v1, pf1, O[dt]);
  }
}

__device__ __forceinline__ void d_attn_block(int B, int g, char* smem, const AttnPtrs& P) {
  const int tid = TIDX, lane = tid & 63, w = tid >> 6;
  const int c = lane & 31, h = lane >> 5, tokl = c >> 2, r = c & 3;
  const int tok0 = 64 * B + 8 * w;
  const int t = tok0 + tokl, hd = g * 4 + r;
  const float slope2 = exp2f(-(float)(hd + 1)) * LOG2E;
  const float c1 = QSCALE * LOG2E;
  const float ninf = -__builtin_inff();
  char* wsm = smem + w * ATT_PW;
  float* impL = (float*)wsm;
  char* otL = wsm;
  unsigned* mskL = (unsigned*)(wsm + 8192);
  unsigned* uniL = mskL + 64;
  LAS3 unsigned char* ring = (LAS3 unsigned char*)(smem + ATT_RING);
  unsigned short* tl = (unsigned short*)(smem + ATT_LIST);
  unsigned* buni = (unsigned*)(smem + ATT_BUNI);
  const bf16_t* kcf = P.kcf + (size_t)g * 32 * 4096;
  const bf16_t* vcf = P.vcf + (size_t)g * 32 * 4096;
  const bf16_t* ksf = P.ksf + (size_t)g * 512 * 4096;
  const bf16_t* vsf = P.vsf + (size_t)g * 512 * 4096;
  const bf16_t* kwf = P.kwf + (size_t)g * 512 * 4096;
  const bf16_t* vwf = P.vwf + (size_t)g * 512 * 4096;
  bf16x8 qf[8];
  {
    const bf16_t* qrow = P.proj + (size_t)t * INWP + OFF_Q + hd * 128 + 8 * h;
#pragma unroll
    for (int s8 = 0; s8 < 8; ++s8) qf[s8] = *(const bf16x8*)(qrow + 16 * s8);
  }
  const float* gt = P.gates + (size_t)t * 24 + hd * 3;
  const float g0 = gt[0], g1 = gt[1], g2 = gt[2];
  {
    unsigned z0 = 0u;
    asm volatile("" : "+v"(z0));
    u32x4 z = {z0, z0, z0, z0};
#pragma unroll
    for (int i = 0; i < 8; ++i) *(u32x4*)(wsm + (i * 64 + lane) * 16) = z;
    if (lane < 18) *(u32x4*)(wsm + 8192 + lane * 16) = z;
    if (tid < 8) buni[tid] = z0;
  }
  f32x16 Ob[4];
  zero_o(Ob);
  const int nmax = (t >= 31) ? ((t - 31) >> 4) : -1;
  const int nmaxw = (tok0 + 7 >= 31) ? ((tok0 + 7 - 31) >> 4) : -1;
  const int nminw = (tok0 >= 31) ? ((tok0 - 31) >> 4) : -1;
  const int ntcw = (nmaxw + 32) >> 5;
  const int ntcB = (((64 * B + 63 - 31) >> 4) + 32) >> 5;
  const float sl16 = slope2 * 16.f;
  float mC = NEGB, lC = 0.f, invC = 0.f, carry = 0.f;
  {
    const int n = 2 * ntcB;
    asm volatile("s_waitcnt vmcnt(0)" ::: "memory");
#define A_TILE(i_) (((i_) < ntcB) ? (ntcB - 1 - (i_)) : ((i_) - ntcB))
    att_issue(ring, 0, w, lane, kcf, vcf, A_TILE(0));
    if (n > 1) att_issue(ring, 1, w, lane, kcf, vcf, A_TILE(1));
#pragma unroll 1
    for (int i = 0; i < n; ++i) {
      if ((i & 1) == 0) {
        asm volatile("s_waitcnt vmcnt(0)" ::: "memory");
        __builtin_amdgcn_s_barrier();
        asm volatile("" ::: "memory");
        if (i + 2 < n) att_issue(ring, (i + 2) & 3, w, lane, kcf, vcf, A_TILE(i + 2));
        if (i + 3 < n) att_issue(ring, (i + 3) & 3, w, lane, kcf, vcf, A_TILE(i + 3));
      }
      const int T = A_TILE(i);
      if (T >= ntcw) continue;
      LAS3 const unsigned char* slot = ring + (i % ATT_R) * 16384;
      const f32x16 acc = qk_lds(slot, qf, lane);
      const float base = slope2 * (float)(512 * T + 128 * h) + slope2 * (15.5f - (float)t);
      const int nb = 32 * T + 8 * h;
      const bool full = (32 * T + 31 <= nminw);
      float sv[16];
#pragma unroll
      for (int rg = 0; rg < 16; ++rg) { const int kk = (rg & 7) + 16 * (rg >> 3); sv[rg] = fmaf(acc[rg], c1, fmaf(sl16, (float)kk, base)); }
      if (!full) {
#pragma unroll
        for (int rg = 0; rg < 16; ++rg) { const int kk = (rg & 7) + 16 * (rg >> 3); sv[rg] = (nb + kk <= nmax) ? sv[rg] : ninf; }
      }
      if (i < ntcB) {
        float tmax = fmaxf(fmaxf(fmaxf(sv[0], sv[1]), fmaxf(sv[2], sv[3])), fmaxf(fmaxf(sv[4], sv[5]), fmaxf(sv[6], sv[7])));
        tmax = fmaxf(tmax, fmaxf(fmaxf(fmaxf(sv[8], sv[9]), fmaxf(sv[10], sv[11])), fmaxf(fmaxf(sv[12], sv[13]), fmaxf(sv[14], sv[15]))));
        tmax = hmax(tmax);
        const float mn = fmaxf(mC, tmax);
        float ps = 0.f;
#pragma unroll
        for (int rg = 0; rg < 16; ++rg) ps += ex2(sv[rg] - mn);
        lC = lC * ex2(mC - mn) + ps; mC = mn;
      } else {
        if (T == 0) { lC = hsum(lC); invC = (lC > 0.f) ? 1.f / lC : 0.f; }
        float p[16];
#pragma unroll
        for (int rg = 0; rg < 16; ++rg) p[rg] = ex2(sv[rg] - mC) * invC;
        float Ga = (p[0] + p[1]) + (p[2] + p[3]), Gb = (p[4] + p[5]) + (p[6] + p[7]);
        float Gc = (p[8] + p[9]) + (p[10] + p[11]), Gd = (p[12] + p[13]) + (p[14] + p[15]);
        float xb, xd; { float a_, b_; halves(p[7], a_, b_); xb = h ? a_ : b_; halves(p[15], a_, b_); xd = h ? a_ : b_; }
        float ia = Ga + (h ? xb : carry);
        float ib = Gb + p[3];
        float ic = Gc + (h ? xd : xb);
        float id = Gd + p[11];
        carry = xd;
        ia = quad_sum(ia); ib = quad_sum(ib); ic = quad_sum(ic); id = quad_sum(id);
        {
          float val = (r == 0) ? ia : (r == 1) ? ib : (r == 2) ? ic : id;
          int j = 8 * T + 2 * h + ((r == 0) ? 0 : (r == 1) ? 1 : (r == 2) ? 4 : 5);
          impL[tokl * 256 + j] = val;
        }
        pv_lds(slot + 8192, p, Ob, lane);
      }
    }
#undef A_TILE
  }
  const int cur = B;
  d_select(impL, mskL, uniL, cur);
  ot_store(otL, lane, Ob, g0);
  zero_o(Ob);
  if (lane < 8) { const unsigned u = uniL[lane]; if (u) atomicOr(&buni[lane], u); }
  __syncthreads();
  int nslc = 0, ntl = 0;
  {
    for (int iw = 7; iw >= 0; --iw) {
      unsigned iuw = __builtin_amdgcn_readfirstlane(buni[iw]);
      while (iuw) {
        const int bit = 31 - __builtin_clz(iuw);
        iuw &= ~(1u << bit);
        const int bb = 32 * iw + bit;
        if (bb < B) { if (lane == 0) tl[ntl] = (unsigned short)(2 * bb + 1); ++ntl; }
        else { if (lane == 0) tl[ntl] = (unsigned short)(2 * bb + 1); ++ntl; }
        if (lane == 0) tl[ntl] = (unsigned short)(2 * bb);
        ++ntl;
      }
    }
    nslc = ntl;
    const int ThiB = 2 * B + 1, TloB = ((64 * B - 511 > 0) ? (64 * B - 511) : 0) >> 5;
    for (int T = ThiB; T >= TloB; --T) { if (lane == 0) tl[ntl] = (unsigned short)T; ++ntl; }
  }
  float m = NEGB, l = 0.f;
  {
    const int n = ntl;
    const int Tlow = ((tok0 - 511 > 0) ? (tok0 - 511) : 0) >> 5, Thiw = (tok0 + 7) >> 5;
#define B_ISSUE(j_, slot_) { const int e_ = __builtin_amdgcn_readfirstlane((int)tl[j_]); if ((j_) < nslc) att_issue(ring, slot_, w, lane, ksf, vsf, e_); else att_issue(ring, slot_, w, lane, kwf, vwf, e_); }
    B_ISSUE(0, 0)
    if (n > 1) B_ISSUE(1, 1)
#pragma unroll 1
    for (int i = 0; i < n; ++i) {
      if ((i & 1) == 0) {
        asm volatile("s_waitcnt vmcnt(0)" ::: "memory");
        __builtin_amdgcn_s_barrier();
        asm volatile("" ::: "memory");
        if (i + 2 < n) B_ISSUE(i + 2, (i + 2) & 3)
        if (i + 3 < n) B_ISSUE(i + 3, (i + 3) & 3)
      }
      if (i == nslc) {
        l = hsum(l);
        const float inv = (l > 0.f) ? g1 / l : 0.f;
        ot_accum(otL, lane, Ob, inv);
        ot_store(otL, lane, Ob, 1.f);
        zero_o(Ob);
        m = NEGB; l = 0.f;
      }
      const int T = __builtin_amdgcn_readfirstlane((int)tl[i]);
      const int pos0 = 32 * T, pb = pos0 + 8 * h;
      bool full; bool mine = true;
      if (i < nslc) {
        const int bb = T >> 1;
        const unsigned uw = __builtin_amdgcn_readfirstlane(uniL[bb >> 5]);
        if (!((uw >> (bb & 31)) & 1u) || pos0 > tok0 + 7) continue;
        mine = (mskL[tokl * 8 + (bb >> 5)] >> (bb & 31)) & 1u;
        full = (pos0 + 31 <= tok0) && (__ballot(!mine) == 0ull);
      } else {
        if (T < Tlow || T > Thiw) continue;
        full = (pos0 + 31 <= tok0) && (pos0 >= tok0 + 7 - 511);
      }
      LAS3 const unsigned char* slot = ring + (i % ATT_R) * 16384;
      const f32x16 acc = qk_lds(slot, qf, lane);
      const float base = slope2 * (float)(pos0 + 8 * h - t);
      float sv[16], p[16];
#pragma unroll
      for (int rg = 0; rg < 16; ++rg) { const int kk = (rg & 7) + 16 * (rg >> 3); sv[rg] = fmaf(acc[rg], c1, fmaf(slope2, (float)kk, base)); }
      if (!full) {
        if (i < nslc) {
#pragma unroll
          for (int rg = 0; rg < 16; ++rg) { const int kk = (rg & 7) + 16 * (rg >> 3); sv[rg] = (mine && (pb + kk <= t)) ? sv[rg] : ninf; }
        } else {
#pragma unroll
          for (int rg = 0; rg < 16; ++rg) { const int kk = (rg & 7) + 16 * (rg >> 3); const int dw = t - (pb + kk); sv[rg] = ((dw >= 0) && (dw < 512)) ? sv[rg] : ninf; }
        }
      }
      osm_step(sv, m, l, Ob, p);
      pv_lds(slot + 8192, p, Ob, lane);
    }
#undef B_ISSUE
    l = hsum(l);
    const float inv = (l > 0.f) ? g2 / l : 0.f;
    ot_accum(otL, lane, Ob, inv);
  }
  {
    float ss = 0.f;
#pragma unroll
    for (int dt = 0; dt < 4; ++dt)
#pragma unroll
      for (int i = 0; i < 16; ++i) ss = fmaf(Ob[dt][i], Ob[dt][i], ss);
    ss = hsum(ss);
    const float rs = rsqrtf(ss * (1.f / 128.f) + 1e-6f);
    bf16_t* orow = P.mix + (size_t)t * DM + hd * 128 + 4 * h;
    const float* grow = P.hng + hd * 128 + 4 * h;
#pragma unroll
    for (int dt = 0; dt < 4; ++dt)
#pragma unroll
      for (int a = 0; a < 4; ++a) {
        const f32x4 gv = *(const f32x4*)(grow + 32 * dt + 8 * a);
        u32x2 wv2 = {pack2(Ob[dt][4 * a] * rs * gv[0], Ob[dt][4 * a + 1] * rs * gv[1]), pack2(Ob[dt][4 * a + 2] * rs * gv[2], Ob[dt][4 * a + 3] * rs * gv[3])};
        *(u32x2*)(orow + 32 * dt + 8 * a) = wv2;
      }
  }
  asm volatile("s_waitcnt vmcnt(0)" ::: "memory");
  __syncthreads();
}

__device__ void d_convmix(int t, int tl, const bf16_t* __restrict__ proj, const float* __restrict__ convw, const float* __restrict__ hng,
                          bf16_t* __restrict__ mix) {
  const int c = tl * 8;
  float acc[8];
#pragma unroll
  for (int i = 0; i < 8; ++i) acc[i] = 0.f;
#pragma unroll
  for (int j = 0; j < 3; ++j) {
    const int tt = t - 2 + j;
    if (tt >= 0) {
      const u32x4 cu = *(const u32x4*)(proj + (size_t)tt * INWP + OFF_C + c);
      const u32x4 uu = *(const u32x4*)(proj + (size_t)tt * INWP + OFF_U + c);
      const f32x4 w0 = *(const f32x4*)(convw + j * 1024 + c), w1 = *(const f32x4*)(convw + j * 1024 + c + 4);
#pragma unroll
      for (int i = 0; i < 4; ++i) {
        const unsigned a = cu[i], b = uu[i];
        const float wl = (i < 2) ? w0[2 * i] : w1[2 * i - 4], wh = (i < 2) ? w0[2 * i + 1] : w1[2 * i - 3];
        acc[2 * i] = fmaf(wl * __uint_as_float(a << 16), __uint_as_float(b << 16), acc[2 * i]);
        acc[2 * i + 1] = fmaf(wh * __uint_as_float(a & 0xFFFF0000u), __uint_as_float(b & 0xFFFF0000u), acc[2 * i + 1]);
      }
    }
  }
  const u32x4 bb = *(const u32x4*)(proj + (size_t)t * INWP + OFF_B + c);
  float ss = 0.f;
#pragma unroll
  for (int i = 0; i < 4; ++i) {
    const unsigned b = bb[i];
    acc[2 * i] *= __uint_as_float(b << 16); acc[2 * i + 1] *= __uint_as_float(b & 0xFFFF0000u);
    ss = fmaf(acc[2 * i], acc[2 * i], ss); ss = fmaf(acc[2 * i + 1], acc[2 * i + 1], ss);
  }
  ss += shx(ss, 8); ss += shx(ss, 4); ss += shx(ss, 2); ss += shx(ss, 1);
  const float rs = rsqrtf(ss * (1.f / 128.f) + 1e-6f);
  const f32x4 g0 = *(const f32x4*)(hng + 1024 + c), g1 = *(const f32x4*)(hng + 1024 + c + 4);
  u32x4 o = {pack2(acc[0] * rs * g0[0], acc[1] * rs * g0[1]), pack2(acc[2] * rs * g0[2], acc[3] * rs * g0[3]),
             pack2(acc[4] * rs * g1[0], acc[5] * rs * g1[1]), pack2(acc[6] * rs * g1[2], acc[7] * rs * g1[3])};
  *(u32x4*)(mix + (size_t)t * DM + 1024 + c) = o;
}

DI void d_ln_fin(int t, const u32x4 (&wr)[4], bf16_t* __restrict__ yh, const float* __restrict__ gam, const float* __restrict__ bet) {
  const int lane = TIDX & 63;
  float v[32];
#pragma unroll
  for (int i = 0; i < 4; ++i) {
    const u32x4 w = wr[i];
#pragma unroll
    for (int j = 0; j < 4; ++j) { const unsigned ww = w[j]; v[i * 8 + 2 * j] = __uint_as_float(ww << 16); v[i * 8 + 2 * j + 1] = __uint_as_float(ww & 0xFFFF0000u); }
  }
  float s = 0.f;
#pragma unroll
  for (int i = 0; i < 32; ++i) s += v[i];
  s = wave_sum(s);
  const float mu = s * (1.f / DM);
  float q = 0.f;
#pragma unroll
  for (int i = 0; i < 32; ++i) { const float d = v[i] - mu; q = fmaf(d, d, q); }
  q = wave_sum(q);
  const float rs = rsqrtf(q * (1.f / DM) + 1e-5f);
#pragma unroll
  for (int i = 0; i < 4; ++i) {
    const int cb = 512 * i + 8 * lane;
    const f32x4 g0 = *(const f32x4*)(gam + cb), g1 = *(const f32x4*)(gam + cb + 4), b0 = *(const f32x4*)(bet + cb), b1 = *(const f32x4*)(bet + cb + 4);
    u32x4 o = {pack2((v[i * 8 + 0] - mu) * rs * g0[0] + b0[0], (v[i * 8 + 1] - mu) * rs * g0[1] + b0[1]), pack2((v[i * 8 + 2] - mu) * rs * g0[2] + b0[2], (v[i * 8 + 3] - mu) * rs * g0[3] + b0[3]),
               pack2((v[i * 8 + 4] - mu) * rs * g1[0] + b1[0], (v[i * 8 + 5] - mu) * rs * g1[1] + b1[1]), pack2((v[i * 8 + 6] - mu) * rs * g1[2] + b1[2], (v[i * 8 + 7] - mu) * rs * g1[3] + b1[3])};
    *(u32x4*)(yh + (size_t)t * DM + cb) = o;
  }
}

__device__ void d_cvt_w1f(size_t c, const float* __restrict__ w1, bf16_t* __restrict__ w1f) {
  const int lane = c & 63, ks = (c >> 6) & 255, ct = c >> 14;
  const int col = lane & 31, h = lane >> 5;
  bf16_t v[8];
#pragma unroll
  for (int j = 0; j < 8; ++j) v[j] = f2bf(w1[(size_t)(16 * ks + 8 * h + j) * 512 + 32 * ct + col]);
  u32x4 o; o.x = v[0] | ((unsigned)v[1] << 16); o.y = v[2] | ((unsigned)v[3] << 16); o.z = v[4] | ((unsigned)v[5] << 16); o.w = v[6] | ((unsigned)v[7] << 16);
  *(u32x4*)(w1f + c * 8) = o;
}
__device__ void d_cvt_w2f(size_t c, const float* __restrict__ w2, bf16_t* __restrict__ w2f) {
  const int lane = c & 63, s = (c >> 6) & 31, ct = c >> 11;
  const int col = lane & 31, h = lane >> 5;
  bf16_t v[8];
#pragma unroll
  for (int j = 0; j < 8; ++j) v[j] = f2bf(w2[(size_t)(16 * s + 8 * h + j) * 128 + 32 * ct + col]);
  u32x4 o; o.x = v[0] | ((unsigned)v[1] << 16); o.y = v[2] | ((unsigned)v[3] << 16); o.z = v[4] | ((unsigned)v[5] << 16); o.w = v[6] | ((unsigned)v[7] << 16);
  *(u32x4*)(w2f + c * 8) = o;
}
__device__ __forceinline__ void d_compress_unit(int rt, char* smem, const bf16_t* __restrict__ proj, int col0, const float* __restrict__ pos,
                                const bf16_t* __restrict__ w1f, const float* __restrict__ b1, const bf16_t* __restrict__ w2f,
                                bf16_t* __restrict__ outf, bool isV) {
  bf16_t* Xs = (bf16_t*)smem;
  bf16_t* Hs = (bf16_t*)(smem + 2 * 8704);
  const int tid = TIDX, lane = tid & 63, w = tid >> 6, c = lane & 31, h = lane >> 5;
  const int R0 = rt * 32;
  const int srow = tid >> 4, sch = tid & 15;
  const int grow = R0 + srow, sn = grow >> 1, sg = grow & 1;
  const bool svalid = grow < 2046;
  const bf16_t* sp = proj + (size_t)(16 * sn) * INWP + col0 + sg * 128 + sch * 8;
  f32x16 acc0, acc1;
#pragma unroll
  for (int i = 0; i < 16; ++i) { acc0[i] = 0.f; acc1[i] = 0.f; }
  u32x4 rx = {0u, 0u, 0u, 0u}; f32x4 rp0, rp1;
#define STAGE_WRITE(buf)                                                                                   \
  {                                                                                                        \
    u32x4 o_;                                                                                              \
    _Pragma("unroll") for (int i = 0; i < 4; ++i) {                                                        \
      const unsigned wv_ = rx[i];                                                                          \
      const float lo = __uint_as_float(wv_ << 16) + ((i < 2) ? rp0[2 * i] : rp1[2 * i - 4]);               \
      const float hi = __uint_as_float(wv_ & 0xFFFF0000u) + ((i < 2) ? rp0[2 * i + 1] : rp1[2 * i - 3]);   \
      o_[i] = pack2(lo, hi);                                                                               \
    }                                                                                                      \
    *(u32x4*)(Xs + (buf) * 4352 + srow * 136 + sch * 8) = o_;                                              \
  }
  if (svalid) rx = *(const u32x4*)(sp);
  rp0 = *(const f32x4*)(pos + sch * 8); rp1 = *(const f32x4*)(pos + sch * 8 + 4);
  STAGE_WRITE(0)
  __syncthreads();
  const bf16_t* wb0 = w1f + ((size_t)(2 * w) * 256 * 64 + lane) * 8;
  const bf16_t* wb1 = w1f + ((size_t)(2 * w + 1) * 256 * 64 + lane) * 8;
  bf16x8 bA[16], bB[16];
#define CMP_LOADB(BUF, L)                                                                      \
  _Pragma("unroll") for (int s8 = 0; s8 < 8; ++s8) {                                           \
    BUF[2 * s8] = *(const bf16x8*)(wb0 + (size_t)(8 * (L) + s8) * 512);                        \
    BUF[2 * s8 + 1] = *(const bf16x8*)(wb1 + (size_t)(8 * (L) + s8) * 512);                    \
  }
#define CMP_LOADX(L)                                                                           \
  if ((L) < 32) {     \
    if (svalid) rx = *(const u32x4*)(sp + (size_t)(L) * INWP);                                 \
    rp0 = *(const f32x4*)(pos + (L) * 128 + sch * 8); rp1 = *(const f32x4*)(pos + (L) * 128 + sch * 8 + 4); \
  }
#define CMP_CHUNK(BUF, L)                                                                      \
  {                                                                                            \
    const bf16_t* xa = Xs + ((L) & 1) * 4352 + c * 136 + 8 * h;                                \
    _Pragma("unroll") for (int s8 = 0; s8 < 8; ++s8) {                                         \
      const bf16x8 a = *(const bf16x8*)(xa + 16 * s8);                                         \
      acc0 = MFMA32(a, BUF[2 * s8], acc0);                                                     \
      acc1 = MFMA32(a, BUF[2 * s8 + 1], acc1);                                                 \
    }                                                                                          \
    if ((L) + 1 < 32) STAGE_WRITE(((L) + 1) & 1)                                               \
    __syncthreads();                                                                           \
  }
  CMP_LOADB(bA, 0)
#pragma unroll 1
  for (int l = 0; l < 32; l += 2) {
    CMP_LOADX(l + 1)
    CMP_LOADB(bB, l + 1)
    __builtin_amdgcn_sched_barrier(0);
    CMP_CHUNK(bA, l)
    __builtin_amdgcn_sched_barrier(0);
    CMP_LOADX(l + 2)
    { const int ln = (l + 2 < 32) ? l + 2 : l;
      CMP_LOADB(bA, ln) }
    __builtin_amdgcn_sched_barrier(0);
    CMP_CHUNK(bB, l + 1)
    __builtin_amdgcn_sched_barrier(0);
  }
#undef CMP_LOADX
#undef CMP_LOADB
#undef CMP_CHUNK
  {
    const float bb0 = b1[64 * w + c], bb1 = b1[64 * w + 32 + c];
#pragma unroll
    for (int rg = 0; rg < 16; ++rg) {
      const int row = (rg & 3) + 8 * (rg >> 2) + 4 * h;
      Hs[row * 520 + 64 * w + c] = f2bf(gelu_tanh(acc0[rg] + bb0));
      Hs[row * 520 + 64 * w + 32 + c] = f2bf(gelu_tanh(acc1[rg] + bb1));
    }
  }
  __syncthreads();
  if (w < 4) {
    f32x16 o2;
#pragma unroll
    for (int i = 0; i < 16; ++i) o2[i] = 0.f;
    const bf16_t* ha = Hs + c * 520 + 8 * h;
    const bf16_t* wb = w2f + ((size_t)w * 32 * 64 + lane) * 8;
#pragma unroll 8
    for (int s2 = 0; s2 < 32; ++s2) {
      const bf16x8 a = *(const bf16x8*)(ha + 16 * s2);
      const bf16x8 b = *(const bf16x8*)(wb + (size_t)s2 * 512);
      o2 = MFMA32(a, b, o2);
    }
    const int d = 32 * w + c;
#pragma unroll
    for (int rg = 0; rg < 16; ++rg) {
      const int row = R0 + (rg & 3) + 8 * (rg >> 2) + 4 * h;
      const int n = row >> 1, g = row & 1;
      const bf16_t val = (row < 2046) ? f2bf(o2[rg]) : (bf16_t)0;
      const int T = n >> 5, nn = n & 31;
      size_t idx;
      if (!isV) idx = ((((size_t)(g * 32 + T) * 8 + (d >> 4)) * 64 + (pi_perm(nn) + 32 * ((d >> 3) & 1))) * 8 + (d & 7));
      else idx = (((((size_t)(g * 32 + T) * 4 + (d >> 5)) * 2 + (nn >> 4)) * 64 + ((d & 31) + 32 * ((nn >> 3) & 1))) * 8 + (nn & 7));
      outf[idx] = val;
    }
  }
  __syncthreads();
}


DI unsigned f2sort(float f) { unsigned u = __float_as_uint(f); return u ^ ((unsigned)((int)u >> 31) | 0x80000000u); }
DI float sort2f(unsigned k) { unsigned u = (k & 0x80000000u) ? (k ^ 0x80000000u) : ~k; return __uint_as_float(u); }
template <int N>
DI void bitonic_sort_desc(unsigned (&key)[N]) {
#pragma unroll
  for (int k = 2; k <= N; k <<= 1) {
#pragma unroll
    for (int jj = k >> 1; jj > 0; jj >>= 1) {
#pragma unroll
      for (int i = 0; i < N; ++i) {
        const int l2 = i ^ jj;
        if (l2 > i) {
          const bool desc = ((i & k) == 0);
          unsigned a = key[i], b = key[l2];
          unsigned mx = a > b ? a : b, mn = a > b ? b : a;
          key[i] = desc ? mx : mn; key[l2] = desc ? mn : mx;
        }
      }
    }
  }
}
DI void merge_top16(unsigned (&a)[16], const unsigned (&b)[16]) {
#pragma unroll
  for (int i = 0; i < 16; ++i) { unsigned o = b[15 - i]; a[i] = a[i] > o ? a[i] : o; }
#pragma unroll
  for (int jj = 8; jj > 0; jj >>= 1) {
#pragma unroll
    for (int i = 0; i < 16; ++i) {
      const int l2 = i ^ jj;
      if (l2 > i) { unsigned x = a[i], y = a[l2]; a[i] = x > y ? x : y; a[l2] = x > y ? y : x; }
    }
  }
}
__device__ void d_cvt_subk(size_t c, const float* __restrict__ subk, bf16_t* __restrict__ skf) {
  int lane = c & 63, s = (c >> 6) & 7, kt = (c >> 9) & 3, hc = c >> 11;
  int i = lane & 31, h = lane >> 5;
  const float* src = subk + ((size_t)hc * 128 + 32 * kt + i) * 128 + 16 * s + 8 * h;
  bf16_t v[8];
#pragma unroll
  for (int j = 0; j < 8; ++j) v[j] = f2bf(src[j]);
  u32x4 o; o.x = v[0] | ((unsigned)v[1] << 16); o.y = v[2] | ((unsigned)v[3] << 16); o.z = v[4] | ((unsigned)v[5] << 16); o.w = v[6] | ((unsigned)v[7] << 16);
  *(u32x4*)(skf + c * 8) = o;
}

#define EPI_LANES()                                                                                                      \
    const int lane = fr | (fq << 4), rr = lane >> 2, rc = lane & 3;                                                       \
    PG8_LAS unsigned char* my = scr + (wr * 4 + wc) * 2048;                                                              \
    const int wo = fr * 64 + ((fq ^ ((fr >> 2) & 3)) << 4), ro = rr * 64 + ((rc ^ ((rr >> 2) & 3)) << 4);
struct EpiProjG {
  static constexpr bool PERM = true, AFTER_DRAIN = false;
  bf16_t* proj; float* gates; PG8_LAS unsigned char* scr;
  DI void operator()(const f32x4 (&acc)[2][2][4][2], const pg8::Unit& u, int wr, int wc, int fr, int fq) const {
    EPI_LANES()
#pragma unroll
    for (int ai = 0; ai < 2; ++ai)
#pragma unroll
      for (int bj = 0; bj < 2; ++bj) {
        const int c0 = u.pn * 256 + bj * 128 + wc * 32 + 8 * fq, cs = u.pn * 256 + bj * 128 + wc * 32 + 8 * rc;
#pragma unroll
        for (int mh = 0; mh < 2; ++mh) {
#pragma unroll
          for (int mm = 0; mm < 2; ++mm) {
            const f32x4 v0 = acc[ai][bj][mh * 2 + mm][0], v1 = acc[ai][bj][mh * 2 + mm][1];
            u32x4 w = {pack2(v0[0], v0[1]), pack2(v0[2], v0[3]), pack2(v1[0], v1[1]), pack2(v1[2], v1[3])};
            *(PG8_LAS u32x4*)(my + wo + mm * 1024) = w;
            if (c0 >= OFF_G && c0 < OFF_G + 24) {
              const int row = u.pm * 256 + ai * 128 + wr * 64 + (mh * 2 + mm) * 16 + fr;
              f32x4 g0, g1;
#pragma unroll
              for (int j = 0; j < 4; ++j) { g0[j] = 1.f / (1.f + __expf(-v0[j])); g1[j] = 1.f / (1.f + __expf(-v1[j])); }
              *(f32x4*)(gates + (size_t)row * 24 + (c0 - OFF_G)) = g0;
              *(f32x4*)(gates + (size_t)row * 24 + (c0 - OFF_G) + 4) = g1;
            }
          }
#pragma unroll
          for (int j = 0; j < 2; ++j) {
            const u32x4 w = *(const PG8_LAS u32x4*)(my + ro + j * 1024);
            const int row = u.pm * 256 + ai * 128 + wr * 64 + mh * 32 + j * 16 + rr;
            if (cs < INW) *(u32x4*)(proj + (size_t)row * INWP + cs) = w;
          }
        }
      }
  }
};
struct EpiResG {
  static constexpr bool PERM = true, AFTER_DRAIN = false;
  bf16_t* YB; PG8_LAS unsigned char* scr;
  DI void operator()(const f32x4 (&acc)[2][2][4][2], const pg8::Unit& u, int wr, int wc, int fr, int fq) const {
    EPI_LANES()
    bf16_t* yb = YB + (size_t)(u.pm * 256 + wr * 64 + rr) * DM + u.pn * 256 + wc * 32 + 8 * rc;
#pragma unroll
    for (int ai = 0; ai < 2; ++ai) {
      u32x4 xr[2][2][2];
#pragma unroll
      for (int bj = 0; bj < 2; ++bj)
#pragma unroll
        for (int mh = 0; mh < 2; ++mh)
#pragma unroll
          for (int j = 0; j < 2; ++j) xr[bj][mh][j] = *(const u32x4*)(yb + (size_t)(ai * 128 + mh * 32 + j * 16) * DM + bj * 128);
#pragma unroll
      for (int bj = 0; bj < 2; ++bj)
#pragma unroll
        for (int mh = 0; mh < 2; ++mh) {
#pragma unroll
          for (int mm = 0; mm < 2; ++mm) {
            const f32x4 v0 = acc[ai][bj][mh * 2 + mm][0], v1 = acc[ai][bj][mh * 2 + mm][1];
            u32x4 w = {pack2(v0[0], v0[1]), pack2(v0[2], v0[3]), pack2(v1[0], v1[1]), pack2(v1[2], v1[3])};
            *(PG8_LAS u32x4*)(my + wo + mm * 1024) = w;
          }
#pragma unroll
          for (int j = 0; j < 2; ++j) {
            const u32x4 a = *(const PG8_LAS u32x4*)(my + ro + j * 1024), xw = xr[bj][mh][j];
            u32x4 o;
#pragma unroll
            for (int q = 0; q < 4; ++q) {
              const unsigned aw = a[q], xq = xw[q];
              o[q] = pack2(fmaf(ALPHA, __uint_as_float(xq << 16), __uint_as_float(aw << 16)), fmaf(ALPHA, __uint_as_float(xq & 0xFFFF0000u), __uint_as_float(aw & 0xFFFF0000u)));
            }
            *(u32x4*)(yb + (size_t)(ai * 128 + mh * 32 + j * 16) * DM + bj * 128) = o;
          }
        }
    }
  }
};
struct EpiF32G {
  static constexpr bool PERM = false, AFTER_DRAIN = false;
  float* C; int ldc;
  DI void operator()(const f32x4 (&acc)[2][2][4][2], const pg8::Unit& u, int wr, int wc, int fr, int fq) const {
#pragma unroll
    for (int ai = 0; ai < 2; ++ai)
#pragma unroll
      for (int m = 0; m < 4; ++m) {
        const size_t ro = (size_t)(u.pm * 256 + ai * 128 + wr * 64 + m * 16 + fr) * ldc + u.pn * 256 + wc * 32 + 4 * fq;
#pragma unroll
        for (int bj = 0; bj < 2; ++bj)
#pragma unroll
          for (int n = 0; n < 2; ++n) *(f32x4*)(C + ro + bj * 128 + n * 16) = acc[ai][bj][m][n];
      }
  }
};
struct EpiRouteG {
  static constexpr bool PERM = false, AFTER_DRAIN = true;
  const bf16_t* skf; unsigned* tops;
  DI void operator()(const f32x4 (&)[2][2][4][2], const pg8::Unit&, int, int, int, int) const {}
  DI void fused(const f32x4 (&acc)[2][2][4][2], const pg8::Unit& u, int wr, int wc, int fr, int fq, PG8_LAS unsigned char* ldsp, int, int) const {
    const int lane = fr | (fq << 4), wid = wr * 4 + wc;
    bf16_t* Qs = (bf16_t*)ldsp;
#pragma unroll
    for (int ai = 0; ai < 2; ++ai)
#pragma unroll
      for (int m = 0; m < 4; ++m) {
        const int row = ai * 128 + wr * 64 + m * 16 + fr;
#pragma unroll
        for (int bj = 0; bj < 2; ++bj)
#pragma unroll
          for (int n = 0; n < 2; ++n) {
            const f32x4 v = acc[ai][bj][m][n];
            u32x2 w = {pack2(v[0], v[1]), pack2(v[2], v[3])};
            *(u32x2*)(Qs + row * 264 + bj * 128 + wc * 32 + n * 16 + 4 * fq) = w;
          }
      }
    __syncthreads();
    const int c = lane & 31, h = lane >> 5;
    unsigned kA[16], kB[16];
#pragma unroll 1
    for (int half = 0; half < 2; ++half) {
      const int hc = u.pn * 2 + half;
      const bf16_t* sk = skf + (size_t)hc * 4 * 4096;
      const bf16_t* qp = Qs + (wid * 32 + c) * 264 + half * 128 + 8 * h;
      unsigned k0[16], k1[16];
      bf16x8 afA[8], afB[8];
#define ROUTE_LD(KT, AF) { _Pragma("unroll") for (int s = 0; s < 8; ++s) AF[s] = *(const bf16x8*)(sk + (KT) * 4096 + s * 512 + lane * 8); }
#define ROUTE_MM(KT, AF, KA)                                                                    \
      {                                                                                         \
        f32x16 sc;                                                                              \
        _Pragma("unroll") for (int i = 0; i < 16; ++i) sc[i] = 0.f;                             \
        _Pragma("unroll") for (int s = 0; s < 8; ++s) {                                         \
          bf16x8 bq = *(const bf16x8*)(qp + 16 * s);                                            \
          sc = __builtin_amdgcn_mfma_f32_32x32x16_bf16(AF[s], bq, sc, 0, 0, 0);                 \
        }                                                                                       \
        _Pragma("unroll") for (int rg = 0; rg < 16; ++rg) {                                     \
          const int kidx = 32 * (KT) + (rg & 3) + 8 * (rg >> 2) + 4 * h;                        \
          KA[rg] = (f2sort(sc[rg]) & 0xFFFFFF80u) | (unsigned)(127 - kidx);                     \
        }                                                                                       \
      }
      ROUTE_LD(0, afA)
      ROUTE_LD(1, afB)
      __builtin_amdgcn_sched_barrier(0);
      ROUTE_MM(0, afA, k0)
      __builtin_amdgcn_sched_barrier(0);
      ROUTE_LD(2, afA)
      __builtin_amdgcn_sched_barrier(0);
      bitonic_sort_desc<16>(k0);
      ROUTE_MM(1, afB, k1)
      __builtin_amdgcn_sched_barrier(0);
      ROUTE_LD(3, afB)
      __builtin_amdgcn_sched_barrier(0);
      bitonic_sort_desc<16>(k1);
      merge_top16(k0, k1);
      ROUTE_MM(2, afA, k1)
      bitonic_sort_desc<16>(k1);
      merge_top16(k0, k1);
      ROUTE_MM(3, afB, k1)
      bitonic_sort_desc<16>(k1);
      merge_top16(k0, k1);
      __builtin_amdgcn_sched_barrier(0);
#undef ROUTE_LD
#undef ROUTE_MM

#pragma unroll
      for (int i = 0; i < 16; ++i) k1[i] = (unsigned)shx_i((int)k0[i], 32);
      merge_top16(k0, k1);
      if (half == 0) {
#pragma unroll
        for (int i = 0; i < 16; ++i) kA[i] = k0[i];
      } else {
#pragma unroll
        for (int i = 0; i < 16; ++i) kB[i] = k0[i];
      }
    }
    {
      unsigned* lk = (unsigned*)(ldsp + wid * 16896);
#pragma unroll
      for (int i = 0; i < 16; ++i) { lk[i * 64 + lane] = kA[i]; lk[(16 + i) * 64 + lane] = kB[i]; }
      float fa[16], fb[16];
#pragma unroll
      for (int i = 0; i < 16; ++i) { fa[i] = sort2f(kA[i]); fb[i] = sort2f(kB[i]); }
#define CAND(ci_, cj_) ((f2sort(fa[ci_] + fb[cj_]) & 0xFFFFFF00u) | (unsigned)(255 - ((ci_) * 16 + (cj_))))
      unsigned R0[16], R1[16], S1[16], S2[16];
#pragma unroll
      for (int j = 0; j < 16; ++j) { R0[j] = CAND(0, j); R1[j] = (j < 8) ? CAND(1, j & 7) : 0u; }
      S1[0] = CAND(2, 0); S1[1] = CAND(2, 1); S1[2] = CAND(2, 2); S1[3] = CAND(2, 3); S1[4] = CAND(2, 4);
      S1[5] = CAND(3, 0); S1[6] = CAND(3, 1); S1[7] = CAND(3, 2); S1[8] = CAND(3, 3);
      S1[9] = CAND(4, 0); S1[10] = CAND(4, 1); S1[11] = CAND(4, 2);
      S1[12] = CAND(5, 0); S1[13] = CAND(5, 1); S1[14] = CAND(6, 0); S1[15] = CAND(6, 1);
      S2[0] = CAND(7, 0); S2[1] = CAND(7, 1);
#pragma unroll
      for (int i = 8; i < 16; ++i) S2[i - 6] = CAND(i, 0);
#pragma unroll
      for (int i = 10; i < 16; ++i) S2[i] = 0u;
#undef CAND
      merge_top16(R0, R1);
      bitonic_sort_desc<16>(S1); bitonic_sort_desc<16>(S2);
      merge_top16(S1, S2);
      merge_top16(R0, S1);
      float sc[16]; unsigned ex[16]; float mx = -3.0e38f;
#pragma unroll
      for (int i = 0; i < 16; ++i) {
        const int flat = 255 - (int)(R0[i] & 255u);
        const unsigned ka = lk[(flat >> 4) * 64 + lane], kb = lk[(16 + (flat & 15)) * 64 + lane];
        sc[i] = sort2f(ka) + sort2f(kb);
        ex[i] = (127u - (ka & 127u)) * 128u + (127u - (kb & 127u));
        mx = fmaxf(mx, sc[i]);
      }
      float sm = 0.f;
#pragma unroll
      for (int i = 0; i < 16; ++i) { sc[i] = __expf(sc[i] - mx); sm += sc[i]; }
      const float rsm = 1.f / sm;
      unsigned* dst = tops + (size_t)(u.pm * 256 + wid * 32 + c) * 256 + h * 128 + u.pn * 16;
#pragma unroll
      for (int q4 = 0; q4 < 4; ++q4) {
        u32x4 o;
#pragma unroll
        for (int i = 0; i < 4; ++i) o[i] = h ? __float_as_uint(sc[4 * q4 + i] * rsm) : ex[4 * q4 + i];
        *(u32x4*)(dst + 4 * q4) = o;
      }
    }
    __syncthreads();
  }
};


template <int CTRL> DI float dpp_f(float v) { const int iv = __float_as_int(v); return __int_as_float(__builtin_amdgcn_update_dpp(iv, iv, CTRL, 0xF, 0xF, false)); }
DI float wsum(float x) {
  x += dpp_f<0xB1>(x);
  x += dpp_f<0x4E>(x);
  x += dpp_f<0x124>(x);
  x += dpp_f<0x128>(x);
  x += shx(x, 16);
  return hsum(x);
}
DI float gelu_fast(float x) {
  const float u2 = 1.5957691216057308f * (x + 0.044715f * x * x * x);
  return x * __builtin_amdgcn_rcpf(1.f + ex2(-LOG2E * u2));
}

constexpr int EROW = 1024;
typedef float v2f __attribute__((ext_vector_type(2)));
DI void d_cvt_fp4_fin(int row, const f32x4 (&x)[8], unsigned char* __restrict__ dst, float* __restrict__ scales) {
  const int lane = TIDX & 63;
  float v[32]; float amax = 0.f;
#pragma unroll
  for (int i = 0; i < 8; ++i)
#pragma unroll
    for (int j = 0; j < 4; ++j) { v[i * 4 + j] = x[i][j]; amax = fmaxf(amax, fabsf(x[i][j])); }
  amax = wave_max(amax);
  const float sc = amax > 0.f ? amax * (1.f / 7.f) : 1.f;
  const float inv = 1.f / sc;
  u32x4 o;
#pragma unroll
  for (int k = 0; k < 4; ++k) {
    unsigned w = 0u;
#define FP4C(x_) fminf(fmaxf((x_) * inv, -6.f), 6.f)
    w = __builtin_amdgcn_cvt_scalef32_pk_fp4_f32(w, FP4C(v[8 * k + 0]), FP4C(v[8 * k + 1]), 1.0f, 0);
    w = __builtin_amdgcn_cvt_scalef32_pk_fp4_f32(w, FP4C(v[8 * k + 2]), FP4C(v[8 * k + 3]), 1.0f, 1);
    w = __builtin_amdgcn_cvt_scalef32_pk_fp4_f32(w, FP4C(v[8 * k + 4]), FP4C(v[8 * k + 5]), 1.0f, 2);
    w = __builtin_amdgcn_cvt_scalef32_pk_fp4_f32(w, FP4C(v[8 * k + 6]), FP4C(v[8 * k + 7]), 1.0f, 3);
#undef FP4C
    o[k] = w;
  }
  *(u32x4*)(dst + (size_t)row * EROW + 16 * lane) = o;
  if (lane == 0) scales[row] = sc;
}
__device__ void d_cvt_fp4_row(int row, const float* __restrict__ src, unsigned char* __restrict__ dst, float* __restrict__ scales) {
  const int lane = TIDX & 63;
  f32x4 x[8];
#pragma unroll
  for (int i = 0; i < 8; ++i) x[i] = *(const f32x4*)(src + (size_t)row * DM + 256 * i + 4 * lane);
  d_cvt_fp4_fin(row, x, dst, scales);
}
DI void d_cvt_i4_fin(int row, const f32x4 (&x)[8], unsigned char* __restrict__ dst, float* __restrict__ scales) {
  const int lane = TIDX & 63;
  float v[32]; float amax = 0.f, ss = 0.f;
#pragma unroll
  for (int i = 0; i < 8; ++i)
#pragma unroll
    for (int j = 0; j < 4; ++j) { v[i * 4 + j] = x[i][j]; amax = fmaxf(amax, fabsf(x[i][j])); ss = fmaf(x[i][j], x[i][j], ss); }
  amax = wave_max(amax); ss = wave_sum(ss);
  float sc = fmaxf(0.36f * sqrtf(ss * (1.f / DM)), amax * (1.f / 14.f));
  sc = sc > 0.f ? sc : 1.f;
  const float inv = 1.f / sc;
  u32x4 o;
#pragma unroll
  for (int k = 0; k < 4; ++k) {
    unsigned w = 0u;
#pragma unroll
    for (int j = 0; j < 8; ++j) {
      const float q = fminf(fmaxf(v[8 * k + j] * inv, -7.f), 7.f) + 12582912.f;
      w |= (__float_as_uint(q) & 15u) << (4 * j);
    }
    o[k] = w;
  }
  *(u32x4*)(dst + (size_t)row * EROW + 16 * lane) = o;
  if (lane == 0) scales[row] = sc;
}
__device__ void d_cvt_i4_row(int row, const float* __restrict__ src, unsigned char* __restrict__ dst, float* __restrict__ scales) {
  const int lane = TIDX & 63;
  f32x4 x[8];
#pragma unroll
  for (int i = 0; i < 8; ++i) x[i] = *(const f32x4*)(src + (size_t)row * DM + 256 * i + 4 * lane);
  d_cvt_i4_fin(row, x, dst, scales);
}
__device__ void d_expert_group(int tg0, int tstr, unsigned* tpl, unsigned* slw, const bf16_t* __restrict__ hbuf, const unsigned* __restrict__ tops,
                               const unsigned char* __restrict__ eu4, const unsigned char* __restrict__ ev4, const float* __restrict__ esu, const float* __restrict__ esv,
                               const float* __restrict__ gam, const float* __restrict__ bet, float* __restrict__ out) {
  const int lane = TIDX & 63;
#define SLOT(j_, f_) slw[((j_) * 16 + (f_)) * 64 + lane]
#pragma unroll 1
  for (int j = 0; j < 4; ++j) {
    const int tt = tg0 + j * tstr, t = tt < S ? tt : S - 1;
  float hv[32];
#pragma unroll
  for (int i = 0; i < 8; ++i) {
    const u32x2 w = *(const u32x2*)(hbuf + (size_t)t * DM + 256 * i + 4 * lane);
    hv[i * 4 + 0] = __uint_as_float(w[0] << 16); hv[i * 4 + 1] = __uint_as_float(w[0] & 0xFFFF0000u);
    hv[i * 4 + 2] = __uint_as_float(w[1] << 16); hv[i * 4 + 3] = __uint_as_float(w[1] & 0xFFFF0000u);
  }
  int e0 = (int)tops[(size_t)t * 256 + lane], e1 = (int)tops[(size_t)t * 256 + 64 + lane];
  float w0 = __uint_as_float(tops[(size_t)t * 256 + 128 + lane]), w1 = __uint_as_float(tops[(size_t)t * 256 + 192 + lane]);
  {
    unsigned k0 = ((unsigned)e0 << 7) | (unsigned)lane, k1 = ((unsigned)e1 << 7) | (unsigned)(64 + lane);
#pragma unroll
    for (int k = 2; k <= 128; k <<= 1) {
#pragma unroll
      for (int jj = k >> 1; jj > 0; jj >>= 1) {
        if (jj == 64) { const unsigned mn = k0 < k1 ? k0 : k1, mx = k0 < k1 ? k1 : k0; k0 = mn; k1 = mx; }
        else {
          const unsigned o0 = (unsigned)shx_i((int)k0, jj), o1 = (unsigned)shx_i((int)k1, jj);
          const bool lower = (lane & jj) == 0;
          const bool asc0 = (k >= 64) ? true : ((lane & k) == 0), asc1 = (k == 128) ? true : (k == 64) ? false : ((lane & k) == 0);
          const unsigned mn0 = k0 < o0 ? k0 : o0, mx0 = k0 < o0 ? o0 : k0, mn1 = k1 < o1 ? k1 : o1, mx1 = k1 < o1 ? o1 : k1;
          k0 = (lower == asc0) ? mn0 : mx0; k1 = (lower == asc1) ? mn1 : mx1;
        }
      }
    }
    const int o0 = (int)(k0 & 127u), o1 = (int)(k1 & 127u);
    const float wa0 = __shfl(w0, o0 & 63), wb0 = __shfl(w1, o0 & 63), wa1 = __shfl(w0, o1 & 63), wb1 = __shfl(w1, o1 & 63);
    e0 = (int)(k0 >> 7); e1 = (int)(k1 >> 7); w0 = (o0 < 64) ? wa0 : wb0; w1 = (o1 < 64) ? wa1 : wb1;
  }
  int hhi[4], hlo[4]; float hsc;
  {
    float m = 0.f;
#pragma unroll
    for (int i = 0; i < 32; ++i) m = fmaxf(m, fabsf(hv[i]));
    m = wave_max(m);
    hsc = m > 0.f ? m * (1.f / 119.f) : 1.f;
    const float hinv = 1.f / hsc;
#pragma unroll
    for (int q = 0; q < 4; ++q) {
      unsigned wh = 0u, wl = 0u;
#pragma unroll
      for (int j = 0; j < 8; ++j) {
        const unsigned b = __float_as_uint(fmaf(hv[8 * q + j], hinv, 12582912.f));
        wl |= (b & 15u) << (4 * j); wh |= (((b + 8u) >> 4) & 15u) << (4 * j);
      }
      hhi[q] = (int)wh; hlo[q] = (int)wl;
    }
  }
    const float su0 = esu[e0], su1 = esu[e1], sv0 = esv[e0], sv1 = esv[e1];
#pragma unroll
    for (int q = 0; q < 4; ++q) { SLOT(j, q) = (unsigned)hhi[q]; SLOT(j, 4 + q) = (unsigned)hlo[q]; }
    SLOT(j, 8) = (unsigned)e0; SLOT(j, 9) = (unsigned)e1;
    SLOT(j, 10) = __float_as_uint(hsc * su0); SLOT(j, 11) = __float_as_uint(hsc * su1);
    SLOT(j, 12) = __float_as_uint(w0 * sv0); SLOT(j, 13) = __float_as_uint(w1 * sv1);
  }
  u32x4 rA[4], rB[4];
  const unsigned lo16 = (unsigned)(16 * lane);
#define G_LOAD(R, TAB, EX, LB)                                                             \
  _Pragma("unroll") for (int k = 0; k < 4; ++k) {                                          \
    const int id = __builtin_amdgcn_readlane((EX), (LB) + k);                              \
    R[k] = *(const u32x4*)((TAB) + (size_t)id * EROW + lo16);                              \
  }
#define PKFMA(a_, b_, c_) __builtin_elementwise_fma((a_), (b_), (c_))
  const int srcb = 4 * (((lane & 1) << 5) | ((lane & 2) << 3));
#define G_COMP_U(R, LB)                                                                    \
  {                                                                                        \
    int dd[4];                                                                             \
    _Pragma("unroll") for (int k = 0; k < 4; ++k) {                                        \
      int dh = 0, dl = 0;                                                                  \
      _Pragma("unroll") for (int q = 0; q < 4; ++q) {                                      \
        dh = __builtin_amdgcn_sdot8((int)R[k][q], hhi[q], dh, false);                      \
        dl = __builtin_amdgcn_sdot8((int)R[k][q], hlo[q], dl, false);                      \
      }                                                                                    \
      dd[k] = dh * 16 + dl;                                                                \
      __builtin_amdgcn_sched_barrier(0);                                                   \
    }                                                                                      \
    unsigned t01, t23;                                                                     \
    { auto r_ = __builtin_amdgcn_permlane32_swap((unsigned)dd[0], (unsigned)dd[1], false, false); t01 = r_[0] + r_[1]; }     \
    { auto r_ = __builtin_amdgcn_permlane32_swap((unsigned)dd[2], (unsigned)dd[3], false, false); t23 = r_[0] + r_[1]; }     \
    const bool b4_ = (lane & 16) != 0;                                                     \
    int tv = (int)(b4_ ? t23 : t01) + shx_i((int)(b4_ ? t01 : t23), 16);                   \
    tv += dpp_i<0x128>(tv); tv += dpp_i<0x124>(tv); tv += dpp_i<0x4E>(tv); tv += dpp_i<0xB1>(tv);   \
    const int got = __builtin_amdgcn_ds_bpermute(srcb, tv);                                \
    cc = ((unsigned)(lane - (LB)) < 4u) ? got : cc;                                        \
    __builtin_amdgcn_sched_barrier(0);                                                     \
  }
#define G_COMP_V(R, ACC, CF, LB)                                                           \
  _Pragma("unroll") for (int k = 0; k < 4; ++k) {                                          \
    const float cs = __int_as_float(__builtin_amdgcn_readlane(__float_as_int(CF), (LB) + k));   \
    const v2f cs2 = {cs, cs};                                                              \
    _Pragma("unroll") for (int q = 0; q < 4; ++q) {                                        \
      const unsigned wq = R[k][q];                                                         \
      const v2f f0 = __builtin_amdgcn_cvt_scalef32_pk_f32_fp4(wq, 1.0f, 0), f1 = __builtin_amdgcn_cvt_scalef32_pk_f32_fp4(wq, 1.0f, 1); \
      const v2f f2 = __builtin_amdgcn_cvt_scalef32_pk_f32_fp4(wq, 1.0f, 2), f3 = __builtin_amdgcn_cvt_scalef32_pk_f32_fp4(wq, 1.0f, 3); \
      ACC[4 * q + 0] = PKFMA(cs2, f0, ACC[4 * q + 0]); ACC[4 * q + 1] = PKFMA(cs2, f1, ACC[4 * q + 1]); \
      ACC[4 * q + 2] = PKFMA(cs2, f2, ACC[4 * q + 2]); ACC[4 * q + 3] = PKFMA(cs2, f3, ACC[4 * q + 3]); \
    }                                                                                      \
    __builtin_amdgcn_sched_barrier(0);                                                     \
  }
  {
    int eX = (int)SLOT(0, 8);
    G_LOAD(rA, eu4, eX, 0)
    __builtin_amdgcn_sched_barrier(0);
#pragma unroll 1
    for (int s_ = 0; s_ < 32; ++s_) {
      const int sg = s_ >> 2, j = s_ & 3, L0 = (sg & 3) * 16;
      const int sn = (s_ + 1) & 31, sgn = sn >> 2, jn = sn & 3, L0n = (sgn & 3) * 16;
      if (j == 0) __builtin_amdgcn_s_barrier();
      int hhi[4], hlo[4];
#pragma unroll
      for (int q = 0; q < 4; ++q) { hhi[q] = (int)SLOT(j, q); hlo[q] = (int)SLOT(j, 4 + q); }
      const int eXn = (int)SLOT(jn, 8 + (sgn >> 2));
      const unsigned char* tabn = (s_ == 31) ? ev4 : eu4;
      int cc = 0;
      G_LOAD(rB, eu4, eX, L0 + 4)
      __builtin_amdgcn_sched_barrier(0);
      G_COMP_U(rA, L0)
      G_LOAD(rA, eu4, eX, L0 + 8)
      __builtin_amdgcn_sched_barrier(0);
      G_COMP_U(rB, L0 + 4)
      G_LOAD(rB, eu4, eX, L0 + 12)
      __builtin_amdgcn_sched_barrier(0);
      G_COMP_U(rA, L0 + 8)
      G_LOAD(rA, tabn, eXn, L0n)
      __builtin_amdgcn_sched_barrier(0);
      G_COMP_U(rB, L0 + 12)
      if ((unsigned)(lane - L0) < 16u) SLOT(j, 14 + (sg >> 2)) = (unsigned)cc;
      eX = eXn;
    }
  }
#pragma unroll 1
  for (int j = 0; j < 4; ++j) {
    const float d0 = (float)(int)SLOT(j, 14), d1 = (float)(int)SLOT(j, 15);
    SLOT(j, 14) = __float_as_uint(__uint_as_float(SLOT(j, 12)) * gelu_fast(__uint_as_float(SLOT(j, 10)) * d0));
    SLOT(j, 15) = __float_as_uint(__uint_as_float(SLOT(j, 13)) * gelu_fast(__uint_as_float(SLOT(j, 11)) * d1));
  }
  v2f accv[4][16];
#pragma unroll
  for (int j = 0; j < 4; ++j)
#pragma unroll
    for (int i = 0; i < 16; ++i) accv[j][i] = v2f{0.f, 0.f};
  {
    int eX = (int)SLOT(0, 8);
#pragma unroll 1
    for (int sg = 0; sg < 8; ++sg) {
      const int L0 = (sg & 3) * 16;
      __builtin_amdgcn_s_barrier();
#pragma unroll
      for (int j = 0; j < 4; ++j) {
        const int jn = (j + 1) & 3, sgn = (j == 3) ? ((sg + 1) & 7) : sg, L0n = (sgn & 3) * 16;
        const float cf = __uint_as_float(SLOT(j, 14 + (sg >> 2)));
        const int eXn = (int)SLOT(jn, 8 + (sgn >> 2));
        G_LOAD(rB, ev4, eX, L0 + 4)
        __builtin_amdgcn_sched_barrier(0);
        G_COMP_V(rA, accv[j], cf, L0)
        G_LOAD(rA, ev4, eX, L0 + 8)
        __builtin_amdgcn_sched_barrier(0);
        G_COMP_V(rB, accv[j], cf, L0 + 4)
        G_LOAD(rB, ev4, eX, L0 + 12)
        __builtin_amdgcn_sched_barrier(0);
        G_COMP_V(rA, accv[j], cf, L0 + 8)
        G_LOAD(rA, ev4, eXn, L0n)
        __builtin_amdgcn_sched_barrier(0);
        G_COMP_V(rB, accv[j], cf, L0 + 12)
        eX = eXn;
      }
    }
  }
#undef G_LOAD
#undef G_COMP_U
#undef G_COMP_V
#undef PKFMA
#pragma unroll
  for (int j = 0; j < 4; ++j) {
    const int t = tg0 + j * tstr;
    if (t < S) {
#define acc2 accv[j]
  float acc[32];
  #pragma unroll
    for (int i = 0; i < 16; ++i) { acc[2 * i] = acc2[i].x; acc[2 * i + 1] = acc2[i].y; }
    int le = lane;
    asm volatile("" : "+v"(le) :: "memory");
    float s = 0.f;
  #pragma unroll
    for (int i = 0; i < 8; ++i) {
      const u32x2 w = *(const u32x2*)(hbuf + (size_t)t * DM + 256 * i + 4 * le);
      const float h0 = __uint_as_float(w[0] << 16), h1 = __uint_as_float(w[0] & 0xFFFF0000u), h2 = __uint_as_float(w[1] << 16), h3 = __uint_as_float(w[1] & 0xFFFF0000u);
      acc[i * 4 + 0] = fmaf(ALPHA, h0, acc[i * 4 + 0]); acc[i * 4 + 1] = fmaf(ALPHA, h1, acc[i * 4 + 1]);
      acc[i * 4 + 2] = fmaf(ALPHA, h2, acc[i * 4 + 2]); acc[i * 4 + 3] = fmaf(ALPHA, h3, acc[i * 4 + 3]);
      s += (acc[i * 4 + 0] + acc[i * 4 + 1]) + (acc[i * 4 + 2] + acc[i * 4 + 3]);
    }
    s = wsum(s);
    const float mu = s * (1.f / DM);
    float qv = 0.f;
  #pragma unroll
    for (int i = 0; i < 32; ++i) { const float d = acc[i] - mu; qv += d * d; }
    qv = wsum(qv);
    const float rs = rsqrtf(qv * (1.f / DM) + 1e-5f);
  #pragma unroll
    for (int i = 0; i < 8; ++i) {
      const int cbase = 256 * i + 4 * le;
      f32x4 ga = *(const f32x4*)(gam + cbase), ba = *(const f32x4*)(bet + cbase), o;
  #pragma unroll
      for (int j = 0; j < 4; ++j) o[j] = (acc[i * 4 + j] - mu) * rs * ga[j] + ba[j];
      *(f32x4*)(out + (size_t)t * DM + cbase) = o;
    }
#undef acc2
    }
  }
#undef SLOT
}

constexpr size_t al256(size_t x) { return (x + 255) & ~(size_t)255; }
constexpr size_t WS_XB = 0;
constexpr size_t WS_PROJ = WS_XB + al256((size_t)S * DM * 2);
constexpr size_t WS_WINT = WS_PROJ + al256((size_t)S * INWP * 2);
constexpr size_t WS_GATES = WS_WINT + al256((size_t)INWG * DM * 2);
constexpr size_t WS_W1KF = WS_GATES + al256((size_t)S * 24 * 4);
constexpr size_t WS_W1VF = WS_W1KF + al256((size_t)512 * 4096 * 2);
constexpr size_t WS_W2KF = WS_W1VF + al256((size_t)512 * 4096 * 2);
constexpr size_t WS_W2VF = WS_W2KF + al256((size_t)512 * 128 * 2);
constexpr size_t WS_VC = WS_W2VF + al256((size_t)512 * 128 * 2) - al256((size_t)2048 * 128 * 4);
constexpr size_t WS_KCF = WS_VC + al256((size_t)2048 * 128 * 4);
constexpr size_t WS_VCF = WS_KCF + al256((size_t)2 * 32 * 4096 * 2);
constexpr size_t WS_KSF = WS_VCF + al256((size_t)2 * 32 * 4096 * 2);
constexpr size_t WS_VSF = WS_KSF + al256((size_t)2 * 512 * 4096 * 2);
constexpr size_t WS_KWF = WS_VSF + al256((size_t)2 * 512 * 4096 * 2);
constexpr size_t WS_VWF = WS_KWF + al256((size_t)2 * 512 * 4096 * 2);
constexpr size_t WS_ENDA = WS_VWF + al256((size_t)2 * 512 * 4096 * 2);
constexpr size_t WS_OATT = WS_ENDA;
constexpr size_t WS_MIX = WS_OATT + al256((size_t)S * 1024 * 4);
constexpr size_t WS_WOUTT = WS_MIX + al256((size_t)S * DM * 2);
constexpr size_t WS_WQT = WS_WOUTT + al256((size_t)DM * DM * 2);
constexpr size_t WS_TOPS = WS_WQT + al256((size_t)DM * DM * 2);
constexpr size_t WS_SKF = WS_TOPS + al256((size_t)S * 256 * 4);
constexpr size_t WS_STATS = WS_SKF + al256((size_t)16 * 128 * 128 * 2);
constexpr size_t WS_CTRL = WS_STATS + al256((size_t)S * 2 * 4);
constexpr size_t CTRL_BYTES = 32768;
constexpr size_t WS_END = WS_CTRL + CTRL_BYTES;
constexpr size_t WS_Y = WS_PROJ;
constexpr size_t WS_HB = WS_XB;
constexpr size_t WS_EU8 = WS_OATT;
constexpr size_t WS_EV8 = WS_EU8 + (size_t)16384 * 1024;
constexpr size_t WS_ESU = WS_EV8 + (size_t)16384 * 1024;
constexpr size_t WS_ESV = WS_ESU + 16384 * 4;
static_assert(WS_ESV + 16384 * 4 <= WS_MIX, "expert tables overflow their region");
constexpr int EXP_EARLY = 6144;
static_assert(WS_END <= (size_t)512 * 1024 * 1024, "workspace over 512 MiB");

struct Params {
  const float *x, *w_in, *ck_pos, *ck_w1, *ck_b1, *ck_w2, *cv_pos, *cv_w1, *cv_b1, *cv_w2, *conv_w, *hng, *w_out, *ln1g, *ln1b, *w_query, *subk,
      *eu, *ev, *ln2g, *ln2b;
  float* out;
  char* ws;
};
#define WSP(T, OFF) ((T*)(p.ws + (OFF)))

#define FOR_VB(n) for (int vb = blockIdx.x; vb < (n); vb += gridDim.x)
#define FOR_VB2(n) for (int vb = blockIdx.x * 2 + (TIDX >> 8); vb < (n); vb += gridDim.x * 2)
constexpr int SMEM_BYTES = 147456;
constexpr int HALF = 36864;

__global__ void __launch_bounds__(512) mega(Params p) {
  __shared__ __attribute__((aligned(16))) char smem[SMEM_BYTES + 16];
  if (TIDX == 0) *(u32x4*)(smem + SMEM_BYTES) = u32x4{0u, 0u, 0u, 0u};
  __syncthreads();
  const XcdBarrier xbar = xcd_barrier_post(WSP(unsigned, WS_CTRL + 1024), (volatile LAS unsigned*)(smem + SMEM_BYTES));
#define smh (smem + (TIDX >> 8) * HALF)
#define wv ((TIDX >> 6))
  constexpr int NWV = 8;
  d_cvt(p.x, WSP(bf16_t, WS_XB), (size_t)S * DM / 4);
  FOR_VB2((INWG / 64) * (DM / 64)) d_cvtT64(vb, smh, p.w_in, WSP(bf16_t, WS_WINT), DM, INW, INWG);
  for (size_t c = (size_t)blockIdx.x * 512 + TIDX; c < (size_t)16 * 256 * 64; c += (size_t)gridDim.x * 512) {
    d_cvt_w1f(c, p.ck_w1, WSP(bf16_t, WS_W1KF)); d_cvt_w1f(c, p.cv_w1, WSP(bf16_t, WS_W1VF));
    if (c < (size_t)4 * 32 * 64) { d_cvt_w2f(c, p.ck_w2, WSP(bf16_t, WS_W2KF)); d_cvt_w2f(c, p.cv_w2, WSP(bf16_t, WS_W2VF)); }
  }
  FOR_VB2((DM / 64) * (DM / 64)) d_cvtT64(vb, smh, p.w_out, WSP(bf16_t, WS_WOUTT), DM, DM, DM);
  FOR_VB2((DM / 64) * (DM / 64)) d_cvtT64(vb, smh, p.w_query, WSP(bf16_t, WS_WQT), DM, DM, DM);
  for (size_t c = (size_t)blockIdx.x * 512 + TIDX; c < (size_t)16 * 4 * 8 * 64; c += (size_t)gridDim.x * 512) d_cvt_subk(c, p.subk, WSP(bf16_t, WS_SKF));
  xcd_barrier(xbar);
  {
    pg8::StaticOrder so; so.init(S, INWG, gridDim.x, blockIdx.x);
    pg8::gemm_phase<EpiProjG, pg8::StaticOrder>((PG8_LAS unsigned char*)smem, pg8::Gemm{WSP(bf16_t, WS_XB), WSP(bf16_t, WS_WINT), S, INWG, DM}, so,
                                                EpiProjG{WSP(bf16_t, WS_PROJ), WSP(float, WS_GATES), (PG8_LAS unsigned char*)smem + pg8::STAGE_BYTES}, nullptr);
    const int nun = (S / 256) * (INWG / 256), gsz = (int)gridDim.x;
    const int nfull = nun % gsz;
    if (nfull != 0 && (int)blockIdx.x >= nfull) {
      const int nidle = gsz - nfull, me = (int)blockIdx.x - nfull;
      for (int r = me * NWV + wv; r < 2 * EXP_EARLY; r += nidle * NWV) {
        if (r < EXP_EARLY) d_cvt_i4_row(r, p.eu, WSP(unsigned char, WS_EU8), WSP(float, WS_ESU)); else d_cvt_fp4_row(r - EXP_EARLY, p.ev, WSP(unsigned char, WS_EV8), WSP(float, WS_ESV));
      }
    }
  }
  xcd_barrier(xbar);
  {
    if (blockIdx.x < 128) {
      const int xcd_ = blockIdx.x & 7, idx_ = blockIdx.x >> 3; const bool isV = (xcd_ & 1) != 0;
      d_compress_unit((xcd_ >> 1) * 16 + idx_, smem, WSP(bf16_t, WS_PROJ), isV ? OFF_VC : OFF_KC, isV ? p.cv_pos : p.ck_pos, isV ? WSP(bf16_t, WS_W1VF) : WSP(bf16_t, WS_W1KF),
                      isV ? p.cv_b1 : p.ck_b1, isV ? WSP(bf16_t, WS_W2VF) : WSP(bf16_t, WS_W2KF), isV ? WSP(bf16_t, WS_VCF) : WSP(bf16_t, WS_KCF), isV);
    }
    int* slot = (int*)smem;
    unsigned* ctr = WSP(unsigned, WS_CTRL);
    for (;;) {
      if (TIDX == 0) *slot = (int)atomicAdd(ctr, 1u);
      __syncthreads();
      const int it = *slot;
      __syncthreads();
      if (it >= 2048) break;
      const int tt = TIDX;
      {
        const int T = it >> 2, which = it & 3;
        d_relayout_tile(T, smem + 64, WSP(bf16_t, WS_PROJ), (which == 0) ? OFF_KS : (which == 1) ? OFF_VS : (which == 2) ? OFF_KW : OFF_VW,
                        (which == 0) ? WSP(bf16_t, WS_KSF) : (which == 1) ? WSP(bf16_t, WS_VSF) : (which == 2) ? WSP(bf16_t, WS_KWF) : WSP(bf16_t, WS_VWF), (which & 1) != 0);
      }
      for (int q = 0; q < 2; ++q) d_convmix(it * 8 + q * 4 + (tt >> 7), tt & 127, WSP(bf16_t, WS_PROJ), p.conv_w, p.hng, WSP(bf16_t, WS_MIX));
    }
  }
  xcd_barrier(xbar);
  {
    AttnPtrs ap{WSP(bf16_t, WS_PROJ), WSP(float, WS_GATES), WSP(bf16_t, WS_KCF), WSP(bf16_t, WS_VCF), WSP(bf16_t, WS_KSF), WSP(bf16_t, WS_VSF), WSP(bf16_t, WS_KWF), WSP(bf16_t, WS_VWF), WSP(bf16_t, WS_MIX), p.hng};
    for (int it = blockIdx.x; it < 512; it += gridDim.x) {
      const int Bq = (it < 256) ? it : (511 - it), gq = (it < 256) ? 0 : 1;
      d_attn_block(Bq, gq, smem, ap);
    }
  }
  xcd_barrier(xbar);
  {
    pg8::StaticOrder so; so.init(S, DM, gridDim.x, blockIdx.x);
    pg8::gemm_phase<EpiResG, pg8::StaticOrder>((PG8_LAS unsigned char*)smem, pg8::Gemm{WSP(bf16_t, WS_MIX), WSP(bf16_t, WS_WOUTT), S, DM, DM}, so,
                                               EpiResG{WSP(bf16_t, WS_HB), (PG8_LAS unsigned char*)smem + pg8::STAGE_BYTES}, nullptr);
  }
  xcd_barrier(xbar);
  {
    const int e0_ = (((S / 256) * (INWG / 256)) % (int)gridDim.x != 0) ? EXP_EARLY : 0;
    const int nrest = 16384 - e0_, ncv = 2 * nrest, wstr = (int)gridDim.x * NWV, lane_ = TIDX & 63;
    int rl = blockIdx.x * NWV + wv, rc = rl;
    u32x4 lcur[4], lnxt[4]; f32x4 ccur[8], cnxt[8];
#define P8_LDLN(R, r_) { _Pragma("unroll") for (int i = 0; i < 4; ++i) R[i] = *(const u32x4*)(WSP(bf16_t, WS_HB) + (size_t)(r_) * DM + 512 * i + 8 * lane_); }
#define P8_LDCV(R, r_) { const float* src_ = ((r_) < nrest) ? p.eu + (size_t)(e0_ + (r_)) * DM : p.ev + (size_t)(e0_ + (r_) - nrest) * DM; \
                         _Pragma("unroll") for (int i = 0; i < 8; ++i) R[i] = *(const f32x4*)(src_ + 256 * i + 4 * lane_); }
    if (rl < S) P8_LDLN(lcur, rl)
    if (rc < ncv) P8_LDCV(ccur, rc)
#pragma unroll 1
    while (rl < S || rc < ncv) {
      const int rln = rl + wstr, rcn = rc + wstr;
      if (rln < S) P8_LDLN(lnxt, rln)
      if (rcn < ncv) P8_LDCV(cnxt, rcn)
      __builtin_amdgcn_sched_barrier(0);
      if (rl < S) d_ln_fin(rl, lcur, WSP(bf16_t, WS_HB), p.ln1g, p.ln1b);
      if (rc < ncv) {
        if (rc < nrest) d_cvt_i4_fin(e0_ + rc, ccur, WSP(unsigned char, WS_EU8), WSP(float, WS_ESU));
        else d_cvt_fp4_fin(e0_ + rc - nrest, ccur, WSP(unsigned char, WS_EV8), WSP(float, WS_ESV));
      }
      __builtin_amdgcn_sched_barrier(0);
#pragma unroll
      for (int i = 0; i < 4; ++i) lcur[i] = lnxt[i];
#pragma unroll
      for (int i = 0; i < 8; ++i) ccur[i] = cnxt[i];
      rl = rln; rc = rcn;
    }
#undef P8_LDLN
#undef P8_LDCV
  }
  xcd_barrier(xbar);
  for (int k = 0; k * (int)gridDim.x < (S / 256) * (DM / 256); ++k) {
    pg8::OneUnit so; so.init(S, DM, gridDim.x, blockIdx.x); so.k = k;
    pg8::gemm_phase<EpiRouteG, pg8::OneUnit>((PG8_LAS unsigned char*)smem, pg8::Gemm{WSP(bf16_t, WS_HB), WSP(bf16_t, WS_WQT), S, DM, DM}, so,
                                             EpiRouteG{WSP(bf16_t, WS_SKF), WSP(unsigned, WS_TOPS)}, nullptr);
    __syncthreads();
  }
  xcd_barrier(xbar);
  {
    const int tstr = (int)gridDim.x * NWV;
    for (int tg0 = blockIdx.x * NWV + wv; tg0 < S; tg0 += 4 * tstr)
      d_expert_group(tg0, tstr, (unsigned*)(smem + wv * 1024), (unsigned*)(smem + 8192 + wv * 16384), WSP(bf16_t, WS_HB), WSP(unsigned, WS_TOPS), WSP(unsigned char, WS_EU8), WSP(unsigned char, WS_EV8),
                     WSP(float, WS_ESU), WSP(float, WS_ESV), p.ln2g, p.ln2b, p.out);
  }
}

extern "C" void kernel_launch(void* const* d_in, const int* in_sizes, int n_in, void* d_out, int out_size, void* d_ws, size_t ws_size,
                              hipStream_t stream) {
  Params p{};
  p.x = (const float*)d_in[0]; p.w_in = (const float*)d_in[1]; p.ck_pos = (const float*)d_in[2]; p.ck_w1 = (const float*)d_in[3];
  p.ck_b1 = (const float*)d_in[4]; p.ck_w2 = (const float*)d_in[5]; p.cv_pos = (const float*)d_in[6]; p.cv_w1 = (const float*)d_in[7];
  p.cv_b1 = (const float*)d_in[8]; p.cv_w2 = (const float*)d_in[9]; p.conv_w = (const float*)d_in[10]; p.hng = (const float*)d_in[11];
  p.w_out = (const float*)d_in[12]; p.ln1g = (const float*)d_in[13]; p.ln1b = (const float*)d_in[14]; p.w_query = (const float*)d_in[15];
  p.subk = (const float*)d_in[16]; p.eu = (const float*)d_in[17]; p.ev = (const float*)d_in[18]; p.ln2g = (const float*)d_in[19];
  p.ln2b = (const float*)d_in[20];
  p.out = (float*)d_out;
  p.ws = (char*)d_ws;
  if (ws_size < WS_END) fprintf(stderr, "workspace too small\n");
  static int grid_blocks = 0;
  if (!grid_blocks) {
    int dev = 0, cus = 0, per_cu = 0;
    hipGetDevice(&dev);
    hipDeviceGetAttribute(&cus, hipDeviceAttributeMultiprocessorCount, dev);
    hipOccupancyMaxActiveBlocksPerMultiprocessor(&per_cu, mega, 512, 0);
    if (per_cu > 1) per_cu = 1;
    if (per_cu < 1) per_cu = 1;
    grid_blocks = cus * per_cu;
  }
  hipMemsetAsync((char*)d_ws + WS_CTRL, 0, CTRL_BYTES, stream);
  void* args[] = {&p};
  hipError_t e = hipLaunchCooperativeKernel((void*)mega, dim3(grid_blocks), dim3(512), args, 0, stream);
  if (e != hipSuccess) fprintf(stderr, "cooperative launch failed: %s (grid %d)\n", hipGetErrorString(e), grid_blocks);
}
```

```cpp
#include <hip/hip_runtime.h>
#include <stdint.h>
#include <stdio.h>


#define DI __device__ __forceinline__
static __device__ __forceinline__ int tidx_() { int t = (int)__builtin_amdgcn_workitem_id_x(); asm volatile("" : "+v"(t)); return t; }
#define TIDX (tidx_())

template <int J> DI int swz_xor(int x) { return __builtin_amdgcn_ds_swizzle(x, (J << 10) | 0x1F); }
template <int CTRL> DI int dpp_i(int x) { return __builtin_amdgcn_update_dpp(x, x, CTRL, 0xF, 0xF, false); }
DI int shx_i(int x, int j) {
  switch (j) {
    case 1: return dpp_i<0xB1>(x);
    case 2: return dpp_i<0x4E>(x);
    case 4: return dpp_i<0x1B>(dpp_i<0x141>(x));
    case 8: return dpp_i<0x128>(x);
    case 16: return swz_xor<16>(x);
    default: {
      auto r = __builtin_amdgcn_permlane32_swap((unsigned)x, (unsigned)x, false, false);
      return (TIDX & 32) ? (int)r[0] : (int)r[1];
    }
  }
}
DI float shx(float x, int j) { return __int_as_float(shx_i(__float_as_int(x), j)); }
typedef unsigned short bf16_t;
using bf16x8 = __attribute__((ext_vector_type(8))) short;
using f32x4 = __attribute__((ext_vector_type(4))) float;
using u32x4 = __attribute__((ext_vector_type(4))) unsigned;
using u32x2 = __attribute__((ext_vector_type(2))) unsigned;

constexpr int S = 16384, DM = 2048, HD = 128;
constexpr int INW = 5656, INWP = 5760, INWG = 5888;
constexpr int OFF_Q = 0, OFF_KC = 1024, OFF_VC = 1280, OFF_KS = 1536, OFF_VS = 1792, OFF_KW = 2048, OFF_VW = 2304,
              OFF_G = 2560, OFF_U = 2584, OFF_B = 3608, OFF_C = 4632;
constexpr int NCMP = 1023;
constexpr float ALPHA = 1.189207115002721f;
constexpr float QSCALE = 0.08838834764831845f;

DI bf16_t f2bf(float x) { unsigned u = __float_as_uint(x); u += 0x7fffu + ((u >> 16) & 1u); return (bf16_t)(u >> 16); }
DI float bf2f(bf16_t b) { return __uint_as_float(((unsigned)b) << 16); }
DI float gelu_tanh(float x) { float u = 0.7978845608028654f * (x + 0.044715f * x * x * x); return 0.5f * x * (1.f + tanhf(u)); }
DI float wave_sum(float v) { for (int o = 32; o > 0; o >>= 1) v += shx(v, o); return v; }
using bf16x2v = __attribute__((ext_vector_type(2))) __bf16;
DI unsigned pack2(float a, float b) { bf16x2v v = {(__bf16)a, (__bf16)b}; return __builtin_bit_cast(unsigned, v); }
DI float wave_max(float v) { for (int o = 32; o > 0; o >>= 1) v = fmaxf(v, shx(v, o)); return v; }

namespace pg8 {
#define PG8_LAS __attribute__((address_space(3)))
typedef unsigned short bf16_t;
typedef short bf16x8 __attribute__((ext_vector_type(8)));
typedef float f32x4 __attribute__((ext_vector_type(4)));
typedef unsigned u32x4 __attribute__((ext_vector_type(4)));
constexpr int BM = 256, BK = 64, HALF = 128, HTB = HALF * BK * 2  , STAGE_BYTES = 8 * HTB, NXCD = 8, WGM = 8;

__host__ __device__ __forceinline__ int lds_byte(int r, int c) { const int st = (r >> 4) * 2 + (c >> 5), rr = r & 15, cc = c & 31, ob = rr * 64 + cc * 2; return st * 1024 + (ob ^ (((ob >> 9) & 1) << 5)); }
__host__ __device__ __forceinline__ void stage_rc(int b, int& R, int& C) { const int st = b / 1024, sb = b % 1024, swz = sb ^ (((sb >> 9) & 1) << 5); R = (st >> 1) * 16 + swz / 64; C = (st & 1) * 32 + (swz % 64) / 2; }
__host__ __device__ __forceinline__ int perm32(int rho) { const int n = rho >> 4, i = rho & 15; return 8 * (i >> 2) + 4 * n + (i & 3); }

struct Unit { int pm, pn; };
struct Gemm { const bf16_t* A; const bf16_t* Bt; int M, N, K; };

struct StaticOrder {
    int nM, nN, nwg, G, c;
    __host__ __device__ void init(int M, int N, int G_, int c_) { nM = M / BM; nN = N / BM; nwg = nM * nN; G = G_; c = c_; }
    __host__ __device__ bool next(int i, Unit& u) const {
        const long L = (long)i * G + c; if (L >= nwg) return false;
        int wgid = (int)L; { const int q = nwg / NXCD, r = nwg % NXCD, xcd = wgid % NXCD, off = wgid / NXCD; wgid = (xcd < r ? xcd * (q + 1) : r * (q + 1) + (xcd - r) * q) + off; }
        const int nig = WGM * nN, gid = wgid / nig, fm = gid * WGM, gsz = (nM - fm) < WGM ? (nM - fm) : WGM;
        u.pm = fm + ((wgid % nig) % gsz); u.pn = (wgid % nig) / gsz; return true;
    }
    __device__ __forceinline__ void a_ready(const Unit&) const {}
    __device__ __forceinline__ void done(const Unit&) const {}
};
struct OneUnit : StaticOrder {
    int k;
    __device__ bool next(int i, Unit& u) const { if (i > 0) return false; return StaticOrder::next(k, u); }
};
__device__ __forceinline__ unsigned cvt_pk_bf16(float lo, float hi) { unsigned r; asm volatile("v_cvt_pk_bf16_f32 %0, %1, %2" : "=v"(r) : "v"(lo), "v"(hi)); return r; }
template <class Epi, class Sched, bool STAMP = false>
__device__ __forceinline__ void gemm_phase(PG8_LAS unsigned char* lds, const Gemm g, const Sched& S, const Epi& E, unsigned long long* stamps) {
    const int tid = TIDX, wid = __builtin_amdgcn_readfirstlane(tid >> 6), lane = tid & 63, wr = wid >> 2, wc = wid & 3, fr = lane & 15, fq = lane >> 4;
    const int K = g.K, nt = K / BK;
    int ts_lo = 0, ts_hi = 0, nts = 0; const unsigned long long rt_entry = STAMP ? (unsigned long long)wall_clock64() : 0ull;
#define PG8_STAMP() do { if (STAMP && wid == 0 && nts < 64) { const unsigned long long _c = (unsigned long long)clock64(); \
        ts_lo = (lane == nts) ? (int)(unsigned)_c : ts_lo; ts_hi = (lane == nts) ? (int)(unsigned)(_c >> 32) : ts_hi; ++nts; } } while (0)
    PG8_STAMP();
    unsigned voffA[2], voffB[2];
#pragma unroll
    for (int i = 0; i < 2; ++i) { int R, C; stage_rc(tid * 16 + i * 8192, R, C); const int Rb = Epi::PERM ? ((R & ~31) + perm32(R & 31)) : R;
        voffA[i] = (unsigned)(R * K + C) * 2u; voffB[i] = (unsigned)(Rb * K + C) * 2u; }
    const size_t kstep = (size_t)(BK * 2);
    const size_t hstep = (size_t)HALF * K * 2;
    const size_t tstep = 2 * hstep;
    const unsigned ldsw = (unsigned)wid * 1024u;
    const int aoff = lds_byte(wr * 64 + fr, fq * 8), boff = lds_byte(wc * 32 + fr, fq * 8);
#define PG8_SA(b, h) (((b) * 2 + (h)) * HTB)
#define PG8_SB(b, h) ((4 + (b) * 2 + (h)) * HTB)
#define PG8_STAGE(bufoff, gbase, voff) do { _Pragma("unroll") for (int _i = 0; _i < 2; ++_i) \
        __builtin_amdgcn_global_load_lds((const unsigned*)((const char*)(gbase) + (voff)[_i]), (PG8_LAS unsigned*)(lds + (bufoff) + ldsw + _i * 8192), 16, 0, 0); } while (0)
#define PG8_LDA(dst, b, h) do { _Pragma("unroll") for (int m = 0; m < 4; ++m) _Pragma("unroll") for (int k = 0; k < 2; ++k) dst[m][k] = *(const PG8_LAS bf16x8*)(lds + PG8_SA(b, h) + aoff + m * 2048 + k * 1024); } while (0)
#define PG8_LDB(dst, b, h) do { _Pragma("unroll") for (int n = 0; n < 2; ++n) _Pragma("unroll") for (int k = 0; k < 2; ++k) dst[n][k] = *(const PG8_LAS bf16x8*)(lds + PG8_SB(b, h) + boff + n * 2048 + k * 1024); } while (0)
#define PG8_MMA(ai, bj, At, Bt) do { __builtin_amdgcn_s_setprio(1); _Pragma("unroll") for (int m = 0; m < 4; ++m) _Pragma("unroll") for (int n = 0; n < 2; ++n) _Pragma("unroll") for (int k = 0; k < 2; ++k) \
        acc[ai][bj][m][n] = __builtin_amdgcn_mfma_f32_16x16x32_bf16(Bt[n][k], At[m][k], acc[ai][bj][m][n], 0, 0, 0); __builtin_amdgcn_s_setprio(0); } while (0)
#define PG8_WAIT_V(n) asm volatile("s_waitcnt vmcnt(" #n ")" ::: "memory")
#define PG8_WAIT_L(n) asm volatile("s_waitcnt lgkmcnt(" #n ")" ::: "memory")
#define PG8_BAR __builtin_amdgcn_s_barrier()
#define PG8_SCHED __builtin_amdgcn_sched_barrier(0)
    Unit cur, nxt; int ui = 0;
    if (!S.next(0, cur)) return;
    f32x4 acc[2][2][4][2];
#pragma unroll
    for (int a = 0; a < 2; ++a)
#pragma unroll
        for (int b = 0; b < 2; ++b)
#pragma unroll
            for (int m = 0; m < 4; ++m)
#pragma unroll
                for (int n = 0; n < 2; ++n) acc[a][b][m][n] = (f32x4){0.f, 0.f, 0.f, 0.f};
    bf16x8 At[4][2], B0[2][2], B1[2][2];
    const char* cA = (const char*)g.A + (size_t)cur.pm * tstep; const char* cB = (const char*)g.Bt + (size_t)cur.pn * tstep;
    S.a_ready(cur);
    PG8_STAGE(PG8_SB(0, 0), cB, voffB); PG8_STAGE(PG8_SA(0, 0), cA, voffA); PG8_STAGE(PG8_SB(0, 1), cB + hstep, voffB); PG8_STAGE(PG8_SA(0, 1), cA + hstep, voffA);
    if (wr == 1) PG8_BAR;
    PG8_WAIT_V(4); PG8_BAR;
    PG8_STAGE(PG8_SB(1, 0), cB + kstep, voffB); PG8_STAGE(PG8_SA(1, 0), cA + kstep, voffA); PG8_STAGE(PG8_SB(1, 1), cB + hstep + kstep, voffB);
    PG8_WAIT_V(6); PG8_BAR;
    PG8_STAMP();
    for (;;) {
        const bool has_next = S.next(ui + 1, nxt);
        const char* nA = has_next ? (const char*)g.A + (size_t)nxt.pm * tstep : cA; const char* nB = has_next ? (const char*)g.Bt + (size_t)nxt.pn * tstep : cB;
        for (int t = 0; t < nt; t += 2) {
            const bool last = (t == nt - 2);
            const char* a1 = cA + (size_t)(t + 1) * kstep;
            const char* a2 = last ? nA : cA + (size_t)(t + 2) * kstep; const char* b2 = last ? nB : cB + (size_t)(t + 2) * kstep;
            const char* a3 = a2 + kstep; const char* b3 = b2 + kstep;
            if (last && has_next) S.a_ready(nxt);
            PG8_LDB(B0, 0, 0); PG8_SCHED; PG8_LDA(At, 0, 0); PG8_STAGE(PG8_SA(1, 1), a1 + hstep, voffA);
            PG8_WAIT_L(8); PG8_BAR; PG8_WAIT_L(0); PG8_MMA(0, 0, At, B0); PG8_BAR; PG8_SCHED;
            PG8_LDB(B1, 0, 1); PG8_STAGE(PG8_SB(0, 0), b2, voffB);
            PG8_BAR; PG8_WAIT_L(0); PG8_MMA(0, 1, At, B1); PG8_BAR;
            PG8_LDA(At, 0, 1); PG8_STAGE(PG8_SA(0, 0), a2, voffA);
            PG8_BAR; PG8_WAIT_L(0); PG8_MMA(1, 0, At, B0); PG8_BAR; PG8_SCHED;
            PG8_STAGE(PG8_SB(0, 1), b2 + hstep, voffB);
            PG8_WAIT_V(6); PG8_BAR; PG8_MMA(1, 1, At, B1); PG8_BAR;
            PG8_LDB(B0, 1, 0); PG8_SCHED; PG8_LDA(At, 1, 0); PG8_STAGE(PG8_SA(0, 1), a2 + hstep, voffA);
            PG8_WAIT_L(8); PG8_BAR; PG8_WAIT_L(0); PG8_MMA(0, 0, At, B0); PG8_BAR; PG8_SCHED;
            PG8_LDB(B1, 1, 1); PG8_STAGE(PG8_SB(1, 0), b3, voffB);
            PG8_BAR; PG8_WAIT_L(0); PG8_MMA(0, 1, At, B1); PG8_BAR;
            PG8_LDA(At, 1, 1); PG8_STAGE(PG8_SA(1, 0), a3, voffA);
            PG8_BAR; PG8_WAIT_L(0); PG8_MMA(1, 0, At, B0); PG8_BAR; PG8_SCHED;
            PG8_STAGE(PG8_SB(1, 1), b3 + hstep, voffB);
            PG8_WAIT_V(6); PG8_BAR; PG8_MMA(1, 1, At, B1); PG8_BAR;
        }
        PG8_STAMP();
        if constexpr (!Epi::AFTER_DRAIN) { E(acc, cur, wr, wc, fr, fq); S.done(cur); }
        PG8_STAMP();
        if (!has_next) break;
#pragma unroll
        for (int a = 0; a < 2; ++a)
#pragma unroll
            for (int b = 0; b < 2; ++b)
#pragma unroll
                for (int m = 0; m < 4; ++m)
#pragma unroll
                    for (int n = 0; n < 2; ++n) acc[a][b][m][n] = (f32x4){0.f, 0.f, 0.f, 0.f};
        cur = nxt; cA = nA; cB = nB; ++ui;
    }
    PG8_WAIT_V(0);
    if (wr == 0) PG8_BAR;
    PG8_BAR;
    if constexpr (Epi::AFTER_DRAIN) { E.fused(acc, cur, wr, wc, fr, fq, lds, wid, lane); S.done(cur); }
    PG8_STAMP();
    if (STAMP && wid == 0) { stamps[lane] = lane < nts ? (((unsigned long long)(unsigned)ts_hi << 32) | (unsigned)ts_lo) : 0ull;
        if (lane == 62) stamps[62] = rt_entry; if (lane == 63) stamps[63] = (unsigned long long)wall_clock64(); }
#undef PG8_STAMP
#undef PG8_SA
#undef PG8_SB
#undef PG8_STAGE
#undef PG8_LDA
#undef PG8_LDB
#undef PG8_MMA
#undef PG8_WAIT_V
#undef PG8_WAIT_L
#undef PG8_BAR
#undef PG8_SCHED
}
}

#define XB_TMO      128
#define XB_XCNT(j)  (256  + 64 * (j))
#define XB_XSUB(j)  (1280 + 64 * (j))
#define XB_XGEN(j)  (2304 + 64 * (j))
#define XB_TOP      3328
#define XB_TOPGEN   3392
#define XCD_BAR_WORDS 3456
#define XB_SPIN_CAP (1u << 18)
#define LAS __attribute__((address_space(3)))

__device__ __forceinline__ unsigned xb_ld(unsigned* p)              { return __hip_atomic_load(p, __ATOMIC_RELAXED, __HIP_MEMORY_SCOPE_AGENT); }
__device__ __forceinline__ unsigned xb_add(unsigned* p, unsigned v) { return __hip_atomic_fetch_add(p, v, __ATOMIC_RELAXED, __HIP_MEMORY_SCOPE_AGENT); }
__device__ __forceinline__ unsigned xb_xcc_id() { return (unsigned)__builtin_amdgcn_s_getreg((3 << 11) | 20) & 0xFu; }
#define XB_SPIN(cond, bar) do { unsigned _sp = 0; while (cond) { __builtin_amdgcn_s_sleep(1); \
    if ((++_sp & 255u) == 0u) { if (xb_ld(&(bar)[XB_TMO])) break; if (_sp > XB_SPIN_CAP) { atomicAdd(&(bar)[XB_TMO], 1u); break; } } } } while (0)

struct XcdBarrier {
    unsigned* bar; unsigned x;
    volatile LAS unsigned* st;
};

__device__ __forceinline__ XcdBarrier xcd_barrier_post(unsigned* bar, volatile LAS unsigned* st) {
    XcdBarrier b; b.bar = bar; b.x = xb_xcc_id(); b.st = st;
    if (TIDX == 0) (void)xb_add(&bar[XB_XCNT(b.x)], 1u);
    return b;
}
__device__ __forceinline__ void xcd_barrier_complete(unsigned* bar, unsigned x, unsigned& nloc, unsigned& nx) {
    const unsigned G = gridDim.x * gridDim.y * gridDim.z;
    unsigned sum, cnt, mine, sp = 0u;
    for (;;) {
        sum = 0u; cnt = 0u; mine = 0u;
#pragma unroll
        for (unsigned j = 0; j < 16; ++j) { const unsigned c = xb_ld(&bar[XB_XCNT(j)]); sum += c; cnt += (c > 0u) ? 1u : 0u; mine = (j == x) ? c : mine; }
        if (sum == G) break;
        __builtin_amdgcn_s_sleep(1);
        if ((++sp & 255u) == 0u) { if (xb_ld(&bar[XB_TMO])) break; if (sp > XB_SPIN_CAP) { atomicAdd(&bar[XB_TMO], 1u); break; } }
    }
    nloc = mine > 0u ? mine : 1u; nx = cnt > 0u ? cnt : 1u;
}

__device__ __forceinline__ void xcd_barrier(const XcdBarrier& b) {
    asm volatile("s_waitcnt vmcnt(0)" ::: "memory");
    __syncthreads();
    if (TIDX == 0) {
        unsigned* bar = b.bar;
        __builtin_amdgcn_s_waitcnt(0);
        unsigned nloc = b.st[0], nx = b.st[1];
        if (nloc == 0u) { xcd_barrier_complete(bar, b.x, nloc, nx); b.st[0] = nloc; b.st[1] = nx; }
        const unsigned old = xb_add(&bar[XB_XSUB(b.x)], 1u);
        const unsigned gen = old / nloc;
        if (old + 1u == (gen + 1u) * nloc) {
            __builtin_amdgcn_fence(__ATOMIC_RELEASE, "agent");
            asm volatile("s_waitcnt vmcnt(0)" ::: "memory");
            const unsigned og = xb_add(&bar[XB_TOP], 1u);
            const unsigned tg = og / nx;
            if (og + 1u == (tg + 1u) * nx) xb_add(&bar[XB_TOPGEN], 1u);
            else XB_SPIN(xb_ld(&bar[XB_TOPGEN]) == tg, bar);
            __builtin_amdgcn_fence(__ATOMIC_ACQUIRE, "agent");
            xb_add(&bar[XB_XGEN(b.x)], 1u);
            asm volatile("s_waitcnt vmcnt(0)" ::: "memory");
        } else {
            XB_SPIN(xb_ld(&bar[XB_XGEN(b.x)]) == gen, bar);
            __builtin_amdgcn_fence(__ATOMIC_ACQUIRE, "agent");
            asm volatile("s_waitcnt vmcnt(0)" ::: "memory");
        }
    }
    __syncthreads();
}

__device__ void d_cvt(const float* __restrict__ in, bf16_t* __restrict__ out, size_t n4) {
  const size_t stride = (size_t)gridDim.x * blockDim.x;
  size_t i = (size_t)blockIdx.x * blockDim.x + TIDX;
  for (; i + 3 * stride < n4; i += 4 * stride) {
    f32x4 v[4];
#pragma unroll
    for (int q = 0; q < 4; ++q) v[q] = ((const f32x4*)in)[i + q * stride];
#pragma unroll
    for (int q = 0; q < 4; ++q) { u32x2 o = {pack2(v[q][0], v[q][1]), pack2(v[q][2], v[q][3])}; ((u32x2*)out)[i + q * stride] = o; }
  }
  for (; i < n4; i += stride) { const f32x4 v = ((const f32x4*)in)[i]; u32x2 o = {pack2(v[0], v[1]), pack2(v[2], v[3])}; ((u32x2*)out)[i] = o; }
}
__device__ void d_cvtT64(int vb, char* smem, const float* __restrict__ W, bf16_t* __restrict__ WT, int K, int N, int NP) {
  float (*tt)[65] = (float (*)[65])smem;
  const int tid = (TIDX & 255);
  const int nbx = NP / 64;
  const int n0 = (vb % nbx) * 64, k0 = (vb / nbx) * 64;
  {
    const int kr = tid >> 4, nc = (tid & 15) * 4;
#pragma unroll
    for (int i = 0; i < 4; ++i) {
      const int k = k0 + kr + 16 * i, n = n0 + nc;
      f32x4 v = {0.f, 0.f, 0.f, 0.f};
      if (n < N) v = *(const f32x4*)(W + (size_t)k * N + n);
      tt[kr + 16 * i][nc] = v[0]; tt[kr + 16 * i][nc + 1] = v[1]; tt[kr + 16 * i][nc + 2] = v[2]; tt[kr + 16 * i][nc + 3] = v[3];
    }
  }
  __syncthreads();
  {
    const int nr = tid >> 3, kc = (tid & 7) * 8;
#pragma unroll
    for (int i = 0; i < 2; ++i) {
      const int nl = nr + 32 * i;
      u32x4 o = {pack2(tt[kc][nl], tt[kc + 1][nl]), pack2(tt[kc + 2][nl], tt[kc + 3][nl]), pack2(tt[kc + 4][nl], tt[kc + 5][nl]), pack2(tt[kc + 6][nl], tt[kc + 7][nl])};
      *(u32x4*)(WT + (size_t)(n0 + nl) * K + k0 + kc) = o;
    }
  }
  __syncthreads();
}

using f32x16 = __attribute__((ext_vector_type(16))) float;
using bf16x8v = __attribute__((ext_vector_type(8))) __bf16;
#define MFMA32(a, b, c) __builtin_amdgcn_mfma_f32_32x32x16_bf16((a), (b), (c), 0, 0, 0)
constexpr float LOG2E = 1.4426950408889634f;
constexpr float NEGB = -1e30f;
DI int pi_perm(int i) { return (i & ~12) | ((i & 8) >> 1) | ((i & 4) << 1); }
DI bf16x8 pack8(float a0, float a1, float a2, float a3, float a4, float a5, float a6, float a7) {
  bf16x8v v = {(__bf16)a0, (__bf16)a1, (__bf16)a2, (__bf16)a3, (__bf16)a4, (__bf16)a5, (__bf16)a6, (__bf16)a7};
  return __builtin_bit_cast(bf16x8, v);
}
__device__ __forceinline__ void d_relayout_tile(int T, char* smem, const bf16_t* __restrict__ proj, int col0, bf16_t* __restrict__ dst, bool isV) {
  bf16_t* Ls = (bf16_t*)smem;
  const int tid = TIDX;
#pragma unroll
  for (int q = 0; q < 2; ++q) {
    const int cidx = tid + q * 512;
    const int g = cidx >> 9, tok = (cidx >> 4) & 31, ch = cidx & 15;
    const u32x4 v = *(const u32x4*)(proj + (size_t)(32 * T + tok) * INWP + col0 + g * 128 + ch * 8);
    *(u32x4*)(Ls + (g * 32 + tok) * 136 + ch * 8) = v;
  }
  __syncthreads();
#pragma unroll
  for (int q = 0; q < 2; ++q) {
    const int oc = tid + q * 512;
    const int g = oc >> 9, r9 = oc & 511, lane = r9 & 63;
    u32x4 o;
    if (!isV) {
      const int s8 = r9 >> 6, i = lane & 31, h = lane >> 5;
      o = *(const u32x4*)(Ls + (g * 32 + pi_perm(i)) * 136 + 16 * s8 + 8 * h);
    } else {
      const int s2 = (r9 >> 6) & 1, dt = r9 >> 7, dd = lane & 31, h = lane >> 5;
      const bf16_t* col = Ls + (g * 32 + 16 * s2 + 8 * h) * 136 + 32 * dt + dd;
      unsigned short e[8];
#pragma unroll
      for (int j = 0; j < 8; ++j) e[j] = col[j * 136];
      o.x = e[0] | ((unsigned)e[1] << 16); o.y = e[2] | ((unsigned)e[3] << 16); o.z = e[4] | ((unsigned)e[5] << 16); o.w = e[6] | ((unsigned)e[7] << 16);
    }
    *(u32x4*)(dst + (((size_t)(g * 512 + T)) * 512 + r9) * 8) = o;
  }
  __syncthreads();
}

struct AttnPtrs {
  const bf16_t* proj; const float* gates;
  const bf16_t *kcf, *vcf, *ksf, *vsf, *kwf, *vwf;
  bf16_t* mix; const float* hng;
};

DI float ex2(float x) { return __builtin_amdgcn_exp2f(x); }
DI void halves(float x, float& lo, float& hi) {
  const unsigned u = __float_as_uint(x);
  auto r = __builtin_amdgcn_permlane32_swap(u, u, false, false);
  lo = __uint_as_float(r[0]); hi = __uint_as_float(r[1]);
}
DI float hmax(float x) { float a, b; halves(x, a, b); return fmaxf(a, b); }
DI float hsum(float x) { float a, b; halves(x, a, b); return a + b; }
DI float dpp_quad(float v, int ctrl_is_xor1) {
  const int iv = __float_as_int(v);
  const int r = ctrl_is_xor1 ? __builtin_amdgcn_update_dpp(iv, iv, 0xB1, 0xF, 0xF, false) : __builtin_amdgcn_update_dpp(iv, iv, 0x4E, 0xF, 0xF, false);
  return __int_as_float(r);
}
DI float quad_sum(float v) { v += dpp_quad(v, 1); v += dpp_quad(v, 0); return v; }
DI void osm_step(const float (&sv)[16], float& m, float& l, f32x16 (&O)[4], float (&p)[16]) {
  float tmax = fmaxf(fmaxf(fmaxf(sv[0], sv[1]), fmaxf(sv[2], sv[3])), fmaxf(fmaxf(sv[4], sv[5]), fmaxf(sv[6], sv[7])));
  tmax = fmaxf(tmax, fmaxf(fmaxf(fmaxf(sv[8], sv[9]), fmaxf(sv[10], sv[11])), fmaxf(fmaxf(sv[12], sv[13]), fmaxf(sv[14], sv[15]))));
  tmax = hmax(tmax);
  if (__ballot(tmax - m > 8.f)) {
    const float mn = fmaxf(m, tmax);
    const float alpha = ex2(m - mn);
    l *= alpha; m = mn;
#pragma unroll
    for (int dt = 0; dt < 4; ++dt)
#pragma unroll
      for (int r = 0; r < 16; ++r) O[dt][r] *= alpha;
  }
  float ps0 = 0.f, ps1 = 0.f;
#pragma unroll
  for (int r = 0; r < 16; r += 2) { const float e0 = ex2(sv[r] - m), e1 = ex2(sv[r + 1] - m); p[r] = e0; p[r + 1] = e1; ps0 += e0; ps1 += e1; }
  l += ps0 + ps1;
}
DI void ot_store(char* otL, int lane, const f32x16 (&O)[4], float sc) {
#pragma unroll
  for (int dt = 0; dt < 4; ++dt) {
    u32x4 a, b;
#pragma unroll
    for (int i = 0; i < 4; ++i) { a[i] = pack2(sc * O[dt][2 * i], sc * O[dt][2 * i + 1]); b[i] = pack2(sc * O[dt][8 + 2 * i], sc * O[dt][8 + 2 * i + 1]); }
    *(u32x4*)(otL + lane * 128 + dt * 32) = a;
    *(u32x4*)(otL + lane * 128 + dt * 32 + 16) = b;
  }
}
DI void ot_accum(const char* otL, int lane, f32x16 (&O)[4], float sc) {
#pragma unroll
  for (int dt = 0; dt < 4; ++dt) {
    u32x4 a = *(const u32x4*)(otL + lane * 128 + dt * 32);
    u32x4 b = *(const u32x4*)(otL + lane * 128 + dt * 32 + 16);
#pragma unroll
    for (int i = 0; i < 4; ++i) {
      const unsigned wa = a[i], wb = b[i];
      O[dt][2 * i] = fmaf(sc, O[dt][2 * i], __uint_as_float(wa << 16));
      O[dt][2 * i + 1] = fmaf(sc, O[dt][2 * i + 1], __uint_as_float(wa & 0xFFFF0000u));
      O[dt][8 + 2 * i] = fmaf(sc, O[dt][8 + 2 * i], __uint_as_float(wb << 16));
      O[dt][8 + 2 * i + 1] = fmaf(sc, O[dt][8 + 2 * i + 1], __uint_as_float(wb & 0xFFFF0000u));
    }
  }
}
DI void zero_o(f32x16 (&O)[4]) {
#pragma unroll
  for (int dt = 0; dt < 4; ++dt)
#pragma unroll
    for (int i = 0; i < 16; ++i) O[dt][i] = 0.f;
}

constexpr int ATT_PW = 8704;
constexpr int ATT_R = 4, ATT_D = 3;
constexpr int ATT_RING = 8 * ATT_PW;
constexpr int ATT_LIST = ATT_RING + ATT_R * 16384;
constexpr int ATT_BUNI = ATT_LIST + 2048;
constexpr int ATT_SMEM = ATT_BUNI + 64;
#define LAS3 __attribute__((address_space(3)))
__device__ __forceinline__ void d_select(const float* impL, unsigned* mskL, unsigned* uniL, int cur) {
  const int lane = TIDX & 63;
  const int stok = lane >> 3, sub = lane & 7;
  unsigned key[32];
#pragma unroll
  for (int i4 = 0; i4 < 8; ++i4) {
    f32x4 v = *(const f32x4*)(impL + stok * 256 + sub * 32 + i4 * 4);
#pragma unroll
    for (int e = 0; e < 4; ++e) {
      const int j = sub * 32 + i4 * 4 + e;
      const bool valid = j <= cur;
      const bool forced = (j == 0) || (j == cur) || (j == cur - 1);
      unsigned kb = forced ? 0xFFFFFF00u : (__float_as_uint(v[e]) & 0xFFFFFF00u);
      key[i4 * 4 + e] = valid ? (kb | (unsigned)(255 - j)) : 0u;
    }
  }
#pragma unroll
  for (int k = 2; k <= 32; k <<= 1) {
#pragma unroll
    for (int jj = k >> 1; jj > 0; jj >>= 1) {
#pragma unroll
      for (int i = 0; i < 32; ++i) {
        const int l2 = i ^ jj;
        if (l2 > i) {
          const bool desc = ((i & k) == 0);
          unsigned a = key[i], b = key[l2];
          unsigned mx = a > b ? a : b, mn = a > b ? b : a;
          key[i] = desc ? mx : mn; key[l2] = desc ? mn : mx;
        }
      }
    }
  }
#pragma unroll
  for (int xm = 1; xm < 8; xm <<= 1) {
    unsigned L[16];
#pragma unroll
    for (int i = 0; i < 16; ++i) { unsigned o = (unsigned)shx_i((int)key[15 - i], xm); L[i] = key[i] > o ? key[i] : o; }
#pragma unroll
    for (int jj = 8; jj > 0; jj >>= 1) {
#pragma unroll
      for (int i = 0; i < 16; ++i) {
        const int l2 = i ^ jj;
        if (l2 > i) { unsigned a = L[i], b = L[l2]; L[i] = a > b ? a : b; L[l2] = a > b ? b : a; }
      }
    }
#pragma unroll
    for (int i = 0; i < 16; ++i) key[i] = L[i];
  }
#pragma unroll
  for (int i = 0; i < 16; ++i) {
    if ((i & 7) == sub) {
      const int j = 255 - (int)(key[i] & 255u);
      if (j <= cur) { atomicOr(&mskL[stok * 8 + (j >> 5)], 1u << (j & 31)); atomicOr(&uniL[j >> 5], 1u << (j & 31)); }
    }
  }
}


DI void att_issue(LAS3 unsigned char* ring, int slot, int w, int lane, const bf16_t* kb, const bf16_t* vb, int tile) {
  const char* ks = (const char*)kb + (size_t)tile * 8192 + w * 1024 + lane * 16;
  const char* vs = (const char*)vb + (size_t)tile * 8192 + w * 1024 + lane * 16;
  __builtin_amdgcn_global_load_lds((const unsigned*)ks, (LAS3 unsigned*)(ring + slot * 16384 + w * 1024), 16, 0, 0);
  __builtin_amdgcn_global_load_lds((const unsigned*)vs, (LAS3 unsigned*)(ring + slot * 16384 + 8192 + w * 1024), 16, 0, 0);
}
DI f32x16 qk_lds(LAS3 const unsigned char* kt, const bf16x8 (&qf)[8], int lane) {
  f32x16 acc;
#pragma unroll
  for (int i = 0; i < 16; ++i) acc[i] = 0.f;
#pragma unroll
  for (int s8 = 0; s8 < 8; ++s8) {
    const bf16x8 kf = *(LAS3 const bf16x8*)(kt + s8 * 1024 + lane * 16);
    acc = MFMA32(kf, qf[s8], acc);
  }
  return acc;
}
DI void pv_lds(LAS3 const unsigned char* vt, const float (&p)[16], f32x16 (&O)[4], int lane) {
  const bf16x8 pf0 = pack8(p[0], p[1], p[2], p[3], p[4], p[5], p[6], p[7]);
  const bf16x8 pf1 = pack8(p[8], p[9], p[10], p[11], p[12], p[13], p[14], p[15]);
#pragma unroll
  for (int dt = 0; dt < 4; ++dt) {
    const bf16x8 v0 = *(LAS3 const bf16x8*)(vt + (dt * 2) * 1024 + lane * 16);
    const bf16x8 v1 = *(LAS3 const bf16x8*)(vt + (dt * 2 + 1) * 1024 + lane * 16);
    O[dt] = MFMA32(v0, pf0, O[dt]);
    O[dt] = MFMA32(v1, pf1, O[dt]);
  }
}

__device__ __forceinline__ void d_attn_block(int B, int g, char* smem, const AttnPtrs& P) {
  const int tid = TIDX, lane = tid & 63, w = tid >> 6;
  const int c = lane & 31, h = lane >> 5, tokl = c >> 2, r = c & 3;
  const int tok0 = 64 * B + 8 * w;
  const int t = tok0 + tokl, hd = g * 4 + r;
  const float slope2 = exp2f(-(float)(hd + 1)) * LOG2E;
  const float c1 = QSCALE * LOG2E;
  const float ninf = -__builtin_inff();
  char* wsm = smem + w * ATT_PW;
  float* impL = (float*)wsm;
  char* otL = wsm;
  unsigned* mskL = (unsigned*)(wsm + 8192);
  unsigned* uniL = mskL + 64;
  LAS3 unsigned char* ring = (LAS3 unsigned char*)(smem + ATT_RING);
  unsigned short* tl = (unsigned short*)(smem + ATT_LIST);
  unsigned* buni = (unsigned*)(smem + ATT_BUNI);
  const bf16_t* kcf = P.kcf + (size_t)g * 32 * 4096;
  const bf16_t* vcf = P.vcf + (size_t)g * 32 * 4096;
  const bf16_t* ksf = P.ksf + (size_t)g * 512 * 4096;
  const bf16_t* vsf = P.vsf + (size_t)g * 512 * 4096;
  const bf16_t* kwf = P.kwf + (size_t)g * 512 * 4096;
  const bf16_t* vwf = P.vwf + (size_t)g * 512 * 4096;
  bf16x8 qf[8];
  {
    const bf16_t* qrow = P.proj + (size_t)t * INWP + OFF_Q + hd * 128 + 8 * h;
#pragma unroll
    for (int s8 = 0; s8 < 8; ++s8) qf[s8] = *(const bf16x8*)(qrow + 16 * s8);
  }
  const float* gt = P.gates + (size_t)t * 24 + hd * 3;
  const float g0 = gt[0], g1 = gt[1], g2 = gt[2];
  {
    unsigned z0 = 0u;
    asm volatile("" : "+v"(z0));
    u32x4 z = {z0, z0, z0, z0};
#pragma unroll
    for (int i = 0; i < 8; ++i) *(u32x4*)(wsm + (i * 64 + lane) * 16) = z;
    if (lane < 18) *(u32x4*)(wsm + 8192 + lane * 16) = z;
    if (tid < 8) buni[tid] = z0;
  }
  f32x16 Ob[4];
  zero_o(Ob);
  const int nmax = (t >= 31) ? ((t - 31) >> 4) : -1;
  const int nmaxw = (tok0 + 7 >= 31) ? ((tok0 + 7 - 31) >> 4) : -1;
  const int nminw = (tok0 >= 31) ? ((tok0 - 31) >> 4) : -1;
  const int ntcw = (nmaxw + 32) >> 5;
  const int ntcB = (((64 * B + 63 - 31) >> 4) + 32) >> 5;
  const float sl16 = slope2 * 16.f;
  float mC = NEGB, lC = 0.f, invC = 0.f, carry = 0.f;
  {
    const int n = 2 * ntcB;
    asm volatile("s_waitcnt vmcnt(0)" ::: "memory");
#define A_TILE(i_) (((i_) < ntcB) ? (ntcB - 1 - (i_)) : ((i_) - ntcB))
    att_issue(ring, 0, w, lane, kcf, vcf, A_TILE(0));
    if (n > 1) att_issue(ring, 1, w, lane, kcf, vcf, A_TILE(1));
#pragma unroll 1
    for (int i = 0; i < n; ++i) {
      if ((i & 1) == 0) {
        asm volatile("s_waitcnt vmcnt(0)" ::: "memory");
        __builtin_amdgcn_s_barrier();
        asm volatile("" ::: "memory");
        if (i + 2 < n) att_issue(ring, (i + 2) & 3, w, lane, kcf, vcf, A_TILE(i + 2));
        if (i + 3 < n) att_issue(ring, (i + 3) & 3, w, lane, kcf, vcf, A_TILE(i + 3));
      }
      const int T = A_TILE(i);
      if (T >= ntcw) continue;
      LAS3 const unsigned char* slot = ring + (i % ATT_R) * 16384;
      const f32x16 acc = qk_lds(slot, qf, lane);
      const float base = slope2 * (float)(512 * T + 128 * h) + slope2 * (15.5f - (float)t);
      const int nb = 32 * T + 8 * h;
      const bool full = (32 * T + 31 <= nminw);
      float sv[16];
#pragma unroll
      for (int rg = 0; rg < 16; ++rg) { const int kk = (rg & 7) + 16 * (rg >> 3); sv[rg] = fmaf(acc[rg], c1, fmaf(sl16, (float)kk, base)); }
      if (!full) {
#pragma unroll
        for (int rg = 0; rg < 16; ++rg) { const int kk = (rg & 7) + 16 * (rg >> 3); sv[rg] = (nb + kk <= nmax) ? sv[rg] : ninf; }
      }
      if (i < ntcB) {
        float tmax = fmaxf(fmaxf(fmaxf(sv[0], sv[1]), fmaxf(sv[2], sv[3])), fmaxf(fmaxf(sv[4], sv[5]), fmaxf(sv[6], sv[7])));
        tmax = fmaxf(tmax, fmaxf(fmaxf(fmaxf(sv[8], sv[9]), fmaxf(sv[10], sv[11])), fmaxf(fmaxf(sv[12], sv[13]), fmaxf(sv[14], sv[15]))));
        tmax = hmax(tmax);
        const float mn = fmaxf(mC, tmax);
        float ps = 0.f;
#pragma unroll
        for (int rg = 0; rg < 16; ++rg) ps += ex2(sv[rg] - mn);
        lC = lC * ex2(mC - mn) + ps; mC = mn;
      } else {
        if (T == 0) { lC = hsum(lC); invC = (lC > 0.f) ? 1.f / lC : 0.f; }
        float p[16];
#pragma unroll
        for (int rg = 0; rg < 16; ++rg) p[rg] = ex2(sv[rg] - mC) * invC;
        float Ga = (p[0] + p[1]) + (p[2] + p[3]), Gb = (p[4] + p[5]) + (p[6] + p[7]);
        float Gc = (p[8] + p[9]) + (p[10] + p[11]), Gd = (p[12] + p[13]) + (p[14] + p[15]);
        float xb, xd; { float a_, b_; halves(p[7], a_, b_); xb = h ? a_ : b_; halves(p[15], a_, b_); xd = h ? a_ : b_; }
        float ia = Ga + (h ? xb : carry);
        float ib = Gb + p[3];
        float ic = Gc + (h ? xd : xb);
        float id = Gd + p[11];
        carry = xd;
        ia = quad_sum(ia); ib = quad_sum(ib); ic = quad_sum(ic); id = quad_sum(id);
        {
          float val = (r == 0) ? ia : (r == 1) ? ib : (r == 2) ? ic : id;
          int j = 8 * T + 2 * h + ((r == 0) ? 0 : (r == 1) ? 1 : (r == 2) ? 4 : 5);
          impL[tokl * 256 + j] = val;
        }
        pv_lds(slot + 8192, p, Ob, lane);
      }
    }
#undef A_TILE
  }
  const int cur = B;
  d_select(impL, mskL, uniL, cur);
  ot_store(otL, lane, Ob, g0);
  zero_o(Ob);
  if (lane < 8) { const unsigned u = uniL[lane]; if (u) atomicOr(&buni[lane], u); }
  __syncthreads();
  int nslc = 0, ntl = 0;
  {
    for (int iw = 7; iw >= 0; --iw) {
      unsigned iuw = __builtin_amdgcn_readfirstlane(buni[iw]);
      while (iuw) {
        const int bit = 31 - __builtin_clz(iuw);
        iuw &= ~(1u << bit);
        const int bb = 32 * iw + bit;
        if (bb < B) { if (lane == 0) tl[ntl] = (unsigned short)(2 * bb + 1); ++ntl; }
        else { if (lane == 0) tl[ntl] = (unsigned short)(2 * bb + 1); ++ntl; }
        if (lane == 0) tl[ntl] = (unsigned short)(2 * bb);
        ++ntl;
      }
    }
    nslc = ntl;
    const int ThiB = 2 * B + 1, TloB = ((64 * B - 511 > 0) ? (64 * B - 511) : 0) >> 5;
    for (int T = ThiB; T >= TloB; --T) { if (lane == 0) tl[ntl] = (unsigned short)T; ++ntl; }
  }
  float m = NEGB, l = 0.f;
  {
    const int n = ntl;
    const int Tlow = ((tok0 - 511 > 0) ? (tok0 - 511) : 0) >> 5, Thiw = (tok0 + 7) >> 5;
#define B_ISSUE(j_, slot_) { const int e_ = __builtin_amdgcn_readfirstlane((int)tl[j_]); if ((j_) < nslc) att_issue(ring, slot_, w, lane, ksf, vsf, e_); else att_issue(ring, slot_, w, lane, kwf, vwf, e_); }
    B_ISSUE(0, 0)
    if (n > 1) B_ISSUE(1, 1)
#pragma unroll 1
    for (int i = 0; i < n; ++i) {
      if ((i & 1) == 0) {
        asm volatile("s_waitcnt vmcnt(0)" ::: "memory");
        __builtin_amdgcn_s_barrier();
        asm volatile("" ::: "memory");
        if (i + 2 < n) B_ISSUE(i + 2, (i + 2) & 3)
        if (i + 3 < n) B_ISSUE(i + 3, (i + 3) & 3)
      }
      if (i == nslc) {
        l = hsum(l);
        const float inv = (l > 0.f) ? g1 / l : 0.f;
        ot_accum(otL, lane, Ob, inv);
        ot_store(otL, lane, Ob, 1.f);
        zero_o(Ob);
        m = NEGB; l = 0.f;
      }
      const int T = __builtin_amdgcn_readfirstlane((int)tl[i]);
      const int pos0 = 32 * T, pb = pos0 + 8 * h;
      bool full; bool mine = true;
      if (i < nslc) {
        const int bb = T >> 1;
        const unsigned uw = __builtin_amdgcn_readfirstlane(uniL[bb >> 5]);
        if (!((uw >> (bb & 31)) & 1u) || pos0 > tok0 + 7) continue;
        mine = (mskL[tokl * 8 + (bb >> 5)] >> (bb & 31)) & 1u;
        full = (pos0 + 31 <= tok0) && (__ballot(!mine) == 0ull);
      } else {
        if (T < Tlow || T > Thiw) continue;
        full = (pos0 + 31 <= tok0) && (pos0 >= tok0 + 7 - 511);
      }
      LAS3 const unsigned char* slot = ring + (i % ATT_R) * 16384;
      const f32x16 acc = qk_lds(slot, qf, lane);
      const float base = slope2 * (float)(pos0 + 8 * h - t);
      float sv[16], p[16];
#pragma unroll
      for (int rg = 0; rg < 16; ++rg) { const int kk = (rg & 7) + 16 * (rg >> 3); sv[rg] = fmaf(acc[rg], c1, fmaf(slope2, (float)kk, base)); }
      if (!full) {
        if (i < nslc) {
#pragma unroll
          for (int rg = 0; rg < 16; ++rg) { const int kk = (rg & 7) + 16 * (rg >> 3); sv[rg] = (mine && (pb + kk <= t)) ? sv[rg] : ninf; }
        } else {
#pragma unroll
          for (int rg = 0; rg < 16; ++rg) { const int kk = (rg & 7) + 16 * (rg >> 3); const int dw = t - (pb + kk); sv[rg] = ((dw >= 0) && (dw < 512)) ? sv[rg] : ninf; }
        }
      }
      osm_step(sv, m, l, Ob, p);
      pv_lds(slot + 8192, p, Ob, lane);
    }
#undef B_ISSUE
    l = hsum(l);
    const float inv = (l > 0.f) ? g2 / l : 0.f;
    ot_accum(otL, lane, Ob, inv);
  }
  {
    float ss = 0.f;
#pragma unroll
    for (int dt = 0; dt < 4; ++dt)
#pragma unroll
      for (int i = 0; i < 16; ++i) ss = fmaf(Ob[dt][i], Ob[dt][i], ss);
    ss = hsum(ss);
    const float rs = rsqrtf(ss * (1.f / 128.f) + 1e-6f);
    bf16_t* orow = P.mix + (size_t)t * DM + hd * 128 + 4 * h;
    const float* grow = P.hng + hd * 128 + 4 * h;
#pragma unroll
    for (int dt = 0; dt < 4; ++dt)
#pragma unroll
      for (int a = 0; a < 4; ++a) {
        const f32x4 gv = *(const f32x4*)(grow + 32 * dt + 8 * a);
        u32x2 wv2 = {pack2(Ob[dt][4 * a] * rs * gv[0], Ob[dt][4 * a + 1] * rs * gv[1]), pack2(Ob[dt][4 * a + 2] * rs * gv[2], Ob[dt][4 * a + 3] * rs * gv[3])};
        *(u32x2*)(orow + 32 * dt + 8 * a) = wv2;
      }
  }
  asm volatile("s_waitcnt vmcnt(0)" ::: "memory");
  __syncthreads();
}

__device__ void d_convmix(int t, int tl, const bf16_t* __restrict__ proj, const float* __restrict__ convw, const float* __restrict__ hng,
                          bf16_t* __restrict__ mix) {
  const int c = tl * 8;
  float acc[8];
#pragma unroll
  for (int i = 0; i < 8; ++i) acc[i] = 0.f;
#pragma unroll
  for (int j = 0; j < 3; ++j) {
    const int tt = t - 2 + j;
    if (tt >= 0) {
      const u32x4 cu = *(const u32x4*)(proj + (size_t)tt * INWP + OFF_C + c);
      const u32x4 uu = *(const u32x4*)(proj + (size_t)tt * INWP + OFF_U + c);
      const f32x4 w0 = *(const f32x4*)(convw + j * 1024 + c), w1 = *(const f32x4*)(convw + j * 1024 + c + 4);
#pragma unroll
      for (int i = 0; i < 4; ++i) {
        const unsigned a = cu[i], b = uu[i];
        const float wl = (i < 2) ? w0[2 * i] : w1[2 * i - 4], wh = (i < 2) ? w0[2 * i + 1] : w1[2 * i - 3];
        acc[2 * i] = fmaf(wl * __uint_as_float(a << 16), __uint_as_float(b << 16), acc[2 * i]);
        acc[2 * i + 1] = fmaf(wh * __uint_as_float(a & 0xFFFF0000u), __uint_as_float(b & 0xFFFF0000u), acc[2 * i + 1]);
      }
    }
  }
  const u32x4 bb = *(const u32x4*)(proj + (size_t)t * INWP + OFF_B + c);
  float ss = 0.f;
#pragma unroll
  for (int i = 0; i < 4; ++i) {
    const unsigned b = bb[i];
    acc[2 * i] *= __uint_as_float(b << 16); acc[2 * i + 1] *= __uint_as_float(b & 0xFFFF0000u);
    ss = fmaf(acc[2 * i], acc[2 * i], ss); ss = fmaf(acc[2 * i + 1], acc[2 * i + 1], ss);
  }
  ss += shx(ss, 8); ss += shx(ss, 4); ss += shx(ss, 2); ss += shx(ss, 1);
  const float rs = rsqrtf(ss * (1.f / 128.f) + 1e-6f);
  const f32x4 g0 = *(const f32x4*)(hng + 1024 + c), g1 = *(const f32x4*)(hng + 1024 + c + 4);
  u32x4 o = {pack2(acc[0] * rs * g0[0], acc[1] * rs * g0[1]), pack2(acc[2] * rs * g0[2], acc[3] * rs * g0[3]),
             pack2(acc[4] * rs * g1[0], acc[5] * rs * g1[1]), pack2(acc[6] * rs * g1[2], acc[7] * rs * g1[3])};
  *(u32x4*)(mix + (size_t)t * DM + 1024 + c) = o;
}
DI void d_convmix2(int t0, int tl, const bf16_t* __restrict__ proj, const float* __restrict__ convw, const float* __restrict__ hng, bf16_t* __restrict__ mix) {
  const int c = tl * 8;
  u32x4 cu[2][3], uu[2][3], bb[2];
#pragma unroll
  for (int q = 0; q < 2; ++q) {
    const int t = t0 + 4 * q;
#pragma unroll
    for (int j = 0; j < 3; ++j) {
      const int tt = t - 2 + j, tc = tt >= 0 ? tt : 0;
      cu[q][j] = *(const u32x4*)(proj + (size_t)tc * INWP + OFF_C + c);
      uu[q][j] = *(const u32x4*)(proj + (size_t)tc * INWP + OFF_U + c);
    }
    bb[q] = *(const u32x4*)(proj + (size_t)t * INWP + OFF_B + c);
  }
  f32x4 w0[3], w1[3];
#pragma unroll
  for (int j = 0; j < 3; ++j) { w0[j] = *(const f32x4*)(convw + j * 1024 + c); w1[j] = *(const f32x4*)(convw + j * 1024 + c + 4); }
  const f32x4 g0 = *(const f32x4*)(hng + 1024 + c), g1 = *(const f32x4*)(hng + 1024 + c + 4);
#pragma unroll
  for (int q = 0; q < 2; ++q) {
    const int t = t0 + 4 * q;
    float acc[8];
#pragma unroll
    for (int i = 0; i < 8; ++i) acc[i] = 0.f;
#pragma unroll
    for (int j = 0; j < 3; ++j) {
      if (t - 2 + j >= 0) {
#pragma unroll
        for (int i = 0; i < 4; ++i) {
          const unsigned a = cu[q][j][i], b = uu[q][j][i];
          const float wl = (i < 2) ? w0[j][2 * i] : w1[j][2 * i - 4], wh = (i < 2) ? w0[j][2 * i + 1] : w1[j][2 * i - 3];
          acc[2 * i] = fmaf(wl * __uint_as_float(a << 16), __uint_as_float(b << 16), acc[2 * i]);
          acc[2 * i + 1] = fmaf(wh * __uint_as_float(a & 0xFFFF0000u), __uint_as_float(b & 0xFFFF0000u), acc[2 * i + 1]);
        }
      }
    }
    float ss = 0.f;
#pragma unroll
    for (int i = 0; i < 4; ++i) {
      const unsigned b = bb[q][i];
      acc[2 * i] *= __uint_as_float(b << 16); acc[2 * i + 1] *= __uint_as_float(b & 0xFFFF0000u);
      ss = fmaf(acc[2 * i], acc[2 * i], ss); ss = fmaf(acc[2 * i + 1], acc[2 * i + 1], ss);
    }
    ss += shx(ss, 8); ss += shx(ss, 4); ss += shx(ss, 2); ss += shx(ss, 1);
    const float rs = rsqrtf(ss * (1.f / 128.f) + 1e-6f);
    u32x4 o = {pack2(acc[0] * rs * g0[0], acc[1] * rs * g0[1]), pack2(acc[2] * rs * g0[2], acc[3] * rs * g0[3]),
               pack2(acc[4] * rs * g1[0], acc[5] * rs * g1[1]), pack2(acc[6] * rs * g1[2], acc[7] * rs * g1[3])};
    *(u32x4*)(mix + (size_t)t * DM + 1024 + c) = o;
  }
}

DI void d_ln_fin(int t, const u32x4 (&wr)[4], bf16_t* __restrict__ yh, const float* __restrict__ gam, const float* __restrict__ bet) {
  const int lane = TIDX & 63;
  float v[32];
#pragma unroll
  for (int i = 0; i < 4; ++i) {
    const u32x4 w = wr[i];
#pragma unroll
    for (int j = 0; j < 4; ++j) { const unsigned ww = w[j]; v[i * 8 + 2 * j] = __uint_as_float(ww << 16); v[i * 8 + 2 * j + 1] = __uint_as_float(ww & 0xFFFF0000u); }
  }
  float s = 0.f;
#pragma unroll
  for (int i = 0; i < 32; ++i) s += v[i];
  s = wave_sum(s);
  const float mu = s * (1.f / DM);
  float q = 0.f;
#pragma unroll
  for (int i = 0; i < 32; ++i) { const float d = v[i] - mu; q = fmaf(d, d, q); }
  q = wave_sum(q);
  const float rs = rsqrtf(q * (1.f / DM) + 1e-5f);
#pragma unroll
  for (int i = 0; i < 4; ++i) {
    const int cb = 512 * i + 8 * lane;
    const f32x4 g0 = *(const f32x4*)(gam + cb), g1 = *(const f32x4*)(gam + cb + 4), b0 = *(const f32x4*)(bet + cb), b1 = *(const f32x4*)(bet + cb + 4);
    u32x4 o = {pack2((v[i * 8 + 0] - mu) * rs * g0[0] + b0[0], (v[i * 8 + 1] - mu) * rs * g0[1] + b0[1]), pack2((v[i * 8 + 2] - mu) * rs * g0[2] + b0[2], (v[i * 8 + 3] - mu) * rs * g0[3] + b0[3]),
               pack2((v[i * 8 + 4] - mu) * rs * g1[0] + b1[0], (v[i * 8 + 5] - mu) * rs * g1[1] + b1[1]), pack2((v[i * 8 + 6] - mu) * rs * g1[2] + b1[2], (v[i * 8 + 7] - mu) * rs * g1[3] + b1[3])};
    *(u32x4*)(yh + (size_t)t * DM + cb) = o;
  }
}

__device__ void d_cvt_w1f(size_t c, const float* __restrict__ w1, bf16_t* __restrict__ w1f) {
  const int lane = c & 63, ks = (c >> 6) & 255, ct = c >> 14;
  const int col = lane & 31, h = lane >> 5;
  bf16_t v[8];
#pragma unroll
  for (int j = 0; j < 8; ++j) v[j] = f2bf(w1[(size_t)(16 * ks + 8 * h + j) * 512 + 32 * ct + col]);
  u32x4 o; o.x = v[0] | ((unsigned)v[1] << 16); o.y = v[2] | ((unsigned)v[3] << 16); o.z = v[4] | ((unsigned)v[5] << 16); o.w = v[6] | ((unsigned)v[7] << 16);
  *(u32x4*)(w1f + c * 8) = o;
}
__device__ void d_cvt_w2f(size_t c, const float* __restrict__ w2, bf16_t* __restrict__ w2f) {
  const int lane = c & 63, s = (c >> 6) & 31, ct = c >> 11;
  const int col = lane & 31, h = lane >> 5;
  bf16_t v[8];
#pragma unroll
  for (int j = 0; j < 8; ++j) v[j] = f2bf(w2[(size_t)(16 * s + 8 * h + j) * 128 + 32 * ct + col]);
  u32x4 o; o.x = v[0] | ((unsigned)v[1] << 16); o.y = v[2] | ((unsigned)v[3] << 16); o.z = v[4] | ((unsigned)v[5] << 16); o.w = v[6] | ((unsigned)v[7] << 16);
  *(u32x4*)(w2f + c * 8) = o;
}
__device__ __forceinline__ void d_compress_unit(int rt, char* smem, const bf16_t* __restrict__ proj, int col0, const float* __restrict__ pos,
                                const bf16_t* __restrict__ w1f, const float* __restrict__ b1, const bf16_t* __restrict__ w2f,
                                bf16_t* __restrict__ outf, bool isV) {
  bf16_t* Xs = (bf16_t*)smem;
  bf16_t* Hs = (bf16_t*)(smem + 2 * 8704);
  const int tid = TIDX, lane = tid & 63, w = tid >> 6, c = lane & 31, h = lane >> 5;
  const int R0 = rt * 32;
  const int srow = tid >> 4, sch = tid & 15;
  const int grow = R0 + srow, sn = grow >> 1, sg = grow & 1;
  const bool svalid = grow < 2046;
  const bf16_t* sp = proj + (size_t)(16 * sn) * INWP + col0 + sg * 128 + sch * 8;
  f32x16 acc0, acc1;
#pragma unroll
  for (int i = 0; i < 16; ++i) { acc0[i] = 0.f; acc1[i] = 0.f; }
  u32x4 rx = {0u, 0u, 0u, 0u}; f32x4 rp0, rp1;
#define STAGE_WRITE(buf)                                                                                   \
  {                                                                                                        \
    u32x4 o_;                                                                                              \
    _Pragma("unroll") for (int i = 0; i < 4; ++i) {                                                        \
      const unsigned wv_ = rx[i];                                                                          \
      const float lo = __uint_as_float(wv_ << 16) + ((i < 2) ? rp0[2 * i] : rp1[2 * i - 4]);               \
      const float hi = __uint_as_float(wv_ & 0xFFFF0000u) + ((i < 2) ? rp0[2 * i + 1] : rp1[2 * i - 3]);   \
      o_[i] = pack2(lo, hi);                                                                               \
    }                                                                                                      \
    *(u32x4*)(Xs + (buf) * 4352 + srow * 136 + sch * 8) = o_;                                              \
  }
  if (svalid) rx = *(const u32x4*)(sp);
  rp0 = *(const f32x4*)(pos + sch * 8); rp1 = *(const f32x4*)(pos + sch * 8 + 4);
  STAGE_WRITE(0)
  __syncthreads();
  const bf16_t* wb0 = w1f + ((size_t)(2 * w) * 256 * 64 + lane) * 8;
  const bf16_t* wb1 = w1f + ((size_t)(2 * w + 1) * 256 * 64 + lane) * 8;
  bf16x8 bA[16], bB[16];
#define CMP_LOADB(BUF, L)                                                                      \
  _Pragma("unroll") for (int s8 = 0; s8 < 8; ++s8) {                                           \
    BUF[2 * s8] = *(const bf16x8*)(wb0 + (size_t)(8 * (L) + s8) * 512);                        \
    BUF[2 * s8 + 1] = *(const bf16x8*)(wb1 + (size_t)(8 * (L) + s8) * 512);                    \
  }
#define CMP_LOADX(L)                                                                           \
  if ((L) < 32) {     \
    if (svalid) rx = *(const u32x4*)(sp + (size_t)(L) * INWP);                                 \
    rp0 = *(const f32x4*)(pos + (L) * 128 + sch * 8); rp1 = *(const f32x4*)(pos + (L) * 128 + sch * 8 + 4); \
  }
#define CMP_CHUNK(BUF, L)                                                                      \
  {                                                                                            \
    const bf16_t* xa = Xs + ((L) & 1) * 4352 + c * 136 + 8 * h;                                \
    _Pragma("unroll") for (int s8 = 0; s8 < 8; ++s8) {                                         \
      const bf16x8 a = *(const bf16x8*)(xa + 16 * s8);                                         \
      acc0 = MFMA32(a, BUF[2 * s8], acc0);                                                     \
      acc1 = MFMA32(a, BUF[2 * s8 + 1], acc1);                                                 \
    }                                                                                          \
    if ((L) + 1 < 32) STAGE_WRITE(((L) + 1) & 1)                                               \
    __syncthreads();                                                                           \
  }
  CMP_LOADB(bA, 0)
#pragma unroll 1
  for (int l = 0; l < 32; l += 2) {
    CMP_LOADX(l + 1)
    CMP_LOADB(bB, l + 1)
    __builtin_amdgcn_sched_barrier(0);
    CMP_CHUNK(bA, l)
    __builtin_amdgcn_sched_barrier(0);
    CMP_LOADX(l + 2)
    { const int ln = (l + 2 < 32) ? l + 2 : l;
      CMP_LOADB(bA, ln) }
    __builtin_amdgcn_sched_barrier(0);
    CMP_CHUNK(bB, l + 1)
    __builtin_amdgcn_sched_barrier(0);
  }
#undef CMP_LOADX
#undef CMP_LOADB
#undef CMP_CHUNK
  {
    const float bb0 = b1[64 * w + c], bb1 = b1[64 * w + 32 + c];
#pragma unroll
    for (int rg = 0; rg < 16; ++rg) {
      const int row = (rg & 3) + 8 * (rg >> 2) + 4 * h;
      Hs[row * 520 + 64 * w + c] = f2bf(gelu_tanh(acc0[rg] + bb0));
      Hs[row * 520 + 64 * w + 32 + c] = f2bf(gelu_tanh(acc1[rg] + bb1));
    }
  }
  __syncthreads();
  if (w < 4) {
    f32x16 o2;
#pragma unroll
    for (int i = 0; i < 16; ++i) o2[i] = 0.f;
    const bf16_t* ha = Hs + c * 520 + 8 * h;
    const bf16_t* wb = w2f + ((size_t)w * 32 * 64 + lane) * 8;
#pragma unroll 8
    for (int s2 = 0; s2 < 32; ++s2) {
      const bf16x8 a = *(const bf16x8*)(ha + 16 * s2);
      const bf16x8 b = *(const bf16x8*)(wb + (size_t)s2 * 512);
      o2 = MFMA32(a, b, o2);
    }
    const int d = 32 * w + c;
#pragma unroll
    for (int rg = 0; rg < 16; ++rg) {
      const int row = R0 + (rg & 3) + 8 * (rg >> 2) + 4 * h;
      const int n = row >> 1, g = row & 1;
      const bf16_t val = (row < 2046) ? f2bf(o2[rg]) : (bf16_t)0;
      const int T = n >> 5, nn = n & 31;
      size_t idx;
      if (!isV) idx = ((((size_t)(g * 32 + T) * 8 + (d >> 4)) * 64 + (pi_perm(nn) + 32 * ((d >> 3) & 1))) * 8 + (d & 7));
      else idx = (((((size_t)(g * 32 + T) * 4 + (d >> 5)) * 2 + (nn >> 4)) * 64 + ((d & 31) + 32 * ((nn >> 3) & 1))) * 8 + (nn & 7));
      outf[idx] = val;
    }
  }
  __syncthreads();
}


DI unsigned f2sort(float f) { unsigned u = __float_as_uint(f); return u ^ ((unsigned)((int)u >> 31) | 0x80000000u); }
DI float sort2f(unsigned k) { unsigned u = (k & 0x80000000u) ? (k ^ 0x80000000u) : ~k; return __uint_as_float(u); }
template <int N>
DI void bitonic_sort_desc(unsigned (&key)[N]) {
#pragma unroll
  for (int k = 2; k <= N; k <<= 1) {
#pragma unroll
    for (int jj = k >> 1; jj > 0; jj >>= 1) {
#pragma unroll
      for (int i = 0; i < N; ++i) {
        const int l2 = i ^ jj;
        if (l2 > i) {
          const bool desc = ((i & k) == 0);
          unsigned a = key[i], b = key[l2];
          unsigned mx = a > b ? a : b, mn = a > b ? b : a;
          key[i] = desc ? mx : mn; key[l2] = desc ? mn : mx;
        }
      }
    }
  }
}
DI void merge_top16(unsigned (&a)[16], const unsigned (&b)[16]) {
#pragma unroll
  for (int i = 0; i < 16; ++i) { unsigned o = b[15 - i]; a[i] = a[i] > o ? a[i] : o; }
#pragma unroll
  for (int jj = 8; jj > 0; jj >>= 1) {
#pragma unroll
    for (int i = 0; i < 16; ++i) {
      const int l2 = i ^ jj;
      if (l2 > i) { unsigned x = a[i], y = a[l2]; a[i] = x > y ? x : y; a[l2] = x > y ? y : x; }
    }
  }
}
__device__ void d_cvt_subk(size_t c, const float* __restrict__ subk, bf16_t* __restrict__ skf) {
  int lane = c & 63, s = (c >> 6) & 7, kt = (c >> 9) & 3, hc = c >> 11;
  int i = lane & 31, h = lane >> 5;
  const float* src = subk + ((size_t)hc * 128 + 32 * kt + i) * 128 + 16 * s + 8 * h;
  bf16_t v[8];
#pragma unroll
  for (int j = 0; j < 8; ++j) v[j] = f2bf(src[j]);
  u32x4 o; o.x = v[0] | ((unsigned)v[1] << 16); o.y = v[2] | ((unsigned)v[3] << 16); o.z = v[4] | ((unsigned)v[5] << 16); o.w = v[6] | ((unsigned)v[7] << 16);
  *(u32x4*)(skf + c * 8) = o;
}

#define EPI_LANES()                                                                                                      \
    const int lane = fr | (fq << 4), rr = lane >> 2, rc = lane & 3;                                                       \
    PG8_LAS unsigned char* my = scr + (wr * 4 + wc) * 2048;                                                              \
    const int wo = fr * 64 + ((fq ^ ((fr >> 2) & 3)) << 4), ro = rr * 64 + ((rc ^ ((rr >> 2) & 3)) << 4);
struct EpiProjG {
  static constexpr bool PERM = true, AFTER_DRAIN = false;
  bf16_t* proj; float* gates; PG8_LAS unsigned char* scr;
  DI void operator()(const f32x4 (&acc)[2][2][4][2], const pg8::Unit& u, int wr, int wc, int fr, int fq) const {
    EPI_LANES()
#pragma unroll
    for (int ai = 0; ai < 2; ++ai)
#pragma unroll
      for (int bj = 0; bj < 2; ++bj) {
        const int c0 = u.pn * 256 + bj * 128 + wc * 32 + 8 * fq, cs = u.pn * 256 + bj * 128 + wc * 32 + 8 * rc;
#pragma unroll
        for (int mh = 0; mh < 2; ++mh) {
#pragma unroll
          for (int mm = 0; mm < 2; ++mm) {
            const f32x4 v0 = acc[ai][bj][mh * 2 + mm][0], v1 = acc[ai][bj][mh * 2 + mm][1];
            u32x4 w = {pack2(v0[0], v0[1]), pack2(v0[2], v0[3]), pack2(v1[0], v1[1]), pack2(v1[2], v1[3])};
            *(PG8_LAS u32x4*)(my + wo + mm * 1024) = w;
            if (c0 >= OFF_G && c0 < OFF_G + 24) {
              const int row = u.pm * 256 + ai * 128 + wr * 64 + (mh * 2 + mm) * 16 + fr;
              f32x4 g0, g1;
#pragma unroll
              for (int j = 0; j < 4; ++j) { g0[j] = 1.f / (1.f + __expf(-v0[j])); g1[j] = 1.f / (1.f + __expf(-v1[j])); }
              *(f32x4*)(gates + (size_t)row * 24 + (c0 - OFF_G)) = g0;
              *(f32x4*)(gates + (size_t)row * 24 + (c0 - OFF_G) + 4) = g1;
            }
          }
#pragma unroll
          for (int j = 0; j < 2; ++j) {
            const u32x4 w = *(const PG8_LAS u32x4*)(my + ro + j * 1024);
            const int row = u.pm * 256 + ai * 128 + wr * 64 + mh * 32 + j * 16 + rr;
            if (cs < INW) *(u32x4*)(proj + (size_t)row * INWP + cs) = w;
          }
        }
      }
  }
};
struct EpiResG {
  static constexpr bool PERM = true, AFTER_DRAIN = false;
  bf16_t* YB; PG8_LAS unsigned char* scr;
  DI void operator()(const f32x4 (&acc)[2][2][4][2], const pg8::Unit& u, int wr, int wc, int fr, int fq) const {
    EPI_LANES()
    bf16_t* yb = YB + (size_t)(u.pm * 256 + wr * 64 + rr) * DM + u.pn * 256 + wc * 32 + 8 * rc;
#pragma unroll
    for (int ai = 0; ai < 2; ++ai) {
      u32x4 xr[2][2][2];
#pragma unroll
      for (int bj = 0; bj < 2; ++bj)
#pragma unroll
        for (int mh = 0; mh < 2; ++mh)
#pragma unroll
          for (int j = 0; j < 2; ++j) xr[bj][mh][j] = *(const u32x4*)(yb + (size_t)(ai * 128 + mh * 32 + j * 16) * DM + bj * 128);
#pragma unroll
      for (int bj = 0; bj < 2; ++bj)
#pragma unroll
        for (int mh = 0; mh < 2; ++mh) {
#pragma unroll
          for (int mm = 0; mm < 2; ++mm) {
            const f32x4 v0 = acc[ai][bj][mh * 2 + mm][0], v1 = acc[ai][bj][mh * 2 + mm][1];
            u32x4 w = {pack2(v0[0], v0[1]), pack2(v0[2], v0[3]), pack2(v1[0], v1[1]), pack2(v1[2], v1[3])};
            *(PG8_LAS u32x4*)(my + wo + mm * 1024) = w;
          }
#pragma unroll
          for (int j = 0; j < 2; ++j) {
            const u32x4 a = *(const PG8_LAS u32x4*)(my + ro + j * 1024), xw = xr[bj][mh][j];
            u32x4 o;
#pragma unroll
            for (int q = 0; q < 4; ++q) {
              const unsigned aw = a[q], xq = xw[q];
              o[q] = pack2(fmaf(ALPHA, __uint_as_float(xq << 16), __uint_as_float(aw << 16)), fmaf(ALPHA, __uint_as_float(xq & 0xFFFF0000u), __uint_as_float(aw & 0xFFFF0000u)));
            }
            *(u32x4*)(yb + (size_t)(ai * 128 + mh * 32 + j * 16) * DM + bj * 128) = o;
          }
        }
    }
  }
};
struct EpiF32G {
  static constexpr bool PERM = false, AFTER_DRAIN = false;
  float* C; int ldc;
  DI void operator()(const f32x4 (&acc)[2][2][4][2], const pg8::Unit& u, int wr, int wc, int fr, int fq) const {
#pragma unroll
    for (int ai = 0; ai < 2; ++ai)
#pragma unroll
      for (int m = 0; m < 4; ++m) {
        const size_t ro = (size_t)(u.pm * 256 + ai * 128 + wr * 64 + m * 16 + fr) * ldc + u.pn * 256 + wc * 32 + 4 * fq;
#pragma unroll
        for (int bj = 0; bj < 2; ++bj)
#pragma unroll
          for (int n = 0; n < 2; ++n) *(f32x4*)(C + ro + bj * 128 + n * 16) = acc[ai][bj][m][n];
      }
  }
};
struct EpiRouteG {
  static constexpr bool PERM = false, AFTER_DRAIN = true;
  const bf16_t* skf; unsigned* tops;
  DI void operator()(const f32x4 (&)[2][2][4][2], const pg8::Unit&, int, int, int, int) const {}
  DI void fused(const f32x4 (&acc)[2][2][4][2], const pg8::Unit& u, int wr, int wc, int fr, int fq, PG8_LAS unsigned char* ldsp, int, int) const {
    const int lane = fr | (fq << 4), wid = wr * 4 + wc;
    bf16_t* Qs = (bf16_t*)ldsp;
#pragma unroll
    for (int ai = 0; ai < 2; ++ai)
#pragma unroll
      for (int m = 0; m < 4; ++m) {
        const int row = ai * 128 + wr * 64 + m * 16 + fr;
#pragma unroll
        for (int bj = 0; bj < 2; ++bj)
#pragma unroll
          for (int n = 0; n < 2; ++n) {
            const f32x4 v = acc[ai][bj][m][n];
            u32x2 w = {pack2(v[0], v[1]), pack2(v[2], v[3])};
            *(u32x2*)(Qs + row * 264 + bj * 128 + wc * 32 + n * 16 + 4 * fq) = w;
          }
      }
    __syncthreads();
    const int c = lane & 31, h = lane >> 5;
    unsigned kA[16], kB[16];
#pragma unroll 1
    for (int half = 0; half < 2; ++half) {
      const int hc = u.pn * 2 + half;
      const bf16_t* sk = skf + (size_t)hc * 4 * 4096;
      const bf16_t* qp = Qs + (wid * 32 + c) * 264 + half * 128 + 8 * h;
      unsigned k0[16], k1[16];
      bf16x8 afA[8], afB[8];
#define ROUTE_LD(KT, AF) { _Pragma("unroll") for (int s = 0; s < 8; ++s) AF[s] = *(const bf16x8*)(sk + (KT) * 4096 + s * 512 + lane * 8); }
#define ROUTE_MM(KT, AF, KA)                                                                    \
      {                                                                                         \
        f32x16 sc;                                                                              \
        _Pragma("unroll") for (int i = 0; i < 16; ++i) sc[i] = 0.f;                             \
        _Pragma("unroll") for (int s = 0; s < 8; ++s) {                                         \
          bf16x8 bq = *(const bf16x8*)(qp + 16 * s);                                            \
          sc = __builtin_amdgcn_mfma_f32_32x32x16_bf16(AF[s], bq, sc, 0, 0, 0);                 \
        }                                                                                       \
        _Pragma("unroll") for (int rg = 0; rg < 16; ++rg) {                                     \
          const int kidx = 32 * (KT) + (rg & 3) + 8 * (rg >> 2) + 4 * h;                        \
          KA[rg] = (f2sort(sc[rg]) & 0xFFFFFF80u) | (unsigned)(127 - kidx);                     \
        }                                                                                       \
      }
      ROUTE_LD(0, afA)
      ROUTE_LD(1, afB)
      __builtin_amdgcn_sched_barrier(0);
      ROUTE_MM(0, afA, k0)
      __builtin_amdgcn_sched_barrier(0);
      ROUTE_LD(2, afA)
      __builtin_amdgcn_sched_barrier(0);
      bitonic_sort_desc<16>(k0);
      ROUTE_MM(1, afB, k1)
      __builtin_amdgcn_sched_barrier(0);
      ROUTE_LD(3, afB)
      __builtin_amdgcn_sched_barrier(0);
      bitonic_sort_desc<16>(k1);
      merge_top16(k0, k1);
      ROUTE_MM(2, afA, k1)
      bitonic_sort_desc<16>(k1);
      merge_top16(k0, k1);
      ROUTE_MM(3, afB, k1)
      bitonic_sort_desc<16>(k1);
      merge_top16(k0, k1);
      __builtin_amdgcn_sched_barrier(0);
#undef ROUTE_LD
#undef ROUTE_MM

#pragma unroll
      for (int i = 0; i < 16; ++i) k1[i] = (unsigned)shx_i((int)k0[i], 32);
      merge_top16(k0, k1);
      if (half == 0) {
#pragma unroll
        for (int i = 0; i < 16; ++i) kA[i] = k0[i];
      } else {
#pragma unroll
        for (int i = 0; i < 16; ++i) kB[i] = k0[i];
      }
    }
    {
      unsigned* lk = (unsigned*)(ldsp + wid * 16896);
#pragma unroll
      for (int i = 0; i < 16; ++i) { lk[i * 64 + lane] = kA[i]; lk[(16 + i) * 64 + lane] = kB[i]; }
      float fa[16], fb[16];
#pragma unroll
      for (int i = 0; i < 16; ++i) { fa[i] = sort2f(kA[i]); fb[i] = sort2f(kB[i]); }
#define CAND(ci_, cj_) ((f2sort(fa[ci_] + fb[cj_]) & 0xFFFFFF00u) | (unsigned)(255 - ((ci_) * 16 + (cj_))))
      unsigned R0[16], R1[16], S1[16], S2[16];
#pragma unroll
      for (int j = 0; j < 16; ++j) { R0[j] = CAND(0, j); R1[j] = (j < 8) ? CAND(1, j & 7) : 0u; }
      S1[0] = CAND(2, 0); S1[1] = CAND(2, 1); S1[2] = CAND(2, 2); S1[3] = CAND(2, 3); S1[4] = CAND(2, 4);
      S1[5] = CAND(3, 0); S1[6] = CAND(3, 1); S1[7] = CAND(3, 2); S1[8] = CAND(3, 3);
      S1[9] = CAND(4, 0); S1[10] = CAND(4, 1); S1[11] = CAND(4, 2);
      S1[12] = CAND(5, 0); S1[13] = CAND(5, 1); S1[14] = CAND(6, 0); S1[15] = CAND(6, 1);
      S2[0] = CAND(7, 0); S2[1] = CAND(7, 1);
#pragma unroll
      for (int i = 8; i < 16; ++i) S2[i - 6] = CAND(i, 0);
#pragma unroll
      for (int i = 10; i < 16; ++i) S2[i] = 0u;
#undef CAND
      merge_top16(R0, R1);
      bitonic_sort_desc<16>(S1); bitonic_sort_desc<16>(S2);
      merge_top16(S1, S2);
      merge_top16(R0, S1);
      float sc[16]; unsigned ex[16]; float mx = -3.0e38f;
#pragma unroll
      for (int i = 0; i < 16; ++i) {
        const int flat = 255 - (int)(R0[i] & 255u);
        const unsigned ka = lk[(flat >> 4) * 64 + lane], kb = lk[(16 + (flat & 15)) * 64 + lane];
        sc[i] = sort2f(ka) + sort2f(kb);
        ex[i] = (127u - (ka & 127u)) * 128u + (127u - (kb & 127u));
        mx = fmaxf(mx, sc[i]);
      }
      float sm = 0.f;
#pragma unroll
      for (int i = 0; i < 16; ++i) { sc[i] = __expf(sc[i] - mx); sm += sc[i]; }
      const float rsm = 1.f / sm;
      unsigned* dst = tops + (size_t)(u.pm * 256 + wid * 32 + c) * 256 + h * 128 + u.pn * 16;
#pragma unroll
      for (int q4 = 0; q4 < 4; ++q4) {
        u32x4 o;
#pragma unroll
        for (int i = 0; i < 4; ++i) o[i] = h ? __float_as_uint(sc[4 * q4 + i] * rsm) : ex[4 * q4 + i];
        *(u32x4*)(dst + 4 * q4) = o;
      }
    }
    __syncthreads();
  }
};


template <int CTRL> DI float dpp_f(float v) { const int iv = __float_as_int(v); return __int_as_float(__builtin_amdgcn_update_dpp(iv, iv, CTRL, 0xF, 0xF, false)); }
DI float wsum(float x) {
  x += dpp_f<0xB1>(x);
  x += dpp_f<0x4E>(x);
  x += dpp_f<0x124>(x);
  x += dpp_f<0x128>(x);
  x += shx(x, 16);
  return hsum(x);
}
DI float gelu_fast(float x) {
  const float u2 = 1.5957691216057308f * (x + 0.044715f * x * x * x);
  return x * __builtin_amdgcn_rcpf(1.f + ex2(-LOG2E * u2));
}

constexpr int EROW = 1024;
typedef float v2f __attribute__((ext_vector_type(2)));
DI void d_cvt_fp4_fin(int row, const f32x4 (&x)[8], unsigned char* __restrict__ dst, float* __restrict__ scales) {
  const int lane = TIDX & 63;
  float v[32]; float amax = 0.f;
#pragma unroll
  for (int i = 0; i < 8; ++i)
#pragma unroll
    for (int j = 0; j < 4; ++j) { v[i * 4 + j] = x[i][j]; amax = fmaxf(amax, fabsf(x[i][j])); }
  amax = wave_max(amax);
  const float sc = amax > 0.f ? amax * (1.f / 7.f) : 1.f;
  const float inv = 1.f / sc;
  u32x4 o;
#pragma unroll
  for (int k = 0; k < 4; ++k) {
    unsigned w = 0u;
#define FP4C(x_) fminf(fmaxf((x_) * inv, -6.f), 6.f)
    w = __builtin_amdgcn_cvt_scalef32_pk_fp4_f32(w, FP4C(v[8 * k + 0]), FP4C(v[8 * k + 1]), 1.0f, 0);
    w = __builtin_amdgcn_cvt_scalef32_pk_fp4_f32(w, FP4C(v[8 * k + 2]), FP4C(v[8 * k + 3]), 1.0f, 1);
    w = __builtin_amdgcn_cvt_scalef32_pk_fp4_f32(w, FP4C(v[8 * k + 4]), FP4C(v[8 * k + 5]), 1.0f, 2);
    w = __builtin_amdgcn_cvt_scalef32_pk_fp4_f32(w, FP4C(v[8 * k + 6]), FP4C(v[8 * k + 7]), 1.0f, 3);
#undef FP4C
    o[k] = w;
  }
  *(u32x4*)(dst + (size_t)row * EROW + 16 * lane) = o;
  if (lane == 0) scales[row] = sc;
}
__device__ void d_cvt_fp4_row(int row, const float* __restrict__ src, unsigned char* __restrict__ dst, float* __restrict__ scales) {
  const int lane = TIDX & 63;
  f32x4 x[8];
#pragma unroll
  for (int i = 0; i < 8; ++i) x[i] = *(const f32x4*)(src + (size_t)row * DM + 256 * i + 4 * lane);
  d_cvt_fp4_fin(row, x, dst, scales);
}
DI void d_cvt_i4_fin(int row, const f32x4 (&x)[8], unsigned char* __restrict__ dst, float* __restrict__ scales) {
  const int lane = TIDX & 63;
  float v[32]; float amax = 0.f, ss = 0.f;
#pragma unroll
  for (int i = 0; i < 8; ++i)
#pragma unroll
    for (int j = 0; j < 4; ++j) { v[i * 4 + j] = x[i][j]; amax = fmaxf(amax, fabsf(x[i][j])); ss = fmaf(x[i][j], x[i][j], ss); }
  amax = wave_max(amax); ss = wave_sum(ss);
  float sc = fmaxf(0.36f * sqrtf(ss * (1.f / DM)), amax * (1.f / 14.f));
  sc = sc > 0.f ? sc : 1.f;
  const float inv = 1.f / sc;
  u32x4 o;
#pragma unroll
  for (int k = 0; k < 4; ++k) {
    unsigned w = 0u;
#pragma unroll
    for (int j = 0; j < 8; ++j) {
      const float q = fminf(fmaxf(v[8 * k + j] * inv, -7.f), 7.f) + 12582912.f;
      w |= (__float_as_uint(q) & 15u) << (4 * j);
    }
    o[k] = w;
  }
  *(u32x4*)(dst + (size_t)row * EROW + 16 * lane) = o;
  if (lane == 0) scales[row] = sc;
}
__device__ void d_cvt_i4_row(int row, const float* __restrict__ src, unsigned char* __restrict__ dst, float* __restrict__ scales) {
  const int lane = TIDX & 63;
  f32x4 x[8];
#pragma unroll
  for (int i = 0; i < 8; ++i) x[i] = *(const f32x4*)(src + (size_t)row * DM + 256 * i + 4 * lane);
  d_cvt_i4_fin(row, x, dst, scales);
}
__device__ void d_expert_group(int tg0, int tstr, unsigned* tpl, unsigned* slw, const bf16_t* __restrict__ hbuf, const unsigned* __restrict__ tops,
                               const unsigned char* __restrict__ eu4, const unsigned char* __restrict__ ev4, const float* __restrict__ esu, const float* __restrict__ esv,
                               const float* __restrict__ gam, const float* __restrict__ bet, float* __restrict__ out) {
  const int lane = TIDX & 63;
#define SLOT(j_, f_) slw[((j_) * 16 + (f_)) * 64 + lane]
#pragma unroll 1
  for (int j = 0; j < 4; ++j) {
    const int tt = tg0 + j * tstr, t = tt < S ? tt : S - 1;
  float hv[32];
#pragma unroll
  for (int i = 0; i < 8; ++i) {
    const u32x2 w = *(const u32x2*)(hbuf + (size_t)t * DM + 256 * i + 4 * lane);
    hv[i * 4 + 0] = __uint_as_float(w[0] << 16); hv[i * 4 + 1] = __uint_as_float(w[0] & 0xFFFF0000u);
    hv[i * 4 + 2] = __uint_as_float(w[1] << 16); hv[i * 4 + 3] = __uint_as_float(w[1] & 0xFFFF0000u);
  }
  int e0 = (int)tops[(size_t)t * 256 + lane], e1 = (int)tops[(size_t)t * 256 + 64 + lane];
  float w0 = __uint_as_float(tops[(size_t)t * 256 + 128 + lane]), w1 = __uint_as_float(tops[(size_t)t * 256 + 192 + lane]);
  {
    unsigned k0 = ((unsigned)e0 << 7) | (unsigned)lane, k1 = ((unsigned)e1 << 7) | (unsigned)(64 + lane);
#pragma unroll
    for (int k = 2; k <= 128; k <<= 1) {
#pragma unroll
      for (int jj = k >> 1; jj > 0; jj >>= 1) {
        if (jj == 64) { const unsigned mn = k0 < k1 ? k0 : k1, mx = k0 < k1 ? k1 : k0; k0 = mn; k1 = mx; }
        else {
          const unsigned o0 = (unsigned)shx_i((int)k0, jj), o1 = (unsigned)shx_i((int)k1, jj);
          const bool lower = (lane & jj) == 0;
          const bool asc0 = (k >= 64) ? true : ((lane & k) == 0), asc1 = (k == 128) ? true : (k == 64) ? false : ((lane & k) == 0);
          const unsigned mn0 = k0 < o0 ? k0 : o0, mx0 = k0 < o0 ? o0 : k0, mn1 = k1 < o1 ? k1 : o1, mx1 = k1 < o1 ? o1 : k1;
          k0 = (lower == asc0) ? mn0 : mx0; k1 = (lower == asc1) ? mn1 : mx1;
        }
      }
    }
    const int o0 = (int)(k0 & 127u), o1 = (int)(k1 & 127u);
    const float wa0 = __shfl(w0, o0 & 63), wb0 = __shfl(w1, o0 & 63), wa1 = __shfl(w0, o1 & 63), wb1 = __shfl(w1, o1 & 63);
    e0 = (int)(k0 >> 7); e1 = (int)(k1 >> 7); w0 = (o0 < 64) ? wa0 : wb0; w1 = (o1 < 64) ? wa1 : wb1;
  }
  int hhi[4], hlo[4]; float hsc;
  {
    float m = 0.f;
#pragma unroll
    for (int i = 0; i < 32; ++i) m = fmaxf(m, fabsf(hv[i]));
    m = wave_max(m);
    hsc = m > 0.f ? m * (1.f / 119.f) : 1.f;
    const float hinv = 1.f / hsc;
#pragma unroll
    for (int q = 0; q < 4; ++q) {
      unsigned wh = 0u, wl = 0u;
#pragma unroll
      for (int j = 0; j < 8; ++j) {
        const unsigned b = __float_as_uint(fmaf(hv[8 * q + j], hinv, 12582912.f));
        wl |= (b & 15u) << (4 * j); wh |= (((b + 8u) >> 4) & 15u) << (4 * j);
      }
      hhi[q] = (int)wh; hlo[q] = (int)wl;
    }
  }
    const float su0 = esu[e0], su1 = esu[e1], sv0 = esv[e0], sv1 = esv[e1];
#pragma unroll
    for (int q = 0; q < 4; ++q) { SLOT(j, q) = (unsigned)hhi[q]; SLOT(j, 4 + q) = (unsigned)hlo[q]; }
    SLOT(j, 8) = (unsigned)e0; SLOT(j, 9) = (unsigned)e1;
    SLOT(j, 10) = __float_as_uint(hsc * su0); SLOT(j, 11) = __float_as_uint(hsc * su1);
    SLOT(j, 12) = __float_as_uint(w0 * sv0); SLOT(j, 13) = __float_as_uint(w1 * sv1);
  }
  u32x4 rA[4], rB[4];
  const unsigned lo16 = (unsigned)(16 * lane);
#define G_LOAD(R, TAB, EX, LB)                                                             \
  _Pragma("unroll") for (int k = 0; k < 4; ++k) {                                          \
    const int id = __builtin_amdgcn_readlane((EX), (LB) + k);                              \
    R[k] = *(const u32x4*)((TAB) + (size_t)id * EROW + lo16);                              \
  }
#define PKFMA(a_, b_, c_) __builtin_elementwise_fma((a_), (b_), (c_))
  const int srcb = 4 * (((lane & 1) << 5) | ((lane & 2) << 3));
#define G_COMP_U(R, LB)                                                                    \
  {                                                                                        \
    int dd[4];                                                                             \
    _Pragma("unroll") for (int k = 0; k < 4; ++k) {                                        \
      int dh = 0, dl = 0;                                                                  \
      _Pragma("unroll") for (int q = 0; q < 4; ++q) {                                      \
        dh = __builtin_amdgcn_sdot8((int)R[k][q], hhi[q], dh, false);                      \
        dl = __builtin_amdgcn_sdot8((int)R[k][q], hlo[q], dl, false);                      \
      }                                                                                    \
      dd[k] = dh * 16 + dl;                                                                \
      __builtin_amdgcn_sched_barrier(0);                                                   \
    }                                                                                      \
    unsigned t01, t23;                                                                     \
    { auto r_ = __builtin_amdgcn_permlane32_swap((unsigned)dd[0], (unsigned)dd[1], false, false); t01 = r_[0] + r_[1]; }     \
    { auto r_ = __builtin_amdgcn_permlane32_swap((unsigned)dd[2], (unsigned)dd[3], false, false); t23 = r_[0] + r_[1]; }     \
    const bool b4_ = (lane & 16) != 0;                                                     \
    int tv = (int)(b4_ ? t23 : t01) + shx_i((int)(b4_ ? t01 : t23), 16);                   \
    tv += dpp_i<0x128>(tv); tv += dpp_i<0x124>(tv); tv += dpp_i<0x4E>(tv); tv += dpp_i<0xB1>(tv);   \
    const int got = __builtin_amdgcn_ds_bpermute(srcb, tv);                                \
    cc = ((unsigned)(lane - (LB)) < 4u) ? got : cc;                                        \
    __builtin_amdgcn_sched_barrier(0);                                                     \
  }
#define G_COMP_V(R, ACC, CF, LB)                                                           \
  _Pragma("unroll") for (int k = 0; k < 4; ++k) {                                          \
    const float cs = __int_as_float(__builtin_amdgcn_readlane(__float_as_int(CF), (LB) + k));   \
    const v2f cs2 = {cs, cs};                                                              \
    _Pragma("unroll") for (int q = 0; q < 4; ++q) {                                        \
      const unsigned wq = R[k][q];                                                         \
      const v2f f0 = __builtin_amdgcn_cvt_scalef32_pk_f32_fp4(wq, 1.0f, 0), f1 = __builtin_amdgcn_cvt_scalef32_pk_f32_fp4(wq, 1.0f, 1); \
      const v2f f2 = __builtin_amdgcn_cvt_scalef32_pk_f32_fp4(wq, 1.0f, 2), f3 = __builtin_amdgcn_cvt_scalef32_pk_f32_fp4(wq, 1.0f, 3); \
      ACC[4 * q + 0] = PKFMA(cs2, f0, ACC[4 * q + 0]); ACC[4 * q + 1] = PKFMA(cs2, f1, ACC[4 * q + 1]); \
      ACC[4 * q + 2] = PKFMA(cs2, f2, ACC[4 * q + 2]); ACC[4 * q + 3] = PKFMA(cs2, f3, ACC[4 * q + 3]); \
    }                                                                                      \
    __builtin_amdgcn_sched_barrier(0);                                                     \
  }
  {
    int eX = (int)SLOT(0, 8);
    G_LOAD(rA, eu4, eX, 0)
    __builtin_amdgcn_sched_barrier(0);
#pragma unroll 1
    for (int s_ = 0; s_ < 32; ++s_) {
      const int sg = s_ >> 2, j = s_ & 3, L0 = (sg & 3) * 16;
      const int sn = (s_ + 1) & 31, sgn = sn >> 2, jn = sn & 3, L0n = (sgn & 3) * 16;
      if (j == 0) __builtin_amdgcn_s_barrier();
      int hhi[4], hlo[4];
#pragma unroll
      for (int q = 0; q < 4; ++q) { hhi[q] = (int)SLOT(j, q); hlo[q] = (int)SLOT(j, 4 + q); }
      const int eXn = (int)SLOT(jn, 8 + (sgn >> 2));
      const unsigned char* tabn = (s_ == 31) ? ev4 : eu4;
      int cc = 0;
      G_LOAD(rB, eu4, eX, L0 + 4)
      __builtin_amdgcn_sched_barrier(0);
      G_COMP_U(rA, L0)
      G_LOAD(rA, eu4, eX, L0 + 8)
      __builtin_amdgcn_sched_barrier(0);
      G_COMP_U(rB, L0 + 4)
      G_LOAD(rB, eu4, eX, L0 + 12)
      __builtin_amdgcn_sched_barrier(0);
      G_COMP_U(rA, L0 + 8)
      G_LOAD(rA, tabn, eXn, L0n)
      __builtin_amdgcn_sched_barrier(0);
      G_COMP_U(rB, L0 + 12)
      if ((unsigned)(lane - L0) < 16u) SLOT(j, 14 + (sg >> 2)) = (unsigned)cc;
      eX = eXn;
    }
  }
#pragma unroll 1
  for (int j = 0; j < 4; ++j) {
    const float d0 = (float)(int)SLOT(j, 14), d1 = (float)(int)SLOT(j, 15);
    SLOT(j, 14) = __float_as_uint(__uint_as_float(SLOT(j, 12)) * gelu_fast(__uint_as_float(SLOT(j, 10)) * d0));
    SLOT(j, 15) = __float_as_uint(__uint_as_float(SLOT(j, 13)) * gelu_fast(__uint_as_float(SLOT(j, 11)) * d1));
  }
  v2f accv[4][16];
#pragma unroll
  for (int j = 0; j < 4; ++j)
#pragma unroll
    for (int i = 0; i < 16; ++i) accv[j][i] = v2f{0.f, 0.f};
  {
    int eX = (int)SLOT(0, 8);
#pragma unroll 1
    for (int sg = 0; sg < 8; ++sg) {
      const int L0 = (sg & 3) * 16;
      __builtin_amdgcn_s_barrier();
#pragma unroll
      for (int j = 0; j < 4; ++j) {
        const int jn = (j + 1) & 3, sgn = (j == 3) ? ((sg + 1) & 7) : sg, L0n = (sgn & 3) * 16;
        const float cf = __uint_as_float(SLOT(j, 14 + (sg >> 2)));
        const int eXn = (int)SLOT(jn, 8 + (sgn >> 2));
        G_LOAD(rB, ev4, eX, L0 + 4)
        __builtin_amdgcn_sched_barrier(0);
        G_COMP_V(rA, accv[j], cf, L0)
        G_LOAD(rA, ev4, eX, L0 + 8)
        __builtin_amdgcn_sched_barrier(0);
        G_COMP_V(rB, accv[j], cf, L0 + 4)
        G_LOAD(rB, ev4, eX, L0 + 12)
        __builtin_amdgcn_sched_barrier(0);
        G_COMP_V(rA, accv[j], cf, L0 + 8)
        G_LOAD(rA, ev4, eXn, L0n)
        __builtin_amdgcn_sched_barrier(0);
        G_COMP_V(rB, accv[j], cf, L0 + 12)
        eX = eXn;
      }
    }
  }
#undef G_LOAD
#undef G_COMP_U
#undef G_COMP_V
#undef PKFMA
#pragma unroll
  for (int j = 0; j < 4; ++j) {
    const int t = tg0 + j * tstr;
    if (t < S) {
#define acc2 accv[j]
  float acc[32];
  #pragma unroll
    for (int i = 0; i < 16; ++i) { acc[2 * i] = acc2[i].x; acc[2 * i + 1] = acc2[i].y; }
    int le = lane;
    asm volatile("" : "+v"(le) :: "memory");
    float s = 0.f;
  #pragma unroll
    for (int i = 0; i < 8; ++i) {
      const u32x2 w = *(const u32x2*)(hbuf + (size_t)t * DM + 256 * i + 4 * le);
      const float h0 = __uint_as_float(w[0] << 16), h1 = __uint_as_float(w[0] & 0xFFFF0000u), h2 = __uint_as_float(w[1] << 16), h3 = __uint_as_float(w[1] & 0xFFFF0000u);
      acc[i * 4 + 0] = fmaf(ALPHA, h0, acc[i * 4 + 0]); acc[i * 4 + 1] = fmaf(ALPHA, h1, acc[i * 4 + 1]);
      acc[i * 4 + 2] = fmaf(ALPHA, h2, acc[i * 4 + 2]); acc[i * 4 + 3] = fmaf(ALPHA, h3, acc[i * 4 + 3]);
      s += (acc[i * 4 + 0] + acc[i * 4 + 1]) + (acc[i * 4 + 2] + acc[i * 4 + 3]);
    }
    s = wsum(s);
    const float mu = s * (1.f / DM);
    float qv = 0.f;
  #pragma unroll
    for (int i = 0; i < 32; ++i) { const float d = acc[i] - mu; qv += d * d; }
    qv = wsum(qv);
    const float rs = rsqrtf(qv * (1.f / DM) + 1e-5f);
  #pragma unroll
    for (int i = 0; i < 8; ++i) {
      const int cbase = 256 * i + 4 * le;
      f32x4 ga = *(const f32x4*)(gam + cbase), ba = *(const f32x4*)(bet + cbase), o;
  #pragma unroll
      for (int j = 0; j < 4; ++j) o[j] = (acc[i * 4 + j] - mu) * rs * ga[j] + ba[j];
      *(f32x4*)(out + (size_t)t * DM + cbase) = o;
    }
#undef acc2
    }
  }
#undef SLOT
}

constexpr size_t al256(size_t x) { return (x + 255) & ~(size_t)255; }
constexpr size_t WS_XB = 0;
constexpr size_t WS_PROJ = WS_XB + al256((size_t)S * DM * 2);
constexpr size_t WS_WINT = WS_PROJ + al256((size_t)S * INWP * 2);
constexpr size_t WS_GATES = WS_WINT + al256((size_t)INWG * DM * 2);
constexpr size_t WS_W1KF = WS_GATES + al256((size_t)S * 24 * 4);
constexpr size_t WS_W1VF = WS_W1KF + al256((size_t)512 * 4096 * 2);
constexpr size_t WS_W2KF = WS_W1VF + al256((size_t)512 * 4096 * 2);
constexpr size_t WS_W2VF = WS_W2KF + al256((size_t)512 * 128 * 2);
constexpr size_t WS_VC = WS_W2VF + al256((size_t)512 * 128 * 2) - al256((size_t)2048 * 128 * 4);
constexpr size_t WS_KCF = WS_VC + al256((size_t)2048 * 128 * 4);
constexpr size_t WS_VCF = WS_KCF + al256((size_t)2 * 32 * 4096 * 2);
constexpr size_t WS_KSF = WS_VCF + al256((size_t)2 * 32 * 4096 * 2);
constexpr size_t WS_VSF = WS_KSF + al256((size_t)2 * 512 * 4096 * 2);
constexpr size_t WS_KWF = WS_VSF + al256((size_t)2 * 512 * 4096 * 2);
constexpr size_t WS_VWF = WS_KWF + al256((size_t)2 * 512 * 4096 * 2);
constexpr size_t WS_ENDA = WS_VWF + al256((size_t)2 * 512 * 4096 * 2);
constexpr size_t WS_OATT = WS_ENDA;
constexpr size_t WS_MIX = WS_OATT + al256((size_t)S * 1024 * 4);
constexpr size_t WS_WOUTT = WS_MIX + al256((size_t)S * DM * 2);
constexpr size_t WS_WQT = WS_WOUTT + al256((size_t)DM * DM * 2);
constexpr size_t WS_TOPS = WS_WQT + al256((size_t)DM * DM * 2);
constexpr size_t WS_SKF = WS_TOPS + al256((size_t)S * 256 * 4);
constexpr size_t WS_STATS = WS_SKF + al256((size_t)16 * 128 * 128 * 2);
constexpr size_t WS_CTRL = WS_STATS + al256((size_t)S * 2 * 4);
constexpr size_t CTRL_BYTES = 32768;
constexpr size_t WS_END = WS_CTRL + CTRL_BYTES;
constexpr size_t WS_Y = WS_PROJ;
constexpr size_t WS_HB = WS_XB;
constexpr size_t WS_EU8 = WS_OATT;
constexpr size_t WS_EV8 = WS_EU8 + (size_t)16384 * 1024;
constexpr size_t WS_ESU = WS_EV8 + (size_t)16384 * 1024;
constexpr size_t WS_ESV = WS_ESU + 16384 * 4;
static_assert(WS_ESV + 16384 * 4 <= WS_MIX, "expert tables overflow their region");
constexpr int EXP_EARLY = 6144;
static_assert(WS_END <= (size_t)512 * 1024 * 1024, "workspace over 512 MiB");

struct Params {
  const float *x, *w_in, *ck_pos, *ck_w1, *ck_b1, *ck_w2, *cv_pos, *cv_w1, *cv_b1, *cv_w2, *conv_w, *hng, *w_out, *ln1g, *ln1b, *w_query, *subk,
      *eu, *ev, *ln2g, *ln2b;
  float* out;
  char* ws;
};
#define WSP(T, OFF) ((T*)(p.ws + (OFF)))

#define FOR_VB(n) for (int vb = blockIdx.x; vb < (n); vb += gridDim.x)
#define FOR_VB2(n) for (int vb = blockIdx.x * 2 + (TIDX >> 8); vb < (n); vb += gridDim.x * 2)
constexpr int SMEM_BYTES = 147456;
constexpr int HALF = 36864;

__global__ void __launch_bounds__(512) mega(Params p) {
  __shared__ __attribute__((aligned(16))) char smem[SMEM_BYTES + 16];
  if (TIDX == 0) *(u32x4*)(smem + SMEM_BYTES) = u32x4{0u, 0u, 0u, 0u};
  __syncthreads();
  const XcdBarrier xbar = xcd_barrier_post(WSP(unsigned, WS_CTRL + 1024), (volatile LAS unsigned*)(smem + SMEM_BYTES));
#define smh (smem + (TIDX >> 8) * HALF)
#define wv ((TIDX >> 6))
  constexpr int NWV = 8;
  d_cvt(p.x, WSP(bf16_t, WS_XB), (size_t)S * DM / 4);
  FOR_VB2((INWG / 64) * (DM / 64)) d_cvtT64(vb, smh, p.w_in, WSP(bf16_t, WS_WINT), DM, INW, INWG);
  for (size_t c = (size_t)blockIdx.x * 512 + TIDX; c < (size_t)16 * 256 * 64; c += (size_t)gridDim.x * 512) {
    d_cvt_w1f(c, p.ck_w1, WSP(bf16_t, WS_W1KF)); d_cvt_w1f(c, p.cv_w1, WSP(bf16_t, WS_W1VF));
    if (c < (size_t)4 * 32 * 64) { d_cvt_w2f(c, p.ck_w2, WSP(bf16_t, WS_W2KF)); d_cvt_w2f(c, p.cv_w2, WSP(bf16_t, WS_W2VF)); }
  }
  FOR_VB2((DM / 64) * (DM / 64)) d_cvtT64(vb, smh, p.w_out, WSP(bf16_t, WS_WOUTT), DM, DM, DM);
  FOR_VB2((DM / 64) * (DM / 64)) d_cvtT64(vb, smh, p.w_query, WSP(bf16_t, WS_WQT), DM, DM, DM);
  for (size_t c = (size_t)blockIdx.x * 512 + TIDX; c < (size_t)16 * 4 * 8 * 64; c += (size_t)gridDim.x * 512) d_cvt_subk(c, p.subk, WSP(bf16_t, WS_SKF));
  xcd_barrier(xbar);
  {
    pg8::StaticOrder so; so.init(S, INWG, gridDim.x, blockIdx.x);
    pg8::gemm_phase<EpiProjG, pg8::StaticOrder>((PG8_LAS unsigned char*)smem, pg8::Gemm{WSP(bf16_t, WS_XB), WSP(bf16_t, WS_WINT), S, INWG, DM}, so,
                                                EpiProjG{WSP(bf16_t, WS_PROJ), WSP(float, WS_GATES), (PG8_LAS unsigned char*)smem + pg8::STAGE_BYTES}, nullptr);
    const int nun = (S / 256) * (INWG / 256), gsz = (int)gridDim.x;
    const int nfull = nun % gsz;
    if (nfull != 0 && (int)blockIdx.x >= nfull) {
      const int nidle = gsz - nfull, me = (int)blockIdx.x - nfull;
      for (int r = me * NWV + wv; r < 2 * EXP_EARLY; r += nidle * NWV) {
        if (r < EXP_EARLY) d_cvt_i4_row(r, p.eu, WSP(unsigned char, WS_EU8), WSP(float, WS_ESU)); else d_cvt_fp4_row(r - EXP_EARLY, p.ev, WSP(unsigned char, WS_EV8), WSP(float, WS_ESV));
      }
    }
  }
  xcd_barrier(xbar);
  {
    if (blockIdx.x < 128) {
      const int xcd_ = blockIdx.x & 7, idx_ = blockIdx.x >> 3; const bool isV = (xcd_ & 1) != 0;
      d_compress_unit((xcd_ >> 1) * 16 + idx_, smem, WSP(bf16_t, WS_PROJ), isV ? OFF_VC : OFF_KC, isV ? p.cv_pos : p.ck_pos, isV ? WSP(bf16_t, WS_W1VF) : WSP(bf16_t, WS_W1KF),
                      isV ? p.cv_b1 : p.ck_b1, isV ? WSP(bf16_t, WS_W2VF) : WSP(bf16_t, WS_W2KF), isV ? WSP(bf16_t, WS_VCF) : WSP(bf16_t, WS_KCF), isV);
    }
    int* slot = (int*)smem;
    unsigned* ctr = WSP(unsigned, WS_CTRL);
    if (TIDX == 0) slot[0] = (int)atomicAdd(ctr, 1u);
    __syncthreads();
    int it = slot[0];
    bf16_t* Ls = (bf16_t*)(smem + 64);
#pragma unroll 1
    for (int n = 0; it < 2048; ++n) {
      int nxt = 0;
      if (TIDX == 0) nxt = (int)atomicAdd(ctr, 1u);
      const int tt = TIDX;
      const int T = it >> 2, which = it & 3;
      const int col0 = (which == 0) ? OFF_KS : (which == 1) ? OFF_VS : (which == 2) ? OFF_KW : OFF_VW;
      bf16_t* dst = (which == 0) ? WSP(bf16_t, WS_KSF) : (which == 1) ? WSP(bf16_t, WS_VSF) : (which == 2) ? WSP(bf16_t, WS_KWF) : WSP(bf16_t, WS_VWF);
      const bool isV = (which & 1) != 0;
      u32x4 rv[2];
#pragma unroll
      for (int q = 0; q < 2; ++q) {
        const int cidx = tt + q * 512;
        const int g = cidx >> 9, tok = (cidx >> 4) & 31, ch = cidx & 15;
        rv[q] = *(const u32x4*)(WSP(bf16_t, WS_PROJ) + (size_t)(32 * T + tok) * INWP + col0 + g * 128 + ch * 8);
      }
      d_convmix2(it * 8 + (tt >> 7), tt & 127, WSP(bf16_t, WS_PROJ), p.conv_w, p.hng, WSP(bf16_t, WS_MIX));
#pragma unroll
      for (int q = 0; q < 2; ++q) {
        const int cidx = tt + q * 512;
        const int g = cidx >> 9, tok = (cidx >> 4) & 31, ch = cidx & 15;
        *(u32x4*)(Ls + (g * 32 + tok) * 136 + ch * 8) = rv[q];
      }
      if (TIDX == 0) slot[(n + 1) & 1] = nxt;
      __syncthreads();
#pragma unroll
      for (int q = 0; q < 2; ++q) {
        const int oc = tt + q * 512;
        const int g = oc >> 9, r9 = oc & 511, lane = r9 & 63;
        u32x4 o;
        if (!isV) {
          const int s8 = r9 >> 6, i = lane & 31, h = lane >> 5;
          o = *(const u32x4*)(Ls + (g * 32 + pi_perm(i)) * 136 + 16 * s8 + 8 * h);
        } else {
          const int s2 = (r9 >> 6) & 1, dt = r9 >> 7, dd = lane & 31, h = lane >> 5;
          const bf16_t* col = Ls + (g * 32 + 16 * s2 + 8 * h) * 136 + 32 * dt + dd;
          unsigned short e[8];
#pragma unroll
          for (int j = 0; j < 8; ++j) e[j] = col[j * 136];
          o.x = e[0] | ((unsigned)e[1] << 16); o.y = e[2] | ((unsigned)e[3] << 16); o.z = e[4] | ((unsigned)e[5] << 16); o.w = e[6] | ((unsigned)e[7] << 16);
        }
        *(u32x4*)(dst + (((size_t)(g * 512 + T)) * 512 + r9) * 8) = o;
      }
      it = slot[(n + 1) & 1];
      __syncthreads();
    }
  }
  xcd_barrier(xbar);
  {
    AttnPtrs ap{WSP(bf16_t, WS_PROJ), WSP(float, WS_GATES), WSP(bf16_t, WS_KCF), WSP(bf16_t, WS_VCF), WSP(bf16_t, WS_KSF), WSP(bf16_t, WS_VSF), WSP(bf16_t, WS_KWF), WSP(bf16_t, WS_VWF), WSP(bf16_t, WS_MIX), p.hng};
    for (int it = blockIdx.x; it < 512; it += gridDim.x) {
      const int Bq = (it < 256) ? it : (511 - it), gq = (it < 256) ? 0 : 1;
      d_attn_block(Bq, gq, smem, ap);
    }
  }
  xcd_barrier(xbar);
  {
    pg8::StaticOrder so; so.init(S, DM, gridDim.x, blockIdx.x);
    pg8::gemm_phase<EpiResG, pg8::StaticOrder>((PG8_LAS unsigned char*)smem, pg8::Gemm{WSP(bf16_t, WS_MIX), WSP(bf16_t, WS_WOUTT), S, DM, DM}, so,
                                               EpiResG{WSP(bf16_t, WS_HB), (PG8_LAS unsigned char*)smem + pg8::STAGE_BYTES}, nullptr);
  }
  xcd_barrier(xbar);
  {
    const int e0_ = (((S / 256) * (INWG / 256)) % (int)gridDim.x != 0) ? EXP_EARLY : 0;
    const int nrest = 16384 - e0_, ncv = 2 * nrest, wstr = (int)gridDim.x * NWV, lane_ = TIDX & 63;
    int rl = blockIdx.x * NWV + wv, rc = rl;
    u32x4 lcur[4], lnxt[4]; f32x4 ccur[8], cnxt[8];
#define P8_LDLN(R, r_) { _Pragma("unroll") for (int i = 0; i < 4; ++i) R[i] = *(const u32x4*)(WSP(bf16_t, WS_HB) + (size_t)(r_) * DM + 512 * i + 8 * lane_); }
#define P8_LDCV(R, r_) { const float* src_ = ((r_) < nrest) ? p.eu + (size_t)(e0_ + (r_)) * DM : p.ev + (size_t)(e0_ + (r_) - nrest) * DM; \
                         _Pragma("unroll") for (int i = 0; i < 8; ++i) R[i] = *(const f32x4*)(src_ + 256 * i + 4 * lane_); }
    if (rl < S) P8_LDLN(lcur, rl)
    if (rc < ncv) P8_LDCV(ccur, rc)
#pragma unroll 1
    while (rl < S || rc < ncv) {
      const int rln = rl + wstr, rcn = rc + wstr;
      if (rln < S) P8_LDLN(lnxt, rln)
      if (rcn < ncv) P8_LDCV(cnxt, rcn)
      __builtin_amdgcn_sched_barrier(0);
      if (rl < S) d_ln_fin(rl, lcur, WSP(bf16_t, WS_HB), p.ln1g, p.ln1b);
      if (rc < ncv) {
        if (rc < nrest) d_cvt_i4_fin(e0_ + rc, ccur, WSP(unsigned char, WS_EU8), WSP(float, WS_ESU));
        else d_cvt_fp4_fin(e0_ + rc - nrest, ccur, WSP(unsigned char, WS_EV8), WSP(float, WS_ESV));
      }
      __builtin_amdgcn_sched_barrier(0);
#pragma unroll
      for (int i = 0; i < 4; ++i) lcur[i] = lnxt[i];
#pragma unroll
      for (int i = 0; i < 8; ++i) ccur[i] = cnxt[i];
      rl = rln; rc = rcn;
    }
#undef P8_LDLN
#undef P8_LDCV
  }
  xcd_barrier(xbar);
  for (int k = 0; k * (int)gridDim.x < (S / 256) * (DM / 256); ++k) {
    pg8::OneUnit so; so.init(S, DM, gridDim.x, blockIdx.x); so.k = k;
    pg8::gemm_phase<EpiRouteG, pg8::OneUnit>((PG8_LAS unsigned char*)smem, pg8::Gemm{WSP(bf16_t, WS_HB), WSP(bf16_t, WS_WQT), S, DM, DM}, so,
                                             EpiRouteG{WSP(bf16_t, WS_SKF), WSP(unsigned, WS_TOPS)}, nullptr);
    __syncthreads();
  }
  xcd_barrier(xbar);
  {
    const int tstr = (int)gridDim.x * NWV;
    for (int tg0 = blockIdx.x * NWV + wv; tg0 < S; tg0 += 4 * tstr)
      d_expert_group(tg0, tstr, (unsigned*)(smem + wv * 1024), (unsigned*)(smem + 8192 + wv * 16384), WSP(bf16_t, WS_HB), WSP(unsigned, WS_TOPS), WSP(unsigned char, WS_EU8), WSP(unsigned char, WS_EV8),
                     WSP(float, WS_ESU), WSP(float, WS_ESV), p.ln2g, p.ln2b, p.out);
  }
}

extern "C" void kernel_launch(void* const* d_in, const int* in_sizes, int n_in, void* d_out, int out_size, void* d_ws, size_t ws_size,
                              hipStream_t stream) {
  Params p{};
  p.x = (const float*)d_in[0]; p.w_in = (const float*)d_in[1]; p.ck_pos = (const float*)d_in[2]; p.ck_w1 = (const float*)d_in[3];
  p.ck_b1 = (const float*)d_in[4]; p.ck_w2 = (const float*)d_in[5]; p.cv_pos = (const float*)d_in[6]; p.cv_w1 = (const float*)d_in[7];
  p.cv_b1 = (const float*)d_in[8]; p.cv_w2 = (const float*)d_in[9]; p.conv_w = (const float*)d_in[10]; p.hng = (const float*)d_in[11];
  p.w_out = (const float*)d_in[12]; p.ln1g = (const float*)d_in[13]; p.ln1b = (const float*)d_in[14]; p.w_query = (const float*)d_in[15];
  p.subk = (const float*)d_in[16]; p.eu = (const float*)d_in[17]; p.ev = (const float*)d_in[18]; p.ln2g = (const float*)d_in[19];
  p.ln2b = (const float*)d_in[20];
  p.out = (float*)d_out;
  p.ws = (char*)d_ws;
  if (ws_size < WS_END) fprintf(stderr, "workspace too small\n");
  static int grid_blocks = 0;
  if (!grid_blocks) {
    int dev = 0, cus = 0, per_cu = 0;
    hipGetDevice(&dev);
    hipDeviceGetAttribute(&cus, hipDeviceAttributeMultiprocessorCount, dev);
    hipOccupancyMaxActiveBlocksPerMultiprocessor(&per_cu, mega, 512, 0);
    if (per_cu > 1) per_cu = 1;
    if (per_cu < 1) per_cu = 1;
    grid_blocks = cus * per_cu;
  }
  hipMemsetAsync((char*)d_ws + WS_CTRL, 0, CTRL_BYTES, stream);
  void* args[] = {&p};
  hipError_t e = hipLaunchCooperativeKernel((void*)mega, dim3(grid_blocks), dim3(512), args, 0, stream);
  if (e != hipSuccess) fprintf(stderr, "cooperative launch failed: %s (grid %d)\n", hipGetErrorString(e), grid_blocks);
}
```

```cpp
#include <hip/hip_runtime.h>
#include <stdint.h>
#include <stdio.h>


#define DI __device__ __forceinline__
static __device__ __forceinline__ int tidx_() { int t = (int)__builtin_amdgcn_workitem_id_x(); asm volatile("" : "+v"(t)); return t; }
#define TIDX (tidx_())

template <int J> DI int swz_xor(int x) { return __builtin_amdgcn_ds_swizzle(x, (J << 10) | 0x1F); }
template <int CTRL> DI int dpp_i(int x) { return __builtin_amdgcn_update_dpp(x, x, CTRL, 0xF, 0xF, false); }
DI int shx_i(int x, int j) {
  switch (j) {
    case 1: return dpp_i<0xB1>(x);
    case 2: return dpp_i<0x4E>(x);
    case 4: return dpp_i<0x1B>(dpp_i<0x141>(x));
    case 8: return dpp_i<0x128>(x);
    case 16: return swz_xor<16>(x);
    default: {
      auto r = __builtin_amdgcn_permlane32_swap((unsigned)x, (unsigned)x, false, false);
      return (TIDX & 32) ? (int)r[0] : (int)r[1];
    }
  }
}
DI float shx(float x, int j) { return __int_as_float(shx_i(__float_as_int(x), j)); }
typedef unsigned short bf16_t;
using bf16x8 = __attribute__((ext_vector_type(8))) short;
using f32x4 = __attribute__((ext_vector_type(4))) float;
using u32x4 = __attribute__((ext_vector_type(4))) unsigned;
using u32x2 = __attribute__((ext_vector_type(2))) unsigned;

constexpr int S = 16384, DM = 2048, HD = 128;
constexpr int INW = 5656, INWP = 5760, INWG = 5888;
constexpr int OFF_Q = 0, OFF_KC = 1024, OFF_VC = 1280, OFF_KS = 1536, OFF_VS = 1792, OFF_KW = 2048, OFF_VW = 2304,
              OFF_G = 2560, OFF_U = 2584, OFF_B = 3608, OFF_C = 4632;
constexpr int NCMP = 1023;
constexpr float ALPHA = 1.189207115002721f;
constexpr float QSCALE = 0.08838834764831845f;

DI bf16_t f2bf(float x) { unsigned u = __float_as_uint(x); u += 0x7fffu + ((u >> 16) & 1u); return (bf16_t)(u >> 16); }
DI float bf2f(bf16_t b) { return __uint_as_float(((unsigned)b) << 16); }
DI float gelu_tanh(float x) { float u = 0.7978845608028654f * (x + 0.044715f * x * x * x); return 0.5f * x * (1.f + tanhf(u)); }
DI float wave_sum(float v) { for (int o = 32; o > 0; o >>= 1) v += shx(v, o); return v; }
using bf16x2v = __attribute__((ext_vector_type(2))) __bf16;
DI unsigned pack2(float a, float b) { bf16x2v v = {(__bf16)a, (__bf16)b}; return __builtin_bit_cast(unsigned, v); }
DI float wave_max(float v) { for (int o = 32; o > 0; o >>= 1) v = fmaxf(v, shx(v, o)); return v; }

namespace pg8 {
#define PG8_LAS __attribute__((address_space(3)))
typedef unsigned short bf16_t;
typedef short bf16x8 __attribute__((ext_vector_type(8)));
typedef float f32x4 __attribute__((ext_vector_type(4)));
typedef unsigned u32x4 __attribute__((ext_vector_type(4)));
constexpr int BM = 256, BK = 64, HALF = 128, HTB = HALF * BK * 2  , STAGE_BYTES = 8 * HTB, NXCD = 8, WGM = 8;

__host__ __device__ __forceinline__ int lds_byte(int r, int c) { const int st = (r >> 4) * 2 + (c >> 5), rr = r & 15, cc = c & 31, ob = rr * 64 + cc * 2; return st * 1024 + (ob ^ (((ob >> 9) & 1) << 5)); }
__host__ __device__ __forceinline__ void stage_rc(int b, int& R, int& C) { const int st = b / 1024, sb = b % 1024, swz = sb ^ (((sb >> 9) & 1) << 5); R = (st >> 1) * 16 + swz / 64; C = (st & 1) * 32 + (swz % 64) / 2; }
__host__ __device__ __forceinline__ int perm32(int rho) { const int n = rho >> 4, i = rho & 15; return 8 * (i >> 2) + 4 * n + (i & 3); }

struct Unit { int pm, pn; };
struct Gemm { const bf16_t* A; const bf16_t* Bt; int M, N, K; };

struct StaticOrder {
    int nM, nN, nwg, G, c;
    __host__ __device__ void init(int M, int N, int G_, int c_) { nM = M / BM; nN = N / BM; nwg = nM * nN; G = G_; c = c_; }
    __host__ __device__ bool next(int i, Unit& u) const {
        const long L = (long)i * G + c; if (L >= nwg) return false;
        int wgid = (int)L; { const int q = nwg / NXCD, r = nwg % NXCD, xcd = wgid % NXCD, off = wgid / NXCD; wgid = (xcd < r ? xcd * (q + 1) : r * (q + 1) + (xcd - r) * q) + off; }
        const int nig = WGM * nN, gid = wgid / nig, fm = gid * WGM, gsz = (nM - fm) < WGM ? (nM - fm) : WGM;
        u.pm = fm + ((wgid % nig) % gsz); u.pn = (wgid % nig) / gsz; return true;
    }
    __device__ __forceinline__ void a_ready(const Unit&) const {}
    __device__ __forceinline__ void done(const Unit&) const {}
};
struct OneUnit : StaticOrder {
    int k;
    __device__ bool next(int i, Unit& u) const { if (i > 0) return false; return StaticOrder::next(k, u); }
};
__device__ __forceinline__ unsigned cvt_pk_bf16(float lo, float hi) { unsigned r; asm volatile("v_cvt_pk_bf16_f32 %0, %1, %2" : "=v"(r) : "v"(lo), "v"(hi)); return r; }
template <class Epi, class Sched, bool STAMP = false>
__device__ __forceinline__ void gemm_phase(PG8_LAS unsigned char* lds, const Gemm g, const Sched& S, const Epi& E, unsigned long long* stamps) {
    const int tid = TIDX, wid = __builtin_amdgcn_readfirstlane(tid >> 6), lane = tid & 63, wr = wid >> 2, wc = wid & 3, fr = lane & 15, fq = lane >> 4;
    const int K = g.K, nt = K / BK;
    int ts_lo = 0, ts_hi = 0, nts = 0; const unsigned long long rt_entry = STAMP ? (unsigned long long)wall_clock64() : 0ull;
#define PG8_STAMP() do { if (STAMP && wid == 0 && nts < 64) { const unsigned long long _c = (unsigned long long)clock64(); \
        ts_lo = (lane == nts) ? (int)(unsigned)_c : ts_lo; ts_hi = (lane == nts) ? (int)(unsigned)(_c >> 32) : ts_hi; ++nts; } } while (0)
    PG8_STAMP();
    unsigned voffA[2], voffB[2];
#pragma unroll
    for (int i = 0; i < 2; ++i) { int R, C; stage_rc(tid * 16 + i * 8192, R, C); const int Rb = Epi::PERM ? ((R & ~31) + perm32(R & 31)) : R;
        voffA[i] = (unsigned)(R * K + C) * 2u; voffB[i] = (unsigned)(Rb * K + C) * 2u; }
    const size_t kstep = (size_t)(BK * 2);
    const size_t hstep = (size_t)HALF * K * 2;
    const size_t tstep = 2 * hstep;
    const unsigned ldsw = (unsigned)wid * 1024u;
    const int aoff = lds_byte(wr * 64 + fr, fq * 8), boff = lds_byte(wc * 32 + fr, fq * 8);
#define PG8_SA(b, h) (((b) * 2 + (h)) * HTB)
#define PG8_SB(b, h) ((4 + (b) * 2 + (h)) * HTB)
#define PG8_STAGE(bufoff, gbase, voff) do { _Pragma("unroll") for (int _i = 0; _i < 2; ++_i) \
        __builtin_amdgcn_global_load_lds((const unsigned*)((const char*)(gbase) + (voff)[_i]), (PG8_LAS unsigned*)(lds + (bufoff) + ldsw + _i * 8192), 16, 0, 0); } while (0)
#define PG8_LDA(dst, b, h) do { _Pragma("unroll") for (int m = 0; m < 4; ++m) _Pragma("unroll") for (int k = 0; k < 2; ++k) dst[m][k] = *(const PG8_LAS bf16x8*)(lds + PG8_SA(b, h) + aoff + m * 2048 + k * 1024); } while (0)
#define PG8_LDB(dst, b, h) do { _Pragma("unroll") for (int n = 0; n < 2; ++n) _Pragma("unroll") for (int k = 0; k < 2; ++k) dst[n][k] = *(const PG8_LAS bf16x8*)(lds + PG8_SB(b, h) + boff + n * 2048 + k * 1024); } while (0)
#define PG8_MMA(ai, bj, At, Bt) do { __builtin_amdgcn_s_setprio(1); _Pragma("unroll") for (int m = 0; m < 4; ++m) _Pragma("unroll") for (int n = 0; n < 2; ++n) _Pragma("unroll") for (int k = 0; k < 2; ++k) \
        acc[ai][bj][m][n] = __builtin_amdgcn_mfma_f32_16x16x32_bf16(Bt[n][k], At[m][k], acc[ai][bj][m][n], 0, 0, 0); __builtin_amdgcn_s_setprio(0); } while (0)
#define PG8_WAIT_V(n) asm volatile("s_waitcnt vmcnt(" #n ")" ::: "memory")
#define PG8_WAIT_L(n) asm volatile("s_waitcnt lgkmcnt(" #n ")" ::: "memory")
#define PG8_BAR __builtin_amdgcn_s_barrier()
#define PG8_SCHED __builtin_amdgcn_sched_barrier(0)
    Unit cur, nxt; int ui = 0;
    if (!S.next(0, cur)) return;
    f32x4 acc[2][2][4][2];
#pragma unroll
    for (int a = 0; a < 2; ++a)
#pragma unroll
        for (int b = 0; b < 2; ++b)
#pragma unroll
            for (int m = 0; m < 4; ++m)
#pragma unroll
                for (int n = 0; n < 2; ++n) acc[a][b][m][n] = (f32x4){0.f, 0.f, 0.f, 0.f};
    bf16x8 At[4][2], B0[2][2], B1[2][2];
    const char* cA = (const char*)g.A + (size_t)cur.pm * tstep; const char* cB = (const char*)g.Bt + (size_t)cur.pn * tstep;
    S.a_ready(cur);
    PG8_STAGE(PG8_SB(0, 0), cB, voffB); PG8_STAGE(PG8_SA(0, 0), cA, voffA); PG8_STAGE(PG8_SB(0, 1), cB + hstep, voffB); PG8_STAGE(PG8_SA(0, 1), cA + hstep, voffA);
    if (wr == 1) PG8_BAR;
    PG8_WAIT_V(4); PG8_BAR;
    PG8_STAGE(PG8_SB(1, 0), cB + kstep, voffB); PG8_STAGE(PG8_SA(1, 0), cA + kstep, voffA); PG8_STAGE(PG8_SB(1, 1), cB + hstep + kstep, voffB);
    PG8_WAIT_V(6); PG8_BAR;
    PG8_STAMP();
    for (;;) {
        const bool has_next = S.next(ui + 1, nxt);
        const char* nA = has_next ? (const char*)g.A + (size_t)nxt.pm * tstep : cA; const char* nB = has_next ? (const char*)g.Bt + (size_t)nxt.pn * tstep : cB;
        for (int t = 0; t < nt; t += 2) {
            const bool last = (t == nt - 2);
            const char* a1 = cA + (size_t)(t + 1) * kstep;
            const char* a2 = last ? nA : cA + (size_t)(t + 2) * kstep; const char* b2 = last ? nB : cB + (size_t)(t + 2) * kstep;
            const char* a3 = a2 + kstep; const char* b3 = b2 + kstep;
            if (last && has_next) S.a_ready(nxt);
            PG8_LDB(B0, 0, 0); PG8_SCHED; PG8_LDA(At, 0, 0); PG8_STAGE(PG8_SA(1, 1), a1 + hstep, voffA);
            PG8_WAIT_L(8); PG8_BAR; PG8_WAIT_L(0); PG8_MMA(0, 0, At, B0); PG8_BAR; PG8_SCHED;
            PG8_LDB(B1, 0, 1); PG8_STAGE(PG8_SB(0, 0), b2, voffB);
            PG8_BAR; PG8_WAIT_L(0); PG8_MMA(0, 1, At, B1); PG8_BAR;
            PG8_LDA(At, 0, 1); PG8_STAGE(PG8_SA(0, 0), a2, voffA);
            PG8_BAR; PG8_WAIT_L(0); PG8_MMA(1, 0, At, B0); PG8_BAR; PG8_SCHED;
            PG8_STAGE(PG8_SB(0, 1), b2 + hstep, voffB);
            PG8_WAIT_V(6); PG8_BAR; PG8_MMA(1, 1, At, B1); PG8_BAR;
            PG8_LDB(B0, 1, 0); PG8_SCHED; PG8_LDA(At, 1, 0); PG8_STAGE(PG8_SA(0, 1), a2 + hstep, voffA);
            PG8_WAIT_L(8); PG8_BAR; PG8_WAIT_L(0); PG8_MMA(0, 0, At, B0); PG8_BAR; PG8_SCHED;
            PG8_LDB(B1, 1, 1); PG8_STAGE(PG8_SB(1, 0), b3, voffB);
            PG8_BAR; PG8_WAIT_L(0); PG8_MMA(0, 1, At, B1); PG8_BAR;
            PG8_LDA(At, 1, 1); PG8_STAGE(PG8_SA(1, 0), a3, voffA);
            PG8_BAR; PG8_WAIT_L(0); PG8_MMA(1, 0, At, B0); PG8_BAR; PG8_SCHED;
            PG8_STAGE(PG8_SB(1, 1), b3 + hstep, voffB);
            PG8_WAIT_V(6); PG8_BAR; PG8_MMA(1, 1, At, B1); PG8_BAR;
        }
        PG8_STAMP();
        if constexpr (!Epi::AFTER_DRAIN) { E(acc, cur, wr, wc, fr, fq); S.done(cur); }
        PG8_STAMP();
        if (!has_next) break;
#pragma unroll
        for (int a = 0; a < 2; ++a)
#pragma unroll
            for (int b = 0; b < 2; ++b)
#pragma unroll
                for (int m = 0; m < 4; ++m)
#pragma unroll
                    for (int n = 0; n < 2; ++n) acc[a][b][m][n] = (f32x4){0.f, 0.f, 0.f, 0.f};
        cur = nxt; cA = nA; cB = nB; ++ui;
    }
    PG8_WAIT_V(0);
    if (wr == 0) PG8_BAR;
    PG8_BAR;
    if constexpr (Epi::AFTER_DRAIN) { E.fused(acc, cur, wr, wc, fr, fq, lds, wid, lane); S.done(cur); }
    PG8_STAMP();
    if (STAMP && wid == 0) { stamps[lane] = lane < nts ? (((unsigned long long)(unsigned)ts_hi << 32) | (unsigned)ts_lo) : 0ull;
        if (lane == 62) stamps[62] = rt_entry; if (lane == 63) stamps[63] = (unsigned long long)wall_clock64(); }
#undef PG8_STAMP
#undef PG8_SA
#undef PG8_SB
#undef PG8_STAGE
#undef PG8_LDA
#undef PG8_LDB
#undef PG8_MMA
#undef PG8_WAIT_V
#undef PG8_WAIT_L
#undef PG8_BAR
#undef PG8_SCHED
}
}

#define XB_TMO      128
#define XB_XCNT(j)  (256  + 64 * (j))
#define XB_XSUB(j)  (1280 + 64 * (j))
#define XB_XGEN(j)  (2304 + 64 * (j))
#define XB_TOP      3328
#define XB_TOPGEN   3392
#define XCD_BAR_WORDS 3456
#define XB_SPIN_CAP (1u << 18)
#define LAS __attribute__((address_space(3)))

__device__ __forceinline__ unsigned xb_ld(unsigned* p)              { return __hip_atomic_load(p, __ATOMIC_RELAXED, __HIP_MEMORY_SCOPE_AGENT); }
__device__ __forceinline__ unsigned xb_add(unsigned* p, unsigned v) { return __hip_atomic_fetch_add(p, v, __ATOMIC_RELAXED, __HIP_MEMORY_SCOPE_AGENT); }
__device__ __forceinline__ unsigned xb_xcc_id() { return (unsigned)__builtin_amdgcn_s_getreg((3 << 11) | 20) & 0xFu; }
#define XB_SPIN(cond, bar) do { unsigned _sp = 0; while (cond) { __builtin_amdgcn_s_sleep(1); \
    if ((++_sp & 255u) == 0u) { if (xb_ld(&(bar)[XB_TMO])) break; if (_sp > XB_SPIN_CAP) { atomicAdd(&(bar)[XB_TMO], 1u); break; } } } } while (0)

struct XcdBarrier {
    unsigned* bar; unsigned x;
    volatile LAS unsigned* st;
};

__device__ __forceinline__ XcdBarrier xcd_barrier_post(unsigned* bar, volatile LAS unsigned* st) {
    XcdBarrier b; b.bar = bar; b.x = xb_xcc_id(); b.st = st;
    if (TIDX == 0) (void)xb_add(&bar[XB_XCNT(b.x)], 1u);
    return b;
}
__device__ __forceinline__ void xcd_barrier_complete(unsigned* bar, unsigned x, unsigned& nloc, unsigned& nx) {
    const unsigned G = gridDim.x * gridDim.y * gridDim.z;
    unsigned sum, cnt, mine, sp = 0u;
    for (;;) {
        sum = 0u; cnt = 0u; mine = 0u;
#pragma unroll
        for (unsigned j = 0; j < 16; ++j) { const unsigned c = xb_ld(&bar[XB_XCNT(j)]); sum += c; cnt += (c > 0u) ? 1u : 0u; mine = (j == x) ? c : mine; }
        if (sum == G) break;
        __builtin_amdgcn_s_sleep(1);
        if ((++sp & 255u) == 0u) { if (xb_ld(&bar[XB_TMO])) break; if (sp > XB_SPIN_CAP) { atomicAdd(&bar[XB_TMO], 1u); break; } }
    }
    nloc = mine > 0u ? mine : 1u; nx = cnt > 0u ? cnt : 1u;
}

__device__ __forceinline__ void xcd_barrier(const XcdBarrier& b) {
    asm volatile("s_waitcnt vmcnt(0)" ::: "memory");
    __syncthreads();
    if (TIDX == 0) {
        unsigned* bar = b.bar;
        __builtin_amdgcn_s_waitcnt(0);
        unsigned nloc = b.st[0], nx = b.st[1];
        if (nloc == 0u) { xcd_barrier_complete(bar, b.x, nloc, nx); b.st[0] = nloc; b.st[1] = nx; }
        const unsigned old = xb_add(&bar[XB_XSUB(b.x)], 1u);
        const unsigned gen = old / nloc;
        if (old + 1u == (gen + 1u) * nloc) {
            __builtin_amdgcn_fence(__ATOMIC_RELEASE, "agent");
            asm volatile("s_waitcnt vmcnt(0)" ::: "memory");
            const unsigned og = xb_add(&bar[XB_TOP], 1u);
            const unsigned tg = og / nx;
            if (og + 1u == (tg + 1u) * nx) xb_add(&bar[XB_TOPGEN], 1u);
            else XB_SPIN(xb_ld(&bar[XB_TOPGEN]) == tg, bar);
            __builtin_amdgcn_fence(__ATOMIC_ACQUIRE, "agent");
            xb_add(&bar[XB_XGEN(b.x)], 1u);
            asm volatile("s_waitcnt vmcnt(0)" ::: "memory");
        } else {
            XB_SPIN(xb_ld(&bar[XB_XGEN(b.x)]) == gen, bar);
            __builtin_amdgcn_fence(__ATOMIC_ACQUIRE, "agent");
            asm volatile("s_waitcnt vmcnt(0)" ::: "memory");
        }
    }
    __syncthreads();
}

__device__ void d_cvt(const float* __restrict__ in, bf16_t* __restrict__ out, size_t n4) {
  const size_t stride = (size_t)gridDim.x * blockDim.x;
  size_t i = (size_t)blockIdx.x * blockDim.x + TIDX;
  for (; i + 3 * stride < n4; i += 4 * stride) {
    f32x4 v[4];
#pragma unroll
    for (int q = 0; q < 4; ++q) v[q] = ((const f32x4*)in)[i + q * stride];
#pragma unroll
    for (int q = 0; q < 4; ++q) { u32x2 o = {pack2(v[q][0], v[q][1]), pack2(v[q][2], v[q][3])}; ((u32x2*)out)[i + q * stride] = o; }
  }
  for (; i < n4; i += stride) { const f32x4 v = ((const f32x4*)in)[i]; u32x2 o = {pack2(v[0], v[1]), pack2(v[2], v[3])}; ((u32x2*)out)[i] = o; }
}
__device__ void d_cvtT64(int vb, char* smem, const float* __restrict__ W, bf16_t* __restrict__ WT, int K, int N, int NP) {
  float (*tt)[65] = (float (*)[65])smem;
  const int tid = (TIDX & 255);
  const int nbx = NP / 64;
  const int n0 = (vb % nbx) * 64, k0 = (vb / nbx) * 64;
  {
    const int kr = tid >> 4, nc = (tid & 15) * 4;
#pragma unroll
    for (int i = 0; i < 4; ++i) {
      const int k = k0 + kr + 16 * i, n = n0 + nc;
      f32x4 v = {0.f, 0.f, 0.f, 0.f};
      if (n < N) v = *(const f32x4*)(W + (size_t)k * N + n);
      tt[kr + 16 * i][nc] = v[0]; tt[kr + 16 * i][nc + 1] = v[1]; tt[kr + 16 * i][nc + 2] = v[2]; tt[kr + 16 * i][nc + 3] = v[3];
    }
  }
  __syncthreads();
  {
    const int nr = tid >> 3, kc = (tid & 7) * 8;
#pragma unroll
    for (int i = 0; i < 2; ++i) {
      const int nl = nr + 32 * i;
      u32x4 o = {pack2(tt[kc][nl], tt[kc + 1][nl]), pack2(tt[kc + 2][nl], tt[kc + 3][nl]), pack2(tt[kc + 4][nl], tt[kc + 5][nl]), pack2(tt[kc + 6][nl], tt[kc + 7][nl])};
      *(u32x4*)(WT + (size_t)(n0 + nl) * K + k0 + kc) = o;
    }
  }
  __syncthreads();
}

using f32x16 = __attribute__((ext_vector_type(16))) float;
using bf16x8v = __attribute__((ext_vector_type(8))) __bf16;
#define MFMA32(a, b, c) __builtin_amdgcn_mfma_f32_32x32x16_bf16((a), (b), (c), 0, 0, 0)
constexpr float LOG2E = 1.4426950408889634f;
constexpr float NEGB = -1e30f;
DI int pi_perm(int i) { return (i & ~12) | ((i & 8) >> 1) | ((i & 4) << 1); }
DI bf16x8 pack8(float a0, float a1, float a2, float a3, float a4, float a5, float a6, float a7) {
  bf16x8v v = {(__bf16)a0, (__bf16)a1, (__bf16)a2, (__bf16)a3, (__bf16)a4, (__bf16)a5, (__bf16)a6, (__bf16)a7};
  return __builtin_bit_cast(bf16x8, v);
}
__device__ __forceinline__ void d_relayout_tile(int T, char* smem, const bf16_t* __restrict__ proj, int col0, bf16_t* __restrict__ dst, bool isV) {
  bf16_t* Ls = (bf16_t*)smem;
  const int tid = TIDX;
#pragma unroll
  for (int q = 0; q < 2; ++q) {
    const int cidx = tid + q * 512;
    const int g = cidx >> 9, tok = (cidx >> 4) & 31, ch = cidx & 15;
    const u32x4 v = *(const u32x4*)(proj + (size_t)(32 * T + tok) * INWP + col0 + g * 128 + ch * 8);
    *(u32x4*)(Ls + (g * 32 + tok) * 136 + ch * 8) = v;
  }
  __syncthreads();
#pragma unroll
  for (int q = 0; q < 2; ++q) {
    const int oc = tid + q * 512;
    const int g = oc >> 9, r9 = oc & 511, lane = r9 & 63;
    u32x4 o;
    if (!isV) {
      const int s8 = r9 >> 6, i = lane & 31, h = lane >> 5;
      o = *(const u32x4*)(Ls + (g * 32 + pi_perm(i)) * 136 + 16 * s8 + 8 * h);
    } else {
      const int s2 = (r9 >> 6) & 1, dt = r9 >> 7, dd = lane & 31, h = lane >> 5;
      const bf16_t* col = Ls + (g * 32 + 16 * s2 + 8 * h) * 136 + 32 * dt + dd;
      unsigned short e[8];
#pragma unroll
      for (int j = 0; j < 8; ++j) e[j] = col[j * 136];
      o.x = e[0] | ((unsigned)e[1] << 16); o.y = e[2] | ((unsigned)e[3] << 16); o.z = e[4] | ((unsigned)e[5] << 16); o.w = e[6] | ((unsigned)e[7] << 16);
    }
    *(u32x4*)(dst + (((size_t)(g * 512 + T)) * 512 + r9) * 8) = o;
  }
  __syncthreads();
}

struct AttnPtrs {
  const bf16_t* proj; const float* gates;
  const bf16_t *kcf, *vcf, *ksf, *vsf, *kwf, *vwf;
  bf16_t* mix; const float* hng;
};

DI float ex2(float x) { return __builtin_amdgcn_exp2f(x); }
DI void halves(float x, float& lo, float& hi) {
  const unsigned u = __float_as_uint(x);
  auto r = __builtin_amdgcn_permlane32_swap(u, u, false, false);
  lo = __uint_as_float(r[0]); hi = __uint_as_float(r[1]);
}
DI float hmax(float x) { float a, b; halves(x, a, b); return fmaxf(a, b); }
DI float hsum(float x) { float a, b; halves(x, a, b); return a + b; }
DI float dpp_quad(float v, int ctrl_is_xor1) {
  const int iv = __float_as_int(v);
  const int r = ctrl_is_xor1 ? __builtin_amdgcn_update_dpp(iv, iv, 0xB1, 0xF, 0xF, false) : __builtin_amdgcn_update_dpp(iv, iv, 0x4E, 0xF, 0xF, false);
  return __int_as_float(r);
}
DI float quad_sum(float v) { v += dpp_quad(v, 1); v += dpp_quad(v, 0); return v; }
DI void osm_step(const float (&sv)[16], float& m, float& l, f32x16 (&O)[4], float (&p)[16]) {
  float tmax = fmaxf(fmaxf(fmaxf(sv[0], sv[1]), fmaxf(sv[2], sv[3])), fmaxf(fmaxf(sv[4], sv[5]), fmaxf(sv[6], sv[7])));
  tmax = fmaxf(tmax, fmaxf(fmaxf(fmaxf(sv[8], sv[9]), fmaxf(sv[10], sv[11])), fmaxf(fmaxf(sv[12], sv[13]), fmaxf(sv[14], sv[15]))));
  tmax = hmax(tmax);
  if (__ballot(tmax - m > 8.f)) {
    const float mn = fmaxf(m, tmax);
    const float alpha = ex2(m - mn);
    l *= alpha; m = mn;
#pragma unroll
    for (int dt = 0; dt < 4; ++dt)
#pragma unroll
      for (int r = 0; r < 16; ++r) O[dt][r] *= alpha;
  }
  float ps0 = 0.f, ps1 = 0.f;
#pragma unroll
  for (int r = 0; r < 16; r += 2) { const float e0 = ex2(sv[r] - m), e1 = ex2(sv[r + 1] - m); p[r] = e0; p[r + 1] = e1; ps0 += e0; ps1 += e1; }
  l += ps0 + ps1;
}
DI void ot_store(char* otL, int lane, const f32x16 (&O)[4], float sc) {
#pragma unroll
  for (int dt = 0; dt < 4; ++dt) {
    u32x4 a, b;
#pragma unroll
    for (int i = 0; i < 4; ++i) { a[i] = pack2(sc * O[dt][2 * i], sc * O[dt][2 * i + 1]); b[i] = pack2(sc * O[dt][8 + 2 * i], sc * O[dt][8 + 2 * i + 1]); }
    *(u32x4*)(otL + lane * 128 + dt * 32) = a;
    *(u32x4*)(otL + lane * 128 + dt * 32 + 16) = b;
  }
}
DI void ot_accum(const char* otL, int lane, f32x16 (&O)[4], float sc) {
#pragma unroll
  for (int dt = 0; dt < 4; ++dt) {
    u32x4 a = *(const u32x4*)(otL + lane * 128 + dt * 32);
    u32x4 b = *(const u32x4*)(otL + lane * 128 + dt * 32 + 16);
#pragma unroll
    for (int i = 0; i < 4; ++i) {
      const unsigned wa = a[i], wb = b[i];
      O[dt][2 * i] = fmaf(sc, O[dt][2 * i], __uint_as_float(wa << 16));
      O[dt][2 * i + 1] = fmaf(sc, O[dt][2 * i + 1], __uint_as_float(wa & 0xFFFF0000u));
      O[dt][8 + 2 * i] = fmaf(sc, O[dt][8 + 2 * i], __uint_as_float(wb << 16));
      O[dt][8 + 2 * i + 1] = fmaf(sc, O[dt][8 + 2 * i + 1], __uint_as_float(wb & 0xFFFF0000u));
    }
  }
}
DI void zero_o(f32x16 (&O)[4]) {
#pragma unroll
  for (int dt = 0; dt < 4; ++dt)
#pragma unroll
    for (int i = 0; i < 16; ++i) O[dt][i] = 0.f;
}

constexpr int ATT_PW = 8704;
constexpr int ATT_R = 4, ATT_D = 3;
constexpr int ATT_RING = 8 * ATT_PW;
constexpr int ATT_LIST = ATT_RING + ATT_R * 16384;
constexpr int ATT_BUNI = ATT_LIST + 2048;
constexpr int ATT_SMEM = ATT_BUNI + 64;
#define LAS3 __attribute__((address_space(3)))
__device__ __forceinline__ void d_select(const float* impL, unsigned* mskL, unsigned* uniL, int cur) {
  const int lane = TIDX & 63;
  const int stok = lane >> 3, sub = lane & 7;
  unsigned key[32];
#pragma unroll
  for (int i4 = 0; i4 < 8; ++i4) {
    f32x4 v = *(const f32x4*)(impL + stok * 256 + sub * 32 + i4 * 4);
#pragma unroll
    for (int e = 0; e < 4; ++e) {
      const int j = sub * 32 + i4 * 4 + e;
      const bool valid = j <= cur;
      const bool forced = (j == 0) || (j == cur) || (j == cur - 1);
      unsigned kb = forced ? 0xFFFFFF00u : (__float_as_uint(v[e]) & 0xFFFFFF00u);
      key[i4 * 4 + e] = valid ? (kb | (unsigned)(255 - j)) : 0u;
    }
  }
#pragma unroll
  for (int k = 2; k <= 32; k <<= 1) {
#pragma unroll
    for (int jj = k >> 1; jj > 0; jj >>= 1) {
#pragma unroll
      for (int i = 0; i < 32; ++i) {
        const int l2 = i ^ jj;
        if (l2 > i) {
          const bool desc = ((i & k) == 0);
          unsigned a = key[i], b = key[l2];
          unsigned mx = a > b ? a : b, mn = a > b ? b : a;
          key[i] = desc ? mx : mn; key[l2] = desc ? mn : mx;
        }
      }
    }
  }
#pragma unroll
  for (int xm = 1; xm < 8; xm <<= 1) {
    unsigned L[16];
#pragma unroll
    for (int i = 0; i < 16; ++i) { unsigned o = (unsigned)shx_i((int)key[15 - i], xm); L[i] = key[i] > o ? key[i] : o; }
#pragma unroll
    for (int jj = 8; jj > 0; jj >>= 1) {
#pragma unroll
      for (int i = 0; i < 16; ++i) {
        const int l2 = i ^ jj;
        if (l2 > i) { unsigned a = L[i], b = L[l2]; L[i] = a > b ? a : b; L[l2] = a > b ? b : a; }
      }
    }
#pragma unroll
    for (int i = 0; i < 16; ++i) key[i] = L[i];
  }
#pragma unroll
  for (int i = 0; i < 16; ++i) {
    if ((i & 7) == sub) {
      const int j = 255 - (int)(key[i] & 255u);
      if (j <= cur) { atomicOr(&mskL[stok * 8 + (j >> 5)], 1u << (j & 31)); atomicOr(&uniL[j >> 5], 1u << (j & 31)); }
    }
  }
}


DI void att_issue(LAS3 unsigned char* ring, int slot, int w, int lane, const bf16_t* kb, const bf16_t* vb, int tile) {
  const char* ks = (const char*)kb + (size_t)tile * 8192 + w * 1024 + lane * 16;
  const char* vs = (const char*)vb + (size_t)tile * 8192 + w * 1024 + lane * 16;
  __builtin_amdgcn_global_load_lds((const unsigned*)ks, (LAS3 unsigned*)(ring + slot * 16384 + w * 1024), 16, 0, 0);
  __builtin_amdgcn_global_load_lds((const unsigned*)vs, (LAS3 unsigned*)(ring + slot * 16384 + 8192 + w * 1024), 16, 0, 0);
}
DI f32x16 qk_lds(LAS3 const unsigned char* kt, const bf16x8 (&qf)[8], int lane) {
  f32x16 acc;
#pragma unroll
  for (int i = 0; i < 16; ++i) acc[i] = 0.f;
#pragma unroll
  for (int s8 = 0; s8 < 8; ++s8) {
    const bf16x8 kf = *(LAS3 const bf16x8*)(kt + s8 * 1024 + lane * 16);
    acc = MFMA32(kf, qf[s8], acc);
  }
  return acc;
}
DI void pv_lds(LAS3 const unsigned char* vt, const float (&p)[16], f32x16 (&O)[4], int lane) {
  const bf16x8 pf0 = pack8(p[0], p[1], p[2], p[3], p[4], p[5], p[6], p[7]);
  const bf16x8 pf1 = pack8(p[8], p[9], p[10], p[11], p[12], p[13], p[14], p[15]);
#pragma unroll
  for (int dt = 0; dt < 4; ++dt) {
    const bf16x8 v0 = *(LAS3 const bf16x8*)(vt + (dt * 2) * 1024 + lane * 16);
    const bf16x8 v1 = *(LAS3 const bf16x8*)(vt + (dt * 2 + 1) * 1024 + lane * 16);
    O[dt] = MFMA32(v0, pf0, O[dt]);
    O[dt] = MFMA32(v1, pf1, O[dt]);
  }
}

__device__ __forceinline__ void d_attn_block(int B, int g, char* smem, const AttnPtrs& P) {
  const int tid = TIDX, lane = tid & 63, w = tid >> 6;
  const int c = lane & 31, h = lane >> 5, tokl = c >> 2, r = c & 3;
  const int tok0 = 64 * B + 8 * w;
  const int t = tok0 + tokl, hd = g * 4 + r;
  const float slope2 = exp2f(-(float)(hd + 1)) * LOG2E;
  const float c1 = QSCALE * LOG2E;
  const float ninf = -__builtin_inff();
  char* wsm = smem + w * ATT_PW;
  float* impL = (float*)wsm;
  char* otL = wsm;
  unsigned* mskL = (unsigned*)(wsm + 8192);
  unsigned* uniL = mskL + 64;
  LAS3 unsigned char* ring = (LAS3 unsigned char*)(smem + ATT_RING);
  unsigned short* tl = (unsigned short*)(smem + ATT_LIST);
  unsigned* buni = (unsigned*)(smem + ATT_BUNI);
  const bf16_t* kcf = P.kcf + (size_t)g * 32 * 4096;
  const bf16_t* vcf = P.vcf + (size_t)g * 32 * 4096;
  const bf16_t* ksf = P.ksf + (size_t)g * 512 * 4096;
  const bf16_t* vsf = P.vsf + (size_t)g * 512 * 4096;
  const bf16_t* kwf = P.kwf + (size_t)g * 512 * 4096;
  const bf16_t* vwf = P.vwf + (size_t)g * 512 * 4096;
  bf16x8 qf[8];
  {
    const bf16_t* qrow = P.proj + (size_t)t * INWP + OFF_Q + hd * 128 + 8 * h;
#pragma unroll
    for (int s8 = 0; s8 < 8; ++s8) qf[s8] = *(const bf16x8*)(qrow + 16 * s8);
  }
  const float* gt = P.gates + (size_t)t * 24 + hd * 3;
  const float g0 = gt[0], g1 = gt[1], g2 = gt[2];
  {
    unsigned z0 = 0u;
    asm volatile("" : "+v"(z0));
    u32x4 z = {z0, z0, z0, z0};
#pragma unroll
    for (int i = 0; i < 8; ++i) *(u32x4*)(wsm + (i * 64 + lane) * 16) = z;
    if (lane < 18) *(u32x4*)(wsm + 8192 + lane * 16) = z;
    if (tid < 8) buni[tid] = z0;
  }
  f32x16 Ob[4];
  zero_o(Ob);
  const int nmax = (t >= 31) ? ((t - 31) >> 4) : -1;
  const int nmaxw = (tok0 + 7 >= 31) ? ((tok0 + 7 - 31) >> 4) : -1;
  const int nminw = (tok0 >= 31) ? ((tok0 - 31) >> 4) : -1;
  const int ntcw = (nmaxw + 32) >> 5;
  const int ntcB = (((64 * B + 63 - 31) >> 4) + 32) >> 5;
  const float sl16 = slope2 * 16.f;
  float mC = NEGB, lC = 0.f, invC = 0.f, carry = 0.f;
  {
    const int n = 2 * ntcB;
    asm volatile("s_waitcnt vmcnt(0)" ::: "memory");
#define A_TILE(i_) (((i_) < ntcB) ? (ntcB - 1 - (i_)) : ((i_) - ntcB))
    att_issue(ring, 0, w, lane, kcf, vcf, A_TILE(0));
    if (n > 1) att_issue(ring, 1, w, lane, kcf, vcf, A_TILE(1));
#pragma unroll 1
    for (int i = 0; i < n; ++i) {
      if ((i & 1) == 0) {
        asm volatile("s_waitcnt vmcnt(0)" ::: "memory");
        __builtin_amdgcn_s_barrier();
        asm volatile("" ::: "memory");
        if (i + 2 < n) att_issue(ring, (i + 2) & 3, w, lane, kcf, vcf, A_TILE(i + 2));
        if (i + 3 < n) att_issue(ring, (i + 3) & 3, w, lane, kcf, vcf, A_TILE(i + 3));
      }
      const int T = A_TILE(i);
      if (T >= ntcw) continue;
      LAS3 const unsigned char* slot = ring + (i % ATT_R) * 16384;
      const f32x16 acc = qk_lds(slot, qf, lane);
      const float base = slope2 * (float)(512 * T + 128 * h) + slope2 * (15.5f - (float)t);
      const int nb = 32 * T + 8 * h;
      const bool full = (32 * T + 31 <= nminw);
      float sv[16];
#pragma unroll
      for (int rg = 0; rg < 16; ++rg) { const int kk = (rg & 7) + 16 * (rg >> 3); sv[rg] = fmaf(acc[rg], c1, fmaf(sl16, (float)kk, base)); }
      if (!full) {
#pragma unroll
        for (int rg = 0; rg < 16; ++rg) { const int kk = (rg & 7) + 16 * (rg >> 3); sv[rg] = (nb + kk <= nmax) ? sv[rg] : ninf; }
      }
      if (i < ntcB) {
        float tmax = fmaxf(fmaxf(fmaxf(sv[0], sv[1]), fmaxf(sv[2], sv[3])), fmaxf(fmaxf(sv[4], sv[5]), fmaxf(sv[6], sv[7])));
        tmax = fmaxf(tmax, fmaxf(fmaxf(fmaxf(sv[8], sv[9]), fmaxf(sv[10], sv[11])), fmaxf(fmaxf(sv[12], sv[13]), fmaxf(sv[14], sv[15]))));
        tmax = hmax(tmax);
        const float mn = fmaxf(mC, tmax);
        float ps = 0.f;
#pragma unroll
        for (int rg = 0; rg < 16; ++rg) ps += ex2(sv[rg] - mn);
        lC = lC * ex2(mC - mn) + ps; mC = mn;
      } else {
        if (T == 0) { lC = hsum(lC); invC = (lC > 0.f) ? 1.f / lC : 0.f; }
        float p[16];
#pragma unroll
        for (int rg = 0; rg < 16; ++rg) p[rg] = ex2(sv[rg] - mC) * invC;
        float Ga = (p[0] + p[1]) + (p[2] + p[3]), Gb = (p[4] + p[5]) + (p[6] + p[7]);
        float Gc = (p[8] + p[9]) + (p[10] + p[11]), Gd = (p[12] + p[13]) + (p[14] + p[15]);
        float xb, xd; { float a_, b_; halves(p[7], a_, b_); xb = h ? a_ : b_; halves(p[15], a_, b_); xd = h ? a_ : b_; }
        float ia = Ga + (h ? xb : carry);
        float ib = Gb + p[3];
        float ic = Gc + (h ? xd : xb);
        float id = Gd + p[11];
        carry = xd;
        ia = quad_sum(ia); ib = quad_sum(ib); ic = quad_sum(ic); id = quad_sum(id);
        {
          float val = (r == 0) ? ia : (r == 1) ? ib : (r == 2) ? ic : id;
          int j = 8 * T + 2 * h + ((r == 0) ? 0 : (r == 1) ? 1 : (r == 2) ? 4 : 5);
          impL[tokl * 256 + j] = val;
        }
        pv_lds(slot + 8192, p, Ob, lane);
      }
    }
#undef A_TILE
  }
  const int cur = B;
  d_select(impL, mskL, uniL, cur);
  ot_store(otL, lane, Ob, g0);
  zero_o(Ob);
  if (lane < 8) { const unsigned u = uniL[lane]; if (u) atomicOr(&buni[lane], u); }
  __syncthreads();
  int nslc = 0, ntl = 0;
  {
    for (int iw = 7; iw >= 0; --iw) {
      unsigned iuw = __builtin_amdgcn_readfirstlane(buni[iw]);
      while (iuw) {
        const int bit = 31 - __builtin_clz(iuw);
        iuw &= ~(1u << bit);
        const int bb = 32 * iw + bit;
        if (bb < B) { if (lane == 0) tl[ntl] = (unsigned short)(2 * bb + 1); ++ntl; }
        else { if (lane == 0) tl[ntl] = (unsigned short)(2 * bb + 1); ++ntl; }
        if (lane == 0) tl[ntl] = (unsigned short)(2 * bb);
        ++ntl;
      }
    }
    nslc = ntl;
    const int ThiB = 2 * B + 1, TloB = ((64 * B - 511 > 0) ? (64 * B - 511) : 0) >> 5;
    for (int T = ThiB; T >= TloB; --T) { if (lane == 0) tl[ntl] = (unsigned short)T; ++ntl; }
  }
  float m = NEGB, l = 0.f;
  {
    const int n = ntl;
    const int Tlow = ((tok0 - 511 > 0) ? (tok0 - 511) : 0) >> 5, Thiw = (tok0 + 7) >> 5;
#define B_ISSUE(j_, slot_) { const int e_ = __builtin_amdgcn_readfirstlane((int)tl[j_]); if ((j_) < nslc) att_issue(ring, slot_, w, lane, ksf, vsf, e_); else att_issue(ring, slot_, w, lane, kwf, vwf, e_); }
    B_ISSUE(0, 0)
    if (n > 1) B_ISSUE(1, 1)
#pragma unroll 1
    for (int i = 0; i < n; ++i) {
      if ((i & 1) == 0) {
        asm volatile("s_waitcnt vmcnt(0)" ::: "memory");
        __builtin_amdgcn_s_barrier();
        asm volatile("" ::: "memory");
        if (i + 2 < n) B_ISSUE(i + 2, (i + 2) & 3)
        if (i + 3 < n) B_ISSUE(i + 3, (i + 3) & 3)
      }
      if (i == nslc) {
        l = hsum(l);
        const float inv = (l > 0.f) ? g1 / l : 0.f;
        ot_accum(otL, lane, Ob, inv);
        ot_store(otL, lane, Ob, 1.f);
        zero_o(Ob);
        m = NEGB; l = 0.f;
      }
      const int T = __builtin_amdgcn_readfirstlane((int)tl[i]);
      const int pos0 = 32 * T, pb = pos0 + 8 * h;
      bool full; bool mine = true;
      if (i < nslc) {
        const int bb = T >> 1;
        const unsigned uw = __builtin_amdgcn_readfirstlane(uniL[bb >> 5]);
        if (!((uw >> (bb & 31)) & 1u) || pos0 > tok0 + 7) continue;
        mine = (mskL[tokl * 8 + (bb >> 5)] >> (bb & 31)) & 1u;
        full = (pos0 + 31 <= tok0) && (__ballot(!mine) == 0ull);
      } else {
        if (T < Tlow || T > Thiw) continue;
        full = (pos0 + 31 <= tok0) && (pos0 >= tok0 + 7 - 511);
      }
      LAS3 const unsigned char* slot = ring + (i % ATT_R) * 16384;
      const f32x16 acc = qk_lds(slot, qf, lane);
      const float base = slope2 * (float)(pos0 + 8 * h - t);
      float sv[16], p[16];
#pragma unroll
      for (int rg = 0; rg < 16; ++rg) { const int kk = (rg & 7) + 16 * (rg >> 3); sv[rg] = fmaf(acc[rg], c1, fmaf(slope2, (float)kk, base)); }
      if (!full) {
        if (i < nslc) {
#pragma unroll
          for (int rg = 0; rg < 16; ++rg) { const int kk = (rg & 7) + 16 * (rg >> 3); sv[rg] = (mine && (pb + kk <= t)) ? sv[rg] : ninf; }
        } else {
#pragma unroll
          for (int rg = 0; rg < 16; ++rg) { const int kk = (rg & 7) + 16 * (rg >> 3); const int dw = t - (pb + kk); sv[rg] = ((dw >= 0) && (dw < 512)) ? sv[rg] : ninf; }
        }
      }
      osm_step(sv, m, l, Ob, p);
      pv_lds(slot + 8192, p, Ob, lane);
    }
#undef B_ISSUE
    l = hsum(l);
    const float inv = (l > 0.f) ? g2 / l : 0.f;
    ot_accum(otL, lane, Ob, inv);
  }
  {
    float ss = 0.f;
#pragma unroll
    for (int dt = 0; dt < 4; ++dt)
#pragma unroll
      for (int i = 0; i < 16; ++i) ss = fmaf(Ob[dt][i], Ob[dt][i], ss);
    ss = hsum(ss);
    const float rs = rsqrtf(ss * (1.f / 128.f) + 1e-6f);
    bf16_t* orow = P.mix + (size_t)t * DM + hd * 128 + 4 * h;
    const float* grow = P.hng + hd * 128 + 4 * h;
#pragma unroll
    for (int dt = 0; dt < 4; ++dt)
#pragma unroll
      for (int a = 0; a < 4; ++a) {
        const f32x4 gv = *(const f32x4*)(grow + 32 * dt + 8 * a);
        u32x2 wv2 = {pack2(Ob[dt][4 * a] * rs * gv[0], Ob[dt][4 * a + 1] * rs * gv[1]), pack2(Ob[dt][4 * a + 2] * rs * gv[2], Ob[dt][4 * a + 3] * rs * gv[3])};
        *(u32x2*)(orow + 32 * dt + 8 * a) = wv2;
      }
  }
  asm volatile("s_waitcnt vmcnt(0)" ::: "memory");
  __syncthreads();
}

__device__ void d_convmix(int t, int tl, const bf16_t* __restrict__ proj, const float* __restrict__ convw, const float* __restrict__ hng,
                          bf16_t* __restrict__ mix) {
  const int c = tl * 8;
  float acc[8];
#pragma unroll
  for (int i = 0; i < 8; ++i) acc[i] = 0.f;
#pragma unroll
  for (int j = 0; j < 3; ++j) {
    const int tt = t - 2 + j;
    if (tt >= 0) {
      const u32x4 cu = *(const u32x4*)(proj + (size_t)tt * INWP + OFF_C + c);
      const u32x4 uu = *(const u32x4*)(proj + (size_t)tt * INWP + OFF_U + c);
      const f32x4 w0 = *(const f32x4*)(convw + j * 1024 + c), w1 = *(const f32x4*)(convw + j * 1024 + c + 4);
#pragma unroll
      for (int i = 0; i < 4; ++i) {
        const unsigned a = cu[i], b = uu[i];
        const float wl = (i < 2) ? w0[2 * i] : w1[2 * i - 4], wh = (i < 2) ? w0[2 * i + 1] : w1[2 * i - 3];
        acc[2 * i] = fmaf(wl * __uint_as_float(a << 16), __uint_as_float(b << 16), acc[2 * i]);
        acc[2 * i + 1] = fmaf(wh * __uint_as_float(a & 0xFFFF0000u), __uint_as_float(b & 0xFFFF0000u), acc[2 * i + 1]);
      }
    }
  }
  const u32x4 bb = *(const u32x4*)(proj + (size_t)t * INWP + OFF_B + c);
  float ss = 0.f;
#pragma unroll
  for (int i = 0; i < 4; ++i) {
    const unsigned b = bb[i];
    acc[2 * i] *= __uint_as_float(b << 16); acc[2 * i + 1] *= __uint_as_float(b & 0xFFFF0000u);
    ss = fmaf(acc[2 * i], acc[2 * i], ss); ss = fmaf(acc[2 * i + 1], acc[2 * i + 1], ss);
  }
  ss += shx(ss, 8); ss += shx(ss, 4); ss += shx(ss, 2); ss += shx(ss, 1);
  const float rs = rsqrtf(ss * (1.f / 128.f) + 1e-6f);
  const f32x4 g0 = *(const f32x4*)(hng + 1024 + c), g1 = *(const f32x4*)(hng + 1024 + c + 4);
  u32x4 o = {pack2(acc[0] * rs * g0[0], acc[1] * rs * g0[1]), pack2(acc[2] * rs * g0[2], acc[3] * rs * g0[3]),
             pack2(acc[4] * rs * g1[0], acc[5] * rs * g1[1]), pack2(acc[6] * rs * g1[2], acc[7] * rs * g1[3])};
  *(u32x4*)(mix + (size_t)t * DM + 1024 + c) = o;
}
DI void d_convmix2(int t0, int tl, const bf16_t* __restrict__ proj, const float* __restrict__ convw, const float* __restrict__ hng, bf16_t* __restrict__ mix) {
  const int c = tl * 8;
  u32x4 cu[2][3], uu[2][3], bb[2];
#pragma unroll
  for (int q = 0; q < 2; ++q) {
    const int t = t0 + 4 * q;
#pragma unroll
    for (int j = 0; j < 3; ++j) {
      const int tt = t - 2 + j, tc = tt >= 0 ? tt : 0;
      cu[q][j] = *(const u32x4*)(proj + (size_t)tc * INWP + OFF_C + c);
      uu[q][j] = *(const u32x4*)(proj + (size_t)tc * INWP + OFF_U + c);
    }
    bb[q] = *(const u32x4*)(proj + (size_t)t * INWP + OFF_B + c);
  }
  f32x4 w0[3], w1[3];
#pragma unroll
  for (int j = 0; j < 3; ++j) { w0[j] = *(const f32x4*)(convw + j * 1024 + c); w1[j] = *(const f32x4*)(convw + j * 1024 + c + 4); }
  const f32x4 g0 = *(const f32x4*)(hng + 1024 + c), g1 = *(const f32x4*)(hng + 1024 + c + 4);
#pragma unroll
  for (int q = 0; q < 2; ++q) {
    const int t = t0 + 4 * q;
    float acc[8];
#pragma unroll
    for (int i = 0; i < 8; ++i) acc[i] = 0.f;
#pragma unroll
    for (int j = 0; j < 3; ++j) {
      if (t - 2 + j >= 0) {
#pragma unroll
        for (int i = 0; i < 4; ++i) {
          const unsigned a = cu[q][j][i], b = uu[q][j][i];
          const float wl = (i < 2) ? w0[j][2 * i] : w1[j][2 * i - 4], wh = (i < 2) ? w0[j][2 * i + 1] : w1[j][2 * i - 3];
          acc[2 * i] = fmaf(wl * __uint_as_float(a << 16), __uint_as_float(b << 16), acc[2 * i]);
          acc[2 * i + 1] = fmaf(wh * __uint_as_float(a & 0xFFFF0000u), __uint_as_float(b & 0xFFFF0000u), acc[2 * i + 1]);
        }
      }
    }
    float ss = 0.f;
#pragma unroll
    for (int i = 0; i < 4; ++i) {
      const unsigned b = bb[q][i];
      acc[2 * i] *= __uint_as_float(b << 16); acc[2 * i + 1] *= __uint_as_float(b & 0xFFFF0000u);
      ss = fmaf(acc[2 * i], acc[2 * i], ss); ss = fmaf(acc[2 * i + 1], acc[2 * i + 1], ss);
    }
    ss += shx(ss, 8); ss += shx(ss, 4); ss += shx(ss, 2); ss += shx(ss, 1);
    const float rs = rsqrtf(ss * (1.f / 128.f) + 1e-6f);
    u32x4 o = {pack2(acc[0] * rs * g0[0], acc[1] * rs * g0[1]), pack2(acc[2] * rs * g0[2], acc[3] * rs * g0[3]),
               pack2(acc[4] * rs * g1[0], acc[5] * rs * g1[1]), pack2(acc[6] * rs * g1[2], acc[7] * rs * g1[3])};
    *(u32x4*)(mix + (size_t)t * DM + 1024 + c) = o;
  }
}

DI void d_ln_fin(int t, const u32x4 (&wr)[4], bf16_t* __restrict__ yh, const float* __restrict__ gam, const float* __restrict__ bet) {
  const int lane = TIDX & 63;
  float v[32];
#pragma unroll
  for (int i = 0; i < 4; ++i) {
    const u32x4 w = wr[i];
#pragma unroll
    for (int j = 0; j < 4; ++j) { const unsigned ww = w[j]; v[i * 8 + 2 * j] = __uint_as_float(ww << 16); v[i * 8 + 2 * j + 1] = __uint_as_float(ww & 0xFFFF0000u); }
  }
  float s = 0.f;
#pragma unroll
  for (int i = 0; i < 32; ++i) s += v[i];
  s = wave_sum(s);
  const float mu = s * (1.f / DM);
  float q = 0.f;
#pragma unroll
  for (int i = 0; i < 32; ++i) { const float d = v[i] - mu; q = fmaf(d, d, q); }
  q = wave_sum(q);
  const float rs = rsqrtf(q * (1.f / DM) + 1e-5f);
#pragma unroll
  for (int i = 0; i < 4; ++i) {
    const int cb = 512 * i + 8 * lane;
    const f32x4 g0 = *(const f32x4*)(gam + cb), g1 = *(const f32x4*)(gam + cb + 4), b0 = *(const f32x4*)(bet + cb), b1 = *(const f32x4*)(bet + cb + 4);
    u32x4 o = {pack2((v[i * 8 + 0] - mu) * rs * g0[0] + b0[0], (v[i * 8 + 1] - mu) * rs * g0[1] + b0[1]), pack2((v[i * 8 + 2] - mu) * rs * g0[2] + b0[2], (v[i * 8 + 3] - mu) * rs * g0[3] + b0[3]),
               pack2((v[i * 8 + 4] - mu) * rs * g1[0] + b1[0], (v[i * 8 + 5] - mu) * rs * g1[1] + b1[1]), pack2((v[i * 8 + 6] - mu) * rs * g1[2] + b1[2], (v[i * 8 + 7] - mu) * rs * g1[3] + b1[3])};
    *(u32x4*)(yh + (size_t)t * DM + cb) = o;
  }
}

__device__ void d_cvt_w1f(size_t c, const float* __restrict__ w1, bf16_t* __restrict__ w1f) {
  const int lane = c & 63, ks = (c >> 6) & 255, ct = c >> 14;
  const int col = lane & 31, h = lane >> 5;
  bf16_t v[8];
#pragma unroll
  for (int j = 0; j < 8; ++j) v[j] = f2bf(w1[(size_t)(16 * ks + 8 * h + j) * 512 + 32 * ct + col]);
  u32x4 o; o.x = v[0] | ((unsigned)v[1] << 16); o.y = v[2] | ((unsigned)v[3] << 16); o.z = v[4] | ((unsigned)v[5] << 16); o.w = v[6] | ((unsigned)v[7] << 16);
  *(u32x4*)(w1f + c * 8) = o;
}
__device__ void d_cvt_w2f(size_t c, const float* __restrict__ w2, bf16_t* __restrict__ w2f) {
  const int lane = c & 63, s = (c >> 6) & 31, ct = c >> 11;
  const int col = lane & 31, h = lane >> 5;
  bf16_t v[8];
#pragma unroll
  for (int j = 0; j < 8; ++j) v[j] = f2bf(w2[(size_t)(16 * s + 8 * h + j) * 128 + 32 * ct + col]);
  u32x4 o; o.x = v[0] | ((unsigned)v[1] << 16); o.y = v[2] | ((unsigned)v[3] << 16); o.z = v[4] | ((unsigned)v[5] << 16); o.w = v[6] | ((unsigned)v[7] << 16);
  *(u32x4*)(w2f + c * 8) = o;
}
__device__ __forceinline__ void d_compress_unit64(int rt, int hf, char* smem, const bf16_t* __restrict__ proj, int col0, const float* __restrict__ pos,
                                const bf16_t* __restrict__ w1f, const float* __restrict__ b1, const bf16_t* __restrict__ w2f,
                                bf16_t* __restrict__ outf, bool isV, float* __restrict__ part, unsigned* flag) {
  bf16_t* Xs = (bf16_t*)smem;
  bf16_t* Hs = (bf16_t*)(smem + 2 * 17408);
  const int tid = TIDX, lane = tid & 63, w = tid >> 6, c = lane & 31, h = lane >> 5;
  const int R0 = rt * 64;
  const int lbeg = hf * 16, lend = lbeg + 16;
  const int srow = tid >> 4, sch = tid & 15;
  const int grow0 = R0 + srow, grow1 = grow0 + 32;
  const bool sval0 = grow0 < 2046, sval1 = grow1 < 2046;
  const bf16_t* sp0 = proj + (size_t)(16 * (grow0 >> 1)) * INWP + col0 + (grow0 & 1) * 128 + sch * 8;
  const bf16_t* sp1 = proj + (size_t)(16 * (grow1 >> 1)) * INWP + col0 + (grow1 & 1) * 128 + sch * 8;
  f32x16 acc00, acc01, acc10, acc11;
#pragma unroll
  for (int i = 0; i < 16; ++i) { acc00[i] = 0.f; acc01[i] = 0.f; acc10[i] = 0.f; acc11[i] = 0.f; }
  u32x4 rx0 = {0u, 0u, 0u, 0u}, rx1 = {0u, 0u, 0u, 0u}; f32x4 rp0, rp1;
#define STAGE_WRITE1(buf, rx_, row_)                                                                       \
  {                                                                                                        \
    u32x4 o_;                                                                                              \
    _Pragma("unroll") for (int i = 0; i < 4; ++i) {                                                        \
      const unsigned wv_ = rx_[i];                                                                         \
      const float lo = __uint_as_float(wv_ << 16) + ((i < 2) ? rp0[2 * i] : rp1[2 * i - 4]);               \
      const float hi = __uint_as_float(wv_ & 0xFFFF0000u) + ((i < 2) ? rp0[2 * i + 1] : rp1[2 * i - 3]);   \
      o_[i] = pack2(lo, hi);                                                                               \
    }                                                                                                      \
    *(u32x4*)(Xs + (buf) * 8704 + (row_) * 136 + sch * 8) = o_;                                            \
  }
#define STAGE_WRITE(buf) { STAGE_WRITE1(buf, rx0, srow) STAGE_WRITE1(buf, rx1, srow + 32) }
  if (sval0) rx0 = *(const u32x4*)(sp0 + (size_t)lbeg * INWP);
  if (sval1) rx1 = *(const u32x4*)(sp1 + (size_t)lbeg * INWP);
  rp0 = *(const f32x4*)(pos + lbeg * 128 + sch * 8); rp1 = *(const f32x4*)(pos + lbeg * 128 + sch * 8 + 4);
  STAGE_WRITE(0)
  __syncthreads();
  const bf16_t* wb0 = w1f + ((size_t)(2 * w) * 256 * 64 + lane) * 8;
  const bf16_t* wb1 = w1f + ((size_t)(2 * w + 1) * 256 * 64 + lane) * 8;
  bf16x8 bA[16], bB[16];
#define CMP_LOADB(BUF, L)                                                                      \
  _Pragma("unroll") for (int s8 = 0; s8 < 8; ++s8) {                                           \
    BUF[2 * s8] = *(const bf16x8*)(wb0 + (size_t)(8 * (L) + s8) * 512);                        \
    BUF[2 * s8 + 1] = *(const bf16x8*)(wb1 + (size_t)(8 * (L) + s8) * 512);                    \
  }
#define CMP_LOADX(L)                                                                           \
  if ((L) < lend) {     \
    if (sval0) rx0 = *(const u32x4*)(sp0 + (size_t)(L) * INWP);                                \
    if (sval1) rx1 = *(const u32x4*)(sp1 + (size_t)(L) * INWP);                                \
    rp0 = *(const f32x4*)(pos + (L) * 128 + sch * 8); rp1 = *(const f32x4*)(pos + (L) * 128 + sch * 8 + 4); \
  }
#define CMP_CHUNK(BUF, L)                                                                      \
  {                                                                                            \
    const bf16_t* xa = Xs + ((L) & 1) * 8704 + c * 136 + 8 * h;                                \
    _Pragma("unroll") for (int s8 = 0; s8 < 8; ++s8) {                                         \
      const bf16x8 a0 = *(const bf16x8*)(xa + 16 * s8), a1 = *(const bf16x8*)(xa + 32 * 136 + 16 * s8); \
      acc00 = MFMA32(a0, BUF[2 * s8], acc00);                                                  \
      acc01 = MFMA32(a0, BUF[2 * s8 + 1], acc01);                                              \
      acc10 = MFMA32(a1, BUF[2 * s8], acc10);                                                  \
      acc11 = MFMA32(a1, BUF[2 * s8 + 1], acc11);                                              \
    }                                                                                          \
    if ((L) + 1 < lend) STAGE_WRITE(((L) + 1) & 1)                                             \
    __syncthreads();                                                                           \
  }
  CMP_LOADB(bA, lbeg)
#pragma unroll 1
  for (int l = lbeg; l < lend; l += 2) {
    CMP_LOADX(l + 1)
    CMP_LOADB(bB, l + 1)
    __builtin_amdgcn_sched_barrier(0);
    CMP_CHUNK(bA, l)
    __builtin_amdgcn_sched_barrier(0);
    CMP_LOADX(l + 2)
    { const int ln = (l + 2 < lend) ? l + 2 : l;
      CMP_LOADB(bA, ln) }
    __builtin_amdgcn_sched_barrier(0);
    CMP_CHUNK(bB, l + 1)
    __builtin_amdgcn_sched_barrier(0);
  }
#undef CMP_LOADX
#undef CMP_LOADB
#undef CMP_CHUNK
#undef STAGE_WRITE
#undef STAGE_WRITE1
  if (hf == 1) {
    float* pp = part + (size_t)tid * 64;
#pragma unroll
    for (int i = 0; i < 4; ++i) {
      *(f32x4*)(pp + 4 * i) = f32x4{acc00[4 * i], acc00[4 * i + 1], acc00[4 * i + 2], acc00[4 * i + 3]}; *(f32x4*)(pp + 16 + 4 * i) = f32x4{acc01[4 * i], acc01[4 * i + 1], acc01[4 * i + 2], acc01[4 * i + 3]};
      *(f32x4*)(pp + 32 + 4 * i) = f32x4{acc10[4 * i], acc10[4 * i + 1], acc10[4 * i + 2], acc10[4 * i + 3]}; *(f32x4*)(pp + 48 + 4 * i) = f32x4{acc11[4 * i], acc11[4 * i + 1], acc11[4 * i + 2], acc11[4 * i + 3]};
    }
    asm volatile("s_waitcnt vmcnt(0)" ::: "memory");
    __syncthreads();
    if (tid == 0) { __builtin_amdgcn_fence(__ATOMIC_RELEASE, "agent"); asm volatile("s_waitcnt vmcnt(0)" ::: "memory"); __hip_atomic_store(flag, 1u, __ATOMIC_RELAXED, __HIP_MEMORY_SCOPE_AGENT); }
    __syncthreads();
    return;
  }
  {
    if (tid < 64) {
      unsigned spins = 0;
      while (__builtin_amdgcn_readfirstlane(__hip_atomic_load(flag, __ATOMIC_RELAXED, __HIP_MEMORY_SCOPE_AGENT)) == 0u && ++spins < (1u << 22)) __builtin_amdgcn_s_sleep(2);
      __builtin_amdgcn_fence(__ATOMIC_ACQUIRE, "agent");
      asm volatile("s_waitcnt vmcnt(0)" ::: "memory");
    }
    __syncthreads();
    const float* pp = part + (size_t)tid * 64;
#pragma unroll
    for (int i = 0; i < 4; ++i) {
      const f32x4 a = *(const f32x4*)(pp + 4 * i), b_ = *(const f32x4*)(pp + 16 + 4 * i), c_ = *(const f32x4*)(pp + 32 + 4 * i), d_ = *(const f32x4*)(pp + 48 + 4 * i);
#pragma unroll
      for (int j = 0; j < 4; ++j) { acc00[4 * i + j] += a[j]; acc01[4 * i + j] += b_[j]; acc10[4 * i + j] += c_[j]; acc11[4 * i + j] += d_[j]; }
    }
  }
  {
    const float bb0 = b1[64 * w + c], bb1 = b1[64 * w + 32 + c];
#pragma unroll
    for (int rg = 0; rg < 16; ++rg) {
      const int row = (rg & 3) + 8 * (rg >> 2) + 4 * h;
      Hs[row * 520 + 64 * w + c] = f2bf(gelu_tanh(acc00[rg] + bb0));
      Hs[row * 520 + 64 * w + 32 + c] = f2bf(gelu_tanh(acc01[rg] + bb1));
      Hs[(32 + row) * 520 + 64 * w + c] = f2bf(gelu_tanh(acc10[rg] + bb0));
      Hs[(32 + row) * 520 + 64 * w + 32 + c] = f2bf(gelu_tanh(acc11[rg] + bb1));
    }
  }
  __syncthreads();
  {
    const int rb = w >> 2, cw = w & 3;
    f32x16 o2;
#pragma unroll
    for (int i = 0; i < 16; ++i) o2[i] = 0.f;
    const bf16_t* ha = Hs + (rb * 32 + c) * 520 + 8 * h;
    const bf16_t* wb = w2f + ((size_t)cw * 32 * 64 + lane) * 8;
#pragma unroll 8
    for (int s2 = 0; s2 < 32; ++s2) {
      const bf16x8 a = *(const bf16x8*)(ha + 16 * s2);
      const bf16x8 b = *(const bf16x8*)(wb + (size_t)s2 * 512);
      o2 = MFMA32(a, b, o2);
    }
    const int d = 32 * cw + c;
#pragma unroll
    for (int rg = 0; rg < 16; ++rg) {
      const int row = R0 + rb * 32 + (rg & 3) + 8 * (rg >> 2) + 4 * h;
      const int n = row >> 1, g = row & 1;
      const bf16_t val = (row < 2046) ? f2bf(o2[rg]) : (bf16_t)0;
      const int T = n >> 5, nn = n & 31;
      size_t idx;
      if (!isV) idx = ((((size_t)(g * 32 + T) * 8 + (d >> 4)) * 64 + (pi_perm(nn) + 32 * ((d >> 3) & 1))) * 8 + (d & 7));
      else idx = (((((size_t)(g * 32 + T) * 4 + (d >> 5)) * 2 + (nn >> 4)) * 64 + ((d & 31) + 32 * ((nn >> 3) & 1))) * 8 + (nn & 7));
      outf[idx] = val;
    }
  }
  __syncthreads();
}
__device__ __forceinline__ void d_compress_unit(int rt, char* smem, const bf16_t* __restrict__ proj, int col0, const float* __restrict__ pos,
                                const bf16_t* __restrict__ w1f, const float* __restrict__ b1, const bf16_t* __restrict__ w2f,
                                bf16_t* __restrict__ outf, bool isV) {
  bf16_t* Xs = (bf16_t*)smem;
  bf16_t* Hs = (bf16_t*)(smem + 2 * 8704);
  const int tid = TIDX, lane = tid & 63, w = tid >> 6, c = lane & 31, h = lane >> 5;
  const int R0 = rt * 32;
  const int srow = tid >> 4, sch = tid & 15;
  const int grow = R0 + srow, sn = grow >> 1, sg = grow & 1;
  const bool svalid = grow < 2046;
  const bf16_t* sp = proj + (size_t)(16 * sn) * INWP + col0 + sg * 128 + sch * 8;
  f32x16 acc0, acc1;
#pragma unroll
  for (int i = 0; i < 16; ++i) { acc0[i] = 0.f; acc1[i] = 0.f; }
  u32x4 rx = {0u, 0u, 0u, 0u}; f32x4 rp0, rp1;
#define STAGE_WRITE(buf)                                                                                   \
  {                                                                                                        \
    u32x4 o_;                                                                                              \
    _Pragma("unroll") for (int i = 0; i < 4; ++i) {                                                        \
      const unsigned wv_ = rx[i];                                                                          \
      const float lo = __uint_as_float(wv_ << 16) + ((i < 2) ? rp0[2 * i] : rp1[2 * i - 4]);               \
      const float hi = __uint_as_float(wv_ & 0xFFFF0000u) + ((i < 2) ? rp0[2 * i + 1] : rp1[2 * i - 3]);   \
      o_[i] = pack2(lo, hi);                                                                               \
    }                                                                                                      \
    *(u32x4*)(Xs + (buf) * 4352 + srow * 136 + sch * 8) = o_;                                              \
  }
  if (svalid) rx = *(const u32x4*)(sp);
  rp0 = *(const f32x4*)(pos + sch * 8); rp1 = *(const f32x4*)(pos + sch * 8 + 4);
  STAGE_WRITE(0)
  __syncthreads();
  const bf16_t* wb0 = w1f + ((size_t)(2 * w) * 256 * 64 + lane) * 8;
  const bf16_t* wb1 = w1f + ((size_t)(2 * w + 1) * 256 * 64 + lane) * 8;
  bf16x8 bA[16], bB[16];
#define CMP_LOADB(BUF, L)                                                                      \
  _Pragma("unroll") for (int s8 = 0; s8 < 8; ++s8) {                                           \
    BUF[2 * s8] = *(const bf16x8*)(wb0 + (size_t)(8 * (L) + s8) * 512);                        \
    BUF[2 * s8 + 1] = *(const bf16x8*)(wb1 + (size_t)(8 * (L) + s8) * 512);                    \
  }
#define CMP_LOADX(L)                                                                           \
  if ((L) < 32) {     \
    if (svalid) rx = *(const u32x4*)(sp + (size_t)(L) * INWP);                                 \
    rp0 = *(const f32x4*)(pos + (L) * 128 + sch * 8); rp1 = *(const f32x4*)(pos + (L) * 128 + sch * 8 + 4); \
  }
#define CMP_CHUNK(BUF, L)                                                                      \
  {                                                                                            \
    const bf16_t* xa = Xs + ((L) & 1) * 4352 + c * 136 + 8 * h;                                \
    _Pragma("unroll") for (int s8 = 0; s8 < 8; ++s8) {                                         \
      const bf16x8 a = *(const bf16x8*)(xa + 16 * s8);                                         \
      acc0 = MFMA32(a, BUF[2 * s8], acc0);                                                     \
      acc1 = MFMA32(a, BUF[2 * s8 + 1], acc1);                                                 \
    }                                                                                          \
    if ((L) + 1 < 32) STAGE_WRITE(((L) + 1) & 1)                                               \
    __syncthreads();                                                                           \
  }
  CMP_LOADB(bA, 0)
#pragma unroll 1
  for (int l = 0; l < 32; l += 2) {
    CMP_LOADX(l + 1)
    CMP_LOADB(bB, l + 1)
    __builtin_amdgcn_sched_barrier(0);
    CMP_CHUNK(bA, l)
    __builtin_amdgcn_sched_barrier(0);
    CMP_LOADX(l + 2)
    { const int ln = (l + 2 < 32) ? l + 2 : l;
      CMP_LOADB(bA, ln) }
    __builtin_amdgcn_sched_barrier(0);
    CMP_CHUNK(bB, l + 1)
    __builtin_amdgcn_sched_barrier(0);
  }
#undef CMP_LOADX
#undef CMP_LOADB
#undef CMP_CHUNK
  {
    const float bb0 = b1[64 * w + c], bb1 = b1[64 * w + 32 + c];
#pragma unroll
    for (int rg = 0; rg < 16; ++rg) {
      const int row = (rg & 3) + 8 * (rg >> 2) + 4 * h;
      Hs[row * 520 + 64 * w + c] = f2bf(gelu_tanh(acc0[rg] + bb0));
      Hs[row * 520 + 64 * w + 32 + c] = f2bf(gelu_tanh(acc1[rg] + bb1));
    }
  }
  __syncthreads();
  if (w < 4) {
    f32x16 o2;
#pragma unroll
    for (int i = 0; i < 16; ++i) o2[i] = 0.f;
    const bf16_t* ha = Hs + c * 520 + 8 * h;
    const bf16_t* wb = w2f + ((size_t)w * 32 * 64 + lane) * 8;
#pragma unroll 8
    for (int s2 = 0; s2 < 32; ++s2) {
      const bf16x8 a = *(const bf16x8*)(ha + 16 * s2);
      const bf16x8 b = *(const bf16x8*)(wb + (size_t)s2 * 512);
      o2 = MFMA32(a, b, o2);
    }
    const int d = 32 * w + c;
#pragma unroll
    for (int rg = 0; rg < 16; ++rg) {
      const int row = R0 + (rg & 3) + 8 * (rg >> 2) + 4 * h;
      const int n = row >> 1, g = row & 1;
      const bf16_t val = (row < 2046) ? f2bf(o2[rg]) : (bf16_t)0;
      const int T = n >> 5, nn = n & 31;
      size_t idx;
      if (!isV) idx = ((((size_t)(g * 32 + T) * 8 + (d >> 4)) * 64 + (pi_perm(nn) + 32 * ((d >> 3) & 1))) * 8 + (d & 7));
      else idx = (((((size_t)(g * 32 + T) * 4 + (d >> 5)) * 2 + (nn >> 4)) * 64 + ((d & 31) + 32 * ((nn >> 3) & 1))) * 8 + (nn & 7));
      outf[idx] = val;
    }
  }
  __syncthreads();
}


DI unsigned f2sort(float f) { unsigned u = __float_as_uint(f); return u ^ ((unsigned)((int)u >> 31) | 0x80000000u); }
DI float sort2f(unsigned k) { unsigned u = (k & 0x80000000u) ? (k ^ 0x80000000u) : ~k; return __uint_as_float(u); }
template <int N>
DI void bitonic_sort_desc(unsigned (&key)[N]) {
#pragma unroll
  for (int k = 2; k <= N; k <<= 1) {
#pragma unroll
    for (int jj = k >> 1; jj > 0; jj >>= 1) {
#pragma unroll
      for (int i = 0; i < N; ++i) {
        const int l2 = i ^ jj;
        if (l2 > i) {
          const bool desc = ((i & k) == 0);
          unsigned a = key[i], b = key[l2];
          unsigned mx = a > b ? a : b, mn = a > b ? b : a;
          key[i] = desc ? mx : mn; key[l2] = desc ? mn : mx;
        }
      }
    }
  }
}
DI void merge_top16(unsigned (&a)[16], const unsigned (&b)[16]) {
#pragma unroll
  for (int i = 0; i < 16; ++i) { unsigned o = b[15 - i]; a[i] = a[i] > o ? a[i] : o; }
#pragma unroll
  for (int jj = 8; jj > 0; jj >>= 1) {
#pragma unroll
    for (int i = 0; i < 16; ++i) {
      const int l2 = i ^ jj;
      if (l2 > i) { unsigned x = a[i], y = a[l2]; a[i] = x > y ? x : y; a[l2] = x > y ? y : x; }
    }
  }
}
__device__ void d_cvt_subk(size_t c, const float* __restrict__ subk, bf16_t* __restrict__ skf) {
  int lane = c & 63, s = (c >> 6) & 7, kt = (c >> 9) & 3, hc = c >> 11;
  int i = lane & 31, h = lane >> 5;
  const float* src = subk + ((size_t)hc * 128 + 32 * kt + i) * 128 + 16 * s + 8 * h;
  bf16_t v[8];
#pragma unroll
  for (int j = 0; j < 8; ++j) v[j] = f2bf(src[j]);
  u32x4 o; o.x = v[0] | ((unsigned)v[1] << 16); o.y = v[2] | ((unsigned)v[3] << 16); o.z = v[4] | ((unsigned)v[5] << 16); o.w = v[6] | ((unsigned)v[7] << 16);
  *(u32x4*)(skf + c * 8) = o;
}

#define EPI_LANES()                                                                                                      \
    const int lane = fr | (fq << 4), rr = lane >> 2, rc = lane & 3;                                                       \
    PG8_LAS unsigned char* my = scr + (wr * 4 + wc) * 2048;                                                              \
    const int wo = fr * 64 + ((fq ^ ((fr >> 2) & 3)) << 4), ro = rr * 64 + ((rc ^ ((rr >> 2) & 3)) << 4);
struct EpiProjG {
  static constexpr bool PERM = true, AFTER_DRAIN = false;
  bf16_t* proj; float* gates; PG8_LAS unsigned char* scr;
  DI void operator()(const f32x4 (&acc)[2][2][4][2], const pg8::Unit& u, int wr, int wc, int fr, int fq) const {
    EPI_LANES()
#pragma unroll
    for (int ai = 0; ai < 2; ++ai)
#pragma unroll
      for (int bj = 0; bj < 2; ++bj) {
        const int c0 = u.pn * 256 + bj * 128 + wc * 32 + 8 * fq, cs = u.pn * 256 + bj * 128 + wc * 32 + 8 * rc;
#pragma unroll
        for (int mh = 0; mh < 2; ++mh) {
#pragma unroll
          for (int mm = 0; mm < 2; ++mm) {
            const f32x4 v0 = acc[ai][bj][mh * 2 + mm][0], v1 = acc[ai][bj][mh * 2 + mm][1];
            u32x4 w = {pack2(v0[0], v0[1]), pack2(v0[2], v0[3]), pack2(v1[0], v1[1]), pack2(v1[2], v1[3])};
            *(PG8_LAS u32x4*)(my + wo + mm * 1024) = w;
            if (c0 >= OFF_G && c0 < OFF_G + 24) {
              const int row = u.pm * 256 + ai * 128 + wr * 64 + (mh * 2 + mm) * 16 + fr;
              f32x4 g0, g1;
#pragma unroll
              for (int j = 0; j < 4; ++j) { g0[j] = 1.f / (1.f + __expf(-v0[j])); g1[j] = 1.f / (1.f + __expf(-v1[j])); }
              *(f32x4*)(gates + (size_t)row * 24 + (c0 - OFF_G)) = g0;
              *(f32x4*)(gates + (size_t)row * 24 + (c0 - OFF_G) + 4) = g1;
            }
          }
#pragma unroll
          for (int j = 0; j < 2; ++j) {
            const u32x4 w = *(const PG8_LAS u32x4*)(my + ro + j * 1024);
            const int row = u.pm * 256 + ai * 128 + wr * 64 + mh * 32 + j * 16 + rr;
            if (cs < INW) *(u32x4*)(proj + (size_t)row * INWP + cs) = w;
          }
        }
      }
  }
};
struct EpiResG {
  static constexpr bool PERM = true, AFTER_DRAIN = false;
  bf16_t* YB; PG8_LAS unsigned char* scr;
  DI void operator()(const f32x4 (&acc)[2][2][4][2], const pg8::Unit& u, int wr, int wc, int fr, int fq) const {
    EPI_LANES()
    bf16_t* yb = YB + (size_t)(u.pm * 256 + wr * 64 + rr) * DM + u.pn * 256 + wc * 32 + 8 * rc;
#pragma unroll
    for (int ai = 0; ai < 2; ++ai) {
      u32x4 xr[2][2][2];
#pragma unroll
      for (int bj = 0; bj < 2; ++bj)
#pragma unroll
        for (int mh = 0; mh < 2; ++mh)
#pragma unroll
          for (int j = 0; j < 2; ++j) xr[bj][mh][j] = *(const u32x4*)(yb + (size_t)(ai * 128 + mh * 32 + j * 16) * DM + bj * 128);
#pragma unroll
      for (int bj = 0; bj < 2; ++bj)
#pragma unroll
        for (int mh = 0; mh < 2; ++mh) {
#pragma unroll
          for (int mm = 0; mm < 2; ++mm) {
            const f32x4 v0 = acc[ai][bj][mh * 2 + mm][0], v1 = acc[ai][bj][mh * 2 + mm][1];
            u32x4 w = {pack2(v0[0], v0[1]), pack2(v0[2], v0[3]), pack2(v1[0], v1[1]), pack2(v1[2], v1[3])};
            *(PG8_LAS u32x4*)(my + wo + mm * 1024) = w;
          }
#pragma unroll
          for (int j = 0; j < 2; ++j) {
            const u32x4 a = *(const PG8_LAS u32x4*)(my + ro + j * 1024), xw = xr[bj][mh][j];
            u32x4 o;
#pragma unroll
            for (int q = 0; q < 4; ++q) {
              const unsigned aw = a[q], xq = xw[q];
              o[q] = pack2(fmaf(ALPHA, __uint_as_float(xq << 16), __uint_as_float(aw << 16)), fmaf(ALPHA, __uint_as_float(xq & 0xFFFF0000u), __uint_as_float(aw & 0xFFFF0000u)));
            }
            *(u32x4*)(yb + (size_t)(ai * 128 + mh * 32 + j * 16) * DM + bj * 128) = o;
          }
        }
    }
  }
};
struct EpiF32G {
  static constexpr bool PERM = false, AFTER_DRAIN = false;
  float* C; int ldc;
  DI void operator()(const f32x4 (&acc)[2][2][4][2], const pg8::Unit& u, int wr, int wc, int fr, int fq) const {
#pragma unroll
    for (int ai = 0; ai < 2; ++ai)
#pragma unroll
      for (int m = 0; m < 4; ++m) {
        const size_t ro = (size_t)(u.pm * 256 + ai * 128 + wr * 64 + m * 16 + fr) * ldc + u.pn * 256 + wc * 32 + 4 * fq;
#pragma unroll
        for (int bj = 0; bj < 2; ++bj)
#pragma unroll
          for (int n = 0; n < 2; ++n) *(f32x4*)(C + ro + bj * 128 + n * 16) = acc[ai][bj][m][n];
      }
  }
};
struct EpiRouteG {
  static constexpr bool PERM = false, AFTER_DRAIN = true;
  const bf16_t* skf; unsigned* tops;
  DI void operator()(const f32x4 (&)[2][2][4][2], const pg8::Unit&, int, int, int, int) const {}
  DI void fused(const f32x4 (&acc)[2][2][4][2], const pg8::Unit& u, int wr, int wc, int fr, int fq, PG8_LAS unsigned char* ldsp, int, int) const {
    const int lane = fr | (fq << 4), wid = wr * 4 + wc;
    bf16_t* Qs = (bf16_t*)ldsp;
#pragma unroll
    for (int ai = 0; ai < 2; ++ai)
#pragma unroll
      for (int m = 0; m < 4; ++m) {
        const int row = ai * 128 + wr * 64 + m * 16 + fr;
#pragma unroll
        for (int bj = 0; bj < 2; ++bj)
#pragma unroll
          for (int n = 0; n < 2; ++n) {
            const f32x4 v = acc[ai][bj][m][n];
            u32x2 w = {pack2(v[0], v[1]), pack2(v[2], v[3])};
            *(u32x2*)(Qs + row * 264 + bj * 128 + wc * 32 + n * 16 + 4 * fq) = w;
          }
      }
    __syncthreads();
    const int c = lane & 31, h = lane >> 5;
    unsigned kA[16], kB[16];
#pragma unroll 1
    for (int half = 0; half < 2; ++half) {
      const int hc = u.pn * 2 + half;
      const bf16_t* sk = skf + (size_t)hc * 4 * 4096;
      const bf16_t* qp = Qs + (wid * 32 + c) * 264 + half * 128 + 8 * h;
      unsigned k0[16], k1[16];
      bf16x8 afA[8], afB[8];
#define ROUTE_LD(KT, AF) { _Pragma("unroll") for (int s = 0; s < 8; ++s) AF[s] = *(const bf16x8*)(sk + (KT) * 4096 + s * 512 + lane * 8); }
#define ROUTE_MM(KT, AF, KA)                                                                    \
      {                                                                                         \
        f32x16 sc;                                                                              \
        _Pragma("unroll") for (int i = 0; i < 16; ++i) sc[i] = 0.f;                             \
        _Pragma("unroll") for (int s = 0; s < 8; ++s) {                                         \
          bf16x8 bq = *(const bf16x8*)(qp + 16 * s);                                            \
          sc = __builtin_amdgcn_mfma_f32_32x32x16_bf16(AF[s], bq, sc, 0, 0, 0);                 \
        }                                                                                       \
        _Pragma("unroll") for (int rg = 0; rg < 16; ++rg) {                                     \
          const int kidx = 32 * (KT) + (rg & 3) + 8 * (rg >> 2) + 4 * h;                        \
          KA[rg] = (f2sort(sc[rg]) & 0xFFFFFF80u) | (unsigned)(127 - kidx);                     \
        }                                                                                       \
      }
      ROUTE_LD(0, afA)
      ROUTE_LD(1, afB)
      __builtin_amdgcn_sched_barrier(0);
      ROUTE_MM(0, afA, k0)
      __builtin_amdgcn_sched_barrier(0);
      ROUTE_LD(2, afA)
      __builtin_amdgcn_sched_barrier(0);
      bitonic_sort_desc<16>(k0);
      ROUTE_MM(1, afB, k1)
      __builtin_amdgcn_sched_barrier(0);
      ROUTE_LD(3, afB)
      __builtin_amdgcn_sched_barrier(0);
      bitonic_sort_desc<16>(k1);
      merge_top16(k0, k1);
      ROUTE_MM(2, afA, k1)
      bitonic_sort_desc<16>(k1);
      merge_top16(k0, k1);
      ROUTE_MM(3, afB, k1)
      bitonic_sort_desc<16>(k1);
      merge_top16(k0, k1);
      __builtin_amdgcn_sched_barrier(0);
#undef ROUTE_LD
#undef ROUTE_MM

#pragma unroll
      for (int i = 0; i < 16; ++i) k1[i] = (unsigned)shx_i((int)k0[i], 32);
      merge_top16(k0, k1);
      if (half == 0) {
#pragma unroll
        for (int i = 0; i < 16; ++i) kA[i] = k0[i];
      } else {
#pragma unroll
        for (int i = 0; i < 16; ++i) kB[i] = k0[i];
      }
    }
    {
      unsigned* lk = (unsigned*)(ldsp + wid * 16896);
#pragma unroll
      for (int i = 0; i < 16; ++i) { lk[i * 64 + lane] = kA[i]; lk[(16 + i) * 64 + lane] = kB[i]; }
      float fa[16], fb[16];
#pragma unroll
      for (int i = 0; i < 16; ++i) { fa[i] = sort2f(kA[i]); fb[i] = sort2f(kB[i]); }
#define CAND(ci_, cj_) ((f2sort(fa[ci_] + fb[cj_]) & 0xFFFFFF00u) | (unsigned)(255 - ((ci_) * 16 + (cj_))))
      unsigned R0[16], R1[16], S1[16], S2[16];
#pragma unroll
      for (int j = 0; j < 16; ++j) { R0[j] = CAND(0, j); R1[j] = (j < 8) ? CAND(1, j & 7) : 0u; }
      S1[0] = CAND(2, 0); S1[1] = CAND(2, 1); S1[2] = CAND(2, 2); S1[3] = CAND(2, 3); S1[4] = CAND(2, 4);
      S1[5] = CAND(3, 0); S1[6] = CAND(3, 1); S1[7] = CAND(3, 2); S1[8] = CAND(3, 3);
      S1[9] = CAND(4, 0); S1[10] = CAND(4, 1); S1[11] = CAND(4, 2);
      S1[12] = CAND(5, 0); S1[13] = CAND(5, 1); S1[14] = CAND(6, 0); S1[15] = CAND(6, 1);
      S2[0] = CAND(7, 0); S2[1] = CAND(7, 1);
#pragma unroll
      for (int i = 8; i < 16; ++i) S2[i - 6] = CAND(i, 0);
#pragma unroll
      for (int i = 10; i < 16; ++i) S2[i] = 0u;
#undef CAND
      merge_top16(R0, R1);
      bitonic_sort_desc<16>(S1); bitonic_sort_desc<16>(S2);
      merge_top16(S1, S2);
      merge_top16(R0, S1);
      float sc[16]; unsigned ex[16]; float mx = -3.0e38f;
#pragma unroll
      for (int i = 0; i < 16; ++i) {
        const int flat = 255 - (int)(R0[i] & 255u);
        const unsigned ka = lk[(flat >> 4) * 64 + lane], kb = lk[(16 + (flat & 15)) * 64 + lane];
        sc[i] = sort2f(ka) + sort2f(kb);
        ex[i] = (127u - (ka & 127u)) * 128u + (127u - (kb & 127u));
        mx = fmaxf(mx, sc[i]);
      }
      float sm = 0.f;
#pragma unroll
      for (int i = 0; i < 16; ++i) { sc[i] = __expf(sc[i] - mx); sm += sc[i]; }
      const float rsm = 1.f / sm;
      unsigned* dst = tops + (size_t)(u.pm * 256 + wid * 32 + c) * 256 + h * 128 + u.pn * 16;
#pragma unroll
      for (int q4 = 0; q4 < 4; ++q4) {
        u32x4 o;
#pragma unroll
        for (int i = 0; i < 4; ++i) o[i] = h ? __float_as_uint(sc[4 * q4 + i] * rsm) : ex[4 * q4 + i];
        *(u32x4*)(dst + 4 * q4) = o;
      }
    }
    __syncthreads();
  }
};


template <int CTRL> DI float dpp_f(float v) { const int iv = __float_as_int(v); return __int_as_float(__builtin_amdgcn_update_dpp(iv, iv, CTRL, 0xF, 0xF, false)); }
DI float wsum(float x) {
  x += dpp_f<0xB1>(x);
  x += dpp_f<0x4E>(x);
  x += dpp_f<0x124>(x);
  x += dpp_f<0x128>(x);
  x += shx(x, 16);
  return hsum(x);
}
DI float gelu_fast(float x) {
  const float u2 = 1.5957691216057308f * (x + 0.044715f * x * x * x);
  return x * __builtin_amdgcn_rcpf(1.f + ex2(-LOG2E * u2));
}

constexpr int EROW = 1024;
typedef float v2f __attribute__((ext_vector_type(2)));
DI void d_cvt_fp4_fin(int row, const f32x4 (&x)[8], unsigned char* __restrict__ dst, float* __restrict__ scales) {
  const int lane = TIDX & 63;
  float v[32]; float amax = 0.f;
#pragma unroll
  for (int i = 0; i < 8; ++i)
#pragma unroll
    for (int j = 0; j < 4; ++j) { v[i * 4 + j] = x[i][j]; amax = fmaxf(amax, fabsf(x[i][j])); }
  amax = wave_max(amax);
  const float sc = amax > 0.f ? amax * (1.f / 7.f) : 1.f;
  const float inv = 1.f / sc;
  u32x4 o;
#pragma unroll
  for (int k = 0; k < 4; ++k) {
    unsigned w = 0u;
#define FP4C(x_) fminf(fmaxf((x_) * inv, -6.f), 6.f)
    w = __builtin_amdgcn_cvt_scalef32_pk_fp4_f32(w, FP4C(v[8 * k + 0]), FP4C(v[8 * k + 1]), 1.0f, 0);
    w = __builtin_amdgcn_cvt_scalef32_pk_fp4_f32(w, FP4C(v[8 * k + 2]), FP4C(v[8 * k + 3]), 1.0f, 1);
    w = __builtin_amdgcn_cvt_scalef32_pk_fp4_f32(w, FP4C(v[8 * k + 4]), FP4C(v[8 * k + 5]), 1.0f, 2);
    w = __builtin_amdgcn_cvt_scalef32_pk_fp4_f32(w, FP4C(v[8 * k + 6]), FP4C(v[8 * k + 7]), 1.0f, 3);
#undef FP4C
    o[k] = w;
  }
  *(u32x4*)(dst + (size_t)row * EROW + 16 * lane) = o;
  if (lane == 0) scales[row] = sc;
}
__device__ void d_cvt_fp4_row(int row, const float* __restrict__ src, unsigned char* __restrict__ dst, float* __restrict__ scales) {
  const int lane = TIDX & 63;
  f32x4 x[8];
#pragma unroll
  for (int i = 0; i < 8; ++i) x[i] = *(const f32x4*)(src + (size_t)row * DM + 256 * i + 4 * lane);
  d_cvt_fp4_fin(row, x, dst, scales);
}
DI void d_cvt_i4_fin(int row, const f32x4 (&x)[8], unsigned char* __restrict__ dst, float* __restrict__ scales) {
  const int lane = TIDX & 63;
  float v[32]; float amax = 0.f, ss = 0.f;
#pragma unroll
  for (int i = 0; i < 8; ++i)
#pragma unroll
    for (int j = 0; j < 4; ++j) { v[i * 4 + j] = x[i][j]; amax = fmaxf(amax, fabsf(x[i][j])); ss = fmaf(x[i][j], x[i][j], ss); }
  amax = wave_max(amax); ss = wave_sum(ss);
  float sc = fmaxf(0.36f * sqrtf(ss * (1.f / DM)), amax * (1.f / 14.f));
  sc = sc > 0.f ? sc : 1.f;
  const float inv = 1.f / sc;
  u32x4 o;
#pragma unroll
  for (int k = 0; k < 4; ++k) {
    unsigned w = 0u;
#pragma unroll
    for (int j = 0; j < 8; ++j) {
      const float q = fminf(fmaxf(v[8 * k + j] * inv, -7.f), 7.f) + 12582912.f;
      w |= (__float_as_uint(q) & 15u) << (4 * j);
    }
    o[k] = w;
  }
  *(u32x4*)(dst + (size_t)row * EROW + 16 * lane) = o;
  if (lane == 0) scales[row] = sc;
}
__device__ void d_cvt_i4_row(int row, const float* __restrict__ src, unsigned char* __restrict__ dst, float* __restrict__ scales) {
  const int lane = TIDX & 63;
  f32x4 x[8];
#pragma unroll
  for (int i = 0; i < 8; ++i) x[i] = *(const f32x4*)(src + (size_t)row * DM + 256 * i + 4 * lane);
  d_cvt_i4_fin(row, x, dst, scales);
}
__device__ void d_expert_group(int tg0, int tstr, unsigned* tpl, unsigned* slw, const bf16_t* __restrict__ hbuf, const unsigned* __restrict__ tops,
                               const unsigned char* __restrict__ eu4, const unsigned char* __restrict__ ev4, const float* __restrict__ esu, const float* __restrict__ esv,
                               const float* __restrict__ gam, const float* __restrict__ bet, float* __restrict__ out) {
  const int lane = TIDX & 63;
#define SLOT(j_, f_) slw[((j_) * 16 + (f_)) * 64 + lane]
#pragma unroll 1
  for (int j = 0; j < 4; ++j) {
    const int tt = tg0 + j * tstr, t = tt < S ? tt : S - 1;
  float hv[32];
#pragma unroll
  for (int i = 0; i < 8; ++i) {
    const u32x2 w = *(const u32x2*)(hbuf + (size_t)t * DM + 256 * i + 4 * lane);
    hv[i * 4 + 0] = __uint_as_float(w[0] << 16); hv[i * 4 + 1] = __uint_as_float(w[0] & 0xFFFF0000u);
    hv[i * 4 + 2] = __uint_as_float(w[1] << 16); hv[i * 4 + 3] = __uint_as_float(w[1] & 0xFFFF0000u);
  }
  int e0 = (int)tops[(size_t)t * 256 + lane], e1 = (int)tops[(size_t)t * 256 + 64 + lane];
  float w0 = __uint_as_float(tops[(size_t)t * 256 + 128 + lane]), w1 = __uint_as_float(tops[(size_t)t * 256 + 192 + lane]);
  {
    unsigned k0 = ((unsigned)e0 << 7) | (unsigned)lane, k1 = ((unsigned)e1 << 7) | (unsigned)(64 + lane);
#pragma unroll
    for (int k = 2; k <= 128; k <<= 1) {
#pragma unroll
      for (int jj = k >> 1; jj > 0; jj >>= 1) {
        if (jj == 64) { const unsigned mn = k0 < k1 ? k0 : k1, mx = k0 < k1 ? k1 : k0; k0 = mn; k1 = mx; }
        else {
          const unsigned o0 = (unsigned)shx_i((int)k0, jj), o1 = (unsigned)shx_i((int)k1, jj);
          const bool lower = (lane & jj) == 0;
          const bool asc0 = (k >= 64) ? true : ((lane & k) == 0), asc1 = (k == 128) ? true : (k == 64) ? false : ((lane & k) == 0);
          const unsigned mn0 = k0 < o0 ? k0 : o0, mx0 = k0 < o0 ? o0 : k0, mn1 = k1 < o1 ? k1 : o1, mx1 = k1 < o1 ? o1 : k1;
          k0 = (lower == asc0) ? mn0 : mx0; k1 = (lower == asc1) ? mn1 : mx1;
        }
      }
    }
    const int o0 = (int)(k0 & 127u), o1 = (int)(k1 & 127u);
    const float wa0 = __shfl(w0, o0 & 63), wb0 = __shfl(w1, o0 & 63), wa1 = __shfl(w0, o1 & 63), wb1 = __shfl(w1, o1 & 63);
    e0 = (int)(k0 >> 7); e1 = (int)(k1 >> 7); w0 = (o0 < 64) ? wa0 : wb0; w1 = (o1 < 64) ? wa1 : wb1;
  }
  int hhi[4], hlo[4]; float hsc;
  {
    float m = 0.f;
#pragma unroll
    for (int i = 0; i < 32; ++i) m = fmaxf(m, fabsf(hv[i]));
    m = wave_max(m);
    hsc = m > 0.f ? m * (1.f / 119.f) : 1.f;
    const float hinv = 1.f / hsc;
#pragma unroll
    for (int q = 0; q < 4; ++q) {
      unsigned wh = 0u, wl = 0u;
#pragma unroll
      for (int j = 0; j < 8; ++j) {
        const unsigned b = __float_as_uint(fmaf(hv[8 * q + j], hinv, 12582912.f));
        wl |= (b & 15u) << (4 * j); wh |= (((b + 8u) >> 4) & 15u) << (4 * j);
      }
      hhi[q] = (int)wh; hlo[q] = (int)wl;
    }
  }
    const float su0 = esu[e0], su1 = esu[e1], sv0 = esv[e0], sv1 = esv[e1];
#pragma unroll
    for (int q = 0; q < 4; ++q) { SLOT(j, q) = (unsigned)hhi[q]; SLOT(j, 4 + q) = (unsigned)hlo[q]; }
    SLOT(j, 8) = (unsigned)e0; SLOT(j, 9) = (unsigned)e1;
    SLOT(j, 10) = __float_as_uint(hsc * su0); SLOT(j, 11) = __float_as_uint(hsc * su1);
    SLOT(j, 12) = __float_as_uint(w0 * sv0); SLOT(j, 13) = __float_as_uint(w1 * sv1);
  }
  u32x4 rA[4], rB[4];
  const unsigned lo16 = (unsigned)(16 * lane);
#define G_LOAD(R, TAB, EX, LB)                                                             \
  _Pragma("unroll") for (int k = 0; k < 4; ++k) {                                          \
    const int id = __builtin_amdgcn_readlane((EX), (LB) + k);                              \
    R[k] = *(const u32x4*)((TAB) + (size_t)id * EROW + lo16);                              \
  }
#define PKFMA(a_, b_, c_) __builtin_elementwise_fma((a_), (b_), (c_))
  const int srcb = 4 * (((lane & 1) << 5) | ((lane & 2) << 3));
#define G_COMP_U(R, LB)                                                                    \
  {                                                                                        \
    int dd[4];                                                                             \
    _Pragma("unroll") for (int k = 0; k < 4; ++k) {                                        \
      int dh = 0, dl = 0;                                                                  \
      _Pragma("unroll") for (int q = 0; q < 4; ++q) {                                      \
        dh = __builtin_amdgcn_sdot8((int)R[k][q], hhi[q], dh, false);                      \
        dl = __builtin_amdgcn_sdot8((int)R[k][q], hlo[q], dl, false);                      \
      }                                                                                    \
      dd[k] = dh * 16 + dl;                                                                \
      __builtin_amdgcn_sched_barrier(0);                                                   \
    }                                                                                      \
    unsigned t01, t23;                                                                     \
    { auto r_ = __builtin_amdgcn_permlane32_swap((unsigned)dd[0], (unsigned)dd[1], false, false); t01 = r_[0] + r_[1]; }     \
    { auto r_ = __builtin_amdgcn_permlane32_swap((unsigned)dd[2], (unsigned)dd[3], false, false); t23 = r_[0] + r_[1]; }     \
    const bool b4_ = (lane & 16) != 0;                                                     \
    int tv = (int)(b4_ ? t23 : t01) + shx_i((int)(b4_ ? t01 : t23), 16);                   \
    tv += dpp_i<0x128>(tv); tv += dpp_i<0x124>(tv); tv += dpp_i<0x4E>(tv); tv += dpp_i<0xB1>(tv);   \
    const int got = __builtin_amdgcn_ds_bpermute(srcb, tv);                                \
    cc = ((unsigned)(lane - (LB)) < 4u) ? got : cc;                                        \
    __builtin_amdgcn_sched_barrier(0);                                                     \
  }
#define G_COMP_V(R, ACC, CF, LB)                                                           \
  _Pragma("unroll") for (int k = 0; k < 4; ++k) {                                          \
    const float cs = __int_as_float(__builtin_amdgcn_readlane(__float_as_int(CF), (LB) + k));   \
    const v2f cs2 = {cs, cs};                                                              \
    _Pragma("unroll") for (int q = 0; q < 4; ++q) {                                        \
      const unsigned wq = R[k][q];                                                         \
      const v2f f0 = __builtin_amdgcn_cvt_scalef32_pk_f32_fp4(wq, 1.0f, 0), f1 = __builtin_amdgcn_cvt_scalef32_pk_f32_fp4(wq, 1.0f, 1); \
      const v2f f2 = __builtin_amdgcn_cvt_scalef32_pk_f32_fp4(wq, 1.0f, 2), f3 = __builtin_amdgcn_cvt_scalef32_pk_f32_fp4(wq, 1.0f, 3); \
      ACC[4 * q + 0] = PKFMA(cs2, f0, ACC[4 * q + 0]); ACC[4 * q + 1] = PKFMA(cs2, f1, ACC[4 * q + 1]); \
      ACC[4 * q + 2] = PKFMA(cs2, f2, ACC[4 * q + 2]); ACC[4 * q + 3] = PKFMA(cs2, f3, ACC[4 * q + 3]); \
    }                                                                                      \
    __builtin_amdgcn_sched_barrier(0);                                                     \
  }
  {
    int eX = (int)SLOT(0, 8);
    G_LOAD(rA, eu4, eX, 0)
    __builtin_amdgcn_sched_barrier(0);
#pragma unroll 1
    for (int s_ = 0; s_ < 32; ++s_) {
      const int sg = s_ >> 2, j = s_ & 3, L0 = (sg & 3) * 16;
      const int sn = (s_ + 1) & 31, sgn = sn >> 2, jn = sn & 3, L0n = (sgn & 3) * 16;
      if (j == 0) __builtin_amdgcn_s_barrier();
      int hhi[4], hlo[4];
#pragma unroll
      for (int q = 0; q < 4; ++q) { hhi[q] = (int)SLOT(j, q); hlo[q] = (int)SLOT(j, 4 + q); }
      const int eXn = (int)SLOT(jn, 8 + (sgn >> 2));
      const unsigned char* tabn = (s_ == 31) ? ev4 : eu4;
      int cc = 0;
      G_LOAD(rB, eu4, eX, L0 + 4)
      __builtin_amdgcn_sched_barrier(0);
      G_COMP_U(rA, L0)
      G_LOAD(rA, eu4, eX, L0 + 8)
      __builtin_amdgcn_sched_barrier(0);
      G_COMP_U(rB, L0 + 4)
      G_LOAD(rB, eu4, eX, L0 + 12)
      __builtin_amdgcn_sched_barrier(0);
      G_COMP_U(rA, L0 + 8)
      G_LOAD(rA, tabn, eXn, L0n)
      __builtin_amdgcn_sched_barrier(0);
      G_COMP_U(rB, L0 + 12)
      if ((unsigned)(lane - L0) < 16u) SLOT(j, 14 + (sg >> 2)) = (unsigned)cc;
      eX = eXn;
    }
  }
#pragma unroll 1
  for (int j = 0; j < 4; ++j) {
    const float d0 = (float)(int)SLOT(j, 14), d1 = (float)(int)SLOT(j, 15);
    SLOT(j, 14) = __float_as_uint(__uint_as_float(SLOT(j, 12)) * gelu_fast(__uint_as_float(SLOT(j, 10)) * d0));
    SLOT(j, 15) = __float_as_uint(__uint_as_float(SLOT(j, 13)) * gelu_fast(__uint_as_float(SLOT(j, 11)) * d1));
  }
  v2f accv[4][16];
#pragma unroll
  for (int j = 0; j < 4; ++j)
#pragma unroll
    for (int i = 0; i < 16; ++i) accv[j][i] = v2f{0.f, 0.f};
  {
    int eX = (int)SLOT(0, 8);
#pragma unroll 1
    for (int sg = 0; sg < 8; ++sg) {
      const int L0 = (sg & 3) * 16;
      __builtin_amdgcn_s_barrier();
#pragma unroll
      for (int j = 0; j < 4; ++j) {
        const int jn = (j + 1) & 3, sgn = (j == 3) ? ((sg + 1) & 7) : sg, L0n = (sgn & 3) * 16;
        const float cf = __uint_as_float(SLOT(j, 14 + (sg >> 2)));
        const int eXn = (int)SLOT(jn, 8 + (sgn >> 2));
        G_LOAD(rB, ev4, eX, L0 + 4)
        __builtin_amdgcn_sched_barrier(0);
        G_COMP_V(rA, accv[j], cf, L0)
        G_LOAD(rA, ev4, eX, L0 + 8)
        __builtin_amdgcn_sched_barrier(0);
        G_COMP_V(rB, accv[j], cf, L0 + 4)
        G_LOAD(rB, ev4, eX, L0 + 12)
        __builtin_amdgcn_sched_barrier(0);
        G_COMP_V(rA, accv[j], cf, L0 + 8)
        G_LOAD(rA, ev4, eXn, L0n)
        __builtin_amdgcn_sched_barrier(0);
        G_COMP_V(rB, accv[j], cf, L0 + 12)
        eX = eXn;
      }
    }
  }
#undef G_LOAD
#undef G_COMP_U
#undef G_COMP_V
#undef PKFMA
#pragma unroll
  for (int j = 0; j < 4; ++j) {
    const int t = tg0 + j * tstr;
    if (t < S) {
#define acc2 accv[j]
  float acc[32];
  #pragma unroll
    for (int i = 0; i < 16; ++i) { acc[2 * i] = acc2[i].x; acc[2 * i + 1] = acc2[i].y; }
    int le = lane;
    asm volatile("" : "+v"(le) :: "memory");
    float s = 0.f;
  #pragma unroll
    for (int i = 0; i < 8; ++i) {
      const u32x2 w = *(const u32x2*)(hbuf + (size_t)t * DM + 256 * i + 4 * le);
      const float h0 = __uint_as_float(w[0] << 16), h1 = __uint_as_float(w[0] & 0xFFFF0000u), h2 = __uint_as_float(w[1] << 16), h3 = __uint_as_float(w[1] & 0xFFFF0000u);
      acc[i * 4 + 0] = fmaf(ALPHA, h0, acc[i * 4 + 0]); acc[i * 4 + 1] = fmaf(ALPHA, h1, acc[i * 4 + 1]);
      acc[i * 4 + 2] = fmaf(ALPHA, h2, acc[i * 4 + 2]); acc[i * 4 + 3] = fmaf(ALPHA, h3, acc[i * 4 + 3]);
      s += (acc[i * 4 + 0] + acc[i * 4 + 1]) + (acc[i * 4 + 2] + acc[i * 4 + 3]);
    }
    s = wsum(s);
    const float mu = s * (1.f / DM);
    float qv = 0.f;
  #pragma unroll
    for (int i = 0; i < 32; ++i) { const float d = acc[i] - mu; qv += d * d; }
    qv = wsum(qv);
    const float rs = rsqrtf(qv * (1.f / DM) + 1e-5f);
  #pragma unroll
    for (int i = 0; i < 8; ++i) {
      const int cbase = 256 * i + 4 * le;
      f32x4 ga = *(const f32x4*)(gam + cbase), ba = *(const f32x4*)(bet + cbase), o;
  #pragma unroll
      for (int j = 0; j < 4; ++j) o[j] = (acc[i * 4 + j] - mu) * rs * ga[j] + ba[j];
      *(f32x4*)(out + (size_t)t * DM + cbase) = o;
    }
#undef acc2
    }
  }
#undef SLOT
}

constexpr size_t al256(size_t x) { return (x + 255) & ~(size_t)255; }
constexpr size_t WS_XB = 0;
constexpr size_t WS_PROJ = WS_XB + al256((size_t)S * DM * 2);
constexpr size_t WS_WINT = WS_PROJ + al256((size_t)S * INWP * 2);
constexpr size_t WS_GATES = WS_WINT + al256((size_t)INWG * DM * 2);
constexpr size_t WS_W1KF = WS_GATES + al256((size_t)S * 24 * 4);
constexpr size_t WS_W1VF = WS_W1KF + al256((size_t)512 * 4096 * 2);
constexpr size_t WS_W2KF = WS_W1VF + al256((size_t)512 * 4096 * 2);
constexpr size_t WS_W2VF = WS_W2KF + al256((size_t)512 * 128 * 2);
constexpr size_t WS_VC = WS_W2VF + al256((size_t)512 * 128 * 2) - al256((size_t)2048 * 128 * 4);
constexpr size_t WS_KCF = WS_VC + al256((size_t)2048 * 128 * 4);
constexpr size_t WS_VCF = WS_KCF + al256((size_t)2 * 32 * 4096 * 2);
constexpr size_t WS_KSF = WS_VCF + al256((size_t)2 * 32 * 4096 * 2);
constexpr size_t WS_VSF = WS_KSF + al256((size_t)2 * 512 * 4096 * 2);
constexpr size_t WS_KWF = WS_VSF + al256((size_t)2 * 512 * 4096 * 2);
constexpr size_t WS_VWF = WS_KWF + al256((size_t)2 * 512 * 4096 * 2);
constexpr size_t WS_ENDA = WS_VWF + al256((size_t)2 * 512 * 4096 * 2);
constexpr size_t WS_OATT = WS_ENDA;
constexpr size_t WS_MIX = WS_OATT + al256((size_t)S * 1024 * 4);
constexpr size_t WS_WOUTT = WS_MIX + al256((size_t)S * DM * 2);
constexpr size_t WS_WQT = WS_WOUTT + al256((size_t)DM * DM * 2);
constexpr size_t WS_TOPS = WS_WQT + al256((size_t)DM * DM * 2);
constexpr size_t WS_SKF = WS_TOPS + al256((size_t)S * 256 * 4);
constexpr size_t WS_STATS = WS_SKF + al256((size_t)16 * 128 * 128 * 2);
constexpr size_t WS_CTRL = WS_STATS + al256((size_t)S * 2 * 4);
constexpr size_t CTRL_BYTES = 32768;
constexpr size_t WS_END = WS_CTRL + CTRL_BYTES;
constexpr size_t WS_Y = WS_PROJ;
constexpr size_t WS_HB = WS_XB;
constexpr size_t WS_EU8 = WS_OATT;
constexpr size_t WS_EV8 = WS_EU8 + (size_t)16384 * 1024;
constexpr size_t WS_ESU = WS_EV8 + (size_t)16384 * 1024;
constexpr size_t WS_ESV = WS_ESU + 16384 * 4;
static_assert(WS_ESV + 16384 * 4 <= WS_MIX, "expert tables overflow their region");
constexpr int EXP_EARLY = 6144;
static_assert(WS_END <= (size_t)512 * 1024 * 1024, "workspace over 512 MiB");

struct Params {
  const float *x, *w_in, *ck_pos, *ck_w1, *ck_b1, *ck_w2, *cv_pos, *cv_w1, *cv_b1, *cv_w2, *conv_w, *hng, *w_out, *ln1g, *ln1b, *w_query, *subk,
      *eu, *ev, *ln2g, *ln2b;
  float* out;
  char* ws;
};
#define WSP(T, OFF) ((T*)(p.ws + (OFF)))

#define FOR_VB(n) for (int vb = blockIdx.x; vb < (n); vb += gridDim.x)
#define FOR_VB2(n) for (int vb = blockIdx.x * 2 + (TIDX >> 8); vb < (n); vb += gridDim.x * 2)
constexpr int SMEM_BYTES = 147456;
constexpr int HALF = 36864;

__global__ void __launch_bounds__(512) mega(Params p) {
  __shared__ __attribute__((aligned(16))) char smem[SMEM_BYTES + 16];
  if (TIDX == 0) *(u32x4*)(smem + SMEM_BYTES) = u32x4{0u, 0u, 0u, 0u};
  __syncthreads();
  const XcdBarrier xbar = xcd_barrier_post(WSP(unsigned, WS_CTRL + 1024), (volatile LAS unsigned*)(smem + SMEM_BYTES));
#define smh (smem + (TIDX >> 8) * HALF)
#define wv ((TIDX >> 6))
  constexpr int NWV = 8;
  d_cvt(p.x, WSP(bf16_t, WS_XB), (size_t)S * DM / 4);
  FOR_VB2((INWG / 64) * (DM / 64)) d_cvtT64(vb, smh, p.w_in, WSP(bf16_t, WS_WINT), DM, INW, INWG);
  for (size_t c = (size_t)blockIdx.x * 512 + TIDX; c < (size_t)16 * 256 * 64; c += (size_t)gridDim.x * 512) {
    d_cvt_w1f(c, p.ck_w1, WSP(bf16_t, WS_W1KF)); d_cvt_w1f(c, p.cv_w1, WSP(bf16_t, WS_W1VF));
    if (c < (size_t)4 * 32 * 64) { d_cvt_w2f(c, p.ck_w2, WSP(bf16_t, WS_W2KF)); d_cvt_w2f(c, p.cv_w2, WSP(bf16_t, WS_W2VF)); }
  }
  FOR_VB2((DM / 64) * (DM / 64)) d_cvtT64(vb, smh, p.w_out, WSP(bf16_t, WS_WOUTT), DM, DM, DM);
  FOR_VB2((DM / 64) * (DM / 64)) d_cvtT64(vb, smh, p.w_query, WSP(bf16_t, WS_WQT), DM, DM, DM);
  for (size_t c = (size_t)blockIdx.x * 512 + TIDX; c < (size_t)16 * 4 * 8 * 64; c += (size_t)gridDim.x * 512) d_cvt_subk(c, p.subk, WSP(bf16_t, WS_SKF));
  xcd_barrier(xbar);
  {
    pg8::StaticOrder so; so.init(S, INWG, gridDim.x, blockIdx.x);
    pg8::gemm_phase<EpiProjG, pg8::StaticOrder>((PG8_LAS unsigned char*)smem, pg8::Gemm{WSP(bf16_t, WS_XB), WSP(bf16_t, WS_WINT), S, INWG, DM}, so,
                                                EpiProjG{WSP(bf16_t, WS_PROJ), WSP(float, WS_GATES), (PG8_LAS unsigned char*)smem + pg8::STAGE_BYTES}, nullptr);
    const int nun = (S / 256) * (INWG / 256), gsz = (int)gridDim.x;
    const int nfull = nun % gsz;
    if (nfull != 0 && (int)blockIdx.x >= nfull) {
      const int nidle = gsz - nfull, me = (int)blockIdx.x - nfull;
      for (int r = me * NWV + wv; r < 2 * EXP_EARLY; r += nidle * NWV) {
        if (r < EXP_EARLY) d_cvt_i4_row(r, p.eu, WSP(unsigned char, WS_EU8), WSP(float, WS_ESU)); else d_cvt_fp4_row(r - EXP_EARLY, p.ev, WSP(unsigned char, WS_EV8), WSP(float, WS_ESV));
      }
    }
  }
  xcd_barrier(xbar);
  {
    if (gridDim.x >= 256) {
      const int xcd_ = blockIdx.x & 7, idx_ = blockIdx.x >> 3; const bool isV = (xcd_ & 1) != 0;
      if (idx_ < 16) {
        const int rt = (xcd_ >> 1) * 8 + (idx_ >> 1), uid = (isV ? 32 : 0) + rt;
        d_compress_unit64(rt, idx_ & 1, smem, WSP(bf16_t, WS_PROJ), isV ? OFF_VC : OFF_KC, isV ? p.cv_pos : p.ck_pos, isV ? WSP(bf16_t, WS_W1VF) : WSP(bf16_t, WS_W1KF),
                          isV ? p.cv_b1 : p.ck_b1, isV ? WSP(bf16_t, WS_W2VF) : WSP(bf16_t, WS_W2KF), isV ? WSP(bf16_t, WS_VCF) : WSP(bf16_t, WS_KCF), isV,
                          WSP(float, WS_TOPS) + (size_t)uid * 512 * 64, WSP(unsigned, WS_CTRL + 16384) + uid * 16);
      }
    } else if (blockIdx.x < 128) {
      const int xcd_ = blockIdx.x & 7, idx_ = blockIdx.x >> 3; const bool isV = (xcd_ & 1) != 0;
      d_compress_unit((xcd_ >> 1) * 16 + idx_, smem, WSP(bf16_t, WS_PROJ), isV ? OFF_VC : OFF_KC, isV ? p.cv_pos : p.ck_pos, isV ? WSP(bf16_t, WS_W1VF) : WSP(bf16_t, WS_W1KF),
                      isV ? p.cv_b1 : p.ck_b1, isV ? WSP(bf16_t, WS_W2VF) : WSP(bf16_t, WS_W2KF), isV ? WSP(bf16_t, WS_VCF) : WSP(bf16_t, WS_KCF), isV);
    }
    int* slot = (int*)smem;
    unsigned* ctr = WSP(unsigned, WS_CTRL);
    if (TIDX == 0) slot[0] = (int)atomicAdd(ctr, 1u);
    __syncthreads();
    int it = slot[0];
    bf16_t* Ls = (bf16_t*)(smem + 64);
#pragma unroll 1
    for (int n = 0; it < 2048; ++n) {
      int nxt = 0;
      if (TIDX == 0) nxt = (int)atomicAdd(ctr, 1u);
      const int tt = TIDX;
      const int T = it >> 2, which = it & 3;
      const int col0 = (which == 0) ? OFF_KS : (which == 1) ? OFF_VS : (which == 2) ? OFF_KW : OFF_VW;
      bf16_t* dst = (which == 0) ? WSP(bf16_t, WS_KSF) : (which == 1) ? WSP(bf16_t, WS_VSF) : (which == 2) ? WSP(bf16_t, WS_KWF) : WSP(bf16_t, WS_VWF);
      const bool isV = (which & 1) != 0;
      u32x4 rv[2];
#pragma unroll
      for (int q = 0; q < 2; ++q) {
        const int cidx = tt + q * 512;
        const int g = cidx >> 9, tok = (cidx >> 4) & 31, ch = cidx & 15;
        rv[q] = *(const u32x4*)(WSP(bf16_t, WS_PROJ) + (size_t)(32 * T + tok) * INWP + col0 + g * 128 + ch * 8);
      }
      d_convmix2(it * 8 + (tt >> 7), tt & 127, WSP(bf16_t, WS_PROJ), p.conv_w, p.hng, WSP(bf16_t, WS_MIX));
#pragma unroll
      for (int q = 0; q < 2; ++q) {
        const int cidx = tt + q * 512;
        const int g = cidx >> 9, tok = (cidx >> 4) & 31, ch = cidx & 15;
        *(u32x4*)(Ls + (g * 32 + tok) * 136 + ch * 8) = rv[q];
      }
      if (TIDX == 0) slot[(n + 1) & 1] = nxt;
      __syncthreads();
#pragma unroll
      for (int q = 0; q < 2; ++q) {
        const int oc = tt + q * 512;
        const int g = oc >> 9, r9 = oc & 511, lane = r9 & 63;
        u32x4 o;
        if (!isV) {
          const int s8 = r9 >> 6, i = lane & 31, h = lane >> 5;
          o = *(const u32x4*)(Ls + (g * 32 + pi_perm(i)) * 136 + 16 * s8 + 8 * h);
        } else {
          const int s2 = (r9 >> 6) & 1, dt = r9 >> 7, dd = lane & 31, h = lane >> 5;
          const bf16_t* col = Ls + (g * 32 + 16 * s2 + 8 * h) * 136 + 32 * dt + dd;
          unsigned short e[8];
#pragma unroll
          for (int j = 0; j < 8; ++j) e[j] = col[j * 136];
          o.x = e[0] | ((unsigned)e[1] << 16); o.y = e[2] | ((unsigned)e[3] << 16); o.z = e[4] | ((unsigned)e[5] << 16); o.w = e[6] | ((unsigned)e[7] << 16);
        }
        *(u32x4*)(dst + (((size_t)(g * 512 + T)) * 512 + r9) * 8) = o;
      }
      it = slot[(n + 1) & 1];
      __syncthreads();
    }
  }
  xcd_barrier(xbar);
  {
    AttnPtrs ap{WSP(bf16_t, WS_PROJ), WSP(float, WS_GATES), WSP(bf16_t, WS_KCF), WSP(bf16_t, WS_VCF), WSP(bf16_t, WS_KSF), WSP(bf16_t, WS_VSF), WSP(bf16_t, WS_KWF), WSP(bf16_t, WS_VWF), WSP(bf16_t, WS_MIX), p.hng};
    for (int it = blockIdx.x; it < 512; it += gridDim.x) {
      const int Bq = (it < 256) ? it : (511 - it), gq = (it < 256) ? 0 : 1;
      d_attn_block(Bq, gq, smem, ap);
    }
  }
  xcd_barrier(xbar);
  {
    pg8::StaticOrder so; so.init(S, DM, gridDim.x, blockIdx.x);
    pg8::gemm_phase<EpiResG, pg8::StaticOrder>((PG8_LAS unsigned char*)smem, pg8::Gemm{WSP(bf16_t, WS_MIX), WSP(bf16_t, WS_WOUTT), S, DM, DM}, so,
                                               EpiResG{WSP(bf16_t, WS_HB), (PG8_LAS unsigned char*)smem + pg8::STAGE_BYTES}, nullptr);
  }
  xcd_barrier(xbar);
  {
    const int e0_ = (((S / 256) * (INWG / 256)) % (int)gridDim.x != 0) ? EXP_EARLY : 0;
    const int nrest = 16384 - e0_, ncv = 2 * nrest, wstr = (int)gridDim.x * NWV, lane_ = TIDX & 63;
    int rl = blockIdx.x * NWV + wv, rc = rl;
    u32x4 lcur[4], lnxt[4]; f32x4 ccur[8], cnxt[8];
#define P8_LDLN(R, r_) { _Pragma("unroll") for (int i = 0; i < 4; ++i) R[i] = *(const u32x4*)(WSP(bf16_t, WS_HB) + (size_t)(r_) * DM + 512 * i + 8 * lane_); }
#define P8_LDCV(R, r_) { const float* src_ = ((r_) < nrest) ? p.eu + (size_t)(e0_ + (r_)) * DM : p.ev + (size_t)(e0_ + (r_) - nrest) * DM; \
                         _Pragma("unroll") for (int i = 0; i < 8; ++i) R[i] = *(const f32x4*)(src_ + 256 * i + 4 * lane_); }
    if (rl < S) P8_LDLN(lcur, rl)
    if (rc < ncv) P8_LDCV(ccur, rc)
#pragma unroll 1
    while (rl < S || rc < ncv) {
      const int rln = rl + wstr, rcn = rc + wstr;
      if (rln < S) P8_LDLN(lnxt, rln)
      if (rcn < ncv) P8_LDCV(cnxt, rcn)
      __builtin_amdgcn_sched_barrier(0);
      if (rl < S) d_ln_fin(rl, lcur, WSP(bf16_t, WS_HB), p.ln1g, p.ln1b);
      if (rc < ncv) {
        if (rc < nrest) d_cvt_i4_fin(e0_ + rc, ccur, WSP(unsigned char, WS_EU8), WSP(float, WS_ESU));
        else d_cvt_fp4_fin(e0_ + rc - nrest, ccur, WSP(unsigned char, WS_EV8), WSP(float, WS_ESV));
      }
      __builtin_amdgcn_sched_barrier(0);
#pragma unroll
      for (int i = 0; i < 4; ++i) lcur[i] = lnxt[i];
#pragma unroll
      for (int i = 0; i < 8; ++i) ccur[i] = cnxt[i];
      rl = rln; rc = rcn;
    }
#undef P8_LDLN
#undef P8_LDCV
  }
  xcd_barrier(xbar);
  for (int k = 0; k * (int)gridDim.x < (S / 256) * (DM / 256); ++k) {
    pg8::OneUnit so; so.init(S, DM, gridDim.x, blockIdx.x); so.k = k;
    pg8::gemm_phase<EpiRouteG, pg8::OneUnit>((PG8_LAS unsigned char*)smem, pg8::Gemm{WSP(bf16_t, WS_HB), WSP(bf16_t, WS_WQT), S, DM, DM}, so,
                                             EpiRouteG{WSP(bf16_t, WS_SKF), WSP(unsigned, WS_TOPS)}, nullptr);
    __syncthreads();
  }
  xcd_barrier(xbar);
  {
    const int tstr = (int)gridDim.x * NWV;
    for (int tg0 = blockIdx.x * NWV + wv; tg0 < S; tg0 += 4 * tstr)
      d_expert_group(tg0, tstr, (unsigned*)(smem + wv * 1024), (unsigned*)(smem + 8192 + wv * 16384), WSP(bf16_t, WS_HB), WSP(unsigned, WS_TOPS), WSP(unsigned char, WS_EU8), WSP(unsigned char, WS_EV8),
                     WSP(float, WS_ESU), WSP(float, WS_ESV), p.ln2g, p.ln2b, p.out);
  }
}

extern "C" void kernel_launch(void* const* d_in, const int* in_sizes, int n_in, void* d_out, int out_size, void* d_ws, size_t ws_size,
                              hipStream_t stream) {
  Params p{};
  p.x = (const float*)d_in[0]; p.w_in = (const float*)d_in[1]; p.ck_pos = (const float*)d_in[2]; p.ck_w1 = (const float*)d_in[3];
  p.ck_b1 = (const float*)d_in[4]; p.ck_w2 = (const float*)d_in[5]; p.cv_pos = (const float*)d_in[6]; p.cv_w1 = (const float*)d_in[7];
  p.cv_b1 = (const float*)d_in[8]; p.cv_w2 = (const float*)d_in[9]; p.conv_w = (const float*)d_in[10]; p.hng = (const float*)d_in[11];
  p.w_out = (const float*)d_in[12]; p.ln1g = (const float*)d_in[13]; p.ln1b = (const float*)d_in[14]; p.w_query = (const float*)d_in[15];
  p.subk = (const float*)d_in[16]; p.eu = (const float*)d_in[17]; p.ev = (const float*)d_in[18]; p.ln2g = (const float*)d_in[19];
  p.ln2b = (const float*)d_in[20];
  p.out = (float*)d_out;
  p.ws = (char*)d_ws;
  if (ws_size < WS_END) fprintf(stderr, "workspace too small\n");
  static int grid_blocks = 0;
  if (!grid_blocks) {
    int dev = 0, cus = 0, per_cu = 0;
    hipGetDevice(&dev);
    hipDeviceGetAttribute(&cus, hipDeviceAttributeMultiprocessorCount, dev);
    hipOccupancyMaxActiveBlocksPerMultiprocessor(&per_cu, mega, 512, 0);
    if (per_cu > 1) per_cu = 1;
    if (per_cu < 1) per_cu = 1;
    grid_blocks = cus * per_cu;
  }
  hipMemsetAsync((char*)d_ws + WS_CTRL, 0, CTRL_BYTES, stream);
  void* args[] = {&p};
  hipError_t e = hipLaunchCooperativeKernel((void*)mega, dim3(grid_blocks), dim3(512), args, 0, stream);
  if (e != hipSuccess) fprintf(stderr, "cooperative launch failed: %s (grid %d)\n", hipGetErrorString(e), grid_blocks);
}
```
